# Optimizing an MI355X kernel written in HIP

```python
import math
import jax, jax.numpy as jnp
from jax import lax
import numpy as np

D_MODEL = 1024
BATCH = 8
SEQ = 2048
DEPTH = 1
DEC_BATCH = 128
DEC_SEQ = 4
PAST_LEN = 16384
PAGE_SIZE = 128

SSD_EXPAND = 2
SSD_INNER = SSD_EXPAND * D_MODEL
SSD_HEAD_DIM = 64
SSD_HEADS = SSD_INNER // SSD_HEAD_DIM
SSD_GROUPS = 4
SSD_STATE = 128
SSD_CONV = 4
SSD_CHUNK = 128
SSD_CONV_DIM = SSD_INNER + 2 * SSD_GROUPS * SSD_STATE
HG_EXPAND = 128
HG_HEADS = D_MODEL // HG_EXPAND
HG_KDIM = HG_HEADS * HG_EXPAND
HG_VDIM = D_MODEL
HG_HEAD_V = HG_VDIM // HG_HEADS
HG_CHUNK = 32
MEM_LEN = 256
XA_HEADS = 4
XA_HEAD_DIM = D_MODEL // XA_HEADS
FFN_DIM = ((-(-8 * D_MODEL // 3)) + 255) // 256 * 256
EPS = 1e-6
F32 = jnp.float32
IN_SIZES = (SSD_INNER, SSD_CONV_DIM, SSD_HEADS, HG_KDIM, HG_KDIM, HG_VDIM, HG_VDIM, D_MODEL, D_MODEL)
IN_DIM = sum(IN_SIZES)
IN_SPLITS = tuple(int(v) for v in np.cumsum(IN_SIZES)[:-1])

kernel_name = 'hybrid_ssd_hgrn2_gated_decoder_step'


def group_rmsnorm(x, w, groups):
    shp = x.shape
    xg = x.astype(F32).reshape(shp[:-1] + (groups, shp[-1] // groups))
    xg = xg * lax.rsqrt(jnp.mean(xg * xg, axis=-1, keepdims=True) + EPS)
    return (xg.reshape(shp) * w.astype(F32)).astype(x.dtype)


def rmsnorm(x, w):
    return group_rmsnorm(x, w, 1)


def causal_dwconv(full, w, b):
    y = lax.conv_general_dilated(full, w[:, None, :], window_strides=(1,), padding='VALID',
                                 dimension_numbers=('NWC', 'WIO', 'NWC'),
                                 feature_group_count=full.shape[-1])
    return y + b


def ssd_scan(x, dt, a, bm, cm, h0):
    bsz, L = x.shape[:2]
    q = SSD_CHUNK if L % SSD_CHUNK == 0 else L
    nc = L // q
    r = SSD_HEADS // SSD_GROUPS

    def chunks(t, tail):
        return jnp.moveaxis(t.astype(F32).reshape((bsz, nc, q) + tail), 1, 0)

    xs = chunks(x, (SSD_GROUPS, r, SSD_HEAD_DIM))
    dts = chunks(dt, (SSD_GROUPS, r))
    bs = chunks(bm, (SSD_GROUPS, SSD_STATE))
    cs = chunks(cm, (SSD_GROUPS, SSD_STATE))
    ag = a.astype(F32).reshape(SSD_GROUPS, r)
    causal = jnp.tril(jnp.ones((q, q), bool))[None, :, :, None, None]

    def step(h, inp):
        xc, dtc, bc, cc = inp
        cum = jnp.cumsum(dtc * ag, axis=1)
        decay = jnp.exp(jnp.where(causal, cum[:, :, None] - cum[:, None, :], -jnp.inf))
        cb = jnp.einsum('btgn,bsgn->btsg', cc, bc)
        y = jnp.einsum('btsg,btsgr,bsgrp->btgrp', cb, decay, xc * dtc[..., None])
        y = y + jnp.einsum('btgn,bgrpn->btgrp', cc, h) * jnp.exp(cum)[..., None]
        w_end = jnp.exp(cum[:, -1:] - cum) * dtc
        h = h * jnp.exp(cum[:, -1])[..., None, None] + jnp.einsum('bsgr,bsgn,bsgrp->bgrpn', w_end, bc, xc)
        return h, y

    h0g = h0.astype(F32).reshape(bsz, SSD_GROUPS, r, SSD_HEAD_DIM, SSD_STATE)
    hT, ys = lax.scan(step, h0g, (xs, dts, bs, cs))
    y = jnp.moveaxis(ys, 0, 1).reshape(bsz, L, SSD_HEADS, SSD_HEAD_DIM)
    return y.astype(x.dtype), hT.reshape(bsz, SSD_HEADS, SSD_HEAD_DIM, SSD_STATE).astype(h0.dtype)


def hgrn2_scan(q, k, v, logf, s0):
    bsz, L = q.shape[:2]
    c = HG_CHUNK if L % HG_CHUNK == 0 else L
    nc = L // c

    def chunks(t):
        return jnp.moveaxis(t.astype(F32).reshape((bsz, nc, c) + t.shape[2:]), 1, 0)

    causal = jnp.tril(jnp.ones((c, c), bool))[None, :, :, None, None]

    def step(s, inp):
        qc, kc, vc, lc = inp
        g = jnp.cumsum(lc, axis=1)
        decay = jnp.exp(jnp.where(causal, g[:, :, None] - g[:, None, :], -jnp.inf))
        att = jnp.einsum('bthk,btshk,bshk->btsh', qc, decay, kc)
        o = jnp.einsum('btsh,bshv->bthv', att, vc) + jnp.einsum('bthk,bhkv->bthv', qc * jnp.exp(g), s)
        s = s * jnp.exp(g[:, -1])[..., None] + jnp.einsum('bshk,bshv->bhkv', kc * jnp.exp(g[:, -1:] - g), vc)
        return s, o

    sT, os_ = lax.scan(step, s0.astype(F32), (chunks(q), chunks(k), chunks(v), chunks(logf)))
    o = jnp.moveaxis(os_, 0, 1).reshape(bsz, L, HG_HEADS, HG_HEAD_V)
    return o.astype(q.dtype), sT.astype(s0.dtype)


def token_mixers(hn, conv_buf, ssm_h, hg_s, p, lb):
    bsz, L, _ = hn.shape
    proj = hn @ p['w_in']
    z, xbc, dt_raw, hq, hf, hi, hgate, g_ssd, g_hg = jnp.split(proj, IN_SPLITS, axis=-1)
    full = jnp.concatenate([conv_buf, xbc], axis=1)
    conv_new = full[:, -(SSD_CONV - 1):]
    xbc = jax.nn.silu(causal_dwconv(full, p['conv_w'], p['conv_b']))
    xs, bm, cm = jnp.split(xbc, [SSD_INNER, SSD_INNER + SSD_GROUPS * SSD_STATE], axis=-1)
    xs = xs.reshape(bsz, L, SSD_HEADS, SSD_HEAD_DIM)
    bm = bm.reshape(bsz, L, SSD_GROUPS, SSD_STATE)
    cm = cm.reshape(bsz, L, SSD_GROUPS, SSD_STATE)
    dt = jax.nn.softplus(dt_raw.astype(F32) + p['dt_bias'].astype(F32))
    a = -jnp.exp(p['a_log'].astype(F32))
    y, ssm_new = ssd_scan(xs, dt, a, bm, cm, ssm_h)
    y = (y + xs * p['d_skip'][:, None]).reshape(bsz, L, SSD_INNER) * jax.nn.silu(z)
    ssd_out = group_rmsnorm(y, p['ssd_norm'], SSD_GROUPS) @ p['w_ssd_out']
    u = hf.astype(F32)
    logf = jnp.log(lb + (1.0 - lb) * jax.nn.sigmoid(u))
    k = (1.0 - lb) * jax.nn.sigmoid(-u)
    heads = lambda t: t.reshape(bsz, L, HG_HEADS, -1)
    o, hg_new = hgrn2_scan(heads(jax.nn.silu(hq)), heads(k), heads(hi), heads(logf), hg_s)
    o = group_rmsnorm(o.reshape(bsz, L, HG_VDIM), p['hgrn_norm'], HG_HEADS) * jax.nn.silu(hgate)
    hg_out = o @ p['w_hgrn_out']
    merged = jax.nn.sigmoid(g_ssd) * ssd_out + jax.nn.sigmoid(g_hg) * hg_out
    return merged @ p['w_out'], conv_new, ssm_new, hg_new


def memory_kv(mem, p):
    bsz = mem.shape[0]
    mn = rmsnorm(mem, p['norm_mem'])
    mk = (mn @ p['w_ck']).reshape(bsz, MEM_LEN, XA_HEADS, XA_HEAD_DIM)
    mv = (mn @ p['w_cv']).reshape(bsz, MEM_LEN, XA_HEADS, XA_HEAD_DIM)
    return mk, mv


def cross_attn(hn, mk, mv, p):
    bsz, L, _ = hn.shape
    q = (hn @ p['w_cq']).reshape(bsz, L, XA_HEADS, XA_HEAD_DIM)
    s = jnp.einsum('blhd,bmhd->bhlm', q, mk).astype(F32) * (XA_HEAD_DIM ** -0.5)
    pr = jax.nn.softmax(s, axis=-1).astype(mv.dtype)
    o = jnp.einsum('bhlm,bmhd->blhd', pr, mv).reshape(bsz, L, XA_HEADS * XA_HEAD_DIM)
    return o @ p['w_co']


def swiglu(hn, p):
    return (jax.nn.silu(hn @ p['w_gate']) * (hn @ p['w_up'])) @ p['w_down']


def decoder_layer(x, conv_buf, ssm_h, hg_s, mk, mv, p, lb):
    mix, conv_new, ssm_new, hg_new = token_mixers(rmsnorm(x, p['norm_mix']), conv_buf, ssm_h, hg_s, p, lb)
    x = x + mix
    x = x + cross_attn(rmsnorm(x, p['norm_cross']), mk, mv, p)
    x = x + swiglu(rmsnorm(x, p['norm_ffn']), p)
    return x, conv_new, ssm_new, hg_new


def setup_inputs(seed: int = 0) -> dict:
    key = jax.random.key(seed)
    ks = jax.random.split(key, 32)
    nrm = lambda k, shape, scale: jax.random.normal(k, shape, jnp.float32) * scale
    gain = lambda k, shape: 1.0 + 0.02 * jax.random.normal(k, shape, jnp.float32)
    dt0 = jnp.exp(jax.random.uniform(ks[12], (DEPTH, SSD_HEADS), jnp.float32, math.log(1e-3), math.log(1e-1)))
    dt_bias = dt0 + jnp.log(-jnp.expm1(-dt0))
    a_log = jnp.log(jax.random.uniform(ks[13], (DEPTH, SSD_HEADS), jnp.float32, 1.0, 16.0))
    xa = XA_HEADS * XA_HEAD_DIM
    return {
        'x_prompt': nrm(ks[0], (BATCH, SEQ, D_MODEL), 1.0),
        'x_sample': nrm(ks[1], (DEC_BATCH, DEC_SEQ, D_MODEL), 1.0),
        'mem_prompt': nrm(ks[2], (BATCH, MEM_LEN, D_MODEL), 1.0),
        'state_ssm': nrm(ks[3], (DEPTH, DEC_BATCH, SSD_HEADS, SSD_HEAD_DIM, SSD_STATE), 0.5),
        'state_conv': nrm(ks[4], (DEPTH, DEC_BATCH, SSD_CONV - 1, SSD_CONV_DIM), 1.0),
        'state_hgrn': nrm(ks[5], (DEPTH, DEC_BATCH, HG_HEADS, HG_EXPAND, HG_HEAD_V), 0.5),
        'cache_mem_k': nrm(ks[6], (DEPTH, DEC_BATCH, MEM_LEN, XA_HEADS, XA_HEAD_DIM), 1.0),
        'cache_mem_v': nrm(ks[7], (DEPTH, DEC_BATCH, MEM_LEN, XA_HEADS, XA_HEAD_DIM), 1.0),
        'norm_mix': gain(ks[8], (DEPTH, D_MODEL)),
        'w_in': nrm(ks[9], (DEPTH, D_MODEL, IN_DIM), D_MODEL ** -0.5),
        'conv_w': nrm(ks[10], (DEPTH, SSD_CONV, SSD_CONV_DIM), SSD_CONV ** -0.5),
        'conv_b': nrm(ks[11], (DEPTH, SSD_CONV_DIM), 0.02),
        'dt_bias': dt_bias,
        'a_log': a_log,
        'd_skip': gain(ks[14], (DEPTH, SSD_HEADS)),
        'ssd_norm': gain(ks[15], (DEPTH, SSD_INNER)),
        'w_ssd_out': nrm(ks[16], (DEPTH, SSD_INNER, D_MODEL), SSD_INNER ** -0.5),
        'hgrn_lb': nrm(ks[17], (DEPTH + 1, HG_KDIM), 0.5),
        'hgrn_norm': gain(ks[18], (DEPTH, HG_VDIM)),
        'w_hgrn_out': nrm(ks[19], (DEPTH, HG_VDIM, D_MODEL), HG_VDIM ** -0.5),
        'w_out': nrm(ks[20], (DEPTH, D_MODEL, D_MODEL), D_MODEL ** -0.5),
        'norm_cross': gain(ks[21], (DEPTH, D_MODEL)),
        'norm_mem': gain(ks[22], (DEPTH, D_MODEL)),
        'w_cq': nrm(ks[23], (DEPTH, D_MODEL, xa), D_MODEL ** -0.5),
        'w_ck': nrm(ks[24], (DEPTH, D_MODEL, xa), D_MODEL ** -0.5),
        'w_cv': nrm(ks[25], (DEPTH, D_MODEL, xa), D_MODEL ** -0.5),
        'w_co': nrm(ks[26], (DEPTH, xa, D_MODEL), xa ** -0.5),
        'norm_ffn': gain(ks[27], (DEPTH, D_MODEL)),
        'w_gate': nrm(ks[28], (DEPTH, D_MODEL, FFN_DIM), D_MODEL ** -0.5),
        'w_up': nrm(ks[29], (DEPTH, D_MODEL, FFN_DIM), D_MODEL ** -0.5),
        'w_down': nrm(ks[30], (DEPTH, FFN_DIM, D_MODEL), FFN_DIM ** -0.5),
        'norm_final': gain(ks[31], (D_MODEL,)),
    }


def reference(x_prompt, x_sample, mem_prompt, state_ssm, state_conv, state_hgrn, cache_mem_k, cache_mem_v,
              norm_mix, w_in, conv_w, conv_b, dt_bias, a_log, d_skip, ssd_norm, w_ssd_out,
              hgrn_lb, hgrn_norm, w_hgrn_out, w_out, norm_cross, norm_mem, w_cq, w_ck, w_cv, w_co,
              norm_ffn, w_gate, w_up, w_down, norm_final):
    lbs = jnp.cumsum(jax.nn.softmax(hgrn_lb.astype(F32), axis=0), axis=0)
    bp = x_prompt.shape[0]
    dtype = x_prompt.dtype
    conv0 = jnp.zeros((bp, SSD_CONV - 1, SSD_CONV_DIM), dtype)
    ssm0 = jnp.zeros((bp, SSD_HEADS, SSD_HEAD_DIM, SSD_STATE), dtype)
    hg0 = jnp.zeros((bp, HG_HEADS, HG_EXPAND, HG_HEAD_V), dtype)
    hp, hs = x_prompt, x_sample
    ssm_p, conv_p, hg_p, mk_p, mv_p = [], [], [], [], []
    ssm_s, conv_s, hg_s = [], [], []
    for l in range(DEPTH):
        p = dict(norm_mix=norm_mix[l], w_in=w_in[l], conv_w=conv_w[l], conv_b=conv_b[l], dt_bias=dt_bias[l],
                 a_log=a_log[l], d_skip=d_skip[l], ssd_norm=ssd_norm[l], w_ssd_out=w_ssd_out[l],
                 hgrn_norm=hgrn_norm[l], w_hgrn_out=w_hgrn_out[l], w_out=w_out[l], norm_cross=norm_cross[l],
                 norm_mem=norm_mem[l], w_cq=w_cq[l], w_ck=w_ck[l], w_cv=w_cv[l], w_co=w_co[l],
                 norm_ffn=norm_ffn[l], w_gate=w_gate[l], w_up=w_up[l], w_down=w_down[l])
        lb = lbs[l]
        mk, mv = memory_kv(mem_prompt, p)
        hp, c_new, s_new, g_new = decoder_layer(hp, conv0, ssm0, hg0, mk, mv, p, lb)
        ssm_p.append(s_new); conv_p.append(c_new); hg_p.append(g_new); mk_p.append(mk); mv_p.append(mv)
        hs, c_new, s_new, g_new = decoder_layer(hs, state_conv[l], state_ssm[l], state_hgrn[l],
                                                cache_mem_k[l], cache_mem_v[l], p, lb)
        ssm_s.append(s_new); conv_s.append(c_new); hg_s.append(g_new)
    y_prompt = rmsnorm(hp, norm_final)
    y_sample = rmsnorm(hs, norm_final)
    return (y_prompt, y_sample,
            jnp.stack(ssm_p), jnp.stack(conv_p), jnp.stack(hg_p), jnp.stack(mk_p), jnp.stack(mv_p),
            jnp.stack(ssm_s), jnp.stack(conv_s), jnp.stack(hg_s))
```

```cpp
#include <hip/hip_runtime.h>
#include <cstdio>
#include <cstdint>
namespace pg8 {
#define PG8_LAS __attribute__((address_space(3)))
typedef unsigned short bf16_t;
typedef short bf16x8 __attribute__((ext_vector_type(8)));
typedef float f32x4 __attribute__((ext_vector_type(4)));
typedef unsigned u32x4 __attribute__((ext_vector_type(4)));
constexpr int BM = 256, BK = 64, HALF = 128, HTB = HALF * BK * 2  , STAGE_BYTES = 8 * HTB, NXCD = 8, WGM = 8;

__host__ __device__ __forceinline__ int lds_byte(int r, int c) { const int st = (r >> 4) * 2 + (c >> 5), rr = r & 15, cc = c & 31, ob = rr * 64 + cc * 2; return st * 1024 + (ob ^ (((ob >> 9) & 1) << 5)); }
__host__ __device__ __forceinline__ void stage_rc(int b, int& R, int& C) { const int st = b / 1024, sb = b % 1024, swz = sb ^ (((sb >> 9) & 1) << 5); R = (st >> 1) * 16 + swz / 64; C = (st & 1) * 32 + (swz % 64) / 2; }
__host__ __device__ __forceinline__ int perm32(int rho) { const int n = rho >> 4, i = rho & 15; return 8 * (i >> 2) + 4 * n + (i & 3); }

struct Unit { int pm, pn; };
struct Gemm { const bf16_t* A; const bf16_t* Bt; int M, N, K; };

struct StaticOrder {
    int nM, nN, nwg, G, c;
    __host__ __device__ void init(int M, int N, int G_, int c_) { nM = M / BM; nN = N / BM; nwg = nM * nN; G = G_; c = c_; }
    __host__ __device__ bool next(int i, Unit& u) const {
        const long L = (long)i * G + c; if (L >= nwg) return false;
        int wgid = (int)L; { const int q = nwg / NXCD, r = nwg % NXCD, xcd = wgid % NXCD, off = wgid / NXCD; wgid = (xcd < r ? xcd * (q + 1) : r * (q + 1) + (xcd - r) * q) + off; }
        const int nig = WGM * nN, gid = wgid / nig, fm = gid * WGM, gsz = (nM - fm) < WGM ? (nM - fm) : WGM;
        u.pm = fm + ((wgid % nig) % gsz); u.pn = (wgid % nig) / gsz; return true;
    }
    __device__ __forceinline__ void a_ready(const Unit&) const {}
    __device__ __forceinline__ void done(const Unit&) const {}
};

__device__ __forceinline__ unsigned cvt_pk_bf16(float lo, float hi) { unsigned r; asm volatile("v_cvt_pk_bf16_f32 %0, %1, %2" : "=v"(r) : "v"(lo), "v"(hi)); return r; }
typedef float f32x2 __attribute__((ext_vector_type(2)));
typedef unsigned u32x2 __attribute__((ext_vector_type(2)));
constexpr float RMS_EPS = 1e-6f;
__device__ __forceinline__ float bfbits2f(unsigned v16) { return __uint_as_float(v16 << 16); }
__device__ __forceinline__ float sigm(float x) { return 1.0f / (1.0f + __expf(-x)); }
template <int NP> __device__ __forceinline__ float row_rs(const float* ssq, int row) {
    float s = 0.f;
    if constexpr (NP == 1) s = ssq[row];
    else {
#pragma unroll
        for (int i = 0; i < NP / 4; ++i) { const f32x4 v = *(const f32x4*)(ssq + (size_t)row * NP + 4 * i); s += (v[0] + v[1]) + (v[2] + v[3]); }
    }
    return 1.0f / sqrtf(s * (1.0f / 1024.0f) + RMS_EPS);
}
template <int NP, bool HAS_DT> struct EpiScaleBf16 {
    static constexpr bool PERM = true, AFTER_DRAIN = false;
    bf16_t* O; size_t slot_elems; const float* ssq; float scale; float* dt;
    __device__ __forceinline__ void operator()(const f32x4 (&acc)[2][2][4][2], const Unit& u, int wr, int wc, int fr, int fq) const {
        const int row0 = u.pm * BM + wr * 64 + fr;
        if (HAS_DT && u.pn == 44) {
            if (wc == 0) {
#pragma unroll
                for (int ai = 0; ai < 2; ++ai)
#pragma unroll
                    for (int m = 0; m < 4; ++m) { const int row = row0 + ai * HALF + m * 16; const float rs = row_rs<NP>(ssq, row);
                        float* p = dt + (size_t)row * 32 + 8 * fq; *(f32x4*)p = acc[ai][0][m][0] * rs; *(f32x4*)(p + 4) = acc[ai][0][m][1] * rs; }
            }
            return;
        }
        bf16_t* base = O + (size_t)(u.pn >> 2) * slot_elems; const int col0 = (u.pn & 3) * BM + wc * 32 + 8 * fq;
#pragma unroll
        for (int ai = 0; ai < 2; ++ai)
#pragma unroll
            for (int m = 0; m < 4; ++m) { const int row = row0 + ai * HALF + m * 16; const float rs = row_rs<NP>(ssq, row) * scale; bf16_t* rowp = base + (size_t)row * 1024 + col0;
#pragma unroll
                for (int bj = 0; bj < 2; ++bj) { const f32x4 v0 = acc[ai][bj][m][0] * rs, v1 = acc[ai][bj][m][1] * rs;
                    u32x4 w; w.x = cvt_pk_bf16(v0[0], v0[1]); w.y = cvt_pk_bf16(v0[2], v0[3]); w.z = cvt_pk_bf16(v1[0], v1[1]); w.w = cvt_pk_bf16(v1[2], v1[3]);
                    *(u32x4*)(rowp + bj * HALF) = w; } }
    }
};
struct EpiKV {
    static constexpr bool PERM = false, AFTER_DRAIN = false;
    float* mk; float* mv; bf16_t* kb; bf16_t* vt; const float* ssq;
    __device__ __forceinline__ void operator()(const f32x4 (&acc)[2][2][4][2], const Unit& u, int wr, int wc, int fr, int fq) const {
        const int row0 = u.pm * BM + wr * 64 + fr; const bool isv = u.pn >= 4; const int colt = (u.pn & 3) * BM + wc * 32 + 4 * fq;
#pragma unroll
        for (int ai = 0; ai < 2; ++ai)
#pragma unroll
            for (int m = 0; m < 4; ++m) { const int row = row0 + ai * HALF + m * 16; const float rs = row_rs<1>(ssq, row);
#pragma unroll
                for (int bj = 0; bj < 2; ++bj)
#pragma unroll
                    for (int n = 0; n < 2; ++n) { const int c = colt + bj * HALF + n * 16; const f32x4 v = acc[ai][bj][m][n] * rs;
                        if (!isv) { *(f32x4*)(mk + (size_t)row * 1024 + c) = v; u32x2 w; w.x = cvt_pk_bf16(v[0], v[1]); w.y = cvt_pk_bf16(v[2], v[3]); *(u32x2*)(kb + (size_t)row * 1024 + c) = w; }
                        else { *(f32x4*)(mv + (size_t)row * 1024 + c) = v; const int b = row >> 8, key = row & 255, hd = c >> 8, d = c & 255;
                            bf16_t* p = vt + ((size_t)((b * 4 + hd) * 256 + d)) * 256 + key; const unsigned w0 = cvt_pk_bf16(v[0], v[1]), w1 = cvt_pk_bf16(v[2], v[3]);
                            p[0] = (bf16_t)(w0 & 0xffffu); p[256] = (bf16_t)(w0 >> 16); p[512] = (bf16_t)(w1 & 0xffffu); p[768] = (bf16_t)(w1 >> 16); } } }
    }
};
template <bool ADD> struct EpiGate {
    static constexpr bool PERM = true, AFTER_DRAIN = false;
    bf16_t* O; const bf16_t* gate;
    __device__ __forceinline__ void operator()(const f32x4 (&acc)[2][2][4][2], const Unit& u, int wr, int wc, int fr, int fq) const {
        const int row0 = u.pm * BM + wr * 64 + fr, col0 = u.pn * BM + wc * 32 + 8 * fq;
#pragma unroll
        for (int ai = 0; ai < 2; ++ai)
#pragma unroll
            for (int m = 0; m < 4; ++m) { const size_t off = (size_t)(row0 + ai * HALF + m * 16) * 1024 + col0;
#pragma unroll
                for (int bj = 0; bj < 2; ++bj) { const u32x4 gw = *(const u32x4*)(gate + off + bj * HALF); u32x4 ow = (u32x4){0u, 0u, 0u, 0u}; if (ADD) ow = *(const u32x4*)(O + off + bj * HALF);
                    float r[8];
#pragma unroll
                    for (int e = 0; e < 8; ++e) { const unsigned g16 = (gw[e >> 1] >> ((e & 1) * 16)) & 0xffffu, o16 = (ow[e >> 1] >> ((e & 1) * 16)) & 0xffffu;
                        const float a = acc[ai][bj][m][e >> 2][e & 3]; r[e] = (ADD ? bfbits2f(o16) : 0.f) + sigm(bfbits2f(g16)) * a; }
                    u32x4 w; w.x = cvt_pk_bf16(r[0], r[1]); w.y = cvt_pk_bf16(r[2], r[3]); w.z = cvt_pk_bf16(r[4], r[5]); w.w = cvt_pk_bf16(r[6], r[7]);
                    *(u32x4*)(O + off + bj * HALF) = w; } }
    }
};
struct EpiRes {
    static constexpr bool PERM = false, AFTER_DRAIN = false;
    const float* base0; const float* base1; float* out; bf16_t* hb; float* ssqp;
    __device__ __forceinline__ void operator()(const f32x4 (&acc)[2][2][4][2], const Unit& u, int wr, int wc, int fr, int fq) const {
        const int row0 = u.pm * BM + wr * 64 + fr, col0 = u.pn * BM + wc * 32 + 4 * fq; const float* base = u.pm < 64 ? base0 : base1;
#pragma unroll
        for (int ai = 0; ai < 2; ++ai)
#pragma unroll
            for (int m = 0; m < 4; ++m) { const int row = row0 + ai * HALF + m * 16; const size_t off = (size_t)row * 1024 + col0; float sq = 0.f;
#pragma unroll
                for (int bj = 0; bj < 2; ++bj)
#pragma unroll
                    for (int n = 0; n < 2; ++n) { const size_t o2 = off + bj * HALF + n * 16; const f32x4 v = *(const f32x4*)(base + o2) + acc[ai][bj][m][n];
                        *(f32x4*)(out + o2) = v; sq += (v[0] * v[0] + v[1] * v[1]) + (v[2] * v[2] + v[3] * v[3]);
                        if (hb) { u32x2 w; w.x = cvt_pk_bf16(v[0], v[1]); w.y = cvt_pk_bf16(v[2], v[3]); *(u32x2*)(hb + o2) = w; } }
                sq += __shfl_xor(sq, 16); sq += __shfl_xor(sq, 32);
                if (fq == 0) ssqp[(size_t)row * 16 + u.pn * 4 + wc] = sq; }
    }
};
struct EpiSwiglu {
    static constexpr bool PERM = true, AFTER_DRAIN = false;
    bf16_t* act; const float* ssq;
    __device__ __forceinline__ void operator()(const f32x4 (&acc)[2][2][4][2], const Unit& u, int wr, int wc, int fr, int fq) const {
        const int row0 = u.pm * BM + wr * 64 + fr, col0 = u.pn * 128 + wc * 16 + 4 * fq;
#pragma unroll
        for (int ai = 0; ai < 2; ++ai)
#pragma unroll
            for (int m = 0; m < 4; ++m) { const int row = row0 + ai * HALF + m * 16; const float rs = row_rs<16>(ssq, row);
#pragma unroll
                for (int bj = 0; bj < 2; ++bj) { const f32x4 a = acc[ai][bj][m][0] * rs, b = acc[ai][bj][m][1] * rs;
                    const float r0 = a[0] * sigm(a[0]) * a[1], r1 = a[2] * sigm(a[2]) * a[3], r2 = b[0] * sigm(b[0]) * b[1], r3 = b[2] * sigm(b[2]) * b[3];
                    u32x2 w; w.x = cvt_pk_bf16(r0, r1); w.y = cvt_pk_bf16(r2, r3); *(u32x2*)(act + (size_t)row * 2816 + col0 + bj * 64) = w; } }
    }
};
template <class Epi, class Sched, bool ALIGN_EPI = false, bool SP2 = false>
__device__ __forceinline__ void gemm_phase(PG8_LAS unsigned char* lds, const Gemm g, const Sched& S, const Epi& E) {
    const int tid = threadIdx.x, wid = __builtin_amdgcn_readfirstlane(tid >> 6), lane = tid & 63, wr = wid >> 2, wc = wid & 3, fr = lane & 15, fq = lane >> 4;
    const int K = g.K, nt = K / BK;
    unsigned voffA[2], voffB[2];
#pragma unroll
    for (int i = 0; i < 2; ++i) { int R, C; stage_rc(tid * 16 + i * 8192, R, C); const int Rb = Epi::PERM ? ((R & ~31) + perm32(R & 31)) : R;
        voffA[i] = (unsigned)(R * K + C) * 2u; voffB[i] = (unsigned)(Rb * K + C) * 2u; }
    const size_t kstep = (size_t)(BK * 2);
    const size_t hstep = (size_t)HALF * K * 2;
    const size_t tstep = 2 * hstep;
    const unsigned ldsw = (unsigned)wid * 1024u;
    const int aoff = lds_byte(wr * 64 + fr, fq * 8), boff = lds_byte(wc * 32 + fr, fq * 8);
#define PG8_SA(b, h) (((b) * 2 + (h)) * HTB)
#define PG8_SB(b, h) ((4 + (b) * 2 + (h)) * HTB)
#define PG8_STAGE(bufoff, gbase, voff) do { _Pragma("unroll") for (int _i = 0; _i < 2; ++_i) \
        __builtin_amdgcn_global_load_lds((const unsigned*)((const char*)(gbase) + (voff)[_i]), (PG8_LAS unsigned*)(lds + (bufoff) + ldsw + _i * 8192), 16, 0, 0); } while (0)
#define PG8_LDA(dst, b, h) do { _Pragma("unroll") for (int m = 0; m < 4; ++m) _Pragma("unroll") for (int k = 0; k < 2; ++k) dst[m][k] = *(const PG8_LAS bf16x8*)(lds + PG8_SA(b, h) + aoff + m * 2048 + k * 1024); } while (0)
#define PG8_LDB(dst, b, h) do { _Pragma("unroll") for (int n = 0; n < 2; ++n) _Pragma("unroll") for (int k = 0; k < 2; ++k) dst[n][k] = *(const PG8_LAS bf16x8*)(lds + PG8_SB(b, h) + boff + n * 2048 + k * 1024); } while (0)
#define PG8_MMA(ai, bj, At, Bt) do { __builtin_amdgcn_s_setprio(1); _Pragma("unroll") for (int m = 0; m < 4; ++m) _Pragma("unroll") for (int n = 0; n < 2; ++n) _Pragma("unroll") for (int k = 0; k < 2; ++k) \
        acc[ai][bj][m][n] = __builtin_amdgcn_mfma_f32_16x16x32_bf16(Bt[n][k], At[m][k], acc[ai][bj][m][n], 0, 0, 0); __builtin_amdgcn_s_setprio(0); } while (0)
#define PG8_WAIT_V(n) asm volatile("s_waitcnt vmcnt(" #n ")" ::: "memory")
#define PG8_WAIT_L(n) asm volatile("s_waitcnt lgkmcnt(" #n ")" ::: "memory")
#define PG8_BAR __builtin_amdgcn_s_barrier()
#define PG8_SCHED __builtin_amdgcn_sched_barrier(0)
    Unit cur, nxt; int ui = 0;
    if (!S.next(0, cur)) return;
    f32x4 acc[2][2][4][2];
#pragma unroll
    for (int a = 0; a < 2; ++a)
#pragma unroll
        for (int b = 0; b < 2; ++b)
#pragma unroll
            for (int m = 0; m < 4; ++m)
#pragma unroll
                for (int n = 0; n < 2; ++n) acc[a][b][m][n] = (f32x4){0.f, 0.f, 0.f, 0.f};
    bf16x8 At[4][2], B0[2][2], B1[2][2];
    const char* cA = (const char*)g.A + (size_t)cur.pm * tstep; const char* cB = (const char*)g.Bt + (size_t)cur.pn * tstep;
    S.a_ready(cur);
    if constexpr (SP2) {
        PG8_STAGE(PG8_SB(0, 0), cB, voffB); PG8_STAGE(PG8_SB(0, 1), cB + hstep, voffB); PG8_STAGE(PG8_SA(0, 0), cA, voffA); PG8_STAGE(PG8_SA(0, 1), cA + hstep, voffA);
        if (wr == 1) PG8_BAR;
        PG8_WAIT_V(2); PG8_BAR;
        PG8_STAGE(PG8_SB(1, 0), cB + kstep, voffB); PG8_STAGE(PG8_SA(1, 0), cA + kstep, voffA); PG8_STAGE(PG8_SB(1, 1), cB + hstep + kstep, voffB);
        PG8_WAIT_V(6); PG8_BAR;
    } else {
        PG8_STAGE(PG8_SB(0, 0), cB, voffB); PG8_STAGE(PG8_SA(0, 0), cA, voffA); PG8_STAGE(PG8_SB(0, 1), cB + hstep, voffB); PG8_STAGE(PG8_SA(0, 1), cA + hstep, voffA);
        if (wr == 1) PG8_BAR;
        PG8_WAIT_V(4); PG8_BAR;
        PG8_STAGE(PG8_SB(1, 0), cB + kstep, voffB); PG8_STAGE(PG8_SA(1, 0), cA + kstep, voffA); PG8_STAGE(PG8_SB(1, 1), cB + hstep + kstep, voffB);
        PG8_WAIT_V(6); PG8_BAR;
    }
    for (;;) {
        const bool has_next = S.next(ui + 1, nxt);
        const char* nA = has_next ? (const char*)g.A + (size_t)nxt.pm * tstep : cA; const char* nB = has_next ? (const char*)g.Bt + (size_t)nxt.pn * tstep : cB;
        for (int t = 0; t < nt; t += 2) {
            const bool last = (t == nt - 2);
            const char* a1 = cA + (size_t)(t + 1) * kstep;
            const char* a2 = last ? nA : cA + (size_t)(t + 2) * kstep; const char* b2 = last ? nB : cB + (size_t)(t + 2) * kstep;
            const char* a3 = a2 + kstep; const char* b3 = b2 + kstep;
            if (last && has_next) S.a_ready(nxt);
            if constexpr (SP2) {
            PG8_LDB(B0, 0, 0); PG8_LDB(B1, 0, 1); PG8_SCHED; PG8_LDA(At, 0, 0); PG8_STAGE(PG8_SA(1, 1), a1 + hstep, voffA);
            PG8_WAIT_V(8); PG8_WAIT_L(0); PG8_BAR; PG8_MMA(0, 0, At, B0); PG8_MMA(0, 1, At, B1); PG8_BAR; PG8_SCHED;
            PG8_LDA(At, 0, 1); PG8_STAGE(PG8_SB(0, 0), b2, voffB); PG8_STAGE(PG8_SB(0, 1), b2 + hstep, voffB); PG8_STAGE(PG8_SA(0, 0), a2, voffA);
            PG8_WAIT_V(8); PG8_WAIT_L(0); PG8_BAR; PG8_MMA(1, 0, At, B0); PG8_MMA(1, 1, At, B1); PG8_BAR; PG8_SCHED;
            PG8_LDB(B0, 1, 0); PG8_LDB(B1, 1, 1); PG8_SCHED; PG8_LDA(At, 1, 0); PG8_STAGE(PG8_SA(0, 1), a2 + hstep, voffA);
            PG8_WAIT_V(8); PG8_WAIT_L(0); PG8_BAR; PG8_MMA(0, 0, At, B0); PG8_MMA(0, 1, At, B1); PG8_BAR; PG8_SCHED;
            PG8_LDA(At, 1, 1); PG8_STAGE(PG8_SB(1, 0), b3, voffB); PG8_STAGE(PG8_SB(1, 1), b3 + hstep, voffB); PG8_STAGE(PG8_SA(1, 0), a3, voffA);
            PG8_WAIT_V(8); PG8_WAIT_L(0); PG8_BAR; PG8_MMA(1, 0, At, B0); PG8_MMA(1, 1, At, B1); PG8_BAR; PG8_SCHED;
            } else {
            PG8_LDB(B0, 0, 0); PG8_SCHED; PG8_LDA(At, 0, 0); PG8_STAGE(PG8_SA(1, 1), a1 + hstep, voffA);
            PG8_WAIT_L(8); PG8_BAR; PG8_WAIT_L(0); PG8_MMA(0, 0, At, B0); PG8_BAR; PG8_SCHED;
            PG8_LDB(B1, 0, 1); PG8_STAGE(PG8_SB(0, 0), b2, voffB);
            PG8_BAR; PG8_WAIT_L(0); PG8_MMA(0, 1, At, B1); PG8_BAR;
            PG8_LDA(At, 0, 1); PG8_STAGE(PG8_SA(0, 0), a2, voffA);
            PG8_BAR; PG8_WAIT_L(0); PG8_MMA(1, 0, At, B0); PG8_BAR; PG8_SCHED;
            PG8_STAGE(PG8_SB(0, 1), b2 + hstep, voffB);
            PG8_WAIT_V(6); PG8_BAR; PG8_MMA(1, 1, At, B1); PG8_BAR;
            PG8_LDB(B0, 1, 0); PG8_SCHED; PG8_LDA(At, 1, 0); PG8_STAGE(PG8_SA(0, 1), a2 + hstep, voffA);
            PG8_WAIT_L(8); PG8_BAR; PG8_WAIT_L(0); PG8_MMA(0, 0, At, B0); PG8_BAR; PG8_SCHED;
            PG8_LDB(B1, 1, 1); PG8_STAGE(PG8_SB(1, 0), b3, voffB);
            PG8_BAR; PG8_WAIT_L(0); PG8_MMA(0, 1, At, B1); PG8_BAR;
            PG8_LDA(At, 1, 1); PG8_STAGE(PG8_SA(1, 0), a3, voffA);
            PG8_BAR; PG8_WAIT_L(0); PG8_MMA(1, 0, At, B0); PG8_BAR; PG8_SCHED;
            PG8_STAGE(PG8_SB(1, 1), b3 + hstep, voffB);
            PG8_WAIT_V(6); PG8_BAR; PG8_MMA(1, 1, At, B1); PG8_BAR;
            }
        }
        if constexpr (ALIGN_EPI) { if (wr == 0) PG8_BAR; }
        if constexpr (!Epi::AFTER_DRAIN) { E(acc, cur, wr, wc, fr, fq); S.done(cur); }
        if (!has_next) break;
#pragma unroll
        for (int a = 0; a < 2; ++a)
#pragma unroll
            for (int b = 0; b < 2; ++b)
#pragma unroll
                for (int m = 0; m < 4; ++m)
#pragma unroll
                    for (int n = 0; n < 2; ++n) acc[a][b][m][n] = (f32x4){0.f, 0.f, 0.f, 0.f};
        cur = nxt; cA = nA; cB = nB; ++ui;
        if constexpr (ALIGN_EPI) { if (wr == 1) PG8_BAR; }
    }
    PG8_WAIT_V(0);
    if constexpr (!ALIGN_EPI) { if (wr == 0) PG8_BAR; }
    PG8_BAR;
    if constexpr (Epi::AFTER_DRAIN) { E.fused(acc, cur, wr, wc, fr, fq, lds, wid, lane); S.done(cur); }
#undef PG8_SA
#undef PG8_SB
#undef PG8_STAGE
#undef PG8_LDA
#undef PG8_LDB
#undef PG8_MMA
#undef PG8_WAIT_V
#undef PG8_WAIT_L
#undef PG8_BAR
#undef PG8_SCHED
}
}
#define GAS __attribute__((address_space(1)))
#define LAS __attribute__((address_space(3)))
typedef unsigned short bf16;
typedef unsigned v4u __attribute__((ext_vector_type(4)));
typedef float f32x4 __attribute__((ext_vector_type(4)));
typedef short bf16x8 __attribute__((ext_vector_type(8)));
typedef GAS unsigned gu32;
typedef GAS unsigned long long gu64;
#define RLX_AGENT __ATOMIC_RELAXED, __HIP_MEMORY_SCOPE_AGENT
#define LDS_WAIT() asm volatile("s_waitcnt lgkmcnt(0)" ::: "memory")
#define VM_WAIT() asm volatile("s_waitcnt vmcnt(0)" ::: "memory")
__device__ __forceinline__ unsigned long long rt() { return __builtin_amdgcn_s_memrealtime(); }
__device__ __forceinline__ unsigned f2bf(float f) { unsigned u = __builtin_bit_cast(unsigned, f); return (u + 0x7fffu + ((u >> 16) & 1u)) >> 16; }
__device__ __forceinline__ unsigned pk2(float lo, float hi) { return f2bf(lo) | (f2bf(hi) << 16); }

#define XB_TMO      128
#define XB_XCNT(j)  (256  + 64 * (j))
#define XB_XSUB(j)  (1280 + 64 * (j))
#define XB_XGEN(j)  (2304 + 64 * (j))
#define XB_TOP      3328
#define XB_TOPGEN   3392
#define XCD_BAR_WORDS 3456
#define XB_SPIN_CAP (1u << 18)

__device__ __forceinline__ unsigned xb_ld(unsigned* p)              { return __hip_atomic_load(p, __ATOMIC_RELAXED, __HIP_MEMORY_SCOPE_AGENT); }
__device__ __forceinline__ unsigned xb_add(unsigned* p, unsigned v) { return __hip_atomic_fetch_add(p, v, __ATOMIC_RELAXED, __HIP_MEMORY_SCOPE_AGENT); }
__device__ __forceinline__ unsigned xb_xcc_id() { return (unsigned)__builtin_amdgcn_s_getreg((3 << 11) | 20) & 0xFu; }
#define XB_SPIN(cond, bar) do { unsigned _sp = 0; while (cond) { __builtin_amdgcn_s_sleep(1); \
    if ((++_sp & 255u) == 0u) { if (xb_ld(&(bar)[XB_TMO])) break; if (_sp > XB_SPIN_CAP) { atomicAdd(&(bar)[XB_TMO], 1u); break; } } } } while (0)

struct XcdBarrier {
    unsigned* bar; unsigned x;
    volatile LAS unsigned* st;
};

__device__ __forceinline__ XcdBarrier xcd_barrier_post(unsigned* bar, volatile LAS unsigned* st) {
    XcdBarrier b; b.bar = bar; b.x = xb_xcc_id(); b.st = st;
    if (threadIdx.x == 0) (void)xb_add(&bar[XB_XCNT(b.x)], 1u);
    return b;
}
__device__ __forceinline__ void xcd_barrier_complete(unsigned* bar, unsigned x, unsigned& nloc, unsigned& nx) {
    const unsigned G = gridDim.x * gridDim.y * gridDim.z;
    unsigned sum, cnt, mine, sp = 0u;
    for (;;) {
        sum = 0u; cnt = 0u; mine = 0u;
#pragma unroll
        for (unsigned j = 0; j < 16; ++j) { const unsigned c = xb_ld(&bar[XB_XCNT(j)]); sum += c; cnt += (c > 0u) ? 1u : 0u; mine = (j == x) ? c : mine; }
        if (sum == G) break;
        __builtin_amdgcn_s_sleep(1);
        if ((++sp & 255u) == 0u) { if (xb_ld(&bar[XB_TMO])) break; if (sp > XB_SPIN_CAP) { atomicAdd(&bar[XB_TMO], 1u); break; } }
    }
    nloc = mine > 0u ? mine : 1u; nx = cnt > 0u ? cnt : 1u;
}

__device__ __forceinline__ void xcd_barrier(const XcdBarrier& b) {
    asm volatile("s_waitcnt vmcnt(0)" ::: "memory");
    __syncthreads();
    if (threadIdx.x == 0) {
        unsigned* bar = b.bar;
        __builtin_amdgcn_s_waitcnt(0);
        unsigned nloc = b.st[0], nx = b.st[1];
        if (nloc == 0u) { xcd_barrier_complete(bar, b.x, nloc, nx); b.st[0] = nloc; b.st[1] = nx; }
        const unsigned old = xb_add(&bar[XB_XSUB(b.x)], 1u);
        const unsigned gen = old / nloc;
        if (old + 1u == (gen + 1u) * nloc) {
            __builtin_amdgcn_fence(__ATOMIC_RELEASE, "agent");
            asm volatile("s_waitcnt vmcnt(0)" ::: "memory");
            const unsigned og = xb_add(&bar[XB_TOP], 1u);
            const unsigned tg = og / nx;
            if (og + 1u == (tg + 1u) * nx) xb_add(&bar[XB_TOPGEN], 1u);
            else XB_SPIN(xb_ld(&bar[XB_TOPGEN]) == tg, bar);
            __builtin_amdgcn_fence(__ATOMIC_ACQUIRE, "agent");
            xb_add(&bar[XB_XGEN(b.x)], 1u);
            asm volatile("s_waitcnt vmcnt(0)" ::: "memory");
        } else {
            XB_SPIN(xb_ld(&bar[XB_XGEN(b.x)]) == gen, bar);
            __builtin_amdgcn_fence(__ATOMIC_ACQUIRE, "agent");
            asm volatile("s_waitcnt vmcnt(0)" ::: "memory");
        }
    }
    __syncthreads();
}
typedef unsigned v2u __attribute__((ext_vector_type(2)));
constexpr int NWAVES = 8, NTHR = 512;
constexpr int DM = 1024, TP = 16384, TS = 512, T = TP + TS;
constexpr int SEQ = 2048, NBP = 8, NBS = 128, LS = 4, MEMR = 2048;
constexpr int NPROJ = 11520;
constexpr int FFN = 2816;
constexpr float EPS = 1e-6f;
constexpr float QSCALE = 0.0625f * 1.4426950408889634f;

constexpr size_t MiB = 1u << 20;
constexpr size_t WS_CTL = 0, CTL_ZERO_BYTES = 1 * MiB;
constexpr size_t WS_SSQX = 1 * MiB, WS_SSQM = 1 * MiB + 512 * 1024;
constexpr size_t WS_DT = 2 * MiB, WS_SSQSSD = 5 * MiB, WS_SSQP1 = 8 * MiB, WS_SSQP2 = 9 * MiB + 512 * 1024, WS_SSQP3 = 11 * MiB;
constexpr size_t WS_WIN = 13 * MiB, WS_WKV = 36 * MiB, WS_WSSD = 40 * MiB, WS_WHG = 44 * MiB, WS_WOUT = 46 * MiB, WS_WCQ = 48 * MiB, WS_WCO = 50 * MiB, WS_WGU = 52 * MiB, WS_WDN = 63 * MiB;
constexpr size_t WS_XB = 69 * MiB, WS_MNB = 102 * MiB, WS_KB = 106 * MiB, WS_VT = 110 * MiB;
constexpr size_t SLOT = 33 * MiB, SLOT_ELEMS = (size_t)T * 1024;
constexpr size_t WS_PROJ = 114 * MiB;
constexpr size_t WS_YG = WS_PROJ + 11 * SLOT, WS_ON = WS_YG + 2 * SLOT, WS_END = WS_ON + SLOT;
static_assert(SLOT == SLOT_ELEMS * 2, "slot size");
static_assert(WS_WIN + (size_t)NPROJ * 1024 * 2 <= WS_WKV && WS_WGU + (size_t)2 * FFN * 1024 * 2 <= WS_WDN && WS_WDN + (size_t)1024 * FFN * 2 <= WS_XB && WS_SSQP3 + (size_t)T * 64 <= WS_WIN, "d_ws map");
static_assert(WS_DT + (size_t)T * 128 <= WS_SSQSSD && WS_SSQSSD + (size_t)T * 128 <= WS_SSQP1 && WS_SSQP1 + (size_t)T * 64 <= WS_SSQP2 && WS_SSQP2 + (size_t)T * 64 <= WS_SSQP3, "d_ws map 2");
enum { S_Z0 = 0, S_Z1 = 1, S_X0 = 2, S_X1 = 3, S_X2 = 4, S_Q = 5, S_F = 6, S_I = 7, S_HG = 8, S_GS = 9, S_GH = 10 };
constexpr size_t WS_MERGED = WS_PROJ + S_Q * SLOT, WS_HB = WS_PROJ + S_F * SLOT, WS_QB = WS_PROJ + S_I * SLOT, WS_OB = WS_PROJ + S_HG * SLOT, WS_ACT = WS_PROJ;
static_assert((size_t)T * FFN * 2 <= 3 * SLOT, "act overlay");
constexpr size_t O_Y = 0, O_SSMP = (size_t)T * 1024, O_CONVP = O_SSMP + 2097152, O_HGP = O_CONVP + 73728, O_MKP = O_HGP + 1048576, O_MVP = O_MKP + 2097152,
                 O_SSMS = O_MVP + 2097152, O_CONVS = O_SSMS + 33554432, O_HGS = O_CONVS + 1179648, O_END = O_HGS + 16777216;
constexpr int CW_QUEUE = 64;
constexpr int CW_BAR = 4096;
constexpr int RING_OFF = 0, RING_BYTES = 131072;
constexpr int LDSCTL_OFF = RING_BYTES, MISC_OFF = LDSCTL_OFF + 320;
constexpr int LDS_BYTES = 147456;
struct Frame {
    LAS unsigned char* lds;
    volatile LAS unsigned* MISC;
    gu32* ctl;
    int tid, lane, wave;
    int vcu, G;
    const float* in[32];
    float* out; unsigned char* ws;
};
__device__ __forceinline__ float bf2f(unsigned v16) { return __uint_as_float(v16 << 16); }
__device__ __forceinline__ float sigmoid_f(float x) { return 1.0f / (1.0f + __expf(-x)); }
__device__ __forceinline__ float silu_f(float x) { return x * sigmoid_f(x); }
__device__ __forceinline__ float wave_sum(float v) {
#pragma unroll
    for (int o = 1; o < 64; o <<= 1) v += __shfl_xor(v, o);
    return v;
}
__device__ __forceinline__ float wave_max(float v) {
#pragma unroll
    for (int o = 1; o < 64; o <<= 1) v = fmaxf(v, __shfl_xor(v, o));
    return v;
}
struct TSrc { const float* W; const float* W2; const float* ks; int ldw; int mode; };
__device__ __forceinline__ float tsrc_elem(const TSrc& s, int k, int n) {
    float v;
    if (s.mode == 0) v = s.W[(size_t)k * s.ldw + n];
    else if (s.mode == 1) { if (n < 5120) v = s.W[(size_t)k * s.ldw + n]; else if (n < 11264) v = s.W[(size_t)k * s.ldw + n + 32]; else if (n < 11296) v = s.W[(size_t)k * s.ldw + 5120 + (n - 11264)]; else v = 0.f; }
    else if (s.mode == 2) v = (n & 1) ? s.W2[(size_t)k * s.ldw + (n >> 1)] : s.W[(size_t)k * s.ldw + (n >> 1)];
    else v = (n < 1024) ? s.W[(size_t)k * s.ldw + n] : s.W2[(size_t)k * s.ldw + (n - 1024)];
    return s.ks ? v * s.ks[k] : v;
}
__device__ __forceinline__ void p0_transpose_item(const TSrc& s, int K, int N, bf16* WT, LAS float* scr, int item, int lane) {
    const int nblk = N / 32, kb = item / nblk, nb = item % nblk, k0 = 64 * kb, n0 = 32 * nb;
#pragma unroll 8
    for (int i = 0; i < 32; ++i) { const int kk = 2 * i + (lane >> 5); scr[kk * 33 + (lane & 31)] = tsrc_elem(s, k0 + kk, n0 + (lane & 31)); }
    LDS_WAIT(); asm volatile("" ::: "memory");
    const int c = lane & 7;
#pragma unroll
    for (int j = 0; j < 4; ++j) { const int n = (lane >> 3) + 8 * j; const LAS float* p = scr + (8 * c) * 33 + n;
        v4u o; o.x = pk2(p[0 * 33], p[1 * 33]); o.y = pk2(p[2 * 33], p[3 * 33]); o.z = pk2(p[4 * 33], p[5 * 33]); o.w = pk2(p[6 * 33], p[7 * 33]);
        *(v4u*)(WT + (size_t)(n0 + n) * K + k0 + 8 * c) = o; }
    LDS_WAIT(); asm volatile("" ::: "memory");
}
__device__ __forceinline__ void row_to_bf16_ssq(const float* xrow, bf16* orow, float* ssq, int lane) {
    const f32x4* xr = (const f32x4*)xrow + lane; f32x4 v[4]; float s = 0.f;
#pragma unroll
    for (int j = 0; j < 4; ++j) { v[j] = xr[64 * j]; s += (v[j].x * v[j].x + v[j].y * v[j].y) + (v[j].z * v[j].z + v[j].w * v[j].w); }
    s = wave_sum(s);
    unsigned long long* o8 = (unsigned long long*)orow + lane;
#pragma unroll
    for (int j = 0; j < 4; ++j) o8[64 * j] = (unsigned long long)pk2(v[j].x, v[j].y) | ((unsigned long long)pk2(v[j].z, v[j].w) << 32);
    if (lane == 0) *ssq = s;
}
__device__ __forceinline__ void p0_prologue(Frame& F) {
    LAS float* scr = (LAS float*)(F.lds + RING_OFF + F.wave * 16384);
    const int gw = F.vcu * NWAVES + F.wave, NGW = F.G * NWAVES;
    unsigned char* ws = F.ws;
    constexpr int I_IN = 16 * (NPROJ / 32), I_KV = 16 * 64, I_SSD = 32 * 32, I_SQ = 16 * 32, I_GU = 16 * (2 * FFN / 32), I_DN = (FFN / 64) * 32;
    constexpr int NITEMS = I_IN + I_KV + I_SSD + 4 * I_SQ + I_GU + I_DN;
    for (int it = gw; it < NITEMS; it += NGW) {
        int r = it;
        if (r < I_IN) { TSrc s{F.in[9], nullptr, F.in[8], 11296, 1}; p0_transpose_item(s, 1024, NPROJ, (bf16*)(ws + WS_WIN), scr, r, F.lane); continue; } r -= I_IN;
        if (r < I_KV) { TSrc s{F.in[24], F.in[25], F.in[22], 1024, 3}; p0_transpose_item(s, 1024, 2048, (bf16*)(ws + WS_WKV), scr, r, F.lane); continue; } r -= I_KV;
        if (r < I_SSD) { TSrc s{F.in[16], nullptr, F.in[15], 1024, 0}; p0_transpose_item(s, 2048, 1024, (bf16*)(ws + WS_WSSD), scr, r, F.lane); continue; } r -= I_SSD;
        if (r < I_SQ) { TSrc s{F.in[19], nullptr, F.in[18], 1024, 0}; p0_transpose_item(s, 1024, 1024, (bf16*)(ws + WS_WHG), scr, r, F.lane); continue; } r -= I_SQ;
        if (r < I_SQ) { TSrc s{F.in[20], nullptr, nullptr, 1024, 0}; p0_transpose_item(s, 1024, 1024, (bf16*)(ws + WS_WOUT), scr, r, F.lane); continue; } r -= I_SQ;
        if (r < I_SQ) { TSrc s{F.in[23], nullptr, F.in[21], 1024, 0}; p0_transpose_item(s, 1024, 1024, (bf16*)(ws + WS_WCQ), scr, r, F.lane); continue; } r -= I_SQ;
        if (r < I_SQ) { TSrc s{F.in[26], nullptr, nullptr, 1024, 0}; p0_transpose_item(s, 1024, 1024, (bf16*)(ws + WS_WCO), scr, r, F.lane); continue; } r -= I_SQ;
        if (r < I_GU) { TSrc s{F.in[28], F.in[29], F.in[27], FFN, 2}; p0_transpose_item(s, 1024, 2 * FFN, (bf16*)(ws + WS_WGU), scr, r, F.lane); continue; } r -= I_GU;
        { TSrc s{F.in[30], nullptr, nullptr, 1024, 0}; p0_transpose_item(s, FFN, 1024, (bf16*)(ws + WS_WDN), scr, r, F.lane); }
    }
    bf16* XB = (bf16*)(ws + WS_XB); float* SSQX = (float*)(ws + WS_SSQX);
    for (int m = gw; m < T; m += NGW) { const float* src = m < TP ? F.in[0] + (size_t)m * DM : F.in[1] + (size_t)(m - TP) * DM; row_to_bf16_ssq(src, XB + (size_t)m * DM, SSQX + m, F.lane); }
    bf16* MNB = (bf16*)(ws + WS_MNB); float* SSQM = (float*)(ws + WS_SSQM);
    for (int m = gw; m < MEMR; m += NGW) row_to_bf16_ssq(F.in[2] + (size_t)m * DM, MNB + (size_t)m * DM, SSQM + m, F.lane);
}
__device__ __forceinline__ void ssd_unit(Frame& F, int gb, int h) {
    const int tid = F.tid; unsigned char* ws = F.ws;
    const bool prompt = gb < NBP; const int L = prompt ? SEQ : LS; const int sb = gb - NBP; const size_t row_base = prompt ? (size_t)gb * SEQ : (size_t)TP + (size_t)sb * LS;
    const int g = h >> 3;
    LAS float* xs = (LAS float*)(F.lds + RING_OFF);
    LAS float* Bs = xs + 64 * 64;
    LAS float* Cs = Bs + 64 * 128;
    LAS float* ys = Cs + 64 * 128;
    LAS float* dts = ys + 64 * 64;
    LAS float* das = dts + 64;
    const bf16* PROJ = (const bf16*)(ws + WS_PROJ); const float* DTR = (const float*)(ws + WS_DT);
    bf16* YG = (bf16*)(ws + WS_YG); float* SSQ = (float*)(ws + WS_SSQSSD);
    const int p = tid >> 3, n0 = (tid & 7) * 16;
    float hs[16];
    float* state_out = prompt ? F.out + O_SSMP + ((size_t)(gb * 32 + h) * 64 + p) * 128 + n0 : F.out + O_SSMS + ((size_t)(sb * 32 + h) * 64 + p) * 128 + n0;
    if (prompt) {
#pragma unroll
        for (int i = 0; i < 16; ++i) hs[i] = 0.f;
    } else { const float* sp = F.in[3] + ((size_t)(sb * 32 + h) * 64 + p) * 128 + n0;
#pragma unroll
        for (int i = 0; i < 4; ++i) { const f32x4 v = *(const f32x4*)(sp + 4 * i); hs[4 * i] = v.x; hs[4 * i + 1] = v.y; hs[4 * i + 2] = v.z; hs[4 * i + 3] = v.w; } }
    const float a = -__expf(F.in[13][h]), dtb = F.in[12][h], Dk = F.in[14][h];
    int col = 0; LAS float* dst = xs; int dstride = 64;
    if (tid < 64) { col = h * 64 + tid; dst = xs + tid; dstride = 64; }
    else if (tid < 192) { col = 2048 + g * 128 + (tid - 64); dst = Bs + (tid - 64); dstride = 128; }
    else if (tid < 320) { col = 2560 + g * 128 + (tid - 192); dst = Cs + (tid - 192); dstride = 128; }
    float w0 = 0.f, w1 = 0.f, w2 = 0.f, w3 = 0.f, cb = 0.f, r0 = 0.f, r1 = 0.f, r2 = 0.f; const bf16* cptr = PROJ;
    if (tid < 320) { const float* cw = F.in[10]; w0 = cw[col]; w1 = cw[3072 + col]; w2 = cw[2 * 3072 + col]; w3 = cw[3 * 3072 + col]; cb = F.in[11][col];
        cptr = PROJ + (size_t)(S_X0 + (col >> 10)) * SLOT_ELEMS + row_base * 1024 + (col & 1023);
        if (!prompt) { const float* sc = F.in[4] + (size_t)sb * 3 * 3072 + col; r0 = sc[0]; r1 = sc[3072]; r2 = sc[2 * 3072]; } }
    for (int t0 = 0; t0 < L; t0 += 64) {
        const int nt = (L - t0) < 64 ? (L - t0) : 64;
        if (tid < 320) {
            for (int tt = 0; tt < nt; ++tt) { const float raw = bf2f(cptr[(size_t)(t0 + tt) * 1024]); float v = w0 * r0 + w1 * r1 + w2 * r2 + w3 * raw + cb; v = silu_f(v); dst[tt * dstride] = v; r0 = r1; r1 = r2; r2 = raw; }
        } else if (tid < 384) { const int tt = tid - 320;
            if (tt < nt) { const float x = DTR[(row_base + t0 + tt) * 32 + h] + dtb; const float dtv = x > 20.f ? x : log1pf(__expf(x)); dts[tt] = dtv; das[tt] = __expf(dtv * a); } }
        __syncthreads();
        for (int tt = 0; tt < nt; ++tt) {
            const float xv = xs[tt * 64 + p], dtv = dts[tt], dA = das[tt], xd = xv * dtv; float part = 0.f;
#pragma unroll
            for (int i = 0; i < 4; ++i) { const f32x4 bv = *(const LAS f32x4*)(Bs + tt * 128 + n0 + 4 * i), cv = *(const LAS f32x4*)(Cs + tt * 128 + n0 + 4 * i);
                hs[4 * i] = dA * hs[4 * i] + xd * bv.x; hs[4 * i + 1] = dA * hs[4 * i + 1] + xd * bv.y; hs[4 * i + 2] = dA * hs[4 * i + 2] + xd * bv.z; hs[4 * i + 3] = dA * hs[4 * i + 3] + xd * bv.w;
                part += (hs[4 * i] * cv.x + hs[4 * i + 1] * cv.y) + (hs[4 * i + 2] * cv.z + hs[4 * i + 3] * cv.w); }
            part += __shfl_xor(part, 1); part += __shfl_xor(part, 2); part += __shfl_xor(part, 4);
            if ((tid & 7) == 0) ys[tt * 64 + p] = part;
        }
        __syncthreads();
        { const int tt = tid >> 3, p0 = (tid & 7) * 8;
          if (tt < nt) { const size_t row = row_base + t0 + tt;
            const v4u zw = *(const v4u*)(PROJ + (size_t)(S_Z0 + (h >> 4)) * SLOT_ELEMS + row * 1024 + (h & 15) * 64 + p0);
            float o[8]; float sq = 0.f;
#pragma unroll
            for (int j = 0; j < 8; ++j) { const unsigned z16 = (zw[j >> 1] >> ((j & 1) * 16)) & 0xffffu; const float yv = (ys[tt * 64 + p0 + j] + xs[tt * 64 + p0 + j] * Dk) * silu_f(bf2f(z16)); o[j] = yv; sq += yv * yv; }
            v4u ow; ow.x = pk2(o[0], o[1]); ow.y = pk2(o[2], o[3]); ow.z = pk2(o[4], o[5]); ow.w = pk2(o[6], o[7]);
            *(v4u*)(YG + row * 2048 + h * 64 + p0) = ow;
            sq += __shfl_xor(sq, 1); sq += __shfl_xor(sq, 2); sq += __shfl_xor(sq, 4);
            if ((tid & 7) == 0) SSQ[row * 32 + h] = sq; } }
        __syncthreads();
    }
#pragma unroll
    for (int i = 0; i < 4; ++i) *(f32x4*)(state_out + 4 * i) = (f32x4){hs[4 * i], hs[4 * i + 1], hs[4 * i + 2], hs[4 * i + 3]};
}
__device__ __forceinline__ void hgrn_unit(Frame& F, int gb, int hd) {
    const int tid = F.tid; unsigned char* ws = F.ws;
    const bool prompt = gb < NBP; const int L = prompt ? SEQ : LS; const int sb = gb - NBP; const size_t row_base = prompt ? (size_t)gb * SEQ : (size_t)TP + (size_t)sb * LS;
    LAS float* qs = (LAS float*)(F.lds + RING_OFF);
    LAS float* fs = qs + 32 * 128; LAS float* ks = fs + 32 * 128; LAS float* vs = ks + 32 * 128; LAS float* os = vs + 32 * 128;
    const bf16* PROJ = (const bf16*)(ws + WS_PROJ); bf16* ON = (bf16*)(ws + WS_ON);
    const int v = tid >> 2, k0 = (tid & 3) * 32;
    float S[32];
    float* state_out = prompt ? F.out + O_HGP + ((size_t)(gb * 8 + hd) * 128 + k0) * 128 + v : F.out + O_HGS + ((size_t)(sb * 8 + hd) * 128 + k0) * 128 + v;
    if (prompt) {
#pragma unroll
        for (int i = 0; i < 32; ++i) S[i] = 0.f;
    } else { const float* sp = F.in[5] + ((size_t)(sb * 8 + hd) * 128 + k0) * 128 + v;
#pragma unroll
        for (int i = 0; i < 32; ++i) S[i] = sp[(size_t)i * 128]; }
    const int c = tid & 127, part = tid >> 7; const int ch = hd * 128 + c;
    float lb = 0.f; if (part == 1) lb = 1.0f / (1.0f + __expf(F.in[17][1024 + ch] - F.in[17][ch]));
    const bf16* sptr = PROJ + (size_t)(part == 0 ? S_Q : (part == 1 ? S_F : S_I)) * SLOT_ELEMS + row_base * 1024 + ch;
    for (int t0 = 0; t0 < L; t0 += 32) {
        const int nt = (L - t0) < 32 ? (L - t0) : 32;
        if (part < 3) {
            for (int tt = 0; tt < nt; ++tt) { const float raw = bf2f(sptr[(size_t)(t0 + tt) * 1024]);
                if (part == 0) qs[tt * 128 + c] = silu_f(raw);
                else if (part == 1) { const float e = __expf(-raw); const float sg = 1.0f / (1.0f + e); fs[tt * 128 + c] = lb + (1.0f - lb) * sg; ks[tt * 128 + c] = (1.0f - lb) * (e / (1.0f + e)); }
                else vs[tt * 128 + c] = raw; }
        }
        __syncthreads();
        for (int tt = 0; tt < nt; ++tt) {
            const float vv = vs[tt * 128 + v]; float acc = 0.f;
#pragma unroll
            for (int i = 0; i < 8; ++i) { const f32x4 fv = *(const LAS f32x4*)(fs + tt * 128 + k0 + 4 * i), kv = *(const LAS f32x4*)(ks + tt * 128 + k0 + 4 * i), qv = *(const LAS f32x4*)(qs + tt * 128 + k0 + 4 * i);
                S[4 * i] = fv.x * S[4 * i] + kv.x * vv; S[4 * i + 1] = fv.y * S[4 * i + 1] + kv.y * vv; S[4 * i + 2] = fv.z * S[4 * i + 2] + kv.z * vv; S[4 * i + 3] = fv.w * S[4 * i + 3] + kv.w * vv;
                acc += (S[4 * i] * qv.x + S[4 * i + 1] * qv.y) + (S[4 * i + 2] * qv.z + S[4 * i + 3] * qv.w); }
            acc += __shfl_xor(acc, 1); acc += __shfl_xor(acc, 2);
            if ((tid & 3) == 0) os[tt * 128 + v] = acc;
        }
        __syncthreads();
        { const int tt = tid >> 4, v0 = (tid & 15) * 8;
          if (tt < nt) { const size_t row = row_base + t0 + tt; float o[8]; float sq = 0.f;
#pragma unroll
            for (int j = 0; j < 8; ++j) { o[j] = os[tt * 128 + v0 + j]; sq += o[j] * o[j]; }
            sq += __shfl_xor(sq, 1); sq += __shfl_xor(sq, 2); sq += __shfl_xor(sq, 4); sq += __shfl_xor(sq, 8);
            const float rs = 1.0f / sqrtf(sq * (1.0f / 128.0f) + EPS);
            const v4u gw = *(const v4u*)(PROJ + (size_t)S_HG * SLOT_ELEMS + row * 1024 + hd * 128 + v0);
#pragma unroll
            for (int j = 0; j < 8; ++j) { const unsigned g16 = (gw[j >> 1] >> ((j & 1) * 16)) & 0xffffu; o[j] = o[j] * rs * silu_f(bf2f(g16)); }
            v4u ow; ow.x = pk2(o[0], o[1]); ow.y = pk2(o[2], o[3]); ow.z = pk2(o[4], o[5]); ow.w = pk2(o[6], o[7]);
            *(v4u*)(ON + row * 1024 + hd * 128 + v0) = ow; } }
        __syncthreads();
    }
#pragma unroll
    for (int i = 0; i < 32; ++i) state_out[(size_t)i * 128] = S[i];
}
__device__ __forceinline__ void conv_copy_unit(Frame& F, int gb) {
    const bf16* PROJ = (const bf16*)(F.ws + WS_PROJ);
    const bool prompt = gb < NBP; const int sb = gb - NBP;
    const size_t row0 = prompt ? (size_t)gb * SEQ + (SEQ - 3) : (size_t)TP + (size_t)sb * LS + 1;
    float* dst = prompt ? F.out + O_CONVP + (size_t)gb * 3 * 3072 : F.out + O_CONVS + (size_t)sb * 3 * 3072;
    for (int e = F.tid; e < 3 * 3072; e += NTHR) { const int j = e / 3072, col = e % 3072;
        dst[e] = bf2f(PROJ[(size_t)(S_X0 + (col >> 10)) * SLOT_ELEMS + (row0 + j) * 1024 + (col & 1023)]); }
}
constexpr int U_HGP = NBP * 8, U_SSDP = NBP * 32, U_HGS = NBS * 8, U_SSDS = NBS * 32, U_CONV = NBP + NBS;
constexpr int U_TOTAL = U_HGP + U_SSDP + U_HGS + U_SSDS + U_CONV;
__device__ __forceinline__ void scan_phase(Frame& F) {
    gu32* head = F.ctl + CW_QUEUE;
    for (;;) {
        if (F.tid == 0) F.MISC[0] = __hip_atomic_fetch_add(head, 1u, RLX_AGENT);
        __syncthreads();
        int u = (int)F.MISC[0];
        __syncthreads();
        if (u >= U_TOTAL) break;
        if (u < U_HGP) { hgrn_unit(F, u >> 3, u & 7); continue; } u -= U_HGP;
        if (u < U_SSDP) { ssd_unit(F, u >> 5, u & 31); continue; } u -= U_SSDP;
        if (u < U_HGS) { hgrn_unit(F, NBP + (u >> 3), u & 7); continue; } u -= U_HGS;
        if (u < U_SSDS) { ssd_unit(F, NBP + (u >> 5), u & 31); continue; } u -= U_SSDS;
        conv_copy_unit(F, u);
    }
}
__device__ __forceinline__ void ssdnorm_phase(Frame& F) {
    const int gw = F.vcu * NWAVES + F.wave, NGW = F.G * NWAVES; bf16* YG = (bf16*)(F.ws + WS_YG); const float* SSQ = (const float*)(F.ws + WS_SSQSSD);
    for (int row = gw; row < T; row += NGW) {
        const f32x4* sp = (const f32x4*)(SSQ + (size_t)row * 32);
#pragma unroll
        for (int j = 0; j < 4; ++j) { const f32x4 a = sp[2 * j], b = sp[2 * j + 1]; const float s = ((a.x + a.y) + (a.z + a.w)) + ((b.x + b.y) + (b.z + b.w)); const float rs = 1.0f / sqrtf(s * (1.0f / 512.0f) + EPS);
            v4u* p = (v4u*)(YG + (size_t)row * 2048) + j * 64 + F.lane; const v4u w = *p; v4u o;
#pragma unroll
            for (int e = 0; e < 4; ++e) o[e] = pk2(bf2f(w[e] & 0xffffu) * rs, bf2f(w[e] >> 16) * rs);
            *p = o; }
    }
}
__device__ __forceinline__ void attn_prompt_wave(Frame& F, int rt, int hd) {
    typedef float f32x4v __attribute__((ext_vector_type(4)));
    const int lane = F.lane, fr = lane & 15, fq = lane >> 4; unsigned char* ws = F.ws;
    const int r0 = rt * 16, b = r0 / SEQ;
    const bf16* QB = (const bf16*)(ws + WS_QB); const bf16* KB = (const bf16*)(ws + WS_KB); const bf16* VT = (const bf16*)(ws + WS_VT); bf16* OB = (bf16*)(ws + WS_OB);
    bf16x8 qf[8];
    const bf16* qp = QB + (size_t)(r0 + fr) * 1024 + hd * 256 + 8 * fq;
#pragma unroll
    for (int s = 0; s < 8; ++s) qf[s] = *(const bf16x8*)(qp + 32 * s);
    f32x4v st[16];
    const bf16* kp = KB + (size_t)(b * 256 + fr) * 1024 + hd * 256 + 8 * fq;
#pragma unroll
    for (int tk = 0; tk < 16; ++tk) { f32x4v acc = (f32x4v){0.f, 0.f, 0.f, 0.f};
#pragma unroll
        for (int s = 0; s < 8; ++s) { const bf16x8 kf = *(const bf16x8*)(kp + (size_t)tk * 16 * 1024 + 32 * s); acc = __builtin_amdgcn_mfma_f32_16x16x32_bf16(kf, qf[s], acc, 0, 0, 0); }
        st[tk] = acc; }
    float m = -3.0e38f;
#pragma unroll
    for (int tk = 0; tk < 16; ++tk) m = fmaxf(fmaxf(m, fmaxf(st[tk][0], st[tk][1])), fmaxf(st[tk][2], st[tk][3]));
    m = fmaxf(m, __shfl_xor(m, 16)); m = fmaxf(m, __shfl_xor(m, 32));
    float l = 0.f;
#pragma unroll
    for (int tk = 0; tk < 16; ++tk) {
#pragma unroll
        for (int r = 0; r < 4; ++r) { const float pv = __builtin_amdgcn_exp2f(st[tk][r] - m); st[tk][r] = pv; l += pv; } }
    l += __shfl_xor(l, 16); l += __shfl_xor(l, 32);
    const float rl = 1.0f / l;
    bf16x8 pf[8];
#pragma unroll
    for (int s = 0; s < 8; ++s) { v4u w; w.x = pk2(st[2 * s][0], st[2 * s][1]); w.y = pk2(st[2 * s][2], st[2 * s][3]); w.z = pk2(st[2 * s + 1][0], st[2 * s + 1][1]); w.w = pk2(st[2 * s + 1][2], st[2 * s + 1][3]);
        pf[s] = __builtin_bit_cast(bf16x8, w); }
    const bf16* vp = VT + ((size_t)((b * 4 + hd) * 256 + fr)) * 256 + 4 * fq;
    bf16* op = OB + (size_t)(r0 + fr) * 1024 + hd * 256 + 4 * fq;
#pragma unroll 2
    for (int dt = 0; dt < 16; ++dt) { f32x4v acc = (f32x4v){0.f, 0.f, 0.f, 0.f};
#pragma unroll
        for (int s = 0; s < 8; ++s) { const v2u lo = *(const v2u*)(vp + (size_t)dt * 16 * 256 + 32 * s), hi = *(const v2u*)(vp + (size_t)dt * 16 * 256 + 32 * s + 16);
            const v4u w = (v4u){lo.x, lo.y, hi.x, hi.y}; acc = __builtin_amdgcn_mfma_f32_16x16x32_bf16(__builtin_bit_cast(bf16x8, w), pf[s], acc, 0, 0, 0); }
        v2u o; o.x = pk2(acc[0] * rl, acc[1] * rl); o.y = pk2(acc[2] * rl, acc[3] * rl); *(v2u*)(op + dt * 16) = o; }
}
__device__ __forceinline__ void attn_sample_unit(Frame& F, int sb, int hd) {
    const int tid = F.tid, lane = F.lane, w = F.wave; unsigned char* ws = F.ws;
    LAS float* sc = (LAS float*)(F.lds + RING_OFF);
    LAS float* red = sc + 4 * 256;
    const bf16* QB = (const bf16*)(ws + WS_QB); bf16* OB = (bf16*)(ws + WS_OB);
    const size_t rowq = (size_t)TP + (size_t)sb * LS;
    float q[4][4];
#pragma unroll
    for (int t = 0; t < 4; ++t) { const v2u qw = *(const v2u*)(QB + (rowq + t) * 1024 + hd * 256 + 4 * lane); q[t][0] = bf2f(qw.x & 0xffffu); q[t][1] = bf2f(qw.x >> 16); q[t][2] = bf2f(qw.y & 0xffffu); q[t][3] = bf2f(qw.y >> 16); }
    const float* Kc = F.in[6] + ((size_t)sb * 256 * 4 + hd) * 256 + 4 * lane; const float* Vc = F.in[7] + ((size_t)sb * 256 * 4 + hd) * 256 + 4 * lane;
    for (int kk = 0; kk < 32; ++kk) { const int key = w * 32 + kk; const f32x4 kv = *(const f32x4*)(Kc + (size_t)key * 1024);
#pragma unroll
        for (int t = 0; t < 4; ++t) { float s = (q[t][0] * kv.x + q[t][1] * kv.y) + (q[t][2] * kv.z + q[t][3] * kv.w); s = wave_sum(s); if (lane == 0) sc[t * 256 + key] = s; } }
    __syncthreads();
    if (w < 4) { float v[4]; float m = -3.0e38f;
#pragma unroll
        for (int j = 0; j < 4; ++j) { v[j] = sc[w * 256 + j * 64 + lane]; m = fmaxf(m, v[j]); }
        m = wave_max(m); float l = 0.f;
#pragma unroll
        for (int j = 0; j < 4; ++j) { v[j] = __builtin_amdgcn_exp2f(v[j] - m); l += v[j]; }
        l = wave_sum(l); const float rl = 1.0f / l;
#pragma unroll
        for (int j = 0; j < 4; ++j) sc[w * 256 + j * 64 + lane] = v[j] * rl; }
    __syncthreads();
    float o[4][4];
#pragma unroll
    for (int t = 0; t < 4; ++t)
#pragma unroll
        for (int e = 0; e < 4; ++e) o[t][e] = 0.f;
    for (int kk = 0; kk < 32; ++kk) { const int key = w * 32 + kk; const f32x4 vv = *(const f32x4*)(Vc + (size_t)key * 1024);
#pragma unroll
        for (int t = 0; t < 4; ++t) { const float pr = sc[t * 256 + key]; o[t][0] += pr * vv.x; o[t][1] += pr * vv.y; o[t][2] += pr * vv.z; o[t][3] += pr * vv.w; } }
#pragma unroll
    for (int t = 0; t < 4; ++t) *(LAS f32x4*)(red + (w * 4 + t) * 256 + 4 * lane) = (f32x4){o[t][0], o[t][1], o[t][2], o[t][3]};
    __syncthreads();
    { const int t = tid >> 7, d0 = (tid & 127) * 2; float a0 = 0.f, a1 = 0.f;
#pragma unroll
      for (int ww = 0; ww < 8; ++ww) { a0 += red[(ww * 4 + t) * 256 + d0]; a1 += red[(ww * 4 + t) * 256 + d0 + 1]; }
      *(unsigned*)(OB + (rowq + t) * 1024 + hd * 256 + d0) = pk2(a0, a1); }
    __syncthreads();
}
__device__ __forceinline__ void attn_phase(Frame& F) {
    const int gw = F.vcu * NWAVES + F.wave, NGW = F.G * NWAVES;
    for (int it = gw; it < (TP / 16) * 4; it += NGW) attn_prompt_wave(F, it >> 2, it & 3);
    for (int u = F.vcu; u < NBS * 4; u += F.G) attn_sample_unit(F, u >> 2, u & 3);
}
__device__ __forceinline__ void final_norm_phase(Frame& F) {
    const int gw = F.vcu * NWAVES + F.wave, NGW = F.G * NWAVES; const float* SSQ = (const float*)(F.ws + WS_SSQP3); const float* wn = F.in[31];
    f32x4 wv[4];
#pragma unroll
    for (int j = 0; j < 4; ++j) wv[j] = *((const f32x4*)wn + 64 * j + F.lane);
    for (int row = gw; row < T; row += NGW) {
        const f32x4* sp = (const f32x4*)(SSQ + (size_t)row * 16); float s = 0.f;
#pragma unroll
        for (int j = 0; j < 4; ++j) { const f32x4 a = sp[j]; s += (a.x + a.y) + (a.z + a.w); }
        const float rs = 1.0f / sqrtf(s * (1.0f / 1024.0f) + EPS);
        f32x4* p = (f32x4*)(F.out + O_Y + (size_t)row * 1024) + F.lane;
#pragma unroll
        for (int j = 0; j < 4; ++j) { const f32x4 v = p[64 * j]; p[64 * j] = v * rs * wv[j]; }
    }
}
#ifndef MK_N_LAUNCHES
#define MK_N_LAUNCHES 13
#endif
constexpr int PER_PHASE = 13;
constexpr int N_LAUNCHES = MK_N_LAUNCHES;
struct Args { const float* in[32]; float* out; unsigned char* ws; int ph_lo, ph_hi; };
__global__ void __launch_bounds__(NTHR, 2) skel_fwd(Args args) {
    extern __shared__ __attribute__((aligned(16))) unsigned char lds[];
    Frame F;
    F.lds = (LAS unsigned char*)lds;
    F.MISC = (volatile LAS unsigned*)(F.lds + MISC_OFF);
    F.tid = threadIdx.x; F.lane = F.tid & 63; F.wave = __builtin_amdgcn_readfirstlane(F.tid >> 6);
    F.G = gridDim.x; { const int bx = blockIdx.x; F.vcu = (F.G % 8 == 0) ? (bx % 8) * (F.G / 8) + bx / 8 : bx; }
    unsigned char* ws = args.ws; F.ws = ws; F.out = args.out;
    F.ctl = (gu32*)(ws + WS_CTL);
#pragma unroll
    for (int i = 0; i < 32; ++i) F.in[i] = args.in[i];
    for (int u = F.tid; u < (LDS_BYTES - LDSCTL_OFF) / 4; u += NTHR) ((LAS unsigned*)(F.lds + LDSCTL_OFF))[u] = 0u;
    __syncthreads();
    XcdBarrier bar; bar.bar = (unsigned*)(F.ctl + CW_BAR); bar.x = 0; bar.st = nullptr;
    if (N_LAUNCHES == 1) bar = xcd_barrier_post((unsigned*)(F.ctl + CW_BAR), F.MISC + 8);
#define GRID_BAR() do { if (N_LAUNCHES == 1) xcd_barrier(bar); } while (0)
    const int lo = args.ph_lo, hi = args.ph_hi;
#define IN(k) (lo <= (k) && (k) < hi)
#define BOTH(k) (IN(k) && IN((k) + 1))
    bf16* const XB = (bf16*)(ws + WS_XB); bf16* const PROJ = (bf16*)(ws + WS_PROJ);
    float* const Y = F.out + O_Y;
    if (IN(0)) { p0_prologue(F); if (BOTH(0)) GRID_BAR(); }
    if (IN(1)) {
        { pg8::Gemm g{XB, (const bf16*)(ws + WS_WIN), T, NPROJ, 1024}; pg8::StaticOrder S; S.init(T, NPROJ, F.G, (int)blockIdx.x);
          pg8::EpiScaleBf16<1, true> E{PROJ, SLOT_ELEMS, (const float*)(ws + WS_SSQX), 1.0f, (float*)(ws + WS_DT)};
          pg8::gemm_phase<pg8::EpiScaleBf16<1, true>, pg8::StaticOrder, true, true>(F.lds + RING_OFF, g, S, E); }
        { pg8::Gemm g{(const bf16*)(ws + WS_MNB), (const bf16*)(ws + WS_WKV), MEMR, 2048, 1024}; pg8::StaticOrder S; S.init(MEMR, 2048, F.G, (int)((blockIdx.x + 64) % F.G));
          pg8::EpiKV E{F.out + O_MKP, F.out + O_MVP, (bf16*)(ws + WS_KB), (bf16*)(ws + WS_VT), (const float*)(ws + WS_SSQM)};
          pg8::gemm_phase<pg8::EpiKV, pg8::StaticOrder, true, true>(F.lds + RING_OFF, g, S, E); }
        if (BOTH(1)) GRID_BAR();
    }
    if (IN(2)) { scan_phase(F); if (BOTH(2)) GRID_BAR(); }
    if (IN(3)) { ssdnorm_phase(F); if (BOTH(3)) GRID_BAR(); }
    if (IN(4)) { pg8::Gemm g{(const bf16*)(ws + WS_YG), (const bf16*)(ws + WS_WSSD), T, 1024, 2048}; pg8::StaticOrder S; S.init(T, 1024, F.G, (int)blockIdx.x);
        pg8::EpiGate<false> E{(bf16*)(ws + WS_MERGED), PROJ + (size_t)S_GS * SLOT_ELEMS};
        pg8::gemm_phase<pg8::EpiGate<false>, pg8::StaticOrder, true, true>(F.lds + RING_OFF, g, S, E);
        if (BOTH(4)) GRID_BAR(); }
    if (IN(5)) { pg8::Gemm g{(const bf16*)(ws + WS_ON), (const bf16*)(ws + WS_WHG), T, 1024, 1024}; pg8::StaticOrder S; S.init(T, 1024, F.G, (int)blockIdx.x);
        pg8::EpiGate<true> E{(bf16*)(ws + WS_MERGED), PROJ + (size_t)S_GH * SLOT_ELEMS};
        pg8::gemm_phase<pg8::EpiGate<true>, pg8::StaticOrder, true, true>(F.lds + RING_OFF, g, S, E);
        if (BOTH(5)) GRID_BAR(); }
    if (IN(6)) { pg8::Gemm g{(const bf16*)(ws + WS_MERGED), (const bf16*)(ws + WS_WOUT), T, 1024, 1024}; pg8::StaticOrder S; S.init(T, 1024, F.G, (int)blockIdx.x);
        pg8::EpiRes E{F.in[0], F.in[1] - (size_t)TP * 1024, Y, (bf16*)(ws + WS_HB), (float*)(ws + WS_SSQP1)};
        pg8::gemm_phase<pg8::EpiRes, pg8::StaticOrder, true, true>(F.lds + RING_OFF, g, S, E);
        if (BOTH(6)) GRID_BAR(); }
    if (IN(7)) { pg8::Gemm g{(const bf16*)(ws + WS_HB), (const bf16*)(ws + WS_WCQ), T, 1024, 1024}; pg8::StaticOrder S; S.init(T, 1024, F.G, (int)blockIdx.x);
        pg8::EpiScaleBf16<16, false> E{(bf16*)(ws + WS_QB), SLOT_ELEMS, (const float*)(ws + WS_SSQP1), QSCALE, nullptr};
        pg8::gemm_phase<pg8::EpiScaleBf16<16, false>, pg8::StaticOrder, true, true>(F.lds + RING_OFF, g, S, E);
        if (BOTH(7)) GRID_BAR(); }
    if (IN(8)) { attn_phase(F); if (BOTH(8)) GRID_BAR(); }
    if (IN(9)) { pg8::Gemm g{(const bf16*)(ws + WS_OB), (const bf16*)(ws + WS_WCO), T, 1024, 1024}; pg8::StaticOrder S; S.init(T, 1024, F.G, (int)blockIdx.x);
        pg8::EpiRes E{Y, Y, Y, (bf16*)(ws + WS_HB), (float*)(ws + WS_SSQP2)};
        pg8::gemm_phase<pg8::EpiRes, pg8::StaticOrder, true, true>(F.lds + RING_OFF, g, S, E);
        if (BOTH(9)) GRID_BAR(); }
    if (IN(10)) { pg8::Gemm g{(const bf16*)(ws + WS_HB), (const bf16*)(ws + WS_WGU), T, 2 * FFN, 1024}; pg8::StaticOrder S; S.init(T, 2 * FFN, F.G, (int)blockIdx.x);
        pg8::EpiSwiglu E{(bf16*)(ws + WS_ACT), (const float*)(ws + WS_SSQP2)};
        pg8::gemm_phase<pg8::EpiSwiglu, pg8::StaticOrder, true, true>(F.lds + RING_OFF, g, S, E);
        if (BOTH(10)) GRID_BAR(); }
    if (IN(11)) { pg8::Gemm g{(const bf16*)(ws + WS_ACT), (const bf16*)(ws + WS_WDN), T, 1024, FFN}; pg8::StaticOrder S; S.init(T, 1024, F.G, (int)blockIdx.x);
        pg8::EpiRes E{Y, Y, Y, nullptr, (float*)(ws + WS_SSQP3)};
        pg8::gemm_phase<pg8::EpiRes, pg8::StaticOrder, true, true>(F.lds + RING_OFF, g, S, E);
        if (BOTH(11)) GRID_BAR(); }
    if (IN(12)) final_norm_phase(F);
#undef IN
#undef BOTH
}

extern "C" void kernel_launch(void* const* d_in, const int* in_sizes, int n_in, void* d_out, int out_size, void* d_ws, size_t ws_size, hipStream_t stream) {
    static int grid = 0;
    if (grid == 0) {
        const int want[32] = {TP * 1024, TS * 1024, MEMR * 1024, 33554432, 1179648, 16777216, 33554432, 33554432, 1024, 1024 * 11296, 4 * 3072, 3072, 32, 32, 32, 2048, 2048 * 1024, 2048, 1024,
                              1024 * 1024, 1024 * 1024, 1024, 1024, 1024 * 1024, 1024 * 1024, 1024 * 1024, 1024 * 1024, 1024, 1024 * FFN, 1024 * FFN, FFN * 1024, 1024};
        bool ok = (n_in == 32); for (int i = 0; ok && i < 32; ++i) if (in_sizes[i] != want[i]) { fprintf(stderr, "kernel_launch: input %d has %d elements, expected %d\n", i, in_sizes[i], want[i]); ok = false; }
        if (!ok || out_size != (int)O_END || ws_size < WS_END) { fprintf(stderr, "kernel_launch: unexpected shapes: n_in %d out %d ws %zu\n", n_in, out_size, ws_size); grid = -1; return; }
        int dev = 0, cus = 0, per_cu = 0;
        if (hipGetDevice(&dev) != hipSuccess || hipDeviceGetAttribute(&cus, hipDeviceAttributeMultiprocessorCount, dev) != hipSuccess) { grid = -1; return; }
        if (hipFuncSetAttribute((const void*)skel_fwd, hipFuncAttributeMaxDynamicSharedMemorySize, LDS_BYTES) != hipSuccess) { fprintf(stderr, "kernel_launch: hipFuncSetAttribute failed\n"); grid = -1; return; }
        if (hipOccupancyMaxActiveBlocksPerMultiprocessor(&per_cu, (const void*)skel_fwd, NTHR, LDS_BYTES) != hipSuccess || per_cu < 1) fprintf(stderr, "kernel_launch: occupancy query reports %d blocks per CU\n", per_cu);
        (void)hipGetLastError();
        grid = cus;
    }
    if (grid < 0) return;
    (void)hipMemsetAsync((char*)d_ws + WS_CTL, 0, CTL_ZERO_BYTES, stream);
    Args a{};
    for (int i = 0; i < 32; ++i) a.in[i] = (const float*)d_in[i];
    a.out = (float*)d_out; a.ws = (unsigned char*)d_ws;
    for (int li = 0; li < N_LAUNCHES; ++li) {
        a.ph_lo = (N_LAUNCHES == PER_PHASE) ? li : 0; a.ph_hi = (N_LAUNCHES == PER_PHASE) ? li + 1 : PER_PHASE;
        hipLaunchKernelGGL(skel_fwd, dim3(grid), dim3(NTHR), LDS_BYTES, stream, a);
    }
}
```

```cpp
#include <hip/hip_runtime.h>
#include <cstdio>
#include <cstdint>
namespace pg8 {
#define PG8_LAS __attribute__((address_space(3)))
typedef unsigned short bf16_t;
typedef short bf16x8 __attribute__((ext_vector_type(8)));
typedef float f32x4 __attribute__((ext_vector_type(4)));
typedef unsigned u32x4 __attribute__((ext_vector_type(4)));
constexpr int BM = 256, BK = 64, HALF = 128, HTB = HALF * BK * 2  , STAGE_BYTES = 8 * HTB, NXCD = 8, WGM = 8;

__host__ __device__ __forceinline__ int lds_byte(int r, int c) { const int st = (r >> 4) * 2 + (c >> 5), rr = r & 15, cc = c & 31, ob = rr * 64 + cc * 2; return st * 1024 + (ob ^ (((ob >> 9) & 1) << 5)); }
__host__ __device__ __forceinline__ void stage_rc(int b, int& R, int& C) { const int st = b / 1024, sb = b % 1024, swz = sb ^ (((sb >> 9) & 1) << 5); R = (st >> 1) * 16 + swz / 64; C = (st & 1) * 32 + (swz % 64) / 2; }
__host__ __device__ __forceinline__ int perm32(int rho) { const int n = rho >> 4, i = rho & 15; return 8 * (i >> 2) + 4 * n + (i & 3); }

struct Unit { int pm, pn; };
struct Gemm { const bf16_t* A; const bf16_t* Bt; int M, N, K; };

struct StaticOrder {
    int nM, nN, nwg, G, c;
    __host__ __device__ void init(int M, int N, int G_, int c_) { nM = M / BM; nN = N / BM; nwg = nM * nN; G = G_; c = c_; }
    __host__ __device__ bool next(int i, Unit& u) const {
        const long L = (long)i * G + c; if (L >= nwg) return false;
        int wgid = (int)L; { const int q = nwg / NXCD, r = nwg % NXCD, xcd = wgid % NXCD, off = wgid / NXCD; wgid = (xcd < r ? xcd * (q + 1) : r * (q + 1) + (xcd - r) * q) + off; }
        const int nig = WGM * nN, gid = wgid / nig, fm = gid * WGM, gsz = (nM - fm) < WGM ? (nM - fm) : WGM;
        u.pm = fm + ((wgid % nig) % gsz); u.pn = (wgid % nig) / gsz; return true;
    }
    __device__ __forceinline__ void a_ready(const Unit&) const {}
    __device__ __forceinline__ void done(const Unit&) const {}
};

__device__ __forceinline__ unsigned cvt_pk_bf16(float lo, float hi) { unsigned r; asm volatile("v_cvt_pk_bf16_f32 %0, %1, %2" : "=v"(r) : "v"(lo), "v"(hi)); return r; }
typedef float f32x2 __attribute__((ext_vector_type(2)));
typedef unsigned u32x2 __attribute__((ext_vector_type(2)));
constexpr float RMS_EPS = 1e-6f;
__device__ __forceinline__ float bfbits2f(unsigned v16) { return __uint_as_float(v16 << 16); }
__device__ __forceinline__ float sigm(float x) { return 1.0f / (1.0f + __expf(-x)); }
template <int NP> __device__ __forceinline__ float row_rs(const float* ssq, int row) {
    float s = 0.f;
    if constexpr (NP == 1) s = ssq[row];
    else {
#pragma unroll
        for (int i = 0; i < NP / 4; ++i) { const f32x4 v = *(const f32x4*)(ssq + (size_t)row * NP + 4 * i); s += (v[0] + v[1]) + (v[2] + v[3]); }
    }
    return 1.0f / sqrtf(s * (1.0f / 1024.0f) + RMS_EPS);
}
template <int NP, bool HAS_DT> struct EpiScaleBf16 {
    static constexpr bool PERM = true, AFTER_DRAIN = false;
    bf16_t* O; size_t slot_elems; const float* ssq; float scale; float* dt;
    __device__ __forceinline__ void operator()(const f32x4 (&acc)[2][2][4][2], const Unit& u, int wr, int wc, int fr, int fq) const {
        const int row0 = u.pm * BM + wr * 64 + fr;
        if (HAS_DT && u.pn == 44) {
            if (wc == 0) {
#pragma unroll
                for (int ai = 0; ai < 2; ++ai)
#pragma unroll
                    for (int m = 0; m < 4; ++m) { const int row = row0 + ai * HALF + m * 16; const float rs = row_rs<NP>(ssq, row);
                        float* p = dt + (size_t)row * 32 + 8 * fq; *(f32x4*)p = acc[ai][0][m][0] * rs; *(f32x4*)(p + 4) = acc[ai][0][m][1] * rs; }
            }
            return;
        }
        bf16_t* base = O + (size_t)(u.pn >> 2) * slot_elems; const int col0 = (u.pn & 3) * BM + wc * 32 + 8 * fq;
#pragma unroll
        for (int ai = 0; ai < 2; ++ai)
#pragma unroll
            for (int m = 0; m < 4; ++m) { const int row = row0 + ai * HALF + m * 16; const float rs = row_rs<NP>(ssq, row) * scale; bf16_t* rowp = base + (size_t)row * 1024 + col0;
#pragma unroll
                for (int bj = 0; bj < 2; ++bj) { const f32x4 v0 = acc[ai][bj][m][0] * rs, v1 = acc[ai][bj][m][1] * rs;
                    u32x4 w; w.x = cvt_pk_bf16(v0[0], v0[1]); w.y = cvt_pk_bf16(v0[2], v0[3]); w.z = cvt_pk_bf16(v1[0], v1[1]); w.w = cvt_pk_bf16(v1[2], v1[3]);
                    *(u32x4*)(rowp + bj * HALF) = w; } }
    }
};
struct EpiKV {
    static constexpr bool PERM = false, AFTER_DRAIN = false;
    float* mk; float* mv; bf16_t* kb; bf16_t* vt; const float* ssq;
    __device__ __forceinline__ void operator()(const f32x4 (&acc)[2][2][4][2], const Unit& u, int wr, int wc, int fr, int fq) const {
        const int row0 = u.pm * BM + wr * 64 + fr; const bool isv = u.pn >= 4; const int colt = (u.pn & 3) * BM + wc * 32 + 4 * fq;
#pragma unroll
        for (int ai = 0; ai < 2; ++ai)
#pragma unroll
            for (int m = 0; m < 4; ++m) { const int row = row0 + ai * HALF + m * 16; const float rs = row_rs<1>(ssq, row);
#pragma unroll
                for (int bj = 0; bj < 2; ++bj)
#pragma unroll
                    for (int n = 0; n < 2; ++n) { const int c = colt + bj * HALF + n * 16; const f32x4 v = acc[ai][bj][m][n] * rs;
                        if (!isv) { *(f32x4*)(mk + (size_t)row * 1024 + c) = v; u32x2 w; w.x = cvt_pk_bf16(v[0], v[1]); w.y = cvt_pk_bf16(v[2], v[3]); *(u32x2*)(kb + (size_t)row * 1024 + c) = w; }
                        else { *(f32x4*)(mv + (size_t)row * 1024 + c) = v; const int b = row >> 8, key = row & 255, hd = c >> 8, d = c & 255;
                            bf16_t* p = vt + ((size_t)((b * 4 + hd) * 256 + d)) * 256 + key; const unsigned w0 = cvt_pk_bf16(v[0], v[1]), w1 = cvt_pk_bf16(v[2], v[3]);
                            p[0] = (bf16_t)(w0 & 0xffffu); p[256] = (bf16_t)(w0 >> 16); p[512] = (bf16_t)(w1 & 0xffffu); p[768] = (bf16_t)(w1 >> 16); } } }
    }
};
template <bool ADD> struct EpiGate {
    static constexpr bool PERM = true, AFTER_DRAIN = false;
    bf16_t* O; const bf16_t* gate;
    __device__ __forceinline__ void operator()(const f32x4 (&acc)[2][2][4][2], const Unit& u, int wr, int wc, int fr, int fq) const {
        const int row0 = u.pm * BM + wr * 64 + fr, col0 = u.pn * BM + wc * 32 + 8 * fq;
#pragma unroll
        for (int ai = 0; ai < 2; ++ai)
#pragma unroll
            for (int m = 0; m < 4; ++m) { const size_t off = (size_t)(row0 + ai * HALF + m * 16) * 1024 + col0;
#pragma unroll
                for (int bj = 0; bj < 2; ++bj) { const u32x4 gw = *(const u32x4*)(gate + off + bj * HALF); u32x4 ow = (u32x4){0u, 0u, 0u, 0u}; if (ADD) ow = *(const u32x4*)(O + off + bj * HALF);
                    float r[8];
#pragma unroll
                    for (int e = 0; e < 8; ++e) { const unsigned g16 = (gw[e >> 1] >> ((e & 1) * 16)) & 0xffffu, o16 = (ow[e >> 1] >> ((e & 1) * 16)) & 0xffffu;
                        const float a = acc[ai][bj][m][e >> 2][e & 3]; r[e] = (ADD ? bfbits2f(o16) : 0.f) + sigm(bfbits2f(g16)) * a; }
                    u32x4 w; w.x = cvt_pk_bf16(r[0], r[1]); w.y = cvt_pk_bf16(r[2], r[3]); w.z = cvt_pk_bf16(r[4], r[5]); w.w = cvt_pk_bf16(r[6], r[7]);
                    *(u32x4*)(O + off + bj * HALF) = w; } }
    }
};
struct EpiRes {
    static constexpr bool PERM = false, AFTER_DRAIN = false;
    const float* base0; const float* base1; float* out; bf16_t* hb; float* ssqp;
    __device__ __forceinline__ void operator()(const f32x4 (&acc)[2][2][4][2], const Unit& u, int wr, int wc, int fr, int fq) const {
        const int row0 = u.pm * BM + wr * 64 + fr, col0 = u.pn * BM + wc * 32 + 4 * fq; const float* base = u.pm < 64 ? base0 : base1;
#pragma unroll
        for (int ai = 0; ai < 2; ++ai)
#pragma unroll
            for (int m = 0; m < 4; ++m) { const int row = row0 + ai * HALF + m * 16; const size_t off = (size_t)row * 1024 + col0; float sq = 0.f;
#pragma unroll
                for (int bj = 0; bj < 2; ++bj)
#pragma unroll
                    for (int n = 0; n < 2; ++n) { const size_t o2 = off + bj * HALF + n * 16; const f32x4 v = *(const f32x4*)(base + o2) + acc[ai][bj][m][n];
                        *(f32x4*)(out + o2) = v; sq += (v[0] * v[0] + v[1] * v[1]) + (v[2] * v[2] + v[3] * v[3]);
                        if (hb) { u32x2 w; w.x = cvt_pk_bf16(v[0], v[1]); w.y = cvt_pk_bf16(v[2], v[3]); *(u32x2*)(hb + o2) = w; } }
                sq += __shfl_xor(sq, 16); sq += __shfl_xor(sq, 32);
                if (fq == 0) ssqp[(size_t)row * 16 + u.pn * 4 + wc] = sq; }
    }
};
struct EpiSwiglu {
    static constexpr bool PERM = true, AFTER_DRAIN = false;
    bf16_t* act; const float* ssq;
    __device__ __forceinline__ void operator()(const f32x4 (&acc)[2][2][4][2], const Unit& u, int wr, int wc, int fr, int fq) const {
        const int row0 = u.pm * BM + wr * 64 + fr, col0 = u.pn * 128 + wc * 16 + 4 * fq;
#pragma unroll
        for (int ai = 0; ai < 2; ++ai)
#pragma unroll
            for (int m = 0; m < 4; ++m) { const int row = row0 + ai * HALF + m * 16; const float rs = row_rs<16>(ssq, row);
#pragma unroll
                for (int bj = 0; bj < 2; ++bj) { const f32x4 a = acc[ai][bj][m][0] * rs, b = acc[ai][bj][m][1] * rs;
                    const float r0 = a[0] * sigm(a[0]) * a[1], r1 = a[2] * sigm(a[2]) * a[3], r2 = b[0] * sigm(b[0]) * b[1], r3 = b[2] * sigm(b[2]) * b[3];
                    u32x2 w; w.x = cvt_pk_bf16(r0, r1); w.y = cvt_pk_bf16(r2, r3); *(u32x2*)(act + (size_t)row * 2816 + col0 + bj * 64) = w; } }
    }
};
template <class Epi, class Sched, bool ALIGN_EPI = false, bool SP2 = false>
__device__ __forceinline__ void gemm_phase(PG8_LAS unsigned char* lds, const Gemm g, const Sched& S, const Epi& E) {
    const int tid = threadIdx.x, wid = __builtin_amdgcn_readfirstlane(tid >> 6), lane = tid & 63, wr = wid >> 2, wc = wid & 3, fr = lane & 15, fq = lane >> 4;
    const int K = g.K, nt = K / BK;
    unsigned voffA[2], voffB[2];
#pragma unroll
    for (int i = 0; i < 2; ++i) { int R, C; stage_rc(tid * 16 + i * 8192, R, C); const int Rb = Epi::PERM ? ((R & ~31) + perm32(R & 31)) : R;
        voffA[i] = (unsigned)(R * K + C) * 2u; voffB[i] = (unsigned)(Rb * K + C) * 2u; }
    const size_t kstep = (size_t)(BK * 2);
    const size_t hstep = (size_t)HALF * K * 2;
    const size_t tstep = 2 * hstep;
    const unsigned ldsw = (unsigned)wid * 1024u;
    const int aoff = lds_byte(wr * 64 + fr, fq * 8), boff = lds_byte(wc * 32 + fr, fq * 8);
#define PG8_SA(b, h) (((b) * 2 + (h)) * HTB)
#define PG8_SB(b, h) ((4 + (b) * 2 + (h)) * HTB)
#define PG8_STAGE(bufoff, gbase, voff) do { _Pragma("unroll") for (int _i = 0; _i < 2; ++_i) \
        __builtin_amdgcn_global_load_lds((const unsigned*)((const char*)(gbase) + (voff)[_i]), (PG8_LAS unsigned*)(lds + (bufoff) + ldsw + _i * 8192), 16, 0, 0); } while (0)
#define PG8_LDA(dst, b, h) do { _Pragma("unroll") for (int m = 0; m < 4; ++m) _Pragma("unroll") for (int k = 0; k < 2; ++k) dst[m][k] = *(const PG8_LAS bf16x8*)(lds + PG8_SA(b, h) + aoff + m * 2048 + k * 1024); } while (0)
#define PG8_LDB(dst, b, h) do { _Pragma("unroll") for (int n = 0; n < 2; ++n) _Pragma("unroll") for (int k = 0; k < 2; ++k) dst[n][k] = *(const PG8_LAS bf16x8*)(lds + PG8_SB(b, h) + boff + n * 2048 + k * 1024); } while (0)
#define PG8_MMA(ai, bj, At, Bt) do { __builtin_amdgcn_s_setprio(1); _Pragma("unroll") for (int m = 0; m < 4; ++m) _Pragma("unroll") for (int n = 0; n < 2; ++n) _Pragma("unroll") for (int k = 0; k < 2; ++k) \
        acc[ai][bj][m][n] = __builtin_amdgcn_mfma_f32_16x16x32_bf16(Bt[n][k], At[m][k], acc[ai][bj][m][n], 0, 0, 0); __builtin_amdgcn_s_setprio(0); } while (0)
#define PG8_WAIT_V(n) asm volatile("s_waitcnt vmcnt(" #n ")" ::: "memory")
#define PG8_WAIT_L(n) asm volatile("s_waitcnt lgkmcnt(" #n ")" ::: "memory")
#define PG8_BAR __builtin_amdgcn_s_barrier()
#define PG8_SCHED __builtin_amdgcn_sched_barrier(0)
    Unit cur, nxt; int ui = 0;
    if (!S.next(0, cur)) return;
    f32x4 acc[2][2][4][2];
#pragma unroll
    for (int a = 0; a < 2; ++a)
#pragma unroll
        for (int b = 0; b < 2; ++b)
#pragma unroll
            for (int m = 0; m < 4; ++m)
#pragma unroll
                for (int n = 0; n < 2; ++n) acc[a][b][m][n] = (f32x4){0.f, 0.f, 0.f, 0.f};
    bf16x8 At[4][2], B0[2][2], B1[2][2];
    const char* cA = (const char*)g.A + (size_t)cur.pm * tstep; const char* cB = (const char*)g.Bt + (size_t)cur.pn * tstep;
    S.a_ready(cur);
    if constexpr (SP2) {
        PG8_STAGE(PG8_SB(0, 0), cB, voffB); PG8_STAGE(PG8_SB(0, 1), cB + hstep, voffB); PG8_STAGE(PG8_SA(0, 0), cA, voffA); PG8_STAGE(PG8_SA(0, 1), cA + hstep, voffA);
        if (wr == 1) PG8_BAR;
        PG8_WAIT_V(2); PG8_BAR;
        PG8_STAGE(PG8_SB(1, 0), cB + kstep, voffB); PG8_STAGE(PG8_SA(1, 0), cA + kstep, voffA); PG8_STAGE(PG8_SB(1, 1), cB + hstep + kstep, voffB);
        PG8_WAIT_V(6); PG8_BAR;
    } else {
        PG8_STAGE(PG8_SB(0, 0), cB, voffB); PG8_STAGE(PG8_SA(0, 0), cA, voffA); PG8_STAGE(PG8_SB(0, 1), cB + hstep, voffB); PG8_STAGE(PG8_SA(0, 1), cA + hstep, voffA);
        if (wr == 1) PG8_BAR;
        PG8_WAIT_V(4); PG8_BAR;
        PG8_STAGE(PG8_SB(1, 0), cB + kstep, voffB); PG8_STAGE(PG8_SA(1, 0), cA + kstep, voffA); PG8_STAGE(PG8_SB(1, 1), cB + hstep + kstep, voffB);
        PG8_WAIT_V(6); PG8_BAR;
    }
    for (;;) {
        const bool has_next = S.next(ui + 1, nxt);
        const char* nA = has_next ? (const char*)g.A + (size_t)nxt.pm * tstep : cA; const char* nB = has_next ? (const char*)g.Bt + (size_t)nxt.pn * tstep : cB;
        for (int t = 0; t < nt; t += 2) {
            const bool last = (t == nt - 2);
            const char* a1 = cA + (size_t)(t + 1) * kstep;
            const char* a2 = last ? nA : cA + (size_t)(t + 2) * kstep; const char* b2 = last ? nB : cB + (size_t)(t + 2) * kstep;
            const char* a3 = a2 + kstep; const char* b3 = b2 + kstep;
            if (last && has_next) S.a_ready(nxt);
            if constexpr (SP2) {
            PG8_LDB(B0, 0, 0); PG8_LDB(B1, 0, 1); PG8_SCHED; PG8_LDA(At, 0, 0); PG8_STAGE(PG8_SA(1, 1), a1 + hstep, voffA);
            PG8_WAIT_V(8); PG8_WAIT_L(0); PG8_BAR; PG8_MMA(0, 0, At, B0); PG8_MMA(0, 1, At, B1); PG8_BAR; PG8_SCHED;
            PG8_LDA(At, 0, 1); PG8_STAGE(PG8_SB(0, 0), b2, voffB); PG8_STAGE(PG8_SB(0, 1), b2 + hstep, voffB); PG8_STAGE(PG8_SA(0, 0), a2, voffA);
            PG8_WAIT_V(8); PG8_WAIT_L(0); PG8_BAR; PG8_MMA(1, 0, At, B0); PG8_MMA(1, 1, At, B1); PG8_BAR; PG8_SCHED;
            PG8_LDB(B0, 1, 0); PG8_LDB(B1, 1, 1); PG8_SCHED; PG8_LDA(At, 1, 0); PG8_STAGE(PG8_SA(0, 1), a2 + hstep, voffA);
            PG8_WAIT_V(8); PG8_WAIT_L(0); PG8_BAR; PG8_MMA(0, 0, At, B0); PG8_MMA(0, 1, At, B1); PG8_BAR; PG8_SCHED;
            PG8_LDA(At, 1, 1); PG8_STAGE(PG8_SB(1, 0), b3, voffB); PG8_STAGE(PG8_SB(1, 1), b3 + hstep, voffB); PG8_STAGE(PG8_SA(1, 0), a3, voffA);
            PG8_WAIT_V(8); PG8_WAIT_L(0); PG8_BAR; PG8_MMA(1, 0, At, B0); PG8_MMA(1, 1, At, B1); PG8_BAR; PG8_SCHED;
            } else {
            PG8_LDB(B0, 0, 0); PG8_SCHED; PG8_LDA(At, 0, 0); PG8_STAGE(PG8_SA(1, 1), a1 + hstep, voffA);
            PG8_WAIT_L(8); PG8_BAR; PG8_WAIT_L(0); PG8_MMA(0, 0, At, B0); PG8_BAR; PG8_SCHED;
            PG8_LDB(B1, 0, 1); PG8_STAGE(PG8_SB(0, 0), b2, voffB);
            PG8_BAR; PG8_WAIT_L(0); PG8_MMA(0, 1, At, B1); PG8_BAR;
            PG8_LDA(At, 0, 1); PG8_STAGE(PG8_SA(0, 0), a2, voffA);
            PG8_BAR; PG8_WAIT_L(0); PG8_MMA(1, 0, At, B0); PG8_BAR; PG8_SCHED;
            PG8_STAGE(PG8_SB(0, 1), b2 + hstep, voffB);
            PG8_WAIT_V(6); PG8_BAR; PG8_MMA(1, 1, At, B1); PG8_BAR;
            PG8_LDB(B0, 1, 0); PG8_SCHED; PG8_LDA(At, 1, 0); PG8_STAGE(PG8_SA(0, 1), a2 + hstep, voffA);
            PG8_WAIT_L(8); PG8_BAR; PG8_WAIT_L(0); PG8_MMA(0, 0, At, B0); PG8_BAR; PG8_SCHED;
            PG8_LDB(B1, 1, 1); PG8_STAGE(PG8_SB(1, 0), b3, voffB);
            PG8_BAR; PG8_WAIT_L(0); PG8_MMA(0, 1, At, B1); PG8_BAR;
            PG8_LDA(At, 1, 1); PG8_STAGE(PG8_SA(1, 0), a3, voffA);
            PG8_BAR; PG8_WAIT_L(0); PG8_MMA(1, 0, At, B0); PG8_BAR; PG8_SCHED;
            PG8_STAGE(PG8_SB(1, 1), b3 + hstep, voffB);
            PG8_WAIT_V(6); PG8_BAR; PG8_MMA(1, 1, At, B1); PG8_BAR;
            }
        }
        if constexpr (ALIGN_EPI) { if (wr == 0) PG8_BAR; }
        if constexpr (!Epi::AFTER_DRAIN) { E(acc, cur, wr, wc, fr, fq); S.done(cur); }
        if (!has_next) break;
#pragma unroll
        for (int a = 0; a < 2; ++a)
#pragma unroll
            for (int b = 0; b < 2; ++b)
#pragma unroll
                for (int m = 0; m < 4; ++m)
#pragma unroll
                    for (int n = 0; n < 2; ++n) acc[a][b][m][n] = (f32x4){0.f, 0.f, 0.f, 0.f};
        cur = nxt; cA = nA; cB = nB; ++ui;
        if constexpr (ALIGN_EPI) { if (wr == 1) PG8_BAR; }
    }
    PG8_WAIT_V(0);
    if constexpr (!ALIGN_EPI) { if (wr == 0) PG8_BAR; }
    PG8_BAR;
    if constexpr (Epi::AFTER_DRAIN) { E.fused(acc, cur, wr, wc, fr, fq, lds, wid, lane); S.done(cur); }
#undef PG8_SA
#undef PG8_SB
#undef PG8_STAGE
#undef PG8_LDA
#undef PG8_LDB
#undef PG8_MMA
#undef PG8_WAIT_V
#undef PG8_WAIT_L
#undef PG8_BAR
#undef PG8_SCHED
}
}
#define GAS __attribute__((address_space(1)))
#define LAS __attribute__((address_space(3)))
typedef unsigned short bf16;
typedef unsigned v4u __attribute__((ext_vector_type(4)));
typedef float f32x4 __attribute__((ext_vector_type(4)));
typedef short bf16x8 __attribute__((ext_vector_type(8)));
typedef GAS unsigned gu32;
typedef GAS unsigned long long gu64;
#define RLX_AGENT __ATOMIC_RELAXED, __HIP_MEMORY_SCOPE_AGENT
#define LDS_WAIT() asm volatile("s_waitcnt lgkmcnt(0)" ::: "memory")
#define VM_WAIT() asm volatile("s_waitcnt vmcnt(0)" ::: "memory")
__device__ __forceinline__ unsigned long long rt() { return __builtin_amdgcn_s_memrealtime(); }
__device__ __forceinline__ unsigned f2bf(float f) { unsigned u = __builtin_bit_cast(unsigned, f); return (u + 0x7fffu + ((u >> 16) & 1u)) >> 16; }
__device__ __forceinline__ unsigned pk2(float lo, float hi) { return f2bf(lo) | (f2bf(hi) << 16); }

#define XB_TMO      128
#define XB_XCNT(j)  (256  + 64 * (j))
#define XB_XSUB(j)  (1280 + 64 * (j))
#define XB_XGEN(j)  (2304 + 64 * (j))
#define XB_TOP      3328
#define XB_TOPGEN   3392
#define XCD_BAR_WORDS 3456
#define XB_SPIN_CAP (1u << 18)

__device__ __forceinline__ unsigned xb_ld(unsigned* p)              { return __hip_atomic_load(p, __ATOMIC_RELAXED, __HIP_MEMORY_SCOPE_AGENT); }
__device__ __forceinline__ unsigned xb_add(unsigned* p, unsigned v) { return __hip_atomic_fetch_add(p, v, __ATOMIC_RELAXED, __HIP_MEMORY_SCOPE_AGENT); }
__device__ __forceinline__ unsigned xb_xcc_id() { return (unsigned)__builtin_amdgcn_s_getreg((3 << 11) | 20) & 0xFu; }
#define XB_SPIN(cond, bar) do { unsigned _sp = 0; while (cond) { __builtin_amdgcn_s_sleep(1); \
    if ((++_sp & 255u) == 0u) { if (xb_ld(&(bar)[XB_TMO])) break; if (_sp > XB_SPIN_CAP) { atomicAdd(&(bar)[XB_TMO], 1u); break; } } } } while (0)

struct XcdBarrier {
    unsigned* bar; unsigned x;
    volatile LAS unsigned* st;
};

__device__ __forceinline__ XcdBarrier xcd_barrier_post(unsigned* bar, volatile LAS unsigned* st) {
    XcdBarrier b; b.bar = bar; b.x = xb_xcc_id(); b.st = st;
    if (threadIdx.x == 0) (void)xb_add(&bar[XB_XCNT(b.x)], 1u);
    return b;
}
__device__ __forceinline__ void xcd_barrier_complete(unsigned* bar, unsigned x, unsigned& nloc, unsigned& nx) {
    const unsigned G = gridDim.x * gridDim.y * gridDim.z;
    unsigned sum, cnt, mine, sp = 0u;
    for (;;) {
        sum = 0u; cnt = 0u; mine = 0u;
#pragma unroll
        for (unsigned j = 0; j < 16; ++j) { const unsigned c = xb_ld(&bar[XB_XCNT(j)]); sum += c; cnt += (c > 0u) ? 1u : 0u; mine = (j == x) ? c : mine; }
        if (sum == G) break;
        __builtin_amdgcn_s_sleep(1);
        if ((++sp & 255u) == 0u) { if (xb_ld(&bar[XB_TMO])) break; if (sp > XB_SPIN_CAP) { atomicAdd(&bar[XB_TMO], 1u); break; } }
    }
    nloc = mine > 0u ? mine : 1u; nx = cnt > 0u ? cnt : 1u;
}

__device__ __forceinline__ void xcd_barrier(const XcdBarrier& b) {
    asm volatile("s_waitcnt vmcnt(0)" ::: "memory");
    __syncthreads();
    if (threadIdx.x == 0) {
        unsigned* bar = b.bar;
        __builtin_amdgcn_s_waitcnt(0);
        unsigned nloc = b.st[0], nx = b.st[1];
        if (nloc == 0u) { xcd_barrier_complete(bar, b.x, nloc, nx); b.st[0] = nloc; b.st[1] = nx; }
        const unsigned old = xb_add(&bar[XB_XSUB(b.x)], 1u);
        const unsigned gen = old / nloc;
        if (old + 1u == (gen + 1u) * nloc) {
            __builtin_amdgcn_fence(__ATOMIC_RELEASE, "agent");
            asm volatile("s_waitcnt vmcnt(0)" ::: "memory");
            const unsigned og = xb_add(&bar[XB_TOP], 1u);
            const unsigned tg = og / nx;
            if (og + 1u == (tg + 1u) * nx) xb_add(&bar[XB_TOPGEN], 1u);
            else XB_SPIN(xb_ld(&bar[XB_TOPGEN]) == tg, bar);
            __builtin_amdgcn_fence(__ATOMIC_ACQUIRE, "agent");
            xb_add(&bar[XB_XGEN(b.x)], 1u);
            asm volatile("s_waitcnt vmcnt(0)" ::: "memory");
        } else {
            XB_SPIN(xb_ld(&bar[XB_XGEN(b.x)]) == gen, bar);
            __builtin_amdgcn_fence(__ATOMIC_ACQUIRE, "agent");
            asm volatile("s_waitcnt vmcnt(0)" ::: "memory");
        }
    }
    __syncthreads();
}
typedef unsigned v2u __attribute__((ext_vector_type(2)));
constexpr int NWAVES = 8, NTHR = 512;
constexpr int DM = 1024, TP = 16384, TS = 512, T = TP + TS;
constexpr int SEQ = 2048, NBP = 8, NBS = 128, LS = 4, MEMR = 2048;
constexpr int NPROJ = 11520;
constexpr int FFN = 2816;
constexpr float EPS = 1e-6f;
constexpr float QSCALE = 0.0625f * 1.4426950408889634f;

constexpr size_t MiB = 1u << 20;
constexpr size_t WS_CTL = 0, CTL_ZERO_BYTES = 1 * MiB;
constexpr size_t WS_SSQX = 1 * MiB, WS_SSQM = 1 * MiB + 512 * 1024;
constexpr size_t WS_DT = 2 * MiB, WS_SSQSSD = 5 * MiB, WS_SSQP1 = 8 * MiB, WS_SSQP2 = 9 * MiB + 512 * 1024, WS_SSQP3 = 11 * MiB;
constexpr size_t WS_WIN = 13 * MiB, WS_WKV = 36 * MiB, WS_WSSD = 40 * MiB, WS_WHG = 44 * MiB, WS_WOUT = 46 * MiB, WS_WCQ = 48 * MiB, WS_WCO = 50 * MiB, WS_WGU = 52 * MiB, WS_WDN = 63 * MiB;
constexpr size_t WS_XB = 69 * MiB, WS_MNB = 102 * MiB, WS_KB = 106 * MiB, WS_VT = 110 * MiB;
constexpr size_t SLOT = 33 * MiB, SLOT_ELEMS = (size_t)T * 1024;
constexpr size_t WS_PROJ = 114 * MiB;
constexpr size_t WS_YG = WS_PROJ + 11 * SLOT, WS_ON = WS_YG + 2 * SLOT, WS_END = WS_ON + SLOT;
static_assert(SLOT == SLOT_ELEMS * 2, "slot size");
static_assert(WS_WIN + (size_t)NPROJ * 1024 * 2 <= WS_WKV && WS_WGU + (size_t)2 * FFN * 1024 * 2 <= WS_WDN && WS_WDN + (size_t)1024 * FFN * 2 <= WS_XB && WS_SSQP3 + (size_t)T * 64 <= WS_WIN, "d_ws map");
static_assert(WS_DT + (size_t)T * 128 <= WS_SSQSSD && WS_SSQSSD + (size_t)T * 128 <= WS_SSQP1 && WS_SSQP1 + (size_t)T * 64 <= WS_SSQP2 && WS_SSQP2 + (size_t)T * 64 <= WS_SSQP3, "d_ws map 2");
enum { S_Z0 = 0, S_Z1 = 1, S_X0 = 2, S_X1 = 3, S_X2 = 4, S_Q = 5, S_F = 6, S_I = 7, S_HG = 8, S_GS = 9, S_GH = 10 };
constexpr size_t WS_MERGED = WS_PROJ + S_Q * SLOT, WS_HB = WS_PROJ + S_F * SLOT, WS_QB = WS_PROJ + S_I * SLOT, WS_OB = WS_PROJ + S_HG * SLOT, WS_ACT = WS_PROJ;
static_assert((size_t)T * FFN * 2 <= 3 * SLOT, "act overlay");
constexpr size_t O_Y = 0, O_SSMP = (size_t)T * 1024, O_CONVP = O_SSMP + 2097152, O_HGP = O_CONVP + 73728, O_MKP = O_HGP + 1048576, O_MVP = O_MKP + 2097152,
                 O_SSMS = O_MVP + 2097152, O_CONVS = O_SSMS + 33554432, O_HGS = O_CONVS + 1179648, O_END = O_HGS + 16777216;
constexpr int CW_QUEUE = 64;
constexpr int CW_BAR = 4096;
constexpr int RING_OFF = 0, RING_BYTES = 131072;
constexpr int LDSCTL_OFF = RING_BYTES, MISC_OFF = LDSCTL_OFF + 320;
constexpr int LDS_BYTES = 147456;
struct Frame {
    LAS unsigned char* lds;
    volatile LAS unsigned* MISC;
    gu32* ctl;
    int tid, lane, wave;
    int vcu, G;
    const float* in[32];
    float* out; unsigned char* ws;
};
__device__ __forceinline__ float bf2f(unsigned v16) { return __uint_as_float(v16 << 16); }
__device__ __forceinline__ float sigmoid_f(float x) { return 1.0f / (1.0f + __expf(-x)); }
__device__ __forceinline__ float silu_f(float x) { return x * sigmoid_f(x); }
__device__ __forceinline__ float wave_sum(float v) {
#pragma unroll
    for (int o = 1; o < 64; o <<= 1) v += __shfl_xor(v, o);
    return v;
}
__device__ __forceinline__ float wave_max(float v) {
#pragma unroll
    for (int o = 1; o < 64; o <<= 1) v = fmaxf(v, __shfl_xor(v, o));
    return v;
}
struct TSrc { const float* W; const float* W2; const float* ks; int ldw; int mode; };
__device__ __forceinline__ float tsrc_elem(const TSrc& s, int k, int n) {
    float v;
    if (s.mode == 0) v = s.W[(size_t)k * s.ldw + n];
    else if (s.mode == 1) { if (n < 5120) v = s.W[(size_t)k * s.ldw + n]; else if (n < 11264) v = s.W[(size_t)k * s.ldw + n + 32]; else if (n < 11296) v = s.W[(size_t)k * s.ldw + 5120 + (n - 11264)]; else v = 0.f; }
    else if (s.mode == 2) v = (n & 1) ? s.W2[(size_t)k * s.ldw + (n >> 1)] : s.W[(size_t)k * s.ldw + (n >> 1)];
    else v = (n < 1024) ? s.W[(size_t)k * s.ldw + n] : s.W2[(size_t)k * s.ldw + (n - 1024)];
    return s.ks ? v * s.ks[k] : v;
}
__device__ __forceinline__ void p0_transpose_item(const TSrc& s, int K, int N, bf16* WT, LAS float* scr, int item, int lane) {
    const int nblk = N / 32, kb = item / nblk, nb = item % nblk, k0 = 64 * kb, n0 = 32 * nb;
#pragma unroll 8
    for (int i = 0; i < 32; ++i) { const int kk = 2 * i + (lane >> 5); scr[kk * 33 + (lane & 31)] = tsrc_elem(s, k0 + kk, n0 + (lane & 31)); }
    LDS_WAIT(); asm volatile("" ::: "memory");
    const int c = lane & 7;
#pragma unroll
    for (int j = 0; j < 4; ++j) { const int n = (lane >> 3) + 8 * j; const LAS float* p = scr + (8 * c) * 33 + n;
        v4u o; o.x = pk2(p[0 * 33], p[1 * 33]); o.y = pk2(p[2 * 33], p[3 * 33]); o.z = pk2(p[4 * 33], p[5 * 33]); o.w = pk2(p[6 * 33], p[7 * 33]);
        *(v4u*)(WT + (size_t)(n0 + n) * K + k0 + 8 * c) = o; }
    LDS_WAIT(); asm volatile("" ::: "memory");
}
__device__ __forceinline__ void row_to_bf16_ssq(const float* xrow, bf16* orow, float* ssq, int lane) {
    const f32x4* xr = (const f32x4*)xrow + lane; f32x4 v[4]; float s = 0.f;
#pragma unroll
    for (int j = 0; j < 4; ++j) { v[j] = xr[64 * j]; s += (v[j].x * v[j].x + v[j].y * v[j].y) + (v[j].z * v[j].z + v[j].w * v[j].w); }
    s = wave_sum(s);
    unsigned long long* o8 = (unsigned long long*)orow + lane;
#pragma unroll
    for (int j = 0; j < 4; ++j) o8[64 * j] = (unsigned long long)pk2(v[j].x, v[j].y) | ((unsigned long long)pk2(v[j].z, v[j].w) << 32);
    if (lane == 0) *ssq = s;
}
__device__ __forceinline__ void p0_prologue(Frame& F) {
    LAS float* scr = (LAS float*)(F.lds + RING_OFF + F.wave * 16384);
    const int gw = F.vcu * NWAVES + F.wave, NGW = F.G * NWAVES;
    unsigned char* ws = F.ws;
    constexpr int I_IN = 16 * (NPROJ / 32), I_KV = 16 * 64, I_SSD = 32 * 32, I_SQ = 16 * 32, I_GU = 16 * (2 * FFN / 32), I_DN = (FFN / 64) * 32;
    constexpr int NITEMS = I_IN + I_KV + I_SSD + 4 * I_SQ + I_GU + I_DN;
    for (int it = gw; it < NITEMS; it += NGW) {
        int r = it;
        if (r < I_IN) { TSrc s{F.in[9], nullptr, F.in[8], 11296, 1}; p0_transpose_item(s, 1024, NPROJ, (bf16*)(ws + WS_WIN), scr, r, F.lane); continue; } r -= I_IN;
        if (r < I_KV) { TSrc s{F.in[24], F.in[25], F.in[22], 1024, 3}; p0_transpose_item(s, 1024, 2048, (bf16*)(ws + WS_WKV), scr, r, F.lane); continue; } r -= I_KV;
        if (r < I_SSD) { TSrc s{F.in[16], nullptr, F.in[15], 1024, 0}; p0_transpose_item(s, 2048, 1024, (bf16*)(ws + WS_WSSD), scr, r, F.lane); continue; } r -= I_SSD;
        if (r < I_SQ) { TSrc s{F.in[19], nullptr, F.in[18], 1024, 0}; p0_transpose_item(s, 1024, 1024, (bf16*)(ws + WS_WHG), scr, r, F.lane); continue; } r -= I_SQ;
        if (r < I_SQ) { TSrc s{F.in[20], nullptr, nullptr, 1024, 0}; p0_transpose_item(s, 1024, 1024, (bf16*)(ws + WS_WOUT), scr, r, F.lane); continue; } r -= I_SQ;
        if (r < I_SQ) { TSrc s{F.in[23], nullptr, F.in[21], 1024, 0}; p0_transpose_item(s, 1024, 1024, (bf16*)(ws + WS_WCQ), scr, r, F.lane); continue; } r -= I_SQ;
        if (r < I_SQ) { TSrc s{F.in[26], nullptr, nullptr, 1024, 0}; p0_transpose_item(s, 1024, 1024, (bf16*)(ws + WS_WCO), scr, r, F.lane); continue; } r -= I_SQ;
        if (r < I_GU) { TSrc s{F.in[28], F.in[29], F.in[27], FFN, 2}; p0_transpose_item(s, 1024, 2 * FFN, (bf16*)(ws + WS_WGU), scr, r, F.lane); continue; } r -= I_GU;
        { TSrc s{F.in[30], nullptr, nullptr, 1024, 0}; p0_transpose_item(s, FFN, 1024, (bf16*)(ws + WS_WDN), scr, r, F.lane); }
    }
    bf16* XB = (bf16*)(ws + WS_XB); float* SSQX = (float*)(ws + WS_SSQX);
    for (int m = gw; m < T; m += NGW) { const float* src = m < TP ? F.in[0] + (size_t)m * DM : F.in[1] + (size_t)(m - TP) * DM; row_to_bf16_ssq(src, XB + (size_t)m * DM, SSQX + m, F.lane); }
    bf16* MNB = (bf16*)(ws + WS_MNB); float* SSQM = (float*)(ws + WS_SSQM);
    for (int m = gw; m < MEMR; m += NGW) row_to_bf16_ssq(F.in[2] + (size_t)m * DM, MNB + (size_t)m * DM, SSQM + m, F.lane);
}
__device__ __forceinline__ void ssd_unit(Frame& F, int gb, int h) {
    const int tid = F.tid; unsigned char* ws = F.ws;
    const bool prompt = gb < NBP; const int L = prompt ? SEQ : LS; const int sb = gb - NBP; const size_t row_base = prompt ? (size_t)gb * SEQ : (size_t)TP + (size_t)sb * LS;
    const int g = h >> 3;
    LAS float* xs = (LAS float*)(F.lds + RING_OFF);
    LAS float* Bs = xs + 64 * 64;
    LAS float* Cs = Bs + 64 * 128;
    LAS float* ys = Cs + 64 * 128;
    LAS float* dts = ys + 64 * 64;
    LAS float* das = dts + 64;
    const bf16* PROJ = (const bf16*)(ws + WS_PROJ); const float* DTR = (const float*)(ws + WS_DT);
    bf16* YG = (bf16*)(ws + WS_YG); float* SSQ = (float*)(ws + WS_SSQSSD);
    const int p = tid >> 3, n0 = (tid & 7) * 16;
    float hs[16];
    float* state_out = prompt ? F.out + O_SSMP + ((size_t)(gb * 32 + h) * 64 + p) * 128 + n0 : F.out + O_SSMS + ((size_t)(sb * 32 + h) * 64 + p) * 128 + n0;
    if (prompt) {
#pragma unroll
        for (int i = 0; i < 16; ++i) hs[i] = 0.f;
    } else { const float* sp = F.in[3] + ((size_t)(sb * 32 + h) * 64 + p) * 128 + n0;
#pragma unroll
        for (int i = 0; i < 4; ++i) { const f32x4 v = *(const f32x4*)(sp + 4 * i); hs[4 * i] = v.x; hs[4 * i + 1] = v.y; hs[4 * i + 2] = v.z; hs[4 * i + 3] = v.w; } }
    const float a = -__expf(F.in[13][h]), dtb = F.in[12][h], Dk = F.in[14][h];
    int col = 0; LAS float* dst = xs; int dstride = 64;
    if (tid < 64) { col = h * 64 + tid; dst = xs + tid; dstride = 64; }
    else if (tid < 192) { col = 2048 + g * 128 + (tid - 64); dst = Bs + (tid - 64); dstride = 128; }
    else if (tid < 320) { col = 2560 + g * 128 + (tid - 192); dst = Cs + (tid - 192); dstride = 128; }
    float w0 = 0.f, w1 = 0.f, w2 = 0.f, w3 = 0.f, cb = 0.f, r0 = 0.f, r1 = 0.f, r2 = 0.f; const bf16* cptr = PROJ;
    if (tid < 320) { const float* cw = F.in[10]; w0 = cw[col]; w1 = cw[3072 + col]; w2 = cw[2 * 3072 + col]; w3 = cw[3 * 3072 + col]; cb = F.in[11][col];
        cptr = PROJ + (size_t)(S_X0 + (col >> 10)) * SLOT_ELEMS + row_base * 1024 + (col & 1023);
        if (!prompt) { const float* sc = F.in[4] + (size_t)sb * 3 * 3072 + col; r0 = sc[0]; r1 = sc[3072]; r2 = sc[2 * 3072]; } }
    for (int t0 = 0; t0 < L; t0 += 64) {
        const int nt = (L - t0) < 64 ? (L - t0) : 64;
        if (tid < 320) {
            for (int tt = 0; tt < nt; ++tt) { const float raw = bf2f(cptr[(size_t)(t0 + tt) * 1024]); float v = w0 * r0 + w1 * r1 + w2 * r2 + w3 * raw + cb; v = silu_f(v); dst[tt * dstride] = v; r0 = r1; r1 = r2; r2 = raw; }
        } else if (tid < 384) { const int tt = tid - 320;
            if (tt < nt) { const float x = DTR[(row_base + t0 + tt) * 32 + h] + dtb; const float dtv = x > 20.f ? x : log1pf(__expf(x)); dts[tt] = dtv; das[tt] = __expf(dtv * a); } }
        __syncthreads();
        for (int tt = 0; tt < nt; ++tt) {
            const float xv = xs[tt * 64 + p], dtv = dts[tt], dA = das[tt], xd = xv * dtv; float part = 0.f;
#pragma unroll
            for (int i = 0; i < 4; ++i) { const f32x4 bv = *(const LAS f32x4*)(Bs + tt * 128 + n0 + 4 * i), cv = *(const LAS f32x4*)(Cs + tt * 128 + n0 + 4 * i);
                hs[4 * i] = dA * hs[4 * i] + xd * bv.x; hs[4 * i + 1] = dA * hs[4 * i + 1] + xd * bv.y; hs[4 * i + 2] = dA * hs[4 * i + 2] + xd * bv.z; hs[4 * i + 3] = dA * hs[4 * i + 3] + xd * bv.w;
                part += (hs[4 * i] * cv.x + hs[4 * i + 1] * cv.y) + (hs[4 * i + 2] * cv.z + hs[4 * i + 3] * cv.w); }
            part += __shfl_xor(part, 1); part += __shfl_xor(part, 2); part += __shfl_xor(part, 4);
            if ((tid & 7) == 0) ys[tt * 64 + p] = part;
        }
        __syncthreads();
        { const int tt = tid >> 3, p0 = (tid & 7) * 8;
          if (tt < nt) { const size_t row = row_base + t0 + tt;
            const v4u zw = *(const v4u*)(PROJ + (size_t)(S_Z0 + (h >> 4)) * SLOT_ELEMS + row * 1024 + (h & 15) * 64 + p0);
            float o[8]; float sq = 0.f;
#pragma unroll
            for (int j = 0; j < 8; ++j) { const unsigned z16 = (zw[j >> 1] >> ((j & 1) * 16)) & 0xffffu; const float yv = (ys[tt * 64 + p0 + j] + xs[tt * 64 + p0 + j] * Dk) * silu_f(bf2f(z16)); o[j] = yv; sq += yv * yv; }
            v4u ow; ow.x = pk2(o[0], o[1]); ow.y = pk2(o[2], o[3]); ow.z = pk2(o[4], o[5]); ow.w = pk2(o[6], o[7]);
            *(v4u*)(YG + row * 2048 + h * 64 + p0) = ow;
            sq += __shfl_xor(sq, 1); sq += __shfl_xor(sq, 2); sq += __shfl_xor(sq, 4);
            if ((tid & 7) == 0) SSQ[row * 32 + h] = sq; } }
        __syncthreads();
    }
#pragma unroll
    for (int i = 0; i < 4; ++i) *(f32x4*)(state_out + 4 * i) = (f32x4){hs[4 * i], hs[4 * i + 1], hs[4 * i + 2], hs[4 * i + 3]};
}
__device__ __forceinline__ void hgrn_unit(Frame& F, int gb, int hd) {
    const int tid = F.tid; unsigned char* ws = F.ws;
    const bool prompt = gb < NBP; const int L = prompt ? SEQ : LS; const int sb = gb - NBP; const size_t row_base = prompt ? (size_t)gb * SEQ : (size_t)TP + (size_t)sb * LS;
    LAS float* qs = (LAS float*)(F.lds + RING_OFF);
    LAS float* fs = qs + 32 * 128; LAS float* ks = fs + 32 * 128; LAS float* vs = ks + 32 * 128; LAS float* os = vs + 32 * 128;
    const bf16* PROJ = (const bf16*)(ws + WS_PROJ); bf16* ON = (bf16*)(ws + WS_ON);
    const int v = tid >> 2, k0 = (tid & 3) * 32;
    float S[32];
    float* state_out = prompt ? F.out + O_HGP + ((size_t)(gb * 8 + hd) * 128 + k0) * 128 + v : F.out + O_HGS + ((size_t)(sb * 8 + hd) * 128 + k0) * 128 + v;
    if (prompt) {
#pragma unroll
        for (int i = 0; i < 32; ++i) S[i] = 0.f;
    } else { const float* sp = F.in[5] + ((size_t)(sb * 8 + hd) * 128 + k0) * 128 + v;
#pragma unroll
        for (int i = 0; i < 32; ++i) S[i] = sp[(size_t)i * 128]; }
    const int c = tid & 127, part = tid >> 7; const int ch = hd * 128 + c;
    float lb = 0.f; if (part == 1) lb = 1.0f / (1.0f + __expf(F.in[17][1024 + ch] - F.in[17][ch]));
    const bf16* sptr = PROJ + (size_t)(part == 0 ? S_Q : (part == 1 ? S_F : S_I)) * SLOT_ELEMS + row_base * 1024 + ch;
    for (int t0 = 0; t0 < L; t0 += 32) {
        const int nt = (L - t0) < 32 ? (L - t0) : 32;
        if (part < 3) {
            for (int tt = 0; tt < nt; ++tt) { const float raw = bf2f(sptr[(size_t)(t0 + tt) * 1024]);
                if (part == 0) qs[tt * 128 + c] = silu_f(raw);
                else if (part == 1) { const float e = __expf(-raw); const float sg = 1.0f / (1.0f + e); fs[tt * 128 + c] = lb + (1.0f - lb) * sg; ks[tt * 128 + c] = (1.0f - lb) * (e / (1.0f + e)); }
                else vs[tt * 128 + c] = raw; }
        }
        __syncthreads();
        for (int tt = 0; tt < nt; ++tt) {
            const float vv = vs[tt * 128 + v]; float acc = 0.f;
#pragma unroll
            for (int i = 0; i < 8; ++i) { const f32x4 fv = *(const LAS f32x4*)(fs + tt * 128 + k0 + 4 * i), kv = *(const LAS f32x4*)(ks + tt * 128 + k0 + 4 * i), qv = *(const LAS f32x4*)(qs + tt * 128 + k0 + 4 * i);
                S[4 * i] = fv.x * S[4 * i] + kv.x * vv; S[4 * i + 1] = fv.y * S[4 * i + 1] + kv.y * vv; S[4 * i + 2] = fv.z * S[4 * i + 2] + kv.z * vv; S[4 * i + 3] = fv.w * S[4 * i + 3] + kv.w * vv;
                acc += (S[4 * i] * qv.x + S[4 * i + 1] * qv.y) + (S[4 * i + 2] * qv.z + S[4 * i + 3] * qv.w); }
            acc += __shfl_xor(acc, 1); acc += __shfl_xor(acc, 2);
            if ((tid & 3) == 0) os[tt * 128 + v] = acc;
        }
        __syncthreads();
        { const int tt = tid >> 4, v0 = (tid & 15) * 8;
          if (tt < nt) { const size_t row = row_base + t0 + tt; float o[8]; float sq = 0.f;
#pragma unroll
            for (int j = 0; j < 8; ++j) { o[j] = os[tt * 128 + v0 + j]; sq += o[j] * o[j]; }
            sq += __shfl_xor(sq, 1); sq += __shfl_xor(sq, 2); sq += __shfl_xor(sq, 4); sq += __shfl_xor(sq, 8);
            const float rs = 1.0f / sqrtf(sq * (1.0f / 128.0f) + EPS);
            const v4u gw = *(const v4u*)(PROJ + (size_t)S_HG * SLOT_ELEMS + row * 1024 + hd * 128 + v0);
#pragma unroll
            for (int j = 0; j < 8; ++j) { const unsigned g16 = (gw[j >> 1] >> ((j & 1) * 16)) & 0xffffu; o[j] = o[j] * rs * silu_f(bf2f(g16)); }
            v4u ow; ow.x = pk2(o[0], o[1]); ow.y = pk2(o[2], o[3]); ow.z = pk2(o[4], o[5]); ow.w = pk2(o[6], o[7]);
            *(v4u*)(ON + row * 1024 + hd * 128 + v0) = ow; } }
        __syncthreads();
    }
#pragma unroll
    for (int i = 0; i < 32; ++i) state_out[(size_t)i * 128] = S[i];
}
__device__ __forceinline__ void conv_copy_unit(Frame& F, int gb) {
    const bf16* PROJ = (const bf16*)(F.ws + WS_PROJ);
    const bool prompt = gb < NBP; const int sb = gb - NBP;
    const size_t row0 = prompt ? (size_t)gb * SEQ + (SEQ - 3) : (size_t)TP + (size_t)sb * LS + 1;
    float* dst = prompt ? F.out + O_CONVP + (size_t)gb * 3 * 3072 : F.out + O_CONVS + (size_t)sb * 3 * 3072;
    for (int e = F.tid; e < 3 * 3072; e += NTHR) { const int j = e / 3072, col = e % 3072;
        dst[e] = bf2f(PROJ[(size_t)(S_X0 + (col >> 10)) * SLOT_ELEMS + (row0 + j) * 1024 + (col & 1023)]); }
}
constexpr int U_HGP = NBP * 8, U_SSDP = NBP * 32, U_HGS = NBS * 8, U_SSDS = NBS * 32, U_CONV = NBP + NBS;
constexpr int U_TOTAL = U_HGP + U_SSDP + U_HGS + U_SSDS + U_CONV;
__device__ __forceinline__ void scan_phase(Frame& F) {
    gu32* head = F.ctl + CW_QUEUE;
    for (;;) {
        if (F.tid == 0) F.MISC[0] = __hip_atomic_fetch_add(head, 1u, RLX_AGENT);
        __syncthreads();
        int u = (int)F.MISC[0];
        __syncthreads();
        if (u >= U_TOTAL) break;
        if (u < U_HGP) { hgrn_unit(F, u >> 3, u & 7); continue; } u -= U_HGP;
        if (u < U_SSDP) { ssd_unit(F, u >> 5, u & 31); continue; } u -= U_SSDP;
        if (u < U_HGS) { hgrn_unit(F, NBP + (u >> 3), u & 7); continue; } u -= U_HGS;
        if (u < U_SSDS) { ssd_unit(F, NBP + (u >> 5), u & 31); continue; } u -= U_SSDS;
        conv_copy_unit(F, u);
    }
}
__device__ __forceinline__ void ssdnorm_phase(Frame& F) {
    const int gw = F.vcu * NWAVES + F.wave, NGW = F.G * NWAVES; bf16* YG = (bf16*)(F.ws + WS_YG); const float* SSQ = (const float*)(F.ws + WS_SSQSSD);
    for (int row = gw; row < T; row += NGW) {
        const f32x4* sp = (const f32x4*)(SSQ + (size_t)row * 32);
#pragma unroll
        for (int j = 0; j < 4; ++j) { const f32x4 a = sp[2 * j], b = sp[2 * j + 1]; const float s = ((a.x + a.y) + (a.z + a.w)) + ((b.x + b.y) + (b.z + b.w)); const float rs = 1.0f / sqrtf(s * (1.0f / 512.0f) + EPS);
            v4u* p = (v4u*)(YG + (size_t)row * 2048) + j * 64 + F.lane; const v4u w = *p; v4u o;
#pragma unroll
            for (int e = 0; e < 4; ++e) o[e] = pk2(bf2f(w[e] & 0xffffu) * rs, bf2f(w[e] >> 16) * rs);
            *p = o; }
    }
}
__device__ __forceinline__ void attn_prompt_wave(Frame& F, int rt, int hd) {
    typedef float f32x4v __attribute__((ext_vector_type(4)));
    const int lane = F.lane, fr = lane & 15, fq = lane >> 4; unsigned char* ws = F.ws;
    const int r0 = rt * 16, b = r0 / SEQ;
    const bf16* QB = (const bf16*)(ws + WS_QB); const bf16* KB = (const bf16*)(ws + WS_KB); const bf16* VT = (const bf16*)(ws + WS_VT); bf16* OB = (bf16*)(ws + WS_OB);
    bf16x8 qf[8];
    const bf16* qp = QB + (size_t)(r0 + fr) * 1024 + hd * 256 + 8 * fq;
#pragma unroll
    for (int s = 0; s < 8; ++s) qf[s] = *(const bf16x8*)(qp + 32 * s);
    f32x4v st[16];
    const bf16* kp = KB + (size_t)(b * 256 + fr) * 1024 + hd * 256 + 8 * fq;
#pragma unroll
    for (int tk = 0; tk < 16; ++tk) { f32x4v acc = (f32x4v){0.f, 0.f, 0.f, 0.f};
#pragma unroll
        for (int s = 0; s < 8; ++s) { const bf16x8 kf = *(const bf16x8*)(kp + (size_t)tk * 16 * 1024 + 32 * s); acc = __builtin_amdgcn_mfma_f32_16x16x32_bf16(kf, qf[s], acc, 0, 0, 0); }
        st[tk] = acc; }
    float m = -3.0e38f;
#pragma unroll
    for (int tk = 0; tk < 16; ++tk) m = fmaxf(fmaxf(m, fmaxf(st[tk][0], st[tk][1])), fmaxf(st[tk][2], st[tk][3]));
    m = fmaxf(m, __shfl_xor(m, 16)); m = fmaxf(m, __shfl_xor(m, 32));
    float l = 0.f;
#pragma unroll
    for (int tk = 0; tk < 16; ++tk) {
#pragma unroll
        for (int r = 0; r < 4; ++r) { const float pv = __builtin_amdgcn_exp2f(st[tk][r] - m); st[tk][r] = pv; l += pv; } }
    l += __shfl_xor(l, 16); l += __shfl_xor(l, 32);
    const float rl = 1.0f / l;
    bf16x8 pf[8];
#pragma unroll
    for (int s = 0; s < 8; ++s) { v4u w; w.x = pk2(st[2 * s][0], st[2 * s][1]); w.y = pk2(st[2 * s][2], st[2 * s][3]); w.z = pk2(st[2 * s + 1][0], st[2 * s + 1][1]); w.w = pk2(st[2 * s + 1][2], st[2 * s + 1][3]);
        pf[s] = __builtin_bit_cast(bf16x8, w); }
    const bf16* vp = VT + ((size_t)((b * 4 + hd) * 256 + fr)) * 256 + 4 * fq;
    bf16* op = OB + (size_t)(r0 + fr) * 1024 + hd * 256 + 4 * fq;
#pragma unroll 2
    for (int dt = 0; dt < 16; ++dt) { f32x4v acc = (f32x4v){0.f, 0.f, 0.f, 0.f};
#pragma unroll
        for (int s = 0; s < 8; ++s) { const v2u lo = *(const v2u*)(vp + (size_t)dt * 16 * 256 + 32 * s), hi = *(const v2u*)(vp + (size_t)dt * 16 * 256 + 32 * s + 16);
            const v4u w = (v4u){lo.x, lo.y, hi.x, hi.y}; acc = __builtin_amdgcn_mfma_f32_16x16x32_bf16(__builtin_bit_cast(bf16x8, w), pf[s], acc, 0, 0, 0); }
        v2u o; o.x = pk2(acc[0] * rl, acc[1] * rl); o.y = pk2(acc[2] * rl, acc[3] * rl); *(v2u*)(op + dt * 16) = o; }
}
__device__ __forceinline__ void attn_sample_unit(Frame& F, int sb, int hd) {
    const int tid = F.tid, lane = F.lane, w = F.wave; unsigned char* ws = F.ws;
    LAS float* sc = (LAS float*)(F.lds + RING_OFF);
    LAS float* red = sc + 4 * 256;
    const bf16* QB = (const bf16*)(ws + WS_QB); bf16* OB = (bf16*)(ws + WS_OB);
    const size_t rowq = (size_t)TP + (size_t)sb * LS;
    float q[4][4];
#pragma unroll
    for (int t = 0; t < 4; ++t) { const v2u qw = *(const v2u*)(QB + (rowq + t) * 1024 + hd * 256 + 4 * lane); q[t][0] = bf2f(qw.x & 0xffffu); q[t][1] = bf2f(qw.x >> 16); q[t][2] = bf2f(qw.y & 0xffffu); q[t][3] = bf2f(qw.y >> 16); }
    const float* Kc = F.in[6] + ((size_t)sb * 256 * 4 + hd) * 256 + 4 * lane; const float* Vc = F.in[7] + ((size_t)sb * 256 * 4 + hd) * 256 + 4 * lane;
    for (int kk = 0; kk < 32; ++kk) { const int key = w * 32 + kk; const f32x4 kv = *(const f32x4*)(Kc + (size_t)key * 1024);
#pragma unroll
        for (int t = 0; t < 4; ++t) { float s = (q[t][0] * kv.x + q[t][1] * kv.y) + (q[t][2] * kv.z + q[t][3] * kv.w); s = wave_sum(s); if (lane == 0) sc[t * 256 + key] = s; } }
    __syncthreads();
    if (w < 4) { float v[4]; float m = -3.0e38f;
#pragma unroll
        for (int j = 0; j < 4; ++j) { v[j] = sc[w * 256 + j * 64 + lane]; m = fmaxf(m, v[j]); }
        m = wave_max(m); float l = 0.f;
#pragma unroll
        for (int j = 0; j < 4; ++j) { v[j] = __builtin_amdgcn_exp2f(v[j] - m); l += v[j]; }
        l = wave_sum(l); const float rl = 1.0f / l;
#pragma unroll
        for (int j = 0; j < 4; ++j) sc[w * 256 + j * 64 + lane] = v[j] * rl; }
    __syncthreads();
    float o[4][4];
#pragma unroll
    for (int t = 0; t < 4; ++t)
#pragma unroll
        for (int e = 0; e < 4; ++e) o[t][e] = 0.f;
    for (int kk = 0; kk < 32; ++kk) { const int key = w * 32 + kk; const f32x4 vv = *(const f32x4*)(Vc + (size_t)key * 1024);
#pragma unroll
        for (int t = 0; t < 4; ++t) { const float pr = sc[t * 256 + key]; o[t][0] += pr * vv.x; o[t][1] += pr * vv.y; o[t][2] += pr * vv.z; o[t][3] += pr * vv.w; } }
#pragma unroll
    for (int t = 0; t < 4; ++t) *(LAS f32x4*)(red + (w * 4 + t) * 256 + 4 * lane) = (f32x4){o[t][0], o[t][1], o[t][2], o[t][3]};
    __syncthreads();
    { const int t = tid >> 7, d0 = (tid & 127) * 2; float a0 = 0.f, a1 = 0.f;
#pragma unroll
      for (int ww = 0; ww < 8; ++ww) { a0 += red[(ww * 4 + t) * 256 + d0]; a1 += red[(ww * 4 + t) * 256 + d0 + 1]; }
      *(unsigned*)(OB + (rowq + t) * 1024 + hd * 256 + d0) = pk2(a0, a1); }
    __syncthreads();
}
__device__ __forceinline__ void attn_phase(Frame& F) {
    const int gw = F.vcu * NWAVES + F.wave, NGW = F.G * NWAVES;
    for (int it = gw; it < (TP / 16) * 4; it += NGW) attn_prompt_wave(F, it >> 2, it & 3);
    for (int u = F.vcu; u < NBS * 4; u += F.G) attn_sample_unit(F, u >> 2, u & 3);
}
__device__ __forceinline__ void final_norm_phase(Frame& F) {
    const int gw = F.vcu * NWAVES + F.wave, NGW = F.G * NWAVES; const float* SSQ = (const float*)(F.ws + WS_SSQP3); const float* wn = F.in[31];
    f32x4 wv[4];
#pragma unroll
    for (int j = 0; j < 4; ++j) wv[j] = *((const f32x4*)wn + 64 * j + F.lane);
    for (int row = gw; row < T; row += NGW) {
        const f32x4* sp = (const f32x4*)(SSQ + (size_t)row * 16); float s = 0.f;
#pragma unroll
        for (int j = 0; j < 4; ++j) { const f32x4 a = sp[j]; s += (a.x + a.y) + (a.z + a.w); }
        const float rs = 1.0f / sqrtf(s * (1.0f / 1024.0f) + EPS);
        f32x4* p = (f32x4*)(F.out + O_Y + (size_t)row * 1024) + F.lane;
#pragma unroll
        for (int j = 0; j < 4; ++j) { const f32x4 v = p[64 * j]; p[64 * j] = v * rs * wv[j]; }
    }
}
#ifndef MK_N_LAUNCHES
#define MK_N_LAUNCHES 1
#endif
constexpr int PER_PHASE = 13;
constexpr int N_LAUNCHES = MK_N_LAUNCHES;
struct Args { const float* in[32]; float* out; unsigned char* ws; int ph_lo, ph_hi; };
__global__ void __launch_bounds__(NTHR, 2) skel_fwd(Args args) {
    extern __shared__ __attribute__((aligned(16))) unsigned char lds[];
    Frame F;
    F.lds = (LAS unsigned char*)lds;
    F.MISC = (volatile LAS unsigned*)(F.lds + MISC_OFF);
    F.tid = threadIdx.x; F.lane = F.tid & 63; F.wave = __builtin_amdgcn_readfirstlane(F.tid >> 6);
    F.G = gridDim.x; { const int bx = blockIdx.x; F.vcu = (F.G % 8 == 0) ? (bx % 8) * (F.G / 8) + bx / 8 : bx; }
    unsigned char* ws = args.ws; F.ws = ws; F.out = args.out;
    F.ctl = (gu32*)(ws + WS_CTL);
#pragma unroll
    for (int i = 0; i < 32; ++i) F.in[i] = args.in[i];
    for (int u = F.tid; u < (LDS_BYTES - LDSCTL_OFF) / 4; u += NTHR) ((LAS unsigned*)(F.lds + LDSCTL_OFF))[u] = 0u;
    __syncthreads();
    XcdBarrier bar; bar.bar = (unsigned*)(F.ctl + CW_BAR); bar.x = 0; bar.st = nullptr;
    if (N_LAUNCHES == 1) bar = xcd_barrier_post((unsigned*)(F.ctl + CW_BAR), F.MISC + 8);
#define GRID_BAR() do { if (N_LAUNCHES == 1) xcd_barrier(bar); } while (0)
    const int lo = args.ph_lo, hi = args.ph_hi;
#define IN(k) (lo <= (k) && (k) < hi)
#define BOTH(k) (IN(k) && IN((k) + 1))
    bf16* const XB = (bf16*)(ws + WS_XB); bf16* const PROJ = (bf16*)(ws + WS_PROJ);
    float* const Y = F.out + O_Y;
    if (IN(0)) { p0_prologue(F); if (BOTH(0)) GRID_BAR(); }
    if (IN(1)) {
        { pg8::Gemm g{XB, (const bf16*)(ws + WS_WIN), T, NPROJ, 1024}; pg8::StaticOrder S; S.init(T, NPROJ, F.G, (int)blockIdx.x);
          pg8::EpiScaleBf16<1, true> E{PROJ, SLOT_ELEMS, (const float*)(ws + WS_SSQX), 1.0f, (float*)(ws + WS_DT)};
          pg8::gemm_phase<pg8::EpiScaleBf16<1, true>, pg8::StaticOrder, true, true>(F.lds + RING_OFF, g, S, E); }
        { pg8::Gemm g{(const bf16*)(ws + WS_MNB), (const bf16*)(ws + WS_WKV), MEMR, 2048, 1024}; pg8::StaticOrder S; S.init(MEMR, 2048, F.G, (int)((blockIdx.x + 64) % F.G));
          pg8::EpiKV E{F.out + O_MKP, F.out + O_MVP, (bf16*)(ws + WS_KB), (bf16*)(ws + WS_VT), (const float*)(ws + WS_SSQM)};
          pg8::gemm_phase<pg8::EpiKV, pg8::StaticOrder, true, true>(F.lds + RING_OFF, g, S, E); }
        if (BOTH(1)) GRID_BAR();
    }
    if (IN(2)) { scan_phase(F); if (BOTH(2)) GRID_BAR(); }
    if (IN(3)) { ssdnorm_phase(F); if (BOTH(3)) GRID_BAR(); }
    if (IN(4)) { pg8::Gemm g{(const bf16*)(ws + WS_YG), (const bf16*)(ws + WS_WSSD), T, 1024, 2048}; pg8::StaticOrder S; S.init(T, 1024, F.G, (int)blockIdx.x);
        pg8::EpiGate<false> E{(bf16*)(ws + WS_MERGED), PROJ + (size_t)S_GS * SLOT_ELEMS};
        pg8::gemm_phase<pg8::EpiGate<false>, pg8::StaticOrder, true, true>(F.lds + RING_OFF, g, S, E);
        if (BOTH(4)) GRID_BAR(); }
    if (IN(5)) { pg8::Gemm g{(const bf16*)(ws + WS_ON), (const bf16*)(ws + WS_WHG), T, 1024, 1024}; pg8::StaticOrder S; S.init(T, 1024, F.G, (int)blockIdx.x);
        pg8::EpiGate<true> E{(bf16*)(ws + WS_MERGED), PROJ + (size_t)S_GH * SLOT_ELEMS};
        pg8::gemm_phase<pg8::EpiGate<true>, pg8::StaticOrder, true, true>(F.lds + RING_OFF, g, S, E);
        if (BOTH(5)) GRID_BAR(); }
    if (IN(6)) { pg8::Gemm g{(const bf16*)(ws + WS_MERGED), (const bf16*)(ws + WS_WOUT), T, 1024, 1024}; pg8::StaticOrder S; S.init(T, 1024, F.G, (int)blockIdx.x);
        pg8::EpiRes E{F.in[0], F.in[1] - (size_t)TP * 1024, Y, (bf16*)(ws + WS_HB), (float*)(ws + WS_SSQP1)};
        pg8::gemm_phase<pg8::EpiRes, pg8::StaticOrder, true, true>(F.lds + RING_OFF, g, S, E);
        if (BOTH(6)) GRID_BAR(); }
    if (IN(7)) { pg8::Gemm g{(const bf16*)(ws + WS_HB), (const bf16*)(ws + WS_WCQ), T, 1024, 1024}; pg8::StaticOrder S; S.init(T, 1024, F.G, (int)blockIdx.x);
        pg8::EpiScaleBf16<16, false> E{(bf16*)(ws + WS_QB), SLOT_ELEMS, (const float*)(ws + WS_SSQP1), QSCALE, nullptr};
        pg8::gemm_phase<pg8::EpiScaleBf16<16, false>, pg8::StaticOrder, true, true>(F.lds + RING_OFF, g, S, E);
        if (BOTH(7)) GRID_BAR(); }
    if (IN(8)) { attn_phase(F); if (BOTH(8)) GRID_BAR(); }
    if (IN(9)) { pg8::Gemm g{(const bf16*)(ws + WS_OB), (const bf16*)(ws + WS_WCO), T, 1024, 1024}; pg8::StaticOrder S; S.init(T, 1024, F.G, (int)blockIdx.x);
        pg8::EpiRes E{Y, Y, Y, (bf16*)(ws + WS_HB), (float*)(ws + WS_SSQP2)};
        pg8::gemm_phase<pg8::EpiRes, pg8::StaticOrder, true, true>(F.lds + RING_OFF, g, S, E);
        if (BOTH(9)) GRID_BAR(); }
    if (IN(10)) { pg8::Gemm g{(const bf16*)(ws + WS_HB), (const bf16*)(ws + WS_WGU), T, 2 * FFN, 1024}; pg8::StaticOrder S; S.init(T, 2 * FFN, F.G, (int)blockIdx.x);
        pg8::EpiSwiglu E{(bf16*)(ws + WS_ACT), (const float*)(ws + WS_SSQP2)};
        pg8::gemm_phase<pg8::EpiSwiglu, pg8::StaticOrder, true, true>(F.lds + RING_OFF, g, S, E);
        if (BOTH(10)) GRID_BAR(); }
    if (IN(11)) { pg8::Gemm g{(const bf16*)(ws + WS_ACT), (const bf16*)(ws + WS_WDN), T, 1024, FFN}; pg8::StaticOrder S; S.init(T, 1024, F.G, (int)blockIdx.x);
        pg8::EpiRes E{Y, Y, Y, nullptr, (float*)(ws + WS_SSQP3)};
        pg8::gemm_phase<pg8::EpiRes, pg8::StaticOrder, true, true>(F.lds + RING_OFF, g, S, E);
        if (BOTH(11)) GRID_BAR(); }
    if (IN(12)) final_norm_phase(F);
#undef IN
#undef BOTH
}

extern "C" void kernel_launch(void* const* d_in, const int* in_sizes, int n_in, void* d_out, int out_size, void* d_ws, size_t ws_size, hipStream_t stream) {
    static int grid = 0;
    if (grid == 0) {
        const int want[32] = {TP * 1024, TS * 1024, MEMR * 1024, 33554432, 1179648, 16777216, 33554432, 33554432, 1024, 1024 * 11296, 4 * 3072, 3072, 32, 32, 32, 2048, 2048 * 1024, 2048, 1024,
                              1024 * 1024, 1024 * 1024, 1024, 1024, 1024 * 1024, 1024 * 1024, 1024 * 1024, 1024 * 1024, 1024, 1024 * FFN, 1024 * FFN, FFN * 1024, 1024};
        bool ok = (n_in == 32); for (int i = 0; ok && i < 32; ++i) if (in_sizes[i] != want[i]) { fprintf(stderr, "kernel_launch: input %d has %d elements, expected %d\n", i, in_sizes[i], want[i]); ok = false; }
        if (!ok || out_size != (int)O_END || ws_size < WS_END) { fprintf(stderr, "kernel_launch: unexpected shapes: n_in %d out %d ws %zu\n", n_in, out_size, ws_size); grid = -1; return; }
        int dev = 0, cus = 0, per_cu = 0;
        if (hipGetDevice(&dev) != hipSuccess || hipDeviceGetAttribute(&cus, hipDeviceAttributeMultiprocessorCount, dev) != hipSuccess) { grid = -1; return; }
        if (hipFuncSetAttribute((const void*)skel_fwd, hipFuncAttributeMaxDynamicSharedMemorySize, LDS_BYTES) != hipSuccess) { fprintf(stderr, "kernel_launch: hipFuncSetAttribute failed\n"); grid = -1; return; }
        if (hipOccupancyMaxActiveBlocksPerMultiprocessor(&per_cu, (const void*)skel_fwd, NTHR, LDS_BYTES) != hipSuccess || per_cu < 1) fprintf(stderr, "kernel_launch: occupancy query reports %d blocks per CU\n", per_cu);
        (void)hipGetLastError();
        grid = cus;
    }
    if (grid < 0) return;
    (void)hipMemsetAsync((char*)d_ws + WS_CTL, 0, CTL_ZERO_BYTES, stream);
    Args a{};
    for (int i = 0; i < 32; ++i) a.in[i] = (const float*)d_in[i];
    a.out = (float*)d_out; a.ws = (unsigned char*)d_ws;
    for (int li = 0; li < N_LAUNCHES; ++li) {
        a.ph_lo = (N_LAUNCHES == PER_PHASE) ? li : 0; a.ph_hi = (N_LAUNCHES == PER_PHASE) ? li + 1 : PER_PHASE;
        hipLaunchKernelGGL(skel_fwd, dim3(grid), dim3(NTHR), LDS_BYTES, stream, a);
    }
}
```

```cpp
#include <hip/hip_runtime.h>
#include <cstdio>
#include <cstdint>
namespace pg8 {
#define PG8_LAS __attribute__((address_space(3)))
typedef unsigned short bf16_t;
typedef short bf16x8 __attribute__((ext_vector_type(8)));
typedef float f32x4 __attribute__((ext_vector_type(4)));
typedef unsigned u32x4 __attribute__((ext_vector_type(4)));
constexpr int BM = 256, BK = 64, HALF = 128, HTB = HALF * BK * 2  , STAGE_BYTES = 8 * HTB, NXCD = 8, WGM = 8;

__host__ __device__ __forceinline__ int lds_byte(int r, int c) { const int st = (r >> 4) * 2 + (c >> 5), rr = r & 15, cc = c & 31, ob = rr * 64 + cc * 2; return st * 1024 + (ob ^ (((ob >> 9) & 1) << 5)); }
__host__ __device__ __forceinline__ void stage_rc(int b, int& R, int& C) { const int st = b / 1024, sb = b % 1024, swz = sb ^ (((sb >> 9) & 1) << 5); R = (st >> 1) * 16 + swz / 64; C = (st & 1) * 32 + (swz % 64) / 2; }
__host__ __device__ __forceinline__ int perm32(int rho) { const int n = rho >> 4, i = rho & 15; return 8 * (i >> 2) + 4 * n + (i & 3); }

struct Unit { int pm, pn; };
struct Gemm { const bf16_t* A; const bf16_t* Bt; int M, N, K; };

struct StaticOrder {
    int nM, nN, nwg, G, c;
    __host__ __device__ void init(int M, int N, int G_, int c_) { nM = M / BM; nN = N / BM; nwg = nM * nN; G = G_; c = c_; }
    __host__ __device__ bool next(int i, Unit& u) const {
        const long L = (long)i * G + c; if (L >= nwg) return false;
        int wgid = (int)L; { const int q = nwg / NXCD, r = nwg % NXCD, xcd = wgid % NXCD, off = wgid / NXCD; wgid = (xcd < r ? xcd * (q + 1) : r * (q + 1) + (xcd - r) * q) + off; }
        const int nig = WGM * nN, gid = wgid / nig, fm = gid * WGM, gsz = (nM - fm) < WGM ? (nM - fm) : WGM;
        u.pm = fm + ((wgid % nig) % gsz); u.pn = (wgid % nig) / gsz; return true;
    }
    __device__ __forceinline__ void a_ready(const Unit&) const {}
    __device__ __forceinline__ void done(const Unit&) const {}
};

__device__ __forceinline__ unsigned cvt_pk_bf16(float lo, float hi) { unsigned r; asm volatile("v_cvt_pk_bf16_f32 %0, %1, %2" : "=v"(r) : "v"(lo), "v"(hi)); return r; }
typedef float f32x2 __attribute__((ext_vector_type(2)));
typedef unsigned u32x2 __attribute__((ext_vector_type(2)));
constexpr float RMS_EPS = 1e-6f;
__device__ __forceinline__ float bfbits2f(unsigned v16) { return __uint_as_float(v16 << 16); }
__device__ __forceinline__ float sigm(float x) { return __builtin_amdgcn_rcpf(1.0f + __expf(-x)); }
template <int NP> __device__ __forceinline__ float row_rs(const float* ssq, int row) {
    float s = 0.f;
    if constexpr (NP == 1) s = ssq[row];
    else {
#pragma unroll
        for (int i = 0; i < NP / 4; ++i) { const f32x4 v = *(const f32x4*)(ssq + (size_t)row * NP + 4 * i); s += (v[0] + v[1]) + (v[2] + v[3]); }
    }
    return 1.0f / sqrtf(s * (1.0f / 1024.0f) + RMS_EPS);
}
template <int NP, bool HAS_DT> struct EpiScaleBf16 {
    static constexpr bool PERM = true, AFTER_DRAIN = false;
    bf16_t* O; size_t slot_elems; const float* ssq; float scale; float* dt;
    __device__ __forceinline__ void operator()(const f32x4 (&acc)[2][2][4][2], const Unit& u, int wr, int wc, int fr, int fq) const {
        const int row0 = u.pm * BM + wr * 64 + fr;
        if (HAS_DT && u.pn == 44) {
            if (wc == 0) {
#pragma unroll
                for (int ai = 0; ai < 2; ++ai)
#pragma unroll
                    for (int m = 0; m < 4; ++m) { const int row = row0 + ai * HALF + m * 16; const float rs = row_rs<NP>(ssq, row);
                        float* p = dt + (size_t)row * 32 + 8 * fq; *(f32x4*)p = acc[ai][0][m][0] * rs; *(f32x4*)(p + 4) = acc[ai][0][m][1] * rs; }
            }
            return;
        }
        bf16_t* base = O + (size_t)(u.pn >> 2) * slot_elems; const int col0 = (u.pn & 3) * BM + wc * 32 + 8 * fq;
#pragma unroll
        for (int ai = 0; ai < 2; ++ai)
#pragma unroll
            for (int m = 0; m < 4; ++m) { const int row = row0 + ai * HALF + m * 16; const float rs = row_rs<NP>(ssq, row) * scale; bf16_t* rowp = base + (size_t)row * 1024 + col0;
#pragma unroll
                for (int bj = 0; bj < 2; ++bj) { const f32x4 v0 = acc[ai][bj][m][0] * rs, v1 = acc[ai][bj][m][1] * rs;
                    u32x4 w; w.x = cvt_pk_bf16(v0[0], v0[1]); w.y = cvt_pk_bf16(v0[2], v0[3]); w.z = cvt_pk_bf16(v1[0], v1[1]); w.w = cvt_pk_bf16(v1[2], v1[3]);
                    *(u32x4*)(rowp + bj * HALF) = w; } }
    }
};
struct EpiKV {
    static constexpr bool PERM = false, AFTER_DRAIN = false;
    float* mk; float* mv; bf16_t* kb; bf16_t* vt; const float* ssq;
    __device__ __forceinline__ void operator()(const f32x4 (&acc)[2][2][4][2], const Unit& u, int wr, int wc, int fr, int fq) const {
        const int row0 = u.pm * BM + wr * 64 + fr; const bool isv = u.pn >= 4; const int colt = (u.pn & 3) * BM + wc * 32 + 4 * fq;
#pragma unroll
        for (int ai = 0; ai < 2; ++ai)
#pragma unroll
            for (int m = 0; m < 4; ++m) { const int row = row0 + ai * HALF + m * 16; const float rs = row_rs<1>(ssq, row);
#pragma unroll
                for (int bj = 0; bj < 2; ++bj)
#pragma unroll
                    for (int n = 0; n < 2; ++n) { const int c = colt + bj * HALF + n * 16; const f32x4 v = acc[ai][bj][m][n] * rs;
                        if (!isv) { *(f32x4*)(mk + (size_t)row * 1024 + c) = v; u32x2 w; w.x = cvt_pk_bf16(v[0], v[1]); w.y = cvt_pk_bf16(v[2], v[3]); *(u32x2*)(kb + (size_t)row * 1024 + c) = w; }
                        else { *(f32x4*)(mv + (size_t)row * 1024 + c) = v; const int b = row >> 8, key = row & 255, hd = c >> 8, d = c & 255;
                            bf16_t* p = vt + ((size_t)((b * 4 + hd) * 256 + d)) * 256 + key; const unsigned w0 = cvt_pk_bf16(v[0], v[1]), w1 = cvt_pk_bf16(v[2], v[3]);
                            p[0] = (bf16_t)(w0 & 0xffffu); p[256] = (bf16_t)(w0 >> 16); p[512] = (bf16_t)(w1 & 0xffffu); p[768] = (bf16_t)(w1 >> 16); } } }
    }
};
template <bool ADD> struct EpiGate {
    static constexpr bool PERM = true, AFTER_DRAIN = false;
    bf16_t* O; const bf16_t* gate;
    __device__ __forceinline__ void operator()(const f32x4 (&acc)[2][2][4][2], const Unit& u, int wr, int wc, int fr, int fq) const {
        const int row0 = u.pm * BM + wr * 64 + fr, col0 = u.pn * BM + wc * 32 + 8 * fq;
#pragma unroll
        for (int ai = 0; ai < 2; ++ai)
#pragma unroll
            for (int m = 0; m < 4; ++m) { const size_t off = (size_t)(row0 + ai * HALF + m * 16) * 1024 + col0;
#pragma unroll
                for (int bj = 0; bj < 2; ++bj) { const u32x4 gw = *(const u32x4*)(gate + off + bj * HALF); u32x4 ow = (u32x4){0u, 0u, 0u, 0u}; if (ADD) ow = *(const u32x4*)(O + off + bj * HALF);
                    float r[8];
#pragma unroll
                    for (int e = 0; e < 8; ++e) { const unsigned g16 = (gw[e >> 1] >> ((e & 1) * 16)) & 0xffffu, o16 = (ow[e >> 1] >> ((e & 1) * 16)) & 0xffffu;
                        const float a = acc[ai][bj][m][e >> 2][e & 3]; r[e] = (ADD ? bfbits2f(o16) : 0.f) + sigm(bfbits2f(g16)) * a; }
                    u32x4 w; w.x = cvt_pk_bf16(r[0], r[1]); w.y = cvt_pk_bf16(r[2], r[3]); w.z = cvt_pk_bf16(r[4], r[5]); w.w = cvt_pk_bf16(r[6], r[7]);
                    *(u32x4*)(O + off + bj * HALF) = w; } }
    }
};
struct EpiRes {
    static constexpr bool PERM = false, AFTER_DRAIN = false;
    const float* base0; const float* base1; float* out; bf16_t* hb; float* ssqp;
    __device__ __forceinline__ void operator()(const f32x4 (&acc)[2][2][4][2], const Unit& u, int wr, int wc, int fr, int fq) const {
        const int row0 = u.pm * BM + wr * 64 + fr, col0 = u.pn * BM + wc * 32 + 4 * fq; const float* base = u.pm < 64 ? base0 : base1;
#pragma unroll
        for (int ai = 0; ai < 2; ++ai)
#pragma unroll
            for (int m = 0; m < 4; ++m) { const int row = row0 + ai * HALF + m * 16; const size_t off = (size_t)row * 1024 + col0; float sq = 0.f;
#pragma unroll
                for (int bj = 0; bj < 2; ++bj)
#pragma unroll
                    for (int n = 0; n < 2; ++n) { const size_t o2 = off + bj * HALF + n * 16; const f32x4 v = *(const f32x4*)(base + o2) + acc[ai][bj][m][n];
                        *(f32x4*)(out + o2) = v; sq += (v[0] * v[0] + v[1] * v[1]) + (v[2] * v[2] + v[3] * v[3]);
                        if (hb) { u32x2 w; w.x = cvt_pk_bf16(v[0], v[1]); w.y = cvt_pk_bf16(v[2], v[3]); *(u32x2*)(hb + o2) = w; } }
                sq += __shfl_xor(sq, 16); sq += __shfl_xor(sq, 32);
                if (fq == 0) ssqp[(size_t)row * 16 + u.pn * 4 + wc] = sq; }
    }
};
struct EpiSwiglu {
    static constexpr bool PERM = true, AFTER_DRAIN = false;
    bf16_t* act; const float* ssq;
    __device__ __forceinline__ void operator()(const f32x4 (&acc)[2][2][4][2], const Unit& u, int wr, int wc, int fr, int fq) const {
        const int row0 = u.pm * BM + wr * 64 + fr, col0 = u.pn * 128 + wc * 16 + 4 * fq;
#pragma unroll
        for (int ai = 0; ai < 2; ++ai)
#pragma unroll
            for (int m = 0; m < 4; ++m) { const int row = row0 + ai * HALF + m * 16; const float rs = row_rs<16>(ssq, row);
#pragma unroll
                for (int bj = 0; bj < 2; ++bj) { const f32x4 a = acc[ai][bj][m][0] * rs, b = acc[ai][bj][m][1] * rs;
                    const float r0 = a[0] * sigm(a[0]) * a[1], r1 = a[2] * sigm(a[2]) * a[3], r2 = b[0] * sigm(b[0]) * b[1], r3 = b[2] * sigm(b[2]) * b[3];
                    u32x2 w; w.x = cvt_pk_bf16(r0, r1); w.y = cvt_pk_bf16(r2, r3); *(u32x2*)(act + (size_t)row * 2816 + col0 + bj * 64) = w; } }
    }
};
template <class Epi, class Sched, bool ALIGN_EPI = false, bool SP2 = false>
__device__ __forceinline__ void gemm_phase(PG8_LAS unsigned char* lds, const Gemm g, const Sched& S, const Epi& E) {
    const int tid = threadIdx.x, wid = __builtin_amdgcn_readfirstlane(tid >> 6), lane = tid & 63, wr = wid >> 2, wc = wid & 3, fr = lane & 15, fq = lane >> 4;
    const int K = g.K, nt = K / BK;
    unsigned voffA[2], voffB[2];
#pragma unroll
    for (int i = 0; i < 2; ++i) { int R, C; stage_rc(tid * 16 + i * 8192, R, C); const int Rb = Epi::PERM ? ((R & ~31) + perm32(R & 31)) : R;
        voffA[i] = (unsigned)(R * K + C) * 2u; voffB[i] = (unsigned)(Rb * K + C) * 2u; }
    const size_t kstep = (size_t)(BK * 2);
    const size_t hstep = (size_t)HALF * K * 2;
    const size_t tstep = 2 * hstep;
    const unsigned ldsw = (unsigned)wid * 1024u;
    const int aoff = lds_byte(wr * 64 + fr, fq * 8), boff = lds_byte(wc * 32 + fr, fq * 8);
#define PG8_SA(b, h) (((b) * 2 + (h)) * HTB)
#define PG8_SB(b, h) ((4 + (b) * 2 + (h)) * HTB)
#define PG8_STAGE(bufoff, gbase, voff) do { _Pragma("unroll") for (int _i = 0; _i < 2; ++_i) \
        __builtin_amdgcn_global_load_lds((const unsigned*)((const char*)(gbase) + (voff)[_i]), (PG8_LAS unsigned*)(lds + (bufoff) + ldsw + _i * 8192), 16, 0, 0); } while (0)
#define PG8_LDA(dst, b, h) do { _Pragma("unroll") for (int m = 0; m < 4; ++m) _Pragma("unroll") for (int k = 0; k < 2; ++k) dst[m][k] = *(const PG8_LAS bf16x8*)(lds + PG8_SA(b, h) + aoff + m * 2048 + k * 1024); } while (0)
#define PG8_LDB(dst, b, h) do { _Pragma("unroll") for (int n = 0; n < 2; ++n) _Pragma("unroll") for (int k = 0; k < 2; ++k) dst[n][k] = *(const PG8_LAS bf16x8*)(lds + PG8_SB(b, h) + boff + n * 2048 + k * 1024); } while (0)
#define PG8_MMA(ai, bj, At, Bt) do { __builtin_amdgcn_s_setprio(1); _Pragma("unroll") for (int m = 0; m < 4; ++m) _Pragma("unroll") for (int n = 0; n < 2; ++n) _Pragma("unroll") for (int k = 0; k < 2; ++k) \
        acc[ai][bj][m][n] = __builtin_amdgcn_mfma_f32_16x16x32_bf16(Bt[n][k], At[m][k], acc[ai][bj][m][n], 0, 0, 0); __builtin_amdgcn_s_setprio(0); } while (0)
#define PG8_WAIT_V(n) asm volatile("s_waitcnt vmcnt(" #n ")" ::: "memory")
#define PG8_WAIT_L(n) asm volatile("s_waitcnt lgkmcnt(" #n ")" ::: "memory")
#define PG8_BAR __builtin_amdgcn_s_barrier()
#define PG8_SCHED __builtin_amdgcn_sched_barrier(0)
    Unit cur, nxt; int ui = 0;
    if (!S.next(0, cur)) return;
    f32x4 acc[2][2][4][2];
#pragma unroll
    for (int a = 0; a < 2; ++a)
#pragma unroll
        for (int b = 0; b < 2; ++b)
#pragma unroll
            for (int m = 0; m < 4; ++m)
#pragma unroll
                for (int n = 0; n < 2; ++n) acc[a][b][m][n] = (f32x4){0.f, 0.f, 0.f, 0.f};
    bf16x8 At[4][2], B0[2][2], B1[2][2];
    const char* cA = (const char*)g.A + (size_t)cur.pm * tstep; const char* cB = (const char*)g.Bt + (size_t)cur.pn * tstep;
    S.a_ready(cur);
    if constexpr (SP2) {
        PG8_STAGE(PG8_SB(0, 0), cB, voffB); PG8_STAGE(PG8_SB(0, 1), cB + hstep, voffB); PG8_STAGE(PG8_SA(0, 0), cA, voffA); PG8_STAGE(PG8_SA(0, 1), cA + hstep, voffA);
        if (wr == 1) PG8_BAR;
        PG8_WAIT_V(2); PG8_BAR;
        PG8_STAGE(PG8_SB(1, 0), cB + kstep, voffB); PG8_STAGE(PG8_SA(1, 0), cA + kstep, voffA); PG8_STAGE(PG8_SB(1, 1), cB + hstep + kstep, voffB);
        PG8_WAIT_V(6); PG8_BAR;
    } else {
        PG8_STAGE(PG8_SB(0, 0), cB, voffB); PG8_STAGE(PG8_SA(0, 0), cA, voffA); PG8_STAGE(PG8_SB(0, 1), cB + hstep, voffB); PG8_STAGE(PG8_SA(0, 1), cA + hstep, voffA);
        if (wr == 1) PG8_BAR;
        PG8_WAIT_V(4); PG8_BAR;
        PG8_STAGE(PG8_SB(1, 0), cB + kstep, voffB); PG8_STAGE(PG8_SA(1, 0), cA + kstep, voffA); PG8_STAGE(PG8_SB(1, 1), cB + hstep + kstep, voffB);
        PG8_WAIT_V(6); PG8_BAR;
    }
    for (;;) {
        const bool has_next = S.next(ui + 1, nxt);
        const char* nA = has_next ? (const char*)g.A + (size_t)nxt.pm * tstep : cA; const char* nB = has_next ? (const char*)g.Bt + (size_t)nxt.pn * tstep : cB;
        for (int t = 0; t < nt; t += 2) {
            const bool last = (t == nt - 2);
            const char* a1 = cA + (size_t)(t + 1) * kstep;
            const char* a2 = last ? nA : cA + (size_t)(t + 2) * kstep; const char* b2 = last ? nB : cB + (size_t)(t + 2) * kstep;
            const char* a3 = a2 + kstep; const char* b3 = b2 + kstep;
            if (last && has_next) S.a_ready(nxt);
            if constexpr (SP2) {
            PG8_LDB(B0, 0, 0); PG8_LDB(B1, 0, 1); PG8_SCHED; PG8_LDA(At, 0, 0); PG8_STAGE(PG8_SA(1, 1), a1 + hstep, voffA);
            PG8_WAIT_V(8); PG8_WAIT_L(0); PG8_BAR; PG8_MMA(0, 0, At, B0); PG8_MMA(0, 1, At, B1); PG8_BAR; PG8_SCHED;
            PG8_LDA(At, 0, 1); PG8_STAGE(PG8_SB(0, 0), b2, voffB); PG8_STAGE(PG8_SB(0, 1), b2 + hstep, voffB); PG8_STAGE(PG8_SA(0, 0), a2, voffA);
            PG8_WAIT_V(8); PG8_WAIT_L(0); PG8_BAR; PG8_MMA(1, 0, At, B0); PG8_MMA(1, 1, At, B1); PG8_BAR; PG8_SCHED;
            PG8_LDB(B0, 1, 0); PG8_LDB(B1, 1, 1); PG8_SCHED; PG8_LDA(At, 1, 0); PG8_STAGE(PG8_SA(0, 1), a2 + hstep, voffA);
            PG8_WAIT_V(8); PG8_WAIT_L(0); PG8_BAR; PG8_MMA(0, 0, At, B0); PG8_MMA(0, 1, At, B1); PG8_BAR; PG8_SCHED;
            PG8_LDA(At, 1, 1); PG8_STAGE(PG8_SB(1, 0), b3, voffB); PG8_STAGE(PG8_SB(1, 1), b3 + hstep, voffB); PG8_STAGE(PG8_SA(1, 0), a3, voffA);
            PG8_WAIT_V(8); PG8_WAIT_L(0); PG8_BAR; PG8_MMA(1, 0, At, B0); PG8_MMA(1, 1, At, B1); PG8_BAR; PG8_SCHED;
            } else {
            PG8_LDB(B0, 0, 0); PG8_SCHED; PG8_LDA(At, 0, 0); PG8_STAGE(PG8_SA(1, 1), a1 + hstep, voffA);
            PG8_WAIT_L(8); PG8_BAR; PG8_WAIT_L(0); PG8_MMA(0, 0, At, B0); PG8_BAR; PG8_SCHED;
            PG8_LDB(B1, 0, 1); PG8_STAGE(PG8_SB(0, 0), b2, voffB);
            PG8_BAR; PG8_WAIT_L(0); PG8_MMA(0, 1, At, B1); PG8_BAR;
            PG8_LDA(At, 0, 1); PG8_STAGE(PG8_SA(0, 0), a2, voffA);
            PG8_BAR; PG8_WAIT_L(0); PG8_MMA(1, 0, At, B0); PG8_BAR; PG8_SCHED;
            PG8_STAGE(PG8_SB(0, 1), b2 + hstep, voffB);
            PG8_WAIT_V(6); PG8_BAR; PG8_MMA(1, 1, At, B1); PG8_BAR;
            PG8_LDB(B0, 1, 0); PG8_SCHED; PG8_LDA(At, 1, 0); PG8_STAGE(PG8_SA(0, 1), a2 + hstep, voffA);
            PG8_WAIT_L(8); PG8_BAR; PG8_WAIT_L(0); PG8_MMA(0, 0, At, B0); PG8_BAR; PG8_SCHED;
            PG8_LDB(B1, 1, 1); PG8_STAGE(PG8_SB(1, 0), b3, voffB);
            PG8_BAR; PG8_WAIT_L(0); PG8_MMA(0, 1, At, B1); PG8_BAR;
            PG8_LDA(At, 1, 1); PG8_STAGE(PG8_SA(1, 0), a3, voffA);
            PG8_BAR; PG8_WAIT_L(0); PG8_MMA(1, 0, At, B0); PG8_BAR; PG8_SCHED;
            PG8_STAGE(PG8_SB(1, 1), b3 + hstep, voffB);
            PG8_WAIT_V(6); PG8_BAR; PG8_MMA(1, 1, At, B1); PG8_BAR;
            }
        }
        if constexpr (ALIGN_EPI) { if (wr == 0) PG8_BAR; }
        if constexpr (!Epi::AFTER_DRAIN) { E(acc, cur, wr, wc, fr, fq); S.done(cur); }
        if (!has_next) break;
#pragma unroll
        for (int a = 0; a < 2; ++a)
#pragma unroll
            for (int b = 0; b < 2; ++b)
#pragma unroll
                for (int m = 0; m < 4; ++m)
#pragma unroll
                    for (int n = 0; n < 2; ++n) acc[a][b][m][n] = (f32x4){0.f, 0.f, 0.f, 0.f};
        cur = nxt; cA = nA; cB = nB; ++ui;
        if constexpr (ALIGN_EPI) { if (wr == 1) PG8_BAR; }
    }
    PG8_WAIT_V(0);
    if constexpr (!ALIGN_EPI) { if (wr == 0) PG8_BAR; }
    PG8_BAR;
    if constexpr (Epi::AFTER_DRAIN) { E.fused(acc, cur, wr, wc, fr, fq, lds, wid, lane); S.done(cur); }
#undef PG8_SA
#undef PG8_SB
#undef PG8_STAGE
#undef PG8_LDA
#undef PG8_LDB
#undef PG8_MMA
#undef PG8_WAIT_V
#undef PG8_WAIT_L
#undef PG8_BAR
#undef PG8_SCHED
}
}
#define GAS __attribute__((address_space(1)))
#define LAS __attribute__((address_space(3)))
typedef unsigned short bf16;
typedef unsigned v4u __attribute__((ext_vector_type(4)));
typedef float f32x4 __attribute__((ext_vector_type(4)));
typedef short bf16x8 __attribute__((ext_vector_type(8)));
typedef GAS unsigned gu32;
typedef GAS unsigned long long gu64;
#define RLX_AGENT __ATOMIC_RELAXED, __HIP_MEMORY_SCOPE_AGENT
#define LDS_WAIT() asm volatile("s_waitcnt lgkmcnt(0)" ::: "memory")
#define VM_WAIT() asm volatile("s_waitcnt vmcnt(0)" ::: "memory")
__device__ __forceinline__ unsigned long long rt() { return __builtin_amdgcn_s_memrealtime(); }
__device__ __forceinline__ unsigned f2bf(float f) { unsigned u = __builtin_bit_cast(unsigned, f); return (u + 0x7fffu + ((u >> 16) & 1u)) >> 16; }
__device__ __forceinline__ unsigned pk2(float lo, float hi) { return f2bf(lo) | (f2bf(hi) << 16); }

#define XB_TMO      128
#define XB_XCNT(j)  (256  + 64 * (j))
#define XB_XSUB(j)  (1280 + 64 * (j))
#define XB_XGEN(j)  (2304 + 64 * (j))
#define XB_TOP      3328
#define XB_TOPGEN   3392
#define XCD_BAR_WORDS 3456
#define XB_SPIN_CAP (1u << 18)

__device__ __forceinline__ unsigned xb_ld(unsigned* p)              { return __hip_atomic_load(p, __ATOMIC_RELAXED, __HIP_MEMORY_SCOPE_AGENT); }
__device__ __forceinline__ unsigned xb_add(unsigned* p, unsigned v) { return __hip_atomic_fetch_add(p, v, __ATOMIC_RELAXED, __HIP_MEMORY_SCOPE_AGENT); }
__device__ __forceinline__ unsigned xb_xcc_id() { return (unsigned)__builtin_amdgcn_s_getreg((3 << 11) | 20) & 0xFu; }
#define XB_SPIN(cond, bar) do { unsigned _sp = 0; while (cond) { __builtin_amdgcn_s_sleep(1); \
    if ((++_sp & 255u) == 0u) { if (xb_ld(&(bar)[XB_TMO])) break; if (_sp > XB_SPIN_CAP) { atomicAdd(&(bar)[XB_TMO], 1u); break; } } } } while (0)

struct XcdBarrier {
    unsigned* bar; unsigned x;
    volatile LAS unsigned* st;
};

__device__ __forceinline__ XcdBarrier xcd_barrier_post(unsigned* bar, volatile LAS unsigned* st) {
    XcdBarrier b; b.bar = bar; b.x = xb_xcc_id(); b.st = st;
    if (threadIdx.x == 0) (void)xb_add(&bar[XB_XCNT(b.x)], 1u);
    return b;
}
__device__ __forceinline__ void xcd_barrier_complete(unsigned* bar, unsigned x, unsigned& nloc, unsigned& nx) {
    const unsigned G = gridDim.x * gridDim.y * gridDim.z;
    unsigned sum, cnt, mine, sp = 0u;
    for (;;) {
        sum = 0u; cnt = 0u; mine = 0u;
#pragma unroll
        for (unsigned j = 0; j < 16; ++j) { const unsigned c = xb_ld(&bar[XB_XCNT(j)]); sum += c; cnt += (c > 0u) ? 1u : 0u; mine = (j == x) ? c : mine; }
        if (sum == G) break;
        __builtin_amdgcn_s_sleep(1);
        if ((++sp & 255u) == 0u) { if (xb_ld(&bar[XB_TMO])) break; if (sp > XB_SPIN_CAP) { atomicAdd(&bar[XB_TMO], 1u); break; } }
    }
    nloc = mine > 0u ? mine : 1u; nx = cnt > 0u ? cnt : 1u;
}

__device__ __forceinline__ void xcd_barrier(const XcdBarrier& b) {
    asm volatile("s_waitcnt vmcnt(0)" ::: "memory");
    __syncthreads();
    if (threadIdx.x == 0) {
        unsigned* bar = b.bar;
        __builtin_amdgcn_s_waitcnt(0);
        unsigned nloc = b.st[0], nx = b.st[1];
        if (nloc == 0u) { xcd_barrier_complete(bar, b.x, nloc, nx); b.st[0] = nloc; b.st[1] = nx; }
        const unsigned old = xb_add(&bar[XB_XSUB(b.x)], 1u);
        const unsigned gen = old / nloc;
        if (old + 1u == (gen + 1u) * nloc) {
            __builtin_amdgcn_fence(__ATOMIC_RELEASE, "agent");
            asm volatile("s_waitcnt vmcnt(0)" ::: "memory");
            const unsigned og = xb_add(&bar[XB_TOP], 1u);
            const unsigned tg = og / nx;
            if (og + 1u == (tg + 1u) * nx) xb_add(&bar[XB_TOPGEN], 1u);
            else XB_SPIN(xb_ld(&bar[XB_TOPGEN]) == tg, bar);
            __builtin_amdgcn_fence(__ATOMIC_ACQUIRE, "agent");
            xb_add(&bar[XB_XGEN(b.x)], 1u);
            asm volatile("s_waitcnt vmcnt(0)" ::: "memory");
        } else {
            XB_SPIN(xb_ld(&bar[XB_XGEN(b.x)]) == gen, bar);
            __builtin_amdgcn_fence(__ATOMIC_ACQUIRE, "agent");
            asm volatile("s_waitcnt vmcnt(0)" ::: "memory");
        }
    }
    __syncthreads();
}
typedef unsigned v2u __attribute__((ext_vector_type(2)));
constexpr int NWAVES = 8, NTHR = 512;
constexpr int DM = 1024, TP = 16384, TS = 512, T = TP + TS;
constexpr int SEQ = 2048, NBP = 8, NBS = 128, LS = 4, MEMR = 2048;
constexpr int NPROJ = 11520;
constexpr int FFN = 2816;
constexpr float EPS = 1e-6f;
constexpr float QSCALE = 0.0625f * 1.4426950408889634f;

constexpr size_t MiB = 1u << 20;
constexpr size_t WS_CTL = 0, CTL_ZERO_BYTES = 1 * MiB;
constexpr size_t WS_SSQX = 1 * MiB, WS_SSQM = 1 * MiB + 512 * 1024;
constexpr size_t WS_DT = 2 * MiB, WS_SSQSSD = 5 * MiB, WS_SSQP1 = 8 * MiB, WS_SSQP2 = 9 * MiB + 512 * 1024, WS_SSQP3 = 11 * MiB;
constexpr size_t WS_WIN = 13 * MiB, WS_WKV = 36 * MiB, WS_WSSD = 40 * MiB, WS_WHG = 44 * MiB, WS_WOUT = 46 * MiB, WS_WCQ = 48 * MiB, WS_WCO = 50 * MiB, WS_WGU = 52 * MiB, WS_WDN = 63 * MiB;
constexpr size_t WS_XB = 69 * MiB, WS_MNB = 102 * MiB, WS_KB = 106 * MiB, WS_VT = 110 * MiB;
constexpr size_t SLOT = 33 * MiB, SLOT_ELEMS = (size_t)T * 1024;
constexpr size_t WS_PROJ = 114 * MiB;
constexpr size_t WS_YG = WS_PROJ + 11 * SLOT, WS_ON = WS_YG + 2 * SLOT, WS_END = WS_ON + SLOT;
static_assert(SLOT == SLOT_ELEMS * 2, "slot size");
static_assert(WS_WIN + (size_t)NPROJ * 1024 * 2 <= WS_WKV && WS_WGU + (size_t)2 * FFN * 1024 * 2 <= WS_WDN && WS_WDN + (size_t)1024 * FFN * 2 <= WS_XB && WS_SSQP3 + (size_t)T * 64 <= WS_WIN, "d_ws map");
static_assert(WS_DT + (size_t)T * 128 <= WS_SSQSSD && WS_SSQSSD + (size_t)T * 128 <= WS_SSQP1 && WS_SSQP1 + (size_t)T * 64 <= WS_SSQP2 && WS_SSQP2 + (size_t)T * 64 <= WS_SSQP3, "d_ws map 2");
enum { S_Z0 = 0, S_Z1 = 1, S_X0 = 2, S_X1 = 3, S_X2 = 4, S_Q = 5, S_F = 6, S_I = 7, S_HG = 8, S_GS = 9, S_GH = 10 };
constexpr size_t WS_MERGED = WS_PROJ + S_Q * SLOT, WS_HB = WS_PROJ + S_F * SLOT, WS_QB = WS_PROJ + S_I * SLOT, WS_OB = WS_PROJ + S_HG * SLOT, WS_ACT = WS_PROJ;
static_assert((size_t)T * FFN * 2 <= 3 * SLOT, "act overlay");
constexpr size_t O_Y = 0, O_SSMP = (size_t)T * 1024, O_CONVP = O_SSMP + 2097152, O_HGP = O_CONVP + 73728, O_MKP = O_HGP + 1048576, O_MVP = O_MKP + 2097152,
                 O_SSMS = O_MVP + 2097152, O_CONVS = O_SSMS + 33554432, O_HGS = O_CONVS + 1179648, O_END = O_HGS + 16777216;
constexpr int CW_QUEUE = 64;
constexpr int CW_BAR = 4096;
constexpr int RING_OFF = 0, RING_BYTES = 131072;
constexpr int LDSCTL_OFF = RING_BYTES, MISC_OFF = LDSCTL_OFF + 320;
constexpr int LDS_BYTES = 147456;
struct Frame {
    LAS unsigned char* lds;
    volatile LAS unsigned* MISC;
    gu32* ctl;
    int tid, lane, wave;
    int vcu, G;
    const float* in[32];
    float* out; unsigned char* ws;
};
__device__ __forceinline__ float bf2f(unsigned v16) { return __uint_as_float(v16 << 16); }
__device__ __forceinline__ float sigmoid_f(float x) { return __builtin_amdgcn_rcpf(1.0f + __expf(-x)); }
__device__ __forceinline__ float silu_f(float x) { return x * sigmoid_f(x); }
__device__ __forceinline__ float wave_sum(float v) {
#pragma unroll
    for (int o = 1; o < 64; o <<= 1) v += __shfl_xor(v, o);
    return v;
}
__device__ __forceinline__ float wave_max(float v) {
#pragma unroll
    for (int o = 1; o < 64; o <<= 1) v = fmaxf(v, __shfl_xor(v, o));
    return v;
}
struct TSrc { const float* W; const float* W2; const float* ks; int ldw; int mode; };
__device__ __forceinline__ float tsrc_elem(const TSrc& s, int k, int n) {
    float v;
    if (s.mode == 0) v = s.W[(size_t)k * s.ldw + n];
    else if (s.mode == 1) { if (n < 5120) v = s.W[(size_t)k * s.ldw + n]; else if (n < 11264) v = s.W[(size_t)k * s.ldw + n + 32]; else if (n < 11296) v = s.W[(size_t)k * s.ldw + 5120 + (n - 11264)]; else v = 0.f; }
    else if (s.mode == 2) v = (n & 1) ? s.W2[(size_t)k * s.ldw + (n >> 1)] : s.W[(size_t)k * s.ldw + (n >> 1)];
    else v = (n < 1024) ? s.W[(size_t)k * s.ldw + n] : s.W2[(size_t)k * s.ldw + (n - 1024)];
    return s.ks ? v * s.ks[k] : v;
}
__device__ __forceinline__ void p0_transpose_item(const TSrc& s, int K, int N, bf16* WT, LAS float* scr, int item, int lane) {
    const int nblk = N / 32, kb = item / nblk, nb = item % nblk, k0 = 64 * kb, n0 = 32 * nb;
#pragma unroll 8
    for (int i = 0; i < 32; ++i) { const int kk = 2 * i + (lane >> 5); scr[kk * 33 + (lane & 31)] = tsrc_elem(s, k0 + kk, n0 + (lane & 31)); }
    LDS_WAIT(); asm volatile("" ::: "memory");
    const int c = lane & 7;
#pragma unroll
    for (int j = 0; j < 4; ++j) { const int n = (lane >> 3) + 8 * j; const LAS float* p = scr + (8 * c) * 33 + n;
        v4u o; o.x = pk2(p[0 * 33], p[1 * 33]); o.y = pk2(p[2 * 33], p[3 * 33]); o.z = pk2(p[4 * 33], p[5 * 33]); o.w = pk2(p[6 * 33], p[7 * 33]);
        *(v4u*)(WT + (size_t)(n0 + n) * K + k0 + 8 * c) = o; }
    LDS_WAIT(); asm volatile("" ::: "memory");
}
__device__ __forceinline__ void row_to_bf16_ssq(const float* xrow, bf16* orow, float* ssq, int lane) {
    const f32x4* xr = (const f32x4*)xrow + lane; f32x4 v[4]; float s = 0.f;
#pragma unroll
    for (int j = 0; j < 4; ++j) { v[j] = xr[64 * j]; s += (v[j].x * v[j].x + v[j].y * v[j].y) + (v[j].z * v[j].z + v[j].w * v[j].w); }
    s = wave_sum(s);
    unsigned long long* o8 = (unsigned long long*)orow + lane;
#pragma unroll
    for (int j = 0; j < 4; ++j) o8[64 * j] = (unsigned long long)pk2(v[j].x, v[j].y) | ((unsigned long long)pk2(v[j].z, v[j].w) << 32);
    if (lane == 0) *ssq = s;
}
__device__ __forceinline__ void p0_prologue(Frame& F) {
    LAS float* scr = (LAS float*)(F.lds + RING_OFF + F.wave * 16384);
    const int gw = F.vcu * NWAVES + F.wave, NGW = F.G * NWAVES;
    unsigned char* ws = F.ws;
    constexpr int I_IN = 16 * (NPROJ / 32), I_KV = 16 * 64, I_SSD = 32 * 32, I_SQ = 16 * 32, I_GU = 16 * (2 * FFN / 32), I_DN = (FFN / 64) * 32;
    constexpr int NITEMS = I_IN + I_KV + I_SSD + 4 * I_SQ + I_GU + I_DN;
    for (int it = gw; it < NITEMS; it += NGW) {
        int r = it;
        if (r < I_IN) { TSrc s{F.in[9], nullptr, F.in[8], 11296, 1}; p0_transpose_item(s, 1024, NPROJ, (bf16*)(ws + WS_WIN), scr, r, F.lane); continue; } r -= I_IN;
        if (r < I_KV) { TSrc s{F.in[24], F.in[25], F.in[22], 1024, 3}; p0_transpose_item(s, 1024, 2048, (bf16*)(ws + WS_WKV), scr, r, F.lane); continue; } r -= I_KV;
        if (r < I_SSD) { TSrc s{F.in[16], nullptr, F.in[15], 1024, 0}; p0_transpose_item(s, 2048, 1024, (bf16*)(ws + WS_WSSD), scr, r, F.lane); continue; } r -= I_SSD;
        if (r < I_SQ) { TSrc s{F.in[19], nullptr, F.in[18], 1024, 0}; p0_transpose_item(s, 1024, 1024, (bf16*)(ws + WS_WHG), scr, r, F.lane); continue; } r -= I_SQ;
        if (r < I_SQ) { TSrc s{F.in[20], nullptr, nullptr, 1024, 0}; p0_transpose_item(s, 1024, 1024, (bf16*)(ws + WS_WOUT), scr, r, F.lane); continue; } r -= I_SQ;
        if (r < I_SQ) { TSrc s{F.in[23], nullptr, F.in[21], 1024, 0}; p0_transpose_item(s, 1024, 1024, (bf16*)(ws + WS_WCQ), scr, r, F.lane); continue; } r -= I_SQ;
        if (r < I_SQ) { TSrc s{F.in[26], nullptr, nullptr, 1024, 0}; p0_transpose_item(s, 1024, 1024, (bf16*)(ws + WS_WCO), scr, r, F.lane); continue; } r -= I_SQ;
        if (r < I_GU) { TSrc s{F.in[28], F.in[29], F.in[27], FFN, 2}; p0_transpose_item(s, 1024, 2 * FFN, (bf16*)(ws + WS_WGU), scr, r, F.lane); continue; } r -= I_GU;
        { TSrc s{F.in[30], nullptr, nullptr, 1024, 0}; p0_transpose_item(s, FFN, 1024, (bf16*)(ws + WS_WDN), scr, r, F.lane); }
    }
    bf16* XB = (bf16*)(ws + WS_XB); float* SSQX = (float*)(ws + WS_SSQX);
    for (int m = gw; m < T; m += NGW) { const float* src = m < TP ? F.in[0] + (size_t)m * DM : F.in[1] + (size_t)(m - TP) * DM; row_to_bf16_ssq(src, XB + (size_t)m * DM, SSQX + m, F.lane); }
    bf16* MNB = (bf16*)(ws + WS_MNB); float* SSQM = (float*)(ws + WS_SSQM);
    for (int m = gw; m < MEMR; m += NGW) row_to_bf16_ssq(F.in[2] + (size_t)m * DM, MNB + (size_t)m * DM, SSQM + m, F.lane);
}
__device__ __forceinline__ void ssd_unit(Frame& F, int gb, int h) {
    const int tid = F.tid; unsigned char* ws = F.ws;
    const bool prompt = gb < NBP; const int L = prompt ? SEQ : LS; const int sb = gb - NBP; const size_t row_base = prompt ? (size_t)gb * SEQ : (size_t)TP + (size_t)sb * LS;
    const int g = h >> 3;
    LAS float* xs = (LAS float*)(F.lds + RING_OFF);
    LAS float* Bs = xs + 64 * 64;
    LAS float* Cs = Bs + 64 * 128;
    LAS float* ys = Cs + 64 * 128;
    LAS float* dts = ys + 64 * 64;
    LAS float* das = dts + 64;
    const bf16* PROJ = (const bf16*)(ws + WS_PROJ); const float* DTR = (const float*)(ws + WS_DT);
    bf16* YG = (bf16*)(ws + WS_YG); float* SSQ = (float*)(ws + WS_SSQSSD);
    const int p = tid >> 3, n0 = (tid & 7) * 16;
    float hs[16];
    float* state_out = prompt ? F.out + O_SSMP + ((size_t)(gb * 32 + h) * 64 + p) * 128 + n0 : F.out + O_SSMS + ((size_t)(sb * 32 + h) * 64 + p) * 128 + n0;
    if (prompt) {
#pragma unroll
        for (int i = 0; i < 16; ++i) hs[i] = 0.f;
    } else { const float* sp = F.in[3] + ((size_t)(sb * 32 + h) * 64 + p) * 128 + n0;
#pragma unroll
        for (int i = 0; i < 4; ++i) { const f32x4 v = *(const f32x4*)(sp + 4 * i); hs[4 * i] = v.x; hs[4 * i + 1] = v.y; hs[4 * i + 2] = v.z; hs[4 * i + 3] = v.w; } }
    const float a = -__expf(F.in[13][h]), dtb = F.in[12][h], Dk = F.in[14][h];
    int col = 0; LAS float* dst = xs; int dstride = 64;
    if (tid < 64) { col = h * 64 + tid; dst = xs + tid; dstride = 64; }
    else if (tid < 192) { col = 2048 + g * 128 + (tid - 64); dst = Bs + (tid - 64); dstride = 128; }
    else if (tid < 320) { col = 2560 + g * 128 + (tid - 192); dst = Cs + (tid - 192); dstride = 128; }
    float w0 = 0.f, w1 = 0.f, w2 = 0.f, w3 = 0.f, cb = 0.f, r0 = 0.f, r1 = 0.f, r2 = 0.f; const bf16* cptr = PROJ;
    if (tid < 320) { const float* cw = F.in[10]; w0 = cw[col]; w1 = cw[3072 + col]; w2 = cw[2 * 3072 + col]; w3 = cw[3 * 3072 + col]; cb = F.in[11][col];
        cptr = PROJ + (size_t)(S_X0 + (col >> 10)) * SLOT_ELEMS + row_base * 1024 + (col & 1023);
        if (!prompt) { const float* sc = F.in[4] + (size_t)sb * 3 * 3072 + col; r0 = sc[0]; r1 = sc[3072]; r2 = sc[2 * 3072]; } }
    for (int t0 = 0; t0 < L; t0 += 64) {
        const int nt = (L - t0) < 64 ? (L - t0) : 64;
        if (tid < 320) {
            for (int tt = 0; tt < nt; ++tt) { const float raw = bf2f(cptr[(size_t)(t0 + tt) * 1024]); float v = w0 * r0 + w1 * r1 + w2 * r2 + w3 * raw + cb; v = silu_f(v); dst[tt * dstride] = v; r0 = r1; r1 = r2; r2 = raw; }
        } else if (tid < 384) { const int tt = tid - 320;
            if (tt < nt) { const float x = DTR[(row_base + t0 + tt) * 32 + h] + dtb; const float dtv = x > 20.f ? x : log1pf(__expf(x)); dts[tt] = dtv; das[tt] = __expf(dtv * a); } }
        __syncthreads();
        for (int tt = 0; tt < nt; ++tt) {
            const float xv = xs[tt * 64 + p], dtv = dts[tt], dA = das[tt], xd = xv * dtv; float part = 0.f;
#pragma unroll
            for (int i = 0; i < 4; ++i) { const f32x4 bv = *(const LAS f32x4*)(Bs + tt * 128 + n0 + 4 * i), cv = *(const LAS f32x4*)(Cs + tt * 128 + n0 + 4 * i);
                hs[4 * i] = dA * hs[4 * i] + xd * bv.x; hs[4 * i + 1] = dA * hs[4 * i + 1] + xd * bv.y; hs[4 * i + 2] = dA * hs[4 * i + 2] + xd * bv.z; hs[4 * i + 3] = dA * hs[4 * i + 3] + xd * bv.w;
                part += (hs[4 * i] * cv.x + hs[4 * i + 1] * cv.y) + (hs[4 * i + 2] * cv.z + hs[4 * i + 3] * cv.w); }
            part += __shfl_xor(part, 1); part += __shfl_xor(part, 2); part += __shfl_xor(part, 4);
            if ((tid & 7) == 0) ys[tt * 64 + p] = part;
        }
        __syncthreads();
        { const int tt = tid >> 3, p0 = (tid & 7) * 8;
          if (tt < nt) { const size_t row = row_base + t0 + tt;
            const v4u zw = *(const v4u*)(PROJ + (size_t)(S_Z0 + (h >> 4)) * SLOT_ELEMS + row * 1024 + (h & 15) * 64 + p0);
            float o[8]; float sq = 0.f;
#pragma unroll
            for (int j = 0; j < 8; ++j) { const unsigned z16 = (zw[j >> 1] >> ((j & 1) * 16)) & 0xffffu; const float yv = (ys[tt * 64 + p0 + j] + xs[tt * 64 + p0 + j] * Dk) * silu_f(bf2f(z16)); o[j] = yv; sq += yv * yv; }
            v4u ow; ow.x = pk2(o[0], o[1]); ow.y = pk2(o[2], o[3]); ow.z = pk2(o[4], o[5]); ow.w = pk2(o[6], o[7]);
            *(v4u*)(YG + row * 2048 + h * 64 + p0) = ow;
            sq += __shfl_xor(sq, 1); sq += __shfl_xor(sq, 2); sq += __shfl_xor(sq, 4);
            if ((tid & 7) == 0) SSQ[row * 32 + h] = sq; } }
        __syncthreads();
    }
#pragma unroll
    for (int i = 0; i < 4; ++i) *(f32x4*)(state_out + 4 * i) = (f32x4){hs[4 * i], hs[4 * i + 1], hs[4 * i + 2], hs[4 * i + 3]};
}
__device__ __forceinline__ void hgrn_unit(Frame& F, int gb, int hd) {
    const int tid = F.tid; unsigned char* ws = F.ws;
    const bool prompt = gb < NBP; const int L = prompt ? SEQ : LS; const int sb = gb - NBP; const size_t row_base = prompt ? (size_t)gb * SEQ : (size_t)TP + (size_t)sb * LS;
    LAS float* qs = (LAS float*)(F.lds + RING_OFF);
    LAS float* fs = qs + 32 * 128; LAS float* ks = fs + 32 * 128; LAS float* vs = ks + 32 * 128; LAS float* os = vs + 32 * 128;
    const bf16* PROJ = (const bf16*)(ws + WS_PROJ); bf16* ON = (bf16*)(ws + WS_ON);
    const int v = tid >> 2, k0 = (tid & 3) * 32;
    float S[32];
    float* state_out = prompt ? F.out + O_HGP + ((size_t)(gb * 8 + hd) * 128 + k0) * 128 + v : F.out + O_HGS + ((size_t)(sb * 8 + hd) * 128 + k0) * 128 + v;
    if (prompt) {
#pragma unroll
        for (int i = 0; i < 32; ++i) S[i] = 0.f;
    } else { const float* sp = F.in[5] + ((size_t)(sb * 8 + hd) * 128 + k0) * 128 + v;
#pragma unroll
        for (int i = 0; i < 32; ++i) S[i] = sp[(size_t)i * 128]; }
    const int c = tid & 127, part = tid >> 7; const int ch = hd * 128 + c;
    float lb = 0.f; if (part == 1) lb = 1.0f / (1.0f + __expf(F.in[17][1024 + ch] - F.in[17][ch]));
    const bf16* sptr = PROJ + (size_t)(part == 0 ? S_Q : (part == 1 ? S_F : S_I)) * SLOT_ELEMS + row_base * 1024 + ch;
    for (int t0 = 0; t0 < L; t0 += 32) {
        const int nt = (L - t0) < 32 ? (L - t0) : 32;
        if (part < 3) {
            for (int tt = 0; tt < nt; ++tt) { const float raw = bf2f(sptr[(size_t)(t0 + tt) * 1024]);
                if (part == 0) qs[tt * 128 + c] = silu_f(raw);
                else if (part == 1) { const float e = __expf(-raw); const float sg = 1.0f / (1.0f + e); fs[tt * 128 + c] = lb + (1.0f - lb) * sg; ks[tt * 128 + c] = (1.0f - lb) * (e / (1.0f + e)); }
                else vs[tt * 128 + c] = raw; }
        }
        __syncthreads();
        for (int tt = 0; tt < nt; ++tt) {
            const float vv = vs[tt * 128 + v]; float acc = 0.f;
#pragma unroll
            for (int i = 0; i < 8; ++i) { const f32x4 fv = *(const LAS f32x4*)(fs + tt * 128 + k0 + 4 * i), kv = *(const LAS f32x4*)(ks + tt * 128 + k0 + 4 * i), qv = *(const LAS f32x4*)(qs + tt * 128 + k0 + 4 * i);
                S[4 * i] = fv.x * S[4 * i] + kv.x * vv; S[4 * i + 1] = fv.y * S[4 * i + 1] + kv.y * vv; S[4 * i + 2] = fv.z * S[4 * i + 2] + kv.z * vv; S[4 * i + 3] = fv.w * S[4 * i + 3] + kv.w * vv;
                acc += (S[4 * i] * qv.x + S[4 * i + 1] * qv.y) + (S[4 * i + 2] * qv.z + S[4 * i + 3] * qv.w); }
            acc += __shfl_xor(acc, 1); acc += __shfl_xor(acc, 2);
            if ((tid & 3) == 0) os[tt * 128 + v] = acc;
        }
        __syncthreads();
        { const int tt = tid >> 4, v0 = (tid & 15) * 8;
          if (tt < nt) { const size_t row = row_base + t0 + tt; float o[8]; float sq = 0.f;
#pragma unroll
            for (int j = 0; j < 8; ++j) { o[j] = os[tt * 128 + v0 + j]; sq += o[j] * o[j]; }
            sq += __shfl_xor(sq, 1); sq += __shfl_xor(sq, 2); sq += __shfl_xor(sq, 4); sq += __shfl_xor(sq, 8);
            const float rs = 1.0f / sqrtf(sq * (1.0f / 128.0f) + EPS);
            const v4u gw = *(const v4u*)(PROJ + (size_t)S_HG * SLOT_ELEMS + row * 1024 + hd * 128 + v0);
#pragma unroll
            for (int j = 0; j < 8; ++j) { const unsigned g16 = (gw[j >> 1] >> ((j & 1) * 16)) & 0xffffu; o[j] = o[j] * rs * silu_f(bf2f(g16)); }
            v4u ow; ow.x = pk2(o[0], o[1]); ow.y = pk2(o[2], o[3]); ow.z = pk2(o[4], o[5]); ow.w = pk2(o[6], o[7]);
            *(v4u*)(ON + row * 1024 + hd * 128 + v0) = ow; } }
        __syncthreads();
    }
#pragma unroll
    for (int i = 0; i < 32; ++i) state_out[(size_t)i * 128] = S[i];
}
__device__ __forceinline__ void conv_copy_unit(Frame& F, int gb) {
    const bf16* PROJ = (const bf16*)(F.ws + WS_PROJ);
    const bool prompt = gb < NBP; const int sb = gb - NBP;
    const size_t row0 = prompt ? (size_t)gb * SEQ + (SEQ - 3) : (size_t)TP + (size_t)sb * LS + 1;
    float* dst = prompt ? F.out + O_CONVP + (size_t)gb * 3 * 3072 : F.out + O_CONVS + (size_t)sb * 3 * 3072;
    for (int e = F.tid; e < 3 * 3072; e += NTHR) { const int j = e / 3072, col = e % 3072;
        dst[e] = bf2f(PROJ[(size_t)(S_X0 + (col >> 10)) * SLOT_ELEMS + (row0 + j) * 1024 + (col & 1023)]); }
}
__device__ __forceinline__ void ssdnorm_phase(Frame& F) {
    const int gw = F.vcu * NWAVES + F.wave, NGW = F.G * NWAVES; bf16* YG = (bf16*)(F.ws + WS_YG); const float* SSQ = (const float*)(F.ws + WS_SSQSSD);
    for (int row = gw; row < T; row += NGW) {
        const f32x4* sp = (const f32x4*)(SSQ + (size_t)row * 32);
#pragma unroll
        for (int j = 0; j < 4; ++j) { const f32x4 a = sp[2 * j], b = sp[2 * j + 1]; const float s = ((a.x + a.y) + (a.z + a.w)) + ((b.x + b.y) + (b.z + b.w)); const float rs = 1.0f / sqrtf(s * (1.0f / 512.0f) + EPS);
            v4u* p = (v4u*)(YG + (size_t)row * 2048) + j * 64 + F.lane; const v4u w = *p; v4u o;
#pragma unroll
            for (int e = 0; e < 4; ++e) o[e] = pk2(bf2f(w[e] & 0xffffu) * rs, bf2f(w[e] >> 16) * rs);
            *p = o; }
    }
}
typedef float f32x16 __attribute__((ext_vector_type(16)));
#define MFMA32(a, b, c) __builtin_amdgcn_mfma_f32_32x32x16_bf16((a), (b), (c), 0, 0, 0)
typedef float f32x2_t __attribute__((ext_vector_type(2))); typedef __bf16 bf16x2_t __attribute__((ext_vector_type(2)));
__device__ __forceinline__ unsigned cvtpk_c(float lo, float hi) { const f32x2_t v = {lo, hi}; const bf16x2_t b = __builtin_convertvector(v, bf16x2_t); return __builtin_bit_cast(unsigned, b); }
__device__ __forceinline__ bf16x8 pack8(float a0, float a1, float a2, float a3, float a4, float a5, float a6, float a7) {
    v4u w; w.x = cvtpk_c(a0, a1); w.y = cvtpk_c(a2, a3); w.z = cvtpk_c(a4, a5); w.w = cvtpk_c(a6, a7); return __builtin_bit_cast(bf16x8, w); }
#define ACC_FRAG(x, s) pack8((x)[8 * (s)], (x)[8 * (s) + 1], (x)[8 * (s) + 2], (x)[8 * (s) + 3], (x)[8 * (s) + 4], (x)[8 * (s) + 5], (x)[8 * (s) + 6], (x)[8 * (s) + 7])
__device__ __forceinline__ bf16x8 lds_frag16(const LAS unsigned char* p) { return *(const LAS bf16x8*)p; }
__device__ __forceinline__ bf16x8 lds_frag8x2(const LAS unsigned char* p) { const v2u lo = *(const LAS v2u*)p, hi = *(const LAS v2u*)(p + 16);
    const v4u w = (v4u){lo.x, lo.y, hi.x, hi.y}; return __builtin_bit_cast(bf16x8, w); }
__device__ __forceinline__ float exp_clamped(float x) { return __expf(fminf(x, 80.0f)); }
constexpr int HG_QA = 0, HG_KA = 8704, HG_KAT = 17408, HG_VT = 27648, HG_EGM = 37888, HG_EGL = 38400, HG_SEG = 38912, HG_OB = 40960, HG_RAW = 74752;
__device__ __forceinline__ void hgrn_unit_mfma(Frame& F, int gb, int hd) {
    const int tid = F.tid, lane = F.lane, w = F.wave, r = lane & 31, hh = lane >> 5; unsigned char* ws = F.ws;
    const bool prompt = gb < NBP; const int L = prompt ? SEQ : LS; const int sb = gb - NBP; const size_t row_base = prompt ? (size_t)gb * SEQ : (size_t)TP + (size_t)sb * LS;
    LAS unsigned char* Lb = F.lds + RING_OFF;
    LAS unsigned short* QA = (LAS unsigned short*)(Lb + HG_QA); LAS unsigned short* KA = (LAS unsigned short*)(Lb + HG_KA);
    LAS unsigned short* KAT = (LAS unsigned short*)(Lb + HG_KAT); LAS unsigned short* VT = (LAS unsigned short*)(Lb + HG_VT);
    LAS float* EGM = (LAS float*)(Lb + HG_EGM); LAS float* EGL = (LAS float*)(Lb + HG_EGL); LAS float* SEG = (LAS float*)(Lb + HG_SEG); LAS float* OB = (LAS float*)(Lb + HG_OB);
    const bf16* PROJ = (const bf16*)(ws + WS_PROJ); bf16* ON = (bf16*)(ws + WS_ON);
    const int vt = w & 3, kh = w >> 2;
    f32x16 S0, S1;
    float* st_g = (prompt ? F.out + O_HGP + (size_t)(gb * 8 + hd) * 16384 : F.out + O_HGS + (size_t)(sb * 8 + hd) * 16384) + 32 * vt + r;
    if (prompt) {
#pragma unroll
        for (int i = 0; i < 16; ++i) { S0[i] = 0.f; S1[i] = 0.f; }
    } else { const float* sp = F.in[5] + (size_t)(sb * 8 + hd) * 16384 + 32 * vt + r;
#pragma unroll
        for (int i = 0; i < 16; ++i) { const int k = 64 * kh + (i & 3) + 8 * (i >> 2) + 4 * hh; S0[i] = sp[(size_t)k * 128]; S1[i] = sp[(size_t)(k + 32) * 128]; } }
    const int c = tid & 127, tq = tid >> 7, ch = hd * 128 + c;
    const float lb = 1.0f / (1.0f + __expf(F.in[17][1024 + ch] - F.in[17][ch]));
    LAS unsigned short* RAW = (LAS unsigned short*)(Lb + HG_RAW);
    const int srow = tid >> 4, sc8 = (tid & 15) * 8;
    const bf16* gsrc = PROJ + row_base * 1024 + hd * 128 + sc8;
    v4u pfF = (v4u){0u, 0u, 0u, 0u}, pfQ = pfF, pfI = pfF;
    if (srow < L) { const size_t o = (size_t)srow * 1024; pfF = *(const v4u*)(gsrc + (size_t)S_F * SLOT_ELEMS + o); pfQ = *(const v4u*)(gsrc + (size_t)S_Q * SLOT_ELEMS + o); pfI = *(const v4u*)(gsrc + (size_t)S_I * SLOT_ELEMS + o); }
    for (int t0 = 0; t0 < L; t0 += 32) {
        int r_l = r, hh_l = hh, c_l = c, tq_l = tq, srow_l = srow, sc8_l = sc8;
        asm volatile("" : "+v"(r_l), "+v"(hh_l), "+v"(c_l), "+v"(tq_l), "+v"(srow_l), "+v"(sc8_l));
        { const int r = r_l, hh = hh_l, c = c_l, tq = tq_l, srow = srow_l, sc8 = sc8_l;
        *(LAS v4u*)(RAW + srow * 128 + sc8) = pfF; *(LAS v4u*)(RAW + 4096 + srow * 128 + sc8) = pfQ; *(LAS v4u*)(RAW + 8192 + srow * 128 + sc8) = pfI;
        __syncthreads();
        { const int tn = t0 + 32 + srow; pfF = (v4u){0u, 0u, 0u, 0u}; pfQ = pfF; pfI = pfF;
          if (tn < L) { const size_t o = (size_t)tn * 1024; pfF = *(const v4u*)(gsrc + (size_t)S_F * SLOT_ELEMS + o); pfQ = *(const v4u*)(gsrc + (size_t)S_Q * SLOT_ELEMS + o); pfI = *(const v4u*)(gsrc + (size_t)S_I * SLOT_ELEMS + o); } }
        float lc[8], kk[8], qs[8], vi[8]; float run = 0.f;
#pragma unroll
        for (int i = 0; i < 8; ++i) { const int tl = 8 * tq + i; float lf = 0.f, kv = 0.f, qv = 0.f, vv = 0.f;
            if (t0 + tl < L) { const float u = fminf(fmaxf(bf2f(RAW[tl * 128 + c]), -30.f), 30.f); const float e = __expf(-u), sg = __builtin_amdgcn_rcpf(1.0f + e); lf = __logf(lb + (1.0f - lb) * sg); kv = (1.0f - lb) * (e * sg);
                const float qr = bf2f(RAW[4096 + tl * 128 + c]); qv = qr * __builtin_amdgcn_rcpf(1.0f + __expf(-qr)); vv = bf2f(RAW[8192 + tl * 128 + c]); }
            run += lf; lc[i] = run; kk[i] = kv; qs[i] = qv; vi[i] = vv; }
        SEG[tq * 128 + c] = run;
        __syncthreads();
        { const float s0 = SEG[c], s1 = SEG[128 + c], s2 = SEG[256 + c], s3 = SEG[384 + c]; const float gm = s0 + s1, gl = (s0 + s1) + (s2 + s3);
          const float pre = tq == 0 ? 0.f : (tq == 1 ? s0 : (tq == 2 ? s0 + s1 : (s0 + s1) + s2));
          float kav[8];
#pragma unroll
          for (int i = 0; i < 8; ++i) { const float d = (pre + lc[i]) - gm; const float qa = qs[i] * exp_clamped(d), ka = kk[i] * exp_clamped(-d); const int t = 8 * tq + i;
              QA[t * 136 + c] = (unsigned short)f2bf(qa); KA[t * 136 + c] = (unsigned short)f2bf(ka); kav[i] = ka; }
          v4u pk; pk.x = pk2(kav[0], kav[1]); pk.y = pk2(kav[2], kav[3]); pk.z = pk2(kav[4], kav[5]); pk.w = pk2(kav[6], kav[7]); *(LAS v4u*)(KAT + c * 40 + 8 * tq) = pk;
          v4u pv; pv.x = pk2(vi[0], vi[1]); pv.y = pk2(vi[2], vi[3]); pv.z = pk2(vi[4], vi[5]); pv.w = pk2(vi[6], vi[7]); *(LAS v4u*)(VT + c * 40 + 8 * tq) = pv;
          if (tq == 0) { EGM[c] = __expf(gm); EGL[c] = __expf(gl - gm); } }
        __syncthreads();
        {
#pragma unroll
            for (int q4 = 0; q4 < 4; ++q4) { const f32x4 e0 = *(const LAS f32x4*)(EGM + 64 * kh + 8 * q4 + 4 * hh), e1 = *(const LAS f32x4*)(EGM + 64 * kh + 32 + 8 * q4 + 4 * hh);
#pragma unroll
                for (int j = 0; j < 4; ++j) { S0[4 * q4 + j] *= e0[j]; S1[4 * q4 + j] *= e1[j]; } }
            __builtin_amdgcn_sched_barrier(0);
            f32x16 o;
#pragma unroll
            for (int i = 0; i < 16; ++i) o[i] = 0.f;
            const LAS unsigned char* qa_row = Lb + HG_QA + r * 272;
            o = MFMA32(lds_frag8x2(qa_row + (64 * kh + 4 * hh) * 2), ACC_FRAG(S0, 0), o);
            o = MFMA32(lds_frag8x2(qa_row + (64 * kh + 16 + 4 * hh) * 2), ACC_FRAG(S0, 1), o);
            o = MFMA32(lds_frag8x2(qa_row + (64 * kh + 32 + 4 * hh) * 2), ACC_FRAG(S1, 0), o);
            o = MFMA32(lds_frag8x2(qa_row + (64 * kh + 48 + 4 * hh) * 2), ACC_FRAG(S1, 1), o);
            __builtin_amdgcn_sched_barrier(0);
            if (kh == 0) {
                f32x16 X;
#pragma unroll
                for (int i = 0; i < 16; ++i) X[i] = 0.f;
                const LAS unsigned char* ka_nat = Lb + HG_KA + r * 272 + hh * 16; const LAS unsigned char* qa_nat = Lb + HG_QA + r * 272 + hh * 16;
#pragma unroll 2
                for (int ks = 0; ks < 8; ++ks) X = MFMA32(lds_frag16(ka_nat + ks * 32), lds_frag16(qa_nat + ks * 32), X);
#pragma unroll
                for (int i = 0; i < 16; ++i) { const int srow = (i & 3) + 8 * (i >> 2) + 4 * hh; X[i] = (srow <= r) ? X[i] : 0.f; }
                const LAS unsigned char* vt_row = Lb + HG_VT + (32 * vt + r) * 80;
                o = MFMA32(ACC_FRAG(X, 0), lds_frag8x2(vt_row + (4 * hh) * 2), o);
                o = MFMA32(ACC_FRAG(X, 1), lds_frag8x2(vt_row + (16 + 4 * hh) * 2), o);
            }
            __builtin_amdgcn_sched_barrier(0);
            LAS float* ob = OB + (kh * 32) * 132 + 32 * vt + r;
#pragma unroll
            for (int i = 0; i < 16; ++i) ob[((i & 3) + 8 * (i >> 2) + 4 * hh) * 132] = o[i];
            __builtin_amdgcn_sched_barrier(0);
            const LAS unsigned char* kat_nat = Lb + HG_KAT + (64 * kh + r) * 80 + hh * 16; const LAS unsigned char* vt_nat = Lb + HG_VT + (32 * vt + r) * 80 + hh * 16;
#pragma unroll
            for (int s2 = 0; s2 < 2; ++s2) { const bf16x8 b = lds_frag16(vt_nat + s2 * 32); S0 = MFMA32(lds_frag16(kat_nat + s2 * 32), b, S0); S1 = MFMA32(lds_frag16(kat_nat + 32 * 80 + s2 * 32), b, S1); }
__builtin_amdgcn_sched_barrier(0);
#pragma unroll
            for (int q4 = 0; q4 < 4; ++q4) { const f32x4 e0 = *(const LAS f32x4*)(EGL + 64 * kh + 8 * q4 + 4 * hh), e1 = *(const LAS f32x4*)(EGL + 64 * kh + 32 + 8 * q4 + 4 * hh);
#pragma unroll
                for (int j = 0; j < 4; ++j) { S0[4 * q4 + j] *= e0[j]; S1[4 * q4 + j] *= e1[j]; } }
        }
        __syncthreads();
        { const int t = tid >> 4, v0 = (tid & 15) * 8;
          if (t0 + t < L) { const size_t row = row_base + t0 + t; float o[8]; float sq = 0.f;
            const f32x4 a0 = *(const LAS f32x4*)(OB + t * 132 + v0), a1 = *(const LAS f32x4*)(OB + t * 132 + v0 + 4), b0 = *(const LAS f32x4*)(OB + (32 + t) * 132 + v0), b1 = *(const LAS f32x4*)(OB + (32 + t) * 132 + v0 + 4);
#pragma unroll
            for (int j = 0; j < 4; ++j) { o[j] = a0[j] + b0[j]; o[4 + j] = a1[j] + b1[j]; }
#pragma unroll
            for (int j = 0; j < 8; ++j) sq += o[j] * o[j];
            sq += __shfl_xor(sq, 1); sq += __shfl_xor(sq, 2); sq += __shfl_xor(sq, 4); sq += __shfl_xor(sq, 8);
            const float rs = __builtin_amdgcn_rsqf(sq * (1.0f / 128.0f) + EPS);
            const v4u gw = *(const v4u*)(PROJ + (size_t)S_HG * SLOT_ELEMS + row * 1024 + hd * 128 + v0);
#pragma unroll
            for (int j = 0; j < 8; ++j) { const unsigned g16 = (gw[j >> 1] >> ((j & 1) * 16)) & 0xffffu; o[j] = o[j] * rs * silu_f(bf2f(g16)); }
            v4u ow; ow.x = pk2(o[0], o[1]); ow.y = pk2(o[2], o[3]); ow.z = pk2(o[4], o[5]); ow.w = pk2(o[6], o[7]);
            *(v4u*)(ON + row * 1024 + hd * 128 + v0) = ow; } }
        }
    }
#pragma unroll
    for (int i = 0; i < 16; ++i) { const int k = 64 * kh + (i & 3) + 8 * (i >> 2) + 4 * hh; st_g[(size_t)k * 128] = S0[i]; st_g[(size_t)(k + 32) * 128] = S1[i]; }
    __syncthreads();
}
constexpr int SD_BN = 0, SD_CN = 17408, SD_BT = 34816, SD_XT = 53248, SD_HT = 62464, SD_YB = 97280, SD_CUM = 114688, SD_DTV = 114944, SD_ECUM = 115200;
__device__ __forceinline__ void ssd_unit_mfma(Frame& F, int gb, int h) {
    const int tid = F.tid, lane = F.lane, w = F.wave, r = lane & 31, hh = lane >> 5; unsigned char* ws = F.ws;
    const bool prompt = gb < NBP; const int L = prompt ? SEQ : LS; const int sb = gb - NBP; const size_t row_base = prompt ? (size_t)gb * SEQ : (size_t)TP + (size_t)sb * LS;
    const int g = h >> 3;
    LAS unsigned char* Lb = F.lds + RING_OFF;
    LAS unsigned short* BN = (LAS unsigned short*)(Lb + SD_BN); LAS unsigned short* CN = (LAS unsigned short*)(Lb + SD_CN);
    LAS unsigned short* BT = (LAS unsigned short*)(Lb + SD_BT); LAS unsigned short* XT = (LAS unsigned short*)(Lb + SD_XT);
    LAS unsigned short* HT = (LAS unsigned short*)(Lb + SD_HT);
    LAS float* YB = (LAS float*)(Lb + SD_YB);
    LAS float* CUM = (LAS float*)(Lb + SD_CUM); LAS float* DTV = (LAS float*)(Lb + SD_DTV); LAS float* ECUM = (LAS float*)(Lb + SD_ECUM);
    const bf16* PROJ = (const bf16*)(ws + WS_PROJ); const float* DTR = (const float*)(ws + WS_DT); bf16* YG = (bf16*)(ws + WS_YG); float* SSQ = (float*)(ws + WS_SSQSSD);
    const int nt = w >> 1, pt = w & 1;
    f32x16 H;
    float* st_g = (prompt ? F.out + O_SSMP + (size_t)(gb * 32 + h) * 8192 : F.out + O_SSMS + (size_t)(sb * 32 + h) * 8192) + (size_t)(32 * pt + r) * 128 + 32 * nt + 4 * hh;
    if (prompt) {
#pragma unroll
        for (int i = 0; i < 16; ++i) H[i] = 0.f;
    } else { const float* sp = F.in[3] + (size_t)(sb * 32 + h) * 8192 + (size_t)(32 * pt + r) * 128 + 32 * nt + 4 * hh;
#pragma unroll
        for (int q4 = 0; q4 < 4; ++q4) { const f32x4 v = *(const f32x4*)(sp + 8 * q4); H[4 * q4] = v.x; H[4 * q4 + 1] = v.y; H[4 * q4 + 2] = v.z; H[4 * q4 + 3] = v.w; } }
    {
        LAS unsigned short* hp = HT + (32 * pt + r) * 136 + 32 * nt + 4 * hh;
#pragma unroll
        for (int q4 = 0; q4 < 4; ++q4) { v2u pk; pk.x = cvtpk_c(H[4 * q4], H[4 * q4 + 1]); pk.y = cvtpk_c(H[4 * q4 + 2], H[4 * q4 + 3]); *(LAS v2u*)(hp + 8 * q4) = pk; }
    }
    const float a = -__expf(F.in[13][h]), dtb = F.in[12][h], Dk = F.in[14][h];
    const float* cw = F.in[10]; const float* cbp = F.in[11]; const float* sconv = F.in[4] + (size_t)(prompt ? 0 : sb) * 3 * 3072;
    int buf = 0;
    for (int t0 = 0; t0 < L; t0 += 64, buf ^= 1) {
        int r_l = r, hh_l = hh, tid_l = tid, lane_l = lane;
        asm volatile("" : "+v"(r_l), "+v"(hh_l), "+v"(tid_l), "+v"(lane_l));
        { const int r = r_l, hh = hh_l, tid = tid_l, lane = lane_l;
        float dtv = 0.f;
        if (t0 + lane < L) { const float x = DTR[(row_base + t0 + lane) * 32 + h] + dtb; dtv = x > 20.f ? x : log1pf(__expf(x)); }
        float cum = dtv * a;
#pragma unroll
        for (int o = 1; o < 64; o <<= 1) { const float u = __shfl_up(cum, o); if (lane >= o) cum += u; }
        const float cum_last = __shfl(cum, 63);
        const float wgt = __expf(cum_last - cum) * dtv;
        if (w == 0) { CUM[lane] = cum; DTV[lane] = dtv; ECUM[lane] = __expf(cum); }
#pragma unroll 1
        for (int j = 0; j < 5; ++j) { const int task = tid + 512 * j; const int c = task % 320, seg = task / 320;
            const int col = c < 64 ? h * 64 + c : (c < 192 ? 2048 + g * 128 + (c - 64) : 2560 + g * 128 + (c - 192));
            const float w0 = cw[col], w1 = cw[3072 + col], w2 = cw[2 * 3072 + col], w3 = cw[3 * 3072 + col], cb = cbp[col];
            const bf16* cptr = PROJ + (size_t)(S_X0 + (col >> 10)) * SLOT_ELEMS + row_base * 1024 + (col & 1023);
            float wv[8];
#pragma unroll
            for (int i = 0; i < 8; ++i) wv[i] = __shfl(wgt, 8 * seg + i);
            float raw[11];
#pragma unroll
            for (int i = 0; i < 11; ++i) { const int gt = t0 + 8 * seg - 3 + i; float v = 0.f;
                if (gt >= 0 && gt < L) v = bf2f(cptr[(size_t)gt * 1024]); else if (gt < 0 && !prompt) v = sconv[(size_t)(3 + gt) * 3072 + col];
                raw[i] = v; }
            float o[8];
#pragma unroll
            for (int i = 0; i < 8; ++i) o[i] = silu_f(w0 * raw[i] + w1 * raw[i + 1] + w2 * raw[i + 2] + w3 * raw[i + 3] + cb);
            if (c < 64) { v4u pk; pk.x = pk2(o[0], o[1]); pk.y = pk2(o[2], o[3]); pk.z = pk2(o[4], o[5]); pk.w = pk2(o[6], o[7]); *(LAS v4u*)(XT + c * 72 + 8 * seg) = pk; }
            else if (c < 192) { const int n = c - 64; float ow[8];
#pragma unroll
                for (int i = 0; i < 8; ++i) { BN[(8 * seg + i) * 136 + n] = (unsigned short)f2bf(o[i]); ow[i] = o[i] * wv[i]; }
                v4u pk; pk.x = pk2(ow[0], ow[1]); pk.y = pk2(ow[2], ow[3]); pk.z = pk2(ow[4], ow[5]); pk.w = pk2(ow[6], ow[7]); *(LAS v4u*)(BT + n * 72 + 8 * seg) = pk; }
            else { const int n = c - 192;
#pragma unroll
                for (int i = 0; i < 8; ++i) CN[(8 * seg + i) * 136 + n] = (unsigned short)f2bf(o[i]); }
        }
        __syncthreads();
        if (w < 4) {
            const int tt = nt;
            f32x16 yi, ya;
#pragma unroll
            for (int i = 0; i < 16; ++i) { yi[i] = 0.f; ya[i] = 0.f; }
            const LAS unsigned char* cn_nat = Lb + SD_CN + (32 * tt + r) * 272 + hh * 16; const LAS unsigned char* ht_nat = Lb + SD_HT + buf * 17408 + (32 * pt + r) * 272 + hh * 16;
#pragma unroll 2
            for (int ks = 0; ks < 8; ++ks) yi = MFMA32(lds_frag16(cn_nat + ks * 32), lds_frag16(ht_nat + ks * 32), yi);
            const float cum_t = CUM[32 * tt + r];
#pragma unroll 1
            for (int st = 0; st <= tt; ++st) {
                f32x16 X;
#pragma unroll
                for (int i = 0; i < 16; ++i) X[i] = 0.f;
                const LAS unsigned char* bn_nat = Lb + SD_BN + (32 * st + r) * 272 + hh * 16;
#pragma unroll 2
                for (int ks = 0; ks < 8; ++ks) X = MFMA32(lds_frag16(bn_nat + ks * 32), lds_frag16(cn_nat + ks * 32), X);
#pragma unroll
                for (int q4 = 0; q4 < 4; ++q4) { const f32x4 cs = *(const LAS f32x4*)(CUM + 32 * st + 8 * q4 + 4 * hh), ds = *(const LAS f32x4*)(DTV + 32 * st + 8 * q4 + 4 * hh);
#pragma unroll
                    for (int jj = 0; jj < 4; ++jj) { const int s_abs = 32 * st + 8 * q4 + 4 * hh + jj; const float f = __expf(fminf(cum_t - cs[jj], 0.f)) * ds[jj]; X[4 * q4 + jj] = (s_abs <= 32 * tt + r) ? X[4 * q4 + jj] * f : 0.f; } }
                const LAS unsigned char* xt_row = Lb + SD_XT + (32 * pt + r) * 144 + (32 * st + 4 * hh) * 2;
                ya = MFMA32(ACC_FRAG(X, 0), lds_frag8x2(xt_row), ya);
                ya = MFMA32(ACC_FRAG(X, 1), lds_frag8x2(xt_row + 32), ya);
            }
            const LAS unsigned short* xt_p = XT + (32 * pt + r) * 72 + 32 * tt + 4 * hh;
#pragma unroll
            for (int q4 = 0; q4 < 4; ++q4) { const f32x4 ec = *(const LAS f32x4*)(ECUM + 32 * tt + 8 * q4 + 4 * hh); const v2u xw = *(const LAS v2u*)(xt_p + 8 * q4);
                const float x0 = bf2f(xw.x & 0xffffu), x1 = bf2f(xw.x >> 16), x2 = bf2f(xw.y & 0xffffu), x3 = bf2f(xw.y >> 16);
                LAS float* yb = YB + (32 * tt + 8 * q4 + 4 * hh) * 68 + 32 * pt + r;
                yb[0] = ya[4 * q4] + ec[0] * yi[4 * q4] + Dk * x0; yb[68] = ya[4 * q4 + 1] + ec[1] * yi[4 * q4 + 1] + Dk * x1;
                yb[136] = ya[4 * q4 + 2] + ec[2] * yi[4 * q4 + 2] + Dk * x2; yb[204] = ya[4 * q4 + 3] + ec[3] * yi[4 * q4 + 3] + Dk * x3; }
        }
        {
            const float el = __expf(CUM[63]);
#pragma unroll
            for (int i = 0; i < 16; ++i) H[i] *= el;
            const LAS unsigned char* bt_nat = Lb + SD_BT + (32 * nt + r) * 144 + hh * 16; const LAS unsigned char* xt_nat = Lb + SD_XT + (32 * pt + r) * 144 + hh * 16;
#pragma unroll
            for (int s2 = 0; s2 < 4; ++s2) H = MFMA32(lds_frag16(bt_nat + s2 * 32), lds_frag16(xt_nat + s2 * 32), H);
            LAS unsigned short* hp = HT + (buf ^ 1) * 8704 + (32 * pt + r) * 136 + 32 * nt + 4 * hh;
#pragma unroll
            for (int q4 = 0; q4 < 4; ++q4) { v2u pk; pk.x = cvtpk_c(H[4 * q4], H[4 * q4 + 1]); pk.y = cvtpk_c(H[4 * q4 + 2], H[4 * q4 + 3]); *(LAS v2u*)(hp + 8 * q4) = pk; }
        }
        __syncthreads();
        { const int tt = tid >> 3, p0 = (tid & 7) * 8;
          if (t0 + tt < L) { const size_t row = row_base + t0 + tt;
            const v4u zw = *(const v4u*)(PROJ + (size_t)(S_Z0 + (h >> 4)) * SLOT_ELEMS + row * 1024 + (h & 15) * 64 + p0);
            const f32x4 y0 = *(const LAS f32x4*)(YB + tt * 68 + p0), y1 = *(const LAS f32x4*)(YB + tt * 68 + p0 + 4);
            float o[8]; float sq = 0.f;
#pragma unroll
            for (int j = 0; j < 8; ++j) { const unsigned z16 = (zw[j >> 1] >> ((j & 1) * 16)) & 0xffffu; const float yv = (j < 4 ? y0[j & 3] : y1[j & 3]) * silu_f(bf2f(z16)); o[j] = yv; sq += yv * yv; }
            v4u ow; ow.x = pk2(o[0], o[1]); ow.y = pk2(o[2], o[3]); ow.z = pk2(o[4], o[5]); ow.w = pk2(o[6], o[7]);
            *(v4u*)(YG + row * 2048 + h * 64 + p0) = ow;
            sq += __shfl_xor(sq, 1); sq += __shfl_xor(sq, 2); sq += __shfl_xor(sq, 4);
            if ((tid & 7) == 0) SSQ[row * 32 + h] = sq; } }
        }
    }
#pragma unroll
    for (int q4 = 0; q4 < 4; ++q4) *(f32x4*)(st_g + 8 * q4) = (f32x4){H[4 * q4], H[4 * q4 + 1], H[4 * q4 + 2], H[4 * q4 + 3]};
    __syncthreads();
}
constexpr int U_HGP = NBP * 8, U_SSDP = NBP * 32, U_HGS = NBS * 8, U_SSDS = NBS * 32, U_CONV = NBP + NBS;
__device__ __forceinline__ void scan_phase(Frame& F) {
    gu32* head = F.ctl + CW_QUEUE;
    for (;;) {
        if (F.tid == 0) F.MISC[0] = __hip_atomic_fetch_add(head, 1u, RLX_AGENT);
        __syncthreads();
        const int u = (int)F.MISC[0];
        __syncthreads();
        if (u >= U_HGP + U_HGS) break;
        const int gb = u < U_HGP ? (u >> 3) : NBP + ((u - U_HGP) >> 3);
        hgrn_unit_mfma(F, gb, u & 7);
    }
    for (;;) {
        if (F.tid == 0) F.MISC[0] = __hip_atomic_fetch_add(head + 64, 1u, RLX_AGENT);
        __syncthreads();
        const int u = (int)F.MISC[0];
        __syncthreads();
        if (u >= U_SSDP + U_SSDS + U_CONV) break;
        if (u >= U_SSDP + U_SSDS) { conv_copy_unit(F, u - (U_SSDP + U_SSDS)); continue; }
        const int gb = u < U_SSDP ? (u >> 5) : NBP + ((u - U_SSDP) >> 5);
        ssd_unit_mfma(F, gb, u & 31);
    }
}
__device__ __forceinline__ void attn_prompt_wave(Frame& F, int rt, int hd) {
    typedef float f32x4v __attribute__((ext_vector_type(4)));
    const int lane = F.lane, fr = lane & 15, fq = lane >> 4; unsigned char* ws = F.ws;
    const int r0 = rt * 16, b = r0 / SEQ;
    const bf16* QB = (const bf16*)(ws + WS_QB); const bf16* KB = (const bf16*)(ws + WS_KB); const bf16* VT = (const bf16*)(ws + WS_VT); bf16* OB = (bf16*)(ws + WS_OB);
    bf16x8 qf[8];
    const bf16* qp = QB + (size_t)(r0 + fr) * 1024 + hd * 256 + 8 * fq;
#pragma unroll
    for (int s = 0; s < 8; ++s) qf[s] = *(const bf16x8*)(qp + 32 * s);
    f32x4v st[16];
    const bf16* kp = KB + (size_t)(b * 256 + fr) * 1024 + hd * 256 + 8 * fq;
#pragma unroll
    for (int tk = 0; tk < 16; ++tk) { f32x4v acc = (f32x4v){0.f, 0.f, 0.f, 0.f};
#pragma unroll
        for (int s = 0; s < 8; ++s) { const bf16x8 kf = *(const bf16x8*)(kp + (size_t)tk * 16 * 1024 + 32 * s); acc = __builtin_amdgcn_mfma_f32_16x16x32_bf16(kf, qf[s], acc, 0, 0, 0); }
        st[tk] = acc; }
    float m = -3.0e38f;
#pragma unroll
    for (int tk = 0; tk < 16; ++tk) m = fmaxf(fmaxf(m, fmaxf(st[tk][0], st[tk][1])), fmaxf(st[tk][2], st[tk][3]));
    m = fmaxf(m, __shfl_xor(m, 16)); m = fmaxf(m, __shfl_xor(m, 32));
    float l = 0.f;
#pragma unroll
    for (int tk = 0; tk < 16; ++tk) {
#pragma unroll
        for (int r = 0; r < 4; ++r) { const float pv = __builtin_amdgcn_exp2f(st[tk][r] - m); st[tk][r] = pv; l += pv; } }
    l += __shfl_xor(l, 16); l += __shfl_xor(l, 32);
    const float rl = 1.0f / l;
    bf16x8 pf[8];
#pragma unroll
    for (int s = 0; s < 8; ++s) { v4u w; w.x = pk2(st[2 * s][0], st[2 * s][1]); w.y = pk2(st[2 * s][2], st[2 * s][3]); w.z = pk2(st[2 * s + 1][0], st[2 * s + 1][1]); w.w = pk2(st[2 * s + 1][2], st[2 * s + 1][3]);
        pf[s] = __builtin_bit_cast(bf16x8, w); }
    const bf16* vp = VT + ((size_t)((b * 4 + hd) * 256 + fr)) * 256 + 4 * fq;
    bf16* op = OB + (size_t)(r0 + fr) * 1024 + hd * 256 + 4 * fq;
#pragma unroll 2
    for (int dt = 0; dt < 16; ++dt) { f32x4v acc = (f32x4v){0.f, 0.f, 0.f, 0.f};
#pragma unroll
        for (int s = 0; s < 8; ++s) { const v2u lo = *(const v2u*)(vp + (size_t)dt * 16 * 256 + 32 * s), hi = *(const v2u*)(vp + (size_t)dt * 16 * 256 + 32 * s + 16);
            const v4u w = (v4u){lo.x, lo.y, hi.x, hi.y}; acc = __builtin_amdgcn_mfma_f32_16x16x32_bf16(__builtin_bit_cast(bf16x8, w), pf[s], acc, 0, 0, 0); }
        v2u o; o.x = pk2(acc[0] * rl, acc[1] * rl); o.y = pk2(acc[2] * rl, acc[3] * rl); *(v2u*)(op + dt * 16) = o; }
}
__device__ __forceinline__ void attn_sample_unit(Frame& F, int sb, int hd) {
    const int tid = F.tid, lane = F.lane, w = F.wave; unsigned char* ws = F.ws;
    LAS float* sc = (LAS float*)(F.lds + RING_OFF);
    LAS float* red = sc + 4 * 256;
    const bf16* QB = (const bf16*)(ws + WS_QB); bf16* OB = (bf16*)(ws + WS_OB);
    const size_t rowq = (size_t)TP + (size_t)sb * LS;
    float q[4][4];
#pragma unroll
    for (int t = 0; t < 4; ++t) { const v2u qw = *(const v2u*)(QB + (rowq + t) * 1024 + hd * 256 + 4 * lane); q[t][0] = bf2f(qw.x & 0xffffu); q[t][1] = bf2f(qw.x >> 16); q[t][2] = bf2f(qw.y & 0xffffu); q[t][3] = bf2f(qw.y >> 16); }
    const float* Kc = F.in[6] + ((size_t)sb * 256 * 4 + hd) * 256 + 4 * lane; const float* Vc = F.in[7] + ((size_t)sb * 256 * 4 + hd) * 256 + 4 * lane;
    for (int kk = 0; kk < 32; ++kk) { const int key = w * 32 + kk; const f32x4 kv = *(const f32x4*)(Kc + (size_t)key * 1024);
#pragma unroll
        for (int t = 0; t < 4; ++t) { float s = (q[t][0] * kv.x + q[t][1] * kv.y) + (q[t][2] * kv.z + q[t][3] * kv.w); s = wave_sum(s); if (lane == 0) sc[t * 256 + key] = s; } }
    __syncthreads();
    if (w < 4) { float v[4]; float m = -3.0e38f;
#pragma unroll
        for (int j = 0; j < 4; ++j) { v[j] = sc[w * 256 + j * 64 + lane]; m = fmaxf(m, v[j]); }
        m = wave_max(m); float l = 0.f;
#pragma unroll
        for (int j = 0; j < 4; ++j) { v[j] = __builtin_amdgcn_exp2f(v[j] - m); l += v[j]; }
        l = wave_sum(l); const float rl = 1.0f / l;
#pragma unroll
        for (int j = 0; j < 4; ++j) sc[w * 256 + j * 64 + lane] = v[j] * rl; }
    __syncthreads();
    float o[4][4];
#pragma unroll
    for (int t = 0; t < 4; ++t)
#pragma unroll
        for (int e = 0; e < 4; ++e) o[t][e] = 0.f;
    for (int kk = 0; kk < 32; ++kk) { const int key = w * 32 + kk; const f32x4 vv = *(const f32x4*)(Vc + (size_t)key * 1024);
#pragma unroll
        for (int t = 0; t < 4; ++t) { const float pr = sc[t * 256 + key]; o[t][0] += pr * vv.x; o[t][1] += pr * vv.y; o[t][2] += pr * vv.z; o[t][3] += pr * vv.w; } }
#pragma unroll
    for (int t = 0; t < 4; ++t) *(LAS f32x4*)(red + (w * 4 + t) * 256 + 4 * lane) = (f32x4){o[t][0], o[t][1], o[t][2], o[t][3]};
    __syncthreads();
    { const int t = tid >> 7, d0 = (tid & 127) * 2; float a0 = 0.f, a1 = 0.f;
#pragma unroll
      for (int ww = 0; ww < 8; ++ww) { a0 += red[(ww * 4 + t) * 256 + d0]; a1 += red[(ww * 4 + t) * 256 + d0 + 1]; }
      *(unsigned*)(OB + (rowq + t) * 1024 + hd * 256 + d0) = pk2(a0, a1); }
    __syncthreads();
}
__device__ __forceinline__ void attn_phase(Frame& F) {
    const int gw = F.vcu * NWAVES + F.wave, NGW = F.G * NWAVES;
    for (int it = gw; it < (TP / 16) * 4; it += NGW) attn_prompt_wave(F, it >> 2, it & 3);
    for (int u = F.vcu; u < NBS * 4; u += F.G) attn_sample_unit(F, u >> 2, u & 3);
}
__device__ __forceinline__ void final_norm_phase(Frame& F) {
    const int gw = F.vcu * NWAVES + F.wave, NGW = F.G * NWAVES; const float* SSQ = (const float*)(F.ws + WS_SSQP3); const float* wn = F.in[31];
    f32x4 wv[4];
#pragma unroll
    for (int j = 0; j < 4; ++j) wv[j] = *((const f32x4*)wn + 64 * j + F.lane);
    for (int row = gw; row < T; row += NGW) {
        const f32x4* sp = (const f32x4*)(SSQ + (size_t)row * 16); float s = 0.f;
#pragma unroll
        for (int j = 0; j < 4; ++j) { const f32x4 a = sp[j]; s += (a.x + a.y) + (a.z + a.w); }
        const float rs = 1.0f / sqrtf(s * (1.0f / 1024.0f) + EPS);
        f32x4* p = (f32x4*)(F.out + O_Y + (size_t)row * 1024) + F.lane;
#pragma unroll
        for (int j = 0; j < 4; ++j) { const f32x4 v = p[64 * j]; p[64 * j] = v * rs * wv[j]; }
    }
}
#ifndef MK_N_LAUNCHES
#define MK_N_LAUNCHES 1
#endif
constexpr int PER_PHASE = 13;
constexpr int N_LAUNCHES = MK_N_LAUNCHES;
struct Args { const float* in[32]; float* out; unsigned char* ws; int ph_lo, ph_hi; };
__global__ void __launch_bounds__(NTHR, 2) skel_fwd(Args args) {
    extern __shared__ __attribute__((aligned(16))) unsigned char lds[];
    Frame F;
    F.lds = (LAS unsigned char*)lds;
    F.MISC = (volatile LAS unsigned*)(F.lds + MISC_OFF);
    F.tid = threadIdx.x; F.lane = F.tid & 63; F.wave = __builtin_amdgcn_readfirstlane(F.tid >> 6);
    F.G = gridDim.x; { const int bx = blockIdx.x; F.vcu = (F.G % 8 == 0) ? (bx % 8) * (F.G / 8) + bx / 8 : bx; }
    unsigned char* ws = args.ws; F.ws = ws; F.out = args.out;
    F.ctl = (gu32*)(ws + WS_CTL);
#pragma unroll
    for (int i = 0; i < 32; ++i) F.in[i] = args.in[i];
    for (int u = F.tid; u < (LDS_BYTES - LDSCTL_OFF) / 4; u += NTHR) ((LAS unsigned*)(F.lds + LDSCTL_OFF))[u] = 0u;
    __syncthreads();
    XcdBarrier bar; bar.bar = (unsigned*)(F.ctl + CW_BAR); bar.x = 0; bar.st = nullptr;
    if (N_LAUNCHES == 1) bar = xcd_barrier_post((unsigned*)(F.ctl + CW_BAR), F.MISC + 8);
#define GRID_BAR() do { if (N_LAUNCHES == 1) xcd_barrier(bar); } while (0)
    const int lo = args.ph_lo, hi = args.ph_hi;
#ifdef ONLY_PHASE
#define IN(k) ((k) == ONLY_PHASE && lo <= (k) && (k) < hi)
#else
#define IN(k) (lo <= (k) && (k) < hi)
#endif
#define BOTH(k) (IN(k) && IN((k) + 1))
    bf16* const XB = (bf16*)(ws + WS_XB); bf16* const PROJ = (bf16*)(ws + WS_PROJ);
    float* const Y = F.out + O_Y;
    if (IN(0)) { p0_prologue(F); if (BOTH(0)) GRID_BAR(); }
    if (IN(1)) {
        { pg8::Gemm g{XB, (const bf16*)(ws + WS_WIN), T, NPROJ, 1024}; pg8::StaticOrder S; S.init(T, NPROJ, F.G, (int)blockIdx.x);
          pg8::EpiScaleBf16<1, true> E{PROJ, SLOT_ELEMS, (const float*)(ws + WS_SSQX), 1.0f, (float*)(ws + WS_DT)};
          pg8::gemm_phase<pg8::EpiScaleBf16<1, true>, pg8::StaticOrder, true, true>(F.lds + RING_OFF, g, S, E); }
        { pg8::Gemm g{(const bf16*)(ws + WS_MNB), (const bf16*)(ws + WS_WKV), MEMR, 2048, 1024}; pg8::StaticOrder S; S.init(MEMR, 2048, F.G, (int)((blockIdx.x + 64) % F.G));
          pg8::EpiKV E{F.out + O_MKP, F.out + O_MVP, (bf16*)(ws + WS_KB), (bf16*)(ws + WS_VT), (const float*)(ws + WS_SSQM)};
          pg8::gemm_phase<pg8::EpiKV, pg8::StaticOrder, true, true>(F.lds + RING_OFF, g, S, E); }
        if (BOTH(1)) GRID_BAR();
    }
    if (IN(2)) { scan_phase(F); if (BOTH(2)) GRID_BAR(); }
    if (IN(3)) { ssdnorm_phase(F); if (BOTH(3)) GRID_BAR(); }
    if (IN(4)) { pg8::Gemm g{(const bf16*)(ws + WS_YG), (const bf16*)(ws + WS_WSSD), T, 1024, 2048}; pg8::StaticOrder S; S.init(T, 1024, F.G, (int)blockIdx.x);
        pg8::EpiGate<false> E{(bf16*)(ws + WS_MERGED), PROJ + (size_t)S_GS * SLOT_ELEMS};
        pg8::gemm_phase<pg8::EpiGate<false>, pg8::StaticOrder, true, true>(F.lds + RING_OFF, g, S, E);
        if (BOTH(4)) GRID_BAR(); }
    if (IN(5)) { pg8::Gemm g{(const bf16*)(ws + WS_ON), (const bf16*)(ws + WS_WHG), T, 1024, 1024}; pg8::StaticOrder S; S.init(T, 1024, F.G, (int)blockIdx.x);
        pg8::EpiGate<true> E{(bf16*)(ws + WS_MERGED), PROJ + (size_t)S_GH * SLOT_ELEMS};
        pg8::gemm_phase<pg8::EpiGate<true>, pg8::StaticOrder, true, true>(F.lds + RING_OFF, g, S, E);
        if (BOTH(5)) GRID_BAR(); }
    if (IN(6)) { pg8::Gemm g{(const bf16*)(ws + WS_MERGED), (const bf16*)(ws + WS_WOUT), T, 1024, 1024}; pg8::StaticOrder S; S.init(T, 1024, F.G, (int)blockIdx.x);
        pg8::EpiRes E{F.in[0], F.in[1] - (size_t)TP * 1024, Y, (bf16*)(ws + WS_HB), (float*)(ws + WS_SSQP1)};
        pg8::gemm_phase<pg8::EpiRes, pg8::StaticOrder, true, true>(F.lds + RING_OFF, g, S, E);
        if (BOTH(6)) GRID_BAR(); }
    if (IN(7)) { pg8::Gemm g{(const bf16*)(ws + WS_HB), (const bf16*)(ws + WS_WCQ), T, 1024, 1024}; pg8::StaticOrder S; S.init(T, 1024, F.G, (int)blockIdx.x);
        pg8::EpiScaleBf16<16, false> E{(bf16*)(ws + WS_QB), SLOT_ELEMS, (const float*)(ws + WS_SSQP1), QSCALE, nullptr};
        pg8::gemm_phase<pg8::EpiScaleBf16<16, false>, pg8::StaticOrder, true, true>(F.lds + RING_OFF, g, S, E);
        if (BOTH(7)) GRID_BAR(); }
    if (IN(8)) { attn_phase(F); if (BOTH(8)) GRID_BAR(); }
    if (IN(9)) { pg8::Gemm g{(const bf16*)(ws + WS_OB), (const bf16*)(ws + WS_WCO), T, 1024, 1024}; pg8::StaticOrder S; S.init(T, 1024, F.G, (int)blockIdx.x);
        pg8::EpiRes E{Y, Y, Y, (bf16*)(ws + WS_HB), (float*)(ws + WS_SSQP2)};
        pg8::gemm_phase<pg8::EpiRes, pg8::StaticOrder, true, true>(F.lds + RING_OFF, g, S, E);
        if (BOTH(9)) GRID_BAR(); }
    if (IN(10)) { pg8::Gemm g{(const bf16*)(ws + WS_HB), (const bf16*)(ws + WS_WGU), T, 2 * FFN, 1024}; pg8::StaticOrder S; S.init(T, 2 * FFN, F.G, (int)blockIdx.x);
        pg8::EpiSwiglu E{(bf16*)(ws + WS_ACT), (const float*)(ws + WS_SSQP2)};
        pg8::gemm_phase<pg8::EpiSwiglu, pg8::StaticOrder, true, true>(F.lds + RING_OFF, g, S, E);
        if (BOTH(10)) GRID_BAR(); }
    if (IN(11)) { pg8::Gemm g{(const bf16*)(ws + WS_ACT), (const bf16*)(ws + WS_WDN), T, 1024, FFN}; pg8::StaticOrder S; S.init(T, 1024, F.G, (int)blockIdx.x);
        pg8::EpiRes E{Y, Y, Y, nullptr, (float*)(ws + WS_SSQP3)};
        pg8::gemm_phase<pg8::EpiRes, pg8::StaticOrder, true, true>(F.lds + RING_OFF, g, S, E);
        if (BOTH(11)) GRID_BAR(); }
    if (IN(12)) final_norm_phase(F);
#undef IN
#undef BOTH
}

extern "C" void kernel_launch(void* const* d_in, const int* in_sizes, int n_in, void* d_out, int out_size, void* d_ws, size_t ws_size, hipStream_t stream) {
    static int grid = 0;
    if (grid == 0) {
        const int want[32] = {TP * 1024, TS * 1024, MEMR * 1024, 33554432, 1179648, 16777216, 33554432, 33554432, 1024, 1024 * 11296, 4 * 3072, 3072, 32, 32, 32, 2048, 2048 * 1024, 2048, 1024,
                              1024 * 1024, 1024 * 1024, 1024, 1024, 1024 * 1024, 1024 * 1024, 1024 * 1024, 1024 * 1024, 1024, 1024 * FFN, 1024 * FFN, FFN * 1024, 1024};
        bool ok = (n_in == 32); for (int i = 0; ok && i < 32; ++i) if (in_sizes[i] != want[i]) { fprintf(stderr, "kernel_launch: input %d has %d elements, expected %d\n", i, in_sizes[i], want[i]); ok = false; }
        if (!ok || out_size != (int)O_END || ws_size < WS_END) { fprintf(stderr, "kernel_launch: unexpected shapes: n_in %d out %d ws %zu\n", n_in, out_size, ws_size); grid = -1; return; }
        int dev = 0, cus = 0, per_cu = 0;
        if (hipGetDevice(&dev) != hipSuccess || hipDeviceGetAttribute(&cus, hipDeviceAttributeMultiprocessorCount, dev) != hipSuccess) { grid = -1; return; }
        if (hipFuncSetAttribute((const void*)skel_fwd, hipFuncAttributeMaxDynamicSharedMemorySize, LDS_BYTES) != hipSuccess) { fprintf(stderr, "kernel_launch: hipFuncSetAttribute failed\n"); grid = -1; return; }
        if (hipOccupancyMaxActiveBlocksPerMultiprocessor(&per_cu, (const void*)skel_fwd, NTHR, LDS_BYTES) != hipSuccess || per_cu < 1) fprintf(stderr, "kernel_launch: occupancy query reports %d blocks per CU\n", per_cu);
        (void)hipGetLastError();
        grid = cus;
    }
    if (grid < 0) return;
    (void)hipMemsetAsync((char*)d_ws + WS_CTL, 0, CTL_ZERO_BYTES, stream);
    Args a{};
    for (int i = 0; i < 32; ++i) a.in[i] = (const float*)d_in[i];
    a.out = (float*)d_out; a.ws = (unsigned char*)d_ws;
    for (int li = 0; li < N_LAUNCHES; ++li) {
        a.ph_lo = (N_LAUNCHES == PER_PHASE) ? li : 0; a.ph_hi = (N_LAUNCHES == PER_PHASE) ? li + 1 : PER_PHASE;
        hipLaunchKernelGGL(skel_fwd, dim3(grid), dim3(NTHR), LDS_BYTES, stream, a);
    }
}
```

```cpp
#include <hip/hip_runtime.h>
#include <cstdio>
#include <cstdint>
namespace pg8 {
#define PG8_LAS __attribute__((address_space(3)))
typedef unsigned short bf16_t;
typedef short bf16x8 __attribute__((ext_vector_type(8)));
typedef float f32x4 __attribute__((ext_vector_type(4)));
typedef unsigned u32x4 __attribute__((ext_vector_type(4)));
constexpr int BM = 256, BK = 64, HALF = 128, HTB = HALF * BK * 2  , STAGE_BYTES = 8 * HTB, NXCD = 8, WGM = 8;

__host__ __device__ __forceinline__ int lds_byte(int r, int c) { const int st = (r >> 4) * 2 + (c >> 5), rr = r & 15, cc = c & 31, ob = rr * 64 + cc * 2; return st * 1024 + (ob ^ (((ob >> 9) & 1) << 5)); }
__host__ __device__ __forceinline__ void stage_rc(int b, int& R, int& C) { const int st = b / 1024, sb = b % 1024, swz = sb ^ (((sb >> 9) & 1) << 5); R = (st >> 1) * 16 + swz / 64; C = (st & 1) * 32 + (swz % 64) / 2; }
__host__ __device__ __forceinline__ int perm32(int rho) { const int n = rho >> 4, i = rho & 15; return 8 * (i >> 2) + 4 * n + (i & 3); }

struct Unit { int pm, pn; };
struct Gemm { const bf16_t* A; const bf16_t* Bt; int M, N, K; };

struct StaticOrder {
    int nM, nN, nwg, G, c;
    __host__ __device__ void init(int M, int N, int G_, int c_) { nM = M / BM; nN = N / BM; nwg = nM * nN; G = G_; c = c_; }
    __host__ __device__ bool next(int i, Unit& u) const {
        const long L = (long)i * G + c; if (L >= nwg) return false;
        int wgid = (int)L; { const int q = nwg / NXCD, r = nwg % NXCD, xcd = wgid % NXCD, off = wgid / NXCD; wgid = (xcd < r ? xcd * (q + 1) : r * (q + 1) + (xcd - r) * q) + off; }
        const int nig = WGM * nN, gid = wgid / nig, fm = gid * WGM, gsz = (nM - fm) < WGM ? (nM - fm) : WGM;
        u.pm = fm + ((wgid % nig) % gsz); u.pn = (wgid % nig) / gsz; return true;
    }
    __device__ __forceinline__ void a_ready(const Unit&) const {}
    __device__ __forceinline__ void done(const Unit&) const {}
};

__device__ __forceinline__ unsigned cvt_pk_bf16(float lo, float hi) { unsigned r; asm volatile("v_cvt_pk_bf16_f32 %0, %1, %2" : "=v"(r) : "v"(lo), "v"(hi)); return r; }
typedef float f32x2 __attribute__((ext_vector_type(2)));
typedef unsigned u32x2 __attribute__((ext_vector_type(2)));
constexpr float RMS_EPS = 1e-6f;
__device__ __forceinline__ float bfbits2f(unsigned v16) { return __uint_as_float(v16 << 16); }
__device__ __forceinline__ float sigm(float x) { return __builtin_amdgcn_rcpf(1.0f + __expf(-x)); }
template <int NP> __device__ __forceinline__ float row_rs(const float* ssq, int row) {
    float s = 0.f;
    if constexpr (NP == 1) s = ssq[row];
    else {
#pragma unroll
        for (int i = 0; i < NP / 4; ++i) { const f32x4 v = *(const f32x4*)(ssq + (size_t)row * NP + 4 * i); s += (v[0] + v[1]) + (v[2] + v[3]); }
    }
    return 1.0f / sqrtf(s * (1.0f / 1024.0f) + RMS_EPS);
}
template <int NP, bool HAS_DT> struct EpiScaleBf16 {
    static constexpr bool PERM = true, AFTER_DRAIN = false;
    bf16_t* O; size_t slot_elems; const float* ssq; float scale; float* dt;
    __device__ __forceinline__ void operator()(const f32x4 (&acc)[2][2][4][2], const Unit& u, int wr, int wc, int fr, int fq) const {
        const int row0 = u.pm * BM + wr * 64 + fr;
        if (HAS_DT && u.pn == 44) {
            if (wc == 0) {
#pragma unroll
                for (int ai = 0; ai < 2; ++ai)
#pragma unroll
                    for (int m = 0; m < 4; ++m) { const int row = row0 + ai * HALF + m * 16; const float rs = row_rs<NP>(ssq, row);
                        float* p = dt + (size_t)row * 32 + 8 * fq; *(f32x4*)p = acc[ai][0][m][0] * rs; *(f32x4*)(p + 4) = acc[ai][0][m][1] * rs; }
            }
            return;
        }
        bf16_t* base = O + (size_t)(u.pn >> 2) * slot_elems; const int col0 = (u.pn & 3) * BM + wc * 32 + 8 * fq;
#pragma unroll
        for (int ai = 0; ai < 2; ++ai)
#pragma unroll
            for (int m = 0; m < 4; ++m) { const int row = row0 + ai * HALF + m * 16; const float rs = row_rs<NP>(ssq, row) * scale; bf16_t* rowp = base + (size_t)row * 1024 + col0;
#pragma unroll
                for (int bj = 0; bj < 2; ++bj) { const f32x4 v0 = acc[ai][bj][m][0] * rs, v1 = acc[ai][bj][m][1] * rs;
                    u32x4 w; w.x = cvt_pk_bf16(v0[0], v0[1]); w.y = cvt_pk_bf16(v0[2], v0[3]); w.z = cvt_pk_bf16(v1[0], v1[1]); w.w = cvt_pk_bf16(v1[2], v1[3]);
                    *(u32x4*)(rowp + bj * HALF) = w; } }
    }
};
struct EpiKV {
    static constexpr bool PERM = false, AFTER_DRAIN = false;
    float* mk; float* mv; bf16_t* kb; bf16_t* vt; const float* ssq;
    __device__ __forceinline__ void operator()(const f32x4 (&acc)[2][2][4][2], const Unit& u, int wr, int wc, int fr, int fq) const {
        const int row0 = u.pm * BM + wr * 64 + fr; const bool isv = u.pn >= 4; const int colt = (u.pn & 3) * BM + wc * 32 + 4 * fq;
#pragma unroll
        for (int ai = 0; ai < 2; ++ai)
#pragma unroll
            for (int m = 0; m < 4; ++m) { const int row = row0 + ai * HALF + m * 16; const float rs = row_rs<1>(ssq, row);
#pragma unroll
                for (int bj = 0; bj < 2; ++bj)
#pragma unroll
                    for (int n = 0; n < 2; ++n) { const int c = colt + bj * HALF + n * 16; const f32x4 v = acc[ai][bj][m][n] * rs;
                        if (!isv) { *(f32x4*)(mk + (size_t)row * 1024 + c) = v; u32x2 w; w.x = cvt_pk_bf16(v[0], v[1]); w.y = cvt_pk_bf16(v[2], v[3]); *(u32x2*)(kb + (size_t)row * 1024 + c) = w; }
                        else { *(f32x4*)(mv + (size_t)row * 1024 + c) = v; const int b = row >> 8, key = row & 255, hd = c >> 8, d = c & 255;
                            bf16_t* p = vt + ((size_t)((b * 4 + hd) * 256 + d)) * 256 + key; const unsigned w0 = cvt_pk_bf16(v[0], v[1]), w1 = cvt_pk_bf16(v[2], v[3]);
                            p[0] = (bf16_t)(w0 & 0xffffu); p[256] = (bf16_t)(w0 >> 16); p[512] = (bf16_t)(w1 & 0xffffu); p[768] = (bf16_t)(w1 >> 16); } } }
    }
};
template <bool ADD> struct EpiGate {
    static constexpr bool PERM = true, AFTER_DRAIN = false;
    bf16_t* O; const bf16_t* gate;
    __device__ __forceinline__ void operator()(const f32x4 (&acc)[2][2][4][2], const Unit& u, int wr, int wc, int fr, int fq) const {
        const int row0 = u.pm * BM + wr * 64 + fr, col0 = u.pn * BM + wc * 32 + 8 * fq;
#pragma unroll
        for (int ai = 0; ai < 2; ++ai)
#pragma unroll
            for (int m = 0; m < 4; ++m) { const size_t off = (size_t)(row0 + ai * HALF + m * 16) * 1024 + col0;
#pragma unroll
                for (int bj = 0; bj < 2; ++bj) { const u32x4 gw = *(const u32x4*)(gate + off + bj * HALF); u32x4 ow = (u32x4){0u, 0u, 0u, 0u}; if (ADD) ow = *(const u32x4*)(O + off + bj * HALF);
                    float r[8];
#pragma unroll
                    for (int e = 0; e < 8; ++e) { const unsigned g16 = (gw[e >> 1] >> ((e & 1) * 16)) & 0xffffu, o16 = (ow[e >> 1] >> ((e & 1) * 16)) & 0xffffu;
                        const float a = acc[ai][bj][m][e >> 2][e & 3]; r[e] = (ADD ? bfbits2f(o16) : 0.f) + sigm(bfbits2f(g16)) * a; }
                    u32x4 w; w.x = cvt_pk_bf16(r[0], r[1]); w.y = cvt_pk_bf16(r[2], r[3]); w.z = cvt_pk_bf16(r[4], r[5]); w.w = cvt_pk_bf16(r[6], r[7]);
                    *(u32x4*)(O + off + bj * HALF) = w; } }
    }
};
struct EpiRes {
    static constexpr bool PERM = false, AFTER_DRAIN = false;
    const float* base0; const float* base1; float* out; bf16_t* hb; float* ssqp;
    __device__ __forceinline__ void operator()(const f32x4 (&acc)[2][2][4][2], const Unit& u, int wr, int wc, int fr, int fq) const {
        const int row0 = u.pm * BM + wr * 64 + fr, col0 = u.pn * BM + wc * 32 + 4 * fq; const float* base = u.pm < 64 ? base0 : base1;
#pragma unroll
        for (int ai = 0; ai < 2; ++ai)
#pragma unroll
            for (int m = 0; m < 4; ++m) { const int row = row0 + ai * HALF + m * 16; const size_t off = (size_t)row * 1024 + col0; float sq = 0.f;
#pragma unroll
                for (int bj = 0; bj < 2; ++bj)
#pragma unroll
                    for (int n = 0; n < 2; ++n) { const size_t o2 = off + bj * HALF + n * 16; const f32x4 v = *(const f32x4*)(base + o2) + acc[ai][bj][m][n];
                        *(f32x4*)(out + o2) = v; sq += (v[0] * v[0] + v[1] * v[1]) + (v[2] * v[2] + v[3] * v[3]);
                        if (hb) { u32x2 w; w.x = cvt_pk_bf16(v[0], v[1]); w.y = cvt_pk_bf16(v[2], v[3]); *(u32x2*)(hb + o2) = w; } }
                sq += __shfl_xor(sq, 16); sq += __shfl_xor(sq, 32);
                if (fq == 0) ssqp[(size_t)row * 16 + u.pn * 4 + wc] = sq; }
    }
};
struct EpiSwiglu {
    static constexpr bool PERM = true, AFTER_DRAIN = false;
    bf16_t* act; const float* ssq;
    __device__ __forceinline__ void operator()(const f32x4 (&acc)[2][2][4][2], const Unit& u, int wr, int wc, int fr, int fq) const {
        const int row0 = u.pm * BM + wr * 64 + fr, col0 = u.pn * 128 + wc * 16 + 4 * fq;
#pragma unroll
        for (int ai = 0; ai < 2; ++ai)
#pragma unroll
            for (int m = 0; m < 4; ++m) { const int row = row0 + ai * HALF + m * 16; const float rs = row_rs<16>(ssq, row);
#pragma unroll
                for (int bj = 0; bj < 2; ++bj) { const f32x4 a = acc[ai][bj][m][0] * rs, b = acc[ai][bj][m][1] * rs;
                    const float r0 = a[0] * sigm(a[0]) * a[1], r1 = a[2] * sigm(a[2]) * a[3], r2 = b[0] * sigm(b[0]) * b[1], r3 = b[2] * sigm(b[2]) * b[3];
                    u32x2 w; w.x = cvt_pk_bf16(r0, r1); w.y = cvt_pk_bf16(r2, r3); *(u32x2*)(act + (size_t)row * 2816 + col0 + bj * 64) = w; } }
    }
};
template <class Epi, class Sched, bool ALIGN_EPI = false, bool SP2 = false>
__device__ __forceinline__ void gemm_phase(PG8_LAS unsigned char* lds, const Gemm g, const Sched& S, const Epi& E) {
    const int tid = threadIdx.x, wid = __builtin_amdgcn_readfirstlane(tid >> 6), lane = tid & 63, wr = wid >> 2, wc = wid & 3, fr = lane & 15, fq = lane >> 4;
    const int K = g.K, nt = K / BK;
    unsigned voffA[2], voffB[2];
#pragma unroll
    for (int i = 0; i < 2; ++i) { int R, C; stage_rc(tid * 16 + i * 8192, R, C); const int Rb = Epi::PERM ? ((R & ~31) + perm32(R & 31)) : R;
        voffA[i] = (unsigned)(R * K + C) * 2u; voffB[i] = (unsigned)(Rb * K + C) * 2u; }
    const size_t kstep = (size_t)(BK * 2);
    const size_t hstep = (size_t)HALF * K * 2;
    const size_t tstep = 2 * hstep;
    const unsigned ldsw = (unsigned)wid * 1024u;
    const int aoff = lds_byte(wr * 64 + fr, fq * 8), boff = lds_byte(wc * 32 + fr, fq * 8);
#define PG8_SA(b, h) (((b) * 2 + (h)) * HTB)
#define PG8_SB(b, h) ((4 + (b) * 2 + (h)) * HTB)
#define PG8_STAGE(bufoff, gbase, voff) do { _Pragma("unroll") for (int _i = 0; _i < 2; ++_i) \
        __builtin_amdgcn_global_load_lds((const unsigned*)((const char*)(gbase) + (voff)[_i]), (PG8_LAS unsigned*)(lds + (bufoff) + ldsw + _i * 8192), 16, 0, 0); } while (0)
#define PG8_LDA(dst, b, h) do { _Pragma("unroll") for (int m = 0; m < 4; ++m) _Pragma("unroll") for (int k = 0; k < 2; ++k) dst[m][k] = *(const PG8_LAS bf16x8*)(lds + PG8_SA(b, h) + aoff + m * 2048 + k * 1024); } while (0)
#define PG8_LDB(dst, b, h) do { _Pragma("unroll") for (int n = 0; n < 2; ++n) _Pragma("unroll") for (int k = 0; k < 2; ++k) dst[n][k] = *(const PG8_LAS bf16x8*)(lds + PG8_SB(b, h) + boff + n * 2048 + k * 1024); } while (0)
#define PG8_MMA(ai, bj, At, Bt) do { __builtin_amdgcn_s_setprio(1); _Pragma("unroll") for (int m = 0; m < 4; ++m) _Pragma("unroll") for (int n = 0; n < 2; ++n) _Pragma("unroll") for (int k = 0; k < 2; ++k) \
        acc[ai][bj][m][n] = __builtin_amdgcn_mfma_f32_16x16x32_bf16(Bt[n][k], At[m][k], acc[ai][bj][m][n], 0, 0, 0); __builtin_amdgcn_s_setprio(0); } while (0)
#define PG8_WAIT_V(n) asm volatile("s_waitcnt vmcnt(" #n ")" ::: "memory")
#define PG8_WAIT_L(n) asm volatile("s_waitcnt lgkmcnt(" #n ")" ::: "memory")
#define PG8_BAR __builtin_amdgcn_s_barrier()
#define PG8_SCHED __builtin_amdgcn_sched_barrier(0)
    Unit cur, nxt; int ui = 0;
    if (!S.next(0, cur)) return;
    f32x4 acc[2][2][4][2];
#pragma unroll
    for (int a = 0; a < 2; ++a)
#pragma unroll
        for (int b = 0; b < 2; ++b)
#pragma unroll
            for (int m = 0; m < 4; ++m)
#pragma unroll
                for (int n = 0; n < 2; ++n) acc[a][b][m][n] = (f32x4){0.f, 0.f, 0.f, 0.f};
    bf16x8 At[4][2], B0[2][2], B1[2][2];
    const char* cA = (const char*)g.A + (size_t)cur.pm * tstep; const char* cB = (const char*)g.Bt + (size_t)cur.pn * tstep;
    S.a_ready(cur);
    if constexpr (SP2) {
        PG8_STAGE(PG8_SB(0, 0), cB, voffB); PG8_STAGE(PG8_SB(0, 1), cB + hstep, voffB); PG8_STAGE(PG8_SA(0, 0), cA, voffA); PG8_STAGE(PG8_SA(0, 1), cA + hstep, voffA);
        if (wr == 1) PG8_BAR;
        PG8_WAIT_V(2); PG8_BAR;
        PG8_STAGE(PG8_SB(1, 0), cB + kstep, voffB); PG8_STAGE(PG8_SA(1, 0), cA + kstep, voffA); PG8_STAGE(PG8_SB(1, 1), cB + hstep + kstep, voffB);
        PG8_WAIT_V(6); PG8_BAR;
    } else {
        PG8_STAGE(PG8_SB(0, 0), cB, voffB); PG8_STAGE(PG8_SA(0, 0), cA, voffA); PG8_STAGE(PG8_SB(0, 1), cB + hstep, voffB); PG8_STAGE(PG8_SA(0, 1), cA + hstep, voffA);
        if (wr == 1) PG8_BAR;
        PG8_WAIT_V(4); PG8_BAR;
        PG8_STAGE(PG8_SB(1, 0), cB + kstep, voffB); PG8_STAGE(PG8_SA(1, 0), cA + kstep, voffA); PG8_STAGE(PG8_SB(1, 1), cB + hstep + kstep, voffB);
        PG8_WAIT_V(6); PG8_BAR;
    }
    for (;;) {
        const bool has_next = S.next(ui + 1, nxt);
        const char* nA = has_next ? (const char*)g.A + (size_t)nxt.pm * tstep : cA; const char* nB = has_next ? (const char*)g.Bt + (size_t)nxt.pn * tstep : cB;
        for (int t = 0; t < nt; t += 2) {
            const bool last = (t == nt - 2);
            const char* a1 = cA + (size_t)(t + 1) * kstep;
            const char* a2 = last ? nA : cA + (size_t)(t + 2) * kstep; const char* b2 = last ? nB : cB + (size_t)(t + 2) * kstep;
            const char* a3 = a2 + kstep; const char* b3 = b2 + kstep;
            if (last && has_next) S.a_ready(nxt);
            if constexpr (SP2) {
            PG8_LDB(B0, 0, 0); PG8_LDB(B1, 0, 1); PG8_SCHED; PG8_LDA(At, 0, 0); PG8_STAGE(PG8_SA(1, 1), a1 + hstep, voffA);
            PG8_WAIT_V(8); PG8_WAIT_L(0); PG8_BAR; PG8_MMA(0, 0, At, B0); PG8_MMA(0, 1, At, B1); PG8_BAR; PG8_SCHED;
            PG8_LDA(At, 0, 1); PG8_STAGE(PG8_SB(0, 0), b2, voffB); PG8_STAGE(PG8_SB(0, 1), b2 + hstep, voffB); PG8_STAGE(PG8_SA(0, 0), a2, voffA);
            PG8_WAIT_V(8); PG8_WAIT_L(0); PG8_BAR; PG8_MMA(1, 0, At, B0); PG8_MMA(1, 1, At, B1); PG8_BAR; PG8_SCHED;
            PG8_LDB(B0, 1, 0); PG8_LDB(B1, 1, 1); PG8_SCHED; PG8_LDA(At, 1, 0); PG8_STAGE(PG8_SA(0, 1), a2 + hstep, voffA);
            PG8_WAIT_V(8); PG8_WAIT_L(0); PG8_BAR; PG8_MMA(0, 0, At, B0); PG8_MMA(0, 1, At, B1); PG8_BAR; PG8_SCHED;
            PG8_LDA(At, 1, 1); PG8_STAGE(PG8_SB(1, 0), b3, voffB); PG8_STAGE(PG8_SB(1, 1), b3 + hstep, voffB); PG8_STAGE(PG8_SA(1, 0), a3, voffA);
            PG8_WAIT_V(8); PG8_WAIT_L(0); PG8_BAR; PG8_MMA(1, 0, At, B0); PG8_MMA(1, 1, At, B1); PG8_BAR; PG8_SCHED;
            } else {
            PG8_LDB(B0, 0, 0); PG8_SCHED; PG8_LDA(At, 0, 0); PG8_STAGE(PG8_SA(1, 1), a1 + hstep, voffA);
            PG8_WAIT_L(8); PG8_BAR; PG8_WAIT_L(0); PG8_MMA(0, 0, At, B0); PG8_BAR; PG8_SCHED;
            PG8_LDB(B1, 0, 1); PG8_STAGE(PG8_SB(0, 0), b2, voffB);
            PG8_BAR; PG8_WAIT_L(0); PG8_MMA(0, 1, At, B1); PG8_BAR;
            PG8_LDA(At, 0, 1); PG8_STAGE(PG8_SA(0, 0), a2, voffA);
            PG8_BAR; PG8_WAIT_L(0); PG8_MMA(1, 0, At, B0); PG8_BAR; PG8_SCHED;
            PG8_STAGE(PG8_SB(0, 1), b2 + hstep, voffB);
            PG8_WAIT_V(6); PG8_BAR; PG8_MMA(1, 1, At, B1); PG8_BAR;
            PG8_LDB(B0, 1, 0); PG8_SCHED; PG8_LDA(At, 1, 0); PG8_STAGE(PG8_SA(0, 1), a2 + hstep, voffA);
            PG8_WAIT_L(8); PG8_BAR; PG8_WAIT_L(0); PG8_MMA(0, 0, At, B0); PG8_BAR; PG8_SCHED;
            PG8_LDB(B1, 1, 1); PG8_STAGE(PG8_SB(1, 0), b3, voffB);
            PG8_BAR; PG8_WAIT_L(0); PG8_MMA(0, 1, At, B1); PG8_BAR;
            PG8_LDA(At, 1, 1); PG8_STAGE(PG8_SA(1, 0), a3, voffA);
            PG8_BAR; PG8_WAIT_L(0); PG8_MMA(1, 0, At, B0); PG8_BAR; PG8_SCHED;
            PG8_STAGE(PG8_SB(1, 1), b3 + hstep, voffB);
            PG8_WAIT_V(6); PG8_BAR; PG8_MMA(1, 1, At, B1); PG8_BAR;
            }
        }
        if constexpr (ALIGN_EPI) { if (wr == 0) PG8_BAR; }
        if constexpr (!Epi::AFTER_DRAIN) { E(acc, cur, wr, wc, fr, fq); S.done(cur); }
        if (!has_next) break;
#pragma unroll
        for (int a = 0; a < 2; ++a)
#pragma unroll
            for (int b = 0; b < 2; ++b)
#pragma unroll
                for (int m = 0; m < 4; ++m)
#pragma unroll
                    for (int n = 0; n < 2; ++n) acc[a][b][m][n] = (f32x4){0.f, 0.f, 0.f, 0.f};
        cur = nxt; cA = nA; cB = nB; ++ui;
        if constexpr (ALIGN_EPI) { if (wr == 1) PG8_BAR; }
    }
    PG8_WAIT_V(0);
    if constexpr (!ALIGN_EPI) { if (wr == 0) PG8_BAR; }
    PG8_BAR;
    if constexpr (Epi::AFTER_DRAIN) { E.fused(acc, cur, wr, wc, fr, fq, lds, wid, lane); S.done(cur); }
#undef PG8_SA
#undef PG8_SB
#undef PG8_STAGE
#undef PG8_LDA
#undef PG8_LDB
#undef PG8_MMA
#undef PG8_WAIT_V
#undef PG8_WAIT_L
#undef PG8_BAR
#undef PG8_SCHED
}
}
#define GAS __attribute__((address_space(1)))
#define LAS __attribute__((address_space(3)))
typedef unsigned short bf16;
typedef unsigned v4u __attribute__((ext_vector_type(4)));
typedef float f32x4 __attribute__((ext_vector_type(4)));
typedef short bf16x8 __attribute__((ext_vector_type(8)));
typedef GAS unsigned gu32;
typedef GAS unsigned long long gu64;
#define RLX_AGENT __ATOMIC_RELAXED, __HIP_MEMORY_SCOPE_AGENT
#define LDS_WAIT() asm volatile("s_waitcnt lgkmcnt(0)" ::: "memory")
#define VM_WAIT() asm volatile("s_waitcnt vmcnt(0)" ::: "memory")
__device__ __forceinline__ unsigned long long rt() { return __builtin_amdgcn_s_memrealtime(); }
typedef float f32x2_t __attribute__((ext_vector_type(2))); typedef __bf16 bf16x2_t __attribute__((ext_vector_type(2)));
__device__ __forceinline__ unsigned pk2(float lo, float hi) { const f32x2_t v = {lo, hi}; const bf16x2_t b = __builtin_convertvector(v, bf16x2_t); return __builtin_bit_cast(unsigned, b); }
__device__ __forceinline__ unsigned f2bf(float f) { return pk2(f, 0.f) & 0xffffu; }

#define XB_TMO      128
#define XB_XCNT(j)  (256  + 64 * (j))
#define XB_XSUB(j)  (1280 + 64 * (j))
#define XB_XGEN(j)  (2304 + 64 * (j))
#define XB_TOP      3328
#define XB_TOPGEN   3392
#define XCD_BAR_WORDS 3456
#define XB_SPIN_CAP (1u << 18)

__device__ __forceinline__ unsigned xb_ld(unsigned* p)              { return __hip_atomic_load(p, __ATOMIC_RELAXED, __HIP_MEMORY_SCOPE_AGENT); }
__device__ __forceinline__ unsigned xb_add(unsigned* p, unsigned v) { return __hip_atomic_fetch_add(p, v, __ATOMIC_RELAXED, __HIP_MEMORY_SCOPE_AGENT); }
__device__ __forceinline__ unsigned xb_xcc_id() { return (unsigned)__builtin_amdgcn_s_getreg((3 << 11) | 20) & 0xFu; }
#define XB_SPIN(cond, bar) do { unsigned _sp = 0; while (cond) { __builtin_amdgcn_s_sleep(1); \
    if ((++_sp & 255u) == 0u) { if (xb_ld(&(bar)[XB_TMO])) break; if (_sp > XB_SPIN_CAP) { atomicAdd(&(bar)[XB_TMO], 1u); break; } } } } while (0)

struct XcdBarrier {
    unsigned* bar; unsigned x;
    volatile LAS unsigned* st;
};

__device__ __forceinline__ XcdBarrier xcd_barrier_post(unsigned* bar, volatile LAS unsigned* st) {
    XcdBarrier b; b.bar = bar; b.x = xb_xcc_id(); b.st = st;
    if (threadIdx.x == 0) (void)xb_add(&bar[XB_XCNT(b.x)], 1u);
    return b;
}
__device__ __forceinline__ void xcd_barrier_complete(unsigned* bar, unsigned x, unsigned& nloc, unsigned& nx) {
    const unsigned G = gridDim.x * gridDim.y * gridDim.z;
    unsigned sum, cnt, mine, sp = 0u;
    for (;;) {
        sum = 0u; cnt = 0u; mine = 0u;
#pragma unroll
        for (unsigned j = 0; j < 16; ++j) { const unsigned c = xb_ld(&bar[XB_XCNT(j)]); sum += c; cnt += (c > 0u) ? 1u : 0u; mine = (j == x) ? c : mine; }
        if (sum == G) break;
        __builtin_amdgcn_s_sleep(1);
        if ((++sp & 255u) == 0u) { if (xb_ld(&bar[XB_TMO])) break; if (sp > XB_SPIN_CAP) { atomicAdd(&bar[XB_TMO], 1u); break; } }
    }
    nloc = mine > 0u ? mine : 1u; nx = cnt > 0u ? cnt : 1u;
}

__device__ __forceinline__ void xcd_barrier(const XcdBarrier& b) {
    asm volatile("s_waitcnt vmcnt(0)" ::: "memory");
    __syncthreads();
    if (threadIdx.x == 0) {
        unsigned* bar = b.bar;
        __builtin_amdgcn_s_waitcnt(0);
        unsigned nloc = b.st[0], nx = b.st[1];
        if (nloc == 0u) { xcd_barrier_complete(bar, b.x, nloc, nx); b.st[0] = nloc; b.st[1] = nx; }
        const unsigned old = xb_add(&bar[XB_XSUB(b.x)], 1u);
        const unsigned gen = old / nloc;
        if (old + 1u == (gen + 1u) * nloc) {
            __builtin_amdgcn_fence(__ATOMIC_RELEASE, "agent");
            asm volatile("s_waitcnt vmcnt(0)" ::: "memory");
            const unsigned og = xb_add(&bar[XB_TOP], 1u);
            const unsigned tg = og / nx;
            if (og + 1u == (tg + 1u) * nx) xb_add(&bar[XB_TOPGEN], 1u);
            else XB_SPIN(xb_ld(&bar[XB_TOPGEN]) == tg, bar);
            __builtin_amdgcn_fence(__ATOMIC_ACQUIRE, "agent");
            xb_add(&bar[XB_XGEN(b.x)], 1u);
            asm volatile("s_waitcnt vmcnt(0)" ::: "memory");
        } else {
            XB_SPIN(xb_ld(&bar[XB_XGEN(b.x)]) == gen, bar);
            __builtin_amdgcn_fence(__ATOMIC_ACQUIRE, "agent");
            asm volatile("s_waitcnt vmcnt(0)" ::: "memory");
        }
    }
    __syncthreads();
}
typedef unsigned v2u __attribute__((ext_vector_type(2)));
constexpr int NWAVES = 8, NTHR = 512;
constexpr int DM = 1024, TP = 16384, TS = 512, T = TP + TS;
constexpr int SEQ = 2048, NBP = 8, NBS = 128, LS = 4, MEMR = 2048;
constexpr int NPROJ = 11520;
constexpr int FFN = 2816;
constexpr float EPS = 1e-6f;
constexpr float QSCALE = 0.0625f * 1.4426950408889634f;

constexpr size_t MiB = 1u << 20;
constexpr size_t WS_CTL = 0, CTL_ZERO_BYTES = 1 * MiB;
constexpr size_t WS_SSQX = 1 * MiB, WS_SSQM = 1 * MiB + 512 * 1024;
constexpr size_t WS_DT = 2 * MiB, WS_SSQSSD = 5 * MiB, WS_SSQP1 = 8 * MiB, WS_SSQP2 = 9 * MiB + 512 * 1024, WS_SSQP3 = 11 * MiB;
constexpr size_t WS_WIN = 13 * MiB, WS_WKV = 36 * MiB, WS_WSSD = 40 * MiB, WS_WHG = 44 * MiB, WS_WOUT = 46 * MiB, WS_WCQ = 48 * MiB, WS_WCO = 50 * MiB, WS_WGU = 52 * MiB, WS_WDN = 63 * MiB;
constexpr size_t WS_XB = 69 * MiB, WS_MNB = 102 * MiB, WS_KB = 106 * MiB, WS_VT = 110 * MiB;
constexpr size_t SLOT = 33 * MiB, SLOT_ELEMS = (size_t)T * 1024;
constexpr size_t WS_PROJ = 114 * MiB;
constexpr size_t WS_YG = WS_PROJ + 11 * SLOT, WS_ON = WS_YG + 2 * SLOT, WS_END = WS_ON + SLOT;
static_assert(SLOT == SLOT_ELEMS * 2, "slot size");
static_assert(WS_WIN + (size_t)NPROJ * 1024 * 2 <= WS_WKV && WS_WGU + (size_t)2 * FFN * 1024 * 2 <= WS_WDN && WS_WDN + (size_t)1024 * FFN * 2 <= WS_XB && WS_SSQP3 + (size_t)T * 64 <= WS_WIN, "d_ws map");
static_assert(WS_DT + (size_t)T * 128 <= WS_SSQSSD && WS_SSQSSD + (size_t)T * 128 <= WS_SSQP1 && WS_SSQP1 + (size_t)T * 64 <= WS_SSQP2 && WS_SSQP2 + (size_t)T * 64 <= WS_SSQP3, "d_ws map 2");
enum { S_Z0 = 0, S_Z1 = 1, S_X0 = 2, S_X1 = 3, S_X2 = 4, S_Q = 5, S_F = 6, S_I = 7, S_HG = 8, S_GS = 9, S_GH = 10 };
constexpr size_t WS_MERGED = WS_PROJ + S_Q * SLOT, WS_HB = WS_PROJ + S_F * SLOT, WS_QB = WS_PROJ + S_I * SLOT, WS_OB = WS_PROJ + S_HG * SLOT, WS_ACT = WS_PROJ;
static_assert((size_t)T * FFN * 2 <= 3 * SLOT, "act overlay");
constexpr size_t O_Y = 0, O_SSMP = (size_t)T * 1024, O_CONVP = O_SSMP + 2097152, O_HGP = O_CONVP + 73728, O_MKP = O_HGP + 1048576, O_MVP = O_MKP + 2097152,
                 O_SSMS = O_MVP + 2097152, O_CONVS = O_SSMS + 33554432, O_HGS = O_CONVS + 1179648, O_END = O_HGS + 16777216;
constexpr int CW_QUEUE = 64;
constexpr int CW_BAR = 4096;
constexpr int RING_OFF = 0, RING_BYTES = 131072;
constexpr int LDSCTL_OFF = RING_BYTES, MISC_OFF = LDSCTL_OFF + 320;
constexpr int LDS_BYTES = 147456;
struct Frame {
    LAS unsigned char* lds;
    volatile LAS unsigned* MISC;
    gu32* ctl;
    int tid, lane, wave;
    int vcu, G;
    const float* in[32];
    float* out; unsigned char* ws;
};
__device__ __forceinline__ float bf2f(unsigned v16) { return __uint_as_float(v16 << 16); }
__device__ __forceinline__ float sigmoid_f(float x) { return __builtin_amdgcn_rcpf(1.0f + __expf(-x)); }
__device__ __forceinline__ float silu_f(float x) { return x * sigmoid_f(x); }
__device__ __forceinline__ float wave_sum(float v) {
#pragma unroll
    for (int o = 1; o < 64; o <<= 1) v += __shfl_xor(v, o);
    return v;
}
__device__ __forceinline__ float wave_max(float v) {
#pragma unroll
    for (int o = 1; o < 64; o <<= 1) v = fmaxf(v, __shfl_xor(v, o));
    return v;
}
struct TSrc { const float* W; const float* W2; const float* ks; int ldw; int mode; };
__device__ __forceinline__ float tsrc_elem(const TSrc& s, int k, int n) {
    float v;
    if (s.mode == 0) v = s.W[(size_t)k * s.ldw + n];
    else if (s.mode == 1) { if (n < 5120) v = s.W[(size_t)k * s.ldw + n]; else if (n < 11264) v = s.W[(size_t)k * s.ldw + n + 32]; else if (n < 11296) v = s.W[(size_t)k * s.ldw + 5120 + (n - 11264)]; else v = 0.f; }
    else if (s.mode == 2) v = (n & 1) ? s.W2[(size_t)k * s.ldw + (n >> 1)] : s.W[(size_t)k * s.ldw + (n >> 1)];
    else v = (n < 1024) ? s.W[(size_t)k * s.ldw + n] : s.W2[(size_t)k * s.ldw + (n - 1024)];
    return s.ks ? v * s.ks[k] : v;
}
__device__ __forceinline__ void p0_transpose_item(const TSrc& s, int K, int N, bf16* WT, LAS float* scr, int item, int lane) {
    const int nblk = N / 32, kb = item / nblk, nb = item % nblk, k0 = 64 * kb, n0 = 32 * nb;
#pragma unroll 8
    for (int i = 0; i < 32; ++i) { const int kk = 2 * i + (lane >> 5); scr[kk * 33 + (lane & 31)] = tsrc_elem(s, k0 + kk, n0 + (lane & 31)); }
    LDS_WAIT(); asm volatile("" ::: "memory");
    const int c = lane & 7;
#pragma unroll
    for (int j = 0; j < 4; ++j) { const int n = (lane >> 3) + 8 * j; const LAS float* p = scr + (8 * c) * 33 + n;
        v4u o; o.x = pk2(p[0 * 33], p[1 * 33]); o.y = pk2(p[2 * 33], p[3 * 33]); o.z = pk2(p[4 * 33], p[5 * 33]); o.w = pk2(p[6 * 33], p[7 * 33]);
        *(v4u*)(WT + (size_t)(n0 + n) * K + k0 + 8 * c) = o; }
    LDS_WAIT(); asm volatile("" ::: "memory");
}
__device__ __forceinline__ void row_to_bf16_ssq(const float* xrow, bf16* orow, float* ssq, int lane) {
    const f32x4* xr = (const f32x4*)xrow + lane; f32x4 v[4]; float s = 0.f;
#pragma unroll
    for (int j = 0; j < 4; ++j) { v[j] = xr[64 * j]; s += (v[j].x * v[j].x + v[j].y * v[j].y) + (v[j].z * v[j].z + v[j].w * v[j].w); }
    s = wave_sum(s);
    unsigned long long* o8 = (unsigned long long*)orow + lane;
#pragma unroll
    for (int j = 0; j < 4; ++j) o8[64 * j] = (unsigned long long)pk2(v[j].x, v[j].y) | ((unsigned long long)pk2(v[j].z, v[j].w) << 32);
    if (lane == 0) *ssq = s;
}
__device__ __forceinline__ void p0_prologue(Frame& F) {
    LAS float* scr = (LAS float*)(F.lds + RING_OFF + F.wave * 16384);
    const int gw = F.vcu * NWAVES + F.wave, NGW = F.G * NWAVES;
    unsigned char* ws = F.ws;
    constexpr int I_IN = 16 * (NPROJ / 32), I_KV = 16 * 64, I_SSD = 32 * 32, I_SQ = 16 * 32, I_GU = 16 * (2 * FFN / 32), I_DN = (FFN / 64) * 32;
    constexpr int NITEMS = I_IN + I_KV + I_SSD + 4 * I_SQ + I_GU + I_DN;
    for (int it = gw; it < NITEMS; it += NGW) {
        int r = it;
        if (r < I_IN) { TSrc s{F.in[9], nullptr, F.in[8], 11296, 1}; p0_transpose_item(s, 1024, NPROJ, (bf16*)(ws + WS_WIN), scr, r, F.lane); continue; } r -= I_IN;
        if (r < I_KV) { TSrc s{F.in[24], F.in[25], F.in[22], 1024, 3}; p0_transpose_item(s, 1024, 2048, (bf16*)(ws + WS_WKV), scr, r, F.lane); continue; } r -= I_KV;
        if (r < I_SSD) { TSrc s{F.in[16], nullptr, F.in[15], 1024, 0}; p0_transpose_item(s, 2048, 1024, (bf16*)(ws + WS_WSSD), scr, r, F.lane); continue; } r -= I_SSD;
        if (r < I_SQ) { TSrc s{F.in[19], nullptr, F.in[18], 1024, 0}; p0_transpose_item(s, 1024, 1024, (bf16*)(ws + WS_WHG), scr, r, F.lane); continue; } r -= I_SQ;
        if (r < I_SQ) { TSrc s{F.in[20], nullptr, nullptr, 1024, 0}; p0_transpose_item(s, 1024, 1024, (bf16*)(ws + WS_WOUT), scr, r, F.lane); continue; } r -= I_SQ;
        if (r < I_SQ) { TSrc s{F.in[23], nullptr, F.in[21], 1024, 0}; p0_transpose_item(s, 1024, 1024, (bf16*)(ws + WS_WCQ), scr, r, F.lane); continue; } r -= I_SQ;
        if (r < I_SQ) { TSrc s{F.in[26], nullptr, nullptr, 1024, 0}; p0_transpose_item(s, 1024, 1024, (bf16*)(ws + WS_WCO), scr, r, F.lane); continue; } r -= I_SQ;
        if (r < I_GU) { TSrc s{F.in[28], F.in[29], F.in[27], FFN, 2}; p0_transpose_item(s, 1024, 2 * FFN, (bf16*)(ws + WS_WGU), scr, r, F.lane); continue; } r -= I_GU;
        { TSrc s{F.in[30], nullptr, nullptr, 1024, 0}; p0_transpose_item(s, FFN, 1024, (bf16*)(ws + WS_WDN), scr, r, F.lane); }
    }
    bf16* XB = (bf16*)(ws + WS_XB); float* SSQX = (float*)(ws + WS_SSQX);
    for (int m = gw; m < T; m += NGW) { const float* src = m < TP ? F.in[0] + (size_t)m * DM : F.in[1] + (size_t)(m - TP) * DM; row_to_bf16_ssq(src, XB + (size_t)m * DM, SSQX + m, F.lane); }
    bf16* MNB = (bf16*)(ws + WS_MNB); float* SSQM = (float*)(ws + WS_SSQM);
    for (int m = gw; m < MEMR; m += NGW) row_to_bf16_ssq(F.in[2] + (size_t)m * DM, MNB + (size_t)m * DM, SSQM + m, F.lane);
}
__device__ __forceinline__ void ssd_unit(Frame& F, int gb, int h) {
    const int tid = F.tid; unsigned char* ws = F.ws;
    const bool prompt = gb < NBP; const int L = prompt ? SEQ : LS; const int sb = gb - NBP; const size_t row_base = prompt ? (size_t)gb * SEQ : (size_t)TP + (size_t)sb * LS;
    const int g = h >> 3;
    LAS float* xs = (LAS float*)(F.lds + RING_OFF);
    LAS float* Bs = xs + 64 * 64;
    LAS float* Cs = Bs + 64 * 128;
    LAS float* ys = Cs + 64 * 128;
    LAS float* dts = ys + 64 * 64;
    LAS float* das = dts + 64;
    const bf16* PROJ = (const bf16*)(ws + WS_PROJ); const float* DTR = (const float*)(ws + WS_DT);
    bf16* YG = (bf16*)(ws + WS_YG); float* SSQ = (float*)(ws + WS_SSQSSD);
    const int p = tid >> 3, n0 = (tid & 7) * 16;
    float hs[16];
    float* state_out = prompt ? F.out + O_SSMP + ((size_t)(gb * 32 + h) * 64 + p) * 128 + n0 : F.out + O_SSMS + ((size_t)(sb * 32 + h) * 64 + p) * 128 + n0;
    if (prompt) {
#pragma unroll
        for (int i = 0; i < 16; ++i) hs[i] = 0.f;
    } else { const float* sp = F.in[3] + ((size_t)(sb * 32 + h) * 64 + p) * 128 + n0;
#pragma unroll
        for (int i = 0; i < 4; ++i) { const f32x4 v = *(const f32x4*)(sp + 4 * i); hs[4 * i] = v.x; hs[4 * i + 1] = v.y; hs[4 * i + 2] = v.z; hs[4 * i + 3] = v.w; } }
    const float a = -__expf(F.in[13][h]), dtb = F.in[12][h], Dk = F.in[14][h];
    int col = 0; LAS float* dst = xs; int dstride = 64;
    if (tid < 64) { col = h * 64 + tid; dst = xs + tid; dstride = 64; }
    else if (tid < 192) { col = 2048 + g * 128 + (tid - 64); dst = Bs + (tid - 64); dstride = 128; }
    else if (tid < 320) { col = 2560 + g * 128 + (tid - 192); dst = Cs + (tid - 192); dstride = 128; }
    float w0 = 0.f, w1 = 0.f, w2 = 0.f, w3 = 0.f, cb = 0.f, r0 = 0.f, r1 = 0.f, r2 = 0.f; const bf16* cptr = PROJ;
    if (tid < 320) { const float* cw = F.in[10]; w0 = cw[col]; w1 = cw[3072 + col]; w2 = cw[2 * 3072 + col]; w3 = cw[3 * 3072 + col]; cb = F.in[11][col];
        cptr = PROJ + (size_t)(S_X0 + (col >> 10)) * SLOT_ELEMS + row_base * 1024 + (col & 1023);
        if (!prompt) { const float* sc = F.in[4] + (size_t)sb * 3 * 3072 + col; r0 = sc[0]; r1 = sc[3072]; r2 = sc[2 * 3072]; } }
    for (int t0 = 0; t0 < L; t0 += 64) {
        const int nt = (L - t0) < 64 ? (L - t0) : 64;
        if (tid < 320) {
            for (int tt = 0; tt < nt; ++tt) { const float raw = bf2f(cptr[(size_t)(t0 + tt) * 1024]); float v = w0 * r0 + w1 * r1 + w2 * r2 + w3 * raw + cb; v = silu_f(v); dst[tt * dstride] = v; r0 = r1; r1 = r2; r2 = raw; }
        } else if (tid < 384) { const int tt = tid - 320;
            if (tt < nt) { const float x = DTR[(row_base + t0 + tt) * 32 + h] + dtb; const float dtv = x > 20.f ? x : log1pf(__expf(x)); dts[tt] = dtv; das[tt] = __expf(dtv * a); } }
        __syncthreads();
        for (int tt = 0; tt < nt; ++tt) {
            const float xv = xs[tt * 64 + p], dtv = dts[tt], dA = das[tt], xd = xv * dtv; float part = 0.f;
#pragma unroll
            for (int i = 0; i < 4; ++i) { const f32x4 bv = *(const LAS f32x4*)(Bs + tt * 128 + n0 + 4 * i), cv = *(const LAS f32x4*)(Cs + tt * 128 + n0 + 4 * i);
                hs[4 * i] = dA * hs[4 * i] + xd * bv.x; hs[4 * i + 1] = dA * hs[4 * i + 1] + xd * bv.y; hs[4 * i + 2] = dA * hs[4 * i + 2] + xd * bv.z; hs[4 * i + 3] = dA * hs[4 * i + 3] + xd * bv.w;
                part += (hs[4 * i] * cv.x + hs[4 * i + 1] * cv.y) + (hs[4 * i + 2] * cv.z + hs[4 * i + 3] * cv.w); }
            part += __shfl_xor(part, 1); part += __shfl_xor(part, 2); part += __shfl_xor(part, 4);
            if ((tid & 7) == 0) ys[tt * 64 + p] = part;
        }
        __syncthreads();
        { const int tt = tid >> 3, p0 = (tid & 7) * 8;
          if (tt < nt) { const size_t row = row_base + t0 + tt;
            const v4u zw = *(const v4u*)(PROJ + (size_t)(S_Z0 + (h >> 4)) * SLOT_ELEMS + row * 1024 + (h & 15) * 64 + p0);
            float o[8]; float sq = 0.f;
#pragma unroll
            for (int j = 0; j < 8; ++j) { const unsigned z16 = (zw[j >> 1] >> ((j & 1) * 16)) & 0xffffu; const float yv = (ys[tt * 64 + p0 + j] + xs[tt * 64 + p0 + j] * Dk) * silu_f(bf2f(z16)); o[j] = yv; sq += yv * yv; }
            v4u ow; ow.x = pk2(o[0], o[1]); ow.y = pk2(o[2], o[3]); ow.z = pk2(o[4], o[5]); ow.w = pk2(o[6], o[7]);
            *(v4u*)(YG + row * 2048 + h * 64 + p0) = ow;
            sq += __shfl_xor(sq, 1); sq += __shfl_xor(sq, 2); sq += __shfl_xor(sq, 4);
            if ((tid & 7) == 0) SSQ[row * 32 + h] = sq; } }
        __syncthreads();
    }
#pragma unroll
    for (int i = 0; i < 4; ++i) *(f32x4*)(state_out + 4 * i) = (f32x4){hs[4 * i], hs[4 * i + 1], hs[4 * i + 2], hs[4 * i + 3]};
}
__device__ __forceinline__ void hgrn_unit(Frame& F, int gb, int hd) {
    const int tid = F.tid; unsigned char* ws = F.ws;
    const bool prompt = gb < NBP; const int L = prompt ? SEQ : LS; const int sb = gb - NBP; const size_t row_base = prompt ? (size_t)gb * SEQ : (size_t)TP + (size_t)sb * LS;
    LAS float* qs = (LAS float*)(F.lds + RING_OFF);
    LAS float* fs = qs + 32 * 128; LAS float* ks = fs + 32 * 128; LAS float* vs = ks + 32 * 128; LAS float* os = vs + 32 * 128;
    const bf16* PROJ = (const bf16*)(ws + WS_PROJ); bf16* ON = (bf16*)(ws + WS_ON);
    const int v = tid >> 2, k0 = (tid & 3) * 32;
    float S[32];
    float* state_out = prompt ? F.out + O_HGP + ((size_t)(gb * 8 + hd) * 128 + k0) * 128 + v : F.out + O_HGS + ((size_t)(sb * 8 + hd) * 128 + k0) * 128 + v;
    if (prompt) {
#pragma unroll
        for (int i = 0; i < 32; ++i) S[i] = 0.f;
    } else { const float* sp = F.in[5] + ((size_t)(sb * 8 + hd) * 128 + k0) * 128 + v;
#pragma unroll
        for (int i = 0; i < 32; ++i) S[i] = sp[(size_t)i * 128]; }
    const int c = tid & 127, part = tid >> 7; const int ch = hd * 128 + c;
    float lb = 0.f; if (part == 1) lb = 1.0f / (1.0f + __expf(F.in[17][1024 + ch] - F.in[17][ch]));
    const bf16* sptr = PROJ + (size_t)(part == 0 ? S_Q : (part == 1 ? S_F : S_I)) * SLOT_ELEMS + row_base * 1024 + ch;
    for (int t0 = 0; t0 < L; t0 += 32) {
        const int nt = (L - t0) < 32 ? (L - t0) : 32;
        if (part < 3) {
            for (int tt = 0; tt < nt; ++tt) { const float raw = bf2f(sptr[(size_t)(t0 + tt) * 1024]);
                if (part == 0) qs[tt * 128 + c] = silu_f(raw);
                else if (part == 1) { const float e = __expf(-raw); const float sg = 1.0f / (1.0f + e); fs[tt * 128 + c] = lb + (1.0f - lb) * sg; ks[tt * 128 + c] = (1.0f - lb) * (e / (1.0f + e)); }
                else vs[tt * 128 + c] = raw; }
        }
        __syncthreads();
        for (int tt = 0; tt < nt; ++tt) {
            const float vv = vs[tt * 128 + v]; float acc = 0.f;
#pragma unroll
            for (int i = 0; i < 8; ++i) { const f32x4 fv = *(const LAS f32x4*)(fs + tt * 128 + k0 + 4 * i), kv = *(const LAS f32x4*)(ks + tt * 128 + k0 + 4 * i), qv = *(const LAS f32x4*)(qs + tt * 128 + k0 + 4 * i);
                S[4 * i] = fv.x * S[4 * i] + kv.x * vv; S[4 * i + 1] = fv.y * S[4 * i + 1] + kv.y * vv; S[4 * i + 2] = fv.z * S[4 * i + 2] + kv.z * vv; S[4 * i + 3] = fv.w * S[4 * i + 3] + kv.w * vv;
                acc += (S[4 * i] * qv.x + S[4 * i + 1] * qv.y) + (S[4 * i + 2] * qv.z + S[4 * i + 3] * qv.w); }
            acc += __shfl_xor(acc, 1); acc += __shfl_xor(acc, 2);
            if ((tid & 3) == 0) os[tt * 128 + v] = acc;
        }
        __syncthreads();
        { const int tt = tid >> 4, v0 = (tid & 15) * 8;
          if (tt < nt) { const size_t row = row_base + t0 + tt; float o[8]; float sq = 0.f;
#pragma unroll
            for (int j = 0; j < 8; ++j) { o[j] = os[tt * 128 + v0 + j]; sq += o[j] * o[j]; }
            sq += __shfl_xor(sq, 1); sq += __shfl_xor(sq, 2); sq += __shfl_xor(sq, 4); sq += __shfl_xor(sq, 8);
            const float rs = 1.0f / sqrtf(sq * (1.0f / 128.0f) + EPS);
            const v4u gw = *(const v4u*)(PROJ + (size_t)S_HG * SLOT_ELEMS + row * 1024 + hd * 128 + v0);
#pragma unroll
            for (int j = 0; j < 8; ++j) { const unsigned g16 = (gw[j >> 1] >> ((j & 1) * 16)) & 0xffffu; o[j] = o[j] * rs * silu_f(bf2f(g16)); }
            v4u ow; ow.x = pk2(o[0], o[1]); ow.y = pk2(o[2], o[3]); ow.z = pk2(o[4], o[5]); ow.w = pk2(o[6], o[7]);
            *(v4u*)(ON + row * 1024 + hd * 128 + v0) = ow; } }
        __syncthreads();
    }
#pragma unroll
    for (int i = 0; i < 32; ++i) state_out[(size_t)i * 128] = S[i];
}
__device__ __forceinline__ void conv_copy_unit(Frame& F, int gb) {
    const bf16* PROJ = (const bf16*)(F.ws + WS_PROJ);
    const bool prompt = gb < NBP; const int sb = gb - NBP;
    const size_t row0 = prompt ? (size_t)gb * SEQ + (SEQ - 3) : (size_t)TP + (size_t)sb * LS + 1;
    float* dst = prompt ? F.out + O_CONVP + (size_t)gb * 3 * 3072 : F.out + O_CONVS + (size_t)sb * 3 * 3072;
    for (int e = F.tid; e < 3 * 3072; e += NTHR) { const int j = e / 3072, col = e % 3072;
        dst[e] = bf2f(PROJ[(size_t)(S_X0 + (col >> 10)) * SLOT_ELEMS + (row0 + j) * 1024 + (col & 1023)]); }
}
__device__ __forceinline__ void ssdnorm_phase(Frame& F) {
    const int gw = F.vcu * NWAVES + F.wave, NGW = F.G * NWAVES; bf16* YG = (bf16*)(F.ws + WS_YG); const float* SSQ = (const float*)(F.ws + WS_SSQSSD);
    for (int row = gw; row < T; row += NGW) {
        const f32x4* sp = (const f32x4*)(SSQ + (size_t)row * 32);
#pragma unroll
        for (int j = 0; j < 4; ++j) { const f32x4 a = sp[2 * j], b = sp[2 * j + 1]; const float s = ((a.x + a.y) + (a.z + a.w)) + ((b.x + b.y) + (b.z + b.w)); const float rs = 1.0f / sqrtf(s * (1.0f / 512.0f) + EPS);
            v4u* p = (v4u*)(YG + (size_t)row * 2048) + j * 64 + F.lane; const v4u w = *p; v4u o;
#pragma unroll
            for (int e = 0; e < 4; ++e) o[e] = pk2(bf2f(w[e] & 0xffffu) * rs, bf2f(w[e] >> 16) * rs);
            *p = o; }
    }
}
typedef float f32x16 __attribute__((ext_vector_type(16)));
#define MFMA32(a, b, c) __builtin_amdgcn_mfma_f32_32x32x16_bf16((a), (b), (c), 0, 0, 0)
__device__ __forceinline__ unsigned cvtpk_c(float lo, float hi) { return pk2(lo, hi); }
__device__ __forceinline__ bf16x8 pack8(float a0, float a1, float a2, float a3, float a4, float a5, float a6, float a7) {
    v4u w; w.x = cvtpk_c(a0, a1); w.y = cvtpk_c(a2, a3); w.z = cvtpk_c(a4, a5); w.w = cvtpk_c(a6, a7); return __builtin_bit_cast(bf16x8, w); }
#define ACC_FRAG(x, s) pack8((x)[8 * (s)], (x)[8 * (s) + 1], (x)[8 * (s) + 2], (x)[8 * (s) + 3], (x)[8 * (s) + 4], (x)[8 * (s) + 5], (x)[8 * (s) + 6], (x)[8 * (s) + 7])
__device__ __forceinline__ bf16x8 lds_frag16(const LAS unsigned char* p) { return *(const LAS bf16x8*)p; }
__device__ __forceinline__ bf16x8 lds_frag8x2(const LAS unsigned char* p) { const v2u lo = *(const LAS v2u*)p, hi = *(const LAS v2u*)(p + 16);
    const v4u w = (v4u){lo.x, lo.y, hi.x, hi.y}; return __builtin_bit_cast(bf16x8, w); }
__device__ __forceinline__ float exp_clamped(float x) { return __expf(fminf(x, 80.0f)); }
constexpr int HG_QA = 0, HG_KA = 8704, HG_KAT = 17408, HG_VT = 27648, HG_EGM = 37888, HG_EGL = 38400, HG_SEG = 38912, HG_OB = 40960, HG_RAW = 74752;
__device__ __forceinline__ void hgrn_unit_mfma(Frame& F, int gb, int hd) {
    int tid_o = F.tid; asm volatile("" : "+v"(tid_o));
    const int tid = tid_o, lane = tid & 63, w = F.wave, r = lane & 31, hh = lane >> 5; unsigned char* ws = F.ws;
    const bool prompt = gb < NBP; const int L = prompt ? SEQ : LS; const int sb = gb - NBP; const size_t row_base = prompt ? (size_t)gb * SEQ : (size_t)TP + (size_t)sb * LS;
    LAS unsigned char* Lb = F.lds + RING_OFF;
    LAS unsigned short* QA = (LAS unsigned short*)(Lb + HG_QA); LAS unsigned short* KA = (LAS unsigned short*)(Lb + HG_KA);
    LAS unsigned short* KAT = (LAS unsigned short*)(Lb + HG_KAT); LAS unsigned short* VT = (LAS unsigned short*)(Lb + HG_VT);
    LAS float* EGM = (LAS float*)(Lb + HG_EGM); LAS float* EGL = (LAS float*)(Lb + HG_EGL); LAS float* SEG = (LAS float*)(Lb + HG_SEG); LAS float* OB = (LAS float*)(Lb + HG_OB);
    const bf16* PROJ = (const bf16*)(ws + WS_PROJ); bf16* ON = (bf16*)(ws + WS_ON);
    const int vt = w & 3, kh = w >> 2;
    f32x16 S0, S1;
    float* st_g = (prompt ? F.out + O_HGP + (size_t)(gb * 8 + hd) * 16384 : F.out + O_HGS + (size_t)(sb * 8 + hd) * 16384) + 32 * vt + r;
    if (prompt) {
#pragma unroll
        for (int i = 0; i < 16; ++i) { S0[i] = 0.f; S1[i] = 0.f; }
    } else { const float* sp = F.in[5] + (size_t)(sb * 8 + hd) * 16384 + 32 * vt + r;
#pragma unroll
        for (int i = 0; i < 16; ++i) { const int k = 64 * kh + (i & 3) + 8 * (i >> 2) + 4 * hh; S0[i] = sp[(size_t)k * 128]; S1[i] = sp[(size_t)(k + 32) * 128]; } }
    const int c = tid & 127, tq = tid >> 7, ch = hd * 128 + c;
    const float lb = 1.0f / (1.0f + __expf(F.in[17][1024 + ch] - F.in[17][ch]));
    LAS unsigned short* RAW = (LAS unsigned short*)(Lb + HG_RAW);
    const int srow = tid >> 4, sc8 = (tid & 15) * 8;
    const bf16* gsrc = PROJ + row_base * 1024 + hd * 128 + sc8;
    v4u pfF = (v4u){0u, 0u, 0u, 0u}, pfQ = pfF, pfI = pfF;
    if (srow < L) { const size_t o = (size_t)srow * 1024; pfF = *(const v4u*)(gsrc + (size_t)S_F * SLOT_ELEMS + o); pfQ = *(const v4u*)(gsrc + (size_t)S_Q * SLOT_ELEMS + o); pfI = *(const v4u*)(gsrc + (size_t)S_I * SLOT_ELEMS + o); }
    for (int t0 = 0; t0 < L; t0 += 32) {
        int r_l = r, hh_l = hh, c_l = c, tq_l = tq, srow_l = srow, sc8_l = sc8;
        asm volatile("" : "+v"(r_l), "+v"(hh_l), "+v"(c_l), "+v"(tq_l), "+v"(srow_l), "+v"(sc8_l));
        { const int r = r_l, hh = hh_l, c = c_l, tq = tq_l, srow = srow_l, sc8 = sc8_l;
        v4u gw = (v4u){0u, 0u, 0u, 0u};
        if (t0 + (tid >> 4) < L) gw = *(const v4u*)(PROJ + (size_t)S_HG * SLOT_ELEMS + (row_base + t0 + (tid >> 4)) * 1024 + hd * 128 + (tid & 15) * 8);
        *(LAS v4u*)(RAW + srow * 128 + sc8) = pfF; *(LAS v4u*)(RAW + 4096 + srow * 128 + sc8) = pfQ; *(LAS v4u*)(RAW + 8192 + srow * 128 + sc8) = pfI;
        __syncthreads();
        { const int tn = t0 + 32 + srow; pfF = (v4u){0u, 0u, 0u, 0u}; pfQ = pfF; pfI = pfF;
          if (tn < L) { const size_t o = (size_t)tn * 1024; pfF = *(const v4u*)(gsrc + (size_t)S_F * SLOT_ELEMS + o); pfQ = *(const v4u*)(gsrc + (size_t)S_Q * SLOT_ELEMS + o); pfI = *(const v4u*)(gsrc + (size_t)S_I * SLOT_ELEMS + o); } }
        float lc[8], kk[8], qs[8], vi[8]; float run = 0.f;
#pragma unroll
        for (int i = 0; i < 8; ++i) { const int tl = 8 * tq + i; float lf = 0.f, kv = 0.f, qv = 0.f, vv = 0.f;
            if (t0 + tl < L) { const float u = fminf(fmaxf(bf2f(RAW[tl * 128 + c]), -30.f), 30.f); const float sg = __builtin_amdgcn_rcpf(1.0f + __builtin_amdgcn_exp2f(u * -1.4426950408889634f));
                const float fg = lb + (1.0f - lb) * sg; lf = __builtin_amdgcn_logf(fg); kv = 1.0f - fg;
                const float qr = bf2f(RAW[4096 + tl * 128 + c]); qv = qr * __builtin_amdgcn_rcpf(1.0f + __builtin_amdgcn_exp2f(qr * -1.4426950408889634f)); vv = bf2f(RAW[8192 + tl * 128 + c]); }
            run += lf; lc[i] = run; kk[i] = kv; qs[i] = qv; vi[i] = vv; }
        SEG[tq * 128 + c] = run;
        __syncthreads();
        { const float s0 = SEG[c], s1 = SEG[128 + c], s2 = SEG[256 + c], s3 = SEG[384 + c]; const float gm = s0 + s1, gl = (s0 + s1) + (s2 + s3);
          const float pre = tq == 0 ? 0.f : (tq == 1 ? s0 : (tq == 2 ? s0 + s1 : (s0 + s1) + s2));
          float kav[8];
#pragma unroll
          for (int i = 0; i < 8; ++i) { const float d = fminf(fmaxf((pre + lc[i]) - gm, -120.f), 120.f); const float e1 = __builtin_amdgcn_exp2f(d), e2 = __builtin_amdgcn_rcpf(e1);
              const float qa = qs[i] * e1, ka = kk[i] * e2; const int t = 8 * tq + i; const unsigned w2 = pk2(qa, ka);
              QA[t * 136 + c] = (unsigned short)(w2 & 0xffffu); KA[t * 136 + c] = (unsigned short)(w2 >> 16); kav[i] = ka; }
          v4u pk; pk.x = pk2(kav[0], kav[1]); pk.y = pk2(kav[2], kav[3]); pk.z = pk2(kav[4], kav[5]); pk.w = pk2(kav[6], kav[7]); *(LAS v4u*)(KAT + c * 40 + 8 * tq) = pk;
          v4u pv; pv.x = pk2(vi[0], vi[1]); pv.y = pk2(vi[2], vi[3]); pv.z = pk2(vi[4], vi[5]); pv.w = pk2(vi[6], vi[7]); *(LAS v4u*)(VT + c * 40 + 8 * tq) = pv;
          if (tq == 0) { EGM[c] = __builtin_amdgcn_exp2f(gm); EGL[c] = __builtin_amdgcn_exp2f(gl - gm); } }
        __syncthreads();
        {
#pragma unroll
            for (int q4 = 0; q4 < 4; ++q4) { const f32x4 e0 = *(const LAS f32x4*)(EGM + 64 * kh + 8 * q4 + 4 * hh), e1 = *(const LAS f32x4*)(EGM + 64 * kh + 32 + 8 * q4 + 4 * hh);
#pragma unroll
                for (int j = 0; j < 4; ++j) { S0[4 * q4 + j] *= e0[j]; S1[4 * q4 + j] *= e1[j]; } }
            __builtin_amdgcn_sched_barrier(0);
            f32x16 o;
#pragma unroll
            for (int i = 0; i < 16; ++i) o[i] = 0.f;
            const LAS unsigned char* qa_row = Lb + HG_QA + r * 272;
            o = MFMA32(lds_frag8x2(qa_row + (64 * kh + 4 * hh) * 2), ACC_FRAG(S0, 0), o);
            o = MFMA32(lds_frag8x2(qa_row + (64 * kh + 16 + 4 * hh) * 2), ACC_FRAG(S0, 1), o);
            o = MFMA32(lds_frag8x2(qa_row + (64 * kh + 32 + 4 * hh) * 2), ACC_FRAG(S1, 0), o);
            o = MFMA32(lds_frag8x2(qa_row + (64 * kh + 48 + 4 * hh) * 2), ACC_FRAG(S1, 1), o);
            __builtin_amdgcn_sched_barrier(0);
            if (kh == 0) {
                f32x16 X;
#pragma unroll
                for (int i = 0; i < 16; ++i) X[i] = 0.f;
                const LAS unsigned char* ka_nat = Lb + HG_KA + r * 272 + hh * 16; const LAS unsigned char* qa_nat = Lb + HG_QA + r * 272 + hh * 16;
#pragma unroll 2
                for (int ks = 0; ks < 8; ++ks) X = MFMA32(lds_frag16(ka_nat + ks * 32), lds_frag16(qa_nat + ks * 32), X);
#pragma unroll
                for (int i = 0; i < 16; ++i) { const int srow = (i & 3) + 8 * (i >> 2) + 4 * hh; X[i] = (srow <= r) ? X[i] : 0.f; }
                const LAS unsigned char* vt_row = Lb + HG_VT + (32 * vt + r) * 80;
                o = MFMA32(ACC_FRAG(X, 0), lds_frag8x2(vt_row + (4 * hh) * 2), o);
                o = MFMA32(ACC_FRAG(X, 1), lds_frag8x2(vt_row + (16 + 4 * hh) * 2), o);
            }
            __builtin_amdgcn_sched_barrier(0);
            LAS float* ob = OB + (kh * 32) * 132 + 32 * vt + r;
#pragma unroll
            for (int i = 0; i < 16; ++i) ob[((i & 3) + 8 * (i >> 2) + 4 * hh) * 132] = o[i];
            __builtin_amdgcn_sched_barrier(0);
            const LAS unsigned char* kat_nat = Lb + HG_KAT + (64 * kh + r) * 80 + hh * 16; const LAS unsigned char* vt_nat = Lb + HG_VT + (32 * vt + r) * 80 + hh * 16;
#pragma unroll
            for (int s2 = 0; s2 < 2; ++s2) { const bf16x8 b = lds_frag16(vt_nat + s2 * 32); S0 = MFMA32(lds_frag16(kat_nat + s2 * 32), b, S0); S1 = MFMA32(lds_frag16(kat_nat + 32 * 80 + s2 * 32), b, S1); }
__builtin_amdgcn_sched_barrier(0);
#pragma unroll
            for (int q4 = 0; q4 < 4; ++q4) { const f32x4 e0 = *(const LAS f32x4*)(EGL + 64 * kh + 8 * q4 + 4 * hh), e1 = *(const LAS f32x4*)(EGL + 64 * kh + 32 + 8 * q4 + 4 * hh);
#pragma unroll
                for (int j = 0; j < 4; ++j) { S0[4 * q4 + j] *= e0[j]; S1[4 * q4 + j] *= e1[j]; } }
        }
        __syncthreads();
        { const int t = tid >> 4, v0 = (tid & 15) * 8;
          if (t0 + t < L) { const size_t row = row_base + t0 + t; float o[8]; float sq = 0.f;
            const f32x4 a0 = *(const LAS f32x4*)(OB + t * 132 + v0), a1 = *(const LAS f32x4*)(OB + t * 132 + v0 + 4), b0 = *(const LAS f32x4*)(OB + (32 + t) * 132 + v0), b1 = *(const LAS f32x4*)(OB + (32 + t) * 132 + v0 + 4);
#pragma unroll
            for (int j = 0; j < 4; ++j) { o[j] = a0[j] + b0[j]; o[4 + j] = a1[j] + b1[j]; }
#pragma unroll
            for (int j = 0; j < 8; ++j) sq += o[j] * o[j];
            sq += __shfl_xor(sq, 1); sq += __shfl_xor(sq, 2); sq += __shfl_xor(sq, 4); sq += __shfl_xor(sq, 8);
            const float rs = __builtin_amdgcn_rsqf(sq * (1.0f / 128.0f) + EPS);
#pragma unroll
            for (int j = 0; j < 8; ++j) { const unsigned g16 = (gw[j >> 1] >> ((j & 1) * 16)) & 0xffffu; o[j] = o[j] * rs * silu_f(bf2f(g16)); }
            v4u ow; ow.x = pk2(o[0], o[1]); ow.y = pk2(o[2], o[3]); ow.z = pk2(o[4], o[5]); ow.w = pk2(o[6], o[7]);
            *(v4u*)(ON + row * 1024 + hd * 128 + v0) = ow; } }
        }
    }
#pragma unroll
    for (int i = 0; i < 16; ++i) { const int k = 64 * kh + (i & 3) + 8 * (i >> 2) + 4 * hh; st_g[(size_t)k * 128] = S0[i]; st_g[(size_t)(k + 32) * 128] = S1[i]; }
    __syncthreads();
}
constexpr int SD_BN = 0, SD_CN = 17408, SD_BT = 34816, SD_XT = 53248, SD_HT = 62464, SD_YB = 97280, SD_CUM = 114688, SD_DTV = 114944, SD_ECUM = 115200;
__device__ __forceinline__ void ssd_unit_mfma(Frame& F, int gb, int h) {
    int tid_o = F.tid; asm volatile("" : "+v"(tid_o));
    const int tid = tid_o, lane = tid & 63, w = F.wave, r = lane & 31, hh = lane >> 5; unsigned char* ws = F.ws;
    const bool prompt = gb < NBP; const int L = prompt ? SEQ : LS; const int sb = gb - NBP; const size_t row_base = prompt ? (size_t)gb * SEQ : (size_t)TP + (size_t)sb * LS;
    const int g = h >> 3;
    LAS unsigned char* Lb = F.lds + RING_OFF;
    LAS unsigned short* BN = (LAS unsigned short*)(Lb + SD_BN); LAS unsigned short* CN = (LAS unsigned short*)(Lb + SD_CN);
    LAS unsigned short* BT = (LAS unsigned short*)(Lb + SD_BT); LAS unsigned short* XT = (LAS unsigned short*)(Lb + SD_XT);
    LAS unsigned short* HT = (LAS unsigned short*)(Lb + SD_HT);
    LAS float* YB = (LAS float*)(Lb + SD_YB);
    LAS float* CUM = (LAS float*)(Lb + SD_CUM); LAS float* DTV = (LAS float*)(Lb + SD_DTV); LAS float* ECUM = (LAS float*)(Lb + SD_ECUM);
    const bf16* PROJ = (const bf16*)(ws + WS_PROJ); const float* DTR = (const float*)(ws + WS_DT); bf16* YG = (bf16*)(ws + WS_YG); float* SSQ = (float*)(ws + WS_SSQSSD);
    const int nt = w >> 1, pt = w & 1;
    f32x16 H;
    float* st_g = (prompt ? F.out + O_SSMP + (size_t)(gb * 32 + h) * 8192 : F.out + O_SSMS + (size_t)(sb * 32 + h) * 8192) + (size_t)(32 * pt + r) * 128 + 32 * nt + 4 * hh;
    if (prompt) {
#pragma unroll
        for (int i = 0; i < 16; ++i) H[i] = 0.f;
    } else { const float* sp = F.in[3] + (size_t)(sb * 32 + h) * 8192 + (size_t)(32 * pt + r) * 128 + 32 * nt + 4 * hh;
#pragma unroll
        for (int q4 = 0; q4 < 4; ++q4) { const f32x4 v = *(const f32x4*)(sp + 8 * q4); H[4 * q4] = v.x; H[4 * q4 + 1] = v.y; H[4 * q4 + 2] = v.z; H[4 * q4 + 3] = v.w; } }
    {
        LAS unsigned short* hp = HT + (32 * pt + r) * 136 + 32 * nt + 4 * hh;
#pragma unroll
        for (int q4 = 0; q4 < 4; ++q4) { v2u pk; pk.x = cvtpk_c(H[4 * q4], H[4 * q4 + 1]); pk.y = cvtpk_c(H[4 * q4 + 2], H[4 * q4 + 3]); *(LAS v2u*)(hp + 8 * q4) = pk; }
    }
    const float a = -__expf(F.in[13][h]), dtb = F.in[12][h], Dk = F.in[14][h];
    const float* cw = F.in[10]; const float* cbp = F.in[11]; const float* sconv = F.in[4] + (size_t)(prompt ? 0 : sb) * 3 * 3072;
    const int typ = tid < 64 ? 0 : (tid < 192 ? 1 : 2);
    const int idx = typ == 0 ? tid : (typ == 1 ? tid - 64 : tid - 192);
    const int cgl = typ == 0 ? (idx & 7) : (idx & 15), seg = typ == 0 ? (idx >> 3) : (idx >> 4);
    const int col = typ == 0 ? h * 64 + 8 * cgl : (typ == 1 ? 2048 + g * 128 + 8 * cgl : 2560 + g * 128 + 8 * cgl);
    const bf16* cptr = PROJ + (size_t)(S_X0 + (col >> 10)) * SLOT_ELEMS + row_base * 1024 + (col & 1023);
    v4u raw[11];
#pragma unroll
    for (int i = 0; i < 11; ++i) raw[i] = (v4u){0u, 0u, 0u, 0u};
    if (tid < 320) {
#pragma unroll
        for (int i = 0; i < 11; ++i) { const int gt = 8 * seg - 3 + i; v4u v = (v4u){0u, 0u, 0u, 0u};
            if (gt >= 0 && gt < L) v = *(const v4u*)(cptr + (size_t)gt * 1024);
            else if (gt < 0 && !prompt) { const float* sp = sconv + (size_t)(3 + gt) * 3072 + col; const f32x4 a4 = *(const f32x4*)sp, b4 = *(const f32x4*)(sp + 4);
                v.x = pk2(a4.x, a4.y); v.y = pk2(a4.z, a4.w); v.z = pk2(b4.x, b4.y); v.w = pk2(b4.z, b4.w); }
            raw[i] = v; }
    }
    int buf = 0;
    float dt_pf = 0.f;
    if (lane < L) dt_pf = DTR[(row_base + lane) * 32 + h];
    for (int t0 = 0; t0 < L; t0 += 64, buf ^= 1) {
        int r_l = r, hh_l = hh, tid_l = tid, lane_l = lane;
        asm volatile("" : "+v"(r_l), "+v"(hh_l), "+v"(tid_l), "+v"(lane_l));
        { const int r = r_l, hh = hh_l, tid = tid_l, lane = lane_l;
        float dtv = 0.f;
        if (t0 + lane < L) { const float x = dt_pf + dtb; dtv = x > 20.f ? x : log1pf(__expf(x)); }
        dt_pf = 0.f; if (t0 + 64 + lane < L) dt_pf = DTR[(row_base + t0 + 64 + lane) * 32 + h];
        v4u zw = (v4u){0u, 0u, 0u, 0u};
        if (t0 + (tid >> 3) < L) zw = *(const v4u*)(PROJ + (size_t)(S_Z0 + (h >> 4)) * SLOT_ELEMS + (row_base + t0 + (tid >> 3)) * 1024 + (h & 15) * 64 + (tid & 7) * 8);
        float cum = dtv * a;
#pragma unroll
        for (int o = 1; o < 64; o <<= 1) { const float u = __shfl_up(cum, o); if (lane >= o) cum += u; }
        const float cum_last = __shfl(cum, 63);
        const float wgt = __expf(cum_last - cum) * dtv;
        if (w == 0) { CUM[lane] = cum; DTV[lane] = dtv; ECUM[lane] = __expf(cum); }
        if (tid < 320) {
            float wv[8];
#pragma unroll
            for (int i = 0; i < 8; ++i) wv[i] = __shfl(wgt, 8 * seg + i);
            v4u rowpk[8];
#pragma unroll
            for (int kp = 0; kp < 4; ++kp) {
                const int c0 = col + 2 * kp; typedef float f32x2 __attribute__((ext_vector_type(2)));
                const f32x2 cw0 = *(const f32x2*)(cw + c0), cw1 = *(const f32x2*)(cw + 3072 + c0), cw2 = *(const f32x2*)(cw + 2 * 3072 + c0), cw3 = *(const f32x2*)(cw + 3 * 3072 + c0), cbb = *(const f32x2*)(cbp + c0);
                f32x2 xv[11];
#pragma unroll
                for (int i = 0; i < 11; ++i) { const unsigned wd = raw[i][kp]; xv[i] = (f32x2){__uint_as_float(wd << 16), __uint_as_float(wd & 0xffff0000u)}; }
                f32x2 o[8];
#pragma unroll
                for (int i = 0; i < 8; ++i) { f32x2 a = cw0 * xv[i] + cbb; a = cw1 * xv[i + 1] + a; a = cw2 * xv[i + 2] + a; a = cw3 * xv[i + 3] + a;
                    const f32x2 t = a * (-1.4426950408889634f); f32x2 e; e.x = __builtin_amdgcn_exp2f(t.x); e.y = __builtin_amdgcn_exp2f(t.y); e = e + 1.0f;
                    f32x2 rc; rc.x = __builtin_amdgcn_rcpf(e.x); rc.y = __builtin_amdgcn_rcpf(e.y); o[i] = a * rc; }
                if (typ == 0) { const int p = 8 * cgl + 2 * kp;
                    v4u pa; pa.x = pk2(o[0].x, o[1].x); pa.y = pk2(o[2].x, o[3].x); pa.z = pk2(o[4].x, o[5].x); pa.w = pk2(o[6].x, o[7].x); *(LAS v4u*)(XT + p * 72 + 8 * seg) = pa;
                    v4u pb; pb.x = pk2(o[0].y, o[1].y); pb.y = pk2(o[2].y, o[3].y); pb.z = pk2(o[4].y, o[5].y); pb.w = pk2(o[6].y, o[7].y); *(LAS v4u*)(XT + (p + 1) * 72 + 8 * seg) = pb; }
                else {
#pragma unroll
                    for (int i = 0; i < 8; ++i) rowpk[i][kp] = pk2(o[i].x, o[i].y);
                    if (typ == 1) { const int n = 8 * cgl + 2 * kp; f32x2 ow[8];
#pragma unroll
                        for (int i = 0; i < 8; ++i) ow[i] = o[i] * wv[i];
                        v4u pa; pa.x = pk2(ow[0].x, ow[1].x); pa.y = pk2(ow[2].x, ow[3].x); pa.z = pk2(ow[4].x, ow[5].x); pa.w = pk2(ow[6].x, ow[7].x); *(LAS v4u*)(BT + n * 72 + 8 * seg) = pa;
                        v4u pb; pb.x = pk2(ow[0].y, ow[1].y); pb.y = pk2(ow[2].y, ow[3].y); pb.z = pk2(ow[4].y, ow[5].y); pb.w = pk2(ow[6].y, ow[7].y); *(LAS v4u*)(BT + (n + 1) * 72 + 8 * seg) = pb; } }
            }
            if (typ != 0) { LAS unsigned short* dstn = (typ == 1 ? BN : CN) + (8 * seg) * 136 + 8 * cgl;
#pragma unroll
                for (int i = 0; i < 8; ++i) *(LAS v4u*)(dstn + i * 136) = rowpk[i]; }
#pragma unroll
            for (int i = 0; i < 11; ++i) { const int gt = t0 + 64 + 8 * seg - 3 + i; v4u v = (v4u){0u, 0u, 0u, 0u};
                if (gt < L) v = *(const v4u*)(cptr + (size_t)gt * 1024);
                raw[i] = v; }
        }
        __syncthreads();
        if (w < 4) {
            const int tt = nt;
            f32x16 yi, ya;
#pragma unroll
            for (int i = 0; i < 16; ++i) { yi[i] = 0.f; ya[i] = 0.f; }
            const LAS unsigned char* cn_nat = Lb + SD_CN + (32 * tt + r) * 272 + hh * 16; const LAS unsigned char* ht_nat = Lb + SD_HT + buf * 17408 + (32 * pt + r) * 272 + hh * 16;
#pragma unroll 2
            for (int ks = 0; ks < 8; ++ks) yi = MFMA32(lds_frag16(cn_nat + ks * 32), lds_frag16(ht_nat + ks * 32), yi);
            const float cum_t = CUM[32 * tt + r];
#pragma unroll 1
            for (int st = 0; st <= tt; ++st) {
                f32x16 X;
#pragma unroll
                for (int i = 0; i < 16; ++i) X[i] = 0.f;
                const LAS unsigned char* bn_nat = Lb + SD_BN + (32 * st + r) * 272 + hh * 16;
#pragma unroll 2
                for (int ks = 0; ks < 8; ++ks) X = MFMA32(lds_frag16(bn_nat + ks * 32), lds_frag16(cn_nat + ks * 32), X);
#pragma unroll
                for (int q4 = 0; q4 < 4; ++q4) { const f32x4 cs = *(const LAS f32x4*)(CUM + 32 * st + 8 * q4 + 4 * hh), ds = *(const LAS f32x4*)(DTV + 32 * st + 8 * q4 + 4 * hh);
#pragma unroll
                    for (int jj = 0; jj < 4; ++jj) { const int s_abs = 32 * st + 8 * q4 + 4 * hh + jj; const float f = __expf(fminf(cum_t - cs[jj], 0.f)) * ds[jj]; X[4 * q4 + jj] = (s_abs <= 32 * tt + r) ? X[4 * q4 + jj] * f : 0.f; } }
                const LAS unsigned char* xt_row = Lb + SD_XT + (32 * pt + r) * 144 + (32 * st + 4 * hh) * 2;
                ya = MFMA32(ACC_FRAG(X, 0), lds_frag8x2(xt_row), ya);
                ya = MFMA32(ACC_FRAG(X, 1), lds_frag8x2(xt_row + 32), ya);
            }
            const LAS unsigned short* xt_p = XT + (32 * pt + r) * 72 + 32 * tt + 4 * hh;
#pragma unroll
            for (int q4 = 0; q4 < 4; ++q4) { const f32x4 ec = *(const LAS f32x4*)(ECUM + 32 * tt + 8 * q4 + 4 * hh); const v2u xw = *(const LAS v2u*)(xt_p + 8 * q4);
                const float x0 = bf2f(xw.x & 0xffffu), x1 = bf2f(xw.x >> 16), x2 = bf2f(xw.y & 0xffffu), x3 = bf2f(xw.y >> 16);
                LAS float* yb = YB + (32 * tt + 8 * q4 + 4 * hh) * 68 + 32 * pt + r;
                yb[0] = ya[4 * q4] + ec[0] * yi[4 * q4] + Dk * x0; yb[68] = ya[4 * q4 + 1] + ec[1] * yi[4 * q4 + 1] + Dk * x1;
                yb[136] = ya[4 * q4 + 2] + ec[2] * yi[4 * q4 + 2] + Dk * x2; yb[204] = ya[4 * q4 + 3] + ec[3] * yi[4 * q4 + 3] + Dk * x3; }
        }
        {
            const float el = __expf(CUM[63]);
#pragma unroll
            for (int i = 0; i < 16; ++i) H[i] *= el;
            const LAS unsigned char* bt_nat = Lb + SD_BT + (32 * nt + r) * 144 + hh * 16; const LAS unsigned char* xt_nat = Lb + SD_XT + (32 * pt + r) * 144 + hh * 16;
#pragma unroll
            for (int s2 = 0; s2 < 4; ++s2) H = MFMA32(lds_frag16(bt_nat + s2 * 32), lds_frag16(xt_nat + s2 * 32), H);
            LAS unsigned short* hp = HT + (buf ^ 1) * 8704 + (32 * pt + r) * 136 + 32 * nt + 4 * hh;
#pragma unroll
            for (int q4 = 0; q4 < 4; ++q4) { v2u pk; pk.x = cvtpk_c(H[4 * q4], H[4 * q4 + 1]); pk.y = cvtpk_c(H[4 * q4 + 2], H[4 * q4 + 3]); *(LAS v2u*)(hp + 8 * q4) = pk; }
        }
        __syncthreads();
        { const int tt = tid >> 3, p0 = (tid & 7) * 8;
          if (t0 + tt < L) { const size_t row = row_base + t0 + tt;
            const f32x4 y0 = *(const LAS f32x4*)(YB + tt * 68 + p0), y1 = *(const LAS f32x4*)(YB + tt * 68 + p0 + 4);
            float o[8]; float sq = 0.f;
#pragma unroll
            for (int j = 0; j < 8; ++j) { const unsigned z16 = (zw[j >> 1] >> ((j & 1) * 16)) & 0xffffu; const float yv = (j < 4 ? y0[j & 3] : y1[j & 3]) * silu_f(bf2f(z16)); o[j] = yv; sq += yv * yv; }
            v4u ow; ow.x = pk2(o[0], o[1]); ow.y = pk2(o[2], o[3]); ow.z = pk2(o[4], o[5]); ow.w = pk2(o[6], o[7]);
            *(v4u*)(YG + row * 2048 + h * 64 + p0) = ow;
            sq += __shfl_xor(sq, 1); sq += __shfl_xor(sq, 2); sq += __shfl_xor(sq, 4);
            if ((tid & 7) == 0) SSQ[row * 32 + h] = sq; } }
        }
    }
#pragma unroll
    for (int q4 = 0; q4 < 4; ++q4) *(f32x4*)(st_g + 8 * q4) = (f32x4){H[4 * q4], H[4 * q4 + 1], H[4 * q4 + 2], H[4 * q4 + 3]};
    __syncthreads();
}
constexpr int U_HGP = NBP * 8, U_SSDP = NBP * 32, U_HGS = NBS * 8, U_SSDS = NBS * 32, U_CONV = NBP + NBS;
__device__ __forceinline__ void scan_phase(Frame& F) {
    gu32* head = F.ctl + CW_QUEUE;
    for (;;) {
        if (F.tid == 0) F.MISC[0] = __hip_atomic_fetch_add(head, 1u, RLX_AGENT);
        __syncthreads();
        const int u = (int)F.MISC[0];
        __syncthreads();
        if (u >= U_HGP + U_HGS) break;
        const int gb = u < U_HGP ? (u >> 3) : NBP + ((u - U_HGP) >> 3);
        hgrn_unit_mfma(F, gb, u & 7);
    }
    for (;;) {
        if (F.tid == 0) F.MISC[0] = __hip_atomic_fetch_add(head + 64, 1u, RLX_AGENT);
        __syncthreads();
        const int u = (int)F.MISC[0];
        __syncthreads();
        if (u >= U_SSDP + U_SSDS + U_CONV) break;
        if (u >= U_SSDP + U_SSDS) { conv_copy_unit(F, u - (U_SSDP + U_SSDS)); continue; }
        const int gb = u < U_SSDP ? (u >> 5) : NBP + ((u - U_SSDP) >> 5);
        ssd_unit_mfma(F, gb, u & 31);
    }
}
typedef float f32x4s __attribute__((ext_vector_type(4)));
template <class Epi> __device__ __forceinline__ void small_tile_phase(Frame& F, const bf16* A, const bf16* Bt, int K, const Epi& E) {
    if (F.G != 256) return;
    const int lane = F.lane, w = F.wave, fr = lane & 15, fq = lane >> 4;
    const int mt = F.vcu >> 4, nt = F.vcu & 15;
    const int row = TP + 32 * mt + 16 * (w & 1) + fr, colb = 64 * nt + 16 * (w >> 1);
    const bf16* ap = A + (size_t)row * K + 8 * fq;
    const bf16* bp = Bt + (size_t)(colb + fr) * K + 8 * fq;
    f32x4s acc = (f32x4s){0.f, 0.f, 0.f, 0.f};
#pragma unroll 8
    for (int ks = 0; ks < K / 32; ++ks) { const bf16x8 bf = *(const bf16x8*)(bp + 32 * ks), af = *(const bf16x8*)(ap + 32 * ks); acc = __builtin_amdgcn_mfma_f32_16x16x32_bf16(bf, af, acc, 0, 0, 0); }
    E.small(F, acc, row, colb + 4 * fq, nt);
}
template <bool ADD> struct SmGate { bf16* O; const bf16* gate;
    __device__ __forceinline__ void small(Frame&, const f32x4s& a, int row, int col, int) const { const size_t off = (size_t)row * 1024 + col;
        const v2u gw = *(const v2u*)(gate + off); v2u ow = (v2u){0u, 0u}; if (ADD) ow = *(const v2u*)(O + off);
        float rr[4];
#pragma unroll
        for (int e = 0; e < 4; ++e) { const unsigned g16 = (gw[e >> 1] >> ((e & 1) * 16)) & 0xffffu, o16 = (ow[e >> 1] >> ((e & 1) * 16)) & 0xffffu; rr[e] = (ADD ? bf2f(o16) : 0.f) + sigmoid_f(bf2f(g16)) * a[e]; }
        v2u wv; wv.x = cvtpk_c(rr[0], rr[1]); wv.y = cvtpk_c(rr[2], rr[3]); *(v2u*)(O + off) = wv; } };
struct SmRes { const float* base; float* out; bf16* hb; float* ssqp;
    __device__ __forceinline__ void small(Frame& F, const f32x4s& a, int row, int col, int nt) const { const size_t off = (size_t)row * 1024 + col;
        const f32x4 v = *(const f32x4*)(base + off) + (f32x4){a[0], a[1], a[2], a[3]}; *(f32x4*)(out + off) = v;
        if (hb) { v2u wv; wv.x = cvtpk_c(v[0], v[1]); wv.y = cvtpk_c(v[2], v[3]); *(v2u*)(hb + off) = wv; }
        float sq = (v[0] * v[0] + v[1] * v[1]) + (v[2] * v[2] + v[3] * v[3]); sq += __shfl_xor(sq, 16); sq += __shfl_xor(sq, 32);
        LAS float* red = (LAS float*)(F.lds + RING_OFF);
        const int rl = 16 * (F.wave & 1) + (F.lane & 15);
        if ((F.lane >> 4) == 0) red[rl * 4 + (F.wave >> 1)] = sq;
        __syncthreads();
        if (F.tid < 32) { const f32x4 p = *(const LAS f32x4*)(red + F.tid * 4); ssqp[(size_t)(row - rl + F.tid) * 16 + nt] = (p[0] + p[1]) + (p[2] + p[3]); }
        __syncthreads(); } };
struct SmScale { bf16* O; const float* ssq; float scale;
    __device__ __forceinline__ void small(Frame&, const f32x4s& a, int row, int col, int) const { const float rs = pg8::row_rs<16>(ssq, row) * scale;
        v2u wv; wv.x = cvtpk_c(a[0] * rs, a[1] * rs); wv.y = cvtpk_c(a[2] * rs, a[3] * rs); *(v2u*)(O + (size_t)row * 1024 + col) = wv; } };
__device__ __forceinline__ void attn_stage_tile(LAS unsigned char* Lb, const bf16* src, size_t pitch, int tid) {
#pragma unroll 1
    for (int hb = 0; hb < 2; ++hb) { v4u v[8];
#pragma unroll
        for (int i = 0; i < 8; ++i) { const int id = tid + 512 * (8 * hb + i), row = id >> 5, c = id & 31; v[i] = *(const v4u*)(src + (size_t)row * pitch + c * 8); }
#pragma unroll
        for (int i = 0; i < 8; ++i) { const int id = tid + 512 * (8 * hb + i), row = id >> 5, c = id & 31; *(LAS v4u*)(Lb + row * 512 + ((c ^ (row & 15)) << 4)) = v[i]; } }
}
__device__ __forceinline__ void attn_prompt_unit(Frame& F, int b, int hd, int qb) {
    const int tid = F.tid, lane = F.lane, w = F.wave, r = lane & 31, hh = lane >> 5; unsigned char* ws = F.ws;
    LAS unsigned char* Lb = F.lds + RING_OFF;
    const bf16* QB = (const bf16*)(ws + WS_QB); const bf16* KB = (const bf16*)(ws + WS_KB); const bf16* VT = (const bf16*)(ws + WS_VT); bf16* OB = (bf16*)(ws + WS_OB);
    const size_t qrow = (size_t)b * SEQ + (size_t)qb * 256 + 32 * w + r;
    attn_stage_tile(Lb, KB + (size_t)b * 256 * 1024 + hd * 256, 1024, tid);
    const bf16* qp = QB + qrow * 1024 + hd * 256 + 8 * hh;
    bf16x8 qf = *(const bf16x8*)qp;
    __syncthreads();
    f32x16 S[8];
#pragma unroll
    for (int t = 0; t < 8; ++t)
#pragma unroll
        for (int i = 0; i < 16; ++i) S[t][i] = 0.f;
    const int sw = r & 15;
#pragma unroll 1
    for (int ks = 0; ks < 16; ++ks) {
        const bf16x8 qn = *(const bf16x8*)(qp + 16 * (ks < 15 ? ks + 1 : ks));
        const LAS unsigned char* kp = Lb + r * 512 + (((2 * ks + hh) ^ sw) << 4);
#pragma unroll
        for (int t = 0; t < 8; ++t) S[t] = MFMA32(lds_frag16(kp + t * 32 * 512), qf, S[t]);
        qf = qn;
    }
    float m = -3.0e38f;
#pragma unroll
    for (int t = 0; t < 8; ++t)
#pragma unroll
        for (int i = 0; i < 16; ++i) m = fmaxf(m, S[t][i]);
    m = fmaxf(m, __shfl_xor(m, 32));
    float l = 0.f;
#pragma unroll
    for (int t = 0; t < 8; ++t)
#pragma unroll
        for (int i = 0; i < 16; ++i) { const float pv = __builtin_amdgcn_exp2f(S[t][i] - m); S[t][i] = pv; l += pv; }
    l += __shfl_xor(l, 32);
    const float rl = __builtin_amdgcn_rcpf(l);
    bf16x8 pf[8][2];
#pragma unroll
    for (int t = 0; t < 8; ++t) { pf[t][0] = ACC_FRAG(S[t], 0); pf[t][1] = ACC_FRAG(S[t], 1); }
    __syncthreads();
    attn_stage_tile(Lb, VT + (size_t)(b * 4 + hd) * 256 * 256, 256, tid);
    __syncthreads();
    bf16* op = OB + qrow * 1024 + hd * 256 + 4 * hh;
#pragma unroll 1
    for (int dt = 0; dt < 8; ++dt) {
        f32x16 O;
#pragma unroll
        for (int i = 0; i < 16; ++i) O[i] = 0.f;
        const LAS unsigned char* vrow = Lb + (32 * dt + r) * 512 + 8 * hh;
#pragma unroll
        for (int t = 0; t < 8; ++t)
#pragma unroll
            for (int s2 = 0; s2 < 2; ++s2) {
                const v2u lo = *(const LAS v2u*)(vrow + (((4 * t + 2 * s2) ^ sw) << 4)), hi = *(const LAS v2u*)(vrow + (((4 * t + 2 * s2 + 1) ^ sw) << 4));
                const v4u wv4 = (v4u){lo.x, lo.y, hi.x, hi.y};
                O = MFMA32(__builtin_bit_cast(bf16x8, wv4), pf[t][s2], O);
            }
#pragma unroll
        for (int q4 = 0; q4 < 4; ++q4) { v2u o; o.x = cvtpk_c(O[4 * q4] * rl, O[4 * q4 + 1] * rl); o.y = cvtpk_c(O[4 * q4 + 2] * rl, O[4 * q4 + 3] * rl);
            *(v2u*)(op + 32 * dt + 8 * q4) = o; }
    }
    __syncthreads();
}
__device__ __forceinline__ void attn_sample_unit(Frame& F, int sb, int hd) {
    const int tid = F.tid, lane = F.lane, w = F.wave; unsigned char* ws = F.ws;
    LAS float* sc = (LAS float*)(F.lds + RING_OFF);
    LAS float* red = sc + 4 * 256;
    const bf16* QB = (const bf16*)(ws + WS_QB); bf16* OB = (bf16*)(ws + WS_OB);
    const size_t rowq = (size_t)TP + (size_t)sb * LS;
    float q[4][4];
#pragma unroll
    for (int t = 0; t < 4; ++t) { const v2u qw = *(const v2u*)(QB + (rowq + t) * 1024 + hd * 256 + 4 * lane); q[t][0] = bf2f(qw.x & 0xffffu); q[t][1] = bf2f(qw.x >> 16); q[t][2] = bf2f(qw.y & 0xffffu); q[t][3] = bf2f(qw.y >> 16); }
    const float* Kc = F.in[6] + ((size_t)sb * 256 * 4 + hd) * 256 + 4 * lane; const float* Vc = F.in[7] + ((size_t)sb * 256 * 4 + hd) * 256 + 4 * lane;
#pragma unroll 1
    for (int kk0 = 0; kk0 < 32; kk0 += 8) { f32x4 kv[8];
#pragma unroll
        for (int u = 0; u < 8; ++u) kv[u] = *(const f32x4*)(Kc + (size_t)(w * 32 + kk0 + u) * 1024);
#pragma unroll
        for (int u = 0; u < 8; ++u) { const int key = w * 32 + kk0 + u;
#pragma unroll
            for (int t = 0; t < 4; ++t) { float s = (q[t][0] * kv[u].x + q[t][1] * kv[u].y) + (q[t][2] * kv[u].z + q[t][3] * kv[u].w); s = wave_sum(s); if (lane == 0) sc[t * 256 + key] = s; } } }
    __syncthreads();
    if (w < 4) { float v[4]; float m = -3.0e38f;
#pragma unroll
        for (int j = 0; j < 4; ++j) { v[j] = sc[w * 256 + j * 64 + lane]; m = fmaxf(m, v[j]); }
        m = wave_max(m); float l = 0.f;
#pragma unroll
        for (int j = 0; j < 4; ++j) { v[j] = __builtin_amdgcn_exp2f(v[j] - m); l += v[j]; }
        l = wave_sum(l); const float rl = 1.0f / l;
#pragma unroll
        for (int j = 0; j < 4; ++j) sc[w * 256 + j * 64 + lane] = v[j] * rl; }
    __syncthreads();
    float o[4][4];
#pragma unroll
    for (int t = 0; t < 4; ++t)
#pragma unroll
        for (int e = 0; e < 4; ++e) o[t][e] = 0.f;
#pragma unroll 1
    for (int kk0 = 0; kk0 < 32; kk0 += 8) { f32x4 vv[8];
#pragma unroll
        for (int u = 0; u < 8; ++u) vv[u] = *(const f32x4*)(Vc + (size_t)(w * 32 + kk0 + u) * 1024);
#pragma unroll
        for (int u = 0; u < 8; ++u) { const int key = w * 32 + kk0 + u;
#pragma unroll
            for (int t = 0; t < 4; ++t) { const float pr = sc[t * 256 + key]; o[t][0] += pr * vv[u].x; o[t][1] += pr * vv[u].y; o[t][2] += pr * vv[u].z; o[t][3] += pr * vv[u].w; } } }
#pragma unroll
    for (int t = 0; t < 4; ++t) *(LAS f32x4*)(red + (w * 4 + t) * 256 + 4 * lane) = (f32x4){o[t][0], o[t][1], o[t][2], o[t][3]};
    __syncthreads();
    { const int t = tid >> 7, d0 = (tid & 127) * 2; float a0 = 0.f, a1 = 0.f;
#pragma unroll
      for (int ww = 0; ww < 8; ++ww) { a0 += red[(ww * 4 + t) * 256 + d0]; a1 += red[(ww * 4 + t) * 256 + d0 + 1]; }
      *(unsigned*)(OB + (rowq + t) * 1024 + hd * 256 + d0) = pk2(a0, a1); }
    __syncthreads();
}
__device__ __forceinline__ void attn_phase(Frame& F) {
    for (int u = F.vcu; u < NBP * 4 * 8; u += F.G) attn_prompt_unit(F, u >> 5, (u >> 3) & 3, u & 7);
    for (int u = F.vcu; u < NBS * 4; u += F.G) attn_sample_unit(F, u >> 2, u & 3);
}
__device__ __forceinline__ void final_norm_phase(Frame& F) {
    const int gw = F.vcu * NWAVES + F.wave, NGW = F.G * NWAVES; const float* SSQ = (const float*)(F.ws + WS_SSQP3); const float* wn = F.in[31];
    f32x4 wv[4];
#pragma unroll
    for (int j = 0; j < 4; ++j) wv[j] = *((const f32x4*)wn + 64 * j + F.lane);
    for (int row = gw; row < T; row += NGW) {
        const f32x4* sp = (const f32x4*)(SSQ + (size_t)row * 16); float s = 0.f;
#pragma unroll
        for (int j = 0; j < 4; ++j) { const f32x4 a = sp[j]; s += (a.x + a.y) + (a.z + a.w); }
        const float rs = 1.0f / sqrtf(s * (1.0f / 1024.0f) + EPS);
        f32x4* p = (f32x4*)(F.out + O_Y + (size_t)row * 1024) + F.lane;
#pragma unroll
        for (int j = 0; j < 4; ++j) { const f32x4 v = p[64 * j]; p[64 * j] = v * rs * wv[j]; }
    }
}
#ifndef MK_N_LAUNCHES
#define MK_N_LAUNCHES 1
#endif
constexpr int PER_PHASE = 13;
constexpr int N_LAUNCHES = MK_N_LAUNCHES;
struct Args { const float* in[32]; float* out; unsigned char* ws; int ph_lo, ph_hi; };
__global__ void __launch_bounds__(NTHR, 2) skel_fwd(Args args) {
    extern __shared__ __attribute__((aligned(16))) unsigned char lds[];
    Frame F;
    F.lds = (LAS unsigned char*)lds;
    F.MISC = (volatile LAS unsigned*)(F.lds + MISC_OFF);
    F.tid = threadIdx.x; F.lane = F.tid & 63; F.wave = __builtin_amdgcn_readfirstlane(F.tid >> 6);
    F.G = gridDim.x; { const int bx = blockIdx.x; F.vcu = (F.G % 8 == 0) ? (bx % 8) * (F.G / 8) + bx / 8 : bx; }
    unsigned char* ws = args.ws; F.ws = ws; F.out = args.out;
    F.ctl = (gu32*)(ws + WS_CTL);
#pragma unroll
    for (int i = 0; i < 32; ++i) F.in[i] = args.in[i];
    for (int u = F.tid; u < (LDS_BYTES - LDSCTL_OFF) / 4; u += NTHR) ((LAS unsigned*)(F.lds + LDSCTL_OFF))[u] = 0u;
    __syncthreads();
    XcdBarrier bar; bar.bar = (unsigned*)(F.ctl + CW_BAR); bar.x = 0; bar.st = nullptr;
    if (N_LAUNCHES == 1) bar = xcd_barrier_post((unsigned*)(F.ctl + CW_BAR), F.MISC + 8);
#define GRID_BAR() do { if (N_LAUNCHES == 1) xcd_barrier(bar); } while (0)
    const int lo = args.ph_lo, hi = args.ph_hi;
#ifdef ONLY_PHASE
#define IN(k) ((k) == ONLY_PHASE && lo <= (k) && (k) < hi)
#else
#define IN(k) (lo <= (k) && (k) < hi)
#endif
#define BOTH(k) (IN(k) && IN((k) + 1))
    bf16* const XB = (bf16*)(ws + WS_XB); bf16* const PROJ = (bf16*)(ws + WS_PROJ);
    float* const Y = F.out + O_Y;
    if (IN(0)) { p0_prologue(F); if (BOTH(0)) GRID_BAR(); }
    if (IN(1)) {
        { pg8::Gemm g{XB, (const bf16*)(ws + WS_WIN), T, NPROJ, 1024}; pg8::StaticOrder S; S.init(T, NPROJ, F.G, (int)blockIdx.x);
          pg8::EpiScaleBf16<1, true> E{PROJ, SLOT_ELEMS, (const float*)(ws + WS_SSQX), 1.0f, (float*)(ws + WS_DT)};
          pg8::gemm_phase<pg8::EpiScaleBf16<1, true>, pg8::StaticOrder, true, true>(F.lds + RING_OFF, g, S, E); }
        { pg8::Gemm g{(const bf16*)(ws + WS_MNB), (const bf16*)(ws + WS_WKV), MEMR, 2048, 1024}; pg8::StaticOrder S; S.init(MEMR, 2048, F.G, (int)((blockIdx.x + 64) % F.G));
          pg8::EpiKV E{F.out + O_MKP, F.out + O_MVP, (bf16*)(ws + WS_KB), (bf16*)(ws + WS_VT), (const float*)(ws + WS_SSQM)};
          pg8::gemm_phase<pg8::EpiKV, pg8::StaticOrder, true, true>(F.lds + RING_OFF, g, S, E); }
        if (BOTH(1)) GRID_BAR();
    }
    if (IN(2)) { scan_phase(F); if (BOTH(2)) GRID_BAR(); }
    if (IN(3)) { ssdnorm_phase(F); if (BOTH(3)) GRID_BAR(); }
    if (IN(4)) { { SmGate<false> Es{(bf16*)(ws + WS_MERGED), PROJ + (size_t)S_GS * SLOT_ELEMS}; small_tile_phase(F, (const bf16*)(ws + WS_YG), (const bf16*)(ws + WS_WSSD), 2048, Es); }
        pg8::Gemm g{(const bf16*)(ws + WS_YG), (const bf16*)(ws + WS_WSSD), TP, 1024, 2048}; pg8::StaticOrder S; S.init(TP, 1024, F.G, (int)blockIdx.x);
        pg8::EpiGate<false> E{(bf16*)(ws + WS_MERGED), PROJ + (size_t)S_GS * SLOT_ELEMS};
        pg8::gemm_phase<pg8::EpiGate<false>, pg8::StaticOrder, true, true>(F.lds + RING_OFF, g, S, E);
        if (BOTH(4)) GRID_BAR(); }
    if (IN(5)) { { SmGate<true> Es{(bf16*)(ws + WS_MERGED), PROJ + (size_t)S_GH * SLOT_ELEMS}; small_tile_phase(F, (const bf16*)(ws + WS_ON), (const bf16*)(ws + WS_WHG), 1024, Es); }
        pg8::Gemm g{(const bf16*)(ws + WS_ON), (const bf16*)(ws + WS_WHG), TP, 1024, 1024}; pg8::StaticOrder S; S.init(TP, 1024, F.G, (int)blockIdx.x);
        pg8::EpiGate<true> E{(bf16*)(ws + WS_MERGED), PROJ + (size_t)S_GH * SLOT_ELEMS};
        pg8::gemm_phase<pg8::EpiGate<true>, pg8::StaticOrder, true, true>(F.lds + RING_OFF, g, S, E);
        if (BOTH(5)) GRID_BAR(); }
    if (IN(6)) { { SmRes Es{F.in[1] - (size_t)TP * 1024, Y, (bf16*)(ws + WS_HB), (float*)(ws + WS_SSQP1)}; small_tile_phase(F, (const bf16*)(ws + WS_MERGED), (const bf16*)(ws + WS_WOUT), 1024, Es); }
        pg8::Gemm g{(const bf16*)(ws + WS_MERGED), (const bf16*)(ws + WS_WOUT), TP, 1024, 1024}; pg8::StaticOrder S; S.init(TP, 1024, F.G, (int)blockIdx.x);
        pg8::EpiRes E{F.in[0], F.in[1] - (size_t)TP * 1024, Y, (bf16*)(ws + WS_HB), (float*)(ws + WS_SSQP1)};
        pg8::gemm_phase<pg8::EpiRes, pg8::StaticOrder, true, true>(F.lds + RING_OFF, g, S, E);
        if (BOTH(6)) GRID_BAR(); }
    if (IN(7)) { { SmScale Es{(bf16*)(ws + WS_QB), (const float*)(ws + WS_SSQP1), QSCALE}; small_tile_phase(F, (const bf16*)(ws + WS_HB), (const bf16*)(ws + WS_WCQ), 1024, Es); }
        pg8::Gemm g{(const bf16*)(ws + WS_HB), (const bf16*)(ws + WS_WCQ), TP, 1024, 1024}; pg8::StaticOrder S; S.init(TP, 1024, F.G, (int)blockIdx.x);
        pg8::EpiScaleBf16<16, false> E{(bf16*)(ws + WS_QB), SLOT_ELEMS, (const float*)(ws + WS_SSQP1), QSCALE, nullptr};
        pg8::gemm_phase<pg8::EpiScaleBf16<16, false>, pg8::StaticOrder, true, true>(F.lds + RING_OFF, g, S, E);
        if (BOTH(7)) GRID_BAR(); }
    if (IN(8)) { attn_phase(F); if (BOTH(8)) GRID_BAR(); }
    if (IN(9)) { { SmRes Es{Y, Y, (bf16*)(ws + WS_HB), (float*)(ws + WS_SSQP2)}; small_tile_phase(F, (const bf16*)(ws + WS_OB), (const bf16*)(ws + WS_WCO), 1024, Es); }
        pg8::Gemm g{(const bf16*)(ws + WS_OB), (const bf16*)(ws + WS_WCO), TP, 1024, 1024}; pg8::StaticOrder S; S.init(TP, 1024, F.G, (int)blockIdx.x);
        pg8::EpiRes E{Y, Y, Y, (bf16*)(ws + WS_HB), (float*)(ws + WS_SSQP2)};
        pg8::gemm_phase<pg8::EpiRes, pg8::StaticOrder, true, true>(F.lds + RING_OFF, g, S, E);
        if (BOTH(9)) GRID_BAR(); }
    if (IN(10)) { pg8::Gemm g{(const bf16*)(ws + WS_HB), (const bf16*)(ws + WS_WGU), T, 2 * FFN, 1024}; pg8::StaticOrder S; S.init(T, 2 * FFN, F.G, (int)blockIdx.x);
        pg8::EpiSwiglu E{(bf16*)(ws + WS_ACT), (const float*)(ws + WS_SSQP2)};
        pg8::gemm_phase<pg8::EpiSwiglu, pg8::StaticOrder, true, true>(F.lds + RING_OFF, g, S, E);
        if (BOTH(10)) GRID_BAR(); }
    if (IN(11)) { { SmRes Es{Y, Y, nullptr, (float*)(ws + WS_SSQP3)}; small_tile_phase(F, (const bf16*)(ws + WS_ACT), (const bf16*)(ws + WS_WDN), FFN, Es); }
        pg8::Gemm g{(const bf16*)(ws + WS_ACT), (const bf16*)(ws + WS_WDN), TP, 1024, FFN}; pg8::StaticOrder S; S.init(TP, 1024, F.G, (int)blockIdx.x);
        pg8::EpiRes E{Y, Y, Y, nullptr, (float*)(ws + WS_SSQP3)};
        pg8::gemm_phase<pg8::EpiRes, pg8::StaticOrder, true, true>(F.lds + RING_OFF, g, S, E);
        if (BOTH(11)) GRID_BAR(); }
    if (IN(12)) final_norm_phase(F);
#undef IN
#undef BOTH
}

extern "C" void kernel_launch(void* const* d_in, const int* in_sizes, int n_in, void* d_out, int out_size, void* d_ws, size_t ws_size, hipStream_t stream) {
    static int grid = 0;
    if (grid == 0) {
        const int want[32] = {TP * 1024, TS * 1024, MEMR * 1024, 33554432, 1179648, 16777216, 33554432, 33554432, 1024, 1024 * 11296, 4 * 3072, 3072, 32, 32, 32, 2048, 2048 * 1024, 2048, 1024,
                              1024 * 1024, 1024 * 1024, 1024, 1024, 1024 * 1024, 1024 * 1024, 1024 * 1024, 1024 * 1024, 1024, 1024 * FFN, 1024 * FFN, FFN * 1024, 1024};
        bool ok = (n_in == 32); for (int i = 0; ok && i < 32; ++i) if (in_sizes[i] != want[i]) { fprintf(stderr, "kernel_launch: input %d has %d elements, expected %d\n", i, in_sizes[i], want[i]); ok = false; }
        if (!ok || out_size != (int)O_END || ws_size < WS_END) { fprintf(stderr, "kernel_launch: unexpected shapes: n_in %d out %d ws %zu\n", n_in, out_size, ws_size); grid = -1; return; }
        int dev = 0, cus = 0, per_cu = 0;
        if (hipGetDevice(&dev) != hipSuccess || hipDeviceGetAttribute(&cus, hipDeviceAttributeMultiprocessorCount, dev) != hipSuccess) { grid = -1; return; }
        if (hipFuncSetAttribute((const void*)skel_fwd, hipFuncAttributeMaxDynamicSharedMemorySize, LDS_BYTES) != hipSuccess) { fprintf(stderr, "kernel_launch: hipFuncSetAttribute failed\n"); grid = -1; return; }
        if (hipOccupancyMaxActiveBlocksPerMultiprocessor(&per_cu, (const void*)skel_fwd, NTHR, LDS_BYTES) != hipSuccess || per_cu < 1) fprintf(stderr, "kernel_launch: occupancy query reports %d blocks per CU\n", per_cu);
        (void)hipGetLastError();
        grid = cus;
    }
    if (grid < 0) return;
    (void)hipMemsetAsync((char*)d_ws + WS_CTL, 0, CTL_ZERO_BYTES, stream);
    Args a{};
    for (int i = 0; i < 32; ++i) a.in[i] = (const float*)d_in[i];
    a.out = (float*)d_out; a.ws = (unsigned char*)d_ws;
    for (int li = 0; li < N_LAUNCHES; ++li) {
        a.ph_lo = (N_LAUNCHES == PER_PHASE) ? li : 0; a.ph_hi = (N_LAUNCHES == PER_PHASE) ? li + 1 : PER_PHASE;
        hipLaunchKernelGGL(skel_fwd, dim3(grid), dim3(NTHR), LDS_BYTES, stream, a);
    }
}
```

```cpp
#include <hip/hip_runtime.h>
#include <cstdio>
#include <cstdint>
namespace pg8 {
#define PG8_LAS __attribute__((address_space(3)))
typedef unsigned short bf16_t;
typedef short bf16x8 __attribute__((ext_vector_type(8)));
typedef float f32x4 __attribute__((ext_vector_type(4)));
typedef unsigned u32x4 __attribute__((ext_vector_type(4)));
constexpr int BM = 256, BK = 64, HALF = 128, HTB = HALF * BK * 2  , STAGE_BYTES = 8 * HTB, NXCD = 8, WGM = 8;

__host__ __device__ __forceinline__ int lds_byte(int r, int c) { const int st = (r >> 4) * 2 + (c >> 5), rr = r & 15, cc = c & 31, ob = rr * 64 + cc * 2; return st * 1024 + (ob ^ (((ob >> 9) & 1) << 5)); }
__host__ __device__ __forceinline__ void stage_rc(int b, int& R, int& C) { const int st = b / 1024, sb = b % 1024, swz = sb ^ (((sb >> 9) & 1) << 5); R = (st >> 1) * 16 + swz / 64; C = (st & 1) * 32 + (swz % 64) / 2; }
__host__ __device__ __forceinline__ int perm32(int rho) { const int n = rho >> 4, i = rho & 15; return 8 * (i >> 2) + 4 * n + (i & 3); }

struct Unit { int pm, pn; };
struct Gemm { const bf16_t* A; const bf16_t* Bt; int M, N, K; };

struct StaticOrder {
    int nM, nN, nwg, G, c;
    __host__ __device__ void init(int M, int N, int G_, int c_) { nM = M / BM; nN = N / BM; nwg = nM * nN; G = G_; c = c_; }
    __host__ __device__ bool next(int i, Unit& u) const {
        const long L = (long)i * G + c; if (L >= nwg) return false;
        int wgid = (int)L; { const int q = nwg / NXCD, r = nwg % NXCD, xcd = wgid % NXCD, off = wgid / NXCD; wgid = (xcd < r ? xcd * (q + 1) : r * (q + 1) + (xcd - r) * q) + off; }
        const int nig = WGM * nN, gid = wgid / nig, fm = gid * WGM, gsz = (nM - fm) < WGM ? (nM - fm) : WGM;
        u.pm = fm + ((wgid % nig) % gsz); u.pn = (wgid % nig) / gsz; return true;
    }
    __device__ __forceinline__ void a_ready(const Unit&) const {}
    __device__ __forceinline__ void done(const Unit&) const {}
};

__device__ __forceinline__ unsigned cvt_pk_bf16(float lo, float hi) { unsigned r; asm volatile("v_cvt_pk_bf16_f32 %0, %1, %2" : "=v"(r) : "v"(lo), "v"(hi)); return r; }
typedef float f32x2 __attribute__((ext_vector_type(2)));
typedef unsigned u32x2 __attribute__((ext_vector_type(2)));
constexpr float RMS_EPS = 1e-6f;
__device__ __forceinline__ float bfbits2f(unsigned v16) { return __uint_as_float(v16 << 16); }
__device__ __forceinline__ float sigm(float x) { return __builtin_amdgcn_rcpf(1.0f + __expf(-x)); }
template <int NP> __device__ __forceinline__ float row_rs(const float* ssq, int row) {
    float s = 0.f;
    if constexpr (NP == 1) s = ssq[row];
    else {
#pragma unroll
        for (int i = 0; i < NP / 4; ++i) { const f32x4 v = *(const f32x4*)(ssq + (size_t)row * NP + 4 * i); s += (v[0] + v[1]) + (v[2] + v[3]); }
    }
    return 1.0f / sqrtf(s * (1.0f / 1024.0f) + RMS_EPS);
}
template <int NP, bool HAS_DT> struct EpiScaleBf16 {
    static constexpr bool PERM = true, AFTER_DRAIN = false;
    bf16_t* O; size_t slot_elems; const float* ssq; float scale; float* dt;
    __device__ __forceinline__ void operator()(const f32x4 (&acc)[2][2][4][2], const Unit& u, int wr, int wc, int fr, int fq) const {
        const int row0 = u.pm * BM + wr * 64 + fr;
        if (HAS_DT && u.pn == 44) {
            if (wc == 0) {
#pragma unroll
                for (int ai = 0; ai < 2; ++ai)
#pragma unroll
                    for (int m = 0; m < 4; ++m) { const int row = row0 + ai * HALF + m * 16; const float rs = row_rs<NP>(ssq, row);
                        float* p = dt + (size_t)row * 32 + 8 * fq; *(f32x4*)p = acc[ai][0][m][0] * rs; *(f32x4*)(p + 4) = acc[ai][0][m][1] * rs; }
            }
            return;
        }
        bf16_t* base = O + (size_t)(u.pn >> 2) * slot_elems; const int col0 = (u.pn & 3) * BM + wc * 32 + 8 * fq;
#pragma unroll
        for (int ai = 0; ai < 2; ++ai)
#pragma unroll
            for (int m = 0; m < 4; ++m) { const int row = row0 + ai * HALF + m * 16; const float rs = row_rs<NP>(ssq, row) * scale; bf16_t* rowp = base + (size_t)row * 1024 + col0;
#pragma unroll
                for (int bj = 0; bj < 2; ++bj) { const f32x4 v0 = acc[ai][bj][m][0] * rs, v1 = acc[ai][bj][m][1] * rs;
                    u32x4 w; w.x = cvt_pk_bf16(v0[0], v0[1]); w.y = cvt_pk_bf16(v0[2], v0[3]); w.z = cvt_pk_bf16(v1[0], v1[1]); w.w = cvt_pk_bf16(v1[2], v1[3]);
                    *(u32x4*)(rowp + bj * HALF) = w; } }
    }
};
struct EpiKV {
    static constexpr bool PERM = false, AFTER_DRAIN = false;
    float* mk; float* mv; bf16_t* kb; bf16_t* vt; const float* ssq;
    __device__ __forceinline__ void operator()(const f32x4 (&acc)[2][2][4][2], const Unit& u, int wr, int wc, int fr, int fq) const {
        const int row0 = u.pm * BM + wr * 64 + fr; const bool isv = u.pn >= 4; const int colt = (u.pn & 3) * BM + wc * 32 + 4 * fq;
#pragma unroll
        for (int ai = 0; ai < 2; ++ai)
#pragma unroll
            for (int m = 0; m < 4; ++m) { const int row = row0 + ai * HALF + m * 16; const float rs = row_rs<1>(ssq, row);
#pragma unroll
                for (int bj = 0; bj < 2; ++bj)
#pragma unroll
                    for (int n = 0; n < 2; ++n) { const int c = colt + bj * HALF + n * 16; const f32x4 v = acc[ai][bj][m][n] * rs;
                        if (!isv) { *(f32x4*)(mk + (size_t)row * 1024 + c) = v; u32x2 w; w.x = cvt_pk_bf16(v[0], v[1]); w.y = cvt_pk_bf16(v[2], v[3]); *(u32x2*)(kb + (size_t)row * 1024 + c) = w; }
                        else { *(f32x4*)(mv + (size_t)row * 1024 + c) = v; const int b = row >> 8, key = row & 255, hd = c >> 8, d = c & 255;
                            bf16_t* p = vt + ((size_t)((b * 4 + hd) * 256 + d)) * 256 + key; const unsigned w0 = cvt_pk_bf16(v[0], v[1]), w1 = cvt_pk_bf16(v[2], v[3]);
                            p[0] = (bf16_t)(w0 & 0xffffu); p[256] = (bf16_t)(w0 >> 16); p[512] = (bf16_t)(w1 & 0xffffu); p[768] = (bf16_t)(w1 >> 16); } } }
    }
};
template <bool ADD> struct EpiGate {
    static constexpr bool PERM = true, AFTER_DRAIN = false;
    bf16_t* O; const bf16_t* gate;
    __device__ __forceinline__ void operator()(const f32x4 (&acc)[2][2][4][2], const Unit& u, int wr, int wc, int fr, int fq) const {
        const int row0 = u.pm * BM + wr * 64 + fr, col0 = u.pn * BM + wc * 32 + 8 * fq;
#pragma unroll
        for (int ai = 0; ai < 2; ++ai)
#pragma unroll
            for (int m = 0; m < 4; ++m) { const size_t off = (size_t)(row0 + ai * HALF + m * 16) * 1024 + col0;
#pragma unroll
                for (int bj = 0; bj < 2; ++bj) { const u32x4 gw = *(const u32x4*)(gate + off + bj * HALF); u32x4 ow = (u32x4){0u, 0u, 0u, 0u}; if (ADD) ow = *(const u32x4*)(O + off + bj * HALF);
                    float r[8];
#pragma unroll
                    for (int e = 0; e < 8; ++e) { const unsigned g16 = (gw[e >> 1] >> ((e & 1) * 16)) & 0xffffu, o16 = (ow[e >> 1] >> ((e & 1) * 16)) & 0xffffu;
                        const float a = acc[ai][bj][m][e >> 2][e & 3]; r[e] = (ADD ? bfbits2f(o16) : 0.f) + sigm(bfbits2f(g16)) * a; }
                    u32x4 w; w.x = cvt_pk_bf16(r[0], r[1]); w.y = cvt_pk_bf16(r[2], r[3]); w.z = cvt_pk_bf16(r[4], r[5]); w.w = cvt_pk_bf16(r[6], r[7]);
                    *(u32x4*)(O + off + bj * HALF) = w; } }
    }
};
template <bool BF> struct EpiRes {
    static constexpr bool PERM = true, AFTER_DRAIN = false;
    const float* base0; const float* base1; bf16_t* hb; float* ssqp;
    __device__ __forceinline__ void operator()(const f32x4 (&acc)[2][2][4][2], const Unit& u, int wr, int wc, int fr, int fq) const {
        const int row0 = u.pm * BM + wr * 64 + fr, col0 = u.pn * BM + wc * 32 + 8 * fq; const float* base = u.pm < 64 ? base0 : base1;
#pragma unroll
        for (int ai = 0; ai < 2; ++ai)
#pragma unroll
            for (int m = 0; m < 4; ++m) { const int row = row0 + ai * HALF + m * 16; const size_t off = (size_t)row * 1024 + col0; float sq = 0.f;
#pragma unroll
                for (int bj = 0; bj < 2; ++bj) { const size_t o2 = off + bj * HALF; f32x4 b0, b1;
                    if (BF) { const u32x4 w = *(const u32x4*)(hb + o2); b0 = (f32x4){bfbits2f(w.x & 0xffffu), __uint_as_float(w.x & 0xffff0000u), bfbits2f(w.y & 0xffffu), __uint_as_float(w.y & 0xffff0000u)};
                        b1 = (f32x4){bfbits2f(w.z & 0xffffu), __uint_as_float(w.z & 0xffff0000u), bfbits2f(w.w & 0xffffu), __uint_as_float(w.w & 0xffff0000u)}; }
                    else { b0 = *(const f32x4*)(base + o2); b1 = *(const f32x4*)(base + o2 + 4); }
                    const f32x4 v0 = b0 + acc[ai][bj][m][0], v1 = b1 + acc[ai][bj][m][1];
                    sq += ((v0[0] * v0[0] + v0[1] * v0[1]) + (v0[2] * v0[2] + v0[3] * v0[3])) + ((v1[0] * v1[0] + v1[1] * v1[1]) + (v1[2] * v1[2] + v1[3] * v1[3]));
                    u32x4 w; w.x = cvt_pk_bf16(v0[0], v0[1]); w.y = cvt_pk_bf16(v0[2], v0[3]); w.z = cvt_pk_bf16(v1[0], v1[1]); w.w = cvt_pk_bf16(v1[2], v1[3]); *(u32x4*)(hb + o2) = w; }
                sq += __shfl_xor(sq, 16); sq += __shfl_xor(sq, 32);
                if (fq == 0) ssqp[(size_t)row * 16 + u.pn * 4 + wc] = sq; }
    }
};
struct EpiSwiglu {
    static constexpr bool PERM = true, AFTER_DRAIN = false;
    bf16_t* act; const float* ssq;
    __device__ __forceinline__ void operator()(const f32x4 (&acc)[2][2][4][2], const Unit& u, int wr, int wc, int fr, int fq) const {
        const int row0 = u.pm * BM + wr * 64 + fr, col0 = u.pn * 128 + wc * 16 + 4 * fq;
#pragma unroll
        for (int ai = 0; ai < 2; ++ai)
#pragma unroll
            for (int m = 0; m < 4; ++m) { const int row = row0 + ai * HALF + m * 16; const float rs = row_rs<16>(ssq, row);
#pragma unroll
                for (int bj = 0; bj < 2; ++bj) { const f32x4 a = acc[ai][bj][m][0] * rs, b = acc[ai][bj][m][1] * rs;
                    const float r0 = a[0] * sigm(a[0]) * a[1], r1 = a[2] * sigm(a[2]) * a[3], r2 = b[0] * sigm(b[0]) * b[1], r3 = b[2] * sigm(b[2]) * b[3];
                    u32x2 w; w.x = cvt_pk_bf16(r0, r1); w.y = cvt_pk_bf16(r2, r3); *(u32x2*)(act + (size_t)row * 2816 + col0 + bj * 64) = w; } }
    }
};
template <class Epi, class Sched, bool ALIGN_EPI = false, bool SP2 = false>
__device__ __forceinline__ void gemm_phase(PG8_LAS unsigned char* lds, const Gemm g, const Sched& S, const Epi& E) {
    const int tid = threadIdx.x, wid = __builtin_amdgcn_readfirstlane(tid >> 6), lane = tid & 63, wr = wid >> 2, wc = wid & 3, fr = lane & 15, fq = lane >> 4;
    const int K = g.K, nt = K / BK;
    unsigned voffA[2], voffB[2];
#pragma unroll
    for (int i = 0; i < 2; ++i) { int R, C; stage_rc(tid * 16 + i * 8192, R, C); const int Rb = Epi::PERM ? ((R & ~31) + perm32(R & 31)) : R;
        voffA[i] = (unsigned)(R * K + C) * 2u; voffB[i] = (unsigned)(Rb * K + C) * 2u; }
    const size_t kstep = (size_t)(BK * 2);
    const size_t hstep = (size_t)HALF * K * 2;
    const size_t tstep = 2 * hstep;
    const unsigned ldsw = (unsigned)wid * 1024u;
    const int aoff = lds_byte(wr * 64 + fr, fq * 8), boff = lds_byte(wc * 32 + fr, fq * 8);
#define PG8_SA(b, h) (((b) * 2 + (h)) * HTB)
#define PG8_SB(b, h) ((4 + (b) * 2 + (h)) * HTB)
#define PG8_STAGE(bufoff, gbase, voff) do { _Pragma("unroll") for (int _i = 0; _i < 2; ++_i) \
        __builtin_amdgcn_global_load_lds((const unsigned*)((const char*)(gbase) + (voff)[_i]), (PG8_LAS unsigned*)(lds + (bufoff) + ldsw + _i * 8192), 16, 0, 0); } while (0)
#define PG8_LDA(dst, b, h) do { _Pragma("unroll") for (int m = 0; m < 4; ++m) _Pragma("unroll") for (int k = 0; k < 2; ++k) dst[m][k] = *(const PG8_LAS bf16x8*)(lds + PG8_SA(b, h) + aoff + m * 2048 + k * 1024); } while (0)
#define PG8_LDB(dst, b, h) do { _Pragma("unroll") for (int n = 0; n < 2; ++n) _Pragma("unroll") for (int k = 0; k < 2; ++k) dst[n][k] = *(const PG8_LAS bf16x8*)(lds + PG8_SB(b, h) + boff + n * 2048 + k * 1024); } while (0)
#define PG8_MMA(ai, bj, At, Bt) do { __builtin_amdgcn_s_setprio(1); _Pragma("unroll") for (int m = 0; m < 4; ++m) _Pragma("unroll") for (int n = 0; n < 2; ++n) _Pragma("unroll") for (int k = 0; k < 2; ++k) \
        acc[ai][bj][m][n] = __builtin_amdgcn_mfma_f32_16x16x32_bf16(Bt[n][k], At[m][k], acc[ai][bj][m][n], 0, 0, 0); __builtin_amdgcn_s_setprio(0); } while (0)
#define PG8_WAIT_V(n) asm volatile("s_waitcnt vmcnt(" #n ")" ::: "memory")
#define PG8_WAIT_L(n) asm volatile("s_waitcnt lgkmcnt(" #n ")" ::: "memory")
#define PG8_BAR __builtin_amdgcn_s_barrier()
#define PG8_SCHED __builtin_amdgcn_sched_barrier(0)
    Unit cur, nxt; int ui = 0;
    if (!S.next(0, cur)) return;
    f32x4 acc[2][2][4][2];
#pragma unroll
    for (int a = 0; a < 2; ++a)
#pragma unroll
        for (int b = 0; b < 2; ++b)
#pragma unroll
            for (int m = 0; m < 4; ++m)
#pragma unroll
                for (int n = 0; n < 2; ++n) acc[a][b][m][n] = (f32x4){0.f, 0.f, 0.f, 0.f};
    bf16x8 At[4][2], B0[2][2], B1[2][2];
    const char* cA = (const char*)g.A + (size_t)cur.pm * tstep; const char* cB = (const char*)g.Bt + (size_t)cur.pn * tstep;
    S.a_ready(cur);
    if constexpr (SP2) {
        PG8_STAGE(PG8_SB(0, 0), cB, voffB); PG8_STAGE(PG8_SB(0, 1), cB + hstep, voffB); PG8_STAGE(PG8_SA(0, 0), cA, voffA); PG8_STAGE(PG8_SA(0, 1), cA + hstep, voffA);
        if (wr == 1) PG8_BAR;
        PG8_WAIT_V(2); PG8_BAR;
        PG8_STAGE(PG8_SB(1, 0), cB + kstep, voffB); PG8_STAGE(PG8_SA(1, 0), cA + kstep, voffA); PG8_STAGE(PG8_SB(1, 1), cB + hstep + kstep, voffB);
        PG8_WAIT_V(6); PG8_BAR;
    } else {
        PG8_STAGE(PG8_SB(0, 0), cB, voffB); PG8_STAGE(PG8_SA(0, 0), cA, voffA); PG8_STAGE(PG8_SB(0, 1), cB + hstep, voffB); PG8_STAGE(PG8_SA(0, 1), cA + hstep, voffA);
        if (wr == 1) PG8_BAR;
        PG8_WAIT_V(4); PG8_BAR;
        PG8_STAGE(PG8_SB(1, 0), cB + kstep, voffB); PG8_STAGE(PG8_SA(1, 0), cA + kstep, voffA); PG8_STAGE(PG8_SB(1, 1), cB + hstep + kstep, voffB);
        PG8_WAIT_V(6); PG8_BAR;
    }
    for (;;) {
        const bool has_next = S.next(ui + 1, nxt);
        const char* nA = has_next ? (const char*)g.A + (size_t)nxt.pm * tstep : cA; const char* nB = has_next ? (const char*)g.Bt + (size_t)nxt.pn * tstep : cB;
        for (int t = 0; t < nt; t += 2) {
            const bool last = (t == nt - 2);
            const char* a1 = cA + (size_t)(t + 1) * kstep;
            const char* a2 = last ? nA : cA + (size_t)(t + 2) * kstep; const char* b2 = last ? nB : cB + (size_t)(t + 2) * kstep;
            const char* a3 = a2 + kstep; const char* b3 = b2 + kstep;
            if (last && has_next) S.a_ready(nxt);
            if constexpr (SP2) {
            PG8_LDB(B0, 0, 0); PG8_LDB(B1, 0, 1); PG8_SCHED; PG8_LDA(At, 0, 0); PG8_STAGE(PG8_SA(1, 1), a1 + hstep, voffA);
            PG8_WAIT_V(8); PG8_WAIT_L(0); PG8_BAR; PG8_MMA(0, 0, At, B0); PG8_MMA(0, 1, At, B1); PG8_BAR; PG8_SCHED;
            PG8_LDA(At, 0, 1); PG8_STAGE(PG8_SB(0, 0), b2, voffB); PG8_STAGE(PG8_SB(0, 1), b2 + hstep, voffB); PG8_STAGE(PG8_SA(0, 0), a2, voffA);
            PG8_WAIT_V(8); PG8_WAIT_L(0); PG8_BAR; PG8_MMA(1, 0, At, B0); PG8_MMA(1, 1, At, B1); PG8_BAR; PG8_SCHED;
            PG8_LDB(B0, 1, 0); PG8_LDB(B1, 1, 1); PG8_SCHED; PG8_LDA(At, 1, 0); PG8_STAGE(PG8_SA(0, 1), a2 + hstep, voffA);
            PG8_WAIT_V(8); PG8_WAIT_L(0); PG8_BAR; PG8_MMA(0, 0, At, B0); PG8_MMA(0, 1, At, B1); PG8_BAR; PG8_SCHED;
            PG8_LDA(At, 1, 1); PG8_STAGE(PG8_SB(1, 0), b3, voffB); PG8_STAGE(PG8_SB(1, 1), b3 + hstep, voffB); PG8_STAGE(PG8_SA(1, 0), a3, voffA);
            PG8_WAIT_V(8); PG8_WAIT_L(0); PG8_BAR; PG8_MMA(1, 0, At, B0); PG8_MMA(1, 1, At, B1); PG8_BAR; PG8_SCHED;
            } else {
            PG8_LDB(B0, 0, 0); PG8_SCHED; PG8_LDA(At, 0, 0); PG8_STAGE(PG8_SA(1, 1), a1 + hstep, voffA);
            PG8_WAIT_L(8); PG8_BAR; PG8_WAIT_L(0); PG8_MMA(0, 0, At, B0); PG8_BAR; PG8_SCHED;
            PG8_LDB(B1, 0, 1); PG8_STAGE(PG8_SB(0, 0), b2, voffB);
            PG8_BAR; PG8_WAIT_L(0); PG8_MMA(0, 1, At, B1); PG8_BAR;
            PG8_LDA(At, 0, 1); PG8_STAGE(PG8_SA(0, 0), a2, voffA);
            PG8_BAR; PG8_WAIT_L(0); PG8_MMA(1, 0, At, B0); PG8_BAR; PG8_SCHED;
            PG8_STAGE(PG8_SB(0, 1), b2 + hstep, voffB);
            PG8_WAIT_V(6); PG8_BAR; PG8_MMA(1, 1, At, B1); PG8_BAR;
            PG8_LDB(B0, 1, 0); PG8_SCHED; PG8_LDA(At, 1, 0); PG8_STAGE(PG8_SA(0, 1), a2 + hstep, voffA);
            PG8_WAIT_L(8); PG8_BAR; PG8_WAIT_L(0); PG8_MMA(0, 0, At, B0); PG8_BAR; PG8_SCHED;
            PG8_LDB(B1, 1, 1); PG8_STAGE(PG8_SB(1, 0), b3, voffB);
            PG8_BAR; PG8_WAIT_L(0); PG8_MMA(0, 1, At, B1); PG8_BAR;
            PG8_LDA(At, 1, 1); PG8_STAGE(PG8_SA(1, 0), a3, voffA);
            PG8_BAR; PG8_WAIT_L(0); PG8_MMA(1, 0, At, B0); PG8_BAR; PG8_SCHED;
            PG8_STAGE(PG8_SB(1, 1), b3 + hstep, voffB);
            PG8_WAIT_V(6); PG8_BAR; PG8_MMA(1, 1, At, B1); PG8_BAR;
            }
        }
        if constexpr (ALIGN_EPI) { if (wr == 0) PG8_BAR; }
        if constexpr (!Epi::AFTER_DRAIN) { E(acc, cur, wr, wc, fr, fq); S.done(cur); }
        if (!has_next) break;
#pragma unroll
        for (int a = 0; a < 2; ++a)
#pragma unroll
            for (int b = 0; b < 2; ++b)
#pragma unroll
                for (int m = 0; m < 4; ++m)
#pragma unroll
                    for (int n = 0; n < 2; ++n) acc[a][b][m][n] = (f32x4){0.f, 0.f, 0.f, 0.f};
        cur = nxt; cA = nA; cB = nB; ++ui;
        if constexpr (ALIGN_EPI) { if (wr == 1) PG8_BAR; }
    }
    PG8_WAIT_V(0);
    if constexpr (!ALIGN_EPI) { if (wr == 0) PG8_BAR; }
    PG8_BAR;
    if constexpr (Epi::AFTER_DRAIN) { E.fused(acc, cur, wr, wc, fr, fq, lds, wid, lane); S.done(cur); }
#undef PG8_SA
#undef PG8_SB
#undef PG8_STAGE
#undef PG8_LDA
#undef PG8_LDB
#undef PG8_MMA
#undef PG8_WAIT_V
#undef PG8_WAIT_L
#undef PG8_BAR
#undef PG8_SCHED
}
}
#define GAS __attribute__((address_space(1)))
#define LAS __attribute__((address_space(3)))
typedef unsigned short bf16;
typedef unsigned v4u __attribute__((ext_vector_type(4)));
typedef float f32x4 __attribute__((ext_vector_type(4)));
typedef short bf16x8 __attribute__((ext_vector_type(8)));
typedef GAS unsigned gu32;
typedef GAS unsigned long long gu64;
#define RLX_AGENT __ATOMIC_RELAXED, __HIP_MEMORY_SCOPE_AGENT
#define LDS_WAIT() asm volatile("s_waitcnt lgkmcnt(0)" ::: "memory")
#define VM_WAIT() asm volatile("s_waitcnt vmcnt(0)" ::: "memory")
__device__ __forceinline__ unsigned long long rt() { return __builtin_amdgcn_s_memrealtime(); }
typedef float f32x2_t __attribute__((ext_vector_type(2))); typedef __bf16 bf16x2_t __attribute__((ext_vector_type(2)));
__device__ __forceinline__ unsigned pk2(float lo, float hi) { const f32x2_t v = {lo, hi}; const bf16x2_t b = __builtin_convertvector(v, bf16x2_t); return __builtin_bit_cast(unsigned, b); }
__device__ __forceinline__ unsigned f2bf(float f) { return pk2(f, 0.f) & 0xffffu; }

#define XB_TMO      128
#define XB_XCNT(j)  (256  + 64 * (j))
#define XB_XSUB(j)  (1280 + 64 * (j))
#define XB_XGEN(j)  (2304 + 64 * (j))
#define XB_TOP      3328
#define XB_TOPGEN   3392
#define XCD_BAR_WORDS 3456
#define XB_SPIN_CAP (1u << 18)

__device__ __forceinline__ unsigned xb_ld(unsigned* p)              { return __hip_atomic_load(p, __ATOMIC_RELAXED, __HIP_MEMORY_SCOPE_AGENT); }
__device__ __forceinline__ unsigned xb_add(unsigned* p, unsigned v) { return __hip_atomic_fetch_add(p, v, __ATOMIC_RELAXED, __HIP_MEMORY_SCOPE_AGENT); }
__device__ __forceinline__ unsigned xb_xcc_id() { return (unsigned)__builtin_amdgcn_s_getreg((3 << 11) | 20) & 0xFu; }
#define XB_SPIN(cond, bar) do { unsigned _sp = 0; while (cond) { __builtin_amdgcn_s_sleep(1); \
    if ((++_sp & 255u) == 0u) { if (xb_ld(&(bar)[XB_TMO])) break; if (_sp > XB_SPIN_CAP) { atomicAdd(&(bar)[XB_TMO], 1u); break; } } } } while (0)

struct XcdBarrier {
    unsigned* bar; unsigned x;
    volatile LAS unsigned* st;
};

__device__ __forceinline__ XcdBarrier xcd_barrier_post(unsigned* bar, volatile LAS unsigned* st) {
    XcdBarrier b; b.bar = bar; b.x = xb_xcc_id(); b.st = st;
    if (threadIdx.x == 0) (void)xb_add(&bar[XB_XCNT(b.x)], 1u);
    return b;
}
__device__ __forceinline__ void xcd_barrier_complete(unsigned* bar, unsigned x, unsigned& nloc, unsigned& nx) {
    const unsigned G = gridDim.x * gridDim.y * gridDim.z;
    unsigned sum, cnt, mine, sp = 0u;
    for (;;) {
        sum = 0u; cnt = 0u; mine = 0u;
#pragma unroll
        for (unsigned j = 0; j < 16; ++j) { const unsigned c = xb_ld(&bar[XB_XCNT(j)]); sum += c; cnt += (c > 0u) ? 1u : 0u; mine = (j == x) ? c : mine; }
        if (sum == G) break;
        __builtin_amdgcn_s_sleep(1);
        if ((++sp & 255u) == 0u) { if (xb_ld(&bar[XB_TMO])) break; if (sp > XB_SPIN_CAP) { atomicAdd(&bar[XB_TMO], 1u); break; } }
    }
    nloc = mine > 0u ? mine : 1u; nx = cnt > 0u ? cnt : 1u;
}

__device__ __forceinline__ void xcd_barrier(const XcdBarrier& b) {
    asm volatile("s_waitcnt vmcnt(0)" ::: "memory");
    __syncthreads();
    if (threadIdx.x == 0) {
        unsigned* bar = b.bar;
        __builtin_amdgcn_s_waitcnt(0);
        unsigned nloc = b.st[0], nx = b.st[1];
        if (nloc == 0u) { xcd_barrier_complete(bar, b.x, nloc, nx); b.st[0] = nloc; b.st[1] = nx; }
        const unsigned old = xb_add(&bar[XB_XSUB(b.x)], 1u);
        const unsigned gen = old / nloc;
        if (old + 1u == (gen + 1u) * nloc) {
            __builtin_amdgcn_fence(__ATOMIC_RELEASE, "agent");
            asm volatile("s_waitcnt vmcnt(0)" ::: "memory");
            const unsigned og = xb_add(&bar[XB_TOP], 1u);
            const unsigned tg = og / nx;
            if (og + 1u == (tg + 1u) * nx) xb_add(&bar[XB_TOPGEN], 1u);
            else XB_SPIN(xb_ld(&bar[XB_TOPGEN]) == tg, bar);
            __builtin_amdgcn_fence(__ATOMIC_ACQUIRE, "agent");
            xb_add(&bar[XB_XGEN(b.x)], 1u);
            asm volatile("s_waitcnt vmcnt(0)" ::: "memory");
        } else {
            XB_SPIN(xb_ld(&bar[XB_XGEN(b.x)]) == gen, bar);
            __builtin_amdgcn_fence(__ATOMIC_ACQUIRE, "agent");
            asm volatile("s_waitcnt vmcnt(0)" ::: "memory");
        }
    }
    __syncthreads();
}
typedef unsigned v2u __attribute__((ext_vector_type(2)));
constexpr int NWAVES = 8, NTHR = 512;
constexpr int DM = 1024, TP = 16384, TS = 512, T = TP + TS;
constexpr int SEQ = 2048, NBP = 8, NBS = 128, LS = 4, MEMR = 2048;
constexpr int NPROJ = 11520;
constexpr int FFN = 2816;
constexpr float EPS = 1e-6f;
constexpr float QSCALE = 0.0625f * 1.4426950408889634f;

constexpr size_t MiB = 1u << 20;
constexpr size_t WS_CTL = 0, CTL_ZERO_BYTES = 1 * MiB;
constexpr size_t WS_SSQX = 1 * MiB, WS_SSQM = 1 * MiB + 512 * 1024;
constexpr size_t WS_DT = 2 * MiB, WS_SSQSSD = 5 * MiB, WS_SSQP1 = 8 * MiB, WS_SSQP2 = 9 * MiB + 512 * 1024, WS_SSQP3 = 11 * MiB;
constexpr size_t WS_WIN = 13 * MiB, WS_WKV = 36 * MiB, WS_WSSD = 40 * MiB, WS_WHG = 44 * MiB, WS_WOUT = 46 * MiB, WS_WCQ = 48 * MiB, WS_WCO = 50 * MiB, WS_WGU = 52 * MiB, WS_WDN = 63 * MiB;
constexpr size_t WS_XB = 69 * MiB, WS_MNB = 102 * MiB, WS_KB = 106 * MiB, WS_VT = 110 * MiB;
constexpr size_t SLOT = 33 * MiB, SLOT_ELEMS = (size_t)T * 1024;
constexpr size_t WS_PROJ = 114 * MiB;
constexpr size_t WS_YG = WS_PROJ + 11 * SLOT, WS_ON = WS_YG + 2 * SLOT, WS_END = WS_ON + SLOT;
static_assert(SLOT == SLOT_ELEMS * 2, "slot size");
static_assert(WS_WIN + (size_t)NPROJ * 1024 * 2 <= WS_WKV && WS_WGU + (size_t)2 * FFN * 1024 * 2 <= WS_WDN && WS_WDN + (size_t)1024 * FFN * 2 <= WS_XB && WS_SSQP3 + (size_t)T * 64 <= WS_WIN, "d_ws map");
static_assert(WS_DT + (size_t)T * 128 <= WS_SSQSSD && WS_SSQSSD + (size_t)T * 128 <= WS_SSQP1 && WS_SSQP1 + (size_t)T * 64 <= WS_SSQP2 && WS_SSQP2 + (size_t)T * 64 <= WS_SSQP3, "d_ws map 2");
enum { S_Z0 = 0, S_Z1 = 1, S_X0 = 2, S_X1 = 3, S_X2 = 4, S_Q = 5, S_F = 6, S_I = 7, S_HG = 8, S_GS = 9, S_GH = 10 };
constexpr size_t WS_MERGED = WS_PROJ + S_Q * SLOT, WS_HB = WS_PROJ + S_F * SLOT, WS_QB = WS_PROJ + S_I * SLOT, WS_OB = WS_PROJ + S_HG * SLOT, WS_ACT = WS_PROJ;
static_assert((size_t)T * FFN * 2 <= 3 * SLOT, "act overlay");
constexpr size_t O_Y = 0, O_SSMP = (size_t)T * 1024, O_CONVP = O_SSMP + 2097152, O_HGP = O_CONVP + 73728, O_MKP = O_HGP + 1048576, O_MVP = O_MKP + 2097152,
                 O_SSMS = O_MVP + 2097152, O_CONVS = O_SSMS + 33554432, O_HGS = O_CONVS + 1179648, O_END = O_HGS + 16777216;
constexpr int CW_QUEUE = 64;
constexpr int CW_BAR = 4096;
constexpr int RING_OFF = 0, RING_BYTES = 131072;
constexpr int LDSCTL_OFF = RING_BYTES, MISC_OFF = LDSCTL_OFF + 320;
constexpr int LDS_BYTES = 147456;
struct Frame {
    LAS unsigned char* lds;
    volatile LAS unsigned* MISC;
    gu32* ctl;
    int tid, lane, wave;
    int vcu, G;
    const float* in[32];
    float* out; unsigned char* ws;
};
__device__ __forceinline__ float bf2f(unsigned v16) { return __uint_as_float(v16 << 16); }
__device__ __forceinline__ float sigmoid_f(float x) { return __builtin_amdgcn_rcpf(1.0f + __expf(-x)); }
__device__ __forceinline__ float silu_f(float x) { return x * sigmoid_f(x); }
__device__ __forceinline__ float wave_sum(float v) {
#pragma unroll
    for (int o = 1; o < 64; o <<= 1) v += __shfl_xor(v, o);
    return v;
}
__device__ __forceinline__ float wave_max(float v) {
#pragma unroll
    for (int o = 1; o < 64; o <<= 1) v = fmaxf(v, __shfl_xor(v, o));
    return v;
}
struct TSrc { const float* W; const float* W2; const float* ks; int ldw; int mode; };
__device__ __forceinline__ void p0_transpose_item(const TSrc& s, int K, int N, bf16* WT, LAS unsigned short* scr, int item, int lane) {
    const int nblk = N / 64, kb = item / nblk, nb = item % nblk, k0 = 64 * kb, n0 = 64 * nb;
    const int kr = lane >> 4, nq = lane & 15;
    const float* const Wa = s.W; const float* const Wb = s.W2;
    const float* src; int c0, cs; bool zero = false;
    if (s.mode == 2) { const float* wsel = Wa; if (nq >= 8) wsel = Wb; src = wsel + (n0 >> 1) + 4 * (nq & 7); c0 = 8 * (nq & 7) + (nq >> 3); cs = 2; }
    else { const int n = n0 + 4 * nq; c0 = 4 * nq; cs = 1;
        if (s.mode == 0) src = Wa + n;
        else if (s.mode == 1) { if (n < 5120) src = Wa + n; else if (n < 11264) src = Wa + n + 32; else if (n < 11296) src = Wa + 5120 + (n - 11264); else { src = Wa; zero = true; } }
        else { src = Wa + n; if (n >= 1024) src = Wb + (n - 1024); } }
    f32x4 v[16];
#pragma unroll
    for (int i = 0; i < 16; ++i) v[i] = zero ? (f32x4){0.f, 0.f, 0.f, 0.f} : *(const f32x4*)(src + (size_t)(k0 + 4 * i + kr) * s.ldw);
#pragma unroll
    for (int i = 0; i < 16; ++i) { const int kk = 4 * i + kr; const float sc = s.ks ? s.ks[k0 + kk] : 1.0f; const unsigned w0 = pk2(v[i].x * sc, v[i].y * sc), w1 = pk2(v[i].z * sc, v[i].w * sc);
        LAS unsigned short* d = scr + kk * 66 + c0;
        if (cs == 1) { *(LAS unsigned*)d = w0; *(LAS unsigned*)(d + 2) = w1; }
        else { d[0] = (unsigned short)(w0 & 0xffffu); d[2] = (unsigned short)(w0 >> 16); d[4] = (unsigned short)(w1 & 0xffffu); d[6] = (unsigned short)(w1 >> 16); } }
    LDS_WAIT(); asm volatile("" ::: "memory");
    const int nr = lane >> 3, kc = lane & 7;
#pragma unroll
    for (int j = 0; j < 8; ++j) { const int n = 8 * j + nr; const LAS unsigned short* p = scr + (8 * kc) * 66 + n;
        v4u o; o.x = (unsigned)p[0] | ((unsigned)p[66] << 16); o.y = (unsigned)p[2 * 66] | ((unsigned)p[3 * 66] << 16); o.z = (unsigned)p[4 * 66] | ((unsigned)p[5 * 66] << 16); o.w = (unsigned)p[6 * 66] | ((unsigned)p[7 * 66] << 16);
        *(v4u*)(WT + (size_t)(n0 + n) * K + k0 + 8 * kc) = o; }
    LDS_WAIT(); asm volatile("" ::: "memory");
}
__device__ __forceinline__ void rows4_to_bf16_ssq(const float* x0, bf16* o0, float* ssq0, int lane) {
    f32x4 v[4][4];
#pragma unroll
    for (int rr = 0; rr < 4; ++rr)
#pragma unroll
        for (int j = 0; j < 4; ++j) v[rr][j] = ((const f32x4*)(x0 + rr * 1024))[64 * j + lane];
#pragma unroll
    for (int rr = 0; rr < 4; ++rr) { float sq = 0.f;
#pragma unroll
        for (int j = 0; j < 4; ++j) sq += (v[rr][j].x * v[rr][j].x + v[rr][j].y * v[rr][j].y) + (v[rr][j].z * v[rr][j].z + v[rr][j].w * v[rr][j].w);
        sq = wave_sum(sq);
        unsigned long long* o8 = (unsigned long long*)(o0 + rr * 1024) + lane;
#pragma unroll
        for (int j = 0; j < 4; ++j) o8[64 * j] = (unsigned long long)pk2(v[rr][j].x, v[rr][j].y) | ((unsigned long long)pk2(v[rr][j].z, v[rr][j].w) << 32);
        if (lane == 0) ssq0[rr] = sq; }
}
__device__ __forceinline__ void p0_prologue(Frame& F) {
    LAS unsigned short* scr = (LAS unsigned short*)(F.lds + RING_OFF + F.wave * 16384);
    const int gw = F.vcu * NWAVES + F.wave, NGW = F.G * NWAVES;
    unsigned char* ws = F.ws;
    constexpr int I_IN = 16 * (NPROJ / 64), I_KV = 16 * 32, I_SSD = 32 * 16, I_SQ = 16 * 16, I_GU = 16 * (2 * FFN / 64), I_DN = (FFN / 64) * 16;
    constexpr int NITEMS = I_IN + I_KV + I_SSD + 4 * I_SQ + I_GU + I_DN;
    for (int it = gw; it < NITEMS; it += NGW) {
        int r = it;
        if (r < I_IN) { TSrc s{F.in[9], nullptr, F.in[8], 11296, 1}; p0_transpose_item(s, 1024, NPROJ, (bf16*)(ws + WS_WIN), scr, r, F.lane); continue; } r -= I_IN;
        if (r < I_KV) { TSrc s{F.in[24], F.in[25], F.in[22], 1024, 3}; p0_transpose_item(s, 1024, 2048, (bf16*)(ws + WS_WKV), scr, r, F.lane); continue; } r -= I_KV;
        if (r < I_SSD) { TSrc s{F.in[16], nullptr, F.in[15], 1024, 0}; p0_transpose_item(s, 2048, 1024, (bf16*)(ws + WS_WSSD), scr, r, F.lane); continue; } r -= I_SSD;
        if (r < I_SQ) { TSrc s{F.in[19], nullptr, F.in[18], 1024, 0}; p0_transpose_item(s, 1024, 1024, (bf16*)(ws + WS_WHG), scr, r, F.lane); continue; } r -= I_SQ;
        if (r < I_SQ) { TSrc s{F.in[20], nullptr, nullptr, 1024, 0}; p0_transpose_item(s, 1024, 1024, (bf16*)(ws + WS_WOUT), scr, r, F.lane); continue; } r -= I_SQ;
        if (r < I_SQ) { TSrc s{F.in[23], nullptr, F.in[21], 1024, 0}; p0_transpose_item(s, 1024, 1024, (bf16*)(ws + WS_WCQ), scr, r, F.lane); continue; } r -= I_SQ;
        if (r < I_SQ) { TSrc s{F.in[26], nullptr, nullptr, 1024, 0}; p0_transpose_item(s, 1024, 1024, (bf16*)(ws + WS_WCO), scr, r, F.lane); continue; } r -= I_SQ;
        if (r < I_GU) { TSrc s{F.in[28], F.in[29], F.in[27], FFN, 2}; p0_transpose_item(s, 1024, 2 * FFN, (bf16*)(ws + WS_WGU), scr, r, F.lane); continue; } r -= I_GU;
        { TSrc s{F.in[30], nullptr, nullptr, 1024, 0}; p0_transpose_item(s, FFN, 1024, (bf16*)(ws + WS_WDN), scr, r, F.lane); }
    }
    bf16* XB = (bf16*)(ws + WS_XB); float* SSQX = (float*)(ws + WS_SSQX);
    for (int m4 = gw; m4 < T / 4; m4 += NGW) { const int m = 4 * m4;
        rows4_to_bf16_ssq(m < TP ? F.in[0] + (size_t)m * DM : F.in[1] + (size_t)(m - TP) * DM, XB + (size_t)m * DM, SSQX + m, F.lane); }
    bf16* MNB = (bf16*)(ws + WS_MNB); float* SSQM = (float*)(ws + WS_SSQM);
    for (int m4 = gw; m4 < MEMR / 4; m4 += NGW) { const int m = 4 * m4; rows4_to_bf16_ssq(F.in[2] + (size_t)m * DM, MNB + (size_t)m * DM, SSQM + m, F.lane); }
}
__device__ __forceinline__ void ssd_unit(Frame& F, int gb, int h) {
    const int tid = F.tid; unsigned char* ws = F.ws;
    const bool prompt = gb < NBP; const int L = prompt ? SEQ : LS; const int sb = gb - NBP; const size_t row_base = prompt ? (size_t)gb * SEQ : (size_t)TP + (size_t)sb * LS;
    const int g = h >> 3;
    LAS float* xs = (LAS float*)(F.lds + RING_OFF);
    LAS float* Bs = xs + 64 * 64;
    LAS float* Cs = Bs + 64 * 128;
    LAS float* ys = Cs + 64 * 128;
    LAS float* dts = ys + 64 * 64;
    LAS float* das = dts + 64;
    const bf16* PROJ = (const bf16*)(ws + WS_PROJ); const float* DTR = (const float*)(ws + WS_DT);
    bf16* YG = (bf16*)(ws + WS_YG); float* SSQ = (float*)(ws + WS_SSQSSD);
    const int p = tid >> 3, n0 = (tid & 7) * 16;
    float hs[16];
    float* state_out = prompt ? F.out + O_SSMP + ((size_t)(gb * 32 + h) * 64 + p) * 128 + n0 : F.out + O_SSMS + ((size_t)(sb * 32 + h) * 64 + p) * 128 + n0;
    if (prompt) {
#pragma unroll
        for (int i = 0; i < 16; ++i) hs[i] = 0.f;
    } else { const float* sp = F.in[3] + ((size_t)(sb * 32 + h) * 64 + p) * 128 + n0;
#pragma unroll
        for (int i = 0; i < 4; ++i) { const f32x4 v = *(const f32x4*)(sp + 4 * i); hs[4 * i] = v.x; hs[4 * i + 1] = v.y; hs[4 * i + 2] = v.z; hs[4 * i + 3] = v.w; } }
    const float a = -__expf(F.in[13][h]), dtb = F.in[12][h], Dk = F.in[14][h];
    int col = 0; LAS float* dst = xs; int dstride = 64;
    if (tid < 64) { col = h * 64 + tid; dst = xs + tid; dstride = 64; }
    else if (tid < 192) { col = 2048 + g * 128 + (tid - 64); dst = Bs + (tid - 64); dstride = 128; }
    else if (tid < 320) { col = 2560 + g * 128 + (tid - 192); dst = Cs + (tid - 192); dstride = 128; }
    float w0 = 0.f, w1 = 0.f, w2 = 0.f, w3 = 0.f, cb = 0.f, r0 = 0.f, r1 = 0.f, r2 = 0.f; const bf16* cptr = PROJ;
    if (tid < 320) { const float* cw = F.in[10]; w0 = cw[col]; w1 = cw[3072 + col]; w2 = cw[2 * 3072 + col]; w3 = cw[3 * 3072 + col]; cb = F.in[11][col];
        cptr = PROJ + (size_t)(S_X0 + (col >> 10)) * SLOT_ELEMS + row_base * 1024 + (col & 1023);
        if (!prompt) { const float* sc = F.in[4] + (size_t)sb * 3 * 3072 + col; r0 = sc[0]; r1 = sc[3072]; r2 = sc[2 * 3072]; } }
    for (int t0 = 0; t0 < L; t0 += 64) {
        const int nt = (L - t0) < 64 ? (L - t0) : 64;
        if (tid < 320) {
            for (int tt = 0; tt < nt; ++tt) { const float raw = bf2f(cptr[(size_t)(t0 + tt) * 1024]); float v = w0 * r0 + w1 * r1 + w2 * r2 + w3 * raw + cb; v = silu_f(v); dst[tt * dstride] = v; r0 = r1; r1 = r2; r2 = raw; }
        } else if (tid < 384) { const int tt = tid - 320;
            if (tt < nt) { const float x = DTR[(row_base + t0 + tt) * 32 + h] + dtb; const float dtv = x > 20.f ? x : log1pf(__expf(x)); dts[tt] = dtv; das[tt] = __expf(dtv * a); } }
        __syncthreads();
        for (int tt = 0; tt < nt; ++tt) {
            const float xv = xs[tt * 64 + p], dtv = dts[tt], dA = das[tt], xd = xv * dtv; float part = 0.f;
#pragma unroll
            for (int i = 0; i < 4; ++i) { const f32x4 bv = *(const LAS f32x4*)(Bs + tt * 128 + n0 + 4 * i), cv = *(const LAS f32x4*)(Cs + tt * 128 + n0 + 4 * i);
                hs[4 * i] = dA * hs[4 * i] + xd * bv.x; hs[4 * i + 1] = dA * hs[4 * i + 1] + xd * bv.y; hs[4 * i + 2] = dA * hs[4 * i + 2] + xd * bv.z; hs[4 * i + 3] = dA * hs[4 * i + 3] + xd * bv.w;
                part += (hs[4 * i] * cv.x + hs[4 * i + 1] * cv.y) + (hs[4 * i + 2] * cv.z + hs[4 * i + 3] * cv.w); }
            part += __shfl_xor(part, 1); part += __shfl_xor(part, 2); part += __shfl_xor(part, 4);
            if ((tid & 7) == 0) ys[tt * 64 + p] = part;
        }
        __syncthreads();
        { const int tt = tid >> 3, p0 = (tid & 7) * 8;
          if (tt < nt) { const size_t row = row_base + t0 + tt;
            const v4u zw = *(const v4u*)(PROJ + (size_t)(S_Z0 + (h >> 4)) * SLOT_ELEMS + row * 1024 + (h & 15) * 64 + p0);
            float o[8]; float sq = 0.f;
#pragma unroll
            for (int j = 0; j < 8; ++j) { const unsigned z16 = (zw[j >> 1] >> ((j & 1) * 16)) & 0xffffu; const float yv = (ys[tt * 64 + p0 + j] + xs[tt * 64 + p0 + j] * Dk) * silu_f(bf2f(z16)); o[j] = yv; sq += yv * yv; }
            v4u ow; ow.x = pk2(o[0], o[1]); ow.y = pk2(o[2], o[3]); ow.z = pk2(o[4], o[5]); ow.w = pk2(o[6], o[7]);
            *(v4u*)(YG + row * 2048 + h * 64 + p0) = ow;
            sq += __shfl_xor(sq, 1); sq += __shfl_xor(sq, 2); sq += __shfl_xor(sq, 4);
            if ((tid & 7) == 0) SSQ[row * 32 + h] = sq; } }
        __syncthreads();
    }
#pragma unroll
    for (int i = 0; i < 4; ++i) *(f32x4*)(state_out + 4 * i) = (f32x4){hs[4 * i], hs[4 * i + 1], hs[4 * i + 2], hs[4 * i + 3]};
}
__device__ __forceinline__ void hgrn_unit(Frame& F, int gb, int hd) {
    const int tid = F.tid; unsigned char* ws = F.ws;
    const bool prompt = gb < NBP; const int L = prompt ? SEQ : LS; const int sb = gb - NBP; const size_t row_base = prompt ? (size_t)gb * SEQ : (size_t)TP + (size_t)sb * LS;
    LAS float* qs = (LAS float*)(F.lds + RING_OFF);
    LAS float* fs = qs + 32 * 128; LAS float* ks = fs + 32 * 128; LAS float* vs = ks + 32 * 128; LAS float* os = vs + 32 * 128;
    const bf16* PROJ = (const bf16*)(ws + WS_PROJ); bf16* ON = (bf16*)(ws + WS_ON);
    const int v = tid >> 2, k0 = (tid & 3) * 32;
    float S[32];
    float* state_out = prompt ? F.out + O_HGP + ((size_t)(gb * 8 + hd) * 128 + k0) * 128 + v : F.out + O_HGS + ((size_t)(sb * 8 + hd) * 128 + k0) * 128 + v;
    if (prompt) {
#pragma unroll
        for (int i = 0; i < 32; ++i) S[i] = 0.f;
    } else { const float* sp = F.in[5] + ((size_t)(sb * 8 + hd) * 128 + k0) * 128 + v;
#pragma unroll
        for (int i = 0; i < 32; ++i) S[i] = sp[(size_t)i * 128]; }
    const int c = tid & 127, part = tid >> 7; const int ch = hd * 128 + c;
    float lb = 0.f; if (part == 1) lb = 1.0f / (1.0f + __expf(F.in[17][1024 + ch] - F.in[17][ch]));
    const bf16* sptr = PROJ + (size_t)(part == 0 ? S_Q : (part == 1 ? S_F : S_I)) * SLOT_ELEMS + row_base * 1024 + ch;
    for (int t0 = 0; t0 < L; t0 += 32) {
        const int nt = (L - t0) < 32 ? (L - t0) : 32;
        if (part < 3) {
            for (int tt = 0; tt < nt; ++tt) { const float raw = bf2f(sptr[(size_t)(t0 + tt) * 1024]);
                if (part == 0) qs[tt * 128 + c] = silu_f(raw);
                else if (part == 1) { const float e = __expf(-raw); const float sg = 1.0f / (1.0f + e); fs[tt * 128 + c] = lb + (1.0f - lb) * sg; ks[tt * 128 + c] = (1.0f - lb) * (e / (1.0f + e)); }
                else vs[tt * 128 + c] = raw; }
        }
        __syncthreads();
        for (int tt = 0; tt < nt; ++tt) {
            const float vv = vs[tt * 128 + v]; float acc = 0.f;
#pragma unroll
            for (int i = 0; i < 8; ++i) { const f32x4 fv = *(const LAS f32x4*)(fs + tt * 128 + k0 + 4 * i), kv = *(const LAS f32x4*)(ks + tt * 128 + k0 + 4 * i), qv = *(const LAS f32x4*)(qs + tt * 128 + k0 + 4 * i);
                S[4 * i] = fv.x * S[4 * i] + kv.x * vv; S[4 * i + 1] = fv.y * S[4 * i + 1] + kv.y * vv; S[4 * i + 2] = fv.z * S[4 * i + 2] + kv.z * vv; S[4 * i + 3] = fv.w * S[4 * i + 3] + kv.w * vv;
                acc += (S[4 * i] * qv.x + S[4 * i + 1] * qv.y) + (S[4 * i + 2] * qv.z + S[4 * i + 3] * qv.w); }
            acc += __shfl_xor(acc, 1); acc += __shfl_xor(acc, 2);
            if ((tid & 3) == 0) os[tt * 128 + v] = acc;
        }
        __syncthreads();
        { const int tt = tid >> 4, v0 = (tid & 15) * 8;
          if (tt < nt) { const size_t row = row_base + t0 + tt; float o[8]; float sq = 0.f;
#pragma unroll
            for (int j = 0; j < 8; ++j) { o[j] = os[tt * 128 + v0 + j]; sq += o[j] * o[j]; }
            sq += __shfl_xor(sq, 1); sq += __shfl_xor(sq, 2); sq += __shfl_xor(sq, 4); sq += __shfl_xor(sq, 8);
            const float rs = 1.0f / sqrtf(sq * (1.0f / 128.0f) + EPS);
            const v4u gw = *(const v4u*)(PROJ + (size_t)S_HG * SLOT_ELEMS + row * 1024 + hd * 128 + v0);
#pragma unroll
            for (int j = 0; j < 8; ++j) { const unsigned g16 = (gw[j >> 1] >> ((j & 1) * 16)) & 0xffffu; o[j] = o[j] * rs * silu_f(bf2f(g16)); }
            v4u ow; ow.x = pk2(o[0], o[1]); ow.y = pk2(o[2], o[3]); ow.z = pk2(o[4], o[5]); ow.w = pk2(o[6], o[7]);
            *(v4u*)(ON + row * 1024 + hd * 128 + v0) = ow; } }
        __syncthreads();
    }
#pragma unroll
    for (int i = 0; i < 32; ++i) state_out[(size_t)i * 128] = S[i];
}
__device__ __forceinline__ void conv_copy_unit(Frame& F, int gb) {
    const bf16* PROJ = (const bf16*)(F.ws + WS_PROJ);
    const bool prompt = gb < NBP; const int sb = gb - NBP;
    const size_t row0 = prompt ? (size_t)gb * SEQ + (SEQ - 3) : (size_t)TP + (size_t)sb * LS + 1;
    float* dst = prompt ? F.out + O_CONVP + (size_t)gb * 3 * 3072 : F.out + O_CONVS + (size_t)sb * 3 * 3072;
    for (int e = F.tid; e < 3 * 3072; e += NTHR) { const int j = e / 3072, col = e % 3072;
        dst[e] = bf2f(PROJ[(size_t)(S_X0 + (col >> 10)) * SLOT_ELEMS + (row0 + j) * 1024 + (col & 1023)]); }
}
__device__ __forceinline__ void ssdnorm_phase(Frame& F) {
    const int gw = F.vcu * NWAVES + F.wave, NGW = F.G * NWAVES; bf16* YG = (bf16*)(F.ws + WS_YG); const float* SSQ = (const float*)(F.ws + WS_SSQSSD);
    for (int row = gw; row < T; row += NGW) {
        const f32x4* sp = (const f32x4*)(SSQ + (size_t)row * 32);
#pragma unroll
        for (int j = 0; j < 4; ++j) { const f32x4 a = sp[2 * j], b = sp[2 * j + 1]; const float s = ((a.x + a.y) + (a.z + a.w)) + ((b.x + b.y) + (b.z + b.w)); const float rs = 1.0f / sqrtf(s * (1.0f / 512.0f) + EPS);
            v4u* p = (v4u*)(YG + (size_t)row * 2048) + j * 64 + F.lane; const v4u w = *p; v4u o;
#pragma unroll
            for (int e = 0; e < 4; ++e) o[e] = pk2(bf2f(w[e] & 0xffffu) * rs, bf2f(w[e] >> 16) * rs);
            *p = o; }
    }
}
typedef float f32x16 __attribute__((ext_vector_type(16)));
#define MFMA32(a, b, c) __builtin_amdgcn_mfma_f32_32x32x16_bf16((a), (b), (c), 0, 0, 0)
__device__ __forceinline__ unsigned cvtpk_c(float lo, float hi) { return pk2(lo, hi); }
__device__ __forceinline__ bf16x8 pack8(float a0, float a1, float a2, float a3, float a4, float a5, float a6, float a7) {
    v4u w; w.x = cvtpk_c(a0, a1); w.y = cvtpk_c(a2, a3); w.z = cvtpk_c(a4, a5); w.w = cvtpk_c(a6, a7); return __builtin_bit_cast(bf16x8, w); }
#define ACC_FRAG(x, s) pack8((x)[8 * (s)], (x)[8 * (s) + 1], (x)[8 * (s) + 2], (x)[8 * (s) + 3], (x)[8 * (s) + 4], (x)[8 * (s) + 5], (x)[8 * (s) + 6], (x)[8 * (s) + 7])
__device__ __forceinline__ bf16x8 lds_frag16(const LAS unsigned char* p) { return *(const LAS bf16x8*)p; }
__device__ __forceinline__ bf16x8 lds_frag8x2(const LAS unsigned char* p) { const v2u lo = *(const LAS v2u*)p, hi = *(const LAS v2u*)(p + 16);
    const v4u w = (v4u){lo.x, lo.y, hi.x, hi.y}; return __builtin_bit_cast(bf16x8, w); }
__device__ __forceinline__ float exp_clamped(float x) { return __expf(fminf(x, 80.0f)); }
constexpr int HG_QA = 0, HG_KA = 8704, HG_KAT = 17408, HG_VT = 27648, HG_EGM = 37888, HG_EGL = 38400, HG_SEG = 38912, HG_OB = 40960, HG_RAW = 74752;
__device__ __forceinline__ void hgrn_unit_mfma(Frame& F, int gb, int hd) {
    int tid_o = F.tid; asm volatile("" : "+v"(tid_o));
    const int tid = tid_o, lane = tid & 63, w = F.wave, r = lane & 31, hh = lane >> 5; unsigned char* ws = F.ws;
    const bool prompt = gb < NBP; const int L = prompt ? SEQ : LS; const int sb = gb - NBP; const size_t row_base = prompt ? (size_t)gb * SEQ : (size_t)TP + (size_t)sb * LS;
    LAS unsigned char* Lb = F.lds + RING_OFF;
    LAS unsigned short* QA = (LAS unsigned short*)(Lb + HG_QA); LAS unsigned short* KA = (LAS unsigned short*)(Lb + HG_KA);
    LAS unsigned short* KAT = (LAS unsigned short*)(Lb + HG_KAT); LAS unsigned short* VT = (LAS unsigned short*)(Lb + HG_VT);
    LAS float* EGM = (LAS float*)(Lb + HG_EGM); LAS float* EGL = (LAS float*)(Lb + HG_EGL); LAS float* SEG = (LAS float*)(Lb + HG_SEG); LAS float* OB = (LAS float*)(Lb + HG_OB);
    const bf16* PROJ = (const bf16*)(ws + WS_PROJ); bf16* ON = (bf16*)(ws + WS_ON);
    const int vt = w & 3, kh = w >> 2;
    f32x16 S0, S1;
    float* st_g = (prompt ? F.out + O_HGP + (size_t)(gb * 8 + hd) * 16384 : F.out + O_HGS + (size_t)(sb * 8 + hd) * 16384) + 32 * vt + r;
    if (prompt) {
#pragma unroll
        for (int i = 0; i < 16; ++i) { S0[i] = 0.f; S1[i] = 0.f; }
    } else { const float* sp = F.in[5] + (size_t)(sb * 8 + hd) * 16384 + 32 * vt + r;
#pragma unroll
        for (int i = 0; i < 16; ++i) { const int k = 64 * kh + (i & 3) + 8 * (i >> 2) + 4 * hh; S0[i] = sp[(size_t)k * 128]; S1[i] = sp[(size_t)(k + 32) * 128]; } }
    const int c = tid & 127, tq = tid >> 7, ch = hd * 128 + c;
    const float lb = 1.0f / (1.0f + __expf(F.in[17][1024 + ch] - F.in[17][ch]));
    LAS unsigned short* RAW = (LAS unsigned short*)(Lb + HG_RAW);
    const int srow = tid >> 4, sc8 = (tid & 15) * 8;
    const bf16* gsrc = PROJ + row_base * 1024 + hd * 128 + sc8;
    v4u pfF = (v4u){0u, 0u, 0u, 0u}, pfQ = pfF, pfI = pfF;
    if (srow < L) { const size_t o = (size_t)srow * 1024; pfF = *(const v4u*)(gsrc + (size_t)S_F * SLOT_ELEMS + o); pfQ = *(const v4u*)(gsrc + (size_t)S_Q * SLOT_ELEMS + o); pfI = *(const v4u*)(gsrc + (size_t)S_I * SLOT_ELEMS + o); }
    for (int t0 = 0; t0 < L; t0 += 32) {
        int r_l = r, hh_l = hh, c_l = c, tq_l = tq, srow_l = srow, sc8_l = sc8;
        asm volatile("" : "+v"(r_l), "+v"(hh_l), "+v"(c_l), "+v"(tq_l), "+v"(srow_l), "+v"(sc8_l));
        { const int r = r_l, hh = hh_l, c = c_l, tq = tq_l, srow = srow_l, sc8 = sc8_l;
        v4u gw = (v4u){0u, 0u, 0u, 0u};
        if (t0 + (tid >> 4) < L) gw = *(const v4u*)(PROJ + (size_t)S_HG * SLOT_ELEMS + (row_base + t0 + (tid >> 4)) * 1024 + hd * 128 + (tid & 15) * 8);
        *(LAS v4u*)(RAW + srow * 128 + sc8) = pfF; *(LAS v4u*)(RAW + 4096 + srow * 128 + sc8) = pfQ; *(LAS v4u*)(RAW + 8192 + srow * 128 + sc8) = pfI;
        __syncthreads();
        { const int tn = t0 + 32 + srow; pfF = (v4u){0u, 0u, 0u, 0u}; pfQ = pfF; pfI = pfF;
          if (tn < L) { const size_t o = (size_t)tn * 1024; pfF = *(const v4u*)(gsrc + (size_t)S_F * SLOT_ELEMS + o); pfQ = *(const v4u*)(gsrc + (size_t)S_Q * SLOT_ELEMS + o); pfI = *(const v4u*)(gsrc + (size_t)S_I * SLOT_ELEMS + o); } }
        float lc[8], kk[8], qs[8], vi[8]; float run = 0.f;
#pragma unroll
        for (int i = 0; i < 8; ++i) { const int tl = 8 * tq + i; float lf = 0.f, kv = 0.f, qv = 0.f, vv = 0.f;
            if (t0 + tl < L) { const float u = fminf(fmaxf(bf2f(RAW[tl * 128 + c]), -30.f), 30.f); const float sg = __builtin_amdgcn_rcpf(1.0f + __builtin_amdgcn_exp2f(u * -1.4426950408889634f));
                const float fg = lb + (1.0f - lb) * sg; lf = __builtin_amdgcn_logf(fg); kv = 1.0f - fg;
                const float qr = bf2f(RAW[4096 + tl * 128 + c]); qv = qr * __builtin_amdgcn_rcpf(1.0f + __builtin_amdgcn_exp2f(qr * -1.4426950408889634f)); vv = bf2f(RAW[8192 + tl * 128 + c]); }
            run += lf; lc[i] = run; kk[i] = kv; qs[i] = qv; vi[i] = vv; }
        SEG[tq * 128 + c] = run;
        __syncthreads();
        { const float s0 = SEG[c], s1 = SEG[128 + c], s2 = SEG[256 + c], s3 = SEG[384 + c]; const float gm = s0 + s1, gl = (s0 + s1) + (s2 + s3);
          const float pre = tq == 0 ? 0.f : (tq == 1 ? s0 : (tq == 2 ? s0 + s1 : (s0 + s1) + s2));
          float kav[8];
#pragma unroll
          for (int i = 0; i < 8; ++i) { const float d = fminf(fmaxf((pre + lc[i]) - gm, -120.f), 120.f); const float e1 = __builtin_amdgcn_exp2f(d), e2 = __builtin_amdgcn_rcpf(e1);
              const float qa = qs[i] * e1, ka = kk[i] * e2; const int t = 8 * tq + i; const unsigned w2 = pk2(qa, ka);
              QA[t * 136 + c] = (unsigned short)(w2 & 0xffffu); KA[t * 136 + c] = (unsigned short)(w2 >> 16); kav[i] = ka; }
          v4u pk; pk.x = pk2(kav[0], kav[1]); pk.y = pk2(kav[2], kav[3]); pk.z = pk2(kav[4], kav[5]); pk.w = pk2(kav[6], kav[7]); *(LAS v4u*)(KAT + c * 40 + 8 * tq) = pk;
          v4u pv; pv.x = pk2(vi[0], vi[1]); pv.y = pk2(vi[2], vi[3]); pv.z = pk2(vi[4], vi[5]); pv.w = pk2(vi[6], vi[7]); *(LAS v4u*)(VT + c * 40 + 8 * tq) = pv;
          if (tq == 0) { EGM[c] = __builtin_amdgcn_exp2f(gm); EGL[c] = __builtin_amdgcn_exp2f(gl - gm); } }
        __syncthreads();
        {
#pragma unroll
            for (int q4 = 0; q4 < 4; ++q4) { const f32x4 e0 = *(const LAS f32x4*)(EGM + 64 * kh + 8 * q4 + 4 * hh), e1 = *(const LAS f32x4*)(EGM + 64 * kh + 32 + 8 * q4 + 4 * hh);
#pragma unroll
                for (int j = 0; j < 4; ++j) { S0[4 * q4 + j] *= e0[j]; S1[4 * q4 + j] *= e1[j]; } }
            __builtin_amdgcn_sched_barrier(0);
            f32x16 o;
#pragma unroll
            for (int i = 0; i < 16; ++i) o[i] = 0.f;
            const LAS unsigned char* qa_row = Lb + HG_QA + r * 272;
            o = MFMA32(lds_frag8x2(qa_row + (64 * kh + 4 * hh) * 2), ACC_FRAG(S0, 0), o);
            o = MFMA32(lds_frag8x2(qa_row + (64 * kh + 16 + 4 * hh) * 2), ACC_FRAG(S0, 1), o);
            o = MFMA32(lds_frag8x2(qa_row + (64 * kh + 32 + 4 * hh) * 2), ACC_FRAG(S1, 0), o);
            o = MFMA32(lds_frag8x2(qa_row + (64 * kh + 48 + 4 * hh) * 2), ACC_FRAG(S1, 1), o);
            __builtin_amdgcn_sched_barrier(0);
            if (kh == 0) {
                f32x16 X;
#pragma unroll
                for (int i = 0; i < 16; ++i) X[i] = 0.f;
                const LAS unsigned char* ka_nat = Lb + HG_KA + r * 272 + hh * 16; const LAS unsigned char* qa_nat = Lb + HG_QA + r * 272 + hh * 16;
#pragma unroll 2
                for (int ks = 0; ks < 8; ++ks) X = MFMA32(lds_frag16(ka_nat + ks * 32), lds_frag16(qa_nat + ks * 32), X);
#pragma unroll
                for (int i = 0; i < 16; ++i) { const int srow = (i & 3) + 8 * (i >> 2) + 4 * hh; X[i] = (srow <= r) ? X[i] : 0.f; }
                const LAS unsigned char* vt_row = Lb + HG_VT + (32 * vt + r) * 80;
                o = MFMA32(ACC_FRAG(X, 0), lds_frag8x2(vt_row + (4 * hh) * 2), o);
                o = MFMA32(ACC_FRAG(X, 1), lds_frag8x2(vt_row + (16 + 4 * hh) * 2), o);
            }
            __builtin_amdgcn_sched_barrier(0);
            LAS float* ob = OB + (kh * 32) * 132 + 32 * vt + r;
#pragma unroll
            for (int i = 0; i < 16; ++i) ob[((i & 3) + 8 * (i >> 2) + 4 * hh) * 132] = o[i];
            __builtin_amdgcn_sched_barrier(0);
            const LAS unsigned char* kat_nat = Lb + HG_KAT + (64 * kh + r) * 80 + hh * 16; const LAS unsigned char* vt_nat = Lb + HG_VT + (32 * vt + r) * 80 + hh * 16;
#pragma unroll
            for (int s2 = 0; s2 < 2; ++s2) { const bf16x8 b = lds_frag16(vt_nat + s2 * 32); S0 = MFMA32(lds_frag16(kat_nat + s2 * 32), b, S0); S1 = MFMA32(lds_frag16(kat_nat + 32 * 80 + s2 * 32), b, S1); }
__builtin_amdgcn_sched_barrier(0);
#pragma unroll
            for (int q4 = 0; q4 < 4; ++q4) { const f32x4 e0 = *(const LAS f32x4*)(EGL + 64 * kh + 8 * q4 + 4 * hh), e1 = *(const LAS f32x4*)(EGL + 64 * kh + 32 + 8 * q4 + 4 * hh);
#pragma unroll
                for (int j = 0; j < 4; ++j) { S0[4 * q4 + j] *= e0[j]; S1[4 * q4 + j] *= e1[j]; } }
        }
        __syncthreads();
        { const int t = tid >> 4, v0 = (tid & 15) * 8;
          if (t0 + t < L) { const size_t row = row_base + t0 + t; float o[8]; float sq = 0.f;
            const f32x4 a0 = *(const LAS f32x4*)(OB + t * 132 + v0), a1 = *(const LAS f32x4*)(OB + t * 132 + v0 + 4), b0 = *(const LAS f32x4*)(OB + (32 + t) * 132 + v0), b1 = *(const LAS f32x4*)(OB + (32 + t) * 132 + v0 + 4);
#pragma unroll
            for (int j = 0; j < 4; ++j) { o[j] = a0[j] + b0[j]; o[4 + j] = a1[j] + b1[j]; }
#pragma unroll
            for (int j = 0; j < 8; ++j) sq += o[j] * o[j];
            sq += __shfl_xor(sq, 1); sq += __shfl_xor(sq, 2); sq += __shfl_xor(sq, 4); sq += __shfl_xor(sq, 8);
            const float rs = __builtin_amdgcn_rsqf(sq * (1.0f / 128.0f) + EPS);
#pragma unroll
            for (int j = 0; j < 8; ++j) { const unsigned g16 = (gw[j >> 1] >> ((j & 1) * 16)) & 0xffffu; o[j] = o[j] * rs * silu_f(bf2f(g16)); }
            v4u ow; ow.x = pk2(o[0], o[1]); ow.y = pk2(o[2], o[3]); ow.z = pk2(o[4], o[5]); ow.w = pk2(o[6], o[7]);
            *(v4u*)(ON + row * 1024 + hd * 128 + v0) = ow; } }
        }
    }
#pragma unroll
    for (int i = 0; i < 16; ++i) { const int k = 64 * kh + (i & 3) + 8 * (i >> 2) + 4 * hh; st_g[(size_t)k * 128] = S0[i]; st_g[(size_t)(k + 32) * 128] = S1[i]; }
    __syncthreads();
}
constexpr size_t WS_BCS = WS_END, WS_BTT = WS_BCS + (size_t)TP * 1024 * 2, WS_END2 = WS_BTT + (size_t)NBP * 32 * 4 * 128 * 64 * 2;
__device__ __forceinline__ void bc_prep_unit(Frame& F, int b, int c) {
    typedef float f32x2 __attribute__((ext_vector_type(2)));
    int tid_o = F.tid; asm volatile("" : "+v"(tid_o));
    const int tid = tid_o, cg = tid & 127, seg = tid >> 7; unsigned char* ws = F.ws;
    const bf16* src = (const bf16*)(ws + WS_PROJ) + (size_t)S_X2 * SLOT_ELEMS + (size_t)b * SEQ * 1024 + 8 * cg;
    bf16* BCS = (bf16*)(ws + WS_BCS); bf16* BTT = (bf16*)(ws + WS_BTT);
    const float* cw = F.in[10] + 2048 + 8 * cg; const float* cbp = F.in[11] + 2048 + 8 * cg;
#pragma unroll 1
    for (int half = 0; half < 2; ++half) {
        const int s0 = 16 * seg + 8 * half;
        v4u raw[11];
#pragma unroll
        for (int i = 0; i < 11; ++i) { const int gt = 64 * c + s0 - 3 + i; raw[i] = (v4u){0u, 0u, 0u, 0u}; if (gt >= 0) raw[i] = *(const v4u*)(src + (size_t)gt * 1024); }
        v4u rowpk[8];
#pragma unroll
        for (int kp = 0; kp < 4; ++kp) {
            const f32x2 cw0 = *(const f32x2*)(cw + 2 * kp), cw1 = *(const f32x2*)(cw + 3072 + 2 * kp), cw2 = *(const f32x2*)(cw + 2 * 3072 + 2 * kp), cw3 = *(const f32x2*)(cw + 3 * 3072 + 2 * kp), cbb = *(const f32x2*)(cbp + 2 * kp);
            f32x2 xv[11];
#pragma unroll
            for (int i = 0; i < 11; ++i) { const unsigned wd = raw[i][kp]; xv[i] = (f32x2){__uint_as_float(wd << 16), __uint_as_float(wd & 0xffff0000u)}; }
            f32x2 o[8];
#pragma unroll
            for (int i = 0; i < 8; ++i) { f32x2 a = cw0 * xv[i] + cbb; a = cw1 * xv[i + 1] + a; a = cw2 * xv[i + 2] + a; a = cw3 * xv[i + 3] + a;
                const f32x2 t = a * (-1.4426950408889634f); f32x2 e; e.x = __builtin_amdgcn_exp2f(t.x); e.y = __builtin_amdgcn_exp2f(t.y); e = e + 1.0f;
                f32x2 rc; rc.x = __builtin_amdgcn_rcpf(e.x); rc.y = __builtin_amdgcn_rcpf(e.y); o[i] = a * rc; }
#pragma unroll
            for (int i = 0; i < 8; ++i) rowpk[i][kp] = pk2(o[i].x, o[i].y);
            if (cg < 64) { const int ng = 8 * cg + 2 * kp, g = ng >> 7, n = ng & 127;
                bf16* dst = BTT + ((size_t)(((b * 32 + c) * 4 + g) * 128 + n)) * 64 + s0;
                v4u pa; pa.x = pk2(o[0].x, o[1].x); pa.y = pk2(o[2].x, o[3].x); pa.z = pk2(o[4].x, o[5].x); pa.w = pk2(o[6].x, o[7].x); *(v4u*)dst = pa;
                v4u pb; pb.x = pk2(o[0].y, o[1].y); pb.y = pk2(o[2].y, o[3].y); pb.z = pk2(o[4].y, o[5].y); pb.w = pk2(o[6].y, o[7].y); *(v4u*)(dst + 64) = pb; }
        }
        bf16* drow = BCS + ((size_t)b * SEQ + 64 * c + s0) * 1024 + 8 * cg;
#pragma unroll
        for (int i = 0; i < 8; ++i) *(v4u*)(drow + (size_t)i * 1024) = rowpk[i];
    }
}
__device__ __forceinline__ void bc_prep_phase(Frame& F) { for (int u = F.vcu; u < NBP * 32; u += F.G) bc_prep_unit(F, u >> 5, u & 31); }
constexpr size_t WS_HVT = WS_XB, WS_EGM = WS_END2, WS_EGL = WS_EGM + (size_t)NBP * 64 * 1024 * 4, WS_END3 = WS_EGL + (size_t)NBP * 64 * 1024 * 4;
__device__ __forceinline__ void hg_prep_unit(Frame& F, int b, int c) {
    typedef float f32x2 __attribute__((ext_vector_type(2)));
    int tid_o = F.tid; asm volatile("" : "+v"(tid_o));
    const int tid = tid_o; unsigned char* ws = F.ws;
    const int ch = 2 * tid, hd = ch >> 7, k = ch & 127;
    const size_t row0 = (size_t)b * SEQ + 32 * c;
    bf16* QS = (bf16*)(ws + WS_PROJ) + (size_t)S_Q * SLOT_ELEMS + row0 * 1024 + ch; bf16* FS = (bf16*)(ws + WS_PROJ) + (size_t)S_F * SLOT_ELEMS + row0 * 1024 + ch;
    bf16* IS = (bf16*)(ws + WS_PROJ) + (size_t)S_I * SLOT_ELEMS + row0 * 1024;
    const f32x2 l0 = *(const f32x2*)(F.in[17] + ch), l1 = *(const f32x2*)(F.in[17] + 1024 + ch);
    f32x2 lb; lb.x = __builtin_amdgcn_rcpf(1.0f + __expf(l1.x - l0.x)); lb.y = __builtin_amdgcn_rcpf(1.0f + __expf(l1.y - l0.y));
    const f32x2 omlb = 1.0f - lb;
    f32x2 P[32]; f32x2 run = (f32x2){1.0f, 1.0f};
#pragma unroll
    for (int t = 0; t < 32; ++t) { const unsigned wd = *(const unsigned*)(FS + (size_t)t * 1024);
        f32x2 u = (f32x2){__uint_as_float(wd << 16), __uint_as_float(wd & 0xffff0000u)}; u.x = fminf(fmaxf(u.x, -30.f), 30.f); u.y = fminf(fmaxf(u.y, -30.f), 30.f);
        const f32x2 tt = u * (-1.4426950408889634f); f32x2 e; e.x = __builtin_amdgcn_exp2f(tt.x); e.y = __builtin_amdgcn_exp2f(tt.y); e = e + 1.0f;
        f32x2 sg; sg.x = __builtin_amdgcn_rcpf(e.x); sg.y = __builtin_amdgcn_rcpf(e.y);
        const f32x2 fg = lb + omlb * sg; run = run * fg; run.x = fmaxf(run.x, 1e-30f); run.y = fmaxf(run.y, 1e-30f); P[t] = run; }
    const f32x2 Pm = P[15], Pl = P[31]; f32x2 rPm; rPm.x = __builtin_amdgcn_rcpf(Pm.x); rPm.y = __builtin_amdgcn_rcpf(Pm.y);
    *(f32x2*)((float*)(ws + WS_EGM) + (size_t)(b * 64 + c) * 1024 + ch) = Pm; *(f32x2*)((float*)(ws + WS_EGL) + (size_t)(b * 64 + c) * 1024 + ch) = Pl * rPm;
    unsigned kx[16], ky[16], vx[16], vy[16];
    f32x2 rPprev = (f32x2){1.0f, 1.0f}; f32x2 kprev = (f32x2){0.f, 0.f}; unsigned iprev = 0u;
#pragma unroll
    for (int t = 0; t < 32; ++t) { f32x2 rP; rP.x = __builtin_amdgcn_rcpf(P[t].x); rP.y = __builtin_amdgcn_rcpf(P[t].y);
        const f32x2 e1 = P[t] * rPm, e2 = Pm * rP, fg = P[t] * rPprev, kk = 1.0f - fg; rPprev = rP;
        const unsigned qw = *(const unsigned*)(QS + (size_t)t * 1024); const f32x2 q = (f32x2){__uint_as_float(qw << 16), __uint_as_float(qw & 0xffff0000u)};
        const f32x2 tq = q * (-1.4426950408889634f); f32x2 eq; eq.x = __builtin_amdgcn_exp2f(tq.x); eq.y = __builtin_amdgcn_exp2f(tq.y); eq = eq + 1.0f;
        f32x2 rq; rq.x = __builtin_amdgcn_rcpf(eq.x); rq.y = __builtin_amdgcn_rcpf(eq.y);
        const f32x2 qa = q * rq * e1, ka = kk * e2;
        *(unsigned*)(QS + (size_t)t * 1024) = pk2(qa.x, qa.y); *(unsigned*)(FS + (size_t)t * 1024) = pk2(ka.x, ka.y);
        const unsigned iw = *(const unsigned*)(IS + (size_t)t * 1024 + ch);
        if (t & 1) { kx[t >> 1] = pk2(kprev.x, ka.x); ky[t >> 1] = pk2(kprev.y, ka.y); vx[t >> 1] = (iprev & 0xffffu) | (iw << 16); vy[t >> 1] = (iprev >> 16) | (iw & 0xffff0000u); }
        kprev = ka; iprev = iw; }
    bf16* VTg = (bf16*)(ws + WS_HVT) + ((size_t)((b * 64 + c) * 8 + hd) * 128 + k) * 32;
#pragma unroll
    for (int j = 0; j < 4; ++j) { *(v4u*)(VTg + 8 * j) = (v4u){vx[4 * j], vx[4 * j + 1], vx[4 * j + 2], vx[4 * j + 3]}; *(v4u*)(VTg + 32 + 8 * j) = (v4u){vy[4 * j], vy[4 * j + 1], vy[4 * j + 2], vy[4 * j + 3]}; }
    __syncthreads();
    bf16* KTg = IS + ((size_t)hd * 128 + k) * 32;
#pragma unroll
    for (int j = 0; j < 4; ++j) { *(v4u*)(KTg + 8 * j) = (v4u){kx[4 * j], kx[4 * j + 1], kx[4 * j + 2], kx[4 * j + 3]}; *(v4u*)(KTg + 32 + 8 * j) = (v4u){ky[4 * j], ky[4 * j + 1], ky[4 * j + 2], ky[4 * j + 3]}; }
    __syncthreads();
}
__device__ __forceinline__ void hg_prep_phase(Frame& F) { for (int u = F.vcu; u < NBP * 64; u += F.G) hg_prep_unit(F, u >> 6, u & 63); }
constexpr int HV_QA = 0, HV_KA = 8704, HV_KAT = 17408, HV_VT = 27648, HV_EGM = 30208, HV_EGL = 30720, HV_OB = 31232;
constexpr size_t WS_SSQH = WS_END3, WS_END4 = WS_SSQH + (size_t)T * 32 * 4;
__device__ __forceinline__ void hgrn_v_unit(Frame& F, int b, int hd, int vt) {
    int tid_o = F.tid; asm volatile("" : "+v"(tid_o));
    const int tid = tid_o, lane = tid & 63, w = F.wave, r = lane & 31, hh = lane >> 5; unsigned char* ws = F.ws;
    LAS unsigned char* Lb = F.lds + RING_OFF;
    LAS float* EGM = (LAS float*)(Lb + HV_EGM); LAS float* EGL = (LAS float*)(Lb + HV_EGL); LAS float* OB = (LAS float*)(Lb + HV_OB);
    const bf16* PROJ = (const bf16*)(ws + WS_PROJ); bf16* OU = (bf16*)(ws + WS_ON); float* SSQH = (float*)(ws + WS_SSQH);
    const size_t rowb = (size_t)b * SEQ;
    const bf16* qsrc = PROJ + (size_t)S_Q * SLOT_ELEMS + (rowb + (tid >> 4)) * 1024 + hd * 128 + 8 * (tid & 15);
    const bf16* ksrc = PROJ + (size_t)S_F * SLOT_ELEMS + (rowb + (tid >> 4)) * 1024 + hd * 128 + 8 * (tid & 15);
    const bf16* tsrc = PROJ + (size_t)S_I * SLOT_ELEMS + rowb * 1024 + (size_t)(hd * 128 + (tid >> 2)) * 32 + 8 * (tid & 3);
    const unsigned char* xsrc = nullptr;
    size_t xstr = 0;
    if (tid < 128) { xsrc = (const unsigned char*)((const bf16*)(ws + WS_HVT) + ((size_t)(b * 64 * 8 + hd) * 128 + 32 * vt + (tid >> 2)) * 32 + 8 * (tid & 3)); xstr = (size_t)8 * 128 * 32 * 2; }
    else if (tid < 160) { xsrc = (const unsigned char*)((const float*)(ws + WS_EGM) + (size_t)b * 64 * 1024 + hd * 128 + 4 * (tid - 128)); xstr = 4096; }
    else if (tid < 192) { xsrc = (const unsigned char*)((const float*)(ws + WS_EGL) + (size_t)b * 64 * 1024 + hd * 128 + 4 * (tid - 160)); xstr = 4096; }
    const int xdst = tid < 128 ? HV_VT + (tid >> 2) * 80 + 16 * (tid & 3) : (tid < 160 ? HV_EGM + 16 * (tid - 128) : HV_EGL + 16 * (tid - 160));
    v4u pq = *(const v4u*)qsrc, pk = *(const v4u*)ksrc, pt = *(const v4u*)tsrc, px = (v4u){0u, 0u, 0u, 0u};
    if (tid < 192) px = *(const v4u*)xsrc;
    const int kt = w;
    f32x16 S;
#pragma unroll
    for (int i = 0; i < 16; ++i) S[i] = 0.f;
#pragma unroll 1
    for (int c = 0; c < 64; ++c) {
        int r_l = r, hh_l = hh, tid_l = tid; asm volatile("" : "+v"(r_l), "+v"(hh_l), "+v"(tid_l));
        { const int r = r_l, hh = hh_l, tid = tid_l;
        *(LAS v4u*)(Lb + HV_QA + (tid >> 4) * 272 + 16 * (tid & 15)) = pq; *(LAS v4u*)(Lb + HV_KA + (tid >> 4) * 272 + 16 * (tid & 15)) = pk;
        *(LAS v4u*)(Lb + HV_KAT + (tid >> 2) * 80 + 16 * (tid & 3)) = pt; if (tid < 192) *(LAS v4u*)(Lb + xdst) = px;
        __syncthreads();
        if (c < 63) { pq = *(const v4u*)(qsrc + (size_t)(c + 1) * 32 * 1024); pk = *(const v4u*)(ksrc + (size_t)(c + 1) * 32 * 1024); pt = *(const v4u*)(tsrc + (size_t)(c + 1) * 32768);
            if (tid < 192) px = *(const v4u*)(xsrc + (size_t)(c + 1) * xstr); }
        if (w < 4) {
#pragma unroll
            for (int q4 = 0; q4 < 4; ++q4) { const f32x4 e0 = *(const LAS f32x4*)(EGM + 32 * kt + 8 * q4 + 4 * hh);
#pragma unroll
                for (int j = 0; j < 4; ++j) S[4 * q4 + j] *= e0[j]; }
            f32x16 o;
#pragma unroll
            for (int i = 0; i < 16; ++i) o[i] = 0.f;
            const LAS unsigned char* qa_row = Lb + HV_QA + r * 272;
            o = MFMA32(lds_frag8x2(qa_row + (32 * kt + 4 * hh) * 2), ACC_FRAG(S, 0), o);
            o = MFMA32(lds_frag8x2(qa_row + (32 * kt + 16 + 4 * hh) * 2), ACC_FRAG(S, 1), o);
            if (w == 0) {
                f32x16 X;
#pragma unroll
                for (int i = 0; i < 16; ++i) X[i] = 0.f;
                const LAS unsigned char* ka_nat = Lb + HV_KA + r * 272 + hh * 16; const LAS unsigned char* qa_nat = Lb + HV_QA + r * 272 + hh * 16;
#pragma unroll 2
                for (int ks = 0; ks < 8; ++ks) X = MFMA32(lds_frag16(ka_nat + ks * 32), lds_frag16(qa_nat + ks * 32), X);
#pragma unroll
                for (int i = 0; i < 16; ++i) { const int srow = (i & 3) + 8 * (i >> 2) + 4 * hh; X[i] = (srow <= r) ? X[i] : 0.f; }
                const LAS unsigned char* vt_row = Lb + HV_VT + r * 80;
                o = MFMA32(ACC_FRAG(X, 0), lds_frag8x2(vt_row + (4 * hh) * 2), o);
                o = MFMA32(ACC_FRAG(X, 1), lds_frag8x2(vt_row + (16 + 4 * hh) * 2), o);
            }
            LAS float* ob = OB + (kt * 32) * 36 + r;
#pragma unroll
            for (int i = 0; i < 16; ++i) ob[((i & 3) + 8 * (i >> 2) + 4 * hh) * 36] = o[i];
            const LAS unsigned char* kat_nat = Lb + HV_KAT + (32 * kt + r) * 80 + hh * 16; const LAS unsigned char* vt_nat = Lb + HV_VT + r * 80 + hh * 16;
            S = MFMA32(lds_frag16(kat_nat), lds_frag16(vt_nat), S); S = MFMA32(lds_frag16(kat_nat + 32), lds_frag16(vt_nat + 32), S);
#pragma unroll
            for (int q4 = 0; q4 < 4; ++q4) { const f32x4 e0 = *(const LAS f32x4*)(EGL + 32 * kt + 8 * q4 + 4 * hh);
#pragma unroll
                for (int j = 0; j < 4; ++j) S[4 * q4 + j] *= e0[j]; }
        }
        __syncthreads();
        if (tid < 256) { const int t = tid >> 3, v0 = (tid & 7) * 4; const size_t row = rowb + 32 * c + t;
            const f32x4 a = *(const LAS f32x4*)(OB + t * 36 + v0), b2 = *(const LAS f32x4*)(OB + (32 + t) * 36 + v0), c2 = *(const LAS f32x4*)(OB + (64 + t) * 36 + v0), d2 = *(const LAS f32x4*)(OB + (96 + t) * 36 + v0);
            const f32x4 o4 = (a + b2) + (c2 + d2);
            float sq = (o4.x * o4.x + o4.y * o4.y) + (o4.z * o4.z + o4.w * o4.w); sq += __shfl_xor(sq, 1); sq += __shfl_xor(sq, 2); sq += __shfl_xor(sq, 4);
            if ((tid & 7) == 0) SSQH[row * 32 + hd * 4 + vt] = sq;
            v2u ow; ow.x = pk2(o4.x, o4.y); ow.y = pk2(o4.z, o4.w); *(v2u*)(OU + row * 1024 + hd * 128 + 32 * vt + v0) = ow; }
        }
    }
    if (w < 4) { float* st_g = F.out + O_HGP + (size_t)(b * 8 + hd) * 16384 + 32 * vt + r;
#pragma unroll
        for (int i = 0; i < 16; ++i) { const int k = 32 * kt + (i & 3) + 8 * (i >> 2) + 4 * hh; st_g[(size_t)k * 128] = S[i]; } }
    __syncthreads();
}
__device__ __forceinline__ void hgnorm_phase(Frame& F) {
    const int gw = F.vcu * NWAVES + F.wave, NGW = F.G * NWAVES; bf16* ON = (bf16*)(F.ws + WS_ON); const float* SSQH = (const float*)(F.ws + WS_SSQH);
    const bf16* HG = (const bf16*)(F.ws + WS_PROJ) + (size_t)S_HG * SLOT_ELEMS;
    for (int row = gw; row < TP; row += NGW) {
#pragma unroll
        for (int j = 0; j < 2; ++j) { const int pc = j * 64 + F.lane, hd = pc >> 4;
            const f32x4 sp = *(const f32x4*)(SSQH + (size_t)row * 32 + hd * 4); const float rs = __builtin_amdgcn_rsqf(((sp.x + sp.y) + (sp.z + sp.w)) * (1.0f / 128.0f) + EPS);
            v4u* p = (v4u*)(ON + (size_t)row * 1024) + pc; const v4u o = *p; const v4u g = *((const v4u*)(HG + (size_t)row * 1024) + pc); v4u res;
#pragma unroll
            for (int e = 0; e < 4; ++e) res[e] = pk2(bf2f(o[e] & 0xffffu) * rs * silu_f(bf2f(g[e] & 0xffffu)), __uint_as_float(o[e] & 0xffff0000u) * rs * silu_f(__uint_as_float(g[e] & 0xffff0000u)));
            *p = res; }
    }
}
constexpr int SD_BN = 0, SD_CN = 17408, SD_BT = 34816, SD_XT = 53248, SD_HT = 62464, SD_YB = 97280, SD_CUM = 114688, SD_DTV = 114944, SD_ECUM = 115200, SD_XWT = 115456;
__device__ __forceinline__ void ssd_unit_mfma(Frame& F, int gb, int h) {
    int tid_o = F.tid; asm volatile("" : "+v"(tid_o));
    const int tid = tid_o, lane = tid & 63, w = F.wave, r = lane & 31, hh = lane >> 5; unsigned char* ws = F.ws;
    const bool prompt = gb < NBP; const int L = prompt ? SEQ : LS; const int sb = gb - NBP; const size_t row_base = prompt ? (size_t)gb * SEQ : (size_t)TP + (size_t)sb * LS;
    const int g = h >> 3;
    LAS unsigned char* Lb = F.lds + RING_OFF;
    LAS unsigned short* BN = (LAS unsigned short*)(Lb + SD_BN); LAS unsigned short* CN = (LAS unsigned short*)(Lb + SD_CN);
    LAS unsigned short* BT = (LAS unsigned short*)(Lb + SD_BT); LAS unsigned short* XT = (LAS unsigned short*)(Lb + SD_XT);
    LAS unsigned short* HT = (LAS unsigned short*)(Lb + SD_HT);
    LAS unsigned short* XWT = (LAS unsigned short*)(Lb + SD_XWT);
    LAS float* YB = (LAS float*)(Lb + SD_YB);
    LAS float* CUM = (LAS float*)(Lb + SD_CUM); LAS float* DTV = (LAS float*)(Lb + SD_DTV); LAS float* ECUM = (LAS float*)(Lb + SD_ECUM);
    const bf16* PROJ = (const bf16*)(ws + WS_PROJ); const float* DTR = (const float*)(ws + WS_DT); bf16* YG = (bf16*)(ws + WS_YG); float* SSQ = (float*)(ws + WS_SSQSSD);
    const int nt = w >> 1, pt = w & 1;
    f32x16 H;
    float* st_g = (prompt ? F.out + O_SSMP + (size_t)(gb * 32 + h) * 8192 : F.out + O_SSMS + (size_t)(sb * 32 + h) * 8192) + (size_t)(32 * pt + r) * 128 + 32 * nt + 4 * hh;
    if (prompt) {
#pragma unroll
        for (int i = 0; i < 16; ++i) H[i] = 0.f;
    } else { const float* sp = F.in[3] + (size_t)(sb * 32 + h) * 8192 + (size_t)(32 * pt + r) * 128 + 32 * nt + 4 * hh;
#pragma unroll
        for (int q4 = 0; q4 < 4; ++q4) { const f32x4 v = *(const f32x4*)(sp + 8 * q4); H[4 * q4] = v.x; H[4 * q4 + 1] = v.y; H[4 * q4 + 2] = v.z; H[4 * q4 + 3] = v.w; } }
    {
        LAS unsigned short* hp = HT + (32 * pt + r) * 136 + 32 * nt + 4 * hh;
#pragma unroll
        for (int q4 = 0; q4 < 4; ++q4) { v2u pk; pk.x = cvtpk_c(H[4 * q4], H[4 * q4 + 1]); pk.y = cvtpk_c(H[4 * q4 + 2], H[4 * q4 + 3]); *(LAS v2u*)(hp + 8 * q4) = pk; }
    }
    const float a = -__expf(F.in[13][h]), dtb = F.in[12][h], Dk = F.in[14][h];
    const float* cw = F.in[10]; const float* cbp = F.in[11]; const float* sconv = F.in[4] + (size_t)(prompt ? 0 : sb) * 3 * 3072;
    const int cgl = tid & 7, xs = tid >> 3;
    const int col = h * 64 + 8 * cgl;
    const bf16* cptr = PROJ + (size_t)(S_X0 + (col >> 10)) * SLOT_ELEMS + row_base * 1024 + (col & 1023);
    const bf16* BCS = (const bf16*)(ws + WS_BCS) + row_base * 1024 + g * 128; const bf16* BTT = (const bf16*)(ws + WS_BTT) + (size_t)(gb * 32 * 4 + g) * 128 * 64;
    v4u xr[4], pc[6];
#pragma unroll
    for (int i = 0; i < 4; ++i) { const int gt = xs - 3 + i; xr[i] = (v4u){0u, 0u, 0u, 0u}; if (gt >= 0) xr[i] = *(const v4u*)(cptr + (size_t)gt * 1024); }
#pragma unroll
    for (int j = 0; j < 6; ++j) { const int idx = (tid + 512 * j) & 1023;
        if (j < 4) pc[j] = *(const v4u*)(BCS + (size_t)(idx >> 4) * 1024 + (j >> 1) * 512 + 8 * (idx & 15));
        else pc[j] = *(const v4u*)(BTT + (size_t)(idx >> 3) * 64 + 8 * (idx & 7)); }
    int buf = 0;
    float dt_pf = 0.f;
    if (lane < L) dt_pf = DTR[(row_base + lane) * 32 + h];
    for (int t0 = 0; t0 < L; t0 += 64, buf ^= 1) {
        int r_l = r, hh_l = hh, tid_l = tid, lane_l = lane;
        asm volatile("" : "+v"(r_l), "+v"(hh_l), "+v"(tid_l), "+v"(lane_l));
        { const int r = r_l, hh = hh_l, tid = tid_l, lane = lane_l;
        float dtv = 0.f;
        if (t0 + lane < L) { const float x = dt_pf + dtb; dtv = x > 20.f ? x : log1pf(__expf(x)); }
        dt_pf = 0.f; if (t0 + 64 + lane < L) dt_pf = DTR[(row_base + t0 + 64 + lane) * 32 + h];
        v4u zw = (v4u){0u, 0u, 0u, 0u};
        if (t0 + (tid >> 3) < L) zw = *(const v4u*)(PROJ + (size_t)(S_Z0 + (h >> 4)) * SLOT_ELEMS + (row_base + t0 + (tid >> 3)) * 1024 + (h & 15) * 64 + (tid & 7) * 8);
        float cum = dtv * a;
#pragma unroll
        for (int o = 1; o < 64; o <<= 1) { const float u = __shfl_up(cum, o); if (lane >= o) cum += u; }
        const float cum_last = __shfl(cum, 63);
        const float wgt = __expf(cum_last - cum) * dtv;
        if (w == 0) { CUM[lane] = cum; DTV[lane] = dtv; ECUM[lane] = __expf(cum); }
#pragma unroll
        for (int j = 0; j < 6; ++j) { const int idx = (tid + 512 * j) & 1023;
            if (j < 2) *(LAS v4u*)(BN + (idx >> 4) * 136 + 8 * (idx & 15)) = pc[j];
            else if (j < 4) *(LAS v4u*)(CN + (idx >> 4) * 136 + 8 * (idx & 15)) = pc[j];
            else *(LAS v4u*)(BT + (idx >> 3) * 72 + 8 * (idx & 7)) = pc[j]; }
        { const int xs = tid >> 3, cgl = tid & 7; const float wx = __shfl(wgt, xs); typedef float f32x2 __attribute__((ext_vector_type(2)));
#pragma unroll
          for (int kp = 0; kp < 4; ++kp) { const int c0 = h * 64 + 8 * cgl + 2 * kp;
              const f32x2 cw0 = *(const f32x2*)(cw + c0), cw1 = *(const f32x2*)(cw + 3072 + c0), cw2 = *(const f32x2*)(cw + 2 * 3072 + c0), cw3 = *(const f32x2*)(cw + 3 * 3072 + c0), cbb = *(const f32x2*)(cbp + c0);
              f32x2 xv[4];
#pragma unroll
              for (int i = 0; i < 4; ++i) { const unsigned wd = xr[i][kp]; xv[i] = (f32x2){__uint_as_float(wd << 16), __uint_as_float(wd & 0xffff0000u)}; }
              f32x2 a = cw0 * xv[0] + cbb; a = cw1 * xv[1] + a; a = cw2 * xv[2] + a; a = cw3 * xv[3] + a;
              const f32x2 t = a * (-1.4426950408889634f); f32x2 e; e.x = __builtin_amdgcn_exp2f(t.x); e.y = __builtin_amdgcn_exp2f(t.y); e = e + 1.0f;
              f32x2 rc; rc.x = __builtin_amdgcn_rcpf(e.x); rc.y = __builtin_amdgcn_rcpf(e.y); const f32x2 o = a * rc, ow = o * wx;
              const unsigned po = pk2(o.x, o.y), pw = pk2(ow.x, ow.y); const int p = 8 * cgl + 2 * kp;
              XT[p * 72 + xs] = (unsigned short)(po & 0xffffu); XT[(p + 1) * 72 + xs] = (unsigned short)(po >> 16);
              XWT[p * 72 + xs] = (unsigned short)(pw & 0xffffu); XWT[(p + 1) * 72 + xs] = (unsigned short)(pw >> 16); }
        }
        if (t0 + 64 < L) {
#pragma unroll
            for (int i = 0; i < 4; ++i) xr[i] = *(const v4u*)(cptr + (size_t)(t0 + 64 + (tid >> 3) - 3 + i) * 1024);
            const int chn = (t0 >> 6) + 1;
#pragma unroll
            for (int j = 0; j < 6; ++j) { const int idx = (tid + 512 * j) & 1023;
                if (j < 4) pc[j] = *(const v4u*)(BCS + (size_t)(t0 + 64 + (idx >> 4)) * 1024 + (j >> 1) * 512 + 8 * (idx & 15));
                else pc[j] = *(const v4u*)(BTT + ((size_t)chn * 4 * 128 + (idx >> 3)) * 64 + 8 * (idx & 7)); }
        }
        __syncthreads();
        if (w < 4) {
            const int tt = nt;
            f32x16 yi, ya;
#pragma unroll
            for (int i = 0; i < 16; ++i) { yi[i] = 0.f; ya[i] = 0.f; }
            const LAS unsigned char* cn_nat = Lb + SD_CN + (32 * tt + r) * 272 + hh * 16; const LAS unsigned char* ht_nat = Lb + SD_HT + buf * 17408 + (32 * pt + r) * 272 + hh * 16;
#pragma unroll 2
            for (int ks = 0; ks < 8; ++ks) yi = MFMA32(lds_frag16(cn_nat + ks * 32), lds_frag16(ht_nat + ks * 32), yi);
            const float cum_t = CUM[32 * tt + r];
#pragma unroll 1
            for (int st = 0; st <= tt; ++st) {
                f32x16 X;
#pragma unroll
                for (int i = 0; i < 16; ++i) X[i] = 0.f;
                const LAS unsigned char* bn_nat = Lb + SD_BN + (32 * st + r) * 272 + hh * 16;
#pragma unroll 2
                for (int ks = 0; ks < 8; ++ks) X = MFMA32(lds_frag16(bn_nat + ks * 32), lds_frag16(cn_nat + ks * 32), X);
#pragma unroll
                for (int q4 = 0; q4 < 4; ++q4) { const f32x4 cs = *(const LAS f32x4*)(CUM + 32 * st + 8 * q4 + 4 * hh), ds = *(const LAS f32x4*)(DTV + 32 * st + 8 * q4 + 4 * hh);
#pragma unroll
                    for (int jj = 0; jj < 4; ++jj) { const int s_abs = 32 * st + 8 * q4 + 4 * hh + jj; const float f = __expf(fminf(cum_t - cs[jj], 0.f)) * ds[jj]; X[4 * q4 + jj] = (s_abs <= 32 * tt + r) ? X[4 * q4 + jj] * f : 0.f; } }
                const LAS unsigned char* xt_row = Lb + SD_XT + (32 * pt + r) * 144 + (32 * st + 4 * hh) * 2;
                ya = MFMA32(ACC_FRAG(X, 0), lds_frag8x2(xt_row), ya);
                ya = MFMA32(ACC_FRAG(X, 1), lds_frag8x2(xt_row + 32), ya);
            }
            const LAS unsigned short* xt_p = XT + (32 * pt + r) * 72 + 32 * tt + 4 * hh;
#pragma unroll
            for (int q4 = 0; q4 < 4; ++q4) { const f32x4 ec = *(const LAS f32x4*)(ECUM + 32 * tt + 8 * q4 + 4 * hh); const v2u xw = *(const LAS v2u*)(xt_p + 8 * q4);
                const float x0 = bf2f(xw.x & 0xffffu), x1 = bf2f(xw.x >> 16), x2 = bf2f(xw.y & 0xffffu), x3 = bf2f(xw.y >> 16);
                LAS float* yb = YB + (32 * tt + 8 * q4 + 4 * hh) * 68 + 32 * pt + r;
                yb[0] = ya[4 * q4] + ec[0] * yi[4 * q4] + Dk * x0; yb[68] = ya[4 * q4 + 1] + ec[1] * yi[4 * q4 + 1] + Dk * x1;
                yb[136] = ya[4 * q4 + 2] + ec[2] * yi[4 * q4 + 2] + Dk * x2; yb[204] = ya[4 * q4 + 3] + ec[3] * yi[4 * q4 + 3] + Dk * x3; }
        }
        {
            const float el = __expf(CUM[63]);
#pragma unroll
            for (int i = 0; i < 16; ++i) H[i] *= el;
            const LAS unsigned char* bt_nat = Lb + SD_BT + (32 * nt + r) * 144 + hh * 16; const LAS unsigned char* xt_nat = Lb + SD_XWT + (32 * pt + r) * 144 + hh * 16;
#pragma unroll
            for (int s2 = 0; s2 < 4; ++s2) H = MFMA32(lds_frag16(bt_nat + s2 * 32), lds_frag16(xt_nat + s2 * 32), H);
            LAS unsigned short* hp = HT + (buf ^ 1) * 8704 + (32 * pt + r) * 136 + 32 * nt + 4 * hh;
#pragma unroll
            for (int q4 = 0; q4 < 4; ++q4) { v2u pk; pk.x = cvtpk_c(H[4 * q4], H[4 * q4 + 1]); pk.y = cvtpk_c(H[4 * q4 + 2], H[4 * q4 + 3]); *(LAS v2u*)(hp + 8 * q4) = pk; }
        }
        __syncthreads();
        { const int tt = tid >> 3, p0 = (tid & 7) * 8;
          if (t0 + tt < L) { const size_t row = row_base + t0 + tt;
            const f32x4 y0 = *(const LAS f32x4*)(YB + tt * 68 + p0), y1 = *(const LAS f32x4*)(YB + tt * 68 + p0 + 4);
            float o[8]; float sq = 0.f;
#pragma unroll
            for (int j = 0; j < 8; ++j) { const unsigned z16 = (zw[j >> 1] >> ((j & 1) * 16)) & 0xffffu; const float yv = (j < 4 ? y0[j & 3] : y1[j & 3]) * silu_f(bf2f(z16)); o[j] = yv; sq += yv * yv; }
            v4u ow; ow.x = pk2(o[0], o[1]); ow.y = pk2(o[2], o[3]); ow.z = pk2(o[4], o[5]); ow.w = pk2(o[6], o[7]);
            *(v4u*)(YG + row * 2048 + h * 64 + p0) = ow;
            sq += __shfl_xor(sq, 1); sq += __shfl_xor(sq, 2); sq += __shfl_xor(sq, 4);
            if ((tid & 7) == 0) SSQ[row * 32 + h] = sq; } }
        }
    }
#pragma unroll
    for (int q4 = 0; q4 < 4; ++q4) *(f32x4*)(st_g + 8 * q4) = (f32x4){H[4 * q4], H[4 * q4 + 1], H[4 * q4 + 2], H[4 * q4 + 3]};
    __syncthreads();
}
__device__ __forceinline__ float tr_reduce32(const float (&v)[32], int lane) {
    const bool b4 = lane & 16, b3 = lane & 8, b2 = lane & 4, b1 = lane & 2, b0 = lane & 1;
    float a[16], b[8], c[4], d[2];
#pragma unroll
    for (int i = 0; i < 16; ++i) { const float keep = b4 ? v[i + 16] : v[i], send = b4 ? v[i] : v[i + 16]; a[i] = keep + __shfl_xor(send, 16); }
#pragma unroll
    for (int i = 0; i < 8; ++i) { const float keep = b3 ? a[i + 8] : a[i], send = b3 ? a[i] : a[i + 8]; b[i] = keep + __shfl_xor(send, 8); }
#pragma unroll
    for (int i = 0; i < 4; ++i) { const float keep = b2 ? b[i + 4] : b[i], send = b2 ? b[i] : b[i + 4]; c[i] = keep + __shfl_xor(send, 4); }
#pragma unroll
    for (int i = 0; i < 2; ++i) { const float keep = b1 ? c[i + 2] : c[i], send = b1 ? c[i] : c[i + 2]; d[i] = keep + __shfl_xor(send, 2); }
    const float keep = b0 ? d[1] : d[0], send = b0 ? d[0] : d[1];
    return keep + __shfl_xor(send, 1);
}
__device__ __forceinline__ void ssd_sample_unit(Frame& F, int sb, int g) {
    int tid_o = F.tid; asm volatile("" : "+v"(tid_o));
    const int tid = tid_o, lane = tid & 63, w = F.wave, hh = lane >> 5, nq = lane & 31; unsigned char* ws = F.ws;
    LAS float* XC = (LAS float*)(F.lds + RING_OFF); LAS float* BC = XC + 8 * 4 * 64; LAS float* CC = BC + 4 * 128; LAS float* DTS = CC + 4 * 128;
    const bf16* PROJ = (const bf16*)(ws + WS_PROJ); const float* DTR = (const float*)(ws + WS_DT); bf16* YG = (bf16*)(ws + WS_YG); float* SSQ = (float*)(ws + WS_SSQSSD);
    const size_t row0 = (size_t)TP + (size_t)sb * LS;
    const int h = 8 * g + w;
    const float* sp = F.in[3] + (size_t)(sb * 32 + h) * 8192 + (size_t)hh * 128 + 4 * nq;
    f32x4 hst[32];
#pragma unroll
    for (int i = 0; i < 32; ++i) hst[i] = *(const f32x4*)(sp + (size_t)i * 256);
    if (tid < 384) { typedef float f32x2 __attribute__((ext_vector_type(2)));
        const int col = tid < 256 ? g * 512 + 2 * tid : (tid < 320 ? 2048 + g * 128 + 2 * (tid - 256) : 2560 + g * 128 + 2 * (tid - 320));
        const float* cw = F.in[10]; const float* sc = F.in[4] + (size_t)sb * 3 * 3072 + col;
        const f32x2 w0 = *(const f32x2*)(cw + col), w1 = *(const f32x2*)(cw + 3072 + col), w2 = *(const f32x2*)(cw + 2 * 3072 + col), w3 = *(const f32x2*)(cw + 3 * 3072 + col), cb = *(const f32x2*)(F.in[11] + col);
        f32x2 full[7]; full[0] = *(const f32x2*)sc; full[1] = *(const f32x2*)(sc + 3072); full[2] = *(const f32x2*)(sc + 2 * 3072);
        const bf16* cp = PROJ + (size_t)(S_X0 + (col >> 10)) * SLOT_ELEMS + row0 * 1024 + (col & 1023);
#pragma unroll
        for (int t = 0; t < 4; ++t) { const unsigned wd = *(const unsigned*)(cp + (size_t)t * 1024); full[3 + t] = (f32x2){__uint_as_float(wd << 16), __uint_as_float(wd & 0xffff0000u)}; }
#pragma unroll
        for (int t = 0; t < 4; ++t) { f32x2 a = w0 * full[t] + cb; a = w1 * full[t + 1] + a; a = w2 * full[t + 2] + a; a = w3 * full[t + 3] + a;
            f32x2 o; o.x = silu_f(a.x); o.y = silu_f(a.y);
            LAS float* dst = tid < 256 ? XC + ((tid >> 5) * 4 + t) * 64 + 2 * (tid & 31) : (tid < 320 ? BC + t * 128 + 2 * (tid - 256) : CC + t * 128 + 2 * (tid - 320));
            *(LAS f32x2*)dst = o; }
    } else if (tid < 416) { const int idx = tid - 384, hl = idx >> 2, t = idx & 3; const float x = DTR[(row0 + t) * 32 + 8 * g + hl] + F.in[12][8 * g + hl]; DTS[idx] = x > 20.f ? x : log1pf(__expf(x)); }
    __syncthreads();
    const float a = -__expf(F.in[13][h]), Dk = F.in[14][h];
#pragma unroll 1
    for (int t = 0; t < 4; ++t) {
        const float dtv = DTS[w * 4 + t], dA = __expf(dtv * a);
        const f32x4 Bv = *(const LAS f32x4*)(BC + t * 128 + 4 * nq), Cv = *(const LAS f32x4*)(CC + t * 128 + 4 * nq);
        const LAS float* xrow = XC + (w * 4 + t) * 64;
        float part[32];
#pragma unroll
        for (int i = 0; i < 32; ++i) { const float xd = xrow[2 * i + hh] * dtv; hst[i] = hst[i] * dA + Bv * xd; part[i] = (hst[i].x * Cv.x + hst[i].y * Cv.y) + (hst[i].z * Cv.z + hst[i].w * Cv.w); }
        float yv = tr_reduce32(part, lane);
        const int p = 2 * nq + hh; const size_t row = row0 + t;
        yv += Dk * xrow[p];
        const float z = bf2f(PROJ[(size_t)(S_Z0 + (h >> 4)) * SLOT_ELEMS + row * 1024 + (h & 15) * 64 + p]);
        const float yg = yv * silu_f(z);
        YG[row * 2048 + h * 64 + p] = (bf16)f2bf(yg);
        const float sq = wave_sum(yg * yg);
        if (lane == 0) SSQ[row * 32 + h] = sq;
    }
    float* so = F.out + O_SSMS + (size_t)(sb * 32 + h) * 8192 + (size_t)hh * 128 + 4 * nq;
#pragma unroll
    for (int i = 0; i < 32; ++i) *(f32x4*)(so + (size_t)i * 256) = hst[i];
    __syncthreads();
}
__device__ __forceinline__ void hgrn_sample_unit(Frame& F, int sb, int hq) {
    int tid_o = F.tid; asm volatile("" : "+v"(tid_o));
    const int tid = tid_o, lane = tid & 63, w = F.wave, hh = lane >> 5, vq = lane & 31; unsigned char* ws = F.ws;
    LAS float* FS = (LAS float*)(F.lds + RING_OFF); LAS float* KS = FS + 2048; LAS float* QS = KS + 2048; LAS float* VS = QS + 2048; LAS float* OP = VS + 2048;
    const bf16* PROJ = (const bf16*)(ws + WS_PROJ); bf16* ON = (bf16*)(ws + WS_ON);
    const size_t row0 = (size_t)TP + (size_t)sb * LS;
    const int hl = w >> 1, kh = w & 1, hd = 4 * hq + hl;
    const float* sp = F.in[5] + (size_t)(sb * 8 + hd) * 16384 + (size_t)(64 * kh + hh) * 128 + 4 * vq;
    f32x4 S[32];
#pragma unroll
    for (int i = 0; i < 32; ++i) S[i] = *(const f32x4*)(sp + (size_t)i * 256);
    { const int ch = hq * 512 + tid; const float lb = __builtin_amdgcn_rcpf(1.0f + __expf(F.in[17][1024 + ch] - F.in[17][ch]));
      const bf16* fp = PROJ + (size_t)S_F * SLOT_ELEMS + row0 * 1024 + ch; const bf16* qp = PROJ + (size_t)S_Q * SLOT_ELEMS + row0 * 1024 + ch; const bf16* ip = PROJ + (size_t)S_I * SLOT_ELEMS + row0 * 1024 + ch;
#pragma unroll
      for (int t = 0; t < 4; ++t) { const float u = fminf(fmaxf(bf2f(fp[(size_t)t * 1024]), -30.f), 30.f); const float fg = lb + (1.0f - lb) * sigmoid_f(u);
          const int o = ((tid >> 7) * 4 + t) * 128 + (tid & 127);
          FS[o] = fg; KS[o] = 1.0f - fg; QS[o] = silu_f(bf2f(qp[(size_t)t * 1024])); VS[o] = bf2f(ip[(size_t)t * 1024]); } }
    __syncthreads();
#pragma unroll 1
    for (int t = 0; t < 4; ++t) {
        const int o = (hl * 4 + t) * 128;
        const f32x4 vv = *(const LAS f32x4*)(VS + o + 4 * vq);
        f32x4 oa = (f32x4){0.f, 0.f, 0.f, 0.f};
#pragma unroll
        for (int i = 0; i < 32; ++i) { const int k = 64 * kh + 2 * i + hh; const float fk = FS[o + k], kv = KS[o + k], qk = QS[o + k]; S[i] = S[i] * fk + vv * kv; oa = oa + S[i] * qk; }
        oa.x += __shfl_xor(oa.x, 32); oa.y += __shfl_xor(oa.y, 32); oa.z += __shfl_xor(oa.z, 32); oa.w += __shfl_xor(oa.w, 32);
        if (hh == 0) *(LAS f32x4*)(OP + ((hl * 4 + t) * 2 + kh) * 128 + 4 * vq) = oa;
    }
    float* so = F.out + O_HGS + (size_t)(sb * 8 + hd) * 16384 + (size_t)(64 * kh + hh) * 128 + 4 * vq;
#pragma unroll
    for (int i = 0; i < 32; ++i) *(f32x4*)(so + (size_t)i * 256) = S[i];
    __syncthreads();
#pragma unroll
    for (int rr2 = 0; rr2 < 2; ++rr2) { const int rr = 2 * w + rr2, ohl = rr >> 2, t = rr & 3, ohd = 4 * hq + ohl; typedef float f32x2 __attribute__((ext_vector_type(2)));
        const f32x2 p0 = *(const LAS f32x2*)(OP + (rr * 2) * 128 + 2 * lane), p1 = *(const LAS f32x2*)(OP + (rr * 2 + 1) * 128 + 2 * lane);
        const float o0 = p0.x + p1.x, o1 = p0.y + p1.y; const float sq = wave_sum(o0 * o0 + o1 * o1); const float rs = __builtin_amdgcn_rsqf(sq * (1.0f / 128.0f) + EPS);
        const size_t row = row0 + t; const unsigned gw = *(const unsigned*)(PROJ + (size_t)S_HG * SLOT_ELEMS + row * 1024 + ohd * 128 + 2 * lane);
        *(unsigned*)(ON + row * 1024 + ohd * 128 + 2 * lane) = pk2(o0 * rs * silu_f(bf2f(gw & 0xffffu)), o1 * rs * silu_f(__uint_as_float(gw & 0xffff0000u))); }
    __syncthreads();
}
constexpr int U_HGP = NBP * 8 * 4, U_SSDP = NBP * 32, U_HGS = NBS * 2, U_SSDS = NBS * 4, U_CONV = NBP + NBS;
__device__ __forceinline__ void scan_phase(Frame& F) {
    gu32* head = F.ctl + CW_QUEUE;
#define SCAN_QUEUE(qi, count, body) for (;;) { if (F.tid == 0) F.MISC[0] = __hip_atomic_fetch_add(head + 64 * (qi), 1u, RLX_AGENT); __syncthreads(); const int u = (int)F.MISC[0]; __syncthreads(); if (u >= (count)) break; body }
    SCAN_QUEUE(1, U_SSDP, ssd_unit_mfma(F, u >> 5, u & 31);)
    SCAN_QUEUE(0, U_HGP, hgrn_v_unit(F, u >> 5, (u >> 2) & 7, u & 3);)
    SCAN_QUEUE(2, U_HGS, hgrn_sample_unit(F, u >> 1, u & 1);)
    SCAN_QUEUE(3, U_SSDS + U_CONV, if (u >= U_SSDS) { conv_copy_unit(F, u - U_SSDS); continue; } ssd_sample_unit(F, u >> 2, u & 3);)
#undef SCAN_QUEUE
}
typedef float f32x4s __attribute__((ext_vector_type(4)));
template <class Epi> __device__ __forceinline__ void small_tile_phase(Frame& F, const bf16* A, const bf16* Bt, int K, const Epi& E) {
    if (F.G != 256) return;
    const int lane = F.lane, w = F.wave, fr = lane & 15, fq = lane >> 4;
    const int mt = F.vcu >> 4, nt = F.vcu & 15;
    const int row = TP + 32 * mt + 16 * (w & 1) + fr, colb = 64 * nt + 16 * (w >> 1);
    const bf16* ap = A + (size_t)row * K + 8 * fq;
    const bf16* bp = Bt + (size_t)(colb + fr) * K + 8 * fq;
    f32x4s acc = (f32x4s){0.f, 0.f, 0.f, 0.f};
#pragma unroll 8
    for (int ks = 0; ks < K / 32; ++ks) { const bf16x8 bf = *(const bf16x8*)(bp + 32 * ks), af = *(const bf16x8*)(ap + 32 * ks); acc = __builtin_amdgcn_mfma_f32_16x16x32_bf16(bf, af, acc, 0, 0, 0); }
    E.small(F, acc, row, colb + 4 * fq, nt);
}
template <bool ADD> struct SmGate { bf16* O; const bf16* gate;
    __device__ __forceinline__ void small(Frame&, const f32x4s& a, int row, int col, int) const { const size_t off = (size_t)row * 1024 + col;
        const v2u gw = *(const v2u*)(gate + off); v2u ow = (v2u){0u, 0u}; if (ADD) ow = *(const v2u*)(O + off);
        float rr[4];
#pragma unroll
        for (int e = 0; e < 4; ++e) { const unsigned g16 = (gw[e >> 1] >> ((e & 1) * 16)) & 0xffffu, o16 = (ow[e >> 1] >> ((e & 1) * 16)) & 0xffffu; rr[e] = (ADD ? bf2f(o16) : 0.f) + sigmoid_f(bf2f(g16)) * a[e]; }
        v2u wv; wv.x = cvtpk_c(rr[0], rr[1]); wv.y = cvtpk_c(rr[2], rr[3]); *(v2u*)(O + off) = wv; } };
template <bool BF> struct SmRes { const float* base; bf16* hb; float* ssqp;
    __device__ __forceinline__ void small(Frame& F, const f32x4s& a, int row, int col, int nt) const { const size_t off = (size_t)row * 1024 + col; f32x4 b;
        if (BF) { const v2u w = *(const v2u*)(hb + off); b = (f32x4){bf2f(w.x & 0xffffu), __uint_as_float(w.x & 0xffff0000u), bf2f(w.y & 0xffffu), __uint_as_float(w.y & 0xffff0000u)}; }
        else b = *(const f32x4*)(base + off);
        const f32x4 v = b + (f32x4){a[0], a[1], a[2], a[3]};
        { v2u wv; wv.x = cvtpk_c(v[0], v[1]); wv.y = cvtpk_c(v[2], v[3]); *(v2u*)(hb + off) = wv; }
        float sq = (v[0] * v[0] + v[1] * v[1]) + (v[2] * v[2] + v[3] * v[3]); sq += __shfl_xor(sq, 16); sq += __shfl_xor(sq, 32);
        LAS float* red = (LAS float*)(F.lds + RING_OFF);
        const int rl = 16 * (F.wave & 1) + (F.lane & 15);
        if ((F.lane >> 4) == 0) red[rl * 4 + (F.wave >> 1)] = sq;
        __syncthreads();
        if (F.tid < 32) { const f32x4 p = *(const LAS f32x4*)(red + F.tid * 4); ssqp[(size_t)(row - rl + F.tid) * 16 + nt] = (p[0] + p[1]) + (p[2] + p[3]); }
        __syncthreads(); } };
struct SmScale { bf16* O; const float* ssq; float scale;
    __device__ __forceinline__ void small(Frame&, const f32x4s& a, int row, int col, int) const { const float rs = pg8::row_rs<16>(ssq, row) * scale;
        v2u wv; wv.x = cvtpk_c(a[0] * rs, a[1] * rs); wv.y = cvtpk_c(a[2] * rs, a[3] * rs); *(v2u*)(O + (size_t)row * 1024 + col) = wv; } };
__device__ __forceinline__ void attn_stage_tile(LAS unsigned char* Lb, const bf16* src, size_t pitch, int tid) {
#pragma unroll 1
    for (int hb = 0; hb < 2; ++hb) { v4u v[8];
#pragma unroll
        for (int i = 0; i < 8; ++i) { const int id = tid + 512 * (8 * hb + i), row = id >> 5, c = id & 31; v[i] = *(const v4u*)(src + (size_t)row * pitch + c * 8); }
#pragma unroll
        for (int i = 0; i < 8; ++i) { const int id = tid + 512 * (8 * hb + i), row = id >> 5, c = id & 31; *(LAS v4u*)(Lb + row * 512 + ((c ^ (row & 15)) << 4)) = v[i]; } }
}
__device__ __forceinline__ void attn_prompt_unit(Frame& F, int b, int hd, int qb) {
    const int tid = F.tid, lane = F.lane, w = F.wave, r = lane & 31, hh = lane >> 5; unsigned char* ws = F.ws;
    LAS unsigned char* Lb = F.lds + RING_OFF;
    const bf16* QB = (const bf16*)(ws + WS_QB); const bf16* KB = (const bf16*)(ws + WS_KB); const bf16* VT = (const bf16*)(ws + WS_VT); bf16* OB = (bf16*)(ws + WS_OB);
    const size_t qrow = (size_t)b * SEQ + (size_t)qb * 256 + 32 * w + r;
    attn_stage_tile(Lb, KB + (size_t)b * 256 * 1024 + hd * 256, 1024, tid);
    const bf16* qp = QB + qrow * 1024 + hd * 256 + 8 * hh;
    bf16x8 qf = *(const bf16x8*)qp;
    __syncthreads();
    f32x16 S[8];
#pragma unroll
    for (int t = 0; t < 8; ++t)
#pragma unroll
        for (int i = 0; i < 16; ++i) S[t][i] = 0.f;
    const int sw = r & 15;
#pragma unroll 1
    for (int ks = 0; ks < 16; ++ks) {
        const bf16x8 qn = *(const bf16x8*)(qp + 16 * (ks < 15 ? ks + 1 : ks));
        const LAS unsigned char* kp = Lb + r * 512 + (((2 * ks + hh) ^ sw) << 4);
#pragma unroll
        for (int t = 0; t < 8; ++t) S[t] = MFMA32(lds_frag16(kp + t * 32 * 512), qf, S[t]);
        qf = qn;
    }
    float m = -3.0e38f;
#pragma unroll
    for (int t = 0; t < 8; ++t)
#pragma unroll
        for (int i = 0; i < 16; ++i) m = fmaxf(m, S[t][i]);
    m = fmaxf(m, __shfl_xor(m, 32));
    float l = 0.f;
#pragma unroll
    for (int t = 0; t < 8; ++t)
#pragma unroll
        for (int i = 0; i < 16; ++i) { const float pv = __builtin_amdgcn_exp2f(S[t][i] - m); S[t][i] = pv; l += pv; }
    l += __shfl_xor(l, 32);
    const float rl = __builtin_amdgcn_rcpf(l);
    bf16x8 pf[8][2];
#pragma unroll
    for (int t = 0; t < 8; ++t) { pf[t][0] = ACC_FRAG(S[t], 0); pf[t][1] = ACC_FRAG(S[t], 1); }
    __syncthreads();
    attn_stage_tile(Lb, VT + (size_t)(b * 4 + hd) * 256 * 256, 256, tid);
    __syncthreads();
    bf16* op = OB + qrow * 1024 + hd * 256 + 4 * hh;
#pragma unroll 1
    for (int dt = 0; dt < 8; ++dt) {
        f32x16 O;
#pragma unroll
        for (int i = 0; i < 16; ++i) O[i] = 0.f;
        const LAS unsigned char* vrow = Lb + (32 * dt + r) * 512 + 8 * hh;
#pragma unroll
        for (int t = 0; t < 8; ++t)
#pragma unroll
            for (int s2 = 0; s2 < 2; ++s2) {
                const v2u lo = *(const LAS v2u*)(vrow + (((4 * t + 2 * s2) ^ sw) << 4)), hi = *(const LAS v2u*)(vrow + (((4 * t + 2 * s2 + 1) ^ sw) << 4));
                const v4u wv4 = (v4u){lo.x, lo.y, hi.x, hi.y};
                O = MFMA32(__builtin_bit_cast(bf16x8, wv4), pf[t][s2], O);
            }
#pragma unroll
        for (int q4 = 0; q4 < 4; ++q4) { v2u o; o.x = cvtpk_c(O[4 * q4] * rl, O[4 * q4 + 1] * rl); o.y = cvtpk_c(O[4 * q4 + 2] * rl, O[4 * q4 + 3] * rl);
            *(v2u*)(op + 32 * dt + 8 * q4) = o; }
    }
    __syncthreads();
}
__device__ __forceinline__ void attn_sample_unit(Frame& F, int sb, int hd) {
    const int tid = F.tid, lane = F.lane, w = F.wave; unsigned char* ws = F.ws;
    LAS float* sc = (LAS float*)(F.lds + RING_OFF);
    LAS float* red = sc + 4 * 256;
    const bf16* QB = (const bf16*)(ws + WS_QB); bf16* OB = (bf16*)(ws + WS_OB);
    const size_t rowq = (size_t)TP + (size_t)sb * LS;
    float q[4][4];
#pragma unroll
    for (int t = 0; t < 4; ++t) { const v2u qw = *(const v2u*)(QB + (rowq + t) * 1024 + hd * 256 + 4 * lane); q[t][0] = bf2f(qw.x & 0xffffu); q[t][1] = bf2f(qw.x >> 16); q[t][2] = bf2f(qw.y & 0xffffu); q[t][3] = bf2f(qw.y >> 16); }
    const float* Kc = F.in[6] + ((size_t)sb * 256 * 4 + hd) * 256 + 4 * lane; const float* Vc = F.in[7] + ((size_t)sb * 256 * 4 + hd) * 256 + 4 * lane;
#pragma unroll 1
    for (int kk0 = 0; kk0 < 32; kk0 += 8) { f32x4 kv[8];
#pragma unroll
        for (int u = 0; u < 8; ++u) kv[u] = *(const f32x4*)(Kc + (size_t)(w * 32 + kk0 + u) * 1024);
#pragma unroll
        for (int u = 0; u < 8; ++u) { const int key = w * 32 + kk0 + u;
#pragma unroll
            for (int t = 0; t < 4; ++t) { float s = (q[t][0] * kv[u].x + q[t][1] * kv[u].y) + (q[t][2] * kv[u].z + q[t][3] * kv[u].w); s = wave_sum(s); if (lane == 0) sc[t * 256 + key] = s; } } }
    __syncthreads();
    if (w < 4) { float v[4]; float m = -3.0e38f;
#pragma unroll
        for (int j = 0; j < 4; ++j) { v[j] = sc[w * 256 + j * 64 + lane]; m = fmaxf(m, v[j]); }
        m = wave_max(m); float l = 0.f;
#pragma unroll
        for (int j = 0; j < 4; ++j) { v[j] = __builtin_amdgcn_exp2f(v[j] - m); l += v[j]; }
        l = wave_sum(l); const float rl = 1.0f / l;
#pragma unroll
        for (int j = 0; j < 4; ++j) sc[w * 256 + j * 64 + lane] = v[j] * rl; }
    __syncthreads();
    float o[4][4];
#pragma unroll
    for (int t = 0; t < 4; ++t)
#pragma unroll
        for (int e = 0; e < 4; ++e) o[t][e] = 0.f;
#pragma unroll 1
    for (int kk0 = 0; kk0 < 32; kk0 += 8) { f32x4 vv[8];
#pragma unroll
        for (int u = 0; u < 8; ++u) vv[u] = *(const f32x4*)(Vc + (size_t)(w * 32 + kk0 + u) * 1024);
#pragma unroll
        for (int u = 0; u < 8; ++u) { const int key = w * 32 + kk0 + u;
#pragma unroll
            for (int t = 0; t < 4; ++t) { const float pr = sc[t * 256 + key]; o[t][0] += pr * vv[u].x; o[t][1] += pr * vv[u].y; o[t][2] += pr * vv[u].z; o[t][3] += pr * vv[u].w; } } }
#pragma unroll
    for (int t = 0; t < 4; ++t) *(LAS f32x4*)(red + (w * 4 + t) * 256 + 4 * lane) = (f32x4){o[t][0], o[t][1], o[t][2], o[t][3]};
    __syncthreads();
    { const int t = tid >> 7, d0 = (tid & 127) * 2; float a0 = 0.f, a1 = 0.f;
#pragma unroll
      for (int ww = 0; ww < 8; ++ww) { a0 += red[(ww * 4 + t) * 256 + d0]; a1 += red[(ww * 4 + t) * 256 + d0 + 1]; }
      *(unsigned*)(OB + (rowq + t) * 1024 + hd * 256 + d0) = pk2(a0, a1); }
    __syncthreads();
}
__device__ __forceinline__ void attn_phase(Frame& F) {
    for (int u = F.vcu; u < NBP * 4 * 8; u += F.G) attn_prompt_unit(F, u >> 5, (u >> 3) & 3, u & 7);
    for (int u = F.vcu; u < NBS * 4; u += F.G) attn_sample_unit(F, u >> 2, u & 3);
}
__device__ __forceinline__ void final_norm_phase(Frame& F) {
    const int gw = F.vcu * NWAVES + F.wave, NGW = F.G * NWAVES; const float* SSQ = (const float*)(F.ws + WS_SSQP3); const float* wn = F.in[31]; const bf16* HB = (const bf16*)(F.ws + WS_HB);
    f32x4 wv[4];
#pragma unroll
    for (int j = 0; j < 2; ++j) { wv[2 * j] = *((const f32x4*)wn + 2 * (64 * j + F.lane)); wv[2 * j + 1] = *((const f32x4*)wn + 2 * (64 * j + F.lane) + 1); }
    for (int row = gw; row < T; row += NGW) {
        const f32x4* sp = (const f32x4*)(SSQ + (size_t)row * 16); float s = 0.f;
#pragma unroll
        for (int j = 0; j < 4; ++j) { const f32x4 a = sp[j]; s += (a.x + a.y) + (a.z + a.w); }
        const float rs = __builtin_amdgcn_rsqf(s * (1.0f / 1024.0f) + EPS);
#pragma unroll
        for (int j = 0; j < 2; ++j) { const int pc = 64 * j + F.lane; const v4u w = *((const v4u*)(HB + (size_t)row * 1024) + pc);
            const f32x4 v0 = (f32x4){bf2f(w.x & 0xffffu), __uint_as_float(w.x & 0xffff0000u), bf2f(w.y & 0xffffu), __uint_as_float(w.y & 0xffff0000u)};
            const f32x4 v1 = (f32x4){bf2f(w.z & 0xffffu), __uint_as_float(w.z & 0xffff0000u), bf2f(w.w & 0xffffu), __uint_as_float(w.w & 0xffff0000u)};
            f32x4* o = (f32x4*)(F.out + O_Y + (size_t)row * 1024) + 2 * pc; o[0] = v0 * rs * wv[2 * j]; o[1] = v1 * rs * wv[2 * j + 1]; }
    }
}
#ifndef MK_N_LAUNCHES
#define MK_N_LAUNCHES 1
#endif
constexpr int PER_PHASE = 13;
constexpr int N_LAUNCHES = MK_N_LAUNCHES;
struct Args { const float* in[32]; float* out; unsigned char* ws; int ph_lo, ph_hi; };
__global__ void __launch_bounds__(NTHR, 2) skel_fwd(Args args) {
    extern __shared__ __attribute__((aligned(16))) unsigned char lds[];
    Frame F;
    F.lds = (LAS unsigned char*)lds;
    F.MISC = (volatile LAS unsigned*)(F.lds + MISC_OFF);
    F.tid = threadIdx.x; F.lane = F.tid & 63; F.wave = __builtin_amdgcn_readfirstlane(F.tid >> 6);
    F.G = gridDim.x; { const int bx = blockIdx.x; F.vcu = (F.G % 8 == 0) ? (bx % 8) * (F.G / 8) + bx / 8 : bx; }
    unsigned char* ws = args.ws; F.ws = ws; F.out = args.out;
    F.ctl = (gu32*)(ws + WS_CTL);
#pragma unroll
    for (int i = 0; i < 32; ++i) F.in[i] = args.in[i];
    for (int u = F.tid; u < (LDS_BYTES - LDSCTL_OFF) / 4; u += NTHR) ((LAS unsigned*)(F.lds + LDSCTL_OFF))[u] = 0u;
    __syncthreads();
    XcdBarrier bar; bar.bar = (unsigned*)(F.ctl + CW_BAR); bar.x = 0; bar.st = nullptr;
    if (N_LAUNCHES == 1) bar = xcd_barrier_post((unsigned*)(F.ctl + CW_BAR), F.MISC + 8);
#define GRID_BAR() do { if (N_LAUNCHES == 1) xcd_barrier(bar); } while (0)
    const int lo = args.ph_lo, hi = args.ph_hi;
#ifdef ONLY_PHASE
#define IN(k) ((k) == ONLY_PHASE && lo <= (k) && (k) < hi)
#else
#define IN(k) (lo <= (k) && (k) < hi)
#endif
#define BOTH(k) (IN(k) && IN((k) + 1))
    bf16* const XB = (bf16*)(ws + WS_XB); bf16* const PROJ = (bf16*)(ws + WS_PROJ);
    float* const Y = F.out + O_Y;
    if (IN(0)) { p0_prologue(F); if (BOTH(0)) GRID_BAR(); }
    if (IN(1)) {
        { pg8::Gemm g{XB, (const bf16*)(ws + WS_WIN), T, NPROJ, 1024}; pg8::StaticOrder S; S.init(T, NPROJ, F.G, (int)blockIdx.x);
          pg8::EpiScaleBf16<1, true> E{PROJ, SLOT_ELEMS, (const float*)(ws + WS_SSQX), 1.0f, (float*)(ws + WS_DT)};
          pg8::gemm_phase<pg8::EpiScaleBf16<1, true>, pg8::StaticOrder, true, true>(F.lds + RING_OFF, g, S, E); }
        { pg8::Gemm g{(const bf16*)(ws + WS_MNB), (const bf16*)(ws + WS_WKV), MEMR, 2048, 1024}; pg8::StaticOrder S; S.init(MEMR, 2048, F.G, (int)((blockIdx.x + 64) % F.G));
          pg8::EpiKV E{F.out + O_MKP, F.out + O_MVP, (bf16*)(ws + WS_KB), (bf16*)(ws + WS_VT), (const float*)(ws + WS_SSQM)};
          pg8::gemm_phase<pg8::EpiKV, pg8::StaticOrder, true, true>(F.lds + RING_OFF, g, S, E); }
        if (BOTH(1)) GRID_BAR();
    }
    if (IN(2)) { bc_prep_phase(F); hg_prep_phase(F); GRID_BAR(); scan_phase(F); if (BOTH(2)) GRID_BAR(); }
    if (IN(3)) { ssdnorm_phase(F); hgnorm_phase(F); if (BOTH(3)) GRID_BAR(); }
    if (IN(4)) { { SmGate<false> Es{(bf16*)(ws + WS_MERGED), PROJ + (size_t)S_GS * SLOT_ELEMS}; small_tile_phase(F, (const bf16*)(ws + WS_YG), (const bf16*)(ws + WS_WSSD), 2048, Es); }
        pg8::Gemm g{(const bf16*)(ws + WS_YG), (const bf16*)(ws + WS_WSSD), TP, 1024, 2048}; pg8::StaticOrder S; S.init(TP, 1024, F.G, (int)blockIdx.x);
        pg8::EpiGate<false> E{(bf16*)(ws + WS_MERGED), PROJ + (size_t)S_GS * SLOT_ELEMS};
        pg8::gemm_phase<pg8::EpiGate<false>, pg8::StaticOrder, true, true>(F.lds + RING_OFF, g, S, E);
        if (BOTH(4)) GRID_BAR(); }
    if (IN(5)) { { SmGate<true> Es{(bf16*)(ws + WS_MERGED), PROJ + (size_t)S_GH * SLOT_ELEMS}; small_tile_phase(F, (const bf16*)(ws + WS_ON), (const bf16*)(ws + WS_WHG), 1024, Es); }
        pg8::Gemm g{(const bf16*)(ws + WS_ON), (const bf16*)(ws + WS_WHG), TP, 1024, 1024}; pg8::StaticOrder S; S.init(TP, 1024, F.G, (int)blockIdx.x);
        pg8::EpiGate<true> E{(bf16*)(ws + WS_MERGED), PROJ + (size_t)S_GH * SLOT_ELEMS};
        pg8::gemm_phase<pg8::EpiGate<true>, pg8::StaticOrder, true, true>(F.lds + RING_OFF, g, S, E);
        if (BOTH(5)) GRID_BAR(); }
    if (IN(6)) { { SmRes<false> Es{F.in[1] - (size_t)TP * 1024, (bf16*)(ws + WS_HB), (float*)(ws + WS_SSQP1)}; small_tile_phase(F, (const bf16*)(ws + WS_MERGED), (const bf16*)(ws + WS_WOUT), 1024, Es); }
        pg8::Gemm g{(const bf16*)(ws + WS_MERGED), (const bf16*)(ws + WS_WOUT), TP, 1024, 1024}; pg8::StaticOrder S; S.init(TP, 1024, F.G, (int)blockIdx.x);
        pg8::EpiRes<false> E{F.in[0], F.in[1] - (size_t)TP * 1024, (bf16*)(ws + WS_HB), (float*)(ws + WS_SSQP1)};
        pg8::gemm_phase<pg8::EpiRes<false>, pg8::StaticOrder, true, true>(F.lds + RING_OFF, g, S, E);
        if (BOTH(6)) GRID_BAR(); }
    if (IN(7)) { { SmScale Es{(bf16*)(ws + WS_QB), (const float*)(ws + WS_SSQP1), QSCALE}; small_tile_phase(F, (const bf16*)(ws + WS_HB), (const bf16*)(ws + WS_WCQ), 1024, Es); }
        pg8::Gemm g{(const bf16*)(ws + WS_HB), (const bf16*)(ws + WS_WCQ), TP, 1024, 1024}; pg8::StaticOrder S; S.init(TP, 1024, F.G, (int)blockIdx.x);
        pg8::EpiScaleBf16<16, false> E{(bf16*)(ws + WS_QB), SLOT_ELEMS, (const float*)(ws + WS_SSQP1), QSCALE, nullptr};
        pg8::gemm_phase<pg8::EpiScaleBf16<16, false>, pg8::StaticOrder, true, true>(F.lds + RING_OFF, g, S, E);
        if (BOTH(7)) GRID_BAR(); }
    if (IN(8)) { attn_phase(F); if (BOTH(8)) GRID_BAR(); }
    if (IN(9)) { { SmRes<true> Es{nullptr, (bf16*)(ws + WS_HB), (float*)(ws + WS_SSQP2)}; small_tile_phase(F, (const bf16*)(ws + WS_OB), (const bf16*)(ws + WS_WCO), 1024, Es); }
        pg8::Gemm g{(const bf16*)(ws + WS_OB), (const bf16*)(ws + WS_WCO), TP, 1024, 1024}; pg8::StaticOrder S; S.init(TP, 1024, F.G, (int)blockIdx.x);
        pg8::EpiRes<true> E{nullptr, nullptr, (bf16*)(ws + WS_HB), (float*)(ws + WS_SSQP2)};
        pg8::gemm_phase<pg8::EpiRes<true>, pg8::StaticOrder, true, true>(F.lds + RING_OFF, g, S, E);
        if (BOTH(9)) GRID_BAR(); }
    if (IN(10)) { pg8::Gemm g{(const bf16*)(ws + WS_HB), (const bf16*)(ws + WS_WGU), T, 2 * FFN, 1024}; pg8::StaticOrder S; S.init(T, 2 * FFN, F.G, (int)blockIdx.x);
        pg8::EpiSwiglu E{(bf16*)(ws + WS_ACT), (const float*)(ws + WS_SSQP2)};
        pg8::gemm_phase<pg8::EpiSwiglu, pg8::StaticOrder, true, true>(F.lds + RING_OFF, g, S, E);
        if (BOTH(10)) GRID_BAR(); }
    if (IN(11)) { { SmRes<true> Es{nullptr, (bf16*)(ws + WS_HB), (float*)(ws + WS_SSQP3)}; small_tile_phase(F, (const bf16*)(ws + WS_ACT), (const bf16*)(ws + WS_WDN), FFN, Es); }
        pg8::Gemm g{(const bf16*)(ws + WS_ACT), (const bf16*)(ws + WS_WDN), TP, 1024, FFN}; pg8::StaticOrder S; S.init(TP, 1024, F.G, (int)blockIdx.x);
        pg8::EpiRes<true> E{nullptr, nullptr, (bf16*)(ws + WS_HB), (float*)(ws + WS_SSQP3)};
        pg8::gemm_phase<pg8::EpiRes<true>, pg8::StaticOrder, true, true>(F.lds + RING_OFF, g, S, E);
        if (BOTH(11)) GRID_BAR(); }
    if (IN(12)) final_norm_phase(F);
#undef IN
#undef BOTH
}

extern "C" void kernel_launch(void* const* d_in, const int* in_sizes, int n_in, void* d_out, int out_size, void* d_ws, size_t ws_size, hipStream_t stream) {
    static int grid = 0;
    if (grid == 0) {
        const int want[32] = {TP * 1024, TS * 1024, MEMR * 1024, 33554432, 1179648, 16777216, 33554432, 33554432, 1024, 1024 * 11296, 4 * 3072, 3072, 32, 32, 32, 2048, 2048 * 1024, 2048, 1024,
                              1024 * 1024, 1024 * 1024, 1024, 1024, 1024 * 1024, 1024 * 1024, 1024 * 1024, 1024 * 1024, 1024, 1024 * FFN, 1024 * FFN, FFN * 1024, 1024};
        bool ok = (n_in == 32); for (int i = 0; ok && i < 32; ++i) if (in_sizes[i] != want[i]) { fprintf(stderr, "kernel_launch: input %d has %d elements, expected %d\n", i, in_sizes[i], want[i]); ok = false; }
        if (!ok || out_size != (int)O_END || ws_size < WS_END4) { fprintf(stderr, "kernel_launch: unexpected shapes: n_in %d out %d ws %zu\n", n_in, out_size, ws_size); grid = -1; return; }
        int dev = 0, cus = 0, per_cu = 0;
        if (hipGetDevice(&dev) != hipSuccess || hipDeviceGetAttribute(&cus, hipDeviceAttributeMultiprocessorCount, dev) != hipSuccess) { grid = -1; return; }
        if (hipFuncSetAttribute((const void*)skel_fwd, hipFuncAttributeMaxDynamicSharedMemorySize, LDS_BYTES) != hipSuccess) { fprintf(stderr, "kernel_launch: hipFuncSetAttribute failed\n"); grid = -1; return; }
        if (hipOccupancyMaxActiveBlocksPerMultiprocessor(&per_cu, (const void*)skel_fwd, NTHR, LDS_BYTES) != hipSuccess || per_cu < 1) fprintf(stderr, "kernel_launch: occupancy query reports %d blocks per CU\n", per_cu);
        (void)hipGetLastError();
        grid = cus;
    }
    if (grid < 0) return;
    (void)hipMemsetAsync((char*)d_ws + WS_CTL, 0, CTL_ZERO_BYTES, stream);
    Args a{};
    for (int i = 0; i < 32; ++i) a.in[i] = (const float*)d_in[i];
    a.out = (float*)d_out; a.ws = (unsigned char*)d_ws;
    for (int li = 0; li < N_LAUNCHES; ++li) {
        a.ph_lo = (N_LAUNCHES == PER_PHASE) ? li : 0; a.ph_hi = (N_LAUNCHES == PER_PHASE) ? li + 1 : PER_PHASE;
        hipLaunchKernelGGL(skel_fwd, dim3(grid), dim3(NTHR), LDS_BYTES, stream, a);
    }
}
```

```cpp
#include <hip/hip_runtime.h>
#include <cstdio>
#include <cstdint>
namespace pg8 {
#define PG8_LAS __attribute__((address_space(3)))
typedef unsigned short bf16_t;
typedef short bf16x8 __attribute__((ext_vector_type(8)));
typedef float f32x4 __attribute__((ext_vector_type(4)));
typedef unsigned u32x4 __attribute__((ext_vector_type(4)));
constexpr int BM = 256, BK = 64, HALF = 128, HTB = HALF * BK * 2  , STAGE_BYTES = 8 * HTB, NXCD = 8, WGM = 8;

__host__ __device__ __forceinline__ int lds_byte(int r, int c) { const int st = (r >> 4) * 2 + (c >> 5), rr = r & 15, cc = c & 31, ob = rr * 64 + cc * 2; return st * 1024 + (ob ^ (((ob >> 9) & 1) << 5)); }
__host__ __device__ __forceinline__ void stage_rc(int b, int& R, int& C) { const int st = b / 1024, sb = b % 1024, swz = sb ^ (((sb >> 9) & 1) << 5); R = (st >> 1) * 16 + swz / 64; C = (st & 1) * 32 + (swz % 64) / 2; }
__host__ __device__ __forceinline__ int perm32(int rho) { const int n = rho >> 4, i = rho & 15; return 8 * (i >> 2) + 4 * n + (i & 3); }

struct Unit { int pm, pn; };
struct Gemm { const bf16_t* A; const bf16_t* Bt; int M, N, K; };

struct StaticOrder {
    int nM, nN, nwg, G, c;
    __host__ __device__ void init(int M, int N, int G_, int c_) { nM = M / BM; nN = N / BM; nwg = nM * nN; G = G_; c = c_; }
    __host__ __device__ bool next(int i, Unit& u) const {
        const long L = (long)i * G + c; if (L >= nwg) return false;
        int wgid = (int)L; { const int q = nwg / NXCD, r = nwg % NXCD, xcd = wgid % NXCD, off = wgid / NXCD; wgid = (xcd < r ? xcd * (q + 1) : r * (q + 1) + (xcd - r) * q) + off; }
        const int nig = WGM * nN, gid = wgid / nig, fm = gid * WGM, gsz = (nM - fm) < WGM ? (nM - fm) : WGM;
        u.pm = fm + ((wgid % nig) % gsz); u.pn = (wgid % nig) / gsz; return true;
    }
    __device__ __forceinline__ void a_ready(const Unit&) const {}
    __device__ __forceinline__ void done(const Unit&) const {}
};

__device__ __forceinline__ unsigned cvt_pk_bf16(float lo, float hi) { unsigned r; asm volatile("v_cvt_pk_bf16_f32 %0, %1, %2" : "=v"(r) : "v"(lo), "v"(hi)); return r; }
typedef float f32x2 __attribute__((ext_vector_type(2)));
typedef unsigned u32x2 __attribute__((ext_vector_type(2)));
constexpr float RMS_EPS = 1e-6f;
__device__ __forceinline__ float bfbits2f(unsigned v16) { return __uint_as_float(v16 << 16); }
__device__ __forceinline__ float sigm(float x) { return __builtin_amdgcn_rcpf(1.0f + __expf(-x)); }
template <int NP> __device__ __forceinline__ float row_rs(const float* ssq, int row) {
    float s = 0.f;
    if constexpr (NP == 1) s = ssq[row];
    else {
#pragma unroll
        for (int i = 0; i < NP / 4; ++i) { const f32x4 v = *(const f32x4*)(ssq + (size_t)row * NP + 4 * i); s += (v[0] + v[1]) + (v[2] + v[3]); }
    }
    return 1.0f / sqrtf(s * (1.0f / 1024.0f) + RMS_EPS);
}
template <int NP, bool HAS_DT> struct EpiScaleBf16 {
    static constexpr bool PERM = true, AFTER_DRAIN = false;
    bf16_t* O; size_t slot_elems; const float* ssq; float scale; float* dt;
    __device__ __forceinline__ void operator()(const f32x4 (&acc)[2][2][4][2], const Unit& u, int wr, int wc, int fr, int fq) const {
        const int row0 = u.pm * BM + wr * 64 + fr;
        if (HAS_DT && u.pn == 44) {
            if (wc == 0) {
#pragma unroll
                for (int ai = 0; ai < 2; ++ai)
#pragma unroll
                    for (int m = 0; m < 4; ++m) { const int row = row0 + ai * HALF + m * 16; const float rs = row_rs<NP>(ssq, row);
                        float* p = dt + (size_t)row * 32 + 8 * fq; *(f32x4*)p = acc[ai][0][m][0] * rs; *(f32x4*)(p + 4) = acc[ai][0][m][1] * rs; }
            }
            return;
        }
        bf16_t* base = O + (size_t)(u.pn >> 2) * slot_elems; const int col0 = (u.pn & 3) * BM + wc * 32 + 8 * fq;
#pragma unroll
        for (int ai = 0; ai < 2; ++ai)
#pragma unroll
            for (int m = 0; m < 4; ++m) { const int row = row0 + ai * HALF + m * 16; const float rs = row_rs<NP>(ssq, row) * scale; bf16_t* rowp = base + (size_t)row * 1024 + col0;
#pragma unroll
                for (int bj = 0; bj < 2; ++bj) { const f32x4 v0 = acc[ai][bj][m][0] * rs, v1 = acc[ai][bj][m][1] * rs;
                    u32x4 w; w.x = cvt_pk_bf16(v0[0], v0[1]); w.y = cvt_pk_bf16(v0[2], v0[3]); w.z = cvt_pk_bf16(v1[0], v1[1]); w.w = cvt_pk_bf16(v1[2], v1[3]);
                    *(u32x4*)(rowp + bj * HALF) = w; } }
    }
};
struct EpiKV {
    static constexpr bool PERM = false, AFTER_DRAIN = false;
    float* mk; float* mv; bf16_t* kb; bf16_t* vt; const float* ssq;
    __device__ __forceinline__ void operator()(const f32x4 (&acc)[2][2][4][2], const Unit& u, int wr, int wc, int fr, int fq) const {
        const int row0 = u.pm * BM + wr * 64 + fr; const bool isv = u.pn >= 4; const int colt = (u.pn & 3) * BM + wc * 32 + 4 * fq;
#pragma unroll
        for (int ai = 0; ai < 2; ++ai)
#pragma unroll
            for (int m = 0; m < 4; ++m) { const int row = row0 + ai * HALF + m * 16; const float rs = row_rs<1>(ssq, row);
#pragma unroll
                for (int bj = 0; bj < 2; ++bj)
#pragma unroll
                    for (int n = 0; n < 2; ++n) { const int c = colt + bj * HALF + n * 16; const f32x4 v = acc[ai][bj][m][n] * rs;
                        if (!isv) { *(f32x4*)(mk + (size_t)row * 1024 + c) = v; u32x2 w; w.x = cvt_pk_bf16(v[0], v[1]); w.y = cvt_pk_bf16(v[2], v[3]); *(u32x2*)(kb + (size_t)row * 1024 + c) = w; }
                        else { *(f32x4*)(mv + (size_t)row * 1024 + c) = v; const int b = row >> 8, key = row & 255, hd = c >> 8, d = c & 255;
                            bf16_t* p = vt + ((size_t)((b * 4 + hd) * 256 + d)) * 256 + key; const unsigned w0 = cvt_pk_bf16(v[0], v[1]), w1 = cvt_pk_bf16(v[2], v[3]);
                            p[0] = (bf16_t)(w0 & 0xffffu); p[256] = (bf16_t)(w0 >> 16); p[512] = (bf16_t)(w1 & 0xffffu); p[768] = (bf16_t)(w1 >> 16); } } }
    }
};
template <bool ADD> struct EpiGate {
    static constexpr bool PERM = true, AFTER_DRAIN = false;
    bf16_t* O; const bf16_t* gate;
    __device__ __forceinline__ void operator()(const f32x4 (&acc)[2][2][4][2], const Unit& u, int wr, int wc, int fr, int fq) const {
        const int row0 = u.pm * BM + wr * 64 + fr, col0 = u.pn * BM + wc * 32 + 8 * fq;
#pragma unroll
        for (int ai = 0; ai < 2; ++ai)
#pragma unroll
            for (int m = 0; m < 4; ++m) { const size_t off = (size_t)(row0 + ai * HALF + m * 16) * 1024 + col0;
#pragma unroll
                for (int bj = 0; bj < 2; ++bj) { const u32x4 gw = *(const u32x4*)(gate + off + bj * HALF); u32x4 ow = (u32x4){0u, 0u, 0u, 0u}; if (ADD) ow = *(const u32x4*)(O + off + bj * HALF);
                    float r[8];
#pragma unroll
                    for (int e = 0; e < 8; ++e) { const unsigned g16 = (gw[e >> 1] >> ((e & 1) * 16)) & 0xffffu, o16 = (ow[e >> 1] >> ((e & 1) * 16)) & 0xffffu;
                        const float a = acc[ai][bj][m][e >> 2][e & 3]; r[e] = (ADD ? bfbits2f(o16) : 0.f) + sigm(bfbits2f(g16)) * a; }
                    u32x4 w; w.x = cvt_pk_bf16(r[0], r[1]); w.y = cvt_pk_bf16(r[2], r[3]); w.z = cvt_pk_bf16(r[4], r[5]); w.w = cvt_pk_bf16(r[6], r[7]);
                    *(u32x4*)(O + off + bj * HALF) = w; } }
    }
};
template <bool BF> struct EpiRes {
    static constexpr bool PERM = true, AFTER_DRAIN = false;
    const float* base0; const float* base1; bf16_t* hb; float* ssqp;
    __device__ __forceinline__ void operator()(const f32x4 (&acc)[2][2][4][2], const Unit& u, int wr, int wc, int fr, int fq) const {
        const int row0 = u.pm * BM + wr * 64 + fr, col0 = u.pn * BM + wc * 32 + 8 * fq; const float* base = u.pm < 64 ? base0 : base1;
#pragma unroll
        for (int ai = 0; ai < 2; ++ai)
#pragma unroll
            for (int m = 0; m < 4; ++m) { const int row = row0 + ai * HALF + m * 16; const size_t off = (size_t)row * 1024 + col0; float sq = 0.f;
#pragma unroll
                for (int bj = 0; bj < 2; ++bj) { const size_t o2 = off + bj * HALF; f32x4 b0, b1;
                    if (BF) { const u32x4 w = *(const u32x4*)(hb + o2); b0 = (f32x4){bfbits2f(w.x & 0xffffu), __uint_as_float(w.x & 0xffff0000u), bfbits2f(w.y & 0xffffu), __uint_as_float(w.y & 0xffff0000u)};
                        b1 = (f32x4){bfbits2f(w.z & 0xffffu), __uint_as_float(w.z & 0xffff0000u), bfbits2f(w.w & 0xffffu), __uint_as_float(w.w & 0xffff0000u)}; }
                    else { b0 = *(const f32x4*)(base + o2); b1 = *(const f32x4*)(base + o2 + 4); }
                    const f32x4 v0 = b0 + acc[ai][bj][m][0], v1 = b1 + acc[ai][bj][m][1];
                    sq += ((v0[0] * v0[0] + v0[1] * v0[1]) + (v0[2] * v0[2] + v0[3] * v0[3])) + ((v1[0] * v1[0] + v1[1] * v1[1]) + (v1[2] * v1[2] + v1[3] * v1[3]));
                    u32x4 w; w.x = cvt_pk_bf16(v0[0], v0[1]); w.y = cvt_pk_bf16(v0[2], v0[3]); w.z = cvt_pk_bf16(v1[0], v1[1]); w.w = cvt_pk_bf16(v1[2], v1[3]); *(u32x4*)(hb + o2) = w; }
                sq += __shfl_xor(sq, 16); sq += __shfl_xor(sq, 32);
                if (fq == 0) ssqp[(size_t)row * 16 + u.pn * 4 + wc] = sq; }
    }
};
struct EpiSwiglu {
    static constexpr bool PERM = true, AFTER_DRAIN = false;
    bf16_t* act; const float* ssq;
    __device__ __forceinline__ void operator()(const f32x4 (&acc)[2][2][4][2], const Unit& u, int wr, int wc, int fr, int fq) const {
        const int row0 = u.pm * BM + wr * 64 + fr, col0 = u.pn * 128 + wc * 16 + 4 * fq;
#pragma unroll
        for (int ai = 0; ai < 2; ++ai)
#pragma unroll
            for (int m = 0; m < 4; ++m) { const int row = row0 + ai * HALF + m * 16; const float rs = row_rs<16>(ssq, row);
#pragma unroll
                for (int bj = 0; bj < 2; ++bj) { const f32x4 a = acc[ai][bj][m][0] * rs, b = acc[ai][bj][m][1] * rs;
                    const float r0 = a[0] * sigm(a[0]) * a[1], r1 = a[2] * sigm(a[2]) * a[3], r2 = b[0] * sigm(b[0]) * b[1], r3 = b[2] * sigm(b[2]) * b[3];
                    u32x2 w; w.x = cvt_pk_bf16(r0, r1); w.y = cvt_pk_bf16(r2, r3); *(u32x2*)(act + (size_t)row * 2816 + col0 + bj * 64) = w; } }
    }
};
template <class Epi, class Sched, bool ALIGN_EPI = false, bool SP2 = false>
__device__ __forceinline__ void gemm_phase(PG8_LAS unsigned char* lds, const Gemm g, const Sched& S, const Epi& E) {
    const int tid = threadIdx.x, wid = __builtin_amdgcn_readfirstlane(tid >> 6), lane = tid & 63, wr = wid >> 2, wc = wid & 3, fr = lane & 15, fq = lane >> 4;
    const int K = g.K, nt = K / BK;
    unsigned voffA[2], voffB[2];
#pragma unroll
    for (int i = 0; i < 2; ++i) { int R, C; stage_rc(tid * 16 + i * 8192, R, C); const int Rb = Epi::PERM ? ((R & ~31) + perm32(R & 31)) : R;
        voffA[i] = (unsigned)(R * K + C) * 2u; voffB[i] = (unsigned)(Rb * K + C) * 2u; }
    const size_t kstep = (size_t)(BK * 2);
    const size_t hstep = (size_t)HALF * K * 2;
    const size_t tstep = 2 * hstep;
    const unsigned ldsw = (unsigned)wid * 1024u;
    const int aoff = lds_byte(wr * 64 + fr, fq * 8), boff = lds_byte(wc * 32 + fr, fq * 8);
#define PG8_SA(b, h) (((b) * 2 + (h)) * HTB)
#define PG8_SB(b, h) ((4 + (b) * 2 + (h)) * HTB)
#define PG8_STAGE(bufoff, gbase, voff) do { _Pragma("unroll") for (int _i = 0; _i < 2; ++_i) \
        __builtin_amdgcn_global_load_lds((const unsigned*)((const char*)(gbase) + (voff)[_i]), (PG8_LAS unsigned*)(lds + (bufoff) + ldsw + _i * 8192), 16, 0, 0); } while (0)
#define PG8_LDA(dst, b, h) do { _Pragma("unroll") for (int m = 0; m < 4; ++m) _Pragma("unroll") for (int k = 0; k < 2; ++k) dst[m][k] = *(const PG8_LAS bf16x8*)(lds + PG8_SA(b, h) + aoff + m * 2048 + k * 1024); } while (0)
#define PG8_LDB(dst, b, h) do { _Pragma("unroll") for (int n = 0; n < 2; ++n) _Pragma("unroll") for (int k = 0; k < 2; ++k) dst[n][k] = *(const PG8_LAS bf16x8*)(lds + PG8_SB(b, h) + boff + n * 2048 + k * 1024); } while (0)
#define PG8_MMA(ai, bj, At, Bt) do { __builtin_amdgcn_s_setprio(1); _Pragma("unroll") for (int m = 0; m < 4; ++m) _Pragma("unroll") for (int n = 0; n < 2; ++n) _Pragma("unroll") for (int k = 0; k < 2; ++k) \
        acc[ai][bj][m][n] = __builtin_amdgcn_mfma_f32_16x16x32_bf16(Bt[n][k], At[m][k], acc[ai][bj][m][n], 0, 0, 0); __builtin_amdgcn_s_setprio(0); } while (0)
#define PG8_WAIT_V(n) asm volatile("s_waitcnt vmcnt(" #n ")" ::: "memory")
#define PG8_WAIT_L(n) asm volatile("s_waitcnt lgkmcnt(" #n ")" ::: "memory")
#define PG8_BAR __builtin_amdgcn_s_barrier()
#define PG8_SCHED __builtin_amdgcn_sched_barrier(0)
    Unit cur, nxt; int ui = 0;
    if (!S.next(0, cur)) return;
    f32x4 acc[2][2][4][2];
#pragma unroll
    for (int a = 0; a < 2; ++a)
#pragma unroll
        for (int b = 0; b < 2; ++b)
#pragma unroll
            for (int m = 0; m < 4; ++m)
#pragma unroll
                for (int n = 0; n < 2; ++n) acc[a][b][m][n] = (f32x4){0.f, 0.f, 0.f, 0.f};
    bf16x8 At[4][2], B0[2][2], B1[2][2];
    const char* cA = (const char*)g.A + (size_t)cur.pm * tstep; const char* cB = (const char*)g.Bt + (size_t)cur.pn * tstep;
    S.a_ready(cur);
    if constexpr (SP2) {
        PG8_STAGE(PG8_SB(0, 0), cB, voffB); PG8_STAGE(PG8_SB(0, 1), cB + hstep, voffB); PG8_STAGE(PG8_SA(0, 0), cA, voffA); PG8_STAGE(PG8_SA(0, 1), cA + hstep, voffA);
        if (wr == 1) PG8_BAR;
        PG8_WAIT_V(2); PG8_BAR;
        PG8_STAGE(PG8_SB(1, 0), cB + kstep, voffB); PG8_STAGE(PG8_SA(1, 0), cA + kstep, voffA); PG8_STAGE(PG8_SB(1, 1), cB + hstep + kstep, voffB);
        PG8_WAIT_V(6); PG8_BAR;
    } else {
        PG8_STAGE(PG8_SB(0, 0), cB, voffB); PG8_STAGE(PG8_SA(0, 0), cA, voffA); PG8_STAGE(PG8_SB(0, 1), cB + hstep, voffB); PG8_STAGE(PG8_SA(0, 1), cA + hstep, voffA);
        if (wr == 1) PG8_BAR;
        PG8_WAIT_V(4); PG8_BAR;
        PG8_STAGE(PG8_SB(1, 0), cB + kstep, voffB); PG8_STAGE(PG8_SA(1, 0), cA + kstep, voffA); PG8_STAGE(PG8_SB(1, 1), cB + hstep + kstep, voffB);
        PG8_WAIT_V(6); PG8_BAR;
    }
    for (;;) {
        const bool has_next = S.next(ui + 1, nxt);
        const char* nA = has_next ? (const char*)g.A + (size_t)nxt.pm * tstep : cA; const char* nB = has_next ? (const char*)g.Bt + (size_t)nxt.pn * tstep : cB;
        for (int t = 0; t < nt; t += 2) {
            const bool last = (t == nt - 2);
            const char* a1 = cA + (size_t)(t + 1) * kstep;
            const char* a2 = last ? nA : cA + (size_t)(t + 2) * kstep; const char* b2 = last ? nB : cB + (size_t)(t + 2) * kstep;
            const char* a3 = a2 + kstep; const char* b3 = b2 + kstep;
            if (last && has_next) S.a_ready(nxt);
            if constexpr (SP2) {
            PG8_LDB(B0, 0, 0); PG8_LDB(B1, 0, 1); PG8_SCHED; PG8_LDA(At, 0, 0); PG8_STAGE(PG8_SA(1, 1), a1 + hstep, voffA);
            PG8_WAIT_V(8); PG8_WAIT_L(0); PG8_BAR; PG8_MMA(0, 0, At, B0); PG8_MMA(0, 1, At, B1); PG8_BAR; PG8_SCHED;
            PG8_LDA(At, 0, 1); PG8_STAGE(PG8_SB(0, 0), b2, voffB); PG8_STAGE(PG8_SB(0, 1), b2 + hstep, voffB); PG8_STAGE(PG8_SA(0, 0), a2, voffA);
            PG8_WAIT_V(8); PG8_WAIT_L(0); PG8_BAR; PG8_MMA(1, 0, At, B0); PG8_MMA(1, 1, At, B1); PG8_BAR; PG8_SCHED;
            PG8_LDB(B0, 1, 0); PG8_LDB(B1, 1, 1); PG8_SCHED; PG8_LDA(At, 1, 0); PG8_STAGE(PG8_SA(0, 1), a2 + hstep, voffA);
            PG8_WAIT_V(8); PG8_WAIT_L(0); PG8_BAR; PG8_MMA(0, 0, At, B0); PG8_MMA(0, 1, At, B1); PG8_BAR; PG8_SCHED;
            PG8_LDA(At, 1, 1); PG8_STAGE(PG8_SB(1, 0), b3, voffB); PG8_STAGE(PG8_SB(1, 1), b3 + hstep, voffB); PG8_STAGE(PG8_SA(1, 0), a3, voffA);
            PG8_WAIT_V(8); PG8_WAIT_L(0); PG8_BAR; PG8_MMA(1, 0, At, B0); PG8_MMA(1, 1, At, B1); PG8_BAR; PG8_SCHED;
            } else {
            PG8_LDB(B0, 0, 0); PG8_SCHED; PG8_LDA(At, 0, 0); PG8_STAGE(PG8_SA(1, 1), a1 + hstep, voffA);
            PG8_WAIT_L(8); PG8_BAR; PG8_WAIT_L(0); PG8_MMA(0, 0, At, B0); PG8_BAR; PG8_SCHED;
            PG8_LDB(B1, 0, 1); PG8_STAGE(PG8_SB(0, 0), b2, voffB);
            PG8_BAR; PG8_WAIT_L(0); PG8_MMA(0, 1, At, B1); PG8_BAR;
            PG8_LDA(At, 0, 1); PG8_STAGE(PG8_SA(0, 0), a2, voffA);
            PG8_BAR; PG8_WAIT_L(0); PG8_MMA(1, 0, At, B0); PG8_BAR; PG8_SCHED;
            PG8_STAGE(PG8_SB(0, 1), b2 + hstep, voffB);
            PG8_WAIT_V(6); PG8_BAR; PG8_MMA(1, 1, At, B1); PG8_BAR;
            PG8_LDB(B0, 1, 0); PG8_SCHED; PG8_LDA(At, 1, 0); PG8_STAGE(PG8_SA(0, 1), a2 + hstep, voffA);
            PG8_WAIT_L(8); PG8_BAR; PG8_WAIT_L(0); PG8_MMA(0, 0, At, B0); PG8_BAR; PG8_SCHED;
            PG8_LDB(B1, 1, 1); PG8_STAGE(PG8_SB(1, 0), b3, voffB);
            PG8_BAR; PG8_WAIT_L(0); PG8_MMA(0, 1, At, B1); PG8_BAR;
            PG8_LDA(At, 1, 1); PG8_STAGE(PG8_SA(1, 0), a3, voffA);
            PG8_BAR; PG8_WAIT_L(0); PG8_MMA(1, 0, At, B0); PG8_BAR; PG8_SCHED;
            PG8_STAGE(PG8_SB(1, 1), b3 + hstep, voffB);
            PG8_WAIT_V(6); PG8_BAR; PG8_MMA(1, 1, At, B1); PG8_BAR;
            }
        }
        if constexpr (ALIGN_EPI) { if (wr == 0) PG8_BAR; }
        if constexpr (!Epi::AFTER_DRAIN) { E(acc, cur, wr, wc, fr, fq); S.done(cur); }
        if (!has_next) break;
#pragma unroll
        for (int a = 0; a < 2; ++a)
#pragma unroll
            for (int b = 0; b < 2; ++b)
#pragma unroll
                for (int m = 0; m < 4; ++m)
#pragma unroll
                    for (int n = 0; n < 2; ++n) acc[a][b][m][n] = (f32x4){0.f, 0.f, 0.f, 0.f};
        cur = nxt; cA = nA; cB = nB; ++ui;
        if constexpr (ALIGN_EPI) { if (wr == 1) PG8_BAR; }
    }
    PG8_WAIT_V(0);
    if constexpr (!ALIGN_EPI) { if (wr == 0) PG8_BAR; }
    PG8_BAR;
    if constexpr (Epi::AFTER_DRAIN) { E.fused(acc, cur, wr, wc, fr, fq, lds, wid, lane); S.done(cur); }
#undef PG8_SA
#undef PG8_SB
#undef PG8_STAGE
#undef PG8_LDA
#undef PG8_LDB
#undef PG8_MMA
#undef PG8_WAIT_V
#undef PG8_WAIT_L
#undef PG8_BAR
#undef PG8_SCHED
}
}
#define GAS __attribute__((address_space(1)))
#define LAS __attribute__((address_space(3)))
typedef unsigned short bf16;
typedef unsigned v4u __attribute__((ext_vector_type(4)));
typedef float f32x4 __attribute__((ext_vector_type(4)));
typedef short bf16x8 __attribute__((ext_vector_type(8)));
typedef GAS unsigned gu32;
typedef GAS unsigned long long gu64;
#define RLX_AGENT __ATOMIC_RELAXED, __HIP_MEMORY_SCOPE_AGENT
#define LDS_WAIT() asm volatile("s_waitcnt lgkmcnt(0)" ::: "memory")
#define VM_WAIT() asm volatile("s_waitcnt vmcnt(0)" ::: "memory")
__device__ __forceinline__ unsigned long long rt() { return __builtin_amdgcn_s_memrealtime(); }
typedef float f32x2_t __attribute__((ext_vector_type(2))); typedef __bf16 bf16x2_t __attribute__((ext_vector_type(2)));
__device__ __forceinline__ unsigned pk2(float lo, float hi) { const f32x2_t v = {lo, hi}; const bf16x2_t b = __builtin_convertvector(v, bf16x2_t); return __builtin_bit_cast(unsigned, b); }
__device__ __forceinline__ unsigned f2bf(float f) { return pk2(f, 0.f) & 0xffffu; }

#define XB_TMO      128
#define XB_XCNT(j)  (256  + 64 * (j))
#define XB_XSUB(j)  (1280 + 64 * (j))
#define XB_XGEN(j)  (2304 + 64 * (j))
#define XB_TOP      3328
#define XB_TOPGEN   3392
#define XCD_BAR_WORDS 3456
#define XB_SPIN_CAP (1u << 18)

__device__ __forceinline__ unsigned xb_ld(unsigned* p)              { return __hip_atomic_load(p, __ATOMIC_RELAXED, __HIP_MEMORY_SCOPE_AGENT); }
__device__ __forceinline__ unsigned xb_add(unsigned* p, unsigned v) { return __hip_atomic_fetch_add(p, v, __ATOMIC_RELAXED, __HIP_MEMORY_SCOPE_AGENT); }
__device__ __forceinline__ unsigned xb_xcc_id() { return (unsigned)__builtin_amdgcn_s_getreg((3 << 11) | 20) & 0xFu; }
#define XB_SPIN(cond, bar) do { unsigned _sp = 0; while (cond) { __builtin_amdgcn_s_sleep(1); \
    if ((++_sp & 255u) == 0u) { if (xb_ld(&(bar)[XB_TMO])) break; if (_sp > XB_SPIN_CAP) { atomicAdd(&(bar)[XB_TMO], 1u); break; } } } } while (0)

struct XcdBarrier {
    unsigned* bar; unsigned x;
    volatile LAS unsigned* st;
};

__device__ __forceinline__ XcdBarrier xcd_barrier_post(unsigned* bar, volatile LAS unsigned* st) {
    XcdBarrier b; b.bar = bar; b.x = xb_xcc_id(); b.st = st;
    if (threadIdx.x == 0) (void)xb_add(&bar[XB_XCNT(b.x)], 1u);
    return b;
}
__device__ __forceinline__ void xcd_barrier_complete(unsigned* bar, unsigned x, unsigned& nloc, unsigned& nx) {
    const unsigned G = gridDim.x * gridDim.y * gridDim.z;
    unsigned sum, cnt, mine, sp = 0u;
    for (;;) {
        sum = 0u; cnt = 0u; mine = 0u;
#pragma unroll
        for (unsigned j = 0; j < 16; ++j) { const unsigned c = xb_ld(&bar[XB_XCNT(j)]); sum += c; cnt += (c > 0u) ? 1u : 0u; mine = (j == x) ? c : mine; }
        if (sum == G) break;
        __builtin_amdgcn_s_sleep(1);
        if ((++sp & 255u) == 0u) { if (xb_ld(&bar[XB_TMO])) break; if (sp > XB_SPIN_CAP) { atomicAdd(&bar[XB_TMO], 1u); break; } }
    }
    nloc = mine > 0u ? mine : 1u; nx = cnt > 0u ? cnt : 1u;
}

__device__ __forceinline__ void xcd_barrier(const XcdBarrier& b) {
    asm volatile("s_waitcnt vmcnt(0)" ::: "memory");
    __syncthreads();
    if (threadIdx.x == 0) {
        unsigned* bar = b.bar;
        __builtin_amdgcn_s_waitcnt(0);
        unsigned nloc = b.st[0], nx = b.st[1];
        if (nloc == 0u) { xcd_barrier_complete(bar, b.x, nloc, nx); b.st[0] = nloc; b.st[1] = nx; }
        const unsigned old = xb_add(&bar[XB_XSUB(b.x)], 1u);
        const unsigned gen = old / nloc;
        if (old + 1u == (gen + 1u) * nloc) {
            __builtin_amdgcn_fence(__ATOMIC_RELEASE, "agent");
            asm volatile("s_waitcnt vmcnt(0)" ::: "memory");
            const unsigned og = xb_add(&bar[XB_TOP], 1u);
            const unsigned tg = og / nx;
            if (og + 1u == (tg + 1u) * nx) xb_add(&bar[XB_TOPGEN], 1u);
            else XB_SPIN(xb_ld(&bar[XB_TOPGEN]) == tg, bar);
            __builtin_amdgcn_fence(__ATOMIC_ACQUIRE, "agent");
            xb_add(&bar[XB_XGEN(b.x)], 1u);
            asm volatile("s_waitcnt vmcnt(0)" ::: "memory");
        } else {
            XB_SPIN(xb_ld(&bar[XB_XGEN(b.x)]) == gen, bar);
            __builtin_amdgcn_fence(__ATOMIC_ACQUIRE, "agent");
            asm volatile("s_waitcnt vmcnt(0)" ::: "memory");
        }
    }
    __syncthreads();
}
typedef unsigned v2u __attribute__((ext_vector_type(2)));
constexpr int NWAVES = 8, NTHR = 512;
constexpr int DM = 1024, TP = 16384, TS = 512, T = TP + TS;
constexpr int SEQ = 2048, NBP = 8, NBS = 128, LS = 4, MEMR = 2048;
constexpr int NPROJ = 11520;
constexpr int FFN = 2816;
constexpr float EPS = 1e-6f;
constexpr float QSCALE = 0.0625f * 1.4426950408889634f;

constexpr size_t MiB = 1u << 20;
constexpr size_t WS_CTL = 0, CTL_ZERO_BYTES = 1 * MiB;
constexpr size_t WS_SSQX = 1 * MiB, WS_SSQM = 1 * MiB + 512 * 1024;
constexpr size_t WS_DT = 2 * MiB, WS_SSQSSD = 5 * MiB, WS_SSQP1 = 8 * MiB, WS_SSQP2 = 9 * MiB + 512 * 1024, WS_SSQP3 = 11 * MiB;
constexpr size_t WS_WIN = 13 * MiB, WS_WKV = 36 * MiB, WS_WSSD = 40 * MiB, WS_WHG = 44 * MiB, WS_WOUT = 46 * MiB, WS_WCQ = 48 * MiB, WS_WCO = 50 * MiB, WS_WGU = 52 * MiB, WS_WDN = 63 * MiB;
constexpr size_t WS_XB = 69 * MiB, WS_MNB = 102 * MiB, WS_KB = 106 * MiB, WS_VT = 110 * MiB;
constexpr size_t SLOT = 33 * MiB, SLOT_ELEMS = (size_t)T * 1024;
constexpr size_t WS_PROJ = 114 * MiB;
constexpr size_t WS_YG = WS_PROJ + 11 * SLOT, WS_ON = WS_YG + 2 * SLOT, WS_END = WS_ON + SLOT;
static_assert(SLOT == SLOT_ELEMS * 2, "slot size");
static_assert(WS_WIN + (size_t)NPROJ * 1024 * 2 <= WS_WKV && WS_WGU + (size_t)2 * FFN * 1024 * 2 <= WS_WDN && WS_WDN + (size_t)1024 * FFN * 2 <= WS_XB && WS_SSQP3 + (size_t)T * 64 <= WS_WIN, "d_ws map");
static_assert(WS_DT + (size_t)T * 128 <= WS_SSQSSD && WS_SSQSSD + (size_t)T * 128 <= WS_SSQP1 && WS_SSQP1 + (size_t)T * 64 <= WS_SSQP2 && WS_SSQP2 + (size_t)T * 64 <= WS_SSQP3, "d_ws map 2");
enum { S_Z0 = 0, S_Z1 = 1, S_X0 = 2, S_X1 = 3, S_X2 = 4, S_Q = 5, S_F = 6, S_I = 7, S_HG = 8, S_GS = 9, S_GH = 10 };
constexpr size_t WS_MERGED = WS_PROJ + S_Q * SLOT, WS_HB = WS_PROJ + S_F * SLOT, WS_QB = WS_PROJ + S_I * SLOT, WS_OB = WS_PROJ + S_HG * SLOT, WS_ACT = WS_PROJ;
static_assert((size_t)T * FFN * 2 <= 3 * SLOT, "act overlay");
constexpr size_t O_Y = 0, O_SSMP = (size_t)T * 1024, O_CONVP = O_SSMP + 2097152, O_HGP = O_CONVP + 73728, O_MKP = O_HGP + 1048576, O_MVP = O_MKP + 2097152,
                 O_SSMS = O_MVP + 2097152, O_CONVS = O_SSMS + 33554432, O_HGS = O_CONVS + 1179648, O_END = O_HGS + 16777216;
constexpr int CW_QUEUE = 64;
constexpr int CW_BAR = 4096;
constexpr int RING_OFF = 0, RING_BYTES = 131072;
constexpr int LDS_BYTES = 147456;
constexpr int LDSCTL_OFF = LDS_BYTES - 1024, MISC_OFF = LDSCTL_OFF + 320;
struct Frame {
    LAS unsigned char* lds;
    volatile LAS unsigned* MISC;
    gu32* ctl;
    int tid, lane, wave;
    int vcu, G;
    const float* in[32];
    float* out; unsigned char* ws;
};
__device__ __forceinline__ float bf2f(unsigned v16) { return __uint_as_float(v16 << 16); }
__device__ __forceinline__ float sigmoid_f(float x) { return __builtin_amdgcn_rcpf(1.0f + __expf(-x)); }
__device__ __forceinline__ float silu_f(float x) { return x * sigmoid_f(x); }
__device__ __forceinline__ float wave_sum(float v) {
#pragma unroll
    for (int o = 1; o < 64; o <<= 1) v += __shfl_xor(v, o);
    return v;
}
__device__ __forceinline__ float wave_max(float v) {
#pragma unroll
    for (int o = 1; o < 64; o <<= 1) v = fmaxf(v, __shfl_xor(v, o));
    return v;
}
struct TSrc { const float* W; const float* W2; const float* ks; int ldw; int mode; };
__device__ __forceinline__ void p0_transpose_item(const TSrc& s, int K, int N, bf16* WT, LAS unsigned short* scr, int item, int lane) {
    const int nblk = N / 64, kb = item / nblk, nb = item % nblk, k0 = 64 * kb, n0 = 64 * nb;
    const int kr = lane >> 4, nq = lane & 15;
    const float* const Wa = s.W; const float* const Wb = s.W2;
    const float* src; int c0, cs; bool zero = false;
    if (s.mode == 2) { const float* wsel = Wa; if (nq >= 8) wsel = Wb; src = wsel + (n0 >> 1) + 4 * (nq & 7); c0 = 8 * (nq & 7) + (nq >> 3); cs = 2; }
    else { const int n = n0 + 4 * nq; c0 = 4 * nq; cs = 1;
        if (s.mode == 0) src = Wa + n;
        else if (s.mode == 1) { if (n < 5120) src = Wa + n; else if (n < 11264) src = Wa + n + 32; else if (n < 11296) src = Wa + 5120 + (n - 11264); else { src = Wa; zero = true; } }
        else { src = Wa + n; if (n >= 1024) src = Wb + (n - 1024); } }
    f32x4 v[16];
#pragma unroll
    for (int i = 0; i < 16; ++i) v[i] = zero ? (f32x4){0.f, 0.f, 0.f, 0.f} : *(const f32x4*)(src + (size_t)(k0 + 4 * i + kr) * s.ldw);
#pragma unroll
    for (int i = 0; i < 16; ++i) { const int kk = 4 * i + kr; const float sc = s.ks ? s.ks[k0 + kk] : 1.0f; const unsigned w0 = pk2(v[i].x * sc, v[i].y * sc), w1 = pk2(v[i].z * sc, v[i].w * sc);
        LAS unsigned short* d = scr + kk * 66 + c0;
        if (cs == 1) { *(LAS unsigned*)d = w0; *(LAS unsigned*)(d + 2) = w1; }
        else { d[0] = (unsigned short)(w0 & 0xffffu); d[2] = (unsigned short)(w0 >> 16); d[4] = (unsigned short)(w1 & 0xffffu); d[6] = (unsigned short)(w1 >> 16); } }
    LDS_WAIT(); asm volatile("" ::: "memory");
    const int nr = lane >> 3, kc = lane & 7;
#pragma unroll
    for (int j = 0; j < 8; ++j) { const int n = 8 * j + nr; const LAS unsigned short* p = scr + (8 * kc) * 66 + n;
        v4u o; o.x = (unsigned)p[0] | ((unsigned)p[66] << 16); o.y = (unsigned)p[2 * 66] | ((unsigned)p[3 * 66] << 16); o.z = (unsigned)p[4 * 66] | ((unsigned)p[5 * 66] << 16); o.w = (unsigned)p[6 * 66] | ((unsigned)p[7 * 66] << 16);
        *(v4u*)(WT + (size_t)(n0 + n) * K + k0 + 8 * kc) = o; }
    LDS_WAIT(); asm volatile("" ::: "memory");
}
__device__ __forceinline__ void rows4_to_bf16_ssq(const float* x0, bf16* o0, float* ssq0, int lane) {
    f32x4 v[4][4];
#pragma unroll
    for (int rr = 0; rr < 4; ++rr)
#pragma unroll
        for (int j = 0; j < 4; ++j) v[rr][j] = ((const f32x4*)(x0 + rr * 1024))[64 * j + lane];
#pragma unroll
    for (int rr = 0; rr < 4; ++rr) { float sq = 0.f;
#pragma unroll
        for (int j = 0; j < 4; ++j) sq += (v[rr][j].x * v[rr][j].x + v[rr][j].y * v[rr][j].y) + (v[rr][j].z * v[rr][j].z + v[rr][j].w * v[rr][j].w);
        sq = wave_sum(sq);
        unsigned long long* o8 = (unsigned long long*)(o0 + rr * 1024) + lane;
#pragma unroll
        for (int j = 0; j < 4; ++j) o8[64 * j] = (unsigned long long)pk2(v[rr][j].x, v[rr][j].y) | ((unsigned long long)pk2(v[rr][j].z, v[rr][j].w) << 32);
        if (lane == 0) ssq0[rr] = sq; }
}
__device__ __forceinline__ void p0_prologue(Frame& F) {
    LAS unsigned short* scr = (LAS unsigned short*)(F.lds + RING_OFF + F.wave * 16384);
    const int gw = F.vcu * NWAVES + F.wave, NGW = F.G * NWAVES;
    unsigned char* ws = F.ws;
    constexpr int I_IN = 16 * (NPROJ / 64), I_KV = 16 * 32, I_SSD = 32 * 16, I_SQ = 16 * 16, I_GU = 16 * (2 * FFN / 64), I_DN = (FFN / 64) * 16;
    constexpr int NITEMS = I_IN + I_KV + I_SSD + 4 * I_SQ + I_GU + I_DN;
    for (int it = gw; it < NITEMS; it += NGW) {
        int r = it;
        if (r < I_IN) { TSrc s{F.in[9], nullptr, F.in[8], 11296, 1}; p0_transpose_item(s, 1024, NPROJ, (bf16*)(ws + WS_WIN), scr, r, F.lane); continue; } r -= I_IN;
        if (r < I_KV) { TSrc s{F.in[24], F.in[25], F.in[22], 1024, 3}; p0_transpose_item(s, 1024, 2048, (bf16*)(ws + WS_WKV), scr, r, F.lane); continue; } r -= I_KV;
        if (r < I_SSD) { TSrc s{F.in[16], nullptr, F.in[15], 1024, 0}; p0_transpose_item(s, 2048, 1024, (bf16*)(ws + WS_WSSD), scr, r, F.lane); continue; } r -= I_SSD;
        if (r < I_SQ) { TSrc s{F.in[19], nullptr, F.in[18], 1024, 0}; p0_transpose_item(s, 1024, 1024, (bf16*)(ws + WS_WHG), scr, r, F.lane); continue; } r -= I_SQ;
        if (r < I_SQ) { TSrc s{F.in[20], nullptr, nullptr, 1024, 0}; p0_transpose_item(s, 1024, 1024, (bf16*)(ws + WS_WOUT), scr, r, F.lane); continue; } r -= I_SQ;
        if (r < I_SQ) { TSrc s{F.in[23], nullptr, F.in[21], 1024, 0}; p0_transpose_item(s, 1024, 1024, (bf16*)(ws + WS_WCQ), scr, r, F.lane); continue; } r -= I_SQ;
        if (r < I_SQ) { TSrc s{F.in[26], nullptr, nullptr, 1024, 0}; p0_transpose_item(s, 1024, 1024, (bf16*)(ws + WS_WCO), scr, r, F.lane); continue; } r -= I_SQ;
        if (r < I_GU) { TSrc s{F.in[28], F.in[29], F.in[27], FFN, 2}; p0_transpose_item(s, 1024, 2 * FFN, (bf16*)(ws + WS_WGU), scr, r, F.lane); continue; } r -= I_GU;
        { TSrc s{F.in[30], nullptr, nullptr, 1024, 0}; p0_transpose_item(s, FFN, 1024, (bf16*)(ws + WS_WDN), scr, r, F.lane); }
    }
    bf16* XB = (bf16*)(ws + WS_XB); float* SSQX = (float*)(ws + WS_SSQX);
    for (int m4 = gw; m4 < T / 4; m4 += NGW) { const int m = 4 * m4;
        rows4_to_bf16_ssq(m < TP ? F.in[0] + (size_t)m * DM : F.in[1] + (size_t)(m - TP) * DM, XB + (size_t)m * DM, SSQX + m, F.lane); }
    bf16* MNB = (bf16*)(ws + WS_MNB); float* SSQM = (float*)(ws + WS_SSQM);
    for (int m4 = gw; m4 < MEMR / 4; m4 += NGW) { const int m = 4 * m4; rows4_to_bf16_ssq(F.in[2] + (size_t)m * DM, MNB + (size_t)m * DM, SSQM + m, F.lane); }
}
__device__ __forceinline__ void ssd_unit(Frame& F, int gb, int h) {
    const int tid = F.tid; unsigned char* ws = F.ws;
    const bool prompt = gb < NBP; const int L = prompt ? SEQ : LS; const int sb = gb - NBP; const size_t row_base = prompt ? (size_t)gb * SEQ : (size_t)TP + (size_t)sb * LS;
    const int g = h >> 3;
    LAS float* xs = (LAS float*)(F.lds + RING_OFF);
    LAS float* Bs = xs + 64 * 64;
    LAS float* Cs = Bs + 64 * 128;
    LAS float* ys = Cs + 64 * 128;
    LAS float* dts = ys + 64 * 64;
    LAS float* das = dts + 64;
    const bf16* PROJ = (const bf16*)(ws + WS_PROJ); const float* DTR = (const float*)(ws + WS_DT);
    bf16* YG = (bf16*)(ws + WS_YG); float* SSQ = (float*)(ws + WS_SSQSSD);
    const int p = tid >> 3, n0 = (tid & 7) * 16;
    float hs[16];
    float* state_out = prompt ? F.out + O_SSMP + ((size_t)(gb * 32 + h) * 64 + p) * 128 + n0 : F.out + O_SSMS + ((size_t)(sb * 32 + h) * 64 + p) * 128 + n0;
    if (prompt) {
#pragma unroll
        for (int i = 0; i < 16; ++i) hs[i] = 0.f;
    } else { const float* sp = F.in[3] + ((size_t)(sb * 32 + h) * 64 + p) * 128 + n0;
#pragma unroll
        for (int i = 0; i < 4; ++i) { const f32x4 v = *(const f32x4*)(sp + 4 * i); hs[4 * i] = v.x; hs[4 * i + 1] = v.y; hs[4 * i + 2] = v.z; hs[4 * i + 3] = v.w; } }
    const float a = -__expf(F.in[13][h]), dtb = F.in[12][h], Dk = F.in[14][h];
    int col = 0; LAS float* dst = xs; int dstride = 64;
    if (tid < 64) { col = h * 64 + tid; dst = xs + tid; dstride = 64; }
    else if (tid < 192) { col = 2048 + g * 128 + (tid - 64); dst = Bs + (tid - 64); dstride = 128; }
    else if (tid < 320) { col = 2560 + g * 128 + (tid - 192); dst = Cs + (tid - 192); dstride = 128; }
    float w0 = 0.f, w1 = 0.f, w2 = 0.f, w3 = 0.f, cb = 0.f, r0 = 0.f, r1 = 0.f, r2 = 0.f; const bf16* cptr = PROJ;
    if (tid < 320) { const float* cw = F.in[10]; w0 = cw[col]; w1 = cw[3072 + col]; w2 = cw[2 * 3072 + col]; w3 = cw[3 * 3072 + col]; cb = F.in[11][col];
        cptr = PROJ + (size_t)(S_X0 + (col >> 10)) * SLOT_ELEMS + row_base * 1024 + (col & 1023);
        if (!prompt) { const float* sc = F.in[4] + (size_t)sb * 3 * 3072 + col; r0 = sc[0]; r1 = sc[3072]; r2 = sc[2 * 3072]; } }
    for (int t0 = 0; t0 < L; t0 += 64) {
        const int nt = (L - t0) < 64 ? (L - t0) : 64;
        if (tid < 320) {
            for (int tt = 0; tt < nt; ++tt) { const float raw = bf2f(cptr[(size_t)(t0 + tt) * 1024]); float v = w0 * r0 + w1 * r1 + w2 * r2 + w3 * raw + cb; v = silu_f(v); dst[tt * dstride] = v; r0 = r1; r1 = r2; r2 = raw; }
        } else if (tid < 384) { const int tt = tid - 320;
            if (tt < nt) { const float x = DTR[(row_base + t0 + tt) * 32 + h] + dtb; const float dtv = x > 20.f ? x : log1pf(__expf(x)); dts[tt] = dtv; das[tt] = __expf(dtv * a); } }
        __syncthreads();
        for (int tt = 0; tt < nt; ++tt) {
            const float xv = xs[tt * 64 + p], dtv = dts[tt], dA = das[tt], xd = xv * dtv; float part = 0.f;
#pragma unroll
            for (int i = 0; i < 4; ++i) { const f32x4 bv = *(const LAS f32x4*)(Bs + tt * 128 + n0 + 4 * i), cv = *(const LAS f32x4*)(Cs + tt * 128 + n0 + 4 * i);
                hs[4 * i] = dA * hs[4 * i] + xd * bv.x; hs[4 * i + 1] = dA * hs[4 * i + 1] + xd * bv.y; hs[4 * i + 2] = dA * hs[4 * i + 2] + xd * bv.z; hs[4 * i + 3] = dA * hs[4 * i + 3] + xd * bv.w;
                part += (hs[4 * i] * cv.x + hs[4 * i + 1] * cv.y) + (hs[4 * i + 2] * cv.z + hs[4 * i + 3] * cv.w); }
            part += __shfl_xor(part, 1); part += __shfl_xor(part, 2); part += __shfl_xor(part, 4);
            if ((tid & 7) == 0) ys[tt * 64 + p] = part;
        }
        __syncthreads();
        { const int tt = tid >> 3, p0 = (tid & 7) * 8;
          if (tt < nt) { const size_t row = row_base + t0 + tt;
            const v4u zw = *(const v4u*)(PROJ + (size_t)(S_Z0 + (h >> 4)) * SLOT_ELEMS + row * 1024 + (h & 15) * 64 + p0);
            float o[8]; float sq = 0.f;
#pragma unroll
            for (int j = 0; j < 8; ++j) { const unsigned z16 = (zw[j >> 1] >> ((j & 1) * 16)) & 0xffffu; const float yv = (ys[tt * 64 + p0 + j] + xs[tt * 64 + p0 + j] * Dk) * silu_f(bf2f(z16)); o[j] = yv; sq += yv * yv; }
            v4u ow; ow.x = pk2(o[0], o[1]); ow.y = pk2(o[2], o[3]); ow.z = pk2(o[4], o[5]); ow.w = pk2(o[6], o[7]);
            *(v4u*)(YG + row * 2048 + h * 64 + p0) = ow;
            sq += __shfl_xor(sq, 1); sq += __shfl_xor(sq, 2); sq += __shfl_xor(sq, 4);
            if ((tid & 7) == 0) SSQ[row * 32 + h] = sq; } }
        __syncthreads();
    }
#pragma unroll
    for (int i = 0; i < 4; ++i) *(f32x4*)(state_out + 4 * i) = (f32x4){hs[4 * i], hs[4 * i + 1], hs[4 * i + 2], hs[4 * i + 3]};
}
__device__ __forceinline__ void hgrn_unit(Frame& F, int gb, int hd) {
    const int tid = F.tid; unsigned char* ws = F.ws;
    const bool prompt = gb < NBP; const int L = prompt ? SEQ : LS; const int sb = gb - NBP; const size_t row_base = prompt ? (size_t)gb * SEQ : (size_t)TP + (size_t)sb * LS;
    LAS float* qs = (LAS float*)(F.lds + RING_OFF);
    LAS float* fs = qs + 32 * 128; LAS float* ks = fs + 32 * 128; LAS float* vs = ks + 32 * 128; LAS float* os = vs + 32 * 128;
    const bf16* PROJ = (const bf16*)(ws + WS_PROJ); bf16* ON = (bf16*)(ws + WS_ON);
    const int v = tid >> 2, k0 = (tid & 3) * 32;
    float S[32];
    float* state_out = prompt ? F.out + O_HGP + ((size_t)(gb * 8 + hd) * 128 + k0) * 128 + v : F.out + O_HGS + ((size_t)(sb * 8 + hd) * 128 + k0) * 128 + v;
    if (prompt) {
#pragma unroll
        for (int i = 0; i < 32; ++i) S[i] = 0.f;
    } else { const float* sp = F.in[5] + ((size_t)(sb * 8 + hd) * 128 + k0) * 128 + v;
#pragma unroll
        for (int i = 0; i < 32; ++i) S[i] = sp[(size_t)i * 128]; }
    const int c = tid & 127, part = tid >> 7; const int ch = hd * 128 + c;
    float lb = 0.f; if (part == 1) lb = 1.0f / (1.0f + __expf(F.in[17][1024 + ch] - F.in[17][ch]));
    const bf16* sptr = PROJ + (size_t)(part == 0 ? S_Q : (part == 1 ? S_F : S_I)) * SLOT_ELEMS + row_base * 1024 + ch;
    for (int t0 = 0; t0 < L; t0 += 32) {
        const int nt = (L - t0) < 32 ? (L - t0) : 32;
        if (part < 3) {
            for (int tt = 0; tt < nt; ++tt) { const float raw = bf2f(sptr[(size_t)(t0 + tt) * 1024]);
                if (part == 0) qs[tt * 128 + c] = silu_f(raw);
                else if (part == 1) { const float e = __expf(-raw); const float sg = 1.0f / (1.0f + e); fs[tt * 128 + c] = lb + (1.0f - lb) * sg; ks[tt * 128 + c] = (1.0f - lb) * (e / (1.0f + e)); }
                else vs[tt * 128 + c] = raw; }
        }
        __syncthreads();
        for (int tt = 0; tt < nt; ++tt) {
            const float vv = vs[tt * 128 + v]; float acc = 0.f;
#pragma unroll
            for (int i = 0; i < 8; ++i) { const f32x4 fv = *(const LAS f32x4*)(fs + tt * 128 + k0 + 4 * i), kv = *(const LAS f32x4*)(ks + tt * 128 + k0 + 4 * i), qv = *(const LAS f32x4*)(qs + tt * 128 + k0 + 4 * i);
                S[4 * i] = fv.x * S[4 * i] + kv.x * vv; S[4 * i + 1] = fv.y * S[4 * i + 1] + kv.y * vv; S[4 * i + 2] = fv.z * S[4 * i + 2] + kv.z * vv; S[4 * i + 3] = fv.w * S[4 * i + 3] + kv.w * vv;
                acc += (S[4 * i] * qv.x + S[4 * i + 1] * qv.y) + (S[4 * i + 2] * qv.z + S[4 * i + 3] * qv.w); }
            acc += __shfl_xor(acc, 1); acc += __shfl_xor(acc, 2);
            if ((tid & 3) == 0) os[tt * 128 + v] = acc;
        }
        __syncthreads();
        { const int tt = tid >> 4, v0 = (tid & 15) * 8;
          if (tt < nt) { const size_t row = row_base + t0 + tt; float o[8]; float sq = 0.f;
#pragma unroll
            for (int j = 0; j < 8; ++j) { o[j] = os[tt * 128 + v0 + j]; sq += o[j] * o[j]; }
            sq += __shfl_xor(sq, 1); sq += __shfl_xor(sq, 2); sq += __shfl_xor(sq, 4); sq += __shfl_xor(sq, 8);
            const float rs = 1.0f / sqrtf(sq * (1.0f / 128.0f) + EPS);
            const v4u gw = *(const v4u*)(PROJ + (size_t)S_HG * SLOT_ELEMS + row * 1024 + hd * 128 + v0);
#pragma unroll
            for (int j = 0; j < 8; ++j) { const unsigned g16 = (gw[j >> 1] >> ((j & 1) * 16)) & 0xffffu; o[j] = o[j] * rs * silu_f(bf2f(g16)); }
            v4u ow; ow.x = pk2(o[0], o[1]); ow.y = pk2(o[2], o[3]); ow.z = pk2(o[4], o[5]); ow.w = pk2(o[6], o[7]);
            *(v4u*)(ON + row * 1024 + hd * 128 + v0) = ow; } }
        __syncthreads();
    }
#pragma unroll
    for (int i = 0; i < 32; ++i) state_out[(size_t)i * 128] = S[i];
}
__device__ __forceinline__ void conv_copy_unit(Frame& F, int gb) {
    const bf16* PROJ = (const bf16*)(F.ws + WS_PROJ);
    const bool prompt = gb < NBP; const int sb = gb - NBP;
    const size_t row0 = prompt ? (size_t)gb * SEQ + (SEQ - 3) : (size_t)TP + (size_t)sb * LS + 1;
    float* dst = prompt ? F.out + O_CONVP + (size_t)gb * 3 * 3072 : F.out + O_CONVS + (size_t)sb * 3 * 3072;
    for (int e = F.tid; e < 3 * 3072; e += NTHR) { const int j = e / 3072, col = e % 3072;
        dst[e] = bf2f(PROJ[(size_t)(S_X0 + (col >> 10)) * SLOT_ELEMS + (row0 + j) * 1024 + (col & 1023)]); }
}
__device__ __forceinline__ void ssdnorm_phase(Frame& F) {
    const int gw = F.vcu * NWAVES + F.wave, NGW = F.G * NWAVES; bf16* YG = (bf16*)(F.ws + WS_YG); const float* SSQ = (const float*)(F.ws + WS_SSQSSD);
    for (int row = gw; row < T; row += NGW) {
        const f32x4* sp = (const f32x4*)(SSQ + (size_t)row * 32);
#pragma unroll
        for (int j = 0; j < 4; ++j) { const f32x4 a = sp[2 * j], b = sp[2 * j + 1]; const float s = ((a.x + a.y) + (a.z + a.w)) + ((b.x + b.y) + (b.z + b.w)); const float rs = 1.0f / sqrtf(s * (1.0f / 512.0f) + EPS);
            v4u* p = (v4u*)(YG + (size_t)row * 2048) + j * 64 + F.lane; const v4u w = *p; v4u o;
#pragma unroll
            for (int e = 0; e < 4; ++e) o[e] = pk2(bf2f(w[e] & 0xffffu) * rs, bf2f(w[e] >> 16) * rs);
            *p = o; }
    }
}
typedef float f32x16 __attribute__((ext_vector_type(16)));
#define MFMA32(a, b, c) __builtin_amdgcn_mfma_f32_32x32x16_bf16((a), (b), (c), 0, 0, 0)
__device__ __forceinline__ unsigned cvtpk_c(float lo, float hi) { return pk2(lo, hi); }
__device__ __forceinline__ bf16x8 pack8(float a0, float a1, float a2, float a3, float a4, float a5, float a6, float a7) {
    v4u w; w.x = cvtpk_c(a0, a1); w.y = cvtpk_c(a2, a3); w.z = cvtpk_c(a4, a5); w.w = cvtpk_c(a6, a7); return __builtin_bit_cast(bf16x8, w); }
#define ACC_FRAG(x, s) pack8((x)[8 * (s)], (x)[8 * (s) + 1], (x)[8 * (s) + 2], (x)[8 * (s) + 3], (x)[8 * (s) + 4], (x)[8 * (s) + 5], (x)[8 * (s) + 6], (x)[8 * (s) + 7])
__device__ __forceinline__ bf16x8 lds_frag16(const LAS unsigned char* p) { return *(const LAS bf16x8*)p; }
__device__ __forceinline__ bf16x8 lds_frag8x2(const LAS unsigned char* p) { const v2u lo = *(const LAS v2u*)p, hi = *(const LAS v2u*)(p + 16);
    const v4u w = (v4u){lo.x, lo.y, hi.x, hi.y}; return __builtin_bit_cast(bf16x8, w); }
__device__ __forceinline__ float exp_clamped(float x) { return __expf(fminf(x, 80.0f)); }
#define LDS_BARRIER() do { asm volatile("s_waitcnt lgkmcnt(0)" ::: "memory"); __builtin_amdgcn_s_barrier(); asm volatile("" ::: "memory"); } while (0)
constexpr int HG_QA = 0, HG_KA = 8704, HG_KAT = 17408, HG_VT = 27648, HG_EGM = 37888, HG_EGL = 38400, HG_SEG = 38912, HG_OB = 40960, HG_RAW = 74752;
__device__ __forceinline__ void hgrn_unit_mfma(Frame& F, int gb, int hd) {
    int tid_o = F.tid; asm volatile("" : "+v"(tid_o));
    const int tid = tid_o, lane = tid & 63, w = F.wave, r = lane & 31, hh = lane >> 5; unsigned char* ws = F.ws;
    const bool prompt = gb < NBP; const int L = prompt ? SEQ : LS; const int sb = gb - NBP; const size_t row_base = prompt ? (size_t)gb * SEQ : (size_t)TP + (size_t)sb * LS;
    LAS unsigned char* Lb = F.lds + RING_OFF;
    LAS unsigned short* QA = (LAS unsigned short*)(Lb + HG_QA); LAS unsigned short* KA = (LAS unsigned short*)(Lb + HG_KA);
    LAS unsigned short* KAT = (LAS unsigned short*)(Lb + HG_KAT); LAS unsigned short* VT = (LAS unsigned short*)(Lb + HG_VT);
    LAS float* EGM = (LAS float*)(Lb + HG_EGM); LAS float* EGL = (LAS float*)(Lb + HG_EGL); LAS float* SEG = (LAS float*)(Lb + HG_SEG); LAS float* OB = (LAS float*)(Lb + HG_OB);
    const bf16* PROJ = (const bf16*)(ws + WS_PROJ); bf16* ON = (bf16*)(ws + WS_ON);
    const int vt = w & 3, kh = w >> 2;
    f32x16 S0, S1;
    float* st_g = (prompt ? F.out + O_HGP + (size_t)(gb * 8 + hd) * 16384 : F.out + O_HGS + (size_t)(sb * 8 + hd) * 16384) + 32 * vt + r;
    if (prompt) {
#pragma unroll
        for (int i = 0; i < 16; ++i) { S0[i] = 0.f; S1[i] = 0.f; }
    } else { const float* sp = F.in[5] + (size_t)(sb * 8 + hd) * 16384 + 32 * vt + r;
#pragma unroll
        for (int i = 0; i < 16; ++i) { const int k = 64 * kh + (i & 3) + 8 * (i >> 2) + 4 * hh; S0[i] = sp[(size_t)k * 128]; S1[i] = sp[(size_t)(k + 32) * 128]; } }
    const int c = tid & 127, tq = tid >> 7, ch = hd * 128 + c;
    const float lb = 1.0f / (1.0f + __expf(F.in[17][1024 + ch] - F.in[17][ch]));
    LAS unsigned short* RAW = (LAS unsigned short*)(Lb + HG_RAW);
    const int srow = tid >> 4, sc8 = (tid & 15) * 8;
    const bf16* gsrc = PROJ + row_base * 1024 + hd * 128 + sc8;
    v4u pfF = (v4u){0u, 0u, 0u, 0u}, pfQ = pfF, pfI = pfF;
    if (srow < L) { const size_t o = (size_t)srow * 1024; pfF = *(const v4u*)(gsrc + (size_t)S_F * SLOT_ELEMS + o); pfQ = *(const v4u*)(gsrc + (size_t)S_Q * SLOT_ELEMS + o); pfI = *(const v4u*)(gsrc + (size_t)S_I * SLOT_ELEMS + o); }
    for (int t0 = 0; t0 < L; t0 += 32) {
        int r_l = r, hh_l = hh, c_l = c, tq_l = tq, srow_l = srow, sc8_l = sc8;
        asm volatile("" : "+v"(r_l), "+v"(hh_l), "+v"(c_l), "+v"(tq_l), "+v"(srow_l), "+v"(sc8_l));
        { const int r = r_l, hh = hh_l, c = c_l, tq = tq_l, srow = srow_l, sc8 = sc8_l;
        v4u gw = (v4u){0u, 0u, 0u, 0u};
        if (t0 + (tid >> 4) < L) gw = *(const v4u*)(PROJ + (size_t)S_HG * SLOT_ELEMS + (row_base + t0 + (tid >> 4)) * 1024 + hd * 128 + (tid & 15) * 8);
        *(LAS v4u*)(RAW + srow * 128 + sc8) = pfF; *(LAS v4u*)(RAW + 4096 + srow * 128 + sc8) = pfQ; *(LAS v4u*)(RAW + 8192 + srow * 128 + sc8) = pfI;
        __syncthreads();
        { const int tn = t0 + 32 + srow; pfF = (v4u){0u, 0u, 0u, 0u}; pfQ = pfF; pfI = pfF;
          if (tn < L) { const size_t o = (size_t)tn * 1024; pfF = *(const v4u*)(gsrc + (size_t)S_F * SLOT_ELEMS + o); pfQ = *(const v4u*)(gsrc + (size_t)S_Q * SLOT_ELEMS + o); pfI = *(const v4u*)(gsrc + (size_t)S_I * SLOT_ELEMS + o); } }
        float lc[8], kk[8], qs[8], vi[8]; float run = 0.f;
#pragma unroll
        for (int i = 0; i < 8; ++i) { const int tl = 8 * tq + i; float lf = 0.f, kv = 0.f, qv = 0.f, vv = 0.f;
            if (t0 + tl < L) { const float u = fminf(fmaxf(bf2f(RAW[tl * 128 + c]), -30.f), 30.f); const float sg = __builtin_amdgcn_rcpf(1.0f + __builtin_amdgcn_exp2f(u * -1.4426950408889634f));
                const float fg = lb + (1.0f - lb) * sg; lf = __builtin_amdgcn_logf(fg); kv = 1.0f - fg;
                const float qr = bf2f(RAW[4096 + tl * 128 + c]); qv = qr * __builtin_amdgcn_rcpf(1.0f + __builtin_amdgcn_exp2f(qr * -1.4426950408889634f)); vv = bf2f(RAW[8192 + tl * 128 + c]); }
            run += lf; lc[i] = run; kk[i] = kv; qs[i] = qv; vi[i] = vv; }
        SEG[tq * 128 + c] = run;
        __syncthreads();
        { const float s0 = SEG[c], s1 = SEG[128 + c], s2 = SEG[256 + c], s3 = SEG[384 + c]; const float gm = s0 + s1, gl = (s0 + s1) + (s2 + s3);
          const float pre = tq == 0 ? 0.f : (tq == 1 ? s0 : (tq == 2 ? s0 + s1 : (s0 + s1) + s2));
          float kav[8];
#pragma unroll
          for (int i = 0; i < 8; ++i) { const float d = fminf(fmaxf((pre + lc[i]) - gm, -120.f), 120.f); const float e1 = __builtin_amdgcn_exp2f(d), e2 = __builtin_amdgcn_rcpf(e1);
              const float qa = qs[i] * e1, ka = kk[i] * e2; const int t = 8 * tq + i; const unsigned w2 = pk2(qa, ka);
              QA[t * 136 + c] = (unsigned short)(w2 & 0xffffu); KA[t * 136 + c] = (unsigned short)(w2 >> 16); kav[i] = ka; }
          v4u pk; pk.x = pk2(kav[0], kav[1]); pk.y = pk2(kav[2], kav[3]); pk.z = pk2(kav[4], kav[5]); pk.w = pk2(kav[6], kav[7]); *(LAS v4u*)(KAT + c * 40 + 8 * tq) = pk;
          v4u pv; pv.x = pk2(vi[0], vi[1]); pv.y = pk2(vi[2], vi[3]); pv.z = pk2(vi[4], vi[5]); pv.w = pk2(vi[6], vi[7]); *(LAS v4u*)(VT + c * 40 + 8 * tq) = pv;
          if (tq == 0) { EGM[c] = __builtin_amdgcn_exp2f(gm); EGL[c] = __builtin_amdgcn_exp2f(gl - gm); } }
        __syncthreads();
        {
#pragma unroll
            for (int q4 = 0; q4 < 4; ++q4) { const f32x4 e0 = *(const LAS f32x4*)(EGM + 64 * kh + 8 * q4 + 4 * hh), e1 = *(const LAS f32x4*)(EGM + 64 * kh + 32 + 8 * q4 + 4 * hh);
#pragma unroll
                for (int j = 0; j < 4; ++j) { S0[4 * q4 + j] *= e0[j]; S1[4 * q4 + j] *= e1[j]; } }
            __builtin_amdgcn_sched_barrier(0);
            f32x16 o;
#pragma unroll
            for (int i = 0; i < 16; ++i) o[i] = 0.f;
            const LAS unsigned char* qa_row = Lb + HG_QA + r * 272;
            o = MFMA32(lds_frag8x2(qa_row + (64 * kh + 4 * hh) * 2), ACC_FRAG(S0, 0), o);
            o = MFMA32(lds_frag8x2(qa_row + (64 * kh + 16 + 4 * hh) * 2), ACC_FRAG(S0, 1), o);
            o = MFMA32(lds_frag8x2(qa_row + (64 * kh + 32 + 4 * hh) * 2), ACC_FRAG(S1, 0), o);
            o = MFMA32(lds_frag8x2(qa_row + (64 * kh + 48 + 4 * hh) * 2), ACC_FRAG(S1, 1), o);
            __builtin_amdgcn_sched_barrier(0);
            if (kh == 0) {
                f32x16 X;
#pragma unroll
                for (int i = 0; i < 16; ++i) X[i] = 0.f;
                const LAS unsigned char* ka_nat = Lb + HG_KA + r * 272 + hh * 16; const LAS unsigned char* qa_nat = Lb + HG_QA + r * 272 + hh * 16;
#pragma unroll 2
                for (int ks = 0; ks < 8; ++ks) X = MFMA32(lds_frag16(ka_nat + ks * 32), lds_frag16(qa_nat + ks * 32), X);
#pragma unroll
                for (int i = 0; i < 16; ++i) { const int srow = (i & 3) + 8 * (i >> 2) + 4 * hh; X[i] = (srow <= r) ? X[i] : 0.f; }
                const LAS unsigned char* vt_row = Lb + HG_VT + (32 * vt + r) * 80;
                o = MFMA32(ACC_FRAG(X, 0), lds_frag8x2(vt_row + (4 * hh) * 2), o);
                o = MFMA32(ACC_FRAG(X, 1), lds_frag8x2(vt_row + (16 + 4 * hh) * 2), o);
            }
            __builtin_amdgcn_sched_barrier(0);
            LAS float* ob = OB + (kh * 32) * 132 + 32 * vt + r;
#pragma unroll
            for (int i = 0; i < 16; ++i) ob[((i & 3) + 8 * (i >> 2) + 4 * hh) * 132] = o[i];
            __builtin_amdgcn_sched_barrier(0);
            const LAS unsigned char* kat_nat = Lb + HG_KAT + (64 * kh + r) * 80 + hh * 16; const LAS unsigned char* vt_nat = Lb + HG_VT + (32 * vt + r) * 80 + hh * 16;
#pragma unroll
            for (int s2 = 0; s2 < 2; ++s2) { const bf16x8 b = lds_frag16(vt_nat + s2 * 32); S0 = MFMA32(lds_frag16(kat_nat + s2 * 32), b, S0); S1 = MFMA32(lds_frag16(kat_nat + 32 * 80 + s2 * 32), b, S1); }
__builtin_amdgcn_sched_barrier(0);
#pragma unroll
            for (int q4 = 0; q4 < 4; ++q4) { const f32x4 e0 = *(const LAS f32x4*)(EGL + 64 * kh + 8 * q4 + 4 * hh), e1 = *(const LAS f32x4*)(EGL + 64 * kh + 32 + 8 * q4 + 4 * hh);
#pragma unroll
                for (int j = 0; j < 4; ++j) { S0[4 * q4 + j] *= e0[j]; S1[4 * q4 + j] *= e1[j]; } }
        }
        __syncthreads();
        { const int t = tid >> 4, v0 = (tid & 15) * 8;
          if (t0 + t < L) { const size_t row = row_base + t0 + t; float o[8]; float sq = 0.f;
            const f32x4 a0 = *(const LAS f32x4*)(OB + t * 132 + v0), a1 = *(const LAS f32x4*)(OB + t * 132 + v0 + 4), b0 = *(const LAS f32x4*)(OB + (32 + t) * 132 + v0), b1 = *(const LAS f32x4*)(OB + (32 + t) * 132 + v0 + 4);
#pragma unroll
            for (int j = 0; j < 4; ++j) { o[j] = a0[j] + b0[j]; o[4 + j] = a1[j] + b1[j]; }
#pragma unroll
            for (int j = 0; j < 8; ++j) sq += o[j] * o[j];
            sq += __shfl_xor(sq, 1); sq += __shfl_xor(sq, 2); sq += __shfl_xor(sq, 4); sq += __shfl_xor(sq, 8);
            const float rs = __builtin_amdgcn_rsqf(sq * (1.0f / 128.0f) + EPS);
#pragma unroll
            for (int j = 0; j < 8; ++j) { const unsigned g16 = (gw[j >> 1] >> ((j & 1) * 16)) & 0xffffu; o[j] = o[j] * rs * silu_f(bf2f(g16)); }
            v4u ow; ow.x = pk2(o[0], o[1]); ow.y = pk2(o[2], o[3]); ow.z = pk2(o[4], o[5]); ow.w = pk2(o[6], o[7]);
            *(v4u*)(ON + row * 1024 + hd * 128 + v0) = ow; } }
        }
    }
#pragma unroll
    for (int i = 0; i < 16; ++i) { const int k = 64 * kh + (i & 3) + 8 * (i >> 2) + 4 * hh; st_g[(size_t)k * 128] = S0[i]; st_g[(size_t)(k + 32) * 128] = S1[i]; }
    __syncthreads();
}
constexpr size_t WS_BCS = WS_END, WS_BTT = WS_BCS + (size_t)TP * 1024 * 2, WS_END2 = WS_BTT + (size_t)NBP * 32 * 4 * 128 * 64 * 2;
__device__ __forceinline__ void bc_prep_unit(Frame& F, int b, int c) {
    typedef float f32x2 __attribute__((ext_vector_type(2)));
    int tid_o = F.tid; asm volatile("" : "+v"(tid_o));
    const int tid = tid_o, cg = tid & 127, seg = tid >> 7; unsigned char* ws = F.ws;
    const bf16* src = (const bf16*)(ws + WS_PROJ) + (size_t)S_X2 * SLOT_ELEMS + (size_t)b * SEQ * 1024 + 8 * cg;
    bf16* BCS = (bf16*)(ws + WS_BCS); bf16* BTT = (bf16*)(ws + WS_BTT);
    const float* cw = F.in[10] + 2048 + 8 * cg; const float* cbp = F.in[11] + 2048 + 8 * cg;
#pragma unroll 1
    for (int half = 0; half < 2; ++half) {
        const int s0 = 16 * seg + 8 * half;
        v4u raw[11];
#pragma unroll
        for (int i = 0; i < 11; ++i) { const int gt = 64 * c + s0 - 3 + i; raw[i] = (v4u){0u, 0u, 0u, 0u}; if (gt >= 0) raw[i] = *(const v4u*)(src + (size_t)gt * 1024); }
        v4u rowpk[8];
#pragma unroll
        for (int kp = 0; kp < 4; ++kp) {
            const f32x2 cw0 = *(const f32x2*)(cw + 2 * kp), cw1 = *(const f32x2*)(cw + 3072 + 2 * kp), cw2 = *(const f32x2*)(cw + 2 * 3072 + 2 * kp), cw3 = *(const f32x2*)(cw + 3 * 3072 + 2 * kp), cbb = *(const f32x2*)(cbp + 2 * kp);
            f32x2 xv[11];
#pragma unroll
            for (int i = 0; i < 11; ++i) { const unsigned wd = raw[i][kp]; xv[i] = (f32x2){__uint_as_float(wd << 16), __uint_as_float(wd & 0xffff0000u)}; }
            f32x2 o[8];
#pragma unroll
            for (int i = 0; i < 8; ++i) { f32x2 a = cw0 * xv[i] + cbb; a = cw1 * xv[i + 1] + a; a = cw2 * xv[i + 2] + a; a = cw3 * xv[i + 3] + a;
                const f32x2 t = a * (-1.4426950408889634f); f32x2 e; e.x = __builtin_amdgcn_exp2f(t.x); e.y = __builtin_amdgcn_exp2f(t.y); e = e + 1.0f;
                f32x2 rc; rc.x = __builtin_amdgcn_rcpf(e.x); rc.y = __builtin_amdgcn_rcpf(e.y); o[i] = a * rc; }
#pragma unroll
            for (int i = 0; i < 8; ++i) rowpk[i][kp] = pk2(o[i].x, o[i].y);
            if (cg < 64) { const int ng = 8 * cg + 2 * kp, g = ng >> 7, n = ng & 127;
                bf16* dst = BTT + ((size_t)(((b * 32 + c) * 4 + g) * 128 + n)) * 64 + s0;
                v4u pa; pa.x = pk2(o[0].x, o[1].x); pa.y = pk2(o[2].x, o[3].x); pa.z = pk2(o[4].x, o[5].x); pa.w = pk2(o[6].x, o[7].x); *(v4u*)dst = pa;
                v4u pb; pb.x = pk2(o[0].y, o[1].y); pb.y = pk2(o[2].y, o[3].y); pb.z = pk2(o[4].y, o[5].y); pb.w = pk2(o[6].y, o[7].y); *(v4u*)(dst + 64) = pb; }
        }
        bf16* drow = BCS + ((size_t)b * SEQ + 64 * c + s0) * 1024 + 8 * cg;
#pragma unroll
        for (int i = 0; i < 8; ++i) *(v4u*)(drow + (size_t)i * 1024) = rowpk[i];
    }
}
__device__ __forceinline__ void bc_prep_phase(Frame& F) { for (int u = F.vcu; u < NBP * 32; u += F.G) bc_prep_unit(F, u >> 5, u & 31); }
constexpr size_t WS_HVT = WS_XB, WS_EGM = WS_END2, WS_EGL = WS_EGM + (size_t)NBP * 64 * 1024 * 4, WS_END3 = WS_EGL + (size_t)NBP * 64 * 1024 * 4;
__device__ __forceinline__ void hg_prep_unit(Frame& F, int b, int c) {
    typedef float f32x2 __attribute__((ext_vector_type(2)));
    int tid_o = F.tid; asm volatile("" : "+v"(tid_o));
    const int tid = tid_o; unsigned char* ws = F.ws;
    const int ch = 2 * tid, hd = ch >> 7, k = ch & 127;
    const size_t row0 = (size_t)b * SEQ + 32 * c;
    bf16* QS = (bf16*)(ws + WS_PROJ) + (size_t)S_Q * SLOT_ELEMS + row0 * 1024 + ch; bf16* FS = (bf16*)(ws + WS_PROJ) + (size_t)S_F * SLOT_ELEMS + row0 * 1024 + ch;
    bf16* IS = (bf16*)(ws + WS_PROJ) + (size_t)S_I * SLOT_ELEMS + row0 * 1024;
    const f32x2 l0 = *(const f32x2*)(F.in[17] + ch), l1 = *(const f32x2*)(F.in[17] + 1024 + ch);
    f32x2 lb; lb.x = __builtin_amdgcn_rcpf(1.0f + __expf(l1.x - l0.x)); lb.y = __builtin_amdgcn_rcpf(1.0f + __expf(l1.y - l0.y));
    const f32x2 omlb = 1.0f - lb;
    f32x2 P[32]; f32x2 run = (f32x2){1.0f, 1.0f};
#pragma unroll
    for (int t = 0; t < 32; ++t) { const unsigned wd = *(const unsigned*)(FS + (size_t)t * 1024);
        f32x2 u = (f32x2){__uint_as_float(wd << 16), __uint_as_float(wd & 0xffff0000u)}; u.x = fminf(fmaxf(u.x, -30.f), 30.f); u.y = fminf(fmaxf(u.y, -30.f), 30.f);
        const f32x2 tt = u * (-1.4426950408889634f); f32x2 e; e.x = __builtin_amdgcn_exp2f(tt.x); e.y = __builtin_amdgcn_exp2f(tt.y); e = e + 1.0f;
        f32x2 sg; sg.x = __builtin_amdgcn_rcpf(e.x); sg.y = __builtin_amdgcn_rcpf(e.y);
        const f32x2 fg = lb + omlb * sg; run = run * fg; run.x = fmaxf(run.x, 1e-30f); run.y = fmaxf(run.y, 1e-30f); P[t] = run; }
    const f32x2 Pm = P[15], Pl = P[31]; f32x2 rPm; rPm.x = __builtin_amdgcn_rcpf(Pm.x); rPm.y = __builtin_amdgcn_rcpf(Pm.y);
    *(f32x2*)((float*)(ws + WS_EGM) + (size_t)(b * 64 + c) * 1024 + ch) = Pm; *(f32x2*)((float*)(ws + WS_EGL) + (size_t)(b * 64 + c) * 1024 + ch) = Pl * rPm;
    unsigned kx[16], ky[16], vx[16], vy[16];
    f32x2 rPprev = (f32x2){1.0f, 1.0f}; f32x2 kprev = (f32x2){0.f, 0.f}; unsigned iprev = 0u;
#pragma unroll
    for (int t = 0; t < 32; ++t) { f32x2 rP; rP.x = __builtin_amdgcn_rcpf(P[t].x); rP.y = __builtin_amdgcn_rcpf(P[t].y);
        const f32x2 e1 = P[t] * rPm, e2 = Pm * rP, fg = P[t] * rPprev, kk = 1.0f - fg; rPprev = rP;
        const unsigned qw = *(const unsigned*)(QS + (size_t)t * 1024); const f32x2 q = (f32x2){__uint_as_float(qw << 16), __uint_as_float(qw & 0xffff0000u)};
        const f32x2 tq = q * (-1.4426950408889634f); f32x2 eq; eq.x = __builtin_amdgcn_exp2f(tq.x); eq.y = __builtin_amdgcn_exp2f(tq.y); eq = eq + 1.0f;
        f32x2 rq; rq.x = __builtin_amdgcn_rcpf(eq.x); rq.y = __builtin_amdgcn_rcpf(eq.y);
        const f32x2 qa = q * rq * e1, ka = kk * e2;
        *(unsigned*)(QS + (size_t)t * 1024) = pk2(qa.x, qa.y); *(unsigned*)(FS + (size_t)t * 1024) = pk2(ka.x, ka.y);
        const unsigned iw = *(const unsigned*)(IS + (size_t)t * 1024 + ch);
        if (t & 1) { kx[t >> 1] = pk2(kprev.x, ka.x); ky[t >> 1] = pk2(kprev.y, ka.y); vx[t >> 1] = (iprev & 0xffffu) | (iw << 16); vy[t >> 1] = (iprev >> 16) | (iw & 0xffff0000u); }
        kprev = ka; iprev = iw; }
    bf16* VTg = (bf16*)(ws + WS_HVT) + ((size_t)((b * 64 + c) * 8 + hd) * 128 + k) * 32;
#pragma unroll
    for (int j = 0; j < 4; ++j) { *(v4u*)(VTg + 8 * j) = (v4u){vx[4 * j], vx[4 * j + 1], vx[4 * j + 2], vx[4 * j + 3]}; *(v4u*)(VTg + 32 + 8 * j) = (v4u){vy[4 * j], vy[4 * j + 1], vy[4 * j + 2], vy[4 * j + 3]}; }
    __syncthreads();
    bf16* KTg = IS + ((size_t)hd * 128 + k) * 32;
#pragma unroll
    for (int j = 0; j < 4; ++j) { *(v4u*)(KTg + 8 * j) = (v4u){kx[4 * j], kx[4 * j + 1], kx[4 * j + 2], kx[4 * j + 3]}; *(v4u*)(KTg + 32 + 8 * j) = (v4u){ky[4 * j], ky[4 * j + 1], ky[4 * j + 2], ky[4 * j + 3]}; }
    __syncthreads();
}
__device__ __forceinline__ void hg_prep_phase(Frame& F) { for (int u = F.vcu; u < NBP * 64; u += F.G) hg_prep_unit(F, u >> 6, u & 63); }
constexpr int HV_QA = 0, HV_KA = 8704, HV_KAT = 17408, HV_VT = 27648, HV_EGM = 30208, HV_EGL = 30720, HV_PBUF = 31232, HV_OB = 2 * HV_PBUF, HV_OBUF = 23040;
constexpr size_t WS_SSQH = WS_END3, WS_END4 = WS_SSQH + (size_t)T * 32 * 4;
__device__ __forceinline__ void hgrn_v_unit(Frame& F, int b, int hd, int vt) {
    int tid_o = F.tid; asm volatile("" : "+v"(tid_o));
    const int tid = tid_o, lane = tid & 63, w = F.wave, r = lane & 31, hh = lane >> 5; unsigned char* ws = F.ws;
    LAS unsigned char* Lb = F.lds + RING_OFF;
    const bf16* PROJ = (const bf16*)(ws + WS_PROJ); bf16* OU = (bf16*)(ws + WS_ON); float* SSQH = (float*)(ws + WS_SSQH);
    const size_t rowb = (size_t)b * SEQ;
    const bf16* qsrc = PROJ + (size_t)S_Q * SLOT_ELEMS + (rowb + (tid >> 4)) * 1024 + hd * 128 + 8 * (tid & 15);
    const bf16* ksrc = PROJ + (size_t)S_F * SLOT_ELEMS + (rowb + (tid >> 4)) * 1024 + hd * 128 + 8 * (tid & 15);
    const bf16* tsrc = PROJ + (size_t)S_I * SLOT_ELEMS + rowb * 1024 + (size_t)(hd * 128 + (tid >> 2)) * 32 + 8 * (tid & 3);
    const unsigned char* xsrc = nullptr; size_t xstr = 0;
    if (tid < 128) { xsrc = (const unsigned char*)((const bf16*)(ws + WS_HVT) + ((size_t)(b * 64 * 8 + hd) * 128 + 32 * vt + (tid >> 2)) * 32 + 8 * (tid & 3)); xstr = (size_t)8 * 128 * 32 * 2; }
    else if (tid < 160) { xsrc = (const unsigned char*)((const float*)(ws + WS_EGM) + (size_t)b * 64 * 1024 + hd * 128 + 4 * (tid - 128)); xstr = 4096; }
    else if (tid < 192) { xsrc = (const unsigned char*)((const float*)(ws + WS_EGL) + (size_t)b * 64 * 1024 + hd * 128 + 4 * (tid - 160)); xstr = 4096; }
    const int xdst = tid < 128 ? HV_VT + (tid >> 2) * 80 + 16 * (tid & 3) : (tid < 160 ? HV_EGM + 16 * (tid - 128) : HV_EGL + 16 * (tid - 160));
#define HGV_LOAD(cc, pq, pk, pt, px) { pq = *(const v4u*)(qsrc + (size_t)(cc) * 32 * 1024); pk = *(const v4u*)(ksrc + (size_t)(cc) * 32 * 1024); pt = *(const v4u*)(tsrc + (size_t)(cc) * 32768); if (tid < 192) px = *(const v4u*)(xsrc + (size_t)(cc) * xstr); }
#define HGV_STORE(pb, pq, pk, pt, px) { *(LAS v4u*)((pb) + HV_QA + (tid >> 4) * 272 + 16 * (tid & 15)) = pq; *(LAS v4u*)((pb) + HV_KA + (tid >> 4) * 272 + 16 * (tid & 15)) = pk; \
        *(LAS v4u*)((pb) + HV_KAT + (tid >> 2) * 80 + 16 * (tid & 3)) = pt; if (tid < 192) *(LAS v4u*)((pb) + xdst) = px; }
    v4u pqA, pkA, ptA, pxA = (v4u){0u, 0u, 0u, 0u}, pqB, pkB, ptB, pxB = (v4u){0u, 0u, 0u, 0u};
    HGV_LOAD(0, pqA, pkA, ptA, pxA) HGV_STORE(Lb, pqA, pkA, ptA, pxA)
    HGV_LOAD(1, pqA, pkA, ptA, pxA) HGV_LOAD(2, pqB, pkB, ptB, pxB)
    const int kt = w;
    f32x16 S;
#pragma unroll
    for (int i = 0; i < 16; ++i) S[i] = 0.f;
    __syncthreads();
#define HGV_ITER(c, pq, pk, pt, px) { \
        int r_l = r, hh_l = hh, tid_l = tid; asm volatile("" : "+v"(r_l), "+v"(hh_l), "+v"(tid_l)); \
        { const int r = r_l, hh = hh_l, tid = tid_l; \
        LAS unsigned char* pbc = Lb + ((c) & 1) * HV_PBUF; LAS unsigned char* pbn = Lb + (((c) + 1) & 1) * HV_PBUF; \
        if ((c) < 63) { HGV_STORE(pbn, pq, pk, pt, px) if ((c) < 61) HGV_LOAD((c) + 3, pq, pk, pt, px) } \
        if (w < 4) { \
            LAS float* EGM = (LAS float*)(pbc + HV_EGM); LAS float* EGL = (LAS float*)(pbc + HV_EGL); LAS float* OB = (LAS float*)(Lb + HV_OB + ((c) & 1) * HV_OBUF); \
            _Pragma("unroll") \
            for (int q4 = 0; q4 < 4; ++q4) { const f32x4 e0 = *(const LAS f32x4*)(EGM + 32 * kt + 8 * q4 + 4 * hh); \
                _Pragma("unroll") \
                for (int j = 0; j < 4; ++j) S[4 * q4 + j] *= e0[j]; } \
            f32x16 o; \
            _Pragma("unroll") \
            for (int i = 0; i < 16; ++i) o[i] = 0.f; \
            const LAS unsigned char* qa_row = pbc + HV_QA + r * 272; \
            o = MFMA32(lds_frag8x2(qa_row + (32 * kt + 4 * hh) * 2), ACC_FRAG(S, 0), o); \
            o = MFMA32(lds_frag8x2(qa_row + (32 * kt + 16 + 4 * hh) * 2), ACC_FRAG(S, 1), o); \
            LAS float* ob = OB + (kt * 32) * 36 + r; \
            _Pragma("unroll") \
            for (int i = 0; i < 16; ++i) ob[((i & 3) + 8 * (i >> 2) + 4 * hh) * 36] = o[i]; \
            const LAS unsigned char* kat_nat = pbc + HV_KAT + (32 * kt + r) * 80 + hh * 16; const LAS unsigned char* vt_nat = pbc + HV_VT + r * 80 + hh * 16; \
            S = MFMA32(lds_frag16(kat_nat), lds_frag16(vt_nat), S); S = MFMA32(lds_frag16(kat_nat + 32), lds_frag16(vt_nat + 32), S); \
            _Pragma("unroll") \
            for (int q4 = 0; q4 < 4; ++q4) { const f32x4 e0 = *(const LAS f32x4*)(EGL + 32 * kt + 8 * q4 + 4 * hh); \
                _Pragma("unroll") \
                for (int j = 0; j < 4; ++j) S[4 * q4 + j] *= e0[j]; } \
        } else { \
            if (w == 4) { LAS float* OB = (LAS float*)(Lb + HV_OB + ((c) & 1) * HV_OBUF); f32x16 o; \
                _Pragma("unroll") \
                for (int i = 0; i < 16; ++i) o[i] = 0.f; \
                f32x16 X; \
                _Pragma("unroll") \
                for (int i = 0; i < 16; ++i) X[i] = 0.f; \
                const LAS unsigned char* ka_nat = pbc + HV_KA + r * 272 + hh * 16; const LAS unsigned char* qa_nat = pbc + HV_QA + r * 272 + hh * 16; \
                _Pragma("unroll 2") \
                for (int ks = 0; ks < 8; ++ks) X = MFMA32(lds_frag16(ka_nat + ks * 32), lds_frag16(qa_nat + ks * 32), X); \
                _Pragma("unroll") \
                for (int i = 0; i < 16; ++i) { const int srow = (i & 3) + 8 * (i >> 2) + 4 * hh; X[i] = (srow <= r) ? X[i] : 0.f; } \
                const LAS unsigned char* vt_row = pbc + HV_VT + r * 80; \
                o = MFMA32(ACC_FRAG(X, 0), lds_frag8x2(vt_row + (4 * hh) * 2), o); \
                o = MFMA32(ACC_FRAG(X, 1), lds_frag8x2(vt_row + (16 + 4 * hh) * 2), o); \
                LAS float* ob4 = OB + (4 * 32) * 36 + r; \
                _Pragma("unroll") \
                for (int i = 0; i < 16; ++i) ob4[((i & 3) + 8 * (i >> 2) + 4 * hh) * 36] = o[i]; \
            } \
            if ((c) > 0) { HGV_OUT((c) - 1) } \
        } \
        LDS_BARRIER(); \
        } }
#define HGV_OUT(cp) { const LAS float* OB = (const LAS float*)(Lb + HV_OB + ((cp) & 1) * HV_OBUF); const int tl = tid - 256, t = tl >> 3, v0 = (tl & 7) * 4; const size_t row = rowb + 32 * (cp) + t; \
            const f32x4 a = *(const LAS f32x4*)(OB + t * 36 + v0), b2 = *(const LAS f32x4*)(OB + (32 + t) * 36 + v0), c2 = *(const LAS f32x4*)(OB + (64 + t) * 36 + v0), d2 = *(const LAS f32x4*)(OB + (96 + t) * 36 + v0), e2 = *(const LAS f32x4*)(OB + (128 + t) * 36 + v0); \
            const f32x4 o4 = ((a + b2) + (c2 + d2)) + e2; \
            float sq = (o4.x * o4.x + o4.y * o4.y) + (o4.z * o4.z + o4.w * o4.w); sq += __shfl_xor(sq, 1); sq += __shfl_xor(sq, 2); sq += __shfl_xor(sq, 4); \
            if ((tl & 7) == 0) SSQH[row * 32 + hd * 4 + vt] = sq; \
            v2u ow; ow.x = pk2(o4.x, o4.y); ow.y = pk2(o4.z, o4.w); *(v2u*)(OU + row * 1024 + hd * 128 + 32 * vt + v0) = ow; }
#pragma unroll 1
    for (int cc = 0; cc < 64; cc += 2) { HGV_ITER(cc, pqA, pkA, ptA, pxA) HGV_ITER(cc + 1, pqB, pkB, ptB, pxB) }
    if (w >= 4) HGV_OUT(63)
#undef HGV_ITER
#undef HGV_OUT
#undef HGV_LOAD
#undef HGV_STORE
    if (w < 4) { float* st_g = F.out + O_HGP + (size_t)(b * 8 + hd) * 16384 + 32 * vt + r;
#pragma unroll
        for (int i = 0; i < 16; ++i) { const int k = 32 * kt + (i & 3) + 8 * (i >> 2) + 4 * hh; st_g[(size_t)k * 128] = S[i]; } }
    __syncthreads();
}
__device__ __forceinline__ void hgnorm_phase(Frame& F) {
    const int gw = F.vcu * NWAVES + F.wave, NGW = F.G * NWAVES; bf16* ON = (bf16*)(F.ws + WS_ON); const float* SSQH = (const float*)(F.ws + WS_SSQH);
    const bf16* HG = (const bf16*)(F.ws + WS_PROJ) + (size_t)S_HG * SLOT_ELEMS;
    for (int row = gw; row < TP; row += NGW) {
#pragma unroll
        for (int j = 0; j < 2; ++j) { const int pc = j * 64 + F.lane, hd = pc >> 4;
            const f32x4 sp = *(const f32x4*)(SSQH + (size_t)row * 32 + hd * 4); const float rs = __builtin_amdgcn_rsqf(((sp.x + sp.y) + (sp.z + sp.w)) * (1.0f / 128.0f) + EPS);
            v4u* p = (v4u*)(ON + (size_t)row * 1024) + pc; const v4u o = *p; const v4u g = *((const v4u*)(HG + (size_t)row * 1024) + pc); v4u res;
#pragma unroll
            for (int e = 0; e < 4; ++e) res[e] = pk2(bf2f(o[e] & 0xffffu) * rs * silu_f(bf2f(g[e] & 0xffffu)), __uint_as_float(o[e] & 0xffff0000u) * rs * silu_f(__uint_as_float(g[e] & 0xffff0000u)));
            *p = res; }
    }
}
constexpr int SD_BN = 0, SD_CN = 17408, SD_BT = 34816, SD_XT = 53248, SD_HT = 62464, SD_YA = 97280, SD_YY = 113664, SD_YO = 130048, SD_CUM = 134144, SD_DTV = 134400, SD_ECUM = 134656, SD_XWT = 134912, SD_CWL = 144128;
__device__ __forceinline__ void ssd_unit_mfma(Frame& F, int gb, int h) {
    int tid_o = F.tid; asm volatile("" : "+v"(tid_o));
    const int tid = tid_o, lane = tid & 63, w = F.wave, r = lane & 31, hh = lane >> 5; unsigned char* ws = F.ws;
    const bool prompt = gb < NBP; const int L = prompt ? SEQ : LS; const int sb = gb - NBP; const size_t row_base = prompt ? (size_t)gb * SEQ : (size_t)TP + (size_t)sb * LS;
    const int g = h >> 3;
    LAS unsigned char* Lb = F.lds + RING_OFF;
    LAS unsigned short* BN = (LAS unsigned short*)(Lb + SD_BN); LAS unsigned short* CN = (LAS unsigned short*)(Lb + SD_CN);
    LAS unsigned short* BT = (LAS unsigned short*)(Lb + SD_BT); LAS unsigned short* XT = (LAS unsigned short*)(Lb + SD_XT);
    LAS unsigned short* HT = (LAS unsigned short*)(Lb + SD_HT);
    LAS unsigned short* XWT = (LAS unsigned short*)(Lb + SD_XWT);
    LAS float* YA = (LAS float*)(Lb + SD_YA); LAS float* YY = (LAS float*)(Lb + SD_YY); LAS unsigned short* YO = (LAS unsigned short*)(Lb + SD_YO);
    LAS float* CUM = (LAS float*)(Lb + SD_CUM); LAS float* DTV = (LAS float*)(Lb + SD_DTV); LAS float* ECUM = (LAS float*)(Lb + SD_ECUM);
    const bf16* PROJ = (const bf16*)(ws + WS_PROJ); const float* DTR = (const float*)(ws + WS_DT); bf16* YG = (bf16*)(ws + WS_YG); float* SSQ = (float*)(ws + WS_SSQSSD);
    const int nt = w >> 1, pt = w & 1;
    f32x16 H;
    float* st_g = (prompt ? F.out + O_SSMP + (size_t)(gb * 32 + h) * 8192 : F.out + O_SSMS + (size_t)(sb * 32 + h) * 8192) + (size_t)(32 * pt + r) * 128 + 32 * nt + 4 * hh;
    if (prompt) {
#pragma unroll
        for (int i = 0; i < 16; ++i) H[i] = 0.f;
    } else { const float* sp = F.in[3] + (size_t)(sb * 32 + h) * 8192 + (size_t)(32 * pt + r) * 128 + 32 * nt + 4 * hh;
#pragma unroll
        for (int q4 = 0; q4 < 4; ++q4) { const f32x4 v = *(const f32x4*)(sp + 8 * q4); H[4 * q4] = v.x; H[4 * q4 + 1] = v.y; H[4 * q4 + 2] = v.z; H[4 * q4 + 3] = v.w; } }
    {
        LAS unsigned short* hp = HT + (32 * pt + r) * 136 + 32 * nt + 4 * hh;
#pragma unroll
        for (int q4 = 0; q4 < 4; ++q4) { v2u pk; pk.x = cvtpk_c(H[4 * q4], H[4 * q4 + 1]); pk.y = cvtpk_c(H[4 * q4 + 2], H[4 * q4 + 3]); *(LAS v2u*)(hp + 8 * q4) = pk; }
    }
    const float a = -__expf(F.in[13][h]), dtb = F.in[12][h], Dk = F.in[14][h];
    const float* cw = F.in[10]; const float* cbp = F.in[11]; const float* sconv = F.in[4] + (size_t)(prompt ? 0 : sb) * 3 * 3072;
    const int cgl = tid & 7, xs = tid >> 3;
    const int col = h * 64 + 8 * cgl;
    const bf16* cptr = PROJ + (size_t)(S_X0 + (col >> 10)) * SLOT_ELEMS + row_base * 1024 + (col & 1023);
    const bf16* BCS = (const bf16*)(ws + WS_BCS) + row_base * 1024 + g * 128; const bf16* BTT = (const bf16*)(ws + WS_BTT) + (size_t)(gb * 32 * 4 + g) * 128 * 64;
    v4u xr[4], pc[6];
#pragma unroll
    for (int i = 0; i < 4; ++i) { const int gt = xs - 3 + i; xr[i] = (v4u){0u, 0u, 0u, 0u}; if (gt >= 0) xr[i] = *(const v4u*)(cptr + (size_t)gt * 1024); }
#pragma unroll
    for (int j = 0; j < 6; ++j) { const int idx = (tid + 512 * j) & 1023;
        if (j < 4) pc[j] = *(const v4u*)(BCS + (size_t)(idx >> 4) * 1024 + (j >> 1) * 512 + 8 * (idx & 15));
        else pc[j] = *(const v4u*)(BTT + (size_t)(idx >> 3) * 64 + 8 * (idx & 7)); }
    LAS float* CWL = (LAS float*)(Lb + SD_CWL);
    if (tid < 320) { const int j = tid >> 6, c = tid & 63; CWL[tid] = j < 4 ? cw[j * 3072 + h * 64 + c] : cbp[h * 64 + c]; }
    __syncthreads();
    int buf = 0;
    float dt_pf = 0.f;
    if (lane < L) dt_pf = DTR[(row_base + lane) * 32 + h];
    for (int t0 = 0; t0 < L; t0 += 64, buf ^= 1) {
        int r_l = r, hh_l = hh, tid_l = tid, lane_l = lane;
        asm volatile("" : "+v"(r_l), "+v"(hh_l), "+v"(tid_l), "+v"(lane_l));
        { const int r = r_l, hh = hh_l, tid = tid_l, lane = lane_l;
        float dtv = 0.f;
        if (t0 + lane < L) { const float x = dt_pf + dtb; dtv = fmaxf(x, 0.f) + 0.6931471805599453f * __builtin_amdgcn_logf(1.0f + __builtin_amdgcn_exp2f(-1.4426950408889634f * fabsf(x))); }
        dt_pf = 0.f; if (t0 + 64 + lane < L) dt_pf = DTR[(row_base + t0 + 64 + lane) * 32 + h];
        v4u zw = (v4u){0u, 0u, 0u, 0u};
        if (t0 + (tid >> 3) < L) zw = *(const v4u*)(PROJ + (size_t)(S_Z0 + (h >> 4)) * SLOT_ELEMS + (row_base + t0 + (tid >> 3)) * 1024 + (h & 15) * 64 + (tid & 7) * 8);
        float cum = dtv * a;
#pragma unroll
        for (int o = 1; o < 64; o <<= 1) { const float u = __shfl_up(cum, o); if (lane >= o) cum += u; }
        const float cum_last = __shfl(cum, 63);
        const float wgt = __expf(cum_last - cum) * dtv;
        if (w == 0) { CUM[lane] = cum; DTV[lane] = dtv; ECUM[lane] = __expf(cum); }
#pragma unroll
        for (int j = 0; j < 6; ++j) { const int idx = (tid + 512 * j) & 1023;
            if (j < 2) *(LAS v4u*)(BN + (idx >> 4) * 136 + 8 * (idx & 15)) = pc[j];
            else if (j < 4) *(LAS v4u*)(CN + (idx >> 4) * 136 + 8 * (idx & 15)) = pc[j];
            else *(LAS v4u*)(BT + (idx >> 3) * 72 + 8 * (idx & 7)) = pc[j]; }
        { const int xs = tid >> 3, cgl = tid & 7; const float wx = __shfl(wgt, xs); typedef float f32x2 __attribute__((ext_vector_type(2)));
#pragma unroll
          for (int kp = 0; kp < 4; ++kp) {
              const LAS float* wl = CWL + 8 * cgl + 2 * kp;
              const f32x2 cw0 = *(const LAS f32x2*)wl, cw1 = *(const LAS f32x2*)(wl + 64), cw2 = *(const LAS f32x2*)(wl + 128), cw3 = *(const LAS f32x2*)(wl + 192), cbb = *(const LAS f32x2*)(wl + 256);
              f32x2 xv[4];
#pragma unroll
              for (int i = 0; i < 4; ++i) { const unsigned wd = xr[i][kp]; xv[i] = (f32x2){__uint_as_float(wd << 16), __uint_as_float(wd & 0xffff0000u)}; }
              f32x2 a = cw0 * xv[0] + cbb; a = cw1 * xv[1] + a; a = cw2 * xv[2] + a; a = cw3 * xv[3] + a;
              const f32x2 t = a * (-1.4426950408889634f); f32x2 e; e.x = __builtin_amdgcn_exp2f(t.x); e.y = __builtin_amdgcn_exp2f(t.y); e = e + 1.0f;
              f32x2 rc; rc.x = __builtin_amdgcn_rcpf(e.x); rc.y = __builtin_amdgcn_rcpf(e.y); const f32x2 o = a * rc, ow = o * wx;
              const unsigned po = pk2(o.x, o.y), pw = pk2(ow.x, ow.y); const int p = 8 * cgl + 2 * kp;
              XT[p * 72 + xs] = (unsigned short)(po & 0xffffu); XT[(p + 1) * 72 + xs] = (unsigned short)(po >> 16);
              XWT[p * 72 + xs] = (unsigned short)(pw & 0xffffu); XWT[(p + 1) * 72 + xs] = (unsigned short)(pw >> 16); }
        }
        if (t0 + 64 < L) {
#pragma unroll
            for (int i = 0; i < 4; ++i) xr[i] = *(const v4u*)(cptr + (size_t)(t0 + 64 + (tid >> 3) - 3 + i) * 1024);
            const int chn = (t0 >> 6) + 1;
#pragma unroll
            for (int j = 0; j < 6; ++j) { const int idx = (tid + 512 * j) & 1023;
                if (j < 4) pc[j] = *(const v4u*)(BCS + (size_t)(t0 + 64 + (idx >> 4)) * 1024 + (j >> 1) * 512 + 8 * (idx & 15));
                else pc[j] = *(const v4u*)(BTT + ((size_t)chn * 4 * 128 + (idx >> 3)) * 64 + 8 * (idx & 7)); }
        }
        LDS_BARRIER();
        if (w < 4 || w >= 6) {
            const int tt = w < 4 ? (w >> 1) : 1, st = w < 4 ? tt : 0, ptj = w & 1;
            f32x16 X, ya;
#pragma unroll
            for (int i = 0; i < 16; ++i) { X[i] = 0.f; ya[i] = 0.f; }
            const LAS unsigned char* cn_nat = Lb + SD_CN + (32 * tt + r) * 272 + hh * 16; const LAS unsigned char* bn_nat = Lb + SD_BN + (32 * st + r) * 272 + hh * 16;
#pragma unroll 2
            for (int ks = 0; ks < 8; ++ks) X = MFMA32(lds_frag16(bn_nat + ks * 32), lds_frag16(cn_nat + ks * 32), X);
            const float cum_t = CUM[32 * tt + r];
#pragma unroll
            for (int q4 = 0; q4 < 4; ++q4) { const f32x4 cs = *(const LAS f32x4*)(CUM + 32 * st + 8 * q4 + 4 * hh), ds = *(const LAS f32x4*)(DTV + 32 * st + 8 * q4 + 4 * hh);
#pragma unroll
                for (int jj = 0; jj < 4; ++jj) { const int s_abs = 32 * st + 8 * q4 + 4 * hh + jj; const float f = __expf(fminf(cum_t - cs[jj], 0.f)) * ds[jj]; X[4 * q4 + jj] = (s_abs <= 32 * tt + r) ? X[4 * q4 + jj] * f : 0.f; } }
            const LAS unsigned char* xt_row = Lb + SD_XT + (32 * ptj + r) * 144 + (32 * st + 4 * hh) * 2;
            ya = MFMA32(ACC_FRAG(X, 0), lds_frag8x2(xt_row), ya);
            ya = MFMA32(ACC_FRAG(X, 1), lds_frag8x2(xt_row + 32), ya);
            if (w < 4) { LAS float* yb = YA + (32 * tt + 4 * hh) * 64 + 32 * ptj + r;
#pragma unroll
                for (int i = 0; i < 16; ++i) yb[((i & 3) + 8 * (i >> 2)) * 64] = ya[i]; }
            else { LAS unsigned short* yb = YO + (4 * hh) * 64 + 32 * ptj + r;
#pragma unroll
                for (int i = 0; i < 16; ++i) yb[((i & 3) + 8 * (i >> 2)) * 64] = (unsigned short)f2bf(ya[i]); }
        } else {
            const int ptj = w & 1;
            const LAS unsigned char* ht_nat = Lb + SD_HT + buf * 17408 + (32 * ptj + r) * 272 + hh * 16;
#pragma unroll 1
            for (int tt = 0; tt < 2; ++tt) {
                f32x16 yi;
#pragma unroll
                for (int i = 0; i < 16; ++i) yi[i] = 0.f;
                const LAS unsigned char* cn_nat = Lb + SD_CN + (32 * tt + r) * 272 + hh * 16;
#pragma unroll 2
                for (int ks = 0; ks < 8; ++ks) yi = MFMA32(lds_frag16(cn_nat + ks * 32), lds_frag16(ht_nat + ks * 32), yi);
                const LAS unsigned short* xt_p = XT + (32 * ptj + r) * 72 + 32 * tt + 4 * hh;
#pragma unroll
                for (int q4 = 0; q4 < 4; ++q4) { const f32x4 ec = *(const LAS f32x4*)(ECUM + 32 * tt + 8 * q4 + 4 * hh); const v2u xw = *(const LAS v2u*)(xt_p + 8 * q4);
                    const float x0 = bf2f(xw.x & 0xffffu), x1 = bf2f(xw.x >> 16), x2 = bf2f(xw.y & 0xffffu), x3 = bf2f(xw.y >> 16);
                    LAS float* yb = YY + (32 * tt + 8 * q4 + 4 * hh) * 64 + 32 * ptj + r;
                    yb[0] = ec[0] * yi[4 * q4] + Dk * x0; yb[64] = ec[1] * yi[4 * q4 + 1] + Dk * x1; yb[128] = ec[2] * yi[4 * q4 + 2] + Dk * x2; yb[192] = ec[3] * yi[4 * q4 + 3] + Dk * x3; }
            }
        }
        {
            const float el = __expf(CUM[63]);
#pragma unroll
            for (int i = 0; i < 16; ++i) H[i] *= el;
            const LAS unsigned char* bt_nat = Lb + SD_BT + (32 * nt + r) * 144 + hh * 16; const LAS unsigned char* xt_nat = Lb + SD_XWT + (32 * pt + r) * 144 + hh * 16;
#pragma unroll
            for (int s2 = 0; s2 < 4; ++s2) H = MFMA32(lds_frag16(bt_nat + s2 * 32), lds_frag16(xt_nat + s2 * 32), H);
            LAS unsigned short* hp = HT + (buf ^ 1) * 8704 + (32 * pt + r) * 136 + 32 * nt + 4 * hh;
#pragma unroll
            for (int q4 = 0; q4 < 4; ++q4) { v2u pk; pk.x = cvtpk_c(H[4 * q4], H[4 * q4 + 1]); pk.y = cvtpk_c(H[4 * q4 + 2], H[4 * q4 + 3]); *(LAS v2u*)(hp + 8 * q4) = pk; }
        }
        LDS_BARRIER();
        { const int tt = tid >> 3, p0 = (tid & 7) * 8;
          if (t0 + tt < L) { const size_t row = row_base + t0 + tt;
            f32x4 y0 = *(const LAS f32x4*)(YA + tt * 64 + p0) + *(const LAS f32x4*)(YY + tt * 64 + p0), y1 = *(const LAS f32x4*)(YA + tt * 64 + p0 + 4) + *(const LAS f32x4*)(YY + tt * 64 + p0 + 4);
            if (tt >= 32) { const v4u ow4 = *(const LAS v4u*)(YO + (tt - 32) * 64 + p0);
                y0 = y0 + (f32x4){bf2f(ow4.x & 0xffffu), __uint_as_float(ow4.x & 0xffff0000u), bf2f(ow4.y & 0xffffu), __uint_as_float(ow4.y & 0xffff0000u)};
                y1 = y1 + (f32x4){bf2f(ow4.z & 0xffffu), __uint_as_float(ow4.z & 0xffff0000u), bf2f(ow4.w & 0xffffu), __uint_as_float(ow4.w & 0xffff0000u)}; }
            float o[8]; float sq = 0.f;
#pragma unroll
            for (int j = 0; j < 8; ++j) { const unsigned z16 = (zw[j >> 1] >> ((j & 1) * 16)) & 0xffffu; const float yv = (j < 4 ? y0[j & 3] : y1[j & 3]) * silu_f(bf2f(z16)); o[j] = yv; sq += yv * yv; }
            v4u ow; ow.x = pk2(o[0], o[1]); ow.y = pk2(o[2], o[3]); ow.z = pk2(o[4], o[5]); ow.w = pk2(o[6], o[7]);
            *(v4u*)(YG + row * 2048 + h * 64 + p0) = ow;
            sq += __shfl_xor(sq, 1); sq += __shfl_xor(sq, 2); sq += __shfl_xor(sq, 4);
            if ((tid & 7) == 0) SSQ[row * 32 + h] = sq; } }
        }
    }
#pragma unroll
    for (int q4 = 0; q4 < 4; ++q4) *(f32x4*)(st_g + 8 * q4) = (f32x4){H[4 * q4], H[4 * q4 + 1], H[4 * q4 + 2], H[4 * q4 + 3]};
    __syncthreads();
}
__device__ __forceinline__ float tr_reduce32(const float (&v)[32], int lane) {
    const bool b4 = lane & 16, b3 = lane & 8, b2 = lane & 4, b1 = lane & 2, b0 = lane & 1;
    float a[16], b[8], c[4], d[2];
#pragma unroll
    for (int i = 0; i < 16; ++i) { const float keep = b4 ? v[i + 16] : v[i], send = b4 ? v[i] : v[i + 16]; a[i] = keep + __shfl_xor(send, 16); }
#pragma unroll
    for (int i = 0; i < 8; ++i) { const float keep = b3 ? a[i + 8] : a[i], send = b3 ? a[i] : a[i + 8]; b[i] = keep + __shfl_xor(send, 8); }
#pragma unroll
    for (int i = 0; i < 4; ++i) { const float keep = b2 ? b[i + 4] : b[i], send = b2 ? b[i] : b[i + 4]; c[i] = keep + __shfl_xor(send, 4); }
#pragma unroll
    for (int i = 0; i < 2; ++i) { const float keep = b1 ? c[i + 2] : c[i], send = b1 ? c[i] : c[i + 2]; d[i] = keep + __shfl_xor(send, 2); }
    const float keep = b0 ? d[1] : d[0], send = b0 ? d[0] : d[1];
    return keep + __shfl_xor(send, 1);
}
__device__ __forceinline__ void ssd_sample_unit(Frame& F, int sb, int g) {
    int tid_o = F.tid; asm volatile("" : "+v"(tid_o));
    const int tid = tid_o, lane = tid & 63, w = F.wave, hh = lane >> 5, nq = lane & 31; unsigned char* ws = F.ws;
    LAS float* XC = (LAS float*)(F.lds + RING_OFF); LAS float* BC = XC + 8 * 4 * 64; LAS float* CC = BC + 4 * 128; LAS float* DTS = CC + 4 * 128;
    const bf16* PROJ = (const bf16*)(ws + WS_PROJ); const float* DTR = (const float*)(ws + WS_DT); bf16* YG = (bf16*)(ws + WS_YG); float* SSQ = (float*)(ws + WS_SSQSSD);
    const size_t row0 = (size_t)TP + (size_t)sb * LS;
    const int h = 8 * g + w;
    const float* sp = F.in[3] + (size_t)(sb * 32 + h) * 8192 + (size_t)hh * 128 + 4 * nq;
    f32x4 hst[32];
#pragma unroll
    for (int i = 0; i < 32; ++i) hst[i] = *(const f32x4*)(sp + (size_t)i * 256);
    if (tid < 384) { typedef float f32x2 __attribute__((ext_vector_type(2)));
        const int col = tid < 256 ? g * 512 + 2 * tid : (tid < 320 ? 2048 + g * 128 + 2 * (tid - 256) : 2560 + g * 128 + 2 * (tid - 320));
        const float* cw = F.in[10]; const float* sc = F.in[4] + (size_t)sb * 3 * 3072 + col;
        const f32x2 w0 = *(const f32x2*)(cw + col), w1 = *(const f32x2*)(cw + 3072 + col), w2 = *(const f32x2*)(cw + 2 * 3072 + col), w3 = *(const f32x2*)(cw + 3 * 3072 + col), cb = *(const f32x2*)(F.in[11] + col);
        f32x2 full[7]; full[0] = *(const f32x2*)sc; full[1] = *(const f32x2*)(sc + 3072); full[2] = *(const f32x2*)(sc + 2 * 3072);
        const bf16* cp = PROJ + (size_t)(S_X0 + (col >> 10)) * SLOT_ELEMS + row0 * 1024 + (col & 1023);
#pragma unroll
        for (int t = 0; t < 4; ++t) { const unsigned wd = *(const unsigned*)(cp + (size_t)t * 1024); full[3 + t] = (f32x2){__uint_as_float(wd << 16), __uint_as_float(wd & 0xffff0000u)}; }
#pragma unroll
        for (int t = 0; t < 4; ++t) { f32x2 a = w0 * full[t] + cb; a = w1 * full[t + 1] + a; a = w2 * full[t + 2] + a; a = w3 * full[t + 3] + a;
            f32x2 o; o.x = silu_f(a.x); o.y = silu_f(a.y);
            LAS float* dst = tid < 256 ? XC + ((tid >> 5) * 4 + t) * 64 + 2 * (tid & 31) : (tid < 320 ? BC + t * 128 + 2 * (tid - 256) : CC + t * 128 + 2 * (tid - 320));
            *(LAS f32x2*)dst = o; }
    } else if (tid < 416) { const int idx = tid - 384, hl = idx >> 2, t = idx & 3; const float x = DTR[(row0 + t) * 32 + 8 * g + hl] + F.in[12][8 * g + hl]; DTS[idx] = x > 20.f ? x : log1pf(__expf(x)); }
    __syncthreads();
    const float a = -__expf(F.in[13][h]), Dk = F.in[14][h];
#pragma unroll 1
    for (int t = 0; t < 4; ++t) {
        const float dtv = DTS[w * 4 + t], dA = __expf(dtv * a);
        const f32x4 Bv = *(const LAS f32x4*)(BC + t * 128 + 4 * nq), Cv = *(const LAS f32x4*)(CC + t * 128 + 4 * nq);
        const LAS float* xrow = XC + (w * 4 + t) * 64;
        float part[32];
#pragma unroll
        for (int i = 0; i < 32; ++i) { const float xd = xrow[2 * i + hh] * dtv; hst[i] = hst[i] * dA + Bv * xd; part[i] = (hst[i].x * Cv.x + hst[i].y * Cv.y) + (hst[i].z * Cv.z + hst[i].w * Cv.w); }
        float yv = tr_reduce32(part, lane);
        const int p = 2 * nq + hh; const size_t row = row0 + t;
        yv += Dk * xrow[p];
        const float z = bf2f(PROJ[(size_t)(S_Z0 + (h >> 4)) * SLOT_ELEMS + row * 1024 + (h & 15) * 64 + p]);
        const float yg = yv * silu_f(z);
        YG[row * 2048 + h * 64 + p] = (bf16)f2bf(yg);
        const float sq = wave_sum(yg * yg);
        if (lane == 0) SSQ[row * 32 + h] = sq;
    }
    float* so = F.out + O_SSMS + (size_t)(sb * 32 + h) * 8192 + (size_t)hh * 128 + 4 * nq;
#pragma unroll
    for (int i = 0; i < 32; ++i) *(f32x4*)(so + (size_t)i * 256) = hst[i];
    __syncthreads();
}
__device__ __forceinline__ void hgrn_sample_unit(Frame& F, int sb, int hq) {
    int tid_o = F.tid; asm volatile("" : "+v"(tid_o));
    const int tid = tid_o, lane = tid & 63, w = F.wave, hh = lane >> 5, vq = lane & 31; unsigned char* ws = F.ws;
    LAS float* FS = (LAS float*)(F.lds + RING_OFF); LAS float* KS = FS + 2048; LAS float* QS = KS + 2048; LAS float* VS = QS + 2048; LAS float* OP = VS + 2048;
    const bf16* PROJ = (const bf16*)(ws + WS_PROJ); bf16* ON = (bf16*)(ws + WS_ON);
    const size_t row0 = (size_t)TP + (size_t)sb * LS;
    const int hl = w >> 1, kh = w & 1, hd = 4 * hq + hl;
    const float* sp = F.in[5] + (size_t)(sb * 8 + hd) * 16384 + (size_t)(64 * kh + hh) * 128 + 4 * vq;
    f32x4 S[32];
#pragma unroll
    for (int i = 0; i < 32; ++i) S[i] = *(const f32x4*)(sp + (size_t)i * 256);
    { const int ch = hq * 512 + tid; const float lb = __builtin_amdgcn_rcpf(1.0f + __expf(F.in[17][1024 + ch] - F.in[17][ch]));
      const bf16* fp = PROJ + (size_t)S_F * SLOT_ELEMS + row0 * 1024 + ch; const bf16* qp = PROJ + (size_t)S_Q * SLOT_ELEMS + row0 * 1024 + ch; const bf16* ip = PROJ + (size_t)S_I * SLOT_ELEMS + row0 * 1024 + ch;
#pragma unroll
      for (int t = 0; t < 4; ++t) { const float u = fminf(fmaxf(bf2f(fp[(size_t)t * 1024]), -30.f), 30.f); const float fg = lb + (1.0f - lb) * sigmoid_f(u);
          const int o = ((tid >> 7) * 4 + t) * 128 + (tid & 127);
          FS[o] = fg; KS[o] = 1.0f - fg; QS[o] = silu_f(bf2f(qp[(size_t)t * 1024])); VS[o] = bf2f(ip[(size_t)t * 1024]); } }
    __syncthreads();
#pragma unroll 1
    for (int t = 0; t < 4; ++t) {
        const int o = (hl * 4 + t) * 128;
        const f32x4 vv = *(const LAS f32x4*)(VS + o + 4 * vq);
        f32x4 oa = (f32x4){0.f, 0.f, 0.f, 0.f};
#pragma unroll
        for (int i = 0; i < 32; ++i) { const int k = 64 * kh + 2 * i + hh; const float fk = FS[o + k], kv = KS[o + k], qk = QS[o + k]; S[i] = S[i] * fk + vv * kv; oa = oa + S[i] * qk; }
        oa.x += __shfl_xor(oa.x, 32); oa.y += __shfl_xor(oa.y, 32); oa.z += __shfl_xor(oa.z, 32); oa.w += __shfl_xor(oa.w, 32);
        if (hh == 0) *(LAS f32x4*)(OP + ((hl * 4 + t) * 2 + kh) * 128 + 4 * vq) = oa;
    }
    float* so = F.out + O_HGS + (size_t)(sb * 8 + hd) * 16384 + (size_t)(64 * kh + hh) * 128 + 4 * vq;
#pragma unroll
    for (int i = 0; i < 32; ++i) *(f32x4*)(so + (size_t)i * 256) = S[i];
    __syncthreads();
#pragma unroll
    for (int rr2 = 0; rr2 < 2; ++rr2) { const int rr = 2 * w + rr2, ohl = rr >> 2, t = rr & 3, ohd = 4 * hq + ohl; typedef float f32x2 __attribute__((ext_vector_type(2)));
        const f32x2 p0 = *(const LAS f32x2*)(OP + (rr * 2) * 128 + 2 * lane), p1 = *(const LAS f32x2*)(OP + (rr * 2 + 1) * 128 + 2 * lane);
        const float o0 = p0.x + p1.x, o1 = p0.y + p1.y; const float sq = wave_sum(o0 * o0 + o1 * o1); const float rs = __builtin_amdgcn_rsqf(sq * (1.0f / 128.0f) + EPS);
        const size_t row = row0 + t; const unsigned gw = *(const unsigned*)(PROJ + (size_t)S_HG * SLOT_ELEMS + row * 1024 + ohd * 128 + 2 * lane);
        *(unsigned*)(ON + row * 1024 + ohd * 128 + 2 * lane) = pk2(o0 * rs * silu_f(bf2f(gw & 0xffffu)), o1 * rs * silu_f(__uint_as_float(gw & 0xffff0000u))); }
    __syncthreads();
}
constexpr int U_HGS = NBS * 2, U_SSDS = NBS * 4, U_CONV = NBP + NBS;
__device__ __forceinline__ void scan_phase(Frame& F) {
    gu32* head = F.ctl + CW_QUEUE;
    const int xcc = (int)(xb_xcc_id() & 7u);
#define SCAN_QUEUE(qi, count, body) for (;;) { if (F.tid == 0) F.MISC[0] = __hip_atomic_fetch_add(head + 64 * (qi), 1u, RLX_AGENT); __syncthreads(); const int u = (int)F.MISC[0]; __syncthreads(); if (u >= (count)) break; body }
#pragma unroll 1
    for (int pass = 0; pass < 8; ++pass) { const int bb = (xcc + pass) & 7; SCAN_QUEUE(4 + bb, 32, ssd_unit_mfma(F, bb, u);) }
#pragma unroll 1
    for (int pass = 0; pass < 8; ++pass) { const int bb = (xcc + pass) & 7; SCAN_QUEUE(12 + bb, 32, hgrn_v_unit(F, bb, u >> 2, u & 3);) }
    SCAN_QUEUE(2, U_HGS, hgrn_sample_unit(F, u >> 1, u & 1);)
    SCAN_QUEUE(3, U_SSDS + U_CONV, if (u >= U_SSDS) { conv_copy_unit(F, u - U_SSDS); continue; } ssd_sample_unit(F, u >> 2, u & 3);)
#undef SCAN_QUEUE
}
typedef float f32x4s __attribute__((ext_vector_type(4)));
template <class Epi> __device__ __forceinline__ void small_tile_phase(Frame& F, const bf16* A, const bf16* Bt, int K, const Epi& E) {
    if (F.G != 256) return;
    const int lane = F.lane, w = F.wave, r = lane & 31, hh = lane >> 5;
    const int mt = F.vcu >> 4, nt = F.vcu & 15;
    const int kw = K >> 3;
    const bf16* ap = A + (size_t)(TP + 32 * mt + r) * K + w * kw + 8 * hh;
    const bf16* bp = Bt + (size_t)(64 * nt + r) * K + w * kw + 8 * hh;
    f32x16 acc0, acc1;
#pragma unroll
    for (int i = 0; i < 16; ++i) { acc0[i] = 0.f; acc1[i] = 0.f; }
#pragma unroll 4
    for (int ks = 0; ks < kw / 16; ++ks) { const bf16x8 af = *(const bf16x8*)(ap + 16 * ks), b0 = *(const bf16x8*)(bp + 16 * ks), b1 = *(const bf16x8*)(bp + (size_t)32 * K + 16 * ks);
        acc0 = MFMA32(b0, af, acc0); acc1 = MFMA32(b1, af, acc1); }
    LAS float* part = (LAS float*)(F.lds + RING_OFF) + w * 2048;
#pragma unroll
    for (int q4 = 0; q4 < 4; ++q4) { *(LAS f32x4*)(part + r * 64 + 8 * q4 + 4 * hh) = (f32x4){acc0[4 * q4], acc0[4 * q4 + 1], acc0[4 * q4 + 2], acc0[4 * q4 + 3]};
        *(LAS f32x4*)(part + r * 64 + 32 + 8 * q4 + 4 * hh) = (f32x4){acc1[4 * q4], acc1[4 * q4 + 1], acc1[4 * q4 + 2], acc1[4 * q4 + 3]}; }
    __syncthreads();
    const int rl = F.tid >> 4, c4 = (F.tid & 15) * 4; const LAS float* src = (const LAS float*)(F.lds + RING_OFF) + rl * 64 + c4;
    f32x4 sum = *(const LAS f32x4*)src;
#pragma unroll
    for (int ww = 1; ww < 8; ++ww) sum = sum + *(const LAS f32x4*)(src + ww * 2048);
    const f32x4s acc = (f32x4s){sum.x, sum.y, sum.z, sum.w};
    E.small(F, acc, TP + 32 * mt + rl, 64 * nt + c4, nt);
    __syncthreads();
}
template <bool ADD> struct SmGate { bf16* O; const bf16* gate;
    __device__ __forceinline__ void small(Frame&, const f32x4s& a, int row, int col, int) const { const size_t off = (size_t)row * 1024 + col;
        const v2u gw = *(const v2u*)(gate + off); v2u ow = (v2u){0u, 0u}; if (ADD) ow = *(const v2u*)(O + off);
        float rr[4];
#pragma unroll
        for (int e = 0; e < 4; ++e) { const unsigned g16 = (gw[e >> 1] >> ((e & 1) * 16)) & 0xffffu, o16 = (ow[e >> 1] >> ((e & 1) * 16)) & 0xffffu; rr[e] = (ADD ? bf2f(o16) : 0.f) + sigmoid_f(bf2f(g16)) * a[e]; }
        v2u wv; wv.x = cvtpk_c(rr[0], rr[1]); wv.y = cvtpk_c(rr[2], rr[3]); *(v2u*)(O + off) = wv; } };
template <bool BF> struct SmRes { const float* base; bf16* hb; float* ssqp;
    __device__ __forceinline__ void small(Frame& F, const f32x4s& a, int row, int col, int nt) const { const size_t off = (size_t)row * 1024 + col; f32x4 b;
        if (BF) { const v2u w = *(const v2u*)(hb + off); b = (f32x4){bf2f(w.x & 0xffffu), __uint_as_float(w.x & 0xffff0000u), bf2f(w.y & 0xffffu), __uint_as_float(w.y & 0xffff0000u)}; }
        else b = *(const f32x4*)(base + off);
        const f32x4 v = b + (f32x4){a[0], a[1], a[2], a[3]};
        { v2u wv; wv.x = cvtpk_c(v[0], v[1]); wv.y = cvtpk_c(v[2], v[3]); *(v2u*)(hb + off) = wv; }
        float sq = (v[0] * v[0] + v[1] * v[1]) + (v[2] * v[2] + v[3] * v[3]); sq += __shfl_xor(sq, 1); sq += __shfl_xor(sq, 2); sq += __shfl_xor(sq, 4); sq += __shfl_xor(sq, 8);
        if ((F.tid & 15) == 0) ssqp[(size_t)row * 16 + nt] = sq; } };
struct SmScale { bf16* O; const float* ssq; float scale;
    __device__ __forceinline__ void small(Frame&, const f32x4s& a, int row, int col, int) const { const float rs = pg8::row_rs<16>(ssq, row) * scale;
        v2u wv; wv.x = cvtpk_c(a[0] * rs, a[1] * rs); wv.y = cvtpk_c(a[2] * rs, a[3] * rs); *(v2u*)(O + (size_t)row * 1024 + col) = wv; } };
__device__ __forceinline__ void attn_stage_tile(LAS unsigned char* Lb, const bf16* src, size_t pitch, int tid) {
#pragma unroll 1
    for (int hb = 0; hb < 2; ++hb) { v4u v[8];
#pragma unroll
        for (int i = 0; i < 8; ++i) { const int id = tid + 512 * (8 * hb + i), row = id >> 5, c = id & 31; v[i] = *(const v4u*)(src + (size_t)row * pitch + c * 8); }
#pragma unroll
        for (int i = 0; i < 8; ++i) { const int id = tid + 512 * (8 * hb + i), row = id >> 5, c = id & 31; *(LAS v4u*)(Lb + row * 512 + ((c ^ (row & 15)) << 4)) = v[i]; } }
}
__device__ __forceinline__ void attn_prompt_unit(Frame& F, int b, int hd, int qb) {
    const int tid = F.tid, lane = F.lane, w = F.wave, r = lane & 31, hh = lane >> 5; unsigned char* ws = F.ws;
    LAS unsigned char* Lb = F.lds + RING_OFF;
    const bf16* QB = (const bf16*)(ws + WS_QB); const bf16* KB = (const bf16*)(ws + WS_KB); const bf16* VT = (const bf16*)(ws + WS_VT); bf16* OB = (bf16*)(ws + WS_OB);
    const size_t qrow = (size_t)b * SEQ + (size_t)qb * 256 + 32 * w + r;
    attn_stage_tile(Lb, KB + (size_t)b * 256 * 1024 + hd * 256, 1024, tid);
    const bf16* qp = QB + qrow * 1024 + hd * 256 + 8 * hh;
    bf16x8 qf = *(const bf16x8*)qp;
    __syncthreads();
    f32x16 S[8];
#pragma unroll
    for (int t = 0; t < 8; ++t)
#pragma unroll
        for (int i = 0; i < 16; ++i) S[t][i] = 0.f;
    const int sw = r & 15;
#pragma unroll 1
    for (int ks = 0; ks < 16; ++ks) {
        const bf16x8 qn = *(const bf16x8*)(qp + 16 * (ks < 15 ? ks + 1 : ks));
        const LAS unsigned char* kp = Lb + r * 512 + (((2 * ks + hh) ^ sw) << 4);
#pragma unroll
        for (int t = 0; t < 8; ++t) S[t] = MFMA32(lds_frag16(kp + t * 32 * 512), qf, S[t]);
        qf = qn;
    }
    float m = -3.0e38f;
#pragma unroll
    for (int t = 0; t < 8; ++t)
#pragma unroll
        for (int i = 0; i < 16; ++i) m = fmaxf(m, S[t][i]);
    m = fmaxf(m, __shfl_xor(m, 32));
    float l = 0.f;
#pragma unroll
    for (int t = 0; t < 8; ++t)
#pragma unroll
        for (int i = 0; i < 16; ++i) { const float pv = __builtin_amdgcn_exp2f(S[t][i] - m); S[t][i] = pv; l += pv; }
    l += __shfl_xor(l, 32);
    const float rl = __builtin_amdgcn_rcpf(l);
    bf16x8 pf[8][2];
#pragma unroll
    for (int t = 0; t < 8; ++t) { pf[t][0] = ACC_FRAG(S[t], 0); pf[t][1] = ACC_FRAG(S[t], 1); }
    __syncthreads();
    attn_stage_tile(Lb, VT + (size_t)(b * 4 + hd) * 256 * 256, 256, tid);
    __syncthreads();
    bf16* op = OB + qrow * 1024 + hd * 256 + 4 * hh;
#pragma unroll 1
    for (int dt = 0; dt < 8; ++dt) {
        f32x16 O;
#pragma unroll
        for (int i = 0; i < 16; ++i) O[i] = 0.f;
        const LAS unsigned char* vrow = Lb + (32 * dt + r) * 512 + 8 * hh;
#pragma unroll
        for (int t = 0; t < 8; ++t)
#pragma unroll
            for (int s2 = 0; s2 < 2; ++s2) {
                const v2u lo = *(const LAS v2u*)(vrow + (((4 * t + 2 * s2) ^ sw) << 4)), hi = *(const LAS v2u*)(vrow + (((4 * t + 2 * s2 + 1) ^ sw) << 4));
                const v4u wv4 = (v4u){lo.x, lo.y, hi.x, hi.y};
                O = MFMA32(__builtin_bit_cast(bf16x8, wv4), pf[t][s2], O);
            }
#pragma unroll
        for (int q4 = 0; q4 < 4; ++q4) { v2u o; o.x = cvtpk_c(O[4 * q4] * rl, O[4 * q4 + 1] * rl); o.y = cvtpk_c(O[4 * q4 + 2] * rl, O[4 * q4 + 3] * rl);
            *(v2u*)(op + 32 * dt + 8 * q4) = o; }
    }
    __syncthreads();
}
__device__ __forceinline__ void attn_sample_unit(Frame& F, int sb, int hd) {
    const int tid = F.tid, lane = F.lane, w = F.wave; unsigned char* ws = F.ws;
    LAS float* sc = (LAS float*)(F.lds + RING_OFF);
    LAS float* red = sc + 4 * 256;
    const bf16* QB = (const bf16*)(ws + WS_QB); bf16* OB = (bf16*)(ws + WS_OB);
    const size_t rowq = (size_t)TP + (size_t)sb * LS;
    float q[4][4];
#pragma unroll
    for (int t = 0; t < 4; ++t) { const v2u qw = *(const v2u*)(QB + (rowq + t) * 1024 + hd * 256 + 4 * lane); q[t][0] = bf2f(qw.x & 0xffffu); q[t][1] = bf2f(qw.x >> 16); q[t][2] = bf2f(qw.y & 0xffffu); q[t][3] = bf2f(qw.y >> 16); }
    const float* Kc = F.in[6] + ((size_t)sb * 256 * 4 + hd) * 256 + 4 * lane; const float* Vc = F.in[7] + ((size_t)sb * 256 * 4 + hd) * 256 + 4 * lane;
#pragma unroll 1
    for (int kk0 = 0; kk0 < 32; kk0 += 8) { f32x4 kv[8];
#pragma unroll
        for (int u = 0; u < 8; ++u) kv[u] = *(const f32x4*)(Kc + (size_t)(w * 32 + kk0 + u) * 1024);
#pragma unroll
        for (int u = 0; u < 8; ++u) { const int key = w * 32 + kk0 + u;
#pragma unroll
            for (int t = 0; t < 4; ++t) { float s = (q[t][0] * kv[u].x + q[t][1] * kv[u].y) + (q[t][2] * kv[u].z + q[t][3] * kv[u].w); s = wave_sum(s); if (lane == 0) sc[t * 256 + key] = s; } } }
    __syncthreads();
    if (w < 4) { float v[4]; float m = -3.0e38f;
#pragma unroll
        for (int j = 0; j < 4; ++j) { v[j] = sc[w * 256 + j * 64 + lane]; m = fmaxf(m, v[j]); }
        m = wave_max(m); float l = 0.f;
#pragma unroll
        for (int j = 0; j < 4; ++j) { v[j] = __builtin_amdgcn_exp2f(v[j] - m); l += v[j]; }
        l = wave_sum(l); const float rl = 1.0f / l;
#pragma unroll
        for (int j = 0; j < 4; ++j) sc[w * 256 + j * 64 + lane] = v[j] * rl; }
    __syncthreads();
    float o[4][4];
#pragma unroll
    for (int t = 0; t < 4; ++t)
#pragma unroll
        for (int e = 0; e < 4; ++e) o[t][e] = 0.f;
#pragma unroll 1
    for (int kk0 = 0; kk0 < 32; kk0 += 8) { f32x4 vv[8];
#pragma unroll
        for (int u = 0; u < 8; ++u) vv[u] = *(const f32x4*)(Vc + (size_t)(w * 32 + kk0 + u) * 1024);
#pragma unroll
        for (int u = 0; u < 8; ++u) { const int key = w * 32 + kk0 + u;
#pragma unroll
            for (int t = 0; t < 4; ++t) { const float pr = sc[t * 256 + key]; o[t][0] += pr * vv[u].x; o[t][1] += pr * vv[u].y; o[t][2] += pr * vv[u].z; o[t][3] += pr * vv[u].w; } } }
#pragma unroll
    for (int t = 0; t < 4; ++t) *(LAS f32x4*)(red + (w * 4 + t) * 256 + 4 * lane) = (f32x4){o[t][0], o[t][1], o[t][2], o[t][3]};
    __syncthreads();
    { const int t = tid >> 7, d0 = (tid & 127) * 2; float a0 = 0.f, a1 = 0.f;
#pragma unroll
      for (int ww = 0; ww < 8; ++ww) { a0 += red[(ww * 4 + t) * 256 + d0]; a1 += red[(ww * 4 + t) * 256 + d0 + 1]; }
      *(unsigned*)(OB + (rowq + t) * 1024 + hd * 256 + d0) = pk2(a0, a1); }
    __syncthreads();
}
__device__ __forceinline__ void attn_phase(Frame& F) {
    for (int u = F.vcu; u < NBP * 4 * 8; u += F.G) attn_prompt_unit(F, u >> 5, (u >> 3) & 3, u & 7);
    for (int u = F.vcu; u < NBS * 4; u += F.G) attn_sample_unit(F, u >> 2, u & 3);
}
__device__ __forceinline__ void final_norm_phase(Frame& F) {
    const int gw = F.vcu * NWAVES + F.wave, NGW = F.G * NWAVES; const float* SSQ = (const float*)(F.ws + WS_SSQP3); const float* wn = F.in[31]; const bf16* HB = (const bf16*)(F.ws + WS_HB);
    f32x4 wv[4];
#pragma unroll
    for (int j = 0; j < 2; ++j) { wv[2 * j] = *((const f32x4*)wn + 2 * (64 * j + F.lane)); wv[2 * j + 1] = *((const f32x4*)wn + 2 * (64 * j + F.lane) + 1); }
    for (int row = gw; row < T; row += NGW) {
        const f32x4* sp = (const f32x4*)(SSQ + (size_t)row * 16); float s = 0.f;
#pragma unroll
        for (int j = 0; j < 4; ++j) { const f32x4 a = sp[j]; s += (a.x + a.y) + (a.z + a.w); }
        const float rs = __builtin_amdgcn_rsqf(s * (1.0f / 1024.0f) + EPS);
#pragma unroll
        for (int j = 0; j < 2; ++j) { const int pc = 64 * j + F.lane; const v4u w = *((const v4u*)(HB + (size_t)row * 1024) + pc);
            const f32x4 v0 = (f32x4){bf2f(w.x & 0xffffu), __uint_as_float(w.x & 0xffff0000u), bf2f(w.y & 0xffffu), __uint_as_float(w.y & 0xffff0000u)};
            const f32x4 v1 = (f32x4){bf2f(w.z & 0xffffu), __uint_as_float(w.z & 0xffff0000u), bf2f(w.w & 0xffffu), __uint_as_float(w.w & 0xffff0000u)};
            f32x4* o = (f32x4*)(F.out + O_Y + (size_t)row * 1024) + 2 * pc; o[0] = v0 * rs * wv[2 * j]; o[1] = v1 * rs * wv[2 * j + 1]; }
    }
}
#ifndef MK_N_LAUNCHES
#define MK_N_LAUNCHES 1
#endif
constexpr int PER_PHASE = 13;
constexpr int N_LAUNCHES = MK_N_LAUNCHES;
struct Args { const float* in[32]; float* out; unsigned char* ws; int ph_lo, ph_hi; };
__global__ void __launch_bounds__(NTHR, 2) skel_fwd(Args args) {
    extern __shared__ __attribute__((aligned(16))) unsigned char lds[];
    Frame F;
    F.lds = (LAS unsigned char*)lds;
    F.MISC = (volatile LAS unsigned*)(F.lds + MISC_OFF);
    F.tid = threadIdx.x; F.lane = F.tid & 63; F.wave = __builtin_amdgcn_readfirstlane(F.tid >> 6);
    F.G = gridDim.x; { const int bx = blockIdx.x; F.vcu = (F.G % 8 == 0) ? (bx % 8) * (F.G / 8) + bx / 8 : bx; }
    unsigned char* ws = args.ws; F.ws = ws; F.out = args.out;
    F.ctl = (gu32*)(ws + WS_CTL);
#pragma unroll
    for (int i = 0; i < 32; ++i) F.in[i] = args.in[i];
    for (int u = F.tid; u < (LDS_BYTES - LDSCTL_OFF) / 4; u += NTHR) ((LAS unsigned*)(F.lds + LDSCTL_OFF))[u] = 0u;
    __syncthreads();
    XcdBarrier bar; bar.bar = (unsigned*)(F.ctl + CW_BAR); bar.x = 0; bar.st = nullptr;
    if (N_LAUNCHES == 1) bar = xcd_barrier_post((unsigned*)(F.ctl + CW_BAR), F.MISC + 8);
#define GRID_BAR() do { if (N_LAUNCHES == 1) xcd_barrier(bar); } while (0)
    const int lo = args.ph_lo, hi = args.ph_hi;
#ifdef ONLY_PHASE
#define IN(k) ((k) == ONLY_PHASE && lo <= (k) && (k) < hi)
#else
#define IN(k) (lo <= (k) && (k) < hi)
#endif
#define BOTH(k) (IN(k) && IN((k) + 1))
    bf16* const XB = (bf16*)(ws + WS_XB); bf16* const PROJ = (bf16*)(ws + WS_PROJ);
    float* const Y = F.out + O_Y;
    if (IN(0)) { p0_prologue(F); if (BOTH(0)) GRID_BAR(); }
    if (IN(1)) {
        { pg8::Gemm g{XB, (const bf16*)(ws + WS_WIN), T, NPROJ, 1024}; pg8::StaticOrder S; S.init(T, NPROJ, F.G, (int)blockIdx.x);
          pg8::EpiScaleBf16<1, true> E{PROJ, SLOT_ELEMS, (const float*)(ws + WS_SSQX), 1.0f, (float*)(ws + WS_DT)};
          pg8::gemm_phase<pg8::EpiScaleBf16<1, true>, pg8::StaticOrder, true, true>(F.lds + RING_OFF, g, S, E); }
        { pg8::Gemm g{(const bf16*)(ws + WS_MNB), (const bf16*)(ws + WS_WKV), MEMR, 2048, 1024}; pg8::StaticOrder S; S.init(MEMR, 2048, F.G, (int)((blockIdx.x + 64) % F.G));
          pg8::EpiKV E{F.out + O_MKP, F.out + O_MVP, (bf16*)(ws + WS_KB), (bf16*)(ws + WS_VT), (const float*)(ws + WS_SSQM)};
          pg8::gemm_phase<pg8::EpiKV, pg8::StaticOrder, true, true>(F.lds + RING_OFF, g, S, E); }
        if (BOTH(1)) GRID_BAR();
    }
    if (IN(2)) { bc_prep_phase(F); hg_prep_phase(F); GRID_BAR(); scan_phase(F); if (BOTH(2)) GRID_BAR(); }
    if (IN(3)) { ssdnorm_phase(F); hgnorm_phase(F); if (BOTH(3)) GRID_BAR(); }
    if (IN(4)) { { SmGate<false> Es{(bf16*)(ws + WS_MERGED), PROJ + (size_t)S_GS * SLOT_ELEMS}; small_tile_phase(F, (const bf16*)(ws + WS_YG), (const bf16*)(ws + WS_WSSD), 2048, Es); }
        pg8::Gemm g{(const bf16*)(ws + WS_YG), (const bf16*)(ws + WS_WSSD), TP, 1024, 2048}; pg8::StaticOrder S; S.init(TP, 1024, F.G, (int)blockIdx.x);
        pg8::EpiGate<false> E{(bf16*)(ws + WS_MERGED), PROJ + (size_t)S_GS * SLOT_ELEMS};
        pg8::gemm_phase<pg8::EpiGate<false>, pg8::StaticOrder, true, true>(F.lds + RING_OFF, g, S, E);
          }
    if (IN(5)) { { SmGate<true> Es{(bf16*)(ws + WS_MERGED), PROJ + (size_t)S_GH * SLOT_ELEMS}; small_tile_phase(F, (const bf16*)(ws + WS_ON), (const bf16*)(ws + WS_WHG), 1024, Es); }
        pg8::Gemm g{(const bf16*)(ws + WS_ON), (const bf16*)(ws + WS_WHG), TP, 1024, 1024}; pg8::StaticOrder S; S.init(TP, 1024, F.G, (int)blockIdx.x);
        pg8::EpiGate<true> E{(bf16*)(ws + WS_MERGED), PROJ + (size_t)S_GH * SLOT_ELEMS};
        pg8::gemm_phase<pg8::EpiGate<true>, pg8::StaticOrder, true, true>(F.lds + RING_OFF, g, S, E);
        if (BOTH(5)) GRID_BAR(); }
    if (IN(6)) { { SmRes<false> Es{F.in[1] - (size_t)TP * 1024, (bf16*)(ws + WS_HB), (float*)(ws + WS_SSQP1)}; small_tile_phase(F, (const bf16*)(ws + WS_MERGED), (const bf16*)(ws + WS_WOUT), 1024, Es); }
        pg8::Gemm g{(const bf16*)(ws + WS_MERGED), (const bf16*)(ws + WS_WOUT), TP, 1024, 1024}; pg8::StaticOrder S; S.init(TP, 1024, F.G, (int)blockIdx.x);
        pg8::EpiRes<false> E{F.in[0], F.in[1] - (size_t)TP * 1024, (bf16*)(ws + WS_HB), (float*)(ws + WS_SSQP1)};
        pg8::gemm_phase<pg8::EpiRes<false>, pg8::StaticOrder, true, true>(F.lds + RING_OFF, g, S, E);
        if (BOTH(6)) GRID_BAR(); }
    if (IN(7)) { { SmScale Es{(bf16*)(ws + WS_QB), (const float*)(ws + WS_SSQP1), QSCALE}; small_tile_phase(F, (const bf16*)(ws + WS_HB), (const bf16*)(ws + WS_WCQ), 1024, Es); }
        pg8::Gemm g{(const bf16*)(ws + WS_HB), (const bf16*)(ws + WS_WCQ), TP, 1024, 1024}; pg8::StaticOrder S; S.init(TP, 1024, F.G, (int)blockIdx.x);
        pg8::EpiScaleBf16<16, false> E{(bf16*)(ws + WS_QB), SLOT_ELEMS, (const float*)(ws + WS_SSQP1), QSCALE, nullptr};
        pg8::gemm_phase<pg8::EpiScaleBf16<16, false>, pg8::StaticOrder, true, true>(F.lds + RING_OFF, g, S, E);
        if (BOTH(7)) GRID_BAR(); }
    if (IN(8)) { attn_phase(F); if (BOTH(8)) GRID_BAR(); }
    if (IN(9)) { { SmRes<true> Es{nullptr, (bf16*)(ws + WS_HB), (float*)(ws + WS_SSQP2)}; small_tile_phase(F, (const bf16*)(ws + WS_OB), (const bf16*)(ws + WS_WCO), 1024, Es); }
        pg8::Gemm g{(const bf16*)(ws + WS_OB), (const bf16*)(ws + WS_WCO), TP, 1024, 1024}; pg8::StaticOrder S; S.init(TP, 1024, F.G, (int)blockIdx.x);
        pg8::EpiRes<true> E{nullptr, nullptr, (bf16*)(ws + WS_HB), (float*)(ws + WS_SSQP2)};
        pg8::gemm_phase<pg8::EpiRes<true>, pg8::StaticOrder, true, true>(F.lds + RING_OFF, g, S, E);
        if (BOTH(9)) GRID_BAR(); }
    if (IN(10)) { pg8::Gemm g{(const bf16*)(ws + WS_HB), (const bf16*)(ws + WS_WGU), T, 2 * FFN, 1024}; pg8::StaticOrder S; S.init(T, 2 * FFN, F.G, (int)blockIdx.x);
        pg8::EpiSwiglu E{(bf16*)(ws + WS_ACT), (const float*)(ws + WS_SSQP2)};
        pg8::gemm_phase<pg8::EpiSwiglu, pg8::StaticOrder, true, true>(F.lds + RING_OFF, g, S, E);
        if (BOTH(10)) GRID_BAR(); }
    if (IN(11)) { { SmRes<true> Es{nullptr, (bf16*)(ws + WS_HB), (float*)(ws + WS_SSQP3)}; small_tile_phase(F, (const bf16*)(ws + WS_ACT), (const bf16*)(ws + WS_WDN), FFN, Es); }
        pg8::Gemm g{(const bf16*)(ws + WS_ACT), (const bf16*)(ws + WS_WDN), TP, 1024, FFN}; pg8::StaticOrder S; S.init(TP, 1024, F.G, (int)blockIdx.x);
        pg8::EpiRes<true> E{nullptr, nullptr, (bf16*)(ws + WS_HB), (float*)(ws + WS_SSQP3)};
        pg8::gemm_phase<pg8::EpiRes<true>, pg8::StaticOrder, true, true>(F.lds + RING_OFF, g, S, E);
        if (BOTH(11)) GRID_BAR(); }
    if (IN(12)) final_norm_phase(F);
#undef IN
#undef BOTH
}

extern "C" void kernel_launch(void* const* d_in, const int* in_sizes, int n_in, void* d_out, int out_size, void* d_ws, size_t ws_size, hipStream_t stream) {
    static int grid = 0;
    if (grid == 0) {
        const int want[32] = {TP * 1024, TS * 1024, MEMR * 1024, 33554432, 1179648, 16777216, 33554432, 33554432, 1024, 1024 * 11296, 4 * 3072, 3072, 32, 32, 32, 2048, 2048 * 1024, 2048, 1024,
                              1024 * 1024, 1024 * 1024, 1024, 1024, 1024 * 1024, 1024 * 1024, 1024 * 1024, 1024 * 1024, 1024, 1024 * FFN, 1024 * FFN, FFN * 1024, 1024};
        bool ok = (n_in == 32); for (int i = 0; ok && i < 32; ++i) if (in_sizes[i] != want[i]) { fprintf(stderr, "kernel_launch: input %d has %d elements, expected %d\n", i, in_sizes[i], want[i]); ok = false; }
        if (!ok || out_size != (int)O_END || ws_size < WS_END4) { fprintf(stderr, "kernel_launch: unexpected shapes: n_in %d out %d ws %zu\n", n_in, out_size, ws_size); grid = -1; return; }
        int dev = 0, cus = 0, per_cu = 0;
        if (hipGetDevice(&dev) != hipSuccess || hipDeviceGetAttribute(&cus, hipDeviceAttributeMultiprocessorCount, dev) != hipSuccess) { grid = -1; return; }
        if (hipFuncSetAttribute((const void*)skel_fwd, hipFuncAttributeMaxDynamicSharedMemorySize, LDS_BYTES) != hipSuccess) { fprintf(stderr, "kernel_launch: hipFuncSetAttribute failed\n"); grid = -1; return; }
        if (hipOccupancyMaxActiveBlocksPerMultiprocessor(&per_cu, (const void*)skel_fwd, NTHR, LDS_BYTES) != hipSuccess || per_cu < 1) fprintf(stderr, "kernel_launch: occupancy query reports %d blocks per CU\n", per_cu);
        (void)hipGetLastError();
        grid = cus;
    }
    if (grid < 0) return;
    (void)hipMemsetAsync((char*)d_ws + WS_CTL, 0, CTL_ZERO_BYTES, stream);
    Args a{};
    for (int i = 0; i < 32; ++i) a.in[i] = (const float*)d_in[i];
    a.out = (float*)d_out; a.ws = (unsigned char*)d_ws;
    for (int li = 0; li < N_LAUNCHES; ++li) {
        a.ph_lo = (N_LAUNCHES == PER_PHASE) ? li : 0; a.ph_hi = (N_LAUNCHES == PER_PHASE) ? li + 1 : PER_PHASE;
        hipLaunchKernelGGL(skel_fwd, dim3(grid), dim3(NTHR), LDS_BYTES, stream, a);
    }
}
```

```cpp
#include <hip/hip_runtime.h>
#include <cstdio>
#include <cstdint>
namespace pg8 {
#define PG8_LAS __attribute__((address_space(3)))
typedef unsigned short bf16_t;
typedef short bf16x8 __attribute__((ext_vector_type(8)));
typedef float f32x4 __attribute__((ext_vector_type(4)));
typedef unsigned u32x4 __attribute__((ext_vector_type(4)));
constexpr int BM = 256, BK = 64, HALF = 128, HTB = HALF * BK * 2  , STAGE_BYTES = 8 * HTB, NXCD = 8, WGM = 8;

__host__ __device__ __forceinline__ int lds_byte(int r, int c) { const int st = (r >> 4) * 2 + (c >> 5), rr = r & 15, cc = c & 31, ob = rr * 64 + cc * 2; return st * 1024 + (ob ^ (((ob >> 9) & 1) << 5)); }
__host__ __device__ __forceinline__ void stage_rc(int b, int& R, int& C) { const int st = b / 1024, sb = b % 1024, swz = sb ^ (((sb >> 9) & 1) << 5); R = (st >> 1) * 16 + swz / 64; C = (st & 1) * 32 + (swz % 64) / 2; }
__host__ __device__ __forceinline__ int perm32(int rho) { const int n = rho >> 4, i = rho & 15; return 8 * (i >> 2) + 4 * n + (i & 3); }

struct Unit { int pm, pn; };
struct Gemm { const bf16_t* A; const bf16_t* Bt; int M, N, K; };

struct StaticOrder {
    int nM, nN, nwg, G, c;
    __host__ __device__ void init(int M, int N, int G_, int c_) { nM = M / BM; nN = N / BM; nwg = nM * nN; G = G_; c = c_; }
    __host__ __device__ bool next(int i, Unit& u) const {
        const long L = (long)i * G + c; if (L >= nwg) return false;
        int wgid = (int)L; { const int q = nwg / NXCD, r = nwg % NXCD, xcd = wgid % NXCD, off = wgid / NXCD; wgid = (xcd < r ? xcd * (q + 1) : r * (q + 1) + (xcd - r) * q) + off; }
        const int nig = WGM * nN, gid = wgid / nig, fm = gid * WGM, gsz = (nM - fm) < WGM ? (nM - fm) : WGM;
        u.pm = fm + ((wgid % nig) % gsz); u.pn = (wgid % nig) / gsz; return true;
    }
    __device__ __forceinline__ void a_ready(const Unit&) const {}
    __device__ __forceinline__ void done(const Unit&) const {}
};

__device__ __forceinline__ unsigned cvt_pk_bf16(float lo, float hi) { unsigned r; asm volatile("v_cvt_pk_bf16_f32 %0, %1, %2" : "=v"(r) : "v"(lo), "v"(hi)); return r; }
typedef float f32x2 __attribute__((ext_vector_type(2)));
typedef unsigned u32x2 __attribute__((ext_vector_type(2)));
constexpr float RMS_EPS = 1e-6f;
__device__ __forceinline__ float bfbits2f(unsigned v16) { return __uint_as_float(v16 << 16); }
__device__ __forceinline__ float sigm(float x) { return __builtin_amdgcn_rcpf(1.0f + __expf(-x)); }
template <int NP> __device__ __forceinline__ float row_rs(const float* ssq, int row) {
    float s = 0.f;
    if constexpr (NP == 1) s = ssq[row];
    else {
#pragma unroll
        for (int i = 0; i < NP / 4; ++i) { const f32x4 v = *(const f32x4*)(ssq + (size_t)row * NP + 4 * i); s += (v[0] + v[1]) + (v[2] + v[3]); }
    }
    return 1.0f / sqrtf(s * (1.0f / 1024.0f) + RMS_EPS);
}
template <int NP, bool HAS_DT> struct EpiScaleBf16 {
    static constexpr bool PERM = true, AFTER_DRAIN = false;
    bf16_t* O; size_t slot_elems; const float* ssq; float scale; float* dt;
    __device__ __forceinline__ void operator()(const f32x4 (&acc)[2][2][4][2], const Unit& u, int wr, int wc, int fr, int fq) const {
        const int row0 = u.pm * BM + wr * 64 + fr;
        if (HAS_DT && u.pn == 44) {
            if (wc == 0) {
#pragma unroll
                for (int ai = 0; ai < 2; ++ai)
#pragma unroll
                    for (int m = 0; m < 4; ++m) { const int row = row0 + ai * HALF + m * 16; const float rs = row_rs<NP>(ssq, row);
                        float* p = dt + (size_t)row * 32 + 8 * fq; *(f32x4*)p = acc[ai][0][m][0] * rs; *(f32x4*)(p + 4) = acc[ai][0][m][1] * rs; }
            }
            return;
        }
        bf16_t* base = O + (size_t)(u.pn >> 2) * slot_elems; const int col0 = (u.pn & 3) * BM + wc * 32 + 8 * fq;
#pragma unroll
        for (int ai = 0; ai < 2; ++ai)
#pragma unroll
            for (int m = 0; m < 4; ++m) { const int row = row0 + ai * HALF + m * 16; const float rs = row_rs<NP>(ssq, row) * scale; bf16_t* rowp = base + (size_t)row * 1024 + col0;
#pragma unroll
                for (int bj = 0; bj < 2; ++bj) { const f32x4 v0 = acc[ai][bj][m][0] * rs, v1 = acc[ai][bj][m][1] * rs;
                    u32x4 w; w.x = cvt_pk_bf16(v0[0], v0[1]); w.y = cvt_pk_bf16(v0[2], v0[3]); w.z = cvt_pk_bf16(v1[0], v1[1]); w.w = cvt_pk_bf16(v1[2], v1[3]);
                    *(u32x4*)(rowp + bj * HALF) = w; } }
    }
};
struct EpiKV {
    static constexpr bool PERM = false, AFTER_DRAIN = false;
    float* mk; float* mv; bf16_t* kb; bf16_t* vt; const float* ssq;
    __device__ __forceinline__ void operator()(const f32x4 (&acc)[2][2][4][2], const Unit& u, int wr, int wc, int fr, int fq) const {
        const int row0 = u.pm * BM + wr * 64 + fr; const bool isv = u.pn >= 4; const int colt = (u.pn & 3) * BM + wc * 32 + 4 * fq;
#pragma unroll
        for (int ai = 0; ai < 2; ++ai)
#pragma unroll
            for (int m = 0; m < 4; ++m) { const int row = row0 + ai * HALF + m * 16; const float rs = row_rs<1>(ssq, row);
#pragma unroll
                for (int bj = 0; bj < 2; ++bj)
#pragma unroll
                    for (int n = 0; n < 2; ++n) { const int c = colt + bj * HALF + n * 16; const f32x4 v = acc[ai][bj][m][n] * rs;
                        if (!isv) { *(f32x4*)(mk + (size_t)row * 1024 + c) = v; u32x2 w; w.x = cvt_pk_bf16(v[0], v[1]); w.y = cvt_pk_bf16(v[2], v[3]); *(u32x2*)(kb + (size_t)row * 1024 + c) = w; }
                        else { *(f32x4*)(mv + (size_t)row * 1024 + c) = v; const int b = row >> 8, key = row & 255, hd = c >> 8, d = c & 255;
                            bf16_t* p = vt + ((size_t)((b * 4 + hd) * 256 + d)) * 256 + key; const unsigned w0 = cvt_pk_bf16(v[0], v[1]), w1 = cvt_pk_bf16(v[2], v[3]);
                            p[0] = (bf16_t)(w0 & 0xffffu); p[256] = (bf16_t)(w0 >> 16); p[512] = (bf16_t)(w1 & 0xffffu); p[768] = (bf16_t)(w1 >> 16); } } }
    }
};
template <bool ADD> struct EpiGate {
    static constexpr bool PERM = true, AFTER_DRAIN = false;
    bf16_t* O; const bf16_t* gate;
    __device__ __forceinline__ void operator()(const f32x4 (&acc)[2][2][4][2], const Unit& u, int wr, int wc, int fr, int fq) const {
        const int row0 = u.pm * BM + wr * 64 + fr, col0 = u.pn * BM + wc * 32 + 8 * fq;
#pragma unroll
        for (int ai = 0; ai < 2; ++ai)
#pragma unroll
            for (int m = 0; m < 4; ++m) { const size_t off = (size_t)(row0 + ai * HALF + m * 16) * 1024 + col0;
#pragma unroll
                for (int bj = 0; bj < 2; ++bj) { const u32x4 gw = *(const u32x4*)(gate + off + bj * HALF); u32x4 ow = (u32x4){0u, 0u, 0u, 0u}; if (ADD) ow = *(const u32x4*)(O + off + bj * HALF);
                    float r[8];
#pragma unroll
                    for (int e = 0; e < 8; ++e) { const unsigned g16 = (gw[e >> 1] >> ((e & 1) * 16)) & 0xffffu, o16 = (ow[e >> 1] >> ((e & 1) * 16)) & 0xffffu;
                        const float a = acc[ai][bj][m][e >> 2][e & 3]; r[e] = (ADD ? bfbits2f(o16) : 0.f) + sigm(bfbits2f(g16)) * a; }
                    u32x4 w; w.x = cvt_pk_bf16(r[0], r[1]); w.y = cvt_pk_bf16(r[2], r[3]); w.z = cvt_pk_bf16(r[4], r[5]); w.w = cvt_pk_bf16(r[6], r[7]);
                    *(u32x4*)(O + off + bj * HALF) = w; } }
    }
};
template <bool BF> struct EpiRes {
    static constexpr bool PERM = true, AFTER_DRAIN = false;
    const float* base0; const float* base1; bf16_t* hb; float* ssqp;
    __device__ __forceinline__ void operator()(const f32x4 (&acc)[2][2][4][2], const Unit& u, int wr, int wc, int fr, int fq) const {
        const int row0 = u.pm * BM + wr * 64 + fr, col0 = u.pn * BM + wc * 32 + 8 * fq; const float* base = u.pm < 64 ? base0 : base1;
#pragma unroll
        for (int ai = 0; ai < 2; ++ai)
#pragma unroll
            for (int m = 0; m < 4; ++m) { const int row = row0 + ai * HALF + m * 16; const size_t off = (size_t)row * 1024 + col0; float sq = 0.f;
#pragma unroll
                for (int bj = 0; bj < 2; ++bj) { const size_t o2 = off + bj * HALF; f32x4 b0, b1;
                    if (BF) { const u32x4 w = *(const u32x4*)(hb + o2); b0 = (f32x4){bfbits2f(w.x & 0xffffu), __uint_as_float(w.x & 0xffff0000u), bfbits2f(w.y & 0xffffu), __uint_as_float(w.y & 0xffff0000u)};
                        b1 = (f32x4){bfbits2f(w.z & 0xffffu), __uint_as_float(w.z & 0xffff0000u), bfbits2f(w.w & 0xffffu), __uint_as_float(w.w & 0xffff0000u)}; }
                    else { b0 = *(const f32x4*)(base + o2); b1 = *(const f32x4*)(base + o2 + 4); }
                    const f32x4 v0 = b0 + acc[ai][bj][m][0], v1 = b1 + acc[ai][bj][m][1];
                    sq += ((v0[0] * v0[0] + v0[1] * v0[1]) + (v0[2] * v0[2] + v0[3] * v0[3])) + ((v1[0] * v1[0] + v1[1] * v1[1]) + (v1[2] * v1[2] + v1[3] * v1[3]));
                    u32x4 w; w.x = cvt_pk_bf16(v0[0], v0[1]); w.y = cvt_pk_bf16(v0[2], v0[3]); w.z = cvt_pk_bf16(v1[0], v1[1]); w.w = cvt_pk_bf16(v1[2], v1[3]); *(u32x4*)(hb + o2) = w; }
                sq += __shfl_xor(sq, 16); sq += __shfl_xor(sq, 32);
                if (fq == 0) ssqp[(size_t)row * 16 + u.pn * 4 + wc] = sq; }
    }
};
struct EpiSwiglu {
    static constexpr bool PERM = true, AFTER_DRAIN = false;
    bf16_t* act; const float* ssq;
    __device__ __forceinline__ void operator()(const f32x4 (&acc)[2][2][4][2], const Unit& u, int wr, int wc, int fr, int fq) const {
        const int row0 = u.pm * BM + wr * 64 + fr, col0 = u.pn * 128 + wc * 16 + 4 * fq;
#pragma unroll
        for (int ai = 0; ai < 2; ++ai)
#pragma unroll
            for (int m = 0; m < 4; ++m) { const int row = row0 + ai * HALF + m * 16; const float rs = row_rs<16>(ssq, row);
#pragma unroll
                for (int bj = 0; bj < 2; ++bj) { const f32x4 a = acc[ai][bj][m][0] * rs, b = acc[ai][bj][m][1] * rs;
                    const float r0 = a[0] * sigm(a[0]) * a[1], r1 = a[2] * sigm(a[2]) * a[3], r2 = b[0] * sigm(b[0]) * b[1], r3 = b[2] * sigm(b[2]) * b[3];
                    u32x2 w; w.x = cvt_pk_bf16(r0, r1); w.y = cvt_pk_bf16(r2, r3); *(u32x2*)(act + (size_t)row * 2816 + col0 + bj * 64) = w; } }
    }
};
template <class Epi, class Sched, bool ALIGN_EPI = false, bool SP2 = false>
__device__ __forceinline__ void gemm_phase(PG8_LAS unsigned char* lds, const Gemm g, const Sched& S, const Epi& E) {
    const int tid = threadIdx.x, wid = __builtin_amdgcn_readfirstlane(tid >> 6), lane = tid & 63, wr = wid >> 2, wc = wid & 3, fr = lane & 15, fq = lane >> 4;
    const int K = g.K, nt = K / BK;
    unsigned voffA[2], voffB[2];
#pragma unroll
    for (int i = 0; i < 2; ++i) { int R, C; stage_rc(tid * 16 + i * 8192, R, C); const int Rb = Epi::PERM ? ((R & ~31) + perm32(R & 31)) : R;
        voffA[i] = (unsigned)(R * K + C) * 2u; voffB[i] = (unsigned)(Rb * K + C) * 2u; }
    const size_t kstep = (size_t)(BK * 2);
    const size_t hstep = (size_t)HALF * K * 2;
    const size_t tstep = 2 * hstep;
    const unsigned ldsw = (unsigned)wid * 1024u;
    const int aoff = lds_byte(wr * 64 + fr, fq * 8), boff = lds_byte(wc * 32 + fr, fq * 8);
#define PG8_SA(b, h) (((b) * 2 + (h)) * HTB)
#define PG8_SB(b, h) ((4 + (b) * 2 + (h)) * HTB)
#define PG8_STAGE(bufoff, gbase, voff) do { _Pragma("unroll") for (int _i = 0; _i < 2; ++_i) \
        __builtin_amdgcn_global_load_lds((const unsigned*)((const char*)(gbase) + (voff)[_i]), (PG8_LAS unsigned*)(lds + (bufoff) + ldsw + _i * 8192), 16, 0, 0); } while (0)
#define PG8_LDA(dst, b, h) do { _Pragma("unroll") for (int m = 0; m < 4; ++m) _Pragma("unroll") for (int k = 0; k < 2; ++k) dst[m][k] = *(const PG8_LAS bf16x8*)(lds + PG8_SA(b, h) + aoff + m * 2048 + k * 1024); } while (0)
#define PG8_LDB(dst, b, h) do { _Pragma("unroll") for (int n = 0; n < 2; ++n) _Pragma("unroll") for (int k = 0; k < 2; ++k) dst[n][k] = *(const PG8_LAS bf16x8*)(lds + PG8_SB(b, h) + boff + n * 2048 + k * 1024); } while (0)
#define PG8_MMA(ai, bj, At, Bt) do { __builtin_amdgcn_s_setprio(1); _Pragma("unroll") for (int m = 0; m < 4; ++m) _Pragma("unroll") for (int n = 0; n < 2; ++n) _Pragma("unroll") for (int k = 0; k < 2; ++k) \
        acc[ai][bj][m][n] = __builtin_amdgcn_mfma_f32_16x16x32_bf16(Bt[n][k], At[m][k], acc[ai][bj][m][n], 0, 0, 0); __builtin_amdgcn_s_setprio(0); } while (0)
#define PG8_WAIT_V(n) asm volatile("s_waitcnt vmcnt(" #n ")" ::: "memory")
#define PG8_WAIT_L(n) asm volatile("s_waitcnt lgkmcnt(" #n ")" ::: "memory")
#define PG8_BAR __builtin_amdgcn_s_barrier()
#define PG8_SCHED __builtin_amdgcn_sched_barrier(0)
    Unit cur, nxt; int ui = 0;
    if (!S.next(0, cur)) return;
    f32x4 acc[2][2][4][2];
#pragma unroll
    for (int a = 0; a < 2; ++a)
#pragma unroll
        for (int b = 0; b < 2; ++b)
#pragma unroll
            for (int m = 0; m < 4; ++m)
#pragma unroll
                for (int n = 0; n < 2; ++n) acc[a][b][m][n] = (f32x4){0.f, 0.f, 0.f, 0.f};
    bf16x8 At[4][2], B0[2][2], B1[2][2];
    const char* cA = (const char*)g.A + (size_t)cur.pm * tstep; const char* cB = (const char*)g.Bt + (size_t)cur.pn * tstep;
    S.a_ready(cur);
    if constexpr (SP2) {
        PG8_STAGE(PG8_SB(0, 0), cB, voffB); PG8_STAGE(PG8_SB(0, 1), cB + hstep, voffB); PG8_STAGE(PG8_SA(0, 0), cA, voffA); PG8_STAGE(PG8_SA(0, 1), cA + hstep, voffA);
        if (wr == 1) PG8_BAR;
        PG8_WAIT_V(2); PG8_BAR;
        PG8_STAGE(PG8_SB(1, 0), cB + kstep, voffB); PG8_STAGE(PG8_SA(1, 0), cA + kstep, voffA); PG8_STAGE(PG8_SB(1, 1), cB + hstep + kstep, voffB);
        PG8_WAIT_V(6); PG8_BAR;
    } else {
        PG8_STAGE(PG8_SB(0, 0), cB, voffB); PG8_STAGE(PG8_SA(0, 0), cA, voffA); PG8_STAGE(PG8_SB(0, 1), cB + hstep, voffB); PG8_STAGE(PG8_SA(0, 1), cA + hstep, voffA);
        if (wr == 1) PG8_BAR;
        PG8_WAIT_V(4); PG8_BAR;
        PG8_STAGE(PG8_SB(1, 0), cB + kstep, voffB); PG8_STAGE(PG8_SA(1, 0), cA + kstep, voffA); PG8_STAGE(PG8_SB(1, 1), cB + hstep + kstep, voffB);
        PG8_WAIT_V(6); PG8_BAR;
    }
    for (;;) {
        const bool has_next = S.next(ui + 1, nxt);
        const char* nA = has_next ? (const char*)g.A + (size_t)nxt.pm * tstep : cA; const char* nB = has_next ? (const char*)g.Bt + (size_t)nxt.pn * tstep : cB;
        for (int t = 0; t < nt; t += 2) {
            const bool last = (t == nt - 2);
            const char* a1 = cA + (size_t)(t + 1) * kstep;
            const char* a2 = last ? nA : cA + (size_t)(t + 2) * kstep; const char* b2 = last ? nB : cB + (size_t)(t + 2) * kstep;
            const char* a3 = a2 + kstep; const char* b3 = b2 + kstep;
            if (last && has_next) S.a_ready(nxt);
            if constexpr (SP2) {
            PG8_LDB(B0, 0, 0); PG8_LDB(B1, 0, 1); PG8_SCHED; PG8_LDA(At, 0, 0); PG8_STAGE(PG8_SA(1, 1), a1 + hstep, voffA);
            PG8_WAIT_V(8); PG8_WAIT_L(0); PG8_BAR; PG8_MMA(0, 0, At, B0); PG8_MMA(0, 1, At, B1); PG8_BAR; PG8_SCHED;
            PG8_LDA(At, 0, 1); PG8_STAGE(PG8_SB(0, 0), b2, voffB); PG8_STAGE(PG8_SB(0, 1), b2 + hstep, voffB); PG8_STAGE(PG8_SA(0, 0), a2, voffA);
            PG8_WAIT_V(8); PG8_WAIT_L(0); PG8_BAR; PG8_MMA(1, 0, At, B0); PG8_MMA(1, 1, At, B1); PG8_BAR; PG8_SCHED;
            PG8_LDB(B0, 1, 0); PG8_LDB(B1, 1, 1); PG8_SCHED; PG8_LDA(At, 1, 0); PG8_STAGE(PG8_SA(0, 1), a2 + hstep, voffA);
            PG8_WAIT_V(8); PG8_WAIT_L(0); PG8_BAR; PG8_MMA(0, 0, At, B0); PG8_MMA(0, 1, At, B1); PG8_BAR; PG8_SCHED;
            PG8_LDA(At, 1, 1); PG8_STAGE(PG8_SB(1, 0), b3, voffB); PG8_STAGE(PG8_SB(1, 1), b3 + hstep, voffB); PG8_STAGE(PG8_SA(1, 0), a3, voffA);
            PG8_WAIT_V(8); PG8_WAIT_L(0); PG8_BAR; PG8_MMA(1, 0, At, B0); PG8_MMA(1, 1, At, B1); PG8_BAR; PG8_SCHED;
            } else {
            PG8_LDB(B0, 0, 0); PG8_SCHED; PG8_LDA(At, 0, 0); PG8_STAGE(PG8_SA(1, 1), a1 + hstep, voffA);
            PG8_WAIT_L(8); PG8_BAR; PG8_WAIT_L(0); PG8_MMA(0, 0, At, B0); PG8_BAR; PG8_SCHED;
            PG8_LDB(B1, 0, 1); PG8_STAGE(PG8_SB(0, 0), b2, voffB);
            PG8_BAR; PG8_WAIT_L(0); PG8_MMA(0, 1, At, B1); PG8_BAR;
            PG8_LDA(At, 0, 1); PG8_STAGE(PG8_SA(0, 0), a2, voffA);
            PG8_BAR; PG8_WAIT_L(0); PG8_MMA(1, 0, At, B0); PG8_BAR; PG8_SCHED;
            PG8_STAGE(PG8_SB(0, 1), b2 + hstep, voffB);
            PG8_WAIT_V(6); PG8_BAR; PG8_MMA(1, 1, At, B1); PG8_BAR;
            PG8_LDB(B0, 1, 0); PG8_SCHED; PG8_LDA(At, 1, 0); PG8_STAGE(PG8_SA(0, 1), a2 + hstep, voffA);
            PG8_WAIT_L(8); PG8_BAR; PG8_WAIT_L(0); PG8_MMA(0, 0, At, B0); PG8_BAR; PG8_SCHED;
            PG8_LDB(B1, 1, 1); PG8_STAGE(PG8_SB(1, 0), b3, voffB);
            PG8_BAR; PG8_WAIT_L(0); PG8_MMA(0, 1, At, B1); PG8_BAR;
            PG8_LDA(At, 1, 1); PG8_STAGE(PG8_SA(1, 0), a3, voffA);
            PG8_BAR; PG8_WAIT_L(0); PG8_MMA(1, 0, At, B0); PG8_BAR; PG8_SCHED;
            PG8_STAGE(PG8_SB(1, 1), b3 + hstep, voffB);
            PG8_WAIT_V(6); PG8_BAR; PG8_MMA(1, 1, At, B1); PG8_BAR;
            }
        }
        if constexpr (ALIGN_EPI) { if (wr == 0) PG8_BAR; }
        if constexpr (!Epi::AFTER_DRAIN) { E(acc, cur, wr, wc, fr, fq); S.done(cur); }
        if (!has_next) break;
#pragma unroll
        for (int a = 0; a < 2; ++a)
#pragma unroll
            for (int b = 0; b < 2; ++b)
#pragma unroll
                for (int m = 0; m < 4; ++m)
#pragma unroll
                    for (int n = 0; n < 2; ++n) acc[a][b][m][n] = (f32x4){0.f, 0.f, 0.f, 0.f};
        cur = nxt; cA = nA; cB = nB; ++ui;
        if constexpr (ALIGN_EPI) { if (wr == 1) PG8_BAR; }
    }
    PG8_WAIT_V(0);
    if constexpr (!ALIGN_EPI) { if (wr == 0) PG8_BAR; }
    PG8_BAR;
    if constexpr (Epi::AFTER_DRAIN) { E.fused(acc, cur, wr, wc, fr, fq, lds, wid, lane); S.done(cur); }
#undef PG8_SA
#undef PG8_SB
#undef PG8_STAGE
#undef PG8_LDA
#undef PG8_LDB
#undef PG8_MMA
#undef PG8_WAIT_V
#undef PG8_WAIT_L
#undef PG8_BAR
#undef PG8_SCHED
}
}
#define GAS __attribute__((address_space(1)))
#define LAS __attribute__((address_space(3)))
typedef unsigned short bf16;
typedef unsigned v4u __attribute__((ext_vector_type(4)));
typedef float f32x4 __attribute__((ext_vector_type(4)));
typedef short bf16x8 __attribute__((ext_vector_type(8)));
typedef GAS unsigned gu32;
typedef GAS unsigned long long gu64;
#define RLX_AGENT __ATOMIC_RELAXED, __HIP_MEMORY_SCOPE_AGENT
#define LDS_WAIT() asm volatile("s_waitcnt lgkmcnt(0)" ::: "memory")
#define VM_WAIT() asm volatile("s_waitcnt vmcnt(0)" ::: "memory")
__device__ __forceinline__ unsigned long long rt() { return __builtin_amdgcn_s_memrealtime(); }
typedef float f32x2_t __attribute__((ext_vector_type(2))); typedef __bf16 bf16x2_t __attribute__((ext_vector_type(2)));
__device__ __forceinline__ unsigned pk2(float lo, float hi) { const f32x2_t v = {lo, hi}; const bf16x2_t b = __builtin_convertvector(v, bf16x2_t); return __builtin_bit_cast(unsigned, b); }
__device__ __forceinline__ unsigned f2bf(float f) { return pk2(f, 0.f) & 0xffffu; }

#define XB_TMO      128
#define XB_XCNT(j)  (256  + 64 * (j))
#define XB_XSUB(j)  (1280 + 64 * (j))
#define XB_XGEN(j)  (2304 + 64 * (j))
#define XB_TOP      3328
#define XB_TOPGEN   3392
#define XCD_BAR_WORDS 3456
#define XB_SPIN_CAP (1u << 18)

__device__ __forceinline__ unsigned xb_ld(unsigned* p)              { return __hip_atomic_load(p, __ATOMIC_RELAXED, __HIP_MEMORY_SCOPE_AGENT); }
__device__ __forceinline__ unsigned xb_add(unsigned* p, unsigned v) { return __hip_atomic_fetch_add(p, v, __ATOMIC_RELAXED, __HIP_MEMORY_SCOPE_AGENT); }
__device__ __forceinline__ unsigned xb_xcc_id() { return (unsigned)__builtin_amdgcn_s_getreg((3 << 11) | 20) & 0xFu; }
#define XB_SPIN(cond, bar) do { unsigned _sp = 0; while (cond) { __builtin_amdgcn_s_sleep(1); \
    if ((++_sp & 255u) == 0u) { if (xb_ld(&(bar)[XB_TMO])) break; if (_sp > XB_SPIN_CAP) { atomicAdd(&(bar)[XB_TMO], 1u); break; } } } } while (0)

struct XcdBarrier {
    unsigned* bar; unsigned x;
    volatile LAS unsigned* st;
};

__device__ __forceinline__ XcdBarrier xcd_barrier_post(unsigned* bar, volatile LAS unsigned* st) {
    XcdBarrier b; b.bar = bar; b.x = xb_xcc_id(); b.st = st;
    if (threadIdx.x == 0) (void)xb_add(&bar[XB_XCNT(b.x)], 1u);
    return b;
}
__device__ __forceinline__ void xcd_barrier_complete(unsigned* bar, unsigned x, unsigned& nloc, unsigned& nx) {
    const unsigned G = gridDim.x * gridDim.y * gridDim.z;
    unsigned sum, cnt, mine, sp = 0u;
    for (;;) {
        sum = 0u; cnt = 0u; mine = 0u;
#pragma unroll
        for (unsigned j = 0; j < 16; ++j) { const unsigned c = xb_ld(&bar[XB_XCNT(j)]); sum += c; cnt += (c > 0u) ? 1u : 0u; mine = (j == x) ? c : mine; }
        if (sum == G) break;
        __builtin_amdgcn_s_sleep(1);
        if ((++sp & 255u) == 0u) { if (xb_ld(&bar[XB_TMO])) break; if (sp > XB_SPIN_CAP) { atomicAdd(&bar[XB_TMO], 1u); break; } }
    }
    nloc = mine > 0u ? mine : 1u; nx = cnt > 0u ? cnt : 1u;
}

__device__ __forceinline__ void xcd_barrier(const XcdBarrier& b) {
    asm volatile("s_waitcnt vmcnt(0)" ::: "memory");
    __syncthreads();
    if (threadIdx.x == 0) {
        unsigned* bar = b.bar;
        __builtin_amdgcn_s_waitcnt(0);
        unsigned nloc = b.st[0], nx = b.st[1];
        if (nloc == 0u) { xcd_barrier_complete(bar, b.x, nloc, nx); b.st[0] = nloc; b.st[1] = nx; }
        const unsigned old = xb_add(&bar[XB_XSUB(b.x)], 1u);
        const unsigned gen = old / nloc;
        if (old + 1u == (gen + 1u) * nloc) {
            __builtin_amdgcn_fence(__ATOMIC_RELEASE, "agent");
            asm volatile("s_waitcnt vmcnt(0)" ::: "memory");
            const unsigned og = xb_add(&bar[XB_TOP], 1u);
            const unsigned tg = og / nx;
            if (og + 1u == (tg + 1u) * nx) xb_add(&bar[XB_TOPGEN], 1u);
            else XB_SPIN(xb_ld(&bar[XB_TOPGEN]) == tg, bar);
            __builtin_amdgcn_fence(__ATOMIC_ACQUIRE, "agent");
            xb_add(&bar[XB_XGEN(b.x)], 1u);
            asm volatile("s_waitcnt vmcnt(0)" ::: "memory");
        } else {
            XB_SPIN(xb_ld(&bar[XB_XGEN(b.x)]) == gen, bar);
            __builtin_amdgcn_fence(__ATOMIC_ACQUIRE, "agent");
            asm volatile("s_waitcnt vmcnt(0)" ::: "memory");
        }
    }
    __syncthreads();
}
typedef unsigned v2u __attribute__((ext_vector_type(2)));
constexpr int NWAVES = 8, NTHR = 512;
constexpr int DM = 1024, TP = 16384, TS = 512, T = TP + TS;
constexpr int SEQ = 2048, NBP = 8, NBS = 128, LS = 4, MEMR = 2048;
constexpr int NPROJ = 11520;
constexpr int FFN = 2816;
constexpr float EPS = 1e-6f;
constexpr float QSCALE = 0.0625f * 1.4426950408889634f;

constexpr size_t MiB = 1u << 20;
constexpr size_t WS_CTL = 0, CTL_ZERO_BYTES = 1 * MiB;
constexpr size_t WS_SSQX = 1 * MiB, WS_SSQM = 1 * MiB + 512 * 1024;
constexpr size_t WS_DT = 2 * MiB, WS_SSQSSD = 5 * MiB, WS_SSQP1 = 8 * MiB, WS_SSQP2 = 9 * MiB + 512 * 1024, WS_SSQP3 = 11 * MiB;
constexpr size_t WS_WIN = 13 * MiB, WS_WKV = 36 * MiB, WS_WSSD = 40 * MiB, WS_WHG = 44 * MiB, WS_WOUT = 46 * MiB, WS_WCQ = 48 * MiB, WS_WCO = 50 * MiB, WS_WGU = 52 * MiB, WS_WDN = 63 * MiB;
constexpr size_t WS_XB = 69 * MiB, WS_MNB = 102 * MiB, WS_KB = 106 * MiB, WS_VT = 110 * MiB;
constexpr size_t SLOT = 33 * MiB, SLOT_ELEMS = (size_t)T * 1024;
constexpr size_t WS_PROJ = 114 * MiB;
constexpr size_t WS_YG = WS_PROJ + 11 * SLOT, WS_ON = WS_YG + 2 * SLOT, WS_END = WS_ON + SLOT;
static_assert(SLOT == SLOT_ELEMS * 2, "slot size");
static_assert(WS_WIN + (size_t)NPROJ * 1024 * 2 <= WS_WKV && WS_WGU + (size_t)2 * FFN * 1024 * 2 <= WS_WDN && WS_WDN + (size_t)1024 * FFN * 2 <= WS_XB && WS_SSQP3 + (size_t)T * 64 <= WS_WIN, "d_ws map");
static_assert(WS_DT + (size_t)T * 128 <= WS_SSQSSD && WS_SSQSSD + (size_t)T * 128 <= WS_SSQP1 && WS_SSQP1 + (size_t)T * 64 <= WS_SSQP2 && WS_SSQP2 + (size_t)T * 64 <= WS_SSQP3, "d_ws map 2");
enum { S_Z0 = 0, S_Z1 = 1, S_X0 = 2, S_X1 = 3, S_X2 = 4, S_Q = 5, S_F = 6, S_I = 7, S_HG = 8, S_GS = 9, S_GH = 10 };
constexpr size_t WS_MERGED = WS_PROJ + S_Q * SLOT, WS_HB = WS_PROJ + S_F * SLOT, WS_QB = WS_PROJ + S_I * SLOT, WS_OB = WS_PROJ + S_HG * SLOT, WS_ACT = WS_PROJ;
static_assert((size_t)T * FFN * 2 <= 3 * SLOT, "act overlay");
constexpr size_t O_Y = 0, O_SSMP = (size_t)T * 1024, O_CONVP = O_SSMP + 2097152, O_HGP = O_CONVP + 73728, O_MKP = O_HGP + 1048576, O_MVP = O_MKP + 2097152,
                 O_SSMS = O_MVP + 2097152, O_CONVS = O_SSMS + 33554432, O_HGS = O_CONVS + 1179648, O_END = O_HGS + 16777216;
constexpr int CW_QUEUE = 64;
constexpr int CW_BAR = 4096;
constexpr int RING_OFF = 0, RING_BYTES = 131072;
constexpr int LDS_BYTES = 147456;
constexpr int LDSCTL_OFF = LDS_BYTES - 1024, MISC_OFF = LDSCTL_OFF + 320;
struct Frame {
    LAS unsigned char* lds;
    volatile LAS unsigned* MISC;
    gu32* ctl;
    int tid, lane, wave;
    int vcu, G;
    const float* in[32];
    float* out; unsigned char* ws;
};
__device__ __forceinline__ float bf2f(unsigned v16) { return __uint_as_float(v16 << 16); }
__device__ __forceinline__ float sigmoid_f(float x) { return __builtin_amdgcn_rcpf(1.0f + __expf(-x)); }
__device__ __forceinline__ float silu_f(float x) { return x * sigmoid_f(x); }
__device__ __forceinline__ float wave_sum(float v) {
#pragma unroll
    for (int o = 1; o < 64; o <<= 1) v += __shfl_xor(v, o);
    return v;
}
__device__ __forceinline__ float wave_max(float v) {
#pragma unroll
    for (int o = 1; o < 64; o <<= 1) v = fmaxf(v, __shfl_xor(v, o));
    return v;
}
struct TSrc { const float* W; const float* W2; const float* ks; int ldw; int mode; };
__device__ __forceinline__ void p0_transpose_item(const TSrc& s, int K, int N, bf16* WT, LAS unsigned short* scr, int item, int lane) {
    const int nblk = N / 64, kb = item / nblk, nb = item % nblk, k0 = 64 * kb, n0 = 64 * nb;
    const int kr = lane >> 4, nq = lane & 15;
    const float* const Wa = s.W; const float* const Wb = s.W2;
    const float* src; int c0, cs; bool zero = false;
    if (s.mode == 2) { const float* wsel = Wa; if (nq >= 8) wsel = Wb; src = wsel + (n0 >> 1) + 4 * (nq & 7); c0 = 8 * (nq & 7) + (nq >> 3); cs = 2; }
    else { const int n = n0 + 4 * nq; c0 = 4 * nq; cs = 1;
        if (s.mode == 0) src = Wa + n;
        else if (s.mode == 1) { if (n < 5120) src = Wa + n; else if (n < 11264) src = Wa + n + 32; else if (n < 11296) src = Wa + 5120 + (n - 11264); else { src = Wa; zero = true; } }
        else { src = Wa + n; if (n >= 1024) src = Wb + (n - 1024); } }
    f32x4 v[16];
#pragma unroll
    for (int i = 0; i < 16; ++i) v[i] = zero ? (f32x4){0.f, 0.f, 0.f, 0.f} : *(const f32x4*)(src + (size_t)(k0 + 4 * i + kr) * s.ldw);
#pragma unroll
    for (int i = 0; i < 16; ++i) { const int kk = 4 * i + kr; const float sc = s.ks ? s.ks[k0 + kk] : 1.0f; const unsigned w0 = pk2(v[i].x * sc, v[i].y * sc), w1 = pk2(v[i].z * sc, v[i].w * sc);
        LAS unsigned short* d = scr + kk * 66 + c0;
        if (cs == 1) { *(LAS unsigned*)d = w0; *(LAS unsigned*)(d + 2) = w1; }
        else { d[0] = (unsigned short)(w0 & 0xffffu); d[2] = (unsigned short)(w0 >> 16); d[4] = (unsigned short)(w1 & 0xffffu); d[6] = (unsigned short)(w1 >> 16); } }
    LDS_WAIT(); asm volatile("" ::: "memory");
    const int nr = lane >> 3, kc = lane & 7;
#pragma unroll
    for (int j = 0; j < 8; ++j) { const int n = 8 * j + nr; const LAS unsigned short* p = scr + (8 * kc) * 66 + n;
        v4u o; o.x = (unsigned)p[0] | ((unsigned)p[66] << 16); o.y = (unsigned)p[2 * 66] | ((unsigned)p[3 * 66] << 16); o.z = (unsigned)p[4 * 66] | ((unsigned)p[5 * 66] << 16); o.w = (unsigned)p[6 * 66] | ((unsigned)p[7 * 66] << 16);
        *(v4u*)(WT + (size_t)(n0 + n) * K + k0 + 8 * kc) = o; }
    LDS_WAIT(); asm volatile("" ::: "memory");
}
__device__ __forceinline__ void rows4_to_bf16_ssq(const float* x0, bf16* o0, float* ssq0, int lane) {
    f32x4 v[4][4];
#pragma unroll
    for (int rr = 0; rr < 4; ++rr)
#pragma unroll
        for (int j = 0; j < 4; ++j) v[rr][j] = ((const f32x4*)(x0 + rr * 1024))[64 * j + lane];
#pragma unroll
    for (int rr = 0; rr < 4; ++rr) { float sq = 0.f;
#pragma unroll
        for (int j = 0; j < 4; ++j) sq += (v[rr][j].x * v[rr][j].x + v[rr][j].y * v[rr][j].y) + (v[rr][j].z * v[rr][j].z + v[rr][j].w * v[rr][j].w);
        sq = wave_sum(sq);
        unsigned long long* o8 = (unsigned long long*)(o0 + rr * 1024) + lane;
#pragma unroll
        for (int j = 0; j < 4; ++j) o8[64 * j] = (unsigned long long)pk2(v[rr][j].x, v[rr][j].y) | ((unsigned long long)pk2(v[rr][j].z, v[rr][j].w) << 32);
        if (lane == 0) ssq0[rr] = sq; }
}
__device__ __forceinline__ void p0_prologue(Frame& F) {
    LAS unsigned short* scr = (LAS unsigned short*)(F.lds + RING_OFF + F.wave * 16384);
    const int gw = F.vcu * NWAVES + F.wave, NGW = F.G * NWAVES;
    unsigned char* ws = F.ws;
    constexpr int I_IN = 16 * (NPROJ / 64), I_KV = 16 * 32, I_SSD = 32 * 16, I_SQ = 16 * 16, I_GU = 16 * (2 * FFN / 64), I_DN = (FFN / 64) * 16;
    constexpr int NITEMS = I_IN + I_KV + I_SSD + 4 * I_SQ + I_GU + I_DN;
    for (int it = gw; it < NITEMS; it += NGW) {
        int r = it;
        if (r < I_IN) { TSrc s{F.in[9], nullptr, F.in[8], 11296, 1}; p0_transpose_item(s, 1024, NPROJ, (bf16*)(ws + WS_WIN), scr, r, F.lane); continue; } r -= I_IN;
        if (r < I_KV) { TSrc s{F.in[24], F.in[25], F.in[22], 1024, 3}; p0_transpose_item(s, 1024, 2048, (bf16*)(ws + WS_WKV), scr, r, F.lane); continue; } r -= I_KV;
        if (r < I_SSD) { TSrc s{F.in[16], nullptr, F.in[15], 1024, 0}; p0_transpose_item(s, 2048, 1024, (bf16*)(ws + WS_WSSD), scr, r, F.lane); continue; } r -= I_SSD;
        if (r < I_SQ) { TSrc s{F.in[19], nullptr, F.in[18], 1024, 0}; p0_transpose_item(s, 1024, 1024, (bf16*)(ws + WS_WHG), scr, r, F.lane); continue; } r -= I_SQ;
        if (r < I_SQ) { TSrc s{F.in[20], nullptr, nullptr, 1024, 0}; p0_transpose_item(s, 1024, 1024, (bf16*)(ws + WS_WOUT), scr, r, F.lane); continue; } r -= I_SQ;
        if (r < I_SQ) { TSrc s{F.in[23], nullptr, F.in[21], 1024, 0}; p0_transpose_item(s, 1024, 1024, (bf16*)(ws + WS_WCQ), scr, r, F.lane); continue; } r -= I_SQ;
        if (r < I_SQ) { TSrc s{F.in[26], nullptr, nullptr, 1024, 0}; p0_transpose_item(s, 1024, 1024, (bf16*)(ws + WS_WCO), scr, r, F.lane); continue; } r -= I_SQ;
        if (r < I_GU) { TSrc s{F.in[28], F.in[29], F.in[27], FFN, 2}; p0_transpose_item(s, 1024, 2 * FFN, (bf16*)(ws + WS_WGU), scr, r, F.lane); continue; } r -= I_GU;
        { TSrc s{F.in[30], nullptr, nullptr, 1024, 0}; p0_transpose_item(s, FFN, 1024, (bf16*)(ws + WS_WDN), scr, r, F.lane); }
    }
    bf16* XB = (bf16*)(ws + WS_XB); float* SSQX = (float*)(ws + WS_SSQX);
    for (int m4 = gw; m4 < T / 4; m4 += NGW) { const int m = 4 * m4;
        rows4_to_bf16_ssq(m < TP ? F.in[0] + (size_t)m * DM : F.in[1] + (size_t)(m - TP) * DM, XB + (size_t)m * DM, SSQX + m, F.lane); }
    bf16* MNB = (bf16*)(ws + WS_MNB); float* SSQM = (float*)(ws + WS_SSQM);
    for (int m4 = gw; m4 < MEMR / 4; m4 += NGW) { const int m = 4 * m4; rows4_to_bf16_ssq(F.in[2] + (size_t)m * DM, MNB + (size_t)m * DM, SSQM + m, F.lane); }
}
__device__ __forceinline__ void conv_copy_unit(Frame& F, int gb) {
    const bf16* PROJ = (const bf16*)(F.ws + WS_PROJ);
    const bool prompt = gb < NBP; const int sb = gb - NBP;
    const size_t row0 = prompt ? (size_t)gb * SEQ + (SEQ - 3) : (size_t)TP + (size_t)sb * LS + 1;
    float* dst = prompt ? F.out + O_CONVP + (size_t)gb * 3 * 3072 : F.out + O_CONVS + (size_t)sb * 3 * 3072;
    for (int e = F.tid; e < 3 * 3072; e += NTHR) { const int j = e / 3072, col = e % 3072;
        dst[e] = bf2f(PROJ[(size_t)(S_X0 + (col >> 10)) * SLOT_ELEMS + (row0 + j) * 1024 + (col & 1023)]); }
}
__device__ __forceinline__ void ssdnorm_phase(Frame& F) {
    const int gw = F.vcu * NWAVES + F.wave, NGW = F.G * NWAVES; bf16* YG = (bf16*)(F.ws + WS_YG); const float* SSQ = (const float*)(F.ws + WS_SSQSSD);
    for (int row = gw; row < T; row += NGW) {
        const f32x4* sp = (const f32x4*)(SSQ + (size_t)row * 32);
#pragma unroll
        for (int j = 0; j < 4; ++j) { const f32x4 a = sp[2 * j], b = sp[2 * j + 1]; const float s = ((a.x + a.y) + (a.z + a.w)) + ((b.x + b.y) + (b.z + b.w)); const float rs = 1.0f / sqrtf(s * (1.0f / 512.0f) + EPS);
            v4u* p = (v4u*)(YG + (size_t)row * 2048) + j * 64 + F.lane; const v4u w = *p; v4u o;
#pragma unroll
            for (int e = 0; e < 4; ++e) o[e] = pk2(bf2f(w[e] & 0xffffu) * rs, bf2f(w[e] >> 16) * rs);
            *p = o; }
    }
}
typedef float f32x16 __attribute__((ext_vector_type(16)));
#define MFMA32(a, b, c) __builtin_amdgcn_mfma_f32_32x32x16_bf16((a), (b), (c), 0, 0, 0)
__device__ __forceinline__ unsigned cvtpk_c(float lo, float hi) { return pk2(lo, hi); }
__device__ __forceinline__ bf16x8 pack8(float a0, float a1, float a2, float a3, float a4, float a5, float a6, float a7) {
    v4u w; w.x = cvtpk_c(a0, a1); w.y = cvtpk_c(a2, a3); w.z = cvtpk_c(a4, a5); w.w = cvtpk_c(a6, a7); return __builtin_bit_cast(bf16x8, w); }
#define ACC_FRAG(x, s) pack8((x)[8 * (s)], (x)[8 * (s) + 1], (x)[8 * (s) + 2], (x)[8 * (s) + 3], (x)[8 * (s) + 4], (x)[8 * (s) + 5], (x)[8 * (s) + 6], (x)[8 * (s) + 7])
__device__ __forceinline__ bf16x8 lds_frag16(const LAS unsigned char* p) { return *(const LAS bf16x8*)p; }
__device__ __forceinline__ bf16x8 lds_frag8x2(const LAS unsigned char* p) { const v2u lo = *(const LAS v2u*)p, hi = *(const LAS v2u*)(p + 16);
    const v4u w = (v4u){lo.x, lo.y, hi.x, hi.y}; return __builtin_bit_cast(bf16x8, w); }
#define LDS_BARRIER() do { asm volatile("s_waitcnt lgkmcnt(0)" ::: "memory"); __builtin_amdgcn_s_barrier(); asm volatile("" ::: "memory"); } while (0)
constexpr size_t WS_BCS = WS_END, WS_BTT = WS_BCS + (size_t)TP * 1024 * 2, WS_END2 = WS_BTT + (size_t)NBP * 32 * 4 * 128 * 64 * 2;
__device__ __forceinline__ void bc_prep_unit(Frame& F, int b, int c) {
    typedef float f32x2 __attribute__((ext_vector_type(2)));
    int tid_o = F.tid; asm volatile("" : "+v"(tid_o));
    const int tid = tid_o, cg = tid & 127, seg = tid >> 7; unsigned char* ws = F.ws;
    const bf16* src = (const bf16*)(ws + WS_PROJ) + (size_t)S_X2 * SLOT_ELEMS + (size_t)b * SEQ * 1024 + 8 * cg;
    bf16* BCS = (bf16*)(ws + WS_BCS); bf16* BTT = (bf16*)(ws + WS_BTT);
    const float* cw = F.in[10] + 2048 + 8 * cg; const float* cbp = F.in[11] + 2048 + 8 * cg;
#pragma unroll 1
    for (int half = 0; half < 2; ++half) {
        const int s0 = 16 * seg + 8 * half;
        v4u raw[11];
#pragma unroll
        for (int i = 0; i < 11; ++i) { const int gt = 64 * c + s0 - 3 + i; raw[i] = (v4u){0u, 0u, 0u, 0u}; if (gt >= 0) raw[i] = *(const v4u*)(src + (size_t)gt * 1024); }
        v4u rowpk[8];
#pragma unroll
        for (int kp = 0; kp < 4; ++kp) {
            const f32x2 cw0 = *(const f32x2*)(cw + 2 * kp), cw1 = *(const f32x2*)(cw + 3072 + 2 * kp), cw2 = *(const f32x2*)(cw + 2 * 3072 + 2 * kp), cw3 = *(const f32x2*)(cw + 3 * 3072 + 2 * kp), cbb = *(const f32x2*)(cbp + 2 * kp);
            f32x2 xv[11];
#pragma unroll
            for (int i = 0; i < 11; ++i) { const unsigned wd = raw[i][kp]; xv[i] = (f32x2){__uint_as_float(wd << 16), __uint_as_float(wd & 0xffff0000u)}; }
            f32x2 o[8];
#pragma unroll
            for (int i = 0; i < 8; ++i) { f32x2 a = cw0 * xv[i] + cbb; a = cw1 * xv[i + 1] + a; a = cw2 * xv[i + 2] + a; a = cw3 * xv[i + 3] + a;
                const f32x2 t = a * (-1.4426950408889634f); f32x2 e; e.x = __builtin_amdgcn_exp2f(t.x); e.y = __builtin_amdgcn_exp2f(t.y); e = e + 1.0f;
                f32x2 rc; rc.x = __builtin_amdgcn_rcpf(e.x); rc.y = __builtin_amdgcn_rcpf(e.y); o[i] = a * rc; }
#pragma unroll
            for (int i = 0; i < 8; ++i) rowpk[i][kp] = pk2(o[i].x, o[i].y);
            if (cg < 64) { const int ng = 8 * cg + 2 * kp, g = ng >> 7, n = ng & 127;
                bf16* dst = BTT + ((size_t)(((b * 32 + c) * 4 + g) * 128 + n)) * 64 + s0;
                v4u pa; pa.x = pk2(o[0].x, o[1].x); pa.y = pk2(o[2].x, o[3].x); pa.z = pk2(o[4].x, o[5].x); pa.w = pk2(o[6].x, o[7].x); *(v4u*)dst = pa;
                v4u pb; pb.x = pk2(o[0].y, o[1].y); pb.y = pk2(o[2].y, o[3].y); pb.z = pk2(o[4].y, o[5].y); pb.w = pk2(o[6].y, o[7].y); *(v4u*)(dst + 64) = pb; }
        }
        bf16* drow = BCS + ((size_t)b * SEQ + 64 * c + s0) * 1024 + 8 * cg;
#pragma unroll
        for (int i = 0; i < 8; ++i) *(v4u*)(drow + (size_t)i * 1024) = rowpk[i];
    }
}
__device__ __forceinline__ void bc_prep_phase(Frame& F) { for (int u = F.vcu; u < NBP * 32; u += F.G) bc_prep_unit(F, u >> 5, u & 31); }
constexpr size_t WS_HVT = WS_XB, WS_EGM = WS_END2, WS_EGL = WS_EGM + (size_t)NBP * 64 * 1024 * 4, WS_END3 = WS_EGL + (size_t)NBP * 64 * 1024 * 4;
__device__ __forceinline__ void hg_prep_unit(Frame& F, int b, int c) {
    typedef float f32x2 __attribute__((ext_vector_type(2)));
    int tid_o = F.tid; asm volatile("" : "+v"(tid_o));
    const int tid = tid_o; unsigned char* ws = F.ws;
    const int ch = 2 * tid, hd = ch >> 7, k = ch & 127;
    const size_t row0 = (size_t)b * SEQ + 32 * c;
    bf16* QS = (bf16*)(ws + WS_PROJ) + (size_t)S_Q * SLOT_ELEMS + row0 * 1024 + ch; bf16* FS = (bf16*)(ws + WS_PROJ) + (size_t)S_F * SLOT_ELEMS + row0 * 1024 + ch;
    bf16* IS = (bf16*)(ws + WS_PROJ) + (size_t)S_I * SLOT_ELEMS + row0 * 1024;
    const f32x2 l0 = *(const f32x2*)(F.in[17] + ch), l1 = *(const f32x2*)(F.in[17] + 1024 + ch);
    f32x2 lb; lb.x = __builtin_amdgcn_rcpf(1.0f + __expf(l1.x - l0.x)); lb.y = __builtin_amdgcn_rcpf(1.0f + __expf(l1.y - l0.y));
    const f32x2 omlb = 1.0f - lb;
    f32x2 P[32]; f32x2 run = (f32x2){1.0f, 1.0f};
#pragma unroll
    for (int t = 0; t < 32; ++t) { const unsigned wd = *(const unsigned*)(FS + (size_t)t * 1024);
        f32x2 u = (f32x2){__uint_as_float(wd << 16), __uint_as_float(wd & 0xffff0000u)}; u.x = fminf(fmaxf(u.x, -30.f), 30.f); u.y = fminf(fmaxf(u.y, -30.f), 30.f);
        const f32x2 tt = u * (-1.4426950408889634f); f32x2 e; e.x = __builtin_amdgcn_exp2f(tt.x); e.y = __builtin_amdgcn_exp2f(tt.y); e = e + 1.0f;
        f32x2 sg; sg.x = __builtin_amdgcn_rcpf(e.x); sg.y = __builtin_amdgcn_rcpf(e.y);
        const f32x2 fg = lb + omlb * sg; run = run * fg; run.x = fmaxf(run.x, 1e-30f); run.y = fmaxf(run.y, 1e-30f); P[t] = run; }
    const f32x2 Pm = P[15], Pl = P[31]; f32x2 rPm; rPm.x = __builtin_amdgcn_rcpf(Pm.x); rPm.y = __builtin_amdgcn_rcpf(Pm.y);
    *(f32x2*)((float*)(ws + WS_EGM) + (size_t)(b * 64 + c) * 1024 + ch) = Pm; *(f32x2*)((float*)(ws + WS_EGL) + (size_t)(b * 64 + c) * 1024 + ch) = Pl * rPm;
    unsigned kx[16], ky[16], vx[16], vy[16];
    f32x2 rPprev = (f32x2){1.0f, 1.0f}; f32x2 kprev = (f32x2){0.f, 0.f}; unsigned iprev = 0u;
#pragma unroll
    for (int t = 0; t < 32; ++t) { f32x2 rP; rP.x = __builtin_amdgcn_rcpf(P[t].x); rP.y = __builtin_amdgcn_rcpf(P[t].y);
        const f32x2 e1 = P[t] * rPm, e2 = Pm * rP, fg = P[t] * rPprev, kk = 1.0f - fg; rPprev = rP;
        const unsigned qw = *(const unsigned*)(QS + (size_t)t * 1024); const f32x2 q = (f32x2){__uint_as_float(qw << 16), __uint_as_float(qw & 0xffff0000u)};
        const f32x2 tq = q * (-1.4426950408889634f); f32x2 eq; eq.x = __builtin_amdgcn_exp2f(tq.x); eq.y = __builtin_amdgcn_exp2f(tq.y); eq = eq + 1.0f;
        f32x2 rq; rq.x = __builtin_amdgcn_rcpf(eq.x); rq.y = __builtin_amdgcn_rcpf(eq.y);
        const f32x2 qa = q * rq * e1, ka = kk * e2;
        *(unsigned*)(QS + (size_t)t * 1024) = pk2(qa.x, qa.y); *(unsigned*)(FS + (size_t)t * 1024) = pk2(ka.x, ka.y);
        const unsigned iw = *(const unsigned*)(IS + (size_t)t * 1024 + ch);
        if (t & 1) { kx[t >> 1] = pk2(kprev.x, ka.x); ky[t >> 1] = pk2(kprev.y, ka.y); vx[t >> 1] = (iprev & 0xffffu) | (iw << 16); vy[t >> 1] = (iprev >> 16) | (iw & 0xffff0000u); }
        kprev = ka; iprev = iw; }
    bf16* VTg = (bf16*)(ws + WS_HVT) + ((size_t)((b * 64 + c) * 8 + hd) * 128 + k) * 32;
#pragma unroll
    for (int j = 0; j < 4; ++j) { *(v4u*)(VTg + 8 * j) = (v4u){vx[4 * j], vx[4 * j + 1], vx[4 * j + 2], vx[4 * j + 3]}; *(v4u*)(VTg + 32 + 8 * j) = (v4u){vy[4 * j], vy[4 * j + 1], vy[4 * j + 2], vy[4 * j + 3]}; }
    __syncthreads();
    bf16* KTg = IS + ((size_t)hd * 128 + k) * 32;
#pragma unroll
    for (int j = 0; j < 4; ++j) { *(v4u*)(KTg + 8 * j) = (v4u){kx[4 * j], kx[4 * j + 1], kx[4 * j + 2], kx[4 * j + 3]}; *(v4u*)(KTg + 32 + 8 * j) = (v4u){ky[4 * j], ky[4 * j + 1], ky[4 * j + 2], ky[4 * j + 3]}; }
    __syncthreads();
}
__device__ __forceinline__ void hg_prep_phase(Frame& F) { for (int u = F.vcu; u < NBP * 64; u += F.G) hg_prep_unit(F, u >> 6, u & 63); }
constexpr int HV_QA = 0, HV_KA = 8704, HV_KAT = 17408, HV_VT = 27648, HV_EGM = 30208, HV_EGL = 30720, HV_PBUF = 31232, HV_OB = 2 * HV_PBUF, HV_OBUF = 23040;
constexpr size_t WS_SSQH = WS_END3, WS_END4 = WS_SSQH + (size_t)T * 32 * 4;
__device__ __forceinline__ void hgrn_v_unit(Frame& F, int b, int hd, int vt) {
    int tid_o = F.tid; asm volatile("" : "+v"(tid_o));
    const int tid = tid_o, lane = tid & 63, w = F.wave, r = lane & 31, hh = lane >> 5; unsigned char* ws = F.ws;
    LAS unsigned char* Lb = F.lds + RING_OFF;
    const bf16* PROJ = (const bf16*)(ws + WS_PROJ); bf16* OU = (bf16*)(ws + WS_ON); float* SSQH = (float*)(ws + WS_SSQH);
    const size_t rowb = (size_t)b * SEQ;
    const bf16* qsrc = PROJ + (size_t)S_Q * SLOT_ELEMS + (rowb + (tid >> 4)) * 1024 + hd * 128 + 8 * (tid & 15);
    const bf16* ksrc = PROJ + (size_t)S_F * SLOT_ELEMS + (rowb + (tid >> 4)) * 1024 + hd * 128 + 8 * (tid & 15);
    const bf16* tsrc = PROJ + (size_t)S_I * SLOT_ELEMS + rowb * 1024 + (size_t)(hd * 128 + (tid >> 2)) * 32 + 8 * (tid & 3);
    const unsigned char* xsrc = nullptr; size_t xstr = 0;
    if (tid < 128) { xsrc = (const unsigned char*)((const bf16*)(ws + WS_HVT) + ((size_t)(b * 64 * 8 + hd) * 128 + 32 * vt + (tid >> 2)) * 32 + 8 * (tid & 3)); xstr = (size_t)8 * 128 * 32 * 2; }
    else if (tid < 160) { xsrc = (const unsigned char*)((const float*)(ws + WS_EGM) + (size_t)b * 64 * 1024 + hd * 128 + 4 * (tid - 128)); xstr = 4096; }
    else if (tid < 192) { xsrc = (const unsigned char*)((const float*)(ws + WS_EGL) + (size_t)b * 64 * 1024 + hd * 128 + 4 * (tid - 160)); xstr = 4096; }
    const int xdst = tid < 128 ? HV_VT + (tid >> 2) * 80 + 16 * (tid & 3) : (tid < 160 ? HV_EGM + 16 * (tid - 128) : HV_EGL + 16 * (tid - 160));
#define HGV_LOAD(cc, pq, pk, pt, px) { pq = *(const v4u*)(qsrc + (size_t)(cc) * 32 * 1024); pk = *(const v4u*)(ksrc + (size_t)(cc) * 32 * 1024); pt = *(const v4u*)(tsrc + (size_t)(cc) * 32768); if (tid < 192) px = *(const v4u*)(xsrc + (size_t)(cc) * xstr); }
#define HGV_STORE(pb, pq, pk, pt, px) { *(LAS v4u*)((pb) + HV_QA + (tid >> 4) * 272 + 16 * (tid & 15)) = pq; *(LAS v4u*)((pb) + HV_KA + (tid >> 4) * 272 + 16 * (tid & 15)) = pk; \
        *(LAS v4u*)((pb) + HV_KAT + (tid >> 2) * 80 + 16 * (tid & 3)) = pt; if (tid < 192) *(LAS v4u*)((pb) + xdst) = px; }
    v4u pqA, pkA, ptA, pxA = (v4u){0u, 0u, 0u, 0u}, pqB, pkB, ptB, pxB = (v4u){0u, 0u, 0u, 0u};
    HGV_LOAD(0, pqA, pkA, ptA, pxA) HGV_STORE(Lb, pqA, pkA, ptA, pxA)
    HGV_LOAD(1, pqA, pkA, ptA, pxA) HGV_LOAD(2, pqB, pkB, ptB, pxB)
    const int kt = w;
    v2u ow_pend = (v2u){0u, 0u}; float sq_pend = 0.f;
    f32x16 S;
#pragma unroll
    for (int i = 0; i < 16; ++i) S[i] = 0.f;
    __syncthreads();
#define HGV_ITER(c, pq, pk, pt, px) { \
        int r_l = r, hh_l = hh, tid_l = tid; asm volatile("" : "+v"(r_l), "+v"(hh_l), "+v"(tid_l)); \
        { const int r = r_l, hh = hh_l, tid = tid_l; \
        LAS unsigned char* pbc = Lb + ((c) & 1) * HV_PBUF; LAS unsigned char* pbn = Lb + (((c) + 1) & 1) * HV_PBUF; \
        if ((c) < 63) { HGV_STORE(pbn, pq, pk, pt, px) if ((c) < 61) HGV_LOAD((c) + 3, pq, pk, pt, px) } \
        if (w < 4) { \
            LAS float* EGM = (LAS float*)(pbc + HV_EGM); LAS float* EGL = (LAS float*)(pbc + HV_EGL); LAS float* OB = (LAS float*)(Lb + HV_OB + ((c) & 1) * HV_OBUF); \
            _Pragma("unroll") \
            for (int q4 = 0; q4 < 4; ++q4) { const f32x4 e0 = *(const LAS f32x4*)(EGM + 32 * kt + 8 * q4 + 4 * hh); \
                _Pragma("unroll") \
                for (int j = 0; j < 4; ++j) S[4 * q4 + j] *= e0[j]; } \
            f32x16 o; \
            _Pragma("unroll") \
            for (int i = 0; i < 16; ++i) o[i] = 0.f; \
            const LAS unsigned char* qa_row = pbc + HV_QA + r * 272; \
            o = MFMA32(lds_frag8x2(qa_row + (32 * kt + 4 * hh) * 2), ACC_FRAG(S, 0), o); \
            o = MFMA32(lds_frag8x2(qa_row + (32 * kt + 16 + 4 * hh) * 2), ACC_FRAG(S, 1), o); \
            LAS float* ob = OB + (kt * 32) * 36 + r; \
            _Pragma("unroll") \
            for (int i = 0; i < 16; ++i) ob[((i & 3) + 8 * (i >> 2) + 4 * hh) * 36] = o[i]; \
            const LAS unsigned char* kat_nat = pbc + HV_KAT + (32 * kt + r) * 80 + hh * 16; const LAS unsigned char* vt_nat = pbc + HV_VT + r * 80 + hh * 16; \
            S = MFMA32(lds_frag16(kat_nat), lds_frag16(vt_nat), S); S = MFMA32(lds_frag16(kat_nat + 32), lds_frag16(vt_nat + 32), S); \
            _Pragma("unroll") \
            for (int q4 = 0; q4 < 4; ++q4) { const f32x4 e0 = *(const LAS f32x4*)(EGL + 32 * kt + 8 * q4 + 4 * hh); \
                _Pragma("unroll") \
                for (int j = 0; j < 4; ++j) S[4 * q4 + j] *= e0[j]; } \
        } else { \
            if (w == 4) { LAS float* OB = (LAS float*)(Lb + HV_OB + ((c) & 1) * HV_OBUF); f32x16 o; \
                _Pragma("unroll") \
                for (int i = 0; i < 16; ++i) o[i] = 0.f; \
                f32x16 X; \
                _Pragma("unroll") \
                for (int i = 0; i < 16; ++i) X[i] = 0.f; \
                const LAS unsigned char* ka_nat = pbc + HV_KA + r * 272 + hh * 16; const LAS unsigned char* qa_nat = pbc + HV_QA + r * 272 + hh * 16; \
                _Pragma("unroll 2") \
                for (int ks = 0; ks < 8; ++ks) X = MFMA32(lds_frag16(ka_nat + ks * 32), lds_frag16(qa_nat + ks * 32), X); \
                _Pragma("unroll") \
                for (int i = 0; i < 16; ++i) { const int srow = (i & 3) + 8 * (i >> 2) + 4 * hh; X[i] = (srow <= r) ? X[i] : 0.f; } \
                const LAS unsigned char* vt_row = pbc + HV_VT + r * 80; \
                o = MFMA32(ACC_FRAG(X, 0), lds_frag8x2(vt_row + (4 * hh) * 2), o); \
                o = MFMA32(ACC_FRAG(X, 1), lds_frag8x2(vt_row + (16 + 4 * hh) * 2), o); \
                LAS float* ob4 = OB + (4 * 32) * 36 + r; \
                _Pragma("unroll") \
                for (int i = 0; i < 16; ++i) ob4[((i & 3) + 8 * (i >> 2) + 4 * hh) * 36] = o[i]; \
            } \
            if ((c) > 1) { HGV_FLUSH((c) - 2) } \
            if ((c) > 0) { HGV_OUT((c) - 1) } \
        } \
        LDS_BARRIER(); \
        } }
#define HGV_OUT(cp) { const LAS float* OB = (const LAS float*)(Lb + HV_OB + ((cp) & 1) * HV_OBUF); const int tl = tid - 256, t = tl >> 3, v0 = (tl & 7) * 4; \
            const f32x4 a = *(const LAS f32x4*)(OB + t * 36 + v0), b2 = *(const LAS f32x4*)(OB + (32 + t) * 36 + v0), c2 = *(const LAS f32x4*)(OB + (64 + t) * 36 + v0), d2 = *(const LAS f32x4*)(OB + (96 + t) * 36 + v0), e2 = *(const LAS f32x4*)(OB + (128 + t) * 36 + v0); \
            const f32x4 o4 = ((a + b2) + (c2 + d2)) + e2; \
            float sq = (o4.x * o4.x + o4.y * o4.y) + (o4.z * o4.z + o4.w * o4.w); sq += __shfl_xor(sq, 1); sq += __shfl_xor(sq, 2); sq += __shfl_xor(sq, 4); \
            sq_pend = sq; ow_pend.x = pk2(o4.x, o4.y); ow_pend.y = pk2(o4.z, o4.w); }
#define HGV_FLUSH(cp) { const int tl = tid - 256, t = tl >> 3, v0 = (tl & 7) * 4; const size_t row = rowb + 32 * (cp) + t; \
            if ((tl & 7) == 0) SSQH[row * 32 + hd * 4 + vt] = sq_pend; *(v2u*)(OU + row * 1024 + hd * 128 + 32 * vt + v0) = ow_pend; }
#pragma unroll 1
    for (int cc = 0; cc < 64; cc += 2) { HGV_ITER(cc, pqA, pkA, ptA, pxA) HGV_ITER(cc + 1, pqB, pkB, ptB, pxB) }
    if (w >= 4) { HGV_FLUSH(62) HGV_OUT(63) HGV_FLUSH(63) }
#undef HGV_ITER
#undef HGV_OUT
#undef HGV_FLUSH
#undef HGV_LOAD
#undef HGV_STORE
    if (w < 4) { float* st_g = F.out + O_HGP + (size_t)(b * 8 + hd) * 16384 + 32 * vt + r;
#pragma unroll
        for (int i = 0; i < 16; ++i) { const int k = 32 * kt + (i & 3) + 8 * (i >> 2) + 4 * hh; st_g[(size_t)k * 128] = S[i]; } }
    __syncthreads();
}
__device__ __forceinline__ void hgnorm_phase(Frame& F) {
    const int gw = F.vcu * NWAVES + F.wave, NGW = F.G * NWAVES; bf16* ON = (bf16*)(F.ws + WS_ON); const float* SSQH = (const float*)(F.ws + WS_SSQH);
    const bf16* HG = (const bf16*)(F.ws + WS_PROJ) + (size_t)S_HG * SLOT_ELEMS;
    for (int row = gw; row < TP; row += NGW) {
#pragma unroll
        for (int j = 0; j < 2; ++j) { const int pc = j * 64 + F.lane, hd = pc >> 4;
            const f32x4 sp = *(const f32x4*)(SSQH + (size_t)row * 32 + hd * 4); const float rs = __builtin_amdgcn_rsqf(((sp.x + sp.y) + (sp.z + sp.w)) * (1.0f / 128.0f) + EPS);
            v4u* p = (v4u*)(ON + (size_t)row * 1024) + pc; const v4u o = *p; const v4u g = *((const v4u*)(HG + (size_t)row * 1024) + pc); v4u res;
#pragma unroll
            for (int e = 0; e < 4; ++e) res[e] = pk2(bf2f(o[e] & 0xffffu) * rs * silu_f(bf2f(g[e] & 0xffffu)), __uint_as_float(o[e] & 0xffff0000u) * rs * silu_f(__uint_as_float(g[e] & 0xffff0000u)));
            *p = res; }
    }
}
constexpr int SD_BN = 0, SD_CN = 17408, SD_BT = 34816, SD_XT = 53248, SD_HT = 62464, SD_YA = 97280, SD_YY = 113664, SD_YO = 130048, SD_CUM = 134144, SD_DTV = 134400, SD_ECUM = 134656, SD_XWT = 134912, SD_CWL = 144128;
__device__ __forceinline__ void ssd_unit_mfma(Frame& F, int gb, int h) {
    int tid_o = F.tid; asm volatile("" : "+v"(tid_o));
    const int tid = tid_o, lane = tid & 63, w = F.wave, r = lane & 31, hh = lane >> 5; unsigned char* ws = F.ws;
    const int L = SEQ; const size_t row_base = (size_t)gb * SEQ;
    const int g = h >> 3;
    LAS unsigned char* Lb = F.lds + RING_OFF;
    LAS unsigned short* BN = (LAS unsigned short*)(Lb + SD_BN); LAS unsigned short* CN = (LAS unsigned short*)(Lb + SD_CN);
    LAS unsigned short* BT = (LAS unsigned short*)(Lb + SD_BT); LAS unsigned short* XT = (LAS unsigned short*)(Lb + SD_XT);
    LAS unsigned short* HT = (LAS unsigned short*)(Lb + SD_HT);
    LAS unsigned short* XWT = (LAS unsigned short*)(Lb + SD_XWT);
    LAS float* YA = (LAS float*)(Lb + SD_YA); LAS float* YY = (LAS float*)(Lb + SD_YY); LAS unsigned short* YO = (LAS unsigned short*)(Lb + SD_YO);
    LAS float* CUM = (LAS float*)(Lb + SD_CUM); LAS float* DTV = (LAS float*)(Lb + SD_DTV); LAS float* ECUM = (LAS float*)(Lb + SD_ECUM);
    const bf16* PROJ = (const bf16*)(ws + WS_PROJ); const float* DTR = (const float*)(ws + WS_DT); bf16* YG = (bf16*)(ws + WS_YG); float* SSQ = (float*)(ws + WS_SSQSSD);
    const int nt = w >> 1, pt = w & 1;
    f32x16 H;
    float* st_g = F.out + O_SSMP + (size_t)(gb * 32 + h) * 8192 + (size_t)(32 * pt + r) * 128 + 32 * nt + 4 * hh;
#pragma unroll
    for (int i = 0; i < 16; ++i) H[i] = 0.f;
    {
        LAS unsigned short* hp = HT + (32 * pt + r) * 136 + 32 * nt + 4 * hh;
#pragma unroll
        for (int q4 = 0; q4 < 4; ++q4) { v2u pk; pk.x = cvtpk_c(H[4 * q4], H[4 * q4 + 1]); pk.y = cvtpk_c(H[4 * q4 + 2], H[4 * q4 + 3]); *(LAS v2u*)(hp + 8 * q4) = pk; }
    }
    const float a = -__expf(F.in[13][h]), dtb = F.in[12][h], Dk = F.in[14][h];
    const float* cw = F.in[10]; const float* cbp = F.in[11];
    const int cgl = tid & 7, xs = tid >> 3;
    const int col = h * 64 + 8 * cgl;
    const bf16* cptr = PROJ + (size_t)(S_X0 + (col >> 10)) * SLOT_ELEMS + row_base * 1024 + (col & 1023);
    const bf16* BCS = (const bf16*)(ws + WS_BCS) + row_base * 1024 + g * 128; const bf16* BTT = (const bf16*)(ws + WS_BTT) + (size_t)(gb * 32 * 4 + g) * 128 * 64;
    v4u xr[4], pc[6];
#pragma unroll
    for (int i = 0; i < 4; ++i) { const int gt = xs - 3 + i; xr[i] = (v4u){0u, 0u, 0u, 0u}; if (gt >= 0) xr[i] = *(const v4u*)(cptr + (size_t)gt * 1024); }
#pragma unroll
    for (int j = 0; j < 6; ++j) { const int idx = (tid + 512 * j) & 1023;
        if (j < 4) pc[j] = *(const v4u*)(BCS + (size_t)(idx >> 4) * 1024 + (j >> 1) * 512 + 8 * (idx & 15));
        else pc[j] = *(const v4u*)(BTT + (size_t)(idx >> 3) * 64 + 8 * (idx & 7)); }
    LAS float* CWL = (LAS float*)(Lb + SD_CWL);
    if (tid < 320) { const int j = tid >> 6, c = tid & 63; CWL[tid] = j < 4 ? cw[j * 3072 + h * 64 + c] : cbp[h * 64 + c]; }
    __syncthreads();
    v4u ow_pend = (v4u){0u, 0u, 0u, 0u}; float sq_pend = 0.f; bool pend = false;
    int buf = 0;
    float dt_pf = 0.f;
    if (lane < L) dt_pf = DTR[(row_base + lane) * 32 + h];
    for (int t0 = 0; t0 < L; t0 += 64, buf ^= 1) {
        int r_l = r, hh_l = hh, tid_l = tid, lane_l = lane;
        asm volatile("" : "+v"(r_l), "+v"(hh_l), "+v"(tid_l), "+v"(lane_l));
        { const int r = r_l, hh = hh_l, tid = tid_l, lane = lane_l;
        float dtv = 0.f;
        if (t0 + lane < L) { const float x = dt_pf + dtb; dtv = fmaxf(x, 0.f) + 0.6931471805599453f * __builtin_amdgcn_logf(1.0f + __builtin_amdgcn_exp2f(-1.4426950408889634f * fabsf(x))); }
        dt_pf = 0.f; if (t0 + 64 + lane < L) dt_pf = DTR[(row_base + t0 + 64 + lane) * 32 + h];
        v4u zw = (v4u){0u, 0u, 0u, 0u};
        if (t0 + (tid >> 3) < L) zw = *(const v4u*)(PROJ + (size_t)(S_Z0 + (h >> 4)) * SLOT_ELEMS + (row_base + t0 + (tid >> 3)) * 1024 + (h & 15) * 64 + (tid & 7) * 8);
        float cum = dtv * a;
#pragma unroll
        for (int o = 1; o < 64; o <<= 1) { const float u = __shfl_up(cum, o); if (lane >= o) cum += u; }
        const float cum_last = __shfl(cum, 63);
        const float wgt = __expf(cum_last - cum) * dtv;
        if (w == 0) { CUM[lane] = cum; DTV[lane] = dtv; ECUM[lane] = __expf(cum); }
#pragma unroll
        for (int j = 0; j < 6; ++j) { const int idx = (tid + 512 * j) & 1023;
            if (j < 2) *(LAS v4u*)(BN + (idx >> 4) * 136 + 8 * (idx & 15)) = pc[j];
            else if (j < 4) *(LAS v4u*)(CN + (idx >> 4) * 136 + 8 * (idx & 15)) = pc[j];
            else *(LAS v4u*)(BT + (idx >> 3) * 72 + 8 * (idx & 7)) = pc[j]; }
        if (pend) { const size_t prow = row_base + (t0 - 64) + (tid >> 3);
            *(v4u*)(YG + prow * 2048 + h * 64 + (tid & 7) * 8) = ow_pend; if ((tid & 7) == 0) SSQ[prow * 32 + h] = sq_pend; pend = false; }
        { const int xs = tid >> 3, cgl = tid & 7; const float wx = __shfl(wgt, xs); typedef float f32x2 __attribute__((ext_vector_type(2)));
#pragma unroll
          for (int kp = 0; kp < 4; ++kp) {
              const LAS float* wl = CWL + 8 * cgl + 2 * kp;
              const f32x2 cw0 = *(const LAS f32x2*)wl, cw1 = *(const LAS f32x2*)(wl + 64), cw2 = *(const LAS f32x2*)(wl + 128), cw3 = *(const LAS f32x2*)(wl + 192), cbb = *(const LAS f32x2*)(wl + 256);
              f32x2 xv[4];
#pragma unroll
              for (int i = 0; i < 4; ++i) { const unsigned wd = xr[i][kp]; xv[i] = (f32x2){__uint_as_float(wd << 16), __uint_as_float(wd & 0xffff0000u)}; }
              f32x2 a = cw0 * xv[0] + cbb; a = cw1 * xv[1] + a; a = cw2 * xv[2] + a; a = cw3 * xv[3] + a;
              const f32x2 t = a * (-1.4426950408889634f); f32x2 e; e.x = __builtin_amdgcn_exp2f(t.x); e.y = __builtin_amdgcn_exp2f(t.y); e = e + 1.0f;
              f32x2 rc; rc.x = __builtin_amdgcn_rcpf(e.x); rc.y = __builtin_amdgcn_rcpf(e.y); const f32x2 o = a * rc, ow = o * wx;
              const unsigned po = pk2(o.x, o.y), pw = pk2(ow.x, ow.y); const int p = 8 * cgl + 2 * kp;
              XT[p * 72 + xs] = (unsigned short)(po & 0xffffu); XT[(p + 1) * 72 + xs] = (unsigned short)(po >> 16);
              XWT[p * 72 + xs] = (unsigned short)(pw & 0xffffu); XWT[(p + 1) * 72 + xs] = (unsigned short)(pw >> 16); }
        }
        if (t0 + 64 < L) {
#pragma unroll
            for (int i = 0; i < 4; ++i) xr[i] = *(const v4u*)(cptr + (size_t)(t0 + 64 + (tid >> 3) - 3 + i) * 1024);
            const int chn = (t0 >> 6) + 1;
#pragma unroll
            for (int j = 0; j < 6; ++j) { const int idx = (tid + 512 * j) & 1023;
                if (j < 4) pc[j] = *(const v4u*)(BCS + (size_t)(t0 + 64 + (idx >> 4)) * 1024 + (j >> 1) * 512 + 8 * (idx & 15));
                else pc[j] = *(const v4u*)(BTT + ((size_t)chn * 4 * 128 + (idx >> 3)) * 64 + 8 * (idx & 7)); }
        }
        LDS_BARRIER();
        if (w < 4 || w >= 6) {
            const int tt = w < 4 ? (w >> 1) : 1, st = w < 4 ? tt : 0, ptj = w & 1;
            f32x16 X, ya;
#pragma unroll
            for (int i = 0; i < 16; ++i) { X[i] = 0.f; ya[i] = 0.f; }
            const LAS unsigned char* cn_nat = Lb + SD_CN + (32 * tt + r) * 272 + hh * 16; const LAS unsigned char* bn_nat = Lb + SD_BN + (32 * st + r) * 272 + hh * 16;
#pragma unroll 2
            for (int ks = 0; ks < 8; ++ks) X = MFMA32(lds_frag16(bn_nat + ks * 32), lds_frag16(cn_nat + ks * 32), X);
            const float cum_t = CUM[32 * tt + r];
#pragma unroll
            for (int q4 = 0; q4 < 4; ++q4) { const f32x4 cs = *(const LAS f32x4*)(CUM + 32 * st + 8 * q4 + 4 * hh), ds = *(const LAS f32x4*)(DTV + 32 * st + 8 * q4 + 4 * hh);
#pragma unroll
                for (int jj = 0; jj < 4; ++jj) { const int s_abs = 32 * st + 8 * q4 + 4 * hh + jj; const float f = __expf(fminf(cum_t - cs[jj], 0.f)) * ds[jj]; X[4 * q4 + jj] = (s_abs <= 32 * tt + r) ? X[4 * q4 + jj] * f : 0.f; } }
            const LAS unsigned char* xt_row = Lb + SD_XT + (32 * ptj + r) * 144 + (32 * st + 4 * hh) * 2;
            ya = MFMA32(ACC_FRAG(X, 0), lds_frag8x2(xt_row), ya);
            ya = MFMA32(ACC_FRAG(X, 1), lds_frag8x2(xt_row + 32), ya);
            if (w < 4) { LAS float* yb = YA + (32 * tt + 4 * hh) * 64 + 32 * ptj + r;
#pragma unroll
                for (int i = 0; i < 16; ++i) yb[((i & 3) + 8 * (i >> 2)) * 64] = ya[i]; }
            else { LAS unsigned short* yb = YO + (4 * hh) * 64 + 32 * ptj + r;
#pragma unroll
                for (int i = 0; i < 16; ++i) yb[((i & 3) + 8 * (i >> 2)) * 64] = (unsigned short)f2bf(ya[i]); }
        } else {
            const int ptj = w & 1;
            const LAS unsigned char* ht_nat = Lb + SD_HT + buf * 17408 + (32 * ptj + r) * 272 + hh * 16;
#pragma unroll 1
            for (int tt = 0; tt < 2; ++tt) {
                f32x16 yi;
#pragma unroll
                for (int i = 0; i < 16; ++i) yi[i] = 0.f;
                const LAS unsigned char* cn_nat = Lb + SD_CN + (32 * tt + r) * 272 + hh * 16;
#pragma unroll 2
                for (int ks = 0; ks < 8; ++ks) yi = MFMA32(lds_frag16(cn_nat + ks * 32), lds_frag16(ht_nat + ks * 32), yi);
                const LAS unsigned short* xt_p = XT + (32 * ptj + r) * 72 + 32 * tt + 4 * hh;
#pragma unroll
                for (int q4 = 0; q4 < 4; ++q4) { const f32x4 ec = *(const LAS f32x4*)(ECUM + 32 * tt + 8 * q4 + 4 * hh); const v2u xw = *(const LAS v2u*)(xt_p + 8 * q4);
                    const float x0 = bf2f(xw.x & 0xffffu), x1 = bf2f(xw.x >> 16), x2 = bf2f(xw.y & 0xffffu), x3 = bf2f(xw.y >> 16);
                    LAS float* yb = YY + (32 * tt + 8 * q4 + 4 * hh) * 64 + 32 * ptj + r;
                    yb[0] = ec[0] * yi[4 * q4] + Dk * x0; yb[64] = ec[1] * yi[4 * q4 + 1] + Dk * x1; yb[128] = ec[2] * yi[4 * q4 + 2] + Dk * x2; yb[192] = ec[3] * yi[4 * q4 + 3] + Dk * x3; }
            }
        }
        {
            const float el = __expf(CUM[63]);
#pragma unroll
            for (int i = 0; i < 16; ++i) H[i] *= el;
            const LAS unsigned char* bt_nat = Lb + SD_BT + (32 * nt + r) * 144 + hh * 16; const LAS unsigned char* xt_nat = Lb + SD_XWT + (32 * pt + r) * 144 + hh * 16;
#pragma unroll
            for (int s2 = 0; s2 < 4; ++s2) H = MFMA32(lds_frag16(bt_nat + s2 * 32), lds_frag16(xt_nat + s2 * 32), H);
            LAS unsigned short* hp = HT + (buf ^ 1) * 8704 + (32 * pt + r) * 136 + 32 * nt + 4 * hh;
#pragma unroll
            for (int q4 = 0; q4 < 4; ++q4) { v2u pk; pk.x = cvtpk_c(H[4 * q4], H[4 * q4 + 1]); pk.y = cvtpk_c(H[4 * q4 + 2], H[4 * q4 + 3]); *(LAS v2u*)(hp + 8 * q4) = pk; }
        }
        LDS_BARRIER();
        { const int tt = tid >> 3, p0 = (tid & 7) * 8;
          if (t0 + tt < L) { const size_t row = row_base + t0 + tt;
            f32x4 y0 = *(const LAS f32x4*)(YA + tt * 64 + p0) + *(const LAS f32x4*)(YY + tt * 64 + p0), y1 = *(const LAS f32x4*)(YA + tt * 64 + p0 + 4) + *(const LAS f32x4*)(YY + tt * 64 + p0 + 4);
            if (tt >= 32) { const v4u ow4 = *(const LAS v4u*)(YO + (tt - 32) * 64 + p0);
                y0 = y0 + (f32x4){bf2f(ow4.x & 0xffffu), __uint_as_float(ow4.x & 0xffff0000u), bf2f(ow4.y & 0xffffu), __uint_as_float(ow4.y & 0xffff0000u)};
                y1 = y1 + (f32x4){bf2f(ow4.z & 0xffffu), __uint_as_float(ow4.z & 0xffff0000u), bf2f(ow4.w & 0xffffu), __uint_as_float(ow4.w & 0xffff0000u)}; }
            float o[8]; float sq = 0.f;
#pragma unroll
            for (int j = 0; j < 8; ++j) { const unsigned z16 = (zw[j >> 1] >> ((j & 1) * 16)) & 0xffffu; const float yv = (j < 4 ? y0[j & 3] : y1[j & 3]) * silu_f(bf2f(z16)); o[j] = yv; sq += yv * yv; }
            ow_pend.x = pk2(o[0], o[1]); ow_pend.y = pk2(o[2], o[3]); ow_pend.z = pk2(o[4], o[5]); ow_pend.w = pk2(o[6], o[7]);
            sq += __shfl_xor(sq, 1); sq += __shfl_xor(sq, 2); sq += __shfl_xor(sq, 4); sq_pend = sq; pend = true; } }
        }
    }
    if (pend) { const size_t prow = row_base + (L - 64) + (tid >> 3); *(v4u*)(YG + prow * 2048 + h * 64 + (tid & 7) * 8) = ow_pend; if ((tid & 7) == 0) SSQ[prow * 32 + h] = sq_pend; }
#pragma unroll
    for (int q4 = 0; q4 < 4; ++q4) *(f32x4*)(st_g + 8 * q4) = (f32x4){H[4 * q4], H[4 * q4 + 1], H[4 * q4 + 2], H[4 * q4 + 3]};
    __syncthreads();
}
__device__ __forceinline__ float tr_reduce32(const float (&v)[32], int lane) {
    const bool b4 = lane & 16, b3 = lane & 8, b2 = lane & 4, b1 = lane & 2, b0 = lane & 1;
    float a[16], b[8], c[4], d[2];
#pragma unroll
    for (int i = 0; i < 16; ++i) { const float keep = b4 ? v[i + 16] : v[i], send = b4 ? v[i] : v[i + 16]; a[i] = keep + __shfl_xor(send, 16); }
#pragma unroll
    for (int i = 0; i < 8; ++i) { const float keep = b3 ? a[i + 8] : a[i], send = b3 ? a[i] : a[i + 8]; b[i] = keep + __shfl_xor(send, 8); }
#pragma unroll
    for (int i = 0; i < 4; ++i) { const float keep = b2 ? b[i + 4] : b[i], send = b2 ? b[i] : b[i + 4]; c[i] = keep + __shfl_xor(send, 4); }
#pragma unroll
    for (int i = 0; i < 2; ++i) { const float keep = b1 ? c[i + 2] : c[i], send = b1 ? c[i] : c[i + 2]; d[i] = keep + __shfl_xor(send, 2); }
    const float keep = b0 ? d[1] : d[0], send = b0 ? d[0] : d[1];
    return keep + __shfl_xor(send, 1);
}
__device__ __forceinline__ void ssd_sample_unit(Frame& F, int sb, int g) {
    int tid_o = F.tid; asm volatile("" : "+v"(tid_o));
    const int tid = tid_o, lane = tid & 63, w = F.wave, hh = lane >> 5, nq = lane & 31; unsigned char* ws = F.ws;
    LAS float* XC = (LAS float*)(F.lds + RING_OFF); LAS float* BC = XC + 8 * 4 * 64; LAS float* CC = BC + 4 * 128; LAS float* DTS = CC + 4 * 128;
    const bf16* PROJ = (const bf16*)(ws + WS_PROJ); const float* DTR = (const float*)(ws + WS_DT); bf16* YG = (bf16*)(ws + WS_YG); float* SSQ = (float*)(ws + WS_SSQSSD);
    const size_t row0 = (size_t)TP + (size_t)sb * LS;
    const int h = 8 * g + w;
    const float* sp = F.in[3] + (size_t)(sb * 32 + h) * 8192 + (size_t)hh * 128 + 4 * nq;
    f32x4 hst[32];
#pragma unroll
    for (int i = 0; i < 32; ++i) hst[i] = *(const f32x4*)(sp + (size_t)i * 256);
    if (tid < 384) { typedef float f32x2 __attribute__((ext_vector_type(2)));
        const int col = tid < 256 ? g * 512 + 2 * tid : (tid < 320 ? 2048 + g * 128 + 2 * (tid - 256) : 2560 + g * 128 + 2 * (tid - 320));
        const float* cw = F.in[10]; const float* sc = F.in[4] + (size_t)sb * 3 * 3072 + col;
        const f32x2 w0 = *(const f32x2*)(cw + col), w1 = *(const f32x2*)(cw + 3072 + col), w2 = *(const f32x2*)(cw + 2 * 3072 + col), w3 = *(const f32x2*)(cw + 3 * 3072 + col), cb = *(const f32x2*)(F.in[11] + col);
        f32x2 full[7]; full[0] = *(const f32x2*)sc; full[1] = *(const f32x2*)(sc + 3072); full[2] = *(const f32x2*)(sc + 2 * 3072);
        const bf16* cp = PROJ + (size_t)(S_X0 + (col >> 10)) * SLOT_ELEMS + row0 * 1024 + (col & 1023);
#pragma unroll
        for (int t = 0; t < 4; ++t) { const unsigned wd = *(const unsigned*)(cp + (size_t)t * 1024); full[3 + t] = (f32x2){__uint_as_float(wd << 16), __uint_as_float(wd & 0xffff0000u)}; }
#pragma unroll
        for (int t = 0; t < 4; ++t) { f32x2 a = w0 * full[t] + cb; a = w1 * full[t + 1] + a; a = w2 * full[t + 2] + a; a = w3 * full[t + 3] + a;
            f32x2 o; o.x = silu_f(a.x); o.y = silu_f(a.y);
            LAS float* dst = tid < 256 ? XC + ((tid >> 5) * 4 + t) * 64 + 2 * (tid & 31) : (tid < 320 ? BC + t * 128 + 2 * (tid - 256) : CC + t * 128 + 2 * (tid - 320));
            *(LAS f32x2*)dst = o; }
    } else if (tid < 416) { const int idx = tid - 384, hl = idx >> 2, t = idx & 3; const float x = DTR[(row0 + t) * 32 + 8 * g + hl] + F.in[12][8 * g + hl]; DTS[idx] = x > 20.f ? x : log1pf(__expf(x)); }
    __syncthreads();
    const float a = -__expf(F.in[13][h]), Dk = F.in[14][h];
#pragma unroll 1
    for (int t = 0; t < 4; ++t) {
        const float dtv = DTS[w * 4 + t], dA = __expf(dtv * a);
        const f32x4 Bv = *(const LAS f32x4*)(BC + t * 128 + 4 * nq), Cv = *(const LAS f32x4*)(CC + t * 128 + 4 * nq);
        const LAS float* xrow = XC + (w * 4 + t) * 64;
        float part[32];
#pragma unroll
        for (int i = 0; i < 32; ++i) { const float xd = xrow[2 * i + hh] * dtv; hst[i] = hst[i] * dA + Bv * xd; part[i] = (hst[i].x * Cv.x + hst[i].y * Cv.y) + (hst[i].z * Cv.z + hst[i].w * Cv.w); }
        float yv = tr_reduce32(part, lane);
        const int p = 2 * nq + hh; const size_t row = row0 + t;
        yv += Dk * xrow[p];
        const float z = bf2f(PROJ[(size_t)(S_Z0 + (h >> 4)) * SLOT_ELEMS + row * 1024 + (h & 15) * 64 + p]);
        const float yg = yv * silu_f(z);
        YG[row * 2048 + h * 64 + p] = (bf16)f2bf(yg);
        const float sq = wave_sum(yg * yg);
        if (lane == 0) SSQ[row * 32 + h] = sq;
    }
    float* so = F.out + O_SSMS + (size_t)(sb * 32 + h) * 8192 + (size_t)hh * 128 + 4 * nq;
#pragma unroll
    for (int i = 0; i < 32; ++i) *(f32x4*)(so + (size_t)i * 256) = hst[i];
    __syncthreads();
}
__device__ __forceinline__ void hgrn_sample_unit(Frame& F, int sb, int hq) {
    int tid_o = F.tid; asm volatile("" : "+v"(tid_o));
    const int tid = tid_o, lane = tid & 63, w = F.wave, hh = lane >> 5, vq = lane & 31; unsigned char* ws = F.ws;
    LAS float* FS = (LAS float*)(F.lds + RING_OFF); LAS float* KS = FS + 2048; LAS float* QS = KS + 2048; LAS float* VS = QS + 2048; LAS float* OP = VS + 2048;
    const bf16* PROJ = (const bf16*)(ws + WS_PROJ); bf16* ON = (bf16*)(ws + WS_ON);
    const size_t row0 = (size_t)TP + (size_t)sb * LS;
    const int hl = w >> 1, kh = w & 1, hd = 4 * hq + hl;
    const float* sp = F.in[5] + (size_t)(sb * 8 + hd) * 16384 + (size_t)(64 * kh + hh) * 128 + 4 * vq;
    f32x4 S[32];
#pragma unroll
    for (int i = 0; i < 32; ++i) S[i] = *(const f32x4*)(sp + (size_t)i * 256);
    { const int ch = hq * 512 + tid; const float lb = __builtin_amdgcn_rcpf(1.0f + __expf(F.in[17][1024 + ch] - F.in[17][ch]));
      const bf16* fp = PROJ + (size_t)S_F * SLOT_ELEMS + row0 * 1024 + ch; const bf16* qp = PROJ + (size_t)S_Q * SLOT_ELEMS + row0 * 1024 + ch; const bf16* ip = PROJ + (size_t)S_I * SLOT_ELEMS + row0 * 1024 + ch;
#pragma unroll
      for (int t = 0; t < 4; ++t) { const float u = fminf(fmaxf(bf2f(fp[(size_t)t * 1024]), -30.f), 30.f); const float fg = lb + (1.0f - lb) * sigmoid_f(u);
          const int o = ((tid >> 7) * 4 + t) * 128 + (tid & 127);
          FS[o] = fg; KS[o] = 1.0f - fg; QS[o] = silu_f(bf2f(qp[(size_t)t * 1024])); VS[o] = bf2f(ip[(size_t)t * 1024]); } }
    __syncthreads();
#pragma unroll 1
    for (int t = 0; t < 4; ++t) {
        const int o = (hl * 4 + t) * 128;
        const f32x4 vv = *(const LAS f32x4*)(VS + o + 4 * vq);
        f32x4 oa = (f32x4){0.f, 0.f, 0.f, 0.f};
#pragma unroll
        for (int i = 0; i < 32; ++i) { const int k = 64 * kh + 2 * i + hh; const float fk = FS[o + k], kv = KS[o + k], qk = QS[o + k]; S[i] = S[i] * fk + vv * kv; oa = oa + S[i] * qk; }
        oa.x += __shfl_xor(oa.x, 32); oa.y += __shfl_xor(oa.y, 32); oa.z += __shfl_xor(oa.z, 32); oa.w += __shfl_xor(oa.w, 32);
        if (hh == 0) *(LAS f32x4*)(OP + ((hl * 4 + t) * 2 + kh) * 128 + 4 * vq) = oa;
    }
    float* so = F.out + O_HGS + (size_t)(sb * 8 + hd) * 16384 + (size_t)(64 * kh + hh) * 128 + 4 * vq;
#pragma unroll
    for (int i = 0; i < 32; ++i) *(f32x4*)(so + (size_t)i * 256) = S[i];
    __syncthreads();
#pragma unroll
    for (int rr2 = 0; rr2 < 2; ++rr2) { const int rr = 2 * w + rr2, ohl = rr >> 2, t = rr & 3, ohd = 4 * hq + ohl; typedef float f32x2 __attribute__((ext_vector_type(2)));
        const f32x2 p0 = *(const LAS f32x2*)(OP + (rr * 2) * 128 + 2 * lane), p1 = *(const LAS f32x2*)(OP + (rr * 2 + 1) * 128 + 2 * lane);
        const float o0 = p0.x + p1.x, o1 = p0.y + p1.y; const float sq = wave_sum(o0 * o0 + o1 * o1); const float rs = __builtin_amdgcn_rsqf(sq * (1.0f / 128.0f) + EPS);
        const size_t row = row0 + t; const unsigned gw = *(const unsigned*)(PROJ + (size_t)S_HG * SLOT_ELEMS + row * 1024 + ohd * 128 + 2 * lane);
        *(unsigned*)(ON + row * 1024 + ohd * 128 + 2 * lane) = pk2(o0 * rs * silu_f(bf2f(gw & 0xffffu)), o1 * rs * silu_f(__uint_as_float(gw & 0xffff0000u))); }
    __syncthreads();
}
constexpr int U_HGS = NBS * 2, U_SSDS = NBS * 4, U_CONV = NBP + NBS;
__device__ __forceinline__ void scan_phase(Frame& F) {
    gu32* head = F.ctl + CW_QUEUE;
    const int xcc = (int)(xb_xcc_id() & 7u);
#define SCAN_QUEUE(qi, count, body) for (;;) { if (F.tid == 0) F.MISC[0] = __hip_atomic_fetch_add(head + 64 * (qi), 1u, RLX_AGENT); __syncthreads(); const int u = (int)F.MISC[0]; __syncthreads(); if (u >= (count)) break; body }
#pragma unroll 1
    for (int pass = 0; pass < 8; ++pass) { const int bb = (xcc + pass) & 7; SCAN_QUEUE(4 + bb, 32, ssd_unit_mfma(F, bb, u);) }
#pragma unroll 1
    for (int pass = 0; pass < 8; ++pass) { const int bb = (xcc + pass) & 7; SCAN_QUEUE(12 + bb, 32, hgrn_v_unit(F, bb, u >> 2, u & 3);) }
    SCAN_QUEUE(2, U_HGS, hgrn_sample_unit(F, u >> 1, u & 1);)
    SCAN_QUEUE(3, U_SSDS + U_CONV, if (u >= U_SSDS) { conv_copy_unit(F, u - U_SSDS); continue; } ssd_sample_unit(F, u >> 2, u & 3);)
#undef SCAN_QUEUE
}
typedef float f32x4s __attribute__((ext_vector_type(4)));
template <class Epi> __device__ __forceinline__ void small_tile_phase(Frame& F, const bf16* A, const bf16* Bt, int K, const Epi& E) {
    const int lane = F.lane, w = F.wave, r = lane & 31, hh = lane >> 5;
#pragma unroll 1
    for (int v = F.vcu; v < 256; v += F.G) {
    const int mt = v >> 4, nt = v & 15;
    const int kw = K >> 3;
    const bf16* ap = A + (size_t)(TP + 32 * mt + r) * K + w * kw + 8 * hh;
    const bf16* bp = Bt + (size_t)(64 * nt + r) * K + w * kw + 8 * hh;
    f32x16 acc0, acc1;
#pragma unroll
    for (int i = 0; i < 16; ++i) { acc0[i] = 0.f; acc1[i] = 0.f; }
#pragma unroll 4
    for (int ks = 0; ks < kw / 16; ++ks) { const bf16x8 af = *(const bf16x8*)(ap + 16 * ks), b0 = *(const bf16x8*)(bp + 16 * ks), b1 = *(const bf16x8*)(bp + (size_t)32 * K + 16 * ks);
        acc0 = MFMA32(b0, af, acc0); acc1 = MFMA32(b1, af, acc1); }
    LAS float* part = (LAS float*)(F.lds + RING_OFF) + w * 2048;
#pragma unroll
    for (int q4 = 0; q4 < 4; ++q4) { *(LAS f32x4*)(part + r * 64 + 8 * q4 + 4 * hh) = (f32x4){acc0[4 * q4], acc0[4 * q4 + 1], acc0[4 * q4 + 2], acc0[4 * q4 + 3]};
        *(LAS f32x4*)(part + r * 64 + 32 + 8 * q4 + 4 * hh) = (f32x4){acc1[4 * q4], acc1[4 * q4 + 1], acc1[4 * q4 + 2], acc1[4 * q4 + 3]}; }
    __syncthreads();
    const int rl = F.tid >> 4, c4 = (F.tid & 15) * 4; const LAS float* src = (const LAS float*)(F.lds + RING_OFF) + rl * 64 + c4;
    f32x4 sum = *(const LAS f32x4*)src;
#pragma unroll
    for (int ww = 1; ww < 8; ++ww) sum = sum + *(const LAS f32x4*)(src + ww * 2048);
    const f32x4s acc = (f32x4s){sum.x, sum.y, sum.z, sum.w};
    E.small(F, acc, TP + 32 * mt + rl, 64 * nt + c4, nt);
    __syncthreads();
    }
}
template <bool ADD> struct SmGate { bf16* O; const bf16* gate;
    __device__ __forceinline__ void small(Frame&, const f32x4s& a, int row, int col, int) const { const size_t off = (size_t)row * 1024 + col;
        const v2u gw = *(const v2u*)(gate + off); v2u ow = (v2u){0u, 0u}; if (ADD) ow = *(const v2u*)(O + off);
        float rr[4];
#pragma unroll
        for (int e = 0; e < 4; ++e) { const unsigned g16 = (gw[e >> 1] >> ((e & 1) * 16)) & 0xffffu, o16 = (ow[e >> 1] >> ((e & 1) * 16)) & 0xffffu; rr[e] = (ADD ? bf2f(o16) : 0.f) + sigmoid_f(bf2f(g16)) * a[e]; }
        v2u wv; wv.x = cvtpk_c(rr[0], rr[1]); wv.y = cvtpk_c(rr[2], rr[3]); *(v2u*)(O + off) = wv; } };
template <bool BF> struct SmRes { const float* base; bf16* hb; float* ssqp;
    __device__ __forceinline__ void small(Frame& F, const f32x4s& a, int row, int col, int nt) const { const size_t off = (size_t)row * 1024 + col; f32x4 b;
        if (BF) { const v2u w = *(const v2u*)(hb + off); b = (f32x4){bf2f(w.x & 0xffffu), __uint_as_float(w.x & 0xffff0000u), bf2f(w.y & 0xffffu), __uint_as_float(w.y & 0xffff0000u)}; }
        else b = *(const f32x4*)(base + off);
        const f32x4 v = b + (f32x4){a[0], a[1], a[2], a[3]};
        { v2u wv; wv.x = cvtpk_c(v[0], v[1]); wv.y = cvtpk_c(v[2], v[3]); *(v2u*)(hb + off) = wv; }
        float sq = (v[0] * v[0] + v[1] * v[1]) + (v[2] * v[2] + v[3] * v[3]); sq += __shfl_xor(sq, 1); sq += __shfl_xor(sq, 2); sq += __shfl_xor(sq, 4); sq += __shfl_xor(sq, 8);
        if ((F.tid & 15) == 0) ssqp[(size_t)row * 16 + nt] = sq; } };
struct SmScale { bf16* O; const float* ssq; float scale;
    __device__ __forceinline__ void small(Frame&, const f32x4s& a, int row, int col, int) const { const float rs = pg8::row_rs<16>(ssq, row) * scale;
        v2u wv; wv.x = cvtpk_c(a[0] * rs, a[1] * rs); wv.y = cvtpk_c(a[2] * rs, a[3] * rs); *(v2u*)(O + (size_t)row * 1024 + col) = wv; } };
__device__ __forceinline__ void attn_stage_tile(LAS unsigned char* Lb, const bf16* src, size_t pitch, int tid) {
#pragma unroll 1
    for (int hb = 0; hb < 2; ++hb) { v4u v[8];
#pragma unroll
        for (int i = 0; i < 8; ++i) { const int id = tid + 512 * (8 * hb + i), row = id >> 5, c = id & 31; v[i] = *(const v4u*)(src + (size_t)row * pitch + c * 8); }
#pragma unroll
        for (int i = 0; i < 8; ++i) { const int id = tid + 512 * (8 * hb + i), row = id >> 5, c = id & 31; *(LAS v4u*)(Lb + row * 512 + ((c ^ (row & 15)) << 4)) = v[i]; } }
}
__device__ __forceinline__ void attn_prompt_unit(Frame& F, int b, int hd, int qb) {
    const int tid = F.tid, lane = F.lane, w = F.wave, r = lane & 31, hh = lane >> 5; unsigned char* ws = F.ws;
    LAS unsigned char* Lb = F.lds + RING_OFF;
    const bf16* QB = (const bf16*)(ws + WS_QB); const bf16* KB = (const bf16*)(ws + WS_KB); const bf16* VT = (const bf16*)(ws + WS_VT); bf16* OB = (bf16*)(ws + WS_OB);
    const size_t qrow = (size_t)b * SEQ + (size_t)qb * 256 + 32 * w + r;
    attn_stage_tile(Lb, KB + (size_t)b * 256 * 1024 + hd * 256, 1024, tid);
    const bf16* qp = QB + qrow * 1024 + hd * 256 + 8 * hh;
    bf16x8 qf = *(const bf16x8*)qp;
    __syncthreads();
    f32x16 S[8];
#pragma unroll
    for (int t = 0; t < 8; ++t)
#pragma unroll
        for (int i = 0; i < 16; ++i) S[t][i] = 0.f;
    const int sw = r & 15;
#pragma unroll 1
    for (int ks = 0; ks < 16; ++ks) {
        const bf16x8 qn = *(const bf16x8*)(qp + 16 * (ks < 15 ? ks + 1 : ks));
        const LAS unsigned char* kp = Lb + r * 512 + (((2 * ks + hh) ^ sw) << 4);
#pragma unroll
        for (int t = 0; t < 8; ++t) S[t] = MFMA32(lds_frag16(kp + t * 32 * 512), qf, S[t]);
        qf = qn;
    }
    float m = -3.0e38f;
#pragma unroll
    for (int t = 0; t < 8; ++t)
#pragma unroll
        for (int i = 0; i < 16; ++i) m = fmaxf(m, S[t][i]);
    m = fmaxf(m, __shfl_xor(m, 32));
    float l = 0.f;
#pragma unroll
    for (int t = 0; t < 8; ++t)
#pragma unroll
        for (int i = 0; i < 16; ++i) { const float pv = __builtin_amdgcn_exp2f(S[t][i] - m); S[t][i] = pv; l += pv; }
    l += __shfl_xor(l, 32);
    const float rl = __builtin_amdgcn_rcpf(l);
    bf16x8 pf[8][2];
#pragma unroll
    for (int t = 0; t < 8; ++t) { pf[t][0] = ACC_FRAG(S[t], 0); pf[t][1] = ACC_FRAG(S[t], 1); }
    __syncthreads();
    attn_stage_tile(Lb, VT + (size_t)(b * 4 + hd) * 256 * 256, 256, tid);
    __syncthreads();
    bf16* op = OB + qrow * 1024 + hd * 256 + 4 * hh;
#pragma unroll 1
    for (int dt = 0; dt < 8; ++dt) {
        f32x16 O;
#pragma unroll
        for (int i = 0; i < 16; ++i) O[i] = 0.f;
        const LAS unsigned char* vrow = Lb + (32 * dt + r) * 512 + 8 * hh;
#pragma unroll
        for (int t = 0; t < 8; ++t)
#pragma unroll
            for (int s2 = 0; s2 < 2; ++s2) {
                const v2u lo = *(const LAS v2u*)(vrow + (((4 * t + 2 * s2) ^ sw) << 4)), hi = *(const LAS v2u*)(vrow + (((4 * t + 2 * s2 + 1) ^ sw) << 4));
                const v4u wv4 = (v4u){lo.x, lo.y, hi.x, hi.y};
                O = MFMA32(__builtin_bit_cast(bf16x8, wv4), pf[t][s2], O);
            }
#pragma unroll
        for (int q4 = 0; q4 < 4; ++q4) { v2u o; o.x = cvtpk_c(O[4 * q4] * rl, O[4 * q4 + 1] * rl); o.y = cvtpk_c(O[4 * q4 + 2] * rl, O[4 * q4 + 3] * rl);
            *(v2u*)(op + 32 * dt + 8 * q4) = o; }
    }
    __syncthreads();
}
__device__ __forceinline__ void attn_sample_unit(Frame& F, int sb, int hd) {
    const int tid = F.tid, lane = F.lane, w = F.wave; unsigned char* ws = F.ws;
    LAS float* sc = (LAS float*)(F.lds + RING_OFF);
    LAS float* red = sc + 4 * 256;
    const bf16* QB = (const bf16*)(ws + WS_QB); bf16* OB = (bf16*)(ws + WS_OB);
    const size_t rowq = (size_t)TP + (size_t)sb * LS;
    float q[4][4];
#pragma unroll
    for (int t = 0; t < 4; ++t) { const v2u qw = *(const v2u*)(QB + (rowq + t) * 1024 + hd * 256 + 4 * lane); q[t][0] = bf2f(qw.x & 0xffffu); q[t][1] = bf2f(qw.x >> 16); q[t][2] = bf2f(qw.y & 0xffffu); q[t][3] = bf2f(qw.y >> 16); }
    const float* Kc = F.in[6] + ((size_t)sb * 256 * 4 + hd) * 256 + 4 * lane; const float* Vc = F.in[7] + ((size_t)sb * 256 * 4 + hd) * 256 + 4 * lane;
    f32x4 kv[8], kn[8];
#pragma unroll
    for (int u = 0; u < 8; ++u) kv[u] = *(const f32x4*)(Kc + (size_t)(w * 32 + u) * 1024);
#pragma unroll 1
    for (int kk0 = 0; kk0 < 32; kk0 += 8) {
#pragma unroll
        for (int u = 0; u < 8; ++u) kn[u] = kk0 < 24 ? *(const f32x4*)(Kc + (size_t)(w * 32 + kk0 + 8 + u) * 1024) : *(const f32x4*)(Vc + (size_t)(w * 32 + u) * 1024);
        { float part[32];
#pragma unroll
          for (int u = 0; u < 8; ++u)
#pragma unroll
              for (int t = 0; t < 4; ++t) part[4 * u + t] = (q[t][0] * kv[u].x + q[t][1] * kv[u].y) + (q[t][2] * kv[u].z + q[t][3] * kv[u].w);
          float sv = tr_reduce32(part, lane); sv += __shfl_xor(sv, 32);
          if (lane < 32) sc[(lane & 3) * 256 + w * 32 + kk0 + (lane >> 2)] = sv; }
#pragma unroll
        for (int u = 0; u < 8; ++u) kv[u] = kn[u]; }
    __syncthreads();
    if (w < 4) { float v[4]; float m = -3.0e38f;
#pragma unroll
        for (int j = 0; j < 4; ++j) { v[j] = sc[w * 256 + j * 64 + lane]; m = fmaxf(m, v[j]); }
        m = wave_max(m); float l = 0.f;
#pragma unroll
        for (int j = 0; j < 4; ++j) { v[j] = __builtin_amdgcn_exp2f(v[j] - m); l += v[j]; }
        l = wave_sum(l); const float rl = 1.0f / l;
#pragma unroll
        for (int j = 0; j < 4; ++j) sc[w * 256 + j * 64 + lane] = v[j] * rl; }
    __syncthreads();
    float o[4][4];
#pragma unroll
    for (int t = 0; t < 4; ++t)
#pragma unroll
        for (int e = 0; e < 4; ++e) o[t][e] = 0.f;
#pragma unroll 1
    for (int kk0 = 0; kk0 < 32; kk0 += 8) {
        if (kk0 < 24) {
#pragma unroll
            for (int u = 0; u < 8; ++u) kn[u] = *(const f32x4*)(Vc + (size_t)(w * 32 + kk0 + 8 + u) * 1024); }
#pragma unroll
        for (int u = 0; u < 8; ++u) { const int key = w * 32 + kk0 + u;
#pragma unroll
            for (int t = 0; t < 4; ++t) { const float pr = sc[t * 256 + key]; o[t][0] += pr * kv[u].x; o[t][1] += pr * kv[u].y; o[t][2] += pr * kv[u].z; o[t][3] += pr * kv[u].w; } }
#pragma unroll
        for (int u = 0; u < 8; ++u) kv[u] = kn[u]; }
#pragma unroll
    for (int t = 0; t < 4; ++t) *(LAS f32x4*)(red + (w * 4 + t) * 256 + 4 * lane) = (f32x4){o[t][0], o[t][1], o[t][2], o[t][3]};
    __syncthreads();
    { const int t = tid >> 7, d0 = (tid & 127) * 2; float a0 = 0.f, a1 = 0.f;
#pragma unroll
      for (int ww = 0; ww < 8; ++ww) { a0 += red[(ww * 4 + t) * 256 + d0]; a1 += red[(ww * 4 + t) * 256 + d0 + 1]; }
      *(unsigned*)(OB + (rowq + t) * 1024 + hd * 256 + d0) = pk2(a0, a1); }
    __syncthreads();
}
__device__ __forceinline__ void attn_phase(Frame& F) {
    for (int u = F.vcu; u < NBP * 4 * 8; u += F.G) attn_prompt_unit(F, u >> 5, (u >> 3) & 3, u & 7);
    for (int u = F.vcu; u < NBS * 4; u += F.G) attn_sample_unit(F, u >> 2, u & 3);
}
__device__ __forceinline__ void final_norm_phase(Frame& F) {
    const int gw = F.vcu * NWAVES + F.wave, NGW = F.G * NWAVES; const float* SSQ = (const float*)(F.ws + WS_SSQP3); const float* wn = F.in[31]; const bf16* HB = (const bf16*)(F.ws + WS_HB);
    f32x4 wv[4];
#pragma unroll
    for (int j = 0; j < 2; ++j) { wv[2 * j] = *((const f32x4*)wn + 2 * (64 * j + F.lane)); wv[2 * j + 1] = *((const f32x4*)wn + 2 * (64 * j + F.lane) + 1); }
    for (int row = gw; row < T; row += NGW) {
        const f32x4* sp = (const f32x4*)(SSQ + (size_t)row * 16); float s = 0.f;
#pragma unroll
        for (int j = 0; j < 4; ++j) { const f32x4 a = sp[j]; s += (a.x + a.y) + (a.z + a.w); }
        const float rs = __builtin_amdgcn_rsqf(s * (1.0f / 1024.0f) + EPS);
#pragma unroll
        for (int j = 0; j < 2; ++j) { const int pc = 64 * j + F.lane; const v4u w = *((const v4u*)(HB + (size_t)row * 1024) + pc);
            const f32x4 v0 = (f32x4){bf2f(w.x & 0xffffu), __uint_as_float(w.x & 0xffff0000u), bf2f(w.y & 0xffffu), __uint_as_float(w.y & 0xffff0000u)};
            const f32x4 v1 = (f32x4){bf2f(w.z & 0xffffu), __uint_as_float(w.z & 0xffff0000u), bf2f(w.w & 0xffffu), __uint_as_float(w.w & 0xffff0000u)};
            f32x4* o = (f32x4*)(F.out + O_Y + (size_t)row * 1024) + 2 * pc; o[0] = v0 * rs * wv[2 * j]; o[1] = v1 * rs * wv[2 * j + 1]; }
    }
}
#ifndef MK_N_LAUNCHES
#define MK_N_LAUNCHES 1
#endif
constexpr int PER_PHASE = 13;
constexpr int N_LAUNCHES = MK_N_LAUNCHES;
struct Args { const float* in[32]; float* out; unsigned char* ws; int ph_lo, ph_hi; };
__global__ void __launch_bounds__(NTHR, 2) skel_fwd(Args args) {
    extern __shared__ __attribute__((aligned(16))) unsigned char lds[];
    Frame F;
    F.lds = (LAS unsigned char*)lds;
    F.MISC = (volatile LAS unsigned*)(F.lds + MISC_OFF);
    F.tid = threadIdx.x; F.lane = F.tid & 63; F.wave = __builtin_amdgcn_readfirstlane(F.tid >> 6);
    F.G = gridDim.x; { const int bx = blockIdx.x; F.vcu = (F.G % 8 == 0) ? (bx % 8) * (F.G / 8) + bx / 8 : bx; }
    unsigned char* ws = args.ws; F.ws = ws; F.out = args.out;
    F.ctl = (gu32*)(ws + WS_CTL);
#pragma unroll
    for (int i = 0; i < 32; ++i) F.in[i] = args.in[i];
    for (int u = F.tid; u < (LDS_BYTES - LDSCTL_OFF) / 4; u += NTHR) ((LAS unsigned*)(F.lds + LDSCTL_OFF))[u] = 0u;
    __syncthreads();
    XcdBarrier bar; bar.bar = (unsigned*)(F.ctl + CW_BAR); bar.x = 0; bar.st = nullptr;
    if (N_LAUNCHES == 1) bar = xcd_barrier_post((unsigned*)(F.ctl + CW_BAR), F.MISC + 8);
#define GRID_BAR() do { if (N_LAUNCHES == 1) xcd_barrier(bar); } while (0)
    const int lo = args.ph_lo, hi = args.ph_hi;
#ifdef ONLY_PHASE
#define IN(k) ((k) == ONLY_PHASE && lo <= (k) && (k) < hi)
#else
#define IN(k) (lo <= (k) && (k) < hi)
#endif
#define BOTH(k) (IN(k) && IN((k) + 1))
    bf16* const XB = (bf16*)(ws + WS_XB); bf16* const PROJ = (bf16*)(ws + WS_PROJ);
    float* const Y = F.out + O_Y;
    if (IN(0)) { p0_prologue(F); if (BOTH(0)) GRID_BAR(); }
    if (IN(1)) {
        { pg8::Gemm g{XB, (const bf16*)(ws + WS_WIN), T, NPROJ, 1024}; pg8::StaticOrder S; S.init(T, NPROJ, F.G, (int)blockIdx.x);
          pg8::EpiScaleBf16<1, true> E{PROJ, SLOT_ELEMS, (const float*)(ws + WS_SSQX), 1.0f, (float*)(ws + WS_DT)};
          pg8::gemm_phase<pg8::EpiScaleBf16<1, true>, pg8::StaticOrder, true, true>(F.lds + RING_OFF, g, S, E); }
        { pg8::Gemm g{(const bf16*)(ws + WS_MNB), (const bf16*)(ws + WS_WKV), MEMR, 2048, 1024}; pg8::StaticOrder S; S.init(MEMR, 2048, F.G, (int)((blockIdx.x + 64) % F.G));
          pg8::EpiKV E{F.out + O_MKP, F.out + O_MVP, (bf16*)(ws + WS_KB), (bf16*)(ws + WS_VT), (const float*)(ws + WS_SSQM)};
          pg8::gemm_phase<pg8::EpiKV, pg8::StaticOrder, true, true>(F.lds + RING_OFF, g, S, E); }
        if (BOTH(1)) GRID_BAR();
    }
    if (IN(2)) { bc_prep_phase(F); hg_prep_phase(F); if (BOTH(2)) GRID_BAR(); }
    if (IN(3)) { scan_phase(F); if (BOTH(3)) GRID_BAR(); }
    if (IN(4)) { ssdnorm_phase(F); hgnorm_phase(F); if (BOTH(4)) GRID_BAR(); }
    if (IN(5)) { { SmGate<false> Es{(bf16*)(ws + WS_MERGED), PROJ + (size_t)S_GS * SLOT_ELEMS}; small_tile_phase(F, (const bf16*)(ws + WS_YG), (const bf16*)(ws + WS_WSSD), 2048, Es); }
        pg8::Gemm g{(const bf16*)(ws + WS_YG), (const bf16*)(ws + WS_WSSD), TP, 1024, 2048}; pg8::StaticOrder S; S.init(TP, 1024, F.G, (int)blockIdx.x);
        pg8::EpiGate<false> E{(bf16*)(ws + WS_MERGED), PROJ + (size_t)S_GS * SLOT_ELEMS};
        pg8::gemm_phase<pg8::EpiGate<false>, pg8::StaticOrder, true, true>(F.lds + RING_OFF, g, S, E);
          }
    if (IN(5)) { { SmGate<true> Es{(bf16*)(ws + WS_MERGED), PROJ + (size_t)S_GH * SLOT_ELEMS}; small_tile_phase(F, (const bf16*)(ws + WS_ON), (const bf16*)(ws + WS_WHG), 1024, Es); }
        pg8::Gemm g{(const bf16*)(ws + WS_ON), (const bf16*)(ws + WS_WHG), TP, 1024, 1024}; pg8::StaticOrder S; S.init(TP, 1024, F.G, (int)blockIdx.x);
        pg8::EpiGate<true> E{(bf16*)(ws + WS_MERGED), PROJ + (size_t)S_GH * SLOT_ELEMS};
        pg8::gemm_phase<pg8::EpiGate<true>, pg8::StaticOrder, true, true>(F.lds + RING_OFF, g, S, E);
        if (BOTH(5)) GRID_BAR(); }
    if (IN(6)) { { SmRes<false> Es{F.in[1] - (size_t)TP * 1024, (bf16*)(ws + WS_HB), (float*)(ws + WS_SSQP1)}; small_tile_phase(F, (const bf16*)(ws + WS_MERGED), (const bf16*)(ws + WS_WOUT), 1024, Es); }
        pg8::Gemm g{(const bf16*)(ws + WS_MERGED), (const bf16*)(ws + WS_WOUT), TP, 1024, 1024}; pg8::StaticOrder S; S.init(TP, 1024, F.G, (int)blockIdx.x);
        pg8::EpiRes<false> E{F.in[0], F.in[1] - (size_t)TP * 1024, (bf16*)(ws + WS_HB), (float*)(ws + WS_SSQP1)};
        pg8::gemm_phase<pg8::EpiRes<false>, pg8::StaticOrder, true, true>(F.lds + RING_OFF, g, S, E);
        if (BOTH(6)) GRID_BAR(); }
    if (IN(7)) { { SmScale Es{(bf16*)(ws + WS_QB), (const float*)(ws + WS_SSQP1), QSCALE}; small_tile_phase(F, (const bf16*)(ws + WS_HB), (const bf16*)(ws + WS_WCQ), 1024, Es); }
        pg8::Gemm g{(const bf16*)(ws + WS_HB), (const bf16*)(ws + WS_WCQ), TP, 1024, 1024}; pg8::StaticOrder S; S.init(TP, 1024, F.G, (int)blockIdx.x);
        pg8::EpiScaleBf16<16, false> E{(bf16*)(ws + WS_QB), SLOT_ELEMS, (const float*)(ws + WS_SSQP1), QSCALE, nullptr};
        pg8::gemm_phase<pg8::EpiScaleBf16<16, false>, pg8::StaticOrder, true, true>(F.lds + RING_OFF, g, S, E);
        if (BOTH(7)) GRID_BAR(); }
    if (IN(8)) { attn_phase(F); if (BOTH(8)) GRID_BAR(); }
    if (IN(9)) { { SmRes<true> Es{nullptr, (bf16*)(ws + WS_HB), (float*)(ws + WS_SSQP2)}; small_tile_phase(F, (const bf16*)(ws + WS_OB), (const bf16*)(ws + WS_WCO), 1024, Es); }
        pg8::Gemm g{(const bf16*)(ws + WS_OB), (const bf16*)(ws + WS_WCO), TP, 1024, 1024}; pg8::StaticOrder S; S.init(TP, 1024, F.G, (int)blockIdx.x);
        pg8::EpiRes<true> E{nullptr, nullptr, (bf16*)(ws + WS_HB), (float*)(ws + WS_SSQP2)};
        pg8::gemm_phase<pg8::EpiRes<true>, pg8::StaticOrder, true, true>(F.lds + RING_OFF, g, S, E);
        if (BOTH(9)) GRID_BAR(); }
    if (IN(10)) { pg8::Gemm g{(const bf16*)(ws + WS_HB), (const bf16*)(ws + WS_WGU), T, 2 * FFN, 1024}; pg8::StaticOrder S; S.init(T, 2 * FFN, F.G, (int)blockIdx.x);
        pg8::EpiSwiglu E{(bf16*)(ws + WS_ACT), (const float*)(ws + WS_SSQP2)};
        pg8::gemm_phase<pg8::EpiSwiglu, pg8::StaticOrder, true, true>(F.lds + RING_OFF, g, S, E);
        if (BOTH(10)) GRID_BAR(); }
    if (IN(11)) { { SmRes<true> Es{nullptr, (bf16*)(ws + WS_HB), (float*)(ws + WS_SSQP3)}; small_tile_phase(F, (const bf16*)(ws + WS_ACT), (const bf16*)(ws + WS_WDN), FFN, Es); }
        pg8::Gemm g{(const bf16*)(ws + WS_ACT), (const bf16*)(ws + WS_WDN), TP, 1024, FFN}; pg8::StaticOrder S; S.init(TP, 1024, F.G, (int)blockIdx.x);
        pg8::EpiRes<true> E{nullptr, nullptr, (bf16*)(ws + WS_HB), (float*)(ws + WS_SSQP3)};
        pg8::gemm_phase<pg8::EpiRes<true>, pg8::StaticOrder, true, true>(F.lds + RING_OFF, g, S, E);
        if (BOTH(11)) GRID_BAR(); }
    if (IN(12)) final_norm_phase(F);
#undef IN
#undef BOTH
}

extern "C" void kernel_launch(void* const* d_in, const int* in_sizes, int n_in, void* d_out, int out_size, void* d_ws, size_t ws_size, hipStream_t stream) {
    static int grid = 0;
    if (grid == 0) {
        const int want[32] = {TP * 1024, TS * 1024, MEMR * 1024, 33554432, 1179648, 16777216, 33554432, 33554432, 1024, 1024 * 11296, 4 * 3072, 3072, 32, 32, 32, 2048, 2048 * 1024, 2048, 1024,
                              1024 * 1024, 1024 * 1024, 1024, 1024, 1024 * 1024, 1024 * 1024, 1024 * 1024, 1024 * 1024, 1024, 1024 * FFN, 1024 * FFN, FFN * 1024, 1024};
        bool ok = (n_in == 32); for (int i = 0; ok && i < 32; ++i) if (in_sizes[i] != want[i]) { fprintf(stderr, "kernel_launch: input %d has %d elements, expected %d\n", i, in_sizes[i], want[i]); ok = false; }
        if (!ok || out_size != (int)O_END || ws_size < WS_END4) { fprintf(stderr, "kernel_launch: unexpected shapes: n_in %d out %d ws %zu\n", n_in, out_size, ws_size); grid = -1; return; }
        int dev = 0, cus = 0, per_cu = 0;
        if (hipGetDevice(&dev) != hipSuccess || hipDeviceGetAttribute(&cus, hipDeviceAttributeMultiprocessorCount, dev) != hipSuccess) { grid = -1; return; }
        if (hipFuncSetAttribute((const void*)skel_fwd, hipFuncAttributeMaxDynamicSharedMemorySize, LDS_BYTES) != hipSuccess) { fprintf(stderr, "kernel_launch: hipFuncSetAttribute failed\n"); grid = -1; return; }
        if (hipOccupancyMaxActiveBlocksPerMultiprocessor(&per_cu, (const void*)skel_fwd, NTHR, LDS_BYTES) != hipSuccess || per_cu < 1) fprintf(stderr, "kernel_launch: occupancy query reports %d blocks per CU\n", per_cu);
        (void)hipGetLastError();
        grid = cus;
    }
    if (grid < 0) return;
    (void)hipMemsetAsync((char*)d_ws + WS_CTL, 0, CTL_ZERO_BYTES, stream);
    Args a{};
    for (int i = 0; i < 32; ++i) a.in[i] = (const float*)d_in[i];
    a.out = (float*)d_out; a.ws = (unsigned char*)d_ws;
    for (int li = 0; li < N_LAUNCHES; ++li) {
        a.ph_lo = (N_LAUNCHES == PER_PHASE) ? li : 0; a.ph_hi = (N_LAUNCHES == PER_PHASE) ? li + 1 : PER_PHASE;
        hipLaunchKernelGGL(skel_fwd, dim3(grid), dim3(NTHR), LDS_BYTES, stream, a);
    }
}
```

```cpp
#include <hip/hip_runtime.h>
#include <cstdio>
#include <cstdint>
namespace pg8 {
#define PG8_LAS __attribute__((address_space(3)))
typedef unsigned short bf16_t;
typedef short bf16x8 __attribute__((ext_vector_type(8)));
typedef float f32x4 __attribute__((ext_vector_type(4)));
typedef unsigned u32x4 __attribute__((ext_vector_type(4)));
constexpr int BM = 256, BK = 64, HALF = 128, HTB = HALF * BK * 2  , STAGE_BYTES = 8 * HTB, NXCD = 8, WGM = 8;

__host__ __device__ __forceinline__ int lds_byte(int r, int c) { const int st = (r >> 4) * 2 + (c >> 5), rr = r & 15, cc = c & 31, ob = rr * 64 + cc * 2; return st * 1024 + (ob ^ (((ob >> 9) & 1) << 5)); }
__host__ __device__ __forceinline__ void stage_rc(int b, int& R, int& C) { const int st = b / 1024, sb = b % 1024, swz = sb ^ (((sb >> 9) & 1) << 5); R = (st >> 1) * 16 + swz / 64; C = (st & 1) * 32 + (swz % 64) / 2; }
__host__ __device__ __forceinline__ int perm32(int rho) { const int n = rho >> 4, i = rho & 15; return 8 * (i >> 2) + 4 * n + (i & 3); }

struct Unit { int pm, pn; };
struct Gemm { const bf16_t* A; const bf16_t* Bt; int M, N, K; };

struct StaticOrder {
    int nM, nN, nwg, G, c;
    __host__ __device__ void init(int M, int N, int G_, int c_) { nM = M / BM; nN = N / BM; nwg = nM * nN; G = G_; c = c_; }
    __host__ __device__ bool next(int i, Unit& u) const {
        const long L = (long)i * G + c; if (L >= nwg) return false;
        int wgid = (int)L; { const int q = nwg / NXCD, r = nwg % NXCD, xcd = wgid % NXCD, off = wgid / NXCD; wgid = (xcd < r ? xcd * (q + 1) : r * (q + 1) + (xcd - r) * q) + off; }
        const int nig = WGM * nN, gid = wgid / nig, fm = gid * WGM, gsz = (nM - fm) < WGM ? (nM - fm) : WGM;
        u.pm = fm + ((wgid % nig) % gsz); u.pn = (wgid % nig) / gsz; return true;
    }
    __device__ __forceinline__ void a_ready(const Unit&) const {}
    __device__ __forceinline__ void done(const Unit&) const {}
};

__device__ __forceinline__ unsigned cvt_pk_bf16(float lo, float hi) { unsigned r; asm volatile("v_cvt_pk_bf16_f32 %0, %1, %2" : "=v"(r) : "v"(lo), "v"(hi)); return r; }
typedef float f32x2 __attribute__((ext_vector_type(2)));
typedef unsigned u32x2 __attribute__((ext_vector_type(2)));
constexpr float RMS_EPS = 1e-6f;
__device__ __forceinline__ float bfbits2f(unsigned v16) { return __uint_as_float(v16 << 16); }
__device__ __forceinline__ float sigm(float x) { return __builtin_amdgcn_rcpf(1.0f + __expf(-x)); }
template <int NP> __device__ __forceinline__ float row_rs(const float* ssq, int row) {
    float s = 0.f;
    if constexpr (NP == 1) s = ssq[row];
    else {
#pragma unroll
        for (int i = 0; i < NP / 4; ++i) { const f32x4 v = *(const f32x4*)(ssq + (size_t)row * NP + 4 * i); s += (v[0] + v[1]) + (v[2] + v[3]); }
    }
    return 1.0f / sqrtf(s * (1.0f / 1024.0f) + RMS_EPS);
}
template <int NP, bool HAS_DT> struct EpiScaleBf16 {
    static constexpr bool PERM = true, AFTER_DRAIN = false;
    bf16_t* O; size_t slot_elems; const float* ssq; float scale; float* dt;
    __device__ __forceinline__ void operator()(const f32x4 (&acc)[2][2][4][2], const Unit& u, int wr, int wc, int fr, int fq) const {
        const int row0 = u.pm * BM + wr * 64 + fr;
        if (HAS_DT && u.pn == 44) {
            if (wc == 0) {
#pragma unroll
                for (int ai = 0; ai < 2; ++ai)
#pragma unroll
                    for (int m = 0; m < 4; ++m) { const int row = row0 + ai * HALF + m * 16; const float rs = row_rs<NP>(ssq, row);
                        float* p = dt + (size_t)row * 32 + 8 * fq; *(f32x4*)p = acc[ai][0][m][0] * rs; *(f32x4*)(p + 4) = acc[ai][0][m][1] * rs; }
            }
            return;
        }
        bf16_t* base = O + (size_t)(u.pn >> 2) * slot_elems; const int col0 = (u.pn & 3) * BM + wc * 32 + 8 * fq;
#pragma unroll
        for (int ai = 0; ai < 2; ++ai)
#pragma unroll
            for (int m = 0; m < 4; ++m) { const int row = row0 + ai * HALF + m * 16; const float rs = row_rs<NP>(ssq, row) * scale; bf16_t* rowp = base + (size_t)row * 1024 + col0;
#pragma unroll
                for (int bj = 0; bj < 2; ++bj) { const f32x4 v0 = acc[ai][bj][m][0] * rs, v1 = acc[ai][bj][m][1] * rs;
                    u32x4 w; w.x = cvt_pk_bf16(v0[0], v0[1]); w.y = cvt_pk_bf16(v0[2], v0[3]); w.z = cvt_pk_bf16(v1[0], v1[1]); w.w = cvt_pk_bf16(v1[2], v1[3]);
                    *(u32x4*)(rowp + bj * HALF) = w; } }
    }
};
struct EpiKV {
    static constexpr bool PERM = false, AFTER_DRAIN = false;
    float* mk; float* mv; bf16_t* kb; bf16_t* vt; const float* ssq;
    __device__ __forceinline__ void operator()(const f32x4 (&acc)[2][2][4][2], const Unit& u, int wr, int wc, int fr, int fq) const {
        const int row0 = u.pm * BM + wr * 64 + fr; const bool isv = u.pn >= 4; const int colt = (u.pn & 3) * BM + wc * 32 + 4 * fq;
#pragma unroll
        for (int ai = 0; ai < 2; ++ai)
#pragma unroll
            for (int m = 0; m < 4; ++m) { const int row = row0 + ai * HALF + m * 16; const float rs = row_rs<1>(ssq, row);
#pragma unroll
                for (int bj = 0; bj < 2; ++bj)
#pragma unroll
                    for (int n = 0; n < 2; ++n) { const int c = colt + bj * HALF + n * 16; const f32x4 v = acc[ai][bj][m][n] * rs;
                        if (!isv) { *(f32x4*)(mk + (size_t)row * 1024 + c) = v; u32x2 w; w.x = cvt_pk_bf16(v[0], v[1]); w.y = cvt_pk_bf16(v[2], v[3]); *(u32x2*)(kb + (size_t)row * 1024 + c) = w; }
                        else { *(f32x4*)(mv + (size_t)row * 1024 + c) = v; const int b = row >> 8, key = row & 255, hd = c >> 8, d = c & 255;
                            bf16_t* p = vt + ((size_t)((b * 4 + hd) * 256 + d)) * 256 + key; const unsigned w0 = cvt_pk_bf16(v[0], v[1]), w1 = cvt_pk_bf16(v[2], v[3]);
                            p[0] = (bf16_t)(w0 & 0xffffu); p[256] = (bf16_t)(w0 >> 16); p[512] = (bf16_t)(w1 & 0xffffu); p[768] = (bf16_t)(w1 >> 16); } } }
    }
};
template <bool ADD> struct EpiGate {
    static constexpr bool PERM = true, AFTER_DRAIN = false;
    bf16_t* O; const bf16_t* gate;
    __device__ __forceinline__ void operator()(const f32x4 (&acc)[2][2][4][2], const Unit& u, int wr, int wc, int fr, int fq) const {
        const int row0 = u.pm * BM + wr * 64 + fr, col0 = u.pn * BM + wc * 32 + 8 * fq;
#pragma unroll
        for (int ai = 0; ai < 2; ++ai)
#pragma unroll
            for (int m = 0; m < 4; ++m) { const size_t off = (size_t)(row0 + ai * HALF + m * 16) * 1024 + col0;
#pragma unroll
                for (int bj = 0; bj < 2; ++bj) { const u32x4 gw = *(const u32x4*)(gate + off + bj * HALF); u32x4 ow = (u32x4){0u, 0u, 0u, 0u}; if (ADD) ow = *(const u32x4*)(O + off + bj * HALF);
                    float r[8];
#pragma unroll
                    for (int e = 0; e < 8; ++e) { const unsigned g16 = (gw[e >> 1] >> ((e & 1) * 16)) & 0xffffu, o16 = (ow[e >> 1] >> ((e & 1) * 16)) & 0xffffu;
                        const float a = acc[ai][bj][m][e >> 2][e & 3]; r[e] = (ADD ? bfbits2f(o16) : 0.f) + sigm(bfbits2f(g16)) * a; }
                    u32x4 w; w.x = cvt_pk_bf16(r[0], r[1]); w.y = cvt_pk_bf16(r[2], r[3]); w.z = cvt_pk_bf16(r[4], r[5]); w.w = cvt_pk_bf16(r[6], r[7]);
                    *(u32x4*)(O + off + bj * HALF) = w; } }
    }
};
template <bool BF> struct EpiRes {
    static constexpr bool PERM = true, AFTER_DRAIN = false;
    const float* base0; const float* base1; bf16_t* hb; float* ssqp;
    __device__ __forceinline__ void operator()(const f32x4 (&acc)[2][2][4][2], const Unit& u, int wr, int wc, int fr, int fq) const {
        const int row0 = u.pm * BM + wr * 64 + fr, col0 = u.pn * BM + wc * 32 + 8 * fq; const float* base = u.pm < 64 ? base0 : base1;
#pragma unroll
        for (int ai = 0; ai < 2; ++ai)
#pragma unroll
            for (int m = 0; m < 4; ++m) { const int row = row0 + ai * HALF + m * 16; const size_t off = (size_t)row * 1024 + col0; float sq = 0.f;
#pragma unroll
                for (int bj = 0; bj < 2; ++bj) { const size_t o2 = off + bj * HALF; f32x4 b0, b1;
                    if (BF) { const u32x4 w = *(const u32x4*)(hb + o2); b0 = (f32x4){bfbits2f(w.x & 0xffffu), __uint_as_float(w.x & 0xffff0000u), bfbits2f(w.y & 0xffffu), __uint_as_float(w.y & 0xffff0000u)};
                        b1 = (f32x4){bfbits2f(w.z & 0xffffu), __uint_as_float(w.z & 0xffff0000u), bfbits2f(w.w & 0xffffu), __uint_as_float(w.w & 0xffff0000u)}; }
                    else { b0 = *(const f32x4*)(base + o2); b1 = *(const f32x4*)(base + o2 + 4); }
                    const f32x4 v0 = b0 + acc[ai][bj][m][0], v1 = b1 + acc[ai][bj][m][1];
                    sq += ((v0[0] * v0[0] + v0[1] * v0[1]) + (v0[2] * v0[2] + v0[3] * v0[3])) + ((v1[0] * v1[0] + v1[1] * v1[1]) + (v1[2] * v1[2] + v1[3] * v1[3]));
                    u32x4 w; w.x = cvt_pk_bf16(v0[0], v0[1]); w.y = cvt_pk_bf16(v0[2], v0[3]); w.z = cvt_pk_bf16(v1[0], v1[1]); w.w = cvt_pk_bf16(v1[2], v1[3]); *(u32x4*)(hb + o2) = w; }
                sq += __shfl_xor(sq, 16); sq += __shfl_xor(sq, 32);
                if (fq == 0) ssqp[(size_t)row * 16 + u.pn * 4 + wc] = sq; }
    }
};
struct EpiSwiglu {
    static constexpr bool PERM = true, AFTER_DRAIN = false;
    bf16_t* act; const float* ssq;
    __device__ __forceinline__ void operator()(const f32x4 (&acc)[2][2][4][2], const Unit& u, int wr, int wc, int fr, int fq) const {
        const int row0 = u.pm * BM + wr * 64 + fr, col0 = u.pn * 128 + wc * 16 + 4 * fq;
#pragma unroll
        for (int ai = 0; ai < 2; ++ai)
#pragma unroll
            for (int m = 0; m < 4; ++m) { const int row = row0 + ai * HALF + m * 16; const float rs = row_rs<16>(ssq, row);
#pragma unroll
                for (int bj = 0; bj < 2; ++bj) { const f32x4 a = acc[ai][bj][m][0] * rs, b = acc[ai][bj][m][1] * rs;
                    const float r0 = a[0] * sigm(a[0]) * a[1], r1 = a[2] * sigm(a[2]) * a[3], r2 = b[0] * sigm(b[0]) * b[1], r3 = b[2] * sigm(b[2]) * b[3];
                    u32x2 w; w.x = cvt_pk_bf16(r0, r1); w.y = cvt_pk_bf16(r2, r3); *(u32x2*)(act + (size_t)row * 2816 + col0 + bj * 64) = w; } }
    }
};
template <class Epi, class Sched, bool ALIGN_EPI = false, bool SP2 = false>
__device__ __forceinline__ void gemm_phase(PG8_LAS unsigned char* lds, const Gemm g, const Sched& S, const Epi& E) {
    const int tid = threadIdx.x, wid = __builtin_amdgcn_readfirstlane(tid >> 6), lane = tid & 63, wr = wid >> 2, wc = wid & 3, fr = lane & 15, fq = lane >> 4;
    const int K = g.K, nt = K / BK;
    unsigned voffA[2], voffB[2];
#pragma unroll
    for (int i = 0; i < 2; ++i) { int R, C; stage_rc(tid * 16 + i * 8192, R, C); const int Rb = Epi::PERM ? ((R & ~31) + perm32(R & 31)) : R;
        voffA[i] = (unsigned)(R * K + C) * 2u; voffB[i] = (unsigned)(Rb * K + C) * 2u; }
    const size_t kstep = (size_t)(BK * 2);
    const size_t hstep = (size_t)HALF * K * 2;
    const size_t tstep = 2 * hstep;
    const unsigned ldsw = (unsigned)wid * 1024u;
    const int aoff = lds_byte(wr * 64 + fr, fq * 8), boff = lds_byte(wc * 32 + fr, fq * 8);
#define PG8_SA(b, h) (((b) * 2 + (h)) * HTB)
#define PG8_SB(b, h) ((4 + (b) * 2 + (h)) * HTB)
#define PG8_STAGE(bufoff, gbase, voff) do { _Pragma("unroll") for (int _i = 0; _i < 2; ++_i) \
        __builtin_amdgcn_global_load_lds((const unsigned*)((const char*)(gbase) + (voff)[_i]), (PG8_LAS unsigned*)(lds + (bufoff) + ldsw + _i * 8192), 16, 0, 0); } while (0)
#define PG8_LDA(dst, b, h) do { _Pragma("unroll") for (int m = 0; m < 4; ++m) _Pragma("unroll") for (int k = 0; k < 2; ++k) dst[m][k] = *(const PG8_LAS bf16x8*)(lds + PG8_SA(b, h) + aoff + m * 2048 + k * 1024); } while (0)
#define PG8_LDB(dst, b, h) do { _Pragma("unroll") for (int n = 0; n < 2; ++n) _Pragma("unroll") for (int k = 0; k < 2; ++k) dst[n][k] = *(const PG8_LAS bf16x8*)(lds + PG8_SB(b, h) + boff + n * 2048 + k * 1024); } while (0)
#define PG8_MMA(ai, bj, At, Bt) do { __builtin_amdgcn_s_setprio(1); _Pragma("unroll") for (int m = 0; m < 4; ++m) _Pragma("unroll") for (int n = 0; n < 2; ++n) _Pragma("unroll") for (int k = 0; k < 2; ++k) \
        acc[ai][bj][m][n] = __builtin_amdgcn_mfma_f32_16x16x32_bf16(Bt[n][k], At[m][k], acc[ai][bj][m][n], 0, 0, 0); __builtin_amdgcn_s_setprio(0); } while (0)
#define PG8_WAIT_V(n) asm volatile("s_waitcnt vmcnt(" #n ")" ::: "memory")
#define PG8_WAIT_L(n) asm volatile("s_waitcnt lgkmcnt(" #n ")" ::: "memory")
#define PG8_BAR __builtin_amdgcn_s_barrier()
#define PG8_SCHED __builtin_amdgcn_sched_barrier(0)
    Unit cur, nxt; int ui = 0;
    if (!S.next(0, cur)) return;
    f32x4 acc[2][2][4][2];
#pragma unroll
    for (int a = 0; a < 2; ++a)
#pragma unroll
        for (int b = 0; b < 2; ++b)
#pragma unroll
            for (int m = 0; m < 4; ++m)
#pragma unroll
                for (int n = 0; n < 2; ++n) acc[a][b][m][n] = (f32x4){0.f, 0.f, 0.f, 0.f};
    bf16x8 At[4][2], B0[2][2], B1[2][2];
    const char* cA = (const char*)g.A + (size_t)cur.pm * tstep; const char* cB = (const char*)g.Bt + (size_t)cur.pn * tstep;
    S.a_ready(cur);
    if constexpr (SP2) {
        PG8_STAGE(PG8_SB(0, 0), cB, voffB); PG8_STAGE(PG8_SB(0, 1), cB + hstep, voffB); PG8_STAGE(PG8_SA(0, 0), cA, voffA); PG8_STAGE(PG8_SA(0, 1), cA + hstep, voffA);
        if (wr == 1) PG8_BAR;
        PG8_WAIT_V(2); PG8_BAR;
        PG8_STAGE(PG8_SB(1, 0), cB + kstep, voffB); PG8_STAGE(PG8_SA(1, 0), cA + kstep, voffA); PG8_STAGE(PG8_SB(1, 1), cB + hstep + kstep, voffB);
        PG8_WAIT_V(6); PG8_BAR;
    } else {
        PG8_STAGE(PG8_SB(0, 0), cB, voffB); PG8_STAGE(PG8_SA(0, 0), cA, voffA); PG8_STAGE(PG8_SB(0, 1), cB + hstep, voffB); PG8_STAGE(PG8_SA(0, 1), cA + hstep, voffA);
        if (wr == 1) PG8_BAR;
        PG8_WAIT_V(4); PG8_BAR;
        PG8_STAGE(PG8_SB(1, 0), cB + kstep, voffB); PG8_STAGE(PG8_SA(1, 0), cA + kstep, voffA); PG8_STAGE(PG8_SB(1, 1), cB + hstep + kstep, voffB);
        PG8_WAIT_V(6); PG8_BAR;
    }
    for (;;) {
        const bool has_next = S.next(ui + 1, nxt);
        const char* nA = has_next ? (const char*)g.A + (size_t)nxt.pm * tstep : cA; const char* nB = has_next ? (const char*)g.Bt + (size_t)nxt.pn * tstep : cB;
        for (int t = 0; t < nt; t += 2) {
            const bool last = (t == nt - 2);
            const char* a1 = cA + (size_t)(t + 1) * kstep;
            const char* a2 = last ? nA : cA + (size_t)(t + 2) * kstep; const char* b2 = last ? nB : cB + (size_t)(t + 2) * kstep;
            const char* a3 = a2 + kstep; const char* b3 = b2 + kstep;
            if (last && has_next) S.a_ready(nxt);
            if constexpr (SP2) {
            PG8_LDB(B0, 0, 0); PG8_LDB(B1, 0, 1); PG8_SCHED; PG8_LDA(At, 0, 0); PG8_STAGE(PG8_SA(1, 1), a1 + hstep, voffA);
            PG8_WAIT_V(8); PG8_WAIT_L(0); PG8_BAR; PG8_MMA(0, 0, At, B0); PG8_MMA(0, 1, At, B1); PG8_BAR; PG8_SCHED;
            PG8_LDA(At, 0, 1); PG8_STAGE(PG8_SB(0, 0), b2, voffB); PG8_STAGE(PG8_SB(0, 1), b2 + hstep, voffB); PG8_STAGE(PG8_SA(0, 0), a2, voffA);
            PG8_WAIT_V(8); PG8_WAIT_L(0); PG8_BAR; PG8_MMA(1, 0, At, B0); PG8_MMA(1, 1, At, B1); PG8_BAR; PG8_SCHED;
            PG8_LDB(B0, 1, 0); PG8_LDB(B1, 1, 1); PG8_SCHED; PG8_LDA(At, 1, 0); PG8_STAGE(PG8_SA(0, 1), a2 + hstep, voffA);
            PG8_WAIT_V(8); PG8_WAIT_L(0); PG8_BAR; PG8_MMA(0, 0, At, B0); PG8_MMA(0, 1, At, B1); PG8_BAR; PG8_SCHED;
            PG8_LDA(At, 1, 1); PG8_STAGE(PG8_SB(1, 0), b3, voffB); PG8_STAGE(PG8_SB(1, 1), b3 + hstep, voffB); PG8_STAGE(PG8_SA(1, 0), a3, voffA);
            PG8_WAIT_V(8); PG8_WAIT_L(0); PG8_BAR; PG8_MMA(1, 0, At, B0); PG8_MMA(1, 1, At, B1); PG8_BAR; PG8_SCHED;
            } else {
            PG8_LDB(B0, 0, 0); PG8_SCHED; PG8_LDA(At, 0, 0); PG8_STAGE(PG8_SA(1, 1), a1 + hstep, voffA);
            PG8_WAIT_L(8); PG8_BAR; PG8_WAIT_L(0); PG8_MMA(0, 0, At, B0); PG8_BAR; PG8_SCHED;
            PG8_LDB(B1, 0, 1); PG8_STAGE(PG8_SB(0, 0), b2, voffB);
            PG8_BAR; PG8_WAIT_L(0); PG8_MMA(0, 1, At, B1); PG8_BAR;
            PG8_LDA(At, 0, 1); PG8_STAGE(PG8_SA(0, 0), a2, voffA);
            PG8_BAR; PG8_WAIT_L(0); PG8_MMA(1, 0, At, B0); PG8_BAR; PG8_SCHED;
            PG8_STAGE(PG8_SB(0, 1), b2 + hstep, voffB);
            PG8_WAIT_V(6); PG8_BAR; PG8_MMA(1, 1, At, B1); PG8_BAR;
            PG8_LDB(B0, 1, 0); PG8_SCHED; PG8_LDA(At, 1, 0); PG8_STAGE(PG8_SA(0, 1), a2 + hstep, voffA);
            PG8_WAIT_L(8); PG8_BAR; PG8_WAIT_L(0); PG8_MMA(0, 0, At, B0); PG8_BAR; PG8_SCHED;
            PG8_LDB(B1, 1, 1); PG8_STAGE(PG8_SB(1, 0), b3, voffB);
            PG8_BAR; PG8_WAIT_L(0); PG8_MMA(0, 1, At, B1); PG8_BAR;
            PG8_LDA(At, 1, 1); PG8_STAGE(PG8_SA(1, 0), a3, voffA);
            PG8_BAR; PG8_WAIT_L(0); PG8_MMA(1, 0, At, B0); PG8_BAR; PG8_SCHED;
            PG8_STAGE(PG8_SB(1, 1), b3 + hstep, voffB);
            PG8_WAIT_V(6); PG8_BAR; PG8_MMA(1, 1, At, B1); PG8_BAR;
            }
        }
        if constexpr (ALIGN_EPI) { if (wr == 0) PG8_BAR; }
        if constexpr (!Epi::AFTER_DRAIN) { E(acc, cur, wr, wc, fr, fq); S.done(cur); }
        if (!has_next) break;
#pragma unroll
        for (int a = 0; a < 2; ++a)
#pragma unroll
            for (int b = 0; b < 2; ++b)
#pragma unroll
                for (int m = 0; m < 4; ++m)
#pragma unroll
                    for (int n = 0; n < 2; ++n) acc[a][b][m][n] = (f32x4){0.f, 0.f, 0.f, 0.f};
        cur = nxt; cA = nA; cB = nB; ++ui;
        if constexpr (ALIGN_EPI) { if (wr == 1) PG8_BAR; }
    }
    PG8_WAIT_V(0);
    if constexpr (!ALIGN_EPI) { if (wr == 0) PG8_BAR; }
    PG8_BAR;
    if constexpr (Epi::AFTER_DRAIN) { E.fused(acc, cur, wr, wc, fr, fq, lds, wid, lane); S.done(cur); }
#undef PG8_SA
#undef PG8_SB
#undef PG8_STAGE
#undef PG8_LDA
#undef PG8_LDB
#undef PG8_MMA
#undef PG8_WAIT_V
#undef PG8_WAIT_L
#undef PG8_BAR
#undef PG8_SCHED
}
}
#define GAS __attribute__((address_space(1)))
#define LAS __attribute__((address_space(3)))
typedef unsigned short bf16;
typedef unsigned v4u __attribute__((ext_vector_type(4)));
typedef float f32x4 __attribute__((ext_vector_type(4)));
typedef short bf16x8 __attribute__((ext_vector_type(8)));
typedef GAS unsigned gu32;
typedef GAS unsigned long long gu64;
#define RLX_AGENT __ATOMIC_RELAXED, __HIP_MEMORY_SCOPE_AGENT
#define LDS_WAIT() asm volatile("s_waitcnt lgkmcnt(0)" ::: "memory")
#define VM_WAIT() asm volatile("s_waitcnt vmcnt(0)" ::: "memory")
__device__ __forceinline__ unsigned long long rt() { return __builtin_amdgcn_s_memrealtime(); }
typedef float f32x2_t __attribute__((ext_vector_type(2))); typedef __bf16 bf16x2_t __attribute__((ext_vector_type(2)));
__device__ __forceinline__ unsigned pk2(float lo, float hi) { const f32x2_t v = {lo, hi}; const bf16x2_t b = __builtin_convertvector(v, bf16x2_t); return __builtin_bit_cast(unsigned, b); }
__device__ __forceinline__ unsigned f2bf(float f) { return pk2(f, 0.f) & 0xffffu; }

#define XB_TMO      128
#define XB_XCNT(j)  (256  + 64 * (j))
#define XB_XSUB(j)  (1280 + 64 * (j))
#define XB_XGEN(j)  (2304 + 64 * (j))
#define XB_TOP      3328
#define XB_TOPGEN   3392
#define XCD_BAR_WORDS 3456
#define XB_SPIN_CAP (1u << 18)

__device__ __forceinline__ unsigned xb_ld(unsigned* p)              { return __hip_atomic_load(p, __ATOMIC_RELAXED, __HIP_MEMORY_SCOPE_AGENT); }
__device__ __forceinline__ unsigned xb_add(unsigned* p, unsigned v) { return __hip_atomic_fetch_add(p, v, __ATOMIC_RELAXED, __HIP_MEMORY_SCOPE_AGENT); }
__device__ __forceinline__ unsigned xb_xcc_id() { return (unsigned)__builtin_amdgcn_s_getreg((3 << 11) | 20) & 0xFu; }
#define XB_SPIN(cond, bar) do { unsigned _sp = 0; while (cond) { __builtin_amdgcn_s_sleep(1); \
    if ((++_sp & 255u) == 0u) { if (xb_ld(&(bar)[XB_TMO])) break; if (_sp > XB_SPIN_CAP) { atomicAdd(&(bar)[XB_TMO], 1u); break; } } } } while (0)

struct XcdBarrier {
    unsigned* bar; unsigned x;
    volatile LAS unsigned* st;
};

__device__ __forceinline__ XcdBarrier xcd_barrier_post(unsigned* bar, volatile LAS unsigned* st) {
    XcdBarrier b; b.bar = bar; b.x = xb_xcc_id(); b.st = st;
    if (threadIdx.x == 0) (void)xb_add(&bar[XB_XCNT(b.x)], 1u);
    return b;
}
__device__ __forceinline__ void xcd_barrier_complete(unsigned* bar, unsigned x, unsigned& nloc, unsigned& nx) {
    const unsigned G = gridDim.x * gridDim.y * gridDim.z;
    unsigned sum, cnt, mine, sp = 0u;
    for (;;) {
        sum = 0u; cnt = 0u; mine = 0u;
#pragma unroll
        for (unsigned j = 0; j < 16; ++j) { const unsigned c = xb_ld(&bar[XB_XCNT(j)]); sum += c; cnt += (c > 0u) ? 1u : 0u; mine = (j == x) ? c : mine; }
        if (sum == G) break;
        __builtin_amdgcn_s_sleep(1);
        if ((++sp & 255u) == 0u) { if (xb_ld(&bar[XB_TMO])) break; if (sp > XB_SPIN_CAP) { atomicAdd(&bar[XB_TMO], 1u); break; } }
    }
    nloc = mine > 0u ? mine : 1u; nx = cnt > 0u ? cnt : 1u;
}

__device__ __forceinline__ void xcd_barrier(const XcdBarrier& b) {
    asm volatile("s_waitcnt vmcnt(0)" ::: "memory");
    __syncthreads();
    if (threadIdx.x == 0) {
        unsigned* bar = b.bar;
        __builtin_amdgcn_s_waitcnt(0);
        unsigned nloc = b.st[0], nx = b.st[1];
        if (nloc == 0u) { xcd_barrier_complete(bar, b.x, nloc, nx); b.st[0] = nloc; b.st[1] = nx; }
        const unsigned old = xb_add(&bar[XB_XSUB(b.x)], 1u);
        const unsigned gen = old / nloc;
        if (old + 1u == (gen + 1u) * nloc) {
            __builtin_amdgcn_fence(__ATOMIC_RELEASE, "agent");
            asm volatile("s_waitcnt vmcnt(0)" ::: "memory");
            const unsigned og = xb_add(&bar[XB_TOP], 1u);
            const unsigned tg = og / nx;
            if (og + 1u == (tg + 1u) * nx) xb_add(&bar[XB_TOPGEN], 1u);
            else XB_SPIN(xb_ld(&bar[XB_TOPGEN]) == tg, bar);
            __builtin_amdgcn_fence(__ATOMIC_ACQUIRE, "agent");
            xb_add(&bar[XB_XGEN(b.x)], 1u);
            asm volatile("s_waitcnt vmcnt(0)" ::: "memory");
        } else {
            XB_SPIN(xb_ld(&bar[XB_XGEN(b.x)]) == gen, bar);
            __builtin_amdgcn_fence(__ATOMIC_ACQUIRE, "agent");
            asm volatile("s_waitcnt vmcnt(0)" ::: "memory");
        }
    }
    __syncthreads();
}
typedef unsigned v2u __attribute__((ext_vector_type(2)));
constexpr int NWAVES = 8, NTHR = 512;
constexpr int DM = 1024, TP = 16384, TS = 512, T = TP + TS;
constexpr int SEQ = 2048, NBP = 8, NBS = 128, LS = 4, MEMR = 2048;
constexpr int NPROJ = 11520;
constexpr int FFN = 2816;
constexpr float EPS = 1e-6f;
constexpr float QSCALE = 0.0625f * 1.4426950408889634f;

constexpr size_t MiB = 1u << 20;
constexpr size_t WS_CTL = 0, CTL_ZERO_BYTES = 1 * MiB;
constexpr size_t WS_SSQX = 1 * MiB, WS_SSQM = 1 * MiB + 512 * 1024;
constexpr size_t WS_DT = 2 * MiB, WS_SSQSSD = 5 * MiB, WS_SSQP1 = 8 * MiB, WS_SSQP2 = 9 * MiB + 512 * 1024, WS_SSQP3 = 11 * MiB;
constexpr size_t WS_WIN = 13 * MiB, WS_WKV = 36 * MiB, WS_WSSD = 40 * MiB, WS_WHG = 44 * MiB, WS_WOUT = 46 * MiB, WS_WCQ = 48 * MiB, WS_WCO = 50 * MiB, WS_WGU = 52 * MiB, WS_WDN = 63 * MiB;
constexpr size_t WS_XB = 69 * MiB, WS_MNB = 102 * MiB, WS_KB = 106 * MiB, WS_VT = 110 * MiB;
constexpr size_t SLOT = 33 * MiB, SLOT_ELEMS = (size_t)T * 1024;
constexpr size_t WS_PROJ = 114 * MiB;
constexpr size_t WS_YG = WS_PROJ + 11 * SLOT, WS_ON = WS_YG + 2 * SLOT, WS_END = WS_ON + SLOT;
static_assert(SLOT == SLOT_ELEMS * 2, "slot size");
static_assert(WS_WIN + (size_t)NPROJ * 1024 * 2 <= WS_WKV && WS_WGU + (size_t)2 * FFN * 1024 * 2 <= WS_WDN && WS_WDN + (size_t)1024 * FFN * 2 <= WS_XB && WS_SSQP3 + (size_t)T * 64 <= WS_WIN, "d_ws map");
static_assert(WS_DT + (size_t)T * 128 <= WS_SSQSSD && WS_SSQSSD + (size_t)T * 128 <= WS_SSQP1 && WS_SSQP1 + (size_t)T * 64 <= WS_SSQP2 && WS_SSQP2 + (size_t)T * 64 <= WS_SSQP3, "d_ws map 2");
enum { S_Z0 = 0, S_Z1 = 1, S_X0 = 2, S_X1 = 3, S_X2 = 4, S_Q = 5, S_F = 6, S_I = 7, S_HG = 8, S_GS = 9, S_GH = 10 };
constexpr size_t WS_MERGED = WS_PROJ + S_Q * SLOT, WS_HB = WS_PROJ + S_F * SLOT, WS_QB = WS_PROJ + S_I * SLOT, WS_OB = WS_PROJ + S_HG * SLOT, WS_ACT = WS_PROJ;
static_assert((size_t)T * FFN * 2 <= 3 * SLOT, "act overlay");
constexpr size_t O_Y = 0, O_SSMP = (size_t)T * 1024, O_CONVP = O_SSMP + 2097152, O_HGP = O_CONVP + 73728, O_MKP = O_HGP + 1048576, O_MVP = O_MKP + 2097152,
                 O_SSMS = O_MVP + 2097152, O_CONVS = O_SSMS + 33554432, O_HGS = O_CONVS + 1179648, O_END = O_HGS + 16777216;
constexpr int CW_QUEUE = 64;
constexpr int CW_BAR = 4096;
constexpr int RING_OFF = 0, RING_BYTES = 131072;
constexpr int LDS_BYTES = 147456;
constexpr int LDSCTL_OFF = LDS_BYTES - 1024, MISC_OFF = LDSCTL_OFF + 320;
struct Frame {
    LAS unsigned char* lds;
    volatile LAS unsigned* MISC;
    gu32* ctl;
    int tid, lane, wave;
    int vcu, G;
    const float* in[32];
    float* out; unsigned char* ws;
};
__device__ __forceinline__ float bf2f(unsigned v16) { return __uint_as_float(v16 << 16); }
__device__ __forceinline__ f32x4 ld_nt(const float* p) { return __builtin_nontemporal_load((const f32x4*)p); }
__device__ __forceinline__ void st_nt(float* p, f32x4 v) { __builtin_nontemporal_store(v, (f32x4*)p); }
__device__ __forceinline__ float sigmoid_f(float x) { return __builtin_amdgcn_rcpf(1.0f + __expf(-x)); }
__device__ __forceinline__ float silu_f(float x) { return x * sigmoid_f(x); }
__device__ __forceinline__ float wave_sum(float v) {
#pragma unroll
    for (int o = 1; o < 64; o <<= 1) v += __shfl_xor(v, o);
    return v;
}
__device__ __forceinline__ float wave_max(float v) {
#pragma unroll
    for (int o = 1; o < 64; o <<= 1) v = fmaxf(v, __shfl_xor(v, o));
    return v;
}
struct TSrc { const float* W; const float* W2; const float* ks; int ldw; int mode; };
__device__ __forceinline__ void p0_transpose_item(const TSrc& s, int K, int N, bf16* WT, LAS unsigned short* scr, int item, int lane) {
    const int nblk = N / 64, kb = item / nblk, nb = item % nblk, k0 = 64 * kb, n0 = 64 * nb;
    const int kr = lane >> 4, nq = lane & 15;
    const float* const Wa = s.W; const float* const Wb = s.W2;
    const float* src; int c0, cs; bool zero = false;
    if (s.mode == 2) { const float* wsel = Wa; if (nq >= 8) wsel = Wb; src = wsel + (n0 >> 1) + 4 * (nq & 7); c0 = 8 * (nq & 7) + (nq >> 3); cs = 2; }
    else { const int n = n0 + 4 * nq; c0 = 4 * nq; cs = 1;
        if (s.mode == 0) src = Wa + n;
        else if (s.mode == 1) { if (n < 5120) src = Wa + n; else if (n < 11264) src = Wa + n + 32; else if (n < 11296) src = Wa + 5120 + (n - 11264); else { src = Wa; zero = true; } }
        else { src = Wa + n; if (n >= 1024) src = Wb + (n - 1024); } }
    f32x4 v[16];
#pragma unroll
    for (int i = 0; i < 16; ++i) v[i] = zero ? (f32x4){0.f, 0.f, 0.f, 0.f} : ld_nt(src + (size_t)(k0 + 4 * i + kr) * s.ldw);
#pragma unroll
    for (int i = 0; i < 16; ++i) { const int kk = 4 * i + kr; const float sc = s.ks ? s.ks[k0 + kk] : 1.0f; const unsigned w0 = pk2(v[i].x * sc, v[i].y * sc), w1 = pk2(v[i].z * sc, v[i].w * sc);
        LAS unsigned short* d = scr + kk * 66 + c0;
        if (cs == 1) { *(LAS unsigned*)d = w0; *(LAS unsigned*)(d + 2) = w1; }
        else { d[0] = (unsigned short)(w0 & 0xffffu); d[2] = (unsigned short)(w0 >> 16); d[4] = (unsigned short)(w1 & 0xffffu); d[6] = (unsigned short)(w1 >> 16); } }
    LDS_WAIT(); asm volatile("" ::: "memory");
    const int nr = lane >> 3, kc = lane & 7;
#pragma unroll
    for (int j = 0; j < 8; ++j) { const int n = 8 * j + nr; const LAS unsigned short* p = scr + (8 * kc) * 66 + n;
        v4u o; o.x = (unsigned)p[0] | ((unsigned)p[66] << 16); o.y = (unsigned)p[2 * 66] | ((unsigned)p[3 * 66] << 16); o.z = (unsigned)p[4 * 66] | ((unsigned)p[5 * 66] << 16); o.w = (unsigned)p[6 * 66] | ((unsigned)p[7 * 66] << 16);
        *(v4u*)(WT + (size_t)(n0 + n) * K + k0 + 8 * kc) = o; }
    LDS_WAIT(); asm volatile("" ::: "memory");
}
__device__ __forceinline__ void rows4_to_bf16_ssq(const float* x0, bf16* o0, float* ssq0, int lane) {
    f32x4 v[4][4];
#pragma unroll
    for (int rr = 0; rr < 4; ++rr)
#pragma unroll
        for (int j = 0; j < 4; ++j) v[rr][j] = ld_nt(x0 + rr * 1024 + 4 * (64 * j + lane));
#pragma unroll
    for (int rr = 0; rr < 4; ++rr) { float sq = 0.f;
#pragma unroll
        for (int j = 0; j < 4; ++j) sq += (v[rr][j].x * v[rr][j].x + v[rr][j].y * v[rr][j].y) + (v[rr][j].z * v[rr][j].z + v[rr][j].w * v[rr][j].w);
        sq = wave_sum(sq);
        unsigned long long* o8 = (unsigned long long*)(o0 + rr * 1024) + lane;
#pragma unroll
        for (int j = 0; j < 4; ++j) o8[64 * j] = (unsigned long long)pk2(v[rr][j].x, v[rr][j].y) | ((unsigned long long)pk2(v[rr][j].z, v[rr][j].w) << 32);
        if (lane == 0) ssq0[rr] = sq; }
}
__device__ __forceinline__ void p0_prologue(Frame& F) {
    LAS unsigned short* scr = (LAS unsigned short*)(F.lds + RING_OFF + F.wave * 16384);
    const int gw = F.vcu * NWAVES + F.wave, NGW = F.G * NWAVES;
    unsigned char* ws = F.ws;
    constexpr int I_IN = 16 * (NPROJ / 64), I_KV = 16 * 32, I_SSD = 32 * 16, I_SQ = 16 * 16, I_GU = 16 * (2 * FFN / 64), I_DN = (FFN / 64) * 16;
    constexpr int NITEMS = I_IN + I_KV + I_SSD + 4 * I_SQ + I_GU + I_DN;
    for (int it = gw; it < NITEMS; it += NGW) {
        int r = it;
        if (r < I_IN) { TSrc s{F.in[9], nullptr, F.in[8], 11296, 1}; p0_transpose_item(s, 1024, NPROJ, (bf16*)(ws + WS_WIN), scr, r, F.lane); continue; } r -= I_IN;
        if (r < I_KV) { TSrc s{F.in[24], F.in[25], F.in[22], 1024, 3}; p0_transpose_item(s, 1024, 2048, (bf16*)(ws + WS_WKV), scr, r, F.lane); continue; } r -= I_KV;
        if (r < I_SSD) { TSrc s{F.in[16], nullptr, F.in[15], 1024, 0}; p0_transpose_item(s, 2048, 1024, (bf16*)(ws + WS_WSSD), scr, r, F.lane); continue; } r -= I_SSD;
        if (r < I_SQ) { TSrc s{F.in[19], nullptr, F.in[18], 1024, 0}; p0_transpose_item(s, 1024, 1024, (bf16*)(ws + WS_WHG), scr, r, F.lane); continue; } r -= I_SQ;
        if (r < I_SQ) { TSrc s{F.in[20], nullptr, nullptr, 1024, 0}; p0_transpose_item(s, 1024, 1024, (bf16*)(ws + WS_WOUT), scr, r, F.lane); continue; } r -= I_SQ;
        if (r < I_SQ) { TSrc s{F.in[23], nullptr, F.in[21], 1024, 0}; p0_transpose_item(s, 1024, 1024, (bf16*)(ws + WS_WCQ), scr, r, F.lane); continue; } r -= I_SQ;
        if (r < I_SQ) { TSrc s{F.in[26], nullptr, nullptr, 1024, 0}; p0_transpose_item(s, 1024, 1024, (bf16*)(ws + WS_WCO), scr, r, F.lane); continue; } r -= I_SQ;
        if (r < I_GU) { TSrc s{F.in[28], F.in[29], F.in[27], FFN, 2}; p0_transpose_item(s, 1024, 2 * FFN, (bf16*)(ws + WS_WGU), scr, r, F.lane); continue; } r -= I_GU;
        { TSrc s{F.in[30], nullptr, nullptr, 1024, 0}; p0_transpose_item(s, FFN, 1024, (bf16*)(ws + WS_WDN), scr, r, F.lane); }
    }
    bf16* XB = (bf16*)(ws + WS_XB); float* SSQX = (float*)(ws + WS_SSQX);
    for (int m4 = gw; m4 < T / 4; m4 += NGW) { const int m = 4 * m4;
        rows4_to_bf16_ssq(m < TP ? F.in[0] + (size_t)m * DM : F.in[1] + (size_t)(m - TP) * DM, XB + (size_t)m * DM, SSQX + m, F.lane); }
    bf16* MNB = (bf16*)(ws + WS_MNB); float* SSQM = (float*)(ws + WS_SSQM);
    for (int m4 = gw; m4 < MEMR / 4; m4 += NGW) { const int m = 4 * m4; rows4_to_bf16_ssq(F.in[2] + (size_t)m * DM, MNB + (size_t)m * DM, SSQM + m, F.lane); }
}
__device__ __forceinline__ void conv_copy_unit(Frame& F, int gb) {
    const bf16* PROJ = (const bf16*)(F.ws + WS_PROJ);
    const bool prompt = gb < NBP; const int sb = gb - NBP;
    const size_t row0 = prompt ? (size_t)gb * SEQ + (SEQ - 3) : (size_t)TP + (size_t)sb * LS + 1;
    float* dst = prompt ? F.out + O_CONVP + (size_t)gb * 3 * 3072 : F.out + O_CONVS + (size_t)sb * 3 * 3072;
    for (int e = F.tid; e < 3 * 3072; e += NTHR) { const int j = e / 3072, col = e % 3072;
        dst[e] = bf2f(PROJ[(size_t)(S_X0 + (col >> 10)) * SLOT_ELEMS + (row0 + j) * 1024 + (col & 1023)]); }
}
__device__ __forceinline__ void ssdnorm_phase(Frame& F) {
    const int gw = F.vcu * NWAVES + F.wave, NGW = F.G * NWAVES; bf16* YG = (bf16*)(F.ws + WS_YG); const float* SSQ = (const float*)(F.ws + WS_SSQSSD);
    for (int row = gw; row < T; row += NGW) {
        const f32x4* sp = (const f32x4*)(SSQ + (size_t)row * 32);
#pragma unroll
        for (int j = 0; j < 4; ++j) { const f32x4 a = sp[2 * j], b = sp[2 * j + 1]; const float s = ((a.x + a.y) + (a.z + a.w)) + ((b.x + b.y) + (b.z + b.w)); const float rs = 1.0f / sqrtf(s * (1.0f / 512.0f) + EPS);
            v4u* p = (v4u*)(YG + (size_t)row * 2048) + j * 64 + F.lane; const v4u w = *p; v4u o;
#pragma unroll
            for (int e = 0; e < 4; ++e) o[e] = pk2(bf2f(w[e] & 0xffffu) * rs, bf2f(w[e] >> 16) * rs);
            *p = o; }
    }
}
typedef float f32x16 __attribute__((ext_vector_type(16)));
#define MFMA32(a, b, c) __builtin_amdgcn_mfma_f32_32x32x16_bf16((a), (b), (c), 0, 0, 0)
__device__ __forceinline__ unsigned cvtpk_c(float lo, float hi) { return pk2(lo, hi); }
__device__ __forceinline__ bf16x8 pack8(float a0, float a1, float a2, float a3, float a4, float a5, float a6, float a7) {
    v4u w; w.x = cvtpk_c(a0, a1); w.y = cvtpk_c(a2, a3); w.z = cvtpk_c(a4, a5); w.w = cvtpk_c(a6, a7); return __builtin_bit_cast(bf16x8, w); }
#define ACC_FRAG(x, s) pack8((x)[8 * (s)], (x)[8 * (s) + 1], (x)[8 * (s) + 2], (x)[8 * (s) + 3], (x)[8 * (s) + 4], (x)[8 * (s) + 5], (x)[8 * (s) + 6], (x)[8 * (s) + 7])
__device__ __forceinline__ bf16x8 lds_frag16(const LAS unsigned char* p) { return *(const LAS bf16x8*)p; }
__device__ __forceinline__ bf16x8 lds_frag8x2(const LAS unsigned char* p) { const v2u lo = *(const LAS v2u*)p, hi = *(const LAS v2u*)(p + 16);
    const v4u w = (v4u){lo.x, lo.y, hi.x, hi.y}; return __builtin_bit_cast(bf16x8, w); }
#define LDS_BARRIER() do { asm volatile("s_waitcnt lgkmcnt(0)" ::: "memory"); __builtin_amdgcn_s_barrier(); asm volatile("" ::: "memory"); } while (0)
constexpr size_t WS_BCS = WS_END, WS_BTT = WS_BCS + (size_t)TP * 1024 * 2, WS_END2 = WS_BTT + (size_t)NBP * 32 * 4 * 128 * 64 * 2;
__device__ __forceinline__ void bc_prep_unit(Frame& F, int b, int c) {
    typedef float f32x2 __attribute__((ext_vector_type(2)));
    int tid_o = F.tid; asm volatile("" : "+v"(tid_o));
    const int tid = tid_o, cg = tid & 127, seg = tid >> 7; unsigned char* ws = F.ws;
    const bf16* src = (const bf16*)(ws + WS_PROJ) + (size_t)S_X2 * SLOT_ELEMS + (size_t)b * SEQ * 1024 + 8 * cg;
    bf16* BCS = (bf16*)(ws + WS_BCS); bf16* BTT = (bf16*)(ws + WS_BTT);
    const float* cw = F.in[10] + 2048 + 8 * cg; const float* cbp = F.in[11] + 2048 + 8 * cg;
#pragma unroll 1
    for (int half = 0; half < 2; ++half) {
        const int s0 = 16 * seg + 8 * half;
        v4u raw[11];
#pragma unroll
        for (int i = 0; i < 11; ++i) { const int gt = 64 * c + s0 - 3 + i; raw[i] = (v4u){0u, 0u, 0u, 0u}; if (gt >= 0) raw[i] = *(const v4u*)(src + (size_t)gt * 1024); }
        v4u rowpk[8];
#pragma unroll
        for (int kp = 0; kp < 4; ++kp) {
            const f32x2 cw0 = *(const f32x2*)(cw + 2 * kp), cw1 = *(const f32x2*)(cw + 3072 + 2 * kp), cw2 = *(const f32x2*)(cw + 2 * 3072 + 2 * kp), cw3 = *(const f32x2*)(cw + 3 * 3072 + 2 * kp), cbb = *(const f32x2*)(cbp + 2 * kp);
            f32x2 xv[11];
#pragma unroll
            for (int i = 0; i < 11; ++i) { const unsigned wd = raw[i][kp]; xv[i] = (f32x2){__uint_as_float(wd << 16), __uint_as_float(wd & 0xffff0000u)}; }
            f32x2 o[8];
#pragma unroll
            for (int i = 0; i < 8; ++i) { f32x2 a = cw0 * xv[i] + cbb; a = cw1 * xv[i + 1] + a; a = cw2 * xv[i + 2] + a; a = cw3 * xv[i + 3] + a;
                const f32x2 t = a * (-1.4426950408889634f); f32x2 e; e.x = __builtin_amdgcn_exp2f(t.x); e.y = __builtin_amdgcn_exp2f(t.y); e = e + 1.0f;
                f32x2 rc; rc.x = __builtin_amdgcn_rcpf(e.x); rc.y = __builtin_amdgcn_rcpf(e.y); o[i] = a * rc; }
#pragma unroll
            for (int i = 0; i < 8; ++i) rowpk[i][kp] = pk2(o[i].x, o[i].y);
            if (cg < 64) { const int ng = 8 * cg + 2 * kp, g = ng >> 7, n = ng & 127;
                bf16* dst = BTT + ((size_t)(((b * 32 + c) * 4 + g) * 128 + n)) * 64 + s0;
                v4u pa; pa.x = pk2(o[0].x, o[1].x); pa.y = pk2(o[2].x, o[3].x); pa.z = pk2(o[4].x, o[5].x); pa.w = pk2(o[6].x, o[7].x); *(v4u*)dst = pa;
                v4u pb; pb.x = pk2(o[0].y, o[1].y); pb.y = pk2(o[2].y, o[3].y); pb.z = pk2(o[4].y, o[5].y); pb.w = pk2(o[6].y, o[7].y); *(v4u*)(dst + 64) = pb; }
        }
        bf16* drow = BCS + ((size_t)b * SEQ + 64 * c + s0) * 1024 + 8 * cg;
#pragma unroll
        for (int i = 0; i < 8; ++i) *(v4u*)(drow + (size_t)i * 1024) = rowpk[i];
    }
}
__device__ __forceinline__ void bc_prep_phase(Frame& F) { for (int u = F.vcu; u < NBP * 32; u += F.G) bc_prep_unit(F, u >> 5, u & 31); }
constexpr size_t WS_HVT = WS_XB, WS_EGM = WS_END2, WS_EGL = WS_EGM + (size_t)NBP * 64 * 1024 * 4, WS_END3 = WS_EGL + (size_t)NBP * 64 * 1024 * 4;
__device__ __forceinline__ void hg_prep_unit(Frame& F, int b, int c) {
    typedef float f32x2 __attribute__((ext_vector_type(2)));
    int tid_o = F.tid; asm volatile("" : "+v"(tid_o));
    const int tid = tid_o; unsigned char* ws = F.ws;
    const int ch = 2 * tid, hd = ch >> 7, k = ch & 127;
    const size_t row0 = (size_t)b * SEQ + 32 * c;
    bf16* QS = (bf16*)(ws + WS_PROJ) + (size_t)S_Q * SLOT_ELEMS + row0 * 1024 + ch; bf16* FS = (bf16*)(ws + WS_PROJ) + (size_t)S_F * SLOT_ELEMS + row0 * 1024 + ch;
    bf16* IS = (bf16*)(ws + WS_PROJ) + (size_t)S_I * SLOT_ELEMS + row0 * 1024;
    const f32x2 l0 = *(const f32x2*)(F.in[17] + ch), l1 = *(const f32x2*)(F.in[17] + 1024 + ch);
    f32x2 lb; lb.x = __builtin_amdgcn_rcpf(1.0f + __expf(l1.x - l0.x)); lb.y = __builtin_amdgcn_rcpf(1.0f + __expf(l1.y - l0.y));
    const f32x2 omlb = 1.0f - lb;
    f32x2 P[32]; f32x2 run = (f32x2){1.0f, 1.0f};
#pragma unroll
    for (int t = 0; t < 32; ++t) { const unsigned wd = *(const unsigned*)(FS + (size_t)t * 1024);
        f32x2 u = (f32x2){__uint_as_float(wd << 16), __uint_as_float(wd & 0xffff0000u)}; u.x = fminf(fmaxf(u.x, -30.f), 30.f); u.y = fminf(fmaxf(u.y, -30.f), 30.f);
        const f32x2 tt = u * (-1.4426950408889634f); f32x2 e; e.x = __builtin_amdgcn_exp2f(tt.x); e.y = __builtin_amdgcn_exp2f(tt.y); e = e + 1.0f;
        f32x2 sg; sg.x = __builtin_amdgcn_rcpf(e.x); sg.y = __builtin_amdgcn_rcpf(e.y);
        const f32x2 fg = lb + omlb * sg; run = run * fg; run.x = fmaxf(run.x, 1e-30f); run.y = fmaxf(run.y, 1e-30f); P[t] = run; }
    const f32x2 Pm = P[15], Pl = P[31]; f32x2 rPm; rPm.x = __builtin_amdgcn_rcpf(Pm.x); rPm.y = __builtin_amdgcn_rcpf(Pm.y);
    *(f32x2*)((float*)(ws + WS_EGM) + (size_t)(b * 64 + c) * 1024 + ch) = Pm; *(f32x2*)((float*)(ws + WS_EGL) + (size_t)(b * 64 + c) * 1024 + ch) = Pl * rPm;
    unsigned kx[16], ky[16], vx[16], vy[16];
    f32x2 rPprev = (f32x2){1.0f, 1.0f}; f32x2 kprev = (f32x2){0.f, 0.f}; unsigned iprev = 0u;
#pragma unroll
    for (int t = 0; t < 32; ++t) { f32x2 rP; rP.x = __builtin_amdgcn_rcpf(P[t].x); rP.y = __builtin_amdgcn_rcpf(P[t].y);
        const f32x2 e1 = P[t] * rPm, e2 = Pm * rP, fg = P[t] * rPprev, kk = 1.0f - fg; rPprev = rP;
        const unsigned qw = *(const unsigned*)(QS + (size_t)t * 1024); const f32x2 q = (f32x2){__uint_as_float(qw << 16), __uint_as_float(qw & 0xffff0000u)};
        const f32x2 tq = q * (-1.4426950408889634f); f32x2 eq; eq.x = __builtin_amdgcn_exp2f(tq.x); eq.y = __builtin_amdgcn_exp2f(tq.y); eq = eq + 1.0f;
        f32x2 rq; rq.x = __builtin_amdgcn_rcpf(eq.x); rq.y = __builtin_amdgcn_rcpf(eq.y);
        const f32x2 qa = q * rq * e1, ka = kk * e2;
        *(unsigned*)(QS + (size_t)t * 1024) = pk2(qa.x, qa.y); *(unsigned*)(FS + (size_t)t * 1024) = pk2(ka.x, ka.y);
        const unsigned iw = *(const unsigned*)(IS + (size_t)t * 1024 + ch);
        if (t & 1) { kx[t >> 1] = pk2(kprev.x, ka.x); ky[t >> 1] = pk2(kprev.y, ka.y); vx[t >> 1] = (iprev & 0xffffu) | (iw << 16); vy[t >> 1] = (iprev >> 16) | (iw & 0xffff0000u); }
        kprev = ka; iprev = iw; }
    bf16* VTg = (bf16*)(ws + WS_HVT) + ((size_t)((b * 64 + c) * 8 + hd) * 128 + k) * 32;
#pragma unroll
    for (int j = 0; j < 4; ++j) { *(v4u*)(VTg + 8 * j) = (v4u){vx[4 * j], vx[4 * j + 1], vx[4 * j + 2], vx[4 * j + 3]}; *(v4u*)(VTg + 32 + 8 * j) = (v4u){vy[4 * j], vy[4 * j + 1], vy[4 * j + 2], vy[4 * j + 3]}; }
    __syncthreads();
    bf16* KTg = IS + ((size_t)hd * 128 + k) * 32;
#pragma unroll
    for (int j = 0; j < 4; ++j) { *(v4u*)(KTg + 8 * j) = (v4u){kx[4 * j], kx[4 * j + 1], kx[4 * j + 2], kx[4 * j + 3]}; *(v4u*)(KTg + 32 + 8 * j) = (v4u){ky[4 * j], ky[4 * j + 1], ky[4 * j + 2], ky[4 * j + 3]}; }
    __syncthreads();
}
__device__ __forceinline__ void hg_prep_phase(Frame& F) { for (int u = F.vcu; u < NBP * 64; u += F.G) hg_prep_unit(F, u >> 6, u & 63); }
constexpr int HV_QA = 0, HV_KA = 8704, HV_KAT = 17408, HV_VT = 27648, HV_EGM = 30208, HV_EGL = 30720, HV_PBUF = 31232, HV_OB = 2 * HV_PBUF, HV_OBUF = 23040;
constexpr size_t WS_SSQH = WS_END3, WS_END4 = WS_SSQH + (size_t)T * 32 * 4;
__device__ __forceinline__ void hgrn_v_unit(Frame& F, int b, int hd, int vt) {
    int tid_o = F.tid; asm volatile("" : "+v"(tid_o));
    const int tid = tid_o, lane = tid & 63, w = F.wave, r = lane & 31, hh = lane >> 5; unsigned char* ws = F.ws;
    LAS unsigned char* Lb = F.lds + RING_OFF;
    const bf16* PROJ = (const bf16*)(ws + WS_PROJ); bf16* OU = (bf16*)(ws + WS_ON); float* SSQH = (float*)(ws + WS_SSQH);
    const size_t rowb = (size_t)b * SEQ;
    const bf16* qsrc = PROJ + (size_t)S_Q * SLOT_ELEMS + (rowb + (tid >> 4)) * 1024 + hd * 128 + 8 * (tid & 15);
    const bf16* ksrc = PROJ + (size_t)S_F * SLOT_ELEMS + (rowb + (tid >> 4)) * 1024 + hd * 128 + 8 * (tid & 15);
    const bf16* tsrc = PROJ + (size_t)S_I * SLOT_ELEMS + rowb * 1024 + (size_t)(hd * 128 + (tid >> 2)) * 32 + 8 * (tid & 3);
    const unsigned char* xsrc = nullptr; size_t xstr = 0;
    if (tid < 128) { xsrc = (const unsigned char*)((const bf16*)(ws + WS_HVT) + ((size_t)(b * 64 * 8 + hd) * 128 + 32 * vt + (tid >> 2)) * 32 + 8 * (tid & 3)); xstr = (size_t)8 * 128 * 32 * 2; }
    else if (tid < 160) { xsrc = (const unsigned char*)((const float*)(ws + WS_EGM) + (size_t)b * 64 * 1024 + hd * 128 + 4 * (tid - 128)); xstr = 4096; }
    else if (tid < 192) { xsrc = (const unsigned char*)((const float*)(ws + WS_EGL) + (size_t)b * 64 * 1024 + hd * 128 + 4 * (tid - 160)); xstr = 4096; }
    const int xdst = tid < 128 ? HV_VT + (tid >> 2) * 80 + 16 * (tid & 3) : (tid < 160 ? HV_EGM + 16 * (tid - 128) : HV_EGL + 16 * (tid - 160));
#define HGV_LOAD(cc, pq, pk, pt, px) { pq = *(const v4u*)(qsrc + (size_t)(cc) * 32 * 1024); pk = *(const v4u*)(ksrc + (size_t)(cc) * 32 * 1024); pt = *(const v4u*)(tsrc + (size_t)(cc) * 32768); if (tid < 192) px = *(const v4u*)(xsrc + (size_t)(cc) * xstr); }
#define HGV_STORE(pb, pq, pk, pt, px) { *(LAS v4u*)((pb) + HV_QA + (tid >> 4) * 272 + 16 * (tid & 15)) = pq; *(LAS v4u*)((pb) + HV_KA + (tid >> 4) * 272 + 16 * (tid & 15)) = pk; \
        *(LAS v4u*)((pb) + HV_KAT + (tid >> 2) * 80 + 16 * (tid & 3)) = pt; if (tid < 192) *(LAS v4u*)((pb) + xdst) = px; }
    v4u pqA, pkA, ptA, pxA = (v4u){0u, 0u, 0u, 0u}, pqB, pkB, ptB, pxB = (v4u){0u, 0u, 0u, 0u};
    HGV_LOAD(0, pqA, pkA, ptA, pxA) HGV_STORE(Lb, pqA, pkA, ptA, pxA)
    HGV_LOAD(1, pqA, pkA, ptA, pxA) HGV_LOAD(2, pqB, pkB, ptB, pxB)
    const int kt = w;
    v2u ow_pend = (v2u){0u, 0u}; float sq_pend = 0.f;
    f32x16 S;
#pragma unroll
    for (int i = 0; i < 16; ++i) S[i] = 0.f;
    __syncthreads();
#define HGV_ITER(c, pq, pk, pt, px) { \
        int r_l = r, hh_l = hh, tid_l = tid; asm volatile("" : "+v"(r_l), "+v"(hh_l), "+v"(tid_l)); \
        { const int r = r_l, hh = hh_l, tid = tid_l; \
        LAS unsigned char* pbc = Lb + ((c) & 1) * HV_PBUF; LAS unsigned char* pbn = Lb + (((c) + 1) & 1) * HV_PBUF; \
        if ((c) < 63) { HGV_STORE(pbn, pq, pk, pt, px) if ((c) < 61) HGV_LOAD((c) + 3, pq, pk, pt, px) } \
        if (w < 4) { \
            LAS float* EGM = (LAS float*)(pbc + HV_EGM); LAS float* EGL = (LAS float*)(pbc + HV_EGL); LAS float* OB = (LAS float*)(Lb + HV_OB + ((c) & 1) * HV_OBUF); \
            _Pragma("unroll") \
            for (int q4 = 0; q4 < 4; ++q4) { const f32x4 e0 = *(const LAS f32x4*)(EGM + 32 * kt + 8 * q4 + 4 * hh); \
                _Pragma("unroll") \
                for (int j = 0; j < 4; ++j) S[4 * q4 + j] *= e0[j]; } \
            f32x16 o; \
            _Pragma("unroll") \
            for (int i = 0; i < 16; ++i) o[i] = 0.f; \
            const LAS unsigned char* qa_row = pbc + HV_QA + r * 272; \
            o = MFMA32(lds_frag8x2(qa_row + (32 * kt + 4 * hh) * 2), ACC_FRAG(S, 0), o); \
            o = MFMA32(lds_frag8x2(qa_row + (32 * kt + 16 + 4 * hh) * 2), ACC_FRAG(S, 1), o); \
            LAS float* ob = OB + (kt * 32) * 36 + r; \
            _Pragma("unroll") \
            for (int i = 0; i < 16; ++i) ob[((i & 3) + 8 * (i >> 2) + 4 * hh) * 36] = o[i]; \
            const LAS unsigned char* kat_nat = pbc + HV_KAT + (32 * kt + r) * 80 + hh * 16; const LAS unsigned char* vt_nat = pbc + HV_VT + r * 80 + hh * 16; \
            S = MFMA32(lds_frag16(kat_nat), lds_frag16(vt_nat), S); S = MFMA32(lds_frag16(kat_nat + 32), lds_frag16(vt_nat + 32), S); \
            _Pragma("unroll") \
            for (int q4 = 0; q4 < 4; ++q4) { const f32x4 e0 = *(const LAS f32x4*)(EGL + 32 * kt + 8 * q4 + 4 * hh); \
                _Pragma("unroll") \
                for (int j = 0; j < 4; ++j) S[4 * q4 + j] *= e0[j]; } \
        } else { \
            if (w == 4) { LAS float* OB = (LAS float*)(Lb + HV_OB + ((c) & 1) * HV_OBUF); f32x16 o; \
                _Pragma("unroll") \
                for (int i = 0; i < 16; ++i) o[i] = 0.f; \
                f32x16 X; \
                _Pragma("unroll") \
                for (int i = 0; i < 16; ++i) X[i] = 0.f; \
                const LAS unsigned char* ka_nat = pbc + HV_KA + r * 272 + hh * 16; const LAS unsigned char* qa_nat = pbc + HV_QA + r * 272 + hh * 16; \
                _Pragma("unroll 2") \
                for (int ks = 0; ks < 8; ++ks) X = MFMA32(lds_frag16(ka_nat + ks * 32), lds_frag16(qa_nat + ks * 32), X); \
                _Pragma("unroll") \
                for (int i = 0; i < 16; ++i) { const int srow = (i & 3) + 8 * (i >> 2) + 4 * hh; X[i] = (srow <= r) ? X[i] : 0.f; } \
                const LAS unsigned char* vt_row = pbc + HV_VT + r * 80; \
                o = MFMA32(ACC_FRAG(X, 0), lds_frag8x2(vt_row + (4 * hh) * 2), o); \
                o = MFMA32(ACC_FRAG(X, 1), lds_frag8x2(vt_row + (16 + 4 * hh) * 2), o); \
                LAS float* ob4 = OB + (4 * 32) * 36 + r; \
                _Pragma("unroll") \
                for (int i = 0; i < 16; ++i) ob4[((i & 3) + 8 * (i >> 2) + 4 * hh) * 36] = o[i]; \
            } \
            if ((c) > 1) { HGV_FLUSH((c) - 2) } \
            if ((c) > 0) { HGV_OUT((c) - 1) } \
        } \
        LDS_BARRIER(); \
        } }
#define HGV_OUT(cp) { const LAS float* OB = (const LAS float*)(Lb + HV_OB + ((cp) & 1) * HV_OBUF); const int tl = tid - 256, t = tl >> 3, v0 = (tl & 7) * 4; \
            const f32x4 a = *(const LAS f32x4*)(OB + t * 36 + v0), b2 = *(const LAS f32x4*)(OB + (32 + t) * 36 + v0), c2 = *(const LAS f32x4*)(OB + (64 + t) * 36 + v0), d2 = *(const LAS f32x4*)(OB + (96 + t) * 36 + v0), e2 = *(const LAS f32x4*)(OB + (128 + t) * 36 + v0); \
            const f32x4 o4 = ((a + b2) + (c2 + d2)) + e2; \
            float sq = (o4.x * o4.x + o4.y * o4.y) + (o4.z * o4.z + o4.w * o4.w); sq += __shfl_xor(sq, 1); sq += __shfl_xor(sq, 2); sq += __shfl_xor(sq, 4); \
            sq_pend = sq; ow_pend.x = pk2(o4.x, o4.y); ow_pend.y = pk2(o4.z, o4.w); }
#define HGV_FLUSH(cp) { const int tl = tid - 256, t = tl >> 3, v0 = (tl & 7) * 4; const size_t row = rowb + 32 * (cp) + t; \
            if ((tl & 7) == 0) SSQH[row * 32 + hd * 4 + vt] = sq_pend; *(v2u*)(OU + row * 1024 + hd * 128 + 32 * vt + v0) = ow_pend; }
#pragma unroll 1
    for (int cc = 0; cc < 64; cc += 2) { HGV_ITER(cc, pqA, pkA, ptA, pxA) HGV_ITER(cc + 1, pqB, pkB, ptB, pxB) }
    if (w >= 4) { HGV_FLUSH(62) HGV_OUT(63) HGV_FLUSH(63) }
#undef HGV_ITER
#undef HGV_OUT
#undef HGV_FLUSH
#undef HGV_LOAD
#undef HGV_STORE
    if (w < 4) { float* st_g = F.out + O_HGP + (size_t)(b * 8 + hd) * 16384 + 32 * vt + r;
#pragma unroll
        for (int i = 0; i < 16; ++i) { const int k = 32 * kt + (i & 3) + 8 * (i >> 2) + 4 * hh; st_g[(size_t)k * 128] = S[i]; } }
    __syncthreads();
}
__device__ __forceinline__ void hgnorm_phase(Frame& F) {
    const int gw = F.vcu * NWAVES + F.wave, NGW = F.G * NWAVES; bf16* ON = (bf16*)(F.ws + WS_ON); const float* SSQH = (const float*)(F.ws + WS_SSQH);
    const bf16* HG = (const bf16*)(F.ws + WS_PROJ) + (size_t)S_HG * SLOT_ELEMS;
    for (int row = gw; row < TP; row += NGW) {
#pragma unroll
        for (int j = 0; j < 2; ++j) { const int pc = j * 64 + F.lane, hd = pc >> 4;
            const f32x4 sp = *(const f32x4*)(SSQH + (size_t)row * 32 + hd * 4); const float rs = __builtin_amdgcn_rsqf(((sp.x + sp.y) + (sp.z + sp.w)) * (1.0f / 128.0f) + EPS);
            v4u* p = (v4u*)(ON + (size_t)row * 1024) + pc; const v4u o = *p; const v4u g = *((const v4u*)(HG + (size_t)row * 1024) + pc); v4u res;
#pragma unroll
            for (int e = 0; e < 4; ++e) res[e] = pk2(bf2f(o[e] & 0xffffu) * rs * silu_f(bf2f(g[e] & 0xffffu)), __uint_as_float(o[e] & 0xffff0000u) * rs * silu_f(__uint_as_float(g[e] & 0xffff0000u)));
            *p = res; }
    }
}
constexpr int SD_BN = 0, SD_CN = 17408, SD_BT = 34816, SD_XT = 53248, SD_HT = 62464, SD_YA = 97280, SD_YY = 113664, SD_YO = 130048, SD_CUM = 134144, SD_DTV = 134400, SD_ECUM = 134656, SD_XWT = 134912, SD_CWL = 144128;
__device__ __forceinline__ void ssd_unit_mfma(Frame& F, int gb, int h) {
    int tid_o = F.tid; asm volatile("" : "+v"(tid_o));
    const int tid = tid_o, lane = tid & 63, w = F.wave, r = lane & 31, hh = lane >> 5; unsigned char* ws = F.ws;
    const int L = SEQ; const size_t row_base = (size_t)gb * SEQ;
    const int g = h >> 3;
    LAS unsigned char* Lb = F.lds + RING_OFF;
    LAS unsigned short* BN = (LAS unsigned short*)(Lb + SD_BN); LAS unsigned short* CN = (LAS unsigned short*)(Lb + SD_CN);
    LAS unsigned short* BT = (LAS unsigned short*)(Lb + SD_BT); LAS unsigned short* XT = (LAS unsigned short*)(Lb + SD_XT);
    LAS unsigned short* HT = (LAS unsigned short*)(Lb + SD_HT);
    LAS unsigned short* XWT = (LAS unsigned short*)(Lb + SD_XWT);
    LAS float* YA = (LAS float*)(Lb + SD_YA); LAS float* YY = (LAS float*)(Lb + SD_YY); LAS unsigned short* YO = (LAS unsigned short*)(Lb + SD_YO);
    LAS float* CUM = (LAS float*)(Lb + SD_CUM); LAS float* DTV = (LAS float*)(Lb + SD_DTV); LAS float* ECUM = (LAS float*)(Lb + SD_ECUM);
    const bf16* PROJ = (const bf16*)(ws + WS_PROJ); const float* DTR = (const float*)(ws + WS_DT); bf16* YG = (bf16*)(ws + WS_YG); float* SSQ = (float*)(ws + WS_SSQSSD);
    const int nt = w >> 1, pt = w & 1;
    f32x16 H;
    float* st_g = F.out + O_SSMP + (size_t)(gb * 32 + h) * 8192 + (size_t)(32 * pt + r) * 128 + 32 * nt + 4 * hh;
#pragma unroll
    for (int i = 0; i < 16; ++i) H[i] = 0.f;
    {
        LAS unsigned short* hp = HT + (32 * pt + r) * 136 + 32 * nt + 4 * hh;
#pragma unroll
        for (int q4 = 0; q4 < 4; ++q4) { v2u pk; pk.x = cvtpk_c(H[4 * q4], H[4 * q4 + 1]); pk.y = cvtpk_c(H[4 * q4 + 2], H[4 * q4 + 3]); *(LAS v2u*)(hp + 8 * q4) = pk; }
    }
    const float a = -__expf(F.in[13][h]), dtb = F.in[12][h], Dk = F.in[14][h];
    const float* cw = F.in[10]; const float* cbp = F.in[11];
    const int cgl = tid & 7, xs = tid >> 3;
    const int col = h * 64 + 8 * cgl;
    const bf16* cptr = PROJ + (size_t)(S_X0 + (col >> 10)) * SLOT_ELEMS + row_base * 1024 + (col & 1023);
    const bf16* BCS = (const bf16*)(ws + WS_BCS) + row_base * 1024 + g * 128; const bf16* BTT = (const bf16*)(ws + WS_BTT) + (size_t)(gb * 32 * 4 + g) * 128 * 64;
    v4u xr[4], pc[6];
#pragma unroll
    for (int i = 0; i < 4; ++i) { const int gt = xs - 3 + i; xr[i] = (v4u){0u, 0u, 0u, 0u}; if (gt >= 0) xr[i] = *(const v4u*)(cptr + (size_t)gt * 1024); }
#pragma unroll
    for (int j = 0; j < 6; ++j) { const int idx = (tid + 512 * j) & 1023;
        if (j < 4) pc[j] = *(const v4u*)(BCS + (size_t)(idx >> 4) * 1024 + (j >> 1) * 512 + 8 * (idx & 15));
        else pc[j] = *(const v4u*)(BTT + (size_t)(idx >> 3) * 64 + 8 * (idx & 7)); }
    LAS float* CWL = (LAS float*)(Lb + SD_CWL);
    if (tid < 320) { const int j = tid >> 6, c = tid & 63; CWL[tid] = j < 4 ? cw[j * 3072 + h * 64 + c] : cbp[h * 64 + c]; }
    __syncthreads();
    v4u ow_pend = (v4u){0u, 0u, 0u, 0u}; float sq_pend = 0.f; bool pend = false;
    int buf = 0;
    float dt_pf = 0.f;
    if (lane < L) dt_pf = DTR[(row_base + lane) * 32 + h];
    for (int t0 = 0; t0 < L; t0 += 64, buf ^= 1) {
        int r_l = r, hh_l = hh, tid_l = tid, lane_l = lane;
        asm volatile("" : "+v"(r_l), "+v"(hh_l), "+v"(tid_l), "+v"(lane_l));
        { const int r = r_l, hh = hh_l, tid = tid_l, lane = lane_l;
        float dtv = 0.f;
        if (t0 + lane < L) { const float x = dt_pf + dtb; dtv = fmaxf(x, 0.f) + 0.6931471805599453f * __builtin_amdgcn_logf(1.0f + __builtin_amdgcn_exp2f(-1.4426950408889634f * fabsf(x))); }
        dt_pf = 0.f; if (t0 + 64 + lane < L) dt_pf = DTR[(row_base + t0 + 64 + lane) * 32 + h];
        v4u zw = (v4u){0u, 0u, 0u, 0u};
        if (t0 + (tid >> 3) < L) zw = *(const v4u*)(PROJ + (size_t)(S_Z0 + (h >> 4)) * SLOT_ELEMS + (row_base + t0 + (tid >> 3)) * 1024 + (h & 15) * 64 + (tid & 7) * 8);
        float cum = dtv * a;
#pragma unroll
        for (int o = 1; o < 64; o <<= 1) { const float u = __shfl_up(cum, o); if (lane >= o) cum += u; }
        const float cum_last = __shfl(cum, 63);
        const float wgt = __expf(cum_last - cum) * dtv;
        if (w == 0) { CUM[lane] = cum; DTV[lane] = dtv; ECUM[lane] = __expf(cum); }
#pragma unroll
        for (int j = 0; j < 6; ++j) { const int idx = (tid + 512 * j) & 1023;
            if (j < 2) *(LAS v4u*)(BN + (idx >> 4) * 136 + 8 * (idx & 15)) = pc[j];
            else if (j < 4) *(LAS v4u*)(CN + (idx >> 4) * 136 + 8 * (idx & 15)) = pc[j];
            else *(LAS v4u*)(BT + (idx >> 3) * 72 + 8 * (idx & 7)) = pc[j]; }
        if (pend) { const size_t prow = row_base + (t0 - 64) + (tid >> 3);
            *(v4u*)(YG + prow * 2048 + h * 64 + (tid & 7) * 8) = ow_pend; if ((tid & 7) == 0) SSQ[prow * 32 + h] = sq_pend; pend = false; }
        { const int xs = tid >> 3, cgl = tid & 7; const float wx = __shfl(wgt, xs); typedef float f32x2 __attribute__((ext_vector_type(2)));
#pragma unroll
          for (int kp = 0; kp < 4; ++kp) {
              const LAS float* wl = CWL + 8 * cgl + 2 * kp;
              const f32x2 cw0 = *(const LAS f32x2*)wl, cw1 = *(const LAS f32x2*)(wl + 64), cw2 = *(const LAS f32x2*)(wl + 128), cw3 = *(const LAS f32x2*)(wl + 192), cbb = *(const LAS f32x2*)(wl + 256);
              f32x2 xv[4];
#pragma unroll
              for (int i = 0; i < 4; ++i) { const unsigned wd = xr[i][kp]; xv[i] = (f32x2){__uint_as_float(wd << 16), __uint_as_float(wd & 0xffff0000u)}; }
              f32x2 a = cw0 * xv[0] + cbb; a = cw1 * xv[1] + a; a = cw2 * xv[2] + a; a = cw3 * xv[3] + a;
              const f32x2 t = a * (-1.4426950408889634f); f32x2 e; e.x = __builtin_amdgcn_exp2f(t.x); e.y = __builtin_amdgcn_exp2f(t.y); e = e + 1.0f;
              f32x2 rc; rc.x = __builtin_amdgcn_rcpf(e.x); rc.y = __builtin_amdgcn_rcpf(e.y); const f32x2 o = a * rc, ow = o * wx;
              const unsigned po = pk2(o.x, o.y), pw = pk2(ow.x, ow.y); const int p = 8 * cgl + 2 * kp;
              XT[p * 72 + xs] = (unsigned short)(po & 0xffffu); XT[(p + 1) * 72 + xs] = (unsigned short)(po >> 16);
              XWT[p * 72 + xs] = (unsigned short)(pw & 0xffffu); XWT[(p + 1) * 72 + xs] = (unsigned short)(pw >> 16); }
        }
        if (t0 + 64 < L) {
#pragma unroll
            for (int i = 0; i < 4; ++i) xr[i] = *(const v4u*)(cptr + (size_t)(t0 + 64 + (tid >> 3) - 3 + i) * 1024);
            const int chn = (t0 >> 6) + 1;
#pragma unroll
            for (int j = 0; j < 6; ++j) { const int idx = (tid + 512 * j) & 1023;
                if (j < 4) pc[j] = *(const v4u*)(BCS + (size_t)(t0 + 64 + (idx >> 4)) * 1024 + (j >> 1) * 512 + 8 * (idx & 15));
                else pc[j] = *(const v4u*)(BTT + ((size_t)chn * 4 * 128 + (idx >> 3)) * 64 + 8 * (idx & 7)); }
        }
        LDS_BARRIER();
        if (w < 4 || w >= 6) {
            const int tt = w < 4 ? (w >> 1) : 1, st = w < 4 ? tt : 0, ptj = w & 1;
            f32x16 X, ya;
#pragma unroll
            for (int i = 0; i < 16; ++i) { X[i] = 0.f; ya[i] = 0.f; }
            const LAS unsigned char* cn_nat = Lb + SD_CN + (32 * tt + r) * 272 + hh * 16; const LAS unsigned char* bn_nat = Lb + SD_BN + (32 * st + r) * 272 + hh * 16;
#pragma unroll 2
            for (int ks = 0; ks < 8; ++ks) X = MFMA32(lds_frag16(bn_nat + ks * 32), lds_frag16(cn_nat + ks * 32), X);
            const float cum_t = CUM[32 * tt + r];
#pragma unroll
            for (int q4 = 0; q4 < 4; ++q4) { const f32x4 cs = *(const LAS f32x4*)(CUM + 32 * st + 8 * q4 + 4 * hh), ds = *(const LAS f32x4*)(DTV + 32 * st + 8 * q4 + 4 * hh);
#pragma unroll
                for (int jj = 0; jj < 4; ++jj) { const int s_abs = 32 * st + 8 * q4 + 4 * hh + jj; const float f = __expf(fminf(cum_t - cs[jj], 0.f)) * ds[jj]; X[4 * q4 + jj] = (s_abs <= 32 * tt + r) ? X[4 * q4 + jj] * f : 0.f; } }
            const LAS unsigned char* xt_row = Lb + SD_XT + (32 * ptj + r) * 144 + (32 * st + 4 * hh) * 2;
            ya = MFMA32(ACC_FRAG(X, 0), lds_frag8x2(xt_row), ya);
            ya = MFMA32(ACC_FRAG(X, 1), lds_frag8x2(xt_row + 32), ya);
            if (w < 4) { LAS float* yb = YA + (32 * tt + 4 * hh) * 64 + 32 * ptj + r;
#pragma unroll
                for (int i = 0; i < 16; ++i) yb[((i & 3) + 8 * (i >> 2)) * 64] = ya[i]; }
            else { LAS unsigned short* yb = YO + (4 * hh) * 64 + 32 * ptj + r;
#pragma unroll
                for (int i = 0; i < 16; ++i) yb[((i & 3) + 8 * (i >> 2)) * 64] = (unsigned short)f2bf(ya[i]); }
        } else {
            const int ptj = w & 1;
            const LAS unsigned char* ht_nat = Lb + SD_HT + buf * 17408 + (32 * ptj + r) * 272 + hh * 16;
#pragma unroll 1
            for (int tt = 0; tt < 2; ++tt) {
                f32x16 yi;
#pragma unroll
                for (int i = 0; i < 16; ++i) yi[i] = 0.f;
                const LAS unsigned char* cn_nat = Lb + SD_CN + (32 * tt + r) * 272 + hh * 16;
#pragma unroll 2
                for (int ks = 0; ks < 8; ++ks) yi = MFMA32(lds_frag16(cn_nat + ks * 32), lds_frag16(ht_nat + ks * 32), yi);
                const LAS unsigned short* xt_p = XT + (32 * ptj + r) * 72 + 32 * tt + 4 * hh;
#pragma unroll
                for (int q4 = 0; q4 < 4; ++q4) { const f32x4 ec = *(const LAS f32x4*)(ECUM + 32 * tt + 8 * q4 + 4 * hh); const v2u xw = *(const LAS v2u*)(xt_p + 8 * q4);
                    const float x0 = bf2f(xw.x & 0xffffu), x1 = bf2f(xw.x >> 16), x2 = bf2f(xw.y & 0xffffu), x3 = bf2f(xw.y >> 16);
                    LAS float* yb = YY + (32 * tt + 8 * q4 + 4 * hh) * 64 + 32 * ptj + r;
                    yb[0] = ec[0] * yi[4 * q4] + Dk * x0; yb[64] = ec[1] * yi[4 * q4 + 1] + Dk * x1; yb[128] = ec[2] * yi[4 * q4 + 2] + Dk * x2; yb[192] = ec[3] * yi[4 * q4 + 3] + Dk * x3; }
            }
        }
        {
            const float el = __expf(CUM[63]);
#pragma unroll
            for (int i = 0; i < 16; ++i) H[i] *= el;
            const LAS unsigned char* bt_nat = Lb + SD_BT + (32 * nt + r) * 144 + hh * 16; const LAS unsigned char* xt_nat = Lb + SD_XWT + (32 * pt + r) * 144 + hh * 16;
#pragma unroll
            for (int s2 = 0; s2 < 4; ++s2) H = MFMA32(lds_frag16(bt_nat + s2 * 32), lds_frag16(xt_nat + s2 * 32), H);
            LAS unsigned short* hp = HT + (buf ^ 1) * 8704 + (32 * pt + r) * 136 + 32 * nt + 4 * hh;
#pragma unroll
            for (int q4 = 0; q4 < 4; ++q4) { v2u pk; pk.x = cvtpk_c(H[4 * q4], H[4 * q4 + 1]); pk.y = cvtpk_c(H[4 * q4 + 2], H[4 * q4 + 3]); *(LAS v2u*)(hp + 8 * q4) = pk; }
        }
        LDS_BARRIER();
        { const int tt = tid >> 3, p0 = (tid & 7) * 8;
          if (t0 + tt < L) { const size_t row = row_base + t0 + tt;
            f32x4 y0 = *(const LAS f32x4*)(YA + tt * 64 + p0) + *(const LAS f32x4*)(YY + tt * 64 + p0), y1 = *(const LAS f32x4*)(YA + tt * 64 + p0 + 4) + *(const LAS f32x4*)(YY + tt * 64 + p0 + 4);
            if (tt >= 32) { const v4u ow4 = *(const LAS v4u*)(YO + (tt - 32) * 64 + p0);
                y0 = y0 + (f32x4){bf2f(ow4.x & 0xffffu), __uint_as_float(ow4.x & 0xffff0000u), bf2f(ow4.y & 0xffffu), __uint_as_float(ow4.y & 0xffff0000u)};
                y1 = y1 + (f32x4){bf2f(ow4.z & 0xffffu), __uint_as_float(ow4.z & 0xffff0000u), bf2f(ow4.w & 0xffffu), __uint_as_float(ow4.w & 0xffff0000u)}; }
            float o[8]; float sq = 0.f;
#pragma unroll
            for (int j = 0; j < 8; ++j) { const unsigned z16 = (zw[j >> 1] >> ((j & 1) * 16)) & 0xffffu; const float yv = (j < 4 ? y0[j & 3] : y1[j & 3]) * silu_f(bf2f(z16)); o[j] = yv; sq += yv * yv; }
            ow_pend.x = pk2(o[0], o[1]); ow_pend.y = pk2(o[2], o[3]); ow_pend.z = pk2(o[4], o[5]); ow_pend.w = pk2(o[6], o[7]);
            sq += __shfl_xor(sq, 1); sq += __shfl_xor(sq, 2); sq += __shfl_xor(sq, 4); sq_pend = sq; pend = true; } }
        }
    }
    if (pend) { const size_t prow = row_base + (L - 64) + (tid >> 3); *(v4u*)(YG + prow * 2048 + h * 64 + (tid & 7) * 8) = ow_pend; if ((tid & 7) == 0) SSQ[prow * 32 + h] = sq_pend; }
#pragma unroll
    for (int q4 = 0; q4 < 4; ++q4) *(f32x4*)(st_g + 8 * q4) = (f32x4){H[4 * q4], H[4 * q4 + 1], H[4 * q4 + 2], H[4 * q4 + 3]};
    __syncthreads();
}
__device__ __forceinline__ float tr_reduce32(const float (&v)[32], int lane) {
    const bool b4 = lane & 16, b3 = lane & 8, b2 = lane & 4, b1 = lane & 2, b0 = lane & 1;
    float a[16], b[8], c[4], d[2];
#pragma unroll
    for (int i = 0; i < 16; ++i) { const float keep = b4 ? v[i + 16] : v[i], send = b4 ? v[i] : v[i + 16]; a[i] = keep + __shfl_xor(send, 16); }
#pragma unroll
    for (int i = 0; i < 8; ++i) { const float keep = b3 ? a[i + 8] : a[i], send = b3 ? a[i] : a[i + 8]; b[i] = keep + __shfl_xor(send, 8); }
#pragma unroll
    for (int i = 0; i < 4; ++i) { const float keep = b2 ? b[i + 4] : b[i], send = b2 ? b[i] : b[i + 4]; c[i] = keep + __shfl_xor(send, 4); }
#pragma unroll
    for (int i = 0; i < 2; ++i) { const float keep = b1 ? c[i + 2] : c[i], send = b1 ? c[i] : c[i + 2]; d[i] = keep + __shfl_xor(send, 2); }
    const float keep = b0 ? d[1] : d[0], send = b0 ? d[0] : d[1];
    return keep + __shfl_xor(send, 1);
}
__device__ __forceinline__ void ssd_sample_unit(Frame& F, int sb, int g) {
    int tid_o = F.tid; asm volatile("" : "+v"(tid_o));
    const int tid = tid_o, lane = tid & 63, w = F.wave, hh = lane >> 5, nq = lane & 31; unsigned char* ws = F.ws;
    LAS float* XC = (LAS float*)(F.lds + RING_OFF); LAS float* BC = XC + 8 * 4 * 64; LAS float* CC = BC + 4 * 128; LAS float* DTS = CC + 4 * 128;
    const bf16* PROJ = (const bf16*)(ws + WS_PROJ); const float* DTR = (const float*)(ws + WS_DT); bf16* YG = (bf16*)(ws + WS_YG); float* SSQ = (float*)(ws + WS_SSQSSD);
    const size_t row0 = (size_t)TP + (size_t)sb * LS;
    const int h = 8 * g + w;
    const float* sp = F.in[3] + (size_t)(sb * 32 + h) * 8192 + (size_t)hh * 128 + 4 * nq;
    f32x4 hst[32];
#pragma unroll
    for (int i = 0; i < 32; ++i) hst[i] = ld_nt(sp + (size_t)i * 256);
    if (tid < 384) { typedef float f32x2 __attribute__((ext_vector_type(2)));
        const int col = tid < 256 ? g * 512 + 2 * tid : (tid < 320 ? 2048 + g * 128 + 2 * (tid - 256) : 2560 + g * 128 + 2 * (tid - 320));
        const float* cw = F.in[10]; const float* sc = F.in[4] + (size_t)sb * 3 * 3072 + col;
        const f32x2 w0 = *(const f32x2*)(cw + col), w1 = *(const f32x2*)(cw + 3072 + col), w2 = *(const f32x2*)(cw + 2 * 3072 + col), w3 = *(const f32x2*)(cw + 3 * 3072 + col), cb = *(const f32x2*)(F.in[11] + col);
        f32x2 full[7]; full[0] = *(const f32x2*)sc; full[1] = *(const f32x2*)(sc + 3072); full[2] = *(const f32x2*)(sc + 2 * 3072);
        const bf16* cp = PROJ + (size_t)(S_X0 + (col >> 10)) * SLOT_ELEMS + row0 * 1024 + (col & 1023);
#pragma unroll
        for (int t = 0; t < 4; ++t) { const unsigned wd = *(const unsigned*)(cp + (size_t)t * 1024); full[3 + t] = (f32x2){__uint_as_float(wd << 16), __uint_as_float(wd & 0xffff0000u)}; }
#pragma unroll
        for (int t = 0; t < 4; ++t) { f32x2 a = w0 * full[t] + cb; a = w1 * full[t + 1] + a; a = w2 * full[t + 2] + a; a = w3 * full[t + 3] + a;
            f32x2 o; o.x = silu_f(a.x); o.y = silu_f(a.y);
            LAS float* dst = tid < 256 ? XC + ((tid >> 5) * 4 + t) * 64 + 2 * (tid & 31) : (tid < 320 ? BC + t * 128 + 2 * (tid - 256) : CC + t * 128 + 2 * (tid - 320));
            *(LAS f32x2*)dst = o; }
    } else if (tid < 416) { const int idx = tid - 384, hl = idx >> 2, t = idx & 3; const float x = DTR[(row0 + t) * 32 + 8 * g + hl] + F.in[12][8 * g + hl]; DTS[idx] = x > 20.f ? x : log1pf(__expf(x)); }
    __syncthreads();
    const float a = -__expf(F.in[13][h]), Dk = F.in[14][h];
#pragma unroll 1
    for (int t = 0; t < 4; ++t) {
        const float dtv = DTS[w * 4 + t], dA = __expf(dtv * a);
        const f32x4 Bv = *(const LAS f32x4*)(BC + t * 128 + 4 * nq), Cv = *(const LAS f32x4*)(CC + t * 128 + 4 * nq);
        const LAS float* xrow = XC + (w * 4 + t) * 64;
        float part[32];
#pragma unroll
        for (int i = 0; i < 32; ++i) { const float xd = xrow[2 * i + hh] * dtv; hst[i] = hst[i] * dA + Bv * xd; part[i] = (hst[i].x * Cv.x + hst[i].y * Cv.y) + (hst[i].z * Cv.z + hst[i].w * Cv.w); }
        float yv = tr_reduce32(part, lane);
        const int p = 2 * nq + hh; const size_t row = row0 + t;
        yv += Dk * xrow[p];
        const float z = bf2f(PROJ[(size_t)(S_Z0 + (h >> 4)) * SLOT_ELEMS + row * 1024 + (h & 15) * 64 + p]);
        const float yg = yv * silu_f(z);
        YG[row * 2048 + h * 64 + p] = (bf16)f2bf(yg);
        const float sq = wave_sum(yg * yg);
        if (lane == 0) SSQ[row * 32 + h] = sq;
    }
    float* so = F.out + O_SSMS + (size_t)(sb * 32 + h) * 8192 + (size_t)hh * 128 + 4 * nq;
#pragma unroll
    for (int i = 0; i < 32; ++i) st_nt(so + (size_t)i * 256, hst[i]);
    __syncthreads();
}
__device__ __forceinline__ void hgrn_sample_unit(Frame& F, int sb, int hq) {
    int tid_o = F.tid; asm volatile("" : "+v"(tid_o));
    const int tid = tid_o, lane = tid & 63, w = F.wave, hh = lane >> 5, vq = lane & 31; unsigned char* ws = F.ws;
    LAS float* FS = (LAS float*)(F.lds + RING_OFF); LAS float* KS = FS + 2048; LAS float* QS = KS + 2048; LAS float* VS = QS + 2048; LAS float* OP = VS + 2048;
    const bf16* PROJ = (const bf16*)(ws + WS_PROJ); bf16* ON = (bf16*)(ws + WS_ON);
    const size_t row0 = (size_t)TP + (size_t)sb * LS;
    const int hl = w >> 1, kh = w & 1, hd = 4 * hq + hl;
    const float* sp = F.in[5] + (size_t)(sb * 8 + hd) * 16384 + (size_t)(64 * kh + hh) * 128 + 4 * vq;
    f32x4 S[32];
#pragma unroll
    for (int i = 0; i < 32; ++i) S[i] = ld_nt(sp + (size_t)i * 256);
    { const int ch = hq * 512 + tid; const float lb = __builtin_amdgcn_rcpf(1.0f + __expf(F.in[17][1024 + ch] - F.in[17][ch]));
      const bf16* fp = PROJ + (size_t)S_F * SLOT_ELEMS + row0 * 1024 + ch; const bf16* qp = PROJ + (size_t)S_Q * SLOT_ELEMS + row0 * 1024 + ch; const bf16* ip = PROJ + (size_t)S_I * SLOT_ELEMS + row0 * 1024 + ch;
#pragma unroll
      for (int t = 0; t < 4; ++t) { const float u = fminf(fmaxf(bf2f(fp[(size_t)t * 1024]), -30.f), 30.f); const float fg = lb + (1.0f - lb) * sigmoid_f(u);
          const int o = ((tid >> 7) * 4 + t) * 128 + (tid & 127);
          FS[o] = fg; KS[o] = 1.0f - fg; QS[o] = silu_f(bf2f(qp[(size_t)t * 1024])); VS[o] = bf2f(ip[(size_t)t * 1024]); } }
    __syncthreads();
#pragma unroll 1
    for (int t = 0; t < 4; ++t) {
        const int o = (hl * 4 + t) * 128;
        const f32x4 vv = *(const LAS f32x4*)(VS + o + 4 * vq);
        f32x4 oa = (f32x4){0.f, 0.f, 0.f, 0.f};
#pragma unroll
        for (int i = 0; i < 32; ++i) { const int k = 64 * kh + 2 * i + hh; const float fk = FS[o + k], kv = KS[o + k], qk = QS[o + k]; S[i] = S[i] * fk + vv * kv; oa = oa + S[i] * qk; }
        oa.x += __shfl_xor(oa.x, 32); oa.y += __shfl_xor(oa.y, 32); oa.z += __shfl_xor(oa.z, 32); oa.w += __shfl_xor(oa.w, 32);
        if (hh == 0) *(LAS f32x4*)(OP + ((hl * 4 + t) * 2 + kh) * 128 + 4 * vq) = oa;
    }
    float* so = F.out + O_HGS + (size_t)(sb * 8 + hd) * 16384 + (size_t)(64 * kh + hh) * 128 + 4 * vq;
#pragma unroll
    for (int i = 0; i < 32; ++i) st_nt(so + (size_t)i * 256, S[i]);
    __syncthreads();
#pragma unroll
    for (int rr2 = 0; rr2 < 2; ++rr2) { const int rr = 2 * w + rr2, ohl = rr >> 2, t = rr & 3, ohd = 4 * hq + ohl; typedef float f32x2 __attribute__((ext_vector_type(2)));
        const f32x2 p0 = *(const LAS f32x2*)(OP + (rr * 2) * 128 + 2 * lane), p1 = *(const LAS f32x2*)(OP + (rr * 2 + 1) * 128 + 2 * lane);
        const float o0 = p0.x + p1.x, o1 = p0.y + p1.y; const float sq = wave_sum(o0 * o0 + o1 * o1); const float rs = __builtin_amdgcn_rsqf(sq * (1.0f / 128.0f) + EPS);
        const size_t row = row0 + t; const unsigned gw = *(const unsigned*)(PROJ + (size_t)S_HG * SLOT_ELEMS + row * 1024 + ohd * 128 + 2 * lane);
        *(unsigned*)(ON + row * 1024 + ohd * 128 + 2 * lane) = pk2(o0 * rs * silu_f(bf2f(gw & 0xffffu)), o1 * rs * silu_f(__uint_as_float(gw & 0xffff0000u))); }
    __syncthreads();
}
constexpr int U_HGS = NBS * 2, U_SSDS = NBS * 4, U_CONV = NBP + NBS;
__device__ __forceinline__ void scan_phase(Frame& F) {
    gu32* head = F.ctl + CW_QUEUE;
    const int xcc = (int)(xb_xcc_id() & 7u);
#define SCAN_QUEUE(qi, count, body) for (;;) { if (F.tid == 0) F.MISC[0] = __hip_atomic_fetch_add(head + 64 * (qi), 1u, RLX_AGENT); __syncthreads(); const int u = (int)F.MISC[0]; __syncthreads(); if (u >= (count)) break; body }
#pragma unroll 1
    for (int pass = 0; pass < 8; ++pass) { const int bb = (xcc + pass) & 7; SCAN_QUEUE(4 + bb, 32, ssd_unit_mfma(F, bb, u);) }
#pragma unroll 1
    for (int pass = 0; pass < 8; ++pass) { const int bb = (xcc + pass) & 7; SCAN_QUEUE(12 + bb, 32, hgrn_v_unit(F, bb, u >> 2, u & 3);) }
    SCAN_QUEUE(2, U_HGS, hgrn_sample_unit(F, u >> 1, u & 1);)
    SCAN_QUEUE(3, U_SSDS + U_CONV, if (u >= U_SSDS) { conv_copy_unit(F, u - U_SSDS); continue; } ssd_sample_unit(F, u >> 2, u & 3);)
#undef SCAN_QUEUE
}
typedef float f32x4s __attribute__((ext_vector_type(4)));
template <class Epi> __device__ __forceinline__ void small_tile_phase(Frame& F, const bf16* A, const bf16* Bt, int K, const Epi& E) {
    const int lane = F.lane, w = F.wave, r = lane & 31, hh = lane >> 5;
#pragma unroll 1
    for (int v = F.vcu; v < 256; v += F.G) {
    const int mt = v >> 4, nt = v & 15;
    const int kw = K >> 3;
    const bf16* ap = A + (size_t)(TP + 32 * mt + r) * K + w * kw + 8 * hh;
    const bf16* bp = Bt + (size_t)(64 * nt + r) * K + w * kw + 8 * hh;
    f32x16 acc0, acc1;
#pragma unroll
    for (int i = 0; i < 16; ++i) { acc0[i] = 0.f; acc1[i] = 0.f; }
#pragma unroll 4
    for (int ks = 0; ks < kw / 16; ++ks) { const bf16x8 af = *(const bf16x8*)(ap + 16 * ks), b0 = *(const bf16x8*)(bp + 16 * ks), b1 = *(const bf16x8*)(bp + (size_t)32 * K + 16 * ks);
        acc0 = MFMA32(b0, af, acc0); acc1 = MFMA32(b1, af, acc1); }
    LAS float* part = (LAS float*)(F.lds + RING_OFF) + w * 2048;
#pragma unroll
    for (int q4 = 0; q4 < 4; ++q4) { *(LAS f32x4*)(part + r * 64 + 8 * q4 + 4 * hh) = (f32x4){acc0[4 * q4], acc0[4 * q4 + 1], acc0[4 * q4 + 2], acc0[4 * q4 + 3]};
        *(LAS f32x4*)(part + r * 64 + 32 + 8 * q4 + 4 * hh) = (f32x4){acc1[4 * q4], acc1[4 * q4 + 1], acc1[4 * q4 + 2], acc1[4 * q4 + 3]}; }
    __syncthreads();
    const int rl = F.tid >> 4, c4 = (F.tid & 15) * 4; const LAS float* src = (const LAS float*)(F.lds + RING_OFF) + rl * 64 + c4;
    f32x4 sum = *(const LAS f32x4*)src;
#pragma unroll
    for (int ww = 1; ww < 8; ++ww) sum = sum + *(const LAS f32x4*)(src + ww * 2048);
    const f32x4s acc = (f32x4s){sum.x, sum.y, sum.z, sum.w};
    E.small(F, acc, TP + 32 * mt + rl, 64 * nt + c4, nt);
    __syncthreads();
    }
}
template <bool ADD> struct SmGate { bf16* O; const bf16* gate;
    __device__ __forceinline__ void small(Frame&, const f32x4s& a, int row, int col, int) const { const size_t off = (size_t)row * 1024 + col;
        const v2u gw = *(const v2u*)(gate + off); v2u ow = (v2u){0u, 0u}; if (ADD) ow = *(const v2u*)(O + off);
        float rr[4];
#pragma unroll
        for (int e = 0; e < 4; ++e) { const unsigned g16 = (gw[e >> 1] >> ((e & 1) * 16)) & 0xffffu, o16 = (ow[e >> 1] >> ((e & 1) * 16)) & 0xffffu; rr[e] = (ADD ? bf2f(o16) : 0.f) + sigmoid_f(bf2f(g16)) * a[e]; }
        v2u wv; wv.x = cvtpk_c(rr[0], rr[1]); wv.y = cvtpk_c(rr[2], rr[3]); *(v2u*)(O + off) = wv; } };
template <bool BF> struct SmRes { const float* base; bf16* hb; float* ssqp;
    __device__ __forceinline__ void small(Frame& F, const f32x4s& a, int row, int col, int nt) const { const size_t off = (size_t)row * 1024 + col; f32x4 b;
        if (BF) { const v2u w = *(const v2u*)(hb + off); b = (f32x4){bf2f(w.x & 0xffffu), __uint_as_float(w.x & 0xffff0000u), bf2f(w.y & 0xffffu), __uint_as_float(w.y & 0xffff0000u)}; }
        else b = *(const f32x4*)(base + off);
        const f32x4 v = b + (f32x4){a[0], a[1], a[2], a[3]};
        { v2u wv; wv.x = cvtpk_c(v[0], v[1]); wv.y = cvtpk_c(v[2], v[3]); *(v2u*)(hb + off) = wv; }
        float sq = (v[0] * v[0] + v[1] * v[1]) + (v[2] * v[2] + v[3] * v[3]); sq += __shfl_xor(sq, 1); sq += __shfl_xor(sq, 2); sq += __shfl_xor(sq, 4); sq += __shfl_xor(sq, 8);
        if ((F.tid & 15) == 0) ssqp[(size_t)row * 16 + nt] = sq; } };
struct SmScale { bf16* O; const float* ssq; float scale;
    __device__ __forceinline__ void small(Frame&, const f32x4s& a, int row, int col, int) const { const float rs = pg8::row_rs<16>(ssq, row) * scale;
        v2u wv; wv.x = cvtpk_c(a[0] * rs, a[1] * rs); wv.y = cvtpk_c(a[2] * rs, a[3] * rs); *(v2u*)(O + (size_t)row * 1024 + col) = wv; } };
__device__ __forceinline__ void attn_stage_tile(LAS unsigned char* Lb, const bf16* src, size_t pitch, int tid) {
#pragma unroll 1
    for (int hb = 0; hb < 2; ++hb) { v4u v[8];
#pragma unroll
        for (int i = 0; i < 8; ++i) { const int id = tid + 512 * (8 * hb + i), row = id >> 5, c = id & 31; v[i] = *(const v4u*)(src + (size_t)row * pitch + c * 8); }
#pragma unroll
        for (int i = 0; i < 8; ++i) { const int id = tid + 512 * (8 * hb + i), row = id >> 5, c = id & 31; *(LAS v4u*)(Lb + row * 512 + ((c ^ (row & 15)) << 4)) = v[i]; } }
}
__device__ __forceinline__ void attn_prompt_unit(Frame& F, int b, int hd, int qb) {
    const int tid = F.tid, lane = F.lane, w = F.wave, r = lane & 31, hh = lane >> 5; unsigned char* ws = F.ws;
    LAS unsigned char* Lb = F.lds + RING_OFF;
    const bf16* QB = (const bf16*)(ws + WS_QB); const bf16* KB = (const bf16*)(ws + WS_KB); const bf16* VT = (const bf16*)(ws + WS_VT); bf16* OB = (bf16*)(ws + WS_OB);
    const size_t qrow = (size_t)b * SEQ + (size_t)qb * 256 + 32 * w + r;
    attn_stage_tile(Lb, KB + (size_t)b * 256 * 1024 + hd * 256, 1024, tid);
    const bf16* qp = QB + qrow * 1024 + hd * 256 + 8 * hh;
    bf16x8 qf = *(const bf16x8*)qp;
    __syncthreads();
    f32x16 S[8];
#pragma unroll
    for (int t = 0; t < 8; ++t)
#pragma unroll
        for (int i = 0; i < 16; ++i) S[t][i] = 0.f;
    const int sw = r & 15;
#pragma unroll 1
    for (int ks = 0; ks < 16; ++ks) {
        const bf16x8 qn = *(const bf16x8*)(qp + 16 * (ks < 15 ? ks + 1 : ks));
        const LAS unsigned char* kp = Lb + r * 512 + (((2 * ks + hh) ^ sw) << 4);
#pragma unroll
        for (int t = 0; t < 8; ++t) S[t] = MFMA32(lds_frag16(kp + t * 32 * 512), qf, S[t]);
        qf = qn;
    }
    float m = -3.0e38f;
#pragma unroll
    for (int t = 0; t < 8; ++t)
#pragma unroll
        for (int i = 0; i < 16; ++i) m = fmaxf(m, S[t][i]);
    m = fmaxf(m, __shfl_xor(m, 32));
    float l = 0.f;
#pragma unroll
    for (int t = 0; t < 8; ++t)
#pragma unroll
        for (int i = 0; i < 16; ++i) { const float pv = __builtin_amdgcn_exp2f(S[t][i] - m); S[t][i] = pv; l += pv; }
    l += __shfl_xor(l, 32);
    const float rl = __builtin_amdgcn_rcpf(l);
    bf16x8 pf[8][2];
#pragma unroll
    for (int t = 0; t < 8; ++t) { pf[t][0] = ACC_FRAG(S[t], 0); pf[t][1] = ACC_FRAG(S[t], 1); }
    __syncthreads();
    attn_stage_tile(Lb, VT + (size_t)(b * 4 + hd) * 256 * 256, 256, tid);
    __syncthreads();
    bf16* op = OB + qrow * 1024 + hd * 256 + 4 * hh;
#pragma unroll 1
    for (int dt = 0; dt < 8; ++dt) {
        f32x16 O;
#pragma unroll
        for (int i = 0; i < 16; ++i) O[i] = 0.f;
        const LAS unsigned char* vrow = Lb + (32 * dt + r) * 512 + 8 * hh;
#pragma unroll
        for (int t = 0; t < 8; ++t)
#pragma unroll
            for (int s2 = 0; s2 < 2; ++s2) {
                const v2u lo = *(const LAS v2u*)(vrow + (((4 * t + 2 * s2) ^ sw) << 4)), hi = *(const LAS v2u*)(vrow + (((4 * t + 2 * s2 + 1) ^ sw) << 4));
                const v4u wv4 = (v4u){lo.x, lo.y, hi.x, hi.y};
                O = MFMA32(__builtin_bit_cast(bf16x8, wv4), pf[t][s2], O);
            }
#pragma unroll
        for (int q4 = 0; q4 < 4; ++q4) { v2u o; o.x = cvtpk_c(O[4 * q4] * rl, O[4 * q4 + 1] * rl); o.y = cvtpk_c(O[4 * q4 + 2] * rl, O[4 * q4 + 3] * rl);
            *(v2u*)(op + 32 * dt + 8 * q4) = o; }
    }
    __syncthreads();
}
__device__ __forceinline__ void attn_sample_unit(Frame& F, int sb, int hd) {
    const int tid = F.tid, lane = F.lane, w = F.wave; unsigned char* ws = F.ws;
    LAS float* sc = (LAS float*)(F.lds + RING_OFF);
    LAS float* red = sc + 4 * 256;
    const bf16* QB = (const bf16*)(ws + WS_QB); bf16* OB = (bf16*)(ws + WS_OB);
    const size_t rowq = (size_t)TP + (size_t)sb * LS;
    float q[4][4];
#pragma unroll
    for (int t = 0; t < 4; ++t) { const v2u qw = *(const v2u*)(QB + (rowq + t) * 1024 + hd * 256 + 4 * lane); q[t][0] = bf2f(qw.x & 0xffffu); q[t][1] = bf2f(qw.x >> 16); q[t][2] = bf2f(qw.y & 0xffffu); q[t][3] = bf2f(qw.y >> 16); }
    const float* Kc = F.in[6] + ((size_t)sb * 256 * 4 + hd) * 256 + 4 * lane; const float* Vc = F.in[7] + ((size_t)sb * 256 * 4 + hd) * 256 + 4 * lane;
    f32x4 kv[8], kn[8];
#pragma unroll
    for (int u = 0; u < 8; ++u) kv[u] = ld_nt(Kc + (size_t)(w * 32 + u) * 1024);
#pragma unroll 1
    for (int kk0 = 0; kk0 < 32; kk0 += 8) {
#pragma unroll
        for (int u = 0; u < 8; ++u) kn[u] = kk0 < 24 ? ld_nt(Kc + (size_t)(w * 32 + kk0 + 8 + u) * 1024) : ld_nt(Vc + (size_t)(w * 32 + u) * 1024);
        { float part[32];
#pragma unroll
          for (int u = 0; u < 8; ++u)
#pragma unroll
              for (int t = 0; t < 4; ++t) part[4 * u + t] = (q[t][0] * kv[u].x + q[t][1] * kv[u].y) + (q[t][2] * kv[u].z + q[t][3] * kv[u].w);
          float sv = tr_reduce32(part, lane); sv += __shfl_xor(sv, 32);
          if (lane < 32) sc[(lane & 3) * 256 + w * 32 + kk0 + (lane >> 2)] = sv; }
#pragma unroll
        for (int u = 0; u < 8; ++u) kv[u] = kn[u]; }
    __syncthreads();
    if (w < 4) { float v[4]; float m = -3.0e38f;
#pragma unroll
        for (int j = 0; j < 4; ++j) { v[j] = sc[w * 256 + j * 64 + lane]; m = fmaxf(m, v[j]); }
        m = wave_max(m); float l = 0.f;
#pragma unroll
        for (int j = 0; j < 4; ++j) { v[j] = __builtin_amdgcn_exp2f(v[j] - m); l += v[j]; }
        l = wave_sum(l); const float rl = 1.0f / l;
#pragma unroll
        for (int j = 0; j < 4; ++j) sc[w * 256 + j * 64 + lane] = v[j] * rl; }
    __syncthreads();
    float o[4][4];
#pragma unroll
    for (int t = 0; t < 4; ++t)
#pragma unroll
        for (int e = 0; e < 4; ++e) o[t][e] = 0.f;
#pragma unroll 1
    for (int kk0 = 0; kk0 < 32; kk0 += 8) {
        if (kk0 < 24) {
#pragma unroll
            for (int u = 0; u < 8; ++u) kn[u] = ld_nt(Vc + (size_t)(w * 32 + kk0 + 8 + u) * 1024); }
#pragma unroll
        for (int u = 0; u < 8; ++u) { const int key = w * 32 + kk0 + u;
#pragma unroll
            for (int t = 0; t < 4; ++t) { const float pr = sc[t * 256 + key]; o[t][0] += pr * kv[u].x; o[t][1] += pr * kv[u].y; o[t][2] += pr * kv[u].z; o[t][3] += pr * kv[u].w; } }
#pragma unroll
        for (int u = 0; u < 8; ++u) kv[u] = kn[u]; }
#pragma unroll
    for (int t = 0; t < 4; ++t) *(LAS f32x4*)(red + (w * 4 + t) * 256 + 4 * lane) = (f32x4){o[t][0], o[t][1], o[t][2], o[t][3]};
    __syncthreads();
    { const int t = tid >> 7, d0 = (tid & 127) * 2; float a0 = 0.f, a1 = 0.f;
#pragma unroll
      for (int ww = 0; ww < 8; ++ww) { a0 += red[(ww * 4 + t) * 256 + d0]; a1 += red[(ww * 4 + t) * 256 + d0 + 1]; }
      *(unsigned*)(OB + (rowq + t) * 1024 + hd * 256 + d0) = pk2(a0, a1); }
    __syncthreads();
}
__device__ __forceinline__ void attn_phase(Frame& F) {
    for (int u = F.vcu; u < NBP * 4 * 8; u += F.G) attn_prompt_unit(F, u >> 5, (u >> 3) & 3, u & 7);
    for (int u = F.vcu; u < NBS * 4; u += F.G) attn_sample_unit(F, u >> 2, u & 3);
}
__device__ __forceinline__ void final_norm_phase(Frame& F) {
    const int gw = F.vcu * NWAVES + F.wave, NGW = F.G * NWAVES; const float* SSQ = (const float*)(F.ws + WS_SSQP3); const float* wn = F.in[31]; const bf16* HB = (const bf16*)(F.ws + WS_HB);
    f32x4 wv[4];
#pragma unroll
    for (int j = 0; j < 2; ++j) { wv[2 * j] = *((const f32x4*)wn + 2 * (64 * j + F.lane)); wv[2 * j + 1] = *((const f32x4*)wn + 2 * (64 * j + F.lane) + 1); }
    for (int row = gw; row < T; row += NGW) {
        const f32x4* sp = (const f32x4*)(SSQ + (size_t)row * 16); float s = 0.f;
#pragma unroll
        for (int j = 0; j < 4; ++j) { const f32x4 a = sp[j]; s += (a.x + a.y) + (a.z + a.w); }
        const float rs = __builtin_amdgcn_rsqf(s * (1.0f / 1024.0f) + EPS);
#pragma unroll
        for (int j = 0; j < 2; ++j) { const int pc = 64 * j + F.lane; const v4u w = *((const v4u*)(HB + (size_t)row * 1024) + pc);
            const f32x4 v0 = (f32x4){bf2f(w.x & 0xffffu), __uint_as_float(w.x & 0xffff0000u), bf2f(w.y & 0xffffu), __uint_as_float(w.y & 0xffff0000u)};
            const f32x4 v1 = (f32x4){bf2f(w.z & 0xffffu), __uint_as_float(w.z & 0xffff0000u), bf2f(w.w & 0xffffu), __uint_as_float(w.w & 0xffff0000u)};
            float* o = F.out + O_Y + (size_t)row * 1024 + 8 * pc; st_nt(o, v0 * rs * wv[2 * j]); st_nt(o + 4, v1 * rs * wv[2 * j + 1]); }
    }
}
#ifndef MK_N_LAUNCHES
#define MK_N_LAUNCHES 1
#endif
constexpr int PER_PHASE = 13;
constexpr int N_LAUNCHES = MK_N_LAUNCHES;
struct Args { const float* in[32]; float* out; unsigned char* ws; int ph_lo, ph_hi; };
__global__ void __launch_bounds__(NTHR, 2) skel_fwd(Args args) {
    extern __shared__ __attribute__((aligned(16))) unsigned char lds[];
    Frame F;
    F.lds = (LAS unsigned char*)lds;
    F.MISC = (volatile LAS unsigned*)(F.lds + MISC_OFF);
    F.tid = threadIdx.x; F.lane = F.tid & 63; F.wave = __builtin_amdgcn_readfirstlane(F.tid >> 6);
    F.G = gridDim.x; { const int bx = blockIdx.x; F.vcu = (F.G % 8 == 0) ? (bx % 8) * (F.G / 8) + bx / 8 : bx; }
    unsigned char* ws = args.ws; F.ws = ws; F.out = args.out;
    F.ctl = (gu32*)(ws + WS_CTL);
#pragma unroll
    for (int i = 0; i < 32; ++i) F.in[i] = args.in[i];
    for (int u = F.tid; u < (LDS_BYTES - LDSCTL_OFF) / 4; u += NTHR) ((LAS unsigned*)(F.lds + LDSCTL_OFF))[u] = 0u;
    __syncthreads();
    XcdBarrier bar; bar.bar = (unsigned*)(F.ctl + CW_BAR); bar.x = 0; bar.st = nullptr;
    if (N_LAUNCHES == 1) bar = xcd_barrier_post((unsigned*)(F.ctl + CW_BAR), F.MISC + 8);
#define GRID_BAR() do { if (N_LAUNCHES == 1) xcd_barrier(bar); } while (0)
    const int lo = args.ph_lo, hi = args.ph_hi;
#ifdef ONLY_PHASE
#define IN(k) ((k) == ONLY_PHASE && lo <= (k) && (k) < hi)
#else
#define IN(k) (lo <= (k) && (k) < hi)
#endif
#define BOTH(k) (IN(k) && IN((k) + 1))
    bf16* const XB = (bf16*)(ws + WS_XB); bf16* const PROJ = (bf16*)(ws + WS_PROJ);
    float* const Y = F.out + O_Y;
    if (IN(0)) { p0_prologue(F); if (BOTH(0)) GRID_BAR(); }
    if (IN(1)) {
        { pg8::Gemm g{XB, (const bf16*)(ws + WS_WIN), T, NPROJ, 1024}; pg8::StaticOrder S; S.init(T, NPROJ, F.G, (int)blockIdx.x);
          pg8::EpiScaleBf16<1, true> E{PROJ, SLOT_ELEMS, (const float*)(ws + WS_SSQX), 1.0f, (float*)(ws + WS_DT)};
          pg8::gemm_phase<pg8::EpiScaleBf16<1, true>, pg8::StaticOrder, true, true>(F.lds + RING_OFF, g, S, E); }
        { pg8::Gemm g{(const bf16*)(ws + WS_MNB), (const bf16*)(ws + WS_WKV), MEMR, 2048, 1024}; pg8::StaticOrder S; S.init(MEMR, 2048, F.G, (int)((blockIdx.x + 64) % F.G));
          pg8::EpiKV E{F.out + O_MKP, F.out + O_MVP, (bf16*)(ws + WS_KB), (bf16*)(ws + WS_VT), (const float*)(ws + WS_SSQM)};
          pg8::gemm_phase<pg8::EpiKV, pg8::StaticOrder, true, true>(F.lds + RING_OFF, g, S, E); }
        if (BOTH(1)) GRID_BAR();
    }
    if (IN(2)) { bc_prep_phase(F); hg_prep_phase(F); if (BOTH(2)) GRID_BAR(); }
    if (IN(3)) { scan_phase(F); if (BOTH(3)) GRID_BAR(); }
    if (IN(4)) { ssdnorm_phase(F); hgnorm_phase(F); if (BOTH(4)) GRID_BAR(); }
    if (IN(5)) { { SmGate<false> Es{(bf16*)(ws + WS_MERGED), PROJ + (size_t)S_GS * SLOT_ELEMS}; small_tile_phase(F, (const bf16*)(ws + WS_YG), (const bf16*)(ws + WS_WSSD), 2048, Es); }
        pg8::Gemm g{(const bf16*)(ws + WS_YG), (const bf16*)(ws + WS_WSSD), TP, 1024, 2048}; pg8::StaticOrder S; S.init(TP, 1024, F.G, (int)blockIdx.x);
        pg8::EpiGate<false> E{(bf16*)(ws + WS_MERGED), PROJ + (size_t)S_GS * SLOT_ELEMS};
        pg8::gemm_phase<pg8::EpiGate<false>, pg8::StaticOrder, true, true>(F.lds + RING_OFF, g, S, E);
          }
    if (IN(5)) { { SmGate<true> Es{(bf16*)(ws + WS_MERGED), PROJ + (size_t)S_GH * SLOT_ELEMS}; small_tile_phase(F, (const bf16*)(ws + WS_ON), (const bf16*)(ws + WS_WHG), 1024, Es); }
        pg8::Gemm g{(const bf16*)(ws + WS_ON), (const bf16*)(ws + WS_WHG), TP, 1024, 1024}; pg8::StaticOrder S; S.init(TP, 1024, F.G, (int)blockIdx.x);
        pg8::EpiGate<true> E{(bf16*)(ws + WS_MERGED), PROJ + (size_t)S_GH * SLOT_ELEMS};
        pg8::gemm_phase<pg8::EpiGate<true>, pg8::StaticOrder, true, true>(F.lds + RING_OFF, g, S, E);
        if (BOTH(5)) GRID_BAR(); }
    if (IN(6)) { { SmRes<false> Es{F.in[1] - (size_t)TP * 1024, (bf16*)(ws + WS_HB), (float*)(ws + WS_SSQP1)}; small_tile_phase(F, (const bf16*)(ws + WS_MERGED), (const bf16*)(ws + WS_WOUT), 1024, Es); }
        pg8::Gemm g{(const bf16*)(ws + WS_MERGED), (const bf16*)(ws + WS_WOUT), TP, 1024, 1024}; pg8::StaticOrder S; S.init(TP, 1024, F.G, (int)blockIdx.x);
        pg8::EpiRes<false> E{F.in[0], F.in[1] - (size_t)TP * 1024, (bf16*)(ws + WS_HB), (float*)(ws + WS_SSQP1)};
        pg8::gemm_phase<pg8::EpiRes<false>, pg8::StaticOrder, true, true>(F.lds + RING_OFF, g, S, E);
        if (BOTH(6)) GRID_BAR(); }
    if (IN(7)) { { SmScale Es{(bf16*)(ws + WS_QB), (const float*)(ws + WS_SSQP1), QSCALE}; small_tile_phase(F, (const bf16*)(ws + WS_HB), (const bf16*)(ws + WS_WCQ), 1024, Es); }
        pg8::Gemm g{(const bf16*)(ws + WS_HB), (const bf16*)(ws + WS_WCQ), TP, 1024, 1024}; pg8::StaticOrder S; S.init(TP, 1024, F.G, (int)blockIdx.x);
        pg8::EpiScaleBf16<16, false> E{(bf16*)(ws + WS_QB), SLOT_ELEMS, (const float*)(ws + WS_SSQP1), QSCALE, nullptr};
        pg8::gemm_phase<pg8::EpiScaleBf16<16, false>, pg8::StaticOrder, true, true>(F.lds + RING_OFF, g, S, E);
        if (BOTH(7)) GRID_BAR(); }
    if (IN(8)) { attn_phase(F); if (BOTH(8)) GRID_BAR(); }
    if (IN(9)) { { SmRes<true> Es{nullptr, (bf16*)(ws + WS_HB), (float*)(ws + WS_SSQP2)}; small_tile_phase(F, (const bf16*)(ws + WS_OB), (const bf16*)(ws + WS_WCO), 1024, Es); }
        pg8::Gemm g{(const bf16*)(ws + WS_OB), (const bf16*)(ws + WS_WCO), TP, 1024, 1024}; pg8::StaticOrder S; S.init(TP, 1024, F.G, (int)blockIdx.x);
        pg8::EpiRes<true> E{nullptr, nullptr, (bf16*)(ws + WS_HB), (float*)(ws + WS_SSQP2)};
        pg8::gemm_phase<pg8::EpiRes<true>, pg8::StaticOrder, true, true>(F.lds + RING_OFF, g, S, E);
        if (BOTH(9)) GRID_BAR(); }
    if (IN(10)) { pg8::Gemm g{(const bf16*)(ws + WS_HB), (const bf16*)(ws + WS_WGU), T, 2 * FFN, 1024}; pg8::StaticOrder S; S.init(T, 2 * FFN, F.G, (int)blockIdx.x);
        pg8::EpiSwiglu E{(bf16*)(ws + WS_ACT), (const float*)(ws + WS_SSQP2)};
        pg8::gemm_phase<pg8::EpiSwiglu, pg8::StaticOrder, true, true>(F.lds + RING_OFF, g, S, E);
        if (BOTH(10)) GRID_BAR(); }
    if (IN(11)) { { SmRes<true> Es{nullptr, (bf16*)(ws + WS_HB), (float*)(ws + WS_SSQP3)}; small_tile_phase(F, (const bf16*)(ws + WS_ACT), (const bf16*)(ws + WS_WDN), FFN, Es); }
        pg8::Gemm g{(const bf16*)(ws + WS_ACT), (const bf16*)(ws + WS_WDN), TP, 1024, FFN}; pg8::StaticOrder S; S.init(TP, 1024, F.G, (int)blockIdx.x);
        pg8::EpiRes<true> E{nullptr, nullptr, (bf16*)(ws + WS_HB), (float*)(ws + WS_SSQP3)};
        pg8::gemm_phase<pg8::EpiRes<true>, pg8::StaticOrder, true, true>(F.lds + RING_OFF, g, S, E);
        if (BOTH(11)) GRID_BAR(); }
    if (IN(12)) final_norm_phase(F);
#undef IN
#undef BOTH
}

extern "C" void kernel_launch(void* const* d_in, const int* in_sizes, int n_in, void* d_out, int out_size, void* d_ws, size_t ws_size, hipStream_t stream) {
    static int grid = 0;
    if (grid == 0) {
        const int want[32] = {TP * 1024, TS * 1024, MEMR * 1024, 33554432, 1179648, 16777216, 33554432, 33554432, 1024, 1024 * 11296, 4 * 3072, 3072, 32, 32, 32, 2048, 2048 * 1024, 2048, 1024,
                              1024 * 1024, 1024 * 1024, 1024, 1024, 1024 * 1024, 1024 * 1024, 1024 * 1024, 1024 * 1024, 1024, 1024 * FFN, 1024 * FFN, FFN * 1024, 1024};
        bool ok = (n_in == 32); for (int i = 0; ok && i < 32; ++i) if (in_sizes[i] != want[i]) { fprintf(stderr, "kernel_launch: input %d has %d elements, expected %d\n", i, in_sizes[i], want[i]); ok = false; }
        if (!ok || out_size != (int)O_END || ws_size < WS_END4) { fprintf(stderr, "kernel_launch: unexpected shapes: n_in %d out %d ws %zu\n", n_in, out_size, ws_size); grid = -1; return; }
        int dev = 0, cus = 0, per_cu = 0;
        if (hipGetDevice(&dev) != hipSuccess || hipDeviceGetAttribute(&cus, hipDeviceAttributeMultiprocessorCount, dev) != hipSuccess) { grid = -1; return; }
        if (hipFuncSetAttribute((const void*)skel_fwd, hipFuncAttributeMaxDynamicSharedMemorySize, LDS_BYTES) != hipSuccess) { fprintf(stderr, "kernel_launch: hipFuncSetAttribute failed\n"); grid = -1; return; }
        if (hipOccupancyMaxActiveBlocksPerMultiprocessor(&per_cu, (const void*)skel_fwd, NTHR, LDS_BYTES) != hipSuccess || per_cu < 1) fprintf(stderr, "kernel_launch: occupancy query reports %d blocks per CU\n", per_cu);
        (void)hipGetLastError();
        grid = cus;
    }
    if (grid < 0) return;
    (void)hipMemsetAsync((char*)d_ws + WS_CTL, 0, CTL_ZERO_BYTES, stream);
    Args a{};
    for (int i = 0; i < 32; ++i) a.in[i] = (const float*)d_in[i];
    a.out = (float*)d_out; a.ws = (unsigned char*)d_ws;
    for (int li = 0; li < N_LAUNCHES; ++li) {
        a.ph_lo = (N_LAUNCHES == PER_PHASE) ? li : 0; a.ph_hi = (N_LAUNCHES == PER_PHASE) ? li + 1 : PER_PHASE;
        hipLaunchKernelGGL(skel_fwd, dim3(grid), dim3(NTHR), LDS_BYTES, stream, a);
    }
}
```

```cpp
#include <hip/hip_runtime.h>
#include <cstdio>
#include <cstdint>
namespace pg8 {
#define PG8_LAS __attribute__((address_space(3)))
typedef unsigned short bf16_t;
typedef short bf16x8 __attribute__((ext_vector_type(8)));
typedef float f32x4 __attribute__((ext_vector_type(4)));
typedef unsigned u32x4 __attribute__((ext_vector_type(4)));
constexpr int BM = 256, BK = 64, HALF = 128, HTB = HALF * BK * 2  , STAGE_BYTES = 8 * HTB, NXCD = 8, WGM = 8;

__host__ __device__ __forceinline__ int lds_byte(int r, int c) { const int st = (r >> 4) * 2 + (c >> 5), rr = r & 15, cc = c & 31, ob = rr * 64 + cc * 2; return st * 1024 + (ob ^ (((ob >> 9) & 1) << 5)); }
__host__ __device__ __forceinline__ void stage_rc(int b, int& R, int& C) { const int st = b / 1024, sb = b % 1024, swz = sb ^ (((sb >> 9) & 1) << 5); R = (st >> 1) * 16 + swz / 64; C = (st & 1) * 32 + (swz % 64) / 2; }
__host__ __device__ __forceinline__ int perm32(int rho) { const int n = rho >> 4, i = rho & 15; return 8 * (i >> 2) + 4 * n + (i & 3); }

struct Unit { int pm, pn; };
struct Gemm { const bf16_t* A; const bf16_t* Bt; int M, N, K; };

struct StaticOrder {
    int nM, nN, nwg, G, c;
    __host__ __device__ void init(int M, int N, int G_, int c_) { nM = M / BM; nN = N / BM; nwg = nM * nN; G = G_; c = c_; }
    __host__ __device__ bool next(int i, Unit& u) const {
        const long L = (long)i * G + c; if (L >= nwg) return false;
        int wgid = (int)L; { const int q = nwg / NXCD, r = nwg % NXCD, xcd = wgid % NXCD, off = wgid / NXCD; wgid = (xcd < r ? xcd * (q + 1) : r * (q + 1) + (xcd - r) * q) + off; }
        const int nig = WGM * nN, gid = wgid / nig, fm = gid * WGM, gsz = (nM - fm) < WGM ? (nM - fm) : WGM;
        u.pm = fm + ((wgid % nig) % gsz); u.pn = (wgid % nig) / gsz; return true;
    }
    __device__ __forceinline__ void a_ready(const Unit&) const {}
    __device__ __forceinline__ void done(const Unit&) const {}
};

__device__ __forceinline__ unsigned cvt_pk_bf16(float lo, float hi) { unsigned r; asm volatile("v_cvt_pk_bf16_f32 %0, %1, %2" : "=v"(r) : "v"(lo), "v"(hi)); return r; }
typedef float f32x2 __attribute__((ext_vector_type(2)));
typedef unsigned u32x2 __attribute__((ext_vector_type(2)));
constexpr float RMS_EPS = 1e-6f;
__device__ __forceinline__ float bfbits2f(unsigned v16) { return __uint_as_float(v16 << 16); }
__device__ __forceinline__ float sigm(float x) { return __builtin_amdgcn_rcpf(1.0f + __expf(-x)); }
template <int NP> __device__ __forceinline__ float row_rs(const float* ssq, int row) {
    float s = 0.f;
    if constexpr (NP == 1) s = ssq[row];
    else {
#pragma unroll
        for (int i = 0; i < NP / 4; ++i) { const f32x4 v = *(const f32x4*)(ssq + (size_t)row * NP + 4 * i); s += (v[0] + v[1]) + (v[2] + v[3]); }
    }
    return 1.0f / sqrtf(s * (1.0f / 1024.0f) + RMS_EPS);
}
template <int NP, bool HAS_DT> struct EpiScaleBf16 {
    static constexpr bool PERM = true, AFTER_DRAIN = false;
    bf16_t* O; size_t slot_elems; const float* ssq; float scale; float* dt;
    __device__ __forceinline__ void operator()(const f32x4 (&acc)[2][2][4][2], const Unit& u, int wr, int wc, int fr, int fq) const {
        const int row0 = u.pm * BM + wr * 64 + fr;
        if (HAS_DT && u.pn == 44) {
            if (wc == 0) {
#pragma unroll
                for (int ai = 0; ai < 2; ++ai)
#pragma unroll
                    for (int m = 0; m < 4; ++m) { const int row = row0 + ai * HALF + m * 16; const float rs = row_rs<NP>(ssq, row);
                        float* p = dt + (size_t)row * 32 + 8 * fq; *(f32x4*)p = acc[ai][0][m][0] * rs; *(f32x4*)(p + 4) = acc[ai][0][m][1] * rs; }
            }
            return;
        }
        bf16_t* base = O + (size_t)(u.pn >> 2) * slot_elems; const int col0 = (u.pn & 3) * BM + wc * 32 + 8 * fq;
#pragma unroll
        for (int ai = 0; ai < 2; ++ai)
#pragma unroll
            for (int m = 0; m < 4; ++m) { const int row = row0 + ai * HALF + m * 16; const float rs = row_rs<NP>(ssq, row) * scale; bf16_t* rowp = base + (size_t)row * 1024 + col0;
#pragma unroll
                for (int bj = 0; bj < 2; ++bj) { const f32x4 v0 = acc[ai][bj][m][0] * rs, v1 = acc[ai][bj][m][1] * rs;
                    u32x4 w; w.x = cvt_pk_bf16(v0[0], v0[1]); w.y = cvt_pk_bf16(v0[2], v0[3]); w.z = cvt_pk_bf16(v1[0], v1[1]); w.w = cvt_pk_bf16(v1[2], v1[3]);
                    if (HAS_DT) __builtin_nontemporal_store(w, (u32x4*)(rowp + bj * HALF));
                    else *(u32x4*)(rowp + bj * HALF) = w; } }
    }
};
struct EpiKV {
    static constexpr bool PERM = false, AFTER_DRAIN = false;
    float* mk; float* mv; bf16_t* kb; bf16_t* vt; const float* ssq;
    __device__ __forceinline__ void operator()(const f32x4 (&acc)[2][2][4][2], const Unit& u, int wr, int wc, int fr, int fq) const {
        const int row0 = u.pm * BM + wr * 64 + fr; const bool isv = u.pn >= 4; const int colt = (u.pn & 3) * BM + wc * 32 + 4 * fq;
#pragma unroll
        for (int ai = 0; ai < 2; ++ai)
#pragma unroll
            for (int m = 0; m < 4; ++m) { const int row = row0 + ai * HALF + m * 16; const float rs = row_rs<1>(ssq, row);
#pragma unroll
                for (int bj = 0; bj < 2; ++bj)
#pragma unroll
                    for (int n = 0; n < 2; ++n) { const int c = colt + bj * HALF + n * 16; const f32x4 v = acc[ai][bj][m][n] * rs;
                        if (!isv) { __builtin_nontemporal_store(v, (f32x4*)(mk + (size_t)row * 1024 + c)); u32x2 w; w.x = cvt_pk_bf16(v[0], v[1]); w.y = cvt_pk_bf16(v[2], v[3]); *(u32x2*)(kb + (size_t)row * 1024 + c) = w; }
                        else { __builtin_nontemporal_store(v, (f32x4*)(mv + (size_t)row * 1024 + c)); const int b = row >> 8, key = row & 255, hd = c >> 8, d = c & 255;
                            bf16_t* p = vt + ((size_t)((b * 4 + hd) * 256 + d)) * 256 + key; const unsigned w0 = cvt_pk_bf16(v[0], v[1]), w1 = cvt_pk_bf16(v[2], v[3]);
                            p[0] = (bf16_t)(w0 & 0xffffu); p[256] = (bf16_t)(w0 >> 16); p[512] = (bf16_t)(w1 & 0xffffu); p[768] = (bf16_t)(w1 >> 16); } } }
    }
};
template <bool ADD> struct EpiGate {
    static constexpr bool PERM = true, AFTER_DRAIN = false;
    bf16_t* O; const bf16_t* gate;
    __device__ __forceinline__ void operator()(const f32x4 (&acc)[2][2][4][2], const Unit& u, int wr, int wc, int fr, int fq) const {
        const int row0 = u.pm * BM + wr * 64 + fr, col0 = u.pn * BM + wc * 32 + 8 * fq;
#pragma unroll
        for (int ai = 0; ai < 2; ++ai)
#pragma unroll
            for (int m = 0; m < 4; ++m) { const size_t off = (size_t)(row0 + ai * HALF + m * 16) * 1024 + col0;
#pragma unroll
                for (int bj = 0; bj < 2; ++bj) { const u32x4 gw = __builtin_nontemporal_load((const u32x4*)(gate + off + bj * HALF)); u32x4 ow = (u32x4){0u, 0u, 0u, 0u}; if (ADD) ow = *(const u32x4*)(O + off + bj * HALF);
                    float r[8];
#pragma unroll
                    for (int e = 0; e < 8; ++e) { const unsigned g16 = (gw[e >> 1] >> ((e & 1) * 16)) & 0xffffu, o16 = (ow[e >> 1] >> ((e & 1) * 16)) & 0xffffu;
                        const float a = acc[ai][bj][m][e >> 2][e & 3]; r[e] = (ADD ? bfbits2f(o16) : 0.f) + sigm(bfbits2f(g16)) * a; }
                    u32x4 w; w.x = cvt_pk_bf16(r[0], r[1]); w.y = cvt_pk_bf16(r[2], r[3]); w.z = cvt_pk_bf16(r[4], r[5]); w.w = cvt_pk_bf16(r[6], r[7]);
                    *(u32x4*)(O + off + bj * HALF) = w; } }
    }
};
template <bool BF> struct EpiRes {
    static constexpr bool PERM = true, AFTER_DRAIN = false;
    const float* base0; const float* base1; bf16_t* hb; float* ssqp;
    __device__ __forceinline__ void operator()(const f32x4 (&acc)[2][2][4][2], const Unit& u, int wr, int wc, int fr, int fq) const {
        const int row0 = u.pm * BM + wr * 64 + fr, col0 = u.pn * BM + wc * 32 + 8 * fq; const float* base = u.pm < 64 ? base0 : base1;
#pragma unroll
        for (int ai = 0; ai < 2; ++ai)
#pragma unroll
            for (int m = 0; m < 4; ++m) { const int row = row0 + ai * HALF + m * 16; const size_t off = (size_t)row * 1024 + col0; float sq = 0.f;
#pragma unroll
                for (int bj = 0; bj < 2; ++bj) { const size_t o2 = off + bj * HALF; f32x4 b0, b1;
                    if (BF) { const u32x4 w = *(const u32x4*)(hb + o2); b0 = (f32x4){bfbits2f(w.x & 0xffffu), __uint_as_float(w.x & 0xffff0000u), bfbits2f(w.y & 0xffffu), __uint_as_float(w.y & 0xffff0000u)};
                        b1 = (f32x4){bfbits2f(w.z & 0xffffu), __uint_as_float(w.z & 0xffff0000u), bfbits2f(w.w & 0xffffu), __uint_as_float(w.w & 0xffff0000u)}; }
                    else { b0 = __builtin_nontemporal_load((const f32x4*)(base + o2)); b1 = __builtin_nontemporal_load((const f32x4*)(base + o2 + 4)); }
                    const f32x4 v0 = b0 + acc[ai][bj][m][0], v1 = b1 + acc[ai][bj][m][1];
                    sq += ((v0[0] * v0[0] + v0[1] * v0[1]) + (v0[2] * v0[2] + v0[3] * v0[3])) + ((v1[0] * v1[0] + v1[1] * v1[1]) + (v1[2] * v1[2] + v1[3] * v1[3]));
                    u32x4 w; w.x = cvt_pk_bf16(v0[0], v0[1]); w.y = cvt_pk_bf16(v0[2], v0[3]); w.z = cvt_pk_bf16(v1[0], v1[1]); w.w = cvt_pk_bf16(v1[2], v1[3]); *(u32x4*)(hb + o2) = w; }
                sq += __shfl_xor(sq, 16); sq += __shfl_xor(sq, 32);
                if (fq == 0) ssqp[(size_t)row * 16 + u.pn * 4 + wc] = sq; }
    }
};
struct EpiSwiglu {
    static constexpr bool PERM = true, AFTER_DRAIN = false;
    bf16_t* act; const float* ssq;
    __device__ __forceinline__ void operator()(const f32x4 (&acc)[2][2][4][2], const Unit& u, int wr, int wc, int fr, int fq) const {
        const int row0 = u.pm * BM + wr * 64 + fr, col0 = u.pn * 128 + wc * 16 + 4 * fq;
#pragma unroll
        for (int ai = 0; ai < 2; ++ai)
#pragma unroll
            for (int m = 0; m < 4; ++m) { const int row = row0 + ai * HALF + m * 16; const float rs = row_rs<16>(ssq, row);
#pragma unroll
                for (int bj = 0; bj < 2; ++bj) { const f32x4 a = acc[ai][bj][m][0] * rs, b = acc[ai][bj][m][1] * rs;
                    const float r0 = a[0] * sigm(a[0]) * a[1], r1 = a[2] * sigm(a[2]) * a[3], r2 = b[0] * sigm(b[0]) * b[1], r3 = b[2] * sigm(b[2]) * b[3];
                    u32x2 w; w.x = cvt_pk_bf16(r0, r1); w.y = cvt_pk_bf16(r2, r3); *(u32x2*)(act + (size_t)row * 2816 + col0 + bj * 64) = w; } }
    }
};
template <class Epi, class Sched, bool ALIGN_EPI = false, bool SP2 = false>
__device__ __forceinline__ void gemm_phase(PG8_LAS unsigned char* lds, const Gemm g, const Sched& S, const Epi& E) {
    const int tid = threadIdx.x, wid = __builtin_amdgcn_readfirstlane(tid >> 6), lane = tid & 63, wr = wid >> 2, wc = wid & 3, fr = lane & 15, fq = lane >> 4;
    const int K = g.K, nt = K / BK;
    unsigned voffA[2], voffB[2];
#pragma unroll
    for (int i = 0; i < 2; ++i) { int R, C; stage_rc(tid * 16 + i * 8192, R, C); const int Rb = Epi::PERM ? ((R & ~31) + perm32(R & 31)) : R;
        voffA[i] = (unsigned)(R * K + C) * 2u; voffB[i] = (unsigned)(Rb * K + C) * 2u; }
    const size_t kstep = (size_t)(BK * 2);
    const size_t hstep = (size_t)HALF * K * 2;
    const size_t tstep = 2 * hstep;
    const unsigned ldsw = (unsigned)wid * 1024u;
    const int aoff = lds_byte(wr * 64 + fr, fq * 8), boff = lds_byte(wc * 32 + fr, fq * 8);
#define PG8_SA(b, h) (((b) * 2 + (h)) * HTB)
#define PG8_SB(b, h) ((4 + (b) * 2 + (h)) * HTB)
#define PG8_STAGE(bufoff, gbase, voff) do { _Pragma("unroll") for (int _i = 0; _i < 2; ++_i) \
        __builtin_amdgcn_global_load_lds((const unsigned*)((const char*)(gbase) + (voff)[_i]), (PG8_LAS unsigned*)(lds + (bufoff) + ldsw + _i * 8192), 16, 0, 0); } while (0)
#define PG8_LDA(dst, b, h) do { _Pragma("unroll") for (int m = 0; m < 4; ++m) _Pragma("unroll") for (int k = 0; k < 2; ++k) dst[m][k] = *(const PG8_LAS bf16x8*)(lds + PG8_SA(b, h) + aoff + m * 2048 + k * 1024); } while (0)
#define PG8_LDB(dst, b, h) do { _Pragma("unroll") for (int n = 0; n < 2; ++n) _Pragma("unroll") for (int k = 0; k < 2; ++k) dst[n][k] = *(const PG8_LAS bf16x8*)(lds + PG8_SB(b, h) + boff + n * 2048 + k * 1024); } while (0)
#define PG8_MMA(ai, bj, At, Bt) do { __builtin_amdgcn_s_setprio(1); _Pragma("unroll") for (int m = 0; m < 4; ++m) _Pragma("unroll") for (int n = 0; n < 2; ++n) _Pragma("unroll") for (int k = 0; k < 2; ++k) \
        acc[ai][bj][m][n] = __builtin_amdgcn_mfma_f32_16x16x32_bf16(Bt[n][k], At[m][k], acc[ai][bj][m][n], 0, 0, 0); __builtin_amdgcn_s_setprio(0); } while (0)
#define PG8_WAIT_V(n) asm volatile("s_waitcnt vmcnt(" #n ")" ::: "memory")
#define PG8_WAIT_L(n) asm volatile("s_waitcnt lgkmcnt(" #n ")" ::: "memory")
#define PG8_BAR __builtin_amdgcn_s_barrier()
#define PG8_SCHED __builtin_amdgcn_sched_barrier(0)
    Unit cur, nxt; int ui = 0;
    if (!S.next(0, cur)) return;
    f32x4 acc[2][2][4][2];
#pragma unroll
    for (int a = 0; a < 2; ++a)
#pragma unroll
        for (int b = 0; b < 2; ++b)
#pragma unroll
            for (int m = 0; m < 4; ++m)
#pragma unroll
                for (int n = 0; n < 2; ++n) acc[a][b][m][n] = (f32x4){0.f, 0.f, 0.f, 0.f};
    bf16x8 At[4][2], B0[2][2], B1[2][2];
    const char* cA = (const char*)g.A + (size_t)cur.pm * tstep; const char* cB = (const char*)g.Bt + (size_t)cur.pn * tstep;
    S.a_ready(cur);
    if constexpr (SP2) {
        PG8_STAGE(PG8_SB(0, 0), cB, voffB); PG8_STAGE(PG8_SB(0, 1), cB + hstep, voffB); PG8_STAGE(PG8_SA(0, 0), cA, voffA); PG8_STAGE(PG8_SA(0, 1), cA + hstep, voffA);
        if (wr == 1) PG8_BAR;
        PG8_WAIT_V(2); PG8_BAR;
        PG8_STAGE(PG8_SB(1, 0), cB + kstep, voffB); PG8_STAGE(PG8_SA(1, 0), cA + kstep, voffA); PG8_STAGE(PG8_SB(1, 1), cB + hstep + kstep, voffB);
        PG8_WAIT_V(6); PG8_BAR;
    } else {
        PG8_STAGE(PG8_SB(0, 0), cB, voffB); PG8_STAGE(PG8_SA(0, 0), cA, voffA); PG8_STAGE(PG8_SB(0, 1), cB + hstep, voffB); PG8_STAGE(PG8_SA(0, 1), cA + hstep, voffA);
        if (wr == 1) PG8_BAR;
        PG8_WAIT_V(4); PG8_BAR;
        PG8_STAGE(PG8_SB(1, 0), cB + kstep, voffB); PG8_STAGE(PG8_SA(1, 0), cA + kstep, voffA); PG8_STAGE(PG8_SB(1, 1), cB + hstep + kstep, voffB);
        PG8_WAIT_V(6); PG8_BAR;
    }
    for (;;) {
        const bool has_next = S.next(ui + 1, nxt);
        const char* nA = has_next ? (const char*)g.A + (size_t)nxt.pm * tstep : cA; const char* nB = has_next ? (const char*)g.Bt + (size_t)nxt.pn * tstep : cB;
        for (int t = 0; t < nt; t += 2) {
            const bool last = (t == nt - 2);
            const char* a1 = cA + (size_t)(t + 1) * kstep;
            const char* a2 = last ? nA : cA + (size_t)(t + 2) * kstep; const char* b2 = last ? nB : cB + (size_t)(t + 2) * kstep;
            const char* a3 = a2 + kstep; const char* b3 = b2 + kstep;
            if (last && has_next) S.a_ready(nxt);
            if constexpr (SP2) {
            PG8_LDB(B0, 0, 0); PG8_LDB(B1, 0, 1); PG8_SCHED; PG8_LDA(At, 0, 0); PG8_STAGE(PG8_SA(1, 1), a1 + hstep, voffA);
            PG8_WAIT_V(8); PG8_WAIT_L(0); PG8_BAR; PG8_MMA(0, 0, At, B0); PG8_MMA(0, 1, At, B1); PG8_BAR; PG8_SCHED;
            PG8_LDA(At, 0, 1); PG8_STAGE(PG8_SB(0, 0), b2, voffB); PG8_STAGE(PG8_SB(0, 1), b2 + hstep, voffB); PG8_STAGE(PG8_SA(0, 0), a2, voffA);
            PG8_WAIT_V(8); PG8_WAIT_L(0); PG8_BAR; PG8_MMA(1, 0, At, B0); PG8_MMA(1, 1, At, B1); PG8_BAR; PG8_SCHED;
            PG8_LDB(B0, 1, 0); PG8_LDB(B1, 1, 1); PG8_SCHED; PG8_LDA(At, 1, 0); PG8_STAGE(PG8_SA(0, 1), a2 + hstep, voffA);
            PG8_WAIT_V(8); PG8_WAIT_L(0); PG8_BAR; PG8_MMA(0, 0, At, B0); PG8_MMA(0, 1, At, B1); PG8_BAR; PG8_SCHED;
            PG8_LDA(At, 1, 1); PG8_STAGE(PG8_SB(1, 0), b3, voffB); PG8_STAGE(PG8_SB(1, 1), b3 + hstep, voffB); PG8_STAGE(PG8_SA(1, 0), a3, voffA);
            PG8_WAIT_V(8); PG8_WAIT_L(0); PG8_BAR; PG8_MMA(1, 0, At, B0); PG8_MMA(1, 1, At, B1); PG8_BAR; PG8_SCHED;
            } else {
            PG8_LDB(B0, 0, 0); PG8_SCHED; PG8_LDA(At, 0, 0); PG8_STAGE(PG8_SA(1, 1), a1 + hstep, voffA);
            PG8_WAIT_L(8); PG8_BAR; PG8_WAIT_L(0); PG8_MMA(0, 0, At, B0); PG8_BAR; PG8_SCHED;
            PG8_LDB(B1, 0, 1); PG8_STAGE(PG8_SB(0, 0), b2, voffB);
            PG8_BAR; PG8_WAIT_L(0); PG8_MMA(0, 1, At, B1); PG8_BAR;
            PG8_LDA(At, 0, 1); PG8_STAGE(PG8_SA(0, 0), a2, voffA);
            PG8_BAR; PG8_WAIT_L(0); PG8_MMA(1, 0, At, B0); PG8_BAR; PG8_SCHED;
            PG8_STAGE(PG8_SB(0, 1), b2 + hstep, voffB);
            PG8_WAIT_V(6); PG8_BAR; PG8_MMA(1, 1, At, B1); PG8_BAR;
            PG8_LDB(B0, 1, 0); PG8_SCHED; PG8_LDA(At, 1, 0); PG8_STAGE(PG8_SA(0, 1), a2 + hstep, voffA);
            PG8_WAIT_L(8); PG8_BAR; PG8_WAIT_L(0); PG8_MMA(0, 0, At, B0); PG8_BAR; PG8_SCHED;
            PG8_LDB(B1, 1, 1); PG8_STAGE(PG8_SB(1, 0), b3, voffB);
            PG8_BAR; PG8_WAIT_L(0); PG8_MMA(0, 1, At, B1); PG8_BAR;
            PG8_LDA(At, 1, 1); PG8_STAGE(PG8_SA(1, 0), a3, voffA);
            PG8_BAR; PG8_WAIT_L(0); PG8_MMA(1, 0, At, B0); PG8_BAR; PG8_SCHED;
            PG8_STAGE(PG8_SB(1, 1), b3 + hstep, voffB);
            PG8_WAIT_V(6); PG8_BAR; PG8_MMA(1, 1, At, B1); PG8_BAR;
            }
        }
        if constexpr (ALIGN_EPI) { if (wr == 0) PG8_BAR; }
        if constexpr (!Epi::AFTER_DRAIN) { E(acc, cur, wr, wc, fr, fq); S.done(cur); }
        if (!has_next) break;
#pragma unroll
        for (int a = 0; a < 2; ++a)
#pragma unroll
            for (int b = 0; b < 2; ++b)
#pragma unroll
                for (int m = 0; m < 4; ++m)
#pragma unroll
                    for (int n = 0; n < 2; ++n) acc[a][b][m][n] = (f32x4){0.f, 0.f, 0.f, 0.f};
        cur = nxt; cA = nA; cB = nB; ++ui;
        if constexpr (ALIGN_EPI) { if (wr == 1) PG8_BAR; }
    }
    PG8_WAIT_V(0);
    if constexpr (!ALIGN_EPI) { if (wr == 0) PG8_BAR; }
    PG8_BAR;
    if constexpr (Epi::AFTER_DRAIN) { E.fused(acc, cur, wr, wc, fr, fq, lds, wid, lane); S.done(cur); }
#undef PG8_SA
#undef PG8_SB
#undef PG8_STAGE
#undef PG8_LDA
#undef PG8_LDB
#undef PG8_MMA
#undef PG8_WAIT_V
#undef PG8_WAIT_L
#undef PG8_BAR
#undef PG8_SCHED
}
}
#define GAS __attribute__((address_space(1)))
#define LAS __attribute__((address_space(3)))
typedef unsigned short bf16;
typedef unsigned v4u __attribute__((ext_vector_type(4)));
typedef float f32x4 __attribute__((ext_vector_type(4)));
typedef short bf16x8 __attribute__((ext_vector_type(8)));
typedef GAS unsigned gu32;
typedef GAS unsigned long long gu64;
#define RLX_AGENT __ATOMIC_RELAXED, __HIP_MEMORY_SCOPE_AGENT
#define LDS_WAIT() asm volatile("s_waitcnt lgkmcnt(0)" ::: "memory")
#define VM_WAIT() asm volatile("s_waitcnt vmcnt(0)" ::: "memory")
__device__ __forceinline__ unsigned long long rt() { return __builtin_amdgcn_s_memrealtime(); }
typedef float f32x2_t __attribute__((ext_vector_type(2))); typedef __bf16 bf16x2_t __attribute__((ext_vector_type(2)));
__device__ __forceinline__ unsigned pk2(float lo, float hi) { const f32x2_t v = {lo, hi}; const bf16x2_t b = __builtin_convertvector(v, bf16x2_t); return __builtin_bit_cast(unsigned, b); }
__device__ __forceinline__ unsigned f2bf(float f) { return pk2(f, 0.f) & 0xffffu; }

#define XB_TMO      128
#define XB_XCNT(j)  (256  + 64 * (j))
#define XB_XSUB(j)  (1280 + 64 * (j))
#define XB_XGEN(j)  (2304 + 64 * (j))
#define XB_TOP      3328
#define XB_TOPGEN   3392
#define XCD_BAR_WORDS 3456
#define XB_SPIN_CAP (1u << 18)

__device__ __forceinline__ unsigned xb_ld(unsigned* p)              { return __hip_atomic_load(p, __ATOMIC_RELAXED, __HIP_MEMORY_SCOPE_AGENT); }
__device__ __forceinline__ unsigned xb_add(unsigned* p, unsigned v) { return __hip_atomic_fetch_add(p, v, __ATOMIC_RELAXED, __HIP_MEMORY_SCOPE_AGENT); }
__device__ __forceinline__ unsigned xb_xcc_id() { return (unsigned)__builtin_amdgcn_s_getreg((3 << 11) | 20) & 0xFu; }
#define XB_SPIN(cond, bar) do { unsigned _sp = 0; while (cond) { __builtin_amdgcn_s_sleep(1); \
    if ((++_sp & 255u) == 0u) { if (xb_ld(&(bar)[XB_TMO])) break; if (_sp > XB_SPIN_CAP) { atomicAdd(&(bar)[XB_TMO], 1u); break; } } } } while (0)

struct XcdBarrier {
    unsigned* bar; unsigned x;
    volatile LAS unsigned* st;
};

__device__ __forceinline__ XcdBarrier xcd_barrier_post(unsigned* bar, volatile LAS unsigned* st) {
    XcdBarrier b; b.bar = bar; b.x = xb_xcc_id(); b.st = st;
    if (threadIdx.x == 0) (void)xb_add(&bar[XB_XCNT(b.x)], 1u);
    return b;
}
__device__ __forceinline__ void xcd_barrier_complete(unsigned* bar, unsigned x, unsigned& nloc, unsigned& nx) {
    const unsigned G = gridDim.x * gridDim.y * gridDim.z;
    unsigned sum, cnt, mine, sp = 0u;
    for (;;) {
        sum = 0u; cnt = 0u; mine = 0u;
#pragma unroll
        for (unsigned j = 0; j < 16; ++j) { const unsigned c = xb_ld(&bar[XB_XCNT(j)]); sum += c; cnt += (c > 0u) ? 1u : 0u; mine = (j == x) ? c : mine; }
        if (sum == G) break;
        __builtin_amdgcn_s_sleep(1);
        if ((++sp & 255u) == 0u) { if (xb_ld(&bar[XB_TMO])) break; if (sp > XB_SPIN_CAP) { atomicAdd(&bar[XB_TMO], 1u); break; } }
    }
    nloc = mine > 0u ? mine : 1u; nx = cnt > 0u ? cnt : 1u;
}

__device__ __forceinline__ void xcd_barrier(const XcdBarrier& b) {
    asm volatile("s_waitcnt vmcnt(0)" ::: "memory");
    __syncthreads();
    if (threadIdx.x == 0) {
        unsigned* bar = b.bar;
        __builtin_amdgcn_s_waitcnt(0);
        unsigned nloc = b.st[0], nx = b.st[1];
        if (nloc == 0u) { xcd_barrier_complete(bar, b.x, nloc, nx); b.st[0] = nloc; b.st[1] = nx; }
        const unsigned old = xb_add(&bar[XB_XSUB(b.x)], 1u);
        const unsigned gen = old / nloc;
        if (old + 1u == (gen + 1u) * nloc) {
            __builtin_amdgcn_fence(__ATOMIC_RELEASE, "agent");
            asm volatile("s_waitcnt vmcnt(0)" ::: "memory");
            const unsigned og = xb_add(&bar[XB_TOP], 1u);
            const unsigned tg = og / nx;
            if (og + 1u == (tg + 1u) * nx) xb_add(&bar[XB_TOPGEN], 1u);
            else XB_SPIN(xb_ld(&bar[XB_TOPGEN]) == tg, bar);
            __builtin_amdgcn_fence(__ATOMIC_ACQUIRE, "agent");
            xb_add(&bar[XB_XGEN(b.x)], 1u);
            asm volatile("s_waitcnt vmcnt(0)" ::: "memory");
        } else {
            XB_SPIN(xb_ld(&bar[XB_XGEN(b.x)]) == gen, bar);
            __builtin_amdgcn_fence(__ATOMIC_ACQUIRE, "agent");
            asm volatile("s_waitcnt vmcnt(0)" ::: "memory");
        }
    }
    __syncthreads();
}
typedef unsigned v2u __attribute__((ext_vector_type(2)));
constexpr int NWAVES = 8, NTHR = 512;
constexpr int DM = 1024, TP = 16384, TS = 512, T = TP + TS;
constexpr int SEQ = 2048, NBP = 8, NBS = 128, LS = 4, MEMR = 2048;
constexpr int NPROJ = 11520;
constexpr int FFN = 2816;
constexpr float EPS = 1e-6f;
constexpr float QSCALE = 0.0625f * 1.4426950408889634f;

constexpr size_t MiB = 1u << 20;
constexpr size_t WS_CTL = 0, CTL_ZERO_BYTES = 1 * MiB;
constexpr size_t WS_SSQX = 1 * MiB, WS_SSQM = 1 * MiB + 512 * 1024;
constexpr size_t WS_DT = 2 * MiB, WS_SSQSSD = 5 * MiB, WS_SSQP1 = 8 * MiB, WS_SSQP2 = 9 * MiB + 512 * 1024, WS_SSQP3 = 11 * MiB;
constexpr size_t WS_WIN = 13 * MiB, WS_WKV = 36 * MiB, WS_WSSD = 40 * MiB, WS_WHG = 44 * MiB, WS_WOUT = 46 * MiB, WS_WCQ = 48 * MiB, WS_WCO = 50 * MiB, WS_WGU = 52 * MiB, WS_WDN = 63 * MiB;
constexpr size_t WS_XB = 69 * MiB, WS_MNB = 102 * MiB, WS_KB = 106 * MiB, WS_VT = 110 * MiB;
constexpr size_t SLOT = 33 * MiB, SLOT_ELEMS = (size_t)T * 1024;
constexpr size_t WS_PROJ = 114 * MiB;
constexpr size_t WS_YG = WS_PROJ + 11 * SLOT, WS_ON = WS_YG + 2 * SLOT, WS_END = WS_ON + SLOT;
static_assert(SLOT == SLOT_ELEMS * 2, "slot size");
static_assert(WS_WIN + (size_t)NPROJ * 1024 * 2 <= WS_WKV && WS_WGU + (size_t)2 * FFN * 1024 * 2 <= WS_WDN && WS_WDN + (size_t)1024 * FFN * 2 <= WS_XB && WS_SSQP3 + (size_t)T * 64 <= WS_WIN, "d_ws map");
static_assert(WS_DT + (size_t)T * 128 <= WS_SSQSSD && WS_SSQSSD + (size_t)T * 128 <= WS_SSQP1 && WS_SSQP1 + (size_t)T * 64 <= WS_SSQP2 && WS_SSQP2 + (size_t)T * 64 <= WS_SSQP3, "d_ws map 2");
enum { S_Z0 = 0, S_Z1 = 1, S_X0 = 2, S_X1 = 3, S_X2 = 4, S_Q = 5, S_F = 6, S_I = 7, S_HG = 8, S_GS = 9, S_GH = 10 };
constexpr size_t WS_MERGED = WS_PROJ + S_Q * SLOT, WS_HB = WS_PROJ + S_F * SLOT, WS_QB = WS_PROJ + S_I * SLOT, WS_OB = WS_PROJ + S_HG * SLOT, WS_ACT = WS_PROJ;
static_assert((size_t)T * FFN * 2 <= 3 * SLOT, "act overlay");
constexpr size_t O_Y = 0, O_SSMP = (size_t)T * 1024, O_CONVP = O_SSMP + 2097152, O_HGP = O_CONVP + 73728, O_MKP = O_HGP + 1048576, O_MVP = O_MKP + 2097152,
                 O_SSMS = O_MVP + 2097152, O_CONVS = O_SSMS + 33554432, O_HGS = O_CONVS + 1179648, O_END = O_HGS + 16777216;
constexpr int CW_QUEUE = 64;
constexpr int CW_BAR = 4096;
constexpr int RING_OFF = 0, RING_BYTES = 131072;
constexpr int LDS_BYTES = 147456;
constexpr int LDSCTL_OFF = LDS_BYTES - 1024, MISC_OFF = LDSCTL_OFF + 320;
struct Frame {
    LAS unsigned char* lds;
    volatile LAS unsigned* MISC;
    gu32* ctl;
    int tid, lane, wave;
    int vcu, G;
    const float* in[32];
    float* out; unsigned char* ws;
};
__device__ __forceinline__ float bf2f(unsigned v16) { return __uint_as_float(v16 << 16); }
__device__ __forceinline__ f32x4 ld_nt(const float* p) { return __builtin_nontemporal_load((const f32x4*)p); }
__device__ __forceinline__ void st_nt(float* p, f32x4 v) { __builtin_nontemporal_store(v, (f32x4*)p); }
__device__ __forceinline__ v4u ld_nt16(const void* p) { return __builtin_nontemporal_load((const v4u*)p); }
__device__ __forceinline__ unsigned ld_nt4(const void* p) { return __builtin_nontemporal_load((const unsigned*)p); }
__device__ __forceinline__ float sigmoid_f(float x) { return __builtin_amdgcn_rcpf(1.0f + __expf(-x)); }
__device__ __forceinline__ float silu_f(float x) { return x * sigmoid_f(x); }
__device__ __forceinline__ float wave_sum(float v) {
#pragma unroll
    for (int o = 1; o < 64; o <<= 1) v += __shfl_xor(v, o);
    return v;
}
__device__ __forceinline__ float wave_max(float v) {
#pragma unroll
    for (int o = 1; o < 64; o <<= 1) v = fmaxf(v, __shfl_xor(v, o));
    return v;
}
struct TSrc { const float* W; const float* W2; const float* ks; int ldw; int mode; };
__device__ __forceinline__ void p0_transpose_item(const TSrc& s, int K, int N, bf16* WT, LAS unsigned short* scr, int item, int lane) {
    const int nblk = N / 64, kb = item / nblk, nb = item % nblk, k0 = 64 * kb, n0 = 64 * nb;
    const int kr = lane >> 4, nq = lane & 15;
    const float* const Wa = s.W; const float* const Wb = s.W2;
    const float* src; int c0, cs; bool zero = false;
    if (s.mode == 2) { const float* wsel = Wa; if (nq >= 8) wsel = Wb; src = wsel + (n0 >> 1) + 4 * (nq & 7); c0 = 8 * (nq & 7) + (nq >> 3); cs = 2; }
    else { const int n = n0 + 4 * nq; c0 = 4 * nq; cs = 1;
        if (s.mode == 0) src = Wa + n;
        else if (s.mode == 1) { if (n < 5120) src = Wa + n; else if (n < 11264) src = Wa + n + 32; else if (n < 11296) src = Wa + 5120 + (n - 11264); else { src = Wa; zero = true; } }
        else { src = Wa + n; if (n >= 1024) src = Wb + (n - 1024); } }
    f32x4 v[16];
#pragma unroll
    for (int i = 0; i < 16; ++i) v[i] = zero ? (f32x4){0.f, 0.f, 0.f, 0.f} : ld_nt(src + (size_t)(k0 + 4 * i + kr) * s.ldw);
#pragma unroll
    for (int i = 0; i < 16; ++i) { const int kk = 4 * i + kr; const float sc = s.ks ? s.ks[k0 + kk] : 1.0f; const unsigned w0 = pk2(v[i].x * sc, v[i].y * sc), w1 = pk2(v[i].z * sc, v[i].w * sc);
        LAS unsigned short* d = scr + kk * 66 + c0;
        if (cs == 1) { *(LAS unsigned*)d = w0; *(LAS unsigned*)(d + 2) = w1; }
        else { d[0] = (unsigned short)(w0 & 0xffffu); d[2] = (unsigned short)(w0 >> 16); d[4] = (unsigned short)(w1 & 0xffffu); d[6] = (unsigned short)(w1 >> 16); } }
    LDS_WAIT(); asm volatile("" ::: "memory");
    const int nr = lane >> 3, kc = lane & 7;
#pragma unroll
    for (int j = 0; j < 8; ++j) { const int n = 8 * j + nr; const LAS unsigned short* p = scr + (8 * kc) * 66 + n;
        v4u o; o.x = (unsigned)p[0] | ((unsigned)p[66] << 16); o.y = (unsigned)p[2 * 66] | ((unsigned)p[3 * 66] << 16); o.z = (unsigned)p[4 * 66] | ((unsigned)p[5 * 66] << 16); o.w = (unsigned)p[6 * 66] | ((unsigned)p[7 * 66] << 16);
        *(v4u*)(WT + (size_t)(n0 + n) * K + k0 + 8 * kc) = o; }
    LDS_WAIT(); asm volatile("" ::: "memory");
}
__device__ __forceinline__ void rows4_to_bf16_ssq(const float* x0, bf16* o0, float* ssq0, int lane) {
    f32x4 v[4][4];
#pragma unroll
    for (int rr = 0; rr < 4; ++rr)
#pragma unroll
        for (int j = 0; j < 4; ++j) v[rr][j] = ld_nt(x0 + rr * 1024 + 4 * (64 * j + lane));
#pragma unroll
    for (int rr = 0; rr < 4; ++rr) { float sq = 0.f;
#pragma unroll
        for (int j = 0; j < 4; ++j) sq += (v[rr][j].x * v[rr][j].x + v[rr][j].y * v[rr][j].y) + (v[rr][j].z * v[rr][j].z + v[rr][j].w * v[rr][j].w);
        sq = wave_sum(sq);
        unsigned long long* o8 = (unsigned long long*)(o0 + rr * 1024) + lane;
#pragma unroll
        for (int j = 0; j < 4; ++j) o8[64 * j] = (unsigned long long)pk2(v[rr][j].x, v[rr][j].y) | ((unsigned long long)pk2(v[rr][j].z, v[rr][j].w) << 32);
        if (lane == 0) ssq0[rr] = sq; }
}
__device__ __forceinline__ void p0_prologue(Frame& F) {
    LAS unsigned short* scr = (LAS unsigned short*)(F.lds + RING_OFF + F.wave * 16384);
    const int gw = F.vcu * NWAVES + F.wave, NGW = F.G * NWAVES;
    unsigned char* ws = F.ws;
    constexpr int I_IN = 16 * (NPROJ / 64), I_KV = 16 * 32, I_SSD = 32 * 16, I_SQ = 16 * 16, I_GU = 16 * (2 * FFN / 64), I_DN = (FFN / 64) * 16;
    constexpr int NITEMS = I_IN + I_KV + I_SSD + 4 * I_SQ + I_GU + I_DN;
    for (int it = gw; it < NITEMS; it += NGW) {
        int r = it;
        if (r < I_IN) { TSrc s{F.in[9], nullptr, F.in[8], 11296, 1}; p0_transpose_item(s, 1024, NPROJ, (bf16*)(ws + WS_WIN), scr, r, F.lane); continue; } r -= I_IN;
        if (r < I_KV) { TSrc s{F.in[24], F.in[25], F.in[22], 1024, 3}; p0_transpose_item(s, 1024, 2048, (bf16*)(ws + WS_WKV), scr, r, F.lane); continue; } r -= I_KV;
        if (r < I_SSD) { TSrc s{F.in[16], nullptr, F.in[15], 1024, 0}; p0_transpose_item(s, 2048, 1024, (bf16*)(ws + WS_WSSD), scr, r, F.lane); continue; } r -= I_SSD;
        if (r < I_SQ) { TSrc s{F.in[19], nullptr, F.in[18], 1024, 0}; p0_transpose_item(s, 1024, 1024, (bf16*)(ws + WS_WHG), scr, r, F.lane); continue; } r -= I_SQ;
        if (r < I_SQ) { TSrc s{F.in[20], nullptr, nullptr, 1024, 0}; p0_transpose_item(s, 1024, 1024, (bf16*)(ws + WS_WOUT), scr, r, F.lane); continue; } r -= I_SQ;
        if (r < I_SQ) { TSrc s{F.in[23], nullptr, F.in[21], 1024, 0}; p0_transpose_item(s, 1024, 1024, (bf16*)(ws + WS_WCQ), scr, r, F.lane); continue; } r -= I_SQ;
        if (r < I_SQ) { TSrc s{F.in[26], nullptr, nullptr, 1024, 0}; p0_transpose_item(s, 1024, 1024, (bf16*)(ws + WS_WCO), scr, r, F.lane); continue; } r -= I_SQ;
        if (r < I_GU) { TSrc s{F.in[28], F.in[29], F.in[27], FFN, 2}; p0_transpose_item(s, 1024, 2 * FFN, (bf16*)(ws + WS_WGU), scr, r, F.lane); continue; } r -= I_GU;
        { TSrc s{F.in[30], nullptr, nullptr, 1024, 0}; p0_transpose_item(s, FFN, 1024, (bf16*)(ws + WS_WDN), scr, r, F.lane); }
    }
    bf16* XB = (bf16*)(ws + WS_XB); float* SSQX = (float*)(ws + WS_SSQX);
    for (int m4 = gw; m4 < T / 4; m4 += NGW) { const int m = 4 * m4;
        rows4_to_bf16_ssq(m < TP ? F.in[0] + (size_t)m * DM : F.in[1] + (size_t)(m - TP) * DM, XB + (size_t)m * DM, SSQX + m, F.lane); }
    bf16* MNB = (bf16*)(ws + WS_MNB); float* SSQM = (float*)(ws + WS_SSQM);
    for (int m4 = gw; m4 < MEMR / 4; m4 += NGW) { const int m = 4 * m4; rows4_to_bf16_ssq(F.in[2] + (size_t)m * DM, MNB + (size_t)m * DM, SSQM + m, F.lane); }
}
__device__ __forceinline__ void conv_copy_unit(Frame& F, int gb) {
    const bf16* PROJ = (const bf16*)(F.ws + WS_PROJ);
    const bool prompt = gb < NBP; const int sb = gb - NBP;
    const size_t row0 = prompt ? (size_t)gb * SEQ + (SEQ - 3) : (size_t)TP + (size_t)sb * LS + 1;
    float* dst = prompt ? F.out + O_CONVP + (size_t)gb * 3 * 3072 : F.out + O_CONVS + (size_t)sb * 3 * 3072;
    for (int e = F.tid; e < 3 * 3072; e += NTHR) { const int j = e / 3072, col = e % 3072;
        dst[e] = bf2f(PROJ[(size_t)(S_X0 + (col >> 10)) * SLOT_ELEMS + (row0 + j) * 1024 + (col & 1023)]); }
}
__device__ __forceinline__ void ssdnorm_phase(Frame& F) {
    const int gw = F.vcu * NWAVES + F.wave, NGW = F.G * NWAVES; bf16* YG = (bf16*)(F.ws + WS_YG); const float* SSQ = (const float*)(F.ws + WS_SSQSSD);
    for (int row = gw; row < T; row += NGW) {
        const f32x4* sp = (const f32x4*)(SSQ + (size_t)row * 32);
#pragma unroll
        for (int j = 0; j < 4; ++j) { const f32x4 a = sp[2 * j], b = sp[2 * j + 1]; const float s = ((a.x + a.y) + (a.z + a.w)) + ((b.x + b.y) + (b.z + b.w)); const float rs = 1.0f / sqrtf(s * (1.0f / 512.0f) + EPS);
            v4u* p = (v4u*)(YG + (size_t)row * 2048) + j * 64 + F.lane; const v4u w = *p; v4u o;
#pragma unroll
            for (int e = 0; e < 4; ++e) o[e] = pk2(bf2f(w[e] & 0xffffu) * rs, bf2f(w[e] >> 16) * rs);
            *p = o; }
    }
}
typedef float f32x16 __attribute__((ext_vector_type(16)));
#define MFMA32(a, b, c) __builtin_amdgcn_mfma_f32_32x32x16_bf16((a), (b), (c), 0, 0, 0)
__device__ __forceinline__ unsigned cvtpk_c(float lo, float hi) { return pk2(lo, hi); }
__device__ __forceinline__ bf16x8 pack8(float a0, float a1, float a2, float a3, float a4, float a5, float a6, float a7) {
    v4u w; w.x = cvtpk_c(a0, a1); w.y = cvtpk_c(a2, a3); w.z = cvtpk_c(a4, a5); w.w = cvtpk_c(a6, a7); return __builtin_bit_cast(bf16x8, w); }
#define ACC_FRAG(x, s) pack8((x)[8 * (s)], (x)[8 * (s) + 1], (x)[8 * (s) + 2], (x)[8 * (s) + 3], (x)[8 * (s) + 4], (x)[8 * (s) + 5], (x)[8 * (s) + 6], (x)[8 * (s) + 7])
__device__ __forceinline__ bf16x8 lds_frag16(const LAS unsigned char* p) { return *(const LAS bf16x8*)p; }
__device__ __forceinline__ bf16x8 lds_frag8x2(const LAS unsigned char* p) { const v2u lo = *(const LAS v2u*)p, hi = *(const LAS v2u*)(p + 16);
    const v4u w = (v4u){lo.x, lo.y, hi.x, hi.y}; return __builtin_bit_cast(bf16x8, w); }
#define LDS_BARRIER() do { asm volatile("s_waitcnt lgkmcnt(0)" ::: "memory"); __builtin_amdgcn_s_barrier(); asm volatile("" ::: "memory"); } while (0)
constexpr size_t WS_BCS = WS_END, WS_BTT = WS_BCS + (size_t)TP * 1024 * 2, WS_END2 = WS_BTT + (size_t)NBP * 32 * 4 * 128 * 64 * 2;
__device__ __forceinline__ void bc_prep_unit(Frame& F, int b, int c) {
    typedef float f32x2 __attribute__((ext_vector_type(2)));
    int tid_o = F.tid; asm volatile("" : "+v"(tid_o));
    const int tid = tid_o, cg = tid & 127, seg = tid >> 7; unsigned char* ws = F.ws;
    const bf16* src = (const bf16*)(ws + WS_PROJ) + (size_t)S_X2 * SLOT_ELEMS + (size_t)b * SEQ * 1024 + 8 * cg;
    bf16* BCS = (bf16*)(ws + WS_BCS); bf16* BTT = (bf16*)(ws + WS_BTT);
    const float* cw = F.in[10] + 2048 + 8 * cg; const float* cbp = F.in[11] + 2048 + 8 * cg;
#pragma unroll 1
    for (int half = 0; half < 2; ++half) {
        const int s0 = 16 * seg + 8 * half;
        v4u raw[11];
#pragma unroll
        for (int i = 0; i < 11; ++i) { const int gt = 64 * c + s0 - 3 + i; raw[i] = (v4u){0u, 0u, 0u, 0u}; if (gt >= 0) raw[i] = ld_nt16(src + (size_t)gt * 1024); }
        v4u rowpk[8];
#pragma unroll
        for (int kp = 0; kp < 4; ++kp) {
            const f32x2 cw0 = *(const f32x2*)(cw + 2 * kp), cw1 = *(const f32x2*)(cw + 3072 + 2 * kp), cw2 = *(const f32x2*)(cw + 2 * 3072 + 2 * kp), cw3 = *(const f32x2*)(cw + 3 * 3072 + 2 * kp), cbb = *(const f32x2*)(cbp + 2 * kp);
            f32x2 xv[11];
#pragma unroll
            for (int i = 0; i < 11; ++i) { const unsigned wd = raw[i][kp]; xv[i] = (f32x2){__uint_as_float(wd << 16), __uint_as_float(wd & 0xffff0000u)}; }
            f32x2 o[8];
#pragma unroll
            for (int i = 0; i < 8; ++i) { f32x2 a = cw0 * xv[i] + cbb; a = cw1 * xv[i + 1] + a; a = cw2 * xv[i + 2] + a; a = cw3 * xv[i + 3] + a;
                const f32x2 t = a * (-1.4426950408889634f); f32x2 e; e.x = __builtin_amdgcn_exp2f(t.x); e.y = __builtin_amdgcn_exp2f(t.y); e = e + 1.0f;
                f32x2 rc; rc.x = __builtin_amdgcn_rcpf(e.x); rc.y = __builtin_amdgcn_rcpf(e.y); o[i] = a * rc; }
#pragma unroll
            for (int i = 0; i < 8; ++i) rowpk[i][kp] = pk2(o[i].x, o[i].y);
            if (cg < 64) { const int ng = 8 * cg + 2 * kp, g = ng >> 7, n = ng & 127;
                bf16* dst = BTT + ((size_t)(((b * 32 + c) * 4 + g) * 128 + n)) * 64 + s0;
                v4u pa; pa.x = pk2(o[0].x, o[1].x); pa.y = pk2(o[2].x, o[3].x); pa.z = pk2(o[4].x, o[5].x); pa.w = pk2(o[6].x, o[7].x); *(v4u*)dst = pa;
                v4u pb; pb.x = pk2(o[0].y, o[1].y); pb.y = pk2(o[2].y, o[3].y); pb.z = pk2(o[4].y, o[5].y); pb.w = pk2(o[6].y, o[7].y); *(v4u*)(dst + 64) = pb; }
        }
        bf16* drow = BCS + ((size_t)b * SEQ + 64 * c + s0) * 1024 + 8 * cg;
#pragma unroll
        for (int i = 0; i < 8; ++i) *(v4u*)(drow + (size_t)i * 1024) = rowpk[i];
    }
}
__device__ __forceinline__ void bc_prep_phase(Frame& F) { for (int u = F.vcu; u < NBP * 32; u += F.G) bc_prep_unit(F, u >> 5, u & 31); }
constexpr size_t WS_HVT = WS_XB, WS_EGM = WS_END2, WS_EGL = WS_EGM + (size_t)NBP * 64 * 1024 * 4, WS_END3 = WS_EGL + (size_t)NBP * 64 * 1024 * 4;
__device__ __forceinline__ void hg_prep_unit(Frame& F, int b, int c) {
    typedef float f32x2 __attribute__((ext_vector_type(2)));
    int tid_o = F.tid; asm volatile("" : "+v"(tid_o));
    const int tid = tid_o; unsigned char* ws = F.ws;
    const int ch = 2 * tid, hd = ch >> 7, k = ch & 127;
    const size_t row0 = (size_t)b * SEQ + 32 * c;
    bf16* QS = (bf16*)(ws + WS_PROJ) + (size_t)S_Q * SLOT_ELEMS + row0 * 1024 + ch; bf16* FS = (bf16*)(ws + WS_PROJ) + (size_t)S_F * SLOT_ELEMS + row0 * 1024 + ch;
    bf16* IS = (bf16*)(ws + WS_PROJ) + (size_t)S_I * SLOT_ELEMS + row0 * 1024;
    const f32x2 l0 = *(const f32x2*)(F.in[17] + ch), l1 = *(const f32x2*)(F.in[17] + 1024 + ch);
    f32x2 lb; lb.x = __builtin_amdgcn_rcpf(1.0f + __expf(l1.x - l0.x)); lb.y = __builtin_amdgcn_rcpf(1.0f + __expf(l1.y - l0.y));
    const f32x2 omlb = 1.0f - lb;
    f32x2 P[32]; f32x2 run = (f32x2){1.0f, 1.0f};
#pragma unroll
    for (int t = 0; t < 32; ++t) { const unsigned wd = ld_nt4(FS + (size_t)t * 1024);
        f32x2 u = (f32x2){__uint_as_float(wd << 16), __uint_as_float(wd & 0xffff0000u)}; u.x = fminf(fmaxf(u.x, -30.f), 30.f); u.y = fminf(fmaxf(u.y, -30.f), 30.f);
        const f32x2 tt = u * (-1.4426950408889634f); f32x2 e; e.x = __builtin_amdgcn_exp2f(tt.x); e.y = __builtin_amdgcn_exp2f(tt.y); e = e + 1.0f;
        f32x2 sg; sg.x = __builtin_amdgcn_rcpf(e.x); sg.y = __builtin_amdgcn_rcpf(e.y);
        const f32x2 fg = lb + omlb * sg; run = run * fg; run.x = fmaxf(run.x, 1e-30f); run.y = fmaxf(run.y, 1e-30f); P[t] = run; }
    const f32x2 Pm = P[15], Pl = P[31]; f32x2 rPm; rPm.x = __builtin_amdgcn_rcpf(Pm.x); rPm.y = __builtin_amdgcn_rcpf(Pm.y);
    *(f32x2*)((float*)(ws + WS_EGM) + (size_t)(b * 64 + c) * 1024 + ch) = Pm; *(f32x2*)((float*)(ws + WS_EGL) + (size_t)(b * 64 + c) * 1024 + ch) = Pl * rPm;
    unsigned kx[16], ky[16], vx[16], vy[16];
    f32x2 rPprev = (f32x2){1.0f, 1.0f}; f32x2 kprev = (f32x2){0.f, 0.f}; unsigned iprev = 0u;
#pragma unroll
    for (int t = 0; t < 32; ++t) { f32x2 rP; rP.x = __builtin_amdgcn_rcpf(P[t].x); rP.y = __builtin_amdgcn_rcpf(P[t].y);
        const f32x2 e1 = P[t] * rPm, e2 = Pm * rP, fg = P[t] * rPprev, kk = 1.0f - fg; rPprev = rP;
        const unsigned qw = ld_nt4(QS + (size_t)t * 1024); const f32x2 q = (f32x2){__uint_as_float(qw << 16), __uint_as_float(qw & 0xffff0000u)};
        const f32x2 tq = q * (-1.4426950408889634f); f32x2 eq; eq.x = __builtin_amdgcn_exp2f(tq.x); eq.y = __builtin_amdgcn_exp2f(tq.y); eq = eq + 1.0f;
        f32x2 rq; rq.x = __builtin_amdgcn_rcpf(eq.x); rq.y = __builtin_amdgcn_rcpf(eq.y);
        const f32x2 qa = q * rq * e1, ka = kk * e2;
        *(unsigned*)(QS + (size_t)t * 1024) = pk2(qa.x, qa.y); *(unsigned*)(FS + (size_t)t * 1024) = pk2(ka.x, ka.y);
        const unsigned iw = ld_nt4(IS + (size_t)t * 1024 + ch);
        if (t & 1) { kx[t >> 1] = pk2(kprev.x, ka.x); ky[t >> 1] = pk2(kprev.y, ka.y); vx[t >> 1] = (iprev & 0xffffu) | (iw << 16); vy[t >> 1] = (iprev >> 16) | (iw & 0xffff0000u); }
        kprev = ka; iprev = iw; }
    bf16* VTg = (bf16*)(ws + WS_HVT) + ((size_t)((b * 64 + c) * 8 + hd) * 128 + k) * 32;
#pragma unroll
    for (int j = 0; j < 4; ++j) { *(v4u*)(VTg + 8 * j) = (v4u){vx[4 * j], vx[4 * j + 1], vx[4 * j + 2], vx[4 * j + 3]}; *(v4u*)(VTg + 32 + 8 * j) = (v4u){vy[4 * j], vy[4 * j + 1], vy[4 * j + 2], vy[4 * j + 3]}; }
    __syncthreads();
    bf16* KTg = IS + ((size_t)hd * 128 + k) * 32;
#pragma unroll
    for (int j = 0; j < 4; ++j) { *(v4u*)(KTg + 8 * j) = (v4u){kx[4 * j], kx[4 * j + 1], kx[4 * j + 2], kx[4 * j + 3]}; *(v4u*)(KTg + 32 + 8 * j) = (v4u){ky[4 * j], ky[4 * j + 1], ky[4 * j + 2], ky[4 * j + 3]}; }
    __syncthreads();
}
__device__ __forceinline__ void hg_prep_phase(Frame& F) { for (int u = F.vcu; u < NBP * 64; u += F.G) hg_prep_unit(F, u >> 6, u & 63); }
constexpr int HV_QA = 0, HV_KA = 8704, HV_KAT = 17408, HV_VT = 27648, HV_EGM = 30208, HV_EGL = 30720, HV_PBUF = 31232, HV_OB = 2 * HV_PBUF, HV_OBUF = 23040;
constexpr size_t WS_SSQH = WS_END3, WS_END4 = WS_SSQH + (size_t)T * 32 * 4;
__device__ __forceinline__ void hgrn_v_unit(Frame& F, int b, int hd, int vt) {
    int tid_o = F.tid; asm volatile("" : "+v"(tid_o));
    const int tid = tid_o, lane = tid & 63, w = F.wave, r = lane & 31, hh = lane >> 5; unsigned char* ws = F.ws;
    LAS unsigned char* Lb = F.lds + RING_OFF;
    const bf16* PROJ = (const bf16*)(ws + WS_PROJ); bf16* OU = (bf16*)(ws + WS_ON); float* SSQH = (float*)(ws + WS_SSQH);
    const size_t rowb = (size_t)b * SEQ;
    const bf16* qsrc = PROJ + (size_t)S_Q * SLOT_ELEMS + (rowb + (tid >> 4)) * 1024 + hd * 128 + 8 * (tid & 15);
    const bf16* ksrc = PROJ + (size_t)S_F * SLOT_ELEMS + (rowb + (tid >> 4)) * 1024 + hd * 128 + 8 * (tid & 15);
    const bf16* tsrc = PROJ + (size_t)S_I * SLOT_ELEMS + rowb * 1024 + (size_t)(hd * 128 + (tid >> 2)) * 32 + 8 * (tid & 3);
    const unsigned char* xsrc = nullptr; size_t xstr = 0;
    if (tid < 128) { xsrc = (const unsigned char*)((const bf16*)(ws + WS_HVT) + ((size_t)(b * 64 * 8 + hd) * 128 + 32 * vt + (tid >> 2)) * 32 + 8 * (tid & 3)); xstr = (size_t)8 * 128 * 32 * 2; }
    else if (tid < 160) { xsrc = (const unsigned char*)((const float*)(ws + WS_EGM) + (size_t)b * 64 * 1024 + hd * 128 + 4 * (tid - 128)); xstr = 4096; }
    else if (tid < 192) { xsrc = (const unsigned char*)((const float*)(ws + WS_EGL) + (size_t)b * 64 * 1024 + hd * 128 + 4 * (tid - 160)); xstr = 4096; }
    const int xdst = tid < 128 ? HV_VT + (tid >> 2) * 80 + 16 * (tid & 3) : (tid < 160 ? HV_EGM + 16 * (tid - 128) : HV_EGL + 16 * (tid - 160));
#define HGV_LOAD(cc, pq, pk, pt, px) { pq = *(const v4u*)(qsrc + (size_t)(cc) * 32 * 1024); pk = *(const v4u*)(ksrc + (size_t)(cc) * 32 * 1024); pt = *(const v4u*)(tsrc + (size_t)(cc) * 32768); if (tid < 192) px = *(const v4u*)(xsrc + (size_t)(cc) * xstr); }
#define HGV_STORE(pb, pq, pk, pt, px) { *(LAS v4u*)((pb) + HV_QA + (tid >> 4) * 272 + 16 * (tid & 15)) = pq; *(LAS v4u*)((pb) + HV_KA + (tid >> 4) * 272 + 16 * (tid & 15)) = pk; \
        *(LAS v4u*)((pb) + HV_KAT + (tid >> 2) * 80 + 16 * (tid & 3)) = pt; if (tid < 192) *(LAS v4u*)((pb) + xdst) = px; }
    v4u pqA, pkA, ptA, pxA = (v4u){0u, 0u, 0u, 0u}, pqB, pkB, ptB, pxB = (v4u){0u, 0u, 0u, 0u};
    HGV_LOAD(0, pqA, pkA, ptA, pxA) HGV_STORE(Lb, pqA, pkA, ptA, pxA)
    HGV_LOAD(1, pqA, pkA, ptA, pxA) HGV_LOAD(2, pqB, pkB, ptB, pxB)
    const int kt = w;
    v2u ow_pend = (v2u){0u, 0u}; float sq_pend = 0.f;
    f32x16 S;
#pragma unroll
    for (int i = 0; i < 16; ++i) S[i] = 0.f;
    __syncthreads();
#define HGV_ITER(c, pq, pk, pt, px) { \
        int r_l = r, hh_l = hh, tid_l = tid; asm volatile("" : "+v"(r_l), "+v"(hh_l), "+v"(tid_l)); \
        { const int r = r_l, hh = hh_l, tid = tid_l; \
        LAS unsigned char* pbc = Lb + ((c) & 1) * HV_PBUF; LAS unsigned char* pbn = Lb + (((c) + 1) & 1) * HV_PBUF; \
        if ((c) < 63) { HGV_STORE(pbn, pq, pk, pt, px) if ((c) < 61) HGV_LOAD((c) + 3, pq, pk, pt, px) } \
        if (w < 4) { \
            LAS float* EGM = (LAS float*)(pbc + HV_EGM); LAS float* EGL = (LAS float*)(pbc + HV_EGL); LAS float* OB = (LAS float*)(Lb + HV_OB + ((c) & 1) * HV_OBUF); \
            _Pragma("unroll") \
            for (int q4 = 0; q4 < 4; ++q4) { const f32x4 e0 = *(const LAS f32x4*)(EGM + 32 * kt + 8 * q4 + 4 * hh); \
                _Pragma("unroll") \
                for (int j = 0; j < 4; ++j) S[4 * q4 + j] *= e0[j]; } \
            f32x16 o; \
            _Pragma("unroll") \
            for (int i = 0; i < 16; ++i) o[i] = 0.f; \
            const LAS unsigned char* qa_row = pbc + HV_QA + r * 272; \
            o = MFMA32(lds_frag8x2(qa_row + (32 * kt + 4 * hh) * 2), ACC_FRAG(S, 0), o); \
            o = MFMA32(lds_frag8x2(qa_row + (32 * kt + 16 + 4 * hh) * 2), ACC_FRAG(S, 1), o); \
            LAS float* ob = OB + (kt * 32) * 36 + r; \
            _Pragma("unroll") \
            for (int i = 0; i < 16; ++i) ob[((i & 3) + 8 * (i >> 2) + 4 * hh) * 36] = o[i]; \
            const LAS unsigned char* kat_nat = pbc + HV_KAT + (32 * kt + r) * 80 + hh * 16; const LAS unsigned char* vt_nat = pbc + HV_VT + r * 80 + hh * 16; \
            S = MFMA32(lds_frag16(kat_nat), lds_frag16(vt_nat), S); S = MFMA32(lds_frag16(kat_nat + 32), lds_frag16(vt_nat + 32), S); \
            _Pragma("unroll") \
            for (int q4 = 0; q4 < 4; ++q4) { const f32x4 e0 = *(const LAS f32x4*)(EGL + 32 * kt + 8 * q4 + 4 * hh); \
                _Pragma("unroll") \
                for (int j = 0; j < 4; ++j) S[4 * q4 + j] *= e0[j]; } \
        } else { \
            if (w == 4) { LAS float* OB = (LAS float*)(Lb + HV_OB + ((c) & 1) * HV_OBUF); f32x16 o; \
                _Pragma("unroll") \
                for (int i = 0; i < 16; ++i) o[i] = 0.f; \
                f32x16 X; \
                _Pragma("unroll") \
                for (int i = 0; i < 16; ++i) X[i] = 0.f; \
                const LAS unsigned char* ka_nat = pbc + HV_KA + r * 272 + hh * 16; const LAS unsigned char* qa_nat = pbc + HV_QA + r * 272 + hh * 16; \
                _Pragma("unroll 2") \
                for (int ks = 0; ks < 8; ++ks) X = MFMA32(lds_frag16(ka_nat + ks * 32), lds_frag16(qa_nat + ks * 32), X); \
                _Pragma("unroll") \
                for (int i = 0; i < 16; ++i) { const int srow = (i & 3) + 8 * (i >> 2) + 4 * hh; X[i] = (srow <= r) ? X[i] : 0.f; } \
                const LAS unsigned char* vt_row = pbc + HV_VT + r * 80; \
                o = MFMA32(ACC_FRAG(X, 0), lds_frag8x2(vt_row + (4 * hh) * 2), o); \
                o = MFMA32(ACC_FRAG(X, 1), lds_frag8x2(vt_row + (16 + 4 * hh) * 2), o); \
                LAS float* ob4 = OB + (4 * 32) * 36 + r; \
                _Pragma("unroll") \
                for (int i = 0; i < 16; ++i) ob4[((i & 3) + 8 * (i >> 2) + 4 * hh) * 36] = o[i]; \
            } \
            if ((c) > 1) { HGV_FLUSH((c) - 2) } \
            if ((c) > 0) { HGV_OUT((c) - 1) } \
        } \
        LDS_BARRIER(); \
        } }
#define HGV_OUT(cp) { const LAS float* OB = (const LAS float*)(Lb + HV_OB + ((cp) & 1) * HV_OBUF); const int tl = tid - 256, t = tl >> 3, v0 = (tl & 7) * 4; \
            const f32x4 a = *(const LAS f32x4*)(OB + t * 36 + v0), b2 = *(const LAS f32x4*)(OB + (32 + t) * 36 + v0), c2 = *(const LAS f32x4*)(OB + (64 + t) * 36 + v0), d2 = *(const LAS f32x4*)(OB + (96 + t) * 36 + v0), e2 = *(const LAS f32x4*)(OB + (128 + t) * 36 + v0); \
            const f32x4 o4 = ((a + b2) + (c2 + d2)) + e2; \
            float sq = (o4.x * o4.x + o4.y * o4.y) + (o4.z * o4.z + o4.w * o4.w); sq += __shfl_xor(sq, 1); sq += __shfl_xor(sq, 2); sq += __shfl_xor(sq, 4); \
            sq_pend = sq; ow_pend.x = pk2(o4.x, o4.y); ow_pend.y = pk2(o4.z, o4.w); }
#define HGV_FLUSH(cp) { const int tl = tid - 256, t = tl >> 3, v0 = (tl & 7) * 4; const size_t row = rowb + 32 * (cp) + t; \
            if ((tl & 7) == 0) SSQH[row * 32 + hd * 4 + vt] = sq_pend; *(v2u*)(OU + row * 1024 + hd * 128 + 32 * vt + v0) = ow_pend; }
#pragma unroll 1
    for (int cc = 0; cc < 64; cc += 2) { HGV_ITER(cc, pqA, pkA, ptA, pxA) HGV_ITER(cc + 1, pqB, pkB, ptB, pxB) }
    if (w >= 4) { HGV_FLUSH(62) HGV_OUT(63) HGV_FLUSH(63) }
#undef HGV_ITER
#undef HGV_OUT
#undef HGV_FLUSH
#undef HGV_LOAD
#undef HGV_STORE
    if (w < 4) { float* st_g = F.out + O_HGP + (size_t)(b * 8 + hd) * 16384 + 32 * vt + r;
#pragma unroll
        for (int i = 0; i < 16; ++i) { const int k = 32 * kt + (i & 3) + 8 * (i >> 2) + 4 * hh; st_g[(size_t)k * 128] = S[i]; } }
    __syncthreads();
}
__device__ __forceinline__ void hgnorm_phase(Frame& F) {
    const int gw = F.vcu * NWAVES + F.wave, NGW = F.G * NWAVES; bf16* ON = (bf16*)(F.ws + WS_ON); const float* SSQH = (const float*)(F.ws + WS_SSQH);
    const bf16* HG = (const bf16*)(F.ws + WS_PROJ) + (size_t)S_HG * SLOT_ELEMS;
    for (int row = gw; row < TP; row += NGW) {
#pragma unroll
        for (int j = 0; j < 2; ++j) { const int pc = j * 64 + F.lane, hd = pc >> 4;
            const f32x4 sp = *(const f32x4*)(SSQH + (size_t)row * 32 + hd * 4); const float rs = __builtin_amdgcn_rsqf(((sp.x + sp.y) + (sp.z + sp.w)) * (1.0f / 128.0f) + EPS);
            v4u* p = (v4u*)(ON + (size_t)row * 1024) + pc; const v4u o = *p; const v4u g = ld_nt16((const v4u*)(HG + (size_t)row * 1024) + pc); v4u res;
#pragma unroll
            for (int e = 0; e < 4; ++e) res[e] = pk2(bf2f(o[e] & 0xffffu) * rs * silu_f(bf2f(g[e] & 0xffffu)), __uint_as_float(o[e] & 0xffff0000u) * rs * silu_f(__uint_as_float(g[e] & 0xffff0000u)));
            *p = res; }
    }
}
constexpr int SD_BN = 0, SD_CN = 17408, SD_BT = 34816, SD_XT = 53248, SD_HT = 62464, SD_YA = 97280, SD_YY = 113664, SD_YO = 130048, SD_CUM = 134144, SD_DTV = 134400, SD_ECUM = 134656, SD_XWT = 134912, SD_CWL = 144128;
__device__ __forceinline__ void ssd_unit_mfma(Frame& F, int gb, int h) {
    int tid_o = F.tid; asm volatile("" : "+v"(tid_o));
    const int tid = tid_o, lane = tid & 63, w = F.wave, r = lane & 31, hh = lane >> 5; unsigned char* ws = F.ws;
    const int L = SEQ; const size_t row_base = (size_t)gb * SEQ;
    const int g = h >> 3;
    LAS unsigned char* Lb = F.lds + RING_OFF;
    LAS unsigned short* BN = (LAS unsigned short*)(Lb + SD_BN); LAS unsigned short* CN = (LAS unsigned short*)(Lb + SD_CN);
    LAS unsigned short* BT = (LAS unsigned short*)(Lb + SD_BT); LAS unsigned short* XT = (LAS unsigned short*)(Lb + SD_XT);
    LAS unsigned short* HT = (LAS unsigned short*)(Lb + SD_HT);
    LAS unsigned short* XWT = (LAS unsigned short*)(Lb + SD_XWT);
    LAS float* YA = (LAS float*)(Lb + SD_YA); LAS float* YY = (LAS float*)(Lb + SD_YY); LAS unsigned short* YO = (LAS unsigned short*)(Lb + SD_YO);
    LAS float* CUM = (LAS float*)(Lb + SD_CUM); LAS float* DTV = (LAS float*)(Lb + SD_DTV); LAS float* ECUM = (LAS float*)(Lb + SD_ECUM);
    const bf16* PROJ = (const bf16*)(ws + WS_PROJ); const float* DTR = (const float*)(ws + WS_DT); bf16* YG = (bf16*)(ws + WS_YG); float* SSQ = (float*)(ws + WS_SSQSSD);
    const int nt = w >> 1, pt = w & 1;
    f32x16 H;
    float* st_g = F.out + O_SSMP + (size_t)(gb * 32 + h) * 8192 + (size_t)(32 * pt + r) * 128 + 32 * nt + 4 * hh;
#pragma unroll
    for (int i = 0; i < 16; ++i) H[i] = 0.f;
    {
        LAS unsigned short* hp = HT + (32 * pt + r) * 136 + 32 * nt + 4 * hh;
#pragma unroll
        for (int q4 = 0; q4 < 4; ++q4) { v2u pk; pk.x = cvtpk_c(H[4 * q4], H[4 * q4 + 1]); pk.y = cvtpk_c(H[4 * q4 + 2], H[4 * q4 + 3]); *(LAS v2u*)(hp + 8 * q4) = pk; }
    }
    const float a = -__expf(F.in[13][h]), dtb = F.in[12][h], Dk = F.in[14][h];
    const float* cw = F.in[10]; const float* cbp = F.in[11];
    const int cgl = tid & 7, xs = tid >> 3;
    const int col = h * 64 + 8 * cgl;
    const bf16* cptr = PROJ + (size_t)(S_X0 + (col >> 10)) * SLOT_ELEMS + row_base * 1024 + (col & 1023);
    const bf16* BCS = (const bf16*)(ws + WS_BCS) + row_base * 1024 + g * 128; const bf16* BTT = (const bf16*)(ws + WS_BTT) + (size_t)(gb * 32 * 4 + g) * 128 * 64;
    v4u xr[4], pc[6];
#pragma unroll
    for (int i = 0; i < 4; ++i) { const int gt = xs - 3 + i; xr[i] = (v4u){0u, 0u, 0u, 0u}; if (gt >= 0) xr[i] = *(const v4u*)(cptr + (size_t)gt * 1024); }
#pragma unroll
    for (int j = 0; j < 6; ++j) { const int idx = (tid + 512 * j) & 1023;
        if (j < 4) pc[j] = *(const v4u*)(BCS + (size_t)(idx >> 4) * 1024 + (j >> 1) * 512 + 8 * (idx & 15));
        else pc[j] = *(const v4u*)(BTT + (size_t)(idx >> 3) * 64 + 8 * (idx & 7)); }
    LAS float* CWL = (LAS float*)(Lb + SD_CWL);
    if (tid < 320) { const int j = tid >> 6, c = tid & 63; CWL[tid] = j < 4 ? cw[j * 3072 + h * 64 + c] : cbp[h * 64 + c]; }
    __syncthreads();
    v4u ow_pend = (v4u){0u, 0u, 0u, 0u}; float sq_pend = 0.f; bool pend = false;
    int buf = 0;
    float dt_pf = 0.f;
    if (lane < L) dt_pf = DTR[(row_base + lane) * 32 + h];
    for (int t0 = 0; t0 < L; t0 += 64, buf ^= 1) {
        int r_l = r, hh_l = hh, tid_l = tid, lane_l = lane;
        asm volatile("" : "+v"(r_l), "+v"(hh_l), "+v"(tid_l), "+v"(lane_l));
        { const int r = r_l, hh = hh_l, tid = tid_l, lane = lane_l;
        float dtv = 0.f;
        if (t0 + lane < L) { const float x = dt_pf + dtb; dtv = fmaxf(x, 0.f) + 0.6931471805599453f * __builtin_amdgcn_logf(1.0f + __builtin_amdgcn_exp2f(-1.4426950408889634f * fabsf(x))); }
        dt_pf = 0.f; if (t0 + 64 + lane < L) dt_pf = DTR[(row_base + t0 + 64 + lane) * 32 + h];
        v4u zw = (v4u){0u, 0u, 0u, 0u};
        if (t0 + (tid >> 3) < L) zw = ld_nt16(PROJ + (size_t)(S_Z0 + (h >> 4)) * SLOT_ELEMS + (row_base + t0 + (tid >> 3)) * 1024 + (h & 15) * 64 + (tid & 7) * 8);
        float cum = dtv * a;
#pragma unroll
        for (int o = 1; o < 64; o <<= 1) { const float u = __shfl_up(cum, o); if (lane >= o) cum += u; }
        const float cum_last = __shfl(cum, 63);
        const float wgt = __expf(cum_last - cum) * dtv;
        if (w == 0) { CUM[lane] = cum; DTV[lane] = dtv; ECUM[lane] = __expf(cum); }
#pragma unroll
        for (int j = 0; j < 6; ++j) { const int idx = (tid + 512 * j) & 1023;
            if (j < 2) *(LAS v4u*)(BN + (idx >> 4) * 136 + 8 * (idx & 15)) = pc[j];
            else if (j < 4) *(LAS v4u*)(CN + (idx >> 4) * 136 + 8 * (idx & 15)) = pc[j];
            else *(LAS v4u*)(BT + (idx >> 3) * 72 + 8 * (idx & 7)) = pc[j]; }
        if (pend) { const size_t prow = row_base + (t0 - 64) + (tid >> 3);
            *(v4u*)(YG + prow * 2048 + h * 64 + (tid & 7) * 8) = ow_pend; if ((tid & 7) == 0) SSQ[prow * 32 + h] = sq_pend; pend = false; }
        { const int xs = tid >> 3, cgl = tid & 7; const float wx = __shfl(wgt, xs); typedef float f32x2 __attribute__((ext_vector_type(2)));
#pragma unroll
          for (int kp = 0; kp < 4; ++kp) {
              const LAS float* wl = CWL + 8 * cgl + 2 * kp;
              const f32x2 cw0 = *(const LAS f32x2*)wl, cw1 = *(const LAS f32x2*)(wl + 64), cw2 = *(const LAS f32x2*)(wl + 128), cw3 = *(const LAS f32x2*)(wl + 192), cbb = *(const LAS f32x2*)(wl + 256);
              f32x2 xv[4];
#pragma unroll
              for (int i = 0; i < 4; ++i) { const unsigned wd = xr[i][kp]; xv[i] = (f32x2){__uint_as_float(wd << 16), __uint_as_float(wd & 0xffff0000u)}; }
              f32x2 a = cw0 * xv[0] + cbb; a = cw1 * xv[1] + a; a = cw2 * xv[2] + a; a = cw3 * xv[3] + a;
              const f32x2 t = a * (-1.4426950408889634f); f32x2 e; e.x = __builtin_amdgcn_exp2f(t.x); e.y = __builtin_amdgcn_exp2f(t.y); e = e + 1.0f;
              f32x2 rc; rc.x = __builtin_amdgcn_rcpf(e.x); rc.y = __builtin_amdgcn_rcpf(e.y); const f32x2 o = a * rc, ow = o * wx;
              const unsigned po = pk2(o.x, o.y), pw = pk2(ow.x, ow.y); const int p = 8 * cgl + 2 * kp;
              XT[p * 72 + xs] = (unsigned short)(po & 0xffffu); XT[(p + 1) * 72 + xs] = (unsigned short)(po >> 16);
              XWT[p * 72 + xs] = (unsigned short)(pw & 0xffffu); XWT[(p + 1) * 72 + xs] = (unsigned short)(pw >> 16); }
        }
        if (t0 + 64 < L) {
#pragma unroll
            for (int i = 0; i < 4; ++i) xr[i] = ld_nt16(cptr + (size_t)(t0 + 64 + (tid >> 3) - 3 + i) * 1024);
            const int chn = (t0 >> 6) + 1;
#pragma unroll
            for (int j = 0; j < 6; ++j) { const int idx = (tid + 512 * j) & 1023;
                if (j < 4) pc[j] = *(const v4u*)(BCS + (size_t)(t0 + 64 + (idx >> 4)) * 1024 + (j >> 1) * 512 + 8 * (idx & 15));
                else pc[j] = *(const v4u*)(BTT + ((size_t)chn * 4 * 128 + (idx >> 3)) * 64 + 8 * (idx & 7)); }
        }
        LDS_BARRIER();
        if (w < 4 || w >= 6) {
            const int tt = w < 4 ? (w >> 1) : 1, st = w < 4 ? tt : 0, ptj = w & 1;
            f32x16 X, ya;
#pragma unroll
            for (int i = 0; i < 16; ++i) { X[i] = 0.f; ya[i] = 0.f; }
            const LAS unsigned char* cn_nat = Lb + SD_CN + (32 * tt + r) * 272 + hh * 16; const LAS unsigned char* bn_nat = Lb + SD_BN + (32 * st + r) * 272 + hh * 16;
#pragma unroll 2
            for (int ks = 0; ks < 8; ++ks) X = MFMA32(lds_frag16(bn_nat + ks * 32), lds_frag16(cn_nat + ks * 32), X);
            const float cum_t = CUM[32 * tt + r];
#pragma unroll
            for (int q4 = 0; q4 < 4; ++q4) { const f32x4 cs = *(const LAS f32x4*)(CUM + 32 * st + 8 * q4 + 4 * hh), ds = *(const LAS f32x4*)(DTV + 32 * st + 8 * q4 + 4 * hh);
#pragma unroll
                for (int jj = 0; jj < 4; ++jj) { const int s_abs = 32 * st + 8 * q4 + 4 * hh + jj; const float f = __expf(fminf(cum_t - cs[jj], 0.f)) * ds[jj]; X[4 * q4 + jj] = (s_abs <= 32 * tt + r) ? X[4 * q4 + jj] * f : 0.f; } }
            const LAS unsigned char* xt_row = Lb + SD_XT + (32 * ptj + r) * 144 + (32 * st + 4 * hh) * 2;
            ya = MFMA32(ACC_FRAG(X, 0), lds_frag8x2(xt_row), ya);
            ya = MFMA32(ACC_FRAG(X, 1), lds_frag8x2(xt_row + 32), ya);
            if (w < 4) { LAS float* yb = YA + (32 * tt + 4 * hh) * 64 + 32 * ptj + r;
#pragma unroll
                for (int i = 0; i < 16; ++i) yb[((i & 3) + 8 * (i >> 2)) * 64] = ya[i]; }
            else { LAS unsigned short* yb = YO + (4 * hh) * 64 + 32 * ptj + r;
#pragma unroll
                for (int i = 0; i < 16; ++i) yb[((i & 3) + 8 * (i >> 2)) * 64] = (unsigned short)f2bf(ya[i]); }
        } else {
            const int ptj = w & 1;
            const LAS unsigned char* ht_nat = Lb + SD_HT + buf * 17408 + (32 * ptj + r) * 272 + hh * 16;
#pragma unroll 1
            for (int tt = 0; tt < 2; ++tt) {
                f32x16 yi;
#pragma unroll
                for (int i = 0; i < 16; ++i) yi[i] = 0.f;
                const LAS unsigned char* cn_nat = Lb + SD_CN + (32 * tt + r) * 272 + hh * 16;
#pragma unroll 2
                for (int ks = 0; ks < 8; ++ks) yi = MFMA32(lds_frag16(cn_nat + ks * 32), lds_frag16(ht_nat + ks * 32), yi);
                const LAS unsigned short* xt_p = XT + (32 * ptj + r) * 72 + 32 * tt + 4 * hh;
#pragma unroll
                for (int q4 = 0; q4 < 4; ++q4) { const f32x4 ec = *(const LAS f32x4*)(ECUM + 32 * tt + 8 * q4 + 4 * hh); const v2u xw = *(const LAS v2u*)(xt_p + 8 * q4);
                    const float x0 = bf2f(xw.x & 0xffffu), x1 = bf2f(xw.x >> 16), x2 = bf2f(xw.y & 0xffffu), x3 = bf2f(xw.y >> 16);
                    LAS float* yb = YY + (32 * tt + 8 * q4 + 4 * hh) * 64 + 32 * ptj + r;
                    yb[0] = ec[0] * yi[4 * q4] + Dk * x0; yb[64] = ec[1] * yi[4 * q4 + 1] + Dk * x1; yb[128] = ec[2] * yi[4 * q4 + 2] + Dk * x2; yb[192] = ec[3] * yi[4 * q4 + 3] + Dk * x3; }
            }
        }
        {
            const float el = __expf(CUM[63]);
#pragma unroll
            for (int i = 0; i < 16; ++i) H[i] *= el;
            const LAS unsigned char* bt_nat = Lb + SD_BT + (32 * nt + r) * 144 + hh * 16; const LAS unsigned char* xt_nat = Lb + SD_XWT + (32 * pt + r) * 144 + hh * 16;
#pragma unroll
            for (int s2 = 0; s2 < 4; ++s2) H = MFMA32(lds_frag16(bt_nat + s2 * 32), lds_frag16(xt_nat + s2 * 32), H);
            LAS unsigned short* hp = HT + (buf ^ 1) * 8704 + (32 * pt + r) * 136 + 32 * nt + 4 * hh;
#pragma unroll
            for (int q4 = 0; q4 < 4; ++q4) { v2u pk; pk.x = cvtpk_c(H[4 * q4], H[4 * q4 + 1]); pk.y = cvtpk_c(H[4 * q4 + 2], H[4 * q4 + 3]); *(LAS v2u*)(hp + 8 * q4) = pk; }
        }
        LDS_BARRIER();
        { const int tt = tid >> 3, p0 = (tid & 7) * 8;
          if (t0 + tt < L) { const size_t row = row_base + t0 + tt;
            f32x4 y0 = *(const LAS f32x4*)(YA + tt * 64 + p0) + *(const LAS f32x4*)(YY + tt * 64 + p0), y1 = *(const LAS f32x4*)(YA + tt * 64 + p0 + 4) + *(const LAS f32x4*)(YY + tt * 64 + p0 + 4);
            if (tt >= 32) { const v4u ow4 = *(const LAS v4u*)(YO + (tt - 32) * 64 + p0);
                y0 = y0 + (f32x4){bf2f(ow4.x & 0xffffu), __uint_as_float(ow4.x & 0xffff0000u), bf2f(ow4.y & 0xffffu), __uint_as_float(ow4.y & 0xffff0000u)};
                y1 = y1 + (f32x4){bf2f(ow4.z & 0xffffu), __uint_as_float(ow4.z & 0xffff0000u), bf2f(ow4.w & 0xffffu), __uint_as_float(ow4.w & 0xffff0000u)}; }
            float o[8]; float sq = 0.f;
#pragma unroll
            for (int j = 0; j < 8; ++j) { const unsigned z16 = (zw[j >> 1] >> ((j & 1) * 16)) & 0xffffu; const float yv = (j < 4 ? y0[j & 3] : y1[j & 3]) * silu_f(bf2f(z16)); o[j] = yv; sq += yv * yv; }
            ow_pend.x = pk2(o[0], o[1]); ow_pend.y = pk2(o[2], o[3]); ow_pend.z = pk2(o[4], o[5]); ow_pend.w = pk2(o[6], o[7]);
            sq += __shfl_xor(sq, 1); sq += __shfl_xor(sq, 2); sq += __shfl_xor(sq, 4); sq_pend = sq; pend = true; } }
        }
    }
    if (pend) { const size_t prow = row_base + (L - 64) + (tid >> 3); *(v4u*)(YG + prow * 2048 + h * 64 + (tid & 7) * 8) = ow_pend; if ((tid & 7) == 0) SSQ[prow * 32 + h] = sq_pend; }
#pragma unroll
    for (int q4 = 0; q4 < 4; ++q4) *(f32x4*)(st_g + 8 * q4) = (f32x4){H[4 * q4], H[4 * q4 + 1], H[4 * q4 + 2], H[4 * q4 + 3]};
    __syncthreads();
}
__device__ __forceinline__ float tr_reduce32(const float (&v)[32], int lane) {
    const bool b4 = lane & 16, b3 = lane & 8, b2 = lane & 4, b1 = lane & 2, b0 = lane & 1;
    float a[16], b[8], c[4], d[2];
#pragma unroll
    for (int i = 0; i < 16; ++i) { const float keep = b4 ? v[i + 16] : v[i], send = b4 ? v[i] : v[i + 16]; a[i] = keep + __shfl_xor(send, 16); }
#pragma unroll
    for (int i = 0; i < 8; ++i) { const float keep = b3 ? a[i + 8] : a[i], send = b3 ? a[i] : a[i + 8]; b[i] = keep + __shfl_xor(send, 8); }
#pragma unroll
    for (int i = 0; i < 4; ++i) { const float keep = b2 ? b[i + 4] : b[i], send = b2 ? b[i] : b[i + 4]; c[i] = keep + __shfl_xor(send, 4); }
#pragma unroll
    for (int i = 0; i < 2; ++i) { const float keep = b1 ? c[i + 2] : c[i], send = b1 ? c[i] : c[i + 2]; d[i] = keep + __shfl_xor(send, 2); }
    const float keep = b0 ? d[1] : d[0], send = b0 ? d[0] : d[1];
    return keep + __shfl_xor(send, 1);
}
__device__ __forceinline__ void ssd_sample_unit(Frame& F, int sb, int g) {
    int tid_o = F.tid; asm volatile("" : "+v"(tid_o));
    const int tid = tid_o, lane = tid & 63, w = F.wave, hh = lane >> 5, nq = lane & 31; unsigned char* ws = F.ws;
    LAS float* XC = (LAS float*)(F.lds + RING_OFF); LAS float* BC = XC + 8 * 4 * 64; LAS float* CC = BC + 4 * 128; LAS float* DTS = CC + 4 * 128;
    const bf16* PROJ = (const bf16*)(ws + WS_PROJ); const float* DTR = (const float*)(ws + WS_DT); bf16* YG = (bf16*)(ws + WS_YG); float* SSQ = (float*)(ws + WS_SSQSSD);
    const size_t row0 = (size_t)TP + (size_t)sb * LS;
    const int h = 8 * g + w;
    const float* sp = F.in[3] + (size_t)(sb * 32 + h) * 8192 + (size_t)hh * 128 + 4 * nq;
    f32x4 hst[32];
#pragma unroll
    for (int i = 0; i < 32; ++i) hst[i] = ld_nt(sp + (size_t)i * 256);
    if (tid < 384) { typedef float f32x2 __attribute__((ext_vector_type(2)));
        const int col = tid < 256 ? g * 512 + 2 * tid : (tid < 320 ? 2048 + g * 128 + 2 * (tid - 256) : 2560 + g * 128 + 2 * (tid - 320));
        const float* cw = F.in[10]; const float* sc = F.in[4] + (size_t)sb * 3 * 3072 + col;
        const f32x2 w0 = *(const f32x2*)(cw + col), w1 = *(const f32x2*)(cw + 3072 + col), w2 = *(const f32x2*)(cw + 2 * 3072 + col), w3 = *(const f32x2*)(cw + 3 * 3072 + col), cb = *(const f32x2*)(F.in[11] + col);
        f32x2 full[7]; full[0] = *(const f32x2*)sc; full[1] = *(const f32x2*)(sc + 3072); full[2] = *(const f32x2*)(sc + 2 * 3072);
        const bf16* cp = PROJ + (size_t)(S_X0 + (col >> 10)) * SLOT_ELEMS + row0 * 1024 + (col & 1023);
#pragma unroll
        for (int t = 0; t < 4; ++t) { const unsigned wd = *(const unsigned*)(cp + (size_t)t * 1024); full[3 + t] = (f32x2){__uint_as_float(wd << 16), __uint_as_float(wd & 0xffff0000u)}; }
#pragma unroll
        for (int t = 0; t < 4; ++t) { f32x2 a = w0 * full[t] + cb; a = w1 * full[t + 1] + a; a = w2 * full[t + 2] + a; a = w3 * full[t + 3] + a;
            f32x2 o; o.x = silu_f(a.x); o.y = silu_f(a.y);
            LAS float* dst = tid < 256 ? XC + ((tid >> 5) * 4 + t) * 64 + 2 * (tid & 31) : (tid < 320 ? BC + t * 128 + 2 * (tid - 256) : CC + t * 128 + 2 * (tid - 320));
            *(LAS f32x2*)dst = o; }
    } else if (tid < 416) { const int idx = tid - 384, hl = idx >> 2, t = idx & 3; const float x = DTR[(row0 + t) * 32 + 8 * g + hl] + F.in[12][8 * g + hl]; DTS[idx] = x > 20.f ? x : log1pf(__expf(x)); }
    __syncthreads();
    const float a = -__expf(F.in[13][h]), Dk = F.in[14][h];
#pragma unroll 1
    for (int t = 0; t < 4; ++t) {
        const float dtv = DTS[w * 4 + t], dA = __expf(dtv * a);
        const f32x4 Bv = *(const LAS f32x4*)(BC + t * 128 + 4 * nq), Cv = *(const LAS f32x4*)(CC + t * 128 + 4 * nq);
        const LAS float* xrow = XC + (w * 4 + t) * 64;
        float part[32];
#pragma unroll
        for (int i = 0; i < 32; ++i) { const float xd = xrow[2 * i + hh] * dtv; hst[i] = hst[i] * dA + Bv * xd; part[i] = (hst[i].x * Cv.x + hst[i].y * Cv.y) + (hst[i].z * Cv.z + hst[i].w * Cv.w); }
        float yv = tr_reduce32(part, lane);
        const int p = 2 * nq + hh; const size_t row = row0 + t;
        yv += Dk * xrow[p];
        const float z = bf2f(PROJ[(size_t)(S_Z0 + (h >> 4)) * SLOT_ELEMS + row * 1024 + (h & 15) * 64 + p]);
        const float yg = yv * silu_f(z);
        YG[row * 2048 + h * 64 + p] = (bf16)f2bf(yg);
        const float sq = wave_sum(yg * yg);
        if (lane == 0) SSQ[row * 32 + h] = sq;
    }
    float* so = F.out + O_SSMS + (size_t)(sb * 32 + h) * 8192 + (size_t)hh * 128 + 4 * nq;
#pragma unroll
    for (int i = 0; i < 32; ++i) st_nt(so + (size_t)i * 256, hst[i]);
    __syncthreads();
}
__device__ __forceinline__ void hgrn_sample_unit(Frame& F, int sb, int hq) {
    int tid_o = F.tid; asm volatile("" : "+v"(tid_o));
    const int tid = tid_o, lane = tid & 63, w = F.wave, hh = lane >> 5, vq = lane & 31; unsigned char* ws = F.ws;
    LAS float* FS = (LAS float*)(F.lds + RING_OFF); LAS float* KS = FS + 2048; LAS float* QS = KS + 2048; LAS float* VS = QS + 2048; LAS float* OP = VS + 2048;
    const bf16* PROJ = (const bf16*)(ws + WS_PROJ); bf16* ON = (bf16*)(ws + WS_ON);
    const size_t row0 = (size_t)TP + (size_t)sb * LS;
    const int hl = w >> 1, kh = w & 1, hd = 4 * hq + hl;
    const float* sp = F.in[5] + (size_t)(sb * 8 + hd) * 16384 + (size_t)(64 * kh + hh) * 128 + 4 * vq;
    f32x4 S[32];
#pragma unroll
    for (int i = 0; i < 32; ++i) S[i] = ld_nt(sp + (size_t)i * 256);
    { const int ch = hq * 512 + tid; const float lb = __builtin_amdgcn_rcpf(1.0f + __expf(F.in[17][1024 + ch] - F.in[17][ch]));
      const bf16* fp = PROJ + (size_t)S_F * SLOT_ELEMS + row0 * 1024 + ch; const bf16* qp = PROJ + (size_t)S_Q * SLOT_ELEMS + row0 * 1024 + ch; const bf16* ip = PROJ + (size_t)S_I * SLOT_ELEMS + row0 * 1024 + ch;
#pragma unroll
      for (int t = 0; t < 4; ++t) { const float u = fminf(fmaxf(bf2f(fp[(size_t)t * 1024]), -30.f), 30.f); const float fg = lb + (1.0f - lb) * sigmoid_f(u);
          const int o = ((tid >> 7) * 4 + t) * 128 + (tid & 127);
          FS[o] = fg; KS[o] = 1.0f - fg; QS[o] = silu_f(bf2f(qp[(size_t)t * 1024])); VS[o] = bf2f(ip[(size_t)t * 1024]); } }
    __syncthreads();
#pragma unroll 1
    for (int t = 0; t < 4; ++t) {
        const int o = (hl * 4 + t) * 128;
        const f32x4 vv = *(const LAS f32x4*)(VS + o + 4 * vq);
        f32x4 oa = (f32x4){0.f, 0.f, 0.f, 0.f};
#pragma unroll
        for (int i = 0; i < 32; ++i) { const int k = 64 * kh + 2 * i + hh; const float fk = FS[o + k], kv = KS[o + k], qk = QS[o + k]; S[i] = S[i] * fk + vv * kv; oa = oa + S[i] * qk; }
        oa.x += __shfl_xor(oa.x, 32); oa.y += __shfl_xor(oa.y, 32); oa.z += __shfl_xor(oa.z, 32); oa.w += __shfl_xor(oa.w, 32);
        if (hh == 0) *(LAS f32x4*)(OP + ((hl * 4 + t) * 2 + kh) * 128 + 4 * vq) = oa;
    }
    float* so = F.out + O_HGS + (size_t)(sb * 8 + hd) * 16384 + (size_t)(64 * kh + hh) * 128 + 4 * vq;
#pragma unroll
    for (int i = 0; i < 32; ++i) st_nt(so + (size_t)i * 256, S[i]);
    __syncthreads();
#pragma unroll
    for (int rr2 = 0; rr2 < 2; ++rr2) { const int rr = 2 * w + rr2, ohl = rr >> 2, t = rr & 3, ohd = 4 * hq + ohl; typedef float f32x2 __attribute__((ext_vector_type(2)));
        const f32x2 p0 = *(const LAS f32x2*)(OP + (rr * 2) * 128 + 2 * lane), p1 = *(const LAS f32x2*)(OP + (rr * 2 + 1) * 128 + 2 * lane);
        const float o0 = p0.x + p1.x, o1 = p0.y + p1.y; const float sq = wave_sum(o0 * o0 + o1 * o1); const float rs = __builtin_amdgcn_rsqf(sq * (1.0f / 128.0f) + EPS);
        const size_t row = row0 + t; const unsigned gw = *(const unsigned*)(PROJ + (size_t)S_HG * SLOT_ELEMS + row * 1024 + ohd * 128 + 2 * lane);
        *(unsigned*)(ON + row * 1024 + ohd * 128 + 2 * lane) = pk2(o0 * rs * silu_f(bf2f(gw & 0xffffu)), o1 * rs * silu_f(__uint_as_float(gw & 0xffff0000u))); }
    __syncthreads();
}
constexpr int U_HGS = NBS * 2, U_SSDS = NBS * 4, U_CONV = NBP + NBS;
__device__ __forceinline__ void scan_phase(Frame& F) {
    gu32* head = F.ctl + CW_QUEUE;
    const int xcc = (int)(xb_xcc_id() & 7u);
#define SCAN_QUEUE(qi, count, body) for (;;) { if (F.tid == 0) F.MISC[0] = __hip_atomic_fetch_add(head + 64 * (qi), 1u, RLX_AGENT); __syncthreads(); const int u = (int)F.MISC[0]; __syncthreads(); if (u >= (count)) break; body }
#pragma unroll 1
    for (int pass = 0; pass < 8; ++pass) { const int bb = (xcc + pass) & 7; SCAN_QUEUE(4 + bb, 32, ssd_unit_mfma(F, bb, u);) }
#pragma unroll 1
    for (int pass = 0; pass < 8; ++pass) { const int bb = (xcc + pass) & 7; SCAN_QUEUE(12 + bb, 32, hgrn_v_unit(F, bb, u >> 2, u & 3);) }
    SCAN_QUEUE(2, U_HGS, hgrn_sample_unit(F, u >> 1, u & 1);)
    SCAN_QUEUE(3, U_SSDS + U_CONV, if (u >= U_SSDS) { conv_copy_unit(F, u - U_SSDS); continue; } ssd_sample_unit(F, u >> 2, u & 3);)
#undef SCAN_QUEUE
}
typedef float f32x4s __attribute__((ext_vector_type(4)));
template <class Epi> __device__ __forceinline__ void small_tile_phase(Frame& F, const bf16* A, const bf16* Bt, int K, const Epi& E) {
    const int lane = F.lane, w = F.wave, r = lane & 31, hh = lane >> 5;
#pragma unroll 1
    for (int v = F.vcu; v < 256; v += F.G) {
    const int mt = v >> 4, nt = v & 15;
    const int kw = K >> 3;
    const bf16* ap = A + (size_t)(TP + 32 * mt + r) * K + w * kw + 8 * hh;
    const bf16* bp = Bt + (size_t)(64 * nt + r) * K + w * kw + 8 * hh;
    f32x16 acc0, acc1;
#pragma unroll
    for (int i = 0; i < 16; ++i) { acc0[i] = 0.f; acc1[i] = 0.f; }
#pragma unroll 4
    for (int ks = 0; ks < kw / 16; ++ks) { const bf16x8 af = *(const bf16x8*)(ap + 16 * ks), b0 = *(const bf16x8*)(bp + 16 * ks), b1 = *(const bf16x8*)(bp + (size_t)32 * K + 16 * ks);
        acc0 = MFMA32(b0, af, acc0); acc1 = MFMA32(b1, af, acc1); }
    LAS float* part = (LAS float*)(F.lds + RING_OFF) + w * 2048;
#pragma unroll
    for (int q4 = 0; q4 < 4; ++q4) { *(LAS f32x4*)(part + r * 64 + 8 * q4 + 4 * hh) = (f32x4){acc0[4 * q4], acc0[4 * q4 + 1], acc0[4 * q4 + 2], acc0[4 * q4 + 3]};
        *(LAS f32x4*)(part + r * 64 + 32 + 8 * q4 + 4 * hh) = (f32x4){acc1[4 * q4], acc1[4 * q4 + 1], acc1[4 * q4 + 2], acc1[4 * q4 + 3]}; }
    __syncthreads();
    const int rl = F.tid >> 4, c4 = (F.tid & 15) * 4; const LAS float* src = (const LAS float*)(F.lds + RING_OFF) + rl * 64 + c4;
    f32x4 sum = *(const LAS f32x4*)src;
#pragma unroll
    for (int ww = 1; ww < 8; ++ww) sum = sum + *(const LAS f32x4*)(src + ww * 2048);
    const f32x4s acc = (f32x4s){sum.x, sum.y, sum.z, sum.w};
    E.small(F, acc, TP + 32 * mt + rl, 64 * nt + c4, nt);
    __syncthreads();
    }
}
template <bool ADD> struct SmGate { bf16* O; const bf16* gate;
    __device__ __forceinline__ void small(Frame&, const f32x4s& a, int row, int col, int) const { const size_t off = (size_t)row * 1024 + col;
        const v2u gw = __builtin_nontemporal_load((const v2u*)(gate + off)); v2u ow = (v2u){0u, 0u}; if (ADD) ow = *(const v2u*)(O + off);
        float rr[4];
#pragma unroll
        for (int e = 0; e < 4; ++e) { const unsigned g16 = (gw[e >> 1] >> ((e & 1) * 16)) & 0xffffu, o16 = (ow[e >> 1] >> ((e & 1) * 16)) & 0xffffu; rr[e] = (ADD ? bf2f(o16) : 0.f) + sigmoid_f(bf2f(g16)) * a[e]; }
        v2u wv; wv.x = cvtpk_c(rr[0], rr[1]); wv.y = cvtpk_c(rr[2], rr[3]); *(v2u*)(O + off) = wv; } };
template <bool BF> struct SmRes { const float* base; bf16* hb; float* ssqp;
    __device__ __forceinline__ void small(Frame& F, const f32x4s& a, int row, int col, int nt) const { const size_t off = (size_t)row * 1024 + col; f32x4 b;
        if (BF) { const v2u w = *(const v2u*)(hb + off); b = (f32x4){bf2f(w.x & 0xffffu), __uint_as_float(w.x & 0xffff0000u), bf2f(w.y & 0xffffu), __uint_as_float(w.y & 0xffff0000u)}; }
        else b = *(const f32x4*)(base + off);
        const f32x4 v = b + (f32x4){a[0], a[1], a[2], a[3]};
        { v2u wv; wv.x = cvtpk_c(v[0], v[1]); wv.y = cvtpk_c(v[2], v[3]); *(v2u*)(hb + off) = wv; }
        float sq = (v[0] * v[0] + v[1] * v[1]) + (v[2] * v[2] + v[3] * v[3]); sq += __shfl_xor(sq, 1); sq += __shfl_xor(sq, 2); sq += __shfl_xor(sq, 4); sq += __shfl_xor(sq, 8);
        if ((F.tid & 15) == 0) ssqp[(size_t)row * 16 + nt] = sq; } };
struct SmScale { bf16* O; const float* ssq; float scale;
    __device__ __forceinline__ void small(Frame&, const f32x4s& a, int row, int col, int) const { const float rs = pg8::row_rs<16>(ssq, row) * scale;
        v2u wv; wv.x = cvtpk_c(a[0] * rs, a[1] * rs); wv.y = cvtpk_c(a[2] * rs, a[3] * rs); *(v2u*)(O + (size_t)row * 1024 + col) = wv; } };
__device__ __forceinline__ void attn_stage_tile(LAS unsigned char* Lb, const bf16* src, size_t pitch, int tid) {
#pragma unroll 1
    for (int hb = 0; hb < 2; ++hb) { v4u v[8];
#pragma unroll
        for (int i = 0; i < 8; ++i) { const int id = tid + 512 * (8 * hb + i), row = id >> 5, c = id & 31; v[i] = *(const v4u*)(src + (size_t)row * pitch + c * 8); }
#pragma unroll
        for (int i = 0; i < 8; ++i) { const int id = tid + 512 * (8 * hb + i), row = id >> 5, c = id & 31; *(LAS v4u*)(Lb + row * 512 + ((c ^ (row & 15)) << 4)) = v[i]; } }
}
__device__ __forceinline__ void attn_prompt_unit(Frame& F, int b, int hd, int qb) {
    const int tid = F.tid, lane = F.lane, w = F.wave, r = lane & 31, hh = lane >> 5; unsigned char* ws = F.ws;
    LAS unsigned char* Lb = F.lds + RING_OFF;
    const bf16* QB = (const bf16*)(ws + WS_QB); const bf16* KB = (const bf16*)(ws + WS_KB); const bf16* VT = (const bf16*)(ws + WS_VT); bf16* OB = (bf16*)(ws + WS_OB);
    const size_t qrow = (size_t)b * SEQ + (size_t)qb * 256 + 32 * w + r;
    attn_stage_tile(Lb, KB + (size_t)b * 256 * 1024 + hd * 256, 1024, tid);
    const bf16* qp = QB + qrow * 1024 + hd * 256 + 8 * hh;
    bf16x8 qf = *(const bf16x8*)qp;
    __syncthreads();
    f32x16 S[8];
#pragma unroll
    for (int t = 0; t < 8; ++t)
#pragma unroll
        for (int i = 0; i < 16; ++i) S[t][i] = 0.f;
    const int sw = r & 15;
#pragma unroll 1
    for (int ks = 0; ks < 16; ++ks) {
        const bf16x8 qn = *(const bf16x8*)(qp + 16 * (ks < 15 ? ks + 1 : ks));
        const LAS unsigned char* kp = Lb + r * 512 + (((2 * ks + hh) ^ sw) << 4);
#pragma unroll
        for (int t = 0; t < 8; ++t) S[t] = MFMA32(lds_frag16(kp + t * 32 * 512), qf, S[t]);
        qf = qn;
    }
    float m = -3.0e38f;
#pragma unroll
    for (int t = 0; t < 8; ++t)
#pragma unroll
        for (int i = 0; i < 16; ++i) m = fmaxf(m, S[t][i]);
    m = fmaxf(m, __shfl_xor(m, 32));
    float l = 0.f;
#pragma unroll
    for (int t = 0; t < 8; ++t)
#pragma unroll
        for (int i = 0; i < 16; ++i) { const float pv = __builtin_amdgcn_exp2f(S[t][i] - m); S[t][i] = pv; l += pv; }
    l += __shfl_xor(l, 32);
    const float rl = __builtin_amdgcn_rcpf(l);
    bf16x8 pf[8][2];
#pragma unroll
    for (int t = 0; t < 8; ++t) { pf[t][0] = ACC_FRAG(S[t], 0); pf[t][1] = ACC_FRAG(S[t], 1); }
    __syncthreads();
    attn_stage_tile(Lb, VT + (size_t)(b * 4 + hd) * 256 * 256, 256, tid);
    __syncthreads();
    bf16* op = OB + qrow * 1024 + hd * 256 + 4 * hh;
#pragma unroll 1
    for (int dt = 0; dt < 8; ++dt) {
        f32x16 O;
#pragma unroll
        for (int i = 0; i < 16; ++i) O[i] = 0.f;
        const LAS unsigned char* vrow = Lb + (32 * dt + r) * 512 + 8 * hh;
#pragma unroll
        for (int t = 0; t < 8; ++t)
#pragma unroll
            for (int s2 = 0; s2 < 2; ++s2) {
                const v2u lo = *(const LAS v2u*)(vrow + (((4 * t + 2 * s2) ^ sw) << 4)), hi = *(const LAS v2u*)(vrow + (((4 * t + 2 * s2 + 1) ^ sw) << 4));
                const v4u wv4 = (v4u){lo.x, lo.y, hi.x, hi.y};
                O = MFMA32(__builtin_bit_cast(bf16x8, wv4), pf[t][s2], O);
            }
#pragma unroll
        for (int q4 = 0; q4 < 4; ++q4) { v2u o; o.x = cvtpk_c(O[4 * q4] * rl, O[4 * q4 + 1] * rl); o.y = cvtpk_c(O[4 * q4 + 2] * rl, O[4 * q4 + 3] * rl);
            *(v2u*)(op + 32 * dt + 8 * q4) = o; }
    }
    __syncthreads();
}
__device__ __forceinline__ void attn_sample_unit(Frame& F, int sb, int hd) {
    const int tid = F.tid, lane = F.lane, w = F.wave; unsigned char* ws = F.ws;
    LAS float* sc = (LAS float*)(F.lds + RING_OFF);
    LAS float* red = sc + 4 * 256;
    const bf16* QB = (const bf16*)(ws + WS_QB); bf16* OB = (bf16*)(ws + WS_OB);
    const size_t rowq = (size_t)TP + (size_t)sb * LS;
    float q[4][4];
#pragma unroll
    for (int t = 0; t < 4; ++t) { const v2u qw = *(const v2u*)(QB + (rowq + t) * 1024 + hd * 256 + 4 * lane); q[t][0] = bf2f(qw.x & 0xffffu); q[t][1] = bf2f(qw.x >> 16); q[t][2] = bf2f(qw.y & 0xffffu); q[t][3] = bf2f(qw.y >> 16); }
    const float* Kc = F.in[6] + ((size_t)sb * 256 * 4 + hd) * 256 + 4 * lane; const float* Vc = F.in[7] + ((size_t)sb * 256 * 4 + hd) * 256 + 4 * lane;
    f32x4 kv[8], kn[8];
#pragma unroll
    for (int u = 0; u < 8; ++u) kv[u] = ld_nt(Kc + (size_t)(w * 32 + u) * 1024);
#pragma unroll 1
    for (int kk0 = 0; kk0 < 32; kk0 += 8) {
#pragma unroll
        for (int u = 0; u < 8; ++u) kn[u] = kk0 < 24 ? ld_nt(Kc + (size_t)(w * 32 + kk0 + 8 + u) * 1024) : ld_nt(Vc + (size_t)(w * 32 + u) * 1024);
        { float part[32];
#pragma unroll
          for (int u = 0; u < 8; ++u)
#pragma unroll
              for (int t = 0; t < 4; ++t) part[4 * u + t] = (q[t][0] * kv[u].x + q[t][1] * kv[u].y) + (q[t][2] * kv[u].z + q[t][3] * kv[u].w);
          float sv = tr_reduce32(part, lane); sv += __shfl_xor(sv, 32);
          if (lane < 32) sc[(lane & 3) * 256 + w * 32 + kk0 + (lane >> 2)] = sv; }
#pragma unroll
        for (int u = 0; u < 8; ++u) kv[u] = kn[u]; }
    __syncthreads();
    if (w < 4) { float v[4]; float m = -3.0e38f;
#pragma unroll
        for (int j = 0; j < 4; ++j) { v[j] = sc[w * 256 + j * 64 + lane]; m = fmaxf(m, v[j]); }
        m = wave_max(m); float l = 0.f;
#pragma unroll
        for (int j = 0; j < 4; ++j) { v[j] = __builtin_amdgcn_exp2f(v[j] - m); l += v[j]; }
        l = wave_sum(l); const float rl = 1.0f / l;
#pragma unroll
        for (int j = 0; j < 4; ++j) sc[w * 256 + j * 64 + lane] = v[j] * rl; }
    __syncthreads();
    float o[4][4];
#pragma unroll
    for (int t = 0; t < 4; ++t)
#pragma unroll
        for (int e = 0; e < 4; ++e) o[t][e] = 0.f;
#pragma unroll 1
    for (int kk0 = 0; kk0 < 32; kk0 += 8) {
        if (kk0 < 24) {
#pragma unroll
            for (int u = 0; u < 8; ++u) kn[u] = ld_nt(Vc + (size_t)(w * 32 + kk0 + 8 + u) * 1024); }
#pragma unroll
        for (int u = 0; u < 8; ++u) { const int key = w * 32 + kk0 + u;
#pragma unroll
            for (int t = 0; t < 4; ++t) { const float pr = sc[t * 256 + key]; o[t][0] += pr * kv[u].x; o[t][1] += pr * kv[u].y; o[t][2] += pr * kv[u].z; o[t][3] += pr * kv[u].w; } }
#pragma unroll
        for (int u = 0; u < 8; ++u) kv[u] = kn[u]; }
#pragma unroll
    for (int t = 0; t < 4; ++t) *(LAS f32x4*)(red + (w * 4 + t) * 256 + 4 * lane) = (f32x4){o[t][0], o[t][1], o[t][2], o[t][3]};
    __syncthreads();
    { const int t = tid >> 7, d0 = (tid & 127) * 2; float a0 = 0.f, a1 = 0.f;
#pragma unroll
      for (int ww = 0; ww < 8; ++ww) { a0 += red[(ww * 4 + t) * 256 + d0]; a1 += red[(ww * 4 + t) * 256 + d0 + 1]; }
      *(unsigned*)(OB + (rowq + t) * 1024 + hd * 256 + d0) = pk2(a0, a1); }
    __syncthreads();
}
__device__ __forceinline__ void attn_phase(Frame& F) {
    for (int u = F.vcu; u < NBP * 4 * 8; u += F.G) attn_prompt_unit(F, u >> 5, (u >> 3) & 3, u & 7);
    for (int u = F.vcu; u < NBS * 4; u += F.G) attn_sample_unit(F, u >> 2, u & 3);
}
__device__ __forceinline__ void final_norm_phase(Frame& F) {
    const int gw = F.vcu * NWAVES + F.wave, NGW = F.G * NWAVES; const float* SSQ = (const float*)(F.ws + WS_SSQP3); const float* wn = F.in[31]; const bf16* HB = (const bf16*)(F.ws + WS_HB);
    f32x4 wv[4];
#pragma unroll
    for (int j = 0; j < 2; ++j) { wv[2 * j] = *((const f32x4*)wn + 2 * (64 * j + F.lane)); wv[2 * j + 1] = *((const f32x4*)wn + 2 * (64 * j + F.lane) + 1); }
    for (int row = gw; row < T; row += NGW) {
        const f32x4* sp = (const f32x4*)(SSQ + (size_t)row * 16); float s = 0.f;
#pragma unroll
        for (int j = 0; j < 4; ++j) { const f32x4 a = sp[j]; s += (a.x + a.y) + (a.z + a.w); }
        const float rs = __builtin_amdgcn_rsqf(s * (1.0f / 1024.0f) + EPS);
#pragma unroll
        for (int j = 0; j < 2; ++j) { const int pc = 64 * j + F.lane; const v4u w = ld_nt16((const v4u*)(HB + (size_t)row * 1024) + pc);
            const f32x4 v0 = (f32x4){bf2f(w.x & 0xffffu), __uint_as_float(w.x & 0xffff0000u), bf2f(w.y & 0xffffu), __uint_as_float(w.y & 0xffff0000u)};
            const f32x4 v1 = (f32x4){bf2f(w.z & 0xffffu), __uint_as_float(w.z & 0xffff0000u), bf2f(w.w & 0xffffu), __uint_as_float(w.w & 0xffff0000u)};
            float* o = F.out + O_Y + (size_t)row * 1024 + 8 * pc; st_nt(o, v0 * rs * wv[2 * j]); st_nt(o + 4, v1 * rs * wv[2 * j + 1]); }
    }
}
#ifndef MK_N_LAUNCHES
#define MK_N_LAUNCHES 1
#endif
constexpr int PER_PHASE = 13;
constexpr int N_LAUNCHES = MK_N_LAUNCHES;
struct Args { const float* in[32]; float* out; unsigned char* ws; int ph_lo, ph_hi; };
__global__ void __launch_bounds__(NTHR, 2) skel_fwd(Args args) {
    extern __shared__ __attribute__((aligned(16))) unsigned char lds[];
    Frame F;
    F.lds = (LAS unsigned char*)lds;
    F.MISC = (volatile LAS unsigned*)(F.lds + MISC_OFF);
    F.tid = threadIdx.x; F.lane = F.tid & 63; F.wave = __builtin_amdgcn_readfirstlane(F.tid >> 6);
    F.G = gridDim.x; { const int bx = blockIdx.x; F.vcu = (F.G % 8 == 0) ? (bx % 8) * (F.G / 8) + bx / 8 : bx; }
    unsigned char* ws = args.ws; F.ws = ws; F.out = args.out;
    F.ctl = (gu32*)(ws + WS_CTL);
#pragma unroll
    for (int i = 0; i < 32; ++i) F.in[i] = args.in[i];
    for (int u = F.tid; u < (LDS_BYTES - LDSCTL_OFF) / 4; u += NTHR) ((LAS unsigned*)(F.lds + LDSCTL_OFF))[u] = 0u;
    __syncthreads();
    XcdBarrier bar; bar.bar = (unsigned*)(F.ctl + CW_BAR); bar.x = 0; bar.st = nullptr;
    if (N_LAUNCHES == 1) bar = xcd_barrier_post((unsigned*)(F.ctl + CW_BAR), F.MISC + 8);
#define GRID_BAR() do { if (N_LAUNCHES == 1) xcd_barrier(bar); } while (0)
    const int lo = args.ph_lo, hi = args.ph_hi;
#ifdef ONLY_PHASE
#define IN(k) ((k) == ONLY_PHASE && lo <= (k) && (k) < hi)
#else
#define IN(k) (lo <= (k) && (k) < hi)
#endif
#define BOTH(k) (IN(k) && IN((k) + 1))
    bf16* const XB = (bf16*)(ws + WS_XB); bf16* const PROJ = (bf16*)(ws + WS_PROJ);
    float* const Y = F.out + O_Y;
    if (IN(0)) { p0_prologue(F); if (BOTH(0)) GRID_BAR(); }
    if (IN(1)) {
        { pg8::Gemm g{XB, (const bf16*)(ws + WS_WIN), T, NPROJ, 1024}; pg8::StaticOrder S; S.init(T, NPROJ, F.G, (int)blockIdx.x);
          pg8::EpiScaleBf16<1, true> E{PROJ, SLOT_ELEMS, (const float*)(ws + WS_SSQX), 1.0f, (float*)(ws + WS_DT)};
          pg8::gemm_phase<pg8::EpiScaleBf16<1, true>, pg8::StaticOrder, true, true>(F.lds + RING_OFF, g, S, E); }
        { pg8::Gemm g{(const bf16*)(ws + WS_MNB), (const bf16*)(ws + WS_WKV), MEMR, 2048, 1024}; pg8::StaticOrder S; S.init(MEMR, 2048, F.G, (int)((blockIdx.x + 64) % F.G));
          pg8::EpiKV E{F.out + O_MKP, F.out + O_MVP, (bf16*)(ws + WS_KB), (bf16*)(ws + WS_VT), (const float*)(ws + WS_SSQM)};
          pg8::gemm_phase<pg8::EpiKV, pg8::StaticOrder, true, true>(F.lds + RING_OFF, g, S, E); }
        if (BOTH(1)) GRID_BAR();
    }
    if (IN(2)) { bc_prep_phase(F); hg_prep_phase(F); if (BOTH(2)) GRID_BAR(); }
    if (IN(3)) { scan_phase(F); if (BOTH(3)) GRID_BAR(); }
    if (IN(4)) { ssdnorm_phase(F); hgnorm_phase(F); if (BOTH(4)) GRID_BAR(); }
    if (IN(5)) { { SmGate<false> Es{(bf16*)(ws + WS_MERGED), PROJ + (size_t)S_GS * SLOT_ELEMS}; small_tile_phase(F, (const bf16*)(ws + WS_YG), (const bf16*)(ws + WS_WSSD), 2048, Es); }
        pg8::Gemm g{(const bf16*)(ws + WS_YG), (const bf16*)(ws + WS_WSSD), TP, 1024, 2048}; pg8::StaticOrder S; S.init(TP, 1024, F.G, (int)blockIdx.x);
        pg8::EpiGate<false> E{(bf16*)(ws + WS_MERGED), PROJ + (size_t)S_GS * SLOT_ELEMS};
        pg8::gemm_phase<pg8::EpiGate<false>, pg8::StaticOrder, true, true>(F.lds + RING_OFF, g, S, E);
          }
    if (IN(5)) { { SmGate<true> Es{(bf16*)(ws + WS_MERGED), PROJ + (size_t)S_GH * SLOT_ELEMS}; small_tile_phase(F, (const bf16*)(ws + WS_ON), (const bf16*)(ws + WS_WHG), 1024, Es); }
        pg8::Gemm g{(const bf16*)(ws + WS_ON), (const bf16*)(ws + WS_WHG), TP, 1024, 1024}; pg8::StaticOrder S; S.init(TP, 1024, F.G, (int)blockIdx.x);
        pg8::EpiGate<true> E{(bf16*)(ws + WS_MERGED), PROJ + (size_t)S_GH * SLOT_ELEMS};
        pg8::gemm_phase<pg8::EpiGate<true>, pg8::StaticOrder, true, true>(F.lds + RING_OFF, g, S, E);
        if (BOTH(5)) GRID_BAR(); }
    if (IN(6)) { { SmRes<false> Es{F.in[1] - (size_t)TP * 1024, (bf16*)(ws + WS_HB), (float*)(ws + WS_SSQP1)}; small_tile_phase(F, (const bf16*)(ws + WS_MERGED), (const bf16*)(ws + WS_WOUT), 1024, Es); }
        pg8::Gemm g{(const bf16*)(ws + WS_MERGED), (const bf16*)(ws + WS_WOUT), TP, 1024, 1024}; pg8::StaticOrder S; S.init(TP, 1024, F.G, (int)blockIdx.x);
        pg8::EpiRes<false> E{F.in[0], F.in[1] - (size_t)TP * 1024, (bf16*)(ws + WS_HB), (float*)(ws + WS_SSQP1)};
        pg8::gemm_phase<pg8::EpiRes<false>, pg8::StaticOrder, true, true>(F.lds + RING_OFF, g, S, E);
        if (BOTH(6)) GRID_BAR(); }
    if (IN(7)) { { SmScale Es{(bf16*)(ws + WS_QB), (const float*)(ws + WS_SSQP1), QSCALE}; small_tile_phase(F, (const bf16*)(ws + WS_HB), (const bf16*)(ws + WS_WCQ), 1024, Es); }
        pg8::Gemm g{(const bf16*)(ws + WS_HB), (const bf16*)(ws + WS_WCQ), TP, 1024, 1024}; pg8::StaticOrder S; S.init(TP, 1024, F.G, (int)blockIdx.x);
        pg8::EpiScaleBf16<16, false> E{(bf16*)(ws + WS_QB), SLOT_ELEMS, (const float*)(ws + WS_SSQP1), QSCALE, nullptr};
        pg8::gemm_phase<pg8::EpiScaleBf16<16, false>, pg8::StaticOrder, true, true>(F.lds + RING_OFF, g, S, E);
        if (BOTH(7)) GRID_BAR(); }
    if (IN(8)) { attn_phase(F); if (BOTH(8)) GRID_BAR(); }
    if (IN(9)) { { SmRes<true> Es{nullptr, (bf16*)(ws + WS_HB), (float*)(ws + WS_SSQP2)}; small_tile_phase(F, (const bf16*)(ws + WS_OB), (const bf16*)(ws + WS_WCO), 1024, Es); }
        pg8::Gemm g{(const bf16*)(ws + WS_OB), (const bf16*)(ws + WS_WCO), TP, 1024, 1024}; pg8::StaticOrder S; S.init(TP, 1024, F.G, (int)blockIdx.x);
        pg8::EpiRes<true> E{nullptr, nullptr, (bf16*)(ws + WS_HB), (float*)(ws + WS_SSQP2)};
        pg8::gemm_phase<pg8::EpiRes<true>, pg8::StaticOrder, true, true>(F.lds + RING_OFF, g, S, E);
        if (BOTH(9)) GRID_BAR(); }
    if (IN(10)) { pg8::Gemm g{(const bf16*)(ws + WS_HB), (const bf16*)(ws + WS_WGU), T, 2 * FFN, 1024}; pg8::StaticOrder S; S.init(T, 2 * FFN, F.G, (int)blockIdx.x);
        pg8::EpiSwiglu E{(bf16*)(ws + WS_ACT), (const float*)(ws + WS_SSQP2)};
        pg8::gemm_phase<pg8::EpiSwiglu, pg8::StaticOrder, true, true>(F.lds + RING_OFF, g, S, E);
        if (BOTH(10)) GRID_BAR(); }
    if (IN(11)) { { SmRes<true> Es{nullptr, (bf16*)(ws + WS_HB), (float*)(ws + WS_SSQP3)}; small_tile_phase(F, (const bf16*)(ws + WS_ACT), (const bf16*)(ws + WS_WDN), FFN, Es); }
        pg8::Gemm g{(const bf16*)(ws + WS_ACT), (const bf16*)(ws + WS_WDN), TP, 1024, FFN}; pg8::StaticOrder S; S.init(TP, 1024, F.G, (int)blockIdx.x);
        pg8::EpiRes<true> E{nullptr, nullptr, (bf16*)(ws + WS_HB), (float*)(ws + WS_SSQP3)};
        pg8::gemm_phase<pg8::EpiRes<true>, pg8::StaticOrder, true, true>(F.lds + RING_OFF, g, S, E);
        if (BOTH(11)) GRID_BAR(); }
    if (IN(12)) final_norm_phase(F);
#undef IN
#undef BOTH
}

extern "C" void kernel_launch(void* const* d_in, const int* in_sizes, int n_in, void* d_out, int out_size, void* d_ws, size_t ws_size, hipStream_t stream) {
    static int grid = 0;
    if (grid == 0) {
        const int want[32] = {TP * 1024, TS * 1024, MEMR * 1024, 33554432, 1179648, 16777216, 33554432, 33554432, 1024, 1024 * 11296, 4 * 3072, 3072, 32, 32, 32, 2048, 2048 * 1024, 2048, 1024,
                              1024 * 1024, 1024 * 1024, 1024, 1024, 1024 * 1024, 1024 * 1024, 1024 * 1024, 1024 * 1024, 1024, 1024 * FFN, 1024 * FFN, FFN * 1024, 1024};
        bool ok = (n_in == 32); for (int i = 0; ok && i < 32; ++i) if (in_sizes[i] != want[i]) { fprintf(stderr, "kernel_launch: input %d has %d elements, expected %d\n", i, in_sizes[i], want[i]); ok = false; }
        if (!ok || out_size != (int)O_END || ws_size < WS_END4) { fprintf(stderr, "kernel_launch: unexpected shapes: n_in %d out %d ws %zu\n", n_in, out_size, ws_size); grid = -1; return; }
        int dev = 0, cus = 0, per_cu = 0;
        if (hipGetDevice(&dev) != hipSuccess || hipDeviceGetAttribute(&cus, hipDeviceAttributeMultiprocessorCount, dev) != hipSuccess) { grid = -1; return; }
        if (hipFuncSetAttribute((const void*)skel_fwd, hipFuncAttributeMaxDynamicSharedMemorySize, LDS_BYTES) != hipSuccess) { fprintf(stderr, "kernel_launch: hipFuncSetAttribute failed\n"); grid = -1; return; }
        if (hipOccupancyMaxActiveBlocksPerMultiprocessor(&per_cu, (const void*)skel_fwd, NTHR, LDS_BYTES) != hipSuccess || per_cu < 1) fprintf(stderr, "kernel_launch: occupancy query reports %d blocks per CU\n", per_cu);
        (void)hipGetLastError();
        grid = cus;
    }
    if (grid < 0) return;
    (void)hipMemsetAsync((char*)d_ws + WS_CTL, 0, CTL_ZERO_BYTES, stream);
    Args a{};
    for (int i = 0; i < 32; ++i) a.in[i] = (const float*)d_in[i];
    a.out = (float*)d_out; a.ws = (unsigned char*)d_ws;
    for (int li = 0; li < N_LAUNCHES; ++li) {
        a.ph_lo = (N_LAUNCHES == PER_PHASE) ? li : 0; a.ph_hi = (N_LAUNCHES == PER_PHASE) ? li + 1 : PER_PHASE;
        hipLaunchKernelGGL(skel_fwd, dim3(grid), dim3(NTHR), LDS_BYTES, stream, a);
    }
}
```

```cpp
#include <hip/hip_runtime.h>
#include <cstdio>
#include <cstdint>
namespace pg8 {
#define PG8_LAS __attribute__((address_space(3)))
typedef unsigned short bf16_t;
typedef short bf16x8 __attribute__((ext_vector_type(8)));
typedef float f32x4 __attribute__((ext_vector_type(4)));
typedef unsigned u32x4 __attribute__((ext_vector_type(4)));
constexpr int BM = 256, BK = 64, HALF = 128, HTB = HALF * BK * 2  , STAGE_BYTES = 8 * HTB, NXCD = 8, WGM = 8;

__host__ __device__ __forceinline__ int lds_byte(int r, int c) { const int st = (r >> 4) * 2 + (c >> 5), rr = r & 15, cc = c & 31, ob = rr * 64 + cc * 2; return st * 1024 + (ob ^ (((ob >> 9) & 1) << 5)); }
__host__ __device__ __forceinline__ void stage_rc(int b, int& R, int& C) { const int st = b / 1024, sb = b % 1024, swz = sb ^ (((sb >> 9) & 1) << 5); R = (st >> 1) * 16 + swz / 64; C = (st & 1) * 32 + (swz % 64) / 2; }
__host__ __device__ __forceinline__ int perm32(int rho) { const int n = rho >> 4, i = rho & 15; return 8 * (i >> 2) + 4 * n + (i & 3); }

struct Unit { int pm, pn; };
struct Gemm { const bf16_t* A; const bf16_t* Bt; int M, N, K; };

struct StaticOrder {
    int nM, nN, nwg, G, c;
    __host__ __device__ void init(int M, int N, int G_, int c_) { nM = M / BM; nN = N / BM; nwg = nM * nN; G = G_; c = c_; }
    __host__ __device__ bool next(int i, Unit& u) const {
        const long L = (long)i * G + c; if (L >= nwg) return false;
        int wgid = (int)L; { const int q = nwg / NXCD, r = nwg % NXCD, xcd = wgid % NXCD, off = wgid / NXCD; wgid = (xcd < r ? xcd * (q + 1) : r * (q + 1) + (xcd - r) * q) + off; }
        const int nig = WGM * nN, gid = wgid / nig, fm = gid * WGM, gsz = (nM - fm) < WGM ? (nM - fm) : WGM;
        u.pm = fm + ((wgid % nig) % gsz); u.pn = (wgid % nig) / gsz; return true;
    }
    __device__ __forceinline__ void a_ready(const Unit&) const {}
    __device__ __forceinline__ void done(const Unit&) const {}
};

__device__ __forceinline__ unsigned cvt_pk_bf16(float lo, float hi) { unsigned r; asm volatile("v_cvt_pk_bf16_f32 %0, %1, %2" : "=v"(r) : "v"(lo), "v"(hi)); return r; }
typedef float f32x2 __attribute__((ext_vector_type(2)));
typedef unsigned u32x2 __attribute__((ext_vector_type(2)));
constexpr float RMS_EPS = 1e-6f;
__device__ __forceinline__ float bfbits2f(unsigned v16) { return __uint_as_float(v16 << 16); }
__device__ __forceinline__ float sigm(float x) { return __builtin_amdgcn_rcpf(1.0f + __expf(-x)); }
template <int NP> __device__ __forceinline__ float row_rs(const float* ssq, int row) {
    float s = 0.f;
    if constexpr (NP == 1) s = ssq[row];
    else {
#pragma unroll
        for (int i = 0; i < NP / 4; ++i) { const f32x4 v = *(const f32x4*)(ssq + (size_t)row * NP + 4 * i); s += (v[0] + v[1]) + (v[2] + v[3]); }
    }
    return 1.0f / sqrtf(s * (1.0f / 1024.0f) + RMS_EPS);
}
template <int NP, bool HAS_DT> struct EpiScaleBf16 {
    static constexpr bool PERM = true, AFTER_DRAIN = false;
    bf16_t* O; size_t slot_elems; const float* ssq; float scale; float* dt;
    __device__ __forceinline__ void operator()(const f32x4 (&acc)[2][2][4][2], const Unit& u, int wr, int wc, int fr, int fq) const {
        const int row0 = u.pm * BM + wr * 64 + fr;
        if (HAS_DT && u.pn == 44) {
            if (wc == 0) {
#pragma unroll
                for (int ai = 0; ai < 2; ++ai)
#pragma unroll
                    for (int m = 0; m < 4; ++m) { const int row = row0 + ai * HALF + m * 16; const float rs = row_rs<NP>(ssq, row);
                        float* p = dt + (size_t)row * 32 + 8 * fq; *(f32x4*)p = acc[ai][0][m][0] * rs; *(f32x4*)(p + 4) = acc[ai][0][m][1] * rs; }
            }
            return;
        }
        bf16_t* base = O + (size_t)(u.pn >> 2) * slot_elems; const int col0 = (u.pn & 3) * BM + wc * 32 + 8 * fq;
#pragma unroll
        for (int ai = 0; ai < 2; ++ai)
#pragma unroll
            for (int m = 0; m < 4; ++m) { const int row = row0 + ai * HALF + m * 16; const float rs = row_rs<NP>(ssq, row) * scale; bf16_t* rowp = base + (size_t)row * 1024 + col0;
#pragma unroll
                for (int bj = 0; bj < 2; ++bj) { const f32x4 v0 = acc[ai][bj][m][0] * rs, v1 = acc[ai][bj][m][1] * rs;
                    u32x4 w; w.x = cvt_pk_bf16(v0[0], v0[1]); w.y = cvt_pk_bf16(v0[2], v0[3]); w.z = cvt_pk_bf16(v1[0], v1[1]); w.w = cvt_pk_bf16(v1[2], v1[3]);
                    if (HAS_DT) __builtin_nontemporal_store(w, (u32x4*)(rowp + bj * HALF));
                    else *(u32x4*)(rowp + bj * HALF) = w; } }
    }
};
struct EpiKV {
    static constexpr bool PERM = false, AFTER_DRAIN = false;
    float* mk; float* mv; bf16_t* kb; bf16_t* vt; const float* ssq;
    __device__ __forceinline__ void operator()(const f32x4 (&acc)[2][2][4][2], const Unit& u, int wr, int wc, int fr, int fq) const {
        const int row0 = u.pm * BM + wr * 64 + fr; const bool isv = u.pn >= 4; const int colt = (u.pn & 3) * BM + wc * 32 + 4 * fq;
#pragma unroll
        for (int ai = 0; ai < 2; ++ai)
#pragma unroll
            for (int m = 0; m < 4; ++m) { const int row = row0 + ai * HALF + m * 16; const float rs = row_rs<1>(ssq, row);
#pragma unroll
                for (int bj = 0; bj < 2; ++bj)
#pragma unroll
                    for (int n = 0; n < 2; ++n) { const int c = colt + bj * HALF + n * 16; const f32x4 v = acc[ai][bj][m][n] * rs;
                        if (!isv) { __builtin_nontemporal_store(v, (f32x4*)(mk + (size_t)row * 1024 + c)); u32x2 w; w.x = cvt_pk_bf16(v[0], v[1]); w.y = cvt_pk_bf16(v[2], v[3]); *(u32x2*)(kb + (size_t)row * 1024 + c) = w; }
                        else { __builtin_nontemporal_store(v, (f32x4*)(mv + (size_t)row * 1024 + c)); const int b = row >> 8, key = row & 255, hd = c >> 8, d = c & 255;
                            bf16_t* p = vt + ((size_t)((b * 4 + hd) * 256 + d)) * 256 + key; const unsigned w0 = cvt_pk_bf16(v[0], v[1]), w1 = cvt_pk_bf16(v[2], v[3]);
                            p[0] = (bf16_t)(w0 & 0xffffu); p[256] = (bf16_t)(w0 >> 16); p[512] = (bf16_t)(w1 & 0xffffu); p[768] = (bf16_t)(w1 >> 16); } } }
    }
};
template <bool ADD> struct EpiGate {
    static constexpr bool PERM = true, AFTER_DRAIN = false;
    bf16_t* O; const bf16_t* gate;
    __device__ __forceinline__ void operator()(const f32x4 (&acc)[2][2][4][2], const Unit& u, int wr, int wc, int fr, int fq) const {
        const int row0 = u.pm * BM + wr * 64 + fr, col0 = u.pn * BM + wc * 32 + 8 * fq;
#pragma unroll
        for (int ai = 0; ai < 2; ++ai)
#pragma unroll
            for (int m = 0; m < 4; ++m) { const size_t off = (size_t)(row0 + ai * HALF + m * 16) * 1024 + col0;
#pragma unroll
                for (int bj = 0; bj < 2; ++bj) { const u32x4 gw = __builtin_nontemporal_load((const u32x4*)(gate + off + bj * HALF)); u32x4 ow = (u32x4){0u, 0u, 0u, 0u}; if (ADD) ow = *(const u32x4*)(O + off + bj * HALF);
                    float r[8];
#pragma unroll
                    for (int e = 0; e < 8; ++e) { const unsigned g16 = (gw[e >> 1] >> ((e & 1) * 16)) & 0xffffu, o16 = (ow[e >> 1] >> ((e & 1) * 16)) & 0xffffu;
                        const float a = acc[ai][bj][m][e >> 2][e & 3]; r[e] = (ADD ? bfbits2f(o16) : 0.f) + sigm(bfbits2f(g16)) * a; }
                    u32x4 w; w.x = cvt_pk_bf16(r[0], r[1]); w.y = cvt_pk_bf16(r[2], r[3]); w.z = cvt_pk_bf16(r[4], r[5]); w.w = cvt_pk_bf16(r[6], r[7]);
                    *(u32x4*)(O + off + bj * HALF) = w; } }
    }
};
template <bool BF> struct EpiRes {
    static constexpr bool PERM = true, AFTER_DRAIN = false;
    const float* base0; const float* base1; bf16_t* hb; float* ssqp;
    __device__ __forceinline__ void operator()(const f32x4 (&acc)[2][2][4][2], const Unit& u, int wr, int wc, int fr, int fq) const {
        const int row0 = u.pm * BM + wr * 64 + fr, col0 = u.pn * BM + wc * 32 + 8 * fq; const float* base = u.pm < 64 ? base0 : base1;
#pragma unroll
        for (int ai = 0; ai < 2; ++ai)
#pragma unroll
            for (int m = 0; m < 4; ++m) { const int row = row0 + ai * HALF + m * 16; const size_t off = (size_t)row * 1024 + col0; float sq = 0.f;
#pragma unroll
                for (int bj = 0; bj < 2; ++bj) { const size_t o2 = off + bj * HALF; f32x4 b0, b1;
                    if (BF) { const u32x4 w = *(const u32x4*)(hb + o2); b0 = (f32x4){bfbits2f(w.x & 0xffffu), __uint_as_float(w.x & 0xffff0000u), bfbits2f(w.y & 0xffffu), __uint_as_float(w.y & 0xffff0000u)};
                        b1 = (f32x4){bfbits2f(w.z & 0xffffu), __uint_as_float(w.z & 0xffff0000u), bfbits2f(w.w & 0xffffu), __uint_as_float(w.w & 0xffff0000u)}; }
                    else { b0 = __builtin_nontemporal_load((const f32x4*)(base + o2)); b1 = __builtin_nontemporal_load((const f32x4*)(base + o2 + 4)); }
                    const f32x4 v0 = b0 + acc[ai][bj][m][0], v1 = b1 + acc[ai][bj][m][1];
                    sq += ((v0[0] * v0[0] + v0[1] * v0[1]) + (v0[2] * v0[2] + v0[3] * v0[3])) + ((v1[0] * v1[0] + v1[1] * v1[1]) + (v1[2] * v1[2] + v1[3] * v1[3]));
                    u32x4 w; w.x = cvt_pk_bf16(v0[0], v0[1]); w.y = cvt_pk_bf16(v0[2], v0[3]); w.z = cvt_pk_bf16(v1[0], v1[1]); w.w = cvt_pk_bf16(v1[2], v1[3]); *(u32x4*)(hb + o2) = w; }
                sq += __shfl_xor(sq, 16); sq += __shfl_xor(sq, 32);
                if (fq == 0) ssqp[(size_t)row * 16 + u.pn * 4 + wc] = sq; }
    }
};
struct EpiSwiglu {
    static constexpr bool PERM = true, AFTER_DRAIN = false;
    bf16_t* act; const float* ssq;
    __device__ __forceinline__ void operator()(const f32x4 (&acc)[2][2][4][2], const Unit& u, int wr, int wc, int fr, int fq) const {
        const int row0 = u.pm * BM + wr * 64 + fr, col0 = u.pn * 128 + wc * 16 + 4 * fq;
#pragma unroll
        for (int ai = 0; ai < 2; ++ai)
#pragma unroll
            for (int m = 0; m < 4; ++m) { const int row = row0 + ai * HALF + m * 16; const float rs = row_rs<16>(ssq, row);
#pragma unroll
                for (int bj = 0; bj < 2; ++bj) { const f32x4 a = acc[ai][bj][m][0] * rs, b = acc[ai][bj][m][1] * rs;
                    const float r0 = a[0] * sigm(a[0]) * a[1], r1 = a[2] * sigm(a[2]) * a[3], r2 = b[0] * sigm(b[0]) * b[1], r3 = b[2] * sigm(b[2]) * b[3];
                    u32x2 w; w.x = cvt_pk_bf16(r0, r1); w.y = cvt_pk_bf16(r2, r3); *(u32x2*)(act + (size_t)row * 2816 + col0 + bj * 64) = w; } }
    }
};
template <class Epi, class Sched, bool ALIGN_EPI = false, bool SP2 = false>
__device__ __forceinline__ void gemm_phase(PG8_LAS unsigned char* lds, const Gemm g, const Sched& S, const Epi& E) {
    const int tid = threadIdx.x, wid = __builtin_amdgcn_readfirstlane(tid >> 6), lane = tid & 63, wr = wid >> 2, wc = wid & 3, fr = lane & 15, fq = lane >> 4;
    const int K = g.K, nt = K / BK;
    unsigned voffA[2], voffB[2];
#pragma unroll
    for (int i = 0; i < 2; ++i) { int R, C; stage_rc(tid * 16 + i * 8192, R, C); const int Rb = Epi::PERM ? ((R & ~31) + perm32(R & 31)) : R;
        voffA[i] = (unsigned)(R * K + C) * 2u; voffB[i] = (unsigned)(Rb * K + C) * 2u; }
    const size_t kstep = (size_t)(BK * 2);
    const size_t hstep = (size_t)HALF * K * 2;
    const size_t tstep = 2 * hstep;
    const unsigned ldsw = (unsigned)wid * 1024u;
    const int aoff = lds_byte(wr * 64 + fr, fq * 8), boff = lds_byte(wc * 32 + fr, fq * 8);
#define PG8_SA(b, h) (((b) * 2 + (h)) * HTB)
#define PG8_SB(b, h) ((4 + (b) * 2 + (h)) * HTB)
#define PG8_STAGE(bufoff, gbase, voff) do { _Pragma("unroll") for (int _i = 0; _i < 2; ++_i) \
        __builtin_amdgcn_global_load_lds((const unsigned*)((const char*)(gbase) + (voff)[_i]), (PG8_LAS unsigned*)(lds + (bufoff) + ldsw + _i * 8192), 16, 0, 0); } while (0)
#define PG8_LDA(dst, b, h) do { _Pragma("unroll") for (int m = 0; m < 4; ++m) _Pragma("unroll") for (int k = 0; k < 2; ++k) dst[m][k] = *(const PG8_LAS bf16x8*)(lds + PG8_SA(b, h) + aoff + m * 2048 + k * 1024); } while (0)
#define PG8_LDB(dst, b, h) do { _Pragma("unroll") for (int n = 0; n < 2; ++n) _Pragma("unroll") for (int k = 0; k < 2; ++k) dst[n][k] = *(const PG8_LAS bf16x8*)(lds + PG8_SB(b, h) + boff + n * 2048 + k * 1024); } while (0)
#define PG8_MMA(ai, bj, At, Bt) do { __builtin_amdgcn_s_setprio(1); _Pragma("unroll") for (int m = 0; m < 4; ++m) _Pragma("unroll") for (int n = 0; n < 2; ++n) _Pragma("unroll") for (int k = 0; k < 2; ++k) \
        acc[ai][bj][m][n] = __builtin_amdgcn_mfma_f32_16x16x32_bf16(Bt[n][k], At[m][k], acc[ai][bj][m][n], 0, 0, 0); __builtin_amdgcn_s_setprio(0); } while (0)
#define PG8_WAIT_V(n) asm volatile("s_waitcnt vmcnt(" #n ")" ::: "memory")
#define PG8_WAIT_L(n) asm volatile("s_waitcnt lgkmcnt(" #n ")" ::: "memory")
#define PG8_BAR __builtin_amdgcn_s_barrier()
#define PG8_SCHED __builtin_amdgcn_sched_barrier(0)
    Unit cur, nxt; int ui = 0;
    if (!S.next(0, cur)) return;
    f32x4 acc[2][2][4][2];
#pragma unroll
    for (int a = 0; a < 2; ++a)
#pragma unroll
        for (int b = 0; b < 2; ++b)
#pragma unroll
            for (int m = 0; m < 4; ++m)
#pragma unroll
                for (int n = 0; n < 2; ++n) acc[a][b][m][n] = (f32x4){0.f, 0.f, 0.f, 0.f};
    bf16x8 At[4][2], B0[2][2], B1[2][2];
    const char* cA = (const char*)g.A + (size_t)cur.pm * tstep; const char* cB = (const char*)g.Bt + (size_t)cur.pn * tstep;
    S.a_ready(cur);
    if constexpr (SP2) {
        PG8_STAGE(PG8_SB(0, 0), cB, voffB); PG8_STAGE(PG8_SB(0, 1), cB + hstep, voffB); PG8_STAGE(PG8_SA(0, 0), cA, voffA); PG8_STAGE(PG8_SA(0, 1), cA + hstep, voffA);
        if (wr == 1) PG8_BAR;
        PG8_WAIT_V(2); PG8_BAR;
        PG8_STAGE(PG8_SB(1, 0), cB + kstep, voffB); PG8_STAGE(PG8_SA(1, 0), cA + kstep, voffA); PG8_STAGE(PG8_SB(1, 1), cB + hstep + kstep, voffB);
        PG8_WAIT_V(6); PG8_BAR;
    } else {
        PG8_STAGE(PG8_SB(0, 0), cB, voffB); PG8_STAGE(PG8_SA(0, 0), cA, voffA); PG8_STAGE(PG8_SB(0, 1), cB + hstep, voffB); PG8_STAGE(PG8_SA(0, 1), cA + hstep, voffA);
        if (wr == 1) PG8_BAR;
        PG8_WAIT_V(4); PG8_BAR;
        PG8_STAGE(PG8_SB(1, 0), cB + kstep, voffB); PG8_STAGE(PG8_SA(1, 0), cA + kstep, voffA); PG8_STAGE(PG8_SB(1, 1), cB + hstep + kstep, voffB);
        PG8_WAIT_V(6); PG8_BAR;
    }
    for (;;) {
        const bool has_next = S.next(ui + 1, nxt);
        const char* nA = has_next ? (const char*)g.A + (size_t)nxt.pm * tstep : cA; const char* nB = has_next ? (const char*)g.Bt + (size_t)nxt.pn * tstep : cB;
        for (int t = 0; t < nt; t += 2) {
            const bool last = (t == nt - 2);
            const char* a1 = cA + (size_t)(t + 1) * kstep;
            const char* a2 = last ? nA : cA + (size_t)(t + 2) * kstep; const char* b2 = last ? nB : cB + (size_t)(t + 2) * kstep;
            const char* a3 = a2 + kstep; const char* b3 = b2 + kstep;
            if (last && has_next) S.a_ready(nxt);
            if constexpr (SP2) {
            PG8_LDB(B0, 0, 0); PG8_LDB(B1, 0, 1); PG8_SCHED; PG8_LDA(At, 0, 0); PG8_STAGE(PG8_SA(1, 1), a1 + hstep, voffA);
            PG8_WAIT_V(8); PG8_WAIT_L(0); PG8_BAR; PG8_MMA(0, 0, At, B0); PG8_MMA(0, 1, At, B1); PG8_BAR; PG8_SCHED;
            PG8_LDA(At, 0, 1); PG8_STAGE(PG8_SB(0, 0), b2, voffB); PG8_STAGE(PG8_SB(0, 1), b2 + hstep, voffB); PG8_STAGE(PG8_SA(0, 0), a2, voffA);
            PG8_WAIT_V(8); PG8_WAIT_L(0); PG8_BAR; PG8_MMA(1, 0, At, B0); PG8_MMA(1, 1, At, B1); PG8_BAR; PG8_SCHED;
            PG8_LDB(B0, 1, 0); PG8_LDB(B1, 1, 1); PG8_SCHED; PG8_LDA(At, 1, 0); PG8_STAGE(PG8_SA(0, 1), a2 + hstep, voffA);
            PG8_WAIT_V(8); PG8_WAIT_L(0); PG8_BAR; PG8_MMA(0, 0, At, B0); PG8_MMA(0, 1, At, B1); PG8_BAR; PG8_SCHED;
            PG8_LDA(At, 1, 1); PG8_STAGE(PG8_SB(1, 0), b3, voffB); PG8_STAGE(PG8_SB(1, 1), b3 + hstep, voffB); PG8_STAGE(PG8_SA(1, 0), a3, voffA);
            PG8_WAIT_V(8); PG8_WAIT_L(0); PG8_BAR; PG8_MMA(1, 0, At, B0); PG8_MMA(1, 1, At, B1); PG8_BAR; PG8_SCHED;
            } else {
            PG8_LDB(B0, 0, 0); PG8_SCHED; PG8_LDA(At, 0, 0); PG8_STAGE(PG8_SA(1, 1), a1 + hstep, voffA);
            PG8_WAIT_L(8); PG8_BAR; PG8_WAIT_L(0); PG8_MMA(0, 0, At, B0); PG8_BAR; PG8_SCHED;
            PG8_LDB(B1, 0, 1); PG8_STAGE(PG8_SB(0, 0), b2, voffB);
            PG8_BAR; PG8_WAIT_L(0); PG8_MMA(0, 1, At, B1); PG8_BAR;
            PG8_LDA(At, 0, 1); PG8_STAGE(PG8_SA(0, 0), a2, voffA);
            PG8_BAR; PG8_WAIT_L(0); PG8_MMA(1, 0, At, B0); PG8_BAR; PG8_SCHED;
            PG8_STAGE(PG8_SB(0, 1), b2 + hstep, voffB);
            PG8_WAIT_V(6); PG8_BAR; PG8_MMA(1, 1, At, B1); PG8_BAR;
            PG8_LDB(B0, 1, 0); PG8_SCHED; PG8_LDA(At, 1, 0); PG8_STAGE(PG8_SA(0, 1), a2 + hstep, voffA);
            PG8_WAIT_L(8); PG8_BAR; PG8_WAIT_L(0); PG8_MMA(0, 0, At, B0); PG8_BAR; PG8_SCHED;
            PG8_LDB(B1, 1, 1); PG8_STAGE(PG8_SB(1, 0), b3, voffB);
            PG8_BAR; PG8_WAIT_L(0); PG8_MMA(0, 1, At, B1); PG8_BAR;
            PG8_LDA(At, 1, 1); PG8_STAGE(PG8_SA(1, 0), a3, voffA);
            PG8_BAR; PG8_WAIT_L(0); PG8_MMA(1, 0, At, B0); PG8_BAR; PG8_SCHED;
            PG8_STAGE(PG8_SB(1, 1), b3 + hstep, voffB);
            PG8_WAIT_V(6); PG8_BAR; PG8_MMA(1, 1, At, B1); PG8_BAR;
            }
        }
        if constexpr (ALIGN_EPI) { if (wr == 0) PG8_BAR; }
        if constexpr (!Epi::AFTER_DRAIN) { E(acc, cur, wr, wc, fr, fq); S.done(cur); }
        if (!has_next) break;
#pragma unroll
        for (int a = 0; a < 2; ++a)
#pragma unroll
            for (int b = 0; b < 2; ++b)
#pragma unroll
                for (int m = 0; m < 4; ++m)
#pragma unroll
                    for (int n = 0; n < 2; ++n) acc[a][b][m][n] = (f32x4){0.f, 0.f, 0.f, 0.f};
        cur = nxt; cA = nA; cB = nB; ++ui;
        if constexpr (ALIGN_EPI) { if (wr == 1) PG8_BAR; }
    }
    PG8_WAIT_V(0);
    if constexpr (!ALIGN_EPI) { if (wr == 0) PG8_BAR; }
    PG8_BAR;
    if constexpr (Epi::AFTER_DRAIN) { E.fused(acc, cur, wr, wc, fr, fq, lds, wid, lane); S.done(cur); }
#undef PG8_SA
#undef PG8_SB
#undef PG8_STAGE
#undef PG8_LDA
#undef PG8_LDB
#undef PG8_MMA
#undef PG8_WAIT_V
#undef PG8_WAIT_L
#undef PG8_BAR
#undef PG8_SCHED
}
}
#define GAS __attribute__((address_space(1)))
#define LAS __attribute__((address_space(3)))
typedef unsigned short bf16;
typedef unsigned v4u __attribute__((ext_vector_type(4)));
typedef float f32x4 __attribute__((ext_vector_type(4)));
typedef short bf16x8 __attribute__((ext_vector_type(8)));
typedef GAS unsigned gu32;
typedef GAS unsigned long long gu64;
#define RLX_AGENT __ATOMIC_RELAXED, __HIP_MEMORY_SCOPE_AGENT
#define LDS_WAIT() asm volatile("s_waitcnt lgkmcnt(0)" ::: "memory")
#define VM_WAIT() asm volatile("s_waitcnt vmcnt(0)" ::: "memory")
__device__ __forceinline__ unsigned long long rt() { return __builtin_amdgcn_s_memrealtime(); }
typedef float f32x2_t __attribute__((ext_vector_type(2))); typedef __bf16 bf16x2_t __attribute__((ext_vector_type(2)));
__device__ __forceinline__ unsigned pk2(float lo, float hi) { const f32x2_t v = {lo, hi}; const bf16x2_t b = __builtin_convertvector(v, bf16x2_t); return __builtin_bit_cast(unsigned, b); }
__device__ __forceinline__ unsigned f2bf(float f) { return pk2(f, 0.f) & 0xffffu; }

#define XB_TMO      128
#define XB_XCNT(j)  (256  + 64 * (j))
#define XB_XSUB(j)  (1280 + 64 * (j))
#define XB_XGEN(j)  (2304 + 64 * (j))
#define XB_TOP      3328
#define XB_TOPGEN   3392
#define XCD_BAR_WORDS 3456
#define XB_SPIN_CAP (1u << 18)

__device__ __forceinline__ unsigned xb_ld(unsigned* p)              { return __hip_atomic_load(p, __ATOMIC_RELAXED, __HIP_MEMORY_SCOPE_AGENT); }
__device__ __forceinline__ unsigned xb_add(unsigned* p, unsigned v) { return __hip_atomic_fetch_add(p, v, __ATOMIC_RELAXED, __HIP_MEMORY_SCOPE_AGENT); }
__device__ __forceinline__ unsigned xb_xcc_id() { return (unsigned)__builtin_amdgcn_s_getreg((3 << 11) | 20) & 0xFu; }
#define XB_SPIN(cond, bar) do { unsigned _sp = 0; while (cond) { __builtin_amdgcn_s_sleep(1); \
    if ((++_sp & 255u) == 0u) { if (xb_ld(&(bar)[XB_TMO])) break; if (_sp > XB_SPIN_CAP) { atomicAdd(&(bar)[XB_TMO], 1u); break; } } } } while (0)

struct XcdBarrier {
    unsigned* bar; unsigned x;
    volatile LAS unsigned* st;
};

__device__ __forceinline__ XcdBarrier xcd_barrier_post(unsigned* bar, volatile LAS unsigned* st) {
    XcdBarrier b; b.bar = bar; b.x = xb_xcc_id(); b.st = st;
    if (threadIdx.x == 0) (void)xb_add(&bar[XB_XCNT(b.x)], 1u);
    return b;
}
__device__ __forceinline__ void xcd_barrier_complete(unsigned* bar, unsigned x, unsigned& nloc, unsigned& nx) {
    const unsigned G = gridDim.x * gridDim.y * gridDim.z;
    unsigned sum, cnt, mine, sp = 0u;
    for (;;) {
        sum = 0u; cnt = 0u; mine = 0u;
#pragma unroll
        for (unsigned j = 0; j < 16; ++j) { const unsigned c = xb_ld(&bar[XB_XCNT(j)]); sum += c; cnt += (c > 0u) ? 1u : 0u; mine = (j == x) ? c : mine; }
        if (sum == G) break;
        __builtin_amdgcn_s_sleep(1);
        if ((++sp & 255u) == 0u) { if (xb_ld(&bar[XB_TMO])) break; if (sp > XB_SPIN_CAP) { atomicAdd(&bar[XB_TMO], 1u); break; } }
    }
    nloc = mine > 0u ? mine : 1u; nx = cnt > 0u ? cnt : 1u;
}

__device__ __forceinline__ void xcd_barrier(const XcdBarrier& b) {
    asm volatile("s_waitcnt vmcnt(0)" ::: "memory");
    __syncthreads();
    if (threadIdx.x == 0) {
        unsigned* bar = b.bar;
        __builtin_amdgcn_s_waitcnt(0);
        unsigned nloc = b.st[0], nx = b.st[1];
        if (nloc == 0u) { xcd_barrier_complete(bar, b.x, nloc, nx); b.st[0] = nloc; b.st[1] = nx; }
        const unsigned old = xb_add(&bar[XB_XSUB(b.x)], 1u);
        const unsigned gen = old / nloc;
        if (old + 1u == (gen + 1u) * nloc) {
            __builtin_amdgcn_fence(__ATOMIC_RELEASE, "agent");
            asm volatile("s_waitcnt vmcnt(0)" ::: "memory");
            const unsigned og = xb_add(&bar[XB_TOP], 1u);
            const unsigned tg = og / nx;
            if (og + 1u == (tg + 1u) * nx) xb_add(&bar[XB_TOPGEN], 1u);
            else XB_SPIN(xb_ld(&bar[XB_TOPGEN]) == tg, bar);
            __builtin_amdgcn_fence(__ATOMIC_ACQUIRE, "agent");
            xb_add(&bar[XB_XGEN(b.x)], 1u);
            asm volatile("s_waitcnt vmcnt(0)" ::: "memory");
        } else {
            XB_SPIN(xb_ld(&bar[XB_XGEN(b.x)]) == gen, bar);
            __builtin_amdgcn_fence(__ATOMIC_ACQUIRE, "agent");
            asm volatile("s_waitcnt vmcnt(0)" ::: "memory");
        }
    }
    __syncthreads();
}
typedef unsigned v2u __attribute__((ext_vector_type(2)));
constexpr int NWAVES = 8, NTHR = 512;
constexpr int DM = 1024, TP = 16384, TS = 512, T = TP + TS;
constexpr int SEQ = 2048, NBP = 8, NBS = 128, LS = 4, MEMR = 2048;
constexpr int NPROJ = 11520;
constexpr int FFN = 2816;
constexpr float EPS = 1e-6f;
constexpr float QSCALE = 0.0625f * 1.4426950408889634f;

constexpr size_t MiB = 1u << 20;
constexpr size_t WS_CTL = 0, CTL_ZERO_BYTES = 1 * MiB;
constexpr size_t WS_SSQX = 1 * MiB, WS_SSQM = 1 * MiB + 512 * 1024;
constexpr size_t WS_DT = 2 * MiB, WS_SSQSSD = 5 * MiB, WS_SSQP1 = 8 * MiB, WS_SSQP2 = 9 * MiB + 512 * 1024, WS_SSQP3 = 11 * MiB;
constexpr size_t WS_WIN = 13 * MiB, WS_WKV = 36 * MiB, WS_WSSD = 40 * MiB, WS_WHG = 44 * MiB, WS_WOUT = 46 * MiB, WS_WCQ = 48 * MiB, WS_WCO = 50 * MiB, WS_WGU = 52 * MiB, WS_WDN = 63 * MiB;
constexpr size_t WS_XB = 69 * MiB, WS_MNB = 102 * MiB, WS_KB = 106 * MiB, WS_VT = 110 * MiB;
constexpr size_t SLOT = 33 * MiB, SLOT_ELEMS = (size_t)T * 1024;
constexpr size_t WS_PROJ = 114 * MiB;
constexpr size_t WS_YG = WS_PROJ + 11 * SLOT, WS_ON = WS_YG + 2 * SLOT, WS_END = WS_ON + SLOT;
static_assert(SLOT == SLOT_ELEMS * 2, "slot size");
static_assert(WS_WIN + (size_t)NPROJ * 1024 * 2 <= WS_WKV && WS_WGU + (size_t)2 * FFN * 1024 * 2 <= WS_WDN && WS_WDN + (size_t)1024 * FFN * 2 <= WS_XB && WS_SSQP3 + (size_t)T * 64 <= WS_WIN, "d_ws map");
static_assert(WS_DT + (size_t)T * 128 <= WS_SSQSSD && WS_SSQSSD + (size_t)T * 128 <= WS_SSQP1 && WS_SSQP1 + (size_t)T * 64 <= WS_SSQP2 && WS_SSQP2 + (size_t)T * 64 <= WS_SSQP3, "d_ws map 2");
enum { S_Z0 = 0, S_Z1 = 1, S_X0 = 2, S_X1 = 3, S_X2 = 4, S_Q = 5, S_F = 6, S_I = 7, S_HG = 8, S_GS = 9, S_GH = 10 };
constexpr size_t WS_MERGED = WS_PROJ + S_Q * SLOT, WS_HB = WS_PROJ + S_F * SLOT, WS_QB = WS_PROJ + S_I * SLOT, WS_OB = WS_PROJ + S_HG * SLOT, WS_ACT = WS_PROJ;
static_assert((size_t)T * FFN * 2 <= 3 * SLOT, "act overlay");
constexpr size_t O_Y = 0, O_SSMP = (size_t)T * 1024, O_CONVP = O_SSMP + 2097152, O_HGP = O_CONVP + 73728, O_MKP = O_HGP + 1048576, O_MVP = O_MKP + 2097152,
                 O_SSMS = O_MVP + 2097152, O_CONVS = O_SSMS + 33554432, O_HGS = O_CONVS + 1179648, O_END = O_HGS + 16777216;
constexpr int CW_QUEUE = 64;
constexpr int CW_BAR = 4096;
constexpr int RING_OFF = 0, RING_BYTES = 131072;
constexpr int LDS_BYTES = 147456;
constexpr int LDSCTL_OFF = LDS_BYTES - 1024, MISC_OFF = LDSCTL_OFF + 320;
struct Frame {
    LAS unsigned char* lds;
    volatile LAS unsigned* MISC;
    gu32* ctl;
    int tid, lane, wave;
    int vcu, G;
    const float* in[32];
    float* out; unsigned char* ws;
};
__device__ __forceinline__ float bf2f(unsigned v16) { return __uint_as_float(v16 << 16); }
__device__ __forceinline__ f32x4 ld_nt(const float* p) { return __builtin_nontemporal_load((const f32x4*)p); }
__device__ __forceinline__ void st_nt(float* p, f32x4 v) { __builtin_nontemporal_store(v, (f32x4*)p); }
__device__ __forceinline__ v4u ld_nt16(const void* p) { return __builtin_nontemporal_load((const v4u*)p); }
__device__ __forceinline__ unsigned ld_nt4(const void* p) { return __builtin_nontemporal_load((const unsigned*)p); }
__device__ __forceinline__ float sigmoid_f(float x) { return __builtin_amdgcn_rcpf(1.0f + __expf(-x)); }
__device__ __forceinline__ float silu_f(float x) { return x * sigmoid_f(x); }
__device__ __forceinline__ float wave_sum(float v) {
#pragma unroll
    for (int o = 1; o < 64; o <<= 1) v += __shfl_xor(v, o);
    return v;
}
__device__ __forceinline__ float wave_max(float v) {
#pragma unroll
    for (int o = 1; o < 64; o <<= 1) v = fmaxf(v, __shfl_xor(v, o));
    return v;
}
struct TSrc { const float* W; const float* W2; const float* ks; int ldw; int mode; };
__device__ __forceinline__ void p0_transpose_item(const TSrc& s, int K, int N, bf16* WT, LAS unsigned short* scr, int item, int lane) {
    const int nblk = N / 64, kb = item / nblk, nb = item % nblk, k0 = 64 * kb, n0 = 64 * nb;
    const int kr = lane >> 4, nq = lane & 15;
    const float* const Wa = s.W; const float* const Wb = s.W2;
    const float* src; int c0, cs; bool zero = false;
    if (s.mode == 2) { const float* wsel = Wa; if (nq >= 8) wsel = Wb; src = wsel + (n0 >> 1) + 4 * (nq & 7); c0 = 8 * (nq & 7) + (nq >> 3); cs = 2; }
    else { const int n = n0 + 4 * nq; c0 = 4 * nq; cs = 1;
        if (s.mode == 0) src = Wa + n;
        else if (s.mode == 1) { if (n < 5120) src = Wa + n; else if (n < 11264) src = Wa + n + 32; else if (n < 11296) src = Wa + 5120 + (n - 11264); else { src = Wa; zero = true; } }
        else { src = Wa + n; if (n >= 1024) src = Wb + (n - 1024); } }
    f32x4 v[16];
#pragma unroll
    for (int i = 0; i < 16; ++i) v[i] = zero ? (f32x4){0.f, 0.f, 0.f, 0.f} : ld_nt(src + (size_t)(k0 + 4 * i + kr) * s.ldw);
#pragma unroll
    for (int i = 0; i < 16; ++i) { const int kk = 4 * i + kr; const float sc = s.ks ? s.ks[k0 + kk] : 1.0f; const unsigned w0 = pk2(v[i].x * sc, v[i].y * sc), w1 = pk2(v[i].z * sc, v[i].w * sc);
        LAS unsigned short* d = scr + kk * 66 + c0;
        if (cs == 1) { *(LAS unsigned*)d = w0; *(LAS unsigned*)(d + 2) = w1; }
        else { d[0] = (unsigned short)(w0 & 0xffffu); d[2] = (unsigned short)(w0 >> 16); d[4] = (unsigned short)(w1 & 0xffffu); d[6] = (unsigned short)(w1 >> 16); } }
    LDS_WAIT(); asm volatile("" ::: "memory");
    const int nr = lane >> 3, kc = lane & 7;
#pragma unroll
    for (int j = 0; j < 8; ++j) { const int n = 8 * j + nr; const LAS unsigned short* p = scr + (8 * kc) * 66 + n;
        v4u o; o.x = (unsigned)p[0] | ((unsigned)p[66] << 16); o.y = (unsigned)p[2 * 66] | ((unsigned)p[3 * 66] << 16); o.z = (unsigned)p[4 * 66] | ((unsigned)p[5 * 66] << 16); o.w = (unsigned)p[6 * 66] | ((unsigned)p[7 * 66] << 16);
        *(v4u*)(WT + (size_t)(n0 + n) * K + k0 + 8 * kc) = o; }
    LDS_WAIT(); asm volatile("" ::: "memory");
}
__device__ __forceinline__ void rows4_to_bf16_ssq(const float* x0, bf16* o0, float* ssq0, int lane) {
    f32x4 v[4][4];
#pragma unroll
    for (int rr = 0; rr < 4; ++rr)
#pragma unroll
        for (int j = 0; j < 4; ++j) v[rr][j] = ld_nt(x0 + rr * 1024 + 4 * (64 * j + lane));
#pragma unroll
    for (int rr = 0; rr < 4; ++rr) { float sq = 0.f;
#pragma unroll
        for (int j = 0; j < 4; ++j) sq += (v[rr][j].x * v[rr][j].x + v[rr][j].y * v[rr][j].y) + (v[rr][j].z * v[rr][j].z + v[rr][j].w * v[rr][j].w);
        sq = wave_sum(sq);
        unsigned long long* o8 = (unsigned long long*)(o0 + rr * 1024) + lane;
#pragma unroll
        for (int j = 0; j < 4; ++j) o8[64 * j] = (unsigned long long)pk2(v[rr][j].x, v[rr][j].y) | ((unsigned long long)pk2(v[rr][j].z, v[rr][j].w) << 32);
        if (lane == 0) ssq0[rr] = sq; }
}
__device__ __forceinline__ void p0_prologue(Frame& F) {
    LAS unsigned short* scr = (LAS unsigned short*)(F.lds + RING_OFF + F.wave * 16384);
    const int gw = F.vcu * NWAVES + F.wave, NGW = F.G * NWAVES;
    unsigned char* ws = F.ws;
    constexpr int I_IN = 16 * (NPROJ / 64), I_KV = 16 * 32, I_SSD = 32 * 16, I_SQ = 16 * 16, I_GU = 16 * (2 * FFN / 64), I_DN = (FFN / 64) * 16;
    constexpr int NITEMS = I_IN + I_KV + I_SSD + 4 * I_SQ + I_GU + I_DN;
    for (int it = gw; it < NITEMS; it += NGW) {
        int r = it;
        if (r < I_IN) { TSrc s{F.in[9], nullptr, F.in[8], 11296, 1}; p0_transpose_item(s, 1024, NPROJ, (bf16*)(ws + WS_WIN), scr, r, F.lane); continue; } r -= I_IN;
        if (r < I_KV) { TSrc s{F.in[24], F.in[25], F.in[22], 1024, 3}; p0_transpose_item(s, 1024, 2048, (bf16*)(ws + WS_WKV), scr, r, F.lane); continue; } r -= I_KV;
        if (r < I_SSD) { TSrc s{F.in[16], nullptr, F.in[15], 1024, 0}; p0_transpose_item(s, 2048, 1024, (bf16*)(ws + WS_WSSD), scr, r, F.lane); continue; } r -= I_SSD;
        if (r < I_SQ) { TSrc s{F.in[19], nullptr, F.in[18], 1024, 0}; p0_transpose_item(s, 1024, 1024, (bf16*)(ws + WS_WHG), scr, r, F.lane); continue; } r -= I_SQ;
        if (r < I_SQ) { TSrc s{F.in[20], nullptr, nullptr, 1024, 0}; p0_transpose_item(s, 1024, 1024, (bf16*)(ws + WS_WOUT), scr, r, F.lane); continue; } r -= I_SQ;
        if (r < I_SQ) { TSrc s{F.in[23], nullptr, F.in[21], 1024, 0}; p0_transpose_item(s, 1024, 1024, (bf16*)(ws + WS_WCQ), scr, r, F.lane); continue; } r -= I_SQ;
        if (r < I_SQ) { TSrc s{F.in[26], nullptr, nullptr, 1024, 0}; p0_transpose_item(s, 1024, 1024, (bf16*)(ws + WS_WCO), scr, r, F.lane); continue; } r -= I_SQ;
        if (r < I_GU) { TSrc s{F.in[28], F.in[29], F.in[27], FFN, 2}; p0_transpose_item(s, 1024, 2 * FFN, (bf16*)(ws + WS_WGU), scr, r, F.lane); continue; } r -= I_GU;
        { TSrc s{F.in[30], nullptr, nullptr, 1024, 0}; p0_transpose_item(s, FFN, 1024, (bf16*)(ws + WS_WDN), scr, r, F.lane); }
    }
    bf16* XB = (bf16*)(ws + WS_XB); float* SSQX = (float*)(ws + WS_SSQX);
    for (int m4 = gw; m4 < T / 4; m4 += NGW) { const int m = 4 * m4;
        rows4_to_bf16_ssq(m < TP ? F.in[0] + (size_t)m * DM : F.in[1] + (size_t)(m - TP) * DM, XB + (size_t)m * DM, SSQX + m, F.lane); }
    bf16* MNB = (bf16*)(ws + WS_MNB); float* SSQM = (float*)(ws + WS_SSQM);
    for (int m4 = gw; m4 < MEMR / 4; m4 += NGW) { const int m = 4 * m4; rows4_to_bf16_ssq(F.in[2] + (size_t)m * DM, MNB + (size_t)m * DM, SSQM + m, F.lane); }
}
__device__ __forceinline__ void conv_copy_unit(Frame& F, int gb) {
    const bf16* PROJ = (const bf16*)(F.ws + WS_PROJ);
    const bool prompt = gb < NBP; const int sb = gb - NBP;
    const size_t row0 = prompt ? (size_t)gb * SEQ + (SEQ - 3) : (size_t)TP + (size_t)sb * LS + 1;
    float* dst = prompt ? F.out + O_CONVP + (size_t)gb * 3 * 3072 : F.out + O_CONVS + (size_t)sb * 3 * 3072;
    for (int e = F.tid; e < 3 * 3072; e += NTHR) { const int j = e / 3072, col = e % 3072;
        dst[e] = bf2f(PROJ[(size_t)(S_X0 + (col >> 10)) * SLOT_ELEMS + (row0 + j) * 1024 + (col & 1023)]); }
}
__device__ __forceinline__ void ssdnorm_phase(Frame& F) {
    const int gw = F.vcu * NWAVES + F.wave, NGW = F.G * NWAVES; bf16* YG = (bf16*)(F.ws + WS_YG); const float* SSQ = (const float*)(F.ws + WS_SSQSSD);
    for (int row = gw; row < T; row += NGW) {
        const f32x4* sp = (const f32x4*)(SSQ + (size_t)row * 32);
#pragma unroll
        for (int j = 0; j < 4; ++j) { const f32x4 a = sp[2 * j], b = sp[2 * j + 1]; const float s = ((a.x + a.y) + (a.z + a.w)) + ((b.x + b.y) + (b.z + b.w)); const float rs = 1.0f / sqrtf(s * (1.0f / 512.0f) + EPS);
            v4u* p = (v4u*)(YG + (size_t)row * 2048) + j * 64 + F.lane; const v4u w = *p; v4u o;
#pragma unroll
            for (int e = 0; e < 4; ++e) o[e] = pk2(bf2f(w[e] & 0xffffu) * rs, bf2f(w[e] >> 16) * rs);
            *p = o; }
    }
}
typedef float f32x16 __attribute__((ext_vector_type(16)));
#define MFMA32(a, b, c) __builtin_amdgcn_mfma_f32_32x32x16_bf16((a), (b), (c), 0, 0, 0)
__device__ __forceinline__ unsigned cvtpk_c(float lo, float hi) { return pk2(lo, hi); }
__device__ __forceinline__ bf16x8 pack8(float a0, float a1, float a2, float a3, float a4, float a5, float a6, float a7) {
    v4u w; w.x = cvtpk_c(a0, a1); w.y = cvtpk_c(a2, a3); w.z = cvtpk_c(a4, a5); w.w = cvtpk_c(a6, a7); return __builtin_bit_cast(bf16x8, w); }
#define ACC_FRAG(x, s) pack8((x)[8 * (s)], (x)[8 * (s) + 1], (x)[8 * (s) + 2], (x)[8 * (s) + 3], (x)[8 * (s) + 4], (x)[8 * (s) + 5], (x)[8 * (s) + 6], (x)[8 * (s) + 7])
__device__ __forceinline__ bf16x8 lds_frag16(const LAS unsigned char* p) { return *(const LAS bf16x8*)p; }
__device__ __forceinline__ bf16x8 lds_frag8x2(const LAS unsigned char* p) { const v2u lo = *(const LAS v2u*)p, hi = *(const LAS v2u*)(p + 16);
    const v4u w = (v4u){lo.x, lo.y, hi.x, hi.y}; return __builtin_bit_cast(bf16x8, w); }
#define LDS_BARRIER() do { asm volatile("s_waitcnt lgkmcnt(0)" ::: "memory"); __builtin_amdgcn_s_barrier(); asm volatile("" ::: "memory"); } while (0)
constexpr size_t WS_BCS = WS_END, WS_BTT = WS_BCS + (size_t)TP * 1024 * 2, WS_END2 = WS_BTT + (size_t)NBP * 32 * 4 * 128 * 64 * 2;
__device__ __forceinline__ void bc_prep_unit(Frame& F, int b, int c) {
    typedef float f32x2 __attribute__((ext_vector_type(2)));
    int tid_o = F.tid; asm volatile("" : "+v"(tid_o));
    const int tid = tid_o, cg = tid & 127, seg = tid >> 7; unsigned char* ws = F.ws;
    const bf16* src = (const bf16*)(ws + WS_PROJ) + (size_t)S_X2 * SLOT_ELEMS + (size_t)b * SEQ * 1024 + 8 * cg;
    bf16* BCS = (bf16*)(ws + WS_BCS); bf16* BTT = (bf16*)(ws + WS_BTT);
    const float* cw = F.in[10] + 2048 + 8 * cg; const float* cbp = F.in[11] + 2048 + 8 * cg;
#pragma unroll 1
    for (int half = 0; half < 2; ++half) {
        const int s0 = 16 * seg + 8 * half;
        v4u raw[11];
#pragma unroll
        for (int i = 0; i < 11; ++i) { const int gt = 64 * c + s0 - 3 + i; raw[i] = (v4u){0u, 0u, 0u, 0u}; if (gt >= 0) raw[i] = ld_nt16(src + (size_t)gt * 1024); }
        v4u rowpk[8];
#pragma unroll
        for (int kp = 0; kp < 4; ++kp) {
            const f32x2 cw0 = *(const f32x2*)(cw + 2 * kp), cw1 = *(const f32x2*)(cw + 3072 + 2 * kp), cw2 = *(const f32x2*)(cw + 2 * 3072 + 2 * kp), cw3 = *(const f32x2*)(cw + 3 * 3072 + 2 * kp), cbb = *(const f32x2*)(cbp + 2 * kp);
            f32x2 xv[11];
#pragma unroll
            for (int i = 0; i < 11; ++i) { const unsigned wd = raw[i][kp]; xv[i] = (f32x2){__uint_as_float(wd << 16), __uint_as_float(wd & 0xffff0000u)}; }
            f32x2 o[8];
#pragma unroll
            for (int i = 0; i < 8; ++i) { f32x2 a = cw0 * xv[i] + cbb; a = cw1 * xv[i + 1] + a; a = cw2 * xv[i + 2] + a; a = cw3 * xv[i + 3] + a;
                const f32x2 t = a * (-1.4426950408889634f); f32x2 e; e.x = __builtin_amdgcn_exp2f(t.x); e.y = __builtin_amdgcn_exp2f(t.y); e = e + 1.0f;
                f32x2 rc; rc.x = __builtin_amdgcn_rcpf(e.x); rc.y = __builtin_amdgcn_rcpf(e.y); o[i] = a * rc; }
#pragma unroll
            for (int i = 0; i < 8; ++i) rowpk[i][kp] = pk2(o[i].x, o[i].y);
            if (cg < 64) { const int ng = 8 * cg + 2 * kp, g = ng >> 7, n = ng & 127;
                bf16* dst = BTT + ((size_t)(((b * 32 + c) * 4 + g) * 128 + n)) * 64 + s0;
                v4u pa; pa.x = pk2(o[0].x, o[1].x); pa.y = pk2(o[2].x, o[3].x); pa.z = pk2(o[4].x, o[5].x); pa.w = pk2(o[6].x, o[7].x); *(v4u*)dst = pa;
                v4u pb; pb.x = pk2(o[0].y, o[1].y); pb.y = pk2(o[2].y, o[3].y); pb.z = pk2(o[4].y, o[5].y); pb.w = pk2(o[6].y, o[7].y); *(v4u*)(dst + 64) = pb; }
        }
        bf16* drow = BCS + ((size_t)b * SEQ + 64 * c + s0) * 1024 + 8 * cg;
#pragma unroll
        for (int i = 0; i < 8; ++i) *(v4u*)(drow + (size_t)i * 1024) = rowpk[i];
    }
}
__device__ __forceinline__ void bc_prep_phase(Frame& F) { for (int u = F.vcu; u < NBP * 32; u += F.G) bc_prep_unit(F, u >> 5, u & 31); }
constexpr size_t WS_HVT = WS_XB, WS_EGM = WS_END2, WS_EGL = WS_EGM + (size_t)NBP * 64 * 1024 * 4, WS_END3 = WS_EGL + (size_t)NBP * 64 * 1024 * 4;
__device__ __forceinline__ void hg_prep_unit(Frame& F, int b, int c) {
    typedef float f32x2 __attribute__((ext_vector_type(2)));
    int tid_o = F.tid; asm volatile("" : "+v"(tid_o));
    const int tid = tid_o; unsigned char* ws = F.ws;
    const int ch = 2 * tid, hd = ch >> 7, k = ch & 127;
    const size_t row0 = (size_t)b * SEQ + 32 * c;
    bf16* QS = (bf16*)(ws + WS_PROJ) + (size_t)S_Q * SLOT_ELEMS + row0 * 1024 + ch; bf16* FS = (bf16*)(ws + WS_PROJ) + (size_t)S_F * SLOT_ELEMS + row0 * 1024 + ch;
    bf16* IS = (bf16*)(ws + WS_PROJ) + (size_t)S_I * SLOT_ELEMS + row0 * 1024;
    const f32x2 l0 = *(const f32x2*)(F.in[17] + ch), l1 = *(const f32x2*)(F.in[17] + 1024 + ch);
    f32x2 lb; lb.x = __builtin_amdgcn_rcpf(1.0f + __expf(l1.x - l0.x)); lb.y = __builtin_amdgcn_rcpf(1.0f + __expf(l1.y - l0.y));
    const f32x2 omlb = 1.0f - lb;
    f32x2 P[32]; f32x2 run = (f32x2){1.0f, 1.0f};
#pragma unroll
    for (int t = 0; t < 32; ++t) { const unsigned wd = ld_nt4(FS + (size_t)t * 1024);
        f32x2 u = (f32x2){__uint_as_float(wd << 16), __uint_as_float(wd & 0xffff0000u)}; u.x = fminf(fmaxf(u.x, -30.f), 30.f); u.y = fminf(fmaxf(u.y, -30.f), 30.f);
        const f32x2 tt = u * (-1.4426950408889634f); f32x2 e; e.x = __builtin_amdgcn_exp2f(tt.x); e.y = __builtin_amdgcn_exp2f(tt.y); e = e + 1.0f;
        f32x2 sg; sg.x = __builtin_amdgcn_rcpf(e.x); sg.y = __builtin_amdgcn_rcpf(e.y);
        const f32x2 fg = lb + omlb * sg; run = run * fg; run.x = fmaxf(run.x, 1e-30f); run.y = fmaxf(run.y, 1e-30f); P[t] = run; }
    const f32x2 Pm = P[15], Pl = P[31]; f32x2 rPm; rPm.x = __builtin_amdgcn_rcpf(Pm.x); rPm.y = __builtin_amdgcn_rcpf(Pm.y);
    *(f32x2*)((float*)(ws + WS_EGM) + (size_t)(b * 64 + c) * 1024 + ch) = Pm; *(f32x2*)((float*)(ws + WS_EGL) + (size_t)(b * 64 + c) * 1024 + ch) = Pl * rPm;
    unsigned kx[16], ky[16], vx[16], vy[16];
    f32x2 rPprev = (f32x2){1.0f, 1.0f}; f32x2 kprev = (f32x2){0.f, 0.f}; unsigned iprev = 0u;
#pragma unroll
    for (int t = 0; t < 32; ++t) { f32x2 rP; rP.x = __builtin_amdgcn_rcpf(P[t].x); rP.y = __builtin_amdgcn_rcpf(P[t].y);
        const f32x2 e1 = P[t] * rPm, e2 = Pm * rP, fg = P[t] * rPprev, kk = 1.0f - fg; rPprev = rP;
        const unsigned qw = ld_nt4(QS + (size_t)t * 1024); const f32x2 q = (f32x2){__uint_as_float(qw << 16), __uint_as_float(qw & 0xffff0000u)};
        const f32x2 tq = q * (-1.4426950408889634f); f32x2 eq; eq.x = __builtin_amdgcn_exp2f(tq.x); eq.y = __builtin_amdgcn_exp2f(tq.y); eq = eq + 1.0f;
        f32x2 rq; rq.x = __builtin_amdgcn_rcpf(eq.x); rq.y = __builtin_amdgcn_rcpf(eq.y);
        const f32x2 qa = q * rq * e1, ka = kk * e2;
        *(unsigned*)(QS + (size_t)t * 1024) = pk2(qa.x, qa.y); *(unsigned*)(FS + (size_t)t * 1024) = pk2(ka.x, ka.y);
        const unsigned iw = ld_nt4(IS + (size_t)t * 1024 + ch);
        if (t & 1) { kx[t >> 1] = pk2(kprev.x, ka.x); ky[t >> 1] = pk2(kprev.y, ka.y); vx[t >> 1] = (iprev & 0xffffu) | (iw << 16); vy[t >> 1] = (iprev >> 16) | (iw & 0xffff0000u); }
        kprev = ka; iprev = iw; }
    bf16* VTg = (bf16*)(ws + WS_HVT) + ((size_t)((b * 64 + c) * 8 + hd) * 128 + k) * 32;
#pragma unroll
    for (int j = 0; j < 4; ++j) { *(v4u*)(VTg + 8 * j) = (v4u){vx[4 * j], vx[4 * j + 1], vx[4 * j + 2], vx[4 * j + 3]}; *(v4u*)(VTg + 32 + 8 * j) = (v4u){vy[4 * j], vy[4 * j + 1], vy[4 * j + 2], vy[4 * j + 3]}; }
    __syncthreads();
    bf16* KTg = IS + ((size_t)hd * 128 + k) * 32;
#pragma unroll
    for (int j = 0; j < 4; ++j) { *(v4u*)(KTg + 8 * j) = (v4u){kx[4 * j], kx[4 * j + 1], kx[4 * j + 2], kx[4 * j + 3]}; *(v4u*)(KTg + 32 + 8 * j) = (v4u){ky[4 * j], ky[4 * j + 1], ky[4 * j + 2], ky[4 * j + 3]}; }
    __syncthreads();
}
__device__ __forceinline__ void hg_prep_phase(Frame& F) { for (int u = F.vcu; u < NBP * 64; u += F.G) hg_prep_unit(F, u >> 6, u & 63); }
constexpr int HV_QA = 0, HV_KA = 8704, HV_KAT = 17408, HV_VT = 27648, HV_EGM = 30208, HV_EGL = 30720, HV_PBUF = 31232, HV_OB = 2 * HV_PBUF, HV_OBUF = 23040;
constexpr size_t WS_SSQH = WS_END3, WS_END4 = WS_SSQH + (size_t)T * 32 * 4;
__device__ __forceinline__ void hgrn_v_unit(Frame& F, int b, int hd, int vt) {
    int tid_o = F.tid; asm volatile("" : "+v"(tid_o));
    const int tid = tid_o, lane = tid & 63, w = F.wave, r = lane & 31, hh = lane >> 5; unsigned char* ws = F.ws;
    LAS unsigned char* Lb = F.lds + RING_OFF;
    const bf16* PROJ = (const bf16*)(ws + WS_PROJ); bf16* OU = (bf16*)(ws + WS_ON); float* SSQH = (float*)(ws + WS_SSQH);
    const size_t rowb = (size_t)b * SEQ;
    const bf16* qsrc = PROJ + (size_t)S_Q * SLOT_ELEMS + (rowb + (tid >> 4)) * 1024 + hd * 128 + 8 * (tid & 15);
    const bf16* ksrc = PROJ + (size_t)S_F * SLOT_ELEMS + (rowb + (tid >> 4)) * 1024 + hd * 128 + 8 * (tid & 15);
    const bf16* tsrc = PROJ + (size_t)S_I * SLOT_ELEMS + rowb * 1024 + (size_t)(hd * 128 + (tid >> 2)) * 32 + 8 * (tid & 3);
    const unsigned char* xsrc = nullptr; size_t xstr = 0;
    if (tid < 128) { xsrc = (const unsigned char*)((const bf16*)(ws + WS_HVT) + ((size_t)(b * 64 * 8 + hd) * 128 + 32 * vt + (tid >> 2)) * 32 + 8 * (tid & 3)); xstr = (size_t)8 * 128 * 32 * 2; }
    else if (tid < 160) { xsrc = (const unsigned char*)((const float*)(ws + WS_EGM) + (size_t)b * 64 * 1024 + hd * 128 + 4 * (tid - 128)); xstr = 4096; }
    else if (tid < 192) { xsrc = (const unsigned char*)((const float*)(ws + WS_EGL) + (size_t)b * 64 * 1024 + hd * 128 + 4 * (tid - 160)); xstr = 4096; }
    const int xdst = tid < 128 ? HV_VT + (tid >> 2) * 80 + 16 * (tid & 3) : (tid < 160 ? HV_EGM + 16 * (tid - 128) : HV_EGL + 16 * (tid - 160));
#define HGV_LOAD(cc, pq, pk, pt, px) { pq = *(const v4u*)(qsrc + (size_t)(cc) * 32 * 1024); pk = *(const v4u*)(ksrc + (size_t)(cc) * 32 * 1024); pt = *(const v4u*)(tsrc + (size_t)(cc) * 32768); if (tid < 192) px = *(const v4u*)(xsrc + (size_t)(cc) * xstr); }
#define HGV_STORE(pb, pq, pk, pt, px) { *(LAS v4u*)((pb) + HV_QA + (tid >> 4) * 272 + 16 * (tid & 15)) = pq; *(LAS v4u*)((pb) + HV_KA + (tid >> 4) * 272 + 16 * (tid & 15)) = pk; \
        *(LAS v4u*)((pb) + HV_KAT + (tid >> 2) * 80 + 16 * (tid & 3)) = pt; if (tid < 192) *(LAS v4u*)((pb) + xdst) = px; }
    v4u pqA, pkA, ptA, pxA = (v4u){0u, 0u, 0u, 0u}, pqB, pkB, ptB, pxB = (v4u){0u, 0u, 0u, 0u};
    HGV_LOAD(0, pqA, pkA, ptA, pxA) HGV_STORE(Lb, pqA, pkA, ptA, pxA)
    HGV_LOAD(1, pqA, pkA, ptA, pxA) HGV_LOAD(2, pqB, pkB, ptB, pxB)
    const int kt = w;
    v2u ow_pend = (v2u){0u, 0u}; float sq_pend = 0.f;
    f32x16 S;
#pragma unroll
    for (int i = 0; i < 16; ++i) S[i] = 0.f;
    __syncthreads();
#define HGV_ITER(c, pq, pk, pt, px) { \
        int r_l = r, hh_l = hh, tid_l = tid; asm volatile("" : "+v"(r_l), "+v"(hh_l), "+v"(tid_l)); \
        { const int r = r_l, hh = hh_l, tid = tid_l; \
        LAS unsigned char* pbc = Lb + ((c) & 1) * HV_PBUF; LAS unsigned char* pbn = Lb + (((c) + 1) & 1) * HV_PBUF; \
        if ((c) < 63) { HGV_STORE(pbn, pq, pk, pt, px) if ((c) < 61) HGV_LOAD((c) + 3, pq, pk, pt, px) } \
        if (w < 4) { \
            LAS float* EGM = (LAS float*)(pbc + HV_EGM); LAS float* EGL = (LAS float*)(pbc + HV_EGL); LAS float* OB = (LAS float*)(Lb + HV_OB + ((c) & 1) * HV_OBUF); \
            _Pragma("unroll") \
            for (int q4 = 0; q4 < 4; ++q4) { const f32x4 e0 = *(const LAS f32x4*)(EGM + 32 * kt + 8 * q4 + 4 * hh); \
                _Pragma("unroll") \
                for (int j = 0; j < 4; ++j) S[4 * q4 + j] *= e0[j]; } \
            f32x16 o; \
            _Pragma("unroll") \
            for (int i = 0; i < 16; ++i) o[i] = 0.f; \
            const LAS unsigned char* qa_row = pbc + HV_QA + r * 272; \
            o = MFMA32(lds_frag8x2(qa_row + (32 * kt + 4 * hh) * 2), ACC_FRAG(S, 0), o); \
            o = MFMA32(lds_frag8x2(qa_row + (32 * kt + 16 + 4 * hh) * 2), ACC_FRAG(S, 1), o); \
            LAS float* ob = OB + (kt * 32) * 36 + r; \
            _Pragma("unroll") \
            for (int i = 0; i < 16; ++i) ob[((i & 3) + 8 * (i >> 2) + 4 * hh) * 36] = o[i]; \
            const LAS unsigned char* kat_nat = pbc + HV_KAT + (32 * kt + r) * 80 + hh * 16; const LAS unsigned char* vt_nat = pbc + HV_VT + r * 80 + hh * 16; \
            S = MFMA32(lds_frag16(kat_nat), lds_frag16(vt_nat), S); S = MFMA32(lds_frag16(kat_nat + 32), lds_frag16(vt_nat + 32), S); \
            _Pragma("unroll") \
            for (int q4 = 0; q4 < 4; ++q4) { const f32x4 e0 = *(const LAS f32x4*)(EGL + 32 * kt + 8 * q4 + 4 * hh); \
                _Pragma("unroll") \
                for (int j = 0; j < 4; ++j) S[4 * q4 + j] *= e0[j]; } \
        } else { \
            if (w == 4) { LAS float* OB = (LAS float*)(Lb + HV_OB + ((c) & 1) * HV_OBUF); f32x16 o; \
                _Pragma("unroll") \
                for (int i = 0; i < 16; ++i) o[i] = 0.f; \
                f32x16 X; \
                _Pragma("unroll") \
                for (int i = 0; i < 16; ++i) X[i] = 0.f; \
                const LAS unsigned char* ka_nat = pbc + HV_KA + r * 272 + hh * 16; const LAS unsigned char* qa_nat = pbc + HV_QA + r * 272 + hh * 16; \
                _Pragma("unroll 2") \
                for (int ks = 0; ks < 8; ++ks) X = MFMA32(lds_frag16(ka_nat + ks * 32), lds_frag16(qa_nat + ks * 32), X); \
                _Pragma("unroll") \
                for (int i = 0; i < 16; ++i) { const int srow = (i & 3) + 8 * (i >> 2) + 4 * hh; X[i] = (srow <= r) ? X[i] : 0.f; } \
                const LAS unsigned char* vt_row = pbc + HV_VT + r * 80; \
                o = MFMA32(ACC_FRAG(X, 0), lds_frag8x2(vt_row + (4 * hh) * 2), o); \
                o = MFMA32(ACC_FRAG(X, 1), lds_frag8x2(vt_row + (16 + 4 * hh) * 2), o); \
                LAS float* ob4 = OB + (4 * 32) * 36 + r; \
                _Pragma("unroll") \
                for (int i = 0; i < 16; ++i) ob4[((i & 3) + 8 * (i >> 2) + 4 * hh) * 36] = o[i]; \
            } \
            if ((c) > 1) { HGV_FLUSH((c) - 2) } \
            if ((c) > 0) { HGV_OUT((c) - 1) } \
        } \
        LDS_BARRIER(); \
        } }
#define HGV_OUT(cp) { const LAS float* OB = (const LAS float*)(Lb + HV_OB + ((cp) & 1) * HV_OBUF); const int tl = tid - 256, t = tl >> 3, v0 = (tl & 7) * 4; \
            const f32x4 a = *(const LAS f32x4*)(OB + t * 36 + v0), b2 = *(const LAS f32x4*)(OB + (32 + t) * 36 + v0), c2 = *(const LAS f32x4*)(OB + (64 + t) * 36 + v0), d2 = *(const LAS f32x4*)(OB + (96 + t) * 36 + v0), e2 = *(const LAS f32x4*)(OB + (128 + t) * 36 + v0); \
            const f32x4 o4 = ((a + b2) + (c2 + d2)) + e2; \
            float sq = (o4.x * o4.x + o4.y * o4.y) + (o4.z * o4.z + o4.w * o4.w); sq += __shfl_xor(sq, 1); sq += __shfl_xor(sq, 2); sq += __shfl_xor(sq, 4); \
            sq_pend = sq; ow_pend.x = pk2(o4.x, o4.y); ow_pend.y = pk2(o4.z, o4.w); }
#define HGV_FLUSH(cp) { const int tl = tid - 256, t = tl >> 3, v0 = (tl & 7) * 4; const size_t row = rowb + 32 * (cp) + t; \
            if ((tl & 7) == 0) SSQH[row * 32 + hd * 4 + vt] = sq_pend; *(v2u*)(OU + row * 1024 + hd * 128 + 32 * vt + v0) = ow_pend; }
#pragma unroll 1
    for (int cc = 0; cc < 64; cc += 2) { HGV_ITER(cc, pqA, pkA, ptA, pxA) HGV_ITER(cc + 1, pqB, pkB, ptB, pxB) }
    if (w >= 4) { HGV_FLUSH(62) HGV_OUT(63) HGV_FLUSH(63) }
#undef HGV_ITER
#undef HGV_OUT
#undef HGV_FLUSH
#undef HGV_LOAD
#undef HGV_STORE
    if (w < 4) { float* st_g = F.out + O_HGP + (size_t)(b * 8 + hd) * 16384 + 32 * vt + r;
#pragma unroll
        for (int i = 0; i < 16; ++i) { const int k = 32 * kt + (i & 3) + 8 * (i >> 2) + 4 * hh; st_g[(size_t)k * 128] = S[i]; } }
    __syncthreads();
}
__device__ __forceinline__ void hgnorm_phase(Frame& F) {
    const int gw = F.vcu * NWAVES + F.wave, NGW = F.G * NWAVES; bf16* ON = (bf16*)(F.ws + WS_ON); const float* SSQH = (const float*)(F.ws + WS_SSQH);
    const bf16* HG = (const bf16*)(F.ws + WS_PROJ) + (size_t)S_HG * SLOT_ELEMS;
    for (int row = gw; row < TP; row += NGW) {
#pragma unroll
        for (int j = 0; j < 2; ++j) { const int pc = j * 64 + F.lane, hd = pc >> 4;
            const f32x4 sp = *(const f32x4*)(SSQH + (size_t)row * 32 + hd * 4); const float rs = __builtin_amdgcn_rsqf(((sp.x + sp.y) + (sp.z + sp.w)) * (1.0f / 128.0f) + EPS);
            v4u* p = (v4u*)(ON + (size_t)row * 1024) + pc; const v4u o = *p; const v4u g = ld_nt16((const v4u*)(HG + (size_t)row * 1024) + pc); v4u res;
#pragma unroll
            for (int e = 0; e < 4; ++e) res[e] = pk2(bf2f(o[e] & 0xffffu) * rs * silu_f(bf2f(g[e] & 0xffffu)), __uint_as_float(o[e] & 0xffff0000u) * rs * silu_f(__uint_as_float(g[e] & 0xffff0000u)));
            *p = res; }
    }
}
constexpr int SD_BN = 0, SD_CN = 17408, SD_BT = 34816, SD_XT = 53248, SD_HT = 62464, SD_YA = 97280, SD_YY = 113664, SD_YO = 130048, SD_CUM = 134144, SD_DTV = 134400, SD_ECUM = 134656, SD_XWT = 134912, SD_CWL = 144128;
__device__ __forceinline__ void ssd_unit_mfma(Frame& F, int gb, int h) {
    int tid_o = F.tid; asm volatile("" : "+v"(tid_o));
    const int tid = tid_o, lane = tid & 63, w = F.wave, r = lane & 31, hh = lane >> 5; unsigned char* ws = F.ws;
    const int L = SEQ; const size_t row_base = (size_t)gb * SEQ;
    const int g = h >> 3;
    LAS unsigned char* Lb = F.lds + RING_OFF;
    LAS unsigned short* BN = (LAS unsigned short*)(Lb + SD_BN); LAS unsigned short* CN = (LAS unsigned short*)(Lb + SD_CN);
    LAS unsigned short* BT = (LAS unsigned short*)(Lb + SD_BT); LAS unsigned short* XT = (LAS unsigned short*)(Lb + SD_XT);
    LAS unsigned short* HT = (LAS unsigned short*)(Lb + SD_HT);
    LAS unsigned short* XWT = (LAS unsigned short*)(Lb + SD_XWT);
    LAS float* YA = (LAS float*)(Lb + SD_YA); LAS float* YY = (LAS float*)(Lb + SD_YY); LAS unsigned short* YO = (LAS unsigned short*)(Lb + SD_YO);
    LAS float* CUM = (LAS float*)(Lb + SD_CUM); LAS float* DTV = (LAS float*)(Lb + SD_DTV); LAS float* ECUM = (LAS float*)(Lb + SD_ECUM);
    const bf16* PROJ = (const bf16*)(ws + WS_PROJ); const float* DTR = (const float*)(ws + WS_DT); bf16* YG = (bf16*)(ws + WS_YG); float* SSQ = (float*)(ws + WS_SSQSSD);
    const int nt = w >> 1, pt = w & 1;
    f32x16 H;
    float* st_g = F.out + O_SSMP + (size_t)(gb * 32 + h) * 8192 + (size_t)(32 * pt + r) * 128 + 32 * nt + 4 * hh;
#pragma unroll
    for (int i = 0; i < 16; ++i) H[i] = 0.f;
    {
        LAS unsigned short* hp = HT + (32 * pt + r) * 136 + 32 * nt + 4 * hh;
#pragma unroll
        for (int q4 = 0; q4 < 4; ++q4) { v2u pk; pk.x = cvtpk_c(H[4 * q4], H[4 * q4 + 1]); pk.y = cvtpk_c(H[4 * q4 + 2], H[4 * q4 + 3]); *(LAS v2u*)(hp + 8 * q4) = pk; }
    }
    const float a = -__expf(F.in[13][h]), dtb = F.in[12][h], Dk = F.in[14][h];
    const float* cw = F.in[10]; const float* cbp = F.in[11];
    const int cgl = tid & 7, xs = tid >> 3;
    const int col = h * 64 + 8 * cgl;
    const bf16* cptr = PROJ + (size_t)(S_X0 + (col >> 10)) * SLOT_ELEMS + row_base * 1024 + (col & 1023);
    const bf16* BCS = (const bf16*)(ws + WS_BCS) + row_base * 1024 + g * 128; const bf16* BTT = (const bf16*)(ws + WS_BTT) + (size_t)(gb * 32 * 4 + g) * 128 * 64;
    v4u xr[4], pc[6];
#pragma unroll
    for (int i = 0; i < 4; ++i) { const int gt = xs - 3 + i; xr[i] = (v4u){0u, 0u, 0u, 0u}; if (gt >= 0) xr[i] = *(const v4u*)(cptr + (size_t)gt * 1024); }
#pragma unroll
    for (int j = 0; j < 6; ++j) { const int idx = (tid + 512 * j) & 1023;
        if (j < 4) pc[j] = *(const v4u*)(BCS + (size_t)(idx >> 4) * 1024 + (j >> 1) * 512 + 8 * (idx & 15));
        else pc[j] = *(const v4u*)(BTT + (size_t)(idx >> 3) * 64 + 8 * (idx & 7)); }
    LAS float* CWL = (LAS float*)(Lb + SD_CWL);
    if (tid < 320) { const int j = tid >> 6, c = tid & 63; CWL[tid] = j < 4 ? cw[j * 3072 + h * 64 + c] : cbp[h * 64 + c]; }
    __syncthreads();
    v4u ow_pend = (v4u){0u, 0u, 0u, 0u}; float sq_pend = 0.f; bool pend = false;
    int buf = 0;
    float dt_pf = 0.f;
    if (lane < L) dt_pf = DTR[(row_base + lane) * 32 + h];
    for (int t0 = 0; t0 < L; t0 += 64, buf ^= 1) {
        int r_l = r, hh_l = hh, tid_l = tid, lane_l = lane;
        asm volatile("" : "+v"(r_l), "+v"(hh_l), "+v"(tid_l), "+v"(lane_l));
        { const int r = r_l, hh = hh_l, tid = tid_l, lane = lane_l;
        float dtv = 0.f;
        if (t0 + lane < L) { const float x = dt_pf + dtb; dtv = fmaxf(x, 0.f) + 0.6931471805599453f * __builtin_amdgcn_logf(1.0f + __builtin_amdgcn_exp2f(-1.4426950408889634f * fabsf(x))); }
        dt_pf = 0.f; if (t0 + 64 + lane < L) dt_pf = DTR[(row_base + t0 + 64 + lane) * 32 + h];
        v4u zw = (v4u){0u, 0u, 0u, 0u};
        if (t0 + (tid >> 3) < L) zw = ld_nt16(PROJ + (size_t)(S_Z0 + (h >> 4)) * SLOT_ELEMS + (row_base + t0 + (tid >> 3)) * 1024 + (h & 15) * 64 + (tid & 7) * 8);
        float cum = dtv * a;
#pragma unroll
        for (int o = 1; o < 64; o <<= 1) { const float u = __shfl_up(cum, o); if (lane >= o) cum += u; }
        const float cum_last = __shfl(cum, 63);
        const float wgt = __expf(cum_last - cum) * dtv;
        if (w == 0) { CUM[lane] = cum; DTV[lane] = dtv; ECUM[lane] = __expf(cum); }
#pragma unroll
        for (int j = 0; j < 6; ++j) { const int idx = (tid + 512 * j) & 1023;
            if (j < 2) *(LAS v4u*)(BN + (idx >> 4) * 136 + 8 * (idx & 15)) = pc[j];
            else if (j < 4) *(LAS v4u*)(CN + (idx >> 4) * 136 + 8 * (idx & 15)) = pc[j];
            else *(LAS v4u*)(BT + (idx >> 3) * 72 + 8 * (idx & 7)) = pc[j]; }
        if (pend) { const size_t prow = row_base + (t0 - 64) + (tid >> 3);
            *(v4u*)(YG + prow * 2048 + h * 64 + (tid & 7) * 8) = ow_pend; if ((tid & 7) == 0) SSQ[prow * 32 + h] = sq_pend; pend = false; }
        { const int xs = tid >> 3, cgl = tid & 7; const float wx = __shfl(wgt, xs); typedef float f32x2 __attribute__((ext_vector_type(2)));
#pragma unroll
          for (int kp = 0; kp < 4; ++kp) {
              const LAS float* wl = CWL + 8 * cgl + 2 * kp;
              const f32x2 cw0 = *(const LAS f32x2*)wl, cw1 = *(const LAS f32x2*)(wl + 64), cw2 = *(const LAS f32x2*)(wl + 128), cw3 = *(const LAS f32x2*)(wl + 192), cbb = *(const LAS f32x2*)(wl + 256);
              f32x2 xv[4];
#pragma unroll
              for (int i = 0; i < 4; ++i) { const unsigned wd = xr[i][kp]; xv[i] = (f32x2){__uint_as_float(wd << 16), __uint_as_float(wd & 0xffff0000u)}; }
              f32x2 a = cw0 * xv[0] + cbb; a = cw1 * xv[1] + a; a = cw2 * xv[2] + a; a = cw3 * xv[3] + a;
              const f32x2 t = a * (-1.4426950408889634f); f32x2 e; e.x = __builtin_amdgcn_exp2f(t.x); e.y = __builtin_amdgcn_exp2f(t.y); e = e + 1.0f;
              f32x2 rc; rc.x = __builtin_amdgcn_rcpf(e.x); rc.y = __builtin_amdgcn_rcpf(e.y); const f32x2 o = a * rc, ow = o * wx;
              const unsigned po = pk2(o.x, o.y), pw = pk2(ow.x, ow.y); const int p = 8 * cgl + 2 * kp;
              XT[p * 72 + xs] = (unsigned short)(po & 0xffffu); XT[(p + 1) * 72 + xs] = (unsigned short)(po >> 16);
              XWT[p * 72 + xs] = (unsigned short)(pw & 0xffffu); XWT[(p + 1) * 72 + xs] = (unsigned short)(pw >> 16); }
        }
        if (t0 + 64 < L) {
#pragma unroll
            for (int i = 0; i < 4; ++i) xr[i] = ld_nt16(cptr + (size_t)(t0 + 64 + (tid >> 3) - 3 + i) * 1024);
            const int chn = (t0 >> 6) + 1;
#pragma unroll
            for (int j = 0; j < 6; ++j) { const int idx = (tid + 512 * j) & 1023;
                if (j < 4) pc[j] = *(const v4u*)(BCS + (size_t)(t0 + 64 + (idx >> 4)) * 1024 + (j >> 1) * 512 + 8 * (idx & 15));
                else pc[j] = *(const v4u*)(BTT + ((size_t)chn * 4 * 128 + (idx >> 3)) * 64 + 8 * (idx & 7)); }
        }
        LDS_BARRIER();
        if (w < 4 || w >= 6) {
            const int tt = w < 4 ? (w >> 1) : 1, st = w < 4 ? tt : 0, ptj = w & 1;
            f32x16 X, ya;
#pragma unroll
            for (int i = 0; i < 16; ++i) { X[i] = 0.f; ya[i] = 0.f; }
            const LAS unsigned char* cn_nat = Lb + SD_CN + (32 * tt + r) * 272 + hh * 16; const LAS unsigned char* bn_nat = Lb + SD_BN + (32 * st + r) * 272 + hh * 16;
#pragma unroll 2
            for (int ks = 0; ks < 8; ++ks) X = MFMA32(lds_frag16(bn_nat + ks * 32), lds_frag16(cn_nat + ks * 32), X);
            const float cum_t = CUM[32 * tt + r];
#pragma unroll
            for (int q4 = 0; q4 < 4; ++q4) { const f32x4 cs = *(const LAS f32x4*)(CUM + 32 * st + 8 * q4 + 4 * hh), ds = *(const LAS f32x4*)(DTV + 32 * st + 8 * q4 + 4 * hh);
#pragma unroll
                for (int jj = 0; jj < 4; ++jj) { const int s_abs = 32 * st + 8 * q4 + 4 * hh + jj; const float f = __expf(fminf(cum_t - cs[jj], 0.f)) * ds[jj]; X[4 * q4 + jj] = (s_abs <= 32 * tt + r) ? X[4 * q4 + jj] * f : 0.f; } }
            const LAS unsigned char* xt_row = Lb + SD_XT + (32 * ptj + r) * 144 + (32 * st + 4 * hh) * 2;
            ya = MFMA32(ACC_FRAG(X, 0), lds_frag8x2(xt_row), ya);
            ya = MFMA32(ACC_FRAG(X, 1), lds_frag8x2(xt_row + 32), ya);
            if (w < 4) { LAS float* yb = YA + (32 * tt + 4 * hh) * 64 + 32 * ptj + r;
#pragma unroll
                for (int i = 0; i < 16; ++i) yb[((i & 3) + 8 * (i >> 2)) * 64] = ya[i]; }
            else { LAS unsigned short* yb = YO + (4 * hh) * 64 + 32 * ptj + r;
#pragma unroll
                for (int i = 0; i < 16; ++i) yb[((i & 3) + 8 * (i >> 2)) * 64] = (unsigned short)f2bf(ya[i]); }
        } else {
            const int ptj = w & 1;
            const LAS unsigned char* ht_nat = Lb + SD_HT + buf * 17408 + (32 * ptj + r) * 272 + hh * 16;
#pragma unroll 1
            for (int tt = 0; tt < 2; ++tt) {
                f32x16 yi;
#pragma unroll
                for (int i = 0; i < 16; ++i) yi[i] = 0.f;
                const LAS unsigned char* cn_nat = Lb + SD_CN + (32 * tt + r) * 272 + hh * 16;
#pragma unroll 2
                for (int ks = 0; ks < 8; ++ks) yi = MFMA32(lds_frag16(cn_nat + ks * 32), lds_frag16(ht_nat + ks * 32), yi);
                const LAS unsigned short* xt_p = XT + (32 * ptj + r) * 72 + 32 * tt + 4 * hh;
#pragma unroll
                for (int q4 = 0; q4 < 4; ++q4) { const f32x4 ec = *(const LAS f32x4*)(ECUM + 32 * tt + 8 * q4 + 4 * hh); const v2u xw = *(const LAS v2u*)(xt_p + 8 * q4);
                    const float x0 = bf2f(xw.x & 0xffffu), x1 = bf2f(xw.x >> 16), x2 = bf2f(xw.y & 0xffffu), x3 = bf2f(xw.y >> 16);
                    LAS float* yb = YY + (32 * tt + 8 * q4 + 4 * hh) * 64 + 32 * ptj + r;
                    yb[0] = ec[0] * yi[4 * q4] + Dk * x0; yb[64] = ec[1] * yi[4 * q4 + 1] + Dk * x1; yb[128] = ec[2] * yi[4 * q4 + 2] + Dk * x2; yb[192] = ec[3] * yi[4 * q4 + 3] + Dk * x3; }
            }
        }
        {
            const float el = __expf(CUM[63]);
#pragma unroll
            for (int i = 0; i < 16; ++i) H[i] *= el;
            const LAS unsigned char* bt_nat = Lb + SD_BT + (32 * nt + r) * 144 + hh * 16; const LAS unsigned char* xt_nat = Lb + SD_XWT + (32 * pt + r) * 144 + hh * 16;
#pragma unroll
            for (int s2 = 0; s2 < 4; ++s2) H = MFMA32(lds_frag16(bt_nat + s2 * 32), lds_frag16(xt_nat + s2 * 32), H);
            LAS unsigned short* hp = HT + (buf ^ 1) * 8704 + (32 * pt + r) * 136 + 32 * nt + 4 * hh;
#pragma unroll
            for (int q4 = 0; q4 < 4; ++q4) { v2u pk; pk.x = cvtpk_c(H[4 * q4], H[4 * q4 + 1]); pk.y = cvtpk_c(H[4 * q4 + 2], H[4 * q4 + 3]); *(LAS v2u*)(hp + 8 * q4) = pk; }
        }
        LDS_BARRIER();
        { const int tt = tid >> 3, p0 = (tid & 7) * 8;
          if (t0 + tt < L) { const size_t row = row_base + t0 + tt;
            f32x4 y0 = *(const LAS f32x4*)(YA + tt * 64 + p0) + *(const LAS f32x4*)(YY + tt * 64 + p0), y1 = *(const LAS f32x4*)(YA + tt * 64 + p0 + 4) + *(const LAS f32x4*)(YY + tt * 64 + p0 + 4);
            if (tt >= 32) { const v4u ow4 = *(const LAS v4u*)(YO + (tt - 32) * 64 + p0);
                y0 = y0 + (f32x4){bf2f(ow4.x & 0xffffu), __uint_as_float(ow4.x & 0xffff0000u), bf2f(ow4.y & 0xffffu), __uint_as_float(ow4.y & 0xffff0000u)};
                y1 = y1 + (f32x4){bf2f(ow4.z & 0xffffu), __uint_as_float(ow4.z & 0xffff0000u), bf2f(ow4.w & 0xffffu), __uint_as_float(ow4.w & 0xffff0000u)}; }
            float o[8]; float sq = 0.f;
#pragma unroll
            for (int j = 0; j < 8; ++j) { const unsigned z16 = (zw[j >> 1] >> ((j & 1) * 16)) & 0xffffu; const float yv = (j < 4 ? y0[j & 3] : y1[j & 3]) * silu_f(bf2f(z16)); o[j] = yv; sq += yv * yv; }
            ow_pend.x = pk2(o[0], o[1]); ow_pend.y = pk2(o[2], o[3]); ow_pend.z = pk2(o[4], o[5]); ow_pend.w = pk2(o[6], o[7]);
            sq += __shfl_xor(sq, 1); sq += __shfl_xor(sq, 2); sq += __shfl_xor(sq, 4); sq_pend = sq; pend = true; } }
        }
    }
    if (pend) { const size_t prow = row_base + (L - 64) + (tid >> 3); *(v4u*)(YG + prow * 2048 + h * 64 + (tid & 7) * 8) = ow_pend; if ((tid & 7) == 0) SSQ[prow * 32 + h] = sq_pend; }
#pragma unroll
    for (int q4 = 0; q4 < 4; ++q4) *(f32x4*)(st_g + 8 * q4) = (f32x4){H[4 * q4], H[4 * q4 + 1], H[4 * q4 + 2], H[4 * q4 + 3]};
    __syncthreads();
}
__device__ __forceinline__ float tr_reduce32(const float (&v)[32], int lane) {
    const bool b4 = lane & 16, b3 = lane & 8, b2 = lane & 4, b1 = lane & 2, b0 = lane & 1;
    float a[16], b[8], c[4], d[2];
#pragma unroll
    for (int i = 0; i < 16; ++i) { const float keep = b4 ? v[i + 16] : v[i], send = b4 ? v[i] : v[i + 16]; a[i] = keep + __shfl_xor(send, 16); }
#pragma unroll
    for (int i = 0; i < 8; ++i) { const float keep = b3 ? a[i + 8] : a[i], send = b3 ? a[i] : a[i + 8]; b[i] = keep + __shfl_xor(send, 8); }
#pragma unroll
    for (int i = 0; i < 4; ++i) { const float keep = b2 ? b[i + 4] : b[i], send = b2 ? b[i] : b[i + 4]; c[i] = keep + __shfl_xor(send, 4); }
#pragma unroll
    for (int i = 0; i < 2; ++i) { const float keep = b1 ? c[i + 2] : c[i], send = b1 ? c[i] : c[i + 2]; d[i] = keep + __shfl_xor(send, 2); }
    const float keep = b0 ? d[1] : d[0], send = b0 ? d[0] : d[1];
    return keep + __shfl_xor(send, 1);
}
__device__ __forceinline__ void ssd_sample_unit(Frame& F, int sb, int g) {
    int tid_o = F.tid; asm volatile("" : "+v"(tid_o));
    const int tid = tid_o, lane = tid & 63, w = F.wave, hh = lane >> 5, nq = lane & 31; unsigned char* ws = F.ws;
    LAS float* XC = (LAS float*)(F.lds + RING_OFF); LAS float* BC = XC + 8 * 4 * 64; LAS float* CC = BC + 4 * 128; LAS float* DTS = CC + 4 * 128;
    const bf16* PROJ = (const bf16*)(ws + WS_PROJ); const float* DTR = (const float*)(ws + WS_DT); bf16* YG = (bf16*)(ws + WS_YG); float* SSQ = (float*)(ws + WS_SSQSSD);
    const size_t row0 = (size_t)TP + (size_t)sb * LS;
    const int h = 8 * g + w;
    const float* sp = F.in[3] + (size_t)(sb * 32 + h) * 8192 + (size_t)hh * 128 + 4 * nq;
    f32x4 hst[32];
#pragma unroll
    for (int i = 0; i < 32; ++i) hst[i] = ld_nt(sp + (size_t)i * 256);
    if (tid < 384) { typedef float f32x2 __attribute__((ext_vector_type(2)));
        const int col = tid < 256 ? g * 512 + 2 * tid : (tid < 320 ? 2048 + g * 128 + 2 * (tid - 256) : 2560 + g * 128 + 2 * (tid - 320));
        const float* cw = F.in[10]; const float* sc = F.in[4] + (size_t)sb * 3 * 3072 + col;
        const f32x2 w0 = *(const f32x2*)(cw + col), w1 = *(const f32x2*)(cw + 3072 + col), w2 = *(const f32x2*)(cw + 2 * 3072 + col), w3 = *(const f32x2*)(cw + 3 * 3072 + col), cb = *(const f32x2*)(F.in[11] + col);
        f32x2 full[7]; full[0] = *(const f32x2*)sc; full[1] = *(const f32x2*)(sc + 3072); full[2] = *(const f32x2*)(sc + 2 * 3072);
        const bf16* cp = PROJ + (size_t)(S_X0 + (col >> 10)) * SLOT_ELEMS + row0 * 1024 + (col & 1023);
#pragma unroll
        for (int t = 0; t < 4; ++t) { const unsigned wd = *(const unsigned*)(cp + (size_t)t * 1024); full[3 + t] = (f32x2){__uint_as_float(wd << 16), __uint_as_float(wd & 0xffff0000u)}; }
#pragma unroll
        for (int t = 0; t < 4; ++t) { f32x2 a = w0 * full[t] + cb; a = w1 * full[t + 1] + a; a = w2 * full[t + 2] + a; a = w3 * full[t + 3] + a;
            f32x2 o; o.x = silu_f(a.x); o.y = silu_f(a.y);
            LAS float* dst = tid < 256 ? XC + ((tid >> 5) * 4 + t) * 64 + 2 * (tid & 31) : (tid < 320 ? BC + t * 128 + 2 * (tid - 256) : CC + t * 128 + 2 * (tid - 320));
            *(LAS f32x2*)dst = o; }
    } else if (tid < 416) { const int idx = tid - 384, hl = idx >> 2, t = idx & 3; const float x = DTR[(row0 + t) * 32 + 8 * g + hl] + F.in[12][8 * g + hl]; DTS[idx] = x > 20.f ? x : log1pf(__expf(x)); }
    __syncthreads();
    const float a = -__expf(F.in[13][h]), Dk = F.in[14][h];
#pragma unroll 1
    for (int t = 0; t < 4; ++t) {
        const float dtv = DTS[w * 4 + t], dA = __expf(dtv * a);
        const f32x4 Bv = *(const LAS f32x4*)(BC + t * 128 + 4 * nq), Cv = *(const LAS f32x4*)(CC + t * 128 + 4 * nq);
        const LAS float* xrow = XC + (w * 4 + t) * 64;
        float part[32];
#pragma unroll
        for (int i = 0; i < 32; ++i) { const float xd = xrow[2 * i + hh] * dtv; hst[i] = hst[i] * dA + Bv * xd; part[i] = (hst[i].x * Cv.x + hst[i].y * Cv.y) + (hst[i].z * Cv.z + hst[i].w * Cv.w); }
        float yv = tr_reduce32(part, lane);
        const int p = 2 * nq + hh; const size_t row = row0 + t;
        yv += Dk * xrow[p];
        const float z = bf2f(PROJ[(size_t)(S_Z0 + (h >> 4)) * SLOT_ELEMS + row * 1024 + (h & 15) * 64 + p]);
        const float yg = yv * silu_f(z);
        YG[row * 2048 + h * 64 + p] = (bf16)f2bf(yg);
        const float sq = wave_sum(yg * yg);
        if (lane == 0) SSQ[row * 32 + h] = sq;
    }
    float* so = F.out + O_SSMS + (size_t)(sb * 32 + h) * 8192 + (size_t)hh * 128 + 4 * nq;
#pragma unroll
    for (int i = 0; i < 32; ++i) st_nt(so + (size_t)i * 256, hst[i]);
    __syncthreads();
}
__device__ __forceinline__ void hgrn_sample_unit(Frame& F, int sb, int hq) {
    int tid_o = F.tid; asm volatile("" : "+v"(tid_o));
    const int tid = tid_o, lane = tid & 63, w = F.wave, hh = lane >> 5, vq = lane & 31; unsigned char* ws = F.ws;
    LAS float* FS = (LAS float*)(F.lds + RING_OFF); LAS float* KS = FS + 2048; LAS float* QS = KS + 2048; LAS float* VS = QS + 2048; LAS float* OP = VS + 2048;
    const bf16* PROJ = (const bf16*)(ws + WS_PROJ); bf16* ON = (bf16*)(ws + WS_ON);
    const size_t row0 = (size_t)TP + (size_t)sb * LS;
    const int hl = w >> 1, kh = w & 1, hd = 4 * hq + hl;
    const float* sp = F.in[5] + (size_t)(sb * 8 + hd) * 16384 + (size_t)(64 * kh + hh) * 128 + 4 * vq;
    f32x4 S[32];
#pragma unroll
    for (int i = 0; i < 32; ++i) S[i] = ld_nt(sp + (size_t)i * 256);
    { const int ch = hq * 512 + tid; const float lb = __builtin_amdgcn_rcpf(1.0f + __expf(F.in[17][1024 + ch] - F.in[17][ch]));
      const bf16* fp = PROJ + (size_t)S_F * SLOT_ELEMS + row0 * 1024 + ch; const bf16* qp = PROJ + (size_t)S_Q * SLOT_ELEMS + row0 * 1024 + ch; const bf16* ip = PROJ + (size_t)S_I * SLOT_ELEMS + row0 * 1024 + ch;
#pragma unroll
      for (int t = 0; t < 4; ++t) { const float u = fminf(fmaxf(bf2f(fp[(size_t)t * 1024]), -30.f), 30.f); const float fg = lb + (1.0f - lb) * sigmoid_f(u);
          const int o = ((tid >> 7) * 4 + t) * 128 + (tid & 127);
          FS[o] = fg; KS[o] = 1.0f - fg; QS[o] = silu_f(bf2f(qp[(size_t)t * 1024])); VS[o] = bf2f(ip[(size_t)t * 1024]); } }
    __syncthreads();
#pragma unroll 1
    for (int t = 0; t < 4; ++t) {
        const int o = (hl * 4 + t) * 128;
        const f32x4 vv = *(const LAS f32x4*)(VS + o + 4 * vq);
        f32x4 oa = (f32x4){0.f, 0.f, 0.f, 0.f};
#pragma unroll
        for (int i = 0; i < 32; ++i) { const int k = 64 * kh + 2 * i + hh; const float fk = FS[o + k], kv = KS[o + k], qk = QS[o + k]; S[i] = S[i] * fk + vv * kv; oa = oa + S[i] * qk; }
        oa.x += __shfl_xor(oa.x, 32); oa.y += __shfl_xor(oa.y, 32); oa.z += __shfl_xor(oa.z, 32); oa.w += __shfl_xor(oa.w, 32);
        if (hh == 0) *(LAS f32x4*)(OP + ((hl * 4 + t) * 2 + kh) * 128 + 4 * vq) = oa;
    }
    float* so = F.out + O_HGS + (size_t)(sb * 8 + hd) * 16384 + (size_t)(64 * kh + hh) * 128 + 4 * vq;
#pragma unroll
    for (int i = 0; i < 32; ++i) st_nt(so + (size_t)i * 256, S[i]);
    __syncthreads();
#pragma unroll
    for (int rr2 = 0; rr2 < 2; ++rr2) { const int rr = 2 * w + rr2, ohl = rr >> 2, t = rr & 3, ohd = 4 * hq + ohl; typedef float f32x2 __attribute__((ext_vector_type(2)));
        const f32x2 p0 = *(const LAS f32x2*)(OP + (rr * 2) * 128 + 2 * lane), p1 = *(const LAS f32x2*)(OP + (rr * 2 + 1) * 128 + 2 * lane);
        const float o0 = p0.x + p1.x, o1 = p0.y + p1.y; const float sq = wave_sum(o0 * o0 + o1 * o1); const float rs = __builtin_amdgcn_rsqf(sq * (1.0f / 128.0f) + EPS);
        const size_t row = row0 + t; const unsigned gw = *(const unsigned*)(PROJ + (size_t)S_HG * SLOT_ELEMS + row * 1024 + ohd * 128 + 2 * lane);
        *(unsigned*)(ON + row * 1024 + ohd * 128 + 2 * lane) = pk2(o0 * rs * silu_f(bf2f(gw & 0xffffu)), o1 * rs * silu_f(__uint_as_float(gw & 0xffff0000u))); }
    __syncthreads();
}
constexpr int U_HGS = NBS * 2, U_SSDS = NBS * 4, U_CONV = NBP + NBS;
__device__ __forceinline__ void scan_phase(Frame& F) {
    gu32* head = F.ctl + CW_QUEUE;
#define SCAN_QUEUE(qi, count, body) for (;;) { if (F.tid == 0) F.MISC[0] = __hip_atomic_fetch_add(head + 64 * (qi), 1u, RLX_AGENT); __syncthreads(); const int u = (int)F.MISC[0]; __syncthreads(); if (u >= (count)) break; body }
    SCAN_QUEUE(1, NBP * 32, ssd_unit_mfma(F, u >> 5, u & 31);)
    SCAN_QUEUE(0, NBP * 32, hgrn_v_unit(F, u >> 5, (u >> 2) & 7, u & 3);)
    SCAN_QUEUE(2, U_HGS, hgrn_sample_unit(F, u >> 1, u & 1);)
    SCAN_QUEUE(3, U_SSDS + U_CONV, if (u >= U_SSDS) { conv_copy_unit(F, u - U_SSDS); continue; } ssd_sample_unit(F, u >> 2, u & 3);)
#undef SCAN_QUEUE
}
typedef float f32x4s __attribute__((ext_vector_type(4)));
template <class Epi> __device__ __forceinline__ void small_tile_phase(Frame& F, const bf16* A, const bf16* Bt, int K, const Epi& E) {
    const int lane = F.lane, w = F.wave, r = lane & 31, hh = lane >> 5;
#pragma unroll 1
    for (int v = F.vcu; v < 256; v += F.G) {
    const int mt = v >> 4, nt = v & 15;
    const int kw = K >> 3;
    const bf16* ap = A + (size_t)(TP + 32 * mt + r) * K + w * kw + 8 * hh;
    const bf16* bp = Bt + (size_t)(64 * nt + r) * K + w * kw + 8 * hh;
    f32x16 acc0, acc1;
#pragma unroll
    for (int i = 0; i < 16; ++i) { acc0[i] = 0.f; acc1[i] = 0.f; }
#pragma unroll 4
    for (int ks = 0; ks < kw / 16; ++ks) { const bf16x8 af = *(const bf16x8*)(ap + 16 * ks), b0 = *(const bf16x8*)(bp + 16 * ks), b1 = *(const bf16x8*)(bp + (size_t)32 * K + 16 * ks);
        acc0 = MFMA32(b0, af, acc0); acc1 = MFMA32(b1, af, acc1); }
    LAS float* part = (LAS float*)(F.lds + RING_OFF) + w * 2048;
#pragma unroll
    for (int q4 = 0; q4 < 4; ++q4) { *(LAS f32x4*)(part + r * 64 + 8 * q4 + 4 * hh) = (f32x4){acc0[4 * q4], acc0[4 * q4 + 1], acc0[4 * q4 + 2], acc0[4 * q4 + 3]};
        *(LAS f32x4*)(part + r * 64 + 32 + 8 * q4 + 4 * hh) = (f32x4){acc1[4 * q4], acc1[4 * q4 + 1], acc1[4 * q4 + 2], acc1[4 * q4 + 3]}; }
    __syncthreads();
    const int rl = F.tid >> 4, c4 = (F.tid & 15) * 4; const LAS float* src = (const LAS float*)(F.lds + RING_OFF) + rl * 64 + c4;
    f32x4 sum = *(const LAS f32x4*)src;
#pragma unroll
    for (int ww = 1; ww < 8; ++ww) sum = sum + *(const LAS f32x4*)(src + ww * 2048);
    const f32x4s acc = (f32x4s){sum.x, sum.y, sum.z, sum.w};
    E.small(F, acc, TP + 32 * mt + rl, 64 * nt + c4, nt);
    __syncthreads();
    }
}
template <bool ADD> struct SmGate { bf16* O; const bf16* gate;
    __device__ __forceinline__ void small(Frame&, const f32x4s& a, int row, int col, int) const { const size_t off = (size_t)row * 1024 + col;
        const v2u gw = __builtin_nontemporal_load((const v2u*)(gate + off)); v2u ow = (v2u){0u, 0u}; if (ADD) ow = *(const v2u*)(O + off);
        float rr[4];
#pragma unroll
        for (int e = 0; e < 4; ++e) { const unsigned g16 = (gw[e >> 1] >> ((e & 1) * 16)) & 0xffffu, o16 = (ow[e >> 1] >> ((e & 1) * 16)) & 0xffffu; rr[e] = (ADD ? bf2f(o16) : 0.f) + sigmoid_f(bf2f(g16)) * a[e]; }
        v2u wv; wv.x = cvtpk_c(rr[0], rr[1]); wv.y = cvtpk_c(rr[2], rr[3]); *(v2u*)(O + off) = wv; } };
template <bool BF> struct SmRes { const float* base; bf16* hb; float* ssqp;
    __device__ __forceinline__ void small(Frame& F, const f32x4s& a, int row, int col, int nt) const { const size_t off = (size_t)row * 1024 + col; f32x4 b;
        if (BF) { const v2u w = *(const v2u*)(hb + off); b = (f32x4){bf2f(w.x & 0xffffu), __uint_as_float(w.x & 0xffff0000u), bf2f(w.y & 0xffffu), __uint_as_float(w.y & 0xffff0000u)}; }
        else b = *(const f32x4*)(base + off);
        const f32x4 v = b + (f32x4){a[0], a[1], a[2], a[3]};
        { v2u wv; wv.x = cvtpk_c(v[0], v[1]); wv.y = cvtpk_c(v[2], v[3]); *(v2u*)(hb + off) = wv; }
        float sq = (v[0] * v[0] + v[1] * v[1]) + (v[2] * v[2] + v[3] * v[3]); sq += __shfl_xor(sq, 1); sq += __shfl_xor(sq, 2); sq += __shfl_xor(sq, 4); sq += __shfl_xor(sq, 8);
        if ((F.tid & 15) == 0) ssqp[(size_t)row * 16 + nt] = sq; } };
struct SmScale { bf16* O; const float* ssq; float scale;
    __device__ __forceinline__ void small(Frame&, const f32x4s& a, int row, int col, int) const { const float rs = pg8::row_rs<16>(ssq, row) * scale;
        v2u wv; wv.x = cvtpk_c(a[0] * rs, a[1] * rs); wv.y = cvtpk_c(a[2] * rs, a[3] * rs); *(v2u*)(O + (size_t)row * 1024 + col) = wv; } };
__device__ __forceinline__ void attn_stage_tile(LAS unsigned char* Lb, const bf16* src, size_t pitch, int tid) {
#pragma unroll 1
    for (int hb = 0; hb < 2; ++hb) { v4u v[8];
#pragma unroll
        for (int i = 0; i < 8; ++i) { const int id = tid + 512 * (8 * hb + i), row = id >> 5, c = id & 31; v[i] = *(const v4u*)(src + (size_t)row * pitch + c * 8); }
#pragma unroll
        for (int i = 0; i < 8; ++i) { const int id = tid + 512 * (8 * hb + i), row = id >> 5, c = id & 31; *(LAS v4u*)(Lb + row * 512 + ((c ^ (row & 15)) << 4)) = v[i]; } }
}
__device__ __forceinline__ void attn_prompt_unit(Frame& F, int b, int hd, int qb) {
    const int tid = F.tid, lane = F.lane, w = F.wave, r = lane & 31, hh = lane >> 5; unsigned char* ws = F.ws;
    LAS unsigned char* Lb = F.lds + RING_OFF;
    const bf16* QB = (const bf16*)(ws + WS_QB); const bf16* KB = (const bf16*)(ws + WS_KB); const bf16* VT = (const bf16*)(ws + WS_VT); bf16* OB = (bf16*)(ws + WS_OB);
    const size_t qrow = (size_t)b * SEQ + (size_t)qb * 256 + 32 * w + r;
    attn_stage_tile(Lb, KB + (size_t)b * 256 * 1024 + hd * 256, 1024, tid);
    const bf16* qp = QB + qrow * 1024 + hd * 256 + 8 * hh;
    bf16x8 qf = *(const bf16x8*)qp;
    __syncthreads();
    f32x16 S[8];
#pragma unroll
    for (int t = 0; t < 8; ++t)
#pragma unroll
        for (int i = 0; i < 16; ++i) S[t][i] = 0.f;
    const int sw = r & 15;
#pragma unroll 1
    for (int ks = 0; ks < 16; ++ks) {
        const bf16x8 qn = *(const bf16x8*)(qp + 16 * (ks < 15 ? ks + 1 : ks));
        const LAS unsigned char* kp = Lb + r * 512 + (((2 * ks + hh) ^ sw) << 4);
#pragma unroll
        for (int t = 0; t < 8; ++t) S[t] = MFMA32(lds_frag16(kp + t * 32 * 512), qf, S[t]);
        qf = qn;
    }
    float m = -3.0e38f;
#pragma unroll
    for (int t = 0; t < 8; ++t)
#pragma unroll
        for (int i = 0; i < 16; ++i) m = fmaxf(m, S[t][i]);
    m = fmaxf(m, __shfl_xor(m, 32));
    float l = 0.f;
#pragma unroll
    for (int t = 0; t < 8; ++t)
#pragma unroll
        for (int i = 0; i < 16; ++i) { const float pv = __builtin_amdgcn_exp2f(S[t][i] - m); S[t][i] = pv; l += pv; }
    l += __shfl_xor(l, 32);
    const float rl = __builtin_amdgcn_rcpf(l);
    bf16x8 pf[8][2];
#pragma unroll
    for (int t = 0; t < 8; ++t) { pf[t][0] = ACC_FRAG(S[t], 0); pf[t][1] = ACC_FRAG(S[t], 1); }
    __syncthreads();
    attn_stage_tile(Lb, VT + (size_t)(b * 4 + hd) * 256 * 256, 256, tid);
    __syncthreads();
    bf16* op = OB + qrow * 1024 + hd * 256 + 4 * hh;
#pragma unroll 1
    for (int dt = 0; dt < 8; ++dt) {
        f32x16 O;
#pragma unroll
        for (int i = 0; i < 16; ++i) O[i] = 0.f;
        const LAS unsigned char* vrow = Lb + (32 * dt + r) * 512 + 8 * hh;
#pragma unroll
        for (int t = 0; t < 8; ++t)
#pragma unroll
            for (int s2 = 0; s2 < 2; ++s2) {
                const v2u lo = *(const LAS v2u*)(vrow + (((4 * t + 2 * s2) ^ sw) << 4)), hi = *(const LAS v2u*)(vrow + (((4 * t + 2 * s2 + 1) ^ sw) << 4));
                const v4u wv4 = (v4u){lo.x, lo.y, hi.x, hi.y};
                O = MFMA32(__builtin_bit_cast(bf16x8, wv4), pf[t][s2], O);
            }
#pragma unroll
        for (int q4 = 0; q4 < 4; ++q4) { v2u o; o.x = cvtpk_c(O[4 * q4] * rl, O[4 * q4 + 1] * rl); o.y = cvtpk_c(O[4 * q4 + 2] * rl, O[4 * q4 + 3] * rl);
            *(v2u*)(op + 32 * dt + 8 * q4) = o; }
    }
    __syncthreads();
}
__device__ __forceinline__ void attn_sample_unit(Frame& F, int sb, int hd) {
    const int tid = F.tid, lane = F.lane, w = F.wave; unsigned char* ws = F.ws;
    LAS float* sc = (LAS float*)(F.lds + RING_OFF);
    LAS float* red = sc + 4 * 256;
    const bf16* QB = (const bf16*)(ws + WS_QB); bf16* OB = (bf16*)(ws + WS_OB);
    const size_t rowq = (size_t)TP + (size_t)sb * LS;
    float q[4][4];
#pragma unroll
    for (int t = 0; t < 4; ++t) { const v2u qw = *(const v2u*)(QB + (rowq + t) * 1024 + hd * 256 + 4 * lane); q[t][0] = bf2f(qw.x & 0xffffu); q[t][1] = bf2f(qw.x >> 16); q[t][2] = bf2f(qw.y & 0xffffu); q[t][3] = bf2f(qw.y >> 16); }
    const float* Kc = F.in[6] + ((size_t)sb * 256 * 4 + hd) * 256 + 4 * lane; const float* Vc = F.in[7] + ((size_t)sb * 256 * 4 + hd) * 256 + 4 * lane;
    f32x4 kv[8], kn[8];
#pragma unroll
    for (int u = 0; u < 8; ++u) kv[u] = ld_nt(Kc + (size_t)(w * 32 + u) * 1024);
#pragma unroll 1
    for (int kk0 = 0; kk0 < 32; kk0 += 8) {
#pragma unroll
        for (int u = 0; u < 8; ++u) kn[u] = kk0 < 24 ? ld_nt(Kc + (size_t)(w * 32 + kk0 + 8 + u) * 1024) : ld_nt(Vc + (size_t)(w * 32 + u) * 1024);
        { float part[32];
#pragma unroll
          for (int u = 0; u < 8; ++u)
#pragma unroll
              for (int t = 0; t < 4; ++t) part[4 * u + t] = (q[t][0] * kv[u].x + q[t][1] * kv[u].y) + (q[t][2] * kv[u].z + q[t][3] * kv[u].w);
          float sv = tr_reduce32(part, lane); sv += __shfl_xor(sv, 32);
          if (lane < 32) sc[(lane & 3) * 256 + w * 32 + kk0 + (lane >> 2)] = sv; }
#pragma unroll
        for (int u = 0; u < 8; ++u) kv[u] = kn[u]; }
    __syncthreads();
    if (w < 4) { float v[4]; float m = -3.0e38f;
#pragma unroll
        for (int j = 0; j < 4; ++j) { v[j] = sc[w * 256 + j * 64 + lane]; m = fmaxf(m, v[j]); }
        m = wave_max(m); float l = 0.f;
#pragma unroll
        for (int j = 0; j < 4; ++j) { v[j] = __builtin_amdgcn_exp2f(v[j] - m); l += v[j]; }
        l = wave_sum(l); const float rl = 1.0f / l;
#pragma unroll
        for (int j = 0; j < 4; ++j) sc[w * 256 + j * 64 + lane] = v[j] * rl; }
    __syncthreads();
    float o[4][4];
#pragma unroll
    for (int t = 0; t < 4; ++t)
#pragma unroll
        for (int e = 0; e < 4; ++e) o[t][e] = 0.f;
#pragma unroll 1
    for (int kk0 = 0; kk0 < 32; kk0 += 8) {
        if (kk0 < 24) {
#pragma unroll
            for (int u = 0; u < 8; ++u) kn[u] = ld_nt(Vc + (size_t)(w * 32 + kk0 + 8 + u) * 1024); }
#pragma unroll
        for (int u = 0; u < 8; ++u) { const int key = w * 32 + kk0 + u;
#pragma unroll
            for (int t = 0; t < 4; ++t) { const float pr = sc[t * 256 + key]; o[t][0] += pr * kv[u].x; o[t][1] += pr * kv[u].y; o[t][2] += pr * kv[u].z; o[t][3] += pr * kv[u].w; } }
#pragma unroll
        for (int u = 0; u < 8; ++u) kv[u] = kn[u]; }
#pragma unroll
    for (int t = 0; t < 4; ++t) *(LAS f32x4*)(red + (w * 4 + t) * 256 + 4 * lane) = (f32x4){o[t][0], o[t][1], o[t][2], o[t][3]};
    __syncthreads();
    { const int t = tid >> 7, d0 = (tid & 127) * 2; float a0 = 0.f, a1 = 0.f;
#pragma unroll
      for (int ww = 0; ww < 8; ++ww) { a0 += red[(ww * 4 + t) * 256 + d0]; a1 += red[(ww * 4 + t) * 256 + d0 + 1]; }
      *(unsigned*)(OB + (rowq + t) * 1024 + hd * 256 + d0) = pk2(a0, a1); }
    __syncthreads();
}
__device__ __forceinline__ void attn_phase(Frame& F) {
    for (int u = F.vcu; u < NBP * 4 * 8; u += F.G) attn_prompt_unit(F, u >> 5, (u >> 3) & 3, u & 7);
    for (int u = F.vcu; u < NBS * 4; u += F.G) attn_sample_unit(F, u >> 2, u & 3);
}
__device__ __forceinline__ void final_norm_phase(Frame& F) {
    const int gw = F.vcu * NWAVES + F.wave, NGW = F.G * NWAVES; const float* SSQ = (const float*)(F.ws + WS_SSQP3); const float* wn = F.in[31]; const bf16* HB = (const bf16*)(F.ws + WS_HB);
    f32x4 wv[4];
#pragma unroll
    for (int j = 0; j < 2; ++j) { wv[2 * j] = *((const f32x4*)wn + 2 * (64 * j + F.lane)); wv[2 * j + 1] = *((const f32x4*)wn + 2 * (64 * j + F.lane) + 1); }
    for (int row = gw; row < T; row += NGW) {
        const f32x4* sp = (const f32x4*)(SSQ + (size_t)row * 16); float s = 0.f;
#pragma unroll
        for (int j = 0; j < 4; ++j) { const f32x4 a = sp[j]; s += (a.x + a.y) + (a.z + a.w); }
        const float rs = __builtin_amdgcn_rsqf(s * (1.0f / 1024.0f) + EPS);
#pragma unroll
        for (int j = 0; j < 2; ++j) { const int pc = 64 * j + F.lane; const v4u w = ld_nt16((const v4u*)(HB + (size_t)row * 1024) + pc);
            const f32x4 v0 = (f32x4){bf2f(w.x & 0xffffu), __uint_as_float(w.x & 0xffff0000u), bf2f(w.y & 0xffffu), __uint_as_float(w.y & 0xffff0000u)};
            const f32x4 v1 = (f32x4){bf2f(w.z & 0xffffu), __uint_as_float(w.z & 0xffff0000u), bf2f(w.w & 0xffffu), __uint_as_float(w.w & 0xffff0000u)};
            float* o = F.out + O_Y + (size_t)row * 1024 + 8 * pc; st_nt(o, v0 * rs * wv[2 * j]); st_nt(o + 4, v1 * rs * wv[2 * j + 1]); }
    }
}
#ifndef MK_N_LAUNCHES
#define MK_N_LAUNCHES 1
#endif
constexpr int PER_PHASE = 13;
constexpr int N_LAUNCHES = MK_N_LAUNCHES;
struct Args { const float* in[32]; float* out; unsigned char* ws; int ph_lo, ph_hi; };
__global__ void __launch_bounds__(NTHR, 2) skel_fwd(Args args) {
    extern __shared__ __attribute__((aligned(16))) unsigned char lds[];
    Frame F;
    F.lds = (LAS unsigned char*)lds;
    F.MISC = (volatile LAS unsigned*)(F.lds + MISC_OFF);
    F.tid = threadIdx.x; F.lane = F.tid & 63; F.wave = __builtin_amdgcn_readfirstlane(F.tid >> 6);
    F.G = gridDim.x; { const int bx = blockIdx.x; F.vcu = (F.G % 8 == 0) ? (bx % 8) * (F.G / 8) + bx / 8 : bx; }
    unsigned char* ws = args.ws; F.ws = ws; F.out = args.out;
    F.ctl = (gu32*)(ws + WS_CTL);
#pragma unroll
    for (int i = 0; i < 32; ++i) F.in[i] = args.in[i];
    for (int u = F.tid; u < (LDS_BYTES - LDSCTL_OFF) / 4; u += NTHR) ((LAS unsigned*)(F.lds + LDSCTL_OFF))[u] = 0u;
    __syncthreads();
    XcdBarrier bar; bar.bar = (unsigned*)(F.ctl + CW_BAR); bar.x = 0; bar.st = nullptr;
    if (N_LAUNCHES == 1) bar = xcd_barrier_post((unsigned*)(F.ctl + CW_BAR), F.MISC + 8);
#define GRID_BAR() do { if (N_LAUNCHES == 1) xcd_barrier(bar); } while (0)
    const int lo = args.ph_lo, hi = args.ph_hi;
#ifdef ONLY_PHASE
#define IN(k) ((k) == ONLY_PHASE && lo <= (k) && (k) < hi)
#else
#define IN(k) (lo <= (k) && (k) < hi)
#endif
#define BOTH(k) (IN(k) && IN((k) + 1))
    bf16* const XB = (bf16*)(ws + WS_XB); bf16* const PROJ = (bf16*)(ws + WS_PROJ);
    float* const Y = F.out + O_Y;
    if (IN(0)) { p0_prologue(F); if (BOTH(0)) GRID_BAR(); }
    if (IN(1)) {
        { pg8::Gemm g{XB, (const bf16*)(ws + WS_WIN), T, NPROJ, 1024}; pg8::StaticOrder S; S.init(T, NPROJ, F.G, (int)blockIdx.x);
          pg8::EpiScaleBf16<1, true> E{PROJ, SLOT_ELEMS, (const float*)(ws + WS_SSQX), 1.0f, (float*)(ws + WS_DT)};
          pg8::gemm_phase<pg8::EpiScaleBf16<1, true>, pg8::StaticOrder, true, true>(F.lds + RING_OFF, g, S, E); }
        { pg8::Gemm g{(const bf16*)(ws + WS_MNB), (const bf16*)(ws + WS_WKV), MEMR, 2048, 1024}; pg8::StaticOrder S; S.init(MEMR, 2048, F.G, (int)((blockIdx.x + 64) % F.G));
          pg8::EpiKV E{F.out + O_MKP, F.out + O_MVP, (bf16*)(ws + WS_KB), (bf16*)(ws + WS_VT), (const float*)(ws + WS_SSQM)};
          pg8::gemm_phase<pg8::EpiKV, pg8::StaticOrder, true, true>(F.lds + RING_OFF, g, S, E); }
        if (BOTH(1)) GRID_BAR();
    }
    if (IN(2)) { bc_prep_phase(F); hg_prep_phase(F); if (BOTH(2)) GRID_BAR(); }
    if (IN(3)) { scan_phase(F); if (BOTH(3)) GRID_BAR(); }
    if (IN(4)) { ssdnorm_phase(F); hgnorm_phase(F); if (BOTH(4)) GRID_BAR(); }
    if (IN(5)) { { SmGate<false> Es{(bf16*)(ws + WS_MERGED), PROJ + (size_t)S_GS * SLOT_ELEMS}; small_tile_phase(F, (const bf16*)(ws + WS_YG), (const bf16*)(ws + WS_WSSD), 2048, Es); }
        pg8::Gemm g{(const bf16*)(ws + WS_YG), (const bf16*)(ws + WS_WSSD), TP, 1024, 2048}; pg8::StaticOrder S; S.init(TP, 1024, F.G, (int)blockIdx.x);
        pg8::EpiGate<false> E{(bf16*)(ws + WS_MERGED), PROJ + (size_t)S_GS * SLOT_ELEMS};
        pg8::gemm_phase<pg8::EpiGate<false>, pg8::StaticOrder, true, true>(F.lds + RING_OFF, g, S, E);
          }
    if (IN(5)) { { SmGate<true> Es{(bf16*)(ws + WS_MERGED), PROJ + (size_t)S_GH * SLOT_ELEMS}; small_tile_phase(F, (const bf16*)(ws + WS_ON), (const bf16*)(ws + WS_WHG), 1024, Es); }
        pg8::Gemm g{(const bf16*)(ws + WS_ON), (const bf16*)(ws + WS_WHG), TP, 1024, 1024}; pg8::StaticOrder S; S.init(TP, 1024, F.G, (int)blockIdx.x);
        pg8::EpiGate<true> E{(bf16*)(ws + WS_MERGED), PROJ + (size_t)S_GH * SLOT_ELEMS};
        pg8::gemm_phase<pg8::EpiGate<true>, pg8::StaticOrder, true, true>(F.lds + RING_OFF, g, S, E);
        if (BOTH(5)) GRID_BAR(); }
    if (IN(6)) { { SmRes<false> Es{F.in[1] - (size_t)TP * 1024, (bf16*)(ws + WS_HB), (float*)(ws + WS_SSQP1)}; small_tile_phase(F, (const bf16*)(ws + WS_MERGED), (const bf16*)(ws + WS_WOUT), 1024, Es); }
        pg8::Gemm g{(const bf16*)(ws + WS_MERGED), (const bf16*)(ws + WS_WOUT), TP, 1024, 1024}; pg8::StaticOrder S; S.init(TP, 1024, F.G, (int)blockIdx.x);
        pg8::EpiRes<false> E{F.in[0], F.in[1] - (size_t)TP * 1024, (bf16*)(ws + WS_HB), (float*)(ws + WS_SSQP1)};
        pg8::gemm_phase<pg8::EpiRes<false>, pg8::StaticOrder, true, true>(F.lds + RING_OFF, g, S, E);
        if (BOTH(6)) GRID_BAR(); }
    if (IN(7)) { { SmScale Es{(bf16*)(ws + WS_QB), (const float*)(ws + WS_SSQP1), QSCALE}; small_tile_phase(F, (const bf16*)(ws + WS_HB), (const bf16*)(ws + WS_WCQ), 1024, Es); }
        pg8::Gemm g{(const bf16*)(ws + WS_HB), (const bf16*)(ws + WS_WCQ), TP, 1024, 1024}; pg8::StaticOrder S; S.init(TP, 1024, F.G, (int)blockIdx.x);
        pg8::EpiScaleBf16<16, false> E{(bf16*)(ws + WS_QB), SLOT_ELEMS, (const float*)(ws + WS_SSQP1), QSCALE, nullptr};
        pg8::gemm_phase<pg8::EpiScaleBf16<16, false>, pg8::StaticOrder, true, true>(F.lds + RING_OFF, g, S, E);
        if (BOTH(7)) GRID_BAR(); }
    if (IN(8)) { attn_phase(F); if (BOTH(8)) GRID_BAR(); }
    if (IN(9)) { { SmRes<true> Es{nullptr, (bf16*)(ws + WS_HB), (float*)(ws + WS_SSQP2)}; small_tile_phase(F, (const bf16*)(ws + WS_OB), (const bf16*)(ws + WS_WCO), 1024, Es); }
        pg8::Gemm g{(const bf16*)(ws + WS_OB), (const bf16*)(ws + WS_WCO), TP, 1024, 1024}; pg8::StaticOrder S; S.init(TP, 1024, F.G, (int)blockIdx.x);
        pg8::EpiRes<true> E{nullptr, nullptr, (bf16*)(ws + WS_HB), (float*)(ws + WS_SSQP2)};
        pg8::gemm_phase<pg8::EpiRes<true>, pg8::StaticOrder, true, true>(F.lds + RING_OFF, g, S, E);
        if (BOTH(9)) GRID_BAR(); }
    if (IN(10)) { pg8::Gemm g{(const bf16*)(ws + WS_HB), (const bf16*)(ws + WS_WGU), T, 2 * FFN, 1024}; pg8::StaticOrder S; S.init(T, 2 * FFN, F.G, (int)blockIdx.x);
        pg8::EpiSwiglu E{(bf16*)(ws + WS_ACT), (const float*)(ws + WS_SSQP2)};
        pg8::gemm_phase<pg8::EpiSwiglu, pg8::StaticOrder, true, true>(F.lds + RING_OFF, g, S, E);
        if (BOTH(10)) GRID_BAR(); }
    if (IN(11)) { { SmRes<true> Es{nullptr, (bf16*)(ws + WS_HB), (float*)(ws + WS_SSQP3)}; small_tile_phase(F, (const bf16*)(ws + WS_ACT), (const bf16*)(ws + WS_WDN), FFN, Es); }
        pg8::Gemm g{(const bf16*)(ws + WS_ACT), (const bf16*)(ws + WS_WDN), TP, 1024, FFN}; pg8::StaticOrder S; S.init(TP, 1024, F.G, (int)blockIdx.x);
        pg8::EpiRes<true> E{nullptr, nullptr, (bf16*)(ws + WS_HB), (float*)(ws + WS_SSQP3)};
        pg8::gemm_phase<pg8::EpiRes<true>, pg8::StaticOrder, true, true>(F.lds + RING_OFF, g, S, E);
        if (BOTH(11)) GRID_BAR(); }
    if (IN(12)) final_norm_phase(F);
#undef IN
#undef BOTH
}

extern "C" void kernel_launch(void* const* d_in, const int* in_sizes, int n_in, void* d_out, int out_size, void* d_ws, size_t ws_size, hipStream_t stream) {
    static int grid = 0;
    if (grid == 0) {
        const int want[32] = {TP * 1024, TS * 1024, MEMR * 1024, 33554432, 1179648, 16777216, 33554432, 33554432, 1024, 1024 * 11296, 4 * 3072, 3072, 32, 32, 32, 2048, 2048 * 1024, 2048, 1024,
                              1024 * 1024, 1024 * 1024, 1024, 1024, 1024 * 1024, 1024 * 1024, 1024 * 1024, 1024 * 1024, 1024, 1024 * FFN, 1024 * FFN, FFN * 1024, 1024};
        bool ok = (n_in == 32); for (int i = 0; ok && i < 32; ++i) if (in_sizes[i] != want[i]) { fprintf(stderr, "kernel_launch: input %d has %d elements, expected %d\n", i, in_sizes[i], want[i]); ok = false; }
        if (!ok || out_size != (int)O_END || ws_size < WS_END4) { fprintf(stderr, "kernel_launch: unexpected shapes: n_in %d out %d ws %zu\n", n_in, out_size, ws_size); grid = -1; return; }
        int dev = 0, cus = 0, per_cu = 0;
        if (hipGetDevice(&dev) != hipSuccess || hipDeviceGetAttribute(&cus, hipDeviceAttributeMultiprocessorCount, dev) != hipSuccess) { grid = -1; return; }
        if (hipFuncSetAttribute((const void*)skel_fwd, hipFuncAttributeMaxDynamicSharedMemorySize, LDS_BYTES) != hipSuccess) { fprintf(stderr, "kernel_launch: hipFuncSetAttribute failed\n"); grid = -1; return; }
        if (hipOccupancyMaxActiveBlocksPerMultiprocessor(&per_cu, (const void*)skel_fwd, NTHR, LDS_BYTES) != hipSuccess || per_cu < 1) fprintf(stderr, "kernel_launch: occupancy query reports %d blocks per CU\n", per_cu);
        (void)hipGetLastError();
        grid = cus;
    }
    if (grid < 0) return;
    (void)hipMemsetAsync((char*)d_ws + WS_CTL, 0, CTL_ZERO_BYTES, stream);
    Args a{};
    for (int i = 0; i < 32; ++i) a.in[i] = (const float*)d_in[i];
    a.out = (float*)d_out; a.ws = (unsigned char*)d_ws;
    for (int li = 0; li < N_LAUNCHES; ++li) {
        a.ph_lo = (N_LAUNCHES == PER_PHASE) ? li : 0; a.ph_hi = (N_LAUNCHES == PER_PHASE) ? li + 1 : PER_PHASE;
        hipLaunchKernelGGL(skel_fwd, dim3(grid), dim3(NTHR), LDS_BYTES, stream, a);
    }
}
```

```cpp
#include <hip/hip_runtime.h>
#include <cstdio>
#include <cstdint>
namespace pg8 {
#define PG8_LAS __attribute__((address_space(3)))
typedef unsigned short bf16_t;
typedef short bf16x8 __attribute__((ext_vector_type(8)));
typedef float f32x4 __attribute__((ext_vector_type(4)));
typedef unsigned u32x4 __attribute__((ext_vector_type(4)));
constexpr int BM = 256, BK = 64, HALF = 128, HTB = HALF * BK * 2  , STAGE_BYTES = 8 * HTB, NXCD = 8, WGM = 8;

__host__ __device__ __forceinline__ int lds_byte(int r, int c) { const int st = (r >> 4) * 2 + (c >> 5), rr = r & 15, cc = c & 31, ob = rr * 64 + cc * 2; return st * 1024 + (ob ^ (((ob >> 9) & 1) << 5)); }
__host__ __device__ __forceinline__ void stage_rc(int b, int& R, int& C) { const int st = b / 1024, sb = b % 1024, swz = sb ^ (((sb >> 9) & 1) << 5); R = (st >> 1) * 16 + swz / 64; C = (st & 1) * 32 + (swz % 64) / 2; }
__host__ __device__ __forceinline__ int perm32(int rho) { const int n = rho >> 4, i = rho & 15; return 8 * (i >> 2) + 4 * n + (i & 3); }

struct Unit { int pm, pn; };
struct Gemm { const bf16_t* A; const bf16_t* Bt; int M, N, K; };

struct StaticOrder {
    int nM, nN, nwg, G, c;
    __host__ __device__ void init(int M, int N, int G_, int c_) { nM = M / BM; nN = N / BM; nwg = nM * nN; G = G_; c = c_; }
    __host__ __device__ bool next(int i, Unit& u) const {
        const long L = (long)i * G + c; if (L >= nwg) return false;
        int wgid = (int)L; { const int q = nwg / NXCD, r = nwg % NXCD, xcd = wgid % NXCD, off = wgid / NXCD; wgid = (xcd < r ? xcd * (q + 1) : r * (q + 1) + (xcd - r) * q) + off; }
        const int nig = WGM * nN, gid = wgid / nig, fm = gid * WGM, gsz = (nM - fm) < WGM ? (nM - fm) : WGM;
        u.pm = fm + ((wgid % nig) % gsz); u.pn = (wgid % nig) / gsz; return true;
    }
    __device__ __forceinline__ void a_ready(const Unit&) const {}
    __device__ __forceinline__ void done(const Unit&) const {}
};

__device__ __forceinline__ unsigned cvt_pk_bf16(float lo, float hi) { unsigned r; asm volatile("v_cvt_pk_bf16_f32 %0, %1, %2" : "=v"(r) : "v"(lo), "v"(hi)); return r; }
typedef float f32x2 __attribute__((ext_vector_type(2)));
typedef unsigned u32x2 __attribute__((ext_vector_type(2)));
constexpr float RMS_EPS = 1e-6f;
__device__ __forceinline__ float bfbits2f(unsigned v16) { return __uint_as_float(v16 << 16); }
__device__ __forceinline__ float sigm(float x) { return __builtin_amdgcn_rcpf(1.0f + __expf(-x)); }
template <int NP> __device__ __forceinline__ float row_rs(const float* ssq, int row) {
    float s = 0.f;
    if constexpr (NP == 1) s = ssq[row];
    else {
#pragma unroll
        for (int i = 0; i < NP / 4; ++i) { const f32x4 v = *(const f32x4*)(ssq + (size_t)row * NP + 4 * i); s += (v[0] + v[1]) + (v[2] + v[3]); }
    }
    return 1.0f / sqrtf(s * (1.0f / 1024.0f) + RMS_EPS);
}
template <int NP, bool HAS_DT> struct EpiScaleBf16 {
    static constexpr bool PERM = true, AFTER_DRAIN = false;
    bf16_t* O; size_t slot_elems; const float* ssq; float scale; float* dt;
    __device__ __forceinline__ void operator()(const f32x4 (&acc)[2][2][4][2], const Unit& u, int wr, int wc, int fr, int fq) const {
        const int row0 = u.pm * BM + wr * 64 + fr;
        if (HAS_DT && u.pn == 44) {
            if (wc == 0) {
#pragma unroll
                for (int ai = 0; ai < 2; ++ai)
#pragma unroll
                    for (int m = 0; m < 4; ++m) { const int row = row0 + ai * HALF + m * 16; const float rs = row_rs<NP>(ssq, row);
                        float* p = dt + (size_t)row * 32 + 8 * fq; *(f32x4*)p = acc[ai][0][m][0] * rs; *(f32x4*)(p + 4) = acc[ai][0][m][1] * rs; }
            }
            return;
        }
        bf16_t* base = O + (size_t)(u.pn >> 2) * slot_elems; const int col0 = (u.pn & 3) * BM + wc * 32 + 8 * fq;
#pragma unroll
        for (int ai = 0; ai < 2; ++ai)
#pragma unroll
            for (int m = 0; m < 4; ++m) { const int row = row0 + ai * HALF + m * 16; const float rs = row_rs<NP>(ssq, row) * scale; bf16_t* rowp = base + (size_t)row * 1024 + col0;
#pragma unroll
                for (int bj = 0; bj < 2; ++bj) { const f32x4 v0 = acc[ai][bj][m][0] * rs, v1 = acc[ai][bj][m][1] * rs;
                    u32x4 w; w.x = cvt_pk_bf16(v0[0], v0[1]); w.y = cvt_pk_bf16(v0[2], v0[3]); w.z = cvt_pk_bf16(v1[0], v1[1]); w.w = cvt_pk_bf16(v1[2], v1[3]);
                    if (HAS_DT) __builtin_nontemporal_store(w, (u32x4*)(rowp + bj * HALF));
                    else *(u32x4*)(rowp + bj * HALF) = w; } }
    }
};
struct EpiKV {
    static constexpr bool PERM = false, AFTER_DRAIN = false;
    float* mk; float* mv; bf16_t* kb; bf16_t* vt; const float* ssq;
    __device__ __forceinline__ void operator()(const f32x4 (&acc)[2][2][4][2], const Unit& u, int wr, int wc, int fr, int fq) const {
        const int row0 = u.pm * BM + wr * 64 + fr; const bool isv = u.pn >= 4; const int colt = (u.pn & 3) * BM + wc * 32 + 4 * fq;
#pragma unroll
        for (int ai = 0; ai < 2; ++ai)
#pragma unroll
            for (int m = 0; m < 4; ++m) { const int row = row0 + ai * HALF + m * 16; const float rs = row_rs<1>(ssq, row);
#pragma unroll
                for (int bj = 0; bj < 2; ++bj)
#pragma unroll
                    for (int n = 0; n < 2; ++n) { const int c = colt + bj * HALF + n * 16; const f32x4 v = acc[ai][bj][m][n] * rs;
                        if (!isv) { __builtin_nontemporal_store(v, (f32x4*)(mk + (size_t)row * 1024 + c)); u32x2 w; w.x = cvt_pk_bf16(v[0], v[1]); w.y = cvt_pk_bf16(v[2], v[3]); *(u32x2*)(kb + (size_t)row * 1024 + c) = w; }
                        else { __builtin_nontemporal_store(v, (f32x4*)(mv + (size_t)row * 1024 + c)); const int b = row >> 8, key = row & 255, hd = c >> 8, d = c & 255;
                            bf16_t* p = vt + ((size_t)((b * 4 + hd) * 256 + d)) * 256 + key; const unsigned w0 = cvt_pk_bf16(v[0], v[1]), w1 = cvt_pk_bf16(v[2], v[3]);
                            p[0] = (bf16_t)(w0 & 0xffffu); p[256] = (bf16_t)(w0 >> 16); p[512] = (bf16_t)(w1 & 0xffffu); p[768] = (bf16_t)(w1 >> 16); } } }
    }
};
template <bool ADD> struct EpiGate {
    static constexpr bool PERM = true, AFTER_DRAIN = false;
    bf16_t* O; const bf16_t* gate;
    __device__ __forceinline__ void operator()(const f32x4 (&acc)[2][2][4][2], const Unit& u, int wr, int wc, int fr, int fq) const {
        const int row0 = u.pm * BM + wr * 64 + fr, col0 = u.pn * BM + wc * 32 + 8 * fq;
#pragma unroll
        for (int ai = 0; ai < 2; ++ai)
#pragma unroll
            for (int m = 0; m < 4; ++m) { const size_t off = (size_t)(row0 + ai * HALF + m * 16) * 1024 + col0;
#pragma unroll
                for (int bj = 0; bj < 2; ++bj) { const u32x4 gw = __builtin_nontemporal_load((const u32x4*)(gate + off + bj * HALF)); u32x4 ow = (u32x4){0u, 0u, 0u, 0u}; if (ADD) ow = *(const u32x4*)(O + off + bj * HALF);
                    float r[8];
#pragma unroll
                    for (int e = 0; e < 8; ++e) { const unsigned g16 = (gw[e >> 1] >> ((e & 1) * 16)) & 0xffffu, o16 = (ow[e >> 1] >> ((e & 1) * 16)) & 0xffffu;
                        const float a = acc[ai][bj][m][e >> 2][e & 3]; r[e] = (ADD ? bfbits2f(o16) : 0.f) + sigm(bfbits2f(g16)) * a; }
                    u32x4 w; w.x = cvt_pk_bf16(r[0], r[1]); w.y = cvt_pk_bf16(r[2], r[3]); w.z = cvt_pk_bf16(r[4], r[5]); w.w = cvt_pk_bf16(r[6], r[7]);
                    *(u32x4*)(O + off + bj * HALF) = w; } }
    }
};
template <bool BF> struct EpiRes {
    static constexpr bool PERM = true, AFTER_DRAIN = false;
    const float* base0; const float* base1; bf16_t* hb; float* ssqp;
    __device__ __forceinline__ void operator()(const f32x4 (&acc)[2][2][4][2], const Unit& u, int wr, int wc, int fr, int fq) const {
        const int row0 = u.pm * BM + wr * 64 + fr, col0 = u.pn * BM + wc * 32 + 8 * fq; const float* base = u.pm < 64 ? base0 : base1;
#pragma unroll
        for (int ai = 0; ai < 2; ++ai)
#pragma unroll
            for (int m = 0; m < 4; ++m) { const int row = row0 + ai * HALF + m * 16; const size_t off = (size_t)row * 1024 + col0; float sq = 0.f;
#pragma unroll
                for (int bj = 0; bj < 2; ++bj) { const size_t o2 = off + bj * HALF; f32x4 b0, b1;
                    if (BF) { const u32x4 w = *(const u32x4*)(hb + o2); b0 = (f32x4){bfbits2f(w.x & 0xffffu), __uint_as_float(w.x & 0xffff0000u), bfbits2f(w.y & 0xffffu), __uint_as_float(w.y & 0xffff0000u)};
                        b1 = (f32x4){bfbits2f(w.z & 0xffffu), __uint_as_float(w.z & 0xffff0000u), bfbits2f(w.w & 0xffffu), __uint_as_float(w.w & 0xffff0000u)}; }
                    else { b0 = __builtin_nontemporal_load((const f32x4*)(base + o2)); b1 = __builtin_nontemporal_load((const f32x4*)(base + o2 + 4)); }
                    const f32x4 v0 = b0 + acc[ai][bj][m][0], v1 = b1 + acc[ai][bj][m][1];
                    sq += ((v0[0] * v0[0] + v0[1] * v0[1]) + (v0[2] * v0[2] + v0[3] * v0[3])) + ((v1[0] * v1[0] + v1[1] * v1[1]) + (v1[2] * v1[2] + v1[3] * v1[3]));
                    u32x4 w; w.x = cvt_pk_bf16(v0[0], v0[1]); w.y = cvt_pk_bf16(v0[2], v0[3]); w.z = cvt_pk_bf16(v1[0], v1[1]); w.w = cvt_pk_bf16(v1[2], v1[3]); *(u32x4*)(hb + o2) = w; }
                sq += __shfl_xor(sq, 16); sq += __shfl_xor(sq, 32);
                if (fq == 0) ssqp[(size_t)row * 16 + u.pn * 4 + wc] = sq; }
    }
};
struct EpiSwiglu {
    static constexpr bool PERM = true, AFTER_DRAIN = false;
    bf16_t* act; const float* ssq;
    __device__ __forceinline__ void operator()(const f32x4 (&acc)[2][2][4][2], const Unit& u, int wr, int wc, int fr, int fq) const {
        const int row0 = u.pm * BM + wr * 64 + fr, col0 = u.pn * 128 + wc * 16 + 4 * fq;
#pragma unroll
        for (int ai = 0; ai < 2; ++ai)
#pragma unroll
            for (int m = 0; m < 4; ++m) { const int row = row0 + ai * HALF + m * 16; const float rs = row_rs<16>(ssq, row);
#pragma unroll
                for (int bj = 0; bj < 2; ++bj) { const f32x4 a = acc[ai][bj][m][0] * rs, b = acc[ai][bj][m][1] * rs;
                    const float r0 = a[0] * sigm(a[0]) * a[1], r1 = a[2] * sigm(a[2]) * a[3], r2 = b[0] * sigm(b[0]) * b[1], r3 = b[2] * sigm(b[2]) * b[3];
                    u32x2 w; w.x = cvt_pk_bf16(r0, r1); w.y = cvt_pk_bf16(r2, r3); *(u32x2*)(act + (size_t)row * 2816 + col0 + bj * 64) = w; } }
    }
};
template <class Epi, class Sched, bool ALIGN_EPI = false, bool SP2 = false>
__device__ __forceinline__ void gemm_phase(PG8_LAS unsigned char* lds, const Gemm g, const Sched& S, const Epi& E) {
    const int tid = threadIdx.x, wid = __builtin_amdgcn_readfirstlane(tid >> 6), lane = tid & 63, wr = wid >> 2, wc = wid & 3, fr = lane & 15, fq = lane >> 4;
    const int K = g.K, nt = K / BK;
    unsigned voffA[2], voffB[2];
#pragma unroll
    for (int i = 0; i < 2; ++i) { int R, C; stage_rc(tid * 16 + i * 8192, R, C); const int Rb = Epi::PERM ? ((R & ~31) + perm32(R & 31)) : R;
        voffA[i] = (unsigned)(R * K + C) * 2u; voffB[i] = (unsigned)(Rb * K + C) * 2u; }
    const size_t kstep = (size_t)(BK * 2);
    const size_t hstep = (size_t)HALF * K * 2;
    const size_t tstep = 2 * hstep;
    const unsigned ldsw = (unsigned)wid * 1024u;
    const int aoff = lds_byte(wr * 64 + fr, fq * 8), boff = lds_byte(wc * 32 + fr, fq * 8);
#define PG8_SA(b, h) (((b) * 2 + (h)) * HTB)
#define PG8_SB(b, h) ((4 + (b) * 2 + (h)) * HTB)
#define PG8_STAGE(bufoff, gbase, voff) do { _Pragma("unroll") for (int _i = 0; _i < 2; ++_i) \
        __builtin_amdgcn_global_load_lds((const unsigned*)((const char*)(gbase) + (voff)[_i]), (PG8_LAS unsigned*)(lds + (bufoff) + ldsw + _i * 8192), 16, 0, 0); } while (0)
#define PG8_LDA(dst, b, h) do { _Pragma("unroll") for (int m = 0; m < 4; ++m) _Pragma("unroll") for (int k = 0; k < 2; ++k) dst[m][k] = *(const PG8_LAS bf16x8*)(lds + PG8_SA(b, h) + aoff + m * 2048 + k * 1024); } while (0)
#define PG8_LDB(dst, b, h) do { _Pragma("unroll") for (int n = 0; n < 2; ++n) _Pragma("unroll") for (int k = 0; k < 2; ++k) dst[n][k] = *(const PG8_LAS bf16x8*)(lds + PG8_SB(b, h) + boff + n * 2048 + k * 1024); } while (0)
#define PG8_MMA(ai, bj, At, Bt) do { __builtin_amdgcn_s_setprio(1); _Pragma("unroll") for (int m = 0; m < 4; ++m) _Pragma("unroll") for (int n = 0; n < 2; ++n) _Pragma("unroll") for (int k = 0; k < 2; ++k) \
        acc[ai][bj][m][n] = __builtin_amdgcn_mfma_f32_16x16x32_bf16(Bt[n][k], At[m][k], acc[ai][bj][m][n], 0, 0, 0); __builtin_amdgcn_s_setprio(0); } while (0)
#define PG8_WAIT_V(n) asm volatile("s_waitcnt vmcnt(" #n ")" ::: "memory")
#define PG8_WAIT_L(n) asm volatile("s_waitcnt lgkmcnt(" #n ")" ::: "memory")
#define PG8_BAR __builtin_amdgcn_s_barrier()
#define PG8_SCHED __builtin_amdgcn_sched_barrier(0)
    Unit cur, nxt; int ui = 0;
    if (!S.next(0, cur)) return;
    f32x4 acc[2][2][4][2];
#pragma unroll
    for (int a = 0; a < 2; ++a)
#pragma unroll
        for (int b = 0; b < 2; ++b)
#pragma unroll
            for (int m = 0; m < 4; ++m)
#pragma unroll
                for (int n = 0; n < 2; ++n) acc[a][b][m][n] = (f32x4){0.f, 0.f, 0.f, 0.f};
    bf16x8 At[4][2], B0[2][2], B1[2][2];
    const char* cA = (const char*)g.A + (size_t)cur.pm * tstep; const char* cB = (const char*)g.Bt + (size_t)cur.pn * tstep;
    S.a_ready(cur);
    if constexpr (SP2) {
        PG8_STAGE(PG8_SB(0, 0), cB, voffB); PG8_STAGE(PG8_SB(0, 1), cB + hstep, voffB); PG8_STAGE(PG8_SA(0, 0), cA, voffA); PG8_STAGE(PG8_SA(0, 1), cA + hstep, voffA);
        if (wr == 1) PG8_BAR;
        PG8_WAIT_V(2); PG8_BAR;
        PG8_STAGE(PG8_SB(1, 0), cB + kstep, voffB); PG8_STAGE(PG8_SA(1, 0), cA + kstep, voffA); PG8_STAGE(PG8_SB(1, 1), cB + hstep + kstep, voffB);
        PG8_WAIT_V(6); PG8_BAR;
    } else {
        PG8_STAGE(PG8_SB(0, 0), cB, voffB); PG8_STAGE(PG8_SA(0, 0), cA, voffA); PG8_STAGE(PG8_SB(0, 1), cB + hstep, voffB); PG8_STAGE(PG8_SA(0, 1), cA + hstep, voffA);
        if (wr == 1) PG8_BAR;
        PG8_WAIT_V(4); PG8_BAR;
        PG8_STAGE(PG8_SB(1, 0), cB + kstep, voffB); PG8_STAGE(PG8_SA(1, 0), cA + kstep, voffA); PG8_STAGE(PG8_SB(1, 1), cB + hstep + kstep, voffB);
        PG8_WAIT_V(6); PG8_BAR;
    }
    for (;;) {
        const bool has_next = S.next(ui + 1, nxt);
        const char* nA = has_next ? (const char*)g.A + (size_t)nxt.pm * tstep : cA; const char* nB = has_next ? (const char*)g.Bt + (size_t)nxt.pn * tstep : cB;
        for (int t = 0; t < nt; t += 2) {
            const bool last = (t == nt - 2);
            const char* a1 = cA + (size_t)(t + 1) * kstep;
            const char* a2 = last ? nA : cA + (size_t)(t + 2) * kstep; const char* b2 = last ? nB : cB + (size_t)(t + 2) * kstep;
            const char* a3 = a2 + kstep; const char* b3 = b2 + kstep;
            if (last && has_next) S.a_ready(nxt);
            if constexpr (SP2) {
            PG8_LDB(B0, 0, 0); PG8_LDB(B1, 0, 1); PG8_SCHED; PG8_LDA(At, 0, 0); PG8_STAGE(PG8_SA(1, 1), a1 + hstep, voffA);
            PG8_WAIT_V(8); PG8_WAIT_L(0); PG8_BAR; PG8_MMA(0, 0, At, B0); PG8_MMA(0, 1, At, B1); PG8_BAR; PG8_SCHED;
            PG8_LDA(At, 0, 1); PG8_STAGE(PG8_SB(0, 0), b2, voffB); PG8_STAGE(PG8_SB(0, 1), b2 + hstep, voffB); PG8_STAGE(PG8_SA(0, 0), a2, voffA);
            PG8_WAIT_V(8); PG8_WAIT_L(0); PG8_BAR; PG8_MMA(1, 0, At, B0); PG8_MMA(1, 1, At, B1); PG8_BAR; PG8_SCHED;
            PG8_LDB(B0, 1, 0); PG8_LDB(B1, 1, 1); PG8_SCHED; PG8_LDA(At, 1, 0); PG8_STAGE(PG8_SA(0, 1), a2 + hstep, voffA);
            PG8_WAIT_V(8); PG8_WAIT_L(0); PG8_BAR; PG8_MMA(0, 0, At, B0); PG8_MMA(0, 1, At, B1); PG8_BAR; PG8_SCHED;
            PG8_LDA(At, 1, 1); PG8_STAGE(PG8_SB(1, 0), b3, voffB); PG8_STAGE(PG8_SB(1, 1), b3 + hstep, voffB); PG8_STAGE(PG8_SA(1, 0), a3, voffA);
            PG8_WAIT_V(8); PG8_WAIT_L(0); PG8_BAR; PG8_MMA(1, 0, At, B0); PG8_MMA(1, 1, At, B1); PG8_BAR; PG8_SCHED;
            } else {
            PG8_LDB(B0, 0, 0); PG8_SCHED; PG8_LDA(At, 0, 0); PG8_STAGE(PG8_SA(1, 1), a1 + hstep, voffA);
            PG8_WAIT_L(8); PG8_BAR; PG8_WAIT_L(0); PG8_MMA(0, 0, At, B0); PG8_BAR; PG8_SCHED;
            PG8_LDB(B1, 0, 1); PG8_STAGE(PG8_SB(0, 0), b2, voffB);
            PG8_BAR; PG8_WAIT_L(0); PG8_MMA(0, 1, At, B1); PG8_BAR;
            PG8_LDA(At, 0, 1); PG8_STAGE(PG8_SA(0, 0), a2, voffA);
            PG8_BAR; PG8_WAIT_L(0); PG8_MMA(1, 0, At, B0); PG8_BAR; PG8_SCHED;
            PG8_STAGE(PG8_SB(0, 1), b2 + hstep, voffB);
            PG8_WAIT_V(6); PG8_BAR; PG8_MMA(1, 1, At, B1); PG8_BAR;
            PG8_LDB(B0, 1, 0); PG8_SCHED; PG8_LDA(At, 1, 0); PG8_STAGE(PG8_SA(0, 1), a2 + hstep, voffA);
            PG8_WAIT_L(8); PG8_BAR; PG8_WAIT_L(0); PG8_MMA(0, 0, At, B0); PG8_BAR; PG8_SCHED;
            PG8_LDB(B1, 1, 1); PG8_STAGE(PG8_SB(1, 0), b3, voffB);
            PG8_BAR; PG8_WAIT_L(0); PG8_MMA(0, 1, At, B1); PG8_BAR;
            PG8_LDA(At, 1, 1); PG8_STAGE(PG8_SA(1, 0), a3, voffA);
            PG8_BAR; PG8_WAIT_L(0); PG8_MMA(1, 0, At, B0); PG8_BAR; PG8_SCHED;
            PG8_STAGE(PG8_SB(1, 1), b3 + hstep, voffB);
            PG8_WAIT_V(6); PG8_BAR; PG8_MMA(1, 1, At, B1); PG8_BAR;
            }
        }
        if constexpr (ALIGN_EPI) { if (wr == 0) PG8_BAR; }
        if constexpr (!Epi::AFTER_DRAIN) { E(acc, cur, wr, wc, fr, fq); S.done(cur); }
        if (!has_next) break;
#pragma unroll
        for (int a = 0; a < 2; ++a)
#pragma unroll
            for (int b = 0; b < 2; ++b)
#pragma unroll
                for (int m = 0; m < 4; ++m)
#pragma unroll
                    for (int n = 0; n < 2; ++n) acc[a][b][m][n] = (f32x4){0.f, 0.f, 0.f, 0.f};
        cur = nxt; cA = nA; cB = nB; ++ui;
        if constexpr (ALIGN_EPI) { if (wr == 1) PG8_BAR; }
    }
    PG8_WAIT_V(0);
    if constexpr (!ALIGN_EPI) { if (wr == 0) PG8_BAR; }
    PG8_BAR;
    if constexpr (Epi::AFTER_DRAIN) { E.fused(acc, cur, wr, wc, fr, fq, lds, wid, lane); S.done(cur); }
#undef PG8_SA
#undef PG8_SB
#undef PG8_STAGE
#undef PG8_LDA
#undef PG8_LDB
#undef PG8_MMA
#undef PG8_WAIT_V
#undef PG8_WAIT_L
#undef PG8_BAR
#undef PG8_SCHED
}
}
#define GAS __attribute__((address_space(1)))
#define LAS __attribute__((address_space(3)))
typedef unsigned short bf16;
typedef unsigned v4u __attribute__((ext_vector_type(4)));
typedef float f32x4 __attribute__((ext_vector_type(4)));
typedef short bf16x8 __attribute__((ext_vector_type(8)));
typedef GAS unsigned gu32;
typedef GAS unsigned long long gu64;
#define RLX_AGENT __ATOMIC_RELAXED, __HIP_MEMORY_SCOPE_AGENT
#define LDS_WAIT() asm volatile("s_waitcnt lgkmcnt(0)" ::: "memory")
#define VM_WAIT() asm volatile("s_waitcnt vmcnt(0)" ::: "memory")
__device__ __forceinline__ unsigned long long rt() { return __builtin_amdgcn_s_memrealtime(); }
typedef float f32x2_t __attribute__((ext_vector_type(2))); typedef __bf16 bf16x2_t __attribute__((ext_vector_type(2)));
__device__ __forceinline__ unsigned pk2(float lo, float hi) { const f32x2_t v = {lo, hi}; const bf16x2_t b = __builtin_convertvector(v, bf16x2_t); return __builtin_bit_cast(unsigned, b); }
__device__ __forceinline__ unsigned f2bf(float f) { return pk2(f, 0.f) & 0xffffu; }

#define XB_TMO      128
#define XB_XCNT(j)  (256  + 64 * (j))
#define XB_XSUB(j)  (1280 + 64 * (j))
#define XB_XGEN(j)  (2304 + 64 * (j))
#define XB_TOP      3328
#define XB_TOPGEN   3392
#define XCD_BAR_WORDS 3456
#define XB_SPIN_CAP (1u << 18)

__device__ __forceinline__ unsigned xb_ld(unsigned* p)              { return __hip_atomic_load(p, __ATOMIC_RELAXED, __HIP_MEMORY_SCOPE_AGENT); }
__device__ __forceinline__ unsigned xb_add(unsigned* p, unsigned v) { return __hip_atomic_fetch_add(p, v, __ATOMIC_RELAXED, __HIP_MEMORY_SCOPE_AGENT); }
__device__ __forceinline__ unsigned xb_xcc_id() { return (unsigned)__builtin_amdgcn_s_getreg((3 << 11) | 20) & 0xFu; }
#define XB_SPIN(cond, bar) do { unsigned _sp = 0; while (cond) { __builtin_amdgcn_s_sleep(1); \
    if ((++_sp & 255u) == 0u) { if (xb_ld(&(bar)[XB_TMO])) break; if (_sp > XB_SPIN_CAP) { atomicAdd(&(bar)[XB_TMO], 1u); break; } } } } while (0)

struct XcdBarrier {
    unsigned* bar; unsigned x;
    volatile LAS unsigned* st;
};

__device__ __forceinline__ XcdBarrier xcd_barrier_post(unsigned* bar, volatile LAS unsigned* st) {
    XcdBarrier b; b.bar = bar; b.x = xb_xcc_id(); b.st = st;
    if (threadIdx.x == 0) (void)xb_add(&bar[XB_XCNT(b.x)], 1u);
    return b;
}
__device__ __forceinline__ void xcd_barrier_complete(unsigned* bar, unsigned x, unsigned& nloc, unsigned& nx) {
    const unsigned G = gridDim.x * gridDim.y * gridDim.z;
    unsigned sum, cnt, mine, sp = 0u;
    for (;;) {
        sum = 0u; cnt = 0u; mine = 0u;
#pragma unroll
        for (unsigned j = 0; j < 16; ++j) { const unsigned c = xb_ld(&bar[XB_XCNT(j)]); sum += c; cnt += (c > 0u) ? 1u : 0u; mine = (j == x) ? c : mine; }
        if (sum == G) break;
        __builtin_amdgcn_s_sleep(1);
        if ((++sp & 255u) == 0u) { if (xb_ld(&bar[XB_TMO])) break; if (sp > XB_SPIN_CAP) { atomicAdd(&bar[XB_TMO], 1u); break; } }
    }
    nloc = mine > 0u ? mine : 1u; nx = cnt > 0u ? cnt : 1u;
}

__device__ __forceinline__ void xcd_barrier(const XcdBarrier& b) {
    asm volatile("s_waitcnt vmcnt(0)" ::: "memory");
    __syncthreads();
    if (threadIdx.x == 0) {
        unsigned* bar = b.bar;
        __builtin_amdgcn_s_waitcnt(0);
        unsigned nloc = b.st[0], nx = b.st[1];
        if (nloc == 0u) { xcd_barrier_complete(bar, b.x, nloc, nx); b.st[0] = nloc; b.st[1] = nx; }
        const unsigned old = xb_add(&bar[XB_XSUB(b.x)], 1u);
        const unsigned gen = old / nloc;
        if (old + 1u == (gen + 1u) * nloc) {
            __builtin_amdgcn_fence(__ATOMIC_RELEASE, "agent");
            asm volatile("s_waitcnt vmcnt(0)" ::: "memory");
            const unsigned og = xb_add(&bar[XB_TOP], 1u);
            const unsigned tg = og / nx;
            if (og + 1u == (tg + 1u) * nx) xb_add(&bar[XB_TOPGEN], 1u);
            else XB_SPIN(xb_ld(&bar[XB_TOPGEN]) == tg, bar);
            __builtin_amdgcn_fence(__ATOMIC_ACQUIRE, "agent");
            xb_add(&bar[XB_XGEN(b.x)], 1u);
            asm volatile("s_waitcnt vmcnt(0)" ::: "memory");
        } else {
            XB_SPIN(xb_ld(&bar[XB_XGEN(b.x)]) == gen, bar);
            __builtin_amdgcn_fence(__ATOMIC_ACQUIRE, "agent");
            asm volatile("s_waitcnt vmcnt(0)" ::: "memory");
        }
    }
    __syncthreads();
}
typedef unsigned v2u __attribute__((ext_vector_type(2)));
constexpr int NWAVES = 8, NTHR = 512;
constexpr int DM = 1024, TP = 16384, TS = 512, T = TP + TS;
constexpr int SEQ = 2048, NBP = 8, NBS = 128, LS = 4, MEMR = 2048;
constexpr int NPROJ = 11520;
constexpr int FFN = 2816;
constexpr float EPS = 1e-6f;
constexpr float QSCALE = 0.0625f * 1.4426950408889634f;

constexpr size_t MiB = 1u << 20;
constexpr size_t WS_CTL = 0, CTL_ZERO_BYTES = 32768;
constexpr size_t WS_SSQX = 1 * MiB, WS_SSQM = 1 * MiB + 512 * 1024;
constexpr size_t WS_DT = 2 * MiB, WS_SSQSSD = 5 * MiB, WS_SSQP1 = 8 * MiB, WS_SSQP2 = 9 * MiB + 512 * 1024, WS_SSQP3 = 11 * MiB;
constexpr size_t WS_WIN = 13 * MiB, WS_WKV = 36 * MiB, WS_WSSD = 40 * MiB, WS_WHG = 44 * MiB, WS_WOUT = 46 * MiB, WS_WCQ = 48 * MiB, WS_WCO = 50 * MiB, WS_WGU = 52 * MiB, WS_WDN = 63 * MiB;
constexpr size_t WS_XB = 69 * MiB, WS_MNB = 102 * MiB, WS_KB = 106 * MiB, WS_VT = 110 * MiB;
constexpr size_t SLOT = 33 * MiB, SLOT_ELEMS = (size_t)T * 1024;
constexpr size_t WS_PROJ = 114 * MiB;
constexpr size_t WS_YG = WS_PROJ + 11 * SLOT, WS_ON = WS_YG + 2 * SLOT, WS_END = WS_ON + SLOT;
static_assert(SLOT == SLOT_ELEMS * 2, "slot size");
static_assert(WS_WIN + (size_t)NPROJ * 1024 * 2 <= WS_WKV && WS_WGU + (size_t)2 * FFN * 1024 * 2 <= WS_WDN && WS_WDN + (size_t)1024 * FFN * 2 <= WS_XB && WS_SSQP3 + (size_t)T * 64 <= WS_WIN, "d_ws map");
static_assert(WS_DT + (size_t)T * 128 <= WS_SSQSSD && WS_SSQSSD + (size_t)T * 128 <= WS_SSQP1 && WS_SSQP1 + (size_t)T * 64 <= WS_SSQP2 && WS_SSQP2 + (size_t)T * 64 <= WS_SSQP3, "d_ws map 2");
enum { S_Z0 = 0, S_Z1 = 1, S_X0 = 2, S_X1 = 3, S_X2 = 4, S_Q = 5, S_F = 6, S_I = 7, S_HG = 8, S_GS = 9, S_GH = 10 };
constexpr size_t WS_MERGED = WS_PROJ + S_Q * SLOT, WS_HB = WS_PROJ + S_F * SLOT, WS_QB = WS_PROJ + S_I * SLOT, WS_OB = WS_PROJ + S_HG * SLOT, WS_ACT = WS_PROJ;
static_assert((size_t)T * FFN * 2 <= 3 * SLOT, "act overlay");
constexpr size_t O_Y = 0, O_SSMP = (size_t)T * 1024, O_CONVP = O_SSMP + 2097152, O_HGP = O_CONVP + 73728, O_MKP = O_HGP + 1048576, O_MVP = O_MKP + 2097152,
                 O_SSMS = O_MVP + 2097152, O_CONVS = O_SSMS + 33554432, O_HGS = O_CONVS + 1179648, O_END = O_HGS + 16777216;
constexpr int CW_QUEUE = 64;
constexpr int CW_BAR = 4096;
constexpr int RING_OFF = 0, RING_BYTES = 131072;
constexpr int LDS_BYTES = 147456;
constexpr int LDSCTL_OFF = LDS_BYTES - 1024, MISC_OFF = LDSCTL_OFF + 320;
struct Frame {
    LAS unsigned char* lds;
    volatile LAS unsigned* MISC;
    gu32* ctl;
    int tid, lane, wave;
    int vcu, G;
    const float* in[32];
    float* out; unsigned char* ws;
};
__device__ __forceinline__ float bf2f(unsigned v16) { return __uint_as_float(v16 << 16); }
__device__ __forceinline__ f32x4 ld_nt(const float* p) { return __builtin_nontemporal_load((const f32x4*)p); }
__device__ __forceinline__ void st_nt(float* p, f32x4 v) { __builtin_nontemporal_store(v, (f32x4*)p); }
__device__ __forceinline__ v4u ld_nt16(const void* p) { return __builtin_nontemporal_load((const v4u*)p); }
__device__ __forceinline__ unsigned ld_nt4(const void* p) { return __builtin_nontemporal_load((const unsigned*)p); }
__device__ __forceinline__ float sigmoid_f(float x) { return __builtin_amdgcn_rcpf(1.0f + __expf(-x)); }
__device__ __forceinline__ float silu_f(float x) { return x * sigmoid_f(x); }
__device__ __forceinline__ float wave_sum(float v) {
#pragma unroll
    for (int o = 1; o < 64; o <<= 1) v += __shfl_xor(v, o);
    return v;
}
__device__ __forceinline__ float wave_max(float v) {
#pragma unroll
    for (int o = 1; o < 64; o <<= 1) v = fmaxf(v, __shfl_xor(v, o));
    return v;
}
struct TSrc { const float* W; const float* W2; const float* ks; int ldw; int mode; };
__device__ __forceinline__ void p0_transpose_item(const TSrc& s, int K, int N, bf16* WT, LAS unsigned short* scr, int item, int lane) {
    const int nblk = N / 64, kb = item / nblk, nb = item % nblk, k0 = 64 * kb, n0 = 64 * nb;
    const int kr = lane >> 4, nq = lane & 15;
    const float* const Wa = s.W; const float* const Wb = s.W2;
    const float* src; int c0, cs; bool zero = false;
    if (s.mode == 2) { const float* wsel = Wa; if (nq >= 8) wsel = Wb; src = wsel + (n0 >> 1) + 4 * (nq & 7); c0 = 8 * (nq & 7) + (nq >> 3); cs = 2; }
    else { const int n = n0 + 4 * nq; c0 = 4 * nq; cs = 1;
        if (s.mode == 0) src = Wa + n;
        else if (s.mode == 1) { if (n < 5120) src = Wa + n; else if (n < 11264) src = Wa + n + 32; else if (n < 11296) src = Wa + 5120 + (n - 11264); else { src = Wa; zero = true; } }
        else { src = Wa + n; if (n >= 1024) src = Wb + (n - 1024); } }
    f32x4 v[16];
#pragma unroll
    for (int i = 0; i < 16; ++i) v[i] = zero ? (f32x4){0.f, 0.f, 0.f, 0.f} : ld_nt(src + (size_t)(k0 + 4 * i + kr) * s.ldw);
#pragma unroll
    for (int i = 0; i < 16; ++i) { const int kk = 4 * i + kr; const float sc = s.ks ? s.ks[k0 + kk] : 1.0f; const unsigned w0 = pk2(v[i].x * sc, v[i].y * sc), w1 = pk2(v[i].z * sc, v[i].w * sc);
        LAS unsigned short* d = scr + kk * 66 + c0;
        if (cs == 1) { *(LAS unsigned*)d = w0; *(LAS unsigned*)(d + 2) = w1; }
        else { d[0] = (unsigned short)(w0 & 0xffffu); d[2] = (unsigned short)(w0 >> 16); d[4] = (unsigned short)(w1 & 0xffffu); d[6] = (unsigned short)(w1 >> 16); } }
    LDS_WAIT(); asm volatile("" ::: "memory");
    const int nr = lane >> 3, kc = lane & 7;
#pragma unroll
    for (int j = 0; j < 8; ++j) { const int n = 8 * j + nr; const LAS unsigned short* p = scr + (8 * kc) * 66 + n;
        v4u o; o.x = (unsigned)p[0] | ((unsigned)p[66] << 16); o.y = (unsigned)p[2 * 66] | ((unsigned)p[3 * 66] << 16); o.z = (unsigned)p[4 * 66] | ((unsigned)p[5 * 66] << 16); o.w = (unsigned)p[6 * 66] | ((unsigned)p[7 * 66] << 16);
        *(v4u*)(WT + (size_t)(n0 + n) * K + k0 + 8 * kc) = o; }
    LDS_WAIT(); asm volatile("" ::: "memory");
}
__device__ __forceinline__ void rows4_to_bf16_ssq(const float* x0, bf16* o0, float* ssq0, int lane) {
    f32x4 v[4][4];
#pragma unroll
    for (int rr = 0; rr < 4; ++rr)
#pragma unroll
        for (int j = 0; j < 4; ++j) v[rr][j] = ld_nt(x0 + rr * 1024 + 4 * (64 * j + lane));
#pragma unroll
    for (int rr = 0; rr < 4; ++rr) { float sq = 0.f;
#pragma unroll
        for (int j = 0; j < 4; ++j) sq += (v[rr][j].x * v[rr][j].x + v[rr][j].y * v[rr][j].y) + (v[rr][j].z * v[rr][j].z + v[rr][j].w * v[rr][j].w);
        sq = wave_sum(sq);
        unsigned long long* o8 = (unsigned long long*)(o0 + rr * 1024) + lane;
#pragma unroll
        for (int j = 0; j < 4; ++j) o8[64 * j] = (unsigned long long)pk2(v[rr][j].x, v[rr][j].y) | ((unsigned long long)pk2(v[rr][j].z, v[rr][j].w) << 32);
        if (lane == 0) ssq0[rr] = sq; }
}
__device__ __forceinline__ void p0_prologue(Frame& F) {
    LAS unsigned short* scr = (LAS unsigned short*)(F.lds + RING_OFF + F.wave * 16384);
    const int gw = F.vcu * NWAVES + F.wave, NGW = F.G * NWAVES;
    unsigned char* ws = F.ws;
    constexpr int I_IN = 16 * (NPROJ / 64), I_KV = 16 * 32, I_SSD = 32 * 16, I_SQ = 16 * 16, I_GU = 16 * (2 * FFN / 64), I_DN = (FFN / 64) * 16;
    constexpr int NITEMS = I_IN + I_KV + I_SSD + 4 * I_SQ + I_GU + I_DN;
    for (int it = gw; it < NITEMS; it += NGW) {
        int r = it;
        if (r < I_IN) { TSrc s{F.in[9], nullptr, F.in[8], 11296, 1}; p0_transpose_item(s, 1024, NPROJ, (bf16*)(ws + WS_WIN), scr, r, F.lane); continue; } r -= I_IN;
        if (r < I_KV) { TSrc s{F.in[24], F.in[25], F.in[22], 1024, 3}; p0_transpose_item(s, 1024, 2048, (bf16*)(ws + WS_WKV), scr, r, F.lane); continue; } r -= I_KV;
        if (r < I_SSD) { TSrc s{F.in[16], nullptr, F.in[15], 1024, 0}; p0_transpose_item(s, 2048, 1024, (bf16*)(ws + WS_WSSD), scr, r, F.lane); continue; } r -= I_SSD;
        if (r < I_SQ) { TSrc s{F.in[19], nullptr, F.in[18], 1024, 0}; p0_transpose_item(s, 1024, 1024, (bf16*)(ws + WS_WHG), scr, r, F.lane); continue; } r -= I_SQ;
        if (r < I_SQ) { TSrc s{F.in[20], nullptr, nullptr, 1024, 0}; p0_transpose_item(s, 1024, 1024, (bf16*)(ws + WS_WOUT), scr, r, F.lane); continue; } r -= I_SQ;
        if (r < I_SQ) { TSrc s{F.in[23], nullptr, F.in[21], 1024, 0}; p0_transpose_item(s, 1024, 1024, (bf16*)(ws + WS_WCQ), scr, r, F.lane); continue; } r -= I_SQ;
        if (r < I_SQ) { TSrc s{F.in[26], nullptr, nullptr, 1024, 0}; p0_transpose_item(s, 1024, 1024, (bf16*)(ws + WS_WCO), scr, r, F.lane); continue; } r -= I_SQ;
        if (r < I_GU) { TSrc s{F.in[28], F.in[29], F.in[27], FFN, 2}; p0_transpose_item(s, 1024, 2 * FFN, (bf16*)(ws + WS_WGU), scr, r, F.lane); continue; } r -= I_GU;
        { TSrc s{F.in[30], nullptr, nullptr, 1024, 0}; p0_transpose_item(s, FFN, 1024, (bf16*)(ws + WS_WDN), scr, r, F.lane); }
    }
    bf16* XB = (bf16*)(ws + WS_XB); float* SSQX = (float*)(ws + WS_SSQX);
    for (int m4 = gw; m4 < T / 4; m4 += NGW) { const int m = 4 * m4;
        rows4_to_bf16_ssq(m < TP ? F.in[0] + (size_t)m * DM : F.in[1] + (size_t)(m - TP) * DM, XB + (size_t)m * DM, SSQX + m, F.lane); }
    bf16* MNB = (bf16*)(ws + WS_MNB); float* SSQM = (float*)(ws + WS_SSQM);
    for (int m4 = gw; m4 < MEMR / 4; m4 += NGW) { const int m = 4 * m4; rows4_to_bf16_ssq(F.in[2] + (size_t)m * DM, MNB + (size_t)m * DM, SSQM + m, F.lane); }
}
__device__ __forceinline__ void conv_copy_unit(Frame& F, int gb) {
    const bf16* PROJ = (const bf16*)(F.ws + WS_PROJ);
    const bool prompt = gb < NBP; const int sb = gb - NBP;
    const size_t row0 = prompt ? (size_t)gb * SEQ + (SEQ - 3) : (size_t)TP + (size_t)sb * LS + 1;
    float* dst = prompt ? F.out + O_CONVP + (size_t)gb * 3 * 3072 : F.out + O_CONVS + (size_t)sb * 3 * 3072;
    for (int e = F.tid; e < 3 * 3072; e += NTHR) { const int j = e / 3072, col = e % 3072;
        dst[e] = bf2f(PROJ[(size_t)(S_X0 + (col >> 10)) * SLOT_ELEMS + (row0 + j) * 1024 + (col & 1023)]); }
}
__device__ __forceinline__ void ssdnorm_phase(Frame& F) {
    const int gw = F.vcu * NWAVES + F.wave, NGW = F.G * NWAVES; bf16* YG = (bf16*)(F.ws + WS_YG); const float* SSQ = (const float*)(F.ws + WS_SSQSSD);
    for (int row = gw; row < T; row += NGW) {
        const f32x4* sp = (const f32x4*)(SSQ + (size_t)row * 32);
#pragma unroll
        for (int j = 0; j < 4; ++j) { const f32x4 a = sp[2 * j], b = sp[2 * j + 1]; const float s = ((a.x + a.y) + (a.z + a.w)) + ((b.x + b.y) + (b.z + b.w)); const float rs = 1.0f / sqrtf(s * (1.0f / 512.0f) + EPS);
            v4u* p = (v4u*)(YG + (size_t)row * 2048) + j * 64 + F.lane; const v4u w = *p; v4u o;
#pragma unroll
            for (int e = 0; e < 4; ++e) o[e] = pk2(bf2f(w[e] & 0xffffu) * rs, bf2f(w[e] >> 16) * rs);
            *p = o; }
    }
}
typedef float f32x16 __attribute__((ext_vector_type(16)));
#define MFMA32(a, b, c) __builtin_amdgcn_mfma_f32_32x32x16_bf16((a), (b), (c), 0, 0, 0)
__device__ __forceinline__ unsigned cvtpk_c(float lo, float hi) { return pk2(lo, hi); }
__device__ __forceinline__ bf16x8 pack8(float a0, float a1, float a2, float a3, float a4, float a5, float a6, float a7) {
    v4u w; w.x = cvtpk_c(a0, a1); w.y = cvtpk_c(a2, a3); w.z = cvtpk_c(a4, a5); w.w = cvtpk_c(a6, a7); return __builtin_bit_cast(bf16x8, w); }
#define ACC_FRAG(x, s) pack8((x)[8 * (s)], (x)[8 * (s) + 1], (x)[8 * (s) + 2], (x)[8 * (s) + 3], (x)[8 * (s) + 4], (x)[8 * (s) + 5], (x)[8 * (s) + 6], (x)[8 * (s) + 7])
__device__ __forceinline__ bf16x8 lds_frag16(const LAS unsigned char* p) { return *(const LAS bf16x8*)p; }
__device__ __forceinline__ bf16x8 lds_frag8x2(const LAS unsigned char* p) { const v2u lo = *(const LAS v2u*)p, hi = *(const LAS v2u*)(p + 16);
    const v4u w = (v4u){lo.x, lo.y, hi.x, hi.y}; return __builtin_bit_cast(bf16x8, w); }
#define LDS_BARRIER() do { asm volatile("s_waitcnt lgkmcnt(0)" ::: "memory"); __builtin_amdgcn_s_barrier(); asm volatile("" ::: "memory"); } while (0)
constexpr size_t WS_BCS = WS_END, WS_BTT = WS_BCS + (size_t)TP * 1024 * 2, WS_END2 = WS_BTT + (size_t)NBP * 32 * 4 * 128 * 64 * 2;
__device__ __forceinline__ void bc_prep_unit(Frame& F, int b, int c) {
    typedef float f32x2 __attribute__((ext_vector_type(2)));
    int tid_o = F.tid; asm volatile("" : "+v"(tid_o));
    const int tid = tid_o, cg = tid & 127, seg = tid >> 7; unsigned char* ws = F.ws;
    const bf16* src = (const bf16*)(ws + WS_PROJ) + (size_t)S_X2 * SLOT_ELEMS + (size_t)b * SEQ * 1024 + 8 * cg;
    bf16* BCS = (bf16*)(ws + WS_BCS); bf16* BTT = (bf16*)(ws + WS_BTT);
    const float* cw = F.in[10] + 2048 + 8 * cg; const float* cbp = F.in[11] + 2048 + 8 * cg;
#pragma unroll 1
    for (int half = 0; half < 2; ++half) {
        const int s0 = 16 * seg + 8 * half;
        v4u raw[11];
#pragma unroll
        for (int i = 0; i < 11; ++i) { const int gt = 64 * c + s0 - 3 + i; raw[i] = (v4u){0u, 0u, 0u, 0u}; if (gt >= 0) raw[i] = ld_nt16(src + (size_t)gt * 1024); }
        v4u rowpk[8];
#pragma unroll
        for (int kp = 0; kp < 4; ++kp) {
            const f32x2 cw0 = *(const f32x2*)(cw + 2 * kp), cw1 = *(const f32x2*)(cw + 3072 + 2 * kp), cw2 = *(const f32x2*)(cw + 2 * 3072 + 2 * kp), cw3 = *(const f32x2*)(cw + 3 * 3072 + 2 * kp), cbb = *(const f32x2*)(cbp + 2 * kp);
            f32x2 xv[11];
#pragma unroll
            for (int i = 0; i < 11; ++i) { const unsigned wd = raw[i][kp]; xv[i] = (f32x2){__uint_as_float(wd << 16), __uint_as_float(wd & 0xffff0000u)}; }
            f32x2 o[8];
#pragma unroll
            for (int i = 0; i < 8; ++i) { f32x2 a = cw0 * xv[i] + cbb; a = cw1 * xv[i + 1] + a; a = cw2 * xv[i + 2] + a; a = cw3 * xv[i + 3] + a;
                const f32x2 t = a * (-1.4426950408889634f); f32x2 e; e.x = __builtin_amdgcn_exp2f(t.x); e.y = __builtin_amdgcn_exp2f(t.y); e = e + 1.0f;
                f32x2 rc; rc.x = __builtin_amdgcn_rcpf(e.x); rc.y = __builtin_amdgcn_rcpf(e.y); o[i] = a * rc; }
#pragma unroll
            for (int i = 0; i < 8; ++i) rowpk[i][kp] = pk2(o[i].x, o[i].y);
            if (cg < 64) { const int ng = 8 * cg + 2 * kp, g = ng >> 7, n = ng & 127;
                bf16* dst = BTT + ((size_t)(((b * 32 + c) * 4 + g) * 128 + n)) * 64 + s0;
                v4u pa; pa.x = pk2(o[0].x, o[1].x); pa.y = pk2(o[2].x, o[3].x); pa.z = pk2(o[4].x, o[5].x); pa.w = pk2(o[6].x, o[7].x); *(v4u*)dst = pa;
                v4u pb; pb.x = pk2(o[0].y, o[1].y); pb.y = pk2(o[2].y, o[3].y); pb.z = pk2(o[4].y, o[5].y); pb.w = pk2(o[6].y, o[7].y); *(v4u*)(dst + 64) = pb; }
        }
        bf16* drow = BCS + ((size_t)b * SEQ + 64 * c + s0) * 1024 + 8 * cg;
#pragma unroll
        for (int i = 0; i < 8; ++i) *(v4u*)(drow + (size_t)i * 1024) = rowpk[i];
    }
}
__device__ __forceinline__ void bc_prep_phase(Frame& F) { for (int u = F.vcu; u < NBP * 32; u += F.G) bc_prep_unit(F, u >> 5, u & 31); }
constexpr size_t WS_HVT = WS_XB, WS_EGM = WS_END2, WS_EGL = WS_EGM + (size_t)NBP * 64 * 1024 * 4, WS_END3 = WS_EGL + (size_t)NBP * 64 * 1024 * 4;
__device__ __forceinline__ void hg_prep_unit(Frame& F, int b, int c) {
    typedef float f32x2 __attribute__((ext_vector_type(2)));
    int tid_o = F.tid; asm volatile("" : "+v"(tid_o));
    const int tid = tid_o; unsigned char* ws = F.ws;
    const int ch = 2 * tid, hd = ch >> 7, k = ch & 127;
    const size_t row0 = (size_t)b * SEQ + 32 * c;
    bf16* QS = (bf16*)(ws + WS_PROJ) + (size_t)S_Q * SLOT_ELEMS + row0 * 1024 + ch; bf16* FS = (bf16*)(ws + WS_PROJ) + (size_t)S_F * SLOT_ELEMS + row0 * 1024 + ch;
    bf16* IS = (bf16*)(ws + WS_PROJ) + (size_t)S_I * SLOT_ELEMS + row0 * 1024;
    const f32x2 l0 = *(const f32x2*)(F.in[17] + ch), l1 = *(const f32x2*)(F.in[17] + 1024 + ch);
    f32x2 lb; lb.x = __builtin_amdgcn_rcpf(1.0f + __expf(l1.x - l0.x)); lb.y = __builtin_amdgcn_rcpf(1.0f + __expf(l1.y - l0.y));
    const f32x2 omlb = 1.0f - lb;
    f32x2 P[32]; f32x2 run = (f32x2){1.0f, 1.0f};
#pragma unroll
    for (int t = 0; t < 32; ++t) { const unsigned wd = ld_nt4(FS + (size_t)t * 1024);
        f32x2 u = (f32x2){__uint_as_float(wd << 16), __uint_as_float(wd & 0xffff0000u)}; u.x = fminf(fmaxf(u.x, -30.f), 30.f); u.y = fminf(fmaxf(u.y, -30.f), 30.f);
        const f32x2 tt = u * (-1.4426950408889634f); f32x2 e; e.x = __builtin_amdgcn_exp2f(tt.x); e.y = __builtin_amdgcn_exp2f(tt.y); e = e + 1.0f;
        f32x2 sg; sg.x = __builtin_amdgcn_rcpf(e.x); sg.y = __builtin_amdgcn_rcpf(e.y);
        const f32x2 fg = lb + omlb * sg; run = run * fg; run.x = fmaxf(run.x, 1e-30f); run.y = fmaxf(run.y, 1e-30f); P[t] = run; }
    const f32x2 Pm = P[15], Pl = P[31]; f32x2 rPm; rPm.x = __builtin_amdgcn_rcpf(Pm.x); rPm.y = __builtin_amdgcn_rcpf(Pm.y);
    *(f32x2*)((float*)(ws + WS_EGM) + (size_t)(b * 64 + c) * 1024 + ch) = Pm; *(f32x2*)((float*)(ws + WS_EGL) + (size_t)(b * 64 + c) * 1024 + ch) = Pl * rPm;
    unsigned kx[16], ky[16], vx[16], vy[16];
    f32x2 rPprev = (f32x2){1.0f, 1.0f}; f32x2 kprev = (f32x2){0.f, 0.f}; unsigned iprev = 0u;
#pragma unroll
    for (int t = 0; t < 32; ++t) { f32x2 rP; rP.x = __builtin_amdgcn_rcpf(P[t].x); rP.y = __builtin_amdgcn_rcpf(P[t].y);
        const f32x2 e1 = P[t] * rPm, e2 = Pm * rP, fg = P[t] * rPprev, kk = 1.0f - fg; rPprev = rP;
        const unsigned qw = ld_nt4(QS + (size_t)t * 1024); const f32x2 q = (f32x2){__uint_as_float(qw << 16), __uint_as_float(qw & 0xffff0000u)};
        const f32x2 tq = q * (-1.4426950408889634f); f32x2 eq; eq.x = __builtin_amdgcn_exp2f(tq.x); eq.y = __builtin_amdgcn_exp2f(tq.y); eq = eq + 1.0f;
        f32x2 rq; rq.x = __builtin_amdgcn_rcpf(eq.x); rq.y = __builtin_amdgcn_rcpf(eq.y);
        const f32x2 qa = q * rq * e1, ka = kk * e2;
        *(unsigned*)(QS + (size_t)t * 1024) = pk2(qa.x, qa.y); *(unsigned*)(FS + (size_t)t * 1024) = pk2(ka.x, ka.y);
        const unsigned iw = ld_nt4(IS + (size_t)t * 1024 + ch);
        if (t & 1) { kx[t >> 1] = pk2(kprev.x, ka.x); ky[t >> 1] = pk2(kprev.y, ka.y); vx[t >> 1] = (iprev & 0xffffu) | (iw << 16); vy[t >> 1] = (iprev >> 16) | (iw & 0xffff0000u); }
        kprev = ka; iprev = iw; }
    bf16* VTg = (bf16*)(ws + WS_HVT) + ((size_t)((b * 64 + c) * 8 + hd) * 128 + k) * 32;
#pragma unroll
    for (int j = 0; j < 4; ++j) { *(v4u*)(VTg + 8 * j) = (v4u){vx[4 * j], vx[4 * j + 1], vx[4 * j + 2], vx[4 * j + 3]}; *(v4u*)(VTg + 32 + 8 * j) = (v4u){vy[4 * j], vy[4 * j + 1], vy[4 * j + 2], vy[4 * j + 3]}; }
    __syncthreads();
    bf16* KTg = IS + ((size_t)hd * 128 + k) * 32;
#pragma unroll
    for (int j = 0; j < 4; ++j) { *(v4u*)(KTg + 8 * j) = (v4u){kx[4 * j], kx[4 * j + 1], kx[4 * j + 2], kx[4 * j + 3]}; *(v4u*)(KTg + 32 + 8 * j) = (v4u){ky[4 * j], ky[4 * j + 1], ky[4 * j + 2], ky[4 * j + 3]}; }
    __syncthreads();
}
__device__ __forceinline__ void hg_prep_phase(Frame& F) { for (int u = F.vcu; u < NBP * 64; u += F.G) hg_prep_unit(F, u >> 6, u & 63); }
constexpr int HV_QA = 0, HV_KA = 8704, HV_KAT = 17408, HV_VT = 27648, HV_EGM = 30208, HV_EGL = 30720, HV_PBUF = 31232, HV_OB = 2 * HV_PBUF, HV_OBUF = 23040;
constexpr size_t WS_SSQH = WS_END3, WS_END4 = WS_SSQH + (size_t)T * 32 * 4;
__device__ __forceinline__ void hgrn_v_unit(Frame& F, int b, int hd, int vt) {
    int tid_o = F.tid; asm volatile("" : "+v"(tid_o));
    const int tid = tid_o, lane = tid & 63, w = F.wave, r = lane & 31, hh = lane >> 5; unsigned char* ws = F.ws;
    LAS unsigned char* Lb = F.lds + RING_OFF;
    const bf16* PROJ = (const bf16*)(ws + WS_PROJ); bf16* OU = (bf16*)(ws + WS_ON); float* SSQH = (float*)(ws + WS_SSQH);
    const size_t rowb = (size_t)b * SEQ;
    const bf16* qsrc = PROJ + (size_t)S_Q * SLOT_ELEMS + (rowb + (tid >> 4)) * 1024 + hd * 128 + 8 * (tid & 15);
    const bf16* ksrc = PROJ + (size_t)S_F * SLOT_ELEMS + (rowb + (tid >> 4)) * 1024 + hd * 128 + 8 * (tid & 15);
    const bf16* tsrc = PROJ + (size_t)S_I * SLOT_ELEMS + rowb * 1024 + (size_t)(hd * 128 + (tid >> 2)) * 32 + 8 * (tid & 3);
    const unsigned char* xsrc = nullptr; size_t xstr = 0;
    if (tid < 128) { xsrc = (const unsigned char*)((const bf16*)(ws + WS_HVT) + ((size_t)(b * 64 * 8 + hd) * 128 + 32 * vt + (tid >> 2)) * 32 + 8 * (tid & 3)); xstr = (size_t)8 * 128 * 32 * 2; }
    else if (tid < 160) { xsrc = (const unsigned char*)((const float*)(ws + WS_EGM) + (size_t)b * 64 * 1024 + hd * 128 + 4 * (tid - 128)); xstr = 4096; }
    else if (tid < 192) { xsrc = (const unsigned char*)((const float*)(ws + WS_EGL) + (size_t)b * 64 * 1024 + hd * 128 + 4 * (tid - 160)); xstr = 4096; }
    const int xdst = tid < 128 ? HV_VT + (tid >> 2) * 80 + 16 * (tid & 3) : (tid < 160 ? HV_EGM + 16 * (tid - 128) : HV_EGL + 16 * (tid - 160));
#define HGV_LOAD(cc, pq, pk, pt, px) { pq = *(const v4u*)(qsrc + (size_t)(cc) * 32 * 1024); pk = *(const v4u*)(ksrc + (size_t)(cc) * 32 * 1024); pt = *(const v4u*)(tsrc + (size_t)(cc) * 32768); if (tid < 192) px = *(const v4u*)(xsrc + (size_t)(cc) * xstr); }
#define HGV_STORE(pb, pq, pk, pt, px) { *(LAS v4u*)((pb) + HV_QA + (tid >> 4) * 272 + 16 * (tid & 15)) = pq; *(LAS v4u*)((pb) + HV_KA + (tid >> 4) * 272 + 16 * (tid & 15)) = pk; \
        *(LAS v4u*)((pb) + HV_KAT + (tid >> 2) * 80 + 16 * (tid & 3)) = pt; if (tid < 192) *(LAS v4u*)((pb) + xdst) = px; }
    v4u pqA, pkA, ptA, pxA = (v4u){0u, 0u, 0u, 0u}, pqB, pkB, ptB, pxB = (v4u){0u, 0u, 0u, 0u};
    HGV_LOAD(0, pqA, pkA, ptA, pxA) HGV_STORE(Lb, pqA, pkA, ptA, pxA)
    HGV_LOAD(1, pqA, pkA, ptA, pxA) HGV_LOAD(2, pqB, pkB, ptB, pxB)
    const int kt = w;
    v2u ow_pend = (v2u){0u, 0u}; float sq_pend = 0.f;
    f32x16 S;
#pragma unroll
    for (int i = 0; i < 16; ++i) S[i] = 0.f;
    __syncthreads();
#define HGV_ITER(c, pq, pk, pt, px) { \
        int r_l = r, hh_l = hh, tid_l = tid; asm volatile("" : "+v"(r_l), "+v"(hh_l), "+v"(tid_l)); \
        { const int r = r_l, hh = hh_l, tid = tid_l; \
        LAS unsigned char* pbc = Lb + ((c) & 1) * HV_PBUF; LAS unsigned char* pbn = Lb + (((c) + 1) & 1) * HV_PBUF; \
        if ((c) < 63) { HGV_STORE(pbn, pq, pk, pt, px) if ((c) < 61) HGV_LOAD((c) + 3, pq, pk, pt, px) } \
        if (w < 4) { \
            LAS float* EGM = (LAS float*)(pbc + HV_EGM); LAS float* EGL = (LAS float*)(pbc + HV_EGL); LAS float* OB = (LAS float*)(Lb + HV_OB + ((c) & 1) * HV_OBUF); \
            _Pragma("unroll") \
            for (int q4 = 0; q4 < 4; ++q4) { const f32x4 e0 = *(const LAS f32x4*)(EGM + 32 * kt + 8 * q4 + 4 * hh); \
                _Pragma("unroll") \
                for (int j = 0; j < 4; ++j) S[4 * q4 + j] *= e0[j]; } \
            f32x16 o; \
            _Pragma("unroll") \
            for (int i = 0; i < 16; ++i) o[i] = 0.f; \
            const LAS unsigned char* qa_row = pbc + HV_QA + r * 272; \
            o = MFMA32(lds_frag8x2(qa_row + (32 * kt + 4 * hh) * 2), ACC_FRAG(S, 0), o); \
            o = MFMA32(lds_frag8x2(qa_row + (32 * kt + 16 + 4 * hh) * 2), ACC_FRAG(S, 1), o); \
            LAS float* ob = OB + (kt * 32) * 36 + r; \
            _Pragma("unroll") \
            for (int i = 0; i < 16; ++i) ob[((i & 3) + 8 * (i >> 2) + 4 * hh) * 36] = o[i]; \
            const LAS unsigned char* kat_nat = pbc + HV_KAT + (32 * kt + r) * 80 + hh * 16; const LAS unsigned char* vt_nat = pbc + HV_VT + r * 80 + hh * 16; \
            S = MFMA32(lds_frag16(kat_nat), lds_frag16(vt_nat), S); S = MFMA32(lds_frag16(kat_nat + 32), lds_frag16(vt_nat + 32), S); \
            _Pragma("unroll") \
            for (int q4 = 0; q4 < 4; ++q4) { const f32x4 e0 = *(const LAS f32x4*)(EGL + 32 * kt + 8 * q4 + 4 * hh); \
                _Pragma("unroll") \
                for (int j = 0; j < 4; ++j) S[4 * q4 + j] *= e0[j]; } \
        } else { \
            if (w == 4) { LAS float* OB = (LAS float*)(Lb + HV_OB + ((c) & 1) * HV_OBUF); f32x16 o; \
                _Pragma("unroll") \
                for (int i = 0; i < 16; ++i) o[i] = 0.f; \
                f32x16 X; \
                _Pragma("unroll") \
                for (int i = 0; i < 16; ++i) X[i] = 0.f; \
                const LAS unsigned char* ka_nat = pbc + HV_KA + r * 272 + hh * 16; const LAS unsigned char* qa_nat = pbc + HV_QA + r * 272 + hh * 16; \
                _Pragma("unroll 2") \
                for (int ks = 0; ks < 8; ++ks) X = MFMA32(lds_frag16(ka_nat + ks * 32), lds_frag16(qa_nat + ks * 32), X); \
                _Pragma("unroll") \
                for (int i = 0; i < 16; ++i) { const int srow = (i & 3) + 8 * (i >> 2) + 4 * hh; X[i] = (srow <= r) ? X[i] : 0.f; } \
                const LAS unsigned char* vt_row = pbc + HV_VT + r * 80; \
                o = MFMA32(ACC_FRAG(X, 0), lds_frag8x2(vt_row + (4 * hh) * 2), o); \
                o = MFMA32(ACC_FRAG(X, 1), lds_frag8x2(vt_row + (16 + 4 * hh) * 2), o); \
                LAS float* ob4 = OB + (4 * 32) * 36 + r; \
                _Pragma("unroll") \
                for (int i = 0; i < 16; ++i) ob4[((i & 3) + 8 * (i >> 2) + 4 * hh) * 36] = o[i]; \
            } \
            if ((c) > 1) { HGV_FLUSH((c) - 2) } \
            if ((c) > 0) { HGV_OUT((c) - 1) } \
        } \
        LDS_BARRIER(); \
        } }
#define HGV_OUT(cp) { const LAS float* OB = (const LAS float*)(Lb + HV_OB + ((cp) & 1) * HV_OBUF); const int tl = tid - 256, t = tl >> 3, v0 = (tl & 7) * 4; \
            const f32x4 a = *(const LAS f32x4*)(OB + t * 36 + v0), b2 = *(const LAS f32x4*)(OB + (32 + t) * 36 + v0), c2 = *(const LAS f32x4*)(OB + (64 + t) * 36 + v0), d2 = *(const LAS f32x4*)(OB + (96 + t) * 36 + v0), e2 = *(const LAS f32x4*)(OB + (128 + t) * 36 + v0); \
            const f32x4 o4 = ((a + b2) + (c2 + d2)) + e2; \
            float sq = (o4.x * o4.x + o4.y * o4.y) + (o4.z * o4.z + o4.w * o4.w); sq += __shfl_xor(sq, 1); sq += __shfl_xor(sq, 2); sq += __shfl_xor(sq, 4); \
            sq_pend = sq; ow_pend.x = pk2(o4.x, o4.y); ow_pend.y = pk2(o4.z, o4.w); }
#define HGV_FLUSH(cp) { const int tl = tid - 256, t = tl >> 3, v0 = (tl & 7) * 4; const size_t row = rowb + 32 * (cp) + t; \
            if ((tl & 7) == 0) SSQH[row * 32 + hd * 4 + vt] = sq_pend; *(v2u*)(OU + row * 1024 + hd * 128 + 32 * vt + v0) = ow_pend; }
#pragma unroll 1
    for (int cc = 0; cc < 64; cc += 2) { HGV_ITER(cc, pqA, pkA, ptA, pxA) HGV_ITER(cc + 1, pqB, pkB, ptB, pxB) }
    if (w >= 4) { HGV_FLUSH(62) HGV_OUT(63) HGV_FLUSH(63) }
#undef HGV_ITER
#undef HGV_OUT
#undef HGV_FLUSH
#undef HGV_LOAD
#undef HGV_STORE
    if (w < 4) { float* st_g = F.out + O_HGP + (size_t)(b * 8 + hd) * 16384 + 32 * vt + r;
#pragma unroll
        for (int i = 0; i < 16; ++i) { const int k = 32 * kt + (i & 3) + 8 * (i >> 2) + 4 * hh; st_g[(size_t)k * 128] = S[i]; } }
    __syncthreads();
}
__device__ __forceinline__ void hgnorm_phase(Frame& F) {
    const int gw = F.vcu * NWAVES + F.wave, NGW = F.G * NWAVES; bf16* ON = (bf16*)(F.ws + WS_ON); const float* SSQH = (const float*)(F.ws + WS_SSQH);
    const bf16* HG = (const bf16*)(F.ws + WS_PROJ) + (size_t)S_HG * SLOT_ELEMS;
    for (int row = gw; row < TP; row += NGW) {
#pragma unroll
        for (int j = 0; j < 2; ++j) { const int pc = j * 64 + F.lane, hd = pc >> 4;
            const f32x4 sp = *(const f32x4*)(SSQH + (size_t)row * 32 + hd * 4); const float rs = __builtin_amdgcn_rsqf(((sp.x + sp.y) + (sp.z + sp.w)) * (1.0f / 128.0f) + EPS);
            v4u* p = (v4u*)(ON + (size_t)row * 1024) + pc; const v4u o = *p; const v4u g = ld_nt16((const v4u*)(HG + (size_t)row * 1024) + pc); v4u res;
#pragma unroll
            for (int e = 0; e < 4; ++e) res[e] = pk2(bf2f(o[e] & 0xffffu) * rs * silu_f(bf2f(g[e] & 0xffffu)), __uint_as_float(o[e] & 0xffff0000u) * rs * silu_f(__uint_as_float(g[e] & 0xffff0000u)));
            *p = res; }
    }
}
constexpr int SD_BN = 0, SD_CN = 17408, SD_BT = 34816, SD_XT = 53248, SD_HT = 62464, SD_YA = 97280, SD_YY = 113664, SD_YO = 130048, SD_CUM = 134144, SD_DTV = 134400, SD_ECUM = 134656, SD_XWT = 134912, SD_CWL = 144128;
__device__ __forceinline__ void ssd_unit_mfma(Frame& F, int gb, int h) {
    int tid_o = F.tid; asm volatile("" : "+v"(tid_o));
    const int tid = tid_o, lane = tid & 63, w = F.wave, r = lane & 31, hh = lane >> 5; unsigned char* ws = F.ws;
    const int L = SEQ; const size_t row_base = (size_t)gb * SEQ;
    const int g = h >> 3;
    LAS unsigned char* Lb = F.lds + RING_OFF;
    LAS unsigned short* BN = (LAS unsigned short*)(Lb + SD_BN); LAS unsigned short* CN = (LAS unsigned short*)(Lb + SD_CN);
    LAS unsigned short* BT = (LAS unsigned short*)(Lb + SD_BT); LAS unsigned short* XT = (LAS unsigned short*)(Lb + SD_XT);
    LAS unsigned short* HT = (LAS unsigned short*)(Lb + SD_HT);
    LAS unsigned short* XWT = (LAS unsigned short*)(Lb + SD_XWT);
    LAS float* YA = (LAS float*)(Lb + SD_YA); LAS float* YY = (LAS float*)(Lb + SD_YY); LAS unsigned short* YO = (LAS unsigned short*)(Lb + SD_YO);
    LAS float* CUM = (LAS float*)(Lb + SD_CUM); LAS float* DTV = (LAS float*)(Lb + SD_DTV); LAS float* ECUM = (LAS float*)(Lb + SD_ECUM);
    const bf16* PROJ = (const bf16*)(ws + WS_PROJ); const float* DTR = (const float*)(ws + WS_DT); bf16* YG = (bf16*)(ws + WS_YG); float* SSQ = (float*)(ws + WS_SSQSSD);
    const int nt = w >> 1, pt = w & 1;
    f32x16 H;
    float* st_g = F.out + O_SSMP + (size_t)(gb * 32 + h) * 8192 + (size_t)(32 * pt + r) * 128 + 32 * nt + 4 * hh;
#pragma unroll
    for (int i = 0; i < 16; ++i) H[i] = 0.f;
    {
        LAS unsigned short* hp = HT + (32 * pt + r) * 136 + 32 * nt + 4 * hh;
#pragma unroll
        for (int q4 = 0; q4 < 4; ++q4) { v2u pk; pk.x = cvtpk_c(H[4 * q4], H[4 * q4 + 1]); pk.y = cvtpk_c(H[4 * q4 + 2], H[4 * q4 + 3]); *(LAS v2u*)(hp + 8 * q4) = pk; }
    }
    const float a = -__expf(F.in[13][h]), dtb = F.in[12][h], Dk = F.in[14][h];
    const float* cw = F.in[10]; const float* cbp = F.in[11];
    const int cgl = tid & 7, xs = tid >> 3;
    const int col = h * 64 + 8 * cgl;
    const bf16* cptr = PROJ + (size_t)(S_X0 + (col >> 10)) * SLOT_ELEMS + row_base * 1024 + (col & 1023);
    const bf16* BCS = (const bf16*)(ws + WS_BCS) + row_base * 1024 + g * 128; const bf16* BTT = (const bf16*)(ws + WS_BTT) + (size_t)(gb * 32 * 4 + g) * 128 * 64;
    v4u xr[4], pc[6];
#pragma unroll
    for (int i = 0; i < 4; ++i) { const int gt = xs - 3 + i; xr[i] = (v4u){0u, 0u, 0u, 0u}; if (gt >= 0) xr[i] = *(const v4u*)(cptr + (size_t)gt * 1024); }
#pragma unroll
    for (int j = 0; j < 6; ++j) { const int idx = (tid + 512 * j) & 1023;
        if (j < 4) pc[j] = *(const v4u*)(BCS + (size_t)(idx >> 4) * 1024 + (j >> 1) * 512 + 8 * (idx & 15));
        else pc[j] = *(const v4u*)(BTT + (size_t)(idx >> 3) * 64 + 8 * (idx & 7)); }
    LAS float* CWL = (LAS float*)(Lb + SD_CWL);
    if (tid < 320) { const int j = tid >> 6, c = tid & 63; CWL[tid] = j < 4 ? cw[j * 3072 + h * 64 + c] : cbp[h * 64 + c]; }
    __syncthreads();
    v4u ow_pend = (v4u){0u, 0u, 0u, 0u}; float sq_pend = 0.f; bool pend = false;
    int buf = 0;
    float dt_pf = 0.f;
    if (lane < L) dt_pf = DTR[(row_base + lane) * 32 + h];
    for (int t0 = 0; t0 < L; t0 += 64, buf ^= 1) {
        int r_l = r, hh_l = hh, tid_l = tid, lane_l = lane;
        asm volatile("" : "+v"(r_l), "+v"(hh_l), "+v"(tid_l), "+v"(lane_l));
        { const int r = r_l, hh = hh_l, tid = tid_l, lane = lane_l;
        float dtv = 0.f;
        if (t0 + lane < L) { const float x = dt_pf + dtb; dtv = fmaxf(x, 0.f) + 0.6931471805599453f * __builtin_amdgcn_logf(1.0f + __builtin_amdgcn_exp2f(-1.4426950408889634f * fabsf(x))); }
        dt_pf = 0.f; if (t0 + 64 + lane < L) dt_pf = DTR[(row_base + t0 + 64 + lane) * 32 + h];
        v4u zw = (v4u){0u, 0u, 0u, 0u};
        if (t0 + (tid >> 3) < L) zw = ld_nt16(PROJ + (size_t)(S_Z0 + (h >> 4)) * SLOT_ELEMS + (row_base + t0 + (tid >> 3)) * 1024 + (h & 15) * 64 + (tid & 7) * 8);
        float cum = dtv * a;
#pragma unroll
        for (int o = 1; o < 64; o <<= 1) { const float u = __shfl_up(cum, o); if (lane >= o) cum += u; }
        const float cum_last = __shfl(cum, 63);
        const float wgt = __expf(cum_last - cum) * dtv;
        if (w == 0) { CUM[lane] = cum; DTV[lane] = dtv; ECUM[lane] = __expf(cum); }
#pragma unroll
        for (int j = 0; j < 6; ++j) { const int idx = (tid + 512 * j) & 1023;
            if (j < 2) *(LAS v4u*)(BN + (idx >> 4) * 136 + 8 * (idx & 15)) = pc[j];
            else if (j < 4) *(LAS v4u*)(CN + (idx >> 4) * 136 + 8 * (idx & 15)) = pc[j];
            else *(LAS v4u*)(BT + (idx >> 3) * 72 + 8 * (idx & 7)) = pc[j]; }
        if (pend) { const size_t prow = row_base + (t0 - 64) + (tid >> 3);
            *(v4u*)(YG + prow * 2048 + h * 64 + (tid & 7) * 8) = ow_pend; if ((tid & 7) == 0) SSQ[prow * 32 + h] = sq_pend; pend = false; }
        { const int xs = tid >> 3, cgl = tid & 7; const float wx = __shfl(wgt, xs); typedef float f32x2 __attribute__((ext_vector_type(2)));
#pragma unroll
          for (int kp = 0; kp < 4; ++kp) {
              const LAS float* wl = CWL + 8 * cgl + 2 * kp;
              const f32x2 cw0 = *(const LAS f32x2*)wl, cw1 = *(const LAS f32x2*)(wl + 64), cw2 = *(const LAS f32x2*)(wl + 128), cw3 = *(const LAS f32x2*)(wl + 192), cbb = *(const LAS f32x2*)(wl + 256);
              f32x2 xv[4];
#pragma unroll
              for (int i = 0; i < 4; ++i) { const unsigned wd = xr[i][kp]; xv[i] = (f32x2){__uint_as_float(wd << 16), __uint_as_float(wd & 0xffff0000u)}; }
              f32x2 a = cw0 * xv[0] + cbb; a = cw1 * xv[1] + a; a = cw2 * xv[2] + a; a = cw3 * xv[3] + a;
              const f32x2 t = a * (-1.4426950408889634f); f32x2 e; e.x = __builtin_amdgcn_exp2f(t.x); e.y = __builtin_amdgcn_exp2f(t.y); e = e + 1.0f;
              f32x2 rc; rc.x = __builtin_amdgcn_rcpf(e.x); rc.y = __builtin_amdgcn_rcpf(e.y); const f32x2 o = a * rc, ow = o * wx;
              const unsigned po = pk2(o.x, o.y), pw = pk2(ow.x, ow.y); const int p = 8 * cgl + 2 * kp;
              XT[p * 72 + xs] = (unsigned short)(po & 0xffffu); XT[(p + 1) * 72 + xs] = (unsigned short)(po >> 16);
              XWT[p * 72 + xs] = (unsigned short)(pw & 0xffffu); XWT[(p + 1) * 72 + xs] = (unsigned short)(pw >> 16); }
        }
        if (t0 + 64 < L) {
#pragma unroll
            for (int i = 0; i < 4; ++i) xr[i] = ld_nt16(cptr + (size_t)(t0 + 64 + (tid >> 3) - 3 + i) * 1024);
            const int chn = (t0 >> 6) + 1;
#pragma unroll
            for (int j = 0; j < 6; ++j) { const int idx = (tid + 512 * j) & 1023;
                if (j < 4) pc[j] = *(const v4u*)(BCS + (size_t)(t0 + 64 + (idx >> 4)) * 1024 + (j >> 1) * 512 + 8 * (idx & 15));
                else pc[j] = *(const v4u*)(BTT + ((size_t)chn * 4 * 128 + (idx >> 3)) * 64 + 8 * (idx & 7)); }
        }
        LDS_BARRIER();
        if (w < 3) {
            const int tt = w == 0 ? 0 : 1, st = w == 1 ? 1 : 0;
            f32x16 X, ya0, ya1;
#pragma unroll
            for (int i = 0; i < 16; ++i) { X[i] = 0.f; ya0[i] = 0.f; ya1[i] = 0.f; }
            const LAS unsigned char* cn_nat = Lb + SD_CN + (32 * tt + r) * 272 + hh * 16; const LAS unsigned char* bn_nat = Lb + SD_BN + (32 * st + r) * 272 + hh * 16;
#pragma unroll 2
            for (int ks = 0; ks < 8; ++ks) X = MFMA32(lds_frag16(bn_nat + ks * 32), lds_frag16(cn_nat + ks * 32), X);
            const float cum_t = CUM[32 * tt + r];
#pragma unroll
            for (int q4 = 0; q4 < 4; ++q4) { const f32x4 cs = *(const LAS f32x4*)(CUM + 32 * st + 8 * q4 + 4 * hh), ds = *(const LAS f32x4*)(DTV + 32 * st + 8 * q4 + 4 * hh);
#pragma unroll
                for (int jj = 0; jj < 4; ++jj) { const int s_abs = 32 * st + 8 * q4 + 4 * hh + jj; const float f = __expf(fminf(cum_t - cs[jj], 0.f)) * ds[jj]; X[4 * q4 + jj] = (s_abs <= 32 * tt + r) ? X[4 * q4 + jj] * f : 0.f; } }
            const bf16x8 xf0 = ACC_FRAG(X, 0), xf1 = ACC_FRAG(X, 1);
            const LAS unsigned char* xt_row = Lb + SD_XT + r * 144 + (32 * st + 4 * hh) * 2;
            ya0 = MFMA32(xf0, lds_frag8x2(xt_row), ya0); ya0 = MFMA32(xf1, lds_frag8x2(xt_row + 32), ya0);
            ya1 = MFMA32(xf0, lds_frag8x2(xt_row + 32 * 144), ya1); ya1 = MFMA32(xf1, lds_frag8x2(xt_row + 32 * 144 + 32), ya1);
            if (w < 2) { LAS float* yb = YA + (32 * tt + 4 * hh) * 64 + r;
#pragma unroll
                for (int i = 0; i < 16; ++i) { yb[((i & 3) + 8 * (i >> 2)) * 64] = ya0[i]; yb[((i & 3) + 8 * (i >> 2)) * 64 + 32] = ya1[i]; } }
            else { LAS unsigned short* yb = YO + (4 * hh) * 64 + r;
#pragma unroll
                for (int i = 0; i < 16; ++i) { yb[((i & 3) + 8 * (i >> 2)) * 64] = (unsigned short)f2bf(ya0[i]); yb[((i & 3) + 8 * (i >> 2)) * 64 + 32] = (unsigned short)f2bf(ya1[i]); } }
        } else if (w >= 4) {
            const int tt = (w - 4) >> 1, ptj = w & 1;
            const LAS unsigned char* ht_nat = Lb + SD_HT + buf * 17408 + (32 * ptj + r) * 272 + hh * 16;
            f32x16 yi;
#pragma unroll
            for (int i = 0; i < 16; ++i) yi[i] = 0.f;
            const LAS unsigned char* cn_nat = Lb + SD_CN + (32 * tt + r) * 272 + hh * 16;
#pragma unroll 2
            for (int ks = 0; ks < 8; ++ks) yi = MFMA32(lds_frag16(cn_nat + ks * 32), lds_frag16(ht_nat + ks * 32), yi);
            const LAS unsigned short* xt_p = XT + (32 * ptj + r) * 72 + 32 * tt + 4 * hh;
#pragma unroll
            for (int q4 = 0; q4 < 4; ++q4) { const f32x4 ec = *(const LAS f32x4*)(ECUM + 32 * tt + 8 * q4 + 4 * hh); const v2u xw = *(const LAS v2u*)(xt_p + 8 * q4);
                const float x0 = bf2f(xw.x & 0xffffu), x1 = bf2f(xw.x >> 16), x2 = bf2f(xw.y & 0xffffu), x3 = bf2f(xw.y >> 16);
                LAS float* yb = YY + (32 * tt + 8 * q4 + 4 * hh) * 64 + 32 * ptj + r;
                yb[0] = ec[0] * yi[4 * q4] + Dk * x0; yb[64] = ec[1] * yi[4 * q4 + 1] + Dk * x1; yb[128] = ec[2] * yi[4 * q4 + 2] + Dk * x2; yb[192] = ec[3] * yi[4 * q4 + 3] + Dk * x3; }
        }
        {
            const float el = __expf(CUM[63]);
#pragma unroll
            for (int i = 0; i < 16; ++i) H[i] *= el;
            const LAS unsigned char* bt_nat = Lb + SD_BT + (32 * nt + r) * 144 + hh * 16; const LAS unsigned char* xt_nat = Lb + SD_XWT + (32 * pt + r) * 144 + hh * 16;
#pragma unroll
            for (int s2 = 0; s2 < 4; ++s2) H = MFMA32(lds_frag16(bt_nat + s2 * 32), lds_frag16(xt_nat + s2 * 32), H);
            LAS unsigned short* hp = HT + (buf ^ 1) * 8704 + (32 * pt + r) * 136 + 32 * nt + 4 * hh;
#pragma unroll
            for (int q4 = 0; q4 < 4; ++q4) { v2u pk; pk.x = cvtpk_c(H[4 * q4], H[4 * q4 + 1]); pk.y = cvtpk_c(H[4 * q4 + 2], H[4 * q4 + 3]); *(LAS v2u*)(hp + 8 * q4) = pk; }
        }
        LDS_BARRIER();
        { const int tt = tid >> 3, p0 = (tid & 7) * 8;
          if (t0 + tt < L) { const size_t row = row_base + t0 + tt;
            f32x4 y0 = *(const LAS f32x4*)(YA + tt * 64 + p0) + *(const LAS f32x4*)(YY + tt * 64 + p0), y1 = *(const LAS f32x4*)(YA + tt * 64 + p0 + 4) + *(const LAS f32x4*)(YY + tt * 64 + p0 + 4);
            if (tt >= 32) { const v4u ow4 = *(const LAS v4u*)(YO + (tt - 32) * 64 + p0);
                y0 = y0 + (f32x4){bf2f(ow4.x & 0xffffu), __uint_as_float(ow4.x & 0xffff0000u), bf2f(ow4.y & 0xffffu), __uint_as_float(ow4.y & 0xffff0000u)};
                y1 = y1 + (f32x4){bf2f(ow4.z & 0xffffu), __uint_as_float(ow4.z & 0xffff0000u), bf2f(ow4.w & 0xffffu), __uint_as_float(ow4.w & 0xffff0000u)}; }
            float o[8]; float sq = 0.f;
#pragma unroll
            for (int j = 0; j < 8; ++j) { const unsigned z16 = (zw[j >> 1] >> ((j & 1) * 16)) & 0xffffu; const float yv = (j < 4 ? y0[j & 3] : y1[j & 3]) * silu_f(bf2f(z16)); o[j] = yv; sq += yv * yv; }
            ow_pend.x = pk2(o[0], o[1]); ow_pend.y = pk2(o[2], o[3]); ow_pend.z = pk2(o[4], o[5]); ow_pend.w = pk2(o[6], o[7]);
            sq += __shfl_xor(sq, 1); sq += __shfl_xor(sq, 2); sq += __shfl_xor(sq, 4); sq_pend = sq; pend = true; } }
        }
    }
    if (pend) { const size_t prow = row_base + (L - 64) + (tid >> 3); *(v4u*)(YG + prow * 2048 + h * 64 + (tid & 7) * 8) = ow_pend; if ((tid & 7) == 0) SSQ[prow * 32 + h] = sq_pend; }
#pragma unroll
    for (int q4 = 0; q4 < 4; ++q4) *(f32x4*)(st_g + 8 * q4) = (f32x4){H[4 * q4], H[4 * q4 + 1], H[4 * q4 + 2], H[4 * q4 + 3]};
    __syncthreads();
}
__device__ __forceinline__ float tr_reduce32(const float (&v)[32], int lane) {
    const bool b4 = lane & 16, b3 = lane & 8, b2 = lane & 4, b1 = lane & 2, b0 = lane & 1;
    float a[16], b[8], c[4], d[2];
#pragma unroll
    for (int i = 0; i < 16; ++i) { const float keep = b4 ? v[i + 16] : v[i], send = b4 ? v[i] : v[i + 16]; a[i] = keep + __shfl_xor(send, 16); }
#pragma unroll
    for (int i = 0; i < 8; ++i) { const float keep = b3 ? a[i + 8] : a[i], send = b3 ? a[i] : a[i + 8]; b[i] = keep + __shfl_xor(send, 8); }
#pragma unroll
    for (int i = 0; i < 4; ++i) { const float keep = b2 ? b[i + 4] : b[i], send = b2 ? b[i] : b[i + 4]; c[i] = keep + __shfl_xor(send, 4); }
#pragma unroll
    for (int i = 0; i < 2; ++i) { const float keep = b1 ? c[i + 2] : c[i], send = b1 ? c[i] : c[i + 2]; d[i] = keep + __shfl_xor(send, 2); }
    const float keep = b0 ? d[1] : d[0], send = b0 ? d[0] : d[1];
    return keep + __shfl_xor(send, 1);
}
__device__ __forceinline__ void ssd_sample_unit(Frame& F, int sb, int g) {
    int tid_o = F.tid; asm volatile("" : "+v"(tid_o));
    const int tid = tid_o, lane = tid & 63, w = F.wave, hh = lane >> 5, nq = lane & 31; unsigned char* ws = F.ws;
    LAS float* XC = (LAS float*)(F.lds + RING_OFF); LAS float* BC = XC + 8 * 4 * 64; LAS float* CC = BC + 4 * 128; LAS float* DTS = CC + 4 * 128;
    const bf16* PROJ = (const bf16*)(ws + WS_PROJ); const float* DTR = (const float*)(ws + WS_DT); bf16* YG = (bf16*)(ws + WS_YG); float* SSQ = (float*)(ws + WS_SSQSSD);
    const size_t row0 = (size_t)TP + (size_t)sb * LS;
    const int h = 8 * g + w;
    const float* sp = F.in[3] + (size_t)(sb * 32 + h) * 8192 + (size_t)hh * 128 + 4 * nq;
    f32x4 hst[32];
#pragma unroll
    for (int i = 0; i < 32; ++i) hst[i] = ld_nt(sp + (size_t)i * 256);
    if (tid < 384) { typedef float f32x2 __attribute__((ext_vector_type(2)));
        const int col = tid < 256 ? g * 512 + 2 * tid : (tid < 320 ? 2048 + g * 128 + 2 * (tid - 256) : 2560 + g * 128 + 2 * (tid - 320));
        const float* cw = F.in[10]; const float* sc = F.in[4] + (size_t)sb * 3 * 3072 + col;
        const f32x2 w0 = *(const f32x2*)(cw + col), w1 = *(const f32x2*)(cw + 3072 + col), w2 = *(const f32x2*)(cw + 2 * 3072 + col), w3 = *(const f32x2*)(cw + 3 * 3072 + col), cb = *(const f32x2*)(F.in[11] + col);
        f32x2 full[7]; full[0] = *(const f32x2*)sc; full[1] = *(const f32x2*)(sc + 3072); full[2] = *(const f32x2*)(sc + 2 * 3072);
        const bf16* cp = PROJ + (size_t)(S_X0 + (col >> 10)) * SLOT_ELEMS + row0 * 1024 + (col & 1023);
#pragma unroll
        for (int t = 0; t < 4; ++t) { const unsigned wd = *(const unsigned*)(cp + (size_t)t * 1024); full[3 + t] = (f32x2){__uint_as_float(wd << 16), __uint_as_float(wd & 0xffff0000u)}; }
#pragma unroll
        for (int t = 0; t < 4; ++t) { f32x2 a = w0 * full[t] + cb; a = w1 * full[t + 1] + a; a = w2 * full[t + 2] + a; a = w3 * full[t + 3] + a;
            f32x2 o; o.x = silu_f(a.x); o.y = silu_f(a.y);
            LAS float* dst = tid < 256 ? XC + ((tid >> 5) * 4 + t) * 64 + 2 * (tid & 31) : (tid < 320 ? BC + t * 128 + 2 * (tid - 256) : CC + t * 128 + 2 * (tid - 320));
            *(LAS f32x2*)dst = o; }
    } else if (tid < 416) { const int idx = tid - 384, hl = idx >> 2, t = idx & 3; const float x = DTR[(row0 + t) * 32 + 8 * g + hl] + F.in[12][8 * g + hl]; DTS[idx] = x > 20.f ? x : log1pf(__expf(x)); }
    __syncthreads();
    const float a = -__expf(F.in[13][h]), Dk = F.in[14][h];
#pragma unroll 1
    for (int t = 0; t < 4; ++t) {
        const float dtv = DTS[w * 4 + t], dA = __expf(dtv * a);
        const f32x4 Bv = *(const LAS f32x4*)(BC + t * 128 + 4 * nq), Cv = *(const LAS f32x4*)(CC + t * 128 + 4 * nq);
        const LAS float* xrow = XC + (w * 4 + t) * 64;
        float part[32];
#pragma unroll
        for (int i = 0; i < 32; ++i) { const float xd = xrow[2 * i + hh] * dtv; hst[i] = hst[i] * dA + Bv * xd; part[i] = (hst[i].x * Cv.x + hst[i].y * Cv.y) + (hst[i].z * Cv.z + hst[i].w * Cv.w); }
        float yv = tr_reduce32(part, lane);
        const int p = 2 * nq + hh; const size_t row = row0 + t;
        yv += Dk * xrow[p];
        const float z = bf2f(PROJ[(size_t)(S_Z0 + (h >> 4)) * SLOT_ELEMS + row * 1024 + (h & 15) * 64 + p]);
        const float yg = yv * silu_f(z);
        YG[row * 2048 + h * 64 + p] = (bf16)f2bf(yg);
        const float sq = wave_sum(yg * yg);
        if (lane == 0) SSQ[row * 32 + h] = sq;
    }
    float* so = F.out + O_SSMS + (size_t)(sb * 32 + h) * 8192 + (size_t)hh * 128 + 4 * nq;
#pragma unroll
    for (int i = 0; i < 32; ++i) st_nt(so + (size_t)i * 256, hst[i]);
    __syncthreads();
}
__device__ __forceinline__ void hgrn_sample_unit(Frame& F, int sb, int hq) {
    int tid_o = F.tid; asm volatile("" : "+v"(tid_o));
    const int tid = tid_o, lane = tid & 63, w = F.wave, hh = lane >> 5, vq = lane & 31; unsigned char* ws = F.ws;
    LAS float* FS = (LAS float*)(F.lds + RING_OFF); LAS float* KS = FS + 2048; LAS float* QS = KS + 2048; LAS float* VS = QS + 2048; LAS float* OP = VS + 2048;
    const bf16* PROJ = (const bf16*)(ws + WS_PROJ); bf16* ON = (bf16*)(ws + WS_ON);
    const size_t row0 = (size_t)TP + (size_t)sb * LS;
    const int hl = w >> 1, kh = w & 1, hd = 4 * hq + hl;
    const float* sp = F.in[5] + (size_t)(sb * 8 + hd) * 16384 + (size_t)(64 * kh + hh) * 128 + 4 * vq;
    f32x4 S[32];
#pragma unroll
    for (int i = 0; i < 32; ++i) S[i] = ld_nt(sp + (size_t)i * 256);
    { const int ch = hq * 512 + tid; const float lb = __builtin_amdgcn_rcpf(1.0f + __expf(F.in[17][1024 + ch] - F.in[17][ch]));
      const bf16* fp = PROJ + (size_t)S_F * SLOT_ELEMS + row0 * 1024 + ch; const bf16* qp = PROJ + (size_t)S_Q * SLOT_ELEMS + row0 * 1024 + ch; const bf16* ip = PROJ + (size_t)S_I * SLOT_ELEMS + row0 * 1024 + ch;
#pragma unroll
      for (int t = 0; t < 4; ++t) { const float u = fminf(fmaxf(bf2f(fp[(size_t)t * 1024]), -30.f), 30.f); const float fg = lb + (1.0f - lb) * sigmoid_f(u);
          const int o = ((tid >> 7) * 4 + t) * 128 + (tid & 127);
          FS[o] = fg; KS[o] = 1.0f - fg; QS[o] = silu_f(bf2f(qp[(size_t)t * 1024])); VS[o] = bf2f(ip[(size_t)t * 1024]); } }
    __syncthreads();
#pragma unroll 1
    for (int t = 0; t < 4; ++t) {
        const int o = (hl * 4 + t) * 128;
        const f32x4 vv = *(const LAS f32x4*)(VS + o + 4 * vq);
        f32x4 oa = (f32x4){0.f, 0.f, 0.f, 0.f};
#pragma unroll
        for (int i = 0; i < 32; ++i) { const int k = 64 * kh + 2 * i + hh; const float fk = FS[o + k], kv = KS[o + k], qk = QS[o + k]; S[i] = S[i] * fk + vv * kv; oa = oa + S[i] * qk; }
        oa.x += __shfl_xor(oa.x, 32); oa.y += __shfl_xor(oa.y, 32); oa.z += __shfl_xor(oa.z, 32); oa.w += __shfl_xor(oa.w, 32);
        if (hh == 0) *(LAS f32x4*)(OP + ((hl * 4 + t) * 2 + kh) * 128 + 4 * vq) = oa;
    }
    float* so = F.out + O_HGS + (size_t)(sb * 8 + hd) * 16384 + (size_t)(64 * kh + hh) * 128 + 4 * vq;
#pragma unroll
    for (int i = 0; i < 32; ++i) st_nt(so + (size_t)i * 256, S[i]);
    __syncthreads();
#pragma unroll
    for (int rr2 = 0; rr2 < 2; ++rr2) { const int rr = 2 * w + rr2, ohl = rr >> 2, t = rr & 3, ohd = 4 * hq + ohl; typedef float f32x2 __attribute__((ext_vector_type(2)));
        const f32x2 p0 = *(const LAS f32x2*)(OP + (rr * 2) * 128 + 2 * lane), p1 = *(const LAS f32x2*)(OP + (rr * 2 + 1) * 128 + 2 * lane);
        const float o0 = p0.x + p1.x, o1 = p0.y + p1.y; const float sq = wave_sum(o0 * o0 + o1 * o1); const float rs = __builtin_amdgcn_rsqf(sq * (1.0f / 128.0f) + EPS);
        const size_t row = row0 + t; const unsigned gw = *(const unsigned*)(PROJ + (size_t)S_HG * SLOT_ELEMS + row * 1024 + ohd * 128 + 2 * lane);
        *(unsigned*)(ON + row * 1024 + ohd * 128 + 2 * lane) = pk2(o0 * rs * silu_f(bf2f(gw & 0xffffu)), o1 * rs * silu_f(__uint_as_float(gw & 0xffff0000u))); }
    __syncthreads();
}
constexpr int U_HGS = NBS * 2, U_SSDS = NBS * 4, U_CONV = NBP + NBS;
__device__ __forceinline__ void scan_phase(Frame& F) {
    gu32* head = F.ctl + CW_QUEUE;
#define SCAN_QUEUE(qi, count, body) for (;;) { if (F.tid == 0) F.MISC[0] = __hip_atomic_fetch_add(head + 64 * (qi), 1u, RLX_AGENT); __syncthreads(); const int u = (int)F.MISC[0]; __syncthreads(); if (u >= (count)) break; body }
    SCAN_QUEUE(1, NBP * 32, ssd_unit_mfma(F, u >> 5, u & 31);)
    SCAN_QUEUE(0, NBP * 32, hgrn_v_unit(F, u >> 5, (u >> 2) & 7, u & 3);)
    SCAN_QUEUE(2, U_HGS, hgrn_sample_unit(F, u >> 1, u & 1);)
    SCAN_QUEUE(3, U_SSDS + U_CONV, if (u >= U_SSDS) { conv_copy_unit(F, u - U_SSDS); continue; } ssd_sample_unit(F, u >> 2, u & 3);)
#undef SCAN_QUEUE
}
typedef float f32x4s __attribute__((ext_vector_type(4)));
template <class Epi> __device__ __forceinline__ void small_tile_phase(Frame& F, const bf16* A, const bf16* Bt, int K, const Epi& E) {
    const int lane = F.lane, w = F.wave, r = lane & 31, hh = lane >> 5;
#pragma unroll 1
    for (int v = F.vcu; v < 256; v += F.G) {
    const int mt = v >> 4, nt = v & 15;
    const int kw = K >> 3;
    const bf16* ap = A + (size_t)(TP + 32 * mt + r) * K + w * kw + 8 * hh;
    const bf16* bp = Bt + (size_t)(64 * nt + r) * K + w * kw + 8 * hh;
    f32x16 acc0, acc1;
#pragma unroll
    for (int i = 0; i < 16; ++i) { acc0[i] = 0.f; acc1[i] = 0.f; }
#pragma unroll 4
    for (int ks = 0; ks < kw / 16; ++ks) { const bf16x8 af = *(const bf16x8*)(ap + 16 * ks), b0 = *(const bf16x8*)(bp + 16 * ks), b1 = *(const bf16x8*)(bp + (size_t)32 * K + 16 * ks);
        acc0 = MFMA32(b0, af, acc0); acc1 = MFMA32(b1, af, acc1); }
    LAS float* part = (LAS float*)(F.lds + RING_OFF) + w * 2048;
#pragma unroll
    for (int q4 = 0; q4 < 4; ++q4) { *(LAS f32x4*)(part + r * 64 + 8 * q4 + 4 * hh) = (f32x4){acc0[4 * q4], acc0[4 * q4 + 1], acc0[4 * q4 + 2], acc0[4 * q4 + 3]};
        *(LAS f32x4*)(part + r * 64 + 32 + 8 * q4 + 4 * hh) = (f32x4){acc1[4 * q4], acc1[4 * q4 + 1], acc1[4 * q4 + 2], acc1[4 * q4 + 3]}; }
    __syncthreads();
    const int rl = F.tid >> 4, c4 = (F.tid & 15) * 4; const LAS float* src = (const LAS float*)(F.lds + RING_OFF) + rl * 64 + c4;
    f32x4 sum = *(const LAS f32x4*)src;
#pragma unroll
    for (int ww = 1; ww < 8; ++ww) sum = sum + *(const LAS f32x4*)(src + ww * 2048);
    const f32x4s acc = (f32x4s){sum.x, sum.y, sum.z, sum.w};
    E.small(F, acc, TP + 32 * mt + rl, 64 * nt + c4, nt);
    __syncthreads();
    }
}
template <bool ADD> struct SmGate { bf16* O; const bf16* gate;
    __device__ __forceinline__ void small(Frame&, const f32x4s& a, int row, int col, int) const { const size_t off = (size_t)row * 1024 + col;
        const v2u gw = __builtin_nontemporal_load((const v2u*)(gate + off)); v2u ow = (v2u){0u, 0u}; if (ADD) ow = *(const v2u*)(O + off);
        float rr[4];
#pragma unroll
        for (int e = 0; e < 4; ++e) { const unsigned g16 = (gw[e >> 1] >> ((e & 1) * 16)) & 0xffffu, o16 = (ow[e >> 1] >> ((e & 1) * 16)) & 0xffffu; rr[e] = (ADD ? bf2f(o16) : 0.f) + sigmoid_f(bf2f(g16)) * a[e]; }
        v2u wv; wv.x = cvtpk_c(rr[0], rr[1]); wv.y = cvtpk_c(rr[2], rr[3]); *(v2u*)(O + off) = wv; } };
template <bool BF> struct SmRes { const float* base; bf16* hb; float* ssqp;
    __device__ __forceinline__ void small(Frame& F, const f32x4s& a, int row, int col, int nt) const { const size_t off = (size_t)row * 1024 + col; f32x4 b;
        if (BF) { const v2u w = *(const v2u*)(hb + off); b = (f32x4){bf2f(w.x & 0xffffu), __uint_as_float(w.x & 0xffff0000u), bf2f(w.y & 0xffffu), __uint_as_float(w.y & 0xffff0000u)}; }
        else b = *(const f32x4*)(base + off);
        const f32x4 v = b + (f32x4){a[0], a[1], a[2], a[3]};
        { v2u wv; wv.x = cvtpk_c(v[0], v[1]); wv.y = cvtpk_c(v[2], v[3]); *(v2u*)(hb + off) = wv; }
        float sq = (v[0] * v[0] + v[1] * v[1]) + (v[2] * v[2] + v[3] * v[3]); sq += __shfl_xor(sq, 1); sq += __shfl_xor(sq, 2); sq += __shfl_xor(sq, 4); sq += __shfl_xor(sq, 8);
        if ((F.tid & 15) == 0) ssqp[(size_t)row * 16 + nt] = sq; } };
struct SmScale { bf16* O; const float* ssq; float scale;
    __device__ __forceinline__ void small(Frame&, const f32x4s& a, int row, int col, int) const { const float rs = pg8::row_rs<16>(ssq, row) * scale;
        v2u wv; wv.x = cvtpk_c(a[0] * rs, a[1] * rs); wv.y = cvtpk_c(a[2] * rs, a[3] * rs); *(v2u*)(O + (size_t)row * 1024 + col) = wv; } };
__device__ __forceinline__ void attn_stage_tile(LAS unsigned char* Lb, const bf16* src, size_t pitch, int tid) {
#pragma unroll 1
    for (int hb = 0; hb < 2; ++hb) { v4u v[8];
#pragma unroll
        for (int i = 0; i < 8; ++i) { const int id = tid + 512 * (8 * hb + i), row = id >> 5, c = id & 31; v[i] = *(const v4u*)(src + (size_t)row * pitch + c * 8); }
#pragma unroll
        for (int i = 0; i < 8; ++i) { const int id = tid + 512 * (8 * hb + i), row = id >> 5, c = id & 31; *(LAS v4u*)(Lb + row * 512 + ((c ^ (row & 15)) << 4)) = v[i]; } }
}
__device__ __forceinline__ void attn_prompt_unit(Frame& F, int b, int hd, int qb) {
    const int tid = F.tid, lane = F.lane, w = F.wave, r = lane & 31, hh = lane >> 5; unsigned char* ws = F.ws;
    LAS unsigned char* Lb = F.lds + RING_OFF;
    const bf16* QB = (const bf16*)(ws + WS_QB); const bf16* KB = (const bf16*)(ws + WS_KB); const bf16* VT = (const bf16*)(ws + WS_VT); bf16* OB = (bf16*)(ws + WS_OB);
    const size_t qrow = (size_t)b * SEQ + (size_t)qb * 256 + 32 * w + r;
    attn_stage_tile(Lb, KB + (size_t)b * 256 * 1024 + hd * 256, 1024, tid);
    const bf16* qp = QB + qrow * 1024 + hd * 256 + 8 * hh;
    bf16x8 qf = *(const bf16x8*)qp;
    __syncthreads();
    f32x16 S[8];
#pragma unroll
    for (int t = 0; t < 8; ++t)
#pragma unroll
        for (int i = 0; i < 16; ++i) S[t][i] = 0.f;
    const int sw = r & 15;
#pragma unroll 1
    for (int ks = 0; ks < 16; ++ks) {
        const bf16x8 qn = *(const bf16x8*)(qp + 16 * (ks < 15 ? ks + 1 : ks));
        const LAS unsigned char* kp = Lb + r * 512 + (((2 * ks + hh) ^ sw) << 4);
#pragma unroll
        for (int t = 0; t < 8; ++t) S[t] = MFMA32(lds_frag16(kp + t * 32 * 512), qf, S[t]);
        qf = qn;
    }
    float m = -3.0e38f;
#pragma unroll
    for (int t = 0; t < 8; ++t)
#pragma unroll
        for (int i = 0; i < 16; ++i) m = fmaxf(m, S[t][i]);
    m = fmaxf(m, __shfl_xor(m, 32));
    float l = 0.f;
#pragma unroll
    for (int t = 0; t < 8; ++t)
#pragma unroll
        for (int i = 0; i < 16; ++i) { const float pv = __builtin_amdgcn_exp2f(S[t][i] - m); S[t][i] = pv; l += pv; }
    l += __shfl_xor(l, 32);
    const float rl = __builtin_amdgcn_rcpf(l);
    bf16x8 pf[8][2];
#pragma unroll
    for (int t = 0; t < 8; ++t) { pf[t][0] = ACC_FRAG(S[t], 0); pf[t][1] = ACC_FRAG(S[t], 1); }
    __syncthreads();
    attn_stage_tile(Lb, VT + (size_t)(b * 4 + hd) * 256 * 256, 256, tid);
    __syncthreads();
    bf16* op = OB + qrow * 1024 + hd * 256 + 4 * hh;
#pragma unroll 1
    for (int dt = 0; dt < 8; ++dt) {
        f32x16 O;
#pragma unroll
        for (int i = 0; i < 16; ++i) O[i] = 0.f;
        const LAS unsigned char* vrow = Lb + (32 * dt + r) * 512 + 8 * hh;
#pragma unroll
        for (int t = 0; t < 8; ++t)
#pragma unroll
            for (int s2 = 0; s2 < 2; ++s2) {
                const v2u lo = *(const LAS v2u*)(vrow + (((4 * t + 2 * s2) ^ sw) << 4)), hi = *(const LAS v2u*)(vrow + (((4 * t + 2 * s2 + 1) ^ sw) << 4));
                const v4u wv4 = (v4u){lo.x, lo.y, hi.x, hi.y};
                O = MFMA32(__builtin_bit_cast(bf16x8, wv4), pf[t][s2], O);
            }
#pragma unroll
        for (int q4 = 0; q4 < 4; ++q4) { v2u o; o.x = cvtpk_c(O[4 * q4] * rl, O[4 * q4 + 1] * rl); o.y = cvtpk_c(O[4 * q4 + 2] * rl, O[4 * q4 + 3] * rl);
            *(v2u*)(op + 32 * dt + 8 * q4) = o; }
    }
    __syncthreads();
}
__device__ __forceinline__ void attn_sample_unit(Frame& F, int sb, int hd) {
    const int tid = F.tid, lane = F.lane, w = F.wave; unsigned char* ws = F.ws;
    LAS float* sc = (LAS float*)(F.lds + RING_OFF);
    LAS float* red = sc + 4 * 256;
    const bf16* QB = (const bf16*)(ws + WS_QB); bf16* OB = (bf16*)(ws + WS_OB);
    const size_t rowq = (size_t)TP + (size_t)sb * LS;
    float q[4][4];
#pragma unroll
    for (int t = 0; t < 4; ++t) { const v2u qw = *(const v2u*)(QB + (rowq + t) * 1024 + hd * 256 + 4 * lane); q[t][0] = bf2f(qw.x & 0xffffu); q[t][1] = bf2f(qw.x >> 16); q[t][2] = bf2f(qw.y & 0xffffu); q[t][3] = bf2f(qw.y >> 16); }
    const float* Kc = F.in[6] + ((size_t)sb * 256 * 4 + hd) * 256 + 4 * lane; const float* Vc = F.in[7] + ((size_t)sb * 256 * 4 + hd) * 256 + 4 * lane;
    f32x4 kv[8], kn[8];
#pragma unroll
    for (int u = 0; u < 8; ++u) kv[u] = ld_nt(Kc + (size_t)(w * 32 + u) * 1024);
#pragma unroll 1
    for (int kk0 = 0; kk0 < 32; kk0 += 8) {
#pragma unroll
        for (int u = 0; u < 8; ++u) kn[u] = kk0 < 24 ? ld_nt(Kc + (size_t)(w * 32 + kk0 + 8 + u) * 1024) : ld_nt(Vc + (size_t)(w * 32 + u) * 1024);
        { float part[32];
#pragma unroll
          for (int u = 0; u < 8; ++u)
#pragma unroll
              for (int t = 0; t < 4; ++t) part[4 * u + t] = (q[t][0] * kv[u].x + q[t][1] * kv[u].y) + (q[t][2] * kv[u].z + q[t][3] * kv[u].w);
          float sv = tr_reduce32(part, lane); sv += __shfl_xor(sv, 32);
          if (lane < 32) sc[(lane & 3) * 256 + w * 32 + kk0 + (lane >> 2)] = sv; }
#pragma unroll
        for (int u = 0; u < 8; ++u) kv[u] = kn[u]; }
    __syncthreads();
    if (w < 4) { float v[4]; float m = -3.0e38f;
#pragma unroll
        for (int j = 0; j < 4; ++j) { v[j] = sc[w * 256 + j * 64 + lane]; m = fmaxf(m, v[j]); }
        m = wave_max(m); float l = 0.f;
#pragma unroll
        for (int j = 0; j < 4; ++j) { v[j] = __builtin_amdgcn_exp2f(v[j] - m); l += v[j]; }
        l = wave_sum(l); const float rl = 1.0f / l;
#pragma unroll
        for (int j = 0; j < 4; ++j) sc[w * 256 + j * 64 + lane] = v[j] * rl; }
    __syncthreads();
    float o[4][4];
#pragma unroll
    for (int t = 0; t < 4; ++t)
#pragma unroll
        for (int e = 0; e < 4; ++e) o[t][e] = 0.f;
#pragma unroll 1
    for (int kk0 = 0; kk0 < 32; kk0 += 8) {
        if (kk0 < 24) {
#pragma unroll
            for (int u = 0; u < 8; ++u) kn[u] = ld_nt(Vc + (size_t)(w * 32 + kk0 + 8 + u) * 1024); }
#pragma unroll
        for (int u = 0; u < 8; ++u) { const int key = w * 32 + kk0 + u;
#pragma unroll
            for (int t = 0; t < 4; ++t) { const float pr = sc[t * 256 + key]; o[t][0] += pr * kv[u].x; o[t][1] += pr * kv[u].y; o[t][2] += pr * kv[u].z; o[t][3] += pr * kv[u].w; } }
#pragma unroll
        for (int u = 0; u < 8; ++u) kv[u] = kn[u]; }
#pragma unroll
    for (int t = 0; t < 4; ++t) *(LAS f32x4*)(red + (w * 4 + t) * 256 + 4 * lane) = (f32x4){o[t][0], o[t][1], o[t][2], o[t][3]};
    __syncthreads();
    { const int t = tid >> 7, d0 = (tid & 127) * 2; float a0 = 0.f, a1 = 0.f;
#pragma unroll
      for (int ww = 0; ww < 8; ++ww) { a0 += red[(ww * 4 + t) * 256 + d0]; a1 += red[(ww * 4 + t) * 256 + d0 + 1]; }
      *(unsigned*)(OB + (rowq + t) * 1024 + hd * 256 + d0) = pk2(a0, a1); }
    __syncthreads();
}
__device__ __forceinline__ void attn_phase(Frame& F) {
    for (int u = F.vcu; u < NBP * 4 * 8; u += F.G) attn_prompt_unit(F, u >> 5, (u >> 3) & 3, u & 7);
    for (int u = F.vcu; u < NBS * 4; u += F.G) attn_sample_unit(F, u >> 2, u & 3);
}
__device__ __forceinline__ void final_norm_phase(Frame& F) {
    const int gw = F.vcu * NWAVES + F.wave, NGW = F.G * NWAVES; const float* SSQ = (const float*)(F.ws + WS_SSQP3); const float* wn = F.in[31]; const bf16* HB = (const bf16*)(F.ws + WS_HB);
    f32x4 wv[4];
#pragma unroll
    for (int j = 0; j < 2; ++j) { wv[2 * j] = *((const f32x4*)wn + 2 * (64 * j + F.lane)); wv[2 * j + 1] = *((const f32x4*)wn + 2 * (64 * j + F.lane) + 1); }
    for (int row = gw; row < T; row += NGW) {
        const f32x4* sp = (const f32x4*)(SSQ + (size_t)row * 16); float s = 0.f;
#pragma unroll
        for (int j = 0; j < 4; ++j) { const f32x4 a = sp[j]; s += (a.x + a.y) + (a.z + a.w); }
        const float rs = __builtin_amdgcn_rsqf(s * (1.0f / 1024.0f) + EPS);
#pragma unroll
        for (int j = 0; j < 2; ++j) { const int pc = 64 * j + F.lane; const v4u w = ld_nt16((const v4u*)(HB + (size_t)row * 1024) + pc);
            const f32x4 v0 = (f32x4){bf2f(w.x & 0xffffu), __uint_as_float(w.x & 0xffff0000u), bf2f(w.y & 0xffffu), __uint_as_float(w.y & 0xffff0000u)};
            const f32x4 v1 = (f32x4){bf2f(w.z & 0xffffu), __uint_as_float(w.z & 0xffff0000u), bf2f(w.w & 0xffffu), __uint_as_float(w.w & 0xffff0000u)};
            float* o = F.out + O_Y + (size_t)row * 1024 + 8 * pc; st_nt(o, v0 * rs * wv[2 * j]); st_nt(o + 4, v1 * rs * wv[2 * j + 1]); }
    }
}
#ifndef MK_N_LAUNCHES
#define MK_N_LAUNCHES 1
#endif
constexpr int PER_PHASE = 13;
constexpr int N_LAUNCHES = MK_N_LAUNCHES;
struct Args { const float* in[32]; float* out; unsigned char* ws; int ph_lo, ph_hi; };
__global__ void __launch_bounds__(NTHR, 2) skel_fwd(Args args) {
    extern __shared__ __attribute__((aligned(16))) unsigned char lds[];
    Frame F;
    F.lds = (LAS unsigned char*)lds;
    F.MISC = (volatile LAS unsigned*)(F.lds + MISC_OFF);
    F.tid = threadIdx.x; F.lane = F.tid & 63; F.wave = __builtin_amdgcn_readfirstlane(F.tid >> 6);
    F.G = gridDim.x; { const int bx = blockIdx.x; F.vcu = (F.G % 8 == 0) ? (bx % 8) * (F.G / 8) + bx / 8 : bx; }
    unsigned char* ws = args.ws; F.ws = ws; F.out = args.out;
    F.ctl = (gu32*)(ws + WS_CTL);
#pragma unroll
    for (int i = 0; i < 32; ++i) F.in[i] = args.in[i];
    for (int u = F.tid; u < (LDS_BYTES - LDSCTL_OFF) / 4; u += NTHR) ((LAS unsigned*)(F.lds + LDSCTL_OFF))[u] = 0u;
    __syncthreads();
    XcdBarrier bar; bar.bar = (unsigned*)(F.ctl + CW_BAR); bar.x = 0; bar.st = nullptr;
    if (N_LAUNCHES == 1) bar = xcd_barrier_post((unsigned*)(F.ctl + CW_BAR), F.MISC + 8);
#define GRID_BAR() do { if (N_LAUNCHES == 1) xcd_barrier(bar); } while (0)
    const int lo = args.ph_lo, hi = args.ph_hi;
#ifdef ONLY_PHASE
#define IN(k) ((k) == ONLY_PHASE && lo <= (k) && (k) < hi)
#else
#define IN(k) (lo <= (k) && (k) < hi)
#endif
#define BOTH(k) (IN(k) && IN((k) + 1))
    bf16* const XB = (bf16*)(ws + WS_XB); bf16* const PROJ = (bf16*)(ws + WS_PROJ);
    float* const Y = F.out + O_Y;
    if (IN(0)) { p0_prologue(F); if (BOTH(0)) GRID_BAR(); }
    if (IN(1)) {
        { pg8::Gemm g{XB, (const bf16*)(ws + WS_WIN), T, NPROJ, 1024}; pg8::StaticOrder S; S.init(T, NPROJ, F.G, (int)blockIdx.x);
          pg8::EpiScaleBf16<1, true> E{PROJ, SLOT_ELEMS, (const float*)(ws + WS_SSQX), 1.0f, (float*)(ws + WS_DT)};
          pg8::gemm_phase<pg8::EpiScaleBf16<1, true>, pg8::StaticOrder, true, true>(F.lds + RING_OFF, g, S, E); }
        { pg8::Gemm g{(const bf16*)(ws + WS_MNB), (const bf16*)(ws + WS_WKV), MEMR, 2048, 1024}; pg8::StaticOrder S; S.init(MEMR, 2048, F.G, (int)((blockIdx.x + 64) % F.G));
          pg8::EpiKV E{F.out + O_MKP, F.out + O_MVP, (bf16*)(ws + WS_KB), (bf16*)(ws + WS_VT), (const float*)(ws + WS_SSQM)};
          pg8::gemm_phase<pg8::EpiKV, pg8::StaticOrder, true, true>(F.lds + RING_OFF, g, S, E); }
        if (BOTH(1)) GRID_BAR();
    }
    if (IN(2)) { bc_prep_phase(F); hg_prep_phase(F); if (BOTH(2)) GRID_BAR(); }
    if (IN(3)) { scan_phase(F); if (BOTH(3)) GRID_BAR(); }
    if (IN(4)) { ssdnorm_phase(F); hgnorm_phase(F); if (BOTH(4)) GRID_BAR(); }
    if (IN(5)) { { SmGate<false> Es{(bf16*)(ws + WS_MERGED), PROJ + (size_t)S_GS * SLOT_ELEMS}; small_tile_phase(F, (const bf16*)(ws + WS_YG), (const bf16*)(ws + WS_WSSD), 2048, Es); }
        pg8::Gemm g{(const bf16*)(ws + WS_YG), (const bf16*)(ws + WS_WSSD), TP, 1024, 2048}; pg8::StaticOrder S; S.init(TP, 1024, F.G, (int)blockIdx.x);
        pg8::EpiGate<false> E{(bf16*)(ws + WS_MERGED), PROJ + (size_t)S_GS * SLOT_ELEMS};
        pg8::gemm_phase<pg8::EpiGate<false>, pg8::StaticOrder, true, true>(F.lds + RING_OFF, g, S, E);
          }
    if (IN(5)) { { SmGate<true> Es{(bf16*)(ws + WS_MERGED), PROJ + (size_t)S_GH * SLOT_ELEMS}; small_tile_phase(F, (const bf16*)(ws + WS_ON), (const bf16*)(ws + WS_WHG), 1024, Es); }
        pg8::Gemm g{(const bf16*)(ws + WS_ON), (const bf16*)(ws + WS_WHG), TP, 1024, 1024}; pg8::StaticOrder S; S.init(TP, 1024, F.G, (int)blockIdx.x);
        pg8::EpiGate<true> E{(bf16*)(ws + WS_MERGED), PROJ + (size_t)S_GH * SLOT_ELEMS};
        pg8::gemm_phase<pg8::EpiGate<true>, pg8::StaticOrder, true, true>(F.lds + RING_OFF, g, S, E);
        if (BOTH(5)) GRID_BAR(); }
    if (IN(6)) { { SmRes<false> Es{F.in[1] - (size_t)TP * 1024, (bf16*)(ws + WS_HB), (float*)(ws + WS_SSQP1)}; small_tile_phase(F, (const bf16*)(ws + WS_MERGED), (const bf16*)(ws + WS_WOUT), 1024, Es); }
        pg8::Gemm g{(const bf16*)(ws + WS_MERGED), (const bf16*)(ws + WS_WOUT), TP, 1024, 1024}; pg8::StaticOrder S; S.init(TP, 1024, F.G, (int)blockIdx.x);
        pg8::EpiRes<false> E{F.in[0], F.in[1] - (size_t)TP * 1024, (bf16*)(ws + WS_HB), (float*)(ws + WS_SSQP1)};
        pg8::gemm_phase<pg8::EpiRes<false>, pg8::StaticOrder, true, true>(F.lds + RING_OFF, g, S, E);
        if (BOTH(6)) GRID_BAR(); }
    if (IN(7)) { { SmScale Es{(bf16*)(ws + WS_QB), (const float*)(ws + WS_SSQP1), QSCALE}; small_tile_phase(F, (const bf16*)(ws + WS_HB), (const bf16*)(ws + WS_WCQ), 1024, Es); }
        pg8::Gemm g{(const bf16*)(ws + WS_HB), (const bf16*)(ws + WS_WCQ), TP, 1024, 1024}; pg8::StaticOrder S; S.init(TP, 1024, F.G, (int)blockIdx.x);
        pg8::EpiScaleBf16<16, false> E{(bf16*)(ws + WS_QB), SLOT_ELEMS, (const float*)(ws + WS_SSQP1), QSCALE, nullptr};
        pg8::gemm_phase<pg8::EpiScaleBf16<16, false>, pg8::StaticOrder, true, true>(F.lds + RING_OFF, g, S, E);
        if (BOTH(7)) GRID_BAR(); }
    if (IN(8)) { attn_phase(F); if (BOTH(8)) GRID_BAR(); }
    if (IN(9)) { { SmRes<true> Es{nullptr, (bf16*)(ws + WS_HB), (float*)(ws + WS_SSQP2)}; small_tile_phase(F, (const bf16*)(ws + WS_OB), (const bf16*)(ws + WS_WCO), 1024, Es); }
        pg8::Gemm g{(const bf16*)(ws + WS_OB), (const bf16*)(ws + WS_WCO), TP, 1024, 1024}; pg8::StaticOrder S; S.init(TP, 1024, F.G, (int)blockIdx.x);
        pg8::EpiRes<true> E{nullptr, nullptr, (bf16*)(ws + WS_HB), (float*)(ws + WS_SSQP2)};
        pg8::gemm_phase<pg8::EpiRes<true>, pg8::StaticOrder, true, true>(F.lds + RING_OFF, g, S, E);
        if (BOTH(9)) GRID_BAR(); }
    if (IN(10)) { pg8::Gemm g{(const bf16*)(ws + WS_HB), (const bf16*)(ws + WS_WGU), T, 2 * FFN, 1024}; pg8::StaticOrder S; S.init(T, 2 * FFN, F.G, (int)blockIdx.x);
        pg8::EpiSwiglu E{(bf16*)(ws + WS_ACT), (const float*)(ws + WS_SSQP2)};
        pg8::gemm_phase<pg8::EpiSwiglu, pg8::StaticOrder, true, true>(F.lds + RING_OFF, g, S, E);
        if (BOTH(10)) GRID_BAR(); }
    if (IN(11)) { { SmRes<true> Es{nullptr, (bf16*)(ws + WS_HB), (float*)(ws + WS_SSQP3)}; small_tile_phase(F, (const bf16*)(ws + WS_ACT), (const bf16*)(ws + WS_WDN), FFN, Es); }
        pg8::Gemm g{(const bf16*)(ws + WS_ACT), (const bf16*)(ws + WS_WDN), TP, 1024, FFN}; pg8::StaticOrder S; S.init(TP, 1024, F.G, (int)blockIdx.x);
        pg8::EpiRes<true> E{nullptr, nullptr, (bf16*)(ws + WS_HB), (float*)(ws + WS_SSQP3)};
        pg8::gemm_phase<pg8::EpiRes<true>, pg8::StaticOrder, true, true>(F.lds + RING_OFF, g, S, E);
        if (BOTH(11)) GRID_BAR(); }
    if (IN(12)) final_norm_phase(F);
#undef IN
#undef BOTH
}

extern "C" void kernel_launch(void* const* d_in, const int* in_sizes, int n_in, void* d_out, int out_size, void* d_ws, size_t ws_size, hipStream_t stream) {
    static int grid = 0;
    if (grid == 0) {
        const int want[32] = {TP * 1024, TS * 1024, MEMR * 1024, 33554432, 1179648, 16777216, 33554432, 33554432, 1024, 1024 * 11296, 4 * 3072, 3072, 32, 32, 32, 2048, 2048 * 1024, 2048, 1024,
                              1024 * 1024, 1024 * 1024, 1024, 1024, 1024 * 1024, 1024 * 1024, 1024 * 1024, 1024 * 1024, 1024, 1024 * FFN, 1024 * FFN, FFN * 1024, 1024};
        bool ok = (n_in == 32); for (int i = 0; ok && i < 32; ++i) if (in_sizes[i] != want[i]) { fprintf(stderr, "kernel_launch: input %d has %d elements, expected %d\n", i, in_sizes[i], want[i]); ok = false; }
        if (!ok || out_size != (int)O_END || ws_size < WS_END4) { fprintf(stderr, "kernel_launch: unexpected shapes: n_in %d out %d ws %zu\n", n_in, out_size, ws_size); grid = -1; return; }
        int dev = 0, cus = 0, per_cu = 0;
        if (hipGetDevice(&dev) != hipSuccess || hipDeviceGetAttribute(&cus, hipDeviceAttributeMultiprocessorCount, dev) != hipSuccess) { grid = -1; return; }
        if (hipFuncSetAttribute((const void*)skel_fwd, hipFuncAttributeMaxDynamicSharedMemorySize, LDS_BYTES) != hipSuccess) { fprintf(stderr, "kernel_launch: hipFuncSetAttribute failed\n"); grid = -1; return; }
        if (hipOccupancyMaxActiveBlocksPerMultiprocessor(&per_cu, (const void*)skel_fwd, NTHR, LDS_BYTES) != hipSuccess || per_cu < 1) fprintf(stderr, "kernel_launch: occupancy query reports %d blocks per CU\n", per_cu);
        (void)hipGetLastError();
        grid = cus;
    }
    if (grid < 0) return;
    (void)hipMemsetAsync((char*)d_ws + WS_CTL, 0, CTL_ZERO_BYTES, stream);
    Args a{};
    for (int i = 0; i < 32; ++i) a.in[i] = (const float*)d_in[i];
    a.out = (float*)d_out; a.ws = (unsigned char*)d_ws;
    for (int li = 0; li < N_LAUNCHES; ++li) {
        a.ph_lo = (N_LAUNCHES == PER_PHASE) ? li : 0; a.ph_hi = (N_LAUNCHES == PER_PHASE) ? li + 1 : PER_PHASE;
        hipLaunchKernelGGL(skel_fwd, dim3(grid), dim3(NTHR), LDS_BYTES, stream, a);
    }
}
```

```cpp
#include <hip/hip_runtime.h>
#include <cstdio>
#include <cstdint>
namespace pg8 {
#define PG8_LAS __attribute__((address_space(3)))
typedef unsigned short bf16_t;
typedef short bf16x8 __attribute__((ext_vector_type(8)));
typedef float f32x4 __attribute__((ext_vector_type(4)));
typedef unsigned u32x4 __attribute__((ext_vector_type(4)));
constexpr int BM = 256, BK = 64, HALF = 128, HTB = HALF * BK * 2  , STAGE_BYTES = 8 * HTB, NXCD = 8, WGM = 8;

__host__ __device__ __forceinline__ int lds_byte(int r, int c) { const int st = (r >> 4) * 2 + (c >> 5), rr = r & 15, cc = c & 31, ob = rr * 64 + cc * 2; return st * 1024 + (ob ^ (((ob >> 9) & 1) << 5)); }
__host__ __device__ __forceinline__ void stage_rc(int b, int& R, int& C) { const int st = b / 1024, sb = b % 1024, swz = sb ^ (((sb >> 9) & 1) << 5); R = (st >> 1) * 16 + swz / 64; C = (st & 1) * 32 + (swz % 64) / 2; }
__host__ __device__ __forceinline__ int perm32(int rho) { const int n = rho >> 4, i = rho & 15; return 8 * (i >> 2) + 4 * n + (i & 3); }

struct Unit { int pm, pn; };
struct Gemm { const bf16_t* A; const bf16_t* Bt; int M, N, K; };

struct StaticOrder {
    int nM, nN, nwg, G, c;
    __host__ __device__ void init(int M, int N, int G_, int c_) { nM = M / BM; nN = N / BM; nwg = nM * nN; G = G_; c = c_; }
    __host__ __device__ bool next(int i, Unit& u) const {
        const long L = (long)i * G + c; if (L >= nwg) return false;
        int wgid = (int)L; { const int q = nwg / NXCD, r = nwg % NXCD, xcd = wgid % NXCD, off = wgid / NXCD; wgid = (xcd < r ? xcd * (q + 1) : r * (q + 1) + (xcd - r) * q) + off; }
        const int nig = WGM * nN, gid = wgid / nig, fm = gid * WGM, gsz = (nM - fm) < WGM ? (nM - fm) : WGM;
        u.pm = fm + ((wgid % nig) % gsz); u.pn = (wgid % nig) / gsz; return true;
    }
    __device__ __forceinline__ void a_ready(const Unit&) const {}
    __device__ __forceinline__ void done(const Unit&) const {}
};

__device__ __forceinline__ unsigned cvt_pk_bf16(float lo, float hi) { unsigned r; asm volatile("v_cvt_pk_bf16_f32 %0, %1, %2" : "=v"(r) : "v"(lo), "v"(hi)); return r; }
typedef float f32x2 __attribute__((ext_vector_type(2)));
typedef unsigned u32x2 __attribute__((ext_vector_type(2)));
constexpr float RMS_EPS = 1e-6f;
__device__ __forceinline__ float bfbits2f(unsigned v16) { return __uint_as_float(v16 << 16); }
__device__ __forceinline__ float sigm(float x) { return __builtin_amdgcn_rcpf(1.0f + __expf(-x)); }
template <int NP> __device__ __forceinline__ float row_rs(const float* ssq, int row) {
    float s = 0.f;
    if constexpr (NP == 1) s = ssq[row];
    else {
#pragma unroll
        for (int i = 0; i < NP / 4; ++i) { const f32x4 v = *(const f32x4*)(ssq + (size_t)row * NP + 4 * i); s += (v[0] + v[1]) + (v[2] + v[3]); }
    }
    return 1.0f / sqrtf(s * (1.0f / 1024.0f) + RMS_EPS);
}
template <int NP, bool HAS_DT> struct EpiScaleBf16 {
    static constexpr bool PERM = true, AFTER_DRAIN = false;
    bf16_t* O; size_t slot_elems; const float* ssq; float scale; float* dt;
    __device__ __forceinline__ void operator()(const f32x4 (&acc)[2][2][4][2], const Unit& u, int wr, int wc, int fr, int fq) const {
        const int row0 = u.pm * BM + wr * 64 + fr;
        if (HAS_DT && u.pn == 44) {
            if (wc == 0) {
#pragma unroll
                for (int ai = 0; ai < 2; ++ai)
#pragma unroll
                    for (int m = 0; m < 4; ++m) { const int row = row0 + ai * HALF + m * 16; const float rs = row_rs<NP>(ssq, row);
                        float* p = dt + (size_t)row * 32 + 8 * fq; *(f32x4*)p = acc[ai][0][m][0] * rs; *(f32x4*)(p + 4) = acc[ai][0][m][1] * rs; }
            }
            return;
        }
        bf16_t* base = O + (size_t)(u.pn >> 2) * slot_elems; const int col0 = (u.pn & 3) * BM + wc * 32 + 8 * fq;
#pragma unroll
        for (int ai = 0; ai < 2; ++ai)
#pragma unroll
            for (int m = 0; m < 4; ++m) { const int row = row0 + ai * HALF + m * 16; const float rs = row_rs<NP>(ssq, row) * scale; bf16_t* rowp = base + (size_t)row * 1024 + col0;
#pragma unroll
                for (int bj = 0; bj < 2; ++bj) { const f32x4 v0 = acc[ai][bj][m][0] * rs, v1 = acc[ai][bj][m][1] * rs;
                    u32x4 w; w.x = cvt_pk_bf16(v0[0], v0[1]); w.y = cvt_pk_bf16(v0[2], v0[3]); w.z = cvt_pk_bf16(v1[0], v1[1]); w.w = cvt_pk_bf16(v1[2], v1[3]);
                    if (HAS_DT) __builtin_nontemporal_store(w, (u32x4*)(rowp + bj * HALF));
                    else *(u32x4*)(rowp + bj * HALF) = w; } }
    }
};
struct EpiKV {
    static constexpr bool PERM = false, AFTER_DRAIN = false;
    float* mk; float* mv; bf16_t* kb; bf16_t* vt; const float* ssq;
    __device__ __forceinline__ void operator()(const f32x4 (&acc)[2][2][4][2], const Unit& u, int wr, int wc, int fr, int fq) const {
        const int row0 = u.pm * BM + wr * 64 + fr; const bool isv = u.pn >= 4; const int colt = (u.pn & 3) * BM + wc * 32 + 4 * fq;
#pragma unroll
        for (int ai = 0; ai < 2; ++ai)
#pragma unroll
            for (int m = 0; m < 4; ++m) { const int row = row0 + ai * HALF + m * 16; const float rs = row_rs<1>(ssq, row);
#pragma unroll
                for (int bj = 0; bj < 2; ++bj)
#pragma unroll
                    for (int n = 0; n < 2; ++n) { const int c = colt + bj * HALF + n * 16; const f32x4 v = acc[ai][bj][m][n] * rs;
                        if (!isv) { __builtin_nontemporal_store(v, (f32x4*)(mk + (size_t)row * 1024 + c)); u32x2 w; w.x = cvt_pk_bf16(v[0], v[1]); w.y = cvt_pk_bf16(v[2], v[3]); *(u32x2*)(kb + (size_t)row * 1024 + c) = w; }
                        else { __builtin_nontemporal_store(v, (f32x4*)(mv + (size_t)row * 1024 + c)); const int b = row >> 8, key = row & 255, hd = c >> 8, d = c & 255;
                            bf16_t* p = vt + ((size_t)((b * 4 + hd) * 256 + d)) * 256 + key; const unsigned w0 = cvt_pk_bf16(v[0], v[1]), w1 = cvt_pk_bf16(v[2], v[3]);
                            p[0] = (bf16_t)(w0 & 0xffffu); p[256] = (bf16_t)(w0 >> 16); p[512] = (bf16_t)(w1 & 0xffffu); p[768] = (bf16_t)(w1 >> 16); } } }
    }
};
template <bool ADD> struct EpiGate {
    static constexpr bool PERM = true, AFTER_DRAIN = false;
    bf16_t* O; const bf16_t* gate;
    __device__ __forceinline__ void operator()(const f32x4 (&acc)[2][2][4][2], const Unit& u, int wr, int wc, int fr, int fq) const {
        const int row0 = u.pm * BM + wr * 64 + fr, col0 = u.pn * BM + wc * 32 + 8 * fq;
#pragma unroll
        for (int ai = 0; ai < 2; ++ai)
#pragma unroll
            for (int m = 0; m < 4; ++m) { const size_t off = (size_t)(row0 + ai * HALF + m * 16) * 1024 + col0;
#pragma unroll
                for (int bj = 0; bj < 2; ++bj) { const u32x4 gw = __builtin_nontemporal_load((const u32x4*)(gate + off + bj * HALF)); u32x4 ow = (u32x4){0u, 0u, 0u, 0u}; if (ADD) ow = *(const u32x4*)(O + off + bj * HALF);
                    float r[8];
#pragma unroll
                    for (int e = 0; e < 8; ++e) { const unsigned g16 = (gw[e >> 1] >> ((e & 1) * 16)) & 0xffffu, o16 = (ow[e >> 1] >> ((e & 1) * 16)) & 0xffffu;
                        const float a = acc[ai][bj][m][e >> 2][e & 3]; r[e] = (ADD ? bfbits2f(o16) : 0.f) + sigm(bfbits2f(g16)) * a; }
                    u32x4 w; w.x = cvt_pk_bf16(r[0], r[1]); w.y = cvt_pk_bf16(r[2], r[3]); w.z = cvt_pk_bf16(r[4], r[5]); w.w = cvt_pk_bf16(r[6], r[7]);
                    *(u32x4*)(O + off + bj * HALF) = w; } }
    }
};
template <bool BF> struct EpiRes {
    static constexpr bool PERM = true, AFTER_DRAIN = false;
    const float* base0; const float* base1; bf16_t* hb; float* ssqp;
    __device__ __forceinline__ void operator()(const f32x4 (&acc)[2][2][4][2], const Unit& u, int wr, int wc, int fr, int fq) const {
        const int row0 = u.pm * BM + wr * 64 + fr, col0 = u.pn * BM + wc * 32 + 8 * fq; const float* base = u.pm < 64 ? base0 : base1;
#pragma unroll
        for (int ai = 0; ai < 2; ++ai)
#pragma unroll
            for (int m = 0; m < 4; ++m) { const int row = row0 + ai * HALF + m * 16; const size_t off = (size_t)row * 1024 + col0; float sq = 0.f;
#pragma unroll
                for (int bj = 0; bj < 2; ++bj) { const size_t o2 = off + bj * HALF; f32x4 b0, b1;
                    if (BF) { const u32x4 w = *(const u32x4*)(hb + o2); b0 = (f32x4){bfbits2f(w.x & 0xffffu), __uint_as_float(w.x & 0xffff0000u), bfbits2f(w.y & 0xffffu), __uint_as_float(w.y & 0xffff0000u)};
                        b1 = (f32x4){bfbits2f(w.z & 0xffffu), __uint_as_float(w.z & 0xffff0000u), bfbits2f(w.w & 0xffffu), __uint_as_float(w.w & 0xffff0000u)}; }
                    else { b0 = __builtin_nontemporal_load((const f32x4*)(base + o2)); b1 = __builtin_nontemporal_load((const f32x4*)(base + o2 + 4)); }
                    const f32x4 v0 = b0 + acc[ai][bj][m][0], v1 = b1 + acc[ai][bj][m][1];
                    sq += ((v0[0] * v0[0] + v0[1] * v0[1]) + (v0[2] * v0[2] + v0[3] * v0[3])) + ((v1[0] * v1[0] + v1[1] * v1[1]) + (v1[2] * v1[2] + v1[3] * v1[3]));
                    u32x4 w; w.x = cvt_pk_bf16(v0[0], v0[1]); w.y = cvt_pk_bf16(v0[2], v0[3]); w.z = cvt_pk_bf16(v1[0], v1[1]); w.w = cvt_pk_bf16(v1[2], v1[3]); *(u32x4*)(hb + o2) = w; }
                sq += __shfl_xor(sq, 16); sq += __shfl_xor(sq, 32);
                if (fq == 0) ssqp[(size_t)row * 16 + u.pn * 4 + wc] = sq; }
    }
};
struct EpiSwiglu {
    static constexpr bool PERM = true, AFTER_DRAIN = false;
    bf16_t* act; const float* ssq;
    __device__ __forceinline__ void operator()(const f32x4 (&acc)[2][2][4][2], const Unit& u, int wr, int wc, int fr, int fq) const {
        const int row0 = u.pm * BM + wr * 64 + fr, col0 = u.pn * 128 + wc * 16 + 4 * fq;
#pragma unroll
        for (int ai = 0; ai < 2; ++ai)
#pragma unroll
            for (int m = 0; m < 4; ++m) { const int row = row0 + ai * HALF + m * 16; const float rs = row_rs<16>(ssq, row);
#pragma unroll
                for (int bj = 0; bj < 2; ++bj) { const f32x4 a = acc[ai][bj][m][0] * rs, b = acc[ai][bj][m][1] * rs;
                    const float r0 = a[0] * sigm(a[0]) * a[1], r1 = a[2] * sigm(a[2]) * a[3], r2 = b[0] * sigm(b[0]) * b[1], r3 = b[2] * sigm(b[2]) * b[3];
                    u32x2 w; w.x = cvt_pk_bf16(r0, r1); w.y = cvt_pk_bf16(r2, r3); *(u32x2*)(act + (size_t)row * 2816 + col0 + bj * 64) = w; } }
    }
};
template <class Epi, class Sched, bool ALIGN_EPI = false, bool SP2 = false>
__device__ __forceinline__ void gemm_phase(PG8_LAS unsigned char* lds, const Gemm g, const Sched& S, const Epi& E) {
    const int tid = threadIdx.x, wid = __builtin_amdgcn_readfirstlane(tid >> 6), lane = tid & 63, wr = wid >> 2, wc = wid & 3, fr = lane & 15, fq = lane >> 4;
    const int K = g.K, nt = K / BK;
    unsigned voffA[2], voffB[2];
#pragma unroll
    for (int i = 0; i < 2; ++i) { int R, C; stage_rc(tid * 16 + i * 8192, R, C); const int Rb = Epi::PERM ? ((R & ~31) + perm32(R & 31)) : R;
        voffA[i] = (unsigned)(R * K + C) * 2u; voffB[i] = (unsigned)(Rb * K + C) * 2u; }
    const size_t kstep = (size_t)(BK * 2);
    const size_t hstep = (size_t)HALF * K * 2;
    const size_t tstep = 2 * hstep;
    const unsigned ldsw = (unsigned)wid * 1024u;
    const int aoff = lds_byte(wr * 64 + fr, fq * 8), boff = lds_byte(wc * 32 + fr, fq * 8);
#define PG8_SA(b, h) (((b) * 2 + (h)) * HTB)
#define PG8_SB(b, h) ((4 + (b) * 2 + (h)) * HTB)
#define PG8_STAGE(bufoff, gbase, voff) do { _Pragma("unroll") for (int _i = 0; _i < 2; ++_i) \
        __builtin_amdgcn_global_load_lds((const unsigned*)((const char*)(gbase) + (voff)[_i]), (PG8_LAS unsigned*)(lds + (bufoff) + ldsw + _i * 8192), 16, 0, 0); } while (0)
#define PG8_LDA(dst, b, h) do { _Pragma("unroll") for (int m = 0; m < 4; ++m) _Pragma("unroll") for (int k = 0; k < 2; ++k) dst[m][k] = *(const PG8_LAS bf16x8*)(lds + PG8_SA(b, h) + aoff + m * 2048 + k * 1024); } while (0)
#define PG8_LDB(dst, b, h) do { _Pragma("unroll") for (int n = 0; n < 2; ++n) _Pragma("unroll") for (int k = 0; k < 2; ++k) dst[n][k] = *(const PG8_LAS bf16x8*)(lds + PG8_SB(b, h) + boff + n * 2048 + k * 1024); } while (0)
#define PG8_MMA(ai, bj, At, Bt) do { __builtin_amdgcn_s_setprio(1); _Pragma("unroll") for (int m = 0; m < 4; ++m) _Pragma("unroll") for (int n = 0; n < 2; ++n) _Pragma("unroll") for (int k = 0; k < 2; ++k) \
        acc[ai][bj][m][n] = __builtin_amdgcn_mfma_f32_16x16x32_bf16(Bt[n][k], At[m][k], acc[ai][bj][m][n], 0, 0, 0); __builtin_amdgcn_s_setprio(0); } while (0)
#define PG8_WAIT_V(n) asm volatile("s_waitcnt vmcnt(" #n ")" ::: "memory")
#define PG8_WAIT_L(n) asm volatile("s_waitcnt lgkmcnt(" #n ")" ::: "memory")
#define PG8_BAR __builtin_amdgcn_s_barrier()
#define PG8_SCHED __builtin_amdgcn_sched_barrier(0)
    Unit cur, nxt; int ui = 0;
    if (!S.next(0, cur)) return;
    f32x4 acc[2][2][4][2];
#pragma unroll
    for (int a = 0; a < 2; ++a)
#pragma unroll
        for (int b = 0; b < 2; ++b)
#pragma unroll
            for (int m = 0; m < 4; ++m)
#pragma unroll
                for (int n = 0; n < 2; ++n) acc[a][b][m][n] = (f32x4){0.f, 0.f, 0.f, 0.f};
    bf16x8 At[4][2], B0[2][2], B1[2][2];
    const char* cA = (const char*)g.A + (size_t)cur.pm * tstep; const char* cB = (const char*)g.Bt + (size_t)cur.pn * tstep;
    S.a_ready(cur);
    if constexpr (SP2) {
        PG8_STAGE(PG8_SB(0, 0), cB, voffB); PG8_STAGE(PG8_SB(0, 1), cB + hstep, voffB); PG8_STAGE(PG8_SA(0, 0), cA, voffA); PG8_STAGE(PG8_SA(0, 1), cA + hstep, voffA);
        if (wr == 1) PG8_BAR;
        PG8_WAIT_V(2); PG8_BAR;
        PG8_STAGE(PG8_SB(1, 0), cB + kstep, voffB); PG8_STAGE(PG8_SA(1, 0), cA + kstep, voffA); PG8_STAGE(PG8_SB(1, 1), cB + hstep + kstep, voffB);
        PG8_WAIT_V(6); PG8_BAR;
    } else {
        PG8_STAGE(PG8_SB(0, 0), cB, voffB); PG8_STAGE(PG8_SA(0, 0), cA, voffA); PG8_STAGE(PG8_SB(0, 1), cB + hstep, voffB); PG8_STAGE(PG8_SA(0, 1), cA + hstep, voffA);
        if (wr == 1) PG8_BAR;
        PG8_WAIT_V(4); PG8_BAR;
        PG8_STAGE(PG8_SB(1, 0), cB + kstep, voffB); PG8_STAGE(PG8_SA(1, 0), cA + kstep, voffA); PG8_STAGE(PG8_SB(1, 1), cB + hstep + kstep, voffB);
        PG8_WAIT_V(6); PG8_BAR;
    }
    for (;;) {
        const bool has_next = S.next(ui + 1, nxt);
        const char* nA = has_next ? (const char*)g.A + (size_t)nxt.pm * tstep : cA; const char* nB = has_next ? (const char*)g.Bt + (size_t)nxt.pn * tstep : cB;
        for (int t = 0; t < nt; t += 2) {
            const bool last = (t == nt - 2);
            const char* a1 = cA + (size_t)(t + 1) * kstep;
            const char* a2 = last ? nA : cA + (size_t)(t + 2) * kstep; const char* b2 = last ? nB : cB + (size_t)(t + 2) * kstep;
            const char* a3 = a2 + kstep; const char* b3 = b2 + kstep;
            if (last && has_next) S.a_ready(nxt);
            if constexpr (SP2) {
            PG8_LDB(B0, 0, 0); PG8_LDB(B1, 0, 1); PG8_SCHED; PG8_LDA(At, 0, 0); PG8_STAGE(PG8_SA(1, 1), a1 + hstep, voffA);
            PG8_WAIT_V(8); PG8_WAIT_L(0); PG8_BAR; PG8_MMA(0, 0, At, B0); PG8_MMA(0, 1, At, B1); PG8_BAR; PG8_SCHED;
            PG8_LDA(At, 0, 1); PG8_STAGE(PG8_SB(0, 0), b2, voffB); PG8_STAGE(PG8_SB(0, 1), b2 + hstep, voffB); PG8_STAGE(PG8_SA(0, 0), a2, voffA);
            PG8_WAIT_V(8); PG8_WAIT_L(0); PG8_BAR; PG8_MMA(1, 0, At, B0); PG8_MMA(1, 1, At, B1); PG8_BAR; PG8_SCHED;
            PG8_LDB(B0, 1, 0); PG8_LDB(B1, 1, 1); PG8_SCHED; PG8_LDA(At, 1, 0); PG8_STAGE(PG8_SA(0, 1), a2 + hstep, voffA);
            PG8_WAIT_V(8); PG8_WAIT_L(0); PG8_BAR; PG8_MMA(0, 0, At, B0); PG8_MMA(0, 1, At, B1); PG8_BAR; PG8_SCHED;
            PG8_LDA(At, 1, 1); PG8_STAGE(PG8_SB(1, 0), b3, voffB); PG8_STAGE(PG8_SB(1, 1), b3 + hstep, voffB); PG8_STAGE(PG8_SA(1, 0), a3, voffA);
            PG8_WAIT_V(8); PG8_WAIT_L(0); PG8_BAR; PG8_MMA(1, 0, At, B0); PG8_MMA(1, 1, At, B1); PG8_BAR; PG8_SCHED;
            } else {
            PG8_LDB(B0, 0, 0); PG8_SCHED; PG8_LDA(At, 0, 0); PG8_STAGE(PG8_SA(1, 1), a1 + hstep, voffA);
            PG8_WAIT_L(8); PG8_BAR; PG8_WAIT_L(0); PG8_MMA(0, 0, At, B0); PG8_BAR; PG8_SCHED;
            PG8_LDB(B1, 0, 1); PG8_STAGE(PG8_SB(0, 0), b2, voffB);
            PG8_BAR; PG8_WAIT_L(0); PG8_MMA(0, 1, At, B1); PG8_BAR;
            PG8_LDA(At, 0, 1); PG8_STAGE(PG8_SA(0, 0), a2, voffA);
            PG8_BAR; PG8_WAIT_L(0); PG8_MMA(1, 0, At, B0); PG8_BAR; PG8_SCHED;
            PG8_STAGE(PG8_SB(0, 1), b2 + hstep, voffB);
            PG8_WAIT_V(6); PG8_BAR; PG8_MMA(1, 1, At, B1); PG8_BAR;
            PG8_LDB(B0, 1, 0); PG8_SCHED; PG8_LDA(At, 1, 0); PG8_STAGE(PG8_SA(0, 1), a2 + hstep, voffA);
            PG8_WAIT_L(8); PG8_BAR; PG8_WAIT_L(0); PG8_MMA(0, 0, At, B0); PG8_BAR; PG8_SCHED;
            PG8_LDB(B1, 1, 1); PG8_STAGE(PG8_SB(1, 0), b3, voffB);
            PG8_BAR; PG8_WAIT_L(0); PG8_MMA(0, 1, At, B1); PG8_BAR;
            PG8_LDA(At, 1, 1); PG8_STAGE(PG8_SA(1, 0), a3, voffA);
            PG8_BAR; PG8_WAIT_L(0); PG8_MMA(1, 0, At, B0); PG8_BAR; PG8_SCHED;
            PG8_STAGE(PG8_SB(1, 1), b3 + hstep, voffB);
            PG8_WAIT_V(6); PG8_BAR; PG8_MMA(1, 1, At, B1); PG8_BAR;
            }
        }
        if constexpr (ALIGN_EPI) { if (wr == 0) PG8_BAR; }
        if constexpr (!Epi::AFTER_DRAIN) { E(acc, cur, wr, wc, fr, fq); S.done(cur); }
        if (!has_next) break;
#pragma unroll
        for (int a = 0; a < 2; ++a)
#pragma unroll
            for (int b = 0; b < 2; ++b)
#pragma unroll
                for (int m = 0; m < 4; ++m)
#pragma unroll
                    for (int n = 0; n < 2; ++n) acc[a][b][m][n] = (f32x4){0.f, 0.f, 0.f, 0.f};
        cur = nxt; cA = nA; cB = nB; ++ui;
        if constexpr (ALIGN_EPI) { if (wr == 1) PG8_BAR; }
    }
    PG8_WAIT_V(0);
    if constexpr (!ALIGN_EPI) { if (wr == 0) PG8_BAR; }
    PG8_BAR;
    if constexpr (Epi::AFTER_DRAIN) { E.fused(acc, cur, wr, wc, fr, fq, lds, wid, lane); S.done(cur); }
#undef PG8_SA
#undef PG8_SB
#undef PG8_STAGE
#undef PG8_LDA
#undef PG8_LDB
#undef PG8_MMA
#undef PG8_WAIT_V
#undef PG8_WAIT_L
#undef PG8_BAR
#undef PG8_SCHED
}
}
#define GAS __attribute__((address_space(1)))
#define LAS __attribute__((address_space(3)))
typedef unsigned short bf16;
typedef unsigned v4u __attribute__((ext_vector_type(4)));
typedef float f32x4 __attribute__((ext_vector_type(4)));
typedef short bf16x8 __attribute__((ext_vector_type(8)));
typedef GAS unsigned gu32;
typedef GAS unsigned long long gu64;
#define RLX_AGENT __ATOMIC_RELAXED, __HIP_MEMORY_SCOPE_AGENT
#define LDS_WAIT() asm volatile("s_waitcnt lgkmcnt(0)" ::: "memory")
#define VM_WAIT() asm volatile("s_waitcnt vmcnt(0)" ::: "memory")
__device__ __forceinline__ unsigned long long rt() { return __builtin_amdgcn_s_memrealtime(); }
typedef float f32x2_t __attribute__((ext_vector_type(2))); typedef __bf16 bf16x2_t __attribute__((ext_vector_type(2)));
__device__ __forceinline__ unsigned pk2(float lo, float hi) { const f32x2_t v = {lo, hi}; const bf16x2_t b = __builtin_convertvector(v, bf16x2_t); return __builtin_bit_cast(unsigned, b); }
__device__ __forceinline__ unsigned f2bf(float f) { return pk2(f, 0.f) & 0xffffu; }

#define XB_TMO      128
#define XB_XCNT(j)  (256  + 64 * (j))
#define XB_XSUB(j)  (1280 + 64 * (j))
#define XB_XGEN(j)  (2304 + 64 * (j))
#define XB_TOP      3328
#define XB_TOPGEN   3392
#define XCD_BAR_WORDS 3456
#define XB_SPIN_CAP (1u << 18)

__device__ __forceinline__ unsigned xb_ld(unsigned* p)              { return __hip_atomic_load(p, __ATOMIC_RELAXED, __HIP_MEMORY_SCOPE_AGENT); }
__device__ __forceinline__ unsigned xb_add(unsigned* p, unsigned v) { return __hip_atomic_fetch_add(p, v, __ATOMIC_RELAXED, __HIP_MEMORY_SCOPE_AGENT); }
__device__ __forceinline__ unsigned xb_xcc_id() { return (unsigned)__builtin_amdgcn_s_getreg((3 << 11) | 20) & 0xFu; }
#define XB_SPIN(cond, bar) do { unsigned _sp = 0; while (cond) { __builtin_amdgcn_s_sleep(1); \
    if ((++_sp & 255u) == 0u) { if (xb_ld(&(bar)[XB_TMO])) break; if (_sp > XB_SPIN_CAP) { atomicAdd(&(bar)[XB_TMO], 1u); break; } } } } while (0)

struct XcdBarrier {
    unsigned* bar; unsigned x;
    volatile LAS unsigned* st;
};

__device__ __forceinline__ XcdBarrier xcd_barrier_post(unsigned* bar, volatile LAS unsigned* st) {
    XcdBarrier b; b.bar = bar; b.x = xb_xcc_id(); b.st = st;
    if (threadIdx.x == 0) (void)xb_add(&bar[XB_XCNT(b.x)], 1u);
    return b;
}
__device__ __forceinline__ void xcd_barrier_complete(unsigned* bar, unsigned x, unsigned& nloc, unsigned& nx) {
    const unsigned G = gridDim.x * gridDim.y * gridDim.z;
    unsigned sum, cnt, mine, sp = 0u;
    for (;;) {
        sum = 0u; cnt = 0u; mine = 0u;
#pragma unroll
        for (unsigned j = 0; j < 16; ++j) { const unsigned c = xb_ld(&bar[XB_XCNT(j)]); sum += c; cnt += (c > 0u) ? 1u : 0u; mine = (j == x) ? c : mine; }
        if (sum == G) break;
        __builtin_amdgcn_s_sleep(1);
        if ((++sp & 255u) == 0u) { if (xb_ld(&bar[XB_TMO])) break; if (sp > XB_SPIN_CAP) { atomicAdd(&bar[XB_TMO], 1u); break; } }
    }
    nloc = mine > 0u ? mine : 1u; nx = cnt > 0u ? cnt : 1u;
}

__device__ __forceinline__ void xcd_barrier(const XcdBarrier& b) {
    asm volatile("s_waitcnt vmcnt(0)" ::: "memory");
    __syncthreads();
    if (threadIdx.x == 0) {
        unsigned* bar = b.bar;
        __builtin_amdgcn_s_waitcnt(0);
        unsigned nloc = b.st[0], nx = b.st[1];
        if (nloc == 0u) { xcd_barrier_complete(bar, b.x, nloc, nx); b.st[0] = nloc; b.st[1] = nx; }
        const unsigned old = xb_add(&bar[XB_XSUB(b.x)], 1u);
        const unsigned gen = old / nloc;
        if (old + 1u == (gen + 1u) * nloc) {
            __builtin_amdgcn_fence(__ATOMIC_RELEASE, "agent");
            asm volatile("s_waitcnt vmcnt(0)" ::: "memory");
            const unsigned og = xb_add(&bar[XB_TOP], 1u);
            const unsigned tg = og / nx;
            if (og + 1u == (tg + 1u) * nx) xb_add(&bar[XB_TOPGEN], 1u);
            else XB_SPIN(xb_ld(&bar[XB_TOPGEN]) == tg, bar);
            __builtin_amdgcn_fence(__ATOMIC_ACQUIRE, "agent");
            xb_add(&bar[XB_XGEN(b.x)], 1u);
            asm volatile("s_waitcnt vmcnt(0)" ::: "memory");
        } else {
            XB_SPIN(xb_ld(&bar[XB_XGEN(b.x)]) == gen, bar);
            __builtin_amdgcn_fence(__ATOMIC_ACQUIRE, "agent");
            asm volatile("s_waitcnt vmcnt(0)" ::: "memory");
        }
    }
    __syncthreads();
}
typedef unsigned v2u __attribute__((ext_vector_type(2)));
constexpr int NWAVES = 8, NTHR = 512;
constexpr int DM = 1024, TP = 16384, TS = 512, T = TP + TS;
constexpr int SEQ = 2048, NBP = 8, NBS = 128, LS = 4, MEMR = 2048;
constexpr int NPROJ = 11520;
constexpr int FFN = 2816;
constexpr float EPS = 1e-6f;
constexpr float QSCALE = 0.0625f * 1.4426950408889634f;

constexpr size_t MiB = 1u << 20;
constexpr size_t WS_CTL = 0, CTL_ZERO_BYTES = 32768;
constexpr size_t WS_SSQX = 1 * MiB, WS_SSQM = 1 * MiB + 512 * 1024;
constexpr size_t WS_DT = 2 * MiB, WS_SSQSSD = 5 * MiB, WS_SSQP1 = 8 * MiB, WS_SSQP2 = 9 * MiB + 512 * 1024, WS_SSQP3 = 11 * MiB;
constexpr size_t WS_WIN = 13 * MiB, WS_WKV = 36 * MiB, WS_WSSD = 40 * MiB, WS_WHG = 44 * MiB, WS_WOUT = 46 * MiB, WS_WCQ = 48 * MiB, WS_WCO = 50 * MiB, WS_WGU = 52 * MiB, WS_WDN = 63 * MiB;
constexpr size_t WS_XB = 69 * MiB, WS_MNB = 102 * MiB, WS_KB = 106 * MiB, WS_VT = 110 * MiB;
constexpr size_t SLOT = 33 * MiB, SLOT_ELEMS = (size_t)T * 1024;
constexpr size_t WS_PROJ = 114 * MiB;
constexpr size_t WS_YG = WS_PROJ + 11 * SLOT, WS_ON = WS_YG + 2 * SLOT, WS_END = WS_ON + SLOT;
static_assert(SLOT == SLOT_ELEMS * 2, "slot size");
static_assert(WS_WIN + (size_t)NPROJ * 1024 * 2 <= WS_WKV && WS_WGU + (size_t)2 * FFN * 1024 * 2 <= WS_WDN && WS_WDN + (size_t)1024 * FFN * 2 <= WS_XB && WS_SSQP3 + (size_t)T * 64 <= WS_WIN, "d_ws map");
static_assert(WS_DT + (size_t)T * 128 <= WS_SSQSSD && WS_SSQSSD + (size_t)T * 128 <= WS_SSQP1 && WS_SSQP1 + (size_t)T * 64 <= WS_SSQP2 && WS_SSQP2 + (size_t)T * 64 <= WS_SSQP3, "d_ws map 2");
enum { S_Z0 = 0, S_Z1 = 1, S_X0 = 2, S_X1 = 3, S_X2 = 4, S_Q = 5, S_F = 6, S_I = 7, S_HG = 8, S_GS = 9, S_GH = 10 };
constexpr size_t WS_MERGED = WS_PROJ + S_Q * SLOT, WS_HB = WS_PROJ + S_F * SLOT, WS_QB = WS_PROJ + S_I * SLOT, WS_OB = WS_PROJ + S_HG * SLOT, WS_ACT = WS_PROJ;
static_assert((size_t)T * FFN * 2 <= 3 * SLOT, "act overlay");
constexpr size_t O_Y = 0, O_SSMP = (size_t)T * 1024, O_CONVP = O_SSMP + 2097152, O_HGP = O_CONVP + 73728, O_MKP = O_HGP + 1048576, O_MVP = O_MKP + 2097152,
                 O_SSMS = O_MVP + 2097152, O_CONVS = O_SSMS + 33554432, O_HGS = O_CONVS + 1179648, O_END = O_HGS + 16777216;
constexpr int CW_QUEUE = 64;
constexpr int CW_BAR = 4096;
constexpr int RING_OFF = 0, RING_BYTES = 131072;
constexpr int LDS_BYTES = 147456;
constexpr int LDSCTL_OFF = LDS_BYTES - 1024, MISC_OFF = LDSCTL_OFF + 320;
struct Frame {
    LAS unsigned char* lds;
    volatile LAS unsigned* MISC;
    gu32* ctl;
    int tid, lane, wave;
    int vcu, G;
    const float* in[32];
    float* out; unsigned char* ws;
};
__device__ __forceinline__ float bf2f(unsigned v16) { return __uint_as_float(v16 << 16); }
__device__ __forceinline__ f32x4 ld_nt(const float* p) { return __builtin_nontemporal_load((const f32x4*)p); }
__device__ __forceinline__ void st_nt(float* p, f32x4 v) { __builtin_nontemporal_store(v, (f32x4*)p); }
__device__ __forceinline__ v4u ld_nt16(const void* p) { return __builtin_nontemporal_load((const v4u*)p); }
__device__ __forceinline__ unsigned ld_nt4(const void* p) { return __builtin_nontemporal_load((const unsigned*)p); }
__device__ __forceinline__ float sigmoid_f(float x) { return __builtin_amdgcn_rcpf(1.0f + __expf(-x)); }
__device__ __forceinline__ float silu_f(float x) { return x * sigmoid_f(x); }
__device__ __forceinline__ float wave_sum(float v) {
#pragma unroll
    for (int o = 1; o < 64; o <<= 1) v += __shfl_xor(v, o);
    return v;
}
__device__ __forceinline__ float wave_max(float v) {
#pragma unroll
    for (int o = 1; o < 64; o <<= 1) v = fmaxf(v, __shfl_xor(v, o));
    return v;
}
struct TSrc { const float* W; const float* W2; const float* ks; int ldw; int mode; };
__device__ __forceinline__ void p0_transpose_item(const TSrc& s, int K, int N, bf16* WT, LAS unsigned short* scr, int item, int lane) {
    const int nblk = N / 64, kb = item / nblk, nb = item % nblk, k0 = 64 * kb, n0 = 64 * nb;
    const int kr = lane >> 4, nq = lane & 15;
    const float* const Wa = s.W; const float* const Wb = s.W2;
    const float* src; int c0, cs; bool zero = false;
    if (s.mode == 2) { const float* wsel = Wa; if (nq >= 8) wsel = Wb; src = wsel + (n0 >> 1) + 4 * (nq & 7); c0 = 8 * (nq & 7) + (nq >> 3); cs = 2; }
    else { const int n = n0 + 4 * nq; c0 = 4 * nq; cs = 1;
        if (s.mode == 0) src = Wa + n;
        else if (s.mode == 1) { if (n < 5120) src = Wa + n; else if (n < 11264) src = Wa + n + 32; else if (n < 11296) src = Wa + 5120 + (n - 11264); else { src = Wa; zero = true; } }
        else { src = Wa + n; if (n >= 1024) src = Wb + (n - 1024); } }
    f32x4 v[16];
#pragma unroll
    for (int i = 0; i < 16; ++i) v[i] = zero ? (f32x4){0.f, 0.f, 0.f, 0.f} : ld_nt(src + (size_t)(k0 + 4 * i + kr) * s.ldw);
#pragma unroll
    for (int i = 0; i < 16; ++i) { const int kk = 4 * i + kr; const float sc = s.ks ? s.ks[k0 + kk] : 1.0f; const unsigned w0 = pk2(v[i].x * sc, v[i].y * sc), w1 = pk2(v[i].z * sc, v[i].w * sc);
        LAS unsigned short* d = scr + kk * 66 + c0;
        if (cs == 1) { *(LAS unsigned*)d = w0; *(LAS unsigned*)(d + 2) = w1; }
        else { d[0] = (unsigned short)(w0 & 0xffffu); d[2] = (unsigned short)(w0 >> 16); d[4] = (unsigned short)(w1 & 0xffffu); d[6] = (unsigned short)(w1 >> 16); } }
    LDS_WAIT(); asm volatile("" ::: "memory");
    const int nr = lane >> 3, kc = lane & 7;
#pragma unroll
    for (int j = 0; j < 8; ++j) { const int n = 8 * j + nr; const LAS unsigned short* p = scr + (8 * kc) * 66 + n;
        v4u o; o.x = (unsigned)p[0] | ((unsigned)p[66] << 16); o.y = (unsigned)p[2 * 66] | ((unsigned)p[3 * 66] << 16); o.z = (unsigned)p[4 * 66] | ((unsigned)p[5 * 66] << 16); o.w = (unsigned)p[6 * 66] | ((unsigned)p[7 * 66] << 16);
        *(v4u*)(WT + (size_t)(n0 + n) * K + k0 + 8 * kc) = o; }
    LDS_WAIT(); asm volatile("" ::: "memory");
}
__device__ __forceinline__ void rows4_to_bf16_ssq(const float* x0, bf16* o0, float* ssq0, int lane) {
    f32x4 v[4][4];
#pragma unroll
    for (int rr = 0; rr < 4; ++rr)
#pragma unroll
        for (int j = 0; j < 4; ++j) v[rr][j] = ld_nt(x0 + rr * 1024 + 4 * (64 * j + lane));
#pragma unroll
    for (int rr = 0; rr < 4; ++rr) { float sq = 0.f;
#pragma unroll
        for (int j = 0; j < 4; ++j) sq += (v[rr][j].x * v[rr][j].x + v[rr][j].y * v[rr][j].y) + (v[rr][j].z * v[rr][j].z + v[rr][j].w * v[rr][j].w);
        sq = wave_sum(sq);
        unsigned long long* o8 = (unsigned long long*)(o0 + rr * 1024) + lane;
#pragma unroll
        for (int j = 0; j < 4; ++j) o8[64 * j] = (unsigned long long)pk2(v[rr][j].x, v[rr][j].y) | ((unsigned long long)pk2(v[rr][j].z, v[rr][j].w) << 32);
        if (lane == 0) ssq0[rr] = sq; }
}
__device__ __forceinline__ void p0_prologue(Frame& F) {
    LAS unsigned short* scr = (LAS unsigned short*)(F.lds + RING_OFF + F.wave * 16384);
    const int gw = F.vcu * NWAVES + F.wave, NGW = F.G * NWAVES;
    unsigned char* ws = F.ws;
    constexpr int I_IN = 16 * (NPROJ / 64), I_KV = 16 * 32, I_SSD = 32 * 16, I_SQ = 16 * 16, I_GU = 16 * (2 * FFN / 64), I_DN = (FFN / 64) * 16;
    constexpr int NITEMS = I_IN + I_KV + I_SSD + 4 * I_SQ + I_GU + I_DN;
    for (int it = gw; it < NITEMS; it += NGW) {
        int r = it;
        if (r < I_IN) { TSrc s{F.in[9], nullptr, F.in[8], 11296, 1}; p0_transpose_item(s, 1024, NPROJ, (bf16*)(ws + WS_WIN), scr, r, F.lane); continue; } r -= I_IN;
        if (r < I_KV) { TSrc s{F.in[24], F.in[25], F.in[22], 1024, 3}; p0_transpose_item(s, 1024, 2048, (bf16*)(ws + WS_WKV), scr, r, F.lane); continue; } r -= I_KV;
        if (r < I_SSD) { TSrc s{F.in[16], nullptr, F.in[15], 1024, 0}; p0_transpose_item(s, 2048, 1024, (bf16*)(ws + WS_WSSD), scr, r, F.lane); continue; } r -= I_SSD;
        if (r < I_SQ) { TSrc s{F.in[19], nullptr, F.in[18], 1024, 0}; p0_transpose_item(s, 1024, 1024, (bf16*)(ws + WS_WHG), scr, r, F.lane); continue; } r -= I_SQ;
        if (r < I_SQ) { TSrc s{F.in[20], nullptr, nullptr, 1024, 0}; p0_transpose_item(s, 1024, 1024, (bf16*)(ws + WS_WOUT), scr, r, F.lane); continue; } r -= I_SQ;
        if (r < I_SQ) { TSrc s{F.in[23], nullptr, F.in[21], 1024, 0}; p0_transpose_item(s, 1024, 1024, (bf16*)(ws + WS_WCQ), scr, r, F.lane); continue; } r -= I_SQ;
        if (r < I_SQ) { TSrc s{F.in[26], nullptr, nullptr, 1024, 0}; p0_transpose_item(s, 1024, 1024, (bf16*)(ws + WS_WCO), scr, r, F.lane); continue; } r -= I_SQ;
        if (r < I_GU) { TSrc s{F.in[28], F.in[29], F.in[27], FFN, 2}; p0_transpose_item(s, 1024, 2 * FFN, (bf16*)(ws + WS_WGU), scr, r, F.lane); continue; } r -= I_GU;
        { TSrc s{F.in[30], nullptr, nullptr, 1024, 0}; p0_transpose_item(s, FFN, 1024, (bf16*)(ws + WS_WDN), scr, r, F.lane); }
    }
    bf16* XB = (bf16*)(ws + WS_XB); float* SSQX = (float*)(ws + WS_SSQX);
    for (int m4 = gw; m4 < T / 4; m4 += NGW) { const int m = 4 * m4;
        rows4_to_bf16_ssq(m < TP ? F.in[0] + (size_t)m * DM : F.in[1] + (size_t)(m - TP) * DM, XB + (size_t)m * DM, SSQX + m, F.lane); }
    bf16* MNB = (bf16*)(ws + WS_MNB); float* SSQM = (float*)(ws + WS_SSQM);
    for (int m4 = gw; m4 < MEMR / 4; m4 += NGW) { const int m = 4 * m4; rows4_to_bf16_ssq(F.in[2] + (size_t)m * DM, MNB + (size_t)m * DM, SSQM + m, F.lane); }
}
__device__ __forceinline__ void conv_copy_unit(Frame& F, int gb) {
    const bf16* PROJ = (const bf16*)(F.ws + WS_PROJ);
    const bool prompt = gb < NBP; const int sb = gb - NBP;
    const size_t row0 = prompt ? (size_t)gb * SEQ + (SEQ - 3) : (size_t)TP + (size_t)sb * LS + 1;
    float* dst = prompt ? F.out + O_CONVP + (size_t)gb * 3 * 3072 : F.out + O_CONVS + (size_t)sb * 3 * 3072;
    for (int e = F.tid; e < 3 * 3072; e += NTHR) { const int j = e / 3072, col = e % 3072;
        dst[e] = bf2f(PROJ[(size_t)(S_X0 + (col >> 10)) * SLOT_ELEMS + (row0 + j) * 1024 + (col & 1023)]); }
}
__device__ __forceinline__ void ssdnorm_phase(Frame& F) {
    const int gw = F.vcu * NWAVES + F.wave, NGW = F.G * NWAVES; bf16* YG = (bf16*)(F.ws + WS_YG); const float* SSQ = (const float*)(F.ws + WS_SSQSSD);
    for (int row = gw; row < T; row += NGW) {
        const f32x4* sp = (const f32x4*)(SSQ + (size_t)row * 32);
#pragma unroll
        for (int j = 0; j < 4; ++j) { const f32x4 a = sp[2 * j], b = sp[2 * j + 1]; const float s = ((a.x + a.y) + (a.z + a.w)) + ((b.x + b.y) + (b.z + b.w)); const float rs = 1.0f / sqrtf(s * (1.0f / 512.0f) + EPS);
            v4u* p = (v4u*)(YG + (size_t)row * 2048) + j * 64 + F.lane; const v4u w = *p; v4u o;
#pragma unroll
            for (int e = 0; e < 4; ++e) o[e] = pk2(bf2f(w[e] & 0xffffu) * rs, bf2f(w[e] >> 16) * rs);
            *p = o; }
    }
}
typedef float f32x16 __attribute__((ext_vector_type(16)));
#define MFMA32(a, b, c) __builtin_amdgcn_mfma_f32_32x32x16_bf16((a), (b), (c), 0, 0, 0)
__device__ __forceinline__ unsigned cvtpk_c(float lo, float hi) { return pk2(lo, hi); }
__device__ __forceinline__ bf16x8 pack8(float a0, float a1, float a2, float a3, float a4, float a5, float a6, float a7) {
    v4u w; w.x = cvtpk_c(a0, a1); w.y = cvtpk_c(a2, a3); w.z = cvtpk_c(a4, a5); w.w = cvtpk_c(a6, a7); return __builtin_bit_cast(bf16x8, w); }
#define ACC_FRAG(x, s) pack8((x)[8 * (s)], (x)[8 * (s) + 1], (x)[8 * (s) + 2], (x)[8 * (s) + 3], (x)[8 * (s) + 4], (x)[8 * (s) + 5], (x)[8 * (s) + 6], (x)[8 * (s) + 7])
__device__ __forceinline__ bf16x8 lds_frag16(const LAS unsigned char* p) { return *(const LAS bf16x8*)p; }
__device__ __forceinline__ bf16x8 lds_frag8x2(const LAS unsigned char* p) { const v2u lo = *(const LAS v2u*)p, hi = *(const LAS v2u*)(p + 16);
    const v4u w = (v4u){lo.x, lo.y, hi.x, hi.y}; return __builtin_bit_cast(bf16x8, w); }
#define LDS_BARRIER() do { asm volatile("s_waitcnt lgkmcnt(0)" ::: "memory"); __builtin_amdgcn_s_barrier(); asm volatile("" ::: "memory"); } while (0)
constexpr size_t WS_BCS = WS_END, WS_BTT = WS_BCS + (size_t)TP * 1024 * 2, WS_END2 = WS_BTT + (size_t)NBP * 32 * 4 * 128 * 64 * 2;
__device__ __forceinline__ void bc_prep_unit(Frame& F, int b, int c) {
    typedef float f32x2 __attribute__((ext_vector_type(2)));
    int tid_o = F.tid; asm volatile("" : "+v"(tid_o));
    const int tid = tid_o, cg = tid & 127, seg = tid >> 7; unsigned char* ws = F.ws;
    const bf16* src = (const bf16*)(ws + WS_PROJ) + (size_t)S_X2 * SLOT_ELEMS + (size_t)b * SEQ * 1024 + 8 * cg;
    bf16* BCS = (bf16*)(ws + WS_BCS); bf16* BTT = (bf16*)(ws + WS_BTT);
    const float* cw = F.in[10] + 2048 + 8 * cg; const float* cbp = F.in[11] + 2048 + 8 * cg;
#pragma unroll 1
    for (int half = 0; half < 2; ++half) {
        const int s0 = 16 * seg + 8 * half;
        v4u raw[11];
#pragma unroll
        for (int i = 0; i < 11; ++i) { const int gt = 64 * c + s0 - 3 + i; raw[i] = (v4u){0u, 0u, 0u, 0u}; if (gt >= 0) raw[i] = ld_nt16(src + (size_t)gt * 1024); }
        v4u rowpk[8];
#pragma unroll
        for (int kp = 0; kp < 4; ++kp) {
            const f32x2 cw0 = *(const f32x2*)(cw + 2 * kp), cw1 = *(const f32x2*)(cw + 3072 + 2 * kp), cw2 = *(const f32x2*)(cw + 2 * 3072 + 2 * kp), cw3 = *(const f32x2*)(cw + 3 * 3072 + 2 * kp), cbb = *(const f32x2*)(cbp + 2 * kp);
            f32x2 xv[11];
#pragma unroll
            for (int i = 0; i < 11; ++i) { const unsigned wd = raw[i][kp]; xv[i] = (f32x2){__uint_as_float(wd << 16), __uint_as_float(wd & 0xffff0000u)}; }
            f32x2 o[8];
#pragma unroll
            for (int i = 0; i < 8; ++i) { f32x2 a = cw0 * xv[i] + cbb; a = cw1 * xv[i + 1] + a; a = cw2 * xv[i + 2] + a; a = cw3 * xv[i + 3] + a;
                const f32x2 t = a * (-1.4426950408889634f); f32x2 e; e.x = __builtin_amdgcn_exp2f(t.x); e.y = __builtin_amdgcn_exp2f(t.y); e = e + 1.0f;
                f32x2 rc; rc.x = __builtin_amdgcn_rcpf(e.x); rc.y = __builtin_amdgcn_rcpf(e.y); o[i] = a * rc; }
#pragma unroll
            for (int i = 0; i < 8; ++i) rowpk[i][kp] = pk2(o[i].x, o[i].y);
            if (cg < 64) { const int ng = 8 * cg + 2 * kp, g = ng >> 7, n = ng & 127;
                bf16* dst = BTT + ((size_t)(((b * 32 + c) * 4 + g) * 128 + n)) * 64 + s0;
                v4u pa; pa.x = pk2(o[0].x, o[1].x); pa.y = pk2(o[2].x, o[3].x); pa.z = pk2(o[4].x, o[5].x); pa.w = pk2(o[6].x, o[7].x); *(v4u*)dst = pa;
                v4u pb; pb.x = pk2(o[0].y, o[1].y); pb.y = pk2(o[2].y, o[3].y); pb.z = pk2(o[4].y, o[5].y); pb.w = pk2(o[6].y, o[7].y); *(v4u*)(dst + 64) = pb; }
        }
        bf16* drow = BCS + ((size_t)b * SEQ + 64 * c + s0) * 1024 + 8 * cg;
#pragma unroll
        for (int i = 0; i < 8; ++i) *(v4u*)(drow + (size_t)i * 1024) = rowpk[i];
    }
}
__device__ __forceinline__ void bc_prep_phase(Frame& F) { for (int u = F.vcu; u < NBP * 32; u += F.G) bc_prep_unit(F, u >> 5, u & 31); }
constexpr size_t WS_HVT = WS_XB, WS_EGM = WS_END2, WS_EGL = WS_EGM + (size_t)NBP * 64 * 1024 * 4, WS_END3 = WS_EGL + (size_t)NBP * 64 * 1024 * 4;
__device__ __forceinline__ void hg_prep_unit(Frame& F, int b, int c) {
    typedef float f32x2 __attribute__((ext_vector_type(2)));
    int tid_o = F.tid; asm volatile("" : "+v"(tid_o));
    const int tid = tid_o; unsigned char* ws = F.ws;
    const int ch = 2 * tid;
    const size_t row0 = (size_t)b * SEQ + 32 * c;
    bf16* QS = (bf16*)(ws + WS_PROJ) + (size_t)S_Q * SLOT_ELEMS + row0 * 1024 + ch; bf16* FS = (bf16*)(ws + WS_PROJ) + (size_t)S_F * SLOT_ELEMS + row0 * 1024 + ch;
    const f32x2 l0 = *(const f32x2*)(F.in[17] + ch), l1 = *(const f32x2*)(F.in[17] + 1024 + ch);
    f32x2 lb; lb.x = __builtin_amdgcn_rcpf(1.0f + __expf(l1.x - l0.x)); lb.y = __builtin_amdgcn_rcpf(1.0f + __expf(l1.y - l0.y));
    const f32x2 omlb = 1.0f - lb;
    f32x2 P[32]; f32x2 run = (f32x2){1.0f, 1.0f};
#pragma unroll
    for (int t = 0; t < 32; ++t) { const unsigned wd = ld_nt4(FS + (size_t)t * 1024);
        f32x2 u = (f32x2){__uint_as_float(wd << 16), __uint_as_float(wd & 0xffff0000u)}; u.x = fminf(fmaxf(u.x, -30.f), 30.f); u.y = fminf(fmaxf(u.y, -30.f), 30.f);
        const f32x2 tt = u * (-1.4426950408889634f); f32x2 e; e.x = __builtin_amdgcn_exp2f(tt.x); e.y = __builtin_amdgcn_exp2f(tt.y); e = e + 1.0f;
        f32x2 sg; sg.x = __builtin_amdgcn_rcpf(e.x); sg.y = __builtin_amdgcn_rcpf(e.y);
        const f32x2 fg = lb + omlb * sg; run = run * fg; run.x = fmaxf(run.x, 1e-30f); run.y = fmaxf(run.y, 1e-30f); P[t] = run; }
    const f32x2 Pm = P[15], Pl = P[31]; f32x2 rPm; rPm.x = __builtin_amdgcn_rcpf(Pm.x); rPm.y = __builtin_amdgcn_rcpf(Pm.y);
    *(f32x2*)((float*)(ws + WS_EGM) + (size_t)(b * 64 + c) * 1024 + ch) = Pm; *(f32x2*)((float*)(ws + WS_EGL) + (size_t)(b * 64 + c) * 1024 + ch) = Pl * rPm;
    f32x2 rPprev = (f32x2){1.0f, 1.0f};
#pragma unroll
    for (int t = 0; t < 32; ++t) { f32x2 rP; rP.x = __builtin_amdgcn_rcpf(P[t].x); rP.y = __builtin_amdgcn_rcpf(P[t].y);
        const f32x2 e1 = P[t] * rPm, e2 = Pm * rP, fg = P[t] * rPprev, kk = 1.0f - fg; rPprev = rP;
        const unsigned qw = ld_nt4(QS + (size_t)t * 1024); const f32x2 q = (f32x2){__uint_as_float(qw << 16), __uint_as_float(qw & 0xffff0000u)};
        const f32x2 tq = q * (-1.4426950408889634f); f32x2 eq; eq.x = __builtin_amdgcn_exp2f(tq.x); eq.y = __builtin_amdgcn_exp2f(tq.y); eq = eq + 1.0f;
        f32x2 rq; rq.x = __builtin_amdgcn_rcpf(eq.x); rq.y = __builtin_amdgcn_rcpf(eq.y);
        const f32x2 qa = q * rq * e1, ka = kk * e2;
        *(unsigned*)(QS + (size_t)t * 1024) = pk2(qa.x, qa.y); *(unsigned*)(FS + (size_t)t * 1024) = pk2(ka.x, ka.y); }
}
__device__ __forceinline__ void hg_prep_phase(Frame& F) { for (int u = F.vcu; u < NBP * 64; u += F.G) hg_prep_unit(F, u >> 6, u & 63); }
constexpr int HV_QA = 0, HV_KA = 8704, HV_KAT = 17408, HV_VT = 27648, HV_EGM = 30208, HV_EGL = 30720, HV_PBUF = 31232, HV_OB = 2 * HV_PBUF, HV_OBUF = 23040;
constexpr size_t WS_SSQH = WS_END3, WS_END4 = WS_SSQH + (size_t)T * 32 * 4;
__device__ __forceinline__ void hgrn_v_unit(Frame& F, int b, int hd, int vt) {
    int tid_o = F.tid; asm volatile("" : "+v"(tid_o));
    const int tid = tid_o, lane = tid & 63, w = F.wave, r = lane & 31, hh = lane >> 5; unsigned char* ws = F.ws;
    LAS unsigned char* Lb = F.lds + RING_OFF;
    const bf16* PROJ = (const bf16*)(ws + WS_PROJ); bf16* OU = (bf16*)(ws + WS_ON); float* SSQH = (float*)(ws + WS_SSQH);
    const size_t rowb = (size_t)b * SEQ;
    const int pt_t = tid & 31, pt_g = tid >> 5;
    const bf16* qsrc = PROJ + (size_t)S_Q * SLOT_ELEMS + (rowb + pt_t) * 1024 + hd * 128 + 8 * pt_g;
    const bf16* ksrc = PROJ + (size_t)S_F * SLOT_ELEMS + (rowb + pt_t) * 1024 + hd * 128 + 8 * pt_g;
    const unsigned char* xsrc = nullptr; size_t xstr = 0;
    if (tid < 128) { xsrc = (const unsigned char*)(PROJ + (size_t)S_I * SLOT_ELEMS + (rowb + pt_t) * 1024 + hd * 128 + 32 * vt + 8 * pt_g); xstr = (size_t)32 * 1024 * 2; }
    else if (tid < 160) { xsrc = (const unsigned char*)((const float*)(ws + WS_EGM) + (size_t)b * 64 * 1024 + hd * 128 + 4 * (tid - 128)); xstr = 4096; }
    else if (tid < 192) { xsrc = (const unsigned char*)((const float*)(ws + WS_EGL) + (size_t)b * 64 * 1024 + hd * 128 + 4 * (tid - 160)); xstr = 4096; }
    const int o_img = pt_t * 272 + 16 * pt_g, o_tr = (8 * pt_g) * 80 + 2 * pt_t;
#define HGV_LOAD(cc, pq, pk, px) { pq = *(const v4u*)(qsrc + (size_t)(cc) * 32 * 1024); pk = *(const v4u*)(ksrc + (size_t)(cc) * 32 * 1024); if (tid < 192) px = *(const v4u*)(xsrc + (size_t)(cc) * xstr); }
#define HGV_TR(dst, v) { _Pragma("unroll") for (int e = 0; e < 8; ++e) *(LAS unsigned short*)((dst) + 80 * e) = (unsigned short)(((v)[e >> 1] >> (16 * (e & 1))) & 0xffffu); }
#define HGV_STORE(pb, pq, pk, px) { *(LAS v4u*)((pb) + HV_QA + o_img) = pq; *(LAS v4u*)((pb) + HV_KA + o_img) = pk; HGV_TR((pb) + HV_KAT + o_tr, pk) \
        if (tid < 128) { HGV_TR((pb) + HV_VT + o_tr, px) } else if (tid < 160) { *(LAS v4u*)((pb) + HV_EGM + 16 * (tid - 128)) = px; } else if (tid < 192) { *(LAS v4u*)((pb) + HV_EGL + 16 * (tid - 160)) = px; } }
    v4u pqA, pkA, pxA = (v4u){0u, 0u, 0u, 0u}, pqB, pkB, pxB = (v4u){0u, 0u, 0u, 0u};
    HGV_LOAD(0, pqA, pkA, pxA) HGV_STORE(Lb, pqA, pkA, pxA)
    HGV_LOAD(1, pqA, pkA, pxA) HGV_LOAD(2, pqB, pkB, pxB)
    const int kt = w;
    v2u ow_pend = (v2u){0u, 0u}; float sq_pend = 0.f;
    f32x16 S;
#pragma unroll
    for (int i = 0; i < 16; ++i) S[i] = 0.f;
    __syncthreads();
#define HGV_ITER(c, pq, pk, px) { \
        int r_l = r, hh_l = hh, tid_l = tid; asm volatile("" : "+v"(r_l), "+v"(hh_l), "+v"(tid_l)); \
        { const int r = r_l, hh = hh_l, tid = tid_l; \
        LAS unsigned char* pbc = Lb + ((c) & 1) * HV_PBUF; LAS unsigned char* pbn = Lb + (((c) + 1) & 1) * HV_PBUF; \
        if ((c) < 63) { HGV_STORE(pbn, pq, pk, px) if ((c) < 61) HGV_LOAD((c) + 3, pq, pk, px) } \
        if (w < 4) { \
            LAS float* EGM = (LAS float*)(pbc + HV_EGM); LAS float* EGL = (LAS float*)(pbc + HV_EGL); LAS float* OB = (LAS float*)(Lb + HV_OB + ((c) & 1) * HV_OBUF); \
            _Pragma("unroll") \
            for (int q4 = 0; q4 < 4; ++q4) { const f32x4 e0 = *(const LAS f32x4*)(EGM + 32 * kt + 8 * q4 + 4 * hh); \
                _Pragma("unroll") \
                for (int j = 0; j < 4; ++j) S[4 * q4 + j] *= e0[j]; } \
            f32x16 o; \
            _Pragma("unroll") \
            for (int i = 0; i < 16; ++i) o[i] = 0.f; \
            const LAS unsigned char* qa_row = pbc + HV_QA + r * 272; \
            o = MFMA32(lds_frag8x2(qa_row + (32 * kt + 4 * hh) * 2), ACC_FRAG(S, 0), o); \
            o = MFMA32(lds_frag8x2(qa_row + (32 * kt + 16 + 4 * hh) * 2), ACC_FRAG(S, 1), o); \
            LAS float* ob = OB + (kt * 32) * 36 + r; \
            _Pragma("unroll") \
            for (int i = 0; i < 16; ++i) ob[((i & 3) + 8 * (i >> 2) + 4 * hh) * 36] = o[i]; \
            const LAS unsigned char* kat_nat = pbc + HV_KAT + (32 * kt + r) * 80 + hh * 16; const LAS unsigned char* vt_nat = pbc + HV_VT + r * 80 + hh * 16; \
            S = MFMA32(lds_frag16(kat_nat), lds_frag16(vt_nat), S); S = MFMA32(lds_frag16(kat_nat + 32), lds_frag16(vt_nat + 32), S); \
            _Pragma("unroll") \
            for (int q4 = 0; q4 < 4; ++q4) { const f32x4 e0 = *(const LAS f32x4*)(EGL + 32 * kt + 8 * q4 + 4 * hh); \
                _Pragma("unroll") \
                for (int j = 0; j < 4; ++j) S[4 * q4 + j] *= e0[j]; } \
        } else { \
            if (w == 4) { LAS float* OB = (LAS float*)(Lb + HV_OB + ((c) & 1) * HV_OBUF); f32x16 o; \
                _Pragma("unroll") \
                for (int i = 0; i < 16; ++i) o[i] = 0.f; \
                f32x16 X; \
                _Pragma("unroll") \
                for (int i = 0; i < 16; ++i) X[i] = 0.f; \
                const LAS unsigned char* ka_nat = pbc + HV_KA + r * 272 + hh * 16; const LAS unsigned char* qa_nat = pbc + HV_QA + r * 272 + hh * 16; \
                _Pragma("unroll 2") \
                for (int ks = 0; ks < 8; ++ks) X = MFMA32(lds_frag16(ka_nat + ks * 32), lds_frag16(qa_nat + ks * 32), X); \
                _Pragma("unroll") \
                for (int i = 0; i < 16; ++i) { const int srow = (i & 3) + 8 * (i >> 2) + 4 * hh; X[i] = (srow <= r) ? X[i] : 0.f; } \
                const LAS unsigned char* vt_row = pbc + HV_VT + r * 80; \
                o = MFMA32(ACC_FRAG(X, 0), lds_frag8x2(vt_row + (4 * hh) * 2), o); \
                o = MFMA32(ACC_FRAG(X, 1), lds_frag8x2(vt_row + (16 + 4 * hh) * 2), o); \
                LAS float* ob4 = OB + (4 * 32) * 36 + r; \
                _Pragma("unroll") \
                for (int i = 0; i < 16; ++i) ob4[((i & 3) + 8 * (i >> 2) + 4 * hh) * 36] = o[i]; \
            } \
            if ((c) > 1) { HGV_FLUSH((c) - 2) } \
            if ((c) > 0) { HGV_OUT((c) - 1) } \
        } \
        LDS_BARRIER(); \
        } }
#define HGV_OUT(cp) { const LAS float* OB = (const LAS float*)(Lb + HV_OB + ((cp) & 1) * HV_OBUF); const int tl = tid - 256, t = tl >> 3, v0 = (tl & 7) * 4; \
            const f32x4 a = *(const LAS f32x4*)(OB + t * 36 + v0), b2 = *(const LAS f32x4*)(OB + (32 + t) * 36 + v0), c2 = *(const LAS f32x4*)(OB + (64 + t) * 36 + v0), d2 = *(const LAS f32x4*)(OB + (96 + t) * 36 + v0), e2 = *(const LAS f32x4*)(OB + (128 + t) * 36 + v0); \
            const f32x4 o4 = ((a + b2) + (c2 + d2)) + e2; \
            float sq = (o4.x * o4.x + o4.y * o4.y) + (o4.z * o4.z + o4.w * o4.w); sq += __shfl_xor(sq, 1); sq += __shfl_xor(sq, 2); sq += __shfl_xor(sq, 4); \
            sq_pend = sq; ow_pend.x = pk2(o4.x, o4.y); ow_pend.y = pk2(o4.z, o4.w); }
#define HGV_FLUSH(cp) { const int tl = tid - 256, t = tl >> 3, v0 = (tl & 7) * 4; const size_t row = rowb + 32 * (cp) + t; \
            if ((tl & 7) == 0) SSQH[row * 32 + hd * 4 + vt] = sq_pend; *(v2u*)(OU + row * 1024 + hd * 128 + 32 * vt + v0) = ow_pend; }
#pragma unroll 1
    for (int cc = 0; cc < 64; cc += 2) { HGV_ITER(cc, pqA, pkA, pxA) HGV_ITER(cc + 1, pqB, pkB, pxB) }
    if (w >= 4) { HGV_FLUSH(62) HGV_OUT(63) HGV_FLUSH(63) }
#undef HGV_ITER
#undef HGV_OUT
#undef HGV_FLUSH
#undef HGV_LOAD
#undef HGV_STORE
#undef HGV_TR
    if (w < 4) { float* st_g = F.out + O_HGP + (size_t)(b * 8 + hd) * 16384 + 32 * vt + r;
#pragma unroll
        for (int i = 0; i < 16; ++i) { const int k = 32 * kt + (i & 3) + 8 * (i >> 2) + 4 * hh; st_g[(size_t)k * 128] = S[i]; } }
    __syncthreads();
}
__device__ __forceinline__ void hgnorm_phase(Frame& F) {
    const int gw = F.vcu * NWAVES + F.wave, NGW = F.G * NWAVES; bf16* ON = (bf16*)(F.ws + WS_ON); const float* SSQH = (const float*)(F.ws + WS_SSQH);
    const bf16* HG = (const bf16*)(F.ws + WS_PROJ) + (size_t)S_HG * SLOT_ELEMS;
    for (int row = gw; row < TP; row += NGW) {
#pragma unroll
        for (int j = 0; j < 2; ++j) { const int pc = j * 64 + F.lane, hd = pc >> 4;
            const f32x4 sp = *(const f32x4*)(SSQH + (size_t)row * 32 + hd * 4); const float rs = __builtin_amdgcn_rsqf(((sp.x + sp.y) + (sp.z + sp.w)) * (1.0f / 128.0f) + EPS);
            v4u* p = (v4u*)(ON + (size_t)row * 1024) + pc; const v4u o = *p; const v4u g = ld_nt16((const v4u*)(HG + (size_t)row * 1024) + pc); v4u res;
#pragma unroll
            for (int e = 0; e < 4; ++e) res[e] = pk2(bf2f(o[e] & 0xffffu) * rs * silu_f(bf2f(g[e] & 0xffffu)), __uint_as_float(o[e] & 0xffff0000u) * rs * silu_f(__uint_as_float(g[e] & 0xffff0000u)));
            *p = res; }
    }
}
constexpr int SD_BN = 0, SD_CN = 17408, SD_BT = 34816, SD_XT = 53248, SD_HT = 62464, SD_YA = 97280, SD_YY = 113664, SD_YO = 130048, SD_CUM = 134144, SD_DTV = 134400, SD_ECUM = 134656, SD_XWT = 134912, SD_CWL = 144128;
__device__ __forceinline__ void ssd_unit_mfma(Frame& F, int gb, int h) {
    int tid_o = F.tid; asm volatile("" : "+v"(tid_o));
    const int tid = tid_o, lane = tid & 63, w = F.wave, r = lane & 31, hh = lane >> 5; unsigned char* ws = F.ws;
    const int L = SEQ; const size_t row_base = (size_t)gb * SEQ;
    const int g = h >> 3;
    LAS unsigned char* Lb = F.lds + RING_OFF;
    LAS unsigned short* BN = (LAS unsigned short*)(Lb + SD_BN); LAS unsigned short* CN = (LAS unsigned short*)(Lb + SD_CN);
    LAS unsigned short* BT = (LAS unsigned short*)(Lb + SD_BT); LAS unsigned short* XT = (LAS unsigned short*)(Lb + SD_XT);
    LAS unsigned short* HT = (LAS unsigned short*)(Lb + SD_HT);
    LAS unsigned short* XWT = (LAS unsigned short*)(Lb + SD_XWT);
    LAS float* YA = (LAS float*)(Lb + SD_YA); LAS float* YY = (LAS float*)(Lb + SD_YY); LAS unsigned short* YO = (LAS unsigned short*)(Lb + SD_YO);
    LAS float* CUM = (LAS float*)(Lb + SD_CUM); LAS float* DTV = (LAS float*)(Lb + SD_DTV); LAS float* ECUM = (LAS float*)(Lb + SD_ECUM);
    const bf16* PROJ = (const bf16*)(ws + WS_PROJ); const float* DTR = (const float*)(ws + WS_DT); bf16* YG = (bf16*)(ws + WS_YG); float* SSQ = (float*)(ws + WS_SSQSSD);
    const int nt = w >> 1, pt = w & 1;
    f32x16 H;
    float* st_g = F.out + O_SSMP + (size_t)(gb * 32 + h) * 8192 + (size_t)(32 * pt + r) * 128 + 32 * nt + 4 * hh;
#pragma unroll
    for (int i = 0; i < 16; ++i) H[i] = 0.f;
    {
        LAS unsigned short* hp = HT + (32 * pt + r) * 136 + 32 * nt + 4 * hh;
#pragma unroll
        for (int q4 = 0; q4 < 4; ++q4) { v2u pk; pk.x = cvtpk_c(H[4 * q4], H[4 * q4 + 1]); pk.y = cvtpk_c(H[4 * q4 + 2], H[4 * q4 + 3]); *(LAS v2u*)(hp + 8 * q4) = pk; }
    }
    const float a = -__expf(F.in[13][h]), dtb = F.in[12][h], Dk = F.in[14][h];
    const float* cw = F.in[10]; const float* cbp = F.in[11];
    const int cgl = tid & 7, xs = tid >> 3;
    const int col = h * 64 + 8 * cgl;
    const bf16* cptr = PROJ + (size_t)(S_X0 + (col >> 10)) * SLOT_ELEMS + row_base * 1024 + (col & 1023);
    const bf16* BCS = (const bf16*)(ws + WS_BCS) + row_base * 1024 + g * 128; const bf16* BTT = (const bf16*)(ws + WS_BTT) + (size_t)(gb * 32 * 4 + g) * 128 * 64;
    v4u xr[4], pc[6];
#pragma unroll
    for (int i = 0; i < 4; ++i) { const int gt = xs - 3 + i; xr[i] = (v4u){0u, 0u, 0u, 0u}; if (gt >= 0) xr[i] = *(const v4u*)(cptr + (size_t)gt * 1024); }
#pragma unroll
    for (int j = 0; j < 6; ++j) { const int idx = (tid + 512 * j) & 1023;
        if (j < 4) pc[j] = *(const v4u*)(BCS + (size_t)(idx >> 4) * 1024 + (j >> 1) * 512 + 8 * (idx & 15));
        else pc[j] = *(const v4u*)(BTT + (size_t)(idx >> 3) * 64 + 8 * (idx & 7)); }
    LAS float* CWL = (LAS float*)(Lb + SD_CWL);
    if (tid < 320) { const int j = tid >> 6, c = tid & 63; CWL[tid] = j < 4 ? cw[j * 3072 + h * 64 + c] : cbp[h * 64 + c]; }
    __syncthreads();
    v4u ow_pend = (v4u){0u, 0u, 0u, 0u}; float sq_pend = 0.f; bool pend = false;
    int buf = 0;
    float dt_pf = 0.f;
    if (lane < L) dt_pf = DTR[(row_base + lane) * 32 + h];
    for (int t0 = 0; t0 < L; t0 += 64, buf ^= 1) {
        int r_l = r, hh_l = hh, tid_l = tid, lane_l = lane;
        asm volatile("" : "+v"(r_l), "+v"(hh_l), "+v"(tid_l), "+v"(lane_l));
        { const int r = r_l, hh = hh_l, tid = tid_l, lane = lane_l;
        float dtv = 0.f;
        if (t0 + lane < L) { const float x = dt_pf + dtb; dtv = fmaxf(x, 0.f) + 0.6931471805599453f * __builtin_amdgcn_logf(1.0f + __builtin_amdgcn_exp2f(-1.4426950408889634f * fabsf(x))); }
        dt_pf = 0.f; if (t0 + 64 + lane < L) dt_pf = DTR[(row_base + t0 + 64 + lane) * 32 + h];
        v4u zw = (v4u){0u, 0u, 0u, 0u};
        if (t0 + (tid >> 3) < L) zw = ld_nt16(PROJ + (size_t)(S_Z0 + (h >> 4)) * SLOT_ELEMS + (row_base + t0 + (tid >> 3)) * 1024 + (h & 15) * 64 + (tid & 7) * 8);
        float cum = dtv * a;
#pragma unroll
        for (int o = 1; o < 64; o <<= 1) { const float u = __shfl_up(cum, o); if (lane >= o) cum += u; }
        const float cum_last = __shfl(cum, 63);
        const float wgt = __expf(cum_last - cum) * dtv;
        if (w == 0) { CUM[lane] = cum; DTV[lane] = dtv; ECUM[lane] = __expf(cum); }
#pragma unroll
        for (int j = 0; j < 6; ++j) { const int idx = (tid + 512 * j) & 1023;
            if (j < 2) *(LAS v4u*)(BN + (idx >> 4) * 136 + 8 * (idx & 15)) = pc[j];
            else if (j < 4) *(LAS v4u*)(CN + (idx >> 4) * 136 + 8 * (idx & 15)) = pc[j];
            else *(LAS v4u*)(BT + (idx >> 3) * 72 + 8 * (idx & 7)) = pc[j]; }
        if (pend) { const size_t prow = row_base + (t0 - 64) + (tid >> 3);
            *(v4u*)(YG + prow * 2048 + h * 64 + (tid & 7) * 8) = ow_pend; if ((tid & 7) == 0) SSQ[prow * 32 + h] = sq_pend; pend = false; }
        { const int xs = tid >> 3, cgl = tid & 7; const float wx = __shfl(wgt, xs); typedef float f32x2 __attribute__((ext_vector_type(2)));
#pragma unroll
          for (int kp = 0; kp < 4; ++kp) {
              const LAS float* wl = CWL + 8 * cgl + 2 * kp;
              const f32x2 cw0 = *(const LAS f32x2*)wl, cw1 = *(const LAS f32x2*)(wl + 64), cw2 = *(const LAS f32x2*)(wl + 128), cw3 = *(const LAS f32x2*)(wl + 192), cbb = *(const LAS f32x2*)(wl + 256);
              f32x2 xv[4];
#pragma unroll
              for (int i = 0; i < 4; ++i) { const unsigned wd = xr[i][kp]; xv[i] = (f32x2){__uint_as_float(wd << 16), __uint_as_float(wd & 0xffff0000u)}; }
              f32x2 a = cw0 * xv[0] + cbb; a = cw1 * xv[1] + a; a = cw2 * xv[2] + a; a = cw3 * xv[3] + a;
              const f32x2 t = a * (-1.4426950408889634f); f32x2 e; e.x = __builtin_amdgcn_exp2f(t.x); e.y = __builtin_amdgcn_exp2f(t.y); e = e + 1.0f;
              f32x2 rc; rc.x = __builtin_amdgcn_rcpf(e.x); rc.y = __builtin_amdgcn_rcpf(e.y); const f32x2 o = a * rc, ow = o * wx;
              const unsigned po = pk2(o.x, o.y), pw = pk2(ow.x, ow.y); const int p = 8 * cgl + 2 * kp;
              XT[p * 72 + xs] = (unsigned short)(po & 0xffffu); XT[(p + 1) * 72 + xs] = (unsigned short)(po >> 16);
              XWT[p * 72 + xs] = (unsigned short)(pw & 0xffffu); XWT[(p + 1) * 72 + xs] = (unsigned short)(pw >> 16); }
        }
        if (t0 + 64 < L) {
#pragma unroll
            for (int i = 0; i < 4; ++i) xr[i] = ld_nt16(cptr + (size_t)(t0 + 64 + (tid >> 3) - 3 + i) * 1024);
            const int chn = (t0 >> 6) + 1;
#pragma unroll
            for (int j = 0; j < 6; ++j) { const int idx = (tid + 512 * j) & 1023;
                if (j < 4) pc[j] = *(const v4u*)(BCS + (size_t)(t0 + 64 + (idx >> 4)) * 1024 + (j >> 1) * 512 + 8 * (idx & 15));
                else pc[j] = *(const v4u*)(BTT + ((size_t)chn * 4 * 128 + (idx >> 3)) * 64 + 8 * (idx & 7)); }
        }
        LDS_BARRIER();
        if (w < 3) {
            const int tt = w == 0 ? 0 : 1, st = w == 1 ? 1 : 0;
            f32x16 X, ya0, ya1;
#pragma unroll
            for (int i = 0; i < 16; ++i) { X[i] = 0.f; ya0[i] = 0.f; ya1[i] = 0.f; }
            const LAS unsigned char* cn_nat = Lb + SD_CN + (32 * tt + r) * 272 + hh * 16; const LAS unsigned char* bn_nat = Lb + SD_BN + (32 * st + r) * 272 + hh * 16;
#pragma unroll 2
            for (int ks = 0; ks < 8; ++ks) X = MFMA32(lds_frag16(bn_nat + ks * 32), lds_frag16(cn_nat + ks * 32), X);
            const float cum_t = CUM[32 * tt + r];
#pragma unroll
            for (int q4 = 0; q4 < 4; ++q4) { const f32x4 cs = *(const LAS f32x4*)(CUM + 32 * st + 8 * q4 + 4 * hh), ds = *(const LAS f32x4*)(DTV + 32 * st + 8 * q4 + 4 * hh);
#pragma unroll
                for (int jj = 0; jj < 4; ++jj) { const int s_abs = 32 * st + 8 * q4 + 4 * hh + jj; const float f = __expf(fminf(cum_t - cs[jj], 0.f)) * ds[jj]; X[4 * q4 + jj] = (s_abs <= 32 * tt + r) ? X[4 * q4 + jj] * f : 0.f; } }
            const bf16x8 xf0 = ACC_FRAG(X, 0), xf1 = ACC_FRAG(X, 1);
            const LAS unsigned char* xt_row = Lb + SD_XT + r * 144 + (32 * st + 4 * hh) * 2;
            ya0 = MFMA32(xf0, lds_frag8x2(xt_row), ya0); ya0 = MFMA32(xf1, lds_frag8x2(xt_row + 32), ya0);
            ya1 = MFMA32(xf0, lds_frag8x2(xt_row + 32 * 144), ya1); ya1 = MFMA32(xf1, lds_frag8x2(xt_row + 32 * 144 + 32), ya1);
            if (w < 2) { LAS float* yb = YA + (32 * tt + 4 * hh) * 64 + r;
#pragma unroll
                for (int i = 0; i < 16; ++i) { yb[((i & 3) + 8 * (i >> 2)) * 64] = ya0[i]; yb[((i & 3) + 8 * (i >> 2)) * 64 + 32] = ya1[i]; } }
            else { LAS unsigned short* yb = YO + (4 * hh) * 64 + r;
#pragma unroll
                for (int i = 0; i < 16; ++i) { yb[((i & 3) + 8 * (i >> 2)) * 64] = (unsigned short)f2bf(ya0[i]); yb[((i & 3) + 8 * (i >> 2)) * 64 + 32] = (unsigned short)f2bf(ya1[i]); } }
        } else if (w >= 4) {
            const int tt = (w - 4) >> 1, ptj = w & 1;
            const LAS unsigned char* ht_nat = Lb + SD_HT + buf * 17408 + (32 * ptj + r) * 272 + hh * 16;
            f32x16 yi;
#pragma unroll
            for (int i = 0; i < 16; ++i) yi[i] = 0.f;
            const LAS unsigned char* cn_nat = Lb + SD_CN + (32 * tt + r) * 272 + hh * 16;
#pragma unroll 2
            for (int ks = 0; ks < 8; ++ks) yi = MFMA32(lds_frag16(cn_nat + ks * 32), lds_frag16(ht_nat + ks * 32), yi);
            const LAS unsigned short* xt_p = XT + (32 * ptj + r) * 72 + 32 * tt + 4 * hh;
#pragma unroll
            for (int q4 = 0; q4 < 4; ++q4) { const f32x4 ec = *(const LAS f32x4*)(ECUM + 32 * tt + 8 * q4 + 4 * hh); const v2u xw = *(const LAS v2u*)(xt_p + 8 * q4);
                const float x0 = bf2f(xw.x & 0xffffu), x1 = bf2f(xw.x >> 16), x2 = bf2f(xw.y & 0xffffu), x3 = bf2f(xw.y >> 16);
                LAS float* yb = YY + (32 * tt + 8 * q4 + 4 * hh) * 64 + 32 * ptj + r;
                yb[0] = ec[0] * yi[4 * q4] + Dk * x0; yb[64] = ec[1] * yi[4 * q4 + 1] + Dk * x1; yb[128] = ec[2] * yi[4 * q4 + 2] + Dk * x2; yb[192] = ec[3] * yi[4 * q4 + 3] + Dk * x3; }
        }
        {
            const float el = __expf(CUM[63]);
#pragma unroll
            for (int i = 0; i < 16; ++i) H[i] *= el;
            const LAS unsigned char* bt_nat = Lb + SD_BT + (32 * nt + r) * 144 + hh * 16; const LAS unsigned char* xt_nat = Lb + SD_XWT + (32 * pt + r) * 144 + hh * 16;
#pragma unroll
            for (int s2 = 0; s2 < 4; ++s2) H = MFMA32(lds_frag16(bt_nat + s2 * 32), lds_frag16(xt_nat + s2 * 32), H);
            LAS unsigned short* hp = HT + (buf ^ 1) * 8704 + (32 * pt + r) * 136 + 32 * nt + 4 * hh;
#pragma unroll
            for (int q4 = 0; q4 < 4; ++q4) { v2u pk; pk.x = cvtpk_c(H[4 * q4], H[4 * q4 + 1]); pk.y = cvtpk_c(H[4 * q4 + 2], H[4 * q4 + 3]); *(LAS v2u*)(hp + 8 * q4) = pk; }
        }
        LDS_BARRIER();
        { const int tt = tid >> 3, p0 = (tid & 7) * 8;
          if (t0 + tt < L) { const size_t row = row_base + t0 + tt;
            f32x4 y0 = *(const LAS f32x4*)(YA + tt * 64 + p0) + *(const LAS f32x4*)(YY + tt * 64 + p0), y1 = *(const LAS f32x4*)(YA + tt * 64 + p0 + 4) + *(const LAS f32x4*)(YY + tt * 64 + p0 + 4);
            if (tt >= 32) { const v4u ow4 = *(const LAS v4u*)(YO + (tt - 32) * 64 + p0);
                y0 = y0 + (f32x4){bf2f(ow4.x & 0xffffu), __uint_as_float(ow4.x & 0xffff0000u), bf2f(ow4.y & 0xffffu), __uint_as_float(ow4.y & 0xffff0000u)};
                y1 = y1 + (f32x4){bf2f(ow4.z & 0xffffu), __uint_as_float(ow4.z & 0xffff0000u), bf2f(ow4.w & 0xffffu), __uint_as_float(ow4.w & 0xffff0000u)}; }
            float o[8]; float sq = 0.f;
#pragma unroll
            for (int j = 0; j < 8; ++j) { const unsigned z16 = (zw[j >> 1] >> ((j & 1) * 16)) & 0xffffu; const float yv = (j < 4 ? y0[j & 3] : y1[j & 3]) * silu_f(bf2f(z16)); o[j] = yv; sq += yv * yv; }
            ow_pend.x = pk2(o[0], o[1]); ow_pend.y = pk2(o[2], o[3]); ow_pend.z = pk2(o[4], o[5]); ow_pend.w = pk2(o[6], o[7]);
            sq += __shfl_xor(sq, 1); sq += __shfl_xor(sq, 2); sq += __shfl_xor(sq, 4); sq_pend = sq; pend = true; } }
        }
    }
    if (pend) { const size_t prow = row_base + (L - 64) + (tid >> 3); *(v4u*)(YG + prow * 2048 + h * 64 + (tid & 7) * 8) = ow_pend; if ((tid & 7) == 0) SSQ[prow * 32 + h] = sq_pend; }
#pragma unroll
    for (int q4 = 0; q4 < 4; ++q4) *(f32x4*)(st_g + 8 * q4) = (f32x4){H[4 * q4], H[4 * q4 + 1], H[4 * q4 + 2], H[4 * q4 + 3]};
    __syncthreads();
}
__device__ __forceinline__ float tr_reduce32(const float (&v)[32], int lane) {
    const bool b4 = lane & 16, b3 = lane & 8, b2 = lane & 4, b1 = lane & 2, b0 = lane & 1;
    float a[16], b[8], c[4], d[2];
#pragma unroll
    for (int i = 0; i < 16; ++i) { const float keep = b4 ? v[i + 16] : v[i], send = b4 ? v[i] : v[i + 16]; a[i] = keep + __shfl_xor(send, 16); }
#pragma unroll
    for (int i = 0; i < 8; ++i) { const float keep = b3 ? a[i + 8] : a[i], send = b3 ? a[i] : a[i + 8]; b[i] = keep + __shfl_xor(send, 8); }
#pragma unroll
    for (int i = 0; i < 4; ++i) { const float keep = b2 ? b[i + 4] : b[i], send = b2 ? b[i] : b[i + 4]; c[i] = keep + __shfl_xor(send, 4); }
#pragma unroll
    for (int i = 0; i < 2; ++i) { const float keep = b1 ? c[i + 2] : c[i], send = b1 ? c[i] : c[i + 2]; d[i] = keep + __shfl_xor(send, 2); }
    const float keep = b0 ? d[1] : d[0], send = b0 ? d[0] : d[1];
    return keep + __shfl_xor(send, 1);
}
__device__ __forceinline__ void ssd_sample_unit(Frame& F, int sb, int g) {
    int tid_o = F.tid; asm volatile("" : "+v"(tid_o));
    const int tid = tid_o, lane = tid & 63, w = F.wave, hh = lane >> 5, nq = lane & 31; unsigned char* ws = F.ws;
    LAS float* XC = (LAS float*)(F.lds + RING_OFF); LAS float* BC = XC + 8 * 4 * 64; LAS float* CC = BC + 4 * 128; LAS float* DTS = CC + 4 * 128;
    const bf16* PROJ = (const bf16*)(ws + WS_PROJ); const float* DTR = (const float*)(ws + WS_DT); bf16* YG = (bf16*)(ws + WS_YG); float* SSQ = (float*)(ws + WS_SSQSSD);
    const size_t row0 = (size_t)TP + (size_t)sb * LS;
    const int h = 8 * g + w;
    const float* sp = F.in[3] + (size_t)(sb * 32 + h) * 8192 + (size_t)hh * 128 + 4 * nq;
    f32x4 hst[32];
#pragma unroll
    for (int i = 0; i < 32; ++i) hst[i] = ld_nt(sp + (size_t)i * 256);
    if (tid < 384) { typedef float f32x2 __attribute__((ext_vector_type(2)));
        const int col = tid < 256 ? g * 512 + 2 * tid : (tid < 320 ? 2048 + g * 128 + 2 * (tid - 256) : 2560 + g * 128 + 2 * (tid - 320));
        const float* cw = F.in[10]; const float* sc = F.in[4] + (size_t)sb * 3 * 3072 + col;
        const f32x2 w0 = *(const f32x2*)(cw + col), w1 = *(const f32x2*)(cw + 3072 + col), w2 = *(const f32x2*)(cw + 2 * 3072 + col), w3 = *(const f32x2*)(cw + 3 * 3072 + col), cb = *(const f32x2*)(F.in[11] + col);
        f32x2 full[7]; full[0] = *(const f32x2*)sc; full[1] = *(const f32x2*)(sc + 3072); full[2] = *(const f32x2*)(sc + 2 * 3072);
        const bf16* cp = PROJ + (size_t)(S_X0 + (col >> 10)) * SLOT_ELEMS + row0 * 1024 + (col & 1023);
#pragma unroll
        for (int t = 0; t < 4; ++t) { const unsigned wd = *(const unsigned*)(cp + (size_t)t * 1024); full[3 + t] = (f32x2){__uint_as_float(wd << 16), __uint_as_float(wd & 0xffff0000u)}; }
#pragma unroll
        for (int t = 0; t < 4; ++t) { f32x2 a = w0 * full[t] + cb; a = w1 * full[t + 1] + a; a = w2 * full[t + 2] + a; a = w3 * full[t + 3] + a;
            f32x2 o; o.x = silu_f(a.x); o.y = silu_f(a.y);
            LAS float* dst = tid < 256 ? XC + ((tid >> 5) * 4 + t) * 64 + 2 * (tid & 31) : (tid < 320 ? BC + t * 128 + 2 * (tid - 256) : CC + t * 128 + 2 * (tid - 320));
            *(LAS f32x2*)dst = o; }
    } else if (tid < 416) { const int idx = tid - 384, hl = idx >> 2, t = idx & 3; const float x = DTR[(row0 + t) * 32 + 8 * g + hl] + F.in[12][8 * g + hl]; DTS[idx] = x > 20.f ? x : log1pf(__expf(x)); }
    __syncthreads();
    const float a = -__expf(F.in[13][h]), Dk = F.in[14][h];
#pragma unroll 1
    for (int t = 0; t < 4; ++t) {
        const float dtv = DTS[w * 4 + t], dA = __expf(dtv * a);
        const f32x4 Bv = *(const LAS f32x4*)(BC + t * 128 + 4 * nq), Cv = *(const LAS f32x4*)(CC + t * 128 + 4 * nq);
        const LAS float* xrow = XC + (w * 4 + t) * 64;
        float part[32];
#pragma unroll
        for (int i = 0; i < 32; ++i) { const float xd = xrow[2 * i + hh] * dtv; hst[i] = hst[i] * dA + Bv * xd; part[i] = (hst[i].x * Cv.x + hst[i].y * Cv.y) + (hst[i].z * Cv.z + hst[i].w * Cv.w); }
        float yv = tr_reduce32(part, lane);
        const int p = 2 * nq + hh; const size_t row = row0 + t;
        yv += Dk * xrow[p];
        const float z = bf2f(PROJ[(size_t)(S_Z0 + (h >> 4)) * SLOT_ELEMS + row * 1024 + (h & 15) * 64 + p]);
        const float yg = yv * silu_f(z);
        YG[row * 2048 + h * 64 + p] = (bf16)f2bf(yg);
        const float sq = wave_sum(yg * yg);
        if (lane == 0) SSQ[row * 32 + h] = sq;
    }
    float* so = F.out + O_SSMS + (size_t)(sb * 32 + h) * 8192 + (size_t)hh * 128 + 4 * nq;
#pragma unroll
    for (int i = 0; i < 32; ++i) st_nt(so + (size_t)i * 256, hst[i]);
    __syncthreads();
}
__device__ __forceinline__ void hgrn_sample_unit(Frame& F, int sb, int hq) {
    int tid_o = F.tid; asm volatile("" : "+v"(tid_o));
    const int tid = tid_o, lane = tid & 63, w = F.wave, hh = lane >> 5, vq = lane & 31; unsigned char* ws = F.ws;
    LAS float* FS = (LAS float*)(F.lds + RING_OFF); LAS float* KS = FS + 2048; LAS float* QS = KS + 2048; LAS float* VS = QS + 2048; LAS float* OP = VS + 2048;
    const bf16* PROJ = (const bf16*)(ws + WS_PROJ); bf16* ON = (bf16*)(ws + WS_ON);
    const size_t row0 = (size_t)TP + (size_t)sb * LS;
    const int hl = w >> 1, kh = w & 1, hd = 4 * hq + hl;
    const float* sp = F.in[5] + (size_t)(sb * 8 + hd) * 16384 + (size_t)(64 * kh + hh) * 128 + 4 * vq;
    f32x4 S[32];
#pragma unroll
    for (int i = 0; i < 32; ++i) S[i] = ld_nt(sp + (size_t)i * 256);
    { const int ch = hq * 512 + tid; const float lb = __builtin_amdgcn_rcpf(1.0f + __expf(F.in[17][1024 + ch] - F.in[17][ch]));
      const bf16* fp = PROJ + (size_t)S_F * SLOT_ELEMS + row0 * 1024 + ch; const bf16* qp = PROJ + (size_t)S_Q * SLOT_ELEMS + row0 * 1024 + ch; const bf16* ip = PROJ + (size_t)S_I * SLOT_ELEMS + row0 * 1024 + ch;
#pragma unroll
      for (int t = 0; t < 4; ++t) { const float u = fminf(fmaxf(bf2f(fp[(size_t)t * 1024]), -30.f), 30.f); const float fg = lb + (1.0f - lb) * sigmoid_f(u);
          const int o = ((tid >> 7) * 4 + t) * 128 + (tid & 127);
          FS[o] = fg; KS[o] = 1.0f - fg; QS[o] = silu_f(bf2f(qp[(size_t)t * 1024])); VS[o] = bf2f(ip[(size_t)t * 1024]); } }
    __syncthreads();
#pragma unroll 1
    for (int t = 0; t < 4; ++t) {
        const int o = (hl * 4 + t) * 128;
        const f32x4 vv = *(const LAS f32x4*)(VS + o + 4 * vq);
        f32x4 oa = (f32x4){0.f, 0.f, 0.f, 0.f};
#pragma unroll
        for (int i = 0; i < 32; ++i) { const int k = 64 * kh + 2 * i + hh; const float fk = FS[o + k], kv = KS[o + k], qk = QS[o + k]; S[i] = S[i] * fk + vv * kv; oa = oa + S[i] * qk; }
        oa.x += __shfl_xor(oa.x, 32); oa.y += __shfl_xor(oa.y, 32); oa.z += __shfl_xor(oa.z, 32); oa.w += __shfl_xor(oa.w, 32);
        if (hh == 0) *(LAS f32x4*)(OP + ((hl * 4 + t) * 2 + kh) * 128 + 4 * vq) = oa;
    }
    float* so = F.out + O_HGS + (size_t)(sb * 8 + hd) * 16384 + (size_t)(64 * kh + hh) * 128 + 4 * vq;
#pragma unroll
    for (int i = 0; i < 32; ++i) st_nt(so + (size_t)i * 256, S[i]);
    __syncthreads();
#pragma unroll
    for (int rr2 = 0; rr2 < 2; ++rr2) { const int rr = 2 * w + rr2, ohl = rr >> 2, t = rr & 3, ohd = 4 * hq + ohl; typedef float f32x2 __attribute__((ext_vector_type(2)));
        const f32x2 p0 = *(const LAS f32x2*)(OP + (rr * 2) * 128 + 2 * lane), p1 = *(const LAS f32x2*)(OP + (rr * 2 + 1) * 128 + 2 * lane);
        const float o0 = p0.x + p1.x, o1 = p0.y + p1.y; const float sq = wave_sum(o0 * o0 + o1 * o1); const float rs = __builtin_amdgcn_rsqf(sq * (1.0f / 128.0f) + EPS);
        const size_t row = row0 + t; const unsigned gw = *(const unsigned*)(PROJ + (size_t)S_HG * SLOT_ELEMS + row * 1024 + ohd * 128 + 2 * lane);
        *(unsigned*)(ON + row * 1024 + ohd * 128 + 2 * lane) = pk2(o0 * rs * silu_f(bf2f(gw & 0xffffu)), o1 * rs * silu_f(__uint_as_float(gw & 0xffff0000u))); }
    __syncthreads();
}
constexpr int U_HGS = NBS * 2, U_SSDS = NBS * 4, U_CONV = NBP + NBS;
__device__ __forceinline__ void scan_phase(Frame& F) {
    gu32* head = F.ctl + CW_QUEUE;
#define SCAN_QUEUE(qi, count, body) for (;;) { if (F.tid == 0) F.MISC[0] = __hip_atomic_fetch_add(head + 64 * (qi), 1u, RLX_AGENT); __syncthreads(); const int u = (int)F.MISC[0]; __syncthreads(); if (u >= (count)) break; body }
    SCAN_QUEUE(1, NBP * 32, ssd_unit_mfma(F, u >> 5, u & 31);)
    SCAN_QUEUE(0, NBP * 32, hgrn_v_unit(F, u >> 5, (u >> 2) & 7, u & 3);)
    SCAN_QUEUE(2, U_HGS, hgrn_sample_unit(F, u >> 1, u & 1);)
    SCAN_QUEUE(3, U_SSDS + U_CONV, if (u >= U_SSDS) { conv_copy_unit(F, u - U_SSDS); continue; } ssd_sample_unit(F, u >> 2, u & 3);)
#undef SCAN_QUEUE
}
typedef float f32x4s __attribute__((ext_vector_type(4)));
template <class Epi> __device__ __forceinline__ void small_tile_phase(Frame& F, const bf16* A, const bf16* Bt, int K, const Epi& E) {
    const int lane = F.lane, w = F.wave, r = lane & 31, hh = lane >> 5;
#pragma unroll 1
    for (int v = F.vcu; v < 256; v += F.G) {
    const int mt = v >> 4, nt = v & 15;
    const int kw = K >> 3;
    const bf16* ap = A + (size_t)(TP + 32 * mt + r) * K + w * kw + 8 * hh;
    const bf16* bp = Bt + (size_t)(64 * nt + r) * K + w * kw + 8 * hh;
    f32x16 acc0, acc1;
#pragma unroll
    for (int i = 0; i < 16; ++i) { acc0[i] = 0.f; acc1[i] = 0.f; }
#pragma unroll 4
    for (int ks = 0; ks < kw / 16; ++ks) { const bf16x8 af = *(const bf16x8*)(ap + 16 * ks), b0 = *(const bf16x8*)(bp + 16 * ks), b1 = *(const bf16x8*)(bp + (size_t)32 * K + 16 * ks);
        acc0 = MFMA32(b0, af, acc0); acc1 = MFMA32(b1, af, acc1); }
    LAS float* part = (LAS float*)(F.lds + RING_OFF) + w * 2048;
#pragma unroll
    for (int q4 = 0; q4 < 4; ++q4) { *(LAS f32x4*)(part + r * 64 + 8 * q4 + 4 * hh) = (f32x4){acc0[4 * q4], acc0[4 * q4 + 1], acc0[4 * q4 + 2], acc0[4 * q4 + 3]};
        *(LAS f32x4*)(part + r * 64 + 32 + 8 * q4 + 4 * hh) = (f32x4){acc1[4 * q4], acc1[4 * q4 + 1], acc1[4 * q4 + 2], acc1[4 * q4 + 3]}; }
    __syncthreads();
    const int rl = F.tid >> 4, c4 = (F.tid & 15) * 4; const LAS float* src = (const LAS float*)(F.lds + RING_OFF) + rl * 64 + c4;
    f32x4 sum = *(const LAS f32x4*)src;
#pragma unroll
    for (int ww = 1; ww < 8; ++ww) sum = sum + *(const LAS f32x4*)(src + ww * 2048);
    const f32x4s acc = (f32x4s){sum.x, sum.y, sum.z, sum.w};
    E.small(F, acc, TP + 32 * mt + rl, 64 * nt + c4, nt);
    __syncthreads();
    }
}
template <bool ADD> struct SmGate { bf16* O; const bf16* gate;
    __device__ __forceinline__ void small(Frame&, const f32x4s& a, int row, int col, int) const { const size_t off = (size_t)row * 1024 + col;
        const v2u gw = __builtin_nontemporal_load((const v2u*)(gate + off)); v2u ow = (v2u){0u, 0u}; if (ADD) ow = *(const v2u*)(O + off);
        float rr[4];
#pragma unroll
        for (int e = 0; e < 4; ++e) { const unsigned g16 = (gw[e >> 1] >> ((e & 1) * 16)) & 0xffffu, o16 = (ow[e >> 1] >> ((e & 1) * 16)) & 0xffffu; rr[e] = (ADD ? bf2f(o16) : 0.f) + sigmoid_f(bf2f(g16)) * a[e]; }
        v2u wv; wv.x = cvtpk_c(rr[0], rr[1]); wv.y = cvtpk_c(rr[2], rr[3]); *(v2u*)(O + off) = wv; } };
template <bool BF> struct SmRes { const float* base; bf16* hb; float* ssqp;
    __device__ __forceinline__ void small(Frame& F, const f32x4s& a, int row, int col, int nt) const { const size_t off = (size_t)row * 1024 + col; f32x4 b;
        if (BF) { const v2u w = *(const v2u*)(hb + off); b = (f32x4){bf2f(w.x & 0xffffu), __uint_as_float(w.x & 0xffff0000u), bf2f(w.y & 0xffffu), __uint_as_float(w.y & 0xffff0000u)}; }
        else b = *(const f32x4*)(base + off);
        const f32x4 v = b + (f32x4){a[0], a[1], a[2], a[3]};
        { v2u wv; wv.x = cvtpk_c(v[0], v[1]); wv.y = cvtpk_c(v[2], v[3]); *(v2u*)(hb + off) = wv; }
        float sq = (v[0] * v[0] + v[1] * v[1]) + (v[2] * v[2] + v[3] * v[3]); sq += __shfl_xor(sq, 1); sq += __shfl_xor(sq, 2); sq += __shfl_xor(sq, 4); sq += __shfl_xor(sq, 8);
        if ((F.tid & 15) == 0) ssqp[(size_t)row * 16 + nt] = sq; } };
struct SmScale { bf16* O; const float* ssq; float scale;
    __device__ __forceinline__ void small(Frame&, const f32x4s& a, int row, int col, int) const { const float rs = pg8::row_rs<16>(ssq, row) * scale;
        v2u wv; wv.x = cvtpk_c(a[0] * rs, a[1] * rs); wv.y = cvtpk_c(a[2] * rs, a[3] * rs); *(v2u*)(O + (size_t)row * 1024 + col) = wv; } };
__device__ __forceinline__ void attn_stage_tile(LAS unsigned char* Lb, const bf16* src, size_t pitch, int tid) {
#pragma unroll 1
    for (int hb = 0; hb < 2; ++hb) { v4u v[8];
#pragma unroll
        for (int i = 0; i < 8; ++i) { const int id = tid + 512 * (8 * hb + i), row = id >> 5, c = id & 31; v[i] = *(const v4u*)(src + (size_t)row * pitch + c * 8); }
#pragma unroll
        for (int i = 0; i < 8; ++i) { const int id = tid + 512 * (8 * hb + i), row = id >> 5, c = id & 31; *(LAS v4u*)(Lb + row * 512 + ((c ^ (row & 15)) << 4)) = v[i]; } }
}
__device__ __forceinline__ void attn_prompt_unit(Frame& F, int b, int hd, int qb) {
    const int tid = F.tid, lane = F.lane, w = F.wave, r = lane & 31, hh = lane >> 5; unsigned char* ws = F.ws;
    LAS unsigned char* Lb = F.lds + RING_OFF;
    const bf16* QB = (const bf16*)(ws + WS_QB); const bf16* KB = (const bf16*)(ws + WS_KB); const bf16* VT = (const bf16*)(ws + WS_VT); bf16* OB = (bf16*)(ws + WS_OB);
    const size_t qrow = (size_t)b * SEQ + (size_t)qb * 256 + 32 * w + r;
    attn_stage_tile(Lb, KB + (size_t)b * 256 * 1024 + hd * 256, 1024, tid);
    const bf16* qp = QB + qrow * 1024 + hd * 256 + 8 * hh;
    bf16x8 qf = *(const bf16x8*)qp;
    __syncthreads();
    f32x16 S[8];
#pragma unroll
    for (int t = 0; t < 8; ++t)
#pragma unroll
        for (int i = 0; i < 16; ++i) S[t][i] = 0.f;
    const int sw = r & 15;
#pragma unroll 1
    for (int ks = 0; ks < 16; ++ks) {
        const bf16x8 qn = *(const bf16x8*)(qp + 16 * (ks < 15 ? ks + 1 : ks));
        const LAS unsigned char* kp = Lb + r * 512 + (((2 * ks + hh) ^ sw) << 4);
#pragma unroll
        for (int t = 0; t < 8; ++t) S[t] = MFMA32(lds_frag16(kp + t * 32 * 512), qf, S[t]);
        qf = qn;
    }
    float m = -3.0e38f;
#pragma unroll
    for (int t = 0; t < 8; ++t)
#pragma unroll
        for (int i = 0; i < 16; ++i) m = fmaxf(m, S[t][i]);
    m = fmaxf(m, __shfl_xor(m, 32));
    float l = 0.f;
#pragma unroll
    for (int t = 0; t < 8; ++t)
#pragma unroll
        for (int i = 0; i < 16; ++i) { const float pv = __builtin_amdgcn_exp2f(S[t][i] - m); S[t][i] = pv; l += pv; }
    l += __shfl_xor(l, 32);
    const float rl = __builtin_amdgcn_rcpf(l);
    bf16x8 pf[8][2];
#pragma unroll
    for (int t = 0; t < 8; ++t) { pf[t][0] = ACC_FRAG(S[t], 0); pf[t][1] = ACC_FRAG(S[t], 1); }
    __syncthreads();
    attn_stage_tile(Lb, VT + (size_t)(b * 4 + hd) * 256 * 256, 256, tid);
    __syncthreads();
    bf16* op = OB + qrow * 1024 + hd * 256 + 4 * hh;
#pragma unroll 1
    for (int dt = 0; dt < 8; ++dt) {
        f32x16 O;
#pragma unroll
        for (int i = 0; i < 16; ++i) O[i] = 0.f;
        const LAS unsigned char* vrow = Lb + (32 * dt + r) * 512 + 8 * hh;
#pragma unroll
        for (int t = 0; t < 8; ++t)
#pragma unroll
            for (int s2 = 0; s2 < 2; ++s2) {
                const v2u lo = *(const LAS v2u*)(vrow + (((4 * t + 2 * s2) ^ sw) << 4)), hi = *(const LAS v2u*)(vrow + (((4 * t + 2 * s2 + 1) ^ sw) << 4));
                const v4u wv4 = (v4u){lo.x, lo.y, hi.x, hi.y};
                O = MFMA32(__builtin_bit_cast(bf16x8, wv4), pf[t][s2], O);
            }
#pragma unroll
        for (int q4 = 0; q4 < 4; ++q4) { v2u o; o.x = cvtpk_c(O[4 * q4] * rl, O[4 * q4 + 1] * rl); o.y = cvtpk_c(O[4 * q4 + 2] * rl, O[4 * q4 + 3] * rl);
            *(v2u*)(op + 32 * dt + 8 * q4) = o; }
    }
    __syncthreads();
}
__device__ __forceinline__ void attn_sample_unit(Frame& F, int sb, int hd) {
    const int tid = F.tid, lane = F.lane, w = F.wave; unsigned char* ws = F.ws;
    LAS float* sc = (LAS float*)(F.lds + RING_OFF);
    LAS float* red = sc + 4 * 256;
    const bf16* QB = (const bf16*)(ws + WS_QB); bf16* OB = (bf16*)(ws + WS_OB);
    const size_t rowq = (size_t)TP + (size_t)sb * LS;
    float q[4][4];
#pragma unroll
    for (int t = 0; t < 4; ++t) { const v2u qw = *(const v2u*)(QB + (rowq + t) * 1024 + hd * 256 + 4 * lane); q[t][0] = bf2f(qw.x & 0xffffu); q[t][1] = bf2f(qw.x >> 16); q[t][2] = bf2f(qw.y & 0xffffu); q[t][3] = bf2f(qw.y >> 16); }
    const float* Kc = F.in[6] + ((size_t)sb * 256 * 4 + hd) * 256 + 4 * lane; const float* Vc = F.in[7] + ((size_t)sb * 256 * 4 + hd) * 256 + 4 * lane;
    f32x4 kv[8], kn[8];
#pragma unroll
    for (int u = 0; u < 8; ++u) kv[u] = ld_nt(Kc + (size_t)(w * 32 + u) * 1024);
#pragma unroll 1
    for (int kk0 = 0; kk0 < 32; kk0 += 8) {
#pragma unroll
        for (int u = 0; u < 8; ++u) kn[u] = kk0 < 24 ? ld_nt(Kc + (size_t)(w * 32 + kk0 + 8 + u) * 1024) : ld_nt(Vc + (size_t)(w * 32 + u) * 1024);
        { float part[32];
#pragma unroll
          for (int u = 0; u < 8; ++u)
#pragma unroll
              for (int t = 0; t < 4; ++t) part[4 * u + t] = (q[t][0] * kv[u].x + q[t][1] * kv[u].y) + (q[t][2] * kv[u].z + q[t][3] * kv[u].w);
          float sv = tr_reduce32(part, lane); sv += __shfl_xor(sv, 32);
          if (lane < 32) sc[(lane & 3) * 256 + w * 32 + kk0 + (lane >> 2)] = sv; }
#pragma unroll
        for (int u = 0; u < 8; ++u) kv[u] = kn[u]; }
    __syncthreads();
    if (w < 4) { float v[4]; float m = -3.0e38f;
#pragma unroll
        for (int j = 0; j < 4; ++j) { v[j] = sc[w * 256 + j * 64 + lane]; m = fmaxf(m, v[j]); }
        m = wave_max(m); float l = 0.f;
#pragma unroll
        for (int j = 0; j < 4; ++j) { v[j] = __builtin_amdgcn_exp2f(v[j] - m); l += v[j]; }
        l = wave_sum(l); const float rl = 1.0f / l;
#pragma unroll
        for (int j = 0; j < 4; ++j) sc[w * 256 + j * 64 + lane] = v[j] * rl; }
    __syncthreads();
    float o[4][4];
#pragma unroll
    for (int t = 0; t < 4; ++t)
#pragma unroll
        for (int e = 0; e < 4; ++e) o[t][e] = 0.f;
#pragma unroll 1
    for (int kk0 = 0; kk0 < 32; kk0 += 8) {
        if (kk0 < 24) {
#pragma unroll
            for (int u = 0; u < 8; ++u) kn[u] = ld_nt(Vc + (size_t)(w * 32 + kk0 + 8 + u) * 1024); }
#pragma unroll
        for (int u = 0; u < 8; ++u) { const int key = w * 32 + kk0 + u;
#pragma unroll
            for (int t = 0; t < 4; ++t) { const float pr = sc[t * 256 + key]; o[t][0] += pr * kv[u].x; o[t][1] += pr * kv[u].y; o[t][2] += pr * kv[u].z; o[t][3] += pr * kv[u].w; } }
#pragma unroll
        for (int u = 0; u < 8; ++u) kv[u] = kn[u]; }
#pragma unroll
    for (int t = 0; t < 4; ++t) *(LAS f32x4*)(red + (w * 4 + t) * 256 + 4 * lane) = (f32x4){o[t][0], o[t][1], o[t][2], o[t][3]};
    __syncthreads();
    { const int t = tid >> 7, d0 = (tid & 127) * 2; float a0 = 0.f, a1 = 0.f;
#pragma unroll
      for (int ww = 0; ww < 8; ++ww) { a0 += red[(ww * 4 + t) * 256 + d0]; a1 += red[(ww * 4 + t) * 256 + d0 + 1]; }
      *(unsigned*)(OB + (rowq + t) * 1024 + hd * 256 + d0) = pk2(a0, a1); }
    __syncthreads();
}
__device__ __forceinline__ void attn_phase(Frame& F) {
    for (int u = F.vcu; u < NBP * 4 * 8; u += F.G) attn_prompt_unit(F, u >> 5, (u >> 3) & 3, u & 7);
    for (int u = F.vcu; u < NBS * 4; u += F.G) attn_sample_unit(F, u >> 2, u & 3);
}
__device__ __forceinline__ void final_norm_phase(Frame& F) {
    const int gw = F.vcu * NWAVES + F.wave, NGW = F.G * NWAVES; const float* SSQ = (const float*)(F.ws + WS_SSQP3); const float* wn = F.in[31]; const bf16* HB = (const bf16*)(F.ws + WS_HB);
    f32x4 wv[4];
#pragma unroll
    for (int j = 0; j < 2; ++j) { wv[2 * j] = *((const f32x4*)wn + 2 * (64 * j + F.lane)); wv[2 * j + 1] = *((const f32x4*)wn + 2 * (64 * j + F.lane) + 1); }
    for (int row = gw; row < T; row += NGW) {
        const f32x4* sp = (const f32x4*)(SSQ + (size_t)row * 16); float s = 0.f;
#pragma unroll
        for (int j = 0; j < 4; ++j) { const f32x4 a = sp[j]; s += (a.x + a.y) + (a.z + a.w); }
        const float rs = __builtin_amdgcn_rsqf(s * (1.0f / 1024.0f) + EPS);
#pragma unroll
        for (int j = 0; j < 2; ++j) { const int pc = 64 * j + F.lane; const v4u w = ld_nt16((const v4u*)(HB + (size_t)row * 1024) + pc);
            const f32x4 v0 = (f32x4){bf2f(w.x & 0xffffu), __uint_as_float(w.x & 0xffff0000u), bf2f(w.y & 0xffffu), __uint_as_float(w.y & 0xffff0000u)};
            const f32x4 v1 = (f32x4){bf2f(w.z & 0xffffu), __uint_as_float(w.z & 0xffff0000u), bf2f(w.w & 0xffffu), __uint_as_float(w.w & 0xffff0000u)};
            float* o = F.out + O_Y + (size_t)row * 1024 + 8 * pc; st_nt(o, v0 * rs * wv[2 * j]); st_nt(o + 4, v1 * rs * wv[2 * j + 1]); }
    }
}
#ifndef MK_N_LAUNCHES
#define MK_N_LAUNCHES 1
#endif
constexpr int PER_PHASE = 13;
constexpr int N_LAUNCHES = MK_N_LAUNCHES;
struct Args { const float* in[32]; float* out; unsigned char* ws; int ph_lo, ph_hi; };
__global__ void __launch_bounds__(NTHR, 2) skel_fwd(Args args) {
    extern __shared__ __attribute__((aligned(16))) unsigned char lds[];
    Frame F;
    F.lds = (LAS unsigned char*)lds;
    F.MISC = (volatile LAS unsigned*)(F.lds + MISC_OFF);
    F.tid = threadIdx.x; F.lane = F.tid & 63; F.wave = __builtin_amdgcn_readfirstlane(F.tid >> 6);
    F.G = gridDim.x; { const int bx = blockIdx.x; F.vcu = (F.G % 8 == 0) ? (bx % 8) * (F.G / 8) + bx / 8 : bx; }
    unsigned char* ws = args.ws; F.ws = ws; F.out = args.out;
    F.ctl = (gu32*)(ws + WS_CTL);
#pragma unroll
    for (int i = 0; i < 32; ++i) F.in[i] = args.in[i];
    for (int u = F.tid; u < (LDS_BYTES - LDSCTL_OFF) / 4; u += NTHR) ((LAS unsigned*)(F.lds + LDSCTL_OFF))[u] = 0u;
    __syncthreads();
    XcdBarrier bar; bar.bar = (unsigned*)(F.ctl + CW_BAR); bar.x = 0; bar.st = nullptr;
    if (N_LAUNCHES == 1) bar = xcd_barrier_post((unsigned*)(F.ctl + CW_BAR), F.MISC + 8);
#define GRID_BAR() do { if (N_LAUNCHES == 1) xcd_barrier(bar); } while (0)
    const int lo = args.ph_lo, hi = args.ph_hi;
#ifdef ONLY_PHASE
#define IN(k) ((k) == ONLY_PHASE && lo <= (k) && (k) < hi)
#else
#define IN(k) (lo <= (k) && (k) < hi)
#endif
#define BOTH(k) (IN(k) && IN((k) + 1))
    bf16* const XB = (bf16*)(ws + WS_XB); bf16* const PROJ = (bf16*)(ws + WS_PROJ);
    float* const Y = F.out + O_Y;
    if (IN(0)) { p0_prologue(F); if (BOTH(0)) GRID_BAR(); }
    if (IN(1)) {
        { pg8::Gemm g{XB, (const bf16*)(ws + WS_WIN), T, NPROJ, 1024}; pg8::StaticOrder S; S.init(T, NPROJ, F.G, (int)blockIdx.x);
          pg8::EpiScaleBf16<1, true> E{PROJ, SLOT_ELEMS, (const float*)(ws + WS_SSQX), 1.0f, (float*)(ws + WS_DT)};
          pg8::gemm_phase<pg8::EpiScaleBf16<1, true>, pg8::StaticOrder, true, true>(F.lds + RING_OFF, g, S, E); }
        { pg8::Gemm g{(const bf16*)(ws + WS_MNB), (const bf16*)(ws + WS_WKV), MEMR, 2048, 1024}; pg8::StaticOrder S; S.init(MEMR, 2048, F.G, (int)((blockIdx.x + 64) % F.G));
          pg8::EpiKV E{F.out + O_MKP, F.out + O_MVP, (bf16*)(ws + WS_KB), (bf16*)(ws + WS_VT), (const float*)(ws + WS_SSQM)};
          pg8::gemm_phase<pg8::EpiKV, pg8::StaticOrder, true, true>(F.lds + RING_OFF, g, S, E); }
        if (BOTH(1)) GRID_BAR();
    }
    if (IN(2)) { bc_prep_phase(F); hg_prep_phase(F); if (BOTH(2)) GRID_BAR(); }
    if (IN(3)) { scan_phase(F); if (BOTH(3)) GRID_BAR(); }
    if (IN(4)) { ssdnorm_phase(F); hgnorm_phase(F); if (BOTH(4)) GRID_BAR(); }
    if (IN(5)) { { SmGate<false> Es{(bf16*)(ws + WS_MERGED), PROJ + (size_t)S_GS * SLOT_ELEMS}; small_tile_phase(F, (const bf16*)(ws + WS_YG), (const bf16*)(ws + WS_WSSD), 2048, Es); }
        pg8::Gemm g{(const bf16*)(ws + WS_YG), (const bf16*)(ws + WS_WSSD), TP, 1024, 2048}; pg8::StaticOrder S; S.init(TP, 1024, F.G, (int)blockIdx.x);
        pg8::EpiGate<false> E{(bf16*)(ws + WS_MERGED), PROJ + (size_t)S_GS * SLOT_ELEMS};
        pg8::gemm_phase<pg8::EpiGate<false>, pg8::StaticOrder, true, true>(F.lds + RING_OFF, g, S, E);
          }
    if (IN(5)) { { SmGate<true> Es{(bf16*)(ws + WS_MERGED), PROJ + (size_t)S_GH * SLOT_ELEMS}; small_tile_phase(F, (const bf16*)(ws + WS_ON), (const bf16*)(ws + WS_WHG), 1024, Es); }
        pg8::Gemm g{(const bf16*)(ws + WS_ON), (const bf16*)(ws + WS_WHG), TP, 1024, 1024}; pg8::StaticOrder S; S.init(TP, 1024, F.G, (int)blockIdx.x);
        pg8::EpiGate<true> E{(bf16*)(ws + WS_MERGED), PROJ + (size_t)S_GH * SLOT_ELEMS};
        pg8::gemm_phase<pg8::EpiGate<true>, pg8::StaticOrder, true, true>(F.lds + RING_OFF, g, S, E);
        if (BOTH(5)) GRID_BAR(); }
    if (IN(6)) { { SmRes<false> Es{F.in[1] - (size_t)TP * 1024, (bf16*)(ws + WS_HB), (float*)(ws + WS_SSQP1)}; small_tile_phase(F, (const bf16*)(ws + WS_MERGED), (const bf16*)(ws + WS_WOUT), 1024, Es); }
        pg8::Gemm g{(const bf16*)(ws + WS_MERGED), (const bf16*)(ws + WS_WOUT), TP, 1024, 1024}; pg8::StaticOrder S; S.init(TP, 1024, F.G, (int)blockIdx.x);
        pg8::EpiRes<false> E{F.in[0], F.in[1] - (size_t)TP * 1024, (bf16*)(ws + WS_HB), (float*)(ws + WS_SSQP1)};
        pg8::gemm_phase<pg8::EpiRes<false>, pg8::StaticOrder, true, true>(F.lds + RING_OFF, g, S, E);
        if (BOTH(6)) GRID_BAR(); }
    if (IN(7)) { { SmScale Es{(bf16*)(ws + WS_QB), (const float*)(ws + WS_SSQP1), QSCALE}; small_tile_phase(F, (const bf16*)(ws + WS_HB), (const bf16*)(ws + WS_WCQ), 1024, Es); }
        pg8::Gemm g{(const bf16*)(ws + WS_HB), (const bf16*)(ws + WS_WCQ), TP, 1024, 1024}; pg8::StaticOrder S; S.init(TP, 1024, F.G, (int)blockIdx.x);
        pg8::EpiScaleBf16<16, false> E{(bf16*)(ws + WS_QB), SLOT_ELEMS, (const float*)(ws + WS_SSQP1), QSCALE, nullptr};
        pg8::gemm_phase<pg8::EpiScaleBf16<16, false>, pg8::StaticOrder, true, true>(F.lds + RING_OFF, g, S, E);
        if (BOTH(7)) GRID_BAR(); }
    if (IN(8)) { attn_phase(F); if (BOTH(8)) GRID_BAR(); }
    if (IN(9)) { { SmRes<true> Es{nullptr, (bf16*)(ws + WS_HB), (float*)(ws + WS_SSQP2)}; small_tile_phase(F, (const bf16*)(ws + WS_OB), (const bf16*)(ws + WS_WCO), 1024, Es); }
        pg8::Gemm g{(const bf16*)(ws + WS_OB), (const bf16*)(ws + WS_WCO), TP, 1024, 1024}; pg8::StaticOrder S; S.init(TP, 1024, F.G, (int)blockIdx.x);
        pg8::EpiRes<true> E{nullptr, nullptr, (bf16*)(ws + WS_HB), (float*)(ws + WS_SSQP2)};
        pg8::gemm_phase<pg8::EpiRes<true>, pg8::StaticOrder, true, true>(F.lds + RING_OFF, g, S, E);
        if (BOTH(9)) GRID_BAR(); }
    if (IN(10)) { pg8::Gemm g{(const bf16*)(ws + WS_HB), (const bf16*)(ws + WS_WGU), T, 2 * FFN, 1024}; pg8::StaticOrder S; S.init(T, 2 * FFN, F.G, (int)blockIdx.x);
        pg8::EpiSwiglu E{(bf16*)(ws + WS_ACT), (const float*)(ws + WS_SSQP2)};
        pg8::gemm_phase<pg8::EpiSwiglu, pg8::StaticOrder, true, true>(F.lds + RING_OFF, g, S, E);
        if (BOTH(10)) GRID_BAR(); }
    if (IN(11)) { { SmRes<true> Es{nullptr, (bf16*)(ws + WS_HB), (float*)(ws + WS_SSQP3)}; small_tile_phase(F, (const bf16*)(ws + WS_ACT), (const bf16*)(ws + WS_WDN), FFN, Es); }
        pg8::Gemm g{(const bf16*)(ws + WS_ACT), (const bf16*)(ws + WS_WDN), TP, 1024, FFN}; pg8::StaticOrder S; S.init(TP, 1024, F.G, (int)blockIdx.x);
        pg8::EpiRes<true> E{nullptr, nullptr, (bf16*)(ws + WS_HB), (float*)(ws + WS_SSQP3)};
        pg8::gemm_phase<pg8::EpiRes<true>, pg8::StaticOrder, true, true>(F.lds + RING_OFF, g, S, E);
        if (BOTH(11)) GRID_BAR(); }
    if (IN(12)) final_norm_phase(F);
#undef IN
#undef BOTH
}

extern "C" void kernel_launch(void* const* d_in, const int* in_sizes, int n_in, void* d_out, int out_size, void* d_ws, size_t ws_size, hipStream_t stream) {
    static int grid = 0;
    if (grid == 0) {
        const int want[32] = {TP * 1024, TS * 1024, MEMR * 1024, 33554432, 1179648, 16777216, 33554432, 33554432, 1024, 1024 * 11296, 4 * 3072, 3072, 32, 32, 32, 2048, 2048 * 1024, 2048, 1024,
                              1024 * 1024, 1024 * 1024, 1024, 1024, 1024 * 1024, 1024 * 1024, 1024 * 1024, 1024 * 1024, 1024, 1024 * FFN, 1024 * FFN, FFN * 1024, 1024};
        bool ok = (n_in == 32); for (int i = 0; ok && i < 32; ++i) if (in_sizes[i] != want[i]) { fprintf(stderr, "kernel_launch: input %d has %d elements, expected %d\n", i, in_sizes[i], want[i]); ok = false; }
        if (!ok || out_size != (int)O_END || ws_size < WS_END4) { fprintf(stderr, "kernel_launch: unexpected shapes: n_in %d out %d ws %zu\n", n_in, out_size, ws_size); grid = -1; return; }
        int dev = 0, cus = 0, per_cu = 0;
        if (hipGetDevice(&dev) != hipSuccess || hipDeviceGetAttribute(&cus, hipDeviceAttributeMultiprocessorCount, dev) != hipSuccess) { grid = -1; return; }
        if (hipFuncSetAttribute((const void*)skel_fwd, hipFuncAttributeMaxDynamicSharedMemorySize, LDS_BYTES) != hipSuccess) { fprintf(stderr, "kernel_launch: hipFuncSetAttribute failed\n"); grid = -1; return; }
        if (hipOccupancyMaxActiveBlocksPerMultiprocessor(&per_cu, (const void*)skel_fwd, NTHR, LDS_BYTES) != hipSuccess || per_cu < 1) fprintf(stderr, "kernel_launch: occupancy query reports %d blocks per CU\n", per_cu);
        (void)hipGetLastError();
        grid = cus;
    }
    if (grid < 0) return;
    (void)hipMemsetAsync((char*)d_ws + WS_CTL, 0, CTL_ZERO_BYTES, stream);
    Args a{};
    for (int i = 0; i < 32; ++i) a.in[i] = (const float*)d_in[i];
    a.out = (float*)d_out; a.ws = (unsigned char*)d_ws;
    for (int li = 0; li < N_LAUNCHES; ++li) {
        a.ph_lo = (N_LAUNCHES == PER_PHASE) ? li : 0; a.ph_hi = (N_LAUNCHES == PER_PHASE) ? li + 1 : PER_PHASE;
        hipLaunchKernelGGL(skel_fwd, dim3(grid), dim3(NTHR), LDS_BYTES, stream, a);
    }
}
```

```cpp
#include <hip/hip_runtime.h>
#include <cstdio>
#include <cstdint>
namespace pg8 {
#define PG8_LAS __attribute__((address_space(3)))
typedef unsigned short bf16_t;
typedef short bf16x8 __attribute__((ext_vector_type(8)));
typedef float f32x4 __attribute__((ext_vector_type(4)));
typedef unsigned u32x4 __attribute__((ext_vector_type(4)));
constexpr int BM = 256, BK = 64, HALF = 128, HTB = HALF * BK * 2  , STAGE_BYTES = 8 * HTB, NXCD = 8, WGM = 8;

__host__ __device__ __forceinline__ int lds_byte(int r, int c) { const int st = (r >> 4) * 2 + (c >> 5), rr = r & 15, cc = c & 31, ob = rr * 64 + cc * 2; return st * 1024 + (ob ^ (((ob >> 9) & 1) << 5)); }
__host__ __device__ __forceinline__ void stage_rc(int b, int& R, int& C) { const int st = b / 1024, sb = b % 1024, swz = sb ^ (((sb >> 9) & 1) << 5); R = (st >> 1) * 16 + swz / 64; C = (st & 1) * 32 + (swz % 64) / 2; }
__host__ __device__ __forceinline__ int perm32(int rho) { const int n = rho >> 4, i = rho & 15; return 8 * (i >> 2) + 4 * n + (i & 3); }

struct Unit { int pm, pn; };
struct Gemm { const bf16_t* A; const bf16_t* Bt; int M, N, K; };

struct StaticOrder {
    int nM, nN, nwg, G, c;
    __host__ __device__ void init(int M, int N, int G_, int c_) { nM = M / BM; nN = N / BM; nwg = nM * nN; G = G_; c = c_; }
    __host__ __device__ bool next(int i, Unit& u) const {
        const long L = (long)i * G + c; if (L >= nwg) return false;
        int wgid = (int)L; { const int q = nwg / NXCD, r = nwg % NXCD, xcd = wgid % NXCD, off = wgid / NXCD; wgid = (xcd < r ? xcd * (q + 1) : r * (q + 1) + (xcd - r) * q) + off; }
        const int nig = WGM * nN, gid = wgid / nig, fm = gid * WGM, gsz = (nM - fm) < WGM ? (nM - fm) : WGM;
        u.pm = fm + ((wgid % nig) % gsz); u.pn = (wgid % nig) / gsz; return true;
    }
    __device__ __forceinline__ void a_ready(const Unit&) const {}
    __device__ __forceinline__ void done(const Unit&) const {}
};

__device__ __forceinline__ unsigned cvt_pk_bf16(float lo, float hi) { unsigned r; asm volatile("v_cvt_pk_bf16_f32 %0, %1, %2" : "=v"(r) : "v"(lo), "v"(hi)); return r; }
typedef float f32x2 __attribute__((ext_vector_type(2)));
typedef unsigned u32x2 __attribute__((ext_vector_type(2)));
constexpr float RMS_EPS = 1e-6f;
__device__ __forceinline__ float bfbits2f(unsigned v16) { return __uint_as_float(v16 << 16); }
__device__ __forceinline__ float sigm(float x) { return __builtin_amdgcn_rcpf(1.0f + __expf(-x)); }
template <int NP> __device__ __forceinline__ float row_rs(const float* ssq, int row) {
    float s = 0.f;
    if constexpr (NP == 1) s = ssq[row];
    else {
#pragma unroll
        for (int i = 0; i < NP / 4; ++i) { const f32x4 v = *(const f32x4*)(ssq + (size_t)row * NP + 4 * i); s += (v[0] + v[1]) + (v[2] + v[3]); }
    }
    return 1.0f / sqrtf(s * (1.0f / 1024.0f) + RMS_EPS);
}
template <int NP, bool HAS_DT> struct EpiScaleBf16 {
    static constexpr bool PERM = true, AFTER_DRAIN = false;
    bf16_t* O; size_t slot_elems; const float* ssq; float scale; float* dt;
    __device__ __forceinline__ void operator()(const f32x4 (&acc)[2][2][4][2], const Unit& u, int wr, int wc, int fr, int fq) const {
        const int row0 = u.pm * BM + wr * 64 + fr;
        if (HAS_DT && u.pn == 44) {
            if (wc == 0) {
#pragma unroll
                for (int ai = 0; ai < 2; ++ai)
#pragma unroll
                    for (int m = 0; m < 4; ++m) { const int row = row0 + ai * HALF + m * 16; const float rs = row_rs<NP>(ssq, row);
                        float* p = dt + (size_t)row * 32 + 8 * fq; *(f32x4*)p = acc[ai][0][m][0] * rs; *(f32x4*)(p + 4) = acc[ai][0][m][1] * rs; }
            }
            return;
        }
        bf16_t* base = O + (size_t)(u.pn >> 2) * slot_elems; const int col0 = (u.pn & 3) * BM + wc * 32 + 8 * fq;
#pragma unroll
        for (int ai = 0; ai < 2; ++ai)
#pragma unroll
            for (int m = 0; m < 4; ++m) { const int row = row0 + ai * HALF + m * 16; const float rs = row_rs<NP>(ssq, row) * scale; bf16_t* rowp = base + (size_t)row * 1024 + col0;
#pragma unroll
                for (int bj = 0; bj < 2; ++bj) { const f32x4 v0 = acc[ai][bj][m][0] * rs, v1 = acc[ai][bj][m][1] * rs;
                    u32x4 w; w.x = cvt_pk_bf16(v0[0], v0[1]); w.y = cvt_pk_bf16(v0[2], v0[3]); w.z = cvt_pk_bf16(v1[0], v1[1]); w.w = cvt_pk_bf16(v1[2], v1[3]);
                    if (HAS_DT) __builtin_nontemporal_store(w, (u32x4*)(rowp + bj * HALF));
                    else *(u32x4*)(rowp + bj * HALF) = w; } }
    }
};
struct EpiKV {
    static constexpr bool PERM = false, AFTER_DRAIN = false;
    float* mk; float* mv; bf16_t* kb; bf16_t* vt; const float* ssq;
    __device__ __forceinline__ void operator()(const f32x4 (&acc)[2][2][4][2], const Unit& u, int wr, int wc, int fr, int fq) const {
        const int row0 = u.pm * BM + wr * 64 + fr; const bool isv = u.pn >= 4; const int colt = (u.pn & 3) * BM + wc * 32 + 4 * fq;
#pragma unroll
        for (int ai = 0; ai < 2; ++ai)
#pragma unroll
            for (int m = 0; m < 4; ++m) { const int row = row0 + ai * HALF + m * 16; const float rs = row_rs<1>(ssq, row);
#pragma unroll
                for (int bj = 0; bj < 2; ++bj)
#pragma unroll
                    for (int n = 0; n < 2; ++n) { const int c = colt + bj * HALF + n * 16; const f32x4 v = acc[ai][bj][m][n] * rs;
                        if (!isv) { __builtin_nontemporal_store(v, (f32x4*)(mk + (size_t)row * 1024 + c)); u32x2 w; w.x = cvt_pk_bf16(v[0], v[1]); w.y = cvt_pk_bf16(v[2], v[3]); *(u32x2*)(kb + (size_t)row * 1024 + c) = w; }
                        else { __builtin_nontemporal_store(v, (f32x4*)(mv + (size_t)row * 1024 + c)); const int b = row >> 8, key = row & 255, hd = c >> 8, d = c & 255;
                            bf16_t* p = vt + ((size_t)((b * 4 + hd) * 256 + d)) * 256 + key; const unsigned w0 = cvt_pk_bf16(v[0], v[1]), w1 = cvt_pk_bf16(v[2], v[3]);
                            p[0] = (bf16_t)(w0 & 0xffffu); p[256] = (bf16_t)(w0 >> 16); p[512] = (bf16_t)(w1 & 0xffffu); p[768] = (bf16_t)(w1 >> 16); } } }
    }
};
template <bool ADD> struct EpiGate {
    static constexpr bool PERM = true, AFTER_DRAIN = false;
    bf16_t* O; const bf16_t* gate;
    __device__ __forceinline__ void operator()(const f32x4 (&acc)[2][2][4][2], const Unit& u, int wr, int wc, int fr, int fq) const {
        const int row0 = u.pm * BM + wr * 64 + fr, col0 = u.pn * BM + wc * 32 + 8 * fq;
#pragma unroll
        for (int ai = 0; ai < 2; ++ai)
#pragma unroll
            for (int m = 0; m < 4; ++m) { const size_t off = (size_t)(row0 + ai * HALF + m * 16) * 1024 + col0;
#pragma unroll
                for (int bj = 0; bj < 2; ++bj) { const u32x4 gw = __builtin_nontemporal_load((const u32x4*)(gate + off + bj * HALF)); u32x4 ow = (u32x4){0u, 0u, 0u, 0u}; if (ADD) ow = *(const u32x4*)(O + off + bj * HALF);
                    float r[8];
#pragma unroll
                    for (int e = 0; e < 8; ++e) { const unsigned g16 = (gw[e >> 1] >> ((e & 1) * 16)) & 0xffffu, o16 = (ow[e >> 1] >> ((e & 1) * 16)) & 0xffffu;
                        const float a = acc[ai][bj][m][e >> 2][e & 3]; r[e] = (ADD ? bfbits2f(o16) : 0.f) + sigm(bfbits2f(g16)) * a; }
                    u32x4 w; w.x = cvt_pk_bf16(r[0], r[1]); w.y = cvt_pk_bf16(r[2], r[3]); w.z = cvt_pk_bf16(r[4], r[5]); w.w = cvt_pk_bf16(r[6], r[7]);
                    *(u32x4*)(O + off + bj * HALF) = w; } }
    }
};
template <bool BF> struct EpiRes {
    static constexpr bool PERM = true, AFTER_DRAIN = false;
    const float* base0; const float* base1; const bf16_t* bb; bf16_t* hb; float* ssqp;
    __device__ __forceinline__ void operator()(const f32x4 (&acc)[2][2][4][2], const Unit& u, int wr, int wc, int fr, int fq) const {
        const int row0 = u.pm * BM + wr * 64 + fr, col0 = u.pn * BM + wc * 32 + 8 * fq; const float* base = u.pm < 64 ? base0 : base1;
#pragma unroll
        for (int ai = 0; ai < 2; ++ai)
#pragma unroll
            for (int m = 0; m < 4; ++m) { const int row = row0 + ai * HALF + m * 16; const size_t off = (size_t)row * 1024 + col0; float sq = 0.f;
#pragma unroll
                for (int bj = 0; bj < 2; ++bj) { const size_t o2 = off + bj * HALF; f32x4 b0, b1;
                    if (BF) { const u32x4 w = *(const u32x4*)(bb + o2); b0 = (f32x4){bfbits2f(w.x & 0xffffu), __uint_as_float(w.x & 0xffff0000u), bfbits2f(w.y & 0xffffu), __uint_as_float(w.y & 0xffff0000u)};
                        b1 = (f32x4){bfbits2f(w.z & 0xffffu), __uint_as_float(w.z & 0xffff0000u), bfbits2f(w.w & 0xffffu), __uint_as_float(w.w & 0xffff0000u)}; }
                    else { b0 = __builtin_nontemporal_load((const f32x4*)(base + o2)); b1 = __builtin_nontemporal_load((const f32x4*)(base + o2 + 4)); }
                    const f32x4 v0 = b0 + acc[ai][bj][m][0], v1 = b1 + acc[ai][bj][m][1];
                    sq += ((v0[0] * v0[0] + v0[1] * v0[1]) + (v0[2] * v0[2] + v0[3] * v0[3])) + ((v1[0] * v1[0] + v1[1] * v1[1]) + (v1[2] * v1[2] + v1[3] * v1[3]));
                    u32x4 w; w.x = cvt_pk_bf16(v0[0], v0[1]); w.y = cvt_pk_bf16(v0[2], v0[3]); w.z = cvt_pk_bf16(v1[0], v1[1]); w.w = cvt_pk_bf16(v1[2], v1[3]); *(u32x4*)(hb + o2) = w; }
                sq += __shfl_xor(sq, 16); sq += __shfl_xor(sq, 32);
                if (fq == 0) ssqp[(size_t)row * 16 + u.pn * 4 + wc] = sq; }
    }
};
struct EpiSwiglu {
    static constexpr bool PERM = true, AFTER_DRAIN = false;
    bf16_t* act; const float* ssq;
    __device__ __forceinline__ void operator()(const f32x4 (&acc)[2][2][4][2], const Unit& u, int wr, int wc, int fr, int fq) const {
        const int row0 = u.pm * BM + wr * 64 + fr, col0 = u.pn * 128 + wc * 16 + 4 * fq;
#pragma unroll
        for (int ai = 0; ai < 2; ++ai)
#pragma unroll
            for (int m = 0; m < 4; ++m) { const int row = row0 + ai * HALF + m * 16; const float rs = row_rs<16>(ssq, row);
#pragma unroll
                for (int bj = 0; bj < 2; ++bj) { const f32x4 a = acc[ai][bj][m][0] * rs, b = acc[ai][bj][m][1] * rs;
                    const float r0 = a[0] * sigm(a[0]) * a[1], r1 = a[2] * sigm(a[2]) * a[3], r2 = b[0] * sigm(b[0]) * b[1], r3 = b[2] * sigm(b[2]) * b[3];
                    u32x2 w; w.x = cvt_pk_bf16(r0, r1); w.y = cvt_pk_bf16(r2, r3); *(u32x2*)(act + (size_t)row * 2816 + col0 + bj * 64) = w; } }
    }
};
template <class Epi, class Sched, bool ALIGN_EPI = false, bool SP2 = false>
__device__ __forceinline__ void gemm_phase(PG8_LAS unsigned char* lds, const Gemm g, const Sched& S, const Epi& E) {
    const int tid = threadIdx.x, wid = __builtin_amdgcn_readfirstlane(tid >> 6), lane = tid & 63, wr = wid >> 2, wc = wid & 3, fr = lane & 15, fq = lane >> 4;
    const int K = g.K, nt = K / BK;
    unsigned voffA[2], voffB[2];
#pragma unroll
    for (int i = 0; i < 2; ++i) { int R, C; stage_rc(tid * 16 + i * 8192, R, C); const int Rb = Epi::PERM ? ((R & ~31) + perm32(R & 31)) : R;
        voffA[i] = (unsigned)(R * K + C) * 2u; voffB[i] = (unsigned)(Rb * K + C) * 2u; }
    const size_t kstep = (size_t)(BK * 2);
    const size_t hstep = (size_t)HALF * K * 2;
    const size_t tstep = 2 * hstep;
    const unsigned ldsw = (unsigned)wid * 1024u;
    const int aoff = lds_byte(wr * 64 + fr, fq * 8), boff = lds_byte(wc * 32 + fr, fq * 8);
#define PG8_SA(b, h) (((b) * 2 + (h)) * HTB)
#define PG8_SB(b, h) ((4 + (b) * 2 + (h)) * HTB)
#define PG8_STAGE(bufoff, gbase, voff) do { _Pragma("unroll") for (int _i = 0; _i < 2; ++_i) \
        __builtin_amdgcn_global_load_lds((const unsigned*)((const char*)(gbase) + (voff)[_i]), (PG8_LAS unsigned*)(lds + (bufoff) + ldsw + _i * 8192), 16, 0, 0); } while (0)
#define PG8_LDA(dst, b, h) do { _Pragma("unroll") for (int m = 0; m < 4; ++m) _Pragma("unroll") for (int k = 0; k < 2; ++k) dst[m][k] = *(const PG8_LAS bf16x8*)(lds + PG8_SA(b, h) + aoff + m * 2048 + k * 1024); } while (0)
#define PG8_LDB(dst, b, h) do { _Pragma("unroll") for (int n = 0; n < 2; ++n) _Pragma("unroll") for (int k = 0; k < 2; ++k) dst[n][k] = *(const PG8_LAS bf16x8*)(lds + PG8_SB(b, h) + boff + n * 2048 + k * 1024); } while (0)
#define PG8_MMA(ai, bj, At, Bt) do { __builtin_amdgcn_s_setprio(1); _Pragma("unroll") for (int m = 0; m < 4; ++m) _Pragma("unroll") for (int n = 0; n < 2; ++n) _Pragma("unroll") for (int k = 0; k < 2; ++k) \
        acc[ai][bj][m][n] = __builtin_amdgcn_mfma_f32_16x16x32_bf16(Bt[n][k], At[m][k], acc[ai][bj][m][n], 0, 0, 0); __builtin_amdgcn_s_setprio(0); } while (0)
#define PG8_WAIT_V(n) asm volatile("s_waitcnt vmcnt(" #n ")" ::: "memory")
#define PG8_WAIT_L(n) asm volatile("s_waitcnt lgkmcnt(" #n ")" ::: "memory")
#define PG8_BAR __builtin_amdgcn_s_barrier()
#define PG8_SCHED __builtin_amdgcn_sched_barrier(0)
    Unit cur, nxt; int ui = 0;
    if (!S.next(0, cur)) return;
    f32x4 acc[2][2][4][2];
#pragma unroll
    for (int a = 0; a < 2; ++a)
#pragma unroll
        for (int b = 0; b < 2; ++b)
#pragma unroll
            for (int m = 0; m < 4; ++m)
#pragma unroll
                for (int n = 0; n < 2; ++n) acc[a][b][m][n] = (f32x4){0.f, 0.f, 0.f, 0.f};
    bf16x8 At[4][2], B0[2][2], B1[2][2];
    const char* cA = (const char*)g.A + (size_t)cur.pm * tstep; const char* cB = (const char*)g.Bt + (size_t)cur.pn * tstep;
    S.a_ready(cur);
    if constexpr (SP2) {
        PG8_STAGE(PG8_SB(0, 0), cB, voffB); PG8_STAGE(PG8_SB(0, 1), cB + hstep, voffB); PG8_STAGE(PG8_SA(0, 0), cA, voffA); PG8_STAGE(PG8_SA(0, 1), cA + hstep, voffA);
        if (wr == 1) PG8_BAR;
        PG8_WAIT_V(2); PG8_BAR;
        PG8_STAGE(PG8_SB(1, 0), cB + kstep, voffB); PG8_STAGE(PG8_SA(1, 0), cA + kstep, voffA); PG8_STAGE(PG8_SB(1, 1), cB + hstep + kstep, voffB);
        PG8_WAIT_V(6); PG8_BAR;
    } else {
        PG8_STAGE(PG8_SB(0, 0), cB, voffB); PG8_STAGE(PG8_SA(0, 0), cA, voffA); PG8_STAGE(PG8_SB(0, 1), cB + hstep, voffB); PG8_STAGE(PG8_SA(0, 1), cA + hstep, voffA);
        if (wr == 1) PG8_BAR;
        PG8_WAIT_V(4); PG8_BAR;
        PG8_STAGE(PG8_SB(1, 0), cB + kstep, voffB); PG8_STAGE(PG8_SA(1, 0), cA + kstep, voffA); PG8_STAGE(PG8_SB(1, 1), cB + hstep + kstep, voffB);
        PG8_WAIT_V(6); PG8_BAR;
    }
    for (;;) {
        const bool has_next = S.next(ui + 1, nxt);
        const char* nA = has_next ? (const char*)g.A + (size_t)nxt.pm * tstep : cA; const char* nB = has_next ? (const char*)g.Bt + (size_t)nxt.pn * tstep : cB;
        for (int t = 0; t < nt; t += 2) {
            const bool last = (t == nt - 2);
            const char* a1 = cA + (size_t)(t + 1) * kstep;
            const char* a2 = last ? nA : cA + (size_t)(t + 2) * kstep; const char* b2 = last ? nB : cB + (size_t)(t + 2) * kstep;
            const char* a3 = a2 + kstep; const char* b3 = b2 + kstep;
            if (last && has_next) S.a_ready(nxt);
            if constexpr (SP2) {
            PG8_LDB(B0, 0, 0); PG8_LDB(B1, 0, 1); PG8_SCHED; PG8_LDA(At, 0, 0); PG8_STAGE(PG8_SA(1, 1), a1 + hstep, voffA);
            PG8_WAIT_V(8); PG8_WAIT_L(0); PG8_BAR; PG8_MMA(0, 0, At, B0); PG8_MMA(0, 1, At, B1); PG8_BAR; PG8_SCHED;
            PG8_LDA(At, 0, 1); PG8_STAGE(PG8_SB(0, 0), b2, voffB); PG8_STAGE(PG8_SB(0, 1), b2 + hstep, voffB); PG8_STAGE(PG8_SA(0, 0), a2, voffA);
            PG8_WAIT_V(8); PG8_WAIT_L(0); PG8_BAR; PG8_MMA(1, 0, At, B0); PG8_MMA(1, 1, At, B1); PG8_BAR; PG8_SCHED;
            PG8_LDB(B0, 1, 0); PG8_LDB(B1, 1, 1); PG8_SCHED; PG8_LDA(At, 1, 0); PG8_STAGE(PG8_SA(0, 1), a2 + hstep, voffA);
            PG8_WAIT_V(8); PG8_WAIT_L(0); PG8_BAR; PG8_MMA(0, 0, At, B0); PG8_MMA(0, 1, At, B1); PG8_BAR; PG8_SCHED;
            PG8_LDA(At, 1, 1); PG8_STAGE(PG8_SB(1, 0), b3, voffB); PG8_STAGE(PG8_SB(1, 1), b3 + hstep, voffB); PG8_STAGE(PG8_SA(1, 0), a3, voffA);
            PG8_WAIT_V(8); PG8_WAIT_L(0); PG8_BAR; PG8_MMA(1, 0, At, B0); PG8_MMA(1, 1, At, B1); PG8_BAR; PG8_SCHED;
            } else {
            PG8_LDB(B0, 0, 0); PG8_SCHED; PG8_LDA(At, 0, 0); PG8_STAGE(PG8_SA(1, 1), a1 + hstep, voffA);
            PG8_WAIT_L(8); PG8_BAR; PG8_WAIT_L(0); PG8_MMA(0, 0, At, B0); PG8_BAR; PG8_SCHED;
            PG8_LDB(B1, 0, 1); PG8_STAGE(PG8_SB(0, 0), b2, voffB);
            PG8_BAR; PG8_WAIT_L(0); PG8_MMA(0, 1, At, B1); PG8_BAR;
            PG8_LDA(At, 0, 1); PG8_STAGE(PG8_SA(0, 0), a2, voffA);
            PG8_BAR; PG8_WAIT_L(0); PG8_MMA(1, 0, At, B0); PG8_BAR; PG8_SCHED;
            PG8_STAGE(PG8_SB(0, 1), b2 + hstep, voffB);
            PG8_WAIT_V(6); PG8_BAR; PG8_MMA(1, 1, At, B1); PG8_BAR;
            PG8_LDB(B0, 1, 0); PG8_SCHED; PG8_LDA(At, 1, 0); PG8_STAGE(PG8_SA(0, 1), a2 + hstep, voffA);
            PG8_WAIT_L(8); PG8_BAR; PG8_WAIT_L(0); PG8_MMA(0, 0, At, B0); PG8_BAR; PG8_SCHED;
            PG8_LDB(B1, 1, 1); PG8_STAGE(PG8_SB(1, 0), b3, voffB);
            PG8_BAR; PG8_WAIT_L(0); PG8_MMA(0, 1, At, B1); PG8_BAR;
            PG8_LDA(At, 1, 1); PG8_STAGE(PG8_SA(1, 0), a3, voffA);
            PG8_BAR; PG8_WAIT_L(0); PG8_MMA(1, 0, At, B0); PG8_BAR; PG8_SCHED;
            PG8_STAGE(PG8_SB(1, 1), b3 + hstep, voffB);
            PG8_WAIT_V(6); PG8_BAR; PG8_MMA(1, 1, At, B1); PG8_BAR;
            }
        }
        if constexpr (ALIGN_EPI) { if (wr == 0) PG8_BAR; }
        if constexpr (!Epi::AFTER_DRAIN) { E(acc, cur, wr, wc, fr, fq); S.done(cur); }
        if (!has_next) break;
#pragma unroll
        for (int a = 0; a < 2; ++a)
#pragma unroll
            for (int b = 0; b < 2; ++b)
#pragma unroll
                for (int m = 0; m < 4; ++m)
#pragma unroll
                    for (int n = 0; n < 2; ++n) acc[a][b][m][n] = (f32x4){0.f, 0.f, 0.f, 0.f};
        cur = nxt; cA = nA; cB = nB; ++ui;
        if constexpr (ALIGN_EPI) { if (wr == 1) PG8_BAR; }
    }
    PG8_WAIT_V(0);
    if constexpr (!ALIGN_EPI) { if (wr == 0) PG8_BAR; }
    PG8_BAR;
    if constexpr (Epi::AFTER_DRAIN) { E.fused(acc, cur, wr, wc, fr, fq, lds, wid, lane); S.done(cur); }
#undef PG8_SA
#undef PG8_SB
#undef PG8_STAGE
#undef PG8_LDA
#undef PG8_LDB
#undef PG8_MMA
#undef PG8_WAIT_V
#undef PG8_WAIT_L
#undef PG8_BAR
#undef PG8_SCHED
}
}
#define GAS __attribute__((address_space(1)))
#define LAS __attribute__((address_space(3)))
typedef unsigned short bf16;
typedef unsigned v4u __attribute__((ext_vector_type(4)));
typedef float f32x4 __attribute__((ext_vector_type(4)));
typedef short bf16x8 __attribute__((ext_vector_type(8)));
typedef GAS unsigned gu32;
typedef GAS unsigned long long gu64;
#define RLX_AGENT __ATOMIC_RELAXED, __HIP_MEMORY_SCOPE_AGENT
#define LDS_WAIT() asm volatile("s_waitcnt lgkmcnt(0)" ::: "memory")
#define VM_WAIT() asm volatile("s_waitcnt vmcnt(0)" ::: "memory")
__device__ __forceinline__ unsigned long long rt() { return __builtin_amdgcn_s_memrealtime(); }
typedef float f32x2_t __attribute__((ext_vector_type(2))); typedef __bf16 bf16x2_t __attribute__((ext_vector_type(2)));
__device__ __forceinline__ unsigned pk2(float lo, float hi) { const f32x2_t v = {lo, hi}; const bf16x2_t b = __builtin_convertvector(v, bf16x2_t); return __builtin_bit_cast(unsigned, b); }
__device__ __forceinline__ unsigned f2bf(float f) { return pk2(f, 0.f) & 0xffffu; }

#define XB_TMO      128
#define XB_XCNT(j)  (256  + 64 * (j))
#define XB_XSUB(j)  (1280 + 64 * (j))
#define XB_XGEN(j)  (2304 + 64 * (j))
#define XB_TOP      3328
#define XB_TOPGEN   3392
#define XCD_BAR_WORDS 3456
#define XB_SPIN_CAP (1u << 18)

__device__ __forceinline__ unsigned xb_ld(unsigned* p)              { return __hip_atomic_load(p, __ATOMIC_RELAXED, __HIP_MEMORY_SCOPE_AGENT); }
__device__ __forceinline__ unsigned xb_add(unsigned* p, unsigned v) { return __hip_atomic_fetch_add(p, v, __ATOMIC_RELAXED, __HIP_MEMORY_SCOPE_AGENT); }
__device__ __forceinline__ unsigned xb_xcc_id() { return (unsigned)__builtin_amdgcn_s_getreg((3 << 11) | 20) & 0xFu; }
#define XB_SPIN(cond, bar) do { unsigned _sp = 0; while (cond) { __builtin_amdgcn_s_sleep(1); \
    if ((++_sp & 255u) == 0u) { if (xb_ld(&(bar)[XB_TMO])) break; if (_sp > XB_SPIN_CAP) { atomicAdd(&(bar)[XB_TMO], 1u); break; } } } } while (0)

struct XcdBarrier {
    unsigned* bar; unsigned x;
    volatile LAS unsigned* st;
};

__device__ __forceinline__ XcdBarrier xcd_barrier_post(unsigned* bar, volatile LAS unsigned* st) {
    XcdBarrier b; b.bar = bar; b.x = xb_xcc_id(); b.st = st;
    if (threadIdx.x == 0) (void)xb_add(&bar[XB_XCNT(b.x)], 1u);
    return b;
}
__device__ __forceinline__ void xcd_barrier_complete(unsigned* bar, unsigned x, unsigned& nloc, unsigned& nx) {
    const unsigned G = gridDim.x * gridDim.y * gridDim.z;
    unsigned sum, cnt, mine, sp = 0u;
    for (;;) {
        sum = 0u; cnt = 0u; mine = 0u;
#pragma unroll
        for (unsigned j = 0; j < 16; ++j) { const unsigned c = xb_ld(&bar[XB_XCNT(j)]); sum += c; cnt += (c > 0u) ? 1u : 0u; mine = (j == x) ? c : mine; }
        if (sum == G) break;
        __builtin_amdgcn_s_sleep(1);
        if ((++sp & 255u) == 0u) { if (xb_ld(&bar[XB_TMO])) break; if (sp > XB_SPIN_CAP) { atomicAdd(&bar[XB_TMO], 1u); break; } }
    }
    nloc = mine > 0u ? mine : 1u; nx = cnt > 0u ? cnt : 1u;
}

__device__ __forceinline__ void xcd_barrier(const XcdBarrier& b) {
    asm volatile("s_waitcnt vmcnt(0)" ::: "memory");
    __syncthreads();
    if (threadIdx.x == 0) {
        unsigned* bar = b.bar;
        __builtin_amdgcn_s_waitcnt(0);
        unsigned nloc = b.st[0], nx = b.st[1];
        if (nloc == 0u) { xcd_barrier_complete(bar, b.x, nloc, nx); b.st[0] = nloc; b.st[1] = nx; }
        const unsigned old = xb_add(&bar[XB_XSUB(b.x)], 1u);
        const unsigned gen = old / nloc;
        if (old + 1u == (gen + 1u) * nloc) {
            __builtin_amdgcn_fence(__ATOMIC_RELEASE, "agent");
            asm volatile("s_waitcnt vmcnt(0)" ::: "memory");
            const unsigned og = xb_add(&bar[XB_TOP], 1u);
            const unsigned tg = og / nx;
            if (og + 1u == (tg + 1u) * nx) xb_add(&bar[XB_TOPGEN], 1u);
            else XB_SPIN(xb_ld(&bar[XB_TOPGEN]) == tg, bar);
            __builtin_amdgcn_fence(__ATOMIC_ACQUIRE, "agent");
            xb_add(&bar[XB_XGEN(b.x)], 1u);
            asm volatile("s_waitcnt vmcnt(0)" ::: "memory");
        } else {
            XB_SPIN(xb_ld(&bar[XB_XGEN(b.x)]) == gen, bar);
            __builtin_amdgcn_fence(__ATOMIC_ACQUIRE, "agent");
            asm volatile("s_waitcnt vmcnt(0)" ::: "memory");
        }
    }
    __syncthreads();
}
typedef unsigned v2u __attribute__((ext_vector_type(2)));
constexpr int NWAVES = 8, NTHR = 512;
constexpr int DM = 1024, TP = 16384, TS = 512, T = TP + TS;
constexpr int SEQ = 2048, NBP = 8, NBS = 128, LS = 4, MEMR = 2048;
constexpr int NPROJ = 11520;
constexpr int FFN = 2816;
constexpr float EPS = 1e-6f;
constexpr float QSCALE = 0.0625f * 1.4426950408889634f;

constexpr size_t MiB = 1u << 20;
constexpr size_t WS_CTL = 0, CTL_ZERO_BYTES = 32768;
constexpr size_t WS_SSQX = 1 * MiB, WS_SSQM = 1 * MiB + 512 * 1024;
constexpr size_t WS_DT = 2 * MiB, WS_SSQSSD = 5 * MiB, WS_SSQP1 = 8 * MiB, WS_SSQP2 = 9 * MiB + 512 * 1024, WS_SSQP3 = 11 * MiB;
constexpr size_t WS_WIN = 13 * MiB, WS_WKV = 36 * MiB, WS_WSSD = 40 * MiB, WS_WHG = 44 * MiB, WS_WOUT = 46 * MiB, WS_WCQ = 48 * MiB, WS_WCO = 50 * MiB, WS_WGU = 52 * MiB, WS_WDN = 63 * MiB;
constexpr size_t WS_XB = 69 * MiB, WS_MNB = 102 * MiB, WS_KB = 106 * MiB, WS_VT = 110 * MiB;
constexpr size_t SLOT = 33 * MiB, SLOT_ELEMS = (size_t)T * 1024;
constexpr size_t WS_PROJ = 114 * MiB;
constexpr size_t WS_YG = WS_PROJ + 11 * SLOT, WS_ON = WS_YG + 2 * SLOT, WS_END = WS_ON + SLOT;
static_assert(SLOT == SLOT_ELEMS * 2, "slot size");
static_assert(WS_WIN + (size_t)NPROJ * 1024 * 2 <= WS_WKV && WS_WGU + (size_t)2 * FFN * 1024 * 2 <= WS_WDN && WS_WDN + (size_t)1024 * FFN * 2 <= WS_XB && WS_SSQP3 + (size_t)T * 64 <= WS_WIN, "d_ws map");
static_assert(WS_DT + (size_t)T * 128 <= WS_SSQSSD && WS_SSQSSD + (size_t)T * 128 <= WS_SSQP1 && WS_SSQP1 + (size_t)T * 64 <= WS_SSQP2 && WS_SSQP2 + (size_t)T * 64 <= WS_SSQP3, "d_ws map 2");
enum { S_Z0 = 0, S_Z1 = 1, S_X0 = 2, S_X1 = 3, S_X2 = 4, S_Q = 5, S_F = 6, S_I = 7, S_HG = 8, S_GS = 9, S_GH = 10 };
constexpr size_t WS_MERGED = WS_PROJ + S_Q * SLOT, WS_HB = WS_PROJ + S_F * SLOT, WS_QB = WS_PROJ + S_I * SLOT, WS_OB = WS_PROJ + S_HG * SLOT, WS_ACT = WS_PROJ;
static_assert((size_t)T * FFN * 2 <= 3 * SLOT, "act overlay");
constexpr size_t O_Y = 0, O_SSMP = (size_t)T * 1024, O_CONVP = O_SSMP + 2097152, O_HGP = O_CONVP + 73728, O_MKP = O_HGP + 1048576, O_MVP = O_MKP + 2097152,
                 O_SSMS = O_MVP + 2097152, O_CONVS = O_SSMS + 33554432, O_HGS = O_CONVS + 1179648, O_END = O_HGS + 16777216;
constexpr int CW_QUEUE = 64;
constexpr int CW_BAR = 4096;
constexpr int RING_OFF = 0, RING_BYTES = 131072;
constexpr int LDS_BYTES = 147456;
constexpr int LDSCTL_OFF = LDS_BYTES - 1024, MISC_OFF = LDSCTL_OFF + 320;
struct Frame {
    LAS unsigned char* lds;
    volatile LAS unsigned* MISC;
    gu32* ctl;
    int tid, lane, wave;
    int vcu, G;
    const float* in[32];
    float* out; unsigned char* ws;
};
__device__ __forceinline__ float bf2f(unsigned v16) { return __uint_as_float(v16 << 16); }
__device__ __forceinline__ f32x4 ld_nt(const float* p) { return __builtin_nontemporal_load((const f32x4*)p); }
__device__ __forceinline__ void st_nt(float* p, f32x4 v) { __builtin_nontemporal_store(v, (f32x4*)p); }
__device__ __forceinline__ v4u ld_nt16(const void* p) { return __builtin_nontemporal_load((const v4u*)p); }
__device__ __forceinline__ unsigned ld_nt4(const void* p) { return __builtin_nontemporal_load((const unsigned*)p); }
__device__ __forceinline__ float sigmoid_f(float x) { return __builtin_amdgcn_rcpf(1.0f + __expf(-x)); }
__device__ __forceinline__ float silu_f(float x) { return x * sigmoid_f(x); }
__device__ __forceinline__ float wave_sum(float v) {
#pragma unroll
    for (int o = 1; o < 64; o <<= 1) v += __shfl_xor(v, o);
    return v;
}
__device__ __forceinline__ float wave_max(float v) {
#pragma unroll
    for (int o = 1; o < 64; o <<= 1) v = fmaxf(v, __shfl_xor(v, o));
    return v;
}
struct TSrc { const float* W; const float* W2; const float* ks; int ldw; int mode; };
__device__ __forceinline__ void p0_transpose_item(const TSrc& s, int K, int N, bf16* WT, LAS unsigned short* scr, int item, int lane) {
    const int nblk = N / 64, kb = item / nblk, nb = item % nblk, k0 = 64 * kb, n0 = 64 * nb;
    const int kr = lane >> 4, nq = lane & 15;
    const float* const Wa = s.W; const float* const Wb = s.W2;
    const float* src; int c0, cs; bool zero = false;
    if (s.mode == 2) { const float* wsel = Wa; if (nq >= 8) wsel = Wb; src = wsel + (n0 >> 1) + 4 * (nq & 7); c0 = 8 * (nq & 7) + (nq >> 3); cs = 2; }
    else { const int n = n0 + 4 * nq; c0 = 4 * nq; cs = 1;
        if (s.mode == 0) src = Wa + n;
        else if (s.mode == 1) { if (n < 5120) src = Wa + n; else if (n < 11264) src = Wa + n + 32; else if (n < 11296) src = Wa + 5120 + (n - 11264); else { src = Wa; zero = true; } }
        else { src = Wa + n; if (n >= 1024) src = Wb + (n - 1024); } }
    f32x4 v[16];
#pragma unroll
    for (int i = 0; i < 16; ++i) v[i] = zero ? (f32x4){0.f, 0.f, 0.f, 0.f} : ld_nt(src + (size_t)(k0 + 4 * i + kr) * s.ldw);
#pragma unroll
    for (int i = 0; i < 16; ++i) { const int kk = 4 * i + kr; const float sc = s.ks ? s.ks[k0 + kk] : 1.0f; const unsigned w0 = pk2(v[i].x * sc, v[i].y * sc), w1 = pk2(v[i].z * sc, v[i].w * sc);
        LAS unsigned short* d = scr + kk * 66 + c0;
        if (cs == 1) { *(LAS unsigned*)d = w0; *(LAS unsigned*)(d + 2) = w1; }
        else { d[0] = (unsigned short)(w0 & 0xffffu); d[2] = (unsigned short)(w0 >> 16); d[4] = (unsigned short)(w1 & 0xffffu); d[6] = (unsigned short)(w1 >> 16); } }
    LDS_WAIT(); asm volatile("" ::: "memory");
    const int nr = lane >> 3, kc = lane & 7;
#pragma unroll
    for (int j = 0; j < 8; ++j) { const int n = 8 * j + nr; const LAS unsigned short* p = scr + (8 * kc) * 66 + n;
        v4u o; o.x = (unsigned)p[0] | ((unsigned)p[66] << 16); o.y = (unsigned)p[2 * 66] | ((unsigned)p[3 * 66] << 16); o.z = (unsigned)p[4 * 66] | ((unsigned)p[5 * 66] << 16); o.w = (unsigned)p[6 * 66] | ((unsigned)p[7 * 66] << 16);
        *(v4u*)(WT + (size_t)(n0 + n) * K + k0 + 8 * kc) = o; }
    LDS_WAIT(); asm volatile("" ::: "memory");
}
__device__ __forceinline__ void rows4_to_bf16_ssq(const float* x0, bf16* o0, float* ssq0, int lane) {
    f32x4 v[4][4];
#pragma unroll
    for (int rr = 0; rr < 4; ++rr)
#pragma unroll
        for (int j = 0; j < 4; ++j) v[rr][j] = ld_nt(x0 + rr * 1024 + 4 * (64 * j + lane));
#pragma unroll
    for (int rr = 0; rr < 4; ++rr) { float sq = 0.f;
#pragma unroll
        for (int j = 0; j < 4; ++j) sq += (v[rr][j].x * v[rr][j].x + v[rr][j].y * v[rr][j].y) + (v[rr][j].z * v[rr][j].z + v[rr][j].w * v[rr][j].w);
        sq = wave_sum(sq);
        unsigned long long* o8 = (unsigned long long*)(o0 + rr * 1024) + lane;
#pragma unroll
        for (int j = 0; j < 4; ++j) o8[64 * j] = (unsigned long long)pk2(v[rr][j].x, v[rr][j].y) | ((unsigned long long)pk2(v[rr][j].z, v[rr][j].w) << 32);
        if (lane == 0) ssq0[rr] = sq; }
}
__device__ __forceinline__ void p0_prologue(Frame& F) {
    LAS unsigned short* scr = (LAS unsigned short*)(F.lds + RING_OFF + F.wave * 16384);
    const int gw = F.vcu * NWAVES + F.wave, NGW = F.G * NWAVES;
    unsigned char* ws = F.ws;
    constexpr int I_IN = 16 * (NPROJ / 64), I_KV = 16 * 32, I_SSD = 32 * 16, I_SQ = 16 * 16, I_GU = 16 * (2 * FFN / 64), I_DN = (FFN / 64) * 16;
    constexpr int NITEMS = I_IN + I_KV + I_SSD + 4 * I_SQ + I_GU + I_DN;
    for (int it = gw; it < NITEMS; it += NGW) {
        int r = it;
        if (r < I_IN) { TSrc s{F.in[9], nullptr, F.in[8], 11296, 1}; p0_transpose_item(s, 1024, NPROJ, (bf16*)(ws + WS_WIN), scr, r, F.lane); continue; } r -= I_IN;
        if (r < I_KV) { TSrc s{F.in[24], F.in[25], F.in[22], 1024, 3}; p0_transpose_item(s, 1024, 2048, (bf16*)(ws + WS_WKV), scr, r, F.lane); continue; } r -= I_KV;
        if (r < I_SSD) { TSrc s{F.in[16], nullptr, F.in[15], 1024, 0}; p0_transpose_item(s, 2048, 1024, (bf16*)(ws + WS_WSSD), scr, r, F.lane); continue; } r -= I_SSD;
        if (r < I_SQ) { TSrc s{F.in[19], nullptr, F.in[18], 1024, 0}; p0_transpose_item(s, 1024, 1024, (bf16*)(ws + WS_WHG), scr, r, F.lane); continue; } r -= I_SQ;
        if (r < I_SQ) { TSrc s{F.in[20], nullptr, nullptr, 1024, 0}; p0_transpose_item(s, 1024, 1024, (bf16*)(ws + WS_WOUT), scr, r, F.lane); continue; } r -= I_SQ;
        if (r < I_SQ) { TSrc s{F.in[23], nullptr, F.in[21], 1024, 0}; p0_transpose_item(s, 1024, 1024, (bf16*)(ws + WS_WCQ), scr, r, F.lane); continue; } r -= I_SQ;
        if (r < I_SQ) { TSrc s{F.in[26], nullptr, nullptr, 1024, 0}; p0_transpose_item(s, 1024, 1024, (bf16*)(ws + WS_WCO), scr, r, F.lane); continue; } r -= I_SQ;
        if (r < I_GU) { TSrc s{F.in[28], F.in[29], F.in[27], FFN, 2}; p0_transpose_item(s, 1024, 2 * FFN, (bf16*)(ws + WS_WGU), scr, r, F.lane); continue; } r -= I_GU;
        { TSrc s{F.in[30], nullptr, nullptr, 1024, 0}; p0_transpose_item(s, FFN, 1024, (bf16*)(ws + WS_WDN), scr, r, F.lane); }
    }
    bf16* XB = (bf16*)(ws + WS_XB); float* SSQX = (float*)(ws + WS_SSQX);
    for (int m4 = gw; m4 < T / 4; m4 += NGW) { const int m = 4 * m4;
        rows4_to_bf16_ssq(m < TP ? F.in[0] + (size_t)m * DM : F.in[1] + (size_t)(m - TP) * DM, XB + (size_t)m * DM, SSQX + m, F.lane); }
    bf16* MNB = (bf16*)(ws + WS_MNB); float* SSQM = (float*)(ws + WS_SSQM);
    for (int m4 = gw; m4 < MEMR / 4; m4 += NGW) { const int m = 4 * m4; rows4_to_bf16_ssq(F.in[2] + (size_t)m * DM, MNB + (size_t)m * DM, SSQM + m, F.lane); }
}
__device__ __forceinline__ void conv_copy_unit(Frame& F, int gb) {
    const bf16* PROJ = (const bf16*)(F.ws + WS_PROJ);
    const bool prompt = gb < NBP; const int sb = gb - NBP;
    const size_t row0 = prompt ? (size_t)gb * SEQ + (SEQ - 3) : (size_t)TP + (size_t)sb * LS + 1;
    float* dst = prompt ? F.out + O_CONVP + (size_t)gb * 3 * 3072 : F.out + O_CONVS + (size_t)sb * 3 * 3072;
    for (int e = F.tid; e < 3 * 3072; e += NTHR) { const int j = e / 3072, col = e % 3072;
        dst[e] = bf2f(PROJ[(size_t)(S_X0 + (col >> 10)) * SLOT_ELEMS + (row0 + j) * 1024 + (col & 1023)]); }
}
__device__ __forceinline__ void ssdnorm_phase(Frame& F) {
    const int gw = F.vcu * NWAVES + F.wave, NGW = F.G * NWAVES; bf16* YG = (bf16*)(F.ws + WS_YG); const float* SSQ = (const float*)(F.ws + WS_SSQSSD);
    for (int row = gw; row < T; row += NGW) {
        const f32x4* sp = (const f32x4*)(SSQ + (size_t)row * 32);
#pragma unroll
        for (int j = 0; j < 4; ++j) { const f32x4 a = sp[2 * j], b = sp[2 * j + 1]; const float s = ((a.x + a.y) + (a.z + a.w)) + ((b.x + b.y) + (b.z + b.w)); const float rs = 1.0f / sqrtf(s * (1.0f / 512.0f) + EPS);
            v4u* p = (v4u*)(YG + (size_t)row * 2048) + j * 64 + F.lane; const v4u w = *p; v4u o;
#pragma unroll
            for (int e = 0; e < 4; ++e) o[e] = pk2(bf2f(w[e] & 0xffffu) * rs, bf2f(w[e] >> 16) * rs);
            *p = o; }
    }
}
typedef float f32x16 __attribute__((ext_vector_type(16)));
#define MFMA32(a, b, c) __builtin_amdgcn_mfma_f32_32x32x16_bf16((a), (b), (c), 0, 0, 0)
__device__ __forceinline__ unsigned cvtpk_c(float lo, float hi) { return pk2(lo, hi); }
__device__ __forceinline__ bf16x8 pack8(float a0, float a1, float a2, float a3, float a4, float a5, float a6, float a7) {
    v4u w; w.x = cvtpk_c(a0, a1); w.y = cvtpk_c(a2, a3); w.z = cvtpk_c(a4, a5); w.w = cvtpk_c(a6, a7); return __builtin_bit_cast(bf16x8, w); }
#define ACC_FRAG(x, s) pack8((x)[8 * (s)], (x)[8 * (s) + 1], (x)[8 * (s) + 2], (x)[8 * (s) + 3], (x)[8 * (s) + 4], (x)[8 * (s) + 5], (x)[8 * (s) + 6], (x)[8 * (s) + 7])
__device__ __forceinline__ bf16x8 lds_frag16(const LAS unsigned char* p) { return *(const LAS bf16x8*)p; }
__device__ __forceinline__ bf16x8 lds_frag8x2(const LAS unsigned char* p) { const v2u lo = *(const LAS v2u*)p, hi = *(const LAS v2u*)(p + 16);
    const v4u w = (v4u){lo.x, lo.y, hi.x, hi.y}; return __builtin_bit_cast(bf16x8, w); }
#define LDS_BARRIER() do { asm volatile("s_waitcnt lgkmcnt(0)" ::: "memory"); __builtin_amdgcn_s_barrier(); asm volatile("" ::: "memory"); } while (0)
constexpr size_t WS_BCS = WS_END, WS_BTT = WS_BCS + (size_t)TP * 1024 * 2, WS_END2 = WS_BTT + (size_t)NBP * 32 * 4 * 128 * 64 * 2;
__device__ __forceinline__ void bc_prep_unit(Frame& F, int b, int c) {
    typedef float f32x2 __attribute__((ext_vector_type(2)));
    int tid_o = F.tid; asm volatile("" : "+v"(tid_o));
    const int tid = tid_o, cg = tid & 127, seg = tid >> 7; unsigned char* ws = F.ws;
    const bf16* src = (const bf16*)(ws + WS_PROJ) + (size_t)S_X2 * SLOT_ELEMS + (size_t)b * SEQ * 1024 + 8 * cg;
    bf16* BCS = (bf16*)(ws + WS_BCS); bf16* BTT = (bf16*)(ws + WS_BTT);
    const float* cw = F.in[10] + 2048 + 8 * cg; const float* cbp = F.in[11] + 2048 + 8 * cg;
#pragma unroll 1
    for (int half = 0; half < 2; ++half) {
        const int s0 = 16 * seg + 8 * half;
        v4u raw[11];
#pragma unroll
        for (int i = 0; i < 11; ++i) { const int gt = 64 * c + s0 - 3 + i; raw[i] = (v4u){0u, 0u, 0u, 0u}; if (gt >= 0) raw[i] = ld_nt16(src + (size_t)gt * 1024); }
        v4u rowpk[8];
#pragma unroll
        for (int kp = 0; kp < 4; ++kp) {
            const f32x2 cw0 = *(const f32x2*)(cw + 2 * kp), cw1 = *(const f32x2*)(cw + 3072 + 2 * kp), cw2 = *(const f32x2*)(cw + 2 * 3072 + 2 * kp), cw3 = *(const f32x2*)(cw + 3 * 3072 + 2 * kp), cbb = *(const f32x2*)(cbp + 2 * kp);
            f32x2 xv[11];
#pragma unroll
            for (int i = 0; i < 11; ++i) { const unsigned wd = raw[i][kp]; xv[i] = (f32x2){__uint_as_float(wd << 16), __uint_as_float(wd & 0xffff0000u)}; }
            f32x2 o[8];
#pragma unroll
            for (int i = 0; i < 8; ++i) { f32x2 a = cw0 * xv[i] + cbb; a = cw1 * xv[i + 1] + a; a = cw2 * xv[i + 2] + a; a = cw3 * xv[i + 3] + a;
                const f32x2 t = a * (-1.4426950408889634f); f32x2 e; e.x = __builtin_amdgcn_exp2f(t.x); e.y = __builtin_amdgcn_exp2f(t.y); e = e + 1.0f;
                f32x2 rc; rc.x = __builtin_amdgcn_rcpf(e.x); rc.y = __builtin_amdgcn_rcpf(e.y); o[i] = a * rc; }
#pragma unroll
            for (int i = 0; i < 8; ++i) rowpk[i][kp] = pk2(o[i].x, o[i].y);
            if (cg < 64) { const int ng = 8 * cg + 2 * kp, g = ng >> 7, n = ng & 127;
                bf16* dst = BTT + ((size_t)(((b * 32 + c) * 4 + g) * 128 + n)) * 64 + s0;
                v4u pa; pa.x = pk2(o[0].x, o[1].x); pa.y = pk2(o[2].x, o[3].x); pa.z = pk2(o[4].x, o[5].x); pa.w = pk2(o[6].x, o[7].x); *(v4u*)dst = pa;
                v4u pb; pb.x = pk2(o[0].y, o[1].y); pb.y = pk2(o[2].y, o[3].y); pb.z = pk2(o[4].y, o[5].y); pb.w = pk2(o[6].y, o[7].y); *(v4u*)(dst + 64) = pb; }
        }
        bf16* drow = BCS + ((size_t)b * SEQ + 64 * c + s0) * 1024 + 8 * cg;
#pragma unroll
        for (int i = 0; i < 8; ++i) *(v4u*)(drow + (size_t)i * 1024) = rowpk[i];
    }
}
__device__ __forceinline__ void bc_prep_phase(Frame& F) { for (int u = F.vcu; u < NBP * 32; u += F.G) bc_prep_unit(F, u >> 5, u & 31); }
constexpr size_t WS_HVT = WS_XB, WS_EGM = WS_END2, WS_EGL = WS_EGM + (size_t)NBP * 64 * 1024 * 4, WS_END3 = WS_EGL + (size_t)NBP * 64 * 1024 * 4;
__device__ __forceinline__ void hg_prep_unit(Frame& F, int b, int c) {
    typedef float f32x2 __attribute__((ext_vector_type(2)));
    int tid_o = F.tid; asm volatile("" : "+v"(tid_o));
    const int tid = tid_o; unsigned char* ws = F.ws;
    const int ch = 2 * tid;
    const size_t row0 = (size_t)b * SEQ + 32 * c;
    bf16* QS = (bf16*)(ws + WS_PROJ) + (size_t)S_Q * SLOT_ELEMS + row0 * 1024 + ch; bf16* FS = (bf16*)(ws + WS_PROJ) + (size_t)S_F * SLOT_ELEMS + row0 * 1024 + ch;
    const f32x2 l0 = *(const f32x2*)(F.in[17] + ch), l1 = *(const f32x2*)(F.in[17] + 1024 + ch);
    f32x2 lb; lb.x = __builtin_amdgcn_rcpf(1.0f + __expf(l1.x - l0.x)); lb.y = __builtin_amdgcn_rcpf(1.0f + __expf(l1.y - l0.y));
    const f32x2 omlb = 1.0f - lb;
    f32x2 P[32]; f32x2 run = (f32x2){1.0f, 1.0f};
#pragma unroll
    for (int t = 0; t < 32; ++t) { const unsigned wd = ld_nt4(FS + (size_t)t * 1024);
        f32x2 u = (f32x2){__uint_as_float(wd << 16), __uint_as_float(wd & 0xffff0000u)}; u.x = fminf(fmaxf(u.x, -30.f), 30.f); u.y = fminf(fmaxf(u.y, -30.f), 30.f);
        const f32x2 tt = u * (-1.4426950408889634f); f32x2 e; e.x = __builtin_amdgcn_exp2f(tt.x); e.y = __builtin_amdgcn_exp2f(tt.y); e = e + 1.0f;
        f32x2 sg; sg.x = __builtin_amdgcn_rcpf(e.x); sg.y = __builtin_amdgcn_rcpf(e.y);
        const f32x2 fg = lb + omlb * sg; run = run * fg; run.x = fmaxf(run.x, 1e-30f); run.y = fmaxf(run.y, 1e-30f); P[t] = run; }
    const f32x2 Pm = P[15], Pl = P[31]; f32x2 rPm; rPm.x = __builtin_amdgcn_rcpf(Pm.x); rPm.y = __builtin_amdgcn_rcpf(Pm.y);
    *(f32x2*)((float*)(ws + WS_EGM) + (size_t)(b * 64 + c) * 1024 + ch) = Pm; *(f32x2*)((float*)(ws + WS_EGL) + (size_t)(b * 64 + c) * 1024 + ch) = Pl * rPm;
    f32x2 rPprev = (f32x2){1.0f, 1.0f};
#pragma unroll
    for (int t = 0; t < 32; ++t) { f32x2 rP; rP.x = __builtin_amdgcn_rcpf(P[t].x); rP.y = __builtin_amdgcn_rcpf(P[t].y);
        const f32x2 e1 = P[t] * rPm, e2 = Pm * rP, fg = P[t] * rPprev, kk = 1.0f - fg; rPprev = rP;
        const unsigned qw = ld_nt4(QS + (size_t)t * 1024); const f32x2 q = (f32x2){__uint_as_float(qw << 16), __uint_as_float(qw & 0xffff0000u)};
        const f32x2 tq = q * (-1.4426950408889634f); f32x2 eq; eq.x = __builtin_amdgcn_exp2f(tq.x); eq.y = __builtin_amdgcn_exp2f(tq.y); eq = eq + 1.0f;
        f32x2 rq; rq.x = __builtin_amdgcn_rcpf(eq.x); rq.y = __builtin_amdgcn_rcpf(eq.y);
        const f32x2 qa = q * rq * e1, ka = kk * e2;
        *(unsigned*)(QS + (size_t)t * 1024) = pk2(qa.x, qa.y); *(unsigned*)(FS + (size_t)t * 1024) = pk2(ka.x, ka.y); }
}
__device__ __forceinline__ void hg_prep_phase(Frame& F) { for (int u = F.vcu; u < NBP * 64; u += F.G) hg_prep_unit(F, u >> 6, u & 63); }
constexpr int HV_QA = 0, HV_KA = 8704, HV_KAT = 17408, HV_VT = 27648, HV_EGM = 30208, HV_EGL = 30720, HV_PBUF = 31232, HV_OB = 2 * HV_PBUF, HV_OBUF = 23040;
constexpr size_t WS_SSQH = WS_END3, WS_END4 = WS_SSQH + (size_t)T * 32 * 4;
__device__ __forceinline__ void hgrn_v_unit(Frame& F, int b, int hd, int vt) {
    int tid_o = F.tid; asm volatile("" : "+v"(tid_o));
    const int tid = tid_o, lane = tid & 63, w = F.wave, r = lane & 31, hh = lane >> 5; unsigned char* ws = F.ws;
    LAS unsigned char* Lb = F.lds + RING_OFF;
    const bf16* PROJ = (const bf16*)(ws + WS_PROJ); bf16* OU = (bf16*)(ws + WS_ON); float* SSQH = (float*)(ws + WS_SSQH);
    const size_t rowb = (size_t)b * SEQ;
    const int pt_t = tid & 31, pt_g = tid >> 5;
    const bf16* qsrc = PROJ + (size_t)S_Q * SLOT_ELEMS + (rowb + pt_t) * 1024 + hd * 128 + 8 * pt_g;
    const bf16* ksrc = PROJ + (size_t)S_F * SLOT_ELEMS + (rowb + pt_t) * 1024 + hd * 128 + 8 * pt_g;
    const unsigned char* xsrc = nullptr; size_t xstr = 0;
    if (tid < 128) { xsrc = (const unsigned char*)(PROJ + (size_t)S_I * SLOT_ELEMS + (rowb + pt_t) * 1024 + hd * 128 + 32 * vt + 8 * pt_g); xstr = (size_t)32 * 1024 * 2; }
    else if (tid < 160) { xsrc = (const unsigned char*)((const float*)(ws + WS_EGM) + (size_t)b * 64 * 1024 + hd * 128 + 4 * (tid - 128)); xstr = 4096; }
    else if (tid < 192) { xsrc = (const unsigned char*)((const float*)(ws + WS_EGL) + (size_t)b * 64 * 1024 + hd * 128 + 4 * (tid - 160)); xstr = 4096; }
    const int o_img = pt_t * 272 + 16 * pt_g, o_tr = (8 * pt_g) * 80 + 2 * pt_t;
#define HGV_LOAD(cc, pq, pk, px) { pq = *(const v4u*)(qsrc + (size_t)(cc) * 32 * 1024); pk = *(const v4u*)(ksrc + (size_t)(cc) * 32 * 1024); if (tid < 192) px = *(const v4u*)(xsrc + (size_t)(cc) * xstr); }
#define HGV_TR(dst, v) { _Pragma("unroll") for (int e = 0; e < 8; ++e) *(LAS unsigned short*)((dst) + 80 * e) = (unsigned short)(((v)[e >> 1] >> (16 * (e & 1))) & 0xffffu); }
#define HGV_STORE(pb, pq, pk, px) { *(LAS v4u*)((pb) + HV_QA + o_img) = pq; *(LAS v4u*)((pb) + HV_KA + o_img) = pk; HGV_TR((pb) + HV_KAT + o_tr, pk) \
        if (tid < 128) { HGV_TR((pb) + HV_VT + o_tr, px) } else if (tid < 160) { *(LAS v4u*)((pb) + HV_EGM + 16 * (tid - 128)) = px; } else if (tid < 192) { *(LAS v4u*)((pb) + HV_EGL + 16 * (tid - 160)) = px; } }
    v4u pqA, pkA, pxA = (v4u){0u, 0u, 0u, 0u}, pqB, pkB, pxB = (v4u){0u, 0u, 0u, 0u};
    HGV_LOAD(0, pqA, pkA, pxA) HGV_STORE(Lb, pqA, pkA, pxA)
    HGV_LOAD(1, pqA, pkA, pxA) HGV_LOAD(2, pqB, pkB, pxB)
    const int kt = w;
    v2u ow_pend = (v2u){0u, 0u}; float sq_pend = 0.f;
    f32x16 S;
#pragma unroll
    for (int i = 0; i < 16; ++i) S[i] = 0.f;
    __syncthreads();
#define HGV_ITER(c, pq, pk, px) { \
        int r_l = r, hh_l = hh, tid_l = tid; asm volatile("" : "+v"(r_l), "+v"(hh_l), "+v"(tid_l)); \
        { const int r = r_l, hh = hh_l, tid = tid_l; \
        LAS unsigned char* pbc = Lb + ((c) & 1) * HV_PBUF; LAS unsigned char* pbn = Lb + (((c) + 1) & 1) * HV_PBUF; \
        if ((c) < 63) { HGV_STORE(pbn, pq, pk, px) if ((c) < 61) HGV_LOAD((c) + 3, pq, pk, px) } \
        if (w < 4) { \
            LAS float* EGM = (LAS float*)(pbc + HV_EGM); LAS float* EGL = (LAS float*)(pbc + HV_EGL); LAS float* OB = (LAS float*)(Lb + HV_OB + ((c) & 1) * HV_OBUF); \
            _Pragma("unroll") \
            for (int q4 = 0; q4 < 4; ++q4) { const f32x4 e0 = *(const LAS f32x4*)(EGM + 32 * kt + 8 * q4 + 4 * hh); \
                _Pragma("unroll") \
                for (int j = 0; j < 4; ++j) S[4 * q4 + j] *= e0[j]; } \
            f32x16 o; \
            _Pragma("unroll") \
            for (int i = 0; i < 16; ++i) o[i] = 0.f; \
            const LAS unsigned char* qa_row = pbc + HV_QA + r * 272; \
            o = MFMA32(lds_frag8x2(qa_row + (32 * kt + 4 * hh) * 2), ACC_FRAG(S, 0), o); \
            o = MFMA32(lds_frag8x2(qa_row + (32 * kt + 16 + 4 * hh) * 2), ACC_FRAG(S, 1), o); \
            LAS float* ob = OB + (kt * 32) * 36 + r; \
            _Pragma("unroll") \
            for (int i = 0; i < 16; ++i) ob[((i & 3) + 8 * (i >> 2) + 4 * hh) * 36] = o[i]; \
            const LAS unsigned char* kat_nat = pbc + HV_KAT + (32 * kt + r) * 80 + hh * 16; const LAS unsigned char* vt_nat = pbc + HV_VT + r * 80 + hh * 16; \
            S = MFMA32(lds_frag16(kat_nat), lds_frag16(vt_nat), S); S = MFMA32(lds_frag16(kat_nat + 32), lds_frag16(vt_nat + 32), S); \
            _Pragma("unroll") \
            for (int q4 = 0; q4 < 4; ++q4) { const f32x4 e0 = *(const LAS f32x4*)(EGL + 32 * kt + 8 * q4 + 4 * hh); \
                _Pragma("unroll") \
                for (int j = 0; j < 4; ++j) S[4 * q4 + j] *= e0[j]; } \
        } else { \
            if (w == 4) { LAS float* OB = (LAS float*)(Lb + HV_OB + ((c) & 1) * HV_OBUF); f32x16 o; \
                _Pragma("unroll") \
                for (int i = 0; i < 16; ++i) o[i] = 0.f; \
                f32x16 X; \
                _Pragma("unroll") \
                for (int i = 0; i < 16; ++i) X[i] = 0.f; \
                const LAS unsigned char* ka_nat = pbc + HV_KA + r * 272 + hh * 16; const LAS unsigned char* qa_nat = pbc + HV_QA + r * 272 + hh * 16; \
                _Pragma("unroll 2") \
                for (int ks = 0; ks < 8; ++ks) X = MFMA32(lds_frag16(ka_nat + ks * 32), lds_frag16(qa_nat + ks * 32), X); \
                _Pragma("unroll") \
                for (int i = 0; i < 16; ++i) { const int srow = (i & 3) + 8 * (i >> 2) + 4 * hh; X[i] = (srow <= r) ? X[i] : 0.f; } \
                const LAS unsigned char* vt_row = pbc + HV_VT + r * 80; \
                o = MFMA32(ACC_FRAG(X, 0), lds_frag8x2(vt_row + (4 * hh) * 2), o); \
                o = MFMA32(ACC_FRAG(X, 1), lds_frag8x2(vt_row + (16 + 4 * hh) * 2), o); \
                LAS float* ob4 = OB + (4 * 32) * 36 + r; \
                _Pragma("unroll") \
                for (int i = 0; i < 16; ++i) ob4[((i & 3) + 8 * (i >> 2) + 4 * hh) * 36] = o[i]; \
            } \
            if ((c) > 1) { HGV_FLUSH((c) - 2) } \
            if ((c) > 0) { HGV_OUT((c) - 1) } \
        } \
        LDS_BARRIER(); \
        } }
#define HGV_OUT(cp) { const LAS float* OB = (const LAS float*)(Lb + HV_OB + ((cp) & 1) * HV_OBUF); const int tl = tid - 256, t = tl >> 3, v0 = (tl & 7) * 4; \
            const f32x4 a = *(const LAS f32x4*)(OB + t * 36 + v0), b2 = *(const LAS f32x4*)(OB + (32 + t) * 36 + v0), c2 = *(const LAS f32x4*)(OB + (64 + t) * 36 + v0), d2 = *(const LAS f32x4*)(OB + (96 + t) * 36 + v0), e2 = *(const LAS f32x4*)(OB + (128 + t) * 36 + v0); \
            const f32x4 o4 = ((a + b2) + (c2 + d2)) + e2; \
            float sq = (o4.x * o4.x + o4.y * o4.y) + (o4.z * o4.z + o4.w * o4.w); sq += __shfl_xor(sq, 1); sq += __shfl_xor(sq, 2); sq += __shfl_xor(sq, 4); \
            sq_pend = sq; ow_pend.x = pk2(o4.x, o4.y); ow_pend.y = pk2(o4.z, o4.w); }
#define HGV_FLUSH(cp) { const int tl = tid - 256, t = tl >> 3, v0 = (tl & 7) * 4; const size_t row = rowb + 32 * (cp) + t; \
            if ((tl & 7) == 0) SSQH[row * 32 + hd * 4 + vt] = sq_pend; *(v2u*)(OU + row * 1024 + hd * 128 + 32 * vt + v0) = ow_pend; }
#pragma unroll 1
    for (int cc = 0; cc < 64; cc += 2) { HGV_ITER(cc, pqA, pkA, pxA) HGV_ITER(cc + 1, pqB, pkB, pxB) }
    if (w >= 4) { HGV_FLUSH(62) HGV_OUT(63) HGV_FLUSH(63) }
#undef HGV_ITER
#undef HGV_OUT
#undef HGV_FLUSH
#undef HGV_LOAD
#undef HGV_STORE
#undef HGV_TR
    if (w < 4) { float* st_g = F.out + O_HGP + (size_t)(b * 8 + hd) * 16384 + 32 * vt + r;
#pragma unroll
        for (int i = 0; i < 16; ++i) { const int k = 32 * kt + (i & 3) + 8 * (i >> 2) + 4 * hh; st_g[(size_t)k * 128] = S[i]; } }
    __syncthreads();
}
__device__ __forceinline__ void hgnorm_phase(Frame& F) {
    const int gw = F.vcu * NWAVES + F.wave, NGW = F.G * NWAVES; bf16* ON = (bf16*)(F.ws + WS_ON); const float* SSQH = (const float*)(F.ws + WS_SSQH);
    const bf16* HG = (const bf16*)(F.ws + WS_PROJ) + (size_t)S_HG * SLOT_ELEMS;
    for (int row = gw; row < TP; row += NGW) {
#pragma unroll
        for (int j = 0; j < 2; ++j) { const int pc = j * 64 + F.lane, hd = pc >> 4;
            const f32x4 sp = *(const f32x4*)(SSQH + (size_t)row * 32 + hd * 4); const float rs = __builtin_amdgcn_rsqf(((sp.x + sp.y) + (sp.z + sp.w)) * (1.0f / 128.0f) + EPS);
            v4u* p = (v4u*)(ON + (size_t)row * 1024) + pc; const v4u o = *p; const v4u g = ld_nt16((const v4u*)(HG + (size_t)row * 1024) + pc); v4u res;
#pragma unroll
            for (int e = 0; e < 4; ++e) res[e] = pk2(bf2f(o[e] & 0xffffu) * rs * silu_f(bf2f(g[e] & 0xffffu)), __uint_as_float(o[e] & 0xffff0000u) * rs * silu_f(__uint_as_float(g[e] & 0xffff0000u)));
            *p = res; }
    }
}
constexpr int SD_BN = 0, SD_CN = 17408, SD_BT = 34816, SD_XT = 53248, SD_HT = 62464, SD_YA = 97280, SD_YY = 113664, SD_YO = 130048, SD_CUM = 134144, SD_DTV = 134400, SD_ECUM = 134656, SD_XWT = 134912, SD_CWL = 144128;
__device__ __forceinline__ void ssd_unit_mfma(Frame& F, int gb, int h) {
    int tid_o = F.tid; asm volatile("" : "+v"(tid_o));
    const int tid = tid_o, lane = tid & 63, w = F.wave, r = lane & 31, hh = lane >> 5; unsigned char* ws = F.ws;
    const int L = SEQ; const size_t row_base = (size_t)gb * SEQ;
    const int g = h >> 3;
    LAS unsigned char* Lb = F.lds + RING_OFF;
    LAS unsigned short* BN = (LAS unsigned short*)(Lb + SD_BN); LAS unsigned short* CN = (LAS unsigned short*)(Lb + SD_CN);
    LAS unsigned short* BT = (LAS unsigned short*)(Lb + SD_BT); LAS unsigned short* XT = (LAS unsigned short*)(Lb + SD_XT);
    LAS unsigned short* HT = (LAS unsigned short*)(Lb + SD_HT);
    LAS unsigned short* XWT = (LAS unsigned short*)(Lb + SD_XWT);
    LAS float* YA = (LAS float*)(Lb + SD_YA); LAS float* YY = (LAS float*)(Lb + SD_YY); LAS unsigned short* YO = (LAS unsigned short*)(Lb + SD_YO);
    LAS float* CUM = (LAS float*)(Lb + SD_CUM); LAS float* DTV = (LAS float*)(Lb + SD_DTV); LAS float* ECUM = (LAS float*)(Lb + SD_ECUM);
    const bf16* PROJ = (const bf16*)(ws + WS_PROJ); const float* DTR = (const float*)(ws + WS_DT); bf16* YG = (bf16*)(ws + WS_YG); float* SSQ = (float*)(ws + WS_SSQSSD);
    const int nt = w >> 1, pt = w & 1;
    f32x16 H;
    float* st_g = F.out + O_SSMP + (size_t)(gb * 32 + h) * 8192 + (size_t)(32 * pt + r) * 128 + 32 * nt + 4 * hh;
#pragma unroll
    for (int i = 0; i < 16; ++i) H[i] = 0.f;
    {
        LAS unsigned short* hp = HT + (32 * pt + r) * 136 + 32 * nt + 4 * hh;
#pragma unroll
        for (int q4 = 0; q4 < 4; ++q4) { v2u pk; pk.x = cvtpk_c(H[4 * q4], H[4 * q4 + 1]); pk.y = cvtpk_c(H[4 * q4 + 2], H[4 * q4 + 3]); *(LAS v2u*)(hp + 8 * q4) = pk; }
    }
    const float a = -__expf(F.in[13][h]), dtb = F.in[12][h], Dk = F.in[14][h];
    const float* cw = F.in[10]; const float* cbp = F.in[11];
    const int cgl = tid & 7, xs = tid >> 3;
    const int col = h * 64 + 8 * cgl;
    const bf16* cptr = PROJ + (size_t)(S_X0 + (col >> 10)) * SLOT_ELEMS + row_base * 1024 + (col & 1023);
    const bf16* BCS = (const bf16*)(ws + WS_BCS) + row_base * 1024 + g * 128; const bf16* BTT = (const bf16*)(ws + WS_BTT) + (size_t)(gb * 32 * 4 + g) * 128 * 64;
    v4u xr[4], pc[6];
#pragma unroll
    for (int i = 0; i < 4; ++i) { const int gt = xs - 3 + i; xr[i] = (v4u){0u, 0u, 0u, 0u}; if (gt >= 0) xr[i] = *(const v4u*)(cptr + (size_t)gt * 1024); }
#pragma unroll
    for (int j = 0; j < 6; ++j) { const int idx = (tid + 512 * j) & 1023;
        if (j < 4) pc[j] = *(const v4u*)(BCS + (size_t)(idx >> 4) * 1024 + (j >> 1) * 512 + 8 * (idx & 15));
        else pc[j] = *(const v4u*)(BTT + (size_t)(idx >> 3) * 64 + 8 * (idx & 7)); }
    LAS float* CWL = (LAS float*)(Lb + SD_CWL);
    if (tid < 320) { const int j = tid >> 6, c = tid & 63; CWL[tid] = j < 4 ? cw[j * 3072 + h * 64 + c] : cbp[h * 64 + c]; }
    __syncthreads();
    v4u ow_pend = (v4u){0u, 0u, 0u, 0u}; float sq_pend = 0.f; bool pend = false;
    int buf = 0;
    float dt_pf = 0.f;
    if (lane < L) dt_pf = DTR[(row_base + lane) * 32 + h];
    for (int t0 = 0; t0 < L; t0 += 64, buf ^= 1) {
        int r_l = r, hh_l = hh, tid_l = tid, lane_l = lane;
        asm volatile("" : "+v"(r_l), "+v"(hh_l), "+v"(tid_l), "+v"(lane_l));
        { const int r = r_l, hh = hh_l, tid = tid_l, lane = lane_l;
        float dtv = 0.f;
        if (t0 + lane < L) { const float x = dt_pf + dtb; dtv = fmaxf(x, 0.f) + 0.6931471805599453f * __builtin_amdgcn_logf(1.0f + __builtin_amdgcn_exp2f(-1.4426950408889634f * fabsf(x))); }
        dt_pf = 0.f; if (t0 + 64 + lane < L) dt_pf = DTR[(row_base + t0 + 64 + lane) * 32 + h];
        v4u zw = (v4u){0u, 0u, 0u, 0u};
        if (t0 + (tid >> 3) < L) zw = ld_nt16(PROJ + (size_t)(S_Z0 + (h >> 4)) * SLOT_ELEMS + (row_base + t0 + (tid >> 3)) * 1024 + (h & 15) * 64 + (tid & 7) * 8);
        float cum = dtv * a;
#pragma unroll
        for (int o = 1; o < 64; o <<= 1) { const float u = __shfl_up(cum, o); if (lane >= o) cum += u; }
        const float cum_last = __shfl(cum, 63);
        const float wgt = __expf(cum_last - cum) * dtv;
        if (w == 0) { CUM[lane] = cum; DTV[lane] = dtv; ECUM[lane] = __expf(cum); }
#pragma unroll
        for (int j = 0; j < 6; ++j) { const int idx = (tid + 512 * j) & 1023;
            if (j < 2) *(LAS v4u*)(BN + (idx >> 4) * 136 + 8 * (idx & 15)) = pc[j];
            else if (j < 4) *(LAS v4u*)(CN + (idx >> 4) * 136 + 8 * (idx & 15)) = pc[j];
            else *(LAS v4u*)(BT + (idx >> 3) * 72 + 8 * (idx & 7)) = pc[j]; }
        if (pend) { const size_t prow = row_base + (t0 - 64) + (tid >> 3);
            *(v4u*)(YG + prow * 2048 + h * 64 + (tid & 7) * 8) = ow_pend; if ((tid & 7) == 0) SSQ[prow * 32 + h] = sq_pend; pend = false; }
        { const int xs = tid >> 3, cgl = tid & 7; const float wx = __shfl(wgt, xs); typedef float f32x2 __attribute__((ext_vector_type(2)));
#pragma unroll
          for (int kp = 0; kp < 4; ++kp) {
              const LAS float* wl = CWL + 8 * cgl + 2 * kp;
              const f32x2 cw0 = *(const LAS f32x2*)wl, cw1 = *(const LAS f32x2*)(wl + 64), cw2 = *(const LAS f32x2*)(wl + 128), cw3 = *(const LAS f32x2*)(wl + 192), cbb = *(const LAS f32x2*)(wl + 256);
              f32x2 xv[4];
#pragma unroll
              for (int i = 0; i < 4; ++i) { const unsigned wd = xr[i][kp]; xv[i] = (f32x2){__uint_as_float(wd << 16), __uint_as_float(wd & 0xffff0000u)}; }
              f32x2 a = cw0 * xv[0] + cbb; a = cw1 * xv[1] + a; a = cw2 * xv[2] + a; a = cw3 * xv[3] + a;
              const f32x2 t = a * (-1.4426950408889634f); f32x2 e; e.x = __builtin_amdgcn_exp2f(t.x); e.y = __builtin_amdgcn_exp2f(t.y); e = e + 1.0f;
              f32x2 rc; rc.x = __builtin_amdgcn_rcpf(e.x); rc.y = __builtin_amdgcn_rcpf(e.y); const f32x2 o = a * rc, ow = o * wx;
              const unsigned po = pk2(o.x, o.y), pw = pk2(ow.x, ow.y); const int p = 8 * cgl + 2 * kp;
              XT[p * 72 + xs] = (unsigned short)(po & 0xffffu); XT[(p + 1) * 72 + xs] = (unsigned short)(po >> 16);
              XWT[p * 72 + xs] = (unsigned short)(pw & 0xffffu); XWT[(p + 1) * 72 + xs] = (unsigned short)(pw >> 16); }
        }
        if (t0 + 64 < L) {
#pragma unroll
            for (int i = 0; i < 4; ++i) xr[i] = ld_nt16(cptr + (size_t)(t0 + 64 + (tid >> 3) - 3 + i) * 1024);
            const int chn = (t0 >> 6) + 1;
#pragma unroll
            for (int j = 0; j < 6; ++j) { const int idx = (tid + 512 * j) & 1023;
                if (j < 4) pc[j] = *(const v4u*)(BCS + (size_t)(t0 + 64 + (idx >> 4)) * 1024 + (j >> 1) * 512 + 8 * (idx & 15));
                else pc[j] = *(const v4u*)(BTT + ((size_t)chn * 4 * 128 + (idx >> 3)) * 64 + 8 * (idx & 7)); }
        }
        LDS_BARRIER();
        if (w < 3) {
            const int tt = w == 0 ? 0 : 1, st = w == 1 ? 1 : 0;
            f32x16 X, ya0, ya1;
#pragma unroll
            for (int i = 0; i < 16; ++i) { X[i] = 0.f; ya0[i] = 0.f; ya1[i] = 0.f; }
            const LAS unsigned char* cn_nat = Lb + SD_CN + (32 * tt + r) * 272 + hh * 16; const LAS unsigned char* bn_nat = Lb + SD_BN + (32 * st + r) * 272 + hh * 16;
#pragma unroll 2
            for (int ks = 0; ks < 8; ++ks) X = MFMA32(lds_frag16(bn_nat + ks * 32), lds_frag16(cn_nat + ks * 32), X);
            const float cum_t = CUM[32 * tt + r];
#pragma unroll
            for (int q4 = 0; q4 < 4; ++q4) { const f32x4 cs = *(const LAS f32x4*)(CUM + 32 * st + 8 * q4 + 4 * hh), ds = *(const LAS f32x4*)(DTV + 32 * st + 8 * q4 + 4 * hh);
#pragma unroll
                for (int jj = 0; jj < 4; ++jj) { const int s_abs = 32 * st + 8 * q4 + 4 * hh + jj; const float f = __expf(fminf(cum_t - cs[jj], 0.f)) * ds[jj]; X[4 * q4 + jj] = (s_abs <= 32 * tt + r) ? X[4 * q4 + jj] * f : 0.f; } }
            const bf16x8 xf0 = ACC_FRAG(X, 0), xf1 = ACC_FRAG(X, 1);
            const LAS unsigned char* xt_row = Lb + SD_XT + r * 144 + (32 * st + 4 * hh) * 2;
            ya0 = MFMA32(xf0, lds_frag8x2(xt_row), ya0); ya0 = MFMA32(xf1, lds_frag8x2(xt_row + 32), ya0);
            ya1 = MFMA32(xf0, lds_frag8x2(xt_row + 32 * 144), ya1); ya1 = MFMA32(xf1, lds_frag8x2(xt_row + 32 * 144 + 32), ya1);
            if (w < 2) { LAS float* yb = YA + (32 * tt + 4 * hh) * 64 + r;
#pragma unroll
                for (int i = 0; i < 16; ++i) { yb[((i & 3) + 8 * (i >> 2)) * 64] = ya0[i]; yb[((i & 3) + 8 * (i >> 2)) * 64 + 32] = ya1[i]; } }
            else { LAS unsigned short* yb = YO + (4 * hh) * 64 + r;
#pragma unroll
                for (int i = 0; i < 16; ++i) { yb[((i & 3) + 8 * (i >> 2)) * 64] = (unsigned short)f2bf(ya0[i]); yb[((i & 3) + 8 * (i >> 2)) * 64 + 32] = (unsigned short)f2bf(ya1[i]); } }
        } else if (w >= 4) {
            const int tt = (w - 4) >> 1, ptj = w & 1;
            const LAS unsigned char* ht_nat = Lb + SD_HT + buf * 17408 + (32 * ptj + r) * 272 + hh * 16;
            f32x16 yi;
#pragma unroll
            for (int i = 0; i < 16; ++i) yi[i] = 0.f;
            const LAS unsigned char* cn_nat = Lb + SD_CN + (32 * tt + r) * 272 + hh * 16;
#pragma unroll 2
            for (int ks = 0; ks < 8; ++ks) yi = MFMA32(lds_frag16(cn_nat + ks * 32), lds_frag16(ht_nat + ks * 32), yi);
            const LAS unsigned short* xt_p = XT + (32 * ptj + r) * 72 + 32 * tt + 4 * hh;
#pragma unroll
            for (int q4 = 0; q4 < 4; ++q4) { const f32x4 ec = *(const LAS f32x4*)(ECUM + 32 * tt + 8 * q4 + 4 * hh); const v2u xw = *(const LAS v2u*)(xt_p + 8 * q4);
                const float x0 = bf2f(xw.x & 0xffffu), x1 = bf2f(xw.x >> 16), x2 = bf2f(xw.y & 0xffffu), x3 = bf2f(xw.y >> 16);
                LAS float* yb = YY + (32 * tt + 8 * q4 + 4 * hh) * 64 + 32 * ptj + r;
                yb[0] = ec[0] * yi[4 * q4] + Dk * x0; yb[64] = ec[1] * yi[4 * q4 + 1] + Dk * x1; yb[128] = ec[2] * yi[4 * q4 + 2] + Dk * x2; yb[192] = ec[3] * yi[4 * q4 + 3] + Dk * x3; }
        }
        {
            const float el = __expf(CUM[63]);
#pragma unroll
            for (int i = 0; i < 16; ++i) H[i] *= el;
            const LAS unsigned char* bt_nat = Lb + SD_BT + (32 * nt + r) * 144 + hh * 16; const LAS unsigned char* xt_nat = Lb + SD_XWT + (32 * pt + r) * 144 + hh * 16;
#pragma unroll
            for (int s2 = 0; s2 < 4; ++s2) H = MFMA32(lds_frag16(bt_nat + s2 * 32), lds_frag16(xt_nat + s2 * 32), H);
            LAS unsigned short* hp = HT + (buf ^ 1) * 8704 + (32 * pt + r) * 136 + 32 * nt + 4 * hh;
#pragma unroll
            for (int q4 = 0; q4 < 4; ++q4) { v2u pk; pk.x = cvtpk_c(H[4 * q4], H[4 * q4 + 1]); pk.y = cvtpk_c(H[4 * q4 + 2], H[4 * q4 + 3]); *(LAS v2u*)(hp + 8 * q4) = pk; }
        }
        LDS_BARRIER();
        { const int tt = tid >> 3, p0 = (tid & 7) * 8;
          if (t0 + tt < L) { const size_t row = row_base + t0 + tt;
            f32x4 y0 = *(const LAS f32x4*)(YA + tt * 64 + p0) + *(const LAS f32x4*)(YY + tt * 64 + p0), y1 = *(const LAS f32x4*)(YA + tt * 64 + p0 + 4) + *(const LAS f32x4*)(YY + tt * 64 + p0 + 4);
            if (tt >= 32) { const v4u ow4 = *(const LAS v4u*)(YO + (tt - 32) * 64 + p0);
                y0 = y0 + (f32x4){bf2f(ow4.x & 0xffffu), __uint_as_float(ow4.x & 0xffff0000u), bf2f(ow4.y & 0xffffu), __uint_as_float(ow4.y & 0xffff0000u)};
                y1 = y1 + (f32x4){bf2f(ow4.z & 0xffffu), __uint_as_float(ow4.z & 0xffff0000u), bf2f(ow4.w & 0xffffu), __uint_as_float(ow4.w & 0xffff0000u)}; }
            float o[8]; float sq = 0.f;
#pragma unroll
            for (int j = 0; j < 8; ++j) { const unsigned z16 = (zw[j >> 1] >> ((j & 1) * 16)) & 0xffffu; const float yv = (j < 4 ? y0[j & 3] : y1[j & 3]) * silu_f(bf2f(z16)); o[j] = yv; sq += yv * yv; }
            ow_pend.x = pk2(o[0], o[1]); ow_pend.y = pk2(o[2], o[3]); ow_pend.z = pk2(o[4], o[5]); ow_pend.w = pk2(o[6], o[7]);
            sq += __shfl_xor(sq, 1); sq += __shfl_xor(sq, 2); sq += __shfl_xor(sq, 4); sq_pend = sq; pend = true; } }
        }
    }
    if (pend) { const size_t prow = row_base + (L - 64) + (tid >> 3); *(v4u*)(YG + prow * 2048 + h * 64 + (tid & 7) * 8) = ow_pend; if ((tid & 7) == 0) SSQ[prow * 32 + h] = sq_pend; }
#pragma unroll
    for (int q4 = 0; q4 < 4; ++q4) *(f32x4*)(st_g + 8 * q4) = (f32x4){H[4 * q4], H[4 * q4 + 1], H[4 * q4 + 2], H[4 * q4 + 3]};
    __syncthreads();
}
__device__ __forceinline__ float tr_reduce32(const float (&v)[32], int lane) {
    const bool b4 = lane & 16, b3 = lane & 8, b2 = lane & 4, b1 = lane & 2, b0 = lane & 1;
    float a[16], b[8], c[4], d[2];
#pragma unroll
    for (int i = 0; i < 16; ++i) { const float keep = b4 ? v[i + 16] : v[i], send = b4 ? v[i] : v[i + 16]; a[i] = keep + __shfl_xor(send, 16); }
#pragma unroll
    for (int i = 0; i < 8; ++i) { const float keep = b3 ? a[i + 8] : a[i], send = b3 ? a[i] : a[i + 8]; b[i] = keep + __shfl_xor(send, 8); }
#pragma unroll
    for (int i = 0; i < 4; ++i) { const float keep = b2 ? b[i + 4] : b[i], send = b2 ? b[i] : b[i + 4]; c[i] = keep + __shfl_xor(send, 4); }
#pragma unroll
    for (int i = 0; i < 2; ++i) { const float keep = b1 ? c[i + 2] : c[i], send = b1 ? c[i] : c[i + 2]; d[i] = keep + __shfl_xor(send, 2); }
    const float keep = b0 ? d[1] : d[0], send = b0 ? d[0] : d[1];
    return keep + __shfl_xor(send, 1);
}
__device__ __forceinline__ void ssd_sample_unit(Frame& F, int sb, int g) {
    int tid_o = F.tid; asm volatile("" : "+v"(tid_o));
    const int tid = tid_o, lane = tid & 63, w = F.wave, hh = lane >> 5, nq = lane & 31; unsigned char* ws = F.ws;
    LAS float* XC = (LAS float*)(F.lds + RING_OFF); LAS float* BC = XC + 8 * 4 * 64; LAS float* CC = BC + 4 * 128; LAS float* DTS = CC + 4 * 128;
    const bf16* PROJ = (const bf16*)(ws + WS_PROJ); const float* DTR = (const float*)(ws + WS_DT); bf16* YG = (bf16*)(ws + WS_YG); float* SSQ = (float*)(ws + WS_SSQSSD);
    const size_t row0 = (size_t)TP + (size_t)sb * LS;
    const int h = 8 * g + w;
    const float* sp = F.in[3] + (size_t)(sb * 32 + h) * 8192 + (size_t)hh * 128 + 4 * nq;
    f32x4 hst[32];
#pragma unroll
    for (int i = 0; i < 32; ++i) hst[i] = ld_nt(sp + (size_t)i * 256);
    if (tid < 384) { typedef float f32x2 __attribute__((ext_vector_type(2)));
        const int col = tid < 256 ? g * 512 + 2 * tid : (tid < 320 ? 2048 + g * 128 + 2 * (tid - 256) : 2560 + g * 128 + 2 * (tid - 320));
        const float* cw = F.in[10]; const float* sc = F.in[4] + (size_t)sb * 3 * 3072 + col;
        const f32x2 w0 = *(const f32x2*)(cw + col), w1 = *(const f32x2*)(cw + 3072 + col), w2 = *(const f32x2*)(cw + 2 * 3072 + col), w3 = *(const f32x2*)(cw + 3 * 3072 + col), cb = *(const f32x2*)(F.in[11] + col);
        f32x2 full[7]; full[0] = *(const f32x2*)sc; full[1] = *(const f32x2*)(sc + 3072); full[2] = *(const f32x2*)(sc + 2 * 3072);
        const bf16* cp = PROJ + (size_t)(S_X0 + (col >> 10)) * SLOT_ELEMS + row0 * 1024 + (col & 1023);
#pragma unroll
        for (int t = 0; t < 4; ++t) { const unsigned wd = *(const unsigned*)(cp + (size_t)t * 1024); full[3 + t] = (f32x2){__uint_as_float(wd << 16), __uint_as_float(wd & 0xffff0000u)}; }
#pragma unroll
        for (int t = 0; t < 4; ++t) { f32x2 a = w0 * full[t] + cb; a = w1 * full[t + 1] + a; a = w2 * full[t + 2] + a; a = w3 * full[t + 3] + a;
            f32x2 o; o.x = silu_f(a.x); o.y = silu_f(a.y);
            LAS float* dst = tid < 256 ? XC + ((tid >> 5) * 4 + t) * 64 + 2 * (tid & 31) : (tid < 320 ? BC + t * 128 + 2 * (tid - 256) : CC + t * 128 + 2 * (tid - 320));
            *(LAS f32x2*)dst = o; }
    } else if (tid < 416) { const int idx = tid - 384, hl = idx >> 2, t = idx & 3; const float x = DTR[(row0 + t) * 32 + 8 * g + hl] + F.in[12][8 * g + hl]; DTS[idx] = x > 20.f ? x : log1pf(__expf(x)); }
    __syncthreads();
    const float a = -__expf(F.in[13][h]), Dk = F.in[14][h];
#pragma unroll 1
    for (int t = 0; t < 4; ++t) {
        const float dtv = DTS[w * 4 + t], dA = __expf(dtv * a);
        const f32x4 Bv = *(const LAS f32x4*)(BC + t * 128 + 4 * nq), Cv = *(const LAS f32x4*)(CC + t * 128 + 4 * nq);
        const LAS float* xrow = XC + (w * 4 + t) * 64;
        float part[32];
#pragma unroll
        for (int i = 0; i < 32; ++i) { const float xd = xrow[2 * i + hh] * dtv; hst[i] = hst[i] * dA + Bv * xd; part[i] = (hst[i].x * Cv.x + hst[i].y * Cv.y) + (hst[i].z * Cv.z + hst[i].w * Cv.w); }
        float yv = tr_reduce32(part, lane);
        const int p = 2 * nq + hh; const size_t row = row0 + t;
        yv += Dk * xrow[p];
        const float z = bf2f(PROJ[(size_t)(S_Z0 + (h >> 4)) * SLOT_ELEMS + row * 1024 + (h & 15) * 64 + p]);
        const float yg = yv * silu_f(z);
        YG[row * 2048 + h * 64 + p] = (bf16)f2bf(yg);
        const float sq = wave_sum(yg * yg);
        if (lane == 0) SSQ[row * 32 + h] = sq;
    }
    float* so = F.out + O_SSMS + (size_t)(sb * 32 + h) * 8192 + (size_t)hh * 128 + 4 * nq;
#pragma unroll
    for (int i = 0; i < 32; ++i) st_nt(so + (size_t)i * 256, hst[i]);
    __syncthreads();
}
__device__ __forceinline__ void hgrn_sample_unit(Frame& F, int sb, int hq) {
    int tid_o = F.tid; asm volatile("" : "+v"(tid_o));
    const int tid = tid_o, lane = tid & 63, w = F.wave, hh = lane >> 5, vq = lane & 31; unsigned char* ws = F.ws;
    LAS float* FS = (LAS float*)(F.lds + RING_OFF); LAS float* KS = FS + 2048; LAS float* QS = KS + 2048; LAS float* VS = QS + 2048; LAS float* OP = VS + 2048;
    const bf16* PROJ = (const bf16*)(ws + WS_PROJ); bf16* ON = (bf16*)(ws + WS_ON);
    const size_t row0 = (size_t)TP + (size_t)sb * LS;
    const int hl = w >> 1, kh = w & 1, hd = 4 * hq + hl;
    const float* sp = F.in[5] + (size_t)(sb * 8 + hd) * 16384 + (size_t)(64 * kh + hh) * 128 + 4 * vq;
    f32x4 S[32];
#pragma unroll
    for (int i = 0; i < 32; ++i) S[i] = ld_nt(sp + (size_t)i * 256);
    { const int ch = hq * 512 + tid; const float lb = __builtin_amdgcn_rcpf(1.0f + __expf(F.in[17][1024 + ch] - F.in[17][ch]));
      const bf16* fp = PROJ + (size_t)S_F * SLOT_ELEMS + row0 * 1024 + ch; const bf16* qp = PROJ + (size_t)S_Q * SLOT_ELEMS + row0 * 1024 + ch; const bf16* ip = PROJ + (size_t)S_I * SLOT_ELEMS + row0 * 1024 + ch;
#pragma unroll
      for (int t = 0; t < 4; ++t) { const float u = fminf(fmaxf(bf2f(fp[(size_t)t * 1024]), -30.f), 30.f); const float fg = lb + (1.0f - lb) * sigmoid_f(u);
          const int o = ((tid >> 7) * 4 + t) * 128 + (tid & 127);
          FS[o] = fg; KS[o] = 1.0f - fg; QS[o] = silu_f(bf2f(qp[(size_t)t * 1024])); VS[o] = bf2f(ip[(size_t)t * 1024]); } }
    __syncthreads();
#pragma unroll 1
    for (int t = 0; t < 4; ++t) {
        const int o = (hl * 4 + t) * 128;
        const f32x4 vv = *(const LAS f32x4*)(VS + o + 4 * vq);
        f32x4 oa = (f32x4){0.f, 0.f, 0.f, 0.f};
#pragma unroll
        for (int i = 0; i < 32; ++i) { const int k = 64 * kh + 2 * i + hh; const float fk = FS[o + k], kv = KS[o + k], qk = QS[o + k]; S[i] = S[i] * fk + vv * kv; oa = oa + S[i] * qk; }
        oa.x += __shfl_xor(oa.x, 32); oa.y += __shfl_xor(oa.y, 32); oa.z += __shfl_xor(oa.z, 32); oa.w += __shfl_xor(oa.w, 32);
        if (hh == 0) *(LAS f32x4*)(OP + ((hl * 4 + t) * 2 + kh) * 128 + 4 * vq) = oa;
    }
    float* so = F.out + O_HGS + (size_t)(sb * 8 + hd) * 16384 + (size_t)(64 * kh + hh) * 128 + 4 * vq;
#pragma unroll
    for (int i = 0; i < 32; ++i) st_nt(so + (size_t)i * 256, S[i]);
    __syncthreads();
#pragma unroll
    for (int rr2 = 0; rr2 < 2; ++rr2) { const int rr = 2 * w + rr2, ohl = rr >> 2, t = rr & 3, ohd = 4 * hq + ohl; typedef float f32x2 __attribute__((ext_vector_type(2)));
        const f32x2 p0 = *(const LAS f32x2*)(OP + (rr * 2) * 128 + 2 * lane), p1 = *(const LAS f32x2*)(OP + (rr * 2 + 1) * 128 + 2 * lane);
        const float o0 = p0.x + p1.x, o1 = p0.y + p1.y; const float sq = wave_sum(o0 * o0 + o1 * o1); const float rs = __builtin_amdgcn_rsqf(sq * (1.0f / 128.0f) + EPS);
        const size_t row = row0 + t; const unsigned gw = *(const unsigned*)(PROJ + (size_t)S_HG * SLOT_ELEMS + row * 1024 + ohd * 128 + 2 * lane);
        *(unsigned*)(ON + row * 1024 + ohd * 128 + 2 * lane) = pk2(o0 * rs * silu_f(bf2f(gw & 0xffffu)), o1 * rs * silu_f(__uint_as_float(gw & 0xffff0000u))); }
    __syncthreads();
}
constexpr int U_HGS = NBS * 2, U_SSDS = NBS * 4, U_CONV = NBP + NBS;
__device__ __forceinline__ void scan_phase(Frame& F) {
    gu32* head = F.ctl + CW_QUEUE;
#define SCAN_QUEUE(qi, count, body) for (;;) { if (F.tid == 0) F.MISC[0] = __hip_atomic_fetch_add(head + 64 * (qi), 1u, RLX_AGENT); __syncthreads(); const int u = (int)F.MISC[0]; __syncthreads(); if (u >= (count)) break; body }
    SCAN_QUEUE(1, NBP * 32, ssd_unit_mfma(F, u >> 5, u & 31);)
    SCAN_QUEUE(0, NBP * 32, hgrn_v_unit(F, u >> 5, (u >> 2) & 7, u & 3);)
    SCAN_QUEUE(2, U_HGS, hgrn_sample_unit(F, u >> 1, u & 1);)
    SCAN_QUEUE(3, U_SSDS + U_CONV, if (u >= U_SSDS) { conv_copy_unit(F, u - U_SSDS); continue; } ssd_sample_unit(F, u >> 2, u & 3);)
#undef SCAN_QUEUE
}
typedef float f32x4s __attribute__((ext_vector_type(4)));
template <class Epi> __device__ __forceinline__ void small_tile_phase(Frame& F, const bf16* A, const bf16* Bt, int K, const Epi& E) {
    const int lane = F.lane, w = F.wave, r = lane & 31, hh = lane >> 5;
#pragma unroll 1
    for (int v = F.vcu; v < 256; v += F.G) {
    const int mt = v >> 4, nt = v & 15;
    const int kw = K >> 3;
    const bf16* ap = A + (size_t)(TP + 32 * mt + r) * K + w * kw + 8 * hh;
    const bf16* bp = Bt + (size_t)(64 * nt + r) * K + w * kw + 8 * hh;
    f32x16 acc0, acc1;
#pragma unroll
    for (int i = 0; i < 16; ++i) { acc0[i] = 0.f; acc1[i] = 0.f; }
#pragma unroll 4
    for (int ks = 0; ks < kw / 16; ++ks) { const bf16x8 af = *(const bf16x8*)(ap + 16 * ks), b0 = *(const bf16x8*)(bp + 16 * ks), b1 = *(const bf16x8*)(bp + (size_t)32 * K + 16 * ks);
        acc0 = MFMA32(b0, af, acc0); acc1 = MFMA32(b1, af, acc1); }
    LAS float* part = (LAS float*)(F.lds + RING_OFF) + w * 2048;
#pragma unroll
    for (int q4 = 0; q4 < 4; ++q4) { *(LAS f32x4*)(part + r * 64 + 8 * q4 + 4 * hh) = (f32x4){acc0[4 * q4], acc0[4 * q4 + 1], acc0[4 * q4 + 2], acc0[4 * q4 + 3]};
        *(LAS f32x4*)(part + r * 64 + 32 + 8 * q4 + 4 * hh) = (f32x4){acc1[4 * q4], acc1[4 * q4 + 1], acc1[4 * q4 + 2], acc1[4 * q4 + 3]}; }
    __syncthreads();
    const int rl = F.tid >> 4, c4 = (F.tid & 15) * 4; const LAS float* src = (const LAS float*)(F.lds + RING_OFF) + rl * 64 + c4;
    f32x4 sum = *(const LAS f32x4*)src;
#pragma unroll
    for (int ww = 1; ww < 8; ++ww) sum = sum + *(const LAS f32x4*)(src + ww * 2048);
    const f32x4s acc = (f32x4s){sum.x, sum.y, sum.z, sum.w};
    E.small(F, acc, TP + 32 * mt + rl, 64 * nt + c4, nt);
    __syncthreads();
    }
}
template <bool ADD> struct SmGate { bf16* O; const bf16* gate;
    __device__ __forceinline__ void small(Frame&, const f32x4s& a, int row, int col, int) const { const size_t off = (size_t)row * 1024 + col;
        const v2u gw = __builtin_nontemporal_load((const v2u*)(gate + off)); v2u ow = (v2u){0u, 0u}; if (ADD) ow = *(const v2u*)(O + off);
        float rr[4];
#pragma unroll
        for (int e = 0; e < 4; ++e) { const unsigned g16 = (gw[e >> 1] >> ((e & 1) * 16)) & 0xffffu, o16 = (ow[e >> 1] >> ((e & 1) * 16)) & 0xffffu; rr[e] = (ADD ? bf2f(o16) : 0.f) + sigmoid_f(bf2f(g16)) * a[e]; }
        v2u wv; wv.x = cvtpk_c(rr[0], rr[1]); wv.y = cvtpk_c(rr[2], rr[3]); *(v2u*)(O + off) = wv; } };
template <bool BF> struct SmRes { const float* base; const bf16* bb; bf16* hb; float* ssqp;
    __device__ __forceinline__ void small(Frame& F, const f32x4s& a, int row, int col, int nt) const { const size_t off = (size_t)row * 1024 + col; f32x4 b;
        if (BF) { const v2u w = *(const v2u*)(bb + off); b = (f32x4){bf2f(w.x & 0xffffu), __uint_as_float(w.x & 0xffff0000u), bf2f(w.y & 0xffffu), __uint_as_float(w.y & 0xffff0000u)}; }
        else b = *(const f32x4*)(base + off);
        const f32x4 v = b + (f32x4){a[0], a[1], a[2], a[3]};
        { v2u wv; wv.x = cvtpk_c(v[0], v[1]); wv.y = cvtpk_c(v[2], v[3]); *(v2u*)(hb + off) = wv; }
        float sq = (v[0] * v[0] + v[1] * v[1]) + (v[2] * v[2] + v[3] * v[3]); sq += __shfl_xor(sq, 1); sq += __shfl_xor(sq, 2); sq += __shfl_xor(sq, 4); sq += __shfl_xor(sq, 8);
        if ((F.tid & 15) == 0) ssqp[(size_t)row * 16 + nt] = sq; } };
struct SmScale { bf16* O; const float* ssq; float scale;
    __device__ __forceinline__ void small(Frame&, const f32x4s& a, int row, int col, int) const { const float rs = pg8::row_rs<16>(ssq, row) * scale;
        v2u wv; wv.x = cvtpk_c(a[0] * rs, a[1] * rs); wv.y = cvtpk_c(a[2] * rs, a[3] * rs); *(v2u*)(O + (size_t)row * 1024 + col) = wv; } };
__device__ __forceinline__ void attn_stage_tile(LAS unsigned char* Lb, const bf16* src, size_t pitch, int tid) {
#pragma unroll 1
    for (int hb = 0; hb < 2; ++hb) { v4u v[8];
#pragma unroll
        for (int i = 0; i < 8; ++i) { const int id = tid + 512 * (8 * hb + i), row = id >> 5, c = id & 31; v[i] = *(const v4u*)(src + (size_t)row * pitch + c * 8); }
#pragma unroll
        for (int i = 0; i < 8; ++i) { const int id = tid + 512 * (8 * hb + i), row = id >> 5, c = id & 31; *(LAS v4u*)(Lb + row * 512 + ((c ^ (row & 15)) << 4)) = v[i]; } }
}
__device__ __forceinline__ void attn_prompt_unit(Frame& F, int b, int hd, int qb) {
    const int tid = F.tid, lane = F.lane, w = F.wave, r = lane & 31, hh = lane >> 5; unsigned char* ws = F.ws;
    LAS unsigned char* Lb = F.lds + RING_OFF;
    const bf16* QB = (const bf16*)(ws + WS_QB); const bf16* KB = (const bf16*)(ws + WS_KB); const bf16* VT = (const bf16*)(ws + WS_VT); bf16* OB = (bf16*)(ws + WS_OB);
    const size_t qrow = (size_t)b * SEQ + (size_t)qb * 256 + 32 * w + r;
    attn_stage_tile(Lb, KB + (size_t)b * 256 * 1024 + hd * 256, 1024, tid);
    const bf16* qp = QB + qrow * 1024 + hd * 256 + 8 * hh;
    bf16x8 qf = *(const bf16x8*)qp;
    __syncthreads();
    f32x16 S[8];
#pragma unroll
    for (int t = 0; t < 8; ++t)
#pragma unroll
        for (int i = 0; i < 16; ++i) S[t][i] = 0.f;
    const int sw = r & 15;
#pragma unroll 1
    for (int ks = 0; ks < 16; ++ks) {
        const bf16x8 qn = *(const bf16x8*)(qp + 16 * (ks < 15 ? ks + 1 : ks));
        const LAS unsigned char* kp = Lb + r * 512 + (((2 * ks + hh) ^ sw) << 4);
#pragma unroll
        for (int t = 0; t < 8; ++t) S[t] = MFMA32(lds_frag16(kp + t * 32 * 512), qf, S[t]);
        qf = qn;
    }
    float m = -3.0e38f;
#pragma unroll
    for (int t = 0; t < 8; ++t)
#pragma unroll
        for (int i = 0; i < 16; ++i) m = fmaxf(m, S[t][i]);
    m = fmaxf(m, __shfl_xor(m, 32));
    float l = 0.f;
#pragma unroll
    for (int t = 0; t < 8; ++t)
#pragma unroll
        for (int i = 0; i < 16; ++i) { const float pv = __builtin_amdgcn_exp2f(S[t][i] - m); S[t][i] = pv; l += pv; }
    l += __shfl_xor(l, 32);
    const float rl = __builtin_amdgcn_rcpf(l);
    bf16x8 pf[8][2];
#pragma unroll
    for (int t = 0; t < 8; ++t) { pf[t][0] = ACC_FRAG(S[t], 0); pf[t][1] = ACC_FRAG(S[t], 1); }
    __syncthreads();
    attn_stage_tile(Lb, VT + (size_t)(b * 4 + hd) * 256 * 256, 256, tid);
    __syncthreads();
    bf16* op = OB + qrow * 1024 + hd * 256 + 4 * hh;
#pragma unroll 1
    for (int dt = 0; dt < 8; ++dt) {
        f32x16 O;
#pragma unroll
        for (int i = 0; i < 16; ++i) O[i] = 0.f;
        const LAS unsigned char* vrow = Lb + (32 * dt + r) * 512 + 8 * hh;
#pragma unroll
        for (int t = 0; t < 8; ++t)
#pragma unroll
            for (int s2 = 0; s2 < 2; ++s2) {
                const v2u lo = *(const LAS v2u*)(vrow + (((4 * t + 2 * s2) ^ sw) << 4)), hi = *(const LAS v2u*)(vrow + (((4 * t + 2 * s2 + 1) ^ sw) << 4));
                const v4u wv4 = (v4u){lo.x, lo.y, hi.x, hi.y};
                O = MFMA32(__builtin_bit_cast(bf16x8, wv4), pf[t][s2], O);
            }
#pragma unroll
        for (int q4 = 0; q4 < 4; ++q4) { v2u o; o.x = cvtpk_c(O[4 * q4] * rl, O[4 * q4 + 1] * rl); o.y = cvtpk_c(O[4 * q4 + 2] * rl, O[4 * q4 + 3] * rl);
            *(v2u*)(op + 32 * dt + 8 * q4) = o; }
    }
    __syncthreads();
}
__device__ __forceinline__ void attn_sample_unit(Frame& F, int sb, int hd) {
    const int tid = F.tid, lane = F.lane, w = F.wave; unsigned char* ws = F.ws;
    LAS float* sc = (LAS float*)(F.lds + RING_OFF);
    LAS float* red = sc + 4 * 256;
    const bf16* QB = (const bf16*)(ws + WS_QB); bf16* OB = (bf16*)(ws + WS_OB);
    const size_t rowq = (size_t)TP + (size_t)sb * LS;
    float q[4][4];
#pragma unroll
    for (int t = 0; t < 4; ++t) { const v2u qw = *(const v2u*)(QB + (rowq + t) * 1024 + hd * 256 + 4 * lane); q[t][0] = bf2f(qw.x & 0xffffu); q[t][1] = bf2f(qw.x >> 16); q[t][2] = bf2f(qw.y & 0xffffu); q[t][3] = bf2f(qw.y >> 16); }
    const float* Kc = F.in[6] + ((size_t)sb * 256 * 4 + hd) * 256 + 4 * lane; const float* Vc = F.in[7] + ((size_t)sb * 256 * 4 + hd) * 256 + 4 * lane;
    f32x4 kv[8], kn[8];
#pragma unroll
    for (int u = 0; u < 8; ++u) kv[u] = ld_nt(Kc + (size_t)(w * 32 + u) * 1024);
#pragma unroll 1
    for (int kk0 = 0; kk0 < 32; kk0 += 8) {
#pragma unroll
        for (int u = 0; u < 8; ++u) kn[u] = kk0 < 24 ? ld_nt(Kc + (size_t)(w * 32 + kk0 + 8 + u) * 1024) : ld_nt(Vc + (size_t)(w * 32 + u) * 1024);
        { float part[32];
#pragma unroll
          for (int u = 0; u < 8; ++u)
#pragma unroll
              for (int t = 0; t < 4; ++t) part[4 * u + t] = (q[t][0] * kv[u].x + q[t][1] * kv[u].y) + (q[t][2] * kv[u].z + q[t][3] * kv[u].w);
          float sv = tr_reduce32(part, lane); sv += __shfl_xor(sv, 32);
          if (lane < 32) sc[(lane & 3) * 256 + w * 32 + kk0 + (lane >> 2)] = sv; }
#pragma unroll
        for (int u = 0; u < 8; ++u) kv[u] = kn[u]; }
    __syncthreads();
    if (w < 4) { float v[4]; float m = -3.0e38f;
#pragma unroll
        for (int j = 0; j < 4; ++j) { v[j] = sc[w * 256 + j * 64 + lane]; m = fmaxf(m, v[j]); }
        m = wave_max(m); float l = 0.f;
#pragma unroll
        for (int j = 0; j < 4; ++j) { v[j] = __builtin_amdgcn_exp2f(v[j] - m); l += v[j]; }
        l = wave_sum(l); const float rl = 1.0f / l;
#pragma unroll
        for (int j = 0; j < 4; ++j) sc[w * 256 + j * 64 + lane] = v[j] * rl; }
    __syncthreads();
    float o[4][4];
#pragma unroll
    for (int t = 0; t < 4; ++t)
#pragma unroll
        for (int e = 0; e < 4; ++e) o[t][e] = 0.f;
#pragma unroll 1
    for (int kk0 = 0; kk0 < 32; kk0 += 8) {
        if (kk0 < 24) {
#pragma unroll
            for (int u = 0; u < 8; ++u) kn[u] = ld_nt(Vc + (size_t)(w * 32 + kk0 + 8 + u) * 1024); }
#pragma unroll
        for (int u = 0; u < 8; ++u) { const int key = w * 32 + kk0 + u;
#pragma unroll
            for (int t = 0; t < 4; ++t) { const float pr = sc[t * 256 + key]; o[t][0] += pr * kv[u].x; o[t][1] += pr * kv[u].y; o[t][2] += pr * kv[u].z; o[t][3] += pr * kv[u].w; } }
#pragma unroll
        for (int u = 0; u < 8; ++u) kv[u] = kn[u]; }
#pragma unroll
    for (int t = 0; t < 4; ++t) *(LAS f32x4*)(red + (w * 4 + t) * 256 + 4 * lane) = (f32x4){o[t][0], o[t][1], o[t][2], o[t][3]};
    __syncthreads();
    { const int t = tid >> 7, d0 = (tid & 127) * 2; float a0 = 0.f, a1 = 0.f;
#pragma unroll
      for (int ww = 0; ww < 8; ++ww) { a0 += red[(ww * 4 + t) * 256 + d0]; a1 += red[(ww * 4 + t) * 256 + d0 + 1]; }
      *(unsigned*)(OB + (rowq + t) * 1024 + hd * 256 + d0) = pk2(a0, a1); }
    __syncthreads();
}
__device__ __forceinline__ void attn_phase(Frame& F) {
    for (int u = F.vcu; u < NBP * 4 * 8; u += F.G) attn_prompt_unit(F, u >> 5, (u >> 3) & 3, u & 7);
    for (int u = F.vcu; u < NBS * 4; u += F.G) attn_sample_unit(F, u >> 2, u & 3);
}
__device__ __forceinline__ void final_norm_phase(Frame& F) {
    const int gw = F.vcu * NWAVES + F.wave, NGW = F.G * NWAVES; const float* SSQ = (const float*)(F.ws + WS_SSQP3); const float* wn = F.in[31]; const bf16* HB = (const bf16*)(F.ws + WS_HB);
    f32x4 wv[4];
#pragma unroll
    for (int j = 0; j < 2; ++j) { wv[2 * j] = *((const f32x4*)wn + 2 * (64 * j + F.lane)); wv[2 * j + 1] = *((const f32x4*)wn + 2 * (64 * j + F.lane) + 1); }
    for (int row = gw; row < T; row += NGW) {
        const f32x4* sp = (const f32x4*)(SSQ + (size_t)row * 16); float s = 0.f;
#pragma unroll
        for (int j = 0; j < 4; ++j) { const f32x4 a = sp[j]; s += (a.x + a.y) + (a.z + a.w); }
        const float rs = __builtin_amdgcn_rsqf(s * (1.0f / 1024.0f) + EPS);
#pragma unroll
        for (int j = 0; j < 2; ++j) { const int pc = 64 * j + F.lane; const v4u w = ld_nt16((const v4u*)(HB + (size_t)row * 1024) + pc);
            const f32x4 v0 = (f32x4){bf2f(w.x & 0xffffu), __uint_as_float(w.x & 0xffff0000u), bf2f(w.y & 0xffffu), __uint_as_float(w.y & 0xffff0000u)};
            const f32x4 v1 = (f32x4){bf2f(w.z & 0xffffu), __uint_as_float(w.z & 0xffff0000u), bf2f(w.w & 0xffffu), __uint_as_float(w.w & 0xffff0000u)};
            float* o = F.out + O_Y + (size_t)row * 1024 + 8 * pc; st_nt(o, v0 * rs * wv[2 * j]); st_nt(o + 4, v1 * rs * wv[2 * j + 1]); }
    }
}
#ifndef MK_N_LAUNCHES
#define MK_N_LAUNCHES 1
#endif
constexpr int PER_PHASE = 13;
constexpr int N_LAUNCHES = MK_N_LAUNCHES;
struct Args { const float* in[32]; float* out; unsigned char* ws; int ph_lo, ph_hi; };
__global__ void __launch_bounds__(NTHR, 2) skel_fwd(Args args) {
    extern __shared__ __attribute__((aligned(16))) unsigned char lds[];
    Frame F;
    F.lds = (LAS unsigned char*)lds;
    F.MISC = (volatile LAS unsigned*)(F.lds + MISC_OFF);
    F.tid = threadIdx.x; F.lane = F.tid & 63; F.wave = __builtin_amdgcn_readfirstlane(F.tid >> 6);
    F.G = gridDim.x; { const int bx = blockIdx.x; F.vcu = (F.G % 8 == 0) ? (bx % 8) * (F.G / 8) + bx / 8 : bx; }
    unsigned char* ws = args.ws; F.ws = ws; F.out = args.out;
    F.ctl = (gu32*)(ws + WS_CTL);
#pragma unroll
    for (int i = 0; i < 32; ++i) F.in[i] = args.in[i];
    for (int u = F.tid; u < (LDS_BYTES - LDSCTL_OFF) / 4; u += NTHR) ((LAS unsigned*)(F.lds + LDSCTL_OFF))[u] = 0u;
    __syncthreads();
    XcdBarrier bar; bar.bar = (unsigned*)(F.ctl + CW_BAR); bar.x = 0; bar.st = nullptr;
    if (N_LAUNCHES == 1) bar = xcd_barrier_post((unsigned*)(F.ctl + CW_BAR), F.MISC + 8);
#define GRID_BAR() do { if (N_LAUNCHES == 1) xcd_barrier(bar); } while (0)
    const int lo = args.ph_lo, hi = args.ph_hi;
#ifdef ONLY_PHASE
#define IN(k) ((k) == ONLY_PHASE && lo <= (k) && (k) < hi)
#else
#define IN(k) (lo <= (k) && (k) < hi)
#endif
#define BOTH(k) (IN(k) && IN((k) + 1))
    bf16* const XB = (bf16*)(ws + WS_XB); bf16* const PROJ = (bf16*)(ws + WS_PROJ);
    float* const Y = F.out + O_Y;
    if (IN(0)) { p0_prologue(F); if (BOTH(0)) GRID_BAR(); }
    if (IN(1)) {
        { pg8::Gemm g{XB, (const bf16*)(ws + WS_WIN), T, NPROJ, 1024}; pg8::StaticOrder S; S.init(T, NPROJ, F.G, (int)blockIdx.x);
          pg8::EpiScaleBf16<1, true> E{PROJ, SLOT_ELEMS, (const float*)(ws + WS_SSQX), 1.0f, (float*)(ws + WS_DT)};
          pg8::gemm_phase<pg8::EpiScaleBf16<1, true>, pg8::StaticOrder, true, true>(F.lds + RING_OFF, g, S, E); }
        { pg8::Gemm g{(const bf16*)(ws + WS_MNB), (const bf16*)(ws + WS_WKV), MEMR, 2048, 1024}; pg8::StaticOrder S; S.init(MEMR, 2048, F.G, (int)((blockIdx.x + 64) % F.G));
          pg8::EpiKV E{F.out + O_MKP, F.out + O_MVP, (bf16*)(ws + WS_KB), (bf16*)(ws + WS_VT), (const float*)(ws + WS_SSQM)};
          pg8::gemm_phase<pg8::EpiKV, pg8::StaticOrder, true, true>(F.lds + RING_OFF, g, S, E); }
        if (BOTH(1)) GRID_BAR();
    }
    if (IN(2)) { bc_prep_phase(F); hg_prep_phase(F); if (BOTH(2)) GRID_BAR(); }
    if (IN(3)) { scan_phase(F); if (BOTH(3)) GRID_BAR(); }
    if (IN(4)) { ssdnorm_phase(F); hgnorm_phase(F); if (BOTH(4)) GRID_BAR(); }
    if (IN(5)) { { SmGate<false> Es{(bf16*)(ws + WS_MERGED), PROJ + (size_t)S_GS * SLOT_ELEMS}; small_tile_phase(F, (const bf16*)(ws + WS_YG), (const bf16*)(ws + WS_WSSD), 2048, Es); }
        pg8::Gemm g{(const bf16*)(ws + WS_YG), (const bf16*)(ws + WS_WSSD), TP, 1024, 2048}; pg8::StaticOrder S; S.init(TP, 1024, F.G, (int)blockIdx.x);
        pg8::EpiGate<false> E{(bf16*)(ws + WS_MERGED), PROJ + (size_t)S_GS * SLOT_ELEMS};
        pg8::gemm_phase<pg8::EpiGate<false>, pg8::StaticOrder, true, true>(F.lds + RING_OFF, g, S, E);
          }
    if (IN(5)) { { SmGate<true> Es{(bf16*)(ws + WS_MERGED), PROJ + (size_t)S_GH * SLOT_ELEMS}; small_tile_phase(F, (const bf16*)(ws + WS_ON), (const bf16*)(ws + WS_WHG), 1024, Es); }
        pg8::Gemm g{(const bf16*)(ws + WS_ON), (const bf16*)(ws + WS_WHG), TP, 1024, 1024}; pg8::StaticOrder S; S.init(TP, 1024, F.G, (int)blockIdx.x);
        pg8::EpiGate<true> E{(bf16*)(ws + WS_MERGED), PROJ + (size_t)S_GH * SLOT_ELEMS};
        pg8::gemm_phase<pg8::EpiGate<true>, pg8::StaticOrder, true, true>(F.lds + RING_OFF, g, S, E);
        if (BOTH(5)) GRID_BAR(); }
    if (IN(6)) { { SmRes<true> Es{nullptr, XB, (bf16*)(ws + WS_HB), (float*)(ws + WS_SSQP1)}; small_tile_phase(F, (const bf16*)(ws + WS_MERGED), (const bf16*)(ws + WS_WOUT), 1024, Es); }
        pg8::Gemm g{(const bf16*)(ws + WS_MERGED), (const bf16*)(ws + WS_WOUT), TP, 1024, 1024}; pg8::StaticOrder S; S.init(TP, 1024, F.G, (int)blockIdx.x);
        pg8::EpiRes<true> E{nullptr, nullptr, XB, (bf16*)(ws + WS_HB), (float*)(ws + WS_SSQP1)};
        pg8::gemm_phase<pg8::EpiRes<true>, pg8::StaticOrder, true, true>(F.lds + RING_OFF, g, S, E);
        if (BOTH(6)) GRID_BAR(); }
    if (IN(7)) { { SmScale Es{(bf16*)(ws + WS_QB), (const float*)(ws + WS_SSQP1), QSCALE}; small_tile_phase(F, (const bf16*)(ws + WS_HB), (const bf16*)(ws + WS_WCQ), 1024, Es); }
        pg8::Gemm g{(const bf16*)(ws + WS_HB), (const bf16*)(ws + WS_WCQ), TP, 1024, 1024}; pg8::StaticOrder S; S.init(TP, 1024, F.G, (int)blockIdx.x);
        pg8::EpiScaleBf16<16, false> E{(bf16*)(ws + WS_QB), SLOT_ELEMS, (const float*)(ws + WS_SSQP1), QSCALE, nullptr};
        pg8::gemm_phase<pg8::EpiScaleBf16<16, false>, pg8::StaticOrder, true, true>(F.lds + RING_OFF, g, S, E);
        if (BOTH(7)) GRID_BAR(); }
    if (IN(8)) { attn_phase(F); if (BOTH(8)) GRID_BAR(); }
    if (IN(9)) { { SmRes<true> Es{nullptr, (const bf16*)(ws + WS_HB), (bf16*)(ws + WS_HB), (float*)(ws + WS_SSQP2)}; small_tile_phase(F, (const bf16*)(ws + WS_OB), (const bf16*)(ws + WS_WCO), 1024, Es); }
        pg8::Gemm g{(const bf16*)(ws + WS_OB), (const bf16*)(ws + WS_WCO), TP, 1024, 1024}; pg8::StaticOrder S; S.init(TP, 1024, F.G, (int)blockIdx.x);
        pg8::EpiRes<true> E{nullptr, nullptr, (const bf16*)(ws + WS_HB), (bf16*)(ws + WS_HB), (float*)(ws + WS_SSQP2)};
        pg8::gemm_phase<pg8::EpiRes<true>, pg8::StaticOrder, true, true>(F.lds + RING_OFF, g, S, E);
        if (BOTH(9)) GRID_BAR(); }
    if (IN(10)) { pg8::Gemm g{(const bf16*)(ws + WS_HB), (const bf16*)(ws + WS_WGU), T, 2 * FFN, 1024}; pg8::StaticOrder S; S.init(T, 2 * FFN, F.G, (int)blockIdx.x);
        pg8::EpiSwiglu E{(bf16*)(ws + WS_ACT), (const float*)(ws + WS_SSQP2)};
        pg8::gemm_phase<pg8::EpiSwiglu, pg8::StaticOrder, true, true>(F.lds + RING_OFF, g, S, E);
        if (BOTH(10)) GRID_BAR(); }
    if (IN(11)) { { SmRes<true> Es{nullptr, (const bf16*)(ws + WS_HB), (bf16*)(ws + WS_HB), (float*)(ws + WS_SSQP3)}; small_tile_phase(F, (const bf16*)(ws + WS_ACT), (const bf16*)(ws + WS_WDN), FFN, Es); }
        pg8::Gemm g{(const bf16*)(ws + WS_ACT), (const bf16*)(ws + WS_WDN), TP, 1024, FFN}; pg8::StaticOrder S; S.init(TP, 1024, F.G, (int)blockIdx.x);
        pg8::EpiRes<true> E{nullptr, nullptr, (const bf16*)(ws + WS_HB), (bf16*)(ws + WS_HB), (float*)(ws + WS_SSQP3)};
        pg8::gemm_phase<pg8::EpiRes<true>, pg8::StaticOrder, true, true>(F.lds + RING_OFF, g, S, E);
        if (BOTH(11)) GRID_BAR(); }
    if (IN(12)) final_norm_phase(F);
#undef IN
#undef BOTH
}

extern "C" void kernel_launch(void* const* d_in, const int* in_sizes, int n_in, void* d_out, int out_size, void* d_ws, size_t ws_size, hipStream_t stream) {
    static int grid = 0;
    if (grid == 0) {
        const int want[32] = {TP * 1024, TS * 1024, MEMR * 1024, 33554432, 1179648, 16777216, 33554432, 33554432, 1024, 1024 * 11296, 4 * 3072, 3072, 32, 32, 32, 2048, 2048 * 1024, 2048, 1024,
                              1024 * 1024, 1024 * 1024, 1024, 1024, 1024 * 1024, 1024 * 1024, 1024 * 1024, 1024 * 1024, 1024, 1024 * FFN, 1024 * FFN, FFN * 1024, 1024};
        bool ok = (n_in == 32); for (int i = 0; ok && i < 32; ++i) if (in_sizes[i] != want[i]) { fprintf(stderr, "kernel_launch: input %d has %d elements, expected %d\n", i, in_sizes[i], want[i]); ok = false; }
        if (!ok || out_size != (int)O_END || ws_size < WS_END4) { fprintf(stderr, "kernel_launch: unexpected shapes: n_in %d out %d ws %zu\n", n_in, out_size, ws_size); grid = -1; return; }
        int dev = 0, cus = 0, per_cu = 0;
        if (hipGetDevice(&dev) != hipSuccess || hipDeviceGetAttribute(&cus, hipDeviceAttributeMultiprocessorCount, dev) != hipSuccess) { grid = -1; return; }
        if (hipFuncSetAttribute((const void*)skel_fwd, hipFuncAttributeMaxDynamicSharedMemorySize, LDS_BYTES) != hipSuccess) { fprintf(stderr, "kernel_launch: hipFuncSetAttribute failed\n"); grid = -1; return; }
        if (hipOccupancyMaxActiveBlocksPerMultiprocessor(&per_cu, (const void*)skel_fwd, NTHR, LDS_BYTES) != hipSuccess || per_cu < 1) fprintf(stderr, "kernel_launch: occupancy query reports %d blocks per CU\n", per_cu);
        (void)hipGetLastError();
        grid = cus;
    }
    if (grid < 0) return;
    (void)hipMemsetAsync((char*)d_ws + WS_CTL, 0, CTL_ZERO_BYTES, stream);
    Args a{};
    for (int i = 0; i < 32; ++i) a.in[i] = (const float*)d_in[i];
    a.out = (float*)d_out; a.ws = (unsigned char*)d_ws;
    for (int li = 0; li < N_LAUNCHES; ++li) {
        a.ph_lo = (N_LAUNCHES == PER_PHASE) ? li : 0; a.ph_hi = (N_LAUNCHES == PER_PHASE) ? li + 1 : PER_PHASE;
        hipLaunchKernelGGL(skel_fwd, dim3(grid), dim3(NTHR), LDS_BYTES, stream, a);
    }
}
```

```cpp
#include <hip/hip_runtime.h>
#include <cstdio>
#include <cstdint>
namespace pg8 {
#define PG8_LAS __attribute__((address_space(3)))
typedef unsigned short bf16_t;
typedef short bf16x8 __attribute__((ext_vector_type(8)));
typedef float f32x4 __attribute__((ext_vector_type(4)));
typedef unsigned u32x4 __attribute__((ext_vector_type(4)));
constexpr int BM = 256, BK = 64, HALF = 128, HTB = HALF * BK * 2  , STAGE_BYTES = 8 * HTB, NXCD = 8, WGM = 8;

__host__ __device__ __forceinline__ int lds_byte(int r, int c) { const int st = (r >> 4) * 2 + (c >> 5), rr = r & 15, cc = c & 31, ob = rr * 64 + cc * 2; return st * 1024 + (ob ^ (((ob >> 9) & 1) << 5)); }
__host__ __device__ __forceinline__ void stage_rc(int b, int& R, int& C) { const int st = b / 1024, sb = b % 1024, swz = sb ^ (((sb >> 9) & 1) << 5); R = (st >> 1) * 16 + swz / 64; C = (st & 1) * 32 + (swz % 64) / 2; }
__host__ __device__ __forceinline__ int perm32(int rho) { const int n = rho >> 4, i = rho & 15; return 8 * (i >> 2) + 4 * n + (i & 3); }

struct Unit { int pm, pn; };
struct Gemm { const bf16_t* A; const bf16_t* Bt; int M, N, K; };

struct StaticOrder {
    int nM, nN, nwg, G, c;
    __host__ __device__ void init(int M, int N, int G_, int c_) { nM = M / BM; nN = N / BM; nwg = nM * nN; G = G_; c = c_; }
    __host__ __device__ bool next(int i, Unit& u) const {
        const long L = (long)i * G + c; if (L >= nwg) return false;
        int wgid = (int)L; { const int q = nwg / NXCD, r = nwg % NXCD, xcd = wgid % NXCD, off = wgid / NXCD; wgid = (xcd < r ? xcd * (q + 1) : r * (q + 1) + (xcd - r) * q) + off; }
        const int nig = WGM * nN, gid = wgid / nig, fm = gid * WGM, gsz = (nM - fm) < WGM ? (nM - fm) : WGM;
        u.pm = fm + ((wgid % nig) % gsz); u.pn = (wgid % nig) / gsz; return true;
    }
    __device__ __forceinline__ void a_ready(const Unit&) const {}
    __device__ __forceinline__ void done(const Unit&) const {}
};

__device__ __forceinline__ unsigned cvt_pk_bf16(float lo, float hi) { unsigned r; asm volatile("v_cvt_pk_bf16_f32 %0, %1, %2" : "=v"(r) : "v"(lo), "v"(hi)); return r; }
typedef float f32x2 __attribute__((ext_vector_type(2)));
typedef unsigned u32x2 __attribute__((ext_vector_type(2)));
constexpr float RMS_EPS = 1e-6f;
__device__ __forceinline__ float bfbits2f(unsigned v16) { return __uint_as_float(v16 << 16); }
__device__ __forceinline__ float sigm(float x) { return __builtin_amdgcn_rcpf(1.0f + __expf(-x)); }
template <int NP> __device__ __forceinline__ float row_rs(const float* ssq, int row) {
    float s = 0.f;
    if constexpr (NP == 1) s = ssq[row];
    else {
#pragma unroll
        for (int i = 0; i < NP / 4; ++i) { const f32x4 v = *(const f32x4*)(ssq + (size_t)row * NP + 4 * i); s += (v[0] + v[1]) + (v[2] + v[3]); }
    }
    return 1.0f / sqrtf(s * (1.0f / 1024.0f) + RMS_EPS);
}
template <int NP, bool HAS_DT> struct EpiScaleBf16 {
    static constexpr bool PERM = true, AFTER_DRAIN = false;
    bf16_t* O; size_t slot_elems; const float* ssq; float scale; float* dt;
    __device__ __forceinline__ void operator()(const f32x4 (&acc)[2][2][4][2], const Unit& u, int wr, int wc, int fr, int fq) const {
        const int row0 = u.pm * BM + wr * 64 + fr;
        if (HAS_DT && u.pn == 44) {
            if (wc == 0) {
#pragma unroll
                for (int ai = 0; ai < 2; ++ai)
#pragma unroll
                    for (int m = 0; m < 4; ++m) { const int row = row0 + ai * HALF + m * 16; float rs = 1.0f; if constexpr (NP > 0) rs = row_rs<NP>(ssq, row);
                        float* p = dt + (size_t)row * 32 + 8 * fq; *(f32x4*)p = acc[ai][0][m][0] * rs; *(f32x4*)(p + 4) = acc[ai][0][m][1] * rs; }
            }
            return;
        }
        bf16_t* base = O + (size_t)(u.pn >> 2) * slot_elems; const int col0 = (u.pn & 3) * BM + wc * 32 + 8 * fq;
#pragma unroll
        for (int ai = 0; ai < 2; ++ai)
#pragma unroll
            for (int m = 0; m < 4; ++m) { const int row = row0 + ai * HALF + m * 16; float rs = scale; if constexpr (NP > 0) rs = row_rs<NP>(ssq, row) * scale; bf16_t* rowp = base + (size_t)row * 1024 + col0;
#pragma unroll
                for (int bj = 0; bj < 2; ++bj) { const f32x4 v0 = acc[ai][bj][m][0] * rs, v1 = acc[ai][bj][m][1] * rs;
                    u32x4 w; w.x = cvt_pk_bf16(v0[0], v0[1]); w.y = cvt_pk_bf16(v0[2], v0[3]); w.z = cvt_pk_bf16(v1[0], v1[1]); w.w = cvt_pk_bf16(v1[2], v1[3]);
                    if (HAS_DT) __builtin_nontemporal_store(w, (u32x4*)(rowp + bj * HALF));
                    else *(u32x4*)(rowp + bj * HALF) = w; } }
    }
};
struct EpiKV {
    static constexpr bool PERM = false, AFTER_DRAIN = false;
    float* mk; float* mv; bf16_t* kb; bf16_t* vt; const float* ssq;
    __device__ __forceinline__ void operator()(const f32x4 (&acc)[2][2][4][2], const Unit& u, int wr, int wc, int fr, int fq) const {
        const int row0 = u.pm * BM + wr * 64 + fr; const bool isv = u.pn >= 4; const int colt = (u.pn & 3) * BM + wc * 32 + 4 * fq;
#pragma unroll
        for (int ai = 0; ai < 2; ++ai)
#pragma unroll
            for (int m = 0; m < 4; ++m) { const int row = row0 + ai * HALF + m * 16; const float rs = 1.0f;
#pragma unroll
                for (int bj = 0; bj < 2; ++bj)
#pragma unroll
                    for (int n = 0; n < 2; ++n) { const int c = colt + bj * HALF + n * 16; const f32x4 v = acc[ai][bj][m][n] * rs;
                        if (!isv) { __builtin_nontemporal_store(v, (f32x4*)(mk + (size_t)row * 1024 + c)); u32x2 w; w.x = cvt_pk_bf16(v[0], v[1]); w.y = cvt_pk_bf16(v[2], v[3]); *(u32x2*)(kb + (size_t)row * 1024 + c) = w; }
                        else { __builtin_nontemporal_store(v, (f32x4*)(mv + (size_t)row * 1024 + c)); const int b = row >> 8, key = row & 255, hd = c >> 8, d = c & 255;
                            bf16_t* p = vt + ((size_t)((b * 4 + hd) * 256 + d)) * 256 + key; const unsigned w0 = cvt_pk_bf16(v[0], v[1]), w1 = cvt_pk_bf16(v[2], v[3]);
                            p[0] = (bf16_t)(w0 & 0xffffu); p[256] = (bf16_t)(w0 >> 16); p[512] = (bf16_t)(w1 & 0xffffu); p[768] = (bf16_t)(w1 >> 16); } } }
    }
};
template <bool ADD> struct EpiGate {
    static constexpr bool PERM = true, AFTER_DRAIN = false;
    bf16_t* O; const bf16_t* gate;
    __device__ __forceinline__ void operator()(const f32x4 (&acc)[2][2][4][2], const Unit& u, int wr, int wc, int fr, int fq) const {
        const int row0 = u.pm * BM + wr * 64 + fr, col0 = u.pn * BM + wc * 32 + 8 * fq;
#pragma unroll
        for (int ai = 0; ai < 2; ++ai)
#pragma unroll
            for (int m = 0; m < 4; ++m) { const size_t off = (size_t)(row0 + ai * HALF + m * 16) * 1024 + col0;
#pragma unroll
                for (int bj = 0; bj < 2; ++bj) { const u32x4 gw = __builtin_nontemporal_load((const u32x4*)(gate + off + bj * HALF)); u32x4 ow = (u32x4){0u, 0u, 0u, 0u}; if (ADD) ow = *(const u32x4*)(O + off + bj * HALF);
                    float r[8];
#pragma unroll
                    for (int e = 0; e < 8; ++e) { const unsigned g16 = (gw[e >> 1] >> ((e & 1) * 16)) & 0xffffu, o16 = (ow[e >> 1] >> ((e & 1) * 16)) & 0xffffu;
                        const float a = acc[ai][bj][m][e >> 2][e & 3]; r[e] = (ADD ? bfbits2f(o16) : 0.f) + sigm(bfbits2f(g16)) * a; }
                    u32x4 w; w.x = cvt_pk_bf16(r[0], r[1]); w.y = cvt_pk_bf16(r[2], r[3]); w.z = cvt_pk_bf16(r[4], r[5]); w.w = cvt_pk_bf16(r[6], r[7]);
                    *(u32x4*)(O + off + bj * HALF) = w; } }
    }
};
template <bool BF, bool BSC = false> struct EpiRes {
    static constexpr bool PERM = true, AFTER_DRAIN = false;
    const float* base0; const float* base1; const bf16_t* bb; bf16_t* hb; float* ssqp; const float* bsc;
    __device__ __forceinline__ void operator()(const f32x4 (&acc)[2][2][4][2], const Unit& u, int wr, int wc, int fr, int fq) const {
        const int row0 = u.pm * BM + wr * 64 + fr, col0 = u.pn * BM + wc * 32 + 8 * fq; const float* base = u.pm < 64 ? base0 : base1;
#pragma unroll
        for (int ai = 0; ai < 2; ++ai)
#pragma unroll
            for (int m = 0; m < 4; ++m) { const int row = row0 + ai * HALF + m * 16; const size_t off = (size_t)row * 1024 + col0; float sq = 0.f; float bs = 1.0f; if constexpr (BSC) bs = bsc[row];
#pragma unroll
                for (int bj = 0; bj < 2; ++bj) { const size_t o2 = off + bj * HALF; f32x4 b0, b1;
                    if (BF) { const u32x4 w = *(const u32x4*)(bb + o2); b0 = (f32x4){bfbits2f(w.x & 0xffffu), __uint_as_float(w.x & 0xffff0000u), bfbits2f(w.y & 0xffffu), __uint_as_float(w.y & 0xffff0000u)};
                        b1 = (f32x4){bfbits2f(w.z & 0xffffu), __uint_as_float(w.z & 0xffff0000u), bfbits2f(w.w & 0xffffu), __uint_as_float(w.w & 0xffff0000u)}; }
                    else { b0 = __builtin_nontemporal_load((const f32x4*)(base + o2)); b1 = __builtin_nontemporal_load((const f32x4*)(base + o2 + 4)); }
                    if constexpr (BSC) { b0 = b0 * bs; b1 = b1 * bs; }
                    const f32x4 v0 = b0 + acc[ai][bj][m][0], v1 = b1 + acc[ai][bj][m][1];
                    sq += ((v0[0] * v0[0] + v0[1] * v0[1]) + (v0[2] * v0[2] + v0[3] * v0[3])) + ((v1[0] * v1[0] + v1[1] * v1[1]) + (v1[2] * v1[2] + v1[3] * v1[3]));
                    u32x4 w; w.x = cvt_pk_bf16(v0[0], v0[1]); w.y = cvt_pk_bf16(v0[2], v0[3]); w.z = cvt_pk_bf16(v1[0], v1[1]); w.w = cvt_pk_bf16(v1[2], v1[3]); *(u32x4*)(hb + o2) = w; }
                sq += __shfl_xor(sq, 16); sq += __shfl_xor(sq, 32);
                if (fq == 0) ssqp[(size_t)row * 16 + u.pn * 4 + wc] = sq; }
    }
};
struct EpiSwiglu {
    static constexpr bool PERM = true, AFTER_DRAIN = false;
    bf16_t* act; const float* ssq;
    __device__ __forceinline__ void operator()(const f32x4 (&acc)[2][2][4][2], const Unit& u, int wr, int wc, int fr, int fq) const {
        const int row0 = u.pm * BM + wr * 64 + fr, col0 = u.pn * 128 + wc * 16 + 4 * fq;
#pragma unroll
        for (int ai = 0; ai < 2; ++ai)
#pragma unroll
            for (int m = 0; m < 4; ++m) { const int row = row0 + ai * HALF + m * 16; const float rs = row_rs<16>(ssq, row);
#pragma unroll
                for (int bj = 0; bj < 2; ++bj) { const f32x4 a = acc[ai][bj][m][0] * rs, b = acc[ai][bj][m][1] * rs;
                    const float r0 = a[0] * sigm(a[0]) * a[1], r1 = a[2] * sigm(a[2]) * a[3], r2 = b[0] * sigm(b[0]) * b[1], r3 = b[2] * sigm(b[2]) * b[3];
                    u32x2 w; w.x = cvt_pk_bf16(r0, r1); w.y = cvt_pk_bf16(r2, r3); *(u32x2*)(act + (size_t)row * 2816 + col0 + bj * 64) = w; } }
    }
};
template <class Epi, class Sched, bool ALIGN_EPI = false, bool SP2 = false, int EPI_REP = 1>
__device__ __forceinline__ void gemm_phase(PG8_LAS unsigned char* lds, const Gemm g, const Sched& S, const Epi& E) {
    const int tid = threadIdx.x, wid = __builtin_amdgcn_readfirstlane(tid >> 6), lane = tid & 63, wr = wid >> 2, wc = wid & 3, fr = lane & 15, fq = lane >> 4;
    const int K = g.K, nt = K / BK;
    unsigned voffA[2], voffB[2];
#pragma unroll
    for (int i = 0; i < 2; ++i) { int R, C; stage_rc(tid * 16 + i * 8192, R, C); const int Rb = Epi::PERM ? ((R & ~31) + perm32(R & 31)) : R;
        voffA[i] = (unsigned)(R * K + C) * 2u; voffB[i] = (unsigned)(Rb * K + C) * 2u; }
    const size_t kstep = (size_t)(BK * 2);
    const size_t hstep = (size_t)HALF * K * 2;
    const size_t tstep = 2 * hstep;
    const unsigned ldsw = (unsigned)wid * 1024u;
    const int aoff = lds_byte(wr * 64 + fr, fq * 8), boff = lds_byte(wc * 32 + fr, fq * 8);
#define PG8_SA(b, h) (((b) * 2 + (h)) * HTB)
#define PG8_SB(b, h) ((4 + (b) * 2 + (h)) * HTB)
#define PG8_STAGE(bufoff, gbase, voff) do { _Pragma("unroll") for (int _i = 0; _i < 2; ++_i) \
        __builtin_amdgcn_global_load_lds((const unsigned*)((const char*)(gbase) + (voff)[_i]), (PG8_LAS unsigned*)(lds + (bufoff) + ldsw + _i * 8192), 16, 0, 0); } while (0)
#define PG8_LDA(dst, b, h) do { _Pragma("unroll") for (int m = 0; m < 4; ++m) _Pragma("unroll") for (int k = 0; k < 2; ++k) dst[m][k] = *(const PG8_LAS bf16x8*)(lds + PG8_SA(b, h) + aoff + m * 2048 + k * 1024); } while (0)
#define PG8_LDB(dst, b, h) do { _Pragma("unroll") for (int n = 0; n < 2; ++n) _Pragma("unroll") for (int k = 0; k < 2; ++k) dst[n][k] = *(const PG8_LAS bf16x8*)(lds + PG8_SB(b, h) + boff + n * 2048 + k * 1024); } while (0)
#define PG8_MMA(ai, bj, At, Bt) do { __builtin_amdgcn_s_setprio(1); _Pragma("unroll") for (int m = 0; m < 4; ++m) _Pragma("unroll") for (int n = 0; n < 2; ++n) _Pragma("unroll") for (int k = 0; k < 2; ++k) \
        acc[ai][bj][m][n] = __builtin_amdgcn_mfma_f32_16x16x32_bf16(Bt[n][k], At[m][k], acc[ai][bj][m][n], 0, 0, 0); __builtin_amdgcn_s_setprio(0); } while (0)
#define PG8_WAIT_V(n) asm volatile("s_waitcnt vmcnt(" #n ")" ::: "memory")
#define PG8_WAIT_L(n) asm volatile("s_waitcnt lgkmcnt(" #n ")" ::: "memory")
#define PG8_BAR __builtin_amdgcn_s_barrier()
#define PG8_SCHED __builtin_amdgcn_sched_barrier(0)
    Unit cur, nxt; int ui = 0;
    if (!S.next(0, cur)) return;
    f32x4 acc[2][2][4][2];
#pragma unroll
    for (int a = 0; a < 2; ++a)
#pragma unroll
        for (int b = 0; b < 2; ++b)
#pragma unroll
            for (int m = 0; m < 4; ++m)
#pragma unroll
                for (int n = 0; n < 2; ++n) acc[a][b][m][n] = (f32x4){0.f, 0.f, 0.f, 0.f};
    bf16x8 At[4][2], B0[2][2], B1[2][2];
    const char* cA = (const char*)g.A + (size_t)cur.pm * tstep; const char* cB = (const char*)g.Bt + (size_t)cur.pn * tstep;
    S.a_ready(cur);
    if constexpr (SP2) {
        PG8_STAGE(PG8_SB(0, 0), cB, voffB); PG8_STAGE(PG8_SB(0, 1), cB + hstep, voffB); PG8_STAGE(PG8_SA(0, 0), cA, voffA); PG8_STAGE(PG8_SA(0, 1), cA + hstep, voffA);
        if (wr == 1) PG8_BAR;
        PG8_WAIT_V(2); PG8_BAR;
        PG8_STAGE(PG8_SB(1, 0), cB + kstep, voffB); PG8_STAGE(PG8_SA(1, 0), cA + kstep, voffA); PG8_STAGE(PG8_SB(1, 1), cB + hstep + kstep, voffB);
        PG8_WAIT_V(6); PG8_BAR;
    } else {
        PG8_STAGE(PG8_SB(0, 0), cB, voffB); PG8_STAGE(PG8_SA(0, 0), cA, voffA); PG8_STAGE(PG8_SB(0, 1), cB + hstep, voffB); PG8_STAGE(PG8_SA(0, 1), cA + hstep, voffA);
        if (wr == 1) PG8_BAR;
        PG8_WAIT_V(4); PG8_BAR;
        PG8_STAGE(PG8_SB(1, 0), cB + kstep, voffB); PG8_STAGE(PG8_SA(1, 0), cA + kstep, voffA); PG8_STAGE(PG8_SB(1, 1), cB + hstep + kstep, voffB);
        PG8_WAIT_V(6); PG8_BAR;
    }
    for (;;) {
        const bool has_next = S.next(ui + 1, nxt);
        const char* nA = has_next ? (const char*)g.A + (size_t)nxt.pm * tstep : cA; const char* nB = has_next ? (const char*)g.Bt + (size_t)nxt.pn * tstep : cB;
        for (int t = 0; t < nt; t += 2) {
            const bool last = (t == nt - 2);
            const char* a1 = cA + (size_t)(t + 1) * kstep;
            const char* a2 = last ? nA : cA + (size_t)(t + 2) * kstep; const char* b2 = last ? nB : cB + (size_t)(t + 2) * kstep;
            const char* a3 = a2 + kstep; const char* b3 = b2 + kstep;
            if (last && has_next) S.a_ready(nxt);
            if constexpr (SP2) {
            PG8_LDB(B0, 0, 0); PG8_LDB(B1, 0, 1); PG8_SCHED; PG8_LDA(At, 0, 0); PG8_STAGE(PG8_SA(1, 1), a1 + hstep, voffA);
            PG8_WAIT_V(8); PG8_WAIT_L(0); PG8_BAR; PG8_MMA(0, 0, At, B0); PG8_MMA(0, 1, At, B1); PG8_BAR; PG8_SCHED;
            PG8_LDA(At, 0, 1); PG8_STAGE(PG8_SB(0, 0), b2, voffB); PG8_STAGE(PG8_SB(0, 1), b2 + hstep, voffB); PG8_STAGE(PG8_SA(0, 0), a2, voffA);
            PG8_WAIT_V(8); PG8_WAIT_L(0); PG8_BAR; PG8_MMA(1, 0, At, B0); PG8_MMA(1, 1, At, B1); PG8_BAR; PG8_SCHED;
            PG8_LDB(B0, 1, 0); PG8_LDB(B1, 1, 1); PG8_SCHED; PG8_LDA(At, 1, 0); PG8_STAGE(PG8_SA(0, 1), a2 + hstep, voffA);
            PG8_WAIT_V(8); PG8_WAIT_L(0); PG8_BAR; PG8_MMA(0, 0, At, B0); PG8_MMA(0, 1, At, B1); PG8_BAR; PG8_SCHED;
            PG8_LDA(At, 1, 1); PG8_STAGE(PG8_SB(1, 0), b3, voffB); PG8_STAGE(PG8_SB(1, 1), b3 + hstep, voffB); PG8_STAGE(PG8_SA(1, 0), a3, voffA);
            PG8_WAIT_V(8); PG8_WAIT_L(0); PG8_BAR; PG8_MMA(1, 0, At, B0); PG8_MMA(1, 1, At, B1); PG8_BAR; PG8_SCHED;
            } else {
            PG8_LDB(B0, 0, 0); PG8_SCHED; PG8_LDA(At, 0, 0); PG8_STAGE(PG8_SA(1, 1), a1 + hstep, voffA);
            PG8_WAIT_L(8); PG8_BAR; PG8_WAIT_L(0); PG8_MMA(0, 0, At, B0); PG8_BAR; PG8_SCHED;
            PG8_LDB(B1, 0, 1); PG8_STAGE(PG8_SB(0, 0), b2, voffB);
            PG8_BAR; PG8_WAIT_L(0); PG8_MMA(0, 1, At, B1); PG8_BAR;
            PG8_LDA(At, 0, 1); PG8_STAGE(PG8_SA(0, 0), a2, voffA);
            PG8_BAR; PG8_WAIT_L(0); PG8_MMA(1, 0, At, B0); PG8_BAR; PG8_SCHED;
            PG8_STAGE(PG8_SB(0, 1), b2 + hstep, voffB);
            PG8_WAIT_V(6); PG8_BAR; PG8_MMA(1, 1, At, B1); PG8_BAR;
            PG8_LDB(B0, 1, 0); PG8_SCHED; PG8_LDA(At, 1, 0); PG8_STAGE(PG8_SA(0, 1), a2 + hstep, voffA);
            PG8_WAIT_L(8); PG8_BAR; PG8_WAIT_L(0); PG8_MMA(0, 0, At, B0); PG8_BAR; PG8_SCHED;
            PG8_LDB(B1, 1, 1); PG8_STAGE(PG8_SB(1, 0), b3, voffB);
            PG8_BAR; PG8_WAIT_L(0); PG8_MMA(0, 1, At, B1); PG8_BAR;
            PG8_LDA(At, 1, 1); PG8_STAGE(PG8_SA(1, 0), a3, voffA);
            PG8_BAR; PG8_WAIT_L(0); PG8_MMA(1, 0, At, B0); PG8_BAR; PG8_SCHED;
            PG8_STAGE(PG8_SB(1, 1), b3 + hstep, voffB);
            PG8_WAIT_V(6); PG8_BAR; PG8_MMA(1, 1, At, B1); PG8_BAR;
            }
        }
        if constexpr (ALIGN_EPI) { if (wr == 0) PG8_BAR; }
        if constexpr (!Epi::AFTER_DRAIN) { for (int rep = 0; rep < EPI_REP; ++rep) { E(acc, cur, wr, wc, fr, fq); asm volatile("" ::: "memory"); } S.done(cur); }
        if (!has_next) break;
#pragma unroll
        for (int a = 0; a < 2; ++a)
#pragma unroll
            for (int b = 0; b < 2; ++b)
#pragma unroll
                for (int m = 0; m < 4; ++m)
#pragma unroll
                    for (int n = 0; n < 2; ++n) acc[a][b][m][n] = (f32x4){0.f, 0.f, 0.f, 0.f};
        cur = nxt; cA = nA; cB = nB; ++ui;
        if constexpr (ALIGN_EPI) { if (wr == 1) PG8_BAR; }
    }
    PG8_WAIT_V(0);
    if constexpr (!ALIGN_EPI) { if (wr == 0) PG8_BAR; }
    PG8_BAR;
    if constexpr (Epi::AFTER_DRAIN) { E.fused(acc, cur, wr, wc, fr, fq, lds, wid, lane); S.done(cur); }
#undef PG8_SA
#undef PG8_SB
#undef PG8_STAGE
#undef PG8_LDA
#undef PG8_LDB
#undef PG8_MMA
#undef PG8_WAIT_V
#undef PG8_WAIT_L
#undef PG8_BAR
#undef PG8_SCHED
}
}
#define GAS __attribute__((address_space(1)))
#define LAS __attribute__((address_space(3)))
typedef unsigned short bf16;
typedef unsigned v4u __attribute__((ext_vector_type(4)));
typedef float f32x4 __attribute__((ext_vector_type(4)));
typedef short bf16x8 __attribute__((ext_vector_type(8)));
typedef GAS unsigned gu32;
typedef GAS unsigned long long gu64;
#define RLX_AGENT __ATOMIC_RELAXED, __HIP_MEMORY_SCOPE_AGENT
#define LDS_WAIT() asm volatile("s_waitcnt lgkmcnt(0)" ::: "memory")
#define VM_WAIT() asm volatile("s_waitcnt vmcnt(0)" ::: "memory")
__device__ __forceinline__ unsigned long long rt() { return __builtin_amdgcn_s_memrealtime(); }
typedef float f32x2_t __attribute__((ext_vector_type(2))); typedef __bf16 bf16x2_t __attribute__((ext_vector_type(2)));
__device__ __forceinline__ unsigned pk2(float lo, float hi) { const f32x2_t v = {lo, hi}; const bf16x2_t b = __builtin_convertvector(v, bf16x2_t); return __builtin_bit_cast(unsigned, b); }
__device__ __forceinline__ unsigned f2bf(float f) { return pk2(f, 0.f) & 0xffffu; }

#define XB_TMO      128
#define XB_XCNT(j)  (256  + 64 * (j))
#define XB_XSUB(j)  (1280 + 64 * (j))
#define XB_XGEN(j)  (2304 + 64 * (j))
#define XB_TOP      3328
#define XB_TOPGEN   3392
#define XCD_BAR_WORDS 3456
#define XB_SPIN_CAP (1u << 18)

__device__ __forceinline__ unsigned xb_ld(unsigned* p)              { return __hip_atomic_load(p, __ATOMIC_RELAXED, __HIP_MEMORY_SCOPE_AGENT); }
__device__ __forceinline__ unsigned xb_add(unsigned* p, unsigned v) { return __hip_atomic_fetch_add(p, v, __ATOMIC_RELAXED, __HIP_MEMORY_SCOPE_AGENT); }
__device__ __forceinline__ unsigned xb_xcc_id() { return (unsigned)__builtin_amdgcn_s_getreg((3 << 11) | 20) & 0xFu; }
#define XB_SPIN(cond, bar) do { unsigned _sp = 0; while (cond) { __builtin_amdgcn_s_sleep(1); \
    if ((++_sp & 255u) == 0u) { if (xb_ld(&(bar)[XB_TMO])) break; if (_sp > XB_SPIN_CAP) { atomicAdd(&(bar)[XB_TMO], 1u); break; } } } } while (0)

struct XcdBarrier {
    unsigned* bar; unsigned x;
    volatile LAS unsigned* st;
};

__device__ __forceinline__ XcdBarrier xcd_barrier_post(unsigned* bar, volatile LAS unsigned* st) {
    XcdBarrier b; b.bar = bar; b.x = xb_xcc_id(); b.st = st;
    if (threadIdx.x == 0) (void)xb_add(&bar[XB_XCNT(b.x)], 1u);
    return b;
}
__device__ __forceinline__ void xcd_barrier_complete(unsigned* bar, unsigned x, unsigned& nloc, unsigned& nx) {
    const unsigned G = gridDim.x * gridDim.y * gridDim.z;
    unsigned sum, cnt, mine, sp = 0u;
    for (;;) {
        sum = 0u; cnt = 0u; mine = 0u;
#pragma unroll
        for (unsigned j = 0; j < 16; ++j) { const unsigned c = xb_ld(&bar[XB_XCNT(j)]); sum += c; cnt += (c > 0u) ? 1u : 0u; mine = (j == x) ? c : mine; }
        if (sum == G) break;
        __builtin_amdgcn_s_sleep(1);
        if ((++sp & 255u) == 0u) { if (xb_ld(&bar[XB_TMO])) break; if (sp > XB_SPIN_CAP) { atomicAdd(&bar[XB_TMO], 1u); break; } }
    }
    nloc = mine > 0u ? mine : 1u; nx = cnt > 0u ? cnt : 1u;
}

__device__ __forceinline__ void xcd_barrier(const XcdBarrier& b) {
    asm volatile("s_waitcnt vmcnt(0)" ::: "memory");
    __syncthreads();
    if (threadIdx.x == 0) {
        unsigned* bar = b.bar;
        __builtin_amdgcn_s_waitcnt(0);
        unsigned nloc = b.st[0], nx = b.st[1];
        if (nloc == 0u) { xcd_barrier_complete(bar, b.x, nloc, nx); b.st[0] = nloc; b.st[1] = nx; }
        const unsigned old = xb_add(&bar[XB_XSUB(b.x)], 1u);
        const unsigned gen = old / nloc;
        if (old + 1u == (gen + 1u) * nloc) {
            __builtin_amdgcn_fence(__ATOMIC_RELEASE, "agent");
            asm volatile("s_waitcnt vmcnt(0)" ::: "memory");
            const unsigned og = xb_add(&bar[XB_TOP], 1u);
            const unsigned tg = og / nx;
            if (og + 1u == (tg + 1u) * nx) xb_add(&bar[XB_TOPGEN], 1u);
            else XB_SPIN(xb_ld(&bar[XB_TOPGEN]) == tg, bar);
            __builtin_amdgcn_fence(__ATOMIC_ACQUIRE, "agent");
            xb_add(&bar[XB_XGEN(b.x)], 1u);
            asm volatile("s_waitcnt vmcnt(0)" ::: "memory");
        } else {
            XB_SPIN(xb_ld(&bar[XB_XGEN(b.x)]) == gen, bar);
            __builtin_amdgcn_fence(__ATOMIC_ACQUIRE, "agent");
            asm volatile("s_waitcnt vmcnt(0)" ::: "memory");
        }
    }
    __syncthreads();
}
typedef unsigned v2u __attribute__((ext_vector_type(2)));
constexpr int NWAVES = 8, NTHR = 512;
constexpr int DM = 1024, TP = 16384, TS = 512, T = TP + TS;
constexpr int SEQ = 2048, NBP = 8, NBS = 128, LS = 4, MEMR = 2048;
constexpr int NPROJ = 11520;
constexpr int FFN = 2816;
constexpr float EPS = 1e-6f;
constexpr float QSCALE = 0.0625f * 1.4426950408889634f;

constexpr size_t MiB = 1u << 20;
constexpr size_t WS_CTL = 0, CTL_ZERO_BYTES = 32768;
constexpr size_t WS_SSQX = 1 * MiB, WS_SSQM = 1 * MiB + 512 * 1024;
constexpr size_t WS_DT = 2 * MiB, WS_SSQSSD = 5 * MiB, WS_SSQP1 = 8 * MiB, WS_SSQP2 = 9 * MiB + 512 * 1024, WS_SSQP3 = 11 * MiB;
constexpr size_t WS_WIN = 13 * MiB, WS_WKV = 36 * MiB, WS_WSSD = 40 * MiB, WS_WHG = 44 * MiB, WS_WOUT = 46 * MiB, WS_WCQ = 48 * MiB, WS_WCO = 50 * MiB, WS_WGU = 52 * MiB, WS_WDN = 63 * MiB;
constexpr size_t WS_XB = 69 * MiB, WS_MNB = 102 * MiB, WS_KB = 106 * MiB, WS_VT = 110 * MiB;
constexpr size_t SLOT = 33 * MiB, SLOT_ELEMS = (size_t)T * 1024;
constexpr size_t WS_PROJ = 114 * MiB;
constexpr size_t WS_YG = WS_PROJ + 11 * SLOT, WS_ON = WS_YG + 2 * SLOT, WS_END = WS_ON + SLOT;
static_assert(SLOT == SLOT_ELEMS * 2, "slot size");
static_assert(WS_WIN + (size_t)NPROJ * 1024 * 2 <= WS_WKV && WS_WGU + (size_t)2 * FFN * 1024 * 2 <= WS_WDN && WS_WDN + (size_t)1024 * FFN * 2 <= WS_XB && WS_SSQP3 + (size_t)T * 64 <= WS_WIN, "d_ws map");
static_assert(WS_DT + (size_t)T * 128 <= WS_SSQSSD && WS_SSQSSD + (size_t)T * 128 <= WS_SSQP1 && WS_SSQP1 + (size_t)T * 64 <= WS_SSQP2 && WS_SSQP2 + (size_t)T * 64 <= WS_SSQP3, "d_ws map 2");
enum { S_Z0 = 0, S_Z1 = 1, S_X0 = 2, S_X1 = 3, S_X2 = 4, S_Q = 5, S_F = 6, S_I = 7, S_HG = 8, S_GS = 9, S_GH = 10 };
constexpr size_t WS_MERGED = WS_PROJ + S_Q * SLOT, WS_HB = WS_PROJ + S_F * SLOT, WS_QB = WS_PROJ + S_I * SLOT, WS_OB = WS_PROJ + S_HG * SLOT, WS_ACT = WS_PROJ;
static_assert((size_t)T * FFN * 2 <= 3 * SLOT, "act overlay");
constexpr size_t O_Y = 0, O_SSMP = (size_t)T * 1024, O_CONVP = O_SSMP + 2097152, O_HGP = O_CONVP + 73728, O_MKP = O_HGP + 1048576, O_MVP = O_MKP + 2097152,
                 O_SSMS = O_MVP + 2097152, O_CONVS = O_SSMS + 33554432, O_HGS = O_CONVS + 1179648, O_END = O_HGS + 16777216;
constexpr int CW_QUEUE = 64;
constexpr int CW_BAR = 4096;
constexpr int RING_OFF = 0, RING_BYTES = 131072;
constexpr int LDS_BYTES = 147456;
constexpr int LDSCTL_OFF = LDS_BYTES - 1024, MISC_OFF = LDSCTL_OFF + 320;
struct Frame {
    LAS unsigned char* lds;
    volatile LAS unsigned* MISC;
    gu32* ctl;
    int tid, lane, wave;
    int vcu, G;
    const float* in[32];
    float* out; unsigned char* ws;
};
__device__ __forceinline__ float bf2f(unsigned v16) { return __uint_as_float(v16 << 16); }
__device__ __forceinline__ f32x4 ld_nt(const float* p) { return __builtin_nontemporal_load((const f32x4*)p); }
__device__ __forceinline__ void st_nt(float* p, f32x4 v) { __builtin_nontemporal_store(v, (f32x4*)p); }
__device__ __forceinline__ v4u ld_nt16(const void* p) { return __builtin_nontemporal_load((const v4u*)p); }
__device__ __forceinline__ unsigned ld_nt4(const void* p) { return __builtin_nontemporal_load((const unsigned*)p); }
__device__ __forceinline__ float sigmoid_f(float x) { return __builtin_amdgcn_rcpf(1.0f + __expf(-x)); }
__device__ __forceinline__ float silu_f(float x) { return x * sigmoid_f(x); }
__device__ __forceinline__ float wave_sum(float v) {
#pragma unroll
    for (int o = 1; o < 64; o <<= 1) v += __shfl_xor(v, o);
    return v;
}
__device__ __forceinline__ float wave_max(float v) {
#pragma unroll
    for (int o = 1; o < 64; o <<= 1) v = fmaxf(v, __shfl_xor(v, o));
    return v;
}
struct TSrc { const float* W; const float* W2; const float* ks; int ldw; int mode; };
__device__ __forceinline__ void p0_transpose_item(const TSrc& s, int K, int N, bf16* WT, LAS unsigned short* scr, int item, int lane) {
    const int nblk = N / 64, kb = item / nblk, nb = item % nblk, k0 = 64 * kb, n0 = 64 * nb;
    const int kr = lane >> 4, nq = lane & 15;
    const float* const Wa = s.W; const float* const Wb = s.W2;
    const float* src; int c0, cs; bool zero = false;
    if (s.mode == 2) { const float* wsel = Wa; if (nq >= 8) wsel = Wb; src = wsel + (n0 >> 1) + 4 * (nq & 7); c0 = 8 * (nq & 7) + (nq >> 3); cs = 2; }
    else { const int n = n0 + 4 * nq; c0 = 4 * nq; cs = 1;
        if (s.mode == 0) src = Wa + n;
        else if (s.mode == 1) { if (n < 5120) src = Wa + n; else if (n < 11264) src = Wa + n + 32; else if (n < 11296) src = Wa + 5120 + (n - 11264); else { src = Wa; zero = true; } }
        else { src = Wa + n; if (n >= 1024) src = Wb + (n - 1024); } }
    f32x4 v[16];
#pragma unroll
    for (int i = 0; i < 16; ++i) v[i] = zero ? (f32x4){0.f, 0.f, 0.f, 0.f} : ld_nt(src + (size_t)(k0 + 4 * i + kr) * s.ldw);
#pragma unroll
    for (int i = 0; i < 16; ++i) { const int kk = 4 * i + kr; const float sc = s.ks ? s.ks[k0 + kk] : 1.0f; const unsigned w0 = pk2(v[i].x * sc, v[i].y * sc), w1 = pk2(v[i].z * sc, v[i].w * sc);
        LAS unsigned short* d = scr + kk * 66 + c0;
        if (cs == 1) { *(LAS unsigned*)d = w0; *(LAS unsigned*)(d + 2) = w1; }
        else { d[0] = (unsigned short)(w0 & 0xffffu); d[2] = (unsigned short)(w0 >> 16); d[4] = (unsigned short)(w1 & 0xffffu); d[6] = (unsigned short)(w1 >> 16); } }
    LDS_WAIT(); asm volatile("" ::: "memory");
    const int nr = lane >> 3, kc = lane & 7;
#pragma unroll
    for (int j = 0; j < 8; ++j) { const int n = 8 * j + nr; const LAS unsigned short* p = scr + (8 * kc) * 66 + n;
        v4u o; o.x = (unsigned)p[0] | ((unsigned)p[66] << 16); o.y = (unsigned)p[2 * 66] | ((unsigned)p[3 * 66] << 16); o.z = (unsigned)p[4 * 66] | ((unsigned)p[5 * 66] << 16); o.w = (unsigned)p[6 * 66] | ((unsigned)p[7 * 66] << 16);
        *(v4u*)(WT + (size_t)(n0 + n) * K + k0 + 8 * kc) = o; }
    LDS_WAIT(); asm volatile("" ::: "memory");
}
__device__ __forceinline__ void rows4_to_bf16_ssq(const float* x0, bf16* o0, float* ssq0, int lane) {
    f32x4 v[4][4];
#pragma unroll
    for (int rr = 0; rr < 4; ++rr)
#pragma unroll
        for (int j = 0; j < 4; ++j) v[rr][j] = ld_nt(x0 + rr * 1024 + 4 * (64 * j + lane));
#pragma unroll
    for (int rr = 0; rr < 4; ++rr) { float sq = 0.f;
#pragma unroll
        for (int j = 0; j < 4; ++j) sq += (v[rr][j].x * v[rr][j].x + v[rr][j].y * v[rr][j].y) + (v[rr][j].z * v[rr][j].z + v[rr][j].w * v[rr][j].w);
        sq = wave_sum(sq);
        const float irs = sqrtf(sq * (1.0f / 1024.0f) + 1e-6f), rs = 1.0f / irs;
        unsigned long long* o8 = (unsigned long long*)(o0 + rr * 1024) + lane;
#pragma unroll
        for (int j = 0; j < 4; ++j) o8[64 * j] = (unsigned long long)pk2(v[rr][j].x * rs, v[rr][j].y * rs) | ((unsigned long long)pk2(v[rr][j].z * rs, v[rr][j].w * rs) << 32);
        if (lane == 0) ssq0[rr] = irs; }
}
__device__ __forceinline__ void p0_prologue(Frame& F) {
    LAS unsigned short* scr = (LAS unsigned short*)(F.lds + RING_OFF + F.wave * 16384);
    const int gw = F.vcu * NWAVES + F.wave, NGW = F.G * NWAVES;
    unsigned char* ws = F.ws;
    constexpr int I_IN = 16 * (NPROJ / 64), I_KV = 16 * 32, I_SSD = 32 * 16, I_SQ = 16 * 16, I_GU = 16 * (2 * FFN / 64), I_DN = (FFN / 64) * 16;
    constexpr int NITEMS = I_IN + I_KV + I_SSD + 4 * I_SQ + I_GU + I_DN;
    for (int it = gw; it < NITEMS; it += NGW) {
        int r = it;
        if (r < I_IN) { TSrc s{F.in[9], nullptr, F.in[8], 11296, 1}; p0_transpose_item(s, 1024, NPROJ, (bf16*)(ws + WS_WIN), scr, r, F.lane); continue; } r -= I_IN;
        if (r < I_KV) { TSrc s{F.in[24], F.in[25], F.in[22], 1024, 3}; p0_transpose_item(s, 1024, 2048, (bf16*)(ws + WS_WKV), scr, r, F.lane); continue; } r -= I_KV;
        if (r < I_SSD) { TSrc s{F.in[16], nullptr, F.in[15], 1024, 0}; p0_transpose_item(s, 2048, 1024, (bf16*)(ws + WS_WSSD), scr, r, F.lane); continue; } r -= I_SSD;
        if (r < I_SQ) { TSrc s{F.in[19], nullptr, F.in[18], 1024, 0}; p0_transpose_item(s, 1024, 1024, (bf16*)(ws + WS_WHG), scr, r, F.lane); continue; } r -= I_SQ;
        if (r < I_SQ) { TSrc s{F.in[20], nullptr, nullptr, 1024, 0}; p0_transpose_item(s, 1024, 1024, (bf16*)(ws + WS_WOUT), scr, r, F.lane); continue; } r -= I_SQ;
        if (r < I_SQ) { TSrc s{F.in[23], nullptr, F.in[21], 1024, 0}; p0_transpose_item(s, 1024, 1024, (bf16*)(ws + WS_WCQ), scr, r, F.lane); continue; } r -= I_SQ;
        if (r < I_SQ) { TSrc s{F.in[26], nullptr, nullptr, 1024, 0}; p0_transpose_item(s, 1024, 1024, (bf16*)(ws + WS_WCO), scr, r, F.lane); continue; } r -= I_SQ;
        if (r < I_GU) { TSrc s{F.in[28], F.in[29], F.in[27], FFN, 2}; p0_transpose_item(s, 1024, 2 * FFN, (bf16*)(ws + WS_WGU), scr, r, F.lane); continue; } r -= I_GU;
        { TSrc s{F.in[30], nullptr, nullptr, 1024, 0}; p0_transpose_item(s, FFN, 1024, (bf16*)(ws + WS_WDN), scr, r, F.lane); }
    }
    bf16* XB = (bf16*)(ws + WS_XB); float* SSQX = (float*)(ws + WS_SSQX);
    for (int m4 = gw; m4 < T / 4; m4 += NGW) { const int m = 4 * m4;
        rows4_to_bf16_ssq(m < TP ? F.in[0] + (size_t)m * DM : F.in[1] + (size_t)(m - TP) * DM, XB + (size_t)m * DM, SSQX + m, F.lane); }
    bf16* MNB = (bf16*)(ws + WS_MNB); float* SSQM = (float*)(ws + WS_SSQM);
    for (int m4 = gw; m4 < MEMR / 4; m4 += NGW) { const int m = 4 * m4; rows4_to_bf16_ssq(F.in[2] + (size_t)m * DM, MNB + (size_t)m * DM, SSQM + m, F.lane); }
}
__device__ __forceinline__ void conv_copy_unit(Frame& F, int gb) {
    const bf16* PROJ = (const bf16*)(F.ws + WS_PROJ);
    const bool prompt = gb < NBP; const int sb = gb - NBP;
    const size_t row0 = prompt ? (size_t)gb * SEQ + (SEQ - 3) : (size_t)TP + (size_t)sb * LS + 1;
    float* dst = prompt ? F.out + O_CONVP + (size_t)gb * 3 * 3072 : F.out + O_CONVS + (size_t)sb * 3 * 3072;
    for (int e = F.tid; e < 3 * 3072; e += NTHR) { const int j = e / 3072, col = e % 3072;
        dst[e] = bf2f(PROJ[(size_t)(S_X0 + (col >> 10)) * SLOT_ELEMS + (row0 + j) * 1024 + (col & 1023)]); }
}
__device__ __forceinline__ void ssdnorm_phase(Frame& F) {
    const int gw = F.vcu * NWAVES + F.wave, NGW = F.G * NWAVES; bf16* YG = (bf16*)(F.ws + WS_YG); const float* SSQ = (const float*)(F.ws + WS_SSQSSD);
    for (int row = gw; row < T; row += NGW) {
        const f32x4* sp = (const f32x4*)(SSQ + (size_t)row * 32);
#pragma unroll
        for (int j = 0; j < 4; ++j) { const f32x4 a = sp[2 * j], b = sp[2 * j + 1]; const float s = ((a.x + a.y) + (a.z + a.w)) + ((b.x + b.y) + (b.z + b.w)); const float rs = 1.0f / sqrtf(s * (1.0f / 512.0f) + EPS);
            v4u* p = (v4u*)(YG + (size_t)row * 2048) + j * 64 + F.lane; const v4u w = *p; v4u o;
#pragma unroll
            for (int e = 0; e < 4; ++e) o[e] = pk2(bf2f(w[e] & 0xffffu) * rs, bf2f(w[e] >> 16) * rs);
            *p = o; }
    }
}
typedef float f32x16 __attribute__((ext_vector_type(16)));
#define MFMA32(a, b, c) __builtin_amdgcn_mfma_f32_32x32x16_bf16((a), (b), (c), 0, 0, 0)
__device__ __forceinline__ unsigned cvtpk_c(float lo, float hi) { return pk2(lo, hi); }
__device__ __forceinline__ bf16x8 pack8(float a0, float a1, float a2, float a3, float a4, float a5, float a6, float a7) {
    v4u w; w.x = cvtpk_c(a0, a1); w.y = cvtpk_c(a2, a3); w.z = cvtpk_c(a4, a5); w.w = cvtpk_c(a6, a7); return __builtin_bit_cast(bf16x8, w); }
#define ACC_FRAG(x, s) pack8((x)[8 * (s)], (x)[8 * (s) + 1], (x)[8 * (s) + 2], (x)[8 * (s) + 3], (x)[8 * (s) + 4], (x)[8 * (s) + 5], (x)[8 * (s) + 6], (x)[8 * (s) + 7])
__device__ __forceinline__ bf16x8 lds_frag16(const LAS unsigned char* p) { return *(const LAS bf16x8*)p; }
__device__ __forceinline__ bf16x8 lds_frag8x2(const LAS unsigned char* p) { const v2u lo = *(const LAS v2u*)p, hi = *(const LAS v2u*)(p + 16);
    const v4u w = (v4u){lo.x, lo.y, hi.x, hi.y}; return __builtin_bit_cast(bf16x8, w); }
#define LDS_BARRIER() do { asm volatile("s_waitcnt lgkmcnt(0)" ::: "memory"); __builtin_amdgcn_s_barrier(); asm volatile("" ::: "memory"); } while (0)
constexpr size_t WS_BCS = WS_END, WS_BTT = WS_BCS + (size_t)TP * 1024 * 2, WS_END2 = WS_BTT + (size_t)NBP * 32 * 4 * 128 * 64 * 2;
__device__ __forceinline__ void bc_prep_unit(Frame& F, int b, int c) {
    typedef float f32x2 __attribute__((ext_vector_type(2)));
    int tid_o = F.tid; asm volatile("" : "+v"(tid_o));
    const int tid = tid_o, cg = tid & 127, seg = tid >> 7; unsigned char* ws = F.ws;
    const bf16* src = (const bf16*)(ws + WS_PROJ) + (size_t)S_X2 * SLOT_ELEMS + (size_t)b * SEQ * 1024 + 8 * cg;
    bf16* BCS = (bf16*)(ws + WS_BCS); bf16* BTT = (bf16*)(ws + WS_BTT);
    const float* cw = F.in[10] + 2048 + 8 * cg; const float* cbp = F.in[11] + 2048 + 8 * cg;
#pragma unroll 1
    for (int half = 0; half < 2; ++half) {
        const int s0 = 16 * seg + 8 * half;
        v4u raw[11];
#pragma unroll
        for (int i = 0; i < 11; ++i) { const int gt = 64 * c + s0 - 3 + i; raw[i] = (v4u){0u, 0u, 0u, 0u}; if (gt >= 0) raw[i] = ld_nt16(src + (size_t)gt * 1024); }
        v4u rowpk[8];
#pragma unroll
        for (int kp = 0; kp < 4; ++kp) {
            const f32x2 cw0 = *(const f32x2*)(cw + 2 * kp), cw1 = *(const f32x2*)(cw + 3072 + 2 * kp), cw2 = *(const f32x2*)(cw + 2 * 3072 + 2 * kp), cw3 = *(const f32x2*)(cw + 3 * 3072 + 2 * kp), cbb = *(const f32x2*)(cbp + 2 * kp);
            f32x2 xv[11];
#pragma unroll
            for (int i = 0; i < 11; ++i) { const unsigned wd = raw[i][kp]; xv[i] = (f32x2){__uint_as_float(wd << 16), __uint_as_float(wd & 0xffff0000u)}; }
            f32x2 o[8];
#pragma unroll
            for (int i = 0; i < 8; ++i) { f32x2 a = cw0 * xv[i] + cbb; a = cw1 * xv[i + 1] + a; a = cw2 * xv[i + 2] + a; a = cw3 * xv[i + 3] + a;
                const f32x2 t = a * (-1.4426950408889634f); f32x2 e; e.x = __builtin_amdgcn_exp2f(t.x); e.y = __builtin_amdgcn_exp2f(t.y); e = e + 1.0f;
                f32x2 rc; rc.x = __builtin_amdgcn_rcpf(e.x); rc.y = __builtin_amdgcn_rcpf(e.y); o[i] = a * rc; }
#pragma unroll
            for (int i = 0; i < 8; ++i) rowpk[i][kp] = pk2(o[i].x, o[i].y);
            if (cg < 64) { const int ng = 8 * cg + 2 * kp, g = ng >> 7, n = ng & 127;
                bf16* dst = BTT + ((size_t)(((b * 32 + c) * 4 + g) * 128 + n)) * 64 + s0;
                v4u pa; pa.x = pk2(o[0].x, o[1].x); pa.y = pk2(o[2].x, o[3].x); pa.z = pk2(o[4].x, o[5].x); pa.w = pk2(o[6].x, o[7].x); *(v4u*)dst = pa;
                v4u pb; pb.x = pk2(o[0].y, o[1].y); pb.y = pk2(o[2].y, o[3].y); pb.z = pk2(o[4].y, o[5].y); pb.w = pk2(o[6].y, o[7].y); *(v4u*)(dst + 64) = pb; }
        }
        bf16* drow = BCS + ((size_t)b * SEQ + 64 * c + s0) * 1024 + 8 * cg;
#pragma unroll
        for (int i = 0; i < 8; ++i) *(v4u*)(drow + (size_t)i * 1024) = rowpk[i];
    }
}
__device__ __forceinline__ void bc_prep_phase(Frame& F) { for (int u = F.vcu; u < NBP * 32; u += F.G) bc_prep_unit(F, u >> 5, u & 31); }
constexpr size_t WS_HVT = WS_XB, WS_EGM = WS_END2, WS_EGL = WS_EGM + (size_t)NBP * 64 * 1024 * 4, WS_END3 = WS_EGL + (size_t)NBP * 64 * 1024 * 4;
__device__ __forceinline__ void hg_prep_unit(Frame& F, int b, int c) {
    typedef float f32x2 __attribute__((ext_vector_type(2)));
    int tid_o = F.tid; asm volatile("" : "+v"(tid_o));
    const int tid = tid_o; unsigned char* ws = F.ws;
    const int ch = 2 * tid;
    const size_t row0 = (size_t)b * SEQ + 32 * c;
    bf16* QS = (bf16*)(ws + WS_PROJ) + (size_t)S_Q * SLOT_ELEMS + row0 * 1024 + ch; bf16* FS = (bf16*)(ws + WS_PROJ) + (size_t)S_F * SLOT_ELEMS + row0 * 1024 + ch;
    const f32x2 l0 = *(const f32x2*)(F.in[17] + ch), l1 = *(const f32x2*)(F.in[17] + 1024 + ch);
    f32x2 lb; lb.x = __builtin_amdgcn_rcpf(1.0f + __expf(l1.x - l0.x)); lb.y = __builtin_amdgcn_rcpf(1.0f + __expf(l1.y - l0.y));
    const f32x2 omlb = 1.0f - lb;
    f32x2 P[32]; f32x2 run = (f32x2){1.0f, 1.0f};
#pragma unroll
    for (int t = 0; t < 32; ++t) { const unsigned wd = ld_nt4(FS + (size_t)t * 1024);
        f32x2 u = (f32x2){__uint_as_float(wd << 16), __uint_as_float(wd & 0xffff0000u)}; u.x = fminf(fmaxf(u.x, -30.f), 30.f); u.y = fminf(fmaxf(u.y, -30.f), 30.f);
        const f32x2 tt = u * (-1.4426950408889634f); f32x2 e; e.x = __builtin_amdgcn_exp2f(tt.x); e.y = __builtin_amdgcn_exp2f(tt.y); e = e + 1.0f;
        f32x2 sg; sg.x = __builtin_amdgcn_rcpf(e.x); sg.y = __builtin_amdgcn_rcpf(e.y);
        const f32x2 fg = lb + omlb * sg; run = run * fg; run.x = fmaxf(run.x, 1e-30f); run.y = fmaxf(run.y, 1e-30f); P[t] = run; }
    const f32x2 Pm = P[15], Pl = P[31]; f32x2 rPm; rPm.x = __builtin_amdgcn_rcpf(Pm.x); rPm.y = __builtin_amdgcn_rcpf(Pm.y);
    *(f32x2*)((float*)(ws + WS_EGM) + (size_t)(b * 64 + c) * 1024 + ch) = Pm; *(f32x2*)((float*)(ws + WS_EGL) + (size_t)(b * 64 + c) * 1024 + ch) = Pl * rPm;
    f32x2 rPprev = (f32x2){1.0f, 1.0f};
#pragma unroll
    for (int t = 0; t < 32; ++t) { f32x2 rP; rP.x = __builtin_amdgcn_rcpf(P[t].x); rP.y = __builtin_amdgcn_rcpf(P[t].y);
        const f32x2 e1 = P[t] * rPm, e2 = Pm * rP, fg = P[t] * rPprev, kk = 1.0f - fg; rPprev = rP;
        const unsigned qw = ld_nt4(QS + (size_t)t * 1024); const f32x2 q = (f32x2){__uint_as_float(qw << 16), __uint_as_float(qw & 0xffff0000u)};
        const f32x2 tq = q * (-1.4426950408889634f); f32x2 eq; eq.x = __builtin_amdgcn_exp2f(tq.x); eq.y = __builtin_amdgcn_exp2f(tq.y); eq = eq + 1.0f;
        f32x2 rq; rq.x = __builtin_amdgcn_rcpf(eq.x); rq.y = __builtin_amdgcn_rcpf(eq.y);
        const f32x2 qa = q * rq * e1, ka = kk * e2;
        *(unsigned*)(QS + (size_t)t * 1024) = pk2(qa.x, qa.y); *(unsigned*)(FS + (size_t)t * 1024) = pk2(ka.x, ka.y); }
}
__device__ __forceinline__ void hg_prep_phase(Frame& F) { for (int u = F.vcu; u < NBP * 64; u += F.G) hg_prep_unit(F, u >> 6, u & 63); }
constexpr int HV_QA = 0, HV_KA = 8704, HV_KAT = 17408, HV_VT = 27648, HV_EGM = 30208, HV_EGL = 30720, HV_PBUF = 31232, HV_OB = 2 * HV_PBUF, HV_OBUF = 23040;
constexpr size_t WS_SSQH = WS_END3, WS_END4 = WS_SSQH + (size_t)T * 32 * 4;
__device__ __forceinline__ void hgrn_v_unit(Frame& F, int b, int hd, int vt) {
    int tid_o = F.tid; asm volatile("" : "+v"(tid_o));
    const int tid = tid_o, lane = tid & 63, w = F.wave, r = lane & 31, hh = lane >> 5; unsigned char* ws = F.ws;
    LAS unsigned char* Lb = F.lds + RING_OFF;
    const bf16* PROJ = (const bf16*)(ws + WS_PROJ); bf16* OU = (bf16*)(ws + WS_ON); float* SSQH = (float*)(ws + WS_SSQH);
    const size_t rowb = (size_t)b * SEQ;
    const int pt_t = tid & 31, pt_g = tid >> 5;
    const bf16* qsrc = PROJ + (size_t)S_Q * SLOT_ELEMS + (rowb + pt_t) * 1024 + hd * 128 + 8 * pt_g;
    const bf16* ksrc = PROJ + (size_t)S_F * SLOT_ELEMS + (rowb + pt_t) * 1024 + hd * 128 + 8 * pt_g;
    const unsigned char* xsrc = nullptr; size_t xstr = 0;
    if (tid < 128) { xsrc = (const unsigned char*)(PROJ + (size_t)S_I * SLOT_ELEMS + (rowb + pt_t) * 1024 + hd * 128 + 32 * vt + 8 * pt_g); xstr = (size_t)32 * 1024 * 2; }
    else if (tid < 160) { xsrc = (const unsigned char*)((const float*)(ws + WS_EGM) + (size_t)b * 64 * 1024 + hd * 128 + 4 * (tid - 128)); xstr = 4096; }
    else if (tid < 192) { xsrc = (const unsigned char*)((const float*)(ws + WS_EGL) + (size_t)b * 64 * 1024 + hd * 128 + 4 * (tid - 160)); xstr = 4096; }
    const int o_img = pt_t * 272 + 16 * pt_g, o_tr = (8 * pt_g) * 80 + 2 * pt_t;
#define HGV_LOAD(cc, pq, pk, px) { pq = *(const v4u*)(qsrc + (size_t)(cc) * 32 * 1024); pk = *(const v4u*)(ksrc + (size_t)(cc) * 32 * 1024); if (tid < 192) px = *(const v4u*)(xsrc + (size_t)(cc) * xstr); }
#define HGV_TR(dst, v) { _Pragma("unroll") for (int e = 0; e < 8; ++e) *(LAS unsigned short*)((dst) + 80 * e) = (unsigned short)(((v)[e >> 1] >> (16 * (e & 1))) & 0xffffu); }
#define HGV_STORE(pb, pq, pk, px) { *(LAS v4u*)((pb) + HV_QA + o_img) = pq; *(LAS v4u*)((pb) + HV_KA + o_img) = pk; HGV_TR((pb) + HV_KAT + o_tr, pk) \
        if (tid < 128) { HGV_TR((pb) + HV_VT + o_tr, px) } else if (tid < 160) { *(LAS v4u*)((pb) + HV_EGM + 16 * (tid - 128)) = px; } else if (tid < 192) { *(LAS v4u*)((pb) + HV_EGL + 16 * (tid - 160)) = px; } }
    v4u pqA, pkA, pxA = (v4u){0u, 0u, 0u, 0u}, pqB, pkB, pxB = (v4u){0u, 0u, 0u, 0u};
    HGV_LOAD(0, pqA, pkA, pxA) HGV_STORE(Lb, pqA, pkA, pxA)
    HGV_LOAD(1, pqA, pkA, pxA) HGV_LOAD(2, pqB, pkB, pxB)
    const int kt = w;
    v2u ow_pend = (v2u){0u, 0u}; float sq_pend = 0.f;
    f32x16 S;
#pragma unroll
    for (int i = 0; i < 16; ++i) S[i] = 0.f;
    __syncthreads();
#define HGV_ITER(c, pq, pk, px) { \
        int r_l = r, hh_l = hh, tid_l = tid; asm volatile("" : "+v"(r_l), "+v"(hh_l), "+v"(tid_l)); \
        { const int r = r_l, hh = hh_l, tid = tid_l; \
        LAS unsigned char* pbc = Lb + ((c) & 1) * HV_PBUF; LAS unsigned char* pbn = Lb + (((c) + 1) & 1) * HV_PBUF; \
        if ((c) < 63) { HGV_STORE(pbn, pq, pk, px) if ((c) < 61) HGV_LOAD((c) + 3, pq, pk, px) } \
        if (w < 4) { \
            LAS float* EGM = (LAS float*)(pbc + HV_EGM); LAS float* EGL = (LAS float*)(pbc + HV_EGL); LAS float* OB = (LAS float*)(Lb + HV_OB + ((c) & 1) * HV_OBUF); \
            _Pragma("unroll") \
            for (int q4 = 0; q4 < 4; ++q4) { const f32x4 e0 = *(const LAS f32x4*)(EGM + 32 * kt + 8 * q4 + 4 * hh); \
                _Pragma("unroll") \
                for (int j = 0; j < 4; ++j) S[4 * q4 + j] *= e0[j]; } \
            f32x16 o; \
            _Pragma("unroll") \
            for (int i = 0; i < 16; ++i) o[i] = 0.f; \
            const LAS unsigned char* qa_row = pbc + HV_QA + r * 272; \
            o = MFMA32(lds_frag8x2(qa_row + (32 * kt + 4 * hh) * 2), ACC_FRAG(S, 0), o); \
            o = MFMA32(lds_frag8x2(qa_row + (32 * kt + 16 + 4 * hh) * 2), ACC_FRAG(S, 1), o); \
            LAS float* ob = OB + (kt * 32) * 36 + r; \
            _Pragma("unroll") \
            for (int i = 0; i < 16; ++i) ob[((i & 3) + 8 * (i >> 2) + 4 * hh) * 36] = o[i]; \
            const LAS unsigned char* kat_nat = pbc + HV_KAT + (32 * kt + r) * 80 + hh * 16; const LAS unsigned char* vt_nat = pbc + HV_VT + r * 80 + hh * 16; \
            S = MFMA32(lds_frag16(kat_nat), lds_frag16(vt_nat), S); S = MFMA32(lds_frag16(kat_nat + 32), lds_frag16(vt_nat + 32), S); \
            _Pragma("unroll") \
            for (int q4 = 0; q4 < 4; ++q4) { const f32x4 e0 = *(const LAS f32x4*)(EGL + 32 * kt + 8 * q4 + 4 * hh); \
                _Pragma("unroll") \
                for (int j = 0; j < 4; ++j) S[4 * q4 + j] *= e0[j]; } \
        } else { \
            if (w == 4) { LAS float* OB = (LAS float*)(Lb + HV_OB + ((c) & 1) * HV_OBUF); f32x16 o; \
                _Pragma("unroll") \
                for (int i = 0; i < 16; ++i) o[i] = 0.f; \
                f32x16 X; \
                _Pragma("unroll") \
                for (int i = 0; i < 16; ++i) X[i] = 0.f; \
                const LAS unsigned char* ka_nat = pbc + HV_KA + r * 272 + hh * 16; const LAS unsigned char* qa_nat = pbc + HV_QA + r * 272 + hh * 16; \
                _Pragma("unroll 2") \
                for (int ks = 0; ks < 8; ++ks) X = MFMA32(lds_frag16(ka_nat + ks * 32), lds_frag16(qa_nat + ks * 32), X); \
                _Pragma("unroll") \
                for (int i = 0; i < 16; ++i) { const int srow = (i & 3) + 8 * (i >> 2) + 4 * hh; X[i] = (srow <= r) ? X[i] : 0.f; } \
                const LAS unsigned char* vt_row = pbc + HV_VT + r * 80; \
                o = MFMA32(ACC_FRAG(X, 0), lds_frag8x2(vt_row + (4 * hh) * 2), o); \
                o = MFMA32(ACC_FRAG(X, 1), lds_frag8x2(vt_row + (16 + 4 * hh) * 2), o); \
                LAS float* ob4 = OB + (4 * 32) * 36 + r; \
                _Pragma("unroll") \
                for (int i = 0; i < 16; ++i) ob4[((i & 3) + 8 * (i >> 2) + 4 * hh) * 36] = o[i]; \
            } \
            if ((c) > 1) { HGV_FLUSH((c) - 2) } \
            if ((c) > 0) { HGV_OUT((c) - 1) } \
        } \
        LDS_BARRIER(); \
        } }
#define HGV_OUT(cp) { const LAS float* OB = (const LAS float*)(Lb + HV_OB + ((cp) & 1) * HV_OBUF); const int tl = tid - 256, t = tl >> 3, v0 = (tl & 7) * 4; \
            const f32x4 a = *(const LAS f32x4*)(OB + t * 36 + v0), b2 = *(const LAS f32x4*)(OB + (32 + t) * 36 + v0), c2 = *(const LAS f32x4*)(OB + (64 + t) * 36 + v0), d2 = *(const LAS f32x4*)(OB + (96 + t) * 36 + v0), e2 = *(const LAS f32x4*)(OB + (128 + t) * 36 + v0); \
            const f32x4 o4 = ((a + b2) + (c2 + d2)) + e2; \
            float sq = (o4.x * o4.x + o4.y * o4.y) + (o4.z * o4.z + o4.w * o4.w); sq += __shfl_xor(sq, 1); sq += __shfl_xor(sq, 2); sq += __shfl_xor(sq, 4); \
            sq_pend = sq; ow_pend.x = pk2(o4.x, o4.y); ow_pend.y = pk2(o4.z, o4.w); }
#define HGV_FLUSH(cp) { const int tl = tid - 256, t = tl >> 3, v0 = (tl & 7) * 4; const size_t row = rowb + 32 * (cp) + t; \
            if ((tl & 7) == 0) SSQH[row * 32 + hd * 4 + vt] = sq_pend; *(v2u*)(OU + row * 1024 + hd * 128 + 32 * vt + v0) = ow_pend; }
#pragma unroll 1
    for (int cc = 0; cc < 64; cc += 2) { HGV_ITER(cc, pqA, pkA, pxA) HGV_ITER(cc + 1, pqB, pkB, pxB) }
    if (w >= 4) { HGV_FLUSH(62) HGV_OUT(63) HGV_FLUSH(63) }
#undef HGV_ITER
#undef HGV_OUT
#undef HGV_FLUSH
#undef HGV_LOAD
#undef HGV_STORE
#undef HGV_TR
    if (w < 4) { float* st_g = F.out + O_HGP + (size_t)(b * 8 + hd) * 16384 + 32 * vt + r;
#pragma unroll
        for (int i = 0; i < 16; ++i) { const int k = 32 * kt + (i & 3) + 8 * (i >> 2) + 4 * hh; st_g[(size_t)k * 128] = S[i]; } }
    __syncthreads();
}
__device__ __forceinline__ void hgnorm_phase(Frame& F) {
    const int gw = F.vcu * NWAVES + F.wave, NGW = F.G * NWAVES; bf16* ON = (bf16*)(F.ws + WS_ON); const float* SSQH = (const float*)(F.ws + WS_SSQH);
    const bf16* HG = (const bf16*)(F.ws + WS_PROJ) + (size_t)S_HG * SLOT_ELEMS;
    for (int row = gw; row < TP; row += NGW) {
#pragma unroll
        for (int j = 0; j < 2; ++j) { const int pc = j * 64 + F.lane, hd = pc >> 4;
            const f32x4 sp = *(const f32x4*)(SSQH + (size_t)row * 32 + hd * 4); const float rs = __builtin_amdgcn_rsqf(((sp.x + sp.y) + (sp.z + sp.w)) * (1.0f / 128.0f) + EPS);
            v4u* p = (v4u*)(ON + (size_t)row * 1024) + pc; const v4u o = *p; const v4u g = ld_nt16((const v4u*)(HG + (size_t)row * 1024) + pc); v4u res;
#pragma unroll
            for (int e = 0; e < 4; ++e) res[e] = pk2(bf2f(o[e] & 0xffffu) * rs * silu_f(bf2f(g[e] & 0xffffu)), __uint_as_float(o[e] & 0xffff0000u) * rs * silu_f(__uint_as_float(g[e] & 0xffff0000u)));
            *p = res; }
    }
}
constexpr int SD_BN = 0, SD_CN = 17408, SD_BT = 34816, SD_XT = 53248, SD_HT = 62464, SD_YA = 97280, SD_YY = 113664, SD_YO = 130048, SD_CUM = 134144, SD_DTV = 134400, SD_ECUM = 134656, SD_XWT = 134912, SD_CWL = 144128;
__device__ __forceinline__ void ssd_unit_mfma(Frame& F, int gb, int h) {
    int tid_o = F.tid; asm volatile("" : "+v"(tid_o));
    const int tid = tid_o, lane = tid & 63, w = F.wave, r = lane & 31, hh = lane >> 5; unsigned char* ws = F.ws;
    const int L = SEQ; const size_t row_base = (size_t)gb * SEQ;
    const int g = h >> 3;
    LAS unsigned char* Lb = F.lds + RING_OFF;
    LAS unsigned short* BN = (LAS unsigned short*)(Lb + SD_BN); LAS unsigned short* CN = (LAS unsigned short*)(Lb + SD_CN);
    LAS unsigned short* BT = (LAS unsigned short*)(Lb + SD_BT); LAS unsigned short* XT = (LAS unsigned short*)(Lb + SD_XT);
    LAS unsigned short* HT = (LAS unsigned short*)(Lb + SD_HT);
    LAS unsigned short* XWT = (LAS unsigned short*)(Lb + SD_XWT);
    LAS float* YA = (LAS float*)(Lb + SD_YA); LAS float* YY = (LAS float*)(Lb + SD_YY); LAS unsigned short* YO = (LAS unsigned short*)(Lb + SD_YO);
    LAS float* CUM = (LAS float*)(Lb + SD_CUM); LAS float* DTV = (LAS float*)(Lb + SD_DTV); LAS float* ECUM = (LAS float*)(Lb + SD_ECUM);
    const bf16* PROJ = (const bf16*)(ws + WS_PROJ); const float* DTR = (const float*)(ws + WS_DT); bf16* YG = (bf16*)(ws + WS_YG); float* SSQ = (float*)(ws + WS_SSQSSD);
    const int nt = w >> 1, pt = w & 1;
    f32x16 H;
    float* st_g = F.out + O_SSMP + (size_t)(gb * 32 + h) * 8192 + (size_t)(32 * pt + r) * 128 + 32 * nt + 4 * hh;
#pragma unroll
    for (int i = 0; i < 16; ++i) H[i] = 0.f;
    {
        LAS unsigned short* hp = HT + (32 * pt + r) * 136 + 32 * nt + 4 * hh;
#pragma unroll
        for (int q4 = 0; q4 < 4; ++q4) { v2u pk; pk.x = cvtpk_c(H[4 * q4], H[4 * q4 + 1]); pk.y = cvtpk_c(H[4 * q4 + 2], H[4 * q4 + 3]); *(LAS v2u*)(hp + 8 * q4) = pk; }
    }
    const float a = -__expf(F.in[13][h]), dtb = F.in[12][h], Dk = F.in[14][h];
    const float* cw = F.in[10]; const float* cbp = F.in[11];
    const int cgl = tid & 7, xs = tid >> 3;
    const int col = h * 64 + 8 * cgl;
    const bf16* cptr = PROJ + (size_t)(S_X0 + (col >> 10)) * SLOT_ELEMS + row_base * 1024 + (col & 1023);
    const bf16* BCS = (const bf16*)(ws + WS_BCS) + row_base * 1024 + g * 128; const bf16* BTT = (const bf16*)(ws + WS_BTT) + (size_t)(gb * 32 * 4 + g) * 128 * 64;
    v4u xr[4], pc[6];
#pragma unroll
    for (int i = 0; i < 4; ++i) { const int gt = xs - 3 + i; xr[i] = (v4u){0u, 0u, 0u, 0u}; if (gt >= 0) xr[i] = *(const v4u*)(cptr + (size_t)gt * 1024); }
#pragma unroll
    for (int j = 0; j < 6; ++j) { const int idx = (tid + 512 * j) & 1023;
        if (j < 4) pc[j] = *(const v4u*)(BCS + (size_t)(idx >> 4) * 1024 + (j >> 1) * 512 + 8 * (idx & 15));
        else pc[j] = *(const v4u*)(BTT + (size_t)(idx >> 3) * 64 + 8 * (idx & 7)); }
    LAS float* CWL = (LAS float*)(Lb + SD_CWL);
    if (tid < 320) { const int j = tid >> 6, c = tid & 63; CWL[tid] = j < 4 ? cw[j * 3072 + h * 64 + c] : cbp[h * 64 + c]; }
    __syncthreads();
    v4u ow_pend = (v4u){0u, 0u, 0u, 0u}; float sq_pend = 0.f; bool pend = false;
    int buf = 0;
    float dt_pf = 0.f;
    if (lane < L) dt_pf = DTR[(row_base + lane) * 32 + h];
    for (int t0 = 0; t0 < L; t0 += 64, buf ^= 1) {
        int r_l = r, hh_l = hh, tid_l = tid, lane_l = lane;
        asm volatile("" : "+v"(r_l), "+v"(hh_l), "+v"(tid_l), "+v"(lane_l));
        { const int r = r_l, hh = hh_l, tid = tid_l, lane = lane_l;
        float dtv = 0.f;
        if (t0 + lane < L) { const float x = dt_pf + dtb; dtv = fmaxf(x, 0.f) + 0.6931471805599453f * __builtin_amdgcn_logf(1.0f + __builtin_amdgcn_exp2f(-1.4426950408889634f * fabsf(x))); }
        dt_pf = 0.f; if (t0 + 64 + lane < L) dt_pf = DTR[(row_base + t0 + 64 + lane) * 32 + h];
        v4u zw = (v4u){0u, 0u, 0u, 0u};
        if (t0 + (tid >> 3) < L) zw = ld_nt16(PROJ + (size_t)(S_Z0 + (h >> 4)) * SLOT_ELEMS + (row_base + t0 + (tid >> 3)) * 1024 + (h & 15) * 64 + (tid & 7) * 8);
        float cum = dtv * a;
#pragma unroll
        for (int o = 1; o < 64; o <<= 1) { const float u = __shfl_up(cum, o); if (lane >= o) cum += u; }
        const float cum_last = __shfl(cum, 63);
        const float wgt = __expf(cum_last - cum) * dtv;
        if (w == 0) { CUM[lane] = cum; DTV[lane] = dtv; ECUM[lane] = __expf(cum); }
#pragma unroll
        for (int j = 0; j < 6; ++j) { const int idx = (tid + 512 * j) & 1023;
            if (j < 2) *(LAS v4u*)(BN + (idx >> 4) * 136 + 8 * (idx & 15)) = pc[j];
            else if (j < 4) *(LAS v4u*)(CN + (idx >> 4) * 136 + 8 * (idx & 15)) = pc[j];
            else *(LAS v4u*)(BT + (idx >> 3) * 72 + 8 * (idx & 7)) = pc[j]; }
        if (pend) { const size_t prow = row_base + (t0 - 64) + (tid >> 3);
            *(v4u*)(YG + prow * 2048 + h * 64 + (tid & 7) * 8) = ow_pend; if ((tid & 7) == 0) SSQ[prow * 32 + h] = sq_pend; pend = false; }
        { const int xs = tid >> 3, cgl = tid & 7; const float wx = __shfl(wgt, xs); typedef float f32x2 __attribute__((ext_vector_type(2)));
#pragma unroll
          for (int kp = 0; kp < 4; ++kp) {
              const LAS float* wl = CWL + 8 * cgl + 2 * kp;
              const f32x2 cw0 = *(const LAS f32x2*)wl, cw1 = *(const LAS f32x2*)(wl + 64), cw2 = *(const LAS f32x2*)(wl + 128), cw3 = *(const LAS f32x2*)(wl + 192), cbb = *(const LAS f32x2*)(wl + 256);
              f32x2 xv[4];
#pragma unroll
              for (int i = 0; i < 4; ++i) { const unsigned wd = xr[i][kp]; xv[i] = (f32x2){__uint_as_float(wd << 16), __uint_as_float(wd & 0xffff0000u)}; }
              f32x2 a = cw0 * xv[0] + cbb; a = cw1 * xv[1] + a; a = cw2 * xv[2] + a; a = cw3 * xv[3] + a;
              const f32x2 t = a * (-1.4426950408889634f); f32x2 e; e.x = __builtin_amdgcn_exp2f(t.x); e.y = __builtin_amdgcn_exp2f(t.y); e = e + 1.0f;
              f32x2 rc; rc.x = __builtin_amdgcn_rcpf(e.x); rc.y = __builtin_amdgcn_rcpf(e.y); const f32x2 o = a * rc, ow = o * wx;
              const unsigned po = pk2(o.x, o.y), pw = pk2(ow.x, ow.y); const int p = 8 * cgl + 2 * kp;
              XT[p * 72 + xs] = (unsigned short)(po & 0xffffu); XT[(p + 1) * 72 + xs] = (unsigned short)(po >> 16);
              XWT[p * 72 + xs] = (unsigned short)(pw & 0xffffu); XWT[(p + 1) * 72 + xs] = (unsigned short)(pw >> 16); }
        }
        if (t0 + 64 < L) {
#pragma unroll
            for (int i = 0; i < 4; ++i) xr[i] = ld_nt16(cptr + (size_t)(t0 + 64 + (tid >> 3) - 3 + i) * 1024);
            const int chn = (t0 >> 6) + 1;
#pragma unroll
            for (int j = 0; j < 6; ++j) { const int idx = (tid + 512 * j) & 1023;
                if (j < 4) pc[j] = *(const v4u*)(BCS + (size_t)(t0 + 64 + (idx >> 4)) * 1024 + (j >> 1) * 512 + 8 * (idx & 15));
                else pc[j] = *(const v4u*)(BTT + ((size_t)chn * 4 * 128 + (idx >> 3)) * 64 + 8 * (idx & 7)); }
        }
        LDS_BARRIER();
        if (w < 3) {
            const int tt = w == 0 ? 0 : 1, st = w == 1 ? 1 : 0;
            f32x16 X, ya0, ya1;
#pragma unroll
            for (int i = 0; i < 16; ++i) { X[i] = 0.f; ya0[i] = 0.f; ya1[i] = 0.f; }
            const LAS unsigned char* cn_nat = Lb + SD_CN + (32 * tt + r) * 272 + hh * 16; const LAS unsigned char* bn_nat = Lb + SD_BN + (32 * st + r) * 272 + hh * 16;
#pragma unroll 2
            for (int ks = 0; ks < 8; ++ks) X = MFMA32(lds_frag16(bn_nat + ks * 32), lds_frag16(cn_nat + ks * 32), X);
            const float cum_t = CUM[32 * tt + r];
#pragma unroll
            for (int q4 = 0; q4 < 4; ++q4) { const f32x4 cs = *(const LAS f32x4*)(CUM + 32 * st + 8 * q4 + 4 * hh), ds = *(const LAS f32x4*)(DTV + 32 * st + 8 * q4 + 4 * hh);
#pragma unroll
                for (int jj = 0; jj < 4; ++jj) { const int s_abs = 32 * st + 8 * q4 + 4 * hh + jj; const float f = __expf(fminf(cum_t - cs[jj], 0.f)) * ds[jj]; X[4 * q4 + jj] = (s_abs <= 32 * tt + r) ? X[4 * q4 + jj] * f : 0.f; } }
            const bf16x8 xf0 = ACC_FRAG(X, 0), xf1 = ACC_FRAG(X, 1);
            const LAS unsigned char* xt_row = Lb + SD_XT + r * 144 + (32 * st + 4 * hh) * 2;
            ya0 = MFMA32(xf0, lds_frag8x2(xt_row), ya0); ya0 = MFMA32(xf1, lds_frag8x2(xt_row + 32), ya0);
            ya1 = MFMA32(xf0, lds_frag8x2(xt_row + 32 * 144), ya1); ya1 = MFMA32(xf1, lds_frag8x2(xt_row + 32 * 144 + 32), ya1);
            if (w < 2) { LAS float* yb = YA + (32 * tt + 4 * hh) * 64 + r;
#pragma unroll
                for (int i = 0; i < 16; ++i) { yb[((i & 3) + 8 * (i >> 2)) * 64] = ya0[i]; yb[((i & 3) + 8 * (i >> 2)) * 64 + 32] = ya1[i]; } }
            else { LAS unsigned short* yb = YO + (4 * hh) * 64 + r;
#pragma unroll
                for (int i = 0; i < 16; ++i) { yb[((i & 3) + 8 * (i >> 2)) * 64] = (unsigned short)f2bf(ya0[i]); yb[((i & 3) + 8 * (i >> 2)) * 64 + 32] = (unsigned short)f2bf(ya1[i]); } }
        } else if (w >= 4) {
            const int tt = (w - 4) >> 1, ptj = w & 1;
            const LAS unsigned char* ht_nat = Lb + SD_HT + buf * 17408 + (32 * ptj + r) * 272 + hh * 16;
            f32x16 yi;
#pragma unroll
            for (int i = 0; i < 16; ++i) yi[i] = 0.f;
            const LAS unsigned char* cn_nat = Lb + SD_CN + (32 * tt + r) * 272 + hh * 16;
#pragma unroll 2
            for (int ks = 0; ks < 8; ++ks) yi = MFMA32(lds_frag16(cn_nat + ks * 32), lds_frag16(ht_nat + ks * 32), yi);
            const LAS unsigned short* xt_p = XT + (32 * ptj + r) * 72 + 32 * tt + 4 * hh;
#pragma unroll
            for (int q4 = 0; q4 < 4; ++q4) { const f32x4 ec = *(const LAS f32x4*)(ECUM + 32 * tt + 8 * q4 + 4 * hh); const v2u xw = *(const LAS v2u*)(xt_p + 8 * q4);
                const float x0 = bf2f(xw.x & 0xffffu), x1 = bf2f(xw.x >> 16), x2 = bf2f(xw.y & 0xffffu), x3 = bf2f(xw.y >> 16);
                LAS float* yb = YY + (32 * tt + 8 * q4 + 4 * hh) * 64 + 32 * ptj + r;
                yb[0] = ec[0] * yi[4 * q4] + Dk * x0; yb[64] = ec[1] * yi[4 * q4 + 1] + Dk * x1; yb[128] = ec[2] * yi[4 * q4 + 2] + Dk * x2; yb[192] = ec[3] * yi[4 * q4 + 3] + Dk * x3; }
        }
        {
            const float el = __expf(CUM[63]);
#pragma unroll
            for (int i = 0; i < 16; ++i) H[i] *= el;
            const LAS unsigned char* bt_nat = Lb + SD_BT + (32 * nt + r) * 144 + hh * 16; const LAS unsigned char* xt_nat = Lb + SD_XWT + (32 * pt + r) * 144 + hh * 16;
#pragma unroll
            for (int s2 = 0; s2 < 4; ++s2) H = MFMA32(lds_frag16(bt_nat + s2 * 32), lds_frag16(xt_nat + s2 * 32), H);
            LAS unsigned short* hp = HT + (buf ^ 1) * 8704 + (32 * pt + r) * 136 + 32 * nt + 4 * hh;
#pragma unroll
            for (int q4 = 0; q4 < 4; ++q4) { v2u pk; pk.x = cvtpk_c(H[4 * q4], H[4 * q4 + 1]); pk.y = cvtpk_c(H[4 * q4 + 2], H[4 * q4 + 3]); *(LAS v2u*)(hp + 8 * q4) = pk; }
        }
        LDS_BARRIER();
        { const int tt = tid >> 3, p0 = (tid & 7) * 8;
          if (t0 + tt < L) { const size_t row = row_base + t0 + tt;
            f32x4 y0 = *(const LAS f32x4*)(YA + tt * 64 + p0) + *(const LAS f32x4*)(YY + tt * 64 + p0), y1 = *(const LAS f32x4*)(YA + tt * 64 + p0 + 4) + *(const LAS f32x4*)(YY + tt * 64 + p0 + 4);
            if (tt >= 32) { const v4u ow4 = *(const LAS v4u*)(YO + (tt - 32) * 64 + p0);
                y0 = y0 + (f32x4){bf2f(ow4.x & 0xffffu), __uint_as_float(ow4.x & 0xffff0000u), bf2f(ow4.y & 0xffffu), __uint_as_float(ow4.y & 0xffff0000u)};
                y1 = y1 + (f32x4){bf2f(ow4.z & 0xffffu), __uint_as_float(ow4.z & 0xffff0000u), bf2f(ow4.w & 0xffffu), __uint_as_float(ow4.w & 0xffff0000u)}; }
            float o[8]; float sq = 0.f;
#pragma unroll
            for (int j = 0; j < 8; ++j) { const unsigned z16 = (zw[j >> 1] >> ((j & 1) * 16)) & 0xffffu; const float yv = (j < 4 ? y0[j & 3] : y1[j & 3]) * silu_f(bf2f(z16)); o[j] = yv; sq += yv * yv; }
            ow_pend.x = pk2(o[0], o[1]); ow_pend.y = pk2(o[2], o[3]); ow_pend.z = pk2(o[4], o[5]); ow_pend.w = pk2(o[6], o[7]);
            sq += __shfl_xor(sq, 1); sq += __shfl_xor(sq, 2); sq += __shfl_xor(sq, 4); sq_pend = sq; pend = true; } }
        }
    }
    if (pend) { const size_t prow = row_base + (L - 64) + (tid >> 3); *(v4u*)(YG + prow * 2048 + h * 64 + (tid & 7) * 8) = ow_pend; if ((tid & 7) == 0) SSQ[prow * 32 + h] = sq_pend; }
#pragma unroll
    for (int q4 = 0; q4 < 4; ++q4) *(f32x4*)(st_g + 8 * q4) = (f32x4){H[4 * q4], H[4 * q4 + 1], H[4 * q4 + 2], H[4 * q4 + 3]};
    __syncthreads();
}
__device__ __forceinline__ float tr_reduce32(const float (&v)[32], int lane) {
    const bool b4 = lane & 16, b3 = lane & 8, b2 = lane & 4, b1 = lane & 2, b0 = lane & 1;
    float a[16], b[8], c[4], d[2];
#pragma unroll
    for (int i = 0; i < 16; ++i) { const float keep = b4 ? v[i + 16] : v[i], send = b4 ? v[i] : v[i + 16]; a[i] = keep + __shfl_xor(send, 16); }
#pragma unroll
    for (int i = 0; i < 8; ++i) { const float keep = b3 ? a[i + 8] : a[i], send = b3 ? a[i] : a[i + 8]; b[i] = keep + __shfl_xor(send, 8); }
#pragma unroll
    for (int i = 0; i < 4; ++i) { const float keep = b2 ? b[i + 4] : b[i], send = b2 ? b[i] : b[i + 4]; c[i] = keep + __shfl_xor(send, 4); }
#pragma unroll
    for (int i = 0; i < 2; ++i) { const float keep = b1 ? c[i + 2] : c[i], send = b1 ? c[i] : c[i + 2]; d[i] = keep + __shfl_xor(send, 2); }
    const float keep = b0 ? d[1] : d[0], send = b0 ? d[0] : d[1];
    return keep + __shfl_xor(send, 1);
}
__device__ __forceinline__ void ssd_sample_unit(Frame& F, int sb, int g) {
    int tid_o = F.tid; asm volatile("" : "+v"(tid_o));
    const int tid = tid_o, lane = tid & 63, w = F.wave, hh = lane >> 5, nq = lane & 31; unsigned char* ws = F.ws;
    LAS float* XC = (LAS float*)(F.lds + RING_OFF); LAS float* BC = XC + 8 * 4 * 64; LAS float* CC = BC + 4 * 128; LAS float* DTS = CC + 4 * 128;
    const bf16* PROJ = (const bf16*)(ws + WS_PROJ); const float* DTR = (const float*)(ws + WS_DT); bf16* YG = (bf16*)(ws + WS_YG); float* SSQ = (float*)(ws + WS_SSQSSD);
    const size_t row0 = (size_t)TP + (size_t)sb * LS;
    const int h = 8 * g + w;
    const float* sp = F.in[3] + (size_t)(sb * 32 + h) * 8192 + (size_t)hh * 128 + 4 * nq;
    f32x4 hst[32];
#pragma unroll
    for (int i = 0; i < 32; ++i) hst[i] = ld_nt(sp + (size_t)i * 256);
    if (tid < 384) { typedef float f32x2 __attribute__((ext_vector_type(2)));
        const int col = tid < 256 ? g * 512 + 2 * tid : (tid < 320 ? 2048 + g * 128 + 2 * (tid - 256) : 2560 + g * 128 + 2 * (tid - 320));
        const float* cw = F.in[10]; const float* sc = F.in[4] + (size_t)sb * 3 * 3072 + col;
        const f32x2 w0 = *(const f32x2*)(cw + col), w1 = *(const f32x2*)(cw + 3072 + col), w2 = *(const f32x2*)(cw + 2 * 3072 + col), w3 = *(const f32x2*)(cw + 3 * 3072 + col), cb = *(const f32x2*)(F.in[11] + col);
        f32x2 full[7]; full[0] = *(const f32x2*)sc; full[1] = *(const f32x2*)(sc + 3072); full[2] = *(const f32x2*)(sc + 2 * 3072);
        const bf16* cp = PROJ + (size_t)(S_X0 + (col >> 10)) * SLOT_ELEMS + row0 * 1024 + (col & 1023);
#pragma unroll
        for (int t = 0; t < 4; ++t) { const unsigned wd = *(const unsigned*)(cp + (size_t)t * 1024); full[3 + t] = (f32x2){__uint_as_float(wd << 16), __uint_as_float(wd & 0xffff0000u)}; }
#pragma unroll
        for (int t = 0; t < 4; ++t) { f32x2 a = w0 * full[t] + cb; a = w1 * full[t + 1] + a; a = w2 * full[t + 2] + a; a = w3 * full[t + 3] + a;
            f32x2 o; o.x = silu_f(a.x); o.y = silu_f(a.y);
            LAS float* dst = tid < 256 ? XC + ((tid >> 5) * 4 + t) * 64 + 2 * (tid & 31) : (tid < 320 ? BC + t * 128 + 2 * (tid - 256) : CC + t * 128 + 2 * (tid - 320));
            *(LAS f32x2*)dst = o; }
    } else if (tid < 416) { const int idx = tid - 384, hl = idx >> 2, t = idx & 3; const float x = DTR[(row0 + t) * 32 + 8 * g + hl] + F.in[12][8 * g + hl]; DTS[idx] = x > 20.f ? x : log1pf(__expf(x)); }
    __syncthreads();
    const float a = -__expf(F.in[13][h]), Dk = F.in[14][h];
#pragma unroll 1
    for (int t = 0; t < 4; ++t) {
        const float dtv = DTS[w * 4 + t], dA = __expf(dtv * a);
        const f32x4 Bv = *(const LAS f32x4*)(BC + t * 128 + 4 * nq), Cv = *(const LAS f32x4*)(CC + t * 128 + 4 * nq);
        const LAS float* xrow = XC + (w * 4 + t) * 64;
        float part[32];
#pragma unroll
        for (int i = 0; i < 32; ++i) { const float xd = xrow[2 * i + hh] * dtv; hst[i] = hst[i] * dA + Bv * xd; part[i] = (hst[i].x * Cv.x + hst[i].y * Cv.y) + (hst[i].z * Cv.z + hst[i].w * Cv.w); }
        float yv = tr_reduce32(part, lane);
        const int p = 2 * nq + hh; const size_t row = row0 + t;
        yv += Dk * xrow[p];
        const float z = bf2f(PROJ[(size_t)(S_Z0 + (h >> 4)) * SLOT_ELEMS + row * 1024 + (h & 15) * 64 + p]);
        const float yg = yv * silu_f(z);
        YG[row * 2048 + h * 64 + p] = (bf16)f2bf(yg);
        const float sq = wave_sum(yg * yg);
        if (lane == 0) SSQ[row * 32 + h] = sq;
    }
    float* so = F.out + O_SSMS + (size_t)(sb * 32 + h) * 8192 + (size_t)hh * 128 + 4 * nq;
#pragma unroll
    for (int i = 0; i < 32; ++i) st_nt(so + (size_t)i * 256, hst[i]);
    __syncthreads();
}
__device__ __forceinline__ void hgrn_sample_unit(Frame& F, int sb, int hq) {
    int tid_o = F.tid; asm volatile("" : "+v"(tid_o));
    const int tid = tid_o, lane = tid & 63, w = F.wave, hh = lane >> 5, vq = lane & 31; unsigned char* ws = F.ws;
    LAS float* FS = (LAS float*)(F.lds + RING_OFF); LAS float* KS = FS + 2048; LAS float* QS = KS + 2048; LAS float* VS = QS + 2048; LAS float* OP = VS + 2048;
    const bf16* PROJ = (const bf16*)(ws + WS_PROJ); bf16* ON = (bf16*)(ws + WS_ON);
    const size_t row0 = (size_t)TP + (size_t)sb * LS;
    const int hl = w >> 1, kh = w & 1, hd = 4 * hq + hl;
    const float* sp = F.in[5] + (size_t)(sb * 8 + hd) * 16384 + (size_t)(64 * kh + hh) * 128 + 4 * vq;
    f32x4 S[32];
#pragma unroll
    for (int i = 0; i < 32; ++i) S[i] = ld_nt(sp + (size_t)i * 256);
    { const int ch = hq * 512 + tid; const float lb = __builtin_amdgcn_rcpf(1.0f + __expf(F.in[17][1024 + ch] - F.in[17][ch]));
      const bf16* fp = PROJ + (size_t)S_F * SLOT_ELEMS + row0 * 1024 + ch; const bf16* qp = PROJ + (size_t)S_Q * SLOT_ELEMS + row0 * 1024 + ch; const bf16* ip = PROJ + (size_t)S_I * SLOT_ELEMS + row0 * 1024 + ch;
#pragma unroll
      for (int t = 0; t < 4; ++t) { const float u = fminf(fmaxf(bf2f(fp[(size_t)t * 1024]), -30.f), 30.f); const float fg = lb + (1.0f - lb) * sigmoid_f(u);
          const int o = ((tid >> 7) * 4 + t) * 128 + (tid & 127);
          FS[o] = fg; KS[o] = 1.0f - fg; QS[o] = silu_f(bf2f(qp[(size_t)t * 1024])); VS[o] = bf2f(ip[(size_t)t * 1024]); } }
    __syncthreads();
#pragma unroll 1
    for (int t = 0; t < 4; ++t) {
        const int o = (hl * 4 + t) * 128;
        const f32x4 vv = *(const LAS f32x4*)(VS + o + 4 * vq);
        f32x4 oa = (f32x4){0.f, 0.f, 0.f, 0.f};
#pragma unroll
        for (int i = 0; i < 32; ++i) { const int k = 64 * kh + 2 * i + hh; const float fk = FS[o + k], kv = KS[o + k], qk = QS[o + k]; S[i] = S[i] * fk + vv * kv; oa = oa + S[i] * qk; }
        oa.x += __shfl_xor(oa.x, 32); oa.y += __shfl_xor(oa.y, 32); oa.z += __shfl_xor(oa.z, 32); oa.w += __shfl_xor(oa.w, 32);
        if (hh == 0) *(LAS f32x4*)(OP + ((hl * 4 + t) * 2 + kh) * 128 + 4 * vq) = oa;
    }
    float* so = F.out + O_HGS + (size_t)(sb * 8 + hd) * 16384 + (size_t)(64 * kh + hh) * 128 + 4 * vq;
#pragma unroll
    for (int i = 0; i < 32; ++i) st_nt(so + (size_t)i * 256, S[i]);
    __syncthreads();
#pragma unroll
    for (int rr2 = 0; rr2 < 2; ++rr2) { const int rr = 2 * w + rr2, ohl = rr >> 2, t = rr & 3, ohd = 4 * hq + ohl; typedef float f32x2 __attribute__((ext_vector_type(2)));
        const f32x2 p0 = *(const LAS f32x2*)(OP + (rr * 2) * 128 + 2 * lane), p1 = *(const LAS f32x2*)(OP + (rr * 2 + 1) * 128 + 2 * lane);
        const float o0 = p0.x + p1.x, o1 = p0.y + p1.y; const float sq = wave_sum(o0 * o0 + o1 * o1); const float rs = __builtin_amdgcn_rsqf(sq * (1.0f / 128.0f) + EPS);
        const size_t row = row0 + t; const unsigned gw = *(const unsigned*)(PROJ + (size_t)S_HG * SLOT_ELEMS + row * 1024 + ohd * 128 + 2 * lane);
        *(unsigned*)(ON + row * 1024 + ohd * 128 + 2 * lane) = pk2(o0 * rs * silu_f(bf2f(gw & 0xffffu)), o1 * rs * silu_f(__uint_as_float(gw & 0xffff0000u))); }
    __syncthreads();
}
constexpr int U_HGS = NBS * 2, U_SSDS = NBS * 4, U_CONV = NBP + NBS;
__device__ __forceinline__ void scan_phase(Frame& F) {
    gu32* head = F.ctl + CW_QUEUE;
#define SCAN_QUEUE(qi, count, body) for (;;) { if (F.tid == 0) F.MISC[0] = __hip_atomic_fetch_add(head + 64 * (qi), 1u, RLX_AGENT); __syncthreads(); const int u = (int)F.MISC[0]; __syncthreads(); if (u >= (count)) break; body }
    SCAN_QUEUE(1, NBP * 32, ssd_unit_mfma(F, u >> 5, u & 31);)
    SCAN_QUEUE(0, NBP * 32, hgrn_v_unit(F, u >> 5, (u >> 2) & 7, u & 3);)
    SCAN_QUEUE(2, U_HGS, hgrn_sample_unit(F, u >> 1, u & 1);)
    SCAN_QUEUE(3, U_SSDS + U_CONV, if (u >= U_SSDS) { conv_copy_unit(F, u - U_SSDS); continue; } ssd_sample_unit(F, u >> 2, u & 3);)
#undef SCAN_QUEUE
}
typedef float f32x4s __attribute__((ext_vector_type(4)));
template <class Epi> __device__ __forceinline__ void small_tile_phase(Frame& F, const bf16* A, const bf16* Bt, int K, const Epi& E) {
    const int lane = F.lane, w = F.wave, r = lane & 31, hh = lane >> 5;
#pragma unroll 1
    for (int v = F.vcu; v < 256; v += F.G) {
    const int mt = v >> 4, nt = v & 15;
    const int kw = K >> 3;
    const bf16* ap = A + (size_t)(TP + 32 * mt + r) * K + w * kw + 8 * hh;
    const bf16* bp = Bt + (size_t)(64 * nt + r) * K + w * kw + 8 * hh;
    f32x16 acc0, acc1;
#pragma unroll
    for (int i = 0; i < 16; ++i) { acc0[i] = 0.f; acc1[i] = 0.f; }
#pragma unroll 4
    for (int ks = 0; ks < kw / 16; ++ks) { const bf16x8 af = *(const bf16x8*)(ap + 16 * ks), b0 = *(const bf16x8*)(bp + 16 * ks), b1 = *(const bf16x8*)(bp + (size_t)32 * K + 16 * ks);
        acc0 = MFMA32(b0, af, acc0); acc1 = MFMA32(b1, af, acc1); }
    LAS float* part = (LAS float*)(F.lds + RING_OFF) + w * 2048;
#pragma unroll
    for (int q4 = 0; q4 < 4; ++q4) { *(LAS f32x4*)(part + r * 64 + 8 * q4 + 4 * hh) = (f32x4){acc0[4 * q4], acc0[4 * q4 + 1], acc0[4 * q4 + 2], acc0[4 * q4 + 3]};
        *(LAS f32x4*)(part + r * 64 + 32 + 8 * q4 + 4 * hh) = (f32x4){acc1[4 * q4], acc1[4 * q4 + 1], acc1[4 * q4 + 2], acc1[4 * q4 + 3]}; }
    __syncthreads();
    const int rl = F.tid >> 4, c4 = (F.tid & 15) * 4; const LAS float* src = (const LAS float*)(F.lds + RING_OFF) + rl * 64 + c4;
    f32x4 sum = *(const LAS f32x4*)src;
#pragma unroll
    for (int ww = 1; ww < 8; ++ww) sum = sum + *(const LAS f32x4*)(src + ww * 2048);
    const f32x4s acc = (f32x4s){sum.x, sum.y, sum.z, sum.w};
    E.small(F, acc, TP + 32 * mt + rl, 64 * nt + c4, nt);
    __syncthreads();
    }
}
template <bool ADD> struct SmGate { bf16* O; const bf16* gate;
    __device__ __forceinline__ void small(Frame&, const f32x4s& a, int row, int col, int) const { const size_t off = (size_t)row * 1024 + col;
        const v2u gw = __builtin_nontemporal_load((const v2u*)(gate + off)); v2u ow = (v2u){0u, 0u}; if (ADD) ow = *(const v2u*)(O + off);
        float rr[4];
#pragma unroll
        for (int e = 0; e < 4; ++e) { const unsigned g16 = (gw[e >> 1] >> ((e & 1) * 16)) & 0xffffu, o16 = (ow[e >> 1] >> ((e & 1) * 16)) & 0xffffu; rr[e] = (ADD ? bf2f(o16) : 0.f) + sigmoid_f(bf2f(g16)) * a[e]; }
        v2u wv; wv.x = cvtpk_c(rr[0], rr[1]); wv.y = cvtpk_c(rr[2], rr[3]); *(v2u*)(O + off) = wv; } };
template <bool BF, bool BSC = false> struct SmRes { const float* base; const bf16* bb; bf16* hb; float* ssqp; const float* bsc;
    __device__ __forceinline__ void small(Frame& F, const f32x4s& a, int row, int col, int nt) const { const size_t off = (size_t)row * 1024 + col; f32x4 b;
        if (BF) { const v2u w = *(const v2u*)(bb + off); b = (f32x4){bf2f(w.x & 0xffffu), __uint_as_float(w.x & 0xffff0000u), bf2f(w.y & 0xffffu), __uint_as_float(w.y & 0xffff0000u)}; }
        else b = *(const f32x4*)(base + off);
        if constexpr (BSC) b = b * bsc[row];
        const f32x4 v = b + (f32x4){a[0], a[1], a[2], a[3]};
        { v2u wv; wv.x = cvtpk_c(v[0], v[1]); wv.y = cvtpk_c(v[2], v[3]); *(v2u*)(hb + off) = wv; }
        float sq = (v[0] * v[0] + v[1] * v[1]) + (v[2] * v[2] + v[3] * v[3]); sq += __shfl_xor(sq, 1); sq += __shfl_xor(sq, 2); sq += __shfl_xor(sq, 4); sq += __shfl_xor(sq, 8);
        if ((F.tid & 15) == 0) ssqp[(size_t)row * 16 + nt] = sq; } };
struct SmScale { bf16* O; const float* ssq; float scale;
    __device__ __forceinline__ void small(Frame&, const f32x4s& a, int row, int col, int) const { const float rs = pg8::row_rs<16>(ssq, row) * scale;
        v2u wv; wv.x = cvtpk_c(a[0] * rs, a[1] * rs); wv.y = cvtpk_c(a[2] * rs, a[3] * rs); *(v2u*)(O + (size_t)row * 1024 + col) = wv; } };
__device__ __forceinline__ void attn_stage_tile(LAS unsigned char* Lb, const bf16* src, size_t pitch, int tid) {
#pragma unroll 1
    for (int hb = 0; hb < 2; ++hb) { v4u v[8];
#pragma unroll
        for (int i = 0; i < 8; ++i) { const int id = tid + 512 * (8 * hb + i), row = id >> 5, c = id & 31; v[i] = *(const v4u*)(src + (size_t)row * pitch + c * 8); }
#pragma unroll
        for (int i = 0; i < 8; ++i) { const int id = tid + 512 * (8 * hb + i), row = id >> 5, c = id & 31; *(LAS v4u*)(Lb + row * 512 + ((c ^ (row & 15)) << 4)) = v[i]; } }
}
__device__ __forceinline__ void attn_prompt_unit(Frame& F, int b, int hd, int qb) {
    const int tid = F.tid, lane = F.lane, w = F.wave, r = lane & 31, hh = lane >> 5; unsigned char* ws = F.ws;
    LAS unsigned char* Lb = F.lds + RING_OFF;
    const bf16* QB = (const bf16*)(ws + WS_QB); const bf16* KB = (const bf16*)(ws + WS_KB); const bf16* VT = (const bf16*)(ws + WS_VT); bf16* OB = (bf16*)(ws + WS_OB);
    const size_t qrow = (size_t)b * SEQ + (size_t)qb * 256 + 32 * w + r;
    attn_stage_tile(Lb, KB + (size_t)b * 256 * 1024 + hd * 256, 1024, tid);
    const bf16* qp = QB + qrow * 1024 + hd * 256 + 8 * hh;
    bf16x8 qf = *(const bf16x8*)qp;
    __syncthreads();
    f32x16 S[8];
#pragma unroll
    for (int t = 0; t < 8; ++t)
#pragma unroll
        for (int i = 0; i < 16; ++i) S[t][i] = 0.f;
    const int sw = r & 15;
#pragma unroll 1
    for (int ks = 0; ks < 16; ++ks) {
        const bf16x8 qn = *(const bf16x8*)(qp + 16 * (ks < 15 ? ks + 1 : ks));
        const LAS unsigned char* kp = Lb + r * 512 + (((2 * ks + hh) ^ sw) << 4);
#pragma unroll
        for (int t = 0; t < 8; ++t) S[t] = MFMA32(lds_frag16(kp + t * 32 * 512), qf, S[t]);
        qf = qn;
    }
    float m = -3.0e38f;
#pragma unroll
    for (int t = 0; t < 8; ++t)
#pragma unroll
        for (int i = 0; i < 16; ++i) m = fmaxf(m, S[t][i]);
    m = fmaxf(m, __shfl_xor(m, 32));
    float l = 0.f;
#pragma unroll
    for (int t = 0; t < 8; ++t)
#pragma unroll
        for (int i = 0; i < 16; ++i) { const float pv = __builtin_amdgcn_exp2f(S[t][i] - m); S[t][i] = pv; l += pv; }
    l += __shfl_xor(l, 32);
    const float rl = __builtin_amdgcn_rcpf(l);
    bf16x8 pf[8][2];
#pragma unroll
    for (int t = 0; t < 8; ++t) { pf[t][0] = ACC_FRAG(S[t], 0); pf[t][1] = ACC_FRAG(S[t], 1); }
    __syncthreads();
    attn_stage_tile(Lb, VT + (size_t)(b * 4 + hd) * 256 * 256, 256, tid);
    __syncthreads();
    bf16* op = OB + qrow * 1024 + hd * 256 + 4 * hh;
#pragma unroll 1
    for (int dt = 0; dt < 8; ++dt) {
        f32x16 O;
#pragma unroll
        for (int i = 0; i < 16; ++i) O[i] = 0.f;
        const LAS unsigned char* vrow = Lb + (32 * dt + r) * 512 + 8 * hh;
#pragma unroll
        for (int t = 0; t < 8; ++t)
#pragma unroll
            for (int s2 = 0; s2 < 2; ++s2) {
                const v2u lo = *(const LAS v2u*)(vrow + (((4 * t + 2 * s2) ^ sw) << 4)), hi = *(const LAS v2u*)(vrow + (((4 * t + 2 * s2 + 1) ^ sw) << 4));
                const v4u wv4 = (v4u){lo.x, lo.y, hi.x, hi.y};
                O = MFMA32(__builtin_bit_cast(bf16x8, wv4), pf[t][s2], O);
            }
#pragma unroll
        for (int q4 = 0; q4 < 4; ++q4) { v2u o; o.x = cvtpk_c(O[4 * q4] * rl, O[4 * q4 + 1] * rl); o.y = cvtpk_c(O[4 * q4 + 2] * rl, O[4 * q4 + 3] * rl);
            *(v2u*)(op + 32 * dt + 8 * q4) = o; }
    }
    __syncthreads();
}
__device__ __forceinline__ void attn_sample_unit(Frame& F, int sb, int hd) {
    const int tid = F.tid, lane = F.lane, w = F.wave; unsigned char* ws = F.ws;
    LAS float* sc = (LAS float*)(F.lds + RING_OFF);
    LAS float* red = sc + 4 * 256;
    const bf16* QB = (const bf16*)(ws + WS_QB); bf16* OB = (bf16*)(ws + WS_OB);
    const size_t rowq = (size_t)TP + (size_t)sb * LS;
    float q[4][4];
#pragma unroll
    for (int t = 0; t < 4; ++t) { const v2u qw = *(const v2u*)(QB + (rowq + t) * 1024 + hd * 256 + 4 * lane); q[t][0] = bf2f(qw.x & 0xffffu); q[t][1] = bf2f(qw.x >> 16); q[t][2] = bf2f(qw.y & 0xffffu); q[t][3] = bf2f(qw.y >> 16); }
    const float* Kc = F.in[6] + ((size_t)sb * 256 * 4 + hd) * 256 + 4 * lane; const float* Vc = F.in[7] + ((size_t)sb * 256 * 4 + hd) * 256 + 4 * lane;
    f32x4 kv[8], kn[8];
#pragma unroll
    for (int u = 0; u < 8; ++u) kv[u] = ld_nt(Kc + (size_t)(w * 32 + u) * 1024);
#pragma unroll 1
    for (int kk0 = 0; kk0 < 32; kk0 += 8) {
#pragma unroll
        for (int u = 0; u < 8; ++u) kn[u] = kk0 < 24 ? ld_nt(Kc + (size_t)(w * 32 + kk0 + 8 + u) * 1024) : ld_nt(Vc + (size_t)(w * 32 + u) * 1024);
        { float part[32];
#pragma unroll
          for (int u = 0; u < 8; ++u)
#pragma unroll
              for (int t = 0; t < 4; ++t) part[4 * u + t] = (q[t][0] * kv[u].x + q[t][1] * kv[u].y) + (q[t][2] * kv[u].z + q[t][3] * kv[u].w);
          float sv = tr_reduce32(part, lane); sv += __shfl_xor(sv, 32);
          if (lane < 32) sc[(lane & 3) * 256 + w * 32 + kk0 + (lane >> 2)] = sv; }
#pragma unroll
        for (int u = 0; u < 8; ++u) kv[u] = kn[u]; }
    __syncthreads();
    if (w < 4) { float v[4]; float m = -3.0e38f;
#pragma unroll
        for (int j = 0; j < 4; ++j) { v[j] = sc[w * 256 + j * 64 + lane]; m = fmaxf(m, v[j]); }
        m = wave_max(m); float l = 0.f;
#pragma unroll
        for (int j = 0; j < 4; ++j) { v[j] = __builtin_amdgcn_exp2f(v[j] - m); l += v[j]; }
        l = wave_sum(l); const float rl = 1.0f / l;
#pragma unroll
        for (int j = 0; j < 4; ++j) sc[w * 256 + j * 64 + lane] = v[j] * rl; }
    __syncthreads();
    float o[4][4];
#pragma unroll
    for (int t = 0; t < 4; ++t)
#pragma unroll
        for (int e = 0; e < 4; ++e) o[t][e] = 0.f;
#pragma unroll 1
    for (int kk0 = 0; kk0 < 32; kk0 += 8) {
        if (kk0 < 24) {
#pragma unroll
            for (int u = 0; u < 8; ++u) kn[u] = ld_nt(Vc + (size_t)(w * 32 + kk0 + 8 + u) * 1024); }
#pragma unroll
        for (int u = 0; u < 8; ++u) { const int key = w * 32 + kk0 + u;
#pragma unroll
            for (int t = 0; t < 4; ++t) { const float pr = sc[t * 256 + key]; o[t][0] += pr * kv[u].x; o[t][1] += pr * kv[u].y; o[t][2] += pr * kv[u].z; o[t][3] += pr * kv[u].w; } }
#pragma unroll
        for (int u = 0; u < 8; ++u) kv[u] = kn[u]; }
#pragma unroll
    for (int t = 0; t < 4; ++t) *(LAS f32x4*)(red + (w * 4 + t) * 256 + 4 * lane) = (f32x4){o[t][0], o[t][1], o[t][2], o[t][3]};
    __syncthreads();
    { const int t = tid >> 7, d0 = (tid & 127) * 2; float a0 = 0.f, a1 = 0.f;
#pragma unroll
      for (int ww = 0; ww < 8; ++ww) { a0 += red[(ww * 4 + t) * 256 + d0]; a1 += red[(ww * 4 + t) * 256 + d0 + 1]; }
      *(unsigned*)(OB + (rowq + t) * 1024 + hd * 256 + d0) = pk2(a0, a1); }
    __syncthreads();
}
__device__ __forceinline__ void attn_phase(Frame& F) {
    for (int u = F.vcu; u < NBP * 4 * 8; u += F.G) attn_prompt_unit(F, u >> 5, (u >> 3) & 3, u & 7);
    for (int u = F.vcu; u < NBS * 4; u += F.G) attn_sample_unit(F, u >> 2, u & 3);
}
__device__ __forceinline__ void final_norm_phase(Frame& F) {
    const int gw = F.vcu * NWAVES + F.wave, NGW = F.G * NWAVES; const float* SSQ = (const float*)(F.ws + WS_SSQP3); const float* wn = F.in[31]; const bf16* HB = (const bf16*)(F.ws + WS_HB);
    f32x4 wv[4];
#pragma unroll
    for (int j = 0; j < 2; ++j) { wv[2 * j] = *((const f32x4*)wn + 2 * (64 * j + F.lane)); wv[2 * j + 1] = *((const f32x4*)wn + 2 * (64 * j + F.lane) + 1); }
    for (int row = gw; row < T; row += NGW) {
        const f32x4* sp = (const f32x4*)(SSQ + (size_t)row * 16); float s = 0.f;
#pragma unroll
        for (int j = 0; j < 4; ++j) { const f32x4 a = sp[j]; s += (a.x + a.y) + (a.z + a.w); }
        const float rs = __builtin_amdgcn_rsqf(s * (1.0f / 1024.0f) + EPS);
#pragma unroll
        for (int j = 0; j < 2; ++j) { const int pc = 64 * j + F.lane; const v4u w = ld_nt16((const v4u*)(HB + (size_t)row * 1024) + pc);
            const f32x4 v0 = (f32x4){bf2f(w.x & 0xffffu), __uint_as_float(w.x & 0xffff0000u), bf2f(w.y & 0xffffu), __uint_as_float(w.y & 0xffff0000u)};
            const f32x4 v1 = (f32x4){bf2f(w.z & 0xffffu), __uint_as_float(w.z & 0xffff0000u), bf2f(w.w & 0xffffu), __uint_as_float(w.w & 0xffff0000u)};
            float* o = F.out + O_Y + (size_t)row * 1024 + 8 * pc; st_nt(o, v0 * rs * wv[2 * j]); st_nt(o + 4, v1 * rs * wv[2 * j + 1]); }
    }
}
#ifndef MK_N_LAUNCHES
#define MK_N_LAUNCHES 1
#endif
constexpr int PER_PHASE = 13;
constexpr int N_LAUNCHES = MK_N_LAUNCHES;
struct Args { const float* in[32]; float* out; unsigned char* ws; int ph_lo, ph_hi; };
__global__ void __launch_bounds__(NTHR, 2) skel_fwd(Args args) {
    extern __shared__ __attribute__((aligned(16))) unsigned char lds[];
    Frame F;
    F.lds = (LAS unsigned char*)lds;
    F.MISC = (volatile LAS unsigned*)(F.lds + MISC_OFF);
    F.tid = threadIdx.x; F.lane = F.tid & 63; F.wave = __builtin_amdgcn_readfirstlane(F.tid >> 6);
    F.G = gridDim.x; { const int bx = blockIdx.x; F.vcu = (F.G % 8 == 0) ? (bx % 8) * (F.G / 8) + bx / 8 : bx; }
    unsigned char* ws = args.ws; F.ws = ws; F.out = args.out;
    F.ctl = (gu32*)(ws + WS_CTL);
#pragma unroll
    for (int i = 0; i < 32; ++i) F.in[i] = args.in[i];
    for (int u = F.tid; u < (LDS_BYTES - LDSCTL_OFF) / 4; u += NTHR) ((LAS unsigned*)(F.lds + LDSCTL_OFF))[u] = 0u;
    __syncthreads();
    XcdBarrier bar; bar.bar = (unsigned*)(F.ctl + CW_BAR); bar.x = 0; bar.st = nullptr;
    if (N_LAUNCHES == 1) bar = xcd_barrier_post((unsigned*)(F.ctl + CW_BAR), F.MISC + 8);
#define GRID_BAR() do { if (N_LAUNCHES == 1) xcd_barrier(bar); } while (0)
    const int lo = args.ph_lo, hi = args.ph_hi;
#ifdef ONLY_PHASE
#define IN(k) ((k) == ONLY_PHASE && lo <= (k) && (k) < hi)
#else
#define IN(k) (lo <= (k) && (k) < hi)
#endif
#define BOTH(k) (IN(k) && IN((k) + 1))
    bf16* const XB = (bf16*)(ws + WS_XB); bf16* const PROJ = (bf16*)(ws + WS_PROJ);
    float* const Y = F.out + O_Y;
    if (IN(0)) { p0_prologue(F); if (BOTH(0)) GRID_BAR(); }
    if (IN(1)) {
        { pg8::Gemm g{XB, (const bf16*)(ws + WS_WIN), T, NPROJ, 1024}; pg8::StaticOrder S; S.init(T, NPROJ, F.G, (int)blockIdx.x);
          pg8::EpiScaleBf16<0, true> E{PROJ, SLOT_ELEMS, nullptr, 1.0f, (float*)(ws + WS_DT)};
          pg8::gemm_phase<pg8::EpiScaleBf16<0, true>, pg8::StaticOrder, true, true>(F.lds + RING_OFF, g, S, E); }
        { pg8::Gemm g{(const bf16*)(ws + WS_MNB), (const bf16*)(ws + WS_WKV), MEMR, 2048, 1024}; pg8::StaticOrder S; S.init(MEMR, 2048, F.G, (int)((blockIdx.x + 64) % F.G));
          pg8::EpiKV E{F.out + O_MKP, F.out + O_MVP, (bf16*)(ws + WS_KB), (bf16*)(ws + WS_VT), (const float*)(ws + WS_SSQM)};
          pg8::gemm_phase<pg8::EpiKV, pg8::StaticOrder, true, true>(F.lds + RING_OFF, g, S, E); }
        if (BOTH(1)) GRID_BAR();
    }
    if (IN(2)) { bc_prep_phase(F); hg_prep_phase(F); if (BOTH(2)) GRID_BAR(); }
    if (IN(3)) { scan_phase(F); if (BOTH(3)) GRID_BAR(); }
    if (IN(4)) { ssdnorm_phase(F); hgnorm_phase(F); if (BOTH(4)) GRID_BAR(); }
    if (IN(5)) { { SmGate<false> Es{(bf16*)(ws + WS_MERGED), PROJ + (size_t)S_GS * SLOT_ELEMS}; small_tile_phase(F, (const bf16*)(ws + WS_YG), (const bf16*)(ws + WS_WSSD), 2048, Es); }
        pg8::Gemm g{(const bf16*)(ws + WS_YG), (const bf16*)(ws + WS_WSSD), TP, 1024, 2048}; pg8::StaticOrder S; S.init(TP, 1024, F.G, (int)blockIdx.x);
        pg8::EpiGate<false> E{(bf16*)(ws + WS_MERGED), PROJ + (size_t)S_GS * SLOT_ELEMS};
        pg8::gemm_phase<pg8::EpiGate<false>, pg8::StaticOrder, true, true>(F.lds + RING_OFF, g, S, E);
          }
    if (IN(5)) { { SmGate<true> Es{(bf16*)(ws + WS_MERGED), PROJ + (size_t)S_GH * SLOT_ELEMS}; small_tile_phase(F, (const bf16*)(ws + WS_ON), (const bf16*)(ws + WS_WHG), 1024, Es); }
        pg8::Gemm g{(const bf16*)(ws + WS_ON), (const bf16*)(ws + WS_WHG), TP, 1024, 1024}; pg8::StaticOrder S; S.init(TP, 1024, F.G, (int)blockIdx.x);
        pg8::EpiGate<true> E{(bf16*)(ws + WS_MERGED), PROJ + (size_t)S_GH * SLOT_ELEMS};
        pg8::gemm_phase<pg8::EpiGate<true>, pg8::StaticOrder, true, true>(F.lds + RING_OFF, g, S, E);
        if (BOTH(5)) GRID_BAR(); }
    if (IN(6)) { { SmRes<true, true> Es{nullptr, XB, (bf16*)(ws + WS_HB), (float*)(ws + WS_SSQP1), (const float*)(ws + WS_SSQX)}; small_tile_phase(F, (const bf16*)(ws + WS_MERGED), (const bf16*)(ws + WS_WOUT), 1024, Es); }
        pg8::Gemm g{(const bf16*)(ws + WS_MERGED), (const bf16*)(ws + WS_WOUT), TP, 1024, 1024}; pg8::StaticOrder S; S.init(TP, 1024, F.G, (int)blockIdx.x);
        pg8::EpiRes<true, true> E{nullptr, nullptr, XB, (bf16*)(ws + WS_HB), (float*)(ws + WS_SSQP1), (const float*)(ws + WS_SSQX)};
        pg8::gemm_phase<pg8::EpiRes<true, true>, pg8::StaticOrder, true, true>(F.lds + RING_OFF, g, S, E);
        if (BOTH(6)) GRID_BAR(); }
    if (IN(7)) { { SmScale Es{(bf16*)(ws + WS_QB), (const float*)(ws + WS_SSQP1), QSCALE}; small_tile_phase(F, (const bf16*)(ws + WS_HB), (const bf16*)(ws + WS_WCQ), 1024, Es); }
        pg8::Gemm g{(const bf16*)(ws + WS_HB), (const bf16*)(ws + WS_WCQ), TP, 1024, 1024}; pg8::StaticOrder S; S.init(TP, 1024, F.G, (int)blockIdx.x);
        pg8::EpiScaleBf16<16, false> E{(bf16*)(ws + WS_QB), SLOT_ELEMS, (const float*)(ws + WS_SSQP1), QSCALE, nullptr};
        pg8::gemm_phase<pg8::EpiScaleBf16<16, false>, pg8::StaticOrder, true, true>(F.lds + RING_OFF, g, S, E);
        if (BOTH(7)) GRID_BAR(); }
    if (IN(8)) { attn_phase(F); if (BOTH(8)) GRID_BAR(); }
    if (IN(9)) { { SmRes<true> Es{nullptr, (const bf16*)(ws + WS_HB), (bf16*)(ws + WS_HB), (float*)(ws + WS_SSQP2)}; small_tile_phase(F, (const bf16*)(ws + WS_OB), (const bf16*)(ws + WS_WCO), 1024, Es); }
        pg8::Gemm g{(const bf16*)(ws + WS_OB), (const bf16*)(ws + WS_WCO), TP, 1024, 1024}; pg8::StaticOrder S; S.init(TP, 1024, F.G, (int)blockIdx.x);
        pg8::EpiRes<true> E{nullptr, nullptr, (const bf16*)(ws + WS_HB), (bf16*)(ws + WS_HB), (float*)(ws + WS_SSQP2)};
        pg8::gemm_phase<pg8::EpiRes<true>, pg8::StaticOrder, true, true>(F.lds + RING_OFF, g, S, E);
        if (BOTH(9)) GRID_BAR(); }
    if (IN(10)) { pg8::Gemm g{(const bf16*)(ws + WS_HB), (const bf16*)(ws + WS_WGU), T, 2 * FFN, 1024}; pg8::StaticOrder S; S.init(T, 2 * FFN, F.G, (int)blockIdx.x);
        pg8::EpiSwiglu E{(bf16*)(ws + WS_ACT), (const float*)(ws + WS_SSQP2)};
        pg8::gemm_phase<pg8::EpiSwiglu, pg8::StaticOrder, true, true>(F.lds + RING_OFF, g, S, E);
        if (BOTH(10)) GRID_BAR(); }
    if (IN(11)) { { SmRes<true> Es{nullptr, (const bf16*)(ws + WS_HB), (bf16*)(ws + WS_HB), (float*)(ws + WS_SSQP3)}; small_tile_phase(F, (const bf16*)(ws + WS_ACT), (const bf16*)(ws + WS_WDN), FFN, Es); }
        pg8::Gemm g{(const bf16*)(ws + WS_ACT), (const bf16*)(ws + WS_WDN), TP, 1024, FFN}; pg8::StaticOrder S; S.init(TP, 1024, F.G, (int)blockIdx.x);
        pg8::EpiRes<true> E{nullptr, nullptr, (const bf16*)(ws + WS_HB), (bf16*)(ws + WS_HB), (float*)(ws + WS_SSQP3)};
        pg8::gemm_phase<pg8::EpiRes<true>, pg8::StaticOrder, true, true>(F.lds + RING_OFF, g, S, E);
        if (BOTH(11)) GRID_BAR(); }
    if (IN(12)) final_norm_phase(F);
#undef IN
#undef BOTH
}

extern "C" void kernel_launch(void* const* d_in, const int* in_sizes, int n_in, void* d_out, int out_size, void* d_ws, size_t ws_size, hipStream_t stream) {
    static int grid = 0;
    if (grid == 0) {
        const int want[32] = {TP * 1024, TS * 1024, MEMR * 1024, 33554432, 1179648, 16777216, 33554432, 33554432, 1024, 1024 * 11296, 4 * 3072, 3072, 32, 32, 32, 2048, 2048 * 1024, 2048, 1024,
                              1024 * 1024, 1024 * 1024, 1024, 1024, 1024 * 1024, 1024 * 1024, 1024 * 1024, 1024 * 1024, 1024, 1024 * FFN, 1024 * FFN, FFN * 1024, 1024};
        bool ok = (n_in == 32); for (int i = 0; ok && i < 32; ++i) if (in_sizes[i] != want[i]) { fprintf(stderr, "kernel_launch: input %d has %d elements, expected %d\n", i, in_sizes[i], want[i]); ok = false; }
        if (!ok || out_size != (int)O_END || ws_size < WS_END4) { fprintf(stderr, "kernel_launch: unexpected shapes: n_in %d out %d ws %zu\n", n_in, out_size, ws_size); grid = -1; return; }
        int dev = 0, cus = 0, per_cu = 0;
        if (hipGetDevice(&dev) != hipSuccess || hipDeviceGetAttribute(&cus, hipDeviceAttributeMultiprocessorCount, dev) != hipSuccess) { grid = -1; return; }
        if (hipFuncSetAttribute((const void*)skel_fwd, hipFuncAttributeMaxDynamicSharedMemorySize, LDS_BYTES) != hipSuccess) { fprintf(stderr, "kernel_launch: hipFuncSetAttribute failed\n"); grid = -1; return; }
        if (hipOccupancyMaxActiveBlocksPerMultiprocessor(&per_cu, (const void*)skel_fwd, NTHR, LDS_BYTES) != hipSuccess || per_cu < 1) fprintf(stderr, "kernel_launch: occupancy query reports %d blocks per CU\n", per_cu);
        (void)hipGetLastError();
        grid = cus;
    }
    if (grid < 0) return;
    (void)hipMemsetAsync((char*)d_ws + WS_CTL, 0, CTL_ZERO_BYTES, stream);
    Args a{};
    for (int i = 0; i < 32; ++i) a.in[i] = (const float*)d_in[i];
    a.out = (float*)d_out; a.ws = (unsigned char*)d_ws;
    for (int li = 0; li < N_LAUNCHES; ++li) {
        a.ph_lo = (N_LAUNCHES == PER_PHASE) ? li : 0; a.ph_hi = (N_LAUNCHES == PER_PHASE) ? li + 1 : PER_PHASE;
        hipLaunchKernelGGL(skel_fwd, dim3(grid), dim3(NTHR), LDS_BYTES, stream, a);
    }
}
```

```cpp
#include <hip/hip_runtime.h>
#include <cstdio>
#include <cstdint>
namespace pg8 {
#define PG8_LAS __attribute__((address_space(3)))
typedef unsigned short bf16_t;
typedef short bf16x8 __attribute__((ext_vector_type(8)));
typedef float f32x4 __attribute__((ext_vector_type(4)));
typedef unsigned u32x4 __attribute__((ext_vector_type(4)));
constexpr int BM = 256, BK = 64, HALF = 128, HTB = HALF * BK * 2  , STAGE_BYTES = 8 * HTB, NXCD = 8, WGM = 8;

__host__ __device__ __forceinline__ int lds_byte(int r, int c) { const int st = (r >> 4) * 2 + (c >> 5), rr = r & 15, cc = c & 31, ob = rr * 64 + cc * 2; return st * 1024 + (ob ^ (((ob >> 9) & 1) << 5)); }
__host__ __device__ __forceinline__ void stage_rc(int b, int& R, int& C) { const int st = b / 1024, sb = b % 1024, swz = sb ^ (((sb >> 9) & 1) << 5); R = (st >> 1) * 16 + swz / 64; C = (st & 1) * 32 + (swz % 64) / 2; }
__host__ __device__ __forceinline__ int perm32(int rho) { const int n = rho >> 4, i = rho & 15; return 8 * (i >> 2) + 4 * n + (i & 3); }

struct Unit { int pm, pn; };
struct Gemm { const bf16_t* A; const bf16_t* Bt; int M, N, K; };

struct StaticOrder {
    int nM, nN, nwg, G, c;
    __host__ __device__ void init(int M, int N, int G_, int c_) { nM = M / BM; nN = N / BM; nwg = nM * nN; G = G_; c = c_; }
    __host__ __device__ bool next(int i, Unit& u) const {
        const long L = (long)i * G + c; if (L >= nwg) return false;
        int wgid = (int)L; { const int q = nwg / NXCD, r = nwg % NXCD, xcd = wgid % NXCD, off = wgid / NXCD; wgid = (xcd < r ? xcd * (q + 1) : r * (q + 1) + (xcd - r) * q) + off; }
        const int nig = WGM * nN, gid = wgid / nig, fm = gid * WGM, gsz = (nM - fm) < WGM ? (nM - fm) : WGM;
        u.pm = fm + ((wgid % nig) % gsz); u.pn = (wgid % nig) / gsz; return true;
    }
    __device__ __forceinline__ void a_ready(const Unit&) const {}
    __device__ __forceinline__ void done(const Unit&) const {}
};

__device__ __forceinline__ unsigned cvt_pk_bf16(float lo, float hi) { unsigned r; asm volatile("v_cvt_pk_bf16_f32 %0, %1, %2" : "=v"(r) : "v"(lo), "v"(hi)); return r; }
typedef float f32x2 __attribute__((ext_vector_type(2)));
typedef unsigned u32x2 __attribute__((ext_vector_type(2)));
constexpr float RMS_EPS = 1e-6f;
__device__ __forceinline__ float bfbits2f(unsigned v16) { return __uint_as_float(v16 << 16); }
__device__ __forceinline__ float sigm(float x) { return __builtin_amdgcn_rcpf(1.0f + __expf(-x)); }
template <int NP> __device__ __forceinline__ float row_rs(const float* ssq, int row) {
    float s = 0.f;
    if constexpr (NP == 1) s = ssq[row];
    else {
#pragma unroll
        for (int i = 0; i < NP / 4; ++i) { const f32x4 v = *(const f32x4*)(ssq + (size_t)row * NP + 4 * i); s += (v[0] + v[1]) + (v[2] + v[3]); }
    }
    return 1.0f / sqrtf(s * (1.0f / 1024.0f) + RMS_EPS);
}
template <int NP, bool HAS_DT> struct EpiScaleBf16 {
    static constexpr bool PERM = true, AFTER_DRAIN = false;
    bf16_t* O; size_t slot_elems; const float* ssq; float scale; float* dt;
    __device__ __forceinline__ void operator()(const f32x4 (&acc)[2][2][4][2], const Unit& u, int wr, int wc, int fr, int fq) const {
        const int row0 = u.pm * BM + wr * 64 + fr;
        if (HAS_DT && u.pn == 44) {
            if (wc == 0) {
#pragma unroll
                for (int ai = 0; ai < 2; ++ai)
#pragma unroll
                    for (int m = 0; m < 4; ++m) { const int row = row0 + ai * HALF + m * 16; float rs = 1.0f; if constexpr (NP > 0) rs = row_rs<NP>(ssq, row);
                        float* p = dt + (size_t)row * 32 + 8 * fq; *(f32x4*)p = acc[ai][0][m][0] * rs; *(f32x4*)(p + 4) = acc[ai][0][m][1] * rs; }
            }
            return;
        }
        bf16_t* base = O + (size_t)(u.pn >> 2) * slot_elems; const int col0 = (u.pn & 3) * BM + wc * 32 + 8 * fq;
#pragma unroll
        for (int ai = 0; ai < 2; ++ai)
#pragma unroll
            for (int m = 0; m < 4; ++m) { const int row = row0 + ai * HALF + m * 16; float rs = scale; if constexpr (NP > 0) rs = row_rs<NP>(ssq, row) * scale; bf16_t* rowp = base + (size_t)row * 1024 + col0;
#pragma unroll
                for (int bj = 0; bj < 2; ++bj) { const f32x4 v0 = acc[ai][bj][m][0] * rs, v1 = acc[ai][bj][m][1] * rs;
                    u32x4 w; w.x = cvt_pk_bf16(v0[0], v0[1]); w.y = cvt_pk_bf16(v0[2], v0[3]); w.z = cvt_pk_bf16(v1[0], v1[1]); w.w = cvt_pk_bf16(v1[2], v1[3]);
                    if (HAS_DT) __builtin_nontemporal_store(w, (u32x4*)(rowp + bj * HALF));
                    else *(u32x4*)(rowp + bj * HALF) = w; } }
    }
};
struct EpiKV {
    static constexpr bool PERM = false, AFTER_DRAIN = false;
    float* mk; float* mv; bf16_t* kb; bf16_t* vt; const float* ssq;
    __device__ __forceinline__ void operator()(const f32x4 (&acc)[2][2][4][2], const Unit& u, int wr, int wc, int fr, int fq) const {
        const int row0 = u.pm * BM + wr * 64 + fr; const bool isv = u.pn >= 4; const int colt = (u.pn & 3) * BM + wc * 32 + 4 * fq;
#pragma unroll
        for (int ai = 0; ai < 2; ++ai)
#pragma unroll
            for (int m = 0; m < 4; ++m) { const int row = row0 + ai * HALF + m * 16; const float rs = 1.0f;
#pragma unroll
                for (int bj = 0; bj < 2; ++bj)
#pragma unroll
                    for (int n = 0; n < 2; ++n) { const int c = colt + bj * HALF + n * 16; const f32x4 v = acc[ai][bj][m][n] * rs;
                        if (!isv) { __builtin_nontemporal_store(v, (f32x4*)(mk + (size_t)row * 1024 + c)); u32x2 w; w.x = cvt_pk_bf16(v[0], v[1]); w.y = cvt_pk_bf16(v[2], v[3]); *(u32x2*)(kb + (size_t)row * 1024 + c) = w; }
                        else { __builtin_nontemporal_store(v, (f32x4*)(mv + (size_t)row * 1024 + c)); const int b = row >> 8, key = row & 255, hd = c >> 8, d = c & 255;
                            bf16_t* p = vt + ((size_t)((b * 4 + hd) * 256 + d)) * 256 + key; const unsigned w0 = cvt_pk_bf16(v[0], v[1]), w1 = cvt_pk_bf16(v[2], v[3]);
                            p[0] = (bf16_t)(w0 & 0xffffu); p[256] = (bf16_t)(w0 >> 16); p[512] = (bf16_t)(w1 & 0xffffu); p[768] = (bf16_t)(w1 >> 16); } } }
    }
};
template <bool ADD> struct EpiGate {
    static constexpr bool PERM = true, AFTER_DRAIN = false;
    bf16_t* O; const bf16_t* gate;
    __device__ __forceinline__ void operator()(const f32x4 (&acc)[2][2][4][2], const Unit& u, int wr, int wc, int fr, int fq) const {
        const int row0 = u.pm * BM + wr * 64 + fr, col0 = u.pn * BM + wc * 32 + 8 * fq;
#pragma unroll
        for (int ai = 0; ai < 2; ++ai)
#pragma unroll
            for (int m = 0; m < 4; ++m) { const size_t off = (size_t)(row0 + ai * HALF + m * 16) * 1024 + col0;
#pragma unroll
                for (int bj = 0; bj < 2; ++bj) { const u32x4 gw = __builtin_nontemporal_load((const u32x4*)(gate + off + bj * HALF)); u32x4 ow = (u32x4){0u, 0u, 0u, 0u}; if (ADD) ow = *(const u32x4*)(O + off + bj * HALF);
                    float r[8];
#pragma unroll
                    for (int e = 0; e < 8; ++e) { const unsigned g16 = (gw[e >> 1] >> ((e & 1) * 16)) & 0xffffu, o16 = (ow[e >> 1] >> ((e & 1) * 16)) & 0xffffu;
                        const float a = acc[ai][bj][m][e >> 2][e & 3]; r[e] = (ADD ? bfbits2f(o16) : 0.f) + sigm(bfbits2f(g16)) * a; }
                    u32x4 w; w.x = cvt_pk_bf16(r[0], r[1]); w.y = cvt_pk_bf16(r[2], r[3]); w.z = cvt_pk_bf16(r[4], r[5]); w.w = cvt_pk_bf16(r[6], r[7]);
                    *(u32x4*)(O + off + bj * HALF) = w; } }
    }
};
template <bool BF, bool BSC = false> struct EpiRes {
    static constexpr bool PERM = true, AFTER_DRAIN = false;
    const float* base0; const float* base1; const bf16_t* bb; bf16_t* hb; float* ssqp; const float* bsc;
    __device__ __forceinline__ void operator()(const f32x4 (&acc)[2][2][4][2], const Unit& u, int wr, int wc, int fr, int fq) const {
        const int row0 = u.pm * BM + wr * 64 + fr, col0 = u.pn * BM + wc * 32 + 8 * fq; const float* base = u.pm < 64 ? base0 : base1;
#pragma unroll
        for (int ai = 0; ai < 2; ++ai)
#pragma unroll
            for (int m = 0; m < 4; ++m) { const int row = row0 + ai * HALF + m * 16; const size_t off = (size_t)row * 1024 + col0; float sq = 0.f; float bs = 1.0f; if constexpr (BSC) bs = bsc[row];
#pragma unroll
                for (int bj = 0; bj < 2; ++bj) { const size_t o2 = off + bj * HALF; f32x4 b0, b1;
                    if (BF) { const u32x4 w = *(const u32x4*)(bb + o2); b0 = (f32x4){bfbits2f(w.x & 0xffffu), __uint_as_float(w.x & 0xffff0000u), bfbits2f(w.y & 0xffffu), __uint_as_float(w.y & 0xffff0000u)};
                        b1 = (f32x4){bfbits2f(w.z & 0xffffu), __uint_as_float(w.z & 0xffff0000u), bfbits2f(w.w & 0xffffu), __uint_as_float(w.w & 0xffff0000u)}; }
                    else { b0 = __builtin_nontemporal_load((const f32x4*)(base + o2)); b1 = __builtin_nontemporal_load((const f32x4*)(base + o2 + 4)); }
                    if constexpr (BSC) { b0 = b0 * bs; b1 = b1 * bs; }
                    const f32x4 v0 = b0 + acc[ai][bj][m][0], v1 = b1 + acc[ai][bj][m][1];
                    sq += ((v0[0] * v0[0] + v0[1] * v0[1]) + (v0[2] * v0[2] + v0[3] * v0[3])) + ((v1[0] * v1[0] + v1[1] * v1[1]) + (v1[2] * v1[2] + v1[3] * v1[3]));
                    u32x4 w; w.x = cvt_pk_bf16(v0[0], v0[1]); w.y = cvt_pk_bf16(v0[2], v0[3]); w.z = cvt_pk_bf16(v1[0], v1[1]); w.w = cvt_pk_bf16(v1[2], v1[3]); *(u32x4*)(hb + o2) = w; }
                sq += __shfl_xor(sq, 16); sq += __shfl_xor(sq, 32);
                if (fq == 0) ssqp[(size_t)row * 16 + u.pn * 4 + wc] = sq; }
    }
};
struct EpiSwiglu {
    static constexpr bool PERM = true, AFTER_DRAIN = false;
    bf16_t* act; const float* ssq;
    __device__ __forceinline__ void operator()(const f32x4 (&acc)[2][2][4][2], const Unit& u, int wr, int wc, int fr, int fq) const {
        const int row0 = u.pm * BM + wr * 64 + fr, col0 = u.pn * 128 + wc * 16 + 4 * fq;
#pragma unroll
        for (int ai = 0; ai < 2; ++ai)
#pragma unroll
            for (int m = 0; m < 4; ++m) { const int row = row0 + ai * HALF + m * 16; const float rs = row_rs<16>(ssq, row);
#pragma unroll
                for (int bj = 0; bj < 2; ++bj) { const f32x4 a = acc[ai][bj][m][0] * rs, b = acc[ai][bj][m][1] * rs;
                    const float r0 = a[0] * sigm(a[0]) * a[1], r1 = a[2] * sigm(a[2]) * a[3], r2 = b[0] * sigm(b[0]) * b[1], r3 = b[2] * sigm(b[2]) * b[3];
                    u32x2 w; w.x = cvt_pk_bf16(r0, r1); w.y = cvt_pk_bf16(r2, r3); *(u32x2*)(act + (size_t)row * 2816 + col0 + bj * 64) = w; } }
    }
};
template <class Epi, class Sched, bool ALIGN_EPI = false, bool SP2 = false, int EPI_REP = 1>
__device__ __forceinline__ void gemm_phase(PG8_LAS unsigned char* lds, const Gemm g, const Sched& S, const Epi& E) {
    const int tid = threadIdx.x, wid = __builtin_amdgcn_readfirstlane(tid >> 6), lane = tid & 63, wr = wid >> 2, wc = wid & 3, fr = lane & 15, fq = lane >> 4;
    const int K = g.K, nt = K / BK;
    unsigned voffA[2], voffB[2];
#pragma unroll
    for (int i = 0; i < 2; ++i) { int R, C; stage_rc(tid * 16 + i * 8192, R, C); const int Rb = Epi::PERM ? ((R & ~31) + perm32(R & 31)) : R;
        voffA[i] = (unsigned)(R * K + C) * 2u; voffB[i] = (unsigned)(Rb * K + C) * 2u; }
    const size_t kstep = (size_t)(BK * 2);
    const size_t hstep = (size_t)HALF * K * 2;
    const size_t tstep = 2 * hstep;
    const unsigned ldsw = (unsigned)wid * 1024u;
    const int aoff = lds_byte(wr * 64 + fr, fq * 8), boff = lds_byte(wc * 32 + fr, fq * 8);
#define PG8_SA(b, h) (((b) * 2 + (h)) * HTB)
#define PG8_SB(b, h) ((4 + (b) * 2 + (h)) * HTB)
#define PG8_STAGE(bufoff, gbase, voff) do { _Pragma("unroll") for (int _i = 0; _i < 2; ++_i) \
        __builtin_amdgcn_global_load_lds((const unsigned*)((const char*)(gbase) + (voff)[_i]), (PG8_LAS unsigned*)(lds + (bufoff) + ldsw + _i * 8192), 16, 0, 0); } while (0)
#define PG8_LDA(dst, b, h) do { _Pragma("unroll") for (int m = 0; m < 4; ++m) _Pragma("unroll") for (int k = 0; k < 2; ++k) dst[m][k] = *(const PG8_LAS bf16x8*)(lds + PG8_SA(b, h) + aoff + m * 2048 + k * 1024); } while (0)
#define PG8_LDB(dst, b, h) do { _Pragma("unroll") for (int n = 0; n < 2; ++n) _Pragma("unroll") for (int k = 0; k < 2; ++k) dst[n][k] = *(const PG8_LAS bf16x8*)(lds + PG8_SB(b, h) + boff + n * 2048 + k * 1024); } while (0)
#define PG8_MMA(ai, bj, At, Bt) do { __builtin_amdgcn_s_setprio(1); _Pragma("unroll") for (int m = 0; m < 4; ++m) _Pragma("unroll") for (int n = 0; n < 2; ++n) _Pragma("unroll") for (int k = 0; k < 2; ++k) \
        acc[ai][bj][m][n] = __builtin_amdgcn_mfma_f32_16x16x32_bf16(Bt[n][k], At[m][k], acc[ai][bj][m][n], 0, 0, 0); __builtin_amdgcn_s_setprio(0); } while (0)
#define PG8_WAIT_V(n) asm volatile("s_waitcnt vmcnt(" #n ")" ::: "memory")
#define PG8_WAIT_L(n) asm volatile("s_waitcnt lgkmcnt(" #n ")" ::: "memory")
#define PG8_BAR __builtin_amdgcn_s_barrier()
#define PG8_SCHED __builtin_amdgcn_sched_barrier(0)
    Unit cur, nxt; int ui = 0;
    if (!S.next(0, cur)) return;
    f32x4 acc[2][2][4][2];
#pragma unroll
    for (int a = 0; a < 2; ++a)
#pragma unroll
        for (int b = 0; b < 2; ++b)
#pragma unroll
            for (int m = 0; m < 4; ++m)
#pragma unroll
                for (int n = 0; n < 2; ++n) acc[a][b][m][n] = (f32x4){0.f, 0.f, 0.f, 0.f};
    bf16x8 At[4][2], B0[2][2], B1[2][2];
    const char* cA = (const char*)g.A + (size_t)cur.pm * tstep; const char* cB = (const char*)g.Bt + (size_t)cur.pn * tstep;
    S.a_ready(cur);
    if constexpr (SP2) {
        PG8_STAGE(PG8_SB(0, 0), cB, voffB); PG8_STAGE(PG8_SB(0, 1), cB + hstep, voffB); PG8_STAGE(PG8_SA(0, 0), cA, voffA); PG8_STAGE(PG8_SA(0, 1), cA + hstep, voffA);
        if (wr == 1) PG8_BAR;
        PG8_WAIT_V(2); PG8_BAR;
        PG8_STAGE(PG8_SB(1, 0), cB + kstep, voffB); PG8_STAGE(PG8_SA(1, 0), cA + kstep, voffA); PG8_STAGE(PG8_SB(1, 1), cB + hstep + kstep, voffB);
        PG8_WAIT_V(6); PG8_BAR;
    } else {
        PG8_STAGE(PG8_SB(0, 0), cB, voffB); PG8_STAGE(PG8_SA(0, 0), cA, voffA); PG8_STAGE(PG8_SB(0, 1), cB + hstep, voffB); PG8_STAGE(PG8_SA(0, 1), cA + hstep, voffA);
        if (wr == 1) PG8_BAR;
        PG8_WAIT_V(4); PG8_BAR;
        PG8_STAGE(PG8_SB(1, 0), cB + kstep, voffB); PG8_STAGE(PG8_SA(1, 0), cA + kstep, voffA); PG8_STAGE(PG8_SB(1, 1), cB + hstep + kstep, voffB);
        PG8_WAIT_V(6); PG8_BAR;
    }
    for (;;) {
        const bool has_next = S.next(ui + 1, nxt);
        const char* nA = has_next ? (const char*)g.A + (size_t)nxt.pm * tstep : cA; const char* nB = has_next ? (const char*)g.Bt + (size_t)nxt.pn * tstep : cB;
        for (int t = 0; t < nt; t += 2) {
            const bool last = (t == nt - 2);
            const char* a1 = cA + (size_t)(t + 1) * kstep;
            const char* a2 = last ? nA : cA + (size_t)(t + 2) * kstep; const char* b2 = last ? nB : cB + (size_t)(t + 2) * kstep;
            const char* a3 = a2 + kstep; const char* b3 = b2 + kstep;
            if (last && has_next) S.a_ready(nxt);
            if constexpr (SP2) {
            PG8_LDB(B0, 0, 0); PG8_LDB(B1, 0, 1); PG8_SCHED; PG8_LDA(At, 0, 0); PG8_STAGE(PG8_SA(1, 1), a1 + hstep, voffA);
            PG8_WAIT_V(8); PG8_WAIT_L(0); PG8_BAR; PG8_MMA(0, 0, At, B0); PG8_MMA(0, 1, At, B1); PG8_BAR; PG8_SCHED;
            PG8_LDA(At, 0, 1); PG8_STAGE(PG8_SB(0, 0), b2, voffB); PG8_STAGE(PG8_SB(0, 1), b2 + hstep, voffB); PG8_STAGE(PG8_SA(0, 0), a2, voffA);
            PG8_WAIT_V(8); PG8_WAIT_L(0); PG8_BAR; PG8_MMA(1, 0, At, B0); PG8_MMA(1, 1, At, B1); PG8_BAR; PG8_SCHED;
            PG8_LDB(B0, 1, 0); PG8_LDB(B1, 1, 1); PG8_SCHED; PG8_LDA(At, 1, 0); PG8_STAGE(PG8_SA(0, 1), a2 + hstep, voffA);
            PG8_WAIT_V(8); PG8_WAIT_L(0); PG8_BAR; PG8_MMA(0, 0, At, B0); PG8_MMA(0, 1, At, B1); PG8_BAR; PG8_SCHED;
            PG8_LDA(At, 1, 1); PG8_STAGE(PG8_SB(1, 0), b3, voffB); PG8_STAGE(PG8_SB(1, 1), b3 + hstep, voffB); PG8_STAGE(PG8_SA(1, 0), a3, voffA);
            PG8_WAIT_V(8); PG8_WAIT_L(0); PG8_BAR; PG8_MMA(1, 0, At, B0); PG8_MMA(1, 1, At, B1); PG8_BAR; PG8_SCHED;
            } else {
            PG8_LDB(B0, 0, 0); PG8_SCHED; PG8_LDA(At, 0, 0); PG8_STAGE(PG8_SA(1, 1), a1 + hstep, voffA);
            PG8_WAIT_L(8); PG8_BAR; PG8_WAIT_L(0); PG8_MMA(0, 0, At, B0); PG8_BAR; PG8_SCHED;
            PG8_LDB(B1, 0, 1); PG8_STAGE(PG8_SB(0, 0), b2, voffB);
            PG8_BAR; PG8_WAIT_L(0); PG8_MMA(0, 1, At, B1); PG8_BAR;
            PG8_LDA(At, 0, 1); PG8_STAGE(PG8_SA(0, 0), a2, voffA);
            PG8_BAR; PG8_WAIT_L(0); PG8_MMA(1, 0, At, B0); PG8_BAR; PG8_SCHED;
            PG8_STAGE(PG8_SB(0, 1), b2 + hstep, voffB);
            PG8_WAIT_V(6); PG8_BAR; PG8_MMA(1, 1, At, B1); PG8_BAR;
            PG8_LDB(B0, 1, 0); PG8_SCHED; PG8_LDA(At, 1, 0); PG8_STAGE(PG8_SA(0, 1), a2 + hstep, voffA);
            PG8_WAIT_L(8); PG8_BAR; PG8_WAIT_L(0); PG8_MMA(0, 0, At, B0); PG8_BAR; PG8_SCHED;
            PG8_LDB(B1, 1, 1); PG8_STAGE(PG8_SB(1, 0), b3, voffB);
            PG8_BAR; PG8_WAIT_L(0); PG8_MMA(0, 1, At, B1); PG8_BAR;
            PG8_LDA(At, 1, 1); PG8_STAGE(PG8_SA(1, 0), a3, voffA);
            PG8_BAR; PG8_WAIT_L(0); PG8_MMA(1, 0, At, B0); PG8_BAR; PG8_SCHED;
            PG8_STAGE(PG8_SB(1, 1), b3 + hstep, voffB);
            PG8_WAIT_V(6); PG8_BAR; PG8_MMA(1, 1, At, B1); PG8_BAR;
            }
        }
        if constexpr (ALIGN_EPI) { if (wr == 0) PG8_BAR; }
        if constexpr (!Epi::AFTER_DRAIN) { for (int rep = 0; rep < EPI_REP; ++rep) { E(acc, cur, wr, wc, fr, fq); asm volatile("" ::: "memory"); } S.done(cur); }
        if (!has_next) break;
#pragma unroll
        for (int a = 0; a < 2; ++a)
#pragma unroll
            for (int b = 0; b < 2; ++b)
#pragma unroll
                for (int m = 0; m < 4; ++m)
#pragma unroll
                    for (int n = 0; n < 2; ++n) acc[a][b][m][n] = (f32x4){0.f, 0.f, 0.f, 0.f};
        cur = nxt; cA = nA; cB = nB; ++ui;
        if constexpr (ALIGN_EPI) { if (wr == 1) PG8_BAR; }
    }
    PG8_WAIT_V(0);
    if constexpr (!ALIGN_EPI) { if (wr == 0) PG8_BAR; }
    PG8_BAR;
    if constexpr (Epi::AFTER_DRAIN) { E.fused(acc, cur, wr, wc, fr, fq, lds, wid, lane); S.done(cur); }
#undef PG8_SA
#undef PG8_SB
#undef PG8_STAGE
#undef PG8_LDA
#undef PG8_LDB
#undef PG8_MMA
#undef PG8_WAIT_V
#undef PG8_WAIT_L
#undef PG8_BAR
#undef PG8_SCHED
}
}
#define GAS __attribute__((address_space(1)))
#define LAS __attribute__((address_space(3)))
typedef unsigned short bf16;
typedef unsigned v4u __attribute__((ext_vector_type(4)));
typedef float f32x4 __attribute__((ext_vector_type(4)));
typedef short bf16x8 __attribute__((ext_vector_type(8)));
typedef GAS unsigned gu32;
typedef GAS unsigned long long gu64;
#define RLX_AGENT __ATOMIC_RELAXED, __HIP_MEMORY_SCOPE_AGENT
#define LDS_WAIT() asm volatile("s_waitcnt lgkmcnt(0)" ::: "memory")
#define VM_WAIT() asm volatile("s_waitcnt vmcnt(0)" ::: "memory")
__device__ __forceinline__ unsigned long long rt() { return __builtin_amdgcn_s_memrealtime(); }
typedef float f32x2_t __attribute__((ext_vector_type(2))); typedef __bf16 bf16x2_t __attribute__((ext_vector_type(2)));
__device__ __forceinline__ unsigned pk2(float lo, float hi) { const f32x2_t v = {lo, hi}; const bf16x2_t b = __builtin_convertvector(v, bf16x2_t); return __builtin_bit_cast(unsigned, b); }
__device__ __forceinline__ unsigned f2bf(float f) { return pk2(f, 0.f) & 0xffffu; }

#define XB_TMO      128
#define XB_XCNT(j)  (256  + 64 * (j))
#define XB_XSUB(j)  (1280 + 64 * (j))
#define XB_XGEN(j)  (2304 + 64 * (j))
#define XB_TOP      3328
#define XB_TOPGEN   3392
#define XCD_BAR_WORDS 3456
#define XB_SPIN_CAP (1u << 18)

__device__ __forceinline__ unsigned xb_ld(unsigned* p)              { return __hip_atomic_load(p, __ATOMIC_RELAXED, __HIP_MEMORY_SCOPE_AGENT); }
__device__ __forceinline__ unsigned xb_add(unsigned* p, unsigned v) { return __hip_atomic_fetch_add(p, v, __ATOMIC_RELAXED, __HIP_MEMORY_SCOPE_AGENT); }
__device__ __forceinline__ unsigned xb_xcc_id() { return (unsigned)__builtin_amdgcn_s_getreg((3 << 11) | 20) & 0xFu; }
#define XB_SPIN(cond, bar) do { unsigned _sp = 0; while (cond) { __builtin_amdgcn_s_sleep(1); \
    if ((++_sp & 255u) == 0u) { if (xb_ld(&(bar)[XB_TMO])) break; if (_sp > XB_SPIN_CAP) { atomicAdd(&(bar)[XB_TMO], 1u); break; } } } } while (0)

struct XcdBarrier {
    unsigned* bar; unsigned x;
    volatile LAS unsigned* st;
};

__device__ __forceinline__ XcdBarrier xcd_barrier_post(unsigned* bar, volatile LAS unsigned* st) {
    XcdBarrier b; b.bar = bar; b.x = xb_xcc_id(); b.st = st;
    if (threadIdx.x == 0) (void)xb_add(&bar[XB_XCNT(b.x)], 1u);
    return b;
}
__device__ __forceinline__ void xcd_barrier_complete(unsigned* bar, unsigned x, unsigned& nloc, unsigned& nx) {
    const unsigned G = gridDim.x * gridDim.y * gridDim.z;
    unsigned sum, cnt, mine, sp = 0u;
    for (;;) {
        sum = 0u; cnt = 0u; mine = 0u;
#pragma unroll
        for (unsigned j = 0; j < 16; ++j) { const unsigned c = xb_ld(&bar[XB_XCNT(j)]); sum += c; cnt += (c > 0u) ? 1u : 0u; mine = (j == x) ? c : mine; }
        if (sum == G) break;
        __builtin_amdgcn_s_sleep(1);
        if ((++sp & 255u) == 0u) { if (xb_ld(&bar[XB_TMO])) break; if (sp > XB_SPIN_CAP) { atomicAdd(&bar[XB_TMO], 1u); break; } }
    }
    nloc = mine > 0u ? mine : 1u; nx = cnt > 0u ? cnt : 1u;
}

__device__ __forceinline__ void xcd_barrier(const XcdBarrier& b) {
    asm volatile("s_waitcnt vmcnt(0)" ::: "memory");
    __syncthreads();
    if (threadIdx.x == 0) {
        unsigned* bar = b.bar;
        __builtin_amdgcn_s_waitcnt(0);
        unsigned nloc = b.st[0], nx = b.st[1];
        if (nloc == 0u) { xcd_barrier_complete(bar, b.x, nloc, nx); b.st[0] = nloc; b.st[1] = nx; }
        const unsigned old = xb_add(&bar[XB_XSUB(b.x)], 1u);
        const unsigned gen = old / nloc;
        if (old + 1u == (gen + 1u) * nloc) {
            __builtin_amdgcn_fence(__ATOMIC_RELEASE, "agent");
            asm volatile("s_waitcnt vmcnt(0)" ::: "memory");
            const unsigned og = xb_add(&bar[XB_TOP], 1u);
            const unsigned tg = og / nx;
            if (og + 1u == (tg + 1u) * nx) xb_add(&bar[XB_TOPGEN], 1u);
            else XB_SPIN(xb_ld(&bar[XB_TOPGEN]) == tg, bar);
            __builtin_amdgcn_fence(__ATOMIC_ACQUIRE, "agent");
            xb_add(&bar[XB_XGEN(b.x)], 1u);
            asm volatile("s_waitcnt vmcnt(0)" ::: "memory");
        } else {
            XB_SPIN(xb_ld(&bar[XB_XGEN(b.x)]) == gen, bar);
            __builtin_amdgcn_fence(__ATOMIC_ACQUIRE, "agent");
            asm volatile("s_waitcnt vmcnt(0)" ::: "memory");
        }
    }
    __syncthreads();
}
typedef unsigned v2u __attribute__((ext_vector_type(2)));
constexpr int NWAVES = 8, NTHR = 512;
constexpr int DM = 1024, TP = 16384, TS = 512, T = TP + TS;
constexpr int SEQ = 2048, NBP = 8, NBS = 128, LS = 4, MEMR = 2048;
constexpr int NPROJ = 11520;
constexpr int FFN = 2816;
constexpr float EPS = 1e-6f;
constexpr float QSCALE = 0.0625f * 1.4426950408889634f;

constexpr size_t MiB = 1u << 20;
constexpr size_t WS_CTL = 0, CTL_ZERO_BYTES = 32768;
constexpr size_t WS_SSQX = 1 * MiB, WS_SSQM = 1 * MiB + 512 * 1024;
constexpr size_t WS_DT = 2 * MiB, WS_SSQSSD = 5 * MiB, WS_SSQP1 = 8 * MiB, WS_SSQP2 = 9 * MiB + 512 * 1024, WS_SSQP3 = 11 * MiB;
constexpr size_t WS_WIN = 13 * MiB, WS_WKV = 36 * MiB, WS_WSSD = 40 * MiB, WS_WHG = 44 * MiB, WS_WOUT = 46 * MiB, WS_WCQ = 48 * MiB, WS_WCO = 50 * MiB, WS_WGU = 52 * MiB, WS_WDN = 63 * MiB;
constexpr size_t WS_XB = 69 * MiB, WS_MNB = 102 * MiB, WS_KB = 106 * MiB, WS_VT = 110 * MiB;
constexpr size_t SLOT = 33 * MiB, SLOT_ELEMS = (size_t)T * 1024;
constexpr size_t WS_PROJ = 114 * MiB;
constexpr size_t WS_YG = WS_PROJ + 11 * SLOT, WS_ON = WS_YG + 2 * SLOT, WS_END = WS_ON + SLOT;
static_assert(SLOT == SLOT_ELEMS * 2, "slot size");
static_assert(WS_WIN + (size_t)NPROJ * 1024 * 2 <= WS_WKV && WS_WGU + (size_t)2 * FFN * 1024 * 2 <= WS_WDN && WS_WDN + (size_t)1024 * FFN * 2 <= WS_XB && WS_SSQP3 + (size_t)T * 64 <= WS_WIN, "d_ws map");
static_assert(WS_DT + (size_t)T * 128 <= WS_SSQSSD && WS_SSQSSD + (size_t)T * 128 <= WS_SSQP1 && WS_SSQP1 + (size_t)T * 64 <= WS_SSQP2 && WS_SSQP2 + (size_t)T * 64 <= WS_SSQP3, "d_ws map 2");
enum { S_Z0 = 0, S_Z1 = 1, S_X0 = 2, S_X1 = 3, S_X2 = 4, S_Q = 5, S_F = 6, S_I = 7, S_HG = 8, S_GS = 9, S_GH = 10 };
constexpr size_t WS_MERGED = WS_PROJ + S_Q * SLOT, WS_HB = WS_PROJ + S_F * SLOT, WS_QB = WS_PROJ + S_I * SLOT, WS_OB = WS_PROJ + S_HG * SLOT, WS_ACT = WS_PROJ;
static_assert((size_t)T * FFN * 2 <= 3 * SLOT, "act overlay");
constexpr size_t O_Y = 0, O_SSMP = (size_t)T * 1024, O_CONVP = O_SSMP + 2097152, O_HGP = O_CONVP + 73728, O_MKP = O_HGP + 1048576, O_MVP = O_MKP + 2097152,
                 O_SSMS = O_MVP + 2097152, O_CONVS = O_SSMS + 33554432, O_HGS = O_CONVS + 1179648, O_END = O_HGS + 16777216;
constexpr int CW_QUEUE = 64;
constexpr int CW_BAR = 4096;
constexpr int RING_OFF = 0, RING_BYTES = 131072;
constexpr int LDS_BYTES = 147456;
constexpr int LDSCTL_OFF = LDS_BYTES - 1024, MISC_OFF = LDSCTL_OFF + 320;
struct Frame {
    LAS unsigned char* lds;
    volatile LAS unsigned* MISC;
    gu32* ctl;
    int tid, lane, wave;
    int vcu, G;
    const float* in[32];
    float* out; unsigned char* ws;
};
__device__ __forceinline__ float bf2f(unsigned v16) { return __uint_as_float(v16 << 16); }
__device__ __forceinline__ f32x4 ld_nt(const float* p) { return __builtin_nontemporal_load((const f32x4*)p); }
__device__ __forceinline__ void st_nt(float* p, f32x4 v) { __builtin_nontemporal_store(v, (f32x4*)p); }
__device__ __forceinline__ v4u ld_nt16(const void* p) { return __builtin_nontemporal_load((const v4u*)p); }
__device__ __forceinline__ unsigned ld_nt4(const void* p) { return __builtin_nontemporal_load((const unsigned*)p); }
__device__ __forceinline__ float sigmoid_f(float x) { return __builtin_amdgcn_rcpf(1.0f + __expf(-x)); }
__device__ __forceinline__ float silu_f(float x) { return x * sigmoid_f(x); }
__device__ __forceinline__ float wave_sum(float v) {
#pragma unroll
    for (int o = 1; o < 64; o <<= 1) v += __shfl_xor(v, o);
    return v;
}
__device__ __forceinline__ float wave_max(float v) {
#pragma unroll
    for (int o = 1; o < 64; o <<= 1) v = fmaxf(v, __shfl_xor(v, o));
    return v;
}
struct TSrc { const float* W; const float* W2; const float* ks; int ldw; int mode; };
__device__ __forceinline__ void p0_transpose_item(const TSrc& s, int K, int N, bf16* WT, LAS unsigned short* scr, int item, int lane) {
    const int nblk = N / 64, kb = item / nblk, nb = item % nblk, k0 = 64 * kb, n0 = 64 * nb;
    const int kr = lane >> 4, nq = lane & 15;
    const float* const Wa = s.W; const float* const Wb = s.W2;
    const float* src; int c0, cs; bool zero = false;
    if (s.mode == 2) { const float* wsel = Wa; if (nq >= 8) wsel = Wb; src = wsel + (n0 >> 1) + 4 * (nq & 7); c0 = 8 * (nq & 7) + (nq >> 3); cs = 2; }
    else { const int n = n0 + 4 * nq; c0 = 4 * nq; cs = 1;
        if (s.mode == 0) src = Wa + n;
        else if (s.mode == 1) { if (n < 5120) src = Wa + n; else if (n < 11264) src = Wa + n + 32; else if (n < 11296) src = Wa + 5120 + (n - 11264); else { src = Wa; zero = true; } }
        else { src = Wa + n; if (n >= 1024) src = Wb + (n - 1024); } }
    f32x4 v[16];
#pragma unroll
    for (int i = 0; i < 16; ++i) v[i] = zero ? (f32x4){0.f, 0.f, 0.f, 0.f} : ld_nt(src + (size_t)(k0 + 4 * i + kr) * s.ldw);
#pragma unroll
    for (int i = 0; i < 16; ++i) { const int kk = 4 * i + kr; const float sc = s.ks ? s.ks[k0 + kk] : 1.0f; const unsigned w0 = pk2(v[i].x * sc, v[i].y * sc), w1 = pk2(v[i].z * sc, v[i].w * sc);
        LAS unsigned short* d = scr + kk * 66 + c0;
        if (cs == 1) { *(LAS unsigned*)d = w0; *(LAS unsigned*)(d + 2) = w1; }
        else { d[0] = (unsigned short)(w0 & 0xffffu); d[2] = (unsigned short)(w0 >> 16); d[4] = (unsigned short)(w1 & 0xffffu); d[6] = (unsigned short)(w1 >> 16); } }
    LDS_WAIT(); asm volatile("" ::: "memory");
    const int nr = lane >> 3, kc = lane & 7;
#pragma unroll
    for (int j = 0; j < 8; ++j) { const int n = 8 * j + nr; const LAS unsigned short* p = scr + (8 * kc) * 66 + n;
        v4u o; o.x = (unsigned)p[0] | ((unsigned)p[66] << 16); o.y = (unsigned)p[2 * 66] | ((unsigned)p[3 * 66] << 16); o.z = (unsigned)p[4 * 66] | ((unsigned)p[5 * 66] << 16); o.w = (unsigned)p[6 * 66] | ((unsigned)p[7 * 66] << 16);
        *(v4u*)(WT + (size_t)(n0 + n) * K + k0 + 8 * kc) = o; }
    LDS_WAIT(); asm volatile("" ::: "memory");
}
__device__ __forceinline__ void rows4_to_bf16_ssq(const float* x0, bf16* o0, float* ssq0, int lane) {
    f32x4 v[4][4];
#pragma unroll
    for (int rr = 0; rr < 4; ++rr)
#pragma unroll
        for (int j = 0; j < 4; ++j) v[rr][j] = ld_nt(x0 + rr * 1024 + 4 * (64 * j + lane));
#pragma unroll
    for (int rr = 0; rr < 4; ++rr) { float sq = 0.f;
#pragma unroll
        for (int j = 0; j < 4; ++j) sq += (v[rr][j].x * v[rr][j].x + v[rr][j].y * v[rr][j].y) + (v[rr][j].z * v[rr][j].z + v[rr][j].w * v[rr][j].w);
        sq = wave_sum(sq);
        const float irs = sqrtf(sq * (1.0f / 1024.0f) + 1e-6f), rs = 1.0f / irs;
        unsigned long long* o8 = (unsigned long long*)(o0 + rr * 1024) + lane;
#pragma unroll
        for (int j = 0; j < 4; ++j) o8[64 * j] = (unsigned long long)pk2(v[rr][j].x * rs, v[rr][j].y * rs) | ((unsigned long long)pk2(v[rr][j].z * rs, v[rr][j].w * rs) << 32);
        if (lane == 0) ssq0[rr] = irs; }
}
__device__ __forceinline__ void p0_prologue(Frame& F) {
    LAS unsigned short* scr = (LAS unsigned short*)(F.lds + RING_OFF + F.wave * 16384);
    const int gw = F.vcu * NWAVES + F.wave, NGW = F.G * NWAVES;
    unsigned char* ws = F.ws;
    constexpr int I_IN = 16 * (NPROJ / 64), I_KV = 16 * 32, I_SSD = 32 * 16, I_SQ = 16 * 16, I_GU = 16 * (2 * FFN / 64), I_DN = (FFN / 64) * 16;
    constexpr int NITEMS = I_IN + I_KV + I_SSD + 4 * I_SQ + I_GU + I_DN;
    for (int it = gw; it < NITEMS; it += NGW) {
        int r = it;
        if (r < I_IN) { TSrc s{F.in[9], nullptr, F.in[8], 11296, 1}; p0_transpose_item(s, 1024, NPROJ, (bf16*)(ws + WS_WIN), scr, r, F.lane); continue; } r -= I_IN;
        if (r < I_KV) { TSrc s{F.in[24], F.in[25], F.in[22], 1024, 3}; p0_transpose_item(s, 1024, 2048, (bf16*)(ws + WS_WKV), scr, r, F.lane); continue; } r -= I_KV;
        if (r < I_SSD) { TSrc s{F.in[16], nullptr, F.in[15], 1024, 0}; p0_transpose_item(s, 2048, 1024, (bf16*)(ws + WS_WSSD), scr, r, F.lane); continue; } r -= I_SSD;
        if (r < I_SQ) { TSrc s{F.in[19], nullptr, F.in[18], 1024, 0}; p0_transpose_item(s, 1024, 1024, (bf16*)(ws + WS_WHG), scr, r, F.lane); continue; } r -= I_SQ;
        if (r < I_SQ) { TSrc s{F.in[20], nullptr, nullptr, 1024, 0}; p0_transpose_item(s, 1024, 1024, (bf16*)(ws + WS_WOUT), scr, r, F.lane); continue; } r -= I_SQ;
        if (r < I_SQ) { TSrc s{F.in[23], nullptr, F.in[21], 1024, 0}; p0_transpose_item(s, 1024, 1024, (bf16*)(ws + WS_WCQ), scr, r, F.lane); continue; } r -= I_SQ;
        if (r < I_SQ) { TSrc s{F.in[26], nullptr, nullptr, 1024, 0}; p0_transpose_item(s, 1024, 1024, (bf16*)(ws + WS_WCO), scr, r, F.lane); continue; } r -= I_SQ;
        if (r < I_GU) { TSrc s{F.in[28], F.in[29], F.in[27], FFN, 2}; p0_transpose_item(s, 1024, 2 * FFN, (bf16*)(ws + WS_WGU), scr, r, F.lane); continue; } r -= I_GU;
        { TSrc s{F.in[30], nullptr, nullptr, 1024, 0}; p0_transpose_item(s, FFN, 1024, (bf16*)(ws + WS_WDN), scr, r, F.lane); }
    }
    bf16* XB = (bf16*)(ws + WS_XB); float* SSQX = (float*)(ws + WS_SSQX);
    for (int m4 = gw; m4 < T / 4; m4 += NGW) { const int m = 4 * m4;
        rows4_to_bf16_ssq(m < TP ? F.in[0] + (size_t)m * DM : F.in[1] + (size_t)(m - TP) * DM, XB + (size_t)m * DM, SSQX + m, F.lane); }
    bf16* MNB = (bf16*)(ws + WS_MNB); float* SSQM = (float*)(ws + WS_SSQM);
    for (int m4 = gw; m4 < MEMR / 4; m4 += NGW) { const int m = 4 * m4; rows4_to_bf16_ssq(F.in[2] + (size_t)m * DM, MNB + (size_t)m * DM, SSQM + m, F.lane); }
}
__device__ __forceinline__ void conv_copy_unit(Frame& F, int gb) {
    const bf16* PROJ = (const bf16*)(F.ws + WS_PROJ);
    const bool prompt = gb < NBP; const int sb = gb - NBP;
    const size_t row0 = prompt ? (size_t)gb * SEQ + (SEQ - 3) : (size_t)TP + (size_t)sb * LS + 1;
    float* dst = prompt ? F.out + O_CONVP + (size_t)gb * 3 * 3072 : F.out + O_CONVS + (size_t)sb * 3 * 3072;
    for (int e = F.tid; e < 3 * 3072; e += NTHR) { const int j = e / 3072, col = e % 3072;
        dst[e] = bf2f(PROJ[(size_t)(S_X0 + (col >> 10)) * SLOT_ELEMS + (row0 + j) * 1024 + (col & 1023)]); }
}
__device__ __forceinline__ void ssdnorm_phase(Frame& F) {
    const int gw = F.vcu * NWAVES + F.wave, NGW = F.G * NWAVES; bf16* YG = (bf16*)(F.ws + WS_YG); const float* SSQ = (const float*)(F.ws + WS_SSQSSD);
    for (int row = gw; row < T; row += NGW) {
        const f32x4* sp = (const f32x4*)(SSQ + (size_t)row * 32);
#pragma unroll
        for (int j = 0; j < 4; ++j) { const f32x4 a = sp[2 * j], b = sp[2 * j + 1]; const float s = ((a.x + a.y) + (a.z + a.w)) + ((b.x + b.y) + (b.z + b.w)); const float rs = 1.0f / sqrtf(s * (1.0f / 512.0f) + EPS);
            v4u* p = (v4u*)(YG + (size_t)row * 2048) + j * 64 + F.lane; const v4u w = *p; v4u o;
#pragma unroll
            for (int e = 0; e < 4; ++e) o[e] = pk2(bf2f(w[e] & 0xffffu) * rs, bf2f(w[e] >> 16) * rs);
            *p = o; }
    }
}
typedef float f32x16 __attribute__((ext_vector_type(16)));
#define MFMA32(a, b, c) __builtin_amdgcn_mfma_f32_32x32x16_bf16((a), (b), (c), 0, 0, 0)
__device__ __forceinline__ unsigned cvtpk_c(float lo, float hi) { return pk2(lo, hi); }
__device__ __forceinline__ bf16x8 pack8(float a0, float a1, float a2, float a3, float a4, float a5, float a6, float a7) {
    v4u w; w.x = cvtpk_c(a0, a1); w.y = cvtpk_c(a2, a3); w.z = cvtpk_c(a4, a5); w.w = cvtpk_c(a6, a7); return __builtin_bit_cast(bf16x8, w); }
#define ACC_FRAG(x, s) pack8((x)[8 * (s)], (x)[8 * (s) + 1], (x)[8 * (s) + 2], (x)[8 * (s) + 3], (x)[8 * (s) + 4], (x)[8 * (s) + 5], (x)[8 * (s) + 6], (x)[8 * (s) + 7])
__device__ __forceinline__ bf16x8 lds_frag16(const LAS unsigned char* p) { return *(const LAS bf16x8*)p; }
__device__ __forceinline__ bf16x8 lds_frag8x2(const LAS unsigned char* p) { const v2u lo = *(const LAS v2u*)p, hi = *(const LAS v2u*)(p + 16);
    const v4u w = (v4u){lo.x, lo.y, hi.x, hi.y}; return __builtin_bit_cast(bf16x8, w); }
#define LDS_BARRIER() do { asm volatile("s_waitcnt lgkmcnt(0)" ::: "memory"); __builtin_amdgcn_s_barrier(); asm volatile("" ::: "memory"); } while (0)
constexpr size_t WS_BCS = WS_END, WS_BTT = WS_BCS + (size_t)TP * 1024 * 2, WS_END2 = WS_BTT + (size_t)NBP * 32 * 4 * 128 * 64 * 2;
__device__ __forceinline__ void bc_prep_unit(Frame& F, int b, int c) {
    typedef float f32x2 __attribute__((ext_vector_type(2)));
    int tid_o = F.tid; asm volatile("" : "+v"(tid_o));
    const int tid = tid_o, cg = tid & 127, seg = tid >> 7; unsigned char* ws = F.ws;
    const bf16* src = (const bf16*)(ws + WS_PROJ) + (size_t)S_X2 * SLOT_ELEMS + (size_t)b * SEQ * 1024 + 8 * cg;
    bf16* BCS = (bf16*)(ws + WS_BCS); bf16* BTT = (bf16*)(ws + WS_BTT);
    const float* cw = F.in[10] + 2048 + 8 * cg; const float* cbp = F.in[11] + 2048 + 8 * cg;
#pragma unroll 1
    for (int half = 0; half < 2; ++half) {
        const int s0 = 16 * seg + 8 * half;
        v4u raw[11];
#pragma unroll
        for (int i = 0; i < 11; ++i) { const int gt = 64 * c + s0 - 3 + i; raw[i] = (v4u){0u, 0u, 0u, 0u}; if (gt >= 0) raw[i] = ld_nt16(src + (size_t)gt * 1024); }
        v4u rowpk[8];
#pragma unroll
        for (int kp = 0; kp < 4; ++kp) {
            const f32x2 cw0 = *(const f32x2*)(cw + 2 * kp), cw1 = *(const f32x2*)(cw + 3072 + 2 * kp), cw2 = *(const f32x2*)(cw + 2 * 3072 + 2 * kp), cw3 = *(const f32x2*)(cw + 3 * 3072 + 2 * kp), cbb = *(const f32x2*)(cbp + 2 * kp);
            f32x2 xv[11];
#pragma unroll
            for (int i = 0; i < 11; ++i) { const unsigned wd = raw[i][kp]; xv[i] = (f32x2){__uint_as_float(wd << 16), __uint_as_float(wd & 0xffff0000u)}; }
            f32x2 o[8];
#pragma unroll
            for (int i = 0; i < 8; ++i) { f32x2 a = cw0 * xv[i] + cbb; a = cw1 * xv[i + 1] + a; a = cw2 * xv[i + 2] + a; a = cw3 * xv[i + 3] + a;
                const f32x2 t = a * (-1.4426950408889634f); f32x2 e; e.x = __builtin_amdgcn_exp2f(t.x); e.y = __builtin_amdgcn_exp2f(t.y); e = e + 1.0f;
                f32x2 rc; rc.x = __builtin_amdgcn_rcpf(e.x); rc.y = __builtin_amdgcn_rcpf(e.y); o[i] = a * rc; }
#pragma unroll
            for (int i = 0; i < 8; ++i) rowpk[i][kp] = pk2(o[i].x, o[i].y);
            if (cg < 64) { const int ng = 8 * cg + 2 * kp, g = ng >> 7, n = ng & 127;
                bf16* dst = BTT + ((size_t)(((b * 32 + c) * 4 + g) * 128 + n)) * 64 + s0;
                v4u pa; pa.x = pk2(o[0].x, o[1].x); pa.y = pk2(o[2].x, o[3].x); pa.z = pk2(o[4].x, o[5].x); pa.w = pk2(o[6].x, o[7].x); *(v4u*)dst = pa;
                v4u pb; pb.x = pk2(o[0].y, o[1].y); pb.y = pk2(o[2].y, o[3].y); pb.z = pk2(o[4].y, o[5].y); pb.w = pk2(o[6].y, o[7].y); *(v4u*)(dst + 64) = pb; }
        }
        bf16* drow = BCS + ((size_t)b * SEQ + 64 * c + s0) * 1024 + 8 * cg;
#pragma unroll
        for (int i = 0; i < 8; ++i) *(v4u*)(drow + (size_t)i * 1024) = rowpk[i];
    }
}
__device__ __forceinline__ void bc_prep_phase(Frame& F) { for (int u = F.vcu; u < NBP * 32; u += F.G) bc_prep_unit(F, u >> 5, u & 31); }
constexpr size_t WS_HVT = WS_XB, WS_EGM = WS_END2, WS_EGL = WS_EGM + (size_t)NBP * 64 * 1024 * 4, WS_END3 = WS_EGL + (size_t)NBP * 64 * 1024 * 4;
__device__ __forceinline__ void hg_prep_unit(Frame& F, int b, int c) {
    typedef float f32x2 __attribute__((ext_vector_type(2)));
    int tid_o = F.tid; asm volatile("" : "+v"(tid_o));
    const int tid = tid_o; unsigned char* ws = F.ws;
    const int ch = 2 * tid;
    const size_t row0 = (size_t)b * SEQ + 32 * c;
    bf16* QS = (bf16*)(ws + WS_PROJ) + (size_t)S_Q * SLOT_ELEMS + row0 * 1024 + ch; bf16* FS = (bf16*)(ws + WS_PROJ) + (size_t)S_F * SLOT_ELEMS + row0 * 1024 + ch;
    const f32x2 l0 = *(const f32x2*)(F.in[17] + ch), l1 = *(const f32x2*)(F.in[17] + 1024 + ch);
    f32x2 lb; lb.x = __builtin_amdgcn_rcpf(1.0f + __expf(l1.x - l0.x)); lb.y = __builtin_amdgcn_rcpf(1.0f + __expf(l1.y - l0.y));
    const f32x2 omlb = 1.0f - lb;
    f32x2 P[32]; f32x2 run = (f32x2){1.0f, 1.0f};
#pragma unroll
    for (int t = 0; t < 32; ++t) { const unsigned wd = ld_nt4(FS + (size_t)t * 1024);
        f32x2 u = (f32x2){__uint_as_float(wd << 16), __uint_as_float(wd & 0xffff0000u)}; u.x = fminf(fmaxf(u.x, -30.f), 30.f); u.y = fminf(fmaxf(u.y, -30.f), 30.f);
        const f32x2 tt = u * (-1.4426950408889634f); f32x2 e; e.x = __builtin_amdgcn_exp2f(tt.x); e.y = __builtin_amdgcn_exp2f(tt.y); e = e + 1.0f;
        f32x2 sg; sg.x = __builtin_amdgcn_rcpf(e.x); sg.y = __builtin_amdgcn_rcpf(e.y);
        const f32x2 fg = lb + omlb * sg; run = run * fg; run.x = fmaxf(run.x, 1e-30f); run.y = fmaxf(run.y, 1e-30f); P[t] = run; }
    const f32x2 Pm = P[15], Pl = P[31]; f32x2 rPm; rPm.x = __builtin_amdgcn_rcpf(Pm.x); rPm.y = __builtin_amdgcn_rcpf(Pm.y);
    *(f32x2*)((float*)(ws + WS_EGM) + (size_t)(b * 64 + c) * 1024 + ch) = Pm; *(f32x2*)((float*)(ws + WS_EGL) + (size_t)(b * 64 + c) * 1024 + ch) = Pl * rPm;
    f32x2 rPprev = (f32x2){1.0f, 1.0f};
#pragma unroll
    for (int t = 0; t < 32; ++t) { f32x2 rP; rP.x = __builtin_amdgcn_rcpf(P[t].x); rP.y = __builtin_amdgcn_rcpf(P[t].y);
        const f32x2 e1 = P[t] * rPm, e2 = Pm * rP, fg = P[t] * rPprev, kk = 1.0f - fg; rPprev = rP;
        const unsigned qw = ld_nt4(QS + (size_t)t * 1024); const f32x2 q = (f32x2){__uint_as_float(qw << 16), __uint_as_float(qw & 0xffff0000u)};
        const f32x2 tq = q * (-1.4426950408889634f); f32x2 eq; eq.x = __builtin_amdgcn_exp2f(tq.x); eq.y = __builtin_amdgcn_exp2f(tq.y); eq = eq + 1.0f;
        f32x2 rq; rq.x = __builtin_amdgcn_rcpf(eq.x); rq.y = __builtin_amdgcn_rcpf(eq.y);
        const f32x2 qa = q * rq * e1, ka = kk * e2;
        *(unsigned*)(QS + (size_t)t * 1024) = pk2(qa.x, qa.y); *(unsigned*)(FS + (size_t)t * 1024) = pk2(ka.x, ka.y); }
}
__device__ __forceinline__ void hg_prep_phase(Frame& F) { for (int u = F.vcu; u < NBP * 64; u += F.G) hg_prep_unit(F, u >> 6, u & 63); }
constexpr int HV_QA = 0, HV_KA = 8704, HV_KAT = 17408, HV_VT = 27648, HV_EGM = 30208, HV_EGL = 30720, HV_PBUF = 31232, HV_OB = 2 * HV_PBUF, HV_OBUF = 23040;
constexpr size_t WS_SSQH = WS_END3, WS_END4 = WS_SSQH + (size_t)T * 32 * 4;
__device__ __forceinline__ void hgrn_v_unit(Frame& F, int b, int hd, int vt) {
    int tid_o = F.tid; asm volatile("" : "+v"(tid_o));
    const int tid = tid_o, lane = tid & 63, w = F.wave, r = lane & 31, hh = lane >> 5; unsigned char* ws = F.ws;
    LAS unsigned char* Lb = F.lds + RING_OFF;
    const bf16* PROJ = (const bf16*)(ws + WS_PROJ); bf16* OU = (bf16*)(ws + WS_ON); float* SSQH = (float*)(ws + WS_SSQH);
    const size_t rowb = (size_t)b * SEQ;
    const int pt_t = tid & 31, pt_g = tid >> 5;
    const bf16* qsrc = PROJ + (size_t)S_Q * SLOT_ELEMS + (rowb + pt_t) * 1024 + hd * 128 + 8 * pt_g;
    const bf16* ksrc = PROJ + (size_t)S_F * SLOT_ELEMS + (rowb + pt_t) * 1024 + hd * 128 + 8 * pt_g;
    const unsigned char* xsrc = nullptr; size_t xstr = 0;
    if (tid < 128) { xsrc = (const unsigned char*)(PROJ + (size_t)S_I * SLOT_ELEMS + (rowb + pt_t) * 1024 + hd * 128 + 32 * vt + 8 * pt_g); xstr = (size_t)32 * 1024 * 2; }
    else if (tid < 160) { xsrc = (const unsigned char*)((const float*)(ws + WS_EGM) + (size_t)b * 64 * 1024 + hd * 128 + 4 * (tid - 128)); xstr = 4096; }
    else if (tid < 192) { xsrc = (const unsigned char*)((const float*)(ws + WS_EGL) + (size_t)b * 64 * 1024 + hd * 128 + 4 * (tid - 160)); xstr = 4096; }
    const int o_img = pt_t * 272 + 16 * pt_g, o_tr = (8 * pt_g) * 80 + 2 * pt_t;
#define HGV_LOAD(cc, pq, pk, px) { pq = *(const v4u*)(qsrc + (size_t)(cc) * 32 * 1024); pk = *(const v4u*)(ksrc + (size_t)(cc) * 32 * 1024); if (tid < 192) px = *(const v4u*)(xsrc + (size_t)(cc) * xstr); }
#define HGV_TR(dst, v) { _Pragma("unroll") for (int e = 0; e < 8; ++e) *(LAS unsigned short*)((dst) + 80 * e) = (unsigned short)(((v)[e >> 1] >> (16 * (e & 1))) & 0xffffu); }
#define HGV_STORE(pb, pq, pk, px) { *(LAS v4u*)((pb) + HV_QA + o_img) = pq; *(LAS v4u*)((pb) + HV_KA + o_img) = pk; HGV_TR((pb) + HV_KAT + o_tr, pk) \
        if (tid < 128) { HGV_TR((pb) + HV_VT + o_tr, px) } else if (tid < 160) { *(LAS v4u*)((pb) + HV_EGM + 16 * (tid - 128)) = px; } else if (tid < 192) { *(LAS v4u*)((pb) + HV_EGL + 16 * (tid - 160)) = px; } }
    v4u pqA, pkA, pxA = (v4u){0u, 0u, 0u, 0u}, pqB, pkB, pxB = (v4u){0u, 0u, 0u, 0u};
    HGV_LOAD(0, pqA, pkA, pxA) HGV_STORE(Lb, pqA, pkA, pxA)
    HGV_LOAD(1, pqA, pkA, pxA) HGV_LOAD(2, pqB, pkB, pxB)
    const int kt = w;
    v2u ow_pend = (v2u){0u, 0u}; float sq_pend = 0.f;
    f32x16 S;
#pragma unroll
    for (int i = 0; i < 16; ++i) S[i] = 0.f;
    __syncthreads();
#define HGV_ITER(c, pq, pk, px) { \
        int r_l = r, hh_l = hh, tid_l = tid; asm volatile("" : "+v"(r_l), "+v"(hh_l), "+v"(tid_l)); \
        { const int r = r_l, hh = hh_l, tid = tid_l; \
        LAS unsigned char* pbc = Lb + ((c) & 1) * HV_PBUF; LAS unsigned char* pbn = Lb + (((c) + 1) & 1) * HV_PBUF; \
        if ((c) < 63) { HGV_STORE(pbn, pq, pk, px) if ((c) < 61) HGV_LOAD((c) + 3, pq, pk, px) } \
        if (w < 4) { \
            LAS float* EGM = (LAS float*)(pbc + HV_EGM); LAS float* EGL = (LAS float*)(pbc + HV_EGL); LAS float* OB = (LAS float*)(Lb + HV_OB + ((c) & 1) * HV_OBUF); \
            _Pragma("unroll") \
            for (int q4 = 0; q4 < 4; ++q4) { const f32x4 e0 = *(const LAS f32x4*)(EGM + 32 * kt + 8 * q4 + 4 * hh); \
                _Pragma("unroll") \
                for (int j = 0; j < 4; ++j) S[4 * q4 + j] *= e0[j]; } \
            f32x16 o; \
            _Pragma("unroll") \
            for (int i = 0; i < 16; ++i) o[i] = 0.f; \
            const LAS unsigned char* qa_row = pbc + HV_QA + r * 272; \
            o = MFMA32(ACC_FRAG(S, 0), lds_frag8x2(qa_row + (32 * kt + 4 * hh) * 2), o);        \
            o = MFMA32(ACC_FRAG(S, 1), lds_frag8x2(qa_row + (32 * kt + 16 + 4 * hh) * 2), o); \
            LAS float* ob = OB + (kt * 32 + r) * 36 + 4 * hh; \
            _Pragma("unroll") \
            for (int q4 = 0; q4 < 4; ++q4) *(LAS f32x4*)(ob + 8 * q4) = (f32x4){o[4 * q4], o[4 * q4 + 1], o[4 * q4 + 2], o[4 * q4 + 3]}; \
            const LAS unsigned char* kat_nat = pbc + HV_KAT + (32 * kt + r) * 80 + hh * 16; const LAS unsigned char* vt_nat = pbc + HV_VT + r * 80 + hh * 16; \
            S = MFMA32(lds_frag16(kat_nat), lds_frag16(vt_nat), S); S = MFMA32(lds_frag16(kat_nat + 32), lds_frag16(vt_nat + 32), S); \
            _Pragma("unroll") \
            for (int q4 = 0; q4 < 4; ++q4) { const f32x4 e0 = *(const LAS f32x4*)(EGL + 32 * kt + 8 * q4 + 4 * hh); \
                _Pragma("unroll") \
                for (int j = 0; j < 4; ++j) S[4 * q4 + j] *= e0[j]; } \
        } else { \
            if (w == 4) { LAS float* OB = (LAS float*)(Lb + HV_OB + ((c) & 1) * HV_OBUF); f32x16 o; \
                _Pragma("unroll") \
                for (int i = 0; i < 16; ++i) o[i] = 0.f; \
                f32x16 X; \
                _Pragma("unroll") \
                for (int i = 0; i < 16; ++i) X[i] = 0.f; \
                const LAS unsigned char* ka_nat = pbc + HV_KA + r * 272 + hh * 16; const LAS unsigned char* qa_nat = pbc + HV_QA + r * 272 + hh * 16; \
                { f32x16 Xb; \
                _Pragma("unroll") \
                for (int i = 0; i < 16; ++i) Xb[i] = 0.f; \
                _Pragma("unroll 2") \
                for (int ks = 0; ks < 8; ks += 2) { X = MFMA32(lds_frag16(ka_nat + ks * 32), lds_frag16(qa_nat + ks * 32), X); Xb = MFMA32(lds_frag16(ka_nat + ks * 32 + 32), lds_frag16(qa_nat + ks * 32 + 32), Xb); } \
                X = X + Xb; } \
                _Pragma("unroll") \
                for (int i = 0; i < 16; ++i) { const int srow = (i & 3) + 8 * (i >> 2) + 4 * hh; X[i] = (srow <= r) ? X[i] : 0.f; } \
                const LAS unsigned char* vt_row = pbc + HV_VT + r * 80; \
                o = MFMA32(lds_frag8x2(vt_row + (4 * hh) * 2), ACC_FRAG(X, 0), o);                \
                o = MFMA32(lds_frag8x2(vt_row + (16 + 4 * hh) * 2), ACC_FRAG(X, 1), o); \
                LAS float* ob4 = OB + (4 * 32 + r) * 36 + 4 * hh; \
                _Pragma("unroll") \
                for (int q4 = 0; q4 < 4; ++q4) *(LAS f32x4*)(ob4 + 8 * q4) = (f32x4){o[4 * q4], o[4 * q4 + 1], o[4 * q4 + 2], o[4 * q4 + 3]}; \
            } \
            if ((c) > 1) { HGV_FLUSH((c) - 2) } \
            if ((c) > 0) { HGV_OUT((c) - 1) } \
        } \
        LDS_BARRIER(); \
        } }
#define HGV_OUT(cp) { const LAS float* OB = (const LAS float*)(Lb + HV_OB + ((cp) & 1) * HV_OBUF); const int tl = tid - 256, t = tl >> 3, v0 = (tl & 7) * 4; \
            const f32x4 a = *(const LAS f32x4*)(OB + t * 36 + v0), b2 = *(const LAS f32x4*)(OB + (32 + t) * 36 + v0), c2 = *(const LAS f32x4*)(OB + (64 + t) * 36 + v0), d2 = *(const LAS f32x4*)(OB + (96 + t) * 36 + v0), e2 = *(const LAS f32x4*)(OB + (128 + t) * 36 + v0); \
            const f32x4 o4 = ((a + b2) + (c2 + d2)) + e2; \
            float sq = (o4.x * o4.x + o4.y * o4.y) + (o4.z * o4.z + o4.w * o4.w); sq += __int_as_float(__builtin_amdgcn_update_dpp(0, __float_as_int(sq), 0x104, 0xf, 0xf, true)); sq += __int_as_float(__builtin_amdgcn_update_dpp(0, __float_as_int(sq), 0x102, 0xf, 0xf, true)); sq += __int_as_float(__builtin_amdgcn_update_dpp(0, __float_as_int(sq), 0x101, 0xf, 0xf, true));   \
            sq_pend = sq; ow_pend.x = pk2(o4.x, o4.y); ow_pend.y = pk2(o4.z, o4.w); }
#define HGV_FLUSH(cp) { const int tl = tid - 256, t = tl >> 3, v0 = (tl & 7) * 4; const size_t row = rowb + 32 * (cp) + t; \
            if ((tl & 7) == 0) SSQH[row * 32 + hd * 4 + vt] = sq_pend; *(v2u*)(OU + row * 1024 + hd * 128 + 32 * vt + v0) = ow_pend; }
#pragma unroll 1
    for (int cc = 0; cc < 64; cc += 2) { HGV_ITER(cc, pqA, pkA, pxA) HGV_ITER(cc + 1, pqB, pkB, pxB) }
    if (w >= 4) { HGV_FLUSH(62) HGV_OUT(63) HGV_FLUSH(63) }
#undef HGV_ITER
#undef HGV_OUT
#undef HGV_FLUSH
#undef HGV_LOAD
#undef HGV_STORE
#undef HGV_TR
    if (w < 4) { float* st_g = F.out + O_HGP + (size_t)(b * 8 + hd) * 16384 + 32 * vt + r;
#pragma unroll
        for (int i = 0; i < 16; ++i) { const int k = 32 * kt + (i & 3) + 8 * (i >> 2) + 4 * hh; st_g[(size_t)k * 128] = S[i]; } }
    __syncthreads();
}
__device__ __forceinline__ void hgnorm_phase(Frame& F) {
    const int gw = F.vcu * NWAVES + F.wave, NGW = F.G * NWAVES; bf16* ON = (bf16*)(F.ws + WS_ON); const float* SSQH = (const float*)(F.ws + WS_SSQH);
    const bf16* HG = (const bf16*)(F.ws + WS_PROJ) + (size_t)S_HG * SLOT_ELEMS;
    for (int row = gw; row < TP; row += NGW) {
#pragma unroll
        for (int j = 0; j < 2; ++j) { const int pc = j * 64 + F.lane, hd = pc >> 4;
            const f32x4 sp = *(const f32x4*)(SSQH + (size_t)row * 32 + hd * 4); const float rs = __builtin_amdgcn_rsqf(((sp.x + sp.y) + (sp.z + sp.w)) * (1.0f / 128.0f) + EPS);
            v4u* p = (v4u*)(ON + (size_t)row * 1024) + pc; const v4u o = *p; const v4u g = ld_nt16((const v4u*)(HG + (size_t)row * 1024) + pc); v4u res;
#pragma unroll
            for (int e = 0; e < 4; ++e) res[e] = pk2(bf2f(o[e] & 0xffffu) * rs * silu_f(bf2f(g[e] & 0xffffu)), __uint_as_float(o[e] & 0xffff0000u) * rs * silu_f(__uint_as_float(g[e] & 0xffff0000u)));
            *p = res; }
    }
}
constexpr int SD_BN = 0, SD_CN = 17408, SD_BT = 34816, SD_XT = 53248, SD_HT = 62464, SD_YA = 97280, SD_YY = 113664, SD_YO = 130048, SD_CUM = 134144, SD_DTV = 134400, SD_ECUM = 134656, SD_XWT = 134912, SD_CWL = 144128;
__device__ __forceinline__ void ssd_unit_mfma(Frame& F, int gb, int h) {
    int tid_o = F.tid; asm volatile("" : "+v"(tid_o));
    const int tid = tid_o, lane = tid & 63, w = F.wave, r = lane & 31, hh = lane >> 5; unsigned char* ws = F.ws;
    const int L = SEQ; const size_t row_base = (size_t)gb * SEQ;
    const int g = h >> 3;
    LAS unsigned char* Lb = F.lds + RING_OFF;
    LAS unsigned short* BN = (LAS unsigned short*)(Lb + SD_BN); LAS unsigned short* CN = (LAS unsigned short*)(Lb + SD_CN);
    LAS unsigned short* BT = (LAS unsigned short*)(Lb + SD_BT); LAS unsigned short* XT = (LAS unsigned short*)(Lb + SD_XT);
    LAS unsigned short* HT = (LAS unsigned short*)(Lb + SD_HT);
    LAS unsigned short* XWT = (LAS unsigned short*)(Lb + SD_XWT);
    LAS float* YA = (LAS float*)(Lb + SD_YA); LAS float* YY = (LAS float*)(Lb + SD_YY); LAS unsigned short* YO = (LAS unsigned short*)(Lb + SD_YO);
    LAS float* CUM = (LAS float*)(Lb + SD_CUM); LAS float* DTV = (LAS float*)(Lb + SD_DTV); LAS float* ECUM = (LAS float*)(Lb + SD_ECUM);
    const bf16* PROJ = (const bf16*)(ws + WS_PROJ); const float* DTR = (const float*)(ws + WS_DT); bf16* YG = (bf16*)(ws + WS_YG); float* SSQ = (float*)(ws + WS_SSQSSD);
    f32x16 H0, H1, H2, H3;
#pragma unroll
    for (int i = 0; i < 16; ++i) { H0[i] = 0.f; H1[i] = 0.f; H2[i] = 0.f; H3[i] = 0.f; }
    float* const st_base = F.out + O_SSMP + (size_t)(gb * 32 + h) * 8192 + (size_t)r * 128 + 4 * hh;
#define SSD_PUBLISH(HX, TILE, BUF) { LAS unsigned short* hp_ = HT + (BUF) * 8704 + (32 * ((TILE) & 1) + r) * 136 + 32 * ((TILE) >> 1) + 4 * hh; \
        _Pragma("unroll") for (int q4 = 0; q4 < 4; ++q4) { v2u pk; pk.x = cvtpk_c(HX[4 * q4], HX[4 * q4 + 1]); pk.y = cvtpk_c(HX[4 * q4 + 2], HX[4 * q4 + 3]); *(LAS v2u*)(hp_ + 8 * q4) = pk; } }
    if (w == 3) { SSD_PUBLISH(H0, 0, 0) SSD_PUBLISH(H1, 1, 0) SSD_PUBLISH(H2, 2, 0) SSD_PUBLISH(H3, 3, 0) } else if (w >= 4) { SSD_PUBLISH(H0, w, 0) }
    const float a = -__expf(F.in[13][h]), dtb = F.in[12][h], Dk = F.in[14][h];
    const float* cw = F.in[10]; const float* cbp = F.in[11];
    typedef float f32x2 __attribute__((ext_vector_type(2)));
    const int col = h * 64 + 2 * (tid & 31);
    const bf16* cptr = PROJ + (size_t)(S_X0 + (col >> 10)) * SLOT_ELEMS + row_base * 1024 + (col & 1023);
    const f32x2 cw0 = *(const f32x2*)(cw + col), cw1 = *(const f32x2*)(cw + 3072 + col), cw2 = *(const f32x2*)(cw + 2 * 3072 + col), cw3 = *(const f32x2*)(cw + 3 * 3072 + col), cbb = *(const f32x2*)(cbp + col);
    const bf16* BCS = (const bf16*)(ws + WS_BCS) + row_base * 1024 + g * 128; const bf16* BTT = (const bf16*)(ws + WS_BTT) + (size_t)(gb * 32 * 4 + g) * 128 * 64;
    unsigned xr[7]; v4u pc[6];
#pragma unroll
    for (int i = 0; i < 7; ++i) { const int gt = 4 * (tid >> 5) - 3 + i; xr[i] = 0u; if (gt >= 0) xr[i] = *(const unsigned*)(cptr + (size_t)gt * 1024); }
#pragma unroll
    for (int j = 0; j < 6; ++j) { const int idx = (tid + 512 * j) & 1023;
        if (j < 4) pc[j] = *(const v4u*)(BCS + (size_t)(idx >> 4) * 1024 + (j >> 1) * 512 + 8 * (idx & 15));
        else pc[j] = *(const v4u*)(BTT + (size_t)(idx >> 3) * 64 + 8 * (idx & 7)); }
    __syncthreads();
    v4u ow_pend = (v4u){0u, 0u, 0u, 0u}; float sq_pend = 0.f; bool pend = false;
    int buf = 0;
    float dt_pf = 0.f;
    if (lane < L) dt_pf = DTR[(row_base + lane) * 32 + h];
    v4u zw_pf = ld_nt16(PROJ + (size_t)(S_Z0 + (h >> 4)) * SLOT_ELEMS + (row_base + (tid >> 3)) * 1024 + (h & 15) * 64 + (tid & 7) * 8);
    for (int t0 = 0; t0 < L; t0 += 64, buf ^= 1) {
        int r_l = r, hh_l = hh, tid_l = tid, lane_l = lane;
        asm volatile("" : "+v"(r_l), "+v"(hh_l), "+v"(tid_l), "+v"(lane_l));
        { const int r = r_l, hh = hh_l, tid = tid_l, lane = lane_l;
        float dtv = 0.f;
        if (t0 + lane < L) { const float x = dt_pf + dtb; dtv = fmaxf(x, 0.f) + 0.6931471805599453f * __builtin_amdgcn_logf(1.0f + __builtin_amdgcn_exp2f(-1.4426950408889634f * fabsf(x))); }
        dt_pf = 0.f; if (t0 + 64 + lane < L) dt_pf = DTR[(row_base + t0 + 64 + lane) * 32 + h];
        const v4u zw = zw_pf; zw_pf = (v4u){0u, 0u, 0u, 0u};
        if (t0 + 64 + (tid >> 3) < L) zw_pf = ld_nt16(PROJ + (size_t)(S_Z0 + (h >> 4)) * SLOT_ELEMS + (row_base + t0 + 64 + (tid >> 3)) * 1024 + (h & 15) * 64 + (tid & 7) * 8);
        float cum = dtv * a;
#define SSD_DPP_ADD(ctrl, rmask) cum += __int_as_float(__builtin_amdgcn_update_dpp(0, __float_as_int(cum), ctrl, rmask, 0xf, true))
        SSD_DPP_ADD(0x111, 0xf); SSD_DPP_ADD(0x112, 0xf); SSD_DPP_ADD(0x114, 0xf); SSD_DPP_ADD(0x118, 0xf);
        SSD_DPP_ADD(0x142, 0xa); SSD_DPP_ADD(0x143, 0xc);
#undef SSD_DPP_ADD
        const float cum_last = __int_as_float(__builtin_amdgcn_readlane(__float_as_int(cum), 63));
        const float wgt = __expf(cum_last - cum) * dtv;
        if (w == 0) { CUM[lane] = cum; DTV[lane] = dtv; ECUM[lane] = __expf(cum); }
#pragma unroll
        for (int j = 0; j < 6; ++j) { const int idx = (tid + 512 * j) & 1023;
            if (j < 2) *(LAS v4u*)(BN + (idx >> 4) * 136 + 8 * (idx & 15)) = pc[j];
            else if (j < 4) *(LAS v4u*)(CN + (idx >> 4) * 136 + 8 * (idx & 15)) = pc[j];
            else *(LAS v4u*)(BT + (idx >> 3) * 72 + 8 * (idx & 7)) = pc[j]; }
        if (pend) { const size_t prow = row_base + (t0 - 64) + (tid >> 3);
            *(v4u*)(YG + prow * 2048 + h * 64 + (tid & 7) * 8) = ow_pend; if ((tid & 7) == 0) SSQ[prow * 32 + h] = sq_pend; pend = false; }
        { const int cp = tid & 31, sq = tid >> 5; const int wu = __builtin_amdgcn_readfirstlane(w);
          f32x2 xv[7];
#pragma unroll
          for (int i = 0; i < 7; ++i) xv[i] = (f32x2){__uint_as_float(xr[i] << 16), __uint_as_float(xr[i] & 0xffff0000u)};
          unsigned po[4], pw[4];
          f32x2 o[4], ow[4];
#pragma unroll
          for (int k = 0; k < 4; ++k) {
              const float w_lo = __int_as_float(__builtin_amdgcn_readlane(__float_as_int(wgt), 8 * wu + k)), w_hi = __int_as_float(__builtin_amdgcn_readlane(__float_as_int(wgt), 8 * wu + 4 + k));
              const float wx = hh ? w_hi : w_lo;
              f32x2 a = cw0 * xv[k] + cbb; a = cw1 * xv[k + 1] + a; a = cw2 * xv[k + 2] + a; a = cw3 * xv[k + 3] + a;
              const f32x2 t = a * (-1.4426950408889634f); f32x2 e; e.x = __builtin_amdgcn_exp2f(t.x); e.y = __builtin_amdgcn_exp2f(t.y); e = e + 1.0f;
              f32x2 rc; rc.x = __builtin_amdgcn_rcpf(e.x); rc.y = __builtin_amdgcn_rcpf(e.y); o[k] = a * rc; ow[k] = o[k] * wx; }
          po[0] = pk2(o[0].x, o[1].x); po[1] = pk2(o[2].x, o[3].x); po[2] = pk2(o[0].y, o[1].y); po[3] = pk2(o[2].y, o[3].y);
          pw[0] = pk2(ow[0].x, ow[1].x); pw[1] = pk2(ow[2].x, ow[3].x); pw[2] = pk2(ow[0].y, ow[1].y); pw[3] = pk2(ow[2].y, ow[3].y);
          *(LAS v2u*)(XT + (2 * cp) * 72 + 4 * sq) = (v2u){po[0], po[1]}; *(LAS v2u*)(XT + (2 * cp + 1) * 72 + 4 * sq) = (v2u){po[2], po[3]};
          *(LAS v2u*)(XWT + (2 * cp) * 72 + 4 * sq) = (v2u){pw[0], pw[1]}; *(LAS v2u*)(XWT + (2 * cp + 1) * 72 + 4 * sq) = (v2u){pw[2], pw[3]};
        }
        if (t0 + 64 < L) {
#pragma unroll
            for (int i = 0; i < 7; ++i) xr[i] = *(const unsigned*)(cptr + (size_t)(t0 + 64 + 4 * (tid >> 5) - 3 + i) * 1024);
            const int chn = (t0 >> 6) + 1;
#pragma unroll
            for (int j = 0; j < 6; ++j) { const int idx = (tid + 512 * j) & 1023;
                if (j < 4) pc[j] = *(const v4u*)(BCS + (size_t)(t0 + 64 + (idx >> 4)) * 1024 + (j >> 1) * 512 + 8 * (idx & 15));
                else pc[j] = *(const v4u*)(BTT + ((size_t)chn * 4 * 128 + (idx >> 3)) * 64 + 8 * (idx & 7)); }
        }
        LDS_BARRIER();
        if (w < 3) {
            const int tt = w == 0 ? 0 : 1, st = w == 1 ? 1 : 0;
            f32x16 X, ya0, ya1;
#pragma unroll
            for (int i = 0; i < 16; ++i) { X[i] = 0.f; ya0[i] = 0.f; ya1[i] = 0.f; }
            const LAS unsigned char* cn_nat = Lb + SD_CN + (32 * tt + r) * 272 + hh * 16; const LAS unsigned char* bn_nat = Lb + SD_BN + (32 * st + r) * 272 + hh * 16;
            { f32x16 Xb;
#pragma unroll
              for (int i = 0; i < 16; ++i) Xb[i] = 0.f;
#pragma unroll
              for (int ks = 0; ks < 8; ks += 2) { X = MFMA32(lds_frag16(bn_nat + ks * 32), lds_frag16(cn_nat + ks * 32), X); Xb = MFMA32(lds_frag16(bn_nat + ks * 32 + 32), lds_frag16(cn_nat + ks * 32 + 32), Xb); }
              X = X + Xb; }
            const float cum_t = CUM[32 * tt + r];
#pragma unroll
            for (int q4 = 0; q4 < 4; ++q4) { const f32x4 cs = *(const LAS f32x4*)(CUM + 32 * st + 8 * q4 + 4 * hh), ds = *(const LAS f32x4*)(DTV + 32 * st + 8 * q4 + 4 * hh);
#pragma unroll
                for (int jj = 0; jj < 4; ++jj) { const int s_abs = 32 * st + 8 * q4 + 4 * hh + jj; const float f = __expf(cum_t - cs[jj]) * ds[jj]; X[4 * q4 + jj] = (s_abs <= 32 * tt + r) ? X[4 * q4 + jj] * f : 0.f;        } }
            const bf16x8 xf0 = ACC_FRAG(X, 0), xf1 = ACC_FRAG(X, 1);
            const LAS unsigned char* xt_row = Lb + SD_XT + r * 144 + (32 * st + 4 * hh) * 2;
            ya0 = MFMA32(lds_frag8x2(xt_row), xf0, ya0); ya0 = MFMA32(lds_frag8x2(xt_row + 32), xf1, ya0);
            ya1 = MFMA32(lds_frag8x2(xt_row + 32 * 144), xf0, ya1); ya1 = MFMA32(lds_frag8x2(xt_row + 32 * 144 + 32), xf1, ya1);
            if (w < 2) { LAS float* yb = YA + (32 * tt + r) * 64;
#pragma unroll
                for (int q4 = 0; q4 < 4; ++q4) { const int ch = 2 * q4 + hh;
                    *(LAS f32x4*)(yb + 4 * (ch ^ (r & 15))) = (f32x4){ya0[4 * q4], ya0[4 * q4 + 1], ya0[4 * q4 + 2], ya0[4 * q4 + 3]};
                    *(LAS f32x4*)(yb + 4 * ((ch + 8) ^ (r & 15))) = (f32x4){ya1[4 * q4], ya1[4 * q4 + 1], ya1[4 * q4 + 2], ya1[4 * q4 + 3]}; } }
            else { LAS unsigned char* yb = (LAS unsigned char*)YO + r * 128;
#pragma unroll
                for (int q4 = 0; q4 < 4; ++q4) { const int ch = 2 * q4 + hh; v2u p0, p1;
                    p0.x = cvtpk_c(ya0[4 * q4], ya0[4 * q4 + 1]); p0.y = cvtpk_c(ya0[4 * q4 + 2], ya0[4 * q4 + 3]); p1.x = cvtpk_c(ya1[4 * q4], ya1[4 * q4 + 1]); p1.y = cvtpk_c(ya1[4 * q4 + 2], ya1[4 * q4 + 3]);
                    *(LAS v2u*)(yb + 8 * (ch ^ ((r & 7) << 1))) = p0; *(LAS v2u*)(yb + 8 * ((ch + 8) ^ ((r & 7) << 1))) = p1; } }
        } else if (w >= 4) {
            const int tt = (w - 4) >> 1, ptj = w & 1;
            const LAS unsigned char* ht_nat = Lb + SD_HT + buf * 17408 + (32 * ptj + r) * 272 + hh * 16;
            f32x16 yi;
#pragma unroll
            for (int i = 0; i < 16; ++i) yi[i] = 0.f;
            const LAS unsigned char* cn_nat = Lb + SD_CN + (32 * tt + r) * 272 + hh * 16;
            { f32x16 yb2;
#pragma unroll
              for (int i = 0; i < 16; ++i) yb2[i] = 0.f;
#pragma unroll 2
              for (int ks = 0; ks < 8; ks += 2) { yi = MFMA32(lds_frag16(cn_nat + ks * 32), lds_frag16(ht_nat + ks * 32), yi); yb2 = MFMA32(lds_frag16(cn_nat + ks * 32 + 32), lds_frag16(ht_nat + ks * 32 + 32), yb2); }
              yi = yi + yb2; }
            const LAS unsigned short* xt_p = XT + (32 * ptj + r) * 72 + 32 * tt + 4 * hh;
#pragma unroll
            for (int q4 = 0; q4 < 4; ++q4) { const f32x4 ec = *(const LAS f32x4*)(ECUM + 32 * tt + 8 * q4 + 4 * hh); const v2u xw = *(const LAS v2u*)(xt_p + 8 * q4);
                const float x0 = bf2f(xw.x & 0xffffu), x1 = bf2f(xw.x >> 16), x2 = bf2f(xw.y & 0xffffu), x3 = bf2f(xw.y >> 16);
                LAS float* yb = YY + (32 * tt + 8 * q4 + 4 * hh) * 64 + 32 * ptj + r;
                yb[0] = ec[0] * yi[4 * q4] + Dk * x0; yb[64] = ec[1] * yi[4 * q4 + 1] + Dk * x1; yb[128] = ec[2] * yi[4 * q4 + 2] + Dk * x2; yb[192] = ec[3] * yi[4 * q4 + 3] + Dk * x3; }
        }
#define SSD_UPD(HX, TILE) { const LAS unsigned char* bt_nat = Lb + SD_BT + (32 * ((TILE) >> 1) + r) * 144 + hh * 16; const LAS unsigned char* xt_nat = Lb + SD_XWT + (32 * ((TILE) & 1) + r) * 144 + hh * 16; \
            f32x16 Ha, Hb; \
            _Pragma("unroll") for (int i = 0; i < 16; ++i) { Ha[i] = 0.f; Hb[i] = 0.f; } \
            Ha = MFMA32(lds_frag16(bt_nat), lds_frag16(xt_nat), Ha); Hb = MFMA32(lds_frag16(bt_nat + 32), lds_frag16(xt_nat + 32), Hb); \
            Ha = MFMA32(lds_frag16(bt_nat + 64), lds_frag16(xt_nat + 64), Ha); Hb = MFMA32(lds_frag16(bt_nat + 96), lds_frag16(xt_nat + 96), Hb);         \
            _Pragma("unroll") for (int i = 0; i < 16; ++i) HX[i] = HX[i] * el + (Ha[i] + Hb[i]); \
            SSD_PUBLISH(HX, TILE, buf ^ 1) }
        if (w >= 3) { const float el = ECUM[63];
            if (w == 3) { SSD_UPD(H0, 0) SSD_UPD(H1, 1) SSD_UPD(H2, 2) SSD_UPD(H3, 3) } else { SSD_UPD(H0, w) } }
        LDS_BARRIER();
        { const int tt = tid >> 3, p0 = (tid & 7) * 8;
          if (t0 + tt < L) { const size_t row = row_base + t0 + tt;
            const int c0 = 2 * (tid & 7);
            f32x4 y0 = *(const LAS f32x4*)(YA + tt * 64 + 4 * (c0 ^ (tt & 15))) + *(const LAS f32x4*)(YY + tt * 64 + p0), y1 = *(const LAS f32x4*)(YA + tt * 64 + 4 * ((c0 + 1) ^ (tt & 15))) + *(const LAS f32x4*)(YY + tt * 64 + p0 + 4);
            if (tt >= 32) { const v4u ow4 = *(const LAS v4u*)((const LAS unsigned char*)YO + (tt - 32) * 128 + 16 * ((tid & 7) ^ (tt & 7)));
                y0 = y0 + (f32x4){bf2f(ow4.x & 0xffffu), __uint_as_float(ow4.x & 0xffff0000u), bf2f(ow4.y & 0xffffu), __uint_as_float(ow4.y & 0xffff0000u)};
                y1 = y1 + (f32x4){bf2f(ow4.z & 0xffffu), __uint_as_float(ow4.z & 0xffff0000u), bf2f(ow4.w & 0xffffu), __uint_as_float(ow4.w & 0xffff0000u)}; }
            float o[8]; float sq = 0.f;
#pragma unroll
            for (int j = 0; j < 8; ++j) { const unsigned z16 = (zw[j >> 1] >> ((j & 1) * 16)) & 0xffffu; const float yv = (j < 4 ? y0[j & 3] : y1[j & 3]) * silu_f(bf2f(z16)); o[j] = yv; sq += yv * yv; }
            ow_pend.x = pk2(o[0], o[1]); ow_pend.y = pk2(o[2], o[3]); ow_pend.z = pk2(o[4], o[5]); ow_pend.w = pk2(o[6], o[7]);
            sq += __int_as_float(__builtin_amdgcn_update_dpp(0, __float_as_int(sq), 0x104, 0xf, 0xf, true));
            sq += __int_as_float(__builtin_amdgcn_update_dpp(0, __float_as_int(sq), 0x102, 0xf, 0xf, true));
            sq += __int_as_float(__builtin_amdgcn_update_dpp(0, __float_as_int(sq), 0x101, 0xf, 0xf, true)); sq_pend = sq; pend = true; } }
        }
    }
    if (pend) { const size_t prow = row_base + (L - 64) + (tid >> 3); *(v4u*)(YG + prow * 2048 + h * 64 + (tid & 7) * 8) = ow_pend; if ((tid & 7) == 0) SSQ[prow * 32 + h] = sq_pend; }
#define SSD_STOUT(HX, TILE) { float* st_g = st_base + (size_t)(32 * ((TILE) & 1)) * 128 + 32 * ((TILE) >> 1); \
        _Pragma("unroll") for (int q4 = 0; q4 < 4; ++q4) *(f32x4*)(st_g + 8 * q4) = (f32x4){HX[4 * q4], HX[4 * q4 + 1], HX[4 * q4 + 2], HX[4 * q4 + 3]}; }
    if (w == 3) { SSD_STOUT(H0, 0) SSD_STOUT(H1, 1) SSD_STOUT(H2, 2) SSD_STOUT(H3, 3) } else if (w >= 4) { SSD_STOUT(H0, w) }
#undef SSD_STOUT
#undef SSD_UPD
#undef SSD_PUBLISH
    __syncthreads();
}
__device__ __forceinline__ float tr_reduce32(const float (&v)[32], int lane) {
    const bool b4 = lane & 16, b3 = lane & 8, b2 = lane & 4, b1 = lane & 2, b0 = lane & 1;
    float a[16], b[8], c[4], d[2];
#pragma unroll
    for (int i = 0; i < 16; ++i) { const float keep = b4 ? v[i + 16] : v[i], send = b4 ? v[i] : v[i + 16]; a[i] = keep + __shfl_xor(send, 16); }
#pragma unroll
    for (int i = 0; i < 8; ++i) { const float keep = b3 ? a[i + 8] : a[i], send = b3 ? a[i] : a[i + 8]; b[i] = keep + __shfl_xor(send, 8); }
#pragma unroll
    for (int i = 0; i < 4; ++i) { const float keep = b2 ? b[i + 4] : b[i], send = b2 ? b[i] : b[i + 4]; c[i] = keep + __shfl_xor(send, 4); }
#pragma unroll
    for (int i = 0; i < 2; ++i) { const float keep = b1 ? c[i + 2] : c[i], send = b1 ? c[i] : c[i + 2]; d[i] = keep + __shfl_xor(send, 2); }
    const float keep = b0 ? d[1] : d[0], send = b0 ? d[0] : d[1];
    return keep + __shfl_xor(send, 1);
}
__device__ __forceinline__ void ssd_sample_unit(Frame& F, int sb, int g) {
    int tid_o = F.tid; asm volatile("" : "+v"(tid_o));
    const int tid = tid_o, lane = tid & 63, w = F.wave, hh = lane >> 5, nq = lane & 31; unsigned char* ws = F.ws;
    LAS float* XC = (LAS float*)(F.lds + RING_OFF); LAS float* BC = XC + 8 * 4 * 64; LAS float* CC = BC + 4 * 128; LAS float* DTS = CC + 4 * 128;
    const bf16* PROJ = (const bf16*)(ws + WS_PROJ); const float* DTR = (const float*)(ws + WS_DT); bf16* YG = (bf16*)(ws + WS_YG); float* SSQ = (float*)(ws + WS_SSQSSD);
    const size_t row0 = (size_t)TP + (size_t)sb * LS;
    const int h = 8 * g + w;
    const float* sp = F.in[3] + (size_t)(sb * 32 + h) * 8192 + (size_t)hh * 128 + 4 * nq;
    f32x4 hst[32];
#pragma unroll
    for (int i = 0; i < 32; ++i) hst[i] = ld_nt(sp + (size_t)i * 256);
    if (tid < 384) { typedef float f32x2 __attribute__((ext_vector_type(2)));
        const int col = tid < 256 ? g * 512 + 2 * tid : (tid < 320 ? 2048 + g * 128 + 2 * (tid - 256) : 2560 + g * 128 + 2 * (tid - 320));
        const float* cw = F.in[10]; const float* sc = F.in[4] + (size_t)sb * 3 * 3072 + col;
        const f32x2 w0 = *(const f32x2*)(cw + col), w1 = *(const f32x2*)(cw + 3072 + col), w2 = *(const f32x2*)(cw + 2 * 3072 + col), w3 = *(const f32x2*)(cw + 3 * 3072 + col), cb = *(const f32x2*)(F.in[11] + col);
        f32x2 full[7]; full[0] = *(const f32x2*)sc; full[1] = *(const f32x2*)(sc + 3072); full[2] = *(const f32x2*)(sc + 2 * 3072);
        const bf16* cp = PROJ + (size_t)(S_X0 + (col >> 10)) * SLOT_ELEMS + row0 * 1024 + (col & 1023);
#pragma unroll
        for (int t = 0; t < 4; ++t) { const unsigned wd = *(const unsigned*)(cp + (size_t)t * 1024); full[3 + t] = (f32x2){__uint_as_float(wd << 16), __uint_as_float(wd & 0xffff0000u)}; }
#pragma unroll
        for (int t = 0; t < 4; ++t) { f32x2 a = w0 * full[t] + cb; a = w1 * full[t + 1] + a; a = w2 * full[t + 2] + a; a = w3 * full[t + 3] + a;
            f32x2 o; o.x = silu_f(a.x); o.y = silu_f(a.y);
            LAS float* dst = tid < 256 ? XC + ((tid >> 5) * 4 + t) * 64 + 2 * (tid & 31) : (tid < 320 ? BC + t * 128 + 2 * (tid - 256) : CC + t * 128 + 2 * (tid - 320));
            *(LAS f32x2*)dst = o; }
    } else if (tid < 416) { const int idx = tid - 384, hl = idx >> 2, t = idx & 3; const float x = DTR[(row0 + t) * 32 + 8 * g + hl] + F.in[12][8 * g + hl]; DTS[idx] = x > 20.f ? x : log1pf(__expf(x)); }
    __syncthreads();
    const float a = -__expf(F.in[13][h]), Dk = F.in[14][h];
#pragma unroll 1
    for (int t = 0; t < 4; ++t) {
        const float dtv = DTS[w * 4 + t], dA = __expf(dtv * a);
        const f32x4 Bv = *(const LAS f32x4*)(BC + t * 128 + 4 * nq), Cv = *(const LAS f32x4*)(CC + t * 128 + 4 * nq);
        const LAS float* xrow = XC + (w * 4 + t) * 64;
        float part[32];
#pragma unroll
        for (int i = 0; i < 32; ++i) { const float xd = xrow[2 * i + hh] * dtv; hst[i] = hst[i] * dA + Bv * xd; part[i] = (hst[i].x * Cv.x + hst[i].y * Cv.y) + (hst[i].z * Cv.z + hst[i].w * Cv.w); }
        float yv = tr_reduce32(part, lane);
        const int p = 2 * nq + hh; const size_t row = row0 + t;
        yv += Dk * xrow[p];
        const float z = bf2f(PROJ[(size_t)(S_Z0 + (h >> 4)) * SLOT_ELEMS + row * 1024 + (h & 15) * 64 + p]);
        const float yg = yv * silu_f(z);
        YG[row * 2048 + h * 64 + p] = (bf16)f2bf(yg);
        const float sq = wave_sum(yg * yg);
        if (lane == 0) SSQ[row * 32 + h] = sq;
    }
    float* so = F.out + O_SSMS + (size_t)(sb * 32 + h) * 8192 + (size_t)hh * 128 + 4 * nq;
#pragma unroll
    for (int i = 0; i < 32; ++i) st_nt(so + (size_t)i * 256, hst[i]);
    __syncthreads();
}
__device__ __forceinline__ void hgrn_sample_unit(Frame& F, int sb, int hq) {
    int tid_o = F.tid; asm volatile("" : "+v"(tid_o));
    const int tid = tid_o, lane = tid & 63, w = F.wave, hh = lane >> 5, vq = lane & 31; unsigned char* ws = F.ws;
    LAS float* FS = (LAS float*)(F.lds + RING_OFF); LAS float* KS = FS + 2048; LAS float* QS = KS + 2048; LAS float* VS = QS + 2048; LAS float* OP = VS + 2048;
    const bf16* PROJ = (const bf16*)(ws + WS_PROJ); bf16* ON = (bf16*)(ws + WS_ON);
    const size_t row0 = (size_t)TP + (size_t)sb * LS;
    const int hl = w >> 1, kh = w & 1, hd = 4 * hq + hl;
    const float* sp = F.in[5] + (size_t)(sb * 8 + hd) * 16384 + (size_t)(64 * kh + hh) * 128 + 4 * vq;
    f32x4 S[32];
#pragma unroll
    for (int i = 0; i < 32; ++i) S[i] = ld_nt(sp + (size_t)i * 256);
    { const int ch = hq * 512 + tid; const float lb = __builtin_amdgcn_rcpf(1.0f + __expf(F.in[17][1024 + ch] - F.in[17][ch]));
      const bf16* fp = PROJ + (size_t)S_F * SLOT_ELEMS + row0 * 1024 + ch; const bf16* qp = PROJ + (size_t)S_Q * SLOT_ELEMS + row0 * 1024 + ch; const bf16* ip = PROJ + (size_t)S_I * SLOT_ELEMS + row0 * 1024 + ch;
#pragma unroll
      for (int t = 0; t < 4; ++t) { const float u = fminf(fmaxf(bf2f(fp[(size_t)t * 1024]), -30.f), 30.f); const float fg = lb + (1.0f - lb) * sigmoid_f(u);
          const int o = ((tid >> 7) * 4 + t) * 128 + (tid & 127);
          FS[o] = fg; KS[o] = 1.0f - fg; QS[o] = silu_f(bf2f(qp[(size_t)t * 1024])); VS[o] = bf2f(ip[(size_t)t * 1024]); } }
    __syncthreads();
#pragma unroll 1
    for (int t = 0; t < 4; ++t) {
        const int o = (hl * 4 + t) * 128;
        const f32x4 vv = *(const LAS f32x4*)(VS + o + 4 * vq);
        f32x4 oa = (f32x4){0.f, 0.f, 0.f, 0.f};
#pragma unroll
        for (int i = 0; i < 32; ++i) { const int k = 64 * kh + 2 * i + hh; const float fk = FS[o + k], kv = KS[o + k], qk = QS[o + k]; S[i] = S[i] * fk + vv * kv; oa = oa + S[i] * qk; }
        oa.x += __shfl_xor(oa.x, 32); oa.y += __shfl_xor(oa.y, 32); oa.z += __shfl_xor(oa.z, 32); oa.w += __shfl_xor(oa.w, 32);
        if (hh == 0) *(LAS f32x4*)(OP + ((hl * 4 + t) * 2 + kh) * 128 + 4 * vq) = oa;
    }
    float* so = F.out + O_HGS + (size_t)(sb * 8 + hd) * 16384 + (size_t)(64 * kh + hh) * 128 + 4 * vq;
#pragma unroll
    for (int i = 0; i < 32; ++i) st_nt(so + (size_t)i * 256, S[i]);
    __syncthreads();
#pragma unroll
    for (int rr2 = 0; rr2 < 2; ++rr2) { const int rr = 2 * w + rr2, ohl = rr >> 2, t = rr & 3, ohd = 4 * hq + ohl; typedef float f32x2 __attribute__((ext_vector_type(2)));
        const f32x2 p0 = *(const LAS f32x2*)(OP + (rr * 2) * 128 + 2 * lane), p1 = *(const LAS f32x2*)(OP + (rr * 2 + 1) * 128 + 2 * lane);
        const float o0 = p0.x + p1.x, o1 = p0.y + p1.y; const float sq = wave_sum(o0 * o0 + o1 * o1); const float rs = __builtin_amdgcn_rsqf(sq * (1.0f / 128.0f) + EPS);
        const size_t row = row0 + t; const unsigned gw = *(const unsigned*)(PROJ + (size_t)S_HG * SLOT_ELEMS + row * 1024 + ohd * 128 + 2 * lane);
        *(unsigned*)(ON + row * 1024 + ohd * 128 + 2 * lane) = pk2(o0 * rs * silu_f(bf2f(gw & 0xffffu)), o1 * rs * silu_f(__uint_as_float(gw & 0xffff0000u))); }
    __syncthreads();
}
constexpr int U_HGS = NBS * 2, U_SSDS = NBS * 4, U_CONV = NBP + NBS;
__device__ __forceinline__ void scan_phase(Frame& F) {
    gu32* head = F.ctl + CW_QUEUE;
#define SCAN_QUEUE(qi, count, body) for (;;) { if (F.tid == 0) F.MISC[0] = __hip_atomic_fetch_add(head + 64 * (qi), 1u, RLX_AGENT); __syncthreads(); const int u = (int)F.MISC[0]; __syncthreads(); if (u >= (count)) break; body }
    SCAN_QUEUE(1, NBP * 32, ssd_unit_mfma(F, u >> 5, u & 31);)
    SCAN_QUEUE(0, NBP * 32, hgrn_v_unit(F, u >> 5, (u >> 2) & 7, u & 3);)
    SCAN_QUEUE(2, U_HGS, hgrn_sample_unit(F, u >> 1, u & 1);)
    SCAN_QUEUE(3, U_SSDS + U_CONV, if (u >= U_SSDS) { conv_copy_unit(F, u - U_SSDS); continue; } ssd_sample_unit(F, u >> 2, u & 3);)
#undef SCAN_QUEUE
}
typedef float f32x4s __attribute__((ext_vector_type(4)));
template <class Epi> __device__ __forceinline__ void small_tile_phase(Frame& F, const bf16* A, const bf16* Bt, int K, const Epi& E) {
    const int lane = F.lane, w = F.wave, r = lane & 31, hh = lane >> 5;
#pragma unroll 1
    for (int v = F.vcu; v < 256; v += F.G) {
    const int mt = v >> 4, nt = v & 15;
    const int kw = K >> 3;
    const bf16* ap = A + (size_t)(TP + 32 * mt + r) * K + w * kw + 8 * hh;
    const bf16* bp = Bt + (size_t)(64 * nt + r) * K + w * kw + 8 * hh;
    f32x16 acc0, acc1;
#pragma unroll
    for (int i = 0; i < 16; ++i) { acc0[i] = 0.f; acc1[i] = 0.f; }
#pragma unroll 4
    for (int ks = 0; ks < kw / 16; ++ks) { const bf16x8 af = *(const bf16x8*)(ap + 16 * ks), b0 = *(const bf16x8*)(bp + 16 * ks), b1 = *(const bf16x8*)(bp + (size_t)32 * K + 16 * ks);
        acc0 = MFMA32(b0, af, acc0); acc1 = MFMA32(b1, af, acc1); }
    LAS float* part = (LAS float*)(F.lds + RING_OFF) + w * 2048;
#pragma unroll
    for (int q4 = 0; q4 < 4; ++q4) { *(LAS f32x4*)(part + r * 64 + 8 * q4 + 4 * hh) = (f32x4){acc0[4 * q4], acc0[4 * q4 + 1], acc0[4 * q4 + 2], acc0[4 * q4 + 3]};
        *(LAS f32x4*)(part + r * 64 + 32 + 8 * q4 + 4 * hh) = (f32x4){acc1[4 * q4], acc1[4 * q4 + 1], acc1[4 * q4 + 2], acc1[4 * q4 + 3]}; }
    __syncthreads();
    const int rl = F.tid >> 4, c4 = (F.tid & 15) * 4; const LAS float* src = (const LAS float*)(F.lds + RING_OFF) + rl * 64 + c4;
    f32x4 sum = *(const LAS f32x4*)src;
#pragma unroll
    for (int ww = 1; ww < 8; ++ww) sum = sum + *(const LAS f32x4*)(src + ww * 2048);
    const f32x4s acc = (f32x4s){sum.x, sum.y, sum.z, sum.w};
    E.small(F, acc, TP + 32 * mt + rl, 64 * nt + c4, nt);
    __syncthreads();
    }
}
template <bool ADD> struct SmGate { bf16* O; const bf16* gate;
    __device__ __forceinline__ void small(Frame&, const f32x4s& a, int row, int col, int) const { const size_t off = (size_t)row * 1024 + col;
        const v2u gw = __builtin_nontemporal_load((const v2u*)(gate + off)); v2u ow = (v2u){0u, 0u}; if (ADD) ow = *(const v2u*)(O + off);
        float rr[4];
#pragma unroll
        for (int e = 0; e < 4; ++e) { const unsigned g16 = (gw[e >> 1] >> ((e & 1) * 16)) & 0xffffu, o16 = (ow[e >> 1] >> ((e & 1) * 16)) & 0xffffu; rr[e] = (ADD ? bf2f(o16) : 0.f) + sigmoid_f(bf2f(g16)) * a[e]; }
        v2u wv; wv.x = cvtpk_c(rr[0], rr[1]); wv.y = cvtpk_c(rr[2], rr[3]); *(v2u*)(O + off) = wv; } };
template <bool BF, bool BSC = false> struct SmRes { const float* base; const bf16* bb; bf16* hb; float* ssqp; const float* bsc;
    __device__ __forceinline__ void small(Frame& F, const f32x4s& a, int row, int col, int nt) const { const size_t off = (size_t)row * 1024 + col; f32x4 b;
        if (BF) { const v2u w = *(const v2u*)(bb + off); b = (f32x4){bf2f(w.x & 0xffffu), __uint_as_float(w.x & 0xffff0000u), bf2f(w.y & 0xffffu), __uint_as_float(w.y & 0xffff0000u)}; }
        else b = *(const f32x4*)(base + off);
        if constexpr (BSC) b = b * bsc[row];
        const f32x4 v = b + (f32x4){a[0], a[1], a[2], a[3]};
        { v2u wv; wv.x = cvtpk_c(v[0], v[1]); wv.y = cvtpk_c(v[2], v[3]); *(v2u*)(hb + off) = wv; }
        float sq = (v[0] * v[0] + v[1] * v[1]) + (v[2] * v[2] + v[3] * v[3]); sq += __shfl_xor(sq, 1); sq += __shfl_xor(sq, 2); sq += __shfl_xor(sq, 4); sq += __shfl_xor(sq, 8);
        if ((F.tid & 15) == 0) ssqp[(size_t)row * 16 + nt] = sq; } };
struct SmScale { bf16* O; const float* ssq; float scale;
    __device__ __forceinline__ void small(Frame&, const f32x4s& a, int row, int col, int) const { const float rs = pg8::row_rs<16>(ssq, row) * scale;
        v2u wv; wv.x = cvtpk_c(a[0] * rs, a[1] * rs); wv.y = cvtpk_c(a[2] * rs, a[3] * rs); *(v2u*)(O + (size_t)row * 1024 + col) = wv; } };
__device__ __forceinline__ void attn_stage_tile(LAS unsigned char* Lb, const bf16* src, size_t pitch, int tid) {
#pragma unroll 1
    for (int hb = 0; hb < 2; ++hb) { v4u v[8];
#pragma unroll
        for (int i = 0; i < 8; ++i) { const int id = tid + 512 * (8 * hb + i), row = id >> 5, c = id & 31; v[i] = *(const v4u*)(src + (size_t)row * pitch + c * 8); }
#pragma unroll
        for (int i = 0; i < 8; ++i) { const int id = tid + 512 * (8 * hb + i), row = id >> 5, c = id & 31; *(LAS v4u*)(Lb + row * 512 + ((c ^ (row & 15)) << 4)) = v[i]; } }
}
__device__ __forceinline__ void attn_prompt_unit(Frame& F, int b, int hd, int qb) {
    const int tid = F.tid, lane = F.lane, w = F.wave, r = lane & 31, hh = lane >> 5; unsigned char* ws = F.ws;
    LAS unsigned char* Lb = F.lds + RING_OFF;
    const bf16* QB = (const bf16*)(ws + WS_QB); const bf16* KB = (const bf16*)(ws + WS_KB); const bf16* VT = (const bf16*)(ws + WS_VT); bf16* OB = (bf16*)(ws + WS_OB);
    const size_t qrow = (size_t)b * SEQ + (size_t)qb * 256 + 32 * w + r;
    attn_stage_tile(Lb, KB + (size_t)b * 256 * 1024 + hd * 256, 1024, tid);
    const bf16* qp = QB + qrow * 1024 + hd * 256 + 8 * hh;
    bf16x8 qf = *(const bf16x8*)qp;
    __syncthreads();
    f32x16 S[8];
#pragma unroll
    for (int t = 0; t < 8; ++t)
#pragma unroll
        for (int i = 0; i < 16; ++i) S[t][i] = 0.f;
    const int sw = r & 15;
#pragma unroll 1
    for (int ks = 0; ks < 16; ++ks) {
        const bf16x8 qn = *(const bf16x8*)(qp + 16 * (ks < 15 ? ks + 1 : ks));
        const LAS unsigned char* kp = Lb + r * 512 + (((2 * ks + hh) ^ sw) << 4);
#pragma unroll
        for (int t = 0; t < 8; ++t) S[t] = MFMA32(lds_frag16(kp + t * 32 * 512), qf, S[t]);
        qf = qn;
    }
    float m = -3.0e38f;
#pragma unroll
    for (int t = 0; t < 8; ++t)
#pragma unroll
        for (int i = 0; i < 16; ++i) m = fmaxf(m, S[t][i]);
    m = fmaxf(m, __shfl_xor(m, 32));
    float l = 0.f;
#pragma unroll
    for (int t = 0; t < 8; ++t)
#pragma unroll
        for (int i = 0; i < 16; ++i) { const float pv = __builtin_amdgcn_exp2f(S[t][i] - m); S[t][i] = pv; l += pv; }
    l += __shfl_xor(l, 32);
    const float rl = __builtin_amdgcn_rcpf(l);
    bf16x8 pf[8][2];
#pragma unroll
    for (int t = 0; t < 8; ++t) { pf[t][0] = ACC_FRAG(S[t], 0); pf[t][1] = ACC_FRAG(S[t], 1); }
    __syncthreads();
    attn_stage_tile(Lb, VT + (size_t)(b * 4 + hd) * 256 * 256, 256, tid);
    __syncthreads();
    bf16* op = OB + qrow * 1024 + hd * 256 + 4 * hh;
#pragma unroll 1
    for (int dt = 0; dt < 8; ++dt) {
        f32x16 O;
#pragma unroll
        for (int i = 0; i < 16; ++i) O[i] = 0.f;
        const LAS unsigned char* vrow = Lb + (32 * dt + r) * 512 + 8 * hh;
#pragma unroll
        for (int t = 0; t < 8; ++t)
#pragma unroll
            for (int s2 = 0; s2 < 2; ++s2) {
                const v2u lo = *(const LAS v2u*)(vrow + (((4 * t + 2 * s2) ^ sw) << 4)), hi = *(const LAS v2u*)(vrow + (((4 * t + 2 * s2 + 1) ^ sw) << 4));
                const v4u wv4 = (v4u){lo.x, lo.y, hi.x, hi.y};
                O = MFMA32(__builtin_bit_cast(bf16x8, wv4), pf[t][s2], O);
            }
#pragma unroll
        for (int q4 = 0; q4 < 4; ++q4) { v2u o; o.x = cvtpk_c(O[4 * q4] * rl, O[4 * q4 + 1] * rl); o.y = cvtpk_c(O[4 * q4 + 2] * rl, O[4 * q4 + 3] * rl);
            *(v2u*)(op + 32 * dt + 8 * q4) = o; }
    }
    __syncthreads();
}
__device__ __forceinline__ void attn_sample_unit(Frame& F, int sb, int hd) {
    const int tid = F.tid, lane = F.lane, w = F.wave; unsigned char* ws = F.ws;
    LAS float* sc = (LAS float*)(F.lds + RING_OFF);
    LAS float* red = sc + 4 * 256;
    const bf16* QB = (const bf16*)(ws + WS_QB); bf16* OB = (bf16*)(ws + WS_OB);
    const size_t rowq = (size_t)TP + (size_t)sb * LS;
    float q[4][4];
#pragma unroll
    for (int t = 0; t < 4; ++t) { const v2u qw = *(const v2u*)(QB + (rowq + t) * 1024 + hd * 256 + 4 * lane); q[t][0] = bf2f(qw.x & 0xffffu); q[t][1] = bf2f(qw.x >> 16); q[t][2] = bf2f(qw.y & 0xffffu); q[t][3] = bf2f(qw.y >> 16); }
    const float* Kc = F.in[6] + ((size_t)sb * 256 * 4 + hd) * 256 + 4 * lane; const float* Vc = F.in[7] + ((size_t)sb * 256 * 4 + hd) * 256 + 4 * lane;
    f32x4 kv[8], kn[8];
#pragma unroll
    for (int u = 0; u < 8; ++u) kv[u] = ld_nt(Kc + (size_t)(w * 32 + u) * 1024);
#pragma unroll 1
    for (int kk0 = 0; kk0 < 32; kk0 += 8) {
#pragma unroll
        for (int u = 0; u < 8; ++u) kn[u] = kk0 < 24 ? ld_nt(Kc + (size_t)(w * 32 + kk0 + 8 + u) * 1024) : ld_nt(Vc + (size_t)(w * 32 + u) * 1024);
        { float part[32];
#pragma unroll
          for (int u = 0; u < 8; ++u)
#pragma unroll
              for (int t = 0; t < 4; ++t) part[4 * u + t] = (q[t][0] * kv[u].x + q[t][1] * kv[u].y) + (q[t][2] * kv[u].z + q[t][3] * kv[u].w);
          float sv = tr_reduce32(part, lane); sv += __shfl_xor(sv, 32);
          if (lane < 32) sc[(lane & 3) * 256 + w * 32 + kk0 + (lane >> 2)] = sv; }
#pragma unroll
        for (int u = 0; u < 8; ++u) kv[u] = kn[u]; }
    __syncthreads();
    if (w < 4) { float v[4]; float m = -3.0e38f;
#pragma unroll
        for (int j = 0; j < 4; ++j) { v[j] = sc[w * 256 + j * 64 + lane]; m = fmaxf(m, v[j]); }
        m = wave_max(m); float l = 0.f;
#pragma unroll
        for (int j = 0; j < 4; ++j) { v[j] = __builtin_amdgcn_exp2f(v[j] - m); l += v[j]; }
        l = wave_sum(l); const float rl = 1.0f / l;
#pragma unroll
        for (int j = 0; j < 4; ++j) sc[w * 256 + j * 64 + lane] = v[j] * rl; }
    __syncthreads();
    float o[4][4];
#pragma unroll
    for (int t = 0; t < 4; ++t)
#pragma unroll
        for (int e = 0; e < 4; ++e) o[t][e] = 0.f;
#pragma unroll 1
    for (int kk0 = 0; kk0 < 32; kk0 += 8) {
        if (kk0 < 24) {
#pragma unroll
            for (int u = 0; u < 8; ++u) kn[u] = ld_nt(Vc + (size_t)(w * 32 + kk0 + 8 + u) * 1024); }
#pragma unroll
        for (int u = 0; u < 8; ++u) { const int key = w * 32 + kk0 + u;
#pragma unroll
            for (int t = 0; t < 4; ++t) { const float pr = sc[t * 256 + key]; o[t][0] += pr * kv[u].x; o[t][1] += pr * kv[u].y; o[t][2] += pr * kv[u].z; o[t][3] += pr * kv[u].w; } }
#pragma unroll
        for (int u = 0; u < 8; ++u) kv[u] = kn[u]; }
#pragma unroll
    for (int t = 0; t < 4; ++t) *(LAS f32x4*)(red + (w * 4 + t) * 256 + 4 * lane) = (f32x4){o[t][0], o[t][1], o[t][2], o[t][3]};
    __syncthreads();
    { const int t = tid >> 7, d0 = (tid & 127) * 2; float a0 = 0.f, a1 = 0.f;
#pragma unroll
      for (int ww = 0; ww < 8; ++ww) { a0 += red[(ww * 4 + t) * 256 + d0]; a1 += red[(ww * 4 + t) * 256 + d0 + 1]; }
      *(unsigned*)(OB + (rowq + t) * 1024 + hd * 256 + d0) = pk2(a0, a1); }
    __syncthreads();
}
__device__ __forceinline__ void attn_phase(Frame& F) {
    for (int u = F.vcu; u < NBP * 4 * 8; u += F.G) attn_prompt_unit(F, u >> 5, (u >> 3) & 3, u & 7);
    for (int u = F.vcu; u < NBS * 4; u += F.G) attn_sample_unit(F, u >> 2, u & 3);
}
__device__ __forceinline__ void final_norm_phase(Frame& F) {
    const int gw = F.vcu * NWAVES + F.wave, NGW = F.G * NWAVES; const float* SSQ = (const float*)(F.ws + WS_SSQP3); const float* wn = F.in[31]; const bf16* HB = (const bf16*)(F.ws + WS_HB);
    f32x4 wv[4];
#pragma unroll
    for (int j = 0; j < 2; ++j) { wv[2 * j] = *((const f32x4*)wn + 2 * (64 * j + F.lane)); wv[2 * j + 1] = *((const f32x4*)wn + 2 * (64 * j + F.lane) + 1); }
    for (int row = gw; row < T; row += NGW) {
        const f32x4* sp = (const f32x4*)(SSQ + (size_t)row * 16); float s = 0.f;
#pragma unroll
        for (int j = 0; j < 4; ++j) { const f32x4 a = sp[j]; s += (a.x + a.y) + (a.z + a.w); }
        const float rs = __builtin_amdgcn_rsqf(s * (1.0f / 1024.0f) + EPS);
#pragma unroll
        for (int j = 0; j < 2; ++j) { const int pc = 64 * j + F.lane; const v4u w = ld_nt16((const v4u*)(HB + (size_t)row * 1024) + pc);
            const f32x4 v0 = (f32x4){bf2f(w.x & 0xffffu), __uint_as_float(w.x & 0xffff0000u), bf2f(w.y & 0xffffu), __uint_as_float(w.y & 0xffff0000u)};
            const f32x4 v1 = (f32x4){bf2f(w.z & 0xffffu), __uint_as_float(w.z & 0xffff0000u), bf2f(w.w & 0xffffu), __uint_as_float(w.w & 0xffff0000u)};
            float* o = F.out + O_Y + (size_t)row * 1024 + 8 * pc; st_nt(o, v0 * rs * wv[2 * j]); st_nt(o + 4, v1 * rs * wv[2 * j + 1]); }
    }
}
#ifndef MK_N_LAUNCHES
#define MK_N_LAUNCHES 1
#endif
constexpr int PER_PHASE = 13;
constexpr int N_LAUNCHES = MK_N_LAUNCHES;
struct Args { const float* in[32]; float* out; unsigned char* ws; int ph_lo, ph_hi; };
__global__ void __launch_bounds__(NTHR, 2) skel_fwd(Args args) {
    extern __shared__ __attribute__((aligned(16))) unsigned char lds[];
    Frame F;
    F.lds = (LAS unsigned char*)lds;
    F.MISC = (volatile LAS unsigned*)(F.lds + MISC_OFF);
    F.tid = threadIdx.x; F.lane = F.tid & 63; F.wave = __builtin_amdgcn_readfirstlane(F.tid >> 6);
    F.G = gridDim.x; { const int bx = blockIdx.x; F.vcu = (F.G % 8 == 0) ? (bx % 8) * (F.G / 8) + bx / 8 : bx; }
    unsigned char* ws = args.ws; F.ws = ws; F.out = args.out;
    F.ctl = (gu32*)(ws + WS_CTL);
#pragma unroll
    for (int i = 0; i < 32; ++i) F.in[i] = args.in[i];
    for (int u = F.tid; u < (LDS_BYTES - LDSCTL_OFF) / 4; u += NTHR) ((LAS unsigned*)(F.lds + LDSCTL_OFF))[u] = 0u;
    __syncthreads();
    XcdBarrier bar; bar.bar = (unsigned*)(F.ctl + CW_BAR); bar.x = 0; bar.st = nullptr;
    if (N_LAUNCHES == 1) bar = xcd_barrier_post((unsigned*)(F.ctl + CW_BAR), F.MISC + 8);
#define GRID_BAR() do { if (N_LAUNCHES == 1) xcd_barrier(bar); } while (0)
    const int lo = args.ph_lo, hi = args.ph_hi;
#ifdef ONLY_PHASE
#define IN(k) ((k) == ONLY_PHASE && lo <= (k) && (k) < hi)
#else
#define IN(k) (lo <= (k) && (k) < hi)
#endif
#define BOTH(k) (IN(k) && IN((k) + 1))
    bf16* const XB = (bf16*)(ws + WS_XB); bf16* const PROJ = (bf16*)(ws + WS_PROJ);
    float* const Y = F.out + O_Y;
    if (IN(0)) { p0_prologue(F); if (BOTH(0)) GRID_BAR(); }
    if (IN(1)) {
        { pg8::Gemm g{XB, (const bf16*)(ws + WS_WIN), T, NPROJ, 1024}; pg8::StaticOrder S; S.init(T, NPROJ, F.G, (int)blockIdx.x);
          pg8::EpiScaleBf16<0, true> E{PROJ, SLOT_ELEMS, nullptr, 1.0f, (float*)(ws + WS_DT)};
          pg8::gemm_phase<pg8::EpiScaleBf16<0, true>, pg8::StaticOrder, true, true>(F.lds + RING_OFF, g, S, E); }
        { pg8::Gemm g{(const bf16*)(ws + WS_MNB), (const bf16*)(ws + WS_WKV), MEMR, 2048, 1024}; pg8::StaticOrder S; S.init(MEMR, 2048, F.G, (int)((blockIdx.x + 64) % F.G));
          pg8::EpiKV E{F.out + O_MKP, F.out + O_MVP, (bf16*)(ws + WS_KB), (bf16*)(ws + WS_VT), (const float*)(ws + WS_SSQM)};
          pg8::gemm_phase<pg8::EpiKV, pg8::StaticOrder, true, true>(F.lds + RING_OFF, g, S, E); }
        if (BOTH(1)) GRID_BAR();
    }
    if (IN(2)) { bc_prep_phase(F); hg_prep_phase(F); if (BOTH(2)) GRID_BAR(); }
    if (IN(3)) { scan_phase(F); if (BOTH(3)) GRID_BAR(); }
    if (IN(4)) { ssdnorm_phase(F); hgnorm_phase(F); if (BOTH(4)) GRID_BAR(); }
    if (IN(5)) { { SmGate<false> Es{(bf16*)(ws + WS_MERGED), PROJ + (size_t)S_GS * SLOT_ELEMS}; small_tile_phase(F, (const bf16*)(ws + WS_YG), (const bf16*)(ws + WS_WSSD), 2048, Es); }
        pg8::Gemm g{(const bf16*)(ws + WS_YG), (const bf16*)(ws + WS_WSSD), TP, 1024, 2048}; pg8::StaticOrder S; S.init(TP, 1024, F.G, (int)blockIdx.x);
        pg8::EpiGate<false> E{(bf16*)(ws + WS_MERGED), PROJ + (size_t)S_GS * SLOT_ELEMS};
        pg8::gemm_phase<pg8::EpiGate<false>, pg8::StaticOrder, true, true>(F.lds + RING_OFF, g, S, E);
          }
    if (IN(5)) { { SmGate<true> Es{(bf16*)(ws + WS_MERGED), PROJ + (size_t)S_GH * SLOT_ELEMS}; small_tile_phase(F, (const bf16*)(ws + WS_ON), (const bf16*)(ws + WS_WHG), 1024, Es); }
        pg8::Gemm g{(const bf16*)(ws + WS_ON), (const bf16*)(ws + WS_WHG), TP, 1024, 1024}; pg8::StaticOrder S; S.init(TP, 1024, F.G, (int)blockIdx.x);
        pg8::EpiGate<true> E{(bf16*)(ws + WS_MERGED), PROJ + (size_t)S_GH * SLOT_ELEMS};
        pg8::gemm_phase<pg8::EpiGate<true>, pg8::StaticOrder, true, true>(F.lds + RING_OFF, g, S, E);
        if (BOTH(5)) GRID_BAR(); }
    if (IN(6)) { { SmRes<true, true> Es{nullptr, XB, (bf16*)(ws + WS_HB), (float*)(ws + WS_SSQP1), (const float*)(ws + WS_SSQX)}; small_tile_phase(F, (const bf16*)(ws + WS_MERGED), (const bf16*)(ws + WS_WOUT), 1024, Es); }
        pg8::Gemm g{(const bf16*)(ws + WS_MERGED), (const bf16*)(ws + WS_WOUT), TP, 1024, 1024}; pg8::StaticOrder S; S.init(TP, 1024, F.G, (int)blockIdx.x);
        pg8::EpiRes<true, true> E{nullptr, nullptr, XB, (bf16*)(ws + WS_HB), (float*)(ws + WS_SSQP1), (const float*)(ws + WS_SSQX)};
        pg8::gemm_phase<pg8::EpiRes<true, true>, pg8::StaticOrder, true, true>(F.lds + RING_OFF, g, S, E);
        if (BOTH(6)) GRID_BAR(); }
    if (IN(7)) { { SmScale Es{(bf16*)(ws + WS_QB), (const float*)(ws + WS_SSQP1), QSCALE}; small_tile_phase(F, (const bf16*)(ws + WS_HB), (const bf16*)(ws + WS_WCQ), 1024, Es); }
        pg8::Gemm g{(const bf16*)(ws + WS_HB), (const bf16*)(ws + WS_WCQ), TP, 1024, 1024}; pg8::StaticOrder S; S.init(TP, 1024, F.G, (int)blockIdx.x);
        pg8::EpiScaleBf16<16, false> E{(bf16*)(ws + WS_QB), SLOT_ELEMS, (const float*)(ws + WS_SSQP1), QSCALE, nullptr};
        pg8::gemm_phase<pg8::EpiScaleBf16<16, false>, pg8::StaticOrder, true, true>(F.lds + RING_OFF, g, S, E);
        if (BOTH(7)) GRID_BAR(); }
    if (IN(8)) { attn_phase(F); if (BOTH(8)) GRID_BAR(); }
    if (IN(9)) { { SmRes<true> Es{nullptr, (const bf16*)(ws + WS_HB), (bf16*)(ws + WS_HB), (float*)(ws + WS_SSQP2)}; small_tile_phase(F, (const bf16*)(ws + WS_OB), (const bf16*)(ws + WS_WCO), 1024, Es); }
        pg8::Gemm g{(const bf16*)(ws + WS_OB), (const bf16*)(ws + WS_WCO), TP, 1024, 1024}; pg8::StaticOrder S; S.init(TP, 1024, F.G, (int)blockIdx.x);
        pg8::EpiRes<true> E{nullptr, nullptr, (const bf16*)(ws + WS_HB), (bf16*)(ws + WS_HB), (float*)(ws + WS_SSQP2)};
        pg8::gemm_phase<pg8::EpiRes<true>, pg8::StaticOrder, true, true>(F.lds + RING_OFF, g, S, E);
        if (BOTH(9)) GRID_BAR(); }
    if (IN(10)) { pg8::Gemm g{(const bf16*)(ws + WS_HB), (const bf16*)(ws + WS_WGU), T, 2 * FFN, 1024}; pg8::StaticOrder S; S.init(T, 2 * FFN, F.G, (int)blockIdx.x);
        pg8::EpiSwiglu E{(bf16*)(ws + WS_ACT), (const float*)(ws + WS_SSQP2)};
        pg8::gemm_phase<pg8::EpiSwiglu, pg8::StaticOrder, true, true>(F.lds + RING_OFF, g, S, E);
        if (BOTH(10)) GRID_BAR(); }
    if (IN(11)) { { SmRes<true> Es{nullptr, (const bf16*)(ws + WS_HB), (bf16*)(ws + WS_HB), (float*)(ws + WS_SSQP3)}; small_tile_phase(F, (const bf16*)(ws + WS_ACT), (const bf16*)(ws + WS_WDN), FFN, Es); }
        pg8::Gemm g{(const bf16*)(ws + WS_ACT), (const bf16*)(ws + WS_WDN), TP, 1024, FFN}; pg8::StaticOrder S; S.init(TP, 1024, F.G, (int)blockIdx.x);
        pg8::EpiRes<true> E{nullptr, nullptr, (const bf16*)(ws + WS_HB), (bf16*)(ws + WS_HB), (float*)(ws + WS_SSQP3)};
        pg8::gemm_phase<pg8::EpiRes<true>, pg8::StaticOrder, true, true>(F.lds + RING_OFF, g, S, E);
        if (BOTH(11)) GRID_BAR(); }
    if (IN(12)) final_norm_phase(F);
#undef IN
#undef BOTH
}

extern "C" void kernel_launch(void* const* d_in, const int* in_sizes, int n_in, void* d_out, int out_size, void* d_ws, size_t ws_size, hipStream_t stream) {
    static int grid = 0;
    if (grid == 0) {
        const int want[32] = {TP * 1024, TS * 1024, MEMR * 1024, 33554432, 1179648, 16777216, 33554432, 33554432, 1024, 1024 * 11296, 4 * 3072, 3072, 32, 32, 32, 2048, 2048 * 1024, 2048, 1024,
                              1024 * 1024, 1024 * 1024, 1024, 1024, 1024 * 1024, 1024 * 1024, 1024 * 1024, 1024 * 1024, 1024, 1024 * FFN, 1024 * FFN, FFN * 1024, 1024};
        bool ok = (n_in == 32); for (int i = 0; ok && i < 32; ++i) if (in_sizes[i] != want[i]) { fprintf(stderr, "kernel_launch: input %d has %d elements, expected %d\n", i, in_sizes[i], want[i]); ok = false; }
        if (!ok || out_size != (int)O_END || ws_size < WS_END4) { fprintf(stderr, "kernel_launch: unexpected shapes: n_in %d out %d ws %zu\n", n_in, out_size, ws_size); grid = -1; return; }
        int dev = 0, cus = 0, per_cu = 0;
        if (hipGetDevice(&dev) != hipSuccess || hipDeviceGetAttribute(&cus, hipDeviceAttributeMultiprocessorCount, dev) != hipSuccess) { grid = -1; return; }
        if (hipFuncSetAttribute((const void*)skel_fwd, hipFuncAttributeMaxDynamicSharedMemorySize, LDS_BYTES) != hipSuccess) { fprintf(stderr, "kernel_launch: hipFuncSetAttribute failed\n"); grid = -1; return; }
        if (hipOccupancyMaxActiveBlocksPerMultiprocessor(&per_cu, (const void*)skel_fwd, NTHR, LDS_BYTES) != hipSuccess || per_cu < 1) fprintf(stderr, "kernel_launch: occupancy query reports %d blocks per CU\n", per_cu);
        (void)hipGetLastError();
        grid = cus;
    }
    if (grid < 0) return;
    (void)hipMemsetAsync((char*)d_ws + WS_CTL, 0, CTL_ZERO_BYTES, stream);
    Args a{};
    for (int i = 0; i < 32; ++i) a.in[i] = (const float*)d_in[i];
    a.out = (float*)d_out; a.ws = (unsigned char*)d_ws;
    for (int li = 0; li < N_LAUNCHES; ++li) {
        a.ph_lo = (N_LAUNCHES == PER_PHASE) ? li : 0; a.ph_hi = (N_LAUNCHES == PER_PHASE) ? li + 1 : PER_PHASE;
        hipLaunchKernelGGL(skel_fwd, dim3(grid), dim3(NTHR), LDS_BYTES, stream, a);
    }
}
```

```cpp
#include <hip/hip_runtime.h>
#include <cstdio>
#include <cstdint>
namespace pg8 {
#define PG8_LAS __attribute__((address_space(3)))
typedef unsigned short bf16_t;
typedef short bf16x8 __attribute__((ext_vector_type(8)));
typedef float f32x4 __attribute__((ext_vector_type(4)));
typedef unsigned u32x4 __attribute__((ext_vector_type(4)));
constexpr int BM = 256, BK = 64, HALF = 128, HTB = HALF * BK * 2  , STAGE_BYTES = 8 * HTB, NXCD = 8, WGM = 8;

__host__ __device__ __forceinline__ int lds_byte(int r, int c) { const int st = (r >> 4) * 2 + (c >> 5), rr = r & 15, cc = c & 31, ob = rr * 64 + cc * 2; return st * 1024 + (ob ^ (((ob >> 9) & 1) << 5)); }
__host__ __device__ __forceinline__ void stage_rc(int b, int& R, int& C) { const int st = b / 1024, sb = b % 1024, swz = sb ^ (((sb >> 9) & 1) << 5); R = (st >> 1) * 16 + swz / 64; C = (st & 1) * 32 + (swz % 64) / 2; }
__host__ __device__ __forceinline__ int perm32(int rho) { const int n = rho >> 4, i = rho & 15; return 8 * (i >> 2) + 4 * n + (i & 3); }

struct Unit { int pm, pn; };
struct Gemm { const bf16_t* A; const bf16_t* Bt; int M, N, K; };

struct StaticOrder {
    int nM, nN, nwg, G, c;
    __host__ __device__ void init(int M, int N, int G_, int c_) { nM = M / BM; nN = N / BM; nwg = nM * nN; G = G_; c = c_; }
    __host__ __device__ bool next(int i, Unit& u) const {
        const long L = (long)i * G + c; if (L >= nwg) return false;
        int wgid = (int)L; { const int q = nwg / NXCD, r = nwg % NXCD, xcd = wgid % NXCD, off = wgid / NXCD; wgid = (xcd < r ? xcd * (q + 1) : r * (q + 1) + (xcd - r) * q) + off; }
        const int nig = WGM * nN, gid = wgid / nig, fm = gid * WGM, gsz = (nM - fm) < WGM ? (nM - fm) : WGM;
        u.pm = fm + ((wgid % nig) % gsz); u.pn = (wgid % nig) / gsz; return true;
    }
    __device__ __forceinline__ void a_ready(const Unit&) const {}
    __device__ __forceinline__ void done(const Unit&) const {}
};

__device__ __forceinline__ unsigned cvt_pk_bf16(float lo, float hi) { unsigned r; asm volatile("v_cvt_pk_bf16_f32 %0, %1, %2" : "=v"(r) : "v"(lo), "v"(hi)); return r; }
typedef float f32x2 __attribute__((ext_vector_type(2)));
typedef unsigned u32x2 __attribute__((ext_vector_type(2)));
constexpr float RMS_EPS = 1e-6f;
__device__ __forceinline__ float bfbits2f(unsigned v16) { return __uint_as_float(v16 << 16); }
__device__ __forceinline__ float sigm(float x) { return __builtin_amdgcn_rcpf(1.0f + __expf(-x)); }
template <int NP> __device__ __forceinline__ float row_rs(const float* ssq, int row) {
    float s = 0.f;
    if constexpr (NP == 1) s = ssq[row];
    else {
#pragma unroll
        for (int i = 0; i < NP / 4; ++i) { const f32x4 v = *(const f32x4*)(ssq + (size_t)row * NP + 4 * i); s += (v[0] + v[1]) + (v[2] + v[3]); }
    }
    return 1.0f / sqrtf(s * (1.0f / 1024.0f) + RMS_EPS);
}
template <int NP, bool HAS_DT> struct EpiScaleBf16 {
    static constexpr bool PERM = true, AFTER_DRAIN = false;
    bf16_t* O; size_t slot_elems; const float* ssq; float scale; float* dt;
    __device__ __forceinline__ void operator()(const f32x4 (&acc)[2][2][4][2], const Unit& u, int wr, int wc, int fr, int fq) const {
        const int row0 = u.pm * BM + wr * 64 + fr;
        if (HAS_DT && u.pn == 44) {
            if (wc == 0) {
#pragma unroll
                for (int ai = 0; ai < 2; ++ai)
#pragma unroll
                    for (int m = 0; m < 4; ++m) { const int row = row0 + ai * HALF + m * 16; float rs = 1.0f; if constexpr (NP > 0) rs = row_rs<NP>(ssq, row);
                        float* p = dt + (size_t)row * 32 + 8 * fq; *(f32x4*)p = acc[ai][0][m][0] * rs; *(f32x4*)(p + 4) = acc[ai][0][m][1] * rs; }
            }
            return;
        }
        bf16_t* base = O + (size_t)(u.pn >> 2) * slot_elems; const int col0 = (u.pn & 3) * BM + wc * 32 + 8 * fq;
#pragma unroll
        for (int ai = 0; ai < 2; ++ai)
#pragma unroll
            for (int m = 0; m < 4; ++m) { const int row = row0 + ai * HALF + m * 16; float rs = scale; if constexpr (NP > 0) rs = row_rs<NP>(ssq, row) * scale; bf16_t* rowp = base + (size_t)row * 1024 + col0;
#pragma unroll
                for (int bj = 0; bj < 2; ++bj) { const f32x4 v0 = acc[ai][bj][m][0] * rs, v1 = acc[ai][bj][m][1] * rs;
                    u32x4 w; w.x = cvt_pk_bf16(v0[0], v0[1]); w.y = cvt_pk_bf16(v0[2], v0[3]); w.z = cvt_pk_bf16(v1[0], v1[1]); w.w = cvt_pk_bf16(v1[2], v1[3]);
                    if (HAS_DT) __builtin_nontemporal_store(w, (u32x4*)(rowp + bj * HALF));
                    else *(u32x4*)(rowp + bj * HALF) = w; } }
    }
};
struct EpiKV {
    static constexpr bool PERM = false, AFTER_DRAIN = false;
    float* mk; float* mv; bf16_t* kb; bf16_t* vt; const float* ssq;
    __device__ __forceinline__ void operator()(const f32x4 (&acc)[2][2][4][2], const Unit& u, int wr, int wc, int fr, int fq) const {
        const int row0 = u.pm * BM + wr * 64 + fr; const bool isv = u.pn >= 4; const int colt = (u.pn & 3) * BM + wc * 32 + 4 * fq;
#pragma unroll
        for (int ai = 0; ai < 2; ++ai)
#pragma unroll
            for (int m = 0; m < 4; ++m) { const int row = row0 + ai * HALF + m * 16; const float rs = 1.0f;
#pragma unroll
                for (int bj = 0; bj < 2; ++bj)
#pragma unroll
                    for (int n = 0; n < 2; ++n) { const int c = colt + bj * HALF + n * 16; const f32x4 v = acc[ai][bj][m][n] * rs;
                        if (!isv) { __builtin_nontemporal_store(v, (f32x4*)(mk + (size_t)row * 1024 + c)); u32x2 w; w.x = cvt_pk_bf16(v[0], v[1]); w.y = cvt_pk_bf16(v[2], v[3]); *(u32x2*)(kb + (size_t)row * 1024 + c) = w; }
                        else { __builtin_nontemporal_store(v, (f32x4*)(mv + (size_t)row * 1024 + c)); const int b = row >> 8, key = row & 255, hd = c >> 8, d = c & 255;
                            bf16_t* p = vt + ((size_t)((b * 4 + hd) * 256 + d)) * 256 + key; const unsigned w0 = cvt_pk_bf16(v[0], v[1]), w1 = cvt_pk_bf16(v[2], v[3]);
                            p[0] = (bf16_t)(w0 & 0xffffu); p[256] = (bf16_t)(w0 >> 16); p[512] = (bf16_t)(w1 & 0xffffu); p[768] = (bf16_t)(w1 >> 16); } } }
    }
};
template <bool ADD> struct EpiGate {
    static constexpr bool PERM = true, AFTER_DRAIN = false;
    bf16_t* O; const bf16_t* gate;
    __device__ __forceinline__ void operator()(const f32x4 (&acc)[2][2][4][2], const Unit& u, int wr, int wc, int fr, int fq) const {
        const int row0 = u.pm * BM + wr * 64 + fr, col0 = u.pn * BM + wc * 32 + 8 * fq;
#pragma unroll
        for (int ai = 0; ai < 2; ++ai)
#pragma unroll
            for (int m = 0; m < 4; ++m) { const size_t off = (size_t)(row0 + ai * HALF + m * 16) * 1024 + col0;
#pragma unroll
                for (int bj = 0; bj < 2; ++bj) { const u32x4 gw = __builtin_nontemporal_load((const u32x4*)(gate + off + bj * HALF)); u32x4 ow = (u32x4){0u, 0u, 0u, 0u}; if (ADD) ow = *(const u32x4*)(O + off + bj * HALF);
                    float r[8];
#pragma unroll
                    for (int e = 0; e < 8; ++e) { const unsigned g16 = (gw[e >> 1] >> ((e & 1) * 16)) & 0xffffu, o16 = (ow[e >> 1] >> ((e & 1) * 16)) & 0xffffu;
                        const float a = acc[ai][bj][m][e >> 2][e & 3]; r[e] = (ADD ? bfbits2f(o16) : 0.f) + sigm(bfbits2f(g16)) * a; }
                    u32x4 w; w.x = cvt_pk_bf16(r[0], r[1]); w.y = cvt_pk_bf16(r[2], r[3]); w.z = cvt_pk_bf16(r[4], r[5]); w.w = cvt_pk_bf16(r[6], r[7]);
                    *(u32x4*)(O + off + bj * HALF) = w; } }
    }
};
template <bool BF, bool BSC = false> struct EpiRes {
    static constexpr bool PERM = true, AFTER_DRAIN = false;
    const float* base0; const float* base1; const bf16_t* bb; bf16_t* hb; float* ssqp; const float* bsc;
    __device__ __forceinline__ void operator()(const f32x4 (&acc)[2][2][4][2], const Unit& u, int wr, int wc, int fr, int fq) const {
        const int row0 = u.pm * BM + wr * 64 + fr, col0 = u.pn * BM + wc * 32 + 8 * fq; const float* base = u.pm < 64 ? base0 : base1;
#pragma unroll
        for (int ai = 0; ai < 2; ++ai)
#pragma unroll
            for (int m = 0; m < 4; ++m) { const int row = row0 + ai * HALF + m * 16; const size_t off = (size_t)row * 1024 + col0; float sq = 0.f; float bs = 1.0f; if constexpr (BSC) bs = bsc[row];
#pragma unroll
                for (int bj = 0; bj < 2; ++bj) { const size_t o2 = off + bj * HALF; f32x4 b0, b1;
                    if (BF) { const u32x4 w = *(const u32x4*)(bb + o2); b0 = (f32x4){bfbits2f(w.x & 0xffffu), __uint_as_float(w.x & 0xffff0000u), bfbits2f(w.y & 0xffffu), __uint_as_float(w.y & 0xffff0000u)};
                        b1 = (f32x4){bfbits2f(w.z & 0xffffu), __uint_as_float(w.z & 0xffff0000u), bfbits2f(w.w & 0xffffu), __uint_as_float(w.w & 0xffff0000u)}; }
                    else { b0 = __builtin_nontemporal_load((const f32x4*)(base + o2)); b1 = __builtin_nontemporal_load((const f32x4*)(base + o2 + 4)); }
                    if constexpr (BSC) { b0 = b0 * bs; b1 = b1 * bs; }
                    const f32x4 v0 = b0 + acc[ai][bj][m][0], v1 = b1 + acc[ai][bj][m][1];
                    sq += ((v0[0] * v0[0] + v0[1] * v0[1]) + (v0[2] * v0[2] + v0[3] * v0[3])) + ((v1[0] * v1[0] + v1[1] * v1[1]) + (v1[2] * v1[2] + v1[3] * v1[3]));
                    u32x4 w; w.x = cvt_pk_bf16(v0[0], v0[1]); w.y = cvt_pk_bf16(v0[2], v0[3]); w.z = cvt_pk_bf16(v1[0], v1[1]); w.w = cvt_pk_bf16(v1[2], v1[3]); *(u32x4*)(hb + o2) = w; }
                sq += __shfl_xor(sq, 16); sq += __shfl_xor(sq, 32);
                if (fq == 0) ssqp[(size_t)row * 16 + u.pn * 4 + wc] = sq; }
    }
};
struct EpiSwiglu {
    static constexpr bool PERM = true, AFTER_DRAIN = false;
    bf16_t* act; const float* ssq;
    __device__ __forceinline__ void operator()(const f32x4 (&acc)[2][2][4][2], const Unit& u, int wr, int wc, int fr, int fq) const {
        const int row0 = u.pm * BM + wr * 64 + fr, col0 = u.pn * 128 + wc * 16 + 4 * fq;
#pragma unroll
        for (int ai = 0; ai < 2; ++ai)
#pragma unroll
            for (int m = 0; m < 4; ++m) { const int row = row0 + ai * HALF + m * 16; const float rs = row_rs<16>(ssq, row);
#pragma unroll
                for (int bj = 0; bj < 2; ++bj) { const f32x4 a = acc[ai][bj][m][0] * rs, b = acc[ai][bj][m][1] * rs;
                    const float r0 = a[0] * sigm(a[0]) * a[1], r1 = a[2] * sigm(a[2]) * a[3], r2 = b[0] * sigm(b[0]) * b[1], r3 = b[2] * sigm(b[2]) * b[3];
                    u32x2 w; w.x = cvt_pk_bf16(r0, r1); w.y = cvt_pk_bf16(r2, r3); *(u32x2*)(act + (size_t)row * 2816 + col0 + bj * 64) = w; } }
    }
};
template <class Epi, class Sched, bool ALIGN_EPI = false, bool SP2 = false, int EPI_REP = 1>
__device__ __forceinline__ void gemm_phase(PG8_LAS unsigned char* lds, const Gemm g, const Sched& S, const Epi& E) {
    const int tid = threadIdx.x, wid = __builtin_amdgcn_readfirstlane(tid >> 6), lane = tid & 63, wr = wid >> 2, wc = wid & 3, fr = lane & 15, fq = lane >> 4;
    const int K = g.K, nt = K / BK;
    unsigned voffA[2], voffB[2];
#pragma unroll
    for (int i = 0; i < 2; ++i) { int R, C; stage_rc(tid * 16 + i * 8192, R, C); const int Rb = Epi::PERM ? ((R & ~31) + perm32(R & 31)) : R;
        voffA[i] = (unsigned)(R * K + C) * 2u; voffB[i] = (unsigned)(Rb * K + C) * 2u; }
    const size_t kstep = (size_t)(BK * 2);
    const size_t hstep = (size_t)HALF * K * 2;
    const size_t tstep = 2 * hstep;
    const unsigned ldsw = (unsigned)wid * 1024u;
    const int aoff = lds_byte(wr * 64 + fr, fq * 8), boff = lds_byte(wc * 32 + fr, fq * 8);
#define PG8_SA(b, h) (((b) * 2 + (h)) * HTB)
#define PG8_SB(b, h) ((4 + (b) * 2 + (h)) * HTB)
#define PG8_STAGE(bufoff, gbase, voff) do { _Pragma("unroll") for (int _i = 0; _i < 2; ++_i) \
        __builtin_amdgcn_global_load_lds((const unsigned*)((const char*)(gbase) + (voff)[_i]), (PG8_LAS unsigned*)(lds + (bufoff) + ldsw + _i * 8192), 16, 0, 0); } while (0)
#define PG8_LDA(dst, b, h) do { _Pragma("unroll") for (int m = 0; m < 4; ++m) _Pragma("unroll") for (int k = 0; k < 2; ++k) dst[m][k] = *(const PG8_LAS bf16x8*)(lds + PG8_SA(b, h) + aoff + m * 2048 + k * 1024); } while (0)
#define PG8_LDB(dst, b, h) do { _Pragma("unroll") for (int n = 0; n < 2; ++n) _Pragma("unroll") for (int k = 0; k < 2; ++k) dst[n][k] = *(const PG8_LAS bf16x8*)(lds + PG8_SB(b, h) + boff + n * 2048 + k * 1024); } while (0)
#define PG8_MMA(ai, bj, At, Bt) do { __builtin_amdgcn_s_setprio(1); _Pragma("unroll") for (int m = 0; m < 4; ++m) _Pragma("unroll") for (int n = 0; n < 2; ++n) _Pragma("unroll") for (int k = 0; k < 2; ++k) \
        acc[ai][bj][m][n] = __builtin_amdgcn_mfma_f32_16x16x32_bf16(Bt[n][k], At[m][k], acc[ai][bj][m][n], 0, 0, 0); __builtin_amdgcn_s_setprio(0); } while (0)
#define PG8_WAIT_V(n) asm volatile("s_waitcnt vmcnt(" #n ")" ::: "memory")
#define PG8_WAIT_L(n) asm volatile("s_waitcnt lgkmcnt(" #n ")" ::: "memory")
#define PG8_BAR __builtin_amdgcn_s_barrier()
#define PG8_SCHED __builtin_amdgcn_sched_barrier(0)
    Unit cur, nxt; int ui = 0;
    if (!S.next(0, cur)) return;
    f32x4 acc[2][2][4][2];
#pragma unroll
    for (int a = 0; a < 2; ++a)
#pragma unroll
        for (int b = 0; b < 2; ++b)
#pragma unroll
            for (int m = 0; m < 4; ++m)
#pragma unroll
                for (int n = 0; n < 2; ++n) acc[a][b][m][n] = (f32x4){0.f, 0.f, 0.f, 0.f};
    bf16x8 At[4][2], B0[2][2], B1[2][2];
    const char* cA = (const char*)g.A + (size_t)cur.pm * tstep; const char* cB = (const char*)g.Bt + (size_t)cur.pn * tstep;
    S.a_ready(cur);
    if constexpr (SP2) {
        PG8_STAGE(PG8_SB(0, 0), cB, voffB); PG8_STAGE(PG8_SB(0, 1), cB + hstep, voffB); PG8_STAGE(PG8_SA(0, 0), cA, voffA); PG8_STAGE(PG8_SA(0, 1), cA + hstep, voffA);
        if (wr == 1) PG8_BAR;
        PG8_WAIT_V(2); PG8_BAR;
        PG8_STAGE(PG8_SB(1, 0), cB + kstep, voffB); PG8_STAGE(PG8_SA(1, 0), cA + kstep, voffA); PG8_STAGE(PG8_SB(1, 1), cB + hstep + kstep, voffB);
        PG8_WAIT_V(6); PG8_BAR;
    } else {
        PG8_STAGE(PG8_SB(0, 0), cB, voffB); PG8_STAGE(PG8_SA(0, 0), cA, voffA); PG8_STAGE(PG8_SB(0, 1), cB + hstep, voffB); PG8_STAGE(PG8_SA(0, 1), cA + hstep, voffA);
        if (wr == 1) PG8_BAR;
        PG8_WAIT_V(4); PG8_BAR;
        PG8_STAGE(PG8_SB(1, 0), cB + kstep, voffB); PG8_STAGE(PG8_SA(1, 0), cA + kstep, voffA); PG8_STAGE(PG8_SB(1, 1), cB + hstep + kstep, voffB);
        PG8_WAIT_V(6); PG8_BAR;
    }
    for (;;) {
        const bool has_next = S.next(ui + 1, nxt);
        const char* nA = has_next ? (const char*)g.A + (size_t)nxt.pm * tstep : cA; const char* nB = has_next ? (const char*)g.Bt + (size_t)nxt.pn * tstep : cB;
        for (int t = 0; t < nt; t += 2) {
            const bool last = (t == nt - 2);
            const char* a1 = cA + (size_t)(t + 1) * kstep;
            const char* a2 = last ? nA : cA + (size_t)(t + 2) * kstep; const char* b2 = last ? nB : cB + (size_t)(t + 2) * kstep;
            const char* a3 = a2 + kstep; const char* b3 = b2 + kstep;
            if (last && has_next) S.a_ready(nxt);
            if constexpr (SP2) {
            PG8_LDB(B0, 0, 0); PG8_LDB(B1, 0, 1); PG8_SCHED; PG8_LDA(At, 0, 0); PG8_STAGE(PG8_SA(1, 1), a1 + hstep, voffA);
            PG8_WAIT_V(8); PG8_WAIT_L(0); PG8_BAR; PG8_MMA(0, 0, At, B0); PG8_MMA(0, 1, At, B1); PG8_BAR; PG8_SCHED;
            PG8_LDA(At, 0, 1); PG8_STAGE(PG8_SB(0, 0), b2, voffB); PG8_STAGE(PG8_SB(0, 1), b2 + hstep, voffB); PG8_STAGE(PG8_SA(0, 0), a2, voffA);
            PG8_WAIT_V(8); PG8_WAIT_L(0); PG8_BAR; PG8_MMA(1, 0, At, B0); PG8_MMA(1, 1, At, B1); PG8_BAR; PG8_SCHED;
            PG8_LDB(B0, 1, 0); PG8_LDB(B1, 1, 1); PG8_SCHED; PG8_LDA(At, 1, 0); PG8_STAGE(PG8_SA(0, 1), a2 + hstep, voffA);
            PG8_WAIT_V(8); PG8_WAIT_L(0); PG8_BAR; PG8_MMA(0, 0, At, B0); PG8_MMA(0, 1, At, B1); PG8_BAR; PG8_SCHED;
            PG8_LDA(At, 1, 1); PG8_STAGE(PG8_SB(1, 0), b3, voffB); PG8_STAGE(PG8_SB(1, 1), b3 + hstep, voffB); PG8_STAGE(PG8_SA(1, 0), a3, voffA);
            PG8_WAIT_V(8); PG8_WAIT_L(0); PG8_BAR; PG8_MMA(1, 0, At, B0); PG8_MMA(1, 1, At, B1); PG8_BAR; PG8_SCHED;
            } else {
            PG8_LDB(B0, 0, 0); PG8_SCHED; PG8_LDA(At, 0, 0); PG8_STAGE(PG8_SA(1, 1), a1 + hstep, voffA);
            PG8_WAIT_L(8); PG8_BAR; PG8_WAIT_L(0); PG8_MMA(0, 0, At, B0); PG8_BAR; PG8_SCHED;
            PG8_LDB(B1, 0, 1); PG8_STAGE(PG8_SB(0, 0), b2, voffB);
            PG8_BAR; PG8_WAIT_L(0); PG8_MMA(0, 1, At, B1); PG8_BAR;
            PG8_LDA(At, 0, 1); PG8_STAGE(PG8_SA(0, 0), a2, voffA);
            PG8_BAR; PG8_WAIT_L(0); PG8_MMA(1, 0, At, B0); PG8_BAR; PG8_SCHED;
            PG8_STAGE(PG8_SB(0, 1), b2 + hstep, voffB);
            PG8_WAIT_V(6); PG8_BAR; PG8_MMA(1, 1, At, B1); PG8_BAR;
            PG8_LDB(B0, 1, 0); PG8_SCHED; PG8_LDA(At, 1, 0); PG8_STAGE(PG8_SA(0, 1), a2 + hstep, voffA);
            PG8_WAIT_L(8); PG8_BAR; PG8_WAIT_L(0); PG8_MMA(0, 0, At, B0); PG8_BAR; PG8_SCHED;
            PG8_LDB(B1, 1, 1); PG8_STAGE(PG8_SB(1, 0), b3, voffB);
            PG8_BAR; PG8_WAIT_L(0); PG8_MMA(0, 1, At, B1); PG8_BAR;
            PG8_LDA(At, 1, 1); PG8_STAGE(PG8_SA(1, 0), a3, voffA);
            PG8_BAR; PG8_WAIT_L(0); PG8_MMA(1, 0, At, B0); PG8_BAR; PG8_SCHED;
            PG8_STAGE(PG8_SB(1, 1), b3 + hstep, voffB);
            PG8_WAIT_V(6); PG8_BAR; PG8_MMA(1, 1, At, B1); PG8_BAR;
            }
        }
        if constexpr (ALIGN_EPI) { if (wr == 0) PG8_BAR; }
        if constexpr (!Epi::AFTER_DRAIN) { for (int rep = 0; rep < EPI_REP; ++rep) { E(acc, cur, wr, wc, fr, fq); asm volatile("" ::: "memory"); } S.done(cur); }
        if (!has_next) break;
#pragma unroll
        for (int a = 0; a < 2; ++a)
#pragma unroll
            for (int b = 0; b < 2; ++b)
#pragma unroll
                for (int m = 0; m < 4; ++m)
#pragma unroll
                    for (int n = 0; n < 2; ++n) acc[a][b][m][n] = (f32x4){0.f, 0.f, 0.f, 0.f};
        cur = nxt; cA = nA; cB = nB; ++ui;
        if constexpr (ALIGN_EPI) { if (wr == 1) PG8_BAR; }
    }
    PG8_WAIT_V(0);
    if constexpr (!ALIGN_EPI) { if (wr == 0) PG8_BAR; }
    PG8_BAR;
    if constexpr (Epi::AFTER_DRAIN) { E.fused(acc, cur, wr, wc, fr, fq, lds, wid, lane); S.done(cur); }
#undef PG8_SA
#undef PG8_SB
#undef PG8_STAGE
#undef PG8_LDA
#undef PG8_LDB
#undef PG8_MMA
#undef PG8_WAIT_V
#undef PG8_WAIT_L
#undef PG8_BAR
#undef PG8_SCHED
}
}
#define GAS __attribute__((address_space(1)))
#define LAS __attribute__((address_space(3)))
typedef unsigned short bf16;
typedef unsigned v4u __attribute__((ext_vector_type(4)));
typedef float f32x4 __attribute__((ext_vector_type(4)));
typedef short bf16x8 __attribute__((ext_vector_type(8)));
typedef GAS unsigned gu32;
typedef GAS unsigned long long gu64;
#define RLX_AGENT __ATOMIC_RELAXED, __HIP_MEMORY_SCOPE_AGENT
#define LDS_WAIT() asm volatile("s_waitcnt lgkmcnt(0)" ::: "memory")
#define VM_WAIT() asm volatile("s_waitcnt vmcnt(0)" ::: "memory")
__device__ __forceinline__ unsigned long long rt() { return __builtin_amdgcn_s_memrealtime(); }
typedef float f32x2_t __attribute__((ext_vector_type(2))); typedef __bf16 bf16x2_t __attribute__((ext_vector_type(2)));
__device__ __forceinline__ unsigned pk2(float lo, float hi) { const f32x2_t v = {lo, hi}; const bf16x2_t b = __builtin_convertvector(v, bf16x2_t); return __builtin_bit_cast(unsigned, b); }
__device__ __forceinline__ unsigned f2bf(float f) { return pk2(f, 0.f) & 0xffffu; }

#define XB_TMO      128
#define XB_XCNT(j)  (256  + 64 * (j))
#define XB_XSUB(j)  (1280 + 64 * (j))
#define XB_XGEN(j)  (2304 + 64 * (j))
#define XB_TOP      3328
#define XB_TOPGEN   3392
#define XCD_BAR_WORDS 3456
#define XB_SPIN_CAP (1u << 18)

__device__ __forceinline__ unsigned xb_ld(unsigned* p)              { return __hip_atomic_load(p, __ATOMIC_RELAXED, __HIP_MEMORY_SCOPE_AGENT); }
__device__ __forceinline__ unsigned xb_add(unsigned* p, unsigned v) { return __hip_atomic_fetch_add(p, v, __ATOMIC_RELAXED, __HIP_MEMORY_SCOPE_AGENT); }
__device__ __forceinline__ unsigned xb_xcc_id() { return (unsigned)__builtin_amdgcn_s_getreg((3 << 11) | 20) & 0xFu; }
#define XB_SPIN(cond, bar) do { unsigned _sp = 0; while (cond) { __builtin_amdgcn_s_sleep(1); \
    if ((++_sp & 255u) == 0u) { if (xb_ld(&(bar)[XB_TMO])) break; if (_sp > XB_SPIN_CAP) { atomicAdd(&(bar)[XB_TMO], 1u); break; } } } } while (0)

struct XcdBarrier {
    unsigned* bar; unsigned x;
    volatile LAS unsigned* st;
};

__device__ __forceinline__ XcdBarrier xcd_barrier_post(unsigned* bar, volatile LAS unsigned* st) {
    XcdBarrier b; b.bar = bar; b.x = xb_xcc_id(); b.st = st;
    if (threadIdx.x == 0) (void)xb_add(&bar[XB_XCNT(b.x)], 1u);
    return b;
}
__device__ __forceinline__ void xcd_barrier_complete(unsigned* bar, unsigned x, unsigned& nloc, unsigned& nx) {
    const unsigned G = gridDim.x * gridDim.y * gridDim.z;
    unsigned sum, cnt, mine, sp = 0u;
    for (;;) {
        sum = 0u; cnt = 0u; mine = 0u;
#pragma unroll
        for (unsigned j = 0; j < 16; ++j) { const unsigned c = xb_ld(&bar[XB_XCNT(j)]); sum += c; cnt += (c > 0u) ? 1u : 0u; mine = (j == x) ? c : mine; }
        if (sum == G) break;
        __builtin_amdgcn_s_sleep(1);
        if ((++sp & 255u) == 0u) { if (xb_ld(&bar[XB_TMO])) break; if (sp > XB_SPIN_CAP) { atomicAdd(&bar[XB_TMO], 1u); break; } }
    }
    nloc = mine > 0u ? mine : 1u; nx = cnt > 0u ? cnt : 1u;
}

__device__ __forceinline__ void xcd_barrier(const XcdBarrier& b) {
    asm volatile("s_waitcnt vmcnt(0)" ::: "memory");
    __syncthreads();
    if (threadIdx.x == 0) {
        unsigned* bar = b.bar;
        __builtin_amdgcn_s_waitcnt(0);
        unsigned nloc = b.st[0], nx = b.st[1];
        if (nloc == 0u) { xcd_barrier_complete(bar, b.x, nloc, nx); b.st[0] = nloc; b.st[1] = nx; }
        const unsigned old = xb_add(&bar[XB_XSUB(b.x)], 1u);
        const unsigned gen = old / nloc;
        if (old + 1u == (gen + 1u) * nloc) {
            __builtin_amdgcn_fence(__ATOMIC_RELEASE, "agent");
            asm volatile("s_waitcnt vmcnt(0)" ::: "memory");
            const unsigned og = xb_add(&bar[XB_TOP], 1u);
            const unsigned tg = og / nx;
            if (og + 1u == (tg + 1u) * nx) xb_add(&bar[XB_TOPGEN], 1u);
            else XB_SPIN(xb_ld(&bar[XB_TOPGEN]) == tg, bar);
            __builtin_amdgcn_fence(__ATOMIC_ACQUIRE, "agent");
            xb_add(&bar[XB_XGEN(b.x)], 1u);
            asm volatile("s_waitcnt vmcnt(0)" ::: "memory");
        } else {
            XB_SPIN(xb_ld(&bar[XB_XGEN(b.x)]) == gen, bar);
            __builtin_amdgcn_fence(__ATOMIC_ACQUIRE, "agent");
            asm volatile("s_waitcnt vmcnt(0)" ::: "memory");
        }
    }
    __syncthreads();
}
typedef unsigned v2u __attribute__((ext_vector_type(2)));
constexpr int NWAVES = 8, NTHR = 512;
constexpr int DM = 1024, TP = 16384, TS = 512, T = TP + TS;
constexpr int SEQ = 2048, NBP = 8, NBS = 128, LS = 4, MEMR = 2048;
constexpr int NPROJ = 11520;
constexpr int FFN = 2816;
constexpr float EPS = 1e-6f;
constexpr float QSCALE = 0.0625f * 1.4426950408889634f;

constexpr size_t MiB = 1u << 20;
constexpr size_t WS_CTL = 0, CTL_ZERO_BYTES = 32768;
constexpr size_t WS_SSQX = 1 * MiB, WS_SSQM = 1 * MiB + 512 * 1024;
constexpr size_t WS_DT = 2 * MiB, WS_SSQSSD = 5 * MiB, WS_SSQP1 = 8 * MiB, WS_SSQP2 = 9 * MiB + 512 * 1024, WS_SSQP3 = 11 * MiB;
constexpr size_t WS_WIN = 13 * MiB, WS_WKV = 36 * MiB, WS_WSSD = 40 * MiB, WS_WHG = 44 * MiB, WS_WOUT = 46 * MiB, WS_WCQ = 48 * MiB, WS_WCO = 50 * MiB, WS_WGU = 52 * MiB, WS_WDN = 63 * MiB;
constexpr size_t WS_XB = 69 * MiB, WS_MNB = 102 * MiB, WS_KB = 106 * MiB, WS_VT = 110 * MiB;
constexpr size_t SLOT = 33 * MiB, SLOT_ELEMS = (size_t)T * 1024;
constexpr size_t WS_PROJ = 114 * MiB;
constexpr size_t WS_YG = WS_PROJ + 11 * SLOT, WS_ON = WS_YG + 2 * SLOT, WS_END = WS_ON + SLOT;
static_assert(SLOT == SLOT_ELEMS * 2, "slot size");
static_assert(WS_WIN + (size_t)NPROJ * 1024 * 2 <= WS_WKV && WS_WGU + (size_t)2 * FFN * 1024 * 2 <= WS_WDN && WS_WDN + (size_t)1024 * FFN * 2 <= WS_XB && WS_SSQP3 + (size_t)T * 64 <= WS_WIN, "d_ws map");
static_assert(WS_DT + (size_t)T * 128 <= WS_SSQSSD && WS_SSQSSD + (size_t)T * 128 <= WS_SSQP1 && WS_SSQP1 + (size_t)T * 64 <= WS_SSQP2 && WS_SSQP2 + (size_t)T * 64 <= WS_SSQP3, "d_ws map 2");
enum { S_Z0 = 0, S_Z1 = 1, S_X0 = 2, S_X1 = 3, S_X2 = 4, S_Q = 5, S_F = 6, S_I = 7, S_HG = 8, S_GS = 9, S_GH = 10 };
constexpr size_t WS_MERGED = WS_PROJ + S_Q * SLOT, WS_HB = WS_PROJ + S_F * SLOT, WS_QB = WS_PROJ + S_I * SLOT, WS_OB = WS_PROJ + S_HG * SLOT, WS_ACT = WS_PROJ;
static_assert((size_t)T * FFN * 2 <= 3 * SLOT, "act overlay");
constexpr size_t O_Y = 0, O_SSMP = (size_t)T * 1024, O_CONVP = O_SSMP + 2097152, O_HGP = O_CONVP + 73728, O_MKP = O_HGP + 1048576, O_MVP = O_MKP + 2097152,
                 O_SSMS = O_MVP + 2097152, O_CONVS = O_SSMS + 33554432, O_HGS = O_CONVS + 1179648, O_END = O_HGS + 16777216;
constexpr int CW_QUEUE = 64;
constexpr int CW_BAR = 4096;
constexpr int RING_OFF = 0, RING_BYTES = 131072;
constexpr int LDS_BYTES = 147456;
constexpr int LDSCTL_OFF = LDS_BYTES - 1024, MISC_OFF = LDSCTL_OFF + 320;
struct Frame {
    LAS unsigned char* lds;
    volatile LAS unsigned* MISC;
    gu32* ctl;
    int tid, lane, wave;
    int vcu, G;
    const float* in[32];
    float* out; unsigned char* ws;
};
__device__ __forceinline__ float bf2f(unsigned v16) { return __uint_as_float(v16 << 16); }
__device__ __forceinline__ f32x4 ld_nt(const float* p) { return __builtin_nontemporal_load((const f32x4*)p); }
__device__ __forceinline__ void st_nt(float* p, f32x4 v) { __builtin_nontemporal_store(v, (f32x4*)p); }
__device__ __forceinline__ v4u ld_nt16(const void* p) { return __builtin_nontemporal_load((const v4u*)p); }
__device__ __forceinline__ unsigned ld_nt4(const void* p) { return __builtin_nontemporal_load((const unsigned*)p); }
__device__ __forceinline__ float sigmoid_f(float x) { return __builtin_amdgcn_rcpf(1.0f + __expf(-x)); }
__device__ __forceinline__ float silu_f(float x) { return x * sigmoid_f(x); }
__device__ __forceinline__ float wave_sum(float v) {
#pragma unroll
    for (int o = 1; o < 64; o <<= 1) v += __shfl_xor(v, o);
    return v;
}
__device__ __forceinline__ float wave_max(float v) {
#pragma unroll
    for (int o = 1; o < 64; o <<= 1) v = fmaxf(v, __shfl_xor(v, o));
    return v;
}
struct TSrc { const float* W; const float* W2; const float* ks; int ldw; int mode; };
__device__ __forceinline__ void p0_transpose_item(const TSrc& s, int K, int N, bf16* WT, LAS unsigned short* scr, int item, int lane) {
    const int nblk = N / 64, kb = item / nblk, nb = item % nblk, k0 = 64 * kb, n0 = 64 * nb;
    const int kr = lane >> 4, nq = lane & 15;
    const float* const Wa = s.W; const float* const Wb = s.W2;
    const float* src; int c0, cs; bool zero = false;
    if (s.mode == 2) { const float* wsel = Wa; if (nq >= 8) wsel = Wb; src = wsel + (n0 >> 1) + 4 * (nq & 7); c0 = 8 * (nq & 7) + (nq >> 3); cs = 2; }
    else { const int n = n0 + 4 * nq; c0 = 4 * nq; cs = 1;
        if (s.mode == 0) src = Wa + n;
        else if (s.mode == 1) { if (n < 5120) src = Wa + n; else if (n < 11264) src = Wa + n + 32; else if (n < 11296) src = Wa + 5120 + (n - 11264); else { src = Wa; zero = true; } }
        else { src = Wa + n; if (n >= 1024) src = Wb + (n - 1024); } }
    f32x4 v[16];
#pragma unroll
    for (int i = 0; i < 16; ++i) v[i] = zero ? (f32x4){0.f, 0.f, 0.f, 0.f} : ld_nt(src + (size_t)(k0 + 4 * i + kr) * s.ldw);
#pragma unroll
    for (int i = 0; i < 16; ++i) { const int kk = 4 * i + kr; const float sc = s.ks ? s.ks[k0 + kk] : 1.0f; const unsigned w0 = pk2(v[i].x * sc, v[i].y * sc), w1 = pk2(v[i].z * sc, v[i].w * sc);
        LAS unsigned short* d = scr + kk * 66 + c0;
        if (cs == 1) { *(LAS unsigned*)d = w0; *(LAS unsigned*)(d + 2) = w1; }
        else { d[0] = (unsigned short)(w0 & 0xffffu); d[2] = (unsigned short)(w0 >> 16); d[4] = (unsigned short)(w1 & 0xffffu); d[6] = (unsigned short)(w1 >> 16); } }
    LDS_WAIT(); asm volatile("" ::: "memory");
    const int nr = lane >> 3, kc = lane & 7;
#pragma unroll
    for (int j = 0; j < 8; ++j) { const int n = 8 * j + nr; const LAS unsigned short* p = scr + (8 * kc) * 66 + n;
        v4u o; o.x = (unsigned)p[0] | ((unsigned)p[66] << 16); o.y = (unsigned)p[2 * 66] | ((unsigned)p[3 * 66] << 16); o.z = (unsigned)p[4 * 66] | ((unsigned)p[5 * 66] << 16); o.w = (unsigned)p[6 * 66] | ((unsigned)p[7 * 66] << 16);
        *(v4u*)(WT + (size_t)(n0 + n) * K + k0 + 8 * kc) = o; }
    LDS_WAIT(); asm volatile("" ::: "memory");
}
__device__ __forceinline__ void rows4_to_bf16_ssq(const float* x0, bf16* o0, float* ssq0, int lane) {
    f32x4 v[4][4];
#pragma unroll
    for (int rr = 0; rr < 4; ++rr)
#pragma unroll
        for (int j = 0; j < 4; ++j) v[rr][j] = ld_nt(x0 + rr * 1024 + 4 * (64 * j + lane));
#pragma unroll
    for (int rr = 0; rr < 4; ++rr) { float sq = 0.f;
#pragma unroll
        for (int j = 0; j < 4; ++j) sq += (v[rr][j].x * v[rr][j].x + v[rr][j].y * v[rr][j].y) + (v[rr][j].z * v[rr][j].z + v[rr][j].w * v[rr][j].w);
        sq = wave_sum(sq);
        const float irs = sqrtf(sq * (1.0f / 1024.0f) + 1e-6f), rs = 1.0f / irs;
        unsigned long long* o8 = (unsigned long long*)(o0 + rr * 1024) + lane;
#pragma unroll
        for (int j = 0; j < 4; ++j) o8[64 * j] = (unsigned long long)pk2(v[rr][j].x * rs, v[rr][j].y * rs) | ((unsigned long long)pk2(v[rr][j].z * rs, v[rr][j].w * rs) << 32);
        if (lane == 0) ssq0[rr] = irs; }
}
__device__ __forceinline__ void p0_prologue(Frame& F) {
    LAS unsigned short* scr = (LAS unsigned short*)(F.lds + RING_OFF + F.wave * 16384);
    const int gw = F.vcu * NWAVES + F.wave, NGW = F.G * NWAVES;
    unsigned char* ws = F.ws;
    constexpr int I_IN = 16 * (NPROJ / 64), I_KV = 16 * 32, I_SSD = 32 * 16, I_SQ = 16 * 16, I_GU = 16 * (2 * FFN / 64), I_DN = (FFN / 64) * 16;
    constexpr int NITEMS = I_IN + I_KV + I_SSD + 4 * I_SQ + I_GU + I_DN;
    for (int it = gw; it < NITEMS; it += NGW) {
        int r = it;
        if (r < I_IN) { TSrc s{F.in[9], nullptr, F.in[8], 11296, 1}; p0_transpose_item(s, 1024, NPROJ, (bf16*)(ws + WS_WIN), scr, r, F.lane); continue; } r -= I_IN;
        if (r < I_KV) { TSrc s{F.in[24], F.in[25], F.in[22], 1024, 3}; p0_transpose_item(s, 1024, 2048, (bf16*)(ws + WS_WKV), scr, r, F.lane); continue; } r -= I_KV;
        if (r < I_SSD) { TSrc s{F.in[16], nullptr, F.in[15], 1024, 0}; p0_transpose_item(s, 2048, 1024, (bf16*)(ws + WS_WSSD), scr, r, F.lane); continue; } r -= I_SSD;
        if (r < I_SQ) { TSrc s{F.in[19], nullptr, F.in[18], 1024, 0}; p0_transpose_item(s, 1024, 1024, (bf16*)(ws + WS_WHG), scr, r, F.lane); continue; } r -= I_SQ;
        if (r < I_SQ) { TSrc s{F.in[20], nullptr, nullptr, 1024, 0}; p0_transpose_item(s, 1024, 1024, (bf16*)(ws + WS_WOUT), scr, r, F.lane); continue; } r -= I_SQ;
        if (r < I_SQ) { TSrc s{F.in[23], nullptr, F.in[21], 1024, 0}; p0_transpose_item(s, 1024, 1024, (bf16*)(ws + WS_WCQ), scr, r, F.lane); continue; } r -= I_SQ;
        if (r < I_SQ) { TSrc s{F.in[26], nullptr, nullptr, 1024, 0}; p0_transpose_item(s, 1024, 1024, (bf16*)(ws + WS_WCO), scr, r, F.lane); continue; } r -= I_SQ;
        if (r < I_GU) { TSrc s{F.in[28], F.in[29], F.in[27], FFN, 2}; p0_transpose_item(s, 1024, 2 * FFN, (bf16*)(ws + WS_WGU), scr, r, F.lane); continue; } r -= I_GU;
        { TSrc s{F.in[30], nullptr, nullptr, 1024, 0}; p0_transpose_item(s, FFN, 1024, (bf16*)(ws + WS_WDN), scr, r, F.lane); }
    }
    bf16* XB = (bf16*)(ws + WS_XB); float* SSQX = (float*)(ws + WS_SSQX);
    for (int m4 = gw; m4 < T / 4; m4 += NGW) { const int m = 4 * m4;
        rows4_to_bf16_ssq(m < TP ? F.in[0] + (size_t)m * DM : F.in[1] + (size_t)(m - TP) * DM, XB + (size_t)m * DM, SSQX + m, F.lane); }
    bf16* MNB = (bf16*)(ws + WS_MNB); float* SSQM = (float*)(ws + WS_SSQM);
    for (int m4 = gw; m4 < MEMR / 4; m4 += NGW) { const int m = 4 * m4; rows4_to_bf16_ssq(F.in[2] + (size_t)m * DM, MNB + (size_t)m * DM, SSQM + m, F.lane); }
}
__device__ __forceinline__ void conv_copy_unit(Frame& F, int gb) {
    const bf16* PROJ = (const bf16*)(F.ws + WS_PROJ);
    const bool prompt = gb < NBP; const int sb = gb - NBP;
    const size_t row0 = prompt ? (size_t)gb * SEQ + (SEQ - 3) : (size_t)TP + (size_t)sb * LS + 1;
    float* dst = prompt ? F.out + O_CONVP + (size_t)gb * 3 * 3072 : F.out + O_CONVS + (size_t)sb * 3 * 3072;
    for (int e = F.tid; e < 3 * 3072; e += NTHR) { const int j = e / 3072, col = e % 3072;
        dst[e] = bf2f(PROJ[(size_t)(S_X0 + (col >> 10)) * SLOT_ELEMS + (row0 + j) * 1024 + (col & 1023)]); }
}
__device__ __forceinline__ void ssdnorm_phase(Frame& F) {
    const int gw = F.vcu * NWAVES + F.wave, NGW = F.G * NWAVES; bf16* YG = (bf16*)(F.ws + WS_YG); const float* SSQ = (const float*)(F.ws + WS_SSQSSD);
    for (int row = gw; row < T; row += NGW) {
        const f32x4* sp = (const f32x4*)(SSQ + (size_t)row * 32);
#pragma unroll
        for (int j = 0; j < 4; ++j) { const f32x4 a = sp[2 * j], b = sp[2 * j + 1]; const float s = ((a.x + a.y) + (a.z + a.w)) + ((b.x + b.y) + (b.z + b.w)); const float rs = 1.0f / sqrtf(s * (1.0f / 512.0f) + EPS);
            v4u* p = (v4u*)(YG + (size_t)row * 2048) + j * 64 + F.lane; const v4u w = *p; v4u o;
#pragma unroll
            for (int e = 0; e < 4; ++e) o[e] = pk2(bf2f(w[e] & 0xffffu) * rs, bf2f(w[e] >> 16) * rs);
            *p = o; }
    }
}
typedef float f32x16 __attribute__((ext_vector_type(16)));
#define MFMA32(a, b, c) __builtin_amdgcn_mfma_f32_32x32x16_bf16((a), (b), (c), 0, 0, 0)
__device__ __forceinline__ unsigned cvtpk_c(float lo, float hi) { return pk2(lo, hi); }
__device__ __forceinline__ bf16x8 pack8(float a0, float a1, float a2, float a3, float a4, float a5, float a6, float a7) {
    v4u w; w.x = cvtpk_c(a0, a1); w.y = cvtpk_c(a2, a3); w.z = cvtpk_c(a4, a5); w.w = cvtpk_c(a6, a7); return __builtin_bit_cast(bf16x8, w); }
#define ACC_FRAG(x, s) pack8((x)[8 * (s)], (x)[8 * (s) + 1], (x)[8 * (s) + 2], (x)[8 * (s) + 3], (x)[8 * (s) + 4], (x)[8 * (s) + 5], (x)[8 * (s) + 6], (x)[8 * (s) + 7])
__device__ __forceinline__ bf16x8 lds_frag16(const LAS unsigned char* p) { return *(const LAS bf16x8*)p; }
__device__ __forceinline__ bf16x8 lds_frag8x2(const LAS unsigned char* p) { const v2u lo = *(const LAS v2u*)p, hi = *(const LAS v2u*)(p + 16);
    const v4u w = (v4u){lo.x, lo.y, hi.x, hi.y}; return __builtin_bit_cast(bf16x8, w); }
#define LDS_BARRIER() do { asm volatile("s_waitcnt lgkmcnt(0)" ::: "memory"); __builtin_amdgcn_s_barrier(); asm volatile("" ::: "memory"); } while (0)
constexpr size_t WS_BCS = WS_END, WS_BTT = WS_BCS + (size_t)TP * 1024 * 2, WS_END2 = WS_BTT + (size_t)NBP * 32 * 4 * 128 * 64 * 2;
__device__ __forceinline__ void bc_prep_unit(Frame& F, int b, int c) {
    typedef float f32x2 __attribute__((ext_vector_type(2)));
    int tid_o = F.tid; asm volatile("" : "+v"(tid_o));
    const int tid = tid_o, cg = tid & 127, seg = tid >> 7; unsigned char* ws = F.ws;
    const bf16* src = (const bf16*)(ws + WS_PROJ) + (size_t)S_X2 * SLOT_ELEMS + (size_t)b * SEQ * 1024 + 8 * cg;
    bf16* BCS = (bf16*)(ws + WS_BCS);
    const float* cw = F.in[10] + 2048 + 8 * cg; const float* cbp = F.in[11] + 2048 + 8 * cg;
#pragma unroll 1
    for (int half = 0; half < 2; ++half) {
        const int s0 = 16 * seg + 8 * half;
        v4u raw[11];
#pragma unroll
        for (int i = 0; i < 11; ++i) { const int gt = 64 * c + s0 - 3 + i; raw[i] = (v4u){0u, 0u, 0u, 0u}; if (gt >= 0) raw[i] = ld_nt16(src + (size_t)gt * 1024); }
        v4u rowpk[8];
#pragma unroll
        for (int kp = 0; kp < 4; ++kp) {
            const f32x2 cw0 = *(const f32x2*)(cw + 2 * kp), cw1 = *(const f32x2*)(cw + 3072 + 2 * kp), cw2 = *(const f32x2*)(cw + 2 * 3072 + 2 * kp), cw3 = *(const f32x2*)(cw + 3 * 3072 + 2 * kp), cbb = *(const f32x2*)(cbp + 2 * kp);
            f32x2 xv[11];
#pragma unroll
            for (int i = 0; i < 11; ++i) { const unsigned wd = raw[i][kp]; xv[i] = (f32x2){__uint_as_float(wd << 16), __uint_as_float(wd & 0xffff0000u)}; }
            f32x2 o[8];
#pragma unroll
            for (int i = 0; i < 8; ++i) { f32x2 a = cw0 * xv[i] + cbb; a = cw1 * xv[i + 1] + a; a = cw2 * xv[i + 2] + a; a = cw3 * xv[i + 3] + a;
                const f32x2 t = a * (-1.4426950408889634f); f32x2 e; e.x = __builtin_amdgcn_exp2f(t.x); e.y = __builtin_amdgcn_exp2f(t.y); e = e + 1.0f;
                f32x2 rc; rc.x = __builtin_amdgcn_rcpf(e.x); rc.y = __builtin_amdgcn_rcpf(e.y); o[i] = a * rc; }
#pragma unroll
            for (int i = 0; i < 8; ++i) rowpk[i][kp] = pk2(o[i].x, o[i].y);
        }
        bf16* drow = BCS + ((size_t)b * SEQ + 64 * c + s0) * 1024 + 8 * cg;
#pragma unroll
        for (int i = 0; i < 8; ++i) *(v4u*)(drow + (size_t)i * 1024) = rowpk[i];
    }
}
__device__ __forceinline__ void bc_prep_phase(Frame& F) { for (int u = F.vcu; u < NBP * 32; u += F.G) bc_prep_unit(F, u >> 5, u & 31); }
constexpr size_t WS_HVT = WS_XB, WS_EGM = WS_END2, WS_EGL = WS_EGM + (size_t)NBP * 64 * 1024 * 4, WS_END3 = WS_EGL + (size_t)NBP * 64 * 1024 * 4;
__device__ __forceinline__ void hg_prep_unit(Frame& F, int b, int c) {
    typedef float f32x2 __attribute__((ext_vector_type(2)));
    int tid_o = F.tid; asm volatile("" : "+v"(tid_o));
    const int tid = tid_o; unsigned char* ws = F.ws;
    const int ch = 2 * tid;
    const size_t row0 = (size_t)b * SEQ + 32 * c;
    bf16* QS = (bf16*)(ws + WS_PROJ) + (size_t)S_Q * SLOT_ELEMS + row0 * 1024 + ch; bf16* FS = (bf16*)(ws + WS_PROJ) + (size_t)S_F * SLOT_ELEMS + row0 * 1024 + ch;
    const f32x2 l0 = *(const f32x2*)(F.in[17] + ch), l1 = *(const f32x2*)(F.in[17] + 1024 + ch);
    f32x2 lb; lb.x = __builtin_amdgcn_rcpf(1.0f + __expf(l1.x - l0.x)); lb.y = __builtin_amdgcn_rcpf(1.0f + __expf(l1.y - l0.y));
    const f32x2 omlb = 1.0f - lb;
    f32x2 P[32]; f32x2 run = (f32x2){1.0f, 1.0f};
#pragma unroll
    for (int t = 0; t < 32; ++t) { const unsigned wd = ld_nt4(FS + (size_t)t * 1024);
        f32x2 u = (f32x2){__uint_as_float(wd << 16), __uint_as_float(wd & 0xffff0000u)}; u.x = fminf(fmaxf(u.x, -30.f), 30.f); u.y = fminf(fmaxf(u.y, -30.f), 30.f);
        const f32x2 tt = u * (-1.4426950408889634f); f32x2 e; e.x = __builtin_amdgcn_exp2f(tt.x); e.y = __builtin_amdgcn_exp2f(tt.y); e = e + 1.0f;
        f32x2 sg; sg.x = __builtin_amdgcn_rcpf(e.x); sg.y = __builtin_amdgcn_rcpf(e.y);
        const f32x2 fg = lb + omlb * sg; run = run * fg; run.x = fmaxf(run.x, 1e-30f); run.y = fmaxf(run.y, 1e-30f); P[t] = run; }
    const f32x2 Pm = P[15], Pl = P[31]; f32x2 rPm; rPm.x = __builtin_amdgcn_rcpf(Pm.x); rPm.y = __builtin_amdgcn_rcpf(Pm.y);
    *(f32x2*)((float*)(ws + WS_EGM) + (size_t)(b * 64 + c) * 1024 + ch) = Pm; *(f32x2*)((float*)(ws + WS_EGL) + (size_t)(b * 64 + c) * 1024 + ch) = Pl * rPm;
    f32x2 rPprev = (f32x2){1.0f, 1.0f};
#pragma unroll
    for (int t = 0; t < 32; ++t) { f32x2 rP; rP.x = __builtin_amdgcn_rcpf(P[t].x); rP.y = __builtin_amdgcn_rcpf(P[t].y);
        const f32x2 e1 = P[t] * rPm, e2 = Pm * rP, fg = P[t] * rPprev, kk = 1.0f - fg; rPprev = rP;
        const unsigned qw = ld_nt4(QS + (size_t)t * 1024); const f32x2 q = (f32x2){__uint_as_float(qw << 16), __uint_as_float(qw & 0xffff0000u)};
        const f32x2 tq = q * (-1.4426950408889634f); f32x2 eq; eq.x = __builtin_amdgcn_exp2f(tq.x); eq.y = __builtin_amdgcn_exp2f(tq.y); eq = eq + 1.0f;
        f32x2 rq; rq.x = __builtin_amdgcn_rcpf(eq.x); rq.y = __builtin_amdgcn_rcpf(eq.y);
        const f32x2 qa = q * rq * e1, ka = kk * e2;
        *(unsigned*)(QS + (size_t)t * 1024) = pk2(qa.x, qa.y); *(unsigned*)(FS + (size_t)t * 1024) = pk2(ka.x, ka.y); }
}
__device__ __forceinline__ void hg_prep_phase(Frame& F) { for (int u = F.vcu; u < NBP * 64; u += F.G) hg_prep_unit(F, u >> 6, u & 63); }
constexpr int HV_QA = 0, HV_KA = 8704, HV_KAT = 17408, HV_VT = 27648, HV_EGM = 30208, HV_EGL = 30720, HV_PBUF = 31232, HV_OB = 2 * HV_PBUF, HV_OBUF = 23040;
constexpr size_t WS_SSQH = WS_END3, WS_END4 = WS_SSQH + (size_t)T * 32 * 4;
__device__ __forceinline__ void hgrn_v_unit(Frame& F, int b, int hd, int vt) {
    int tid_o = F.tid; asm volatile("" : "+v"(tid_o));
    const int tid = tid_o, lane = tid & 63, w = F.wave, r = lane & 31, hh = lane >> 5; unsigned char* ws = F.ws;
    LAS unsigned char* Lb = F.lds + RING_OFF;
    const bf16* PROJ = (const bf16*)(ws + WS_PROJ); bf16* OU = (bf16*)(ws + WS_ON); float* SSQH = (float*)(ws + WS_SSQH);
    const size_t rowb = (size_t)b * SEQ;
    const int pt_t = tid & 31, pt_g = tid >> 5;
    const bf16* qsrc = PROJ + (size_t)S_Q * SLOT_ELEMS + (rowb + pt_t) * 1024 + hd * 128 + 8 * pt_g;
    const bf16* ksrc = PROJ + (size_t)S_F * SLOT_ELEMS + (rowb + pt_t) * 1024 + hd * 128 + 8 * pt_g;
    const unsigned char* xsrc = nullptr; size_t xstr = 0;
    if (tid < 128) { xsrc = (const unsigned char*)(PROJ + (size_t)S_I * SLOT_ELEMS + (rowb + pt_t) * 1024 + hd * 128 + 32 * vt + 8 * pt_g); xstr = (size_t)32 * 1024 * 2; }
    else if (tid < 160) { xsrc = (const unsigned char*)((const float*)(ws + WS_EGM) + (size_t)b * 64 * 1024 + hd * 128 + 4 * (tid - 128)); xstr = 4096; }
    else if (tid < 192) { xsrc = (const unsigned char*)((const float*)(ws + WS_EGL) + (size_t)b * 64 * 1024 + hd * 128 + 4 * (tid - 160)); xstr = 4096; }
    const int o_img = pt_t * 272 + 16 * pt_g, o_tr = (8 * pt_g) * 80 + 2 * pt_t;
#define HGV_LOAD(cc, pq, pk, px) { pq = *(const v4u*)(qsrc + (size_t)(cc) * 32 * 1024); pk = *(const v4u*)(ksrc + (size_t)(cc) * 32 * 1024); if (tid < 192) px = *(const v4u*)(xsrc + (size_t)(cc) * xstr); }
#define HGV_TR(dst, v) { _Pragma("unroll") for (int e = 0; e < 8; ++e) *(LAS unsigned short*)((dst) + 80 * e) = (unsigned short)(((v)[e >> 1] >> (16 * (e & 1))) & 0xffffu); }
#define HGV_STORE(pb, pq, pk, px) { *(LAS v4u*)((pb) + HV_QA + o_img) = pq; *(LAS v4u*)((pb) + HV_KA + o_img) = pk; HGV_TR((pb) + HV_KAT + o_tr, pk) \
        if (tid < 128) { HGV_TR((pb) + HV_VT + o_tr, px) } else if (tid < 160) { *(LAS v4u*)((pb) + HV_EGM + 16 * (tid - 128)) = px; } else if (tid < 192) { *(LAS v4u*)((pb) + HV_EGL + 16 * (tid - 160)) = px; } }
    v4u pqA, pkA, pxA = (v4u){0u, 0u, 0u, 0u}, pqB, pkB, pxB = (v4u){0u, 0u, 0u, 0u};
    HGV_LOAD(0, pqA, pkA, pxA) HGV_STORE(Lb, pqA, pkA, pxA)
    HGV_LOAD(1, pqA, pkA, pxA) HGV_LOAD(2, pqB, pkB, pxB)
    const int kt = w;
    v2u ow_pend = (v2u){0u, 0u}; float sq_pend = 0.f;
    f32x16 S;
#pragma unroll
    for (int i = 0; i < 16; ++i) S[i] = 0.f;
    __syncthreads();
#define HGV_ITER(c, pq, pk, px) { \
        int r_l = r, hh_l = hh, tid_l = tid; asm volatile("" : "+v"(r_l), "+v"(hh_l), "+v"(tid_l)); \
        { const int r = r_l, hh = hh_l, tid = tid_l; \
        LAS unsigned char* pbc = Lb + ((c) & 1) * HV_PBUF; LAS unsigned char* pbn = Lb + (((c) + 1) & 1) * HV_PBUF; \
        if ((c) < 63) { HGV_STORE(pbn, pq, pk, px) if ((c) < 61) HGV_LOAD((c) + 3, pq, pk, px) } \
        if (w < 4) { \
            LAS float* EGM = (LAS float*)(pbc + HV_EGM); LAS float* EGL = (LAS float*)(pbc + HV_EGL); LAS float* OB = (LAS float*)(Lb + HV_OB + ((c) & 1) * HV_OBUF); \
            _Pragma("unroll") \
            for (int q4 = 0; q4 < 4; ++q4) { const f32x4 e0 = *(const LAS f32x4*)(EGM + 32 * kt + 8 * q4 + 4 * hh); \
                _Pragma("unroll") \
                for (int j = 0; j < 4; ++j) S[4 * q4 + j] *= e0[j]; } \
            f32x16 o; \
            _Pragma("unroll") \
            for (int i = 0; i < 16; ++i) o[i] = 0.f; \
            const LAS unsigned char* qa_row = pbc + HV_QA + r * 272; \
            o = MFMA32(ACC_FRAG(S, 0), lds_frag8x2(qa_row + (32 * kt + 4 * hh) * 2), o);        \
            o = MFMA32(ACC_FRAG(S, 1), lds_frag8x2(qa_row + (32 * kt + 16 + 4 * hh) * 2), o); \
            LAS float* ob = OB + (kt * 32 + r) * 36 + 4 * hh; \
            _Pragma("unroll") \
            for (int q4 = 0; q4 < 4; ++q4) *(LAS f32x4*)(ob + 8 * q4) = (f32x4){o[4 * q4], o[4 * q4 + 1], o[4 * q4 + 2], o[4 * q4 + 3]}; \
            const LAS unsigned char* kat_nat = pbc + HV_KAT + (32 * kt + r) * 80 + hh * 16; const LAS unsigned char* vt_nat = pbc + HV_VT + r * 80 + hh * 16; \
            S = MFMA32(lds_frag16(kat_nat), lds_frag16(vt_nat), S); S = MFMA32(lds_frag16(kat_nat + 32), lds_frag16(vt_nat + 32), S); \
            _Pragma("unroll") \
            for (int q4 = 0; q4 < 4; ++q4) { const f32x4 e0 = *(const LAS f32x4*)(EGL + 32 * kt + 8 * q4 + 4 * hh); \
                _Pragma("unroll") \
                for (int j = 0; j < 4; ++j) S[4 * q4 + j] *= e0[j]; } \
        } else { \
            if (w == 4) { LAS float* OB = (LAS float*)(Lb + HV_OB + ((c) & 1) * HV_OBUF); f32x16 o; \
                _Pragma("unroll") \
                for (int i = 0; i < 16; ++i) o[i] = 0.f; \
                f32x16 X; \
                _Pragma("unroll") \
                for (int i = 0; i < 16; ++i) X[i] = 0.f; \
                const LAS unsigned char* ka_nat = pbc + HV_KA + r * 272 + hh * 16; const LAS unsigned char* qa_nat = pbc + HV_QA + r * 272 + hh * 16; \
                { f32x16 Xb; \
                _Pragma("unroll") \
                for (int i = 0; i < 16; ++i) Xb[i] = 0.f; \
                _Pragma("unroll 2") \
                for (int ks = 0; ks < 8; ks += 2) { X = MFMA32(lds_frag16(ka_nat + ks * 32), lds_frag16(qa_nat + ks * 32), X); Xb = MFMA32(lds_frag16(ka_nat + ks * 32 + 32), lds_frag16(qa_nat + ks * 32 + 32), Xb); } \
                X = X + Xb; } \
                _Pragma("unroll") \
                for (int i = 0; i < 16; ++i) { const int srow = (i & 3) + 8 * (i >> 2) + 4 * hh; X[i] = (srow <= r) ? X[i] : 0.f; } \
                const LAS unsigned char* vt_row = pbc + HV_VT + r * 80; \
                o = MFMA32(lds_frag8x2(vt_row + (4 * hh) * 2), ACC_FRAG(X, 0), o);                \
                o = MFMA32(lds_frag8x2(vt_row + (16 + 4 * hh) * 2), ACC_FRAG(X, 1), o); \
                LAS float* ob4 = OB + (4 * 32 + r) * 36 + 4 * hh; \
                _Pragma("unroll") \
                for (int q4 = 0; q4 < 4; ++q4) *(LAS f32x4*)(ob4 + 8 * q4) = (f32x4){o[4 * q4], o[4 * q4 + 1], o[4 * q4 + 2], o[4 * q4 + 3]}; \
            } \
            if ((c) > 1) { HGV_FLUSH((c) - 2) } \
            if ((c) > 0) { HGV_OUT((c) - 1) } \
        } \
        LDS_BARRIER(); \
        } }
#define HGV_OUT(cp) { const LAS float* OB = (const LAS float*)(Lb + HV_OB + ((cp) & 1) * HV_OBUF); const int tl = tid - 256, t = tl >> 3, v0 = (tl & 7) * 4; \
            const f32x4 a = *(const LAS f32x4*)(OB + t * 36 + v0), b2 = *(const LAS f32x4*)(OB + (32 + t) * 36 + v0), c2 = *(const LAS f32x4*)(OB + (64 + t) * 36 + v0), d2 = *(const LAS f32x4*)(OB + (96 + t) * 36 + v0), e2 = *(const LAS f32x4*)(OB + (128 + t) * 36 + v0); \
            const f32x4 o4 = ((a + b2) + (c2 + d2)) + e2; \
            float sq = (o4.x * o4.x + o4.y * o4.y) + (o4.z * o4.z + o4.w * o4.w); sq += __int_as_float(__builtin_amdgcn_update_dpp(0, __float_as_int(sq), 0x104, 0xf, 0xf, true)); sq += __int_as_float(__builtin_amdgcn_update_dpp(0, __float_as_int(sq), 0x102, 0xf, 0xf, true)); sq += __int_as_float(__builtin_amdgcn_update_dpp(0, __float_as_int(sq), 0x101, 0xf, 0xf, true));   \
            sq_pend = sq; ow_pend.x = pk2(o4.x, o4.y); ow_pend.y = pk2(o4.z, o4.w); }
#define HGV_FLUSH(cp) { const int tl = tid - 256, t = tl >> 3, v0 = (tl & 7) * 4; const size_t row = rowb + 32 * (cp) + t; \
            if ((tl & 7) == 0) SSQH[row * 32 + hd * 4 + vt] = sq_pend; *(v2u*)(OU + row * 1024 + hd * 128 + 32 * vt + v0) = ow_pend; }
#pragma unroll 1
    for (int cc = 0; cc < 64; cc += 2) { HGV_ITER(cc, pqA, pkA, pxA) HGV_ITER(cc + 1, pqB, pkB, pxB) }
    if (w >= 4) { HGV_FLUSH(62) HGV_OUT(63) HGV_FLUSH(63) }
#undef HGV_ITER
#undef HGV_OUT
#undef HGV_FLUSH
#undef HGV_LOAD
#undef HGV_STORE
#undef HGV_TR
    if (w < 4) { float* st_g = F.out + O_HGP + (size_t)(b * 8 + hd) * 16384 + 32 * vt + r;
#pragma unroll
        for (int i = 0; i < 16; ++i) { const int k = 32 * kt + (i & 3) + 8 * (i >> 2) + 4 * hh; st_g[(size_t)k * 128] = S[i]; } }
    __syncthreads();
}
__device__ __forceinline__ void hgnorm_phase(Frame& F) {
    const int gw = F.vcu * NWAVES + F.wave, NGW = F.G * NWAVES; bf16* ON = (bf16*)(F.ws + WS_ON); const float* SSQH = (const float*)(F.ws + WS_SSQH);
    const bf16* HG = (const bf16*)(F.ws + WS_PROJ) + (size_t)S_HG * SLOT_ELEMS;
    for (int row = gw; row < TP; row += NGW) {
#pragma unroll
        for (int j = 0; j < 2; ++j) { const int pc = j * 64 + F.lane, hd = pc >> 4;
            const f32x4 sp = *(const f32x4*)(SSQH + (size_t)row * 32 + hd * 4); const float rs = __builtin_amdgcn_rsqf(((sp.x + sp.y) + (sp.z + sp.w)) * (1.0f / 128.0f) + EPS);
            v4u* p = (v4u*)(ON + (size_t)row * 1024) + pc; const v4u o = *p; const v4u g = ld_nt16((const v4u*)(HG + (size_t)row * 1024) + pc); v4u res;
#pragma unroll
            for (int e = 0; e < 4; ++e) res[e] = pk2(bf2f(o[e] & 0xffffu) * rs * silu_f(bf2f(g[e] & 0xffffu)), __uint_as_float(o[e] & 0xffff0000u) * rs * silu_f(__uint_as_float(g[e] & 0xffff0000u)));
            *p = res; }
    }
}
constexpr int SD_BN = 0, SD_CN = 17408, SD_BT = 34816, SD_XT = 53248, SD_HT = 62464, SD_YA = 97280, SD_YY = 113664, SD_YO = 130048, SD_CUM = 134144, SD_DTV = 134400, SD_ECUM = 134656, SD_XWT = 134912, SD_CWL = 144128;
typedef short s16x4 __attribute__((ext_vector_type(4)));
__device__ __forceinline__ bf16x8 lds_frag_tr(const LAS unsigned char* p, const LAS unsigned char* p4) {
    const s16x4 lo = __builtin_amdgcn_ds_read_tr16_b64_v4i16((LAS s16x4*)p), hi = __builtin_amdgcn_ds_read_tr16_b64_v4i16((LAS s16x4*)p4);
    return (bf16x8){lo.x, lo.y, lo.z, lo.w, hi.x, hi.y, hi.z, hi.w}; }
__device__ __forceinline__ void ssd_unit_mfma(Frame& F, int gb, int h) {
    int tid_o = F.tid; asm volatile("" : "+v"(tid_o));
    const int tid = tid_o, lane = tid & 63, w = F.wave, r = lane & 31, hh = lane >> 5; unsigned char* ws = F.ws;
    const int L = SEQ; const size_t row_base = (size_t)gb * SEQ;
    const int g = h >> 3;
    LAS unsigned char* Lb = F.lds + RING_OFF;
    LAS unsigned short* BN = (LAS unsigned short*)(Lb + SD_BN); LAS unsigned short* CN = (LAS unsigned short*)(Lb + SD_CN);
    LAS unsigned short* BT = (LAS unsigned short*)(Lb + SD_BT); LAS unsigned short* XT = (LAS unsigned short*)(Lb + SD_XT);
    LAS unsigned short* HT = (LAS unsigned short*)(Lb + SD_HT);
    LAS unsigned short* XWT = (LAS unsigned short*)(Lb + SD_XWT);
    LAS float* YA = (LAS float*)(Lb + SD_YA); LAS float* YY = (LAS float*)(Lb + SD_YY); LAS unsigned short* YO = (LAS unsigned short*)(Lb + SD_YO);
    LAS float* CUM = (LAS float*)(Lb + SD_CUM); LAS float* DTV = (LAS float*)(Lb + SD_DTV); LAS float* ECUM = (LAS float*)(Lb + SD_ECUM);
    const bf16* PROJ = (const bf16*)(ws + WS_PROJ); const float* DTR = (const float*)(ws + WS_DT); bf16* YG = (bf16*)(ws + WS_YG); float* SSQ = (float*)(ws + WS_SSQSSD);
    f32x16 H0, H1, H2, H3;
#pragma unroll
    for (int i = 0; i < 16; ++i) { H0[i] = 0.f; H1[i] = 0.f; H2[i] = 0.f; H3[i] = 0.f; }
    float* const st_base = F.out + O_SSMP + (size_t)(gb * 32 + h) * 8192 + (size_t)r * 128 + 4 * hh;
#define SSD_PUBLISH(HX, TILE, BUF) { LAS unsigned short* hp_ = HT + (BUF) * 8704 + (32 * ((TILE) & 1) + r) * 136 + 32 * ((TILE) >> 1) + 4 * hh; \
        _Pragma("unroll") for (int q4 = 0; q4 < 4; ++q4) { v2u pk; pk.x = cvtpk_c(HX[4 * q4], HX[4 * q4 + 1]); pk.y = cvtpk_c(HX[4 * q4 + 2], HX[4 * q4 + 3]); *(LAS v2u*)(hp_ + 8 * q4) = pk; } }
    if (w == 3) { SSD_PUBLISH(H0, 0, 0) SSD_PUBLISH(H1, 1, 0) SSD_PUBLISH(H2, 2, 0) SSD_PUBLISH(H3, 3, 0) } else if (w >= 4) { SSD_PUBLISH(H0, w, 0) }
    const float a = -__expf(F.in[13][h]), dtb = F.in[12][h], Dk = F.in[14][h];
    const float* cw = F.in[10]; const float* cbp = F.in[11];
    typedef float f32x2 __attribute__((ext_vector_type(2)));
    const int col = h * 64 + 2 * (tid & 31);
    const bf16* cptr = PROJ + (size_t)(S_X0 + (col >> 10)) * SLOT_ELEMS + row_base * 1024 + (col & 1023);
    const f32x2 cw0 = *(const f32x2*)(cw + col), cw1 = *(const f32x2*)(cw + 3072 + col), cw2 = *(const f32x2*)(cw + 2 * 3072 + col), cw3 = *(const f32x2*)(cw + 3 * 3072 + col), cbb = *(const f32x2*)(cbp + col);
    const bf16* BCS = (const bf16*)(ws + WS_BCS) + row_base * 1024 + g * 128;
    unsigned xr[7]; v4u pc[4];
#pragma unroll
    for (int i = 0; i < 7; ++i) { const int gt = 4 * (tid >> 5) - 3 + i; xr[i] = 0u; if (gt >= 0) xr[i] = *(const unsigned*)(cptr + (size_t)gt * 1024); }
#pragma unroll
    for (int j = 0; j < 4; ++j) { const int idx = (tid + 512 * j) & 1023; pc[j] = *(const v4u*)(BCS + (size_t)(idx >> 4) * 1024 + (j >> 1) * 512 + 8 * (idx & 15)); }
    __syncthreads();
    v4u ow_pend = (v4u){0u, 0u, 0u, 0u}; float sq_pend = 0.f; bool pend = false;
    int buf = 0;
    float dt_pf = 0.f;
    if (lane < L) dt_pf = DTR[(row_base + lane) * 32 + h];
    v4u zw_pf = ld_nt16(PROJ + (size_t)(S_Z0 + (h >> 4)) * SLOT_ELEMS + (row_base + (tid >> 3)) * 1024 + (h & 15) * 64 + (tid & 7) * 8);
    for (int t0 = 0; t0 < L; t0 += 64, buf ^= 1) {
        int r_l = r, hh_l = hh, tid_l = tid, lane_l = lane;
        asm volatile("" : "+v"(r_l), "+v"(hh_l), "+v"(tid_l), "+v"(lane_l));
        { const int r = r_l, hh = hh_l, tid = tid_l, lane = lane_l;
        float dtv = 0.f;
        if (t0 + lane < L) { const float x = dt_pf + dtb; dtv = fmaxf(x, 0.f) + 0.6931471805599453f * __builtin_amdgcn_logf(1.0f + __builtin_amdgcn_exp2f(-1.4426950408889634f * fabsf(x))); }
        dt_pf = 0.f; if (t0 + 64 + lane < L) dt_pf = DTR[(row_base + t0 + 64 + lane) * 32 + h];
        const v4u zw = zw_pf; zw_pf = (v4u){0u, 0u, 0u, 0u};
        if (t0 + 64 + (tid >> 3) < L) zw_pf = ld_nt16(PROJ + (size_t)(S_Z0 + (h >> 4)) * SLOT_ELEMS + (row_base + t0 + 64 + (tid >> 3)) * 1024 + (h & 15) * 64 + (tid & 7) * 8);
        float cum = dtv * a;
#define SSD_DPP_ADD(ctrl, rmask) cum += __int_as_float(__builtin_amdgcn_update_dpp(0, __float_as_int(cum), ctrl, rmask, 0xf, true))
        SSD_DPP_ADD(0x111, 0xf); SSD_DPP_ADD(0x112, 0xf); SSD_DPP_ADD(0x114, 0xf); SSD_DPP_ADD(0x118, 0xf);
        SSD_DPP_ADD(0x142, 0xa); SSD_DPP_ADD(0x143, 0xc);
#undef SSD_DPP_ADD
        const float cum_last = __int_as_float(__builtin_amdgcn_readlane(__float_as_int(cum), 63));
        const float wgt = __expf(cum_last - cum) * dtv;
        if (w == 0) { CUM[lane] = cum; DTV[lane] = dtv; ECUM[lane] = __expf(cum); }
#pragma unroll
        for (int j = 0; j < 4; ++j) { const int idx = (tid + 512 * j) & 1023;
            if (j < 2) { const int row = idx >> 4; *(LAS v4u*)((LAS unsigned char*)BN + 256 * row + 16 * ((idx & 15) ^ (((row & 3) << 2) | ((row >> 2) & 3)))) = pc[j]; }
            else *(LAS v4u*)(CN + (idx >> 4) * 136 + 8 * (idx & 15)) = pc[j]; }
        if (pend) { const size_t prow = row_base + (t0 - 64) + (tid >> 3);
            *(v4u*)(YG + prow * 2048 + h * 64 + (tid & 7) * 8) = ow_pend; if ((tid & 7) == 0) SSQ[prow * 32 + h] = sq_pend; pend = false; }
        { const int cp = tid & 31, sq = tid >> 5; const int wu = __builtin_amdgcn_readfirstlane(w);
          f32x2 xv[7];
#pragma unroll
          for (int i = 0; i < 7; ++i) xv[i] = (f32x2){__uint_as_float(xr[i] << 16), __uint_as_float(xr[i] & 0xffff0000u)};
          unsigned po[4], pw[4];
          f32x2 o[4], ow[4];
#pragma unroll
          for (int k = 0; k < 4; ++k) {
              const float w_lo = __int_as_float(__builtin_amdgcn_readlane(__float_as_int(wgt), 8 * wu + k)), w_hi = __int_as_float(__builtin_amdgcn_readlane(__float_as_int(wgt), 8 * wu + 4 + k));
              const float wx = hh ? w_hi : w_lo;
              f32x2 a = cw0 * xv[k] + cbb; a = cw1 * xv[k + 1] + a; a = cw2 * xv[k + 2] + a; a = cw3 * xv[k + 3] + a;
              const f32x2 t = a * (-1.4426950408889634f); f32x2 e; e.x = __builtin_amdgcn_exp2f(t.x); e.y = __builtin_amdgcn_exp2f(t.y); e = e + 1.0f;
              f32x2 rc; rc.x = __builtin_amdgcn_rcpf(e.x); rc.y = __builtin_amdgcn_rcpf(e.y); o[k] = a * rc; ow[k] = o[k] * wx; }
          po[0] = pk2(o[0].x, o[1].x); po[1] = pk2(o[2].x, o[3].x); po[2] = pk2(o[0].y, o[1].y); po[3] = pk2(o[2].y, o[3].y);
          pw[0] = pk2(ow[0].x, ow[1].x); pw[1] = pk2(ow[2].x, ow[3].x); pw[2] = pk2(ow[0].y, ow[1].y); pw[3] = pk2(ow[2].y, ow[3].y);
          *(LAS v2u*)(XT + (2 * cp) * 72 + 4 * sq) = (v2u){po[0], po[1]}; *(LAS v2u*)(XT + (2 * cp + 1) * 72 + 4 * sq) = (v2u){po[2], po[3]};
          *(LAS v2u*)(XWT + (2 * cp) * 72 + 4 * sq) = (v2u){pw[0], pw[1]}; *(LAS v2u*)(XWT + (2 * cp + 1) * 72 + 4 * sq) = (v2u){pw[2], pw[3]};
        }
        if (t0 + 64 < L) {
#pragma unroll
            for (int i = 0; i < 7; ++i) xr[i] = *(const unsigned*)(cptr + (size_t)(t0 + 64 + 4 * (tid >> 5) - 3 + i) * 1024);
#pragma unroll
            for (int j = 0; j < 4; ++j) { const int idx = (tid + 512 * j) & 1023; pc[j] = *(const v4u*)(BCS + (size_t)(t0 + 64 + (idx >> 4)) * 1024 + (j >> 1) * 512 + 8 * (idx & 15)); }
        }
        LDS_BARRIER();
        if (w < 3) {
            const int tt = w == 0 ? 0 : 1, st = w == 1 ? 1 : 0;
            f32x16 X, ya0, ya1;
#pragma unroll
            for (int i = 0; i < 16; ++i) { X[i] = 0.f; ya0[i] = 0.f; ya1[i] = 0.f; }
            const LAS unsigned char* cn_nat = Lb + SD_CN + (32 * tt + r) * 272 + hh * 16; const int bn_sw = ((r & 3) << 2) | ((r >> 2) & 3); const LAS unsigned char* bn_row = Lb + SD_BN + (32 * st + r) * 256;
            { f32x16 Xb;
#pragma unroll
              for (int i = 0; i < 16; ++i) Xb[i] = 0.f;
#pragma unroll
              for (int ks = 0; ks < 8; ks += 2) { X = MFMA32(lds_frag16(bn_row + 16 * ((2 * ks + hh) ^ bn_sw)), lds_frag16(cn_nat + ks * 32), X); Xb = MFMA32(lds_frag16(bn_row + 16 * ((2 * ks + 2 + hh) ^ bn_sw)), lds_frag16(cn_nat + ks * 32 + 32), Xb); }
              X = X + Xb; }
            const float cum_t = CUM[32 * tt + r];
#pragma unroll
            for (int q4 = 0; q4 < 4; ++q4) { const f32x4 cs = *(const LAS f32x4*)(CUM + 32 * st + 8 * q4 + 4 * hh), ds = *(const LAS f32x4*)(DTV + 32 * st + 8 * q4 + 4 * hh);
#pragma unroll
                for (int jj = 0; jj < 4; ++jj) { const int s_abs = 32 * st + 8 * q4 + 4 * hh + jj; const float f = __expf(cum_t - cs[jj]) * ds[jj]; X[4 * q4 + jj] = (s_abs <= 32 * tt + r) ? X[4 * q4 + jj] * f : 0.f;        } }
            const bf16x8 xf0 = ACC_FRAG(X, 0), xf1 = ACC_FRAG(X, 1);
            const LAS unsigned char* xt_row = Lb + SD_XT + r * 144 + (32 * st + 4 * hh) * 2;
            ya0 = MFMA32(lds_frag8x2(xt_row), xf0, ya0); ya0 = MFMA32(lds_frag8x2(xt_row + 32), xf1, ya0);
            ya1 = MFMA32(lds_frag8x2(xt_row + 32 * 144), xf0, ya1); ya1 = MFMA32(lds_frag8x2(xt_row + 32 * 144 + 32), xf1, ya1);
            if (w < 2) { LAS float* yb = YA + (32 * tt + r) * 64;
#pragma unroll
                for (int q4 = 0; q4 < 4; ++q4) { const int ch = 2 * q4 + hh;
                    *(LAS f32x4*)(yb + 4 * (ch ^ (r & 15))) = (f32x4){ya0[4 * q4], ya0[4 * q4 + 1], ya0[4 * q4 + 2], ya0[4 * q4 + 3]};
                    *(LAS f32x4*)(yb + 4 * ((ch + 8) ^ (r & 15))) = (f32x4){ya1[4 * q4], ya1[4 * q4 + 1], ya1[4 * q4 + 2], ya1[4 * q4 + 3]}; } }
            else { LAS unsigned char* yb = (LAS unsigned char*)YO + r * 128;
#pragma unroll
                for (int q4 = 0; q4 < 4; ++q4) { const int ch = 2 * q4 + hh; v2u p0, p1;
                    p0.x = cvtpk_c(ya0[4 * q4], ya0[4 * q4 + 1]); p0.y = cvtpk_c(ya0[4 * q4 + 2], ya0[4 * q4 + 3]); p1.x = cvtpk_c(ya1[4 * q4], ya1[4 * q4 + 1]); p1.y = cvtpk_c(ya1[4 * q4 + 2], ya1[4 * q4 + 3]);
                    *(LAS v2u*)(yb + 8 * (ch ^ ((r & 7) << 1))) = p0; *(LAS v2u*)(yb + 8 * ((ch + 8) ^ ((r & 7) << 1))) = p1; } }
        } else if (w >= 4) {
            const int tt = (w - 4) >> 1, ptj = w & 1;
            const LAS unsigned char* ht_nat = Lb + SD_HT + buf * 17408 + (32 * ptj + r) * 272 + hh * 16;
            f32x16 yi;
#pragma unroll
            for (int i = 0; i < 16; ++i) yi[i] = 0.f;
            const LAS unsigned char* cn_nat = Lb + SD_CN + (32 * tt + r) * 272 + hh * 16;
            { f32x16 yb2;
#pragma unroll
              for (int i = 0; i < 16; ++i) yb2[i] = 0.f;
#pragma unroll 2
              for (int ks = 0; ks < 8; ks += 2) { yi = MFMA32(lds_frag16(cn_nat + ks * 32), lds_frag16(ht_nat + ks * 32), yi); yb2 = MFMA32(lds_frag16(cn_nat + ks * 32 + 32), lds_frag16(ht_nat + ks * 32 + 32), yb2); }
              yi = yi + yb2; }
            const LAS unsigned short* xt_p = XT + (32 * ptj + r) * 72 + 32 * tt + 4 * hh;
#pragma unroll
            for (int q4 = 0; q4 < 4; ++q4) { const f32x4 ec = *(const LAS f32x4*)(ECUM + 32 * tt + 8 * q4 + 4 * hh); const v2u xw = *(const LAS v2u*)(xt_p + 8 * q4);
                const float x0 = bf2f(xw.x & 0xffffu), x1 = bf2f(xw.x >> 16), x2 = bf2f(xw.y & 0xffffu), x3 = bf2f(xw.y >> 16);
                LAS float* yb = YY + (32 * tt + 8 * q4 + 4 * hh) * 64 + 32 * ptj + r;
                yb[0] = ec[0] * yi[4 * q4] + Dk * x0; yb[64] = ec[1] * yi[4 * q4 + 1] + Dk * x1; yb[128] = ec[2] * yi[4 * q4 + 2] + Dk * x2; yb[192] = ec[3] * yi[4 * q4 + 3] + Dk * x3; }
        }
#define SSD_UPD(HX, TILE) { const int q_ = (lane >> 2) & 3, ch_ = 4 * ((TILE) >> 1) + 2 * ((lane >> 4) & 1) + ((lane >> 1) & 1); \
            const LAS unsigned char* bn_lo = Lb + SD_BN + (8 * hh + q_) * 256 + 16 * (ch_ ^ ((q_ << 2) | ((2 * hh) & 3))) + 8 * (lane & 1); \
            const LAS unsigned char* bn_hi = Lb + SD_BN + (8 * hh + 4 + q_) * 256 + 16 * (ch_ ^ ((q_ << 2) | ((2 * hh + 1) & 3))) + 8 * (lane & 1); \
            const LAS unsigned char* xt_nat = Lb + SD_XWT + (32 * ((TILE) & 1) + r) * 144 + hh * 16; \
            f32x16 Ha, Hb; \
            _Pragma("unroll") for (int i = 0; i < 16; ++i) { Ha[i] = 0.f; Hb[i] = 0.f; } \
            Ha = MFMA32(lds_frag_tr(bn_lo, bn_hi), lds_frag16(xt_nat), Ha); Hb = MFMA32(lds_frag_tr(bn_lo + 4096, bn_hi + 4096), lds_frag16(xt_nat + 32), Hb); \
            Ha = MFMA32(lds_frag_tr(bn_lo + 8192, bn_hi + 8192), lds_frag16(xt_nat + 64), Ha); Hb = MFMA32(lds_frag_tr(bn_lo + 12288, bn_hi + 12288), lds_frag16(xt_nat + 96), Hb);         \
            _Pragma("unroll") for (int i = 0; i < 16; ++i) HX[i] = HX[i] * el + (Ha[i] + Hb[i]); \
            SSD_PUBLISH(HX, TILE, buf ^ 1) }
        if (w >= 3) { const float el = ECUM[63];
            if (w == 3) { SSD_UPD(H0, 0) SSD_UPD(H1, 1) SSD_UPD(H2, 2) SSD_UPD(H3, 3) } else { SSD_UPD(H0, w) } }
        LDS_BARRIER();
        { const int tt = tid >> 3, p0 = (tid & 7) * 8;
          if (t0 + tt < L) { const size_t row = row_base + t0 + tt;
            const int c0 = 2 * (tid & 7);
            f32x4 y0 = *(const LAS f32x4*)(YA + tt * 64 + 4 * (c0 ^ (tt & 15))) + *(const LAS f32x4*)(YY + tt * 64 + p0), y1 = *(const LAS f32x4*)(YA + tt * 64 + 4 * ((c0 + 1) ^ (tt & 15))) + *(const LAS f32x4*)(YY + tt * 64 + p0 + 4);
            if (tt >= 32) { const v4u ow4 = *(const LAS v4u*)((const LAS unsigned char*)YO + (tt - 32) * 128 + 16 * ((tid & 7) ^ (tt & 7)));
                y0 = y0 + (f32x4){bf2f(ow4.x & 0xffffu), __uint_as_float(ow4.x & 0xffff0000u), bf2f(ow4.y & 0xffffu), __uint_as_float(ow4.y & 0xffff0000u)};
                y1 = y1 + (f32x4){bf2f(ow4.z & 0xffffu), __uint_as_float(ow4.z & 0xffff0000u), bf2f(ow4.w & 0xffffu), __uint_as_float(ow4.w & 0xffff0000u)}; }
            float o[8]; float sq = 0.f;
#pragma unroll
            for (int j = 0; j < 8; ++j) { const unsigned z16 = (zw[j >> 1] >> ((j & 1) * 16)) & 0xffffu; const float yv = (j < 4 ? y0[j & 3] : y1[j & 3]) * silu_f(bf2f(z16)); o[j] = yv; sq += yv * yv; }
            ow_pend.x = pk2(o[0], o[1]); ow_pend.y = pk2(o[2], o[3]); ow_pend.z = pk2(o[4], o[5]); ow_pend.w = pk2(o[6], o[7]);
            sq += __int_as_float(__builtin_amdgcn_update_dpp(0, __float_as_int(sq), 0x104, 0xf, 0xf, true));
            sq += __int_as_float(__builtin_amdgcn_update_dpp(0, __float_as_int(sq), 0x102, 0xf, 0xf, true));
            sq += __int_as_float(__builtin_amdgcn_update_dpp(0, __float_as_int(sq), 0x101, 0xf, 0xf, true)); sq_pend = sq; pend = true; } }
        }
    }
    if (pend) { const size_t prow = row_base + (L - 64) + (tid >> 3); *(v4u*)(YG + prow * 2048 + h * 64 + (tid & 7) * 8) = ow_pend; if ((tid & 7) == 0) SSQ[prow * 32 + h] = sq_pend; }
#define SSD_STOUT(HX, TILE) { float* st_g = st_base + (size_t)(32 * ((TILE) & 1)) * 128 + 32 * ((TILE) >> 1); \
        _Pragma("unroll") for (int q4 = 0; q4 < 4; ++q4) *(f32x4*)(st_g + 8 * q4) = (f32x4){HX[4 * q4], HX[4 * q4 + 1], HX[4 * q4 + 2], HX[4 * q4 + 3]}; }
    if (w == 3) { SSD_STOUT(H0, 0) SSD_STOUT(H1, 1) SSD_STOUT(H2, 2) SSD_STOUT(H3, 3) } else if (w >= 4) { SSD_STOUT(H0, w) }
#undef SSD_STOUT
#undef SSD_UPD
#undef SSD_PUBLISH
    __syncthreads();
}
__device__ __forceinline__ float tr_reduce32(const float (&v)[32], int lane) {
    const bool b4 = lane & 16, b3 = lane & 8, b2 = lane & 4, b1 = lane & 2, b0 = lane & 1;
    float a[16], b[8], c[4], d[2];
#pragma unroll
    for (int i = 0; i < 16; ++i) { const float keep = b4 ? v[i + 16] : v[i], send = b4 ? v[i] : v[i + 16]; a[i] = keep + __shfl_xor(send, 16); }
#pragma unroll
    for (int i = 0; i < 8; ++i) { const float keep = b3 ? a[i + 8] : a[i], send = b3 ? a[i] : a[i + 8]; b[i] = keep + __shfl_xor(send, 8); }
#pragma unroll
    for (int i = 0; i < 4; ++i) { const float keep = b2 ? b[i + 4] : b[i], send = b2 ? b[i] : b[i + 4]; c[i] = keep + __shfl_xor(send, 4); }
#pragma unroll
    for (int i = 0; i < 2; ++i) { const float keep = b1 ? c[i + 2] : c[i], send = b1 ? c[i] : c[i + 2]; d[i] = keep + __shfl_xor(send, 2); }
    const float keep = b0 ? d[1] : d[0], send = b0 ? d[0] : d[1];
    return keep + __shfl_xor(send, 1);
}
__device__ __forceinline__ void ssd_sample_unit(Frame& F, int sb, int g) {
    int tid_o = F.tid; asm volatile("" : "+v"(tid_o));
    const int tid = tid_o, lane = tid & 63, w = F.wave, hh = lane >> 5, nq = lane & 31; unsigned char* ws = F.ws;
    LAS float* XC = (LAS float*)(F.lds + RING_OFF); LAS float* BC = XC + 8 * 4 * 64; LAS float* CC = BC + 4 * 128; LAS float* DTS = CC + 4 * 128;
    const bf16* PROJ = (const bf16*)(ws + WS_PROJ); const float* DTR = (const float*)(ws + WS_DT); bf16* YG = (bf16*)(ws + WS_YG); float* SSQ = (float*)(ws + WS_SSQSSD);
    const size_t row0 = (size_t)TP + (size_t)sb * LS;
    const int h = 8 * g + w;
    const float* sp = F.in[3] + (size_t)(sb * 32 + h) * 8192 + (size_t)hh * 128 + 4 * nq;
    f32x4 hst[32];
#pragma unroll
    for (int i = 0; i < 32; ++i) hst[i] = ld_nt(sp + (size_t)i * 256);
    if (tid < 384) { typedef float f32x2 __attribute__((ext_vector_type(2)));
        const int col = tid < 256 ? g * 512 + 2 * tid : (tid < 320 ? 2048 + g * 128 + 2 * (tid - 256) : 2560 + g * 128 + 2 * (tid - 320));
        const float* cw = F.in[10]; const float* sc = F.in[4] + (size_t)sb * 3 * 3072 + col;
        const f32x2 w0 = *(const f32x2*)(cw + col), w1 = *(const f32x2*)(cw + 3072 + col), w2 = *(const f32x2*)(cw + 2 * 3072 + col), w3 = *(const f32x2*)(cw + 3 * 3072 + col), cb = *(const f32x2*)(F.in[11] + col);
        f32x2 full[7]; full[0] = *(const f32x2*)sc; full[1] = *(const f32x2*)(sc + 3072); full[2] = *(const f32x2*)(sc + 2 * 3072);
        const bf16* cp = PROJ + (size_t)(S_X0 + (col >> 10)) * SLOT_ELEMS + row0 * 1024 + (col & 1023);
#pragma unroll
        for (int t = 0; t < 4; ++t) { const unsigned wd = *(const unsigned*)(cp + (size_t)t * 1024); full[3 + t] = (f32x2){__uint_as_float(wd << 16), __uint_as_float(wd & 0xffff0000u)}; }
#pragma unroll
        for (int t = 0; t < 4; ++t) { f32x2 a = w0 * full[t] + cb; a = w1 * full[t + 1] + a; a = w2 * full[t + 2] + a; a = w3 * full[t + 3] + a;
            f32x2 o; o.x = silu_f(a.x); o.y = silu_f(a.y);
            LAS float* dst = tid < 256 ? XC + ((tid >> 5) * 4 + t) * 64 + 2 * (tid & 31) : (tid < 320 ? BC + t * 128 + 2 * (tid - 256) : CC + t * 128 + 2 * (tid - 320));
            *(LAS f32x2*)dst = o; }
    } else if (tid < 416) { const int idx = tid - 384, hl = idx >> 2, t = idx & 3; const float x = DTR[(row0 + t) * 32 + 8 * g + hl] + F.in[12][8 * g + hl]; DTS[idx] = x > 20.f ? x : log1pf(__expf(x)); }
    __syncthreads();
    const float a = -__expf(F.in[13][h]), Dk = F.in[14][h];
#pragma unroll 1
    for (int t = 0; t < 4; ++t) {
        const float dtv = DTS[w * 4 + t], dA = __expf(dtv * a);
        const f32x4 Bv = *(const LAS f32x4*)(BC + t * 128 + 4 * nq), Cv = *(const LAS f32x4*)(CC + t * 128 + 4 * nq);
        const LAS float* xrow = XC + (w * 4 + t) * 64;
        float part[32];
#pragma unroll
        for (int i = 0; i < 32; ++i) { const float xd = xrow[2 * i + hh] * dtv; hst[i] = hst[i] * dA + Bv * xd; part[i] = (hst[i].x * Cv.x + hst[i].y * Cv.y) + (hst[i].z * Cv.z + hst[i].w * Cv.w); }
        float yv = tr_reduce32(part, lane);
        const int p = 2 * nq + hh; const size_t row = row0 + t;
        yv += Dk * xrow[p];
        const float z = bf2f(PROJ[(size_t)(S_Z0 + (h >> 4)) * SLOT_ELEMS + row * 1024 + (h & 15) * 64 + p]);
        const float yg = yv * silu_f(z);
        YG[row * 2048 + h * 64 + p] = (bf16)f2bf(yg);
        const float sq = wave_sum(yg * yg);
        if (lane == 0) SSQ[row * 32 + h] = sq;
    }
    float* so = F.out + O_SSMS + (size_t)(sb * 32 + h) * 8192 + (size_t)hh * 128 + 4 * nq;
#pragma unroll
    for (int i = 0; i < 32; ++i) st_nt(so + (size_t)i * 256, hst[i]);
    __syncthreads();
}
__device__ __forceinline__ void hgrn_sample_unit(Frame& F, int sb, int hq) {
    int tid_o = F.tid; asm volatile("" : "+v"(tid_o));
    const int tid = tid_o, lane = tid & 63, w = F.wave, hh = lane >> 5, vq = lane & 31; unsigned char* ws = F.ws;
    LAS float* FS = (LAS float*)(F.lds + RING_OFF); LAS float* KS = FS + 2048; LAS float* QS = KS + 2048; LAS float* VS = QS + 2048; LAS float* OP = VS + 2048;
    const bf16* PROJ = (const bf16*)(ws + WS_PROJ); bf16* ON = (bf16*)(ws + WS_ON);
    const size_t row0 = (size_t)TP + (size_t)sb * LS;
    const int hl = w >> 1, kh = w & 1, hd = 4 * hq + hl;
    const float* sp = F.in[5] + (size_t)(sb * 8 + hd) * 16384 + (size_t)(64 * kh + hh) * 128 + 4 * vq;
    f32x4 S[32];
#pragma unroll
    for (int i = 0; i < 32; ++i) S[i] = ld_nt(sp + (size_t)i * 256);
    { const int ch = hq * 512 + tid; const float lb = __builtin_amdgcn_rcpf(1.0f + __expf(F.in[17][1024 + ch] - F.in[17][ch]));
      const bf16* fp = PROJ + (size_t)S_F * SLOT_ELEMS + row0 * 1024 + ch; const bf16* qp = PROJ + (size_t)S_Q * SLOT_ELEMS + row0 * 1024 + ch; const bf16* ip = PROJ + (size_t)S_I * SLOT_ELEMS + row0 * 1024 + ch;
#pragma unroll
      for (int t = 0; t < 4; ++t) { const float u = fminf(fmaxf(bf2f(fp[(size_t)t * 1024]), -30.f), 30.f); const float fg = lb + (1.0f - lb) * sigmoid_f(u);
          const int o = ((tid >> 7) * 4 + t) * 128 + (tid & 127);
          FS[o] = fg; KS[o] = 1.0f - fg; QS[o] = silu_f(bf2f(qp[(size_t)t * 1024])); VS[o] = bf2f(ip[(size_t)t * 1024]); } }
    __syncthreads();
#pragma unroll 1
    for (int t = 0; t < 4; ++t) {
        const int o = (hl * 4 + t) * 128;
        const f32x4 vv = *(const LAS f32x4*)(VS + o + 4 * vq);
        f32x4 oa = (f32x4){0.f, 0.f, 0.f, 0.f};
#pragma unroll
        for (int i = 0; i < 32; ++i) { const int k = 64 * kh + 2 * i + hh; const float fk = FS[o + k], kv = KS[o + k], qk = QS[o + k]; S[i] = S[i] * fk + vv * kv; oa = oa + S[i] * qk; }
        oa.x += __shfl_xor(oa.x, 32); oa.y += __shfl_xor(oa.y, 32); oa.z += __shfl_xor(oa.z, 32); oa.w += __shfl_xor(oa.w, 32);
        if (hh == 0) *(LAS f32x4*)(OP + ((hl * 4 + t) * 2 + kh) * 128 + 4 * vq) = oa;
    }
    float* so = F.out + O_HGS + (size_t)(sb * 8 + hd) * 16384 + (size_t)(64 * kh + hh) * 128 + 4 * vq;
#pragma unroll
    for (int i = 0; i < 32; ++i) st_nt(so + (size_t)i * 256, S[i]);
    __syncthreads();
#pragma unroll
    for (int rr2 = 0; rr2 < 2; ++rr2) { const int rr = 2 * w + rr2, ohl = rr >> 2, t = rr & 3, ohd = 4 * hq + ohl; typedef float f32x2 __attribute__((ext_vector_type(2)));
        const f32x2 p0 = *(const LAS f32x2*)(OP + (rr * 2) * 128 + 2 * lane), p1 = *(const LAS f32x2*)(OP + (rr * 2 + 1) * 128 + 2 * lane);
        const float o0 = p0.x + p1.x, o1 = p0.y + p1.y; const float sq = wave_sum(o0 * o0 + o1 * o1); const float rs = __builtin_amdgcn_rsqf(sq * (1.0f / 128.0f) + EPS);
        const size_t row = row0 + t; const unsigned gw = *(const unsigned*)(PROJ + (size_t)S_HG * SLOT_ELEMS + row * 1024 + ohd * 128 + 2 * lane);
        *(unsigned*)(ON + row * 1024 + ohd * 128 + 2 * lane) = pk2(o0 * rs * silu_f(bf2f(gw & 0xffffu)), o1 * rs * silu_f(__uint_as_float(gw & 0xffff0000u))); }
    __syncthreads();
}
constexpr int U_HGS = NBS * 2, U_SSDS = NBS * 4, U_CONV = NBP + NBS;
__device__ __forceinline__ void scan_phase(Frame& F) {
    gu32* head = F.ctl + CW_QUEUE;
#define SCAN_QUEUE(qi, count, body) for (;;) { if (F.tid == 0) F.MISC[0] = __hip_atomic_fetch_add(head + 64 * (qi), 1u, RLX_AGENT); __syncthreads(); const int u = (int)F.MISC[0]; __syncthreads(); if (u >= (count)) break; body }
    SCAN_QUEUE(1, NBP * 32, ssd_unit_mfma(F, u >> 5, u & 31);)
    SCAN_QUEUE(0, NBP * 32, hgrn_v_unit(F, u >> 5, (u >> 2) & 7, u & 3);)
    SCAN_QUEUE(2, U_HGS, hgrn_sample_unit(F, u >> 1, u & 1);)
    SCAN_QUEUE(3, U_SSDS + U_CONV, if (u >= U_SSDS) { conv_copy_unit(F, u - U_SSDS); continue; } ssd_sample_unit(F, u >> 2, u & 3);)
#undef SCAN_QUEUE
}
typedef float f32x4s __attribute__((ext_vector_type(4)));
template <class Epi> __device__ __forceinline__ void small_tile_phase(Frame& F, const bf16* A, const bf16* Bt, int K, const Epi& E) {
    const int lane = F.lane, w = F.wave, r = lane & 31, hh = lane >> 5;
#pragma unroll 1
    for (int v = F.vcu; v < 256; v += F.G) {
    const int mt = v >> 4, nt = v & 15;
    const int kw = K >> 3;
    const bf16* ap = A + (size_t)(TP + 32 * mt + r) * K + w * kw + 8 * hh;
    const bf16* bp = Bt + (size_t)(64 * nt + r) * K + w * kw + 8 * hh;
    f32x16 acc0, acc1;
#pragma unroll
    for (int i = 0; i < 16; ++i) { acc0[i] = 0.f; acc1[i] = 0.f; }
#pragma unroll 4
    for (int ks = 0; ks < kw / 16; ++ks) { const bf16x8 af = *(const bf16x8*)(ap + 16 * ks), b0 = *(const bf16x8*)(bp + 16 * ks), b1 = *(const bf16x8*)(bp + (size_t)32 * K + 16 * ks);
        acc0 = MFMA32(b0, af, acc0); acc1 = MFMA32(b1, af, acc1); }
    LAS float* part = (LAS float*)(F.lds + RING_OFF) + w * 2048;
#pragma unroll
    for (int q4 = 0; q4 < 4; ++q4) { *(LAS f32x4*)(part + r * 64 + 8 * q4 + 4 * hh) = (f32x4){acc0[4 * q4], acc0[4 * q4 + 1], acc0[4 * q4 + 2], acc0[4 * q4 + 3]};
        *(LAS f32x4*)(part + r * 64 + 32 + 8 * q4 + 4 * hh) = (f32x4){acc1[4 * q4], acc1[4 * q4 + 1], acc1[4 * q4 + 2], acc1[4 * q4 + 3]}; }
    __syncthreads();
    const int rl = F.tid >> 4, c4 = (F.tid & 15) * 4; const LAS float* src = (const LAS float*)(F.lds + RING_OFF) + rl * 64 + c4;
    f32x4 sum = *(const LAS f32x4*)src;
#pragma unroll
    for (int ww = 1; ww < 8; ++ww) sum = sum + *(const LAS f32x4*)(src + ww * 2048);
    const f32x4s acc = (f32x4s){sum.x, sum.y, sum.z, sum.w};
    E.small(F, acc, TP + 32 * mt + rl, 64 * nt + c4, nt);
    __syncthreads();
    }
}
template <bool ADD> struct SmGate { bf16* O; const bf16* gate;
    __device__ __forceinline__ void small(Frame&, const f32x4s& a, int row, int col, int) const { const size_t off = (size_t)row * 1024 + col;
        const v2u gw = __builtin_nontemporal_load((const v2u*)(gate + off)); v2u ow = (v2u){0u, 0u}; if (ADD) ow = *(const v2u*)(O + off);
        float rr[4];
#pragma unroll
        for (int e = 0; e < 4; ++e) { const unsigned g16 = (gw[e >> 1] >> ((e & 1) * 16)) & 0xffffu, o16 = (ow[e >> 1] >> ((e & 1) * 16)) & 0xffffu; rr[e] = (ADD ? bf2f(o16) : 0.f) + sigmoid_f(bf2f(g16)) * a[e]; }
        v2u wv; wv.x = cvtpk_c(rr[0], rr[1]); wv.y = cvtpk_c(rr[2], rr[3]); *(v2u*)(O + off) = wv; } };
template <bool BF, bool BSC = false> struct SmRes { const float* base; const bf16* bb; bf16* hb; float* ssqp; const float* bsc;
    __device__ __forceinline__ void small(Frame& F, const f32x4s& a, int row, int col, int nt) const { const size_t off = (size_t)row * 1024 + col; f32x4 b;
        if (BF) { const v2u w = *(const v2u*)(bb + off); b = (f32x4){bf2f(w.x & 0xffffu), __uint_as_float(w.x & 0xffff0000u), bf2f(w.y & 0xffffu), __uint_as_float(w.y & 0xffff0000u)}; }
        else b = *(const f32x4*)(base + off);
        if constexpr (BSC) b = b * bsc[row];
        const f32x4 v = b + (f32x4){a[0], a[1], a[2], a[3]};
        { v2u wv; wv.x = cvtpk_c(v[0], v[1]); wv.y = cvtpk_c(v[2], v[3]); *(v2u*)(hb + off) = wv; }
        float sq = (v[0] * v[0] + v[1] * v[1]) + (v[2] * v[2] + v[3] * v[3]); sq += __shfl_xor(sq, 1); sq += __shfl_xor(sq, 2); sq += __shfl_xor(sq, 4); sq += __shfl_xor(sq, 8);
        if ((F.tid & 15) == 0) ssqp[(size_t)row * 16 + nt] = sq; } };
struct SmScale { bf16* O; const float* ssq; float scale;
    __device__ __forceinline__ void small(Frame&, const f32x4s& a, int row, int col, int) const { const float rs = pg8::row_rs<16>(ssq, row) * scale;
        v2u wv; wv.x = cvtpk_c(a[0] * rs, a[1] * rs); wv.y = cvtpk_c(a[2] * rs, a[3] * rs); *(v2u*)(O + (size_t)row * 1024 + col) = wv; } };
__device__ __forceinline__ void attn_stage_tile(LAS unsigned char* Lb, const bf16* src, size_t pitch, int tid) {
#pragma unroll 1
    for (int hb = 0; hb < 2; ++hb) { v4u v[8];
#pragma unroll
        for (int i = 0; i < 8; ++i) { const int id = tid + 512 * (8 * hb + i), row = id >> 5, c = id & 31; v[i] = *(const v4u*)(src + (size_t)row * pitch + c * 8); }
#pragma unroll
        for (int i = 0; i < 8; ++i) { const int id = tid + 512 * (8 * hb + i), row = id >> 5, c = id & 31; *(LAS v4u*)(Lb + row * 512 + ((c ^ (row & 15)) << 4)) = v[i]; } }
}
__device__ __forceinline__ void attn_prompt_unit(Frame& F, int b, int hd, int qb) {
    const int tid = F.tid, lane = F.lane, w = F.wave, r = lane & 31, hh = lane >> 5; unsigned char* ws = F.ws;
    LAS unsigned char* Lb = F.lds + RING_OFF;
    const bf16* QB = (const bf16*)(ws + WS_QB); const bf16* KB = (const bf16*)(ws + WS_KB); const bf16* VT = (const bf16*)(ws + WS_VT); bf16* OB = (bf16*)(ws + WS_OB);
    const size_t qrow = (size_t)b * SEQ + (size_t)qb * 256 + 32 * w + r;
    attn_stage_tile(Lb, KB + (size_t)b * 256 * 1024 + hd * 256, 1024, tid);
    const bf16* qp = QB + qrow * 1024 + hd * 256 + 8 * hh;
    bf16x8 qf = *(const bf16x8*)qp;
    __syncthreads();
    f32x16 S[8];
#pragma unroll
    for (int t = 0; t < 8; ++t)
#pragma unroll
        for (int i = 0; i < 16; ++i) S[t][i] = 0.f;
    const int sw = r & 15;
#pragma unroll 1
    for (int ks = 0; ks < 16; ++ks) {
        const bf16x8 qn = *(const bf16x8*)(qp + 16 * (ks < 15 ? ks + 1 : ks));
        const LAS unsigned char* kp = Lb + r * 512 + (((2 * ks + hh) ^ sw) << 4);
#pragma unroll
        for (int t = 0; t < 8; ++t) S[t] = MFMA32(lds_frag16(kp + t * 32 * 512), qf, S[t]);
        qf = qn;
    }
    float m = -3.0e38f;
#pragma unroll
    for (int t = 0; t < 8; ++t)
#pragma unroll
        for (int i = 0; i < 16; ++i) m = fmaxf(m, S[t][i]);
    m = fmaxf(m, __shfl_xor(m, 32));
    float l = 0.f;
#pragma unroll
    for (int t = 0; t < 8; ++t)
#pragma unroll
        for (int i = 0; i < 16; ++i) { const float pv = __builtin_amdgcn_exp2f(S[t][i] - m); S[t][i] = pv; l += pv; }
    l += __shfl_xor(l, 32);
    const float rl = __builtin_amdgcn_rcpf(l);
    bf16x8 pf[8][2];
#pragma unroll
    for (int t = 0; t < 8; ++t) { pf[t][0] = ACC_FRAG(S[t], 0); pf[t][1] = ACC_FRAG(S[t], 1); }
    __syncthreads();
    attn_stage_tile(Lb, VT + (size_t)(b * 4 + hd) * 256 * 256, 256, tid);
    __syncthreads();
    bf16* op = OB + qrow * 1024 + hd * 256 + 4 * hh;
#pragma unroll 1
    for (int dt = 0; dt < 8; ++dt) {
        f32x16 O;
#pragma unroll
        for (int i = 0; i < 16; ++i) O[i] = 0.f;
        const LAS unsigned char* vrow = Lb + (32 * dt + r) * 512 + 8 * hh;
#pragma unroll
        for (int t = 0; t < 8; ++t)
#pragma unroll
            for (int s2 = 0; s2 < 2; ++s2) {
                const v2u lo = *(const LAS v2u*)(vrow + (((4 * t + 2 * s2) ^ sw) << 4)), hi = *(const LAS v2u*)(vrow + (((4 * t + 2 * s2 + 1) ^ sw) << 4));
                const v4u wv4 = (v4u){lo.x, lo.y, hi.x, hi.y};
                O = MFMA32(__builtin_bit_cast(bf16x8, wv4), pf[t][s2], O);
            }
#pragma unroll
        for (int q4 = 0; q4 < 4; ++q4) { v2u o; o.x = cvtpk_c(O[4 * q4] * rl, O[4 * q4 + 1] * rl); o.y = cvtpk_c(O[4 * q4 + 2] * rl, O[4 * q4 + 3] * rl);
            *(v2u*)(op + 32 * dt + 8 * q4) = o; }
    }
    __syncthreads();
}
__device__ __forceinline__ void attn_sample_unit(Frame& F, int sb, int hd) {
    const int tid = F.tid, lane = F.lane, w = F.wave; unsigned char* ws = F.ws;
    LAS float* sc = (LAS float*)(F.lds + RING_OFF);
    LAS float* red = sc + 4 * 256;
    const bf16* QB = (const bf16*)(ws + WS_QB); bf16* OB = (bf16*)(ws + WS_OB);
    const size_t rowq = (size_t)TP + (size_t)sb * LS;
    float q[4][4];
#pragma unroll
    for (int t = 0; t < 4; ++t) { const v2u qw = *(const v2u*)(QB + (rowq + t) * 1024 + hd * 256 + 4 * lane); q[t][0] = bf2f(qw.x & 0xffffu); q[t][1] = bf2f(qw.x >> 16); q[t][2] = bf2f(qw.y & 0xffffu); q[t][3] = bf2f(qw.y >> 16); }
    const float* Kc = F.in[6] + ((size_t)sb * 256 * 4 + hd) * 256 + 4 * lane; const float* Vc = F.in[7] + ((size_t)sb * 256 * 4 + hd) * 256 + 4 * lane;
    f32x4 kv[8], kn[8];
#pragma unroll
    for (int u = 0; u < 8; ++u) kv[u] = ld_nt(Kc + (size_t)(w * 32 + u) * 1024);
#pragma unroll 1
    for (int kk0 = 0; kk0 < 32; kk0 += 8) {
#pragma unroll
        for (int u = 0; u < 8; ++u) kn[u] = kk0 < 24 ? ld_nt(Kc + (size_t)(w * 32 + kk0 + 8 + u) * 1024) : ld_nt(Vc + (size_t)(w * 32 + u) * 1024);
        { float part[32];
#pragma unroll
          for (int u = 0; u < 8; ++u)
#pragma unroll
              for (int t = 0; t < 4; ++t) part[4 * u + t] = (q[t][0] * kv[u].x + q[t][1] * kv[u].y) + (q[t][2] * kv[u].z + q[t][3] * kv[u].w);
          float sv = tr_reduce32(part, lane); sv += __shfl_xor(sv, 32);
          if (lane < 32) sc[(lane & 3) * 256 + w * 32 + kk0 + (lane >> 2)] = sv; }
#pragma unroll
        for (int u = 0; u < 8; ++u) kv[u] = kn[u]; }
    __syncthreads();
    if (w < 4) { float v[4]; float m = -3.0e38f;
#pragma unroll
        for (int j = 0; j < 4; ++j) { v[j] = sc[w * 256 + j * 64 + lane]; m = fmaxf(m, v[j]); }
        m = wave_max(m); float l = 0.f;
#pragma unroll
        for (int j = 0; j < 4; ++j) { v[j] = __builtin_amdgcn_exp2f(v[j] - m); l += v[j]; }
        l = wave_sum(l); const float rl = 1.0f / l;
#pragma unroll
        for (int j = 0; j < 4; ++j) sc[w * 256 + j * 64 + lane] = v[j] * rl; }
    __syncthreads();
    float o[4][4];
#pragma unroll
    for (int t = 0; t < 4; ++t)
#pragma unroll
        for (int e = 0; e < 4; ++e) o[t][e] = 0.f;
#pragma unroll 1
    for (int kk0 = 0; kk0 < 32; kk0 += 8) {
        if (kk0 < 24) {
#pragma unroll
            for (int u = 0; u < 8; ++u) kn[u] = ld_nt(Vc + (size_t)(w * 32 + kk0 + 8 + u) * 1024); }
#pragma unroll
        for (int u = 0; u < 8; ++u) { const int key = w * 32 + kk0 + u;
#pragma unroll
            for (int t = 0; t < 4; ++t) { const float pr = sc[t * 256 + key]; o[t][0] += pr * kv[u].x; o[t][1] += pr * kv[u].y; o[t][2] += pr * kv[u].z; o[t][3] += pr * kv[u].w; } }
#pragma unroll
        for (int u = 0; u < 8; ++u) kv[u] = kn[u]; }
#pragma unroll
    for (int t = 0; t < 4; ++t) *(LAS f32x4*)(red + (w * 4 + t) * 256 + 4 * lane) = (f32x4){o[t][0], o[t][1], o[t][2], o[t][3]};
    __syncthreads();
    { const int t = tid >> 7, d0 = (tid & 127) * 2; float a0 = 0.f, a1 = 0.f;
#pragma unroll
      for (int ww = 0; ww < 8; ++ww) { a0 += red[(ww * 4 + t) * 256 + d0]; a1 += red[(ww * 4 + t) * 256 + d0 + 1]; }
      *(unsigned*)(OB + (rowq + t) * 1024 + hd * 256 + d0) = pk2(a0, a1); }
    __syncthreads();
}
__device__ __forceinline__ void attn_phase(Frame& F) {
    for (int u = F.vcu; u < NBP * 4 * 8; u += F.G) attn_prompt_unit(F, u >> 5, (u >> 3) & 3, u & 7);
    for (int u = F.vcu; u < NBS * 4; u += F.G) attn_sample_unit(F, u >> 2, u & 3);
}
__device__ __forceinline__ void final_norm_phase(Frame& F) {
    const int gw = F.vcu * NWAVES + F.wave, NGW = F.G * NWAVES; const float* SSQ = (const float*)(F.ws + WS_SSQP3); const float* wn = F.in[31]; const bf16* HB = (const bf16*)(F.ws + WS_HB);
    f32x4 wv[4];
#pragma unroll
    for (int j = 0; j < 2; ++j) { wv[2 * j] = *((const f32x4*)wn + 2 * (64 * j + F.lane)); wv[2 * j + 1] = *((const f32x4*)wn + 2 * (64 * j + F.lane) + 1); }
    for (int row = gw; row < T; row += NGW) {
        const f32x4* sp = (const f32x4*)(SSQ + (size_t)row * 16); float s = 0.f;
#pragma unroll
        for (int j = 0; j < 4; ++j) { const f32x4 a = sp[j]; s += (a.x + a.y) + (a.z + a.w); }
        const float rs = __builtin_amdgcn_rsqf(s * (1.0f / 1024.0f) + EPS);
#pragma unroll
        for (int j = 0; j < 2; ++j) { const int pc = 64 * j + F.lane; const v4u w = ld_nt16((const v4u*)(HB + (size_t)row * 1024) + pc);
            const f32x4 v0 = (f32x4){bf2f(w.x & 0xffffu), __uint_as_float(w.x & 0xffff0000u), bf2f(w.y & 0xffffu), __uint_as_float(w.y & 0xffff0000u)};
            const f32x4 v1 = (f32x4){bf2f(w.z & 0xffffu), __uint_as_float(w.z & 0xffff0000u), bf2f(w.w & 0xffffu), __uint_as_float(w.w & 0xffff0000u)};
            float* o = F.out + O_Y + (size_t)row * 1024 + 8 * pc; st_nt(o, v0 * rs * wv[2 * j]); st_nt(o + 4, v1 * rs * wv[2 * j + 1]); }
    }
}
#ifndef MK_N_LAUNCHES
#define MK_N_LAUNCHES 1
#endif
constexpr int PER_PHASE = 13;
constexpr int N_LAUNCHES = MK_N_LAUNCHES;
struct Args { const float* in[32]; float* out; unsigned char* ws; int ph_lo, ph_hi; };
__global__ void __launch_bounds__(NTHR, 2) skel_fwd(Args args) {
    extern __shared__ __attribute__((aligned(16))) unsigned char lds[];
    Frame F;
    F.lds = (LAS unsigned char*)lds;
    F.MISC = (volatile LAS unsigned*)(F.lds + MISC_OFF);
    F.tid = threadIdx.x; F.lane = F.tid & 63; F.wave = __builtin_amdgcn_readfirstlane(F.tid >> 6);
    F.G = gridDim.x; { const int bx = blockIdx.x; F.vcu = (F.G % 8 == 0) ? (bx % 8) * (F.G / 8) + bx / 8 : bx; }
    unsigned char* ws = args.ws; F.ws = ws; F.out = args.out;
    F.ctl = (gu32*)(ws + WS_CTL);
#pragma unroll
    for (int i = 0; i < 32; ++i) F.in[i] = args.in[i];
    for (int u = F.tid; u < (LDS_BYTES - LDSCTL_OFF) / 4; u += NTHR) ((LAS unsigned*)(F.lds + LDSCTL_OFF))[u] = 0u;
    __syncthreads();
    XcdBarrier bar; bar.bar = (unsigned*)(F.ctl + CW_BAR); bar.x = 0; bar.st = nullptr;
    if (N_LAUNCHES == 1) bar = xcd_barrier_post((unsigned*)(F.ctl + CW_BAR), F.MISC + 8);
#define GRID_BAR() do { if (N_LAUNCHES == 1) xcd_barrier(bar); } while (0)
    const int lo = args.ph_lo, hi = args.ph_hi;
#ifdef ONLY_PHASE
#define IN(k) ((k) == ONLY_PHASE && lo <= (k) && (k) < hi)
#else
#define IN(k) (lo <= (k) && (k) < hi)
#endif
#define BOTH(k) (IN(k) && IN((k) + 1))
    bf16* const XB = (bf16*)(ws + WS_XB); bf16* const PROJ = (bf16*)(ws + WS_PROJ);
    float* const Y = F.out + O_Y;
    if (IN(0)) { p0_prologue(F); if (BOTH(0)) GRID_BAR(); }
    if (IN(1)) {
        { pg8::Gemm g{XB, (const bf16*)(ws + WS_WIN), T, NPROJ, 1024}; pg8::StaticOrder S; S.init(T, NPROJ, F.G, (int)blockIdx.x);
          pg8::EpiScaleBf16<0, true> E{PROJ, SLOT_ELEMS, nullptr, 1.0f, (float*)(ws + WS_DT)};
          pg8::gemm_phase<pg8::EpiScaleBf16<0, true>, pg8::StaticOrder, true, true>(F.lds + RING_OFF, g, S, E); }
        { pg8::Gemm g{(const bf16*)(ws + WS_MNB), (const bf16*)(ws + WS_WKV), MEMR, 2048, 1024}; pg8::StaticOrder S; S.init(MEMR, 2048, F.G, (int)((blockIdx.x + 64) % F.G));
          pg8::EpiKV E{F.out + O_MKP, F.out + O_MVP, (bf16*)(ws + WS_KB), (bf16*)(ws + WS_VT), (const float*)(ws + WS_SSQM)};
          pg8::gemm_phase<pg8::EpiKV, pg8::StaticOrder, true, true>(F.lds + RING_OFF, g, S, E); }
        if (BOTH(1)) GRID_BAR();
    }
    if (IN(2)) { bc_prep_phase(F); hg_prep_phase(F); if (BOTH(2)) GRID_BAR(); }
    if (IN(3)) { scan_phase(F); if (BOTH(3)) GRID_BAR(); }
    if (IN(4)) { ssdnorm_phase(F); hgnorm_phase(F); if (BOTH(4)) GRID_BAR(); }
    if (IN(5)) { { SmGate<false> Es{(bf16*)(ws + WS_MERGED), PROJ + (size_t)S_GS * SLOT_ELEMS}; small_tile_phase(F, (const bf16*)(ws + WS_YG), (const bf16*)(ws + WS_WSSD), 2048, Es); }
        pg8::Gemm g{(const bf16*)(ws + WS_YG), (const bf16*)(ws + WS_WSSD), TP, 1024, 2048}; pg8::StaticOrder S; S.init(TP, 1024, F.G, (int)blockIdx.x);
        pg8::EpiGate<false> E{(bf16*)(ws + WS_MERGED), PROJ + (size_t)S_GS * SLOT_ELEMS};
        pg8::gemm_phase<pg8::EpiGate<false>, pg8::StaticOrder, true, true>(F.lds + RING_OFF, g, S, E);
          }
    if (IN(5)) { { SmGate<true> Es{(bf16*)(ws + WS_MERGED), PROJ + (size_t)S_GH * SLOT_ELEMS}; small_tile_phase(F, (const bf16*)(ws + WS_ON), (const bf16*)(ws + WS_WHG), 1024, Es); }
        pg8::Gemm g{(const bf16*)(ws + WS_ON), (const bf16*)(ws + WS_WHG), TP, 1024, 1024}; pg8::StaticOrder S; S.init(TP, 1024, F.G, (int)blockIdx.x);
        pg8::EpiGate<true> E{(bf16*)(ws + WS_MERGED), PROJ + (size_t)S_GH * SLOT_ELEMS};
        pg8::gemm_phase<pg8::EpiGate<true>, pg8::StaticOrder, true, true>(F.lds + RING_OFF, g, S, E);
        if (BOTH(5)) GRID_BAR(); }
    if (IN(6)) { { SmRes<true, true> Es{nullptr, XB, (bf16*)(ws + WS_HB), (float*)(ws + WS_SSQP1), (const float*)(ws + WS_SSQX)}; small_tile_phase(F, (const bf16*)(ws + WS_MERGED), (const bf16*)(ws + WS_WOUT), 1024, Es); }
        pg8::Gemm g{(const bf16*)(ws + WS_MERGED), (const bf16*)(ws + WS_WOUT), TP, 1024, 1024}; pg8::StaticOrder S; S.init(TP, 1024, F.G, (int)blockIdx.x);
        pg8::EpiRes<true, true> E{nullptr, nullptr, XB, (bf16*)(ws + WS_HB), (float*)(ws + WS_SSQP1), (const float*)(ws + WS_SSQX)};
        pg8::gemm_phase<pg8::EpiRes<true, true>, pg8::StaticOrder, true, true>(F.lds + RING_OFF, g, S, E);
        if (BOTH(6)) GRID_BAR(); }
    if (IN(7)) { { SmScale Es{(bf16*)(ws + WS_QB), (const float*)(ws + WS_SSQP1), QSCALE}; small_tile_phase(F, (const bf16*)(ws + WS_HB), (const bf16*)(ws + WS_WCQ), 1024, Es); }
        pg8::Gemm g{(const bf16*)(ws + WS_HB), (const bf16*)(ws + WS_WCQ), TP, 1024, 1024}; pg8::StaticOrder S; S.init(TP, 1024, F.G, (int)blockIdx.x);
        pg8::EpiScaleBf16<16, false> E{(bf16*)(ws + WS_QB), SLOT_ELEMS, (const float*)(ws + WS_SSQP1), QSCALE, nullptr};
        pg8::gemm_phase<pg8::EpiScaleBf16<16, false>, pg8::StaticOrder, true, true>(F.lds + RING_OFF, g, S, E);
        if (BOTH(7)) GRID_BAR(); }
    if (IN(8)) { attn_phase(F); if (BOTH(8)) GRID_BAR(); }
    if (IN(9)) { { SmRes<true> Es{nullptr, (const bf16*)(ws + WS_HB), (bf16*)(ws + WS_HB), (float*)(ws + WS_SSQP2)}; small_tile_phase(F, (const bf16*)(ws + WS_OB), (const bf16*)(ws + WS_WCO), 1024, Es); }
        pg8::Gemm g{(const bf16*)(ws + WS_OB), (const bf16*)(ws + WS_WCO), TP, 1024, 1024}; pg8::StaticOrder S; S.init(TP, 1024, F.G, (int)blockIdx.x);
        pg8::EpiRes<true> E{nullptr, nullptr, (const bf16*)(ws + WS_HB), (bf16*)(ws + WS_HB), (float*)(ws + WS_SSQP2)};
        pg8::gemm_phase<pg8::EpiRes<true>, pg8::StaticOrder, true, true>(F.lds + RING_OFF, g, S, E);
        if (BOTH(9)) GRID_BAR(); }
    if (IN(10)) { pg8::Gemm g{(const bf16*)(ws + WS_HB), (const bf16*)(ws + WS_WGU), T, 2 * FFN, 1024}; pg8::StaticOrder S; S.init(T, 2 * FFN, F.G, (int)blockIdx.x);
        pg8::EpiSwiglu E{(bf16*)(ws + WS_ACT), (const float*)(ws + WS_SSQP2)};
        pg8::gemm_phase<pg8::EpiSwiglu, pg8::StaticOrder, true, true>(F.lds + RING_OFF, g, S, E);
        if (BOTH(10)) GRID_BAR(); }
    if (IN(11)) { { SmRes<true> Es{nullptr, (const bf16*)(ws + WS_HB), (bf16*)(ws + WS_HB), (float*)(ws + WS_SSQP3)}; small_tile_phase(F, (const bf16*)(ws + WS_ACT), (const bf16*)(ws + WS_WDN), FFN, Es); }
        pg8::Gemm g{(const bf16*)(ws + WS_ACT), (const bf16*)(ws + WS_WDN), TP, 1024, FFN}; pg8::StaticOrder S; S.init(TP, 1024, F.G, (int)blockIdx.x);
        pg8::EpiRes<true> E{nullptr, nullptr, (const bf16*)(ws + WS_HB), (bf16*)(ws + WS_HB), (float*)(ws + WS_SSQP3)};
        pg8::gemm_phase<pg8::EpiRes<true>, pg8::StaticOrder, true, true>(F.lds + RING_OFF, g, S, E);
        if (BOTH(11)) GRID_BAR(); }
    if (IN(12)) final_norm_phase(F);
#undef IN
#undef BOTH
}

extern "C" void kernel_launch(void* const* d_in, const int* in_sizes, int n_in, void* d_out, int out_size, void* d_ws, size_t ws_size, hipStream_t stream) {
    static int grid = 0;
    if (grid == 0) {
        const int want[32] = {TP * 1024, TS * 1024, MEMR * 1024, 33554432, 1179648, 16777216, 33554432, 33554432, 1024, 1024 * 11296, 4 * 3072, 3072, 32, 32, 32, 2048, 2048 * 1024, 2048, 1024,
                              1024 * 1024, 1024 * 1024, 1024, 1024, 1024 * 1024, 1024 * 1024, 1024 * 1024, 1024 * 1024, 1024, 1024 * FFN, 1024 * FFN, FFN * 1024, 1024};
        bool ok = (n_in == 32); for (int i = 0; ok && i < 32; ++i) if (in_sizes[i] != want[i]) { fprintf(stderr, "kernel_launch: input %d has %d elements, expected %d\n", i, in_sizes[i], want[i]); ok = false; }
        if (!ok || out_size != (int)O_END || ws_size < WS_END4) { fprintf(stderr, "kernel_launch: unexpected shapes: n_in %d out %d ws %zu\n", n_in, out_size, ws_size); grid = -1; return; }
        int dev = 0, cus = 0, per_cu = 0;
        if (hipGetDevice(&dev) != hipSuccess || hipDeviceGetAttribute(&cus, hipDeviceAttributeMultiprocessorCount, dev) != hipSuccess) { grid = -1; return; }
        if (hipFuncSetAttribute((const void*)skel_fwd, hipFuncAttributeMaxDynamicSharedMemorySize, LDS_BYTES) != hipSuccess) { fprintf(stderr, "kernel_launch: hipFuncSetAttribute failed\n"); grid = -1; return; }
        if (hipOccupancyMaxActiveBlocksPerMultiprocessor(&per_cu, (const void*)skel_fwd, NTHR, LDS_BYTES) != hipSuccess || per_cu < 1) fprintf(stderr, "kernel_launch: occupancy query reports %d blocks per CU\n", per_cu);
        (void)hipGetLastError();
        grid = cus;
    }
    if (grid < 0) return;
    (void)hipMemsetAsync((char*)d_ws + WS_CTL, 0, CTL_ZERO_BYTES, stream);
    Args a{};
    for (int i = 0; i < 32; ++i) a.in[i] = (const float*)d_in[i];
    a.out = (float*)d_out; a.ws = (unsigned char*)d_ws;
    for (int li = 0; li < N_LAUNCHES; ++li) {
        a.ph_lo = (N_LAUNCHES == PER_PHASE) ? li : 0; a.ph_hi = (N_LAUNCHES == PER_PHASE) ? li + 1 : PER_PHASE;
        hipLaunchKernelGGL(skel_fwd, dim3(grid), dim3(NTHR), LDS_BYTES, stream, a);
    }
}
```

```cpp
#include <hip/hip_runtime.h>
#include <cstdio>
#include <cstdint>
namespace pg8 {
#define PG8_LAS __attribute__((address_space(3)))
typedef unsigned short bf16_t;
typedef short bf16x8 __attribute__((ext_vector_type(8)));
typedef float f32x4 __attribute__((ext_vector_type(4)));
typedef unsigned u32x4 __attribute__((ext_vector_type(4)));
constexpr int BM = 256, BK = 64, HALF = 128, HTB = HALF * BK * 2  , STAGE_BYTES = 8 * HTB, NXCD = 8, WGM = 8;

__host__ __device__ __forceinline__ int lds_byte(int r, int c) { const int st = (r >> 4) * 2 + (c >> 5), rr = r & 15, cc = c & 31, ob = rr * 64 + cc * 2; return st * 1024 + (ob ^ (((ob >> 9) & 1) << 5)); }
__host__ __device__ __forceinline__ void stage_rc(int b, int& R, int& C) { const int st = b / 1024, sb = b % 1024, swz = sb ^ (((sb >> 9) & 1) << 5); R = (st >> 1) * 16 + swz / 64; C = (st & 1) * 32 + (swz % 64) / 2; }
__host__ __device__ __forceinline__ int perm32(int rho) { const int n = rho >> 4, i = rho & 15; return 8 * (i >> 2) + 4 * n + (i & 3); }

struct Unit { int pm, pn; };
struct Gemm { const bf16_t* A; const bf16_t* Bt; int M, N, K; };

struct StaticOrder {
    int nM, nN, nwg, G, c;
    __host__ __device__ void init(int M, int N, int G_, int c_) { nM = M / BM; nN = N / BM; nwg = nM * nN; G = G_; c = c_; }
    __host__ __device__ bool next(int i, Unit& u) const {
        const long L = (long)i * G + c; if (L >= nwg) return false;
        int wgid = (int)L; { const int q = nwg / NXCD, r = nwg % NXCD, xcd = wgid % NXCD, off = wgid / NXCD; wgid = (xcd < r ? xcd * (q + 1) : r * (q + 1) + (xcd - r) * q) + off; }
        const int nig = WGM * nN, gid = wgid / nig, fm = gid * WGM, gsz = (nM - fm) < WGM ? (nM - fm) : WGM;
        u.pm = fm + ((wgid % nig) % gsz); u.pn = (wgid % nig) / gsz; return true;
    }
    __device__ __forceinline__ void a_ready(const Unit&) const {}
    __device__ __forceinline__ void done(const Unit&) const {}
};

__device__ __forceinline__ unsigned cvt_pk_bf16(float lo, float hi) { unsigned r; asm volatile("v_cvt_pk_bf16_f32 %0, %1, %2" : "=v"(r) : "v"(lo), "v"(hi)); return r; }
typedef float f32x2 __attribute__((ext_vector_type(2)));
typedef unsigned u32x2 __attribute__((ext_vector_type(2)));
constexpr float RMS_EPS = 1e-6f;
__device__ __forceinline__ float bfbits2f(unsigned v16) { return __uint_as_float(v16 << 16); }
__device__ __forceinline__ float sigm(float x) { return __builtin_amdgcn_rcpf(1.0f + __expf(-x)); }
template <int NP> __device__ __forceinline__ float row_rs(const float* ssq, int row) {
    float s = 0.f;
    if constexpr (NP == 1) s = ssq[row];
    else {
#pragma unroll
        for (int i = 0; i < NP / 4; ++i) { const f32x4 v = *(const f32x4*)(ssq + (size_t)row * NP + 4 * i); s += (v[0] + v[1]) + (v[2] + v[3]); }
    }
    return 1.0f / sqrtf(s * (1.0f / 1024.0f) + RMS_EPS);
}
template <int NP, bool HAS_DT> struct EpiScaleBf16 {
    static constexpr bool PERM = true, AFTER_DRAIN = false;
    bf16_t* O; size_t slot_elems; const float* ssq; float scale; float* dt;
    __device__ __forceinline__ void operator()(const f32x4 (&acc)[2][2][4][2], const Unit& u, int wr, int wc, int fr, int fq) const {
        const int row0 = u.pm * BM + wr * 64 + fr;
        if (HAS_DT && u.pn == 44) {
            if (wc == 0) {
#pragma unroll
                for (int ai = 0; ai < 2; ++ai)
#pragma unroll
                    for (int m = 0; m < 4; ++m) { const int row = row0 + ai * HALF + m * 16; float rs = 1.0f; if constexpr (NP > 0) rs = row_rs<NP>(ssq, row);
                        float* p = dt + (size_t)row * 32 + 8 * fq; *(f32x4*)p = acc[ai][0][m][0] * rs; *(f32x4*)(p + 4) = acc[ai][0][m][1] * rs; }
            }
            return;
        }
        bf16_t* base = O + (size_t)(u.pn >> 2) * slot_elems; const int col0 = (u.pn & 3) * BM + wc * 32 + 8 * fq;
#pragma unroll
        for (int ai = 0; ai < 2; ++ai)
#pragma unroll
            for (int m = 0; m < 4; ++m) { const int row = row0 + ai * HALF + m * 16; float rs = scale; if constexpr (NP > 0) rs = row_rs<NP>(ssq, row) * scale; bf16_t* rowp = base + (size_t)row * 1024 + col0;
#pragma unroll
                for (int bj = 0; bj < 2; ++bj) { const f32x4 v0 = acc[ai][bj][m][0] * rs, v1 = acc[ai][bj][m][1] * rs;
                    u32x4 w; w.x = cvt_pk_bf16(v0[0], v0[1]); w.y = cvt_pk_bf16(v0[2], v0[3]); w.z = cvt_pk_bf16(v1[0], v1[1]); w.w = cvt_pk_bf16(v1[2], v1[3]);
                    if (HAS_DT) __builtin_nontemporal_store(w, (u32x4*)(rowp + bj * HALF));
                    else *(u32x4*)(rowp + bj * HALF) = w; } }
    }
};
struct EpiKV {
    static constexpr bool PERM = false, AFTER_DRAIN = false;
    float* mk; float* mv; bf16_t* kb; bf16_t* vt; const float* ssq;
    __device__ __forceinline__ void operator()(const f32x4 (&acc)[2][2][4][2], const Unit& u, int wr, int wc, int fr, int fq) const {
        const int row0 = u.pm * BM + wr * 64 + fr; const bool isv = u.pn >= 4; const int colt = (u.pn & 3) * BM + wc * 32 + 4 * fq;
#pragma unroll
        for (int ai = 0; ai < 2; ++ai)
#pragma unroll
            for (int m = 0; m < 4; ++m) { const int row = row0 + ai * HALF + m * 16; const float rs = 1.0f;
#pragma unroll
                for (int bj = 0; bj < 2; ++bj)
#pragma unroll
                    for (int n = 0; n < 2; ++n) { const int c = colt + bj * HALF + n * 16; const f32x4 v = acc[ai][bj][m][n] * rs;
                        if (!isv) { __builtin_nontemporal_store(v, (f32x4*)(mk + (size_t)row * 1024 + c)); u32x2 w; w.x = cvt_pk_bf16(v[0], v[1]); w.y = cvt_pk_bf16(v[2], v[3]); *(u32x2*)(kb + (size_t)row * 1024 + c) = w; }
                        else { __builtin_nontemporal_store(v, (f32x4*)(mv + (size_t)row * 1024 + c)); const int b = row >> 8, key = row & 255, hd = c >> 8, d = c & 255;
                            bf16_t* p = vt + ((size_t)((b * 4 + hd) * 256 + d)) * 256 + key; const unsigned w0 = cvt_pk_bf16(v[0], v[1]), w1 = cvt_pk_bf16(v[2], v[3]);
                            p[0] = (bf16_t)(w0 & 0xffffu); p[256] = (bf16_t)(w0 >> 16); p[512] = (bf16_t)(w1 & 0xffffu); p[768] = (bf16_t)(w1 >> 16); } } }
    }
};
template <bool ADD> struct EpiGate {
    static constexpr bool PERM = true, AFTER_DRAIN = false;
    bf16_t* O; const bf16_t* gate;
    __device__ __forceinline__ void operator()(const f32x4 (&acc)[2][2][4][2], const Unit& u, int wr, int wc, int fr, int fq) const {
        const int row0 = u.pm * BM + wr * 64 + fr, col0 = u.pn * BM + wc * 32 + 8 * fq;
#pragma unroll
        for (int ai = 0; ai < 2; ++ai)
#pragma unroll
            for (int m = 0; m < 4; ++m) { const size_t off = (size_t)(row0 + ai * HALF + m * 16) * 1024 + col0;
#pragma unroll
                for (int bj = 0; bj < 2; ++bj) { const u32x4 gw = __builtin_nontemporal_load((const u32x4*)(gate + off + bj * HALF)); u32x4 ow = (u32x4){0u, 0u, 0u, 0u}; if (ADD) ow = *(const u32x4*)(O + off + bj * HALF);
                    float r[8];
#pragma unroll
                    for (int e = 0; e < 8; ++e) { const unsigned g16 = (gw[e >> 1] >> ((e & 1) * 16)) & 0xffffu, o16 = (ow[e >> 1] >> ((e & 1) * 16)) & 0xffffu;
                        const float a = acc[ai][bj][m][e >> 2][e & 3]; r[e] = (ADD ? bfbits2f(o16) : 0.f) + sigm(bfbits2f(g16)) * a; }
                    u32x4 w; w.x = cvt_pk_bf16(r[0], r[1]); w.y = cvt_pk_bf16(r[2], r[3]); w.z = cvt_pk_bf16(r[4], r[5]); w.w = cvt_pk_bf16(r[6], r[7]);
                    *(u32x4*)(O + off + bj * HALF) = w; } }
    }
};
template <bool BF, bool BSC = false> struct EpiRes {
    static constexpr bool PERM = true, AFTER_DRAIN = false;
    const float* base0; const float* base1; const bf16_t* bb; bf16_t* hb; float* ssqp; const float* bsc;
    __device__ __forceinline__ void operator()(const f32x4 (&acc)[2][2][4][2], const Unit& u, int wr, int wc, int fr, int fq) const {
        const int row0 = u.pm * BM + wr * 64 + fr, col0 = u.pn * BM + wc * 32 + 8 * fq; const float* base = u.pm < 64 ? base0 : base1;
#pragma unroll
        for (int ai = 0; ai < 2; ++ai)
#pragma unroll
            for (int m = 0; m < 4; ++m) { const int row = row0 + ai * HALF + m * 16; const size_t off = (size_t)row * 1024 + col0; float sq = 0.f; float bs = 1.0f; if constexpr (BSC) bs = bsc[row];
#pragma unroll
                for (int bj = 0; bj < 2; ++bj) { const size_t o2 = off + bj * HALF; f32x4 b0, b1;
                    if (BF) { const u32x4 w = *(const u32x4*)(bb + o2); b0 = (f32x4){bfbits2f(w.x & 0xffffu), __uint_as_float(w.x & 0xffff0000u), bfbits2f(w.y & 0xffffu), __uint_as_float(w.y & 0xffff0000u)};
                        b1 = (f32x4){bfbits2f(w.z & 0xffffu), __uint_as_float(w.z & 0xffff0000u), bfbits2f(w.w & 0xffffu), __uint_as_float(w.w & 0xffff0000u)}; }
                    else { b0 = __builtin_nontemporal_load((const f32x4*)(base + o2)); b1 = __builtin_nontemporal_load((const f32x4*)(base + o2 + 4)); }
                    if constexpr (BSC) { b0 = b0 * bs; b1 = b1 * bs; }
                    const f32x4 v0 = b0 + acc[ai][bj][m][0], v1 = b1 + acc[ai][bj][m][1];
                    sq += ((v0[0] * v0[0] + v0[1] * v0[1]) + (v0[2] * v0[2] + v0[3] * v0[3])) + ((v1[0] * v1[0] + v1[1] * v1[1]) + (v1[2] * v1[2] + v1[3] * v1[3]));
                    u32x4 w; w.x = cvt_pk_bf16(v0[0], v0[1]); w.y = cvt_pk_bf16(v0[2], v0[3]); w.z = cvt_pk_bf16(v1[0], v1[1]); w.w = cvt_pk_bf16(v1[2], v1[3]); *(u32x4*)(hb + o2) = w; }
                sq += __shfl_xor(sq, 16); sq += __shfl_xor(sq, 32);
                if (fq == 0) ssqp[(size_t)row * 16 + u.pn * 4 + wc] = sq; }
    }
};
struct EpiSwiglu {
    static constexpr bool PERM = true, AFTER_DRAIN = false;
    bf16_t* act; const float* ssq;
    __device__ __forceinline__ void operator()(const f32x4 (&acc)[2][2][4][2], const Unit& u, int wr, int wc, int fr, int fq) const {
        const int row0 = u.pm * BM + wr * 64 + fr, col0 = u.pn * 128 + wc * 16 + 4 * fq;
#pragma unroll
        for (int ai = 0; ai < 2; ++ai)
#pragma unroll
            for (int m = 0; m < 4; ++m) { const int row = row0 + ai * HALF + m * 16; const float rs = row_rs<16>(ssq, row);
#pragma unroll
                for (int bj = 0; bj < 2; ++bj) { const f32x4 a = acc[ai][bj][m][0] * rs, b = acc[ai][bj][m][1] * rs;
                    const float r0 = a[0] * sigm(a[0]) * a[1], r1 = a[2] * sigm(a[2]) * a[3], r2 = b[0] * sigm(b[0]) * b[1], r3 = b[2] * sigm(b[2]) * b[3];
                    u32x2 w; w.x = cvt_pk_bf16(r0, r1); w.y = cvt_pk_bf16(r2, r3); *(u32x2*)(act + (size_t)row * 2816 + col0 + bj * 64) = w; } }
    }
};
template <class Epi, class Sched, bool ALIGN_EPI = false, bool SP2 = false, int EPI_REP = 1>
__device__ __forceinline__ void gemm_phase(PG8_LAS unsigned char* lds, const Gemm g, const Sched& S, const Epi& E) {
    const int tid = threadIdx.x, wid = __builtin_amdgcn_readfirstlane(tid >> 6), lane = tid & 63, wr = wid >> 2, wc = wid & 3, fr = lane & 15, fq = lane >> 4;
    const int K = g.K, nt = K / BK;
    unsigned voffA[2], voffB[2];
#pragma unroll
    for (int i = 0; i < 2; ++i) { int R, C; stage_rc(tid * 16 + i * 8192, R, C); const int Rb = Epi::PERM ? ((R & ~31) + perm32(R & 31)) : R;
        voffA[i] = (unsigned)(R * K + C) * 2u; voffB[i] = (unsigned)(Rb * K + C) * 2u; }
    const size_t kstep = (size_t)(BK * 2);
    const size_t hstep = (size_t)HALF * K * 2;
    const size_t tstep = 2 * hstep;
    const unsigned ldsw = (unsigned)wid * 1024u;
    const int aoff = lds_byte(wr * 64 + fr, fq * 8), boff = lds_byte(wc * 32 + fr, fq * 8);
#define PG8_SA(b, h) (((b) * 2 + (h)) * HTB)
#define PG8_SB(b, h) ((4 + (b) * 2 + (h)) * HTB)
#define PG8_STAGE(bufoff, gbase, voff) do { _Pragma("unroll") for (int _i = 0; _i < 2; ++_i) \
        __builtin_amdgcn_global_load_lds((const unsigned*)((const char*)(gbase) + (voff)[_i]), (PG8_LAS unsigned*)(lds + (bufoff) + ldsw + _i * 8192), 16, 0, 0); } while (0)
#define PG8_LDA(dst, b, h) do { _Pragma("unroll") for (int m = 0; m < 4; ++m) _Pragma("unroll") for (int k = 0; k < 2; ++k) dst[m][k] = *(const PG8_LAS bf16x8*)(lds + PG8_SA(b, h) + aoff + m * 2048 + k * 1024); } while (0)
#define PG8_LDB(dst, b, h) do { _Pragma("unroll") for (int n = 0; n < 2; ++n) _Pragma("unroll") for (int k = 0; k < 2; ++k) dst[n][k] = *(const PG8_LAS bf16x8*)(lds + PG8_SB(b, h) + boff + n * 2048 + k * 1024); } while (0)
#define PG8_MMA(ai, bj, At, Bt) do { __builtin_amdgcn_s_setprio(1); _Pragma("unroll") for (int m = 0; m < 4; ++m) _Pragma("unroll") for (int n = 0; n < 2; ++n) _Pragma("unroll") for (int k = 0; k < 2; ++k) \
        acc[ai][bj][m][n] = __builtin_amdgcn_mfma_f32_16x16x32_bf16(Bt[n][k], At[m][k], acc[ai][bj][m][n], 0, 0, 0); __builtin_amdgcn_s_setprio(0); } while (0)
#define PG8_WAIT_V(n) asm volatile("s_waitcnt vmcnt(" #n ")" ::: "memory")
#define PG8_WAIT_L(n) asm volatile("s_waitcnt lgkmcnt(" #n ")" ::: "memory")
#define PG8_BAR __builtin_amdgcn_s_barrier()
#define PG8_SCHED __builtin_amdgcn_sched_barrier(0)
    Unit cur, nxt; int ui = 0;
    if (!S.next(0, cur)) return;
    f32x4 acc[2][2][4][2];
#pragma unroll
    for (int a = 0; a < 2; ++a)
#pragma unroll
        for (int b = 0; b < 2; ++b)
#pragma unroll
            for (int m = 0; m < 4; ++m)
#pragma unroll
                for (int n = 0; n < 2; ++n) acc[a][b][m][n] = (f32x4){0.f, 0.f, 0.f, 0.f};
    bf16x8 At[4][2], B0[2][2], B1[2][2];
    const char* cA = (const char*)g.A + (size_t)cur.pm * tstep; const char* cB = (const char*)g.Bt + (size_t)cur.pn * tstep;
    S.a_ready(cur);
    if constexpr (SP2) {
        PG8_STAGE(PG8_SB(0, 0), cB, voffB); PG8_STAGE(PG8_SB(0, 1), cB + hstep, voffB); PG8_STAGE(PG8_SA(0, 0), cA, voffA); PG8_STAGE(PG8_SA(0, 1), cA + hstep, voffA);
        if (wr == 1) PG8_BAR;
        PG8_WAIT_V(2); PG8_BAR;
        PG8_STAGE(PG8_SB(1, 0), cB + kstep, voffB); PG8_STAGE(PG8_SA(1, 0), cA + kstep, voffA); PG8_STAGE(PG8_SB(1, 1), cB + hstep + kstep, voffB);
        PG8_WAIT_V(6); PG8_BAR;
    } else {
        PG8_STAGE(PG8_SB(0, 0), cB, voffB); PG8_STAGE(PG8_SA(0, 0), cA, voffA); PG8_STAGE(PG8_SB(0, 1), cB + hstep, voffB); PG8_STAGE(PG8_SA(0, 1), cA + hstep, voffA);
        if (wr == 1) PG8_BAR;
        PG8_WAIT_V(4); PG8_BAR;
        PG8_STAGE(PG8_SB(1, 0), cB + kstep, voffB); PG8_STAGE(PG8_SA(1, 0), cA + kstep, voffA); PG8_STAGE(PG8_SB(1, 1), cB + hstep + kstep, voffB);
        PG8_WAIT_V(6); PG8_BAR;
    }
    for (;;) {
        const bool has_next = S.next(ui + 1, nxt);
        const char* nA = has_next ? (const char*)g.A + (size_t)nxt.pm * tstep : cA; const char* nB = has_next ? (const char*)g.Bt + (size_t)nxt.pn * tstep : cB;
        for (int t = 0; t < nt; t += 2) {
            const bool last = (t == nt - 2);
            const char* a1 = cA + (size_t)(t + 1) * kstep;
            const char* a2 = last ? nA : cA + (size_t)(t + 2) * kstep; const char* b2 = last ? nB : cB + (size_t)(t + 2) * kstep;
            const char* a3 = a2 + kstep; const char* b3 = b2 + kstep;
            if (last && has_next) S.a_ready(nxt);
            if constexpr (SP2) {
            PG8_LDB(B0, 0, 0); PG8_LDB(B1, 0, 1); PG8_SCHED; PG8_LDA(At, 0, 0); PG8_STAGE(PG8_SA(1, 1), a1 + hstep, voffA);
            PG8_WAIT_V(8); PG8_WAIT_L(0); PG8_BAR; PG8_MMA(0, 0, At, B0); PG8_MMA(0, 1, At, B1); PG8_BAR; PG8_SCHED;
            PG8_LDA(At, 0, 1); PG8_STAGE(PG8_SB(0, 0), b2, voffB); PG8_STAGE(PG8_SB(0, 1), b2 + hstep, voffB); PG8_STAGE(PG8_SA(0, 0), a2, voffA);
            PG8_WAIT_V(8); PG8_WAIT_L(0); PG8_BAR; PG8_MMA(1, 0, At, B0); PG8_MMA(1, 1, At, B1); PG8_BAR; PG8_SCHED;
            PG8_LDB(B0, 1, 0); PG8_LDB(B1, 1, 1); PG8_SCHED; PG8_LDA(At, 1, 0); PG8_STAGE(PG8_SA(0, 1), a2 + hstep, voffA);
            PG8_WAIT_V(8); PG8_WAIT_L(0); PG8_BAR; PG8_MMA(0, 0, At, B0); PG8_MMA(0, 1, At, B1); PG8_BAR; PG8_SCHED;
            PG8_LDA(At, 1, 1); PG8_STAGE(PG8_SB(1, 0), b3, voffB); PG8_STAGE(PG8_SB(1, 1), b3 + hstep, voffB); PG8_STAGE(PG8_SA(1, 0), a3, voffA);
            PG8_WAIT_V(8); PG8_WAIT_L(0); PG8_BAR; PG8_MMA(1, 0, At, B0); PG8_MMA(1, 1, At, B1); PG8_BAR; PG8_SCHED;
            } else {
            PG8_LDB(B0, 0, 0); PG8_SCHED; PG8_LDA(At, 0, 0); PG8_STAGE(PG8_SA(1, 1), a1 + hstep, voffA);
            PG8_WAIT_L(8); PG8_BAR; PG8_WAIT_L(0); PG8_MMA(0, 0, At, B0); PG8_BAR; PG8_SCHED;
            PG8_LDB(B1, 0, 1); PG8_STAGE(PG8_SB(0, 0), b2, voffB);
            PG8_BAR; PG8_WAIT_L(0); PG8_MMA(0, 1, At, B1); PG8_BAR;
            PG8_LDA(At, 0, 1); PG8_STAGE(PG8_SA(0, 0), a2, voffA);
            PG8_BAR; PG8_WAIT_L(0); PG8_MMA(1, 0, At, B0); PG8_BAR; PG8_SCHED;
            PG8_STAGE(PG8_SB(0, 1), b2 + hstep, voffB);
            PG8_WAIT_V(6); PG8_BAR; PG8_MMA(1, 1, At, B1); PG8_BAR;
            PG8_LDB(B0, 1, 0); PG8_SCHED; PG8_LDA(At, 1, 0); PG8_STAGE(PG8_SA(0, 1), a2 + hstep, voffA);
            PG8_WAIT_L(8); PG8_BAR; PG8_WAIT_L(0); PG8_MMA(0, 0, At, B0); PG8_BAR; PG8_SCHED;
            PG8_LDB(B1, 1, 1); PG8_STAGE(PG8_SB(1, 0), b3, voffB);
            PG8_BAR; PG8_WAIT_L(0); PG8_MMA(0, 1, At, B1); PG8_BAR;
            PG8_LDA(At, 1, 1); PG8_STAGE(PG8_SA(1, 0), a3, voffA);
            PG8_BAR; PG8_WAIT_L(0); PG8_MMA(1, 0, At, B0); PG8_BAR; PG8_SCHED;
            PG8_STAGE(PG8_SB(1, 1), b3 + hstep, voffB);
            PG8_WAIT_V(6); PG8_BAR; PG8_MMA(1, 1, At, B1); PG8_BAR;
            }
        }
        if constexpr (ALIGN_EPI) { if (wr == 0) PG8_BAR; }
        if constexpr (!Epi::AFTER_DRAIN) { for (int rep = 0; rep < EPI_REP; ++rep) { E(acc, cur, wr, wc, fr, fq); asm volatile("" ::: "memory"); } S.done(cur); }
        if (!has_next) break;
#pragma unroll
        for (int a = 0; a < 2; ++a)
#pragma unroll
            for (int b = 0; b < 2; ++b)
#pragma unroll
                for (int m = 0; m < 4; ++m)
#pragma unroll
                    for (int n = 0; n < 2; ++n) acc[a][b][m][n] = (f32x4){0.f, 0.f, 0.f, 0.f};
        cur = nxt; cA = nA; cB = nB; ++ui;
        if constexpr (ALIGN_EPI) { if (wr == 1) PG8_BAR; }
    }
    PG8_WAIT_V(0);
    if constexpr (!ALIGN_EPI) { if (wr == 0) PG8_BAR; }
    PG8_BAR;
    if constexpr (Epi::AFTER_DRAIN) { E.fused(acc, cur, wr, wc, fr, fq, lds, wid, lane); S.done(cur); }
#undef PG8_SA
#undef PG8_SB
#undef PG8_STAGE
#undef PG8_LDA
#undef PG8_LDB
#undef PG8_MMA
#undef PG8_WAIT_V
#undef PG8_WAIT_L
#undef PG8_BAR
#undef PG8_SCHED
}
}
#define GAS __attribute__((address_space(1)))
#define LAS __attribute__((address_space(3)))
typedef unsigned short bf16;
typedef unsigned v4u __attribute__((ext_vector_type(4)));
typedef float f32x4 __attribute__((ext_vector_type(4)));
typedef short bf16x8 __attribute__((ext_vector_type(8)));
typedef GAS unsigned gu32;
typedef GAS unsigned long long gu64;
#define RLX_AGENT __ATOMIC_RELAXED, __HIP_MEMORY_SCOPE_AGENT
#define LDS_WAIT() asm volatile("s_waitcnt lgkmcnt(0)" ::: "memory")
#define VM_WAIT() asm volatile("s_waitcnt vmcnt(0)" ::: "memory")
__device__ __forceinline__ unsigned long long rt() { return __builtin_amdgcn_s_memrealtime(); }
typedef float f32x2_t __attribute__((ext_vector_type(2))); typedef __bf16 bf16x2_t __attribute__((ext_vector_type(2)));
__device__ __forceinline__ unsigned pk2(float lo, float hi) { const f32x2_t v = {lo, hi}; const bf16x2_t b = __builtin_convertvector(v, bf16x2_t); return __builtin_bit_cast(unsigned, b); }
__device__ __forceinline__ unsigned f2bf(float f) { return pk2(f, 0.f) & 0xffffu; }

#define XB_TMO      128
#define XB_XCNT(j)  (256  + 64 * (j))
#define XB_XSUB(j)  (1280 + 64 * (j))
#define XB_XGEN(j)  (2304 + 64 * (j))
#define XB_TOP      3328
#define XB_TOPGEN   3392
#define XCD_BAR_WORDS 3456
#define XB_SPIN_CAP (1u << 18)

__device__ __forceinline__ unsigned xb_ld(unsigned* p)              { return __hip_atomic_load(p, __ATOMIC_RELAXED, __HIP_MEMORY_SCOPE_AGENT); }
__device__ __forceinline__ unsigned xb_add(unsigned* p, unsigned v) { return __hip_atomic_fetch_add(p, v, __ATOMIC_RELAXED, __HIP_MEMORY_SCOPE_AGENT); }
__device__ __forceinline__ unsigned xb_xcc_id() { return (unsigned)__builtin_amdgcn_s_getreg((3 << 11) | 20) & 0xFu; }
#define XB_SPIN(cond, bar) do { unsigned _sp = 0; while (cond) { __builtin_amdgcn_s_sleep(1); \
    if ((++_sp & 255u) == 0u) { if (xb_ld(&(bar)[XB_TMO])) break; if (_sp > XB_SPIN_CAP) { atomicAdd(&(bar)[XB_TMO], 1u); break; } } } } while (0)

struct XcdBarrier {
    unsigned* bar; unsigned x;
    volatile LAS unsigned* st;
};

__device__ __forceinline__ XcdBarrier xcd_barrier_post(unsigned* bar, volatile LAS unsigned* st) {
    XcdBarrier b; b.bar = bar; b.x = xb_xcc_id(); b.st = st;
    if (threadIdx.x == 0) (void)xb_add(&bar[XB_XCNT(b.x)], 1u);
    return b;
}
__device__ __forceinline__ void xcd_barrier_complete(unsigned* bar, unsigned x, unsigned& nloc, unsigned& nx) {
    const unsigned G = gridDim.x * gridDim.y * gridDim.z;
    unsigned sum, cnt, mine, sp = 0u;
    for (;;) {
        sum = 0u; cnt = 0u; mine = 0u;
#pragma unroll
        for (unsigned j = 0; j < 16; ++j) { const unsigned c = xb_ld(&bar[XB_XCNT(j)]); sum += c; cnt += (c > 0u) ? 1u : 0u; mine = (j == x) ? c : mine; }
        if (sum == G) break;
        __builtin_amdgcn_s_sleep(1);
        if ((++sp & 255u) == 0u) { if (xb_ld(&bar[XB_TMO])) break; if (sp > XB_SPIN_CAP) { atomicAdd(&bar[XB_TMO], 1u); break; } }
    }
    nloc = mine > 0u ? mine : 1u; nx = cnt > 0u ? cnt : 1u;
}

__device__ __forceinline__ void xcd_barrier(const XcdBarrier& b) {
    asm volatile("s_waitcnt vmcnt(0)" ::: "memory");
    __syncthreads();
    if (threadIdx.x == 0) {
        unsigned* bar = b.bar;
        __builtin_amdgcn_s_waitcnt(0);
        unsigned nloc = b.st[0], nx = b.st[1];
        if (nloc == 0u) { xcd_barrier_complete(bar, b.x, nloc, nx); b.st[0] = nloc; b.st[1] = nx; }
        const unsigned old = xb_add(&bar[XB_XSUB(b.x)], 1u);
        const unsigned gen = old / nloc;
        if (old + 1u == (gen + 1u) * nloc) {
            __builtin_amdgcn_fence(__ATOMIC_RELEASE, "agent");
            asm volatile("s_waitcnt vmcnt(0)" ::: "memory");
            const unsigned og = xb_add(&bar[XB_TOP], 1u);
            const unsigned tg = og / nx;
            if (og + 1u == (tg + 1u) * nx) xb_add(&bar[XB_TOPGEN], 1u);
            else XB_SPIN(xb_ld(&bar[XB_TOPGEN]) == tg, bar);
            __builtin_amdgcn_fence(__ATOMIC_ACQUIRE, "agent");
            xb_add(&bar[XB_XGEN(b.x)], 1u);
            asm volatile("s_waitcnt vmcnt(0)" ::: "memory");
        } else {
            XB_SPIN(xb_ld(&bar[XB_XGEN(b.x)]) == gen, bar);
            __builtin_amdgcn_fence(__ATOMIC_ACQUIRE, "agent");
            asm volatile("s_waitcnt vmcnt(0)" ::: "memory");
        }
    }
    __syncthreads();
}
typedef unsigned v2u __attribute__((ext_vector_type(2)));
constexpr int NWAVES = 8, NTHR = 512;
constexpr int DM = 1024, TP = 16384, TS = 512, T = TP + TS;
constexpr int SEQ = 2048, NBP = 8, NBS = 128, LS = 4, MEMR = 2048;
constexpr int NPROJ = 11520;
constexpr int FFN = 2816;
constexpr float EPS = 1e-6f;
constexpr float QSCALE = 0.0625f * 1.4426950408889634f;

constexpr size_t MiB = 1u << 20;
constexpr size_t WS_CTL = 0, CTL_ZERO_BYTES = 32768;
constexpr size_t WS_SSQX = 1 * MiB, WS_SSQM = 1 * MiB + 512 * 1024;
constexpr size_t WS_DT = 2 * MiB, WS_SSQSSD = 5 * MiB, WS_SSQP1 = 8 * MiB, WS_SSQP2 = 9 * MiB + 512 * 1024, WS_SSQP3 = 11 * MiB;
constexpr size_t WS_WIN = 13 * MiB, WS_WKV = 36 * MiB, WS_WSSD = 40 * MiB, WS_WHG = 44 * MiB, WS_WOUT = 46 * MiB, WS_WCQ = 48 * MiB, WS_WCO = 50 * MiB, WS_WGU = 52 * MiB, WS_WDN = 63 * MiB;
constexpr size_t WS_XB = 69 * MiB, WS_MNB = 102 * MiB, WS_KB = 106 * MiB, WS_VT = 110 * MiB;
constexpr size_t SLOT = 33 * MiB, SLOT_ELEMS = (size_t)T * 1024;
constexpr size_t WS_PROJ = 114 * MiB;
constexpr size_t WS_YG = WS_PROJ + 11 * SLOT, WS_ON = WS_YG + 2 * SLOT, WS_END = WS_ON + SLOT;
static_assert(SLOT == SLOT_ELEMS * 2, "slot size");
static_assert(WS_WIN + (size_t)NPROJ * 1024 * 2 <= WS_WKV && WS_WGU + (size_t)2 * FFN * 1024 * 2 <= WS_WDN && WS_WDN + (size_t)1024 * FFN * 2 <= WS_XB && WS_SSQP3 + (size_t)T * 64 <= WS_WIN, "d_ws map");
static_assert(WS_DT + (size_t)T * 128 <= WS_SSQSSD && WS_SSQSSD + (size_t)T * 128 <= WS_SSQP1 && WS_SSQP1 + (size_t)T * 64 <= WS_SSQP2 && WS_SSQP2 + (size_t)T * 64 <= WS_SSQP3, "d_ws map 2");
enum { S_Z0 = 0, S_Z1 = 1, S_X0 = 2, S_X1 = 3, S_X2 = 4, S_Q = 5, S_F = 6, S_I = 7, S_HG = 8, S_GS = 9, S_GH = 10 };
constexpr size_t WS_MERGED = WS_PROJ + S_Q * SLOT, WS_HB = WS_PROJ + S_F * SLOT, WS_QB = WS_PROJ + S_I * SLOT, WS_OB = WS_PROJ + S_HG * SLOT, WS_ACT = WS_PROJ;
static_assert((size_t)T * FFN * 2 <= 3 * SLOT, "act overlay");
constexpr size_t O_Y = 0, O_SSMP = (size_t)T * 1024, O_CONVP = O_SSMP + 2097152, O_HGP = O_CONVP + 73728, O_MKP = O_HGP + 1048576, O_MVP = O_MKP + 2097152,
                 O_SSMS = O_MVP + 2097152, O_CONVS = O_SSMS + 33554432, O_HGS = O_CONVS + 1179648, O_END = O_HGS + 16777216;
constexpr int CW_QUEUE = 64;
constexpr int CW_BAR = 4096;
constexpr int RING_OFF = 0, RING_BYTES = 131072;
constexpr int LDS_BYTES = 147456;
constexpr int LDSCTL_OFF = LDS_BYTES - 1024, MISC_OFF = LDSCTL_OFF + 320;
struct Frame {
    LAS unsigned char* lds;
    volatile LAS unsigned* MISC;
    gu32* ctl;
    int tid, lane, wave;
    int vcu, G;
    const float* in[32];
    float* out; unsigned char* ws;
};
__device__ __forceinline__ float bf2f(unsigned v16) { return __uint_as_float(v16 << 16); }
__device__ __forceinline__ f32x4 ld_nt(const float* p) { return __builtin_nontemporal_load((const f32x4*)p); }
__device__ __forceinline__ void st_nt(float* p, f32x4 v) { __builtin_nontemporal_store(v, (f32x4*)p); }
__device__ __forceinline__ v4u ld_nt16(const void* p) { return __builtin_nontemporal_load((const v4u*)p); }
__device__ __forceinline__ unsigned ld_nt4(const void* p) { return __builtin_nontemporal_load((const unsigned*)p); }
__device__ __forceinline__ float sigmoid_f(float x) { return __builtin_amdgcn_rcpf(1.0f + __expf(-x)); }
__device__ __forceinline__ float silu_f(float x) { return x * sigmoid_f(x); }
__device__ __forceinline__ float wave_sum(float v) {
#pragma unroll
    for (int o = 1; o < 64; o <<= 1) v += __shfl_xor(v, o);
    return v;
}
__device__ __forceinline__ float wave_max(float v) {
#pragma unroll
    for (int o = 1; o < 64; o <<= 1) v = fmaxf(v, __shfl_xor(v, o));
    return v;
}
struct TSrc { const float* W; const float* W2; const float* ks; int ldw; int mode; };
__device__ __forceinline__ void p0_transpose_item(const TSrc& s, int K, int N, bf16* WT, LAS unsigned short* scr, int item, int lane) {
    const int nblk = N / 64, kb = item / nblk, nb = item % nblk, k0 = 64 * kb, n0 = 64 * nb;
    const int kr = lane >> 4, nq = lane & 15;
    const float* const Wa = s.W; const float* const Wb = s.W2;
    const float* src; int c0, cs; bool zero = false;
    if (s.mode == 2) { const float* wsel = Wa; if (nq >= 8) wsel = Wb; src = wsel + (n0 >> 1) + 4 * (nq & 7); c0 = 8 * (nq & 7) + (nq >> 3); cs = 2; }
    else { const int n = n0 + 4 * nq; c0 = 4 * nq; cs = 1;
        if (s.mode == 0) src = Wa + n;
        else if (s.mode == 1) { if (n < 5120) src = Wa + n; else if (n < 11264) src = Wa + n + 32; else if (n < 11296) src = Wa + 5120 + (n - 11264); else { src = Wa; zero = true; } }
        else { src = Wa + n; if (n >= 1024) src = Wb + (n - 1024); } }
    f32x4 v[16];
#pragma unroll
    for (int i = 0; i < 16; ++i) v[i] = zero ? (f32x4){0.f, 0.f, 0.f, 0.f} : ld_nt(src + (size_t)(k0 + 4 * i + kr) * s.ldw);
#pragma unroll
    for (int i = 0; i < 16; ++i) { const int kk = 4 * i + kr; const float sc = s.ks ? s.ks[k0 + kk] : 1.0f; const unsigned w0 = pk2(v[i].x * sc, v[i].y * sc), w1 = pk2(v[i].z * sc, v[i].w * sc);
        LAS unsigned short* d = scr + kk * 66 + c0;
        if (cs == 1) { *(LAS unsigned*)d = w0; *(LAS unsigned*)(d + 2) = w1; }
        else { d[0] = (unsigned short)(w0 & 0xffffu); d[2] = (unsigned short)(w0 >> 16); d[4] = (unsigned short)(w1 & 0xffffu); d[6] = (unsigned short)(w1 >> 16); } }
    LDS_WAIT(); asm volatile("" ::: "memory");
    const int nr = lane >> 3, kc = lane & 7;
#pragma unroll
    for (int j = 0; j < 8; ++j) { const int n = 8 * j + nr; const LAS unsigned short* p = scr + (8 * kc) * 66 + n;
        v4u o; o.x = (unsigned)p[0] | ((unsigned)p[66] << 16); o.y = (unsigned)p[2 * 66] | ((unsigned)p[3 * 66] << 16); o.z = (unsigned)p[4 * 66] | ((unsigned)p[5 * 66] << 16); o.w = (unsigned)p[6 * 66] | ((unsigned)p[7 * 66] << 16);
        *(v4u*)(WT + (size_t)(n0 + n) * K + k0 + 8 * kc) = o; }
    LDS_WAIT(); asm volatile("" ::: "memory");
}
__device__ __forceinline__ void rows4_to_bf16_ssq(const float* x0, bf16* o0, float* ssq0, int lane) {
    f32x4 v[4][4];
#pragma unroll
    for (int rr = 0; rr < 4; ++rr)
#pragma unroll
        for (int j = 0; j < 4; ++j) v[rr][j] = ld_nt(x0 + rr * 1024 + 4 * (64 * j + lane));
#pragma unroll
    for (int rr = 0; rr < 4; ++rr) { float sq = 0.f;
#pragma unroll
        for (int j = 0; j < 4; ++j) sq += (v[rr][j].x * v[rr][j].x + v[rr][j].y * v[rr][j].y) + (v[rr][j].z * v[rr][j].z + v[rr][j].w * v[rr][j].w);
        sq = wave_sum(sq);
        const float irs = sqrtf(sq * (1.0f / 1024.0f) + 1e-6f), rs = 1.0f / irs;
        unsigned long long* o8 = (unsigned long long*)(o0 + rr * 1024) + lane;
#pragma unroll
        for (int j = 0; j < 4; ++j) o8[64 * j] = (unsigned long long)pk2(v[rr][j].x * rs, v[rr][j].y * rs) | ((unsigned long long)pk2(v[rr][j].z * rs, v[rr][j].w * rs) << 32);
        if (lane == 0) ssq0[rr] = irs; }
}
__device__ __forceinline__ void p0_prologue(Frame& F) {
    LAS unsigned short* scr = (LAS unsigned short*)(F.lds + RING_OFF + F.wave * 16384);
    const int gw = F.vcu * NWAVES + F.wave, NGW = F.G * NWAVES;
    unsigned char* ws = F.ws;
    constexpr int I_IN = 16 * (NPROJ / 64), I_KV = 16 * 32, I_SSD = 32 * 16, I_SQ = 16 * 16, I_GU = 16 * (2 * FFN / 64), I_DN = (FFN / 64) * 16;
    constexpr int NITEMS = I_IN + I_KV + I_SSD + 4 * I_SQ + I_GU + I_DN;
    for (int it = gw; it < NITEMS; it += NGW) {
        int r = it;
        if (r < I_IN) { TSrc s{F.in[9], nullptr, F.in[8], 11296, 1}; p0_transpose_item(s, 1024, NPROJ, (bf16*)(ws + WS_WIN), scr, r, F.lane); continue; } r -= I_IN;
        if (r < I_KV) { TSrc s{F.in[24], F.in[25], F.in[22], 1024, 3}; p0_transpose_item(s, 1024, 2048, (bf16*)(ws + WS_WKV), scr, r, F.lane); continue; } r -= I_KV;
        if (r < I_SSD) { TSrc s{F.in[16], nullptr, F.in[15], 1024, 0}; p0_transpose_item(s, 2048, 1024, (bf16*)(ws + WS_WSSD), scr, r, F.lane); continue; } r -= I_SSD;
        if (r < I_SQ) { TSrc s{F.in[19], nullptr, F.in[18], 1024, 0}; p0_transpose_item(s, 1024, 1024, (bf16*)(ws + WS_WHG), scr, r, F.lane); continue; } r -= I_SQ;
        if (r < I_SQ) { TSrc s{F.in[20], nullptr, nullptr, 1024, 0}; p0_transpose_item(s, 1024, 1024, (bf16*)(ws + WS_WOUT), scr, r, F.lane); continue; } r -= I_SQ;
        if (r < I_SQ) { TSrc s{F.in[23], nullptr, F.in[21], 1024, 0}; p0_transpose_item(s, 1024, 1024, (bf16*)(ws + WS_WCQ), scr, r, F.lane); continue; } r -= I_SQ;
        if (r < I_SQ) { TSrc s{F.in[26], nullptr, nullptr, 1024, 0}; p0_transpose_item(s, 1024, 1024, (bf16*)(ws + WS_WCO), scr, r, F.lane); continue; } r -= I_SQ;
        if (r < I_GU) { TSrc s{F.in[28], F.in[29], F.in[27], FFN, 2}; p0_transpose_item(s, 1024, 2 * FFN, (bf16*)(ws + WS_WGU), scr, r, F.lane); continue; } r -= I_GU;
        { TSrc s{F.in[30], nullptr, nullptr, 1024, 0}; p0_transpose_item(s, FFN, 1024, (bf16*)(ws + WS_WDN), scr, r, F.lane); }
    }
    bf16* XB = (bf16*)(ws + WS_XB); float* SSQX = (float*)(ws + WS_SSQX);
    for (int m4 = gw; m4 < T / 4; m4 += NGW) { const int m = 4 * m4;
        rows4_to_bf16_ssq(m < TP ? F.in[0] + (size_t)m * DM : F.in[1] + (size_t)(m - TP) * DM, XB + (size_t)m * DM, SSQX + m, F.lane); }
    bf16* MNB = (bf16*)(ws + WS_MNB); float* SSQM = (float*)(ws + WS_SSQM);
    for (int m4 = gw; m4 < MEMR / 4; m4 += NGW) { const int m = 4 * m4; rows4_to_bf16_ssq(F.in[2] + (size_t)m * DM, MNB + (size_t)m * DM, SSQM + m, F.lane); }
}
__device__ __forceinline__ void conv_copy_unit(Frame& F, int gb) {
    const bf16* PROJ = (const bf16*)(F.ws + WS_PROJ);
    const bool prompt = gb < NBP; const int sb = gb - NBP;
    const size_t row0 = prompt ? (size_t)gb * SEQ + (SEQ - 3) : (size_t)TP + (size_t)sb * LS + 1;
    float* dst = prompt ? F.out + O_CONVP + (size_t)gb * 3 * 3072 : F.out + O_CONVS + (size_t)sb * 3 * 3072;
    for (int e = F.tid; e < 3 * 3072; e += NTHR) { const int j = e / 3072, col = e % 3072;
        dst[e] = bf2f(PROJ[(size_t)(S_X0 + (col >> 10)) * SLOT_ELEMS + (row0 + j) * 1024 + (col & 1023)]); }
}
__device__ __forceinline__ void ssdnorm_phase(Frame& F) {
    const int gw = F.vcu * NWAVES + F.wave, NGW = F.G * NWAVES; bf16* YG = (bf16*)(F.ws + WS_YG); const float* SSQ = (const float*)(F.ws + WS_SSQSSD);
    for (int row = gw; row < T; row += NGW) {
        const f32x4* sp = (const f32x4*)(SSQ + (size_t)row * 32);
#pragma unroll
        for (int j = 0; j < 4; ++j) { const f32x4 a = sp[2 * j], b = sp[2 * j + 1]; const float s = ((a.x + a.y) + (a.z + a.w)) + ((b.x + b.y) + (b.z + b.w)); const float rs = 1.0f / sqrtf(s * (1.0f / 512.0f) + EPS);
            v4u* p = (v4u*)(YG + (size_t)row * 2048) + j * 64 + F.lane; const v4u w = *p; v4u o;
#pragma unroll
            for (int e = 0; e < 4; ++e) o[e] = pk2(bf2f(w[e] & 0xffffu) * rs, bf2f(w[e] >> 16) * rs);
            *p = o; }
    }
}
typedef float f32x16 __attribute__((ext_vector_type(16)));
#define MFMA32(a, b, c) __builtin_amdgcn_mfma_f32_32x32x16_bf16((a), (b), (c), 0, 0, 0)
__device__ __forceinline__ unsigned cvtpk_c(float lo, float hi) { return pk2(lo, hi); }
__device__ __forceinline__ bf16x8 pack8(float a0, float a1, float a2, float a3, float a4, float a5, float a6, float a7) {
    v4u w; w.x = cvtpk_c(a0, a1); w.y = cvtpk_c(a2, a3); w.z = cvtpk_c(a4, a5); w.w = cvtpk_c(a6, a7); return __builtin_bit_cast(bf16x8, w); }
#define ACC_FRAG(x, s) pack8((x)[8 * (s)], (x)[8 * (s) + 1], (x)[8 * (s) + 2], (x)[8 * (s) + 3], (x)[8 * (s) + 4], (x)[8 * (s) + 5], (x)[8 * (s) + 6], (x)[8 * (s) + 7])
__device__ __forceinline__ bf16x8 lds_frag16(const LAS unsigned char* p) { return *(const LAS bf16x8*)p; }
__device__ __forceinline__ bf16x8 lds_frag8x2(const LAS unsigned char* p) { const v2u lo = *(const LAS v2u*)p, hi = *(const LAS v2u*)(p + 16);
    const v4u w = (v4u){lo.x, lo.y, hi.x, hi.y}; return __builtin_bit_cast(bf16x8, w); }
#define LDS_BARRIER() do { asm volatile("s_waitcnt lgkmcnt(0)" ::: "memory"); __builtin_amdgcn_s_barrier(); asm volatile("" ::: "memory"); } while (0)
typedef short s16x4 __attribute__((ext_vector_type(4)));
__device__ __forceinline__ bf16x8 lds_frag_tr(const LAS unsigned char* p, const LAS unsigned char* p4) {
    const s16x4 lo = __builtin_amdgcn_ds_read_tr16_b64_v4i16((LAS s16x4*)p), hi = __builtin_amdgcn_ds_read_tr16_b64_v4i16((LAS s16x4*)p4);
    return (bf16x8){lo.x, lo.y, lo.z, lo.w, hi.x, hi.y, hi.z, hi.w}; }
constexpr size_t WS_BCS = WS_END, WS_BTT = WS_BCS + (size_t)TP * 1024 * 2, WS_END2 = WS_BTT + (size_t)NBP * 32 * 4 * 128 * 64 * 2;
__device__ __forceinline__ void bc_prep_unit(Frame& F, int b, int c) {
    typedef float f32x2 __attribute__((ext_vector_type(2)));
    int tid_o = F.tid; asm volatile("" : "+v"(tid_o));
    const int tid = tid_o, cg = tid & 127, seg = tid >> 7; unsigned char* ws = F.ws;
    const bf16* src = (const bf16*)(ws + WS_PROJ) + (size_t)S_X2 * SLOT_ELEMS + (size_t)b * SEQ * 1024 + 8 * cg;
    bf16* BCS = (bf16*)(ws + WS_BCS);
    const float* cw = F.in[10] + 2048 + 8 * cg; const float* cbp = F.in[11] + 2048 + 8 * cg;
#pragma unroll 1
    for (int half = 0; half < 2; ++half) {
        const int s0 = 16 * seg + 8 * half;
        v4u raw[11];
#pragma unroll
        for (int i = 0; i < 11; ++i) { const int gt = 64 * c + s0 - 3 + i; raw[i] = (v4u){0u, 0u, 0u, 0u}; if (gt >= 0) raw[i] = ld_nt16(src + (size_t)gt * 1024); }
        v4u rowpk[8];
#pragma unroll
        for (int kp = 0; kp < 4; ++kp) {
            const f32x2 cw0 = *(const f32x2*)(cw + 2 * kp), cw1 = *(const f32x2*)(cw + 3072 + 2 * kp), cw2 = *(const f32x2*)(cw + 2 * 3072 + 2 * kp), cw3 = *(const f32x2*)(cw + 3 * 3072 + 2 * kp), cbb = *(const f32x2*)(cbp + 2 * kp);
            f32x2 xv[11];
#pragma unroll
            for (int i = 0; i < 11; ++i) { const unsigned wd = raw[i][kp]; xv[i] = (f32x2){__uint_as_float(wd << 16), __uint_as_float(wd & 0xffff0000u)}; }
            f32x2 o[8];
#pragma unroll
            for (int i = 0; i < 8; ++i) { f32x2 a = cw0 * xv[i] + cbb; a = cw1 * xv[i + 1] + a; a = cw2 * xv[i + 2] + a; a = cw3 * xv[i + 3] + a;
                const f32x2 t = a * (-1.4426950408889634f); f32x2 e; e.x = __builtin_amdgcn_exp2f(t.x); e.y = __builtin_amdgcn_exp2f(t.y); e = e + 1.0f;
                f32x2 rc; rc.x = __builtin_amdgcn_rcpf(e.x); rc.y = __builtin_amdgcn_rcpf(e.y); o[i] = a * rc; }
#pragma unroll
            for (int i = 0; i < 8; ++i) rowpk[i][kp] = pk2(o[i].x, o[i].y);
        }
        bf16* drow = BCS + ((size_t)b * SEQ + 64 * c + s0) * 1024 + 8 * cg;
#pragma unroll
        for (int i = 0; i < 8; ++i) *(v4u*)(drow + (size_t)i * 1024) = rowpk[i];
    }
}
__device__ __forceinline__ void bc_prep_phase(Frame& F) { for (int u = F.vcu; u < NBP * 32; u += F.G) bc_prep_unit(F, u >> 5, u & 31); }
constexpr size_t WS_HVT = WS_XB, WS_EGM = WS_END2, WS_EGL = WS_EGM + (size_t)NBP * 64 * 1024 * 4, WS_END3 = WS_EGL + (size_t)NBP * 64 * 1024 * 4;
__device__ __forceinline__ void hg_prep_unit(Frame& F, int b, int c) {
    typedef float f32x2 __attribute__((ext_vector_type(2)));
    int tid_o = F.tid; asm volatile("" : "+v"(tid_o));
    const int tid = tid_o; unsigned char* ws = F.ws;
    const int ch = 2 * tid;
    const size_t row0 = (size_t)b * SEQ + 32 * c;
    bf16* QS = (bf16*)(ws + WS_PROJ) + (size_t)S_Q * SLOT_ELEMS + row0 * 1024 + ch; bf16* FS = (bf16*)(ws + WS_PROJ) + (size_t)S_F * SLOT_ELEMS + row0 * 1024 + ch;
    const f32x2 l0 = *(const f32x2*)(F.in[17] + ch), l1 = *(const f32x2*)(F.in[17] + 1024 + ch);
    f32x2 lb; lb.x = __builtin_amdgcn_rcpf(1.0f + __expf(l1.x - l0.x)); lb.y = __builtin_amdgcn_rcpf(1.0f + __expf(l1.y - l0.y));
    const f32x2 omlb = 1.0f - lb;
    f32x2 P[32]; f32x2 run = (f32x2){1.0f, 1.0f};
#pragma unroll
    for (int t = 0; t < 32; ++t) { const unsigned wd = ld_nt4(FS + (size_t)t * 1024);
        f32x2 u = (f32x2){__uint_as_float(wd << 16), __uint_as_float(wd & 0xffff0000u)}; u.x = fminf(fmaxf(u.x, -30.f), 30.f); u.y = fminf(fmaxf(u.y, -30.f), 30.f);
        const f32x2 tt = u * (-1.4426950408889634f); f32x2 e; e.x = __builtin_amdgcn_exp2f(tt.x); e.y = __builtin_amdgcn_exp2f(tt.y); e = e + 1.0f;
        f32x2 sg; sg.x = __builtin_amdgcn_rcpf(e.x); sg.y = __builtin_amdgcn_rcpf(e.y);
        const f32x2 fg = lb + omlb * sg; run = run * fg; run.x = fmaxf(run.x, 1e-30f); run.y = fmaxf(run.y, 1e-30f); P[t] = run; }
    const f32x2 Pm = P[15], Pl = P[31]; f32x2 rPm; rPm.x = __builtin_amdgcn_rcpf(Pm.x); rPm.y = __builtin_amdgcn_rcpf(Pm.y);
    *(f32x2*)((float*)(ws + WS_EGM) + (size_t)(b * 64 + c) * 1024 + ch) = Pm; *(f32x2*)((float*)(ws + WS_EGL) + (size_t)(b * 64 + c) * 1024 + ch) = Pl * rPm;
    f32x2 rPprev = (f32x2){1.0f, 1.0f};
#pragma unroll
    for (int t = 0; t < 32; ++t) { f32x2 rP; rP.x = __builtin_amdgcn_rcpf(P[t].x); rP.y = __builtin_amdgcn_rcpf(P[t].y);
        const f32x2 e1 = P[t] * rPm, e2 = Pm * rP, fg = P[t] * rPprev, kk = 1.0f - fg; rPprev = rP;
        const unsigned qw = ld_nt4(QS + (size_t)t * 1024); const f32x2 q = (f32x2){__uint_as_float(qw << 16), __uint_as_float(qw & 0xffff0000u)};
        const f32x2 tq = q * (-1.4426950408889634f); f32x2 eq; eq.x = __builtin_amdgcn_exp2f(tq.x); eq.y = __builtin_amdgcn_exp2f(tq.y); eq = eq + 1.0f;
        f32x2 rq; rq.x = __builtin_amdgcn_rcpf(eq.x); rq.y = __builtin_amdgcn_rcpf(eq.y);
        const f32x2 qa = q * rq * e1, ka = kk * e2;
        *(unsigned*)(QS + (size_t)t * 1024) = pk2(qa.x, qa.y); *(unsigned*)(FS + (size_t)t * 1024) = pk2(ka.x, ka.y); }
}
__device__ __forceinline__ void hg_prep_phase(Frame& F) { for (int u = F.vcu; u < NBP * 64; u += F.G) hg_prep_unit(F, u >> 6, u & 63); }
constexpr int HV_QA = 0, HV_KA = 8704, HV_KAT = 17408, HV_VT = 27648, HV_EGM = 30208, HV_EGL = 30720, HV_PBUF = 31232, HV_OB = 2 * HV_PBUF, HV_OBUF = 23040;
constexpr size_t WS_SSQH = WS_END3, WS_END4 = WS_SSQH + (size_t)T * 32 * 4;
__device__ __forceinline__ void hgrn_v_unit(Frame& F, int b, int hd, int vt) {
    int tid_o = F.tid; asm volatile("" : "+v"(tid_o));
    const int tid = tid_o, lane = tid & 63, w = F.wave, r = lane & 31, hh = lane >> 5; unsigned char* ws = F.ws;
    LAS unsigned char* Lb = F.lds + RING_OFF;
    const bf16* PROJ = (const bf16*)(ws + WS_PROJ); bf16* OU = (bf16*)(ws + WS_ON); float* SSQH = (float*)(ws + WS_SSQH);
    const size_t rowb = (size_t)b * SEQ;
    const int pt_t = tid & 31, pt_g = tid >> 5;
    const bf16* qsrc = PROJ + (size_t)S_Q * SLOT_ELEMS + (rowb + pt_t) * 1024 + hd * 128 + 8 * pt_g;
    const bf16* ksrc = PROJ + (size_t)S_F * SLOT_ELEMS + (rowb + pt_t) * 1024 + hd * 128 + 8 * pt_g;
    const unsigned char* xsrc = nullptr; size_t xstr = 0;
    if (tid < 128) { xsrc = (const unsigned char*)(PROJ + (size_t)S_I * SLOT_ELEMS + (rowb + pt_t) * 1024 + hd * 128 + 32 * vt + 8 * pt_g); xstr = (size_t)32 * 1024 * 2; }
    else if (tid < 160) { xsrc = (const unsigned char*)((const float*)(ws + WS_EGM) + (size_t)b * 64 * 1024 + hd * 128 + 4 * (tid - 128)); xstr = 4096; }
    else if (tid < 192) { xsrc = (const unsigned char*)((const float*)(ws + WS_EGL) + (size_t)b * 64 * 1024 + hd * 128 + 4 * (tid - 160)); xstr = 4096; }
    const int o_img = pt_t * 272 + 16 * pt_g, o_ka = pt_t * 256 + 16 * (pt_g ^ (((pt_t & 3) << 2) | ((pt_t >> 2) & 3))), o_v = pt_t * 64 + 16 * pt_g;
#define HGV_LOAD(cc, pq, pk, px) { pq = *(const v4u*)(qsrc + (size_t)(cc) * 32 * 1024); pk = *(const v4u*)(ksrc + (size_t)(cc) * 32 * 1024); if (tid < 192) px = *(const v4u*)(xsrc + (size_t)(cc) * xstr); }
#define HGV_STORE(pb, pq, pk, px) { *(LAS v4u*)((pb) + HV_QA + o_img) = pq; *(LAS v4u*)((pb) + HV_KA + o_ka) = pk; \
        if (tid < 128) { *(LAS v4u*)((pb) + HV_VT + o_v) = px; } else if (tid < 160) { *(LAS v4u*)((pb) + HV_EGM + 16 * (tid - 128)) = px; } else if (tid < 192) { *(LAS v4u*)((pb) + HV_EGL + 16 * (tid - 160)) = px; } }
    v4u pqA, pkA, pxA = (v4u){0u, 0u, 0u, 0u}, pqB, pkB, pxB = (v4u){0u, 0u, 0u, 0u};
    HGV_LOAD(0, pqA, pkA, pxA) HGV_STORE(Lb, pqA, pkA, pxA)
    HGV_LOAD(1, pqA, pkA, pxA) HGV_LOAD(2, pqB, pkB, pxB)
    const int kt = w;
    v2u ow_pend = (v2u){0u, 0u}; float sq_pend = 0.f;
    f32x16 S;
#pragma unroll
    for (int i = 0; i < 16; ++i) S[i] = 0.f;
    __syncthreads();
#define HGV_ITER(c, pq, pk, px) { \
        int r_l = r, hh_l = hh, tid_l = tid; asm volatile("" : "+v"(r_l), "+v"(hh_l), "+v"(tid_l)); \
        { const int r = r_l, hh = hh_l, tid = tid_l; \
        LAS unsigned char* pbc = Lb + ((c) & 1) * HV_PBUF; LAS unsigned char* pbn = Lb + (((c) + 1) & 1) * HV_PBUF; \
        if ((c) < 63) { HGV_STORE(pbn, pq, pk, px) if ((c) < 61) HGV_LOAD((c) + 3, pq, pk, px) } \
        if (w < 4) { \
            LAS float* EGM = (LAS float*)(pbc + HV_EGM); LAS float* EGL = (LAS float*)(pbc + HV_EGL); LAS float* OB = (LAS float*)(Lb + HV_OB + ((c) & 1) * HV_OBUF); \
            _Pragma("unroll") \
            for (int q4 = 0; q4 < 4; ++q4) { const f32x4 e0 = *(const LAS f32x4*)(EGM + 32 * kt + 8 * q4 + 4 * hh); \
                _Pragma("unroll") \
                for (int j = 0; j < 4; ++j) S[4 * q4 + j] *= e0[j]; } \
            f32x16 o; \
            _Pragma("unroll") \
            for (int i = 0; i < 16; ++i) o[i] = 0.f; \
            const LAS unsigned char* qa_row = pbc + HV_QA + r * 272; \
            o = MFMA32(ACC_FRAG(S, 0), lds_frag8x2(qa_row + (32 * kt + 4 * hh) * 2), o);        \
            o = MFMA32(ACC_FRAG(S, 1), lds_frag8x2(qa_row + (32 * kt + 16 + 4 * hh) * 2), o); \
            LAS float* ob = OB + (kt * 32 + r) * 36 + 4 * hh; \
            _Pragma("unroll") \
            for (int q4 = 0; q4 < 4; ++q4) *(LAS f32x4*)(ob + 8 * q4) = (f32x4){o[4 * q4], o[4 * q4 + 1], o[4 * q4 + 2], o[4 * q4 + 3]}; \
              \
            const int q_ = ((tid & 63) >> 2) & 3, chk_ = 4 * kt + 2 * (((tid & 63) >> 4) & 1) + (((tid & 63) >> 1) & 1); \
            const LAS unsigned char* ka_lo = pbc + HV_KA + (8 * hh + q_) * 256 + 16 * (chk_ ^ ((q_ << 2) | ((2 * hh) & 3))) + 8 * ((tid & 63) & 1); \
            const LAS unsigned char* ka_hi = pbc + HV_KA + (8 * hh + 4 + q_) * 256 + 16 * (chk_ ^ ((q_ << 2) | ((2 * hh + 1) & 3))) + 8 * ((tid & 63) & 1); \
            const LAS unsigned char* v_lo = pbc + HV_VT + (8 * hh + q_) * 64 + (16 * (((tid & 63) >> 4) & 1) + 4 * ((tid & 63) & 3)) * 2; \
            S = MFMA32(lds_frag_tr(ka_lo, ka_hi), lds_frag_tr(v_lo, v_lo + 4 * 64), S); S = MFMA32(lds_frag_tr(ka_lo + 4096, ka_hi + 4096), lds_frag_tr(v_lo + 16 * 64, v_lo + 20 * 64), S); \
            _Pragma("unroll") \
            for (int q4 = 0; q4 < 4; ++q4) { const f32x4 e0 = *(const LAS f32x4*)(EGL + 32 * kt + 8 * q4 + 4 * hh); \
                _Pragma("unroll") \
                for (int j = 0; j < 4; ++j) S[4 * q4 + j] *= e0[j]; } \
        } else { \
            if (w == 4) { LAS float* OB = (LAS float*)(Lb + HV_OB + ((c) & 1) * HV_OBUF); f32x16 o; \
                _Pragma("unroll") \
                for (int i = 0; i < 16; ++i) o[i] = 0.f; \
                f32x16 X; \
                _Pragma("unroll") \
                for (int i = 0; i < 16; ++i) X[i] = 0.f; \
                const LAS unsigned char* ka_rowp = pbc + HV_KA + r * 256; const int ka_sw = ((r & 3) << 2) | ((r >> 2) & 3); const LAS unsigned char* qa_nat = pbc + HV_QA + r * 272 + hh * 16; \
                { f32x16 Xb; \
                _Pragma("unroll") \
                for (int i = 0; i < 16; ++i) Xb[i] = 0.f; \
                _Pragma("unroll 2") \
                for (int ks = 0; ks < 8; ks += 2) { X = MFMA32(lds_frag16(ka_rowp + 16 * ((2 * ks + hh) ^ ka_sw)), lds_frag16(qa_nat + ks * 32), X); Xb = MFMA32(lds_frag16(ka_rowp + 16 * ((2 * ks + 2 + hh) ^ ka_sw)), lds_frag16(qa_nat + ks * 32 + 32), Xb); } \
                X = X + Xb; } \
                _Pragma("unroll") \
                for (int i = 0; i < 16; ++i) { const int srow = (i & 3) + 8 * (i >> 2) + 4 * hh; X[i] = (srow <= r) ? X[i] : 0.f; } \
                const LAS unsigned char* v4_lo = pbc + HV_VT + (4 * hh + (((tid & 63) >> 2) & 3)) * 64 + (16 * (((tid & 63) >> 4) & 1) + 4 * ((tid & 63) & 3)) * 2;        \
                o = MFMA32(lds_frag_tr(v4_lo, v4_lo + 8 * 64), ACC_FRAG(X, 0), o);                \
                o = MFMA32(lds_frag_tr(v4_lo + 16 * 64, v4_lo + 24 * 64), ACC_FRAG(X, 1), o); \
                LAS float* ob4 = OB + (4 * 32 + r) * 36 + 4 * hh; \
                _Pragma("unroll") \
                for (int q4 = 0; q4 < 4; ++q4) *(LAS f32x4*)(ob4 + 8 * q4) = (f32x4){o[4 * q4], o[4 * q4 + 1], o[4 * q4 + 2], o[4 * q4 + 3]}; \
            } \
            if ((c) > 1) { HGV_FLUSH((c) - 2) } \
            if ((c) > 0) { HGV_OUT((c) - 1) } \
        } \
        LDS_BARRIER(); \
        } }
#define HGV_OUT(cp) { const LAS float* OB = (const LAS float*)(Lb + HV_OB + ((cp) & 1) * HV_OBUF); const int tl = tid - 256, t = tl >> 3, v0 = (tl & 7) * 4; \
            const f32x4 a = *(const LAS f32x4*)(OB + t * 36 + v0), b2 = *(const LAS f32x4*)(OB + (32 + t) * 36 + v0), c2 = *(const LAS f32x4*)(OB + (64 + t) * 36 + v0), d2 = *(const LAS f32x4*)(OB + (96 + t) * 36 + v0), e2 = *(const LAS f32x4*)(OB + (128 + t) * 36 + v0); \
            const f32x4 o4 = ((a + b2) + (c2 + d2)) + e2; \
            float sq = (o4.x * o4.x + o4.y * o4.y) + (o4.z * o4.z + o4.w * o4.w); sq += __int_as_float(__builtin_amdgcn_update_dpp(0, __float_as_int(sq), 0x104, 0xf, 0xf, true)); sq += __int_as_float(__builtin_amdgcn_update_dpp(0, __float_as_int(sq), 0x102, 0xf, 0xf, true)); sq += __int_as_float(__builtin_amdgcn_update_dpp(0, __float_as_int(sq), 0x101, 0xf, 0xf, true));   \
            sq_pend = sq; ow_pend.x = pk2(o4.x, o4.y); ow_pend.y = pk2(o4.z, o4.w); }
#define HGV_FLUSH(cp) { const int tl = tid - 256, t = tl >> 3, v0 = (tl & 7) * 4; const size_t row = rowb + 32 * (cp) + t; \
            if ((tl & 7) == 0) SSQH[row * 32 + hd * 4 + vt] = sq_pend; *(v2u*)(OU + row * 1024 + hd * 128 + 32 * vt + v0) = ow_pend; }
#pragma unroll 1
    for (int cc = 0; cc < 64; cc += 2) { HGV_ITER(cc, pqA, pkA, pxA) HGV_ITER(cc + 1, pqB, pkB, pxB) }
    if (w >= 4) { HGV_FLUSH(62) HGV_OUT(63) HGV_FLUSH(63) }
#undef HGV_ITER
#undef HGV_OUT
#undef HGV_FLUSH
#undef HGV_LOAD
#undef HGV_STORE
    if (w < 4) { float* st_g = F.out + O_HGP + (size_t)(b * 8 + hd) * 16384 + 32 * vt + r;
#pragma unroll
        for (int i = 0; i < 16; ++i) { const int k = 32 * kt + (i & 3) + 8 * (i >> 2) + 4 * hh; st_g[(size_t)k * 128] = S[i]; } }
    __syncthreads();
}
__device__ __forceinline__ void hgnorm_phase(Frame& F) {
    const int gw = F.vcu * NWAVES + F.wave, NGW = F.G * NWAVES; bf16* ON = (bf16*)(F.ws + WS_ON); const float* SSQH = (const float*)(F.ws + WS_SSQH);
    const bf16* HG = (const bf16*)(F.ws + WS_PROJ) + (size_t)S_HG * SLOT_ELEMS;
    for (int row = gw; row < TP; row += NGW) {
#pragma unroll
        for (int j = 0; j < 2; ++j) { const int pc = j * 64 + F.lane, hd = pc >> 4;
            const f32x4 sp = *(const f32x4*)(SSQH + (size_t)row * 32 + hd * 4); const float rs = __builtin_amdgcn_rsqf(((sp.x + sp.y) + (sp.z + sp.w)) * (1.0f / 128.0f) + EPS);
            v4u* p = (v4u*)(ON + (size_t)row * 1024) + pc; const v4u o = *p; const v4u g = ld_nt16((const v4u*)(HG + (size_t)row * 1024) + pc); v4u res;
#pragma unroll
            for (int e = 0; e < 4; ++e) res[e] = pk2(bf2f(o[e] & 0xffffu) * rs * silu_f(bf2f(g[e] & 0xffffu)), __uint_as_float(o[e] & 0xffff0000u) * rs * silu_f(__uint_as_float(g[e] & 0xffff0000u)));
            *p = res; }
    }
}
constexpr int SD_BN = 0, SD_CN = 17408, SD_BT = 34816, SD_XT = 53248, SD_HT = 62464, SD_YA = 97280, SD_YY = 113664, SD_YO = 130048, SD_CUM = 134144, SD_DTV = 134400, SD_ECUM = 134656, SD_XWT = 134912, SD_CWL = 144128;
__device__ __forceinline__ void ssd_unit_mfma(Frame& F, int gb, int h) {
    int tid_o = F.tid; asm volatile("" : "+v"(tid_o));
    const int tid = tid_o, lane = tid & 63, w = F.wave, r = lane & 31, hh = lane >> 5; unsigned char* ws = F.ws;
    const int L = SEQ; const size_t row_base = (size_t)gb * SEQ;
    const int g = h >> 3;
    LAS unsigned char* Lb = F.lds + RING_OFF;
    LAS unsigned short* BN = (LAS unsigned short*)(Lb + SD_BN); LAS unsigned short* CN = (LAS unsigned short*)(Lb + SD_CN);
    LAS unsigned short* BT = (LAS unsigned short*)(Lb + SD_BT); LAS unsigned short* XT = (LAS unsigned short*)(Lb + SD_XT);
    LAS unsigned short* HT = (LAS unsigned short*)(Lb + SD_HT);
    LAS unsigned short* XWT = (LAS unsigned short*)(Lb + SD_XWT);
    LAS float* YA = (LAS float*)(Lb + SD_YA); LAS float* YY = (LAS float*)(Lb + SD_YY); LAS unsigned short* YO = (LAS unsigned short*)(Lb + SD_YO);
    LAS float* CUM = (LAS float*)(Lb + SD_CUM); LAS float* DTV = (LAS float*)(Lb + SD_DTV); LAS float* ECUM = (LAS float*)(Lb + SD_ECUM);
    const bf16* PROJ = (const bf16*)(ws + WS_PROJ); const float* DTR = (const float*)(ws + WS_DT); bf16* YG = (bf16*)(ws + WS_YG); float* SSQ = (float*)(ws + WS_SSQSSD);
    f32x16 H0, H1, H2, H3;
#pragma unroll
    for (int i = 0; i < 16; ++i) { H0[i] = 0.f; H1[i] = 0.f; H2[i] = 0.f; H3[i] = 0.f; }
    float* const st_base = F.out + O_SSMP + (size_t)(gb * 32 + h) * 8192 + (size_t)r * 128 + 4 * hh;
#define SSD_PUBLISH(HX, TILE, BUF) { LAS unsigned short* hp_ = HT + (BUF) * 8704 + (32 * ((TILE) & 1) + r) * 136 + 32 * ((TILE) >> 1) + 4 * hh; \
        _Pragma("unroll") for (int q4 = 0; q4 < 4; ++q4) { v2u pk; pk.x = cvtpk_c(HX[4 * q4], HX[4 * q4 + 1]); pk.y = cvtpk_c(HX[4 * q4 + 2], HX[4 * q4 + 3]); *(LAS v2u*)(hp_ + 8 * q4) = pk; } }
    if (w == 3) { SSD_PUBLISH(H0, 0, 0) SSD_PUBLISH(H1, 1, 0) SSD_PUBLISH(H2, 2, 0) SSD_PUBLISH(H3, 3, 0) } else if (w >= 4) { SSD_PUBLISH(H0, w, 0) }
    const float a = -__expf(F.in[13][h]), dtb = F.in[12][h], Dk = F.in[14][h];
    const float* cw = F.in[10]; const float* cbp = F.in[11];
    typedef float f32x2 __attribute__((ext_vector_type(2)));
    const int col = h * 64 + 2 * (tid & 31);
    const bf16* cptr = PROJ + (size_t)(S_X0 + (col >> 10)) * SLOT_ELEMS + row_base * 1024 + (col & 1023);
    const f32x2 cw0 = *(const f32x2*)(cw + col), cw1 = *(const f32x2*)(cw + 3072 + col), cw2 = *(const f32x2*)(cw + 2 * 3072 + col), cw3 = *(const f32x2*)(cw + 3 * 3072 + col), cbb = *(const f32x2*)(cbp + col);
    const bf16* BCS = (const bf16*)(ws + WS_BCS) + row_base * 1024 + g * 128;
    unsigned xr[7]; v4u pc[4];
#pragma unroll
    for (int i = 0; i < 7; ++i) { const int gt = 4 * (tid >> 5) - 3 + i; xr[i] = 0u; if (gt >= 0) xr[i] = *(const unsigned*)(cptr + (size_t)gt * 1024); }
#pragma unroll
    for (int j = 0; j < 4; ++j) { const int idx = (tid + 512 * j) & 1023; pc[j] = *(const v4u*)(BCS + (size_t)(idx >> 4) * 1024 + (j >> 1) * 512 + 8 * (idx & 15)); }
    __syncthreads();
    v4u ow_pend = (v4u){0u, 0u, 0u, 0u}; float sq_pend = 0.f; bool pend = false;
    int buf = 0;
    float dt_pf = 0.f;
    if (lane < L) dt_pf = DTR[(row_base + lane) * 32 + h];
    v4u zw_pf = ld_nt16(PROJ + (size_t)(S_Z0 + (h >> 4)) * SLOT_ELEMS + (row_base + (tid >> 3)) * 1024 + (h & 15) * 64 + (tid & 7) * 8);
    for (int t0 = 0; t0 < L; t0 += 64, buf ^= 1) {
        int r_l = r, hh_l = hh, tid_l = tid, lane_l = lane;
        asm volatile("" : "+v"(r_l), "+v"(hh_l), "+v"(tid_l), "+v"(lane_l));
        { const int r = r_l, hh = hh_l, tid = tid_l, lane = lane_l;
        float dtv = 0.f;
        if (t0 + lane < L) { const float x = dt_pf + dtb; dtv = fmaxf(x, 0.f) + 0.6931471805599453f * __builtin_amdgcn_logf(1.0f + __builtin_amdgcn_exp2f(-1.4426950408889634f * fabsf(x))); }
        dt_pf = 0.f; if (t0 + 64 + lane < L) dt_pf = DTR[(row_base + t0 + 64 + lane) * 32 + h];
        const v4u zw = zw_pf; zw_pf = (v4u){0u, 0u, 0u, 0u};
        if (t0 + 64 + (tid >> 3) < L) zw_pf = ld_nt16(PROJ + (size_t)(S_Z0 + (h >> 4)) * SLOT_ELEMS + (row_base + t0 + 64 + (tid >> 3)) * 1024 + (h & 15) * 64 + (tid & 7) * 8);
        float cum = dtv * a;
#define SSD_DPP_ADD(ctrl, rmask) cum += __int_as_float(__builtin_amdgcn_update_dpp(0, __float_as_int(cum), ctrl, rmask, 0xf, true))
        SSD_DPP_ADD(0x111, 0xf); SSD_DPP_ADD(0x112, 0xf); SSD_DPP_ADD(0x114, 0xf); SSD_DPP_ADD(0x118, 0xf);
        SSD_DPP_ADD(0x142, 0xa); SSD_DPP_ADD(0x143, 0xc);
#undef SSD_DPP_ADD
        const float cum_last = __int_as_float(__builtin_amdgcn_readlane(__float_as_int(cum), 63));
        const float wgt = __expf(cum_last - cum) * dtv;
        if (w == 0) { CUM[lane] = cum; DTV[lane] = dtv; ECUM[lane] = __expf(cum); }
#pragma unroll
        for (int j = 0; j < 4; ++j) { const int idx = (tid + 512 * j) & 1023;
            if (j < 2) { const int row = idx >> 4; *(LAS v4u*)((LAS unsigned char*)BN + 256 * row + 16 * ((idx & 15) ^ (((row & 3) << 2) | ((row >> 2) & 3)))) = pc[j]; }
            else *(LAS v4u*)(CN + (idx >> 4) * 136 + 8 * (idx & 15)) = pc[j]; }
        if (pend) { const size_t prow = row_base + (t0 - 64) + (tid >> 3);
            *(v4u*)(YG + prow * 2048 + h * 64 + (tid & 7) * 8) = ow_pend; if ((tid & 7) == 0) SSQ[prow * 32 + h] = sq_pend; pend = false; }
        { const int cp = tid & 31, sq = tid >> 5; const int wu = __builtin_amdgcn_readfirstlane(w);
          f32x2 xv[7];
#pragma unroll
          for (int i = 0; i < 7; ++i) xv[i] = (f32x2){__uint_as_float(xr[i] << 16), __uint_as_float(xr[i] & 0xffff0000u)};
          unsigned po[4], pw[4];
          f32x2 o[4], ow[4];
#pragma unroll
          for (int k = 0; k < 4; ++k) {
              const float w_lo = __int_as_float(__builtin_amdgcn_readlane(__float_as_int(wgt), 8 * wu + k)), w_hi = __int_as_float(__builtin_amdgcn_readlane(__float_as_int(wgt), 8 * wu + 4 + k));
              const float wx = hh ? w_hi : w_lo;
              f32x2 a = cw0 * xv[k] + cbb; a = cw1 * xv[k + 1] + a; a = cw2 * xv[k + 2] + a; a = cw3 * xv[k + 3] + a;
              const f32x2 t = a * (-1.4426950408889634f); f32x2 e; e.x = __builtin_amdgcn_exp2f(t.x); e.y = __builtin_amdgcn_exp2f(t.y); e = e + 1.0f;
              f32x2 rc; rc.x = __builtin_amdgcn_rcpf(e.x); rc.y = __builtin_amdgcn_rcpf(e.y); o[k] = a * rc; ow[k] = o[k] * wx; }
          po[0] = pk2(o[0].x, o[1].x); po[1] = pk2(o[2].x, o[3].x); po[2] = pk2(o[0].y, o[1].y); po[3] = pk2(o[2].y, o[3].y);
          pw[0] = pk2(ow[0].x, ow[1].x); pw[1] = pk2(ow[2].x, ow[3].x); pw[2] = pk2(ow[0].y, ow[1].y); pw[3] = pk2(ow[2].y, ow[3].y);
          *(LAS v2u*)(XT + (2 * cp) * 72 + 4 * sq) = (v2u){po[0], po[1]}; *(LAS v2u*)(XT + (2 * cp + 1) * 72 + 4 * sq) = (v2u){po[2], po[3]};
          *(LAS v2u*)(XWT + (2 * cp) * 72 + 4 * sq) = (v2u){pw[0], pw[1]}; *(LAS v2u*)(XWT + (2 * cp + 1) * 72 + 4 * sq) = (v2u){pw[2], pw[3]};
        }
        if (t0 + 64 < L) {
#pragma unroll
            for (int i = 0; i < 7; ++i) xr[i] = *(const unsigned*)(cptr + (size_t)(t0 + 64 + 4 * (tid >> 5) - 3 + i) * 1024);
#pragma unroll
            for (int j = 0; j < 4; ++j) { const int idx = (tid + 512 * j) & 1023; pc[j] = *(const v4u*)(BCS + (size_t)(t0 + 64 + (idx >> 4)) * 1024 + (j >> 1) * 512 + 8 * (idx & 15)); }
        }
        LDS_BARRIER();
        if (w < 3) {
            const int tt = w == 0 ? 0 : 1, st = w == 1 ? 1 : 0;
            f32x16 X, ya0, ya1;
#pragma unroll
            for (int i = 0; i < 16; ++i) { X[i] = 0.f; ya0[i] = 0.f; ya1[i] = 0.f; }
            const LAS unsigned char* cn_nat = Lb + SD_CN + (32 * tt + r) * 272 + hh * 16; const int bn_sw = ((r & 3) << 2) | ((r >> 2) & 3); const LAS unsigned char* bn_row = Lb + SD_BN + (32 * st + r) * 256;
            { f32x16 Xb;
#pragma unroll
              for (int i = 0; i < 16; ++i) Xb[i] = 0.f;
#pragma unroll
              for (int ks = 0; ks < 8; ks += 2) { X = MFMA32(lds_frag16(bn_row + 16 * ((2 * ks + hh) ^ bn_sw)), lds_frag16(cn_nat + ks * 32), X); Xb = MFMA32(lds_frag16(bn_row + 16 * ((2 * ks + 2 + hh) ^ bn_sw)), lds_frag16(cn_nat + ks * 32 + 32), Xb); }
              X = X + Xb; }
            const float cum_t = CUM[32 * tt + r];
#pragma unroll
            for (int q4 = 0; q4 < 4; ++q4) { const f32x4 cs = *(const LAS f32x4*)(CUM + 32 * st + 8 * q4 + 4 * hh), ds = *(const LAS f32x4*)(DTV + 32 * st + 8 * q4 + 4 * hh);
#pragma unroll
                for (int jj = 0; jj < 4; ++jj) { const int s_abs = 32 * st + 8 * q4 + 4 * hh + jj; const float f = __expf(cum_t - cs[jj]) * ds[jj]; X[4 * q4 + jj] = (s_abs <= 32 * tt + r) ? X[4 * q4 + jj] * f : 0.f;        } }
            const bf16x8 xf0 = ACC_FRAG(X, 0), xf1 = ACC_FRAG(X, 1);
            const LAS unsigned char* xt_row = Lb + SD_XT + r * 144 + (32 * st + 4 * hh) * 2;
            ya0 = MFMA32(lds_frag8x2(xt_row), xf0, ya0); ya0 = MFMA32(lds_frag8x2(xt_row + 32), xf1, ya0);
            ya1 = MFMA32(lds_frag8x2(xt_row + 32 * 144), xf0, ya1); ya1 = MFMA32(lds_frag8x2(xt_row + 32 * 144 + 32), xf1, ya1);
            if (w < 2) { LAS float* yb = YA + (32 * tt + r) * 64;
#pragma unroll
                for (int q4 = 0; q4 < 4; ++q4) { const int ch = 2 * q4 + hh;
                    *(LAS f32x4*)(yb + 4 * (ch ^ (r & 15))) = (f32x4){ya0[4 * q4], ya0[4 * q4 + 1], ya0[4 * q4 + 2], ya0[4 * q4 + 3]};
                    *(LAS f32x4*)(yb + 4 * ((ch + 8) ^ (r & 15))) = (f32x4){ya1[4 * q4], ya1[4 * q4 + 1], ya1[4 * q4 + 2], ya1[4 * q4 + 3]}; } }
            else { LAS unsigned char* yb = (LAS unsigned char*)YO + r * 128;
#pragma unroll
                for (int q4 = 0; q4 < 4; ++q4) { const int ch = 2 * q4 + hh; v2u p0, p1;
                    p0.x = cvtpk_c(ya0[4 * q4], ya0[4 * q4 + 1]); p0.y = cvtpk_c(ya0[4 * q4 + 2], ya0[4 * q4 + 3]); p1.x = cvtpk_c(ya1[4 * q4], ya1[4 * q4 + 1]); p1.y = cvtpk_c(ya1[4 * q4 + 2], ya1[4 * q4 + 3]);
                    *(LAS v2u*)(yb + 8 * (ch ^ ((r & 7) << 1))) = p0; *(LAS v2u*)(yb + 8 * ((ch + 8) ^ ((r & 7) << 1))) = p1; } }
        } else if (w >= 4) {
            const int tt = (w - 4) >> 1, ptj = w & 1;
            const LAS unsigned char* ht_nat = Lb + SD_HT + buf * 17408 + (32 * ptj + r) * 272 + hh * 16;
            f32x16 yi;
#pragma unroll
            for (int i = 0; i < 16; ++i) yi[i] = 0.f;
            const LAS unsigned char* cn_nat = Lb + SD_CN + (32 * tt + r) * 272 + hh * 16;
            { f32x16 yb2;
#pragma unroll
              for (int i = 0; i < 16; ++i) yb2[i] = 0.f;
#pragma unroll 2
              for (int ks = 0; ks < 8; ks += 2) { yi = MFMA32(lds_frag16(cn_nat + ks * 32), lds_frag16(ht_nat + ks * 32), yi); yb2 = MFMA32(lds_frag16(cn_nat + ks * 32 + 32), lds_frag16(ht_nat + ks * 32 + 32), yb2); }
              yi = yi + yb2; }
            const LAS unsigned short* xt_p = XT + (32 * ptj + r) * 72 + 32 * tt + 4 * hh;
#pragma unroll
            for (int q4 = 0; q4 < 4; ++q4) { const f32x4 ec = *(const LAS f32x4*)(ECUM + 32 * tt + 8 * q4 + 4 * hh); const v2u xw = *(const LAS v2u*)(xt_p + 8 * q4);
                const float x0 = bf2f(xw.x & 0xffffu), x1 = bf2f(xw.x >> 16), x2 = bf2f(xw.y & 0xffffu), x3 = bf2f(xw.y >> 16);
                LAS float* yb = YY + (32 * tt + 8 * q4 + 4 * hh) * 64 + 32 * ptj + r;
                yb[0] = ec[0] * yi[4 * q4] + Dk * x0; yb[64] = ec[1] * yi[4 * q4 + 1] + Dk * x1; yb[128] = ec[2] * yi[4 * q4 + 2] + Dk * x2; yb[192] = ec[3] * yi[4 * q4 + 3] + Dk * x3; }
        }
#define SSD_UPD(HX, TILE) { const int q_ = (lane >> 2) & 3, ch_ = 4 * ((TILE) >> 1) + 2 * ((lane >> 4) & 1) + ((lane >> 1) & 1); \
            const LAS unsigned char* bn_lo = Lb + SD_BN + (8 * hh + q_) * 256 + 16 * (ch_ ^ ((q_ << 2) | ((2 * hh) & 3))) + 8 * (lane & 1); \
            const LAS unsigned char* bn_hi = Lb + SD_BN + (8 * hh + 4 + q_) * 256 + 16 * (ch_ ^ ((q_ << 2) | ((2 * hh + 1) & 3))) + 8 * (lane & 1); \
            const LAS unsigned char* xt_nat = Lb + SD_XWT + (32 * ((TILE) & 1) + r) * 144 + hh * 16; \
            f32x16 Ha, Hb; \
            _Pragma("unroll") for (int i = 0; i < 16; ++i) { Ha[i] = 0.f; Hb[i] = 0.f; } \
            Ha = MFMA32(lds_frag_tr(bn_lo, bn_hi), lds_frag16(xt_nat), Ha); Hb = MFMA32(lds_frag_tr(bn_lo + 4096, bn_hi + 4096), lds_frag16(xt_nat + 32), Hb); \
            Ha = MFMA32(lds_frag_tr(bn_lo + 8192, bn_hi + 8192), lds_frag16(xt_nat + 64), Ha); Hb = MFMA32(lds_frag_tr(bn_lo + 12288, bn_hi + 12288), lds_frag16(xt_nat + 96), Hb);         \
            _Pragma("unroll") for (int i = 0; i < 16; ++i) HX[i] = HX[i] * el + (Ha[i] + Hb[i]); \
            SSD_PUBLISH(HX, TILE, buf ^ 1) }
        if (w >= 3) { const float el = ECUM[63];
            if (w == 3) { SSD_UPD(H0, 0) SSD_UPD(H1, 1) SSD_UPD(H2, 2) SSD_UPD(H3, 3) } else { SSD_UPD(H0, w) } }
        LDS_BARRIER();
        { const int tt = tid >> 3, p0 = (tid & 7) * 8;
          if (t0 + tt < L) { const size_t row = row_base + t0 + tt;
            const int c0 = 2 * (tid & 7);
            f32x4 y0 = *(const LAS f32x4*)(YA + tt * 64 + 4 * (c0 ^ (tt & 15))) + *(const LAS f32x4*)(YY + tt * 64 + p0), y1 = *(const LAS f32x4*)(YA + tt * 64 + 4 * ((c0 + 1) ^ (tt & 15))) + *(const LAS f32x4*)(YY + tt * 64 + p0 + 4);
            if (tt >= 32) { const v4u ow4 = *(const LAS v4u*)((const LAS unsigned char*)YO + (tt - 32) * 128 + 16 * ((tid & 7) ^ (tt & 7)));
                y0 = y0 + (f32x4){bf2f(ow4.x & 0xffffu), __uint_as_float(ow4.x & 0xffff0000u), bf2f(ow4.y & 0xffffu), __uint_as_float(ow4.y & 0xffff0000u)};
                y1 = y1 + (f32x4){bf2f(ow4.z & 0xffffu), __uint_as_float(ow4.z & 0xffff0000u), bf2f(ow4.w & 0xffffu), __uint_as_float(ow4.w & 0xffff0000u)}; }
            float o[8]; float sq = 0.f;
#pragma unroll
            for (int j = 0; j < 8; ++j) { const unsigned z16 = (zw[j >> 1] >> ((j & 1) * 16)) & 0xffffu; const float yv = (j < 4 ? y0[j & 3] : y1[j & 3]) * silu_f(bf2f(z16)); o[j] = yv; sq += yv * yv; }
            ow_pend.x = pk2(o[0], o[1]); ow_pend.y = pk2(o[2], o[3]); ow_pend.z = pk2(o[4], o[5]); ow_pend.w = pk2(o[6], o[7]);
            sq += __int_as_float(__builtin_amdgcn_update_dpp(0, __float_as_int(sq), 0x104, 0xf, 0xf, true));
            sq += __int_as_float(__builtin_amdgcn_update_dpp(0, __float_as_int(sq), 0x102, 0xf, 0xf, true));
            sq += __int_as_float(__builtin_amdgcn_update_dpp(0, __float_as_int(sq), 0x101, 0xf, 0xf, true)); sq_pend = sq; pend = true; } }
        }
    }
    if (pend) { const size_t prow = row_base + (L - 64) + (tid >> 3); *(v4u*)(YG + prow * 2048 + h * 64 + (tid & 7) * 8) = ow_pend; if ((tid & 7) == 0) SSQ[prow * 32 + h] = sq_pend; }
#define SSD_STOUT(HX, TILE) { float* st_g = st_base + (size_t)(32 * ((TILE) & 1)) * 128 + 32 * ((TILE) >> 1); \
        _Pragma("unroll") for (int q4 = 0; q4 < 4; ++q4) *(f32x4*)(st_g + 8 * q4) = (f32x4){HX[4 * q4], HX[4 * q4 + 1], HX[4 * q4 + 2], HX[4 * q4 + 3]}; }
    if (w == 3) { SSD_STOUT(H0, 0) SSD_STOUT(H1, 1) SSD_STOUT(H2, 2) SSD_STOUT(H3, 3) } else if (w >= 4) { SSD_STOUT(H0, w) }
#undef SSD_STOUT
#undef SSD_UPD
#undef SSD_PUBLISH
    __syncthreads();
}
__device__ __forceinline__ float tr_reduce32(const float (&v)[32], int lane) {
    const bool b4 = lane & 16, b3 = lane & 8, b2 = lane & 4, b1 = lane & 2, b0 = lane & 1;
    float a[16], b[8], c[4], d[2];
#pragma unroll
    for (int i = 0; i < 16; ++i) { const float keep = b4 ? v[i + 16] : v[i], send = b4 ? v[i] : v[i + 16]; a[i] = keep + __shfl_xor(send, 16); }
#pragma unroll
    for (int i = 0; i < 8; ++i) { const float keep = b3 ? a[i + 8] : a[i], send = b3 ? a[i] : a[i + 8]; b[i] = keep + __shfl_xor(send, 8); }
#pragma unroll
    for (int i = 0; i < 4; ++i) { const float keep = b2 ? b[i + 4] : b[i], send = b2 ? b[i] : b[i + 4]; c[i] = keep + __shfl_xor(send, 4); }
#pragma unroll
    for (int i = 0; i < 2; ++i) { const float keep = b1 ? c[i + 2] : c[i], send = b1 ? c[i] : c[i + 2]; d[i] = keep + __shfl_xor(send, 2); }
    const float keep = b0 ? d[1] : d[0], send = b0 ? d[0] : d[1];
    return keep + __shfl_xor(send, 1);
}
__device__ __forceinline__ void ssd_sample_unit(Frame& F, int sb, int g) {
    int tid_o = F.tid; asm volatile("" : "+v"(tid_o));
    const int tid = tid_o, lane = tid & 63, w = F.wave, hh = lane >> 5, nq = lane & 31; unsigned char* ws = F.ws;
    LAS float* XC = (LAS float*)(F.lds + RING_OFF); LAS float* BC = XC + 8 * 4 * 64; LAS float* CC = BC + 4 * 128; LAS float* DTS = CC + 4 * 128;
    const bf16* PROJ = (const bf16*)(ws + WS_PROJ); const float* DTR = (const float*)(ws + WS_DT); bf16* YG = (bf16*)(ws + WS_YG); float* SSQ = (float*)(ws + WS_SSQSSD);
    const size_t row0 = (size_t)TP + (size_t)sb * LS;
    const int h = 8 * g + w;
    const float* sp = F.in[3] + (size_t)(sb * 32 + h) * 8192 + (size_t)hh * 128 + 4 * nq;
    f32x4 hst[32];
#pragma unroll
    for (int i = 0; i < 32; ++i) hst[i] = ld_nt(sp + (size_t)i * 256);
    if (tid < 384) { typedef float f32x2 __attribute__((ext_vector_type(2)));
        const int col = tid < 256 ? g * 512 + 2 * tid : (tid < 320 ? 2048 + g * 128 + 2 * (tid - 256) : 2560 + g * 128 + 2 * (tid - 320));
        const float* cw = F.in[10]; const float* sc = F.in[4] + (size_t)sb * 3 * 3072 + col;
        const f32x2 w0 = *(const f32x2*)(cw + col), w1 = *(const f32x2*)(cw + 3072 + col), w2 = *(const f32x2*)(cw + 2 * 3072 + col), w3 = *(const f32x2*)(cw + 3 * 3072 + col), cb = *(const f32x2*)(F.in[11] + col);
        f32x2 full[7]; full[0] = *(const f32x2*)sc; full[1] = *(const f32x2*)(sc + 3072); full[2] = *(const f32x2*)(sc + 2 * 3072);
        const bf16* cp = PROJ + (size_t)(S_X0 + (col >> 10)) * SLOT_ELEMS + row0 * 1024 + (col & 1023);
#pragma unroll
        for (int t = 0; t < 4; ++t) { const unsigned wd = *(const unsigned*)(cp + (size_t)t * 1024); full[3 + t] = (f32x2){__uint_as_float(wd << 16), __uint_as_float(wd & 0xffff0000u)}; }
#pragma unroll
        for (int t = 0; t < 4; ++t) { f32x2 a = w0 * full[t] + cb; a = w1 * full[t + 1] + a; a = w2 * full[t + 2] + a; a = w3 * full[t + 3] + a;
            f32x2 o; o.x = silu_f(a.x); o.y = silu_f(a.y);
            LAS float* dst = tid < 256 ? XC + ((tid >> 5) * 4 + t) * 64 + 2 * (tid & 31) : (tid < 320 ? BC + t * 128 + 2 * (tid - 256) : CC + t * 128 + 2 * (tid - 320));
            *(LAS f32x2*)dst = o; }
    } else if (tid < 416) { const int idx = tid - 384, hl = idx >> 2, t = idx & 3; const float x = DTR[(row0 + t) * 32 + 8 * g + hl] + F.in[12][8 * g + hl]; DTS[idx] = x > 20.f ? x : log1pf(__expf(x)); }
    __syncthreads();
    const float a = -__expf(F.in[13][h]), Dk = F.in[14][h];
#pragma unroll 1
    for (int t = 0; t < 4; ++t) {
        const float dtv = DTS[w * 4 + t], dA = __expf(dtv * a);
        const f32x4 Bv = *(const LAS f32x4*)(BC + t * 128 + 4 * nq), Cv = *(const LAS f32x4*)(CC + t * 128 + 4 * nq);
        const LAS float* xrow = XC + (w * 4 + t) * 64;
        float part[32];
#pragma unroll
        for (int i = 0; i < 32; ++i) { const float xd = xrow[2 * i + hh] * dtv; hst[i] = hst[i] * dA + Bv * xd; part[i] = (hst[i].x * Cv.x + hst[i].y * Cv.y) + (hst[i].z * Cv.z + hst[i].w * Cv.w); }
        float yv = tr_reduce32(part, lane);
        const int p = 2 * nq + hh; const size_t row = row0 + t;
        yv += Dk * xrow[p];
        const float z = bf2f(PROJ[(size_t)(S_Z0 + (h >> 4)) * SLOT_ELEMS + row * 1024 + (h & 15) * 64 + p]);
        const float yg = yv * silu_f(z);
        YG[row * 2048 + h * 64 + p] = (bf16)f2bf(yg);
        const float sq = wave_sum(yg * yg);
        if (lane == 0) SSQ[row * 32 + h] = sq;
    }
    float* so = F.out + O_SSMS + (size_t)(sb * 32 + h) * 8192 + (size_t)hh * 128 + 4 * nq;
#pragma unroll
    for (int i = 0; i < 32; ++i) st_nt(so + (size_t)i * 256, hst[i]);
    __syncthreads();
}
__device__ __forceinline__ void hgrn_sample_unit(Frame& F, int sb, int hq) {
    int tid_o = F.tid; asm volatile("" : "+v"(tid_o));
    const int tid = tid_o, lane = tid & 63, w = F.wave, hh = lane >> 5, vq = lane & 31; unsigned char* ws = F.ws;
    LAS float* FS = (LAS float*)(F.lds + RING_OFF); LAS float* KS = FS + 2048; LAS float* QS = KS + 2048; LAS float* VS = QS + 2048; LAS float* OP = VS + 2048;
    const bf16* PROJ = (const bf16*)(ws + WS_PROJ); bf16* ON = (bf16*)(ws + WS_ON);
    const size_t row0 = (size_t)TP + (size_t)sb * LS;
    const int hl = w >> 1, kh = w & 1, hd = 4 * hq + hl;
    const float* sp = F.in[5] + (size_t)(sb * 8 + hd) * 16384 + (size_t)(64 * kh + hh) * 128 + 4 * vq;
    f32x4 S[32];
#pragma unroll
    for (int i = 0; i < 32; ++i) S[i] = ld_nt(sp + (size_t)i * 256);
    { const int ch = hq * 512 + tid; const float lb = __builtin_amdgcn_rcpf(1.0f + __expf(F.in[17][1024 + ch] - F.in[17][ch]));
      const bf16* fp = PROJ + (size_t)S_F * SLOT_ELEMS + row0 * 1024 + ch; const bf16* qp = PROJ + (size_t)S_Q * SLOT_ELEMS + row0 * 1024 + ch; const bf16* ip = PROJ + (size_t)S_I * SLOT_ELEMS + row0 * 1024 + ch;
#pragma unroll
      for (int t = 0; t < 4; ++t) { const float u = fminf(fmaxf(bf2f(fp[(size_t)t * 1024]), -30.f), 30.f); const float fg = lb + (1.0f - lb) * sigmoid_f(u);
          const int o = ((tid >> 7) * 4 + t) * 128 + (tid & 127);
          FS[o] = fg; KS[o] = 1.0f - fg; QS[o] = silu_f(bf2f(qp[(size_t)t * 1024])); VS[o] = bf2f(ip[(size_t)t * 1024]); } }
    __syncthreads();
#pragma unroll 1
    for (int t = 0; t < 4; ++t) {
        const int o = (hl * 4 + t) * 128;
        const f32x4 vv = *(const LAS f32x4*)(VS + o + 4 * vq);
        f32x4 oa = (f32x4){0.f, 0.f, 0.f, 0.f};
#pragma unroll
        for (int i = 0; i < 32; ++i) { const int k = 64 * kh + 2 * i + hh; const float fk = FS[o + k], kv = KS[o + k], qk = QS[o + k]; S[i] = S[i] * fk + vv * kv; oa = oa + S[i] * qk; }
        oa.x += __shfl_xor(oa.x, 32); oa.y += __shfl_xor(oa.y, 32); oa.z += __shfl_xor(oa.z, 32); oa.w += __shfl_xor(oa.w, 32);
        if (hh == 0) *(LAS f32x4*)(OP + ((hl * 4 + t) * 2 + kh) * 128 + 4 * vq) = oa;
    }
    float* so = F.out + O_HGS + (size_t)(sb * 8 + hd) * 16384 + (size_t)(64 * kh + hh) * 128 + 4 * vq;
#pragma unroll
    for (int i = 0; i < 32; ++i) st_nt(so + (size_t)i * 256, S[i]);
    __syncthreads();
#pragma unroll
    for (int rr2 = 0; rr2 < 2; ++rr2) { const int rr = 2 * w + rr2, ohl = rr >> 2, t = rr & 3, ohd = 4 * hq + ohl; typedef float f32x2 __attribute__((ext_vector_type(2)));
        const f32x2 p0 = *(const LAS f32x2*)(OP + (rr * 2) * 128 + 2 * lane), p1 = *(const LAS f32x2*)(OP + (rr * 2 + 1) * 128 + 2 * lane);
        const float o0 = p0.x + p1.x, o1 = p0.y + p1.y; const float sq = wave_sum(o0 * o0 + o1 * o1); const float rs = __builtin_amdgcn_rsqf(sq * (1.0f / 128.0f) + EPS);
        const size_t row = row0 + t; const unsigned gw = *(const unsigned*)(PROJ + (size_t)S_HG * SLOT_ELEMS + row * 1024 + ohd * 128 + 2 * lane);
        *(unsigned*)(ON + row * 1024 + ohd * 128 + 2 * lane) = pk2(o0 * rs * silu_f(bf2f(gw & 0xffffu)), o1 * rs * silu_f(__uint_as_float(gw & 0xffff0000u))); }
    __syncthreads();
}
constexpr int U_HGS = NBS * 2, U_SSDS = NBS * 4, U_CONV = NBP + NBS;
__device__ __forceinline__ void scan_phase(Frame& F) {
    gu32* head = F.ctl + CW_QUEUE;
#define SCAN_QUEUE(qi, count, body) for (;;) { if (F.tid == 0) F.MISC[0] = __hip_atomic_fetch_add(head + 64 * (qi), 1u, RLX_AGENT); __syncthreads(); const int u = (int)F.MISC[0]; __syncthreads(); if (u >= (count)) break; body }
    SCAN_QUEUE(1, NBP * 32, ssd_unit_mfma(F, u >> 5, u & 31);)
    SCAN_QUEUE(0, NBP * 32, hgrn_v_unit(F, u >> 5, (u >> 2) & 7, u & 3);)
    SCAN_QUEUE(2, U_HGS, hgrn_sample_unit(F, u >> 1, u & 1);)
    SCAN_QUEUE(3, U_SSDS + U_CONV, if (u >= U_SSDS) { conv_copy_unit(F, u - U_SSDS); continue; } ssd_sample_unit(F, u >> 2, u & 3);)
#undef SCAN_QUEUE
}
typedef float f32x4s __attribute__((ext_vector_type(4)));
template <class Epi> __device__ __forceinline__ void small_tile_phase(Frame& F, const bf16* A, const bf16* Bt, int K, const Epi& E) {
    const int lane = F.lane, w = F.wave, r = lane & 31, hh = lane >> 5;
#pragma unroll 1
    for (int v = F.vcu; v < 256; v += F.G) {
    const int mt = v >> 4, nt = v & 15;
    const int kw = K >> 3;
    const bf16* ap = A + (size_t)(TP + 32 * mt + r) * K + w * kw + 8 * hh;
    const bf16* bp = Bt + (size_t)(64 * nt + r) * K + w * kw + 8 * hh;
    f32x16 acc0, acc1;
#pragma unroll
    for (int i = 0; i < 16; ++i) { acc0[i] = 0.f; acc1[i] = 0.f; }
#pragma unroll 4
    for (int ks = 0; ks < kw / 16; ++ks) { const bf16x8 af = *(const bf16x8*)(ap + 16 * ks), b0 = *(const bf16x8*)(bp + 16 * ks), b1 = *(const bf16x8*)(bp + (size_t)32 * K + 16 * ks);
        acc0 = MFMA32(b0, af, acc0); acc1 = MFMA32(b1, af, acc1); }
    LAS float* part = (LAS float*)(F.lds + RING_OFF) + w * 2048;
#pragma unroll
    for (int q4 = 0; q4 < 4; ++q4) { *(LAS f32x4*)(part + r * 64 + 8 * q4 + 4 * hh) = (f32x4){acc0[4 * q4], acc0[4 * q4 + 1], acc0[4 * q4 + 2], acc0[4 * q4 + 3]};
        *(LAS f32x4*)(part + r * 64 + 32 + 8 * q4 + 4 * hh) = (f32x4){acc1[4 * q4], acc1[4 * q4 + 1], acc1[4 * q4 + 2], acc1[4 * q4 + 3]}; }
    __syncthreads();
    const int rl = F.tid >> 4, c4 = (F.tid & 15) * 4; const LAS float* src = (const LAS float*)(F.lds + RING_OFF) + rl * 64 + c4;
    f32x4 sum = *(const LAS f32x4*)src;
#pragma unroll
    for (int ww = 1; ww < 8; ++ww) sum = sum + *(const LAS f32x4*)(src + ww * 2048);
    const f32x4s acc = (f32x4s){sum.x, sum.y, sum.z, sum.w};
    E.small(F, acc, TP + 32 * mt + rl, 64 * nt + c4, nt);
    __syncthreads();
    }
}
template <bool ADD> struct SmGate { bf16* O; const bf16* gate;
    __device__ __forceinline__ void small(Frame&, const f32x4s& a, int row, int col, int) const { const size_t off = (size_t)row * 1024 + col;
        const v2u gw = __builtin_nontemporal_load((const v2u*)(gate + off)); v2u ow = (v2u){0u, 0u}; if (ADD) ow = *(const v2u*)(O + off);
        float rr[4];
#pragma unroll
        for (int e = 0; e < 4; ++e) { const unsigned g16 = (gw[e >> 1] >> ((e & 1) * 16)) & 0xffffu, o16 = (ow[e >> 1] >> ((e & 1) * 16)) & 0xffffu; rr[e] = (ADD ? bf2f(o16) : 0.f) + sigmoid_f(bf2f(g16)) * a[e]; }
        v2u wv; wv.x = cvtpk_c(rr[0], rr[1]); wv.y = cvtpk_c(rr[2], rr[3]); *(v2u*)(O + off) = wv; } };
template <bool BF, bool BSC = false> struct SmRes { const float* base; const bf16* bb; bf16* hb; float* ssqp; const float* bsc;
    __device__ __forceinline__ void small(Frame& F, const f32x4s& a, int row, int col, int nt) const { const size_t off = (size_t)row * 1024 + col; f32x4 b;
        if (BF) { const v2u w = *(const v2u*)(bb + off); b = (f32x4){bf2f(w.x & 0xffffu), __uint_as_float(w.x & 0xffff0000u), bf2f(w.y & 0xffffu), __uint_as_float(w.y & 0xffff0000u)}; }
        else b = *(const f32x4*)(base + off);
        if constexpr (BSC) b = b * bsc[row];
        const f32x4 v = b + (f32x4){a[0], a[1], a[2], a[3]};
        { v2u wv; wv.x = cvtpk_c(v[0], v[1]); wv.y = cvtpk_c(v[2], v[3]); *(v2u*)(hb + off) = wv; }
        float sq = (v[0] * v[0] + v[1] * v[1]) + (v[2] * v[2] + v[3] * v[3]); sq += __shfl_xor(sq, 1); sq += __shfl_xor(sq, 2); sq += __shfl_xor(sq, 4); sq += __shfl_xor(sq, 8);
        if ((F.tid & 15) == 0) ssqp[(size_t)row * 16 + nt] = sq; } };
struct SmScale { bf16* O; const float* ssq; float scale;
    __device__ __forceinline__ void small(Frame&, const f32x4s& a, int row, int col, int) const { const float rs = pg8::row_rs<16>(ssq, row) * scale;
        v2u wv; wv.x = cvtpk_c(a[0] * rs, a[1] * rs); wv.y = cvtpk_c(a[2] * rs, a[3] * rs); *(v2u*)(O + (size_t)row * 1024 + col) = wv; } };
__device__ __forceinline__ void attn_stage_tile(LAS unsigned char* Lb, const bf16* src, size_t pitch, int tid) {
#pragma unroll 1
    for (int hb = 0; hb < 2; ++hb) { v4u v[8];
#pragma unroll
        for (int i = 0; i < 8; ++i) { const int id = tid + 512 * (8 * hb + i), row = id >> 5, c = id & 31; v[i] = *(const v4u*)(src + (size_t)row * pitch + c * 8); }
#pragma unroll
        for (int i = 0; i < 8; ++i) { const int id = tid + 512 * (8 * hb + i), row = id >> 5, c = id & 31; *(LAS v4u*)(Lb + row * 512 + ((c ^ (row & 15)) << 4)) = v[i]; } }
}
__device__ __forceinline__ void attn_prompt_unit(Frame& F, int b, int hd, int qb) {
    const int tid = F.tid, lane = F.lane, w = F.wave, r = lane & 31, hh = lane >> 5; unsigned char* ws = F.ws;
    LAS unsigned char* Lb = F.lds + RING_OFF;
    const bf16* QB = (const bf16*)(ws + WS_QB); const bf16* KB = (const bf16*)(ws + WS_KB); const bf16* VT = (const bf16*)(ws + WS_VT); bf16* OB = (bf16*)(ws + WS_OB);
    const size_t qrow = (size_t)b * SEQ + (size_t)qb * 256 + 32 * w + r;
    attn_stage_tile(Lb, KB + (size_t)b * 256 * 1024 + hd * 256, 1024, tid);
    const bf16* qp = QB + qrow * 1024 + hd * 256 + 8 * hh;
    bf16x8 qf = *(const bf16x8*)qp;
    __syncthreads();
    f32x16 S[8];
#pragma unroll
    for (int t = 0; t < 8; ++t)
#pragma unroll
        for (int i = 0; i < 16; ++i) S[t][i] = 0.f;
    const int sw = r & 15;
#pragma unroll 1
    for (int ks = 0; ks < 16; ++ks) {
        const bf16x8 qn = *(const bf16x8*)(qp + 16 * (ks < 15 ? ks + 1 : ks));
        const LAS unsigned char* kp = Lb + r * 512 + (((2 * ks + hh) ^ sw) << 4);
#pragma unroll
        for (int t = 0; t < 8; ++t) S[t] = MFMA32(lds_frag16(kp + t * 32 * 512), qf, S[t]);
        qf = qn;
    }
    float m = -3.0e38f;
#pragma unroll
    for (int t = 0; t < 8; ++t)
#pragma unroll
        for (int i = 0; i < 16; ++i) m = fmaxf(m, S[t][i]);
    m = fmaxf(m, __shfl_xor(m, 32));
    float l = 0.f;
#pragma unroll
    for (int t = 0; t < 8; ++t)
#pragma unroll
        for (int i = 0; i < 16; ++i) { const float pv = __builtin_amdgcn_exp2f(S[t][i] - m); S[t][i] = pv; l += pv; }
    l += __shfl_xor(l, 32);
    const float rl = __builtin_amdgcn_rcpf(l);
    bf16x8 pf[8][2];
#pragma unroll
    for (int t = 0; t < 8; ++t) { pf[t][0] = ACC_FRAG(S[t], 0); pf[t][1] = ACC_FRAG(S[t], 1); }
    __syncthreads();
    attn_stage_tile(Lb, VT + (size_t)(b * 4 + hd) * 256 * 256, 256, tid);
    __syncthreads();
    bf16* op = OB + qrow * 1024 + hd * 256 + 4 * hh;
#pragma unroll 1
    for (int dt = 0; dt < 8; ++dt) {
        f32x16 O;
#pragma unroll
        for (int i = 0; i < 16; ++i) O[i] = 0.f;
        const LAS unsigned char* vrow = Lb + (32 * dt + r) * 512 + 8 * hh;
#pragma unroll
        for (int t = 0; t < 8; ++t)
#pragma unroll
            for (int s2 = 0; s2 < 2; ++s2) {
                const v2u lo = *(const LAS v2u*)(vrow + (((4 * t + 2 * s2) ^ sw) << 4)), hi = *(const LAS v2u*)(vrow + (((4 * t + 2 * s2 + 1) ^ sw) << 4));
                const v4u wv4 = (v4u){lo.x, lo.y, hi.x, hi.y};
                O = MFMA32(__builtin_bit_cast(bf16x8, wv4), pf[t][s2], O);
            }
#pragma unroll
        for (int q4 = 0; q4 < 4; ++q4) { v2u o; o.x = cvtpk_c(O[4 * q4] * rl, O[4 * q4 + 1] * rl); o.y = cvtpk_c(O[4 * q4 + 2] * rl, O[4 * q4 + 3] * rl);
            *(v2u*)(op + 32 * dt + 8 * q4) = o; }
    }
    __syncthreads();
}
__device__ __forceinline__ void attn_sample_unit(Frame& F, int sb, int hd) {
    const int tid = F.tid, lane = F.lane, w = F.wave; unsigned char* ws = F.ws;
    LAS float* sc = (LAS float*)(F.lds + RING_OFF);
    LAS float* red = sc + 4 * 256;
    const bf16* QB = (const bf16*)(ws + WS_QB); bf16* OB = (bf16*)(ws + WS_OB);
    const size_t rowq = (size_t)TP + (size_t)sb * LS;
    float q[4][4];
#pragma unroll
    for (int t = 0; t < 4; ++t) { const v2u qw = *(const v2u*)(QB + (rowq + t) * 1024 + hd * 256 + 4 * lane); q[t][0] = bf2f(qw.x & 0xffffu); q[t][1] = bf2f(qw.x >> 16); q[t][2] = bf2f(qw.y & 0xffffu); q[t][3] = bf2f(qw.y >> 16); }
    const float* Kc = F.in[6] + ((size_t)sb * 256 * 4 + hd) * 256 + 4 * lane; const float* Vc = F.in[7] + ((size_t)sb * 256 * 4 + hd) * 256 + 4 * lane;
    f32x4 kv[8], kn[8];
#pragma unroll
    for (int u = 0; u < 8; ++u) kv[u] = ld_nt(Kc + (size_t)(w * 32 + u) * 1024);
#pragma unroll 1
    for (int kk0 = 0; kk0 < 32; kk0 += 8) {
#pragma unroll
        for (int u = 0; u < 8; ++u) kn[u] = kk0 < 24 ? ld_nt(Kc + (size_t)(w * 32 + kk0 + 8 + u) * 1024) : ld_nt(Vc + (size_t)(w * 32 + u) * 1024);
        { float part[32];
#pragma unroll
          for (int u = 0; u < 8; ++u)
#pragma unroll
              for (int t = 0; t < 4; ++t) part[4 * u + t] = (q[t][0] * kv[u].x + q[t][1] * kv[u].y) + (q[t][2] * kv[u].z + q[t][3] * kv[u].w);
          float sv = tr_reduce32(part, lane); sv += __shfl_xor(sv, 32);
          if (lane < 32) sc[(lane & 3) * 256 + w * 32 + kk0 + (lane >> 2)] = sv; }
#pragma unroll
        for (int u = 0; u < 8; ++u) kv[u] = kn[u]; }
    __syncthreads();
    if (w < 4) { float v[4]; float m = -3.0e38f;
#pragma unroll
        for (int j = 0; j < 4; ++j) { v[j] = sc[w * 256 + j * 64 + lane]; m = fmaxf(m, v[j]); }
        m = wave_max(m); float l = 0.f;
#pragma unroll
        for (int j = 0; j < 4; ++j) { v[j] = __builtin_amdgcn_exp2f(v[j] - m); l += v[j]; }
        l = wave_sum(l); const float rl = 1.0f / l;
#pragma unroll
        for (int j = 0; j < 4; ++j) sc[w * 256 + j * 64 + lane] = v[j] * rl; }
    __syncthreads();
    float o[4][4];
#pragma unroll
    for (int t = 0; t < 4; ++t)
#pragma unroll
        for (int e = 0; e < 4; ++e) o[t][e] = 0.f;
#pragma unroll 1
    for (int kk0 = 0; kk0 < 32; kk0 += 8) {
        if (kk0 < 24) {
#pragma unroll
            for (int u = 0; u < 8; ++u) kn[u] = ld_nt(Vc + (size_t)(w * 32 + kk0 + 8 + u) * 1024); }
#pragma unroll
        for (int u = 0; u < 8; ++u) { const int key = w * 32 + kk0 + u;
#pragma unroll
            for (int t = 0; t < 4; ++t) { const float pr = sc[t * 256 + key]; o[t][0] += pr * kv[u].x; o[t][1] += pr * kv[u].y; o[t][2] += pr * kv[u].z; o[t][3] += pr * kv[u].w; } }
#pragma unroll
        for (int u = 0; u < 8; ++u) kv[u] = kn[u]; }
#pragma unroll
    for (int t = 0; t < 4; ++t) *(LAS f32x4*)(red + (w * 4 + t) * 256 + 4 * lane) = (f32x4){o[t][0], o[t][1], o[t][2], o[t][3]};
    __syncthreads();
    { const int t = tid >> 7, d0 = (tid & 127) * 2; float a0 = 0.f, a1 = 0.f;
#pragma unroll
      for (int ww = 0; ww < 8; ++ww) { a0 += red[(ww * 4 + t) * 256 + d0]; a1 += red[(ww * 4 + t) * 256 + d0 + 1]; }
      *(unsigned*)(OB + (rowq + t) * 1024 + hd * 256 + d0) = pk2(a0, a1); }
    __syncthreads();
}
__device__ __forceinline__ void attn_phase(Frame& F) {
    for (int u = F.vcu; u < NBP * 4 * 8; u += F.G) attn_prompt_unit(F, u >> 5, (u >> 3) & 3, u & 7);
    for (int u = F.vcu; u < NBS * 4; u += F.G) attn_sample_unit(F, u >> 2, u & 3);
}
__device__ __forceinline__ void final_norm_phase(Frame& F) {
    const int gw = F.vcu * NWAVES + F.wave, NGW = F.G * NWAVES; const float* SSQ = (const float*)(F.ws + WS_SSQP3); const float* wn = F.in[31]; const bf16* HB = (const bf16*)(F.ws + WS_HB);
    f32x4 wv[4];
#pragma unroll
    for (int j = 0; j < 2; ++j) { wv[2 * j] = *((const f32x4*)wn + 2 * (64 * j + F.lane)); wv[2 * j + 1] = *((const f32x4*)wn + 2 * (64 * j + F.lane) + 1); }
    for (int row = gw; row < T; row += NGW) {
        const f32x4* sp = (const f32x4*)(SSQ + (size_t)row * 16); float s = 0.f;
#pragma unroll
        for (int j = 0; j < 4; ++j) { const f32x4 a = sp[j]; s += (a.x + a.y) + (a.z + a.w); }
        const float rs = __builtin_amdgcn_rsqf(s * (1.0f / 1024.0f) + EPS);
#pragma unroll
        for (int j = 0; j < 2; ++j) { const int pc = 64 * j + F.lane; const v4u w = ld_nt16((const v4u*)(HB + (size_t)row * 1024) + pc);
            const f32x4 v0 = (f32x4){bf2f(w.x & 0xffffu), __uint_as_float(w.x & 0xffff0000u), bf2f(w.y & 0xffffu), __uint_as_float(w.y & 0xffff0000u)};
            const f32x4 v1 = (f32x4){bf2f(w.z & 0xffffu), __uint_as_float(w.z & 0xffff0000u), bf2f(w.w & 0xffffu), __uint_as_float(w.w & 0xffff0000u)};
            float* o = F.out + O_Y + (size_t)row * 1024 + 8 * pc; st_nt(o, v0 * rs * wv[2 * j]); st_nt(o + 4, v1 * rs * wv[2 * j + 1]); }
    }
}
#ifndef MK_N_LAUNCHES
#define MK_N_LAUNCHES 1
#endif
constexpr int PER_PHASE = 13;
constexpr int N_LAUNCHES = MK_N_LAUNCHES;
struct Args { const float* in[32]; float* out; unsigned char* ws; int ph_lo, ph_hi; };
__global__ void __launch_bounds__(NTHR, 2) skel_fwd(Args args) {
    extern __shared__ __attribute__((aligned(16))) unsigned char lds[];
    Frame F;
    F.lds = (LAS unsigned char*)lds;
    F.MISC = (volatile LAS unsigned*)(F.lds + MISC_OFF);
    F.tid = threadIdx.x; F.lane = F.tid & 63; F.wave = __builtin_amdgcn_readfirstlane(F.tid >> 6);
    F.G = gridDim.x; { const int bx = blockIdx.x; F.vcu = (F.G % 8 == 0) ? (bx % 8) * (F.G / 8) + bx / 8 : bx; }
    unsigned char* ws = args.ws; F.ws = ws; F.out = args.out;
    F.ctl = (gu32*)(ws + WS_CTL);
#pragma unroll
    for (int i = 0; i < 32; ++i) F.in[i] = args.in[i];
    for (int u = F.tid; u < (LDS_BYTES - LDSCTL_OFF) / 4; u += NTHR) ((LAS unsigned*)(F.lds + LDSCTL_OFF))[u] = 0u;
    __syncthreads();
    XcdBarrier bar; bar.bar = (unsigned*)(F.ctl + CW_BAR); bar.x = 0; bar.st = nullptr;
    if (N_LAUNCHES == 1) bar = xcd_barrier_post((unsigned*)(F.ctl + CW_BAR), F.MISC + 8);
#define GRID_BAR() do { if (N_LAUNCHES == 1) xcd_barrier(bar); } while (0)
    const int lo = args.ph_lo, hi = args.ph_hi;
#ifdef ONLY_PHASE
#define IN(k) ((k) == ONLY_PHASE && lo <= (k) && (k) < hi)
#else
#define IN(k) (lo <= (k) && (k) < hi)
#endif
#define BOTH(k) (IN(k) && IN((k) + 1))
    bf16* const XB = (bf16*)(ws + WS_XB); bf16* const PROJ = (bf16*)(ws + WS_PROJ);
    float* const Y = F.out + O_Y;
    if (IN(0)) { p0_prologue(F); if (BOTH(0)) GRID_BAR(); }
    if (IN(1)) {
        { pg8::Gemm g{XB, (const bf16*)(ws + WS_WIN), T, NPROJ, 1024}; pg8::StaticOrder S; S.init(T, NPROJ, F.G, (int)blockIdx.x);
          pg8::EpiScaleBf16<0, true> E{PROJ, SLOT_ELEMS, nullptr, 1.0f, (float*)(ws + WS_DT)};
          pg8::gemm_phase<pg8::EpiScaleBf16<0, true>, pg8::StaticOrder, true, true>(F.lds + RING_OFF, g, S, E); }
        { pg8::Gemm g{(const bf16*)(ws + WS_MNB), (const bf16*)(ws + WS_WKV), MEMR, 2048, 1024}; pg8::StaticOrder S; S.init(MEMR, 2048, F.G, (int)((blockIdx.x + 64) % F.G));
          pg8::EpiKV E{F.out + O_MKP, F.out + O_MVP, (bf16*)(ws + WS_KB), (bf16*)(ws + WS_VT), (const float*)(ws + WS_SSQM)};
          pg8::gemm_phase<pg8::EpiKV, pg8::StaticOrder, true, true>(F.lds + RING_OFF, g, S, E); }
        if (BOTH(1)) GRID_BAR();
    }
    if (IN(2)) { bc_prep_phase(F); hg_prep_phase(F); if (BOTH(2)) GRID_BAR(); }
    if (IN(3)) { scan_phase(F); if (BOTH(3)) GRID_BAR(); }
    if (IN(4)) { ssdnorm_phase(F); hgnorm_phase(F); if (BOTH(4)) GRID_BAR(); }
    if (IN(5)) { { SmGate<false> Es{(bf16*)(ws + WS_MERGED), PROJ + (size_t)S_GS * SLOT_ELEMS}; small_tile_phase(F, (const bf16*)(ws + WS_YG), (const bf16*)(ws + WS_WSSD), 2048, Es); }
        pg8::Gemm g{(const bf16*)(ws + WS_YG), (const bf16*)(ws + WS_WSSD), TP, 1024, 2048}; pg8::StaticOrder S; S.init(TP, 1024, F.G, (int)blockIdx.x);
        pg8::EpiGate<false> E{(bf16*)(ws + WS_MERGED), PROJ + (size_t)S_GS * SLOT_ELEMS};
        pg8::gemm_phase<pg8::EpiGate<false>, pg8::StaticOrder, true, true>(F.lds + RING_OFF, g, S, E);
          }
    if (IN(5)) { { SmGate<true> Es{(bf16*)(ws + WS_MERGED), PROJ + (size_t)S_GH * SLOT_ELEMS}; small_tile_phase(F, (const bf16*)(ws + WS_ON), (const bf16*)(ws + WS_WHG), 1024, Es); }
        pg8::Gemm g{(const bf16*)(ws + WS_ON), (const bf16*)(ws + WS_WHG), TP, 1024, 1024}; pg8::StaticOrder S; S.init(TP, 1024, F.G, (int)blockIdx.x);
        pg8::EpiGate<true> E{(bf16*)(ws + WS_MERGED), PROJ + (size_t)S_GH * SLOT_ELEMS};
        pg8::gemm_phase<pg8::EpiGate<true>, pg8::StaticOrder, true, true>(F.lds + RING_OFF, g, S, E);
        if (BOTH(5)) GRID_BAR(); }
    if (IN(6)) { { SmRes<true, true> Es{nullptr, XB, (bf16*)(ws + WS_HB), (float*)(ws + WS_SSQP1), (const float*)(ws + WS_SSQX)}; small_tile_phase(F, (const bf16*)(ws + WS_MERGED), (const bf16*)(ws + WS_WOUT), 1024, Es); }
        pg8::Gemm g{(const bf16*)(ws + WS_MERGED), (const bf16*)(ws + WS_WOUT), TP, 1024, 1024}; pg8::StaticOrder S; S.init(TP, 1024, F.G, (int)blockIdx.x);
        pg8::EpiRes<true, true> E{nullptr, nullptr, XB, (bf16*)(ws + WS_HB), (float*)(ws + WS_SSQP1), (const float*)(ws + WS_SSQX)};
        pg8::gemm_phase<pg8::EpiRes<true, true>, pg8::StaticOrder, true, true>(F.lds + RING_OFF, g, S, E);
        if (BOTH(6)) GRID_BAR(); }
    if (IN(7)) { { SmScale Es{(bf16*)(ws + WS_QB), (const float*)(ws + WS_SSQP1), QSCALE}; small_tile_phase(F, (const bf16*)(ws + WS_HB), (const bf16*)(ws + WS_WCQ), 1024, Es); }
        pg8::Gemm g{(const bf16*)(ws + WS_HB), (const bf16*)(ws + WS_WCQ), TP, 1024, 1024}; pg8::StaticOrder S; S.init(TP, 1024, F.G, (int)blockIdx.x);
        pg8::EpiScaleBf16<16, false> E{(bf16*)(ws + WS_QB), SLOT_ELEMS, (const float*)(ws + WS_SSQP1), QSCALE, nullptr};
        pg8::gemm_phase<pg8::EpiScaleBf16<16, false>, pg8::StaticOrder, true, true>(F.lds + RING_OFF, g, S, E);
        if (BOTH(7)) GRID_BAR(); }
    if (IN(8)) { attn_phase(F); if (BOTH(8)) GRID_BAR(); }
    if (IN(9)) { { SmRes<true> Es{nullptr, (const bf16*)(ws + WS_HB), (bf16*)(ws + WS_HB), (float*)(ws + WS_SSQP2)}; small_tile_phase(F, (const bf16*)(ws + WS_OB), (const bf16*)(ws + WS_WCO), 1024, Es); }
        pg8::Gemm g{(const bf16*)(ws + WS_OB), (const bf16*)(ws + WS_WCO), TP, 1024, 1024}; pg8::StaticOrder S; S.init(TP, 1024, F.G, (int)blockIdx.x);
        pg8::EpiRes<true> E{nullptr, nullptr, (const bf16*)(ws + WS_HB), (bf16*)(ws + WS_HB), (float*)(ws + WS_SSQP2)};
        pg8::gemm_phase<pg8::EpiRes<true>, pg8::StaticOrder, true, true>(F.lds + RING_OFF, g, S, E);
        if (BOTH(9)) GRID_BAR(); }
    if (IN(10)) { pg8::Gemm g{(const bf16*)(ws + WS_HB), (const bf16*)(ws + WS_WGU), T, 2 * FFN, 1024}; pg8::StaticOrder S; S.init(T, 2 * FFN, F.G, (int)blockIdx.x);
        pg8::EpiSwiglu E{(bf16*)(ws + WS_ACT), (const float*)(ws + WS_SSQP2)};
        pg8::gemm_phase<pg8::EpiSwiglu, pg8::StaticOrder, true, true>(F.lds + RING_OFF, g, S, E);
        if (BOTH(10)) GRID_BAR(); }
    if (IN(11)) { { SmRes<true> Es{nullptr, (const bf16*)(ws + WS_HB), (bf16*)(ws + WS_HB), (float*)(ws + WS_SSQP3)}; small_tile_phase(F, (const bf16*)(ws + WS_ACT), (const bf16*)(ws + WS_WDN), FFN, Es); }
        pg8::Gemm g{(const bf16*)(ws + WS_ACT), (const bf16*)(ws + WS_WDN), TP, 1024, FFN}; pg8::StaticOrder S; S.init(TP, 1024, F.G, (int)blockIdx.x);
        pg8::EpiRes<true> E{nullptr, nullptr, (const bf16*)(ws + WS_HB), (bf16*)(ws + WS_HB), (float*)(ws + WS_SSQP3)};
        pg8::gemm_phase<pg8::EpiRes<true>, pg8::StaticOrder, true, true>(F.lds + RING_OFF, g, S, E);
        if (BOTH(11)) GRID_BAR(); }
    if (IN(12)) final_norm_phase(F);
#undef IN
#undef BOTH
}

extern "C" void kernel_launch(void* const* d_in, const int* in_sizes, int n_in, void* d_out, int out_size, void* d_ws, size_t ws_size, hipStream_t stream) {
    static int grid = 0;
    if (grid == 0) {
        const int want[32] = {TP * 1024, TS * 1024, MEMR * 1024, 33554432, 1179648, 16777216, 33554432, 33554432, 1024, 1024 * 11296, 4 * 3072, 3072, 32, 32, 32, 2048, 2048 * 1024, 2048, 1024,
                              1024 * 1024, 1024 * 1024, 1024, 1024, 1024 * 1024, 1024 * 1024, 1024 * 1024, 1024 * 1024, 1024, 1024 * FFN, 1024 * FFN, FFN * 1024, 1024};
        bool ok = (n_in == 32); for (int i = 0; ok && i < 32; ++i) if (in_sizes[i] != want[i]) { fprintf(stderr, "kernel_launch: input %d has %d elements, expected %d\n", i, in_sizes[i], want[i]); ok = false; }
        if (!ok || out_size != (int)O_END || ws_size < WS_END4) { fprintf(stderr, "kernel_launch: unexpected shapes: n_in %d out %d ws %zu\n", n_in, out_size, ws_size); grid = -1; return; }
        int dev = 0, cus = 0, per_cu = 0;
        if (hipGetDevice(&dev) != hipSuccess || hipDeviceGetAttribute(&cus, hipDeviceAttributeMultiprocessorCount, dev) != hipSuccess) { grid = -1; return; }
        if (hipFuncSetAttribute((const void*)skel_fwd, hipFuncAttributeMaxDynamicSharedMemorySize, LDS_BYTES) != hipSuccess) { fprintf(stderr, "kernel_launch: hipFuncSetAttribute failed\n"); grid = -1; return; }
        if (hipOccupancyMaxActiveBlocksPerMultiprocessor(&per_cu, (const void*)skel_fwd, NTHR, LDS_BYTES) != hipSuccess || per_cu < 1) fprintf(stderr, "kernel_launch: occupancy query reports %d blocks per CU\n", per_cu);
        (void)hipGetLastError();
        grid = cus;
    }
    if (grid < 0) return;
    (void)hipMemsetAsync((char*)d_ws + WS_CTL, 0, CTL_ZERO_BYTES, stream);
    Args a{};
    for (int i = 0; i < 32; ++i) a.in[i] = (const float*)d_in[i];
    a.out = (float*)d_out; a.ws = (unsigned char*)d_ws;
    for (int li = 0; li < N_LAUNCHES; ++li) {
        a.ph_lo = (N_LAUNCHES == PER_PHASE) ? li : 0; a.ph_hi = (N_LAUNCHES == PER_PHASE) ? li + 1 : PER_PHASE;
        hipLaunchKernelGGL(skel_fwd, dim3(grid), dim3(NTHR), LDS_BYTES, stream, a);
    }
}
```

```cpp
#include <hip/hip_runtime.h>
#include <cstdio>
#include <cstdint>
namespace pg8 {
#define PG8_LAS __attribute__((address_space(3)))
typedef unsigned short bf16_t;
typedef short bf16x8 __attribute__((ext_vector_type(8)));
typedef float f32x4 __attribute__((ext_vector_type(4)));
typedef unsigned u32x4 __attribute__((ext_vector_type(4)));
constexpr int BM = 256, BK = 64, HALF = 128, HTB = HALF * BK * 2  , STAGE_BYTES = 8 * HTB, NXCD = 8, WGM = 8;

__host__ __device__ __forceinline__ int lds_byte(int r, int c) { const int st = (r >> 4) * 2 + (c >> 5), rr = r & 15, cc = c & 31, ob = rr * 64 + cc * 2; return st * 1024 + (ob ^ (((ob >> 9) & 1) << 5)); }
__host__ __device__ __forceinline__ void stage_rc(int b, int& R, int& C) { const int st = b / 1024, sb = b % 1024, swz = sb ^ (((sb >> 9) & 1) << 5); R = (st >> 1) * 16 + swz / 64; C = (st & 1) * 32 + (swz % 64) / 2; }
__host__ __device__ __forceinline__ int perm32(int rho) { const int n = rho >> 4, i = rho & 15; return 8 * (i >> 2) + 4 * n + (i & 3); }

struct Unit { int pm, pn; };
struct Gemm { const bf16_t* A; const bf16_t* Bt; int M, N, K; };

struct StaticOrder {
    int nM, nN, nwg, G, c;
    __host__ __device__ void init(int M, int N, int G_, int c_) { nM = M / BM; nN = N / BM; nwg = nM * nN; G = G_; c = c_; }
    __host__ __device__ bool next(int i, Unit& u) const {
        const long L = (long)i * G + c; if (L >= nwg) return false;
        int wgid = (int)L; { const int q = nwg / NXCD, r = nwg % NXCD, xcd = wgid % NXCD, off = wgid / NXCD; wgid = (xcd < r ? xcd * (q + 1) : r * (q + 1) + (xcd - r) * q) + off; }
        const int nig = WGM * nN, gid = wgid / nig, fm = gid * WGM, gsz = (nM - fm) < WGM ? (nM - fm) : WGM;
        u.pm = fm + ((wgid % nig) % gsz); u.pn = (wgid % nig) / gsz; return true;
    }
    __device__ __forceinline__ void a_ready(const Unit&) const {}
    __device__ __forceinline__ void done(const Unit&) const {}
};

__device__ __forceinline__ unsigned cvt_pk_bf16(float lo, float hi) { unsigned r; asm volatile("v_cvt_pk_bf16_f32 %0, %1, %2" : "=v"(r) : "v"(lo), "v"(hi)); return r; }
typedef float f32x2 __attribute__((ext_vector_type(2)));
typedef unsigned u32x2 __attribute__((ext_vector_type(2)));
constexpr float RMS_EPS = 1e-6f;
__device__ __forceinline__ float bfbits2f(unsigned v16) { return __uint_as_float(v16 << 16); }
__device__ __forceinline__ float sigm(float x) { return __builtin_amdgcn_rcpf(1.0f + __expf(-x)); }
template <int NP> __device__ __forceinline__ float row_rs(const float* ssq, int row) {
    float s = 0.f;
    if constexpr (NP == 1) s = ssq[row];
    else {
#pragma unroll
        for (int i = 0; i < NP / 4; ++i) { const f32x4 v = *(const f32x4*)(ssq + (size_t)row * NP + 4 * i); s += (v[0] + v[1]) + (v[2] + v[3]); }
    }
    return 1.0f / sqrtf(s * (1.0f / 1024.0f) + RMS_EPS);
}
template <int NP, bool HAS_DT> struct EpiScaleBf16 {
    static constexpr bool PERM = true, AFTER_DRAIN = false;
    bf16_t* O; size_t slot_elems; const float* ssq; float scale; float* dt;
    __device__ __forceinline__ void operator()(const f32x4 (&acc)[2][2][4][2], const Unit& u, int wr, int wc, int fr, int fq) const {
        const int row0 = u.pm * BM + wr * 64 + fr;
        if (HAS_DT && u.pn == 44) {
            if (wc == 0) {
#pragma unroll
                for (int ai = 0; ai < 2; ++ai)
#pragma unroll
                    for (int m = 0; m < 4; ++m) { const int row = row0 + ai * HALF + m * 16; float rs = 1.0f; if constexpr (NP > 0) rs = row_rs<NP>(ssq, row);
                        float* p = dt + (size_t)row * 32 + 8 * fq; *(f32x4*)p = acc[ai][0][m][0] * rs; *(f32x4*)(p + 4) = acc[ai][0][m][1] * rs; }
            }
            return;
        }
        bf16_t* base = O + (size_t)(u.pn >> 2) * slot_elems; const int col0 = (u.pn & 3) * BM + wc * 32 + 8 * fq;
        const bool cached_slot = (u.pn >> 2) >= 4 && (u.pn >> 2) <= 6;
#pragma unroll
        for (int ai = 0; ai < 2; ++ai)
#pragma unroll
            for (int m = 0; m < 4; ++m) { const int row = row0 + ai * HALF + m * 16; float rs = scale; if constexpr (NP > 0) rs = row_rs<NP>(ssq, row) * scale; bf16_t* rowp = base + (size_t)row * 1024 + col0;
#pragma unroll
                for (int bj = 0; bj < 2; ++bj) { const f32x4 v0 = acc[ai][bj][m][0] * rs, v1 = acc[ai][bj][m][1] * rs;
                    u32x4 w; w.x = cvt_pk_bf16(v0[0], v0[1]); w.y = cvt_pk_bf16(v0[2], v0[3]); w.z = cvt_pk_bf16(v1[0], v1[1]); w.w = cvt_pk_bf16(v1[2], v1[3]);
                    if (HAS_DT && !cached_slot) __builtin_nontemporal_store(w, (u32x4*)(rowp + bj * HALF));
                    else *(u32x4*)(rowp + bj * HALF) = w; } }
    }
};
struct EpiKV {
    static constexpr bool PERM = false, AFTER_DRAIN = false;
    float* mk; float* mv; bf16_t* kb; bf16_t* vt; const float* ssq;
    __device__ __forceinline__ void operator()(const f32x4 (&acc)[2][2][4][2], const Unit& u, int wr, int wc, int fr, int fq) const {
        const int row0 = u.pm * BM + wr * 64 + fr; const bool isv = u.pn >= 4; const int colt = (u.pn & 3) * BM + wc * 32 + 4 * fq;
#pragma unroll
        for (int ai = 0; ai < 2; ++ai)
#pragma unroll
            for (int m = 0; m < 4; ++m) { const int row = row0 + ai * HALF + m * 16; const float rs = 1.0f;
#pragma unroll
                for (int bj = 0; bj < 2; ++bj)
#pragma unroll
                    for (int n = 0; n < 2; ++n) { const int c = colt + bj * HALF + n * 16; const f32x4 v = acc[ai][bj][m][n] * rs;
                        if (!isv) { __builtin_nontemporal_store(v, (f32x4*)(mk + (size_t)row * 1024 + c)); u32x2 w; w.x = cvt_pk_bf16(v[0], v[1]); w.y = cvt_pk_bf16(v[2], v[3]); *(u32x2*)(kb + (size_t)row * 1024 + c) = w; }
                        else { __builtin_nontemporal_store(v, (f32x4*)(mv + (size_t)row * 1024 + c)); const int b = row >> 8, key = row & 255, hd = c >> 8, d = c & 255;
                            bf16_t* p = vt + ((size_t)((b * 4 + hd) * 256 + d)) * 256 + key; const unsigned w0 = cvt_pk_bf16(v[0], v[1]), w1 = cvt_pk_bf16(v[2], v[3]);
                            p[0] = (bf16_t)(w0 & 0xffffu); p[256] = (bf16_t)(w0 >> 16); p[512] = (bf16_t)(w1 & 0xffffu); p[768] = (bf16_t)(w1 >> 16); } } }
    }
};
template <bool ADD> struct EpiGate {
    static constexpr bool PERM = true, AFTER_DRAIN = false;
    bf16_t* O; const bf16_t* gate;
    __device__ __forceinline__ void operator()(const f32x4 (&acc)[2][2][4][2], const Unit& u, int wr, int wc, int fr, int fq) const {
        const int row0 = u.pm * BM + wr * 64 + fr, col0 = u.pn * BM + wc * 32 + 8 * fq;
#pragma unroll
        for (int ai = 0; ai < 2; ++ai)
#pragma unroll
            for (int m = 0; m < 4; ++m) { const size_t off = (size_t)(row0 + ai * HALF + m * 16) * 1024 + col0;
#pragma unroll
                for (int bj = 0; bj < 2; ++bj) { const u32x4 gw = __builtin_nontemporal_load((const u32x4*)(gate + off + bj * HALF)); u32x4 ow = (u32x4){0u, 0u, 0u, 0u}; if (ADD) ow = *(const u32x4*)(O + off + bj * HALF);
                    float r[8];
#pragma unroll
                    for (int e = 0; e < 8; ++e) { const unsigned g16 = (gw[e >> 1] >> ((e & 1) * 16)) & 0xffffu, o16 = (ow[e >> 1] >> ((e & 1) * 16)) & 0xffffu;
                        const float a = acc[ai][bj][m][e >> 2][e & 3]; r[e] = (ADD ? bfbits2f(o16) : 0.f) + sigm(bfbits2f(g16)) * a; }
                    u32x4 w; w.x = cvt_pk_bf16(r[0], r[1]); w.y = cvt_pk_bf16(r[2], r[3]); w.z = cvt_pk_bf16(r[4], r[5]); w.w = cvt_pk_bf16(r[6], r[7]);
                    *(u32x4*)(O + off + bj * HALF) = w; } }
    }
};
template <bool BF, bool BSC = false> struct EpiRes {
    static constexpr bool PERM = true, AFTER_DRAIN = false;
    const float* base0; const float* base1; const bf16_t* bb; bf16_t* hb; float* ssqp; const float* bsc;
    __device__ __forceinline__ void operator()(const f32x4 (&acc)[2][2][4][2], const Unit& u, int wr, int wc, int fr, int fq) const {
        const int row0 = u.pm * BM + wr * 64 + fr, col0 = u.pn * BM + wc * 32 + 8 * fq; const float* base = u.pm < 64 ? base0 : base1;
#pragma unroll
        for (int ai = 0; ai < 2; ++ai)
#pragma unroll
            for (int m = 0; m < 4; ++m) { const int row = row0 + ai * HALF + m * 16; const size_t off = (size_t)row * 1024 + col0; float sq = 0.f; float bs = 1.0f; if constexpr (BSC) bs = bsc[row];
#pragma unroll
                for (int bj = 0; bj < 2; ++bj) { const size_t o2 = off + bj * HALF; f32x4 b0, b1;
                    if (BF) { const u32x4 w = *(const u32x4*)(bb + o2); b0 = (f32x4){bfbits2f(w.x & 0xffffu), __uint_as_float(w.x & 0xffff0000u), bfbits2f(w.y & 0xffffu), __uint_as_float(w.y & 0xffff0000u)};
                        b1 = (f32x4){bfbits2f(w.z & 0xffffu), __uint_as_float(w.z & 0xffff0000u), bfbits2f(w.w & 0xffffu), __uint_as_float(w.w & 0xffff0000u)}; }
                    else { b0 = __builtin_nontemporal_load((const f32x4*)(base + o2)); b1 = __builtin_nontemporal_load((const f32x4*)(base + o2 + 4)); }
                    if constexpr (BSC) { b0 = b0 * bs; b1 = b1 * bs; }
                    const f32x4 v0 = b0 + acc[ai][bj][m][0], v1 = b1 + acc[ai][bj][m][1];
                    sq += ((v0[0] * v0[0] + v0[1] * v0[1]) + (v0[2] * v0[2] + v0[3] * v0[3])) + ((v1[0] * v1[0] + v1[1] * v1[1]) + (v1[2] * v1[2] + v1[3] * v1[3]));
                    u32x4 w; w.x = cvt_pk_bf16(v0[0], v0[1]); w.y = cvt_pk_bf16(v0[2], v0[3]); w.z = cvt_pk_bf16(v1[0], v1[1]); w.w = cvt_pk_bf16(v1[2], v1[3]); *(u32x4*)(hb + o2) = w; }
                sq += __shfl_xor(sq, 16); sq += __shfl_xor(sq, 32);
                if (fq == 0) ssqp[(size_t)row * 16 + u.pn * 4 + wc] = sq; }
    }
};
struct EpiSwiglu {
    static constexpr bool PERM = true, AFTER_DRAIN = false;
    bf16_t* act; const float* ssq;
    __device__ __forceinline__ void operator()(const f32x4 (&acc)[2][2][4][2], const Unit& u, int wr, int wc, int fr, int fq) const {
        const int row0 = u.pm * BM + wr * 64 + fr, col0 = u.pn * 128 + wc * 16 + 4 * fq;
#pragma unroll
        for (int ai = 0; ai < 2; ++ai)
#pragma unroll
            for (int m = 0; m < 4; ++m) { const int row = row0 + ai * HALF + m * 16; const float rs = row_rs<16>(ssq, row);
#pragma unroll
                for (int bj = 0; bj < 2; ++bj) { const f32x4 a = acc[ai][bj][m][0] * rs, b = acc[ai][bj][m][1] * rs;
                    const float r0 = a[0] * sigm(a[0]) * a[1], r1 = a[2] * sigm(a[2]) * a[3], r2 = b[0] * sigm(b[0]) * b[1], r3 = b[2] * sigm(b[2]) * b[3];
                    u32x2 w; w.x = cvt_pk_bf16(r0, r1); w.y = cvt_pk_bf16(r2, r3); *(u32x2*)(act + (size_t)row * 2816 + col0 + bj * 64) = w; } }
    }
};
template <class Epi, class Sched, bool ALIGN_EPI = false, bool SP2 = false, int EPI_REP = 1>
__device__ __forceinline__ void gemm_phase(PG8_LAS unsigned char* lds, const Gemm g, const Sched& S, const Epi& E) {
    const int tid = threadIdx.x, wid = __builtin_amdgcn_readfirstlane(tid >> 6), lane = tid & 63, wr = wid >> 2, wc = wid & 3, fr = lane & 15, fq = lane >> 4;
    const int K = g.K, nt = K / BK;
    unsigned voffA[2], voffB[2];
#pragma unroll
    for (int i = 0; i < 2; ++i) { int R, C; stage_rc(tid * 16 + i * 8192, R, C); const int Rb = Epi::PERM ? ((R & ~31) + perm32(R & 31)) : R;
        voffA[i] = (unsigned)(R * K + C) * 2u; voffB[i] = (unsigned)(Rb * K + C) * 2u; }
    const size_t kstep = (size_t)(BK * 2);
    const size_t hstep = (size_t)HALF * K * 2;
    const size_t tstep = 2 * hstep;
    const unsigned ldsw = (unsigned)wid * 1024u;
    const int aoff = lds_byte(wr * 64 + fr, fq * 8), boff = lds_byte(wc * 32 + fr, fq * 8);
#define PG8_SA(b, h) (((b) * 2 + (h)) * HTB)
#define PG8_SB(b, h) ((4 + (b) * 2 + (h)) * HTB)
#define PG8_STAGE(bufoff, gbase, voff) do { _Pragma("unroll") for (int _i = 0; _i < 2; ++_i) \
        __builtin_amdgcn_global_load_lds((const unsigned*)((const char*)(gbase) + (voff)[_i]), (PG8_LAS unsigned*)(lds + (bufoff) + ldsw + _i * 8192), 16, 0, 0); } while (0)
#define PG8_LDA(dst, b, h) do { _Pragma("unroll") for (int m = 0; m < 4; ++m) _Pragma("unroll") for (int k = 0; k < 2; ++k) dst[m][k] = *(const PG8_LAS bf16x8*)(lds + PG8_SA(b, h) + aoff + m * 2048 + k * 1024); } while (0)
#define PG8_LDB(dst, b, h) do { _Pragma("unroll") for (int n = 0; n < 2; ++n) _Pragma("unroll") for (int k = 0; k < 2; ++k) dst[n][k] = *(const PG8_LAS bf16x8*)(lds + PG8_SB(b, h) + boff + n * 2048 + k * 1024); } while (0)
#define PG8_MMA(ai, bj, At, Bt) do { __builtin_amdgcn_s_setprio(1); _Pragma("unroll") for (int m = 0; m < 4; ++m) _Pragma("unroll") for (int n = 0; n < 2; ++n) _Pragma("unroll") for (int k = 0; k < 2; ++k) \
        acc[ai][bj][m][n] = __builtin_amdgcn_mfma_f32_16x16x32_bf16(Bt[n][k], At[m][k], acc[ai][bj][m][n], 0, 0, 0); __builtin_amdgcn_s_setprio(0); } while (0)
#define PG8_WAIT_V(n) asm volatile("s_waitcnt vmcnt(" #n ")" ::: "memory")
#define PG8_WAIT_L(n) asm volatile("s_waitcnt lgkmcnt(" #n ")" ::: "memory")
#define PG8_BAR __builtin_amdgcn_s_barrier()
#define PG8_SCHED __builtin_amdgcn_sched_barrier(0)
    Unit cur, nxt; int ui = 0;
    if (!S.next(0, cur)) return;
    f32x4 acc[2][2][4][2];
#pragma unroll
    for (int a = 0; a < 2; ++a)
#pragma unroll
        for (int b = 0; b < 2; ++b)
#pragma unroll
            for (int m = 0; m < 4; ++m)
#pragma unroll
                for (int n = 0; n < 2; ++n) acc[a][b][m][n] = (f32x4){0.f, 0.f, 0.f, 0.f};
    bf16x8 At[4][2], B0[2][2], B1[2][2];
    const char* cA = (const char*)g.A + (size_t)cur.pm * tstep; const char* cB = (const char*)g.Bt + (size_t)cur.pn * tstep;
    S.a_ready(cur);
    if constexpr (SP2) {
        PG8_STAGE(PG8_SB(0, 0), cB, voffB); PG8_STAGE(PG8_SB(0, 1), cB + hstep, voffB); PG8_STAGE(PG8_SA(0, 0), cA, voffA); PG8_STAGE(PG8_SA(0, 1), cA + hstep, voffA);
        if (wr == 1) PG8_BAR;
        PG8_WAIT_V(2); PG8_BAR;
        PG8_STAGE(PG8_SB(1, 0), cB + kstep, voffB); PG8_STAGE(PG8_SA(1, 0), cA + kstep, voffA); PG8_STAGE(PG8_SB(1, 1), cB + hstep + kstep, voffB);
        PG8_WAIT_V(6); PG8_BAR;
    } else {
        PG8_STAGE(PG8_SB(0, 0), cB, voffB); PG8_STAGE(PG8_SA(0, 0), cA, voffA); PG8_STAGE(PG8_SB(0, 1), cB + hstep, voffB); PG8_STAGE(PG8_SA(0, 1), cA + hstep, voffA);
        if (wr == 1) PG8_BAR;
        PG8_WAIT_V(4); PG8_BAR;
        PG8_STAGE(PG8_SB(1, 0), cB + kstep, voffB); PG8_STAGE(PG8_SA(1, 0), cA + kstep, voffA); PG8_STAGE(PG8_SB(1, 1), cB + hstep + kstep, voffB);
        PG8_WAIT_V(6); PG8_BAR;
    }
    for (;;) {
        const bool has_next = S.next(ui + 1, nxt);
        const char* nA = has_next ? (const char*)g.A + (size_t)nxt.pm * tstep : cA; const char* nB = has_next ? (const char*)g.Bt + (size_t)nxt.pn * tstep : cB;
        for (int t = 0; t < nt; t += 2) {
            const bool last = (t == nt - 2);
            const char* a1 = cA + (size_t)(t + 1) * kstep;
            const char* a2 = last ? nA : cA + (size_t)(t + 2) * kstep; const char* b2 = last ? nB : cB + (size_t)(t + 2) * kstep;
            const char* a3 = a2 + kstep; const char* b3 = b2 + kstep;
            if (last && has_next) S.a_ready(nxt);
            if constexpr (SP2) {
            PG8_LDB(B0, 0, 0); PG8_LDB(B1, 0, 1); PG8_SCHED; PG8_LDA(At, 0, 0); PG8_STAGE(PG8_SA(1, 1), a1 + hstep, voffA);
            PG8_WAIT_V(8); PG8_WAIT_L(0); PG8_BAR; PG8_MMA(0, 0, At, B0); PG8_MMA(0, 1, At, B1); PG8_BAR; PG8_SCHED;
            PG8_LDA(At, 0, 1); PG8_STAGE(PG8_SB(0, 0), b2, voffB); PG8_STAGE(PG8_SB(0, 1), b2 + hstep, voffB); PG8_STAGE(PG8_SA(0, 0), a2, voffA);
            PG8_WAIT_V(8); PG8_WAIT_L(0); PG8_BAR; PG8_MMA(1, 0, At, B0); PG8_MMA(1, 1, At, B1); PG8_BAR; PG8_SCHED;
            PG8_LDB(B0, 1, 0); PG8_LDB(B1, 1, 1); PG8_SCHED; PG8_LDA(At, 1, 0); PG8_STAGE(PG8_SA(0, 1), a2 + hstep, voffA);
            PG8_WAIT_V(8); PG8_WAIT_L(0); PG8_BAR; PG8_MMA(0, 0, At, B0); PG8_MMA(0, 1, At, B1); PG8_BAR; PG8_SCHED;
            PG8_LDA(At, 1, 1); PG8_STAGE(PG8_SB(1, 0), b3, voffB); PG8_STAGE(PG8_SB(1, 1), b3 + hstep, voffB); PG8_STAGE(PG8_SA(1, 0), a3, voffA);
            PG8_WAIT_V(8); PG8_WAIT_L(0); PG8_BAR; PG8_MMA(1, 0, At, B0); PG8_MMA(1, 1, At, B1); PG8_BAR; PG8_SCHED;
            } else {
            PG8_LDB(B0, 0, 0); PG8_SCHED; PG8_LDA(At, 0, 0); PG8_STAGE(PG8_SA(1, 1), a1 + hstep, voffA);
            PG8_WAIT_L(8); PG8_BAR; PG8_WAIT_L(0); PG8_MMA(0, 0, At, B0); PG8_BAR; PG8_SCHED;
            PG8_LDB(B1, 0, 1); PG8_STAGE(PG8_SB(0, 0), b2, voffB);
            PG8_BAR; PG8_WAIT_L(0); PG8_MMA(0, 1, At, B1); PG8_BAR;
            PG8_LDA(At, 0, 1); PG8_STAGE(PG8_SA(0, 0), a2, voffA);
            PG8_BAR; PG8_WAIT_L(0); PG8_MMA(1, 0, At, B0); PG8_BAR; PG8_SCHED;
            PG8_STAGE(PG8_SB(0, 1), b2 + hstep, voffB);
            PG8_WAIT_V(6); PG8_BAR; PG8_MMA(1, 1, At, B1); PG8_BAR;
            PG8_LDB(B0, 1, 0); PG8_SCHED; PG8_LDA(At, 1, 0); PG8_STAGE(PG8_SA(0, 1), a2 + hstep, voffA);
            PG8_WAIT_L(8); PG8_BAR; PG8_WAIT_L(0); PG8_MMA(0, 0, At, B0); PG8_BAR; PG8_SCHED;
            PG8_LDB(B1, 1, 1); PG8_STAGE(PG8_SB(1, 0), b3, voffB);
            PG8_BAR; PG8_WAIT_L(0); PG8_MMA(0, 1, At, B1); PG8_BAR;
            PG8_LDA(At, 1, 1); PG8_STAGE(PG8_SA(1, 0), a3, voffA);
            PG8_BAR; PG8_WAIT_L(0); PG8_MMA(1, 0, At, B0); PG8_BAR; PG8_SCHED;
            PG8_STAGE(PG8_SB(1, 1), b3 + hstep, voffB);
            PG8_WAIT_V(6); PG8_BAR; PG8_MMA(1, 1, At, B1); PG8_BAR;
            }
        }
        if constexpr (ALIGN_EPI) { if (wr == 0) PG8_BAR; }
        if constexpr (!Epi::AFTER_DRAIN) { for (int rep = 0; rep < EPI_REP; ++rep) { E(acc, cur, wr, wc, fr, fq); asm volatile("" ::: "memory"); } S.done(cur); }
        if (!has_next) break;
#pragma unroll
        for (int a = 0; a < 2; ++a)
#pragma unroll
            for (int b = 0; b < 2; ++b)
#pragma unroll
                for (int m = 0; m < 4; ++m)
#pragma unroll
                    for (int n = 0; n < 2; ++n) acc[a][b][m][n] = (f32x4){0.f, 0.f, 0.f, 0.f};
        cur = nxt; cA = nA; cB = nB; ++ui;
        if constexpr (ALIGN_EPI) { if (wr == 1) PG8_BAR; }
    }
    PG8_WAIT_V(0);
    if constexpr (!ALIGN_EPI) { if (wr == 0) PG8_BAR; }
    PG8_BAR;
    if constexpr (Epi::AFTER_DRAIN) { E.fused(acc, cur, wr, wc, fr, fq, lds, wid, lane); S.done(cur); }
#undef PG8_SA
#undef PG8_SB
#undef PG8_STAGE
#undef PG8_LDA
#undef PG8_LDB
#undef PG8_MMA
#undef PG8_WAIT_V
#undef PG8_WAIT_L
#undef PG8_BAR
#undef PG8_SCHED
}
}
#define GAS __attribute__((address_space(1)))
#define LAS __attribute__((address_space(3)))
typedef unsigned short bf16;
typedef unsigned v4u __attribute__((ext_vector_type(4)));
typedef float f32x4 __attribute__((ext_vector_type(4)));
typedef short bf16x8 __attribute__((ext_vector_type(8)));
typedef GAS unsigned gu32;
typedef GAS unsigned long long gu64;
#define RLX_AGENT __ATOMIC_RELAXED, __HIP_MEMORY_SCOPE_AGENT
#define LDS_WAIT() asm volatile("s_waitcnt lgkmcnt(0)" ::: "memory")
#define VM_WAIT() asm volatile("s_waitcnt vmcnt(0)" ::: "memory")
__device__ __forceinline__ unsigned long long rt() { return __builtin_amdgcn_s_memrealtime(); }
typedef float f32x2_t __attribute__((ext_vector_type(2))); typedef __bf16 bf16x2_t __attribute__((ext_vector_type(2)));
__device__ __forceinline__ unsigned pk2(float lo, float hi) { const f32x2_t v = {lo, hi}; const bf16x2_t b = __builtin_convertvector(v, bf16x2_t); return __builtin_bit_cast(unsigned, b); }
__device__ __forceinline__ unsigned f2bf(float f) { return pk2(f, 0.f) & 0xffffu; }

#define XB_TMO      128
#define XB_XCNT(j)  (256  + 64 * (j))
#define XB_XSUB(j)  (1280 + 64 * (j))
#define XB_XGEN(j)  (2304 + 64 * (j))
#define XB_TOP      3328
#define XB_TOPGEN   3392
#define XCD_BAR_WORDS 3456
#define XB_SPIN_CAP (1u << 18)

__device__ __forceinline__ unsigned xb_ld(unsigned* p)              { return __hip_atomic_load(p, __ATOMIC_RELAXED, __HIP_MEMORY_SCOPE_AGENT); }
__device__ __forceinline__ unsigned xb_add(unsigned* p, unsigned v) { return __hip_atomic_fetch_add(p, v, __ATOMIC_RELAXED, __HIP_MEMORY_SCOPE_AGENT); }
__device__ __forceinline__ unsigned xb_xcc_id() { return (unsigned)__builtin_amdgcn_s_getreg((3 << 11) | 20) & 0xFu; }
#define XB_SPIN(cond, bar) do { unsigned _sp = 0; while (cond) { __builtin_amdgcn_s_sleep(1); \
    if ((++_sp & 255u) == 0u) { if (xb_ld(&(bar)[XB_TMO])) break; if (_sp > XB_SPIN_CAP) { atomicAdd(&(bar)[XB_TMO], 1u); break; } } } } while (0)

struct XcdBarrier {
    unsigned* bar; unsigned x;
    volatile LAS unsigned* st;
};

__device__ __forceinline__ XcdBarrier xcd_barrier_post(unsigned* bar, volatile LAS unsigned* st) {
    XcdBarrier b; b.bar = bar; b.x = xb_xcc_id(); b.st = st;
    if (threadIdx.x == 0) (void)xb_add(&bar[XB_XCNT(b.x)], 1u);
    return b;
}
__device__ __forceinline__ void xcd_barrier_complete(unsigned* bar, unsigned x, unsigned& nloc, unsigned& nx) {
    const unsigned G = gridDim.x * gridDim.y * gridDim.z;
    unsigned sum, cnt, mine, sp = 0u;
    for (;;) {
        sum = 0u; cnt = 0u; mine = 0u;
#pragma unroll
        for (unsigned j = 0; j < 16; ++j) { const unsigned c = xb_ld(&bar[XB_XCNT(j)]); sum += c; cnt += (c > 0u) ? 1u : 0u; mine = (j == x) ? c : mine; }
        if (sum == G) break;
        __builtin_amdgcn_s_sleep(1);
        if ((++sp & 255u) == 0u) { if (xb_ld(&bar[XB_TMO])) break; if (sp > XB_SPIN_CAP) { atomicAdd(&bar[XB_TMO], 1u); break; } }
    }
    nloc = mine > 0u ? mine : 1u; nx = cnt > 0u ? cnt : 1u;
}

__device__ __forceinline__ void xcd_barrier(const XcdBarrier& b) {
    asm volatile("s_waitcnt vmcnt(0)" ::: "memory");
    __syncthreads();
    if (threadIdx.x == 0) {
        unsigned* bar = b.bar;
        __builtin_amdgcn_s_waitcnt(0);
        unsigned nloc = b.st[0], nx = b.st[1];
        if (nloc == 0u) { xcd_barrier_complete(bar, b.x, nloc, nx); b.st[0] = nloc; b.st[1] = nx; }
        const unsigned old = xb_add(&bar[XB_XSUB(b.x)], 1u);
        const unsigned gen = old / nloc;
        if (old + 1u == (gen + 1u) * nloc) {
            __builtin_amdgcn_fence(__ATOMIC_RELEASE, "agent");
            asm volatile("s_waitcnt vmcnt(0)" ::: "memory");
            const unsigned og = xb_add(&bar[XB_TOP], 1u);
            const unsigned tg = og / nx;
            if (og + 1u == (tg + 1u) * nx) xb_add(&bar[XB_TOPGEN], 1u);
            else XB_SPIN(xb_ld(&bar[XB_TOPGEN]) == tg, bar);
            __builtin_amdgcn_fence(__ATOMIC_ACQUIRE, "agent");
            xb_add(&bar[XB_XGEN(b.x)], 1u);
            asm volatile("s_waitcnt vmcnt(0)" ::: "memory");
        } else {
            XB_SPIN(xb_ld(&bar[XB_XGEN(b.x)]) == gen, bar);
            __builtin_amdgcn_fence(__ATOMIC_ACQUIRE, "agent");
            asm volatile("s_waitcnt vmcnt(0)" ::: "memory");
        }
    }
    __syncthreads();
}
typedef unsigned v2u __attribute__((ext_vector_type(2)));
constexpr int NWAVES = 8, NTHR = 512;
constexpr int DM = 1024, TP = 16384, TS = 512, T = TP + TS;
constexpr int SEQ = 2048, NBP = 8, NBS = 128, LS = 4, MEMR = 2048;
constexpr int NPROJ = 11520;
constexpr int FFN = 2816;
constexpr float EPS = 1e-6f;
constexpr float QSCALE = 0.0625f * 1.4426950408889634f;

constexpr size_t MiB = 1u << 20;
constexpr size_t WS_CTL = 0, CTL_ZERO_BYTES = 32768;
constexpr size_t WS_SSQX = 1 * MiB, WS_SSQM = 1 * MiB + 512 * 1024;
constexpr size_t WS_DT = 2 * MiB, WS_SSQSSD = 5 * MiB, WS_SSQP1 = 8 * MiB, WS_SSQP2 = 9 * MiB + 512 * 1024, WS_SSQP3 = 11 * MiB;
constexpr size_t WS_WIN = 13 * MiB, WS_WKV = 36 * MiB, WS_WSSD = 40 * MiB, WS_WHG = 44 * MiB, WS_WOUT = 46 * MiB, WS_WCQ = 48 * MiB, WS_WCO = 50 * MiB, WS_WGU = 52 * MiB, WS_WDN = 63 * MiB;
constexpr size_t WS_XB = 69 * MiB, WS_MNB = 102 * MiB, WS_KB = 106 * MiB, WS_VT = 110 * MiB;
constexpr size_t SLOT = 33 * MiB, SLOT_ELEMS = (size_t)T * 1024;
constexpr size_t WS_PROJ = 114 * MiB;
constexpr size_t WS_YG = WS_PROJ + 11 * SLOT, WS_ON = WS_YG + 2 * SLOT, WS_END = WS_ON + SLOT;
static_assert(SLOT == SLOT_ELEMS * 2, "slot size");
static_assert(WS_WIN + (size_t)NPROJ * 1024 * 2 <= WS_WKV && WS_WGU + (size_t)2 * FFN * 1024 * 2 <= WS_WDN && WS_WDN + (size_t)1024 * FFN * 2 <= WS_XB && WS_SSQP3 + (size_t)T * 64 <= WS_WIN, "d_ws map");
static_assert(WS_DT + (size_t)T * 128 <= WS_SSQSSD && WS_SSQSSD + (size_t)T * 128 <= WS_SSQP1 && WS_SSQP1 + (size_t)T * 64 <= WS_SSQP2 && WS_SSQP2 + (size_t)T * 64 <= WS_SSQP3, "d_ws map 2");
enum { S_Z0 = 0, S_Z1 = 1, S_X0 = 2, S_X1 = 3, S_X2 = 4, S_Q = 5, S_F = 6, S_I = 7, S_HG = 8, S_GS = 9, S_GH = 10 };
constexpr size_t WS_MERGED = WS_PROJ + S_Q * SLOT, WS_HB = WS_PROJ + S_F * SLOT, WS_QB = WS_PROJ + S_I * SLOT, WS_OB = WS_PROJ + S_HG * SLOT, WS_ACT = WS_PROJ;
static_assert((size_t)T * FFN * 2 <= 3 * SLOT, "act overlay");
constexpr size_t O_Y = 0, O_SSMP = (size_t)T * 1024, O_CONVP = O_SSMP + 2097152, O_HGP = O_CONVP + 73728, O_MKP = O_HGP + 1048576, O_MVP = O_MKP + 2097152,
                 O_SSMS = O_MVP + 2097152, O_CONVS = O_SSMS + 33554432, O_HGS = O_CONVS + 1179648, O_END = O_HGS + 16777216;
constexpr int CW_QUEUE = 64;
constexpr int CW_BAR = 4096;
constexpr int RING_OFF = 0, RING_BYTES = 131072;
constexpr int LDS_BYTES = 147456;
constexpr int LDSCTL_OFF = LDS_BYTES - 1024, MISC_OFF = LDSCTL_OFF + 320;
struct Frame {
    LAS unsigned char* lds;
    volatile LAS unsigned* MISC;
    gu32* ctl;
    int tid, lane, wave;
    int vcu, G;
    const float* in[32];
    float* out; unsigned char* ws;
};
__device__ __forceinline__ float bf2f(unsigned v16) { return __uint_as_float(v16 << 16); }
__device__ __forceinline__ f32x4 ld_nt(const float* p) { return __builtin_nontemporal_load((const f32x4*)p); }
__device__ __forceinline__ void st_nt(float* p, f32x4 v) { __builtin_nontemporal_store(v, (f32x4*)p); }
__device__ __forceinline__ v4u ld_nt16(const void* p) { return __builtin_nontemporal_load((const v4u*)p); }
__device__ __forceinline__ unsigned ld_nt4(const void* p) { return __builtin_nontemporal_load((const unsigned*)p); }
__device__ __forceinline__ float sigmoid_f(float x) { return __builtin_amdgcn_rcpf(1.0f + __expf(-x)); }
__device__ __forceinline__ float silu_f(float x) { return x * sigmoid_f(x); }
__device__ __forceinline__ float wave_sum(float v) {
#pragma unroll
    for (int o = 1; o < 64; o <<= 1) v += __shfl_xor(v, o);
    return v;
}
__device__ __forceinline__ float wave_max(float v) {
#pragma unroll
    for (int o = 1; o < 64; o <<= 1) v = fmaxf(v, __shfl_xor(v, o));
    return v;
}
struct TSrc { const float* W; const float* W2; const float* ks; int ldw; int mode; };
__device__ __forceinline__ void p0_transpose_item(const TSrc& s, int K, int N, bf16* WT, LAS unsigned short* scr, int item, int lane) {
    const int nblk = N / 64, kb = item / nblk, nb = item % nblk, k0 = 64 * kb, n0 = 64 * nb;
    const int kr = lane >> 4, nq = lane & 15;
    const float* const Wa = s.W; const float* const Wb = s.W2;
    const float* src; int c0, cs; bool zero = false;
    if (s.mode == 2) { const float* wsel = Wa; if (nq >= 8) wsel = Wb; src = wsel + (n0 >> 1) + 4 * (nq & 7); c0 = 8 * (nq & 7) + (nq >> 3); cs = 2; }
    else { const int n = n0 + 4 * nq; c0 = 4 * nq; cs = 1;
        if (s.mode == 0) src = Wa + n;
        else if (s.mode == 1) { if (n < 5120) src = Wa + n; else if (n < 11264) src = Wa + n + 32; else if (n < 11296) src = Wa + 5120 + (n - 11264); else { src = Wa; zero = true; } }
        else { src = Wa + n; if (n >= 1024) src = Wb + (n - 1024); } }
    f32x4 v[16];
#pragma unroll
    for (int i = 0; i < 16; ++i) v[i] = zero ? (f32x4){0.f, 0.f, 0.f, 0.f} : ld_nt(src + (size_t)(k0 + 4 * i + kr) * s.ldw);
#pragma unroll
    for (int i = 0; i < 16; ++i) { const int kk = 4 * i + kr; const float sc = s.ks ? s.ks[k0 + kk] : 1.0f; const unsigned w0 = pk2(v[i].x * sc, v[i].y * sc), w1 = pk2(v[i].z * sc, v[i].w * sc);
        LAS unsigned short* d = scr + kk * 66 + c0;
        if (cs == 1) { *(LAS unsigned*)d = w0; *(LAS unsigned*)(d + 2) = w1; }
        else { d[0] = (unsigned short)(w0 & 0xffffu); d[2] = (unsigned short)(w0 >> 16); d[4] = (unsigned short)(w1 & 0xffffu); d[6] = (unsigned short)(w1 >> 16); } }
    LDS_WAIT(); asm volatile("" ::: "memory");
    const int nr = lane >> 3, kc = lane & 7;
#pragma unroll
    for (int j = 0; j < 8; ++j) { const int n = 8 * j + nr; const LAS unsigned short* p = scr + (8 * kc) * 66 + n;
        v4u o; o.x = (unsigned)p[0] | ((unsigned)p[66] << 16); o.y = (unsigned)p[2 * 66] | ((unsigned)p[3 * 66] << 16); o.z = (unsigned)p[4 * 66] | ((unsigned)p[5 * 66] << 16); o.w = (unsigned)p[6 * 66] | ((unsigned)p[7 * 66] << 16);
        *(v4u*)(WT + (size_t)(n0 + n) * K + k0 + 8 * kc) = o; }
    LDS_WAIT(); asm volatile("" ::: "memory");
}
__device__ __forceinline__ void rows4_to_bf16_ssq(const float* x0, bf16* o0, float* ssq0, int lane) {
    f32x4 v[4][4];
#pragma unroll
    for (int rr = 0; rr < 4; ++rr)
#pragma unroll
        for (int j = 0; j < 4; ++j) v[rr][j] = ld_nt(x0 + rr * 1024 + 4 * (64 * j + lane));
#pragma unroll
    for (int rr = 0; rr < 4; ++rr) { float sq = 0.f;
#pragma unroll
        for (int j = 0; j < 4; ++j) sq += (v[rr][j].x * v[rr][j].x + v[rr][j].y * v[rr][j].y) + (v[rr][j].z * v[rr][j].z + v[rr][j].w * v[rr][j].w);
        sq = wave_sum(sq);
        const float irs = sqrtf(sq * (1.0f / 1024.0f) + 1e-6f), rs = 1.0f / irs;
        unsigned long long* o8 = (unsigned long long*)(o0 + rr * 1024) + lane;
#pragma unroll
        for (int j = 0; j < 4; ++j) o8[64 * j] = (unsigned long long)pk2(v[rr][j].x * rs, v[rr][j].y * rs) | ((unsigned long long)pk2(v[rr][j].z * rs, v[rr][j].w * rs) << 32);
        if (lane == 0) ssq0[rr] = irs; }
}
__device__ __forceinline__ void p0_prologue(Frame& F) {
    LAS unsigned short* scr = (LAS unsigned short*)(F.lds + RING_OFF + F.wave * 16384);
    const int gw = F.vcu * NWAVES + F.wave, NGW = F.G * NWAVES;
    unsigned char* ws = F.ws;
    constexpr int I_IN = 16 * (NPROJ / 64), I_KV = 16 * 32, I_SSD = 32 * 16, I_SQ = 16 * 16, I_GU = 16 * (2 * FFN / 64), I_DN = (FFN / 64) * 16;
    constexpr int NITEMS = I_IN + I_KV + I_SSD + 4 * I_SQ + I_GU + I_DN;
    for (int it = gw; it < NITEMS; it += NGW) {
        int r = it;
        if (r < I_IN) { TSrc s{F.in[9], nullptr, F.in[8], 11296, 1}; p0_transpose_item(s, 1024, NPROJ, (bf16*)(ws + WS_WIN), scr, r, F.lane); continue; } r -= I_IN;
        if (r < I_KV) { TSrc s{F.in[24], F.in[25], F.in[22], 1024, 3}; p0_transpose_item(s, 1024, 2048, (bf16*)(ws + WS_WKV), scr, r, F.lane); continue; } r -= I_KV;
        if (r < I_SSD) { TSrc s{F.in[16], nullptr, F.in[15], 1024, 0}; p0_transpose_item(s, 2048, 1024, (bf16*)(ws + WS_WSSD), scr, r, F.lane); continue; } r -= I_SSD;
        if (r < I_SQ) { TSrc s{F.in[19], nullptr, F.in[18], 1024, 0}; p0_transpose_item(s, 1024, 1024, (bf16*)(ws + WS_WHG), scr, r, F.lane); continue; } r -= I_SQ;
        if (r < I_SQ) { TSrc s{F.in[20], nullptr, nullptr, 1024, 0}; p0_transpose_item(s, 1024, 1024, (bf16*)(ws + WS_WOUT), scr, r, F.lane); continue; } r -= I_SQ;
        if (r < I_SQ) { TSrc s{F.in[23], nullptr, F.in[21], 1024, 0}; p0_transpose_item(s, 1024, 1024, (bf16*)(ws + WS_WCQ), scr, r, F.lane); continue; } r -= I_SQ;
        if (r < I_SQ) { TSrc s{F.in[26], nullptr, nullptr, 1024, 0}; p0_transpose_item(s, 1024, 1024, (bf16*)(ws + WS_WCO), scr, r, F.lane); continue; } r -= I_SQ;
        if (r < I_GU) { TSrc s{F.in[28], F.in[29], F.in[27], FFN, 2}; p0_transpose_item(s, 1024, 2 * FFN, (bf16*)(ws + WS_WGU), scr, r, F.lane); continue; } r -= I_GU;
        { TSrc s{F.in[30], nullptr, nullptr, 1024, 0}; p0_transpose_item(s, FFN, 1024, (bf16*)(ws + WS_WDN), scr, r, F.lane); }
    }
    bf16* XB = (bf16*)(ws + WS_XB); float* SSQX = (float*)(ws + WS_SSQX);
    for (int m4 = gw; m4 < T / 4; m4 += NGW) { const int m = 4 * m4;
        rows4_to_bf16_ssq(m < TP ? F.in[0] + (size_t)m * DM : F.in[1] + (size_t)(m - TP) * DM, XB + (size_t)m * DM, SSQX + m, F.lane); }
    bf16* MNB = (bf16*)(ws + WS_MNB); float* SSQM = (float*)(ws + WS_SSQM);
    for (int m4 = gw; m4 < MEMR / 4; m4 += NGW) { const int m = 4 * m4; rows4_to_bf16_ssq(F.in[2] + (size_t)m * DM, MNB + (size_t)m * DM, SSQM + m, F.lane); }
}
__device__ __forceinline__ void conv_copy_unit(Frame& F, int gb) {
    const bf16* PROJ = (const bf16*)(F.ws + WS_PROJ);
    const bool prompt = gb < NBP; const int sb = gb - NBP;
    const size_t row0 = prompt ? (size_t)gb * SEQ + (SEQ - 3) : (size_t)TP + (size_t)sb * LS + 1;
    float* dst = prompt ? F.out + O_CONVP + (size_t)gb * 3 * 3072 : F.out + O_CONVS + (size_t)sb * 3 * 3072;
    for (int e = F.tid; e < 3 * 3072; e += NTHR) { const int j = e / 3072, col = e % 3072;
        dst[e] = bf2f(PROJ[(size_t)(S_X0 + (col >> 10)) * SLOT_ELEMS + (row0 + j) * 1024 + (col & 1023)]); }
}
__device__ __forceinline__ void ssdnorm_phase(Frame& F) {
    const int gw = F.vcu * NWAVES + F.wave, NGW = F.G * NWAVES; bf16* YG = (bf16*)(F.ws + WS_YG); const float* SSQ = (const float*)(F.ws + WS_SSQSSD);
    for (int row = gw; row < T; row += NGW) {
        const f32x4* sp = (const f32x4*)(SSQ + (size_t)row * 32);
#pragma unroll
        for (int j = 0; j < 4; ++j) { const f32x4 a = sp[2 * j], b = sp[2 * j + 1]; const float s = ((a.x + a.y) + (a.z + a.w)) + ((b.x + b.y) + (b.z + b.w)); const float rs = 1.0f / sqrtf(s * (1.0f / 512.0f) + EPS);
            v4u* p = (v4u*)(YG + (size_t)row * 2048) + j * 64 + F.lane; const v4u w = *p; v4u o;
#pragma unroll
            for (int e = 0; e < 4; ++e) o[e] = pk2(bf2f(w[e] & 0xffffu) * rs, bf2f(w[e] >> 16) * rs);
            *p = o; }
    }
}
typedef float f32x16 __attribute__((ext_vector_type(16)));
#define MFMA32(a, b, c) __builtin_amdgcn_mfma_f32_32x32x16_bf16((a), (b), (c), 0, 0, 0)
__device__ __forceinline__ unsigned cvtpk_c(float lo, float hi) { return pk2(lo, hi); }
__device__ __forceinline__ bf16x8 pack8(float a0, float a1, float a2, float a3, float a4, float a5, float a6, float a7) {
    v4u w; w.x = cvtpk_c(a0, a1); w.y = cvtpk_c(a2, a3); w.z = cvtpk_c(a4, a5); w.w = cvtpk_c(a6, a7); return __builtin_bit_cast(bf16x8, w); }
#define ACC_FRAG(x, s) pack8((x)[8 * (s)], (x)[8 * (s) + 1], (x)[8 * (s) + 2], (x)[8 * (s) + 3], (x)[8 * (s) + 4], (x)[8 * (s) + 5], (x)[8 * (s) + 6], (x)[8 * (s) + 7])
__device__ __forceinline__ bf16x8 lds_frag16(const LAS unsigned char* p) { return *(const LAS bf16x8*)p; }
__device__ __forceinline__ bf16x8 lds_frag8x2(const LAS unsigned char* p) { const v2u lo = *(const LAS v2u*)p, hi = *(const LAS v2u*)(p + 16);
    const v4u w = (v4u){lo.x, lo.y, hi.x, hi.y}; return __builtin_bit_cast(bf16x8, w); }
#define LDS_BARRIER() do { asm volatile("s_waitcnt lgkmcnt(0)" ::: "memory"); __builtin_amdgcn_s_barrier(); asm volatile("" ::: "memory"); } while (0)
typedef short s16x4 __attribute__((ext_vector_type(4)));
__device__ __forceinline__ bf16x8 lds_frag_tr(const LAS unsigned char* p, const LAS unsigned char* p4) {
    const s16x4 lo = __builtin_amdgcn_ds_read_tr16_b64_v4i16((LAS s16x4*)p), hi = __builtin_amdgcn_ds_read_tr16_b64_v4i16((LAS s16x4*)p4);
    return (bf16x8){lo.x, lo.y, lo.z, lo.w, hi.x, hi.y, hi.z, hi.w}; }
constexpr size_t WS_BCS = WS_END, WS_BTT = WS_BCS + (size_t)TP * 1024 * 2, WS_END2 = WS_BTT + (size_t)NBP * 32 * 4 * 128 * 64 * 2;
__device__ __forceinline__ void bc_prep_unit(Frame& F, int b, int c) {
    typedef float f32x2 __attribute__((ext_vector_type(2)));
    int tid_o = F.tid; asm volatile("" : "+v"(tid_o));
    const int tid = tid_o, cg = tid & 127, seg = tid >> 7; unsigned char* ws = F.ws;
    const bf16* src = (const bf16*)(ws + WS_PROJ) + (size_t)S_X2 * SLOT_ELEMS + (size_t)b * SEQ * 1024 + 8 * cg;
    bf16* BCS = (bf16*)(ws + WS_BCS);
    const float* cw = F.in[10] + 2048 + 8 * cg; const float* cbp = F.in[11] + 2048 + 8 * cg;
#pragma unroll 1
    for (int half = 0; half < 2; ++half) {
        const int s0 = 16 * seg + 8 * half;
        v4u raw[11];
#pragma unroll
        for (int i = 0; i < 11; ++i) { const int gt = 64 * c + s0 - 3 + i; raw[i] = (v4u){0u, 0u, 0u, 0u}; if (gt >= 0) raw[i] = ld_nt16(src + (size_t)gt * 1024); }
        v4u rowpk[8];
#pragma unroll
        for (int kp = 0; kp < 4; ++kp) {
            const f32x2 cw0 = *(const f32x2*)(cw + 2 * kp), cw1 = *(const f32x2*)(cw + 3072 + 2 * kp), cw2 = *(const f32x2*)(cw + 2 * 3072 + 2 * kp), cw3 = *(const f32x2*)(cw + 3 * 3072 + 2 * kp), cbb = *(const f32x2*)(cbp + 2 * kp);
            f32x2 xv[11];
#pragma unroll
            for (int i = 0; i < 11; ++i) { const unsigned wd = raw[i][kp]; xv[i] = (f32x2){__uint_as_float(wd << 16), __uint_as_float(wd & 0xffff0000u)}; }
            f32x2 o[8];
#pragma unroll
            for (int i = 0; i < 8; ++i) { f32x2 a = cw0 * xv[i] + cbb; a = cw1 * xv[i + 1] + a; a = cw2 * xv[i + 2] + a; a = cw3 * xv[i + 3] + a;
                const f32x2 t = a * (-1.4426950408889634f); f32x2 e; e.x = __builtin_amdgcn_exp2f(t.x); e.y = __builtin_amdgcn_exp2f(t.y); e = e + 1.0f;
                f32x2 rc; rc.x = __builtin_amdgcn_rcpf(e.x); rc.y = __builtin_amdgcn_rcpf(e.y); o[i] = a * rc; }
#pragma unroll
            for (int i = 0; i < 8; ++i) rowpk[i][kp] = pk2(o[i].x, o[i].y);
        }
        bf16* drow = BCS + ((size_t)b * SEQ + 64 * c + s0) * 1024 + 8 * cg;
#pragma unroll
        for (int i = 0; i < 8; ++i) *(v4u*)(drow + (size_t)i * 1024) = rowpk[i];
    }
}
__device__ __forceinline__ void bc_prep_phase(Frame& F) { for (int u = F.vcu; u < NBP * 32; u += F.G) bc_prep_unit(F, u >> 5, u & 31); }
constexpr size_t WS_HVT = WS_XB, WS_EGM = WS_END2, WS_EGL = WS_EGM + (size_t)NBP * 64 * 1024 * 4, WS_END3 = WS_EGL + (size_t)NBP * 64 * 1024 * 4;
__device__ __forceinline__ void hg_prep_unit(Frame& F, int b, int c) {
    typedef float f32x2 __attribute__((ext_vector_type(2)));
    int tid_o = F.tid; asm volatile("" : "+v"(tid_o));
    const int tid = tid_o; unsigned char* ws = F.ws;
    const int ch = 2 * tid;
    const size_t row0 = (size_t)b * SEQ + 32 * c;
    bf16* QS = (bf16*)(ws + WS_PROJ) + (size_t)S_Q * SLOT_ELEMS + row0 * 1024 + ch; bf16* FS = (bf16*)(ws + WS_PROJ) + (size_t)S_F * SLOT_ELEMS + row0 * 1024 + ch;
    const f32x2 l0 = *(const f32x2*)(F.in[17] + ch), l1 = *(const f32x2*)(F.in[17] + 1024 + ch);
    f32x2 lb; lb.x = __builtin_amdgcn_rcpf(1.0f + __expf(l1.x - l0.x)); lb.y = __builtin_amdgcn_rcpf(1.0f + __expf(l1.y - l0.y));
    const f32x2 omlb = 1.0f - lb;
    f32x2 P[32]; f32x2 run = (f32x2){1.0f, 1.0f};
#pragma unroll
    for (int t = 0; t < 32; ++t) { const unsigned wd = ld_nt4(FS + (size_t)t * 1024);
        f32x2 u = (f32x2){__uint_as_float(wd << 16), __uint_as_float(wd & 0xffff0000u)}; u.x = fminf(fmaxf(u.x, -30.f), 30.f); u.y = fminf(fmaxf(u.y, -30.f), 30.f);
        const f32x2 tt = u * (-1.4426950408889634f); f32x2 e; e.x = __builtin_amdgcn_exp2f(tt.x); e.y = __builtin_amdgcn_exp2f(tt.y); e = e + 1.0f;
        f32x2 sg; sg.x = __builtin_amdgcn_rcpf(e.x); sg.y = __builtin_amdgcn_rcpf(e.y);
        const f32x2 fg = lb + omlb * sg; run = run * fg; run.x = fmaxf(run.x, 1e-30f); run.y = fmaxf(run.y, 1e-30f); P[t] = run; }
    const f32x2 Pm = P[15], Pl = P[31]; f32x2 rPm; rPm.x = __builtin_amdgcn_rcpf(Pm.x); rPm.y = __builtin_amdgcn_rcpf(Pm.y);
    *(f32x2*)((float*)(ws + WS_EGM) + (size_t)(b * 64 + c) * 1024 + ch) = Pm; *(f32x2*)((float*)(ws + WS_EGL) + (size_t)(b * 64 + c) * 1024 + ch) = Pl * rPm;
    f32x2 rPprev = (f32x2){1.0f, 1.0f};
#pragma unroll
    for (int t = 0; t < 32; ++t) { f32x2 rP; rP.x = __builtin_amdgcn_rcpf(P[t].x); rP.y = __builtin_amdgcn_rcpf(P[t].y);
        const f32x2 e1 = P[t] * rPm, e2 = Pm * rP, fg = P[t] * rPprev, kk = 1.0f - fg; rPprev = rP;
        const unsigned qw = ld_nt4(QS + (size_t)t * 1024); const f32x2 q = (f32x2){__uint_as_float(qw << 16), __uint_as_float(qw & 0xffff0000u)};
        const f32x2 tq = q * (-1.4426950408889634f); f32x2 eq; eq.x = __builtin_amdgcn_exp2f(tq.x); eq.y = __builtin_amdgcn_exp2f(tq.y); eq = eq + 1.0f;
        f32x2 rq; rq.x = __builtin_amdgcn_rcpf(eq.x); rq.y = __builtin_amdgcn_rcpf(eq.y);
        const f32x2 qa = q * rq * e1, ka = kk * e2;
        *(unsigned*)(QS + (size_t)t * 1024) = pk2(qa.x, qa.y); *(unsigned*)(FS + (size_t)t * 1024) = pk2(ka.x, ka.y); }
}
__device__ __forceinline__ void hg_prep_phase(Frame& F) { for (int u = F.vcu; u < NBP * 64; u += F.G) hg_prep_unit(F, u >> 6, u & 63); }
constexpr int HV_QA = 0, HV_KA = 8704, HV_KAT = 17408, HV_VT = 27648, HV_EGM = 30208, HV_EGL = 30720, HV_PBUF = 31232, HV_OB = 2 * HV_PBUF, HV_OBUF = 23040;
constexpr size_t WS_SSQH = WS_END3, WS_END4 = WS_SSQH + (size_t)T * 32 * 4;
__device__ __forceinline__ void hgrn_v_unit(Frame& F, int b, int hd, int vt) {
    int tid_o = F.tid; asm volatile("" : "+v"(tid_o));
    const int tid = tid_o, lane = tid & 63, w = F.wave, r = lane & 31, hh = lane >> 5; unsigned char* ws = F.ws;
    LAS unsigned char* Lb = F.lds + RING_OFF;
    const bf16* PROJ = (const bf16*)(ws + WS_PROJ); bf16* OU = (bf16*)(ws + WS_ON); float* SSQH = (float*)(ws + WS_SSQH);
    const size_t rowb = (size_t)b * SEQ;
    const int pt_t = tid & 31, pt_g = tid >> 5;
    const bf16* qsrc = PROJ + (size_t)S_Q * SLOT_ELEMS + (rowb + pt_t) * 1024 + hd * 128 + 8 * pt_g;
    const bf16* ksrc = PROJ + (size_t)S_F * SLOT_ELEMS + (rowb + pt_t) * 1024 + hd * 128 + 8 * pt_g;
    const unsigned char* xsrc = nullptr; size_t xstr = 0;
    if (tid < 128) { xsrc = (const unsigned char*)(PROJ + (size_t)S_I * SLOT_ELEMS + (rowb + pt_t) * 1024 + hd * 128 + 32 * vt + 8 * pt_g); xstr = (size_t)32 * 1024 * 2; }
    else if (tid < 160) { xsrc = (const unsigned char*)((const float*)(ws + WS_EGM) + (size_t)b * 64 * 1024 + hd * 128 + 4 * (tid - 128)); xstr = 4096; }
    else if (tid < 192) { xsrc = (const unsigned char*)((const float*)(ws + WS_EGL) + (size_t)b * 64 * 1024 + hd * 128 + 4 * (tid - 160)); xstr = 4096; }
    const int o_img = pt_t * 272 + 16 * pt_g, o_ka = pt_t * 256 + 16 * (pt_g ^ (((pt_t & 3) << 2) | ((pt_t >> 2) & 3))), o_v = pt_t * 64 + 16 * pt_g;
#define HGV_LOAD(cc, pq, pk, px) { pq = *(const v4u*)(qsrc + (size_t)(cc) * 32 * 1024); pk = *(const v4u*)(ksrc + (size_t)(cc) * 32 * 1024); if (tid < 192) px = *(const v4u*)(xsrc + (size_t)(cc) * xstr); }
#define HGV_STORE(pb, pq, pk, px) { *(LAS v4u*)((pb) + HV_QA + o_img) = pq; *(LAS v4u*)((pb) + HV_KA + o_ka) = pk; \
        if (tid < 128) { *(LAS v4u*)((pb) + HV_VT + o_v) = px; } else if (tid < 160) { *(LAS v4u*)((pb) + HV_EGM + 16 * (tid - 128)) = px; } else if (tid < 192) { *(LAS v4u*)((pb) + HV_EGL + 16 * (tid - 160)) = px; } }
    v4u pqA, pkA, pxA = (v4u){0u, 0u, 0u, 0u}, pqB, pkB, pxB = (v4u){0u, 0u, 0u, 0u};
    HGV_LOAD(0, pqA, pkA, pxA) HGV_STORE(Lb, pqA, pkA, pxA)
    HGV_LOAD(1, pqA, pkA, pxA) HGV_LOAD(2, pqB, pkB, pxB)
    const int kt = w;
    v2u ow_pend = (v2u){0u, 0u}; float sq_pend = 0.f;
    f32x16 S;
#pragma unroll
    for (int i = 0; i < 16; ++i) S[i] = 0.f;
    __syncthreads();
#define HGV_ITER(c, pq, pk, px) { \
        int r_l = r, hh_l = hh, tid_l = tid; asm volatile("" : "+v"(r_l), "+v"(hh_l), "+v"(tid_l)); \
        { const int r = r_l, hh = hh_l, tid = tid_l; \
        LAS unsigned char* pbc = Lb + ((c) & 1) * HV_PBUF; LAS unsigned char* pbn = Lb + (((c) + 1) & 1) * HV_PBUF; \
        if ((c) < 63) { HGV_STORE(pbn, pq, pk, px) if ((c) < 61) HGV_LOAD((c) + 3, pq, pk, px) } \
        if (w < 4) { \
            LAS float* EGM = (LAS float*)(pbc + HV_EGM); LAS float* EGL = (LAS float*)(pbc + HV_EGL); LAS float* OB = (LAS float*)(Lb + HV_OB + ((c) & 1) * HV_OBUF); \
            _Pragma("unroll") \
            for (int q4 = 0; q4 < 4; ++q4) { const f32x4 e0 = *(const LAS f32x4*)(EGM + 32 * kt + 8 * q4 + 4 * hh); \
                _Pragma("unroll") \
                for (int j = 0; j < 4; ++j) S[4 * q4 + j] *= e0[j]; } \
            f32x16 o; \
            _Pragma("unroll") \
            for (int i = 0; i < 16; ++i) o[i] = 0.f; \
            const LAS unsigned char* qa_row = pbc + HV_QA + r * 272; \
            o = MFMA32(ACC_FRAG(S, 0), lds_frag8x2(qa_row + (32 * kt + 4 * hh) * 2), o);        \
            o = MFMA32(ACC_FRAG(S, 1), lds_frag8x2(qa_row + (32 * kt + 16 + 4 * hh) * 2), o); \
            LAS float* ob = OB + (kt * 32 + r) * 36 + 4 * hh; \
            _Pragma("unroll") \
            for (int q4 = 0; q4 < 4; ++q4) *(LAS f32x4*)(ob + 8 * q4) = (f32x4){o[4 * q4], o[4 * q4 + 1], o[4 * q4 + 2], o[4 * q4 + 3]}; \
              \
            const int q_ = ((tid & 63) >> 2) & 3, chk_ = 4 * kt + 2 * (((tid & 63) >> 4) & 1) + (((tid & 63) >> 1) & 1); \
            const LAS unsigned char* ka_lo = pbc + HV_KA + (8 * hh + q_) * 256 + 16 * (chk_ ^ ((q_ << 2) | ((2 * hh) & 3))) + 8 * ((tid & 63) & 1); \
            const LAS unsigned char* ka_hi = pbc + HV_KA + (8 * hh + 4 + q_) * 256 + 16 * (chk_ ^ ((q_ << 2) | ((2 * hh + 1) & 3))) + 8 * ((tid & 63) & 1); \
            const LAS unsigned char* v_lo = pbc + HV_VT + (8 * hh + q_) * 64 + (16 * (((tid & 63) >> 4) & 1) + 4 * ((tid & 63) & 3)) * 2; \
            S = MFMA32(lds_frag_tr(ka_lo, ka_hi), lds_frag_tr(v_lo, v_lo + 4 * 64), S); S = MFMA32(lds_frag_tr(ka_lo + 4096, ka_hi + 4096), lds_frag_tr(v_lo + 16 * 64, v_lo + 20 * 64), S); \
            _Pragma("unroll") \
            for (int q4 = 0; q4 < 4; ++q4) { const f32x4 e0 = *(const LAS f32x4*)(EGL + 32 * kt + 8 * q4 + 4 * hh); \
                _Pragma("unroll") \
                for (int j = 0; j < 4; ++j) S[4 * q4 + j] *= e0[j]; } \
        } else { \
            if (w == 4) { LAS float* OB = (LAS float*)(Lb + HV_OB + ((c) & 1) * HV_OBUF); f32x16 o; \
                _Pragma("unroll") \
                for (int i = 0; i < 16; ++i) o[i] = 0.f; \
                f32x16 X; \
                _Pragma("unroll") \
                for (int i = 0; i < 16; ++i) X[i] = 0.f; \
                const LAS unsigned char* ka_rowp = pbc + HV_KA + r * 256; const int ka_sw = ((r & 3) << 2) | ((r >> 2) & 3); const LAS unsigned char* qa_nat = pbc + HV_QA + r * 272 + hh * 16; \
                { f32x16 Xb; \
                _Pragma("unroll") \
                for (int i = 0; i < 16; ++i) Xb[i] = 0.f; \
                _Pragma("unroll 2") \
                for (int ks = 0; ks < 8; ks += 2) { X = MFMA32(lds_frag16(ka_rowp + 16 * ((2 * ks + hh) ^ ka_sw)), lds_frag16(qa_nat + ks * 32), X); Xb = MFMA32(lds_frag16(ka_rowp + 16 * ((2 * ks + 2 + hh) ^ ka_sw)), lds_frag16(qa_nat + ks * 32 + 32), Xb); } \
                X = X + Xb; } \
                _Pragma("unroll") \
                for (int i = 0; i < 16; ++i) { const int srow = (i & 3) + 8 * (i >> 2) + 4 * hh; X[i] = (srow <= r) ? X[i] : 0.f; } \
                const LAS unsigned char* v4_lo = pbc + HV_VT + (4 * hh + (((tid & 63) >> 2) & 3)) * 64 + (16 * (((tid & 63) >> 4) & 1) + 4 * ((tid & 63) & 3)) * 2;        \
                o = MFMA32(lds_frag_tr(v4_lo, v4_lo + 8 * 64), ACC_FRAG(X, 0), o);                \
                o = MFMA32(lds_frag_tr(v4_lo + 16 * 64, v4_lo + 24 * 64), ACC_FRAG(X, 1), o); \
                LAS float* ob4 = OB + (4 * 32 + r) * 36 + 4 * hh; \
                _Pragma("unroll") \
                for (int q4 = 0; q4 < 4; ++q4) *(LAS f32x4*)(ob4 + 8 * q4) = (f32x4){o[4 * q4], o[4 * q4 + 1], o[4 * q4 + 2], o[4 * q4 + 3]}; \
            } \
            if ((c) > 1) { HGV_FLUSH((c) - 2) } \
            if ((c) > 0) { HGV_OUT((c) - 1) } \
        } \
        LDS_BARRIER(); \
        } }
#define HGV_OUT(cp) { const LAS float* OB = (const LAS float*)(Lb + HV_OB + ((cp) & 1) * HV_OBUF); const int tl = tid - 256, t = tl >> 3, v0 = (tl & 7) * 4; \
            const f32x4 a = *(const LAS f32x4*)(OB + t * 36 + v0), b2 = *(const LAS f32x4*)(OB + (32 + t) * 36 + v0), c2 = *(const LAS f32x4*)(OB + (64 + t) * 36 + v0), d2 = *(const LAS f32x4*)(OB + (96 + t) * 36 + v0), e2 = *(const LAS f32x4*)(OB + (128 + t) * 36 + v0); \
            const f32x4 o4 = ((a + b2) + (c2 + d2)) + e2; \
            float sq = (o4.x * o4.x + o4.y * o4.y) + (o4.z * o4.z + o4.w * o4.w); sq += __int_as_float(__builtin_amdgcn_update_dpp(0, __float_as_int(sq), 0x104, 0xf, 0xf, true)); sq += __int_as_float(__builtin_amdgcn_update_dpp(0, __float_as_int(sq), 0x102, 0xf, 0xf, true)); sq += __int_as_float(__builtin_amdgcn_update_dpp(0, __float_as_int(sq), 0x101, 0xf, 0xf, true));   \
            sq_pend = sq; ow_pend.x = pk2(o4.x, o4.y); ow_pend.y = pk2(o4.z, o4.w); }
#define HGV_FLUSH(cp) { const int tl = tid - 256, t = tl >> 3, v0 = (tl & 7) * 4; const size_t row = rowb + 32 * (cp) + t; \
            if ((tl & 7) == 0) SSQH[row * 32 + hd * 4 + vt] = sq_pend; *(v2u*)(OU + row * 1024 + hd * 128 + 32 * vt + v0) = ow_pend; }
#pragma unroll 1
    for (int cc = 0; cc < 64; cc += 2) { HGV_ITER(cc, pqA, pkA, pxA) HGV_ITER(cc + 1, pqB, pkB, pxB) }
    if (w >= 4) { HGV_FLUSH(62) HGV_OUT(63) HGV_FLUSH(63) }
#undef HGV_ITER
#undef HGV_OUT
#undef HGV_FLUSH
#undef HGV_LOAD
#undef HGV_STORE
    if (w < 4) { float* st_g = F.out + O_HGP + (size_t)(b * 8 + hd) * 16384 + 32 * vt + r;
#pragma unroll
        for (int i = 0; i < 16; ++i) { const int k = 32 * kt + (i & 3) + 8 * (i >> 2) + 4 * hh; st_g[(size_t)k * 128] = S[i]; } }
    __syncthreads();
}
__device__ __forceinline__ void hgnorm_phase(Frame& F) {
    const int gw = F.vcu * NWAVES + F.wave, NGW = F.G * NWAVES; bf16* ON = (bf16*)(F.ws + WS_ON); const float* SSQH = (const float*)(F.ws + WS_SSQH);
    const bf16* HG = (const bf16*)(F.ws + WS_PROJ) + (size_t)S_HG * SLOT_ELEMS;
    for (int row = gw; row < TP; row += NGW) {
#pragma unroll
        for (int j = 0; j < 2; ++j) { const int pc = j * 64 + F.lane, hd = pc >> 4;
            const f32x4 sp = *(const f32x4*)(SSQH + (size_t)row * 32 + hd * 4); const float rs = __builtin_amdgcn_rsqf(((sp.x + sp.y) + (sp.z + sp.w)) * (1.0f / 128.0f) + EPS);
            v4u* p = (v4u*)(ON + (size_t)row * 1024) + pc; const v4u o = *p; const v4u g = ld_nt16((const v4u*)(HG + (size_t)row * 1024) + pc); v4u res;
#pragma unroll
            for (int e = 0; e < 4; ++e) res[e] = pk2(bf2f(o[e] & 0xffffu) * rs * silu_f(bf2f(g[e] & 0xffffu)), __uint_as_float(o[e] & 0xffff0000u) * rs * silu_f(__uint_as_float(g[e] & 0xffff0000u)));
            *p = res; }
    }
}
constexpr int SD_BN = 0, SD_CN = 17408, SD_BT = 34816, SD_XT = 53248, SD_HT = 62464, SD_YA = 97280, SD_YY = 113664, SD_YO = 130048, SD_CUM = 134144, SD_DTV = 134400, SD_ECUM = 134656, SD_XWT = 134912, SD_CWL = 144128;
__device__ __forceinline__ void ssd_unit_mfma(Frame& F, int gb, int h) {
    int tid_o = F.tid; asm volatile("" : "+v"(tid_o));
    const int tid = tid_o, lane = tid & 63, w = F.wave, r = lane & 31, hh = lane >> 5; unsigned char* ws = F.ws;
    const int L = SEQ; const size_t row_base = (size_t)gb * SEQ;
    const int g = h >> 3;
    LAS unsigned char* Lb = F.lds + RING_OFF;
    LAS unsigned short* BN = (LAS unsigned short*)(Lb + SD_BN); LAS unsigned short* CN = (LAS unsigned short*)(Lb + SD_CN);
    LAS unsigned short* BT = (LAS unsigned short*)(Lb + SD_BT); LAS unsigned short* XT = (LAS unsigned short*)(Lb + SD_XT);
    LAS unsigned short* HT = (LAS unsigned short*)(Lb + SD_HT);
    LAS unsigned short* XWT = (LAS unsigned short*)(Lb + SD_XWT);
    LAS float* YA = (LAS float*)(Lb + SD_YA); LAS float* YY = (LAS float*)(Lb + SD_YY); LAS unsigned short* YO = (LAS unsigned short*)(Lb + SD_YO);
    LAS float* CUM = (LAS float*)(Lb + SD_CUM); LAS float* DTV = (LAS float*)(Lb + SD_DTV); LAS float* ECUM = (LAS float*)(Lb + SD_ECUM);
    const bf16* PROJ = (const bf16*)(ws + WS_PROJ); const float* DTR = (const float*)(ws + WS_DT); bf16* YG = (bf16*)(ws + WS_YG); float* SSQ = (float*)(ws + WS_SSQSSD);
    f32x16 H0, H1, H2, H3;
#pragma unroll
    for (int i = 0; i < 16; ++i) { H0[i] = 0.f; H1[i] = 0.f; H2[i] = 0.f; H3[i] = 0.f; }
    float* const st_base = F.out + O_SSMP + (size_t)(gb * 32 + h) * 8192 + (size_t)r * 128 + 4 * hh;
#define SSD_PUBLISH(HX, TILE, BUF) { LAS unsigned short* hp_ = HT + (BUF) * 8704 + (32 * ((TILE) & 1) + r) * 136 + 32 * ((TILE) >> 1) + 4 * hh; \
        _Pragma("unroll") for (int q4 = 0; q4 < 4; ++q4) { v2u pk; pk.x = cvtpk_c(HX[4 * q4], HX[4 * q4 + 1]); pk.y = cvtpk_c(HX[4 * q4 + 2], HX[4 * q4 + 3]); *(LAS v2u*)(hp_ + 8 * q4) = pk; } }
    if (w == 3) { SSD_PUBLISH(H0, 0, 0) SSD_PUBLISH(H1, 1, 0) SSD_PUBLISH(H2, 2, 0) SSD_PUBLISH(H3, 3, 0) } else if (w >= 4) { SSD_PUBLISH(H0, w, 0) }
    const float a = -__expf(F.in[13][h]), dtb = F.in[12][h], Dk = F.in[14][h];
    const float* cw = F.in[10]; const float* cbp = F.in[11];
    typedef float f32x2 __attribute__((ext_vector_type(2)));
    const int col = h * 64 + 2 * (tid & 31);
    const bf16* cptr = PROJ + (size_t)(S_X0 + (col >> 10)) * SLOT_ELEMS + row_base * 1024 + (col & 1023);
    const f32x2 cw0 = *(const f32x2*)(cw + col), cw1 = *(const f32x2*)(cw + 3072 + col), cw2 = *(const f32x2*)(cw + 2 * 3072 + col), cw3 = *(const f32x2*)(cw + 3 * 3072 + col), cbb = *(const f32x2*)(cbp + col);
    const bf16* BCS = (const bf16*)(ws + WS_BCS) + row_base * 1024 + g * 128;
    unsigned xr[7]; v4u pc[4];
#pragma unroll
    for (int i = 0; i < 7; ++i) { const int gt = 4 * (tid >> 5) - 3 + i; xr[i] = 0u; if (gt >= 0) xr[i] = *(const unsigned*)(cptr + (size_t)gt * 1024); }
#pragma unroll
    for (int j = 0; j < 4; ++j) { const int idx = (tid + 512 * j) & 1023; pc[j] = *(const v4u*)(BCS + (size_t)(idx >> 4) * 1024 + (j >> 1) * 512 + 8 * (idx & 15)); }
    __syncthreads();
    v4u ow_pend = (v4u){0u, 0u, 0u, 0u}; float sq_pend = 0.f; bool pend = false;
    int buf = 0;
    float dt_pf = 0.f;
    if (lane < L) dt_pf = DTR[(row_base + lane) * 32 + h];
    v4u zw_pf = ld_nt16(PROJ + (size_t)(S_Z0 + (h >> 4)) * SLOT_ELEMS + (row_base + (tid >> 3)) * 1024 + (h & 15) * 64 + (tid & 7) * 8);
    for (int t0 = 0; t0 < L; t0 += 64, buf ^= 1) {
        int r_l = r, hh_l = hh, tid_l = tid, lane_l = lane;
        asm volatile("" : "+v"(r_l), "+v"(hh_l), "+v"(tid_l), "+v"(lane_l));
        { const int r = r_l, hh = hh_l, tid = tid_l, lane = lane_l;
        float dtv = 0.f;
        if (t0 + lane < L) { const float x = dt_pf + dtb; dtv = fmaxf(x, 0.f) + 0.6931471805599453f * __builtin_amdgcn_logf(1.0f + __builtin_amdgcn_exp2f(-1.4426950408889634f * fabsf(x))); }
        dt_pf = 0.f; if (t0 + 64 + lane < L) dt_pf = DTR[(row_base + t0 + 64 + lane) * 32 + h];
        const v4u zw = zw_pf; zw_pf = (v4u){0u, 0u, 0u, 0u};
        if (t0 + 64 + (tid >> 3) < L) zw_pf = ld_nt16(PROJ + (size_t)(S_Z0 + (h >> 4)) * SLOT_ELEMS + (row_base + t0 + 64 + (tid >> 3)) * 1024 + (h & 15) * 64 + (tid & 7) * 8);
        float cum = dtv * a;
#define SSD_DPP_ADD(ctrl, rmask) cum += __int_as_float(__builtin_amdgcn_update_dpp(0, __float_as_int(cum), ctrl, rmask, 0xf, true))
        SSD_DPP_ADD(0x111, 0xf); SSD_DPP_ADD(0x112, 0xf); SSD_DPP_ADD(0x114, 0xf); SSD_DPP_ADD(0x118, 0xf);
        SSD_DPP_ADD(0x142, 0xa); SSD_DPP_ADD(0x143, 0xc);
#undef SSD_DPP_ADD
        const float cum_last = __int_as_float(__builtin_amdgcn_readlane(__float_as_int(cum), 63));
        const float wgt = __expf(cum_last - cum) * dtv;
        if (w == 0) { CUM[lane] = cum; DTV[lane] = dtv; ECUM[lane] = __expf(cum); }
#pragma unroll
        for (int j = 0; j < 4; ++j) { const int idx = (tid + 512 * j) & 1023;
            if (j < 2) { const int row = idx >> 4; *(LAS v4u*)((LAS unsigned char*)BN + 256 * row + 16 * ((idx & 15) ^ (((row & 3) << 2) | ((row >> 2) & 3)))) = pc[j]; }
            else *(LAS v4u*)(CN + (idx >> 4) * 136 + 8 * (idx & 15)) = pc[j]; }
        if (pend) { const size_t prow = row_base + (t0 - 64) + (tid >> 3);
            *(v4u*)(YG + prow * 2048 + h * 64 + (tid & 7) * 8) = ow_pend; if ((tid & 7) == 0) SSQ[prow * 32 + h] = sq_pend; pend = false; }
        { const int cp = tid & 31, sq = tid >> 5; const int wu = __builtin_amdgcn_readfirstlane(w);
          f32x2 xv[7];
#pragma unroll
          for (int i = 0; i < 7; ++i) xv[i] = (f32x2){__uint_as_float(xr[i] << 16), __uint_as_float(xr[i] & 0xffff0000u)};
          unsigned po[4], pw[4];
          f32x2 o[4], ow[4];
#pragma unroll
          for (int k = 0; k < 4; ++k) {
              const float w_lo = __int_as_float(__builtin_amdgcn_readlane(__float_as_int(wgt), 8 * wu + k)), w_hi = __int_as_float(__builtin_amdgcn_readlane(__float_as_int(wgt), 8 * wu + 4 + k));
              const float wx = hh ? w_hi : w_lo;
              f32x2 a = cw0 * xv[k] + cbb; a = cw1 * xv[k + 1] + a; a = cw2 * xv[k + 2] + a; a = cw3 * xv[k + 3] + a;
              const f32x2 t = a * (-1.4426950408889634f); f32x2 e; e.x = __builtin_amdgcn_exp2f(t.x); e.y = __builtin_amdgcn_exp2f(t.y); e = e + 1.0f;
              f32x2 rc; rc.x = __builtin_amdgcn_rcpf(e.x); rc.y = __builtin_amdgcn_rcpf(e.y); o[k] = a * rc; ow[k] = o[k] * wx; }
          po[0] = pk2(o[0].x, o[1].x); po[1] = pk2(o[2].x, o[3].x); po[2] = pk2(o[0].y, o[1].y); po[3] = pk2(o[2].y, o[3].y);
          pw[0] = pk2(ow[0].x, ow[1].x); pw[1] = pk2(ow[2].x, ow[3].x); pw[2] = pk2(ow[0].y, ow[1].y); pw[3] = pk2(ow[2].y, ow[3].y);
          *(LAS v2u*)(XT + (2 * cp) * 72 + 4 * sq) = (v2u){po[0], po[1]}; *(LAS v2u*)(XT + (2 * cp + 1) * 72 + 4 * sq) = (v2u){po[2], po[3]};
          *(LAS v2u*)(XWT + (2 * cp) * 72 + 4 * sq) = (v2u){pw[0], pw[1]}; *(LAS v2u*)(XWT + (2 * cp + 1) * 72 + 4 * sq) = (v2u){pw[2], pw[3]};
        }
        if (t0 + 64 < L) {
#pragma unroll
            for (int i = 0; i < 7; ++i) xr[i] = *(const unsigned*)(cptr + (size_t)(t0 + 64 + 4 * (tid >> 5) - 3 + i) * 1024);
#pragma unroll
            for (int j = 0; j < 4; ++j) { const int idx = (tid + 512 * j) & 1023; pc[j] = *(const v4u*)(BCS + (size_t)(t0 + 64 + (idx >> 4)) * 1024 + (j >> 1) * 512 + 8 * (idx & 15)); }
        }
        LDS_BARRIER();
        if (w < 3) {
            const int tt = w == 0 ? 0 : 1, st = w == 1 ? 1 : 0;
            f32x16 X, ya0, ya1;
#pragma unroll
            for (int i = 0; i < 16; ++i) { X[i] = 0.f; ya0[i] = 0.f; ya1[i] = 0.f; }
            const LAS unsigned char* cn_nat = Lb + SD_CN + (32 * tt + r) * 272 + hh * 16; const int bn_sw = ((r & 3) << 2) | ((r >> 2) & 3); const LAS unsigned char* bn_row = Lb + SD_BN + (32 * st + r) * 256;
            { f32x16 Xb;
#pragma unroll
              for (int i = 0; i < 16; ++i) Xb[i] = 0.f;
#pragma unroll
              for (int ks = 0; ks < 8; ks += 2) { X = MFMA32(lds_frag16(bn_row + 16 * ((2 * ks + hh) ^ bn_sw)), lds_frag16(cn_nat + ks * 32), X); Xb = MFMA32(lds_frag16(bn_row + 16 * ((2 * ks + 2 + hh) ^ bn_sw)), lds_frag16(cn_nat + ks * 32 + 32), Xb); }
              X = X + Xb; }
            const float cum_t = CUM[32 * tt + r];
#pragma unroll
            for (int q4 = 0; q4 < 4; ++q4) { const f32x4 cs = *(const LAS f32x4*)(CUM + 32 * st + 8 * q4 + 4 * hh), ds = *(const LAS f32x4*)(DTV + 32 * st + 8 * q4 + 4 * hh);
#pragma unroll
                for (int jj = 0; jj < 4; ++jj) { const int s_abs = 32 * st + 8 * q4 + 4 * hh + jj; const float f = __expf(cum_t - cs[jj]) * ds[jj]; X[4 * q4 + jj] = (s_abs <= 32 * tt + r) ? X[4 * q4 + jj] * f : 0.f;        } }
            const bf16x8 xf0 = ACC_FRAG(X, 0), xf1 = ACC_FRAG(X, 1);
            const LAS unsigned char* xt_row = Lb + SD_XT + r * 144 + (32 * st + 4 * hh) * 2;
            ya0 = MFMA32(lds_frag8x2(xt_row), xf0, ya0); ya0 = MFMA32(lds_frag8x2(xt_row + 32), xf1, ya0);
            ya1 = MFMA32(lds_frag8x2(xt_row + 32 * 144), xf0, ya1); ya1 = MFMA32(lds_frag8x2(xt_row + 32 * 144 + 32), xf1, ya1);
            if (w < 2) { LAS float* yb = YA + (32 * tt + r) * 64;
#pragma unroll
                for (int q4 = 0; q4 < 4; ++q4) { const int ch = 2 * q4 + hh;
                    *(LAS f32x4*)(yb + 4 * (ch ^ (r & 15))) = (f32x4){ya0[4 * q4], ya0[4 * q4 + 1], ya0[4 * q4 + 2], ya0[4 * q4 + 3]};
                    *(LAS f32x4*)(yb + 4 * ((ch + 8) ^ (r & 15))) = (f32x4){ya1[4 * q4], ya1[4 * q4 + 1], ya1[4 * q4 + 2], ya1[4 * q4 + 3]}; } }
            else { LAS unsigned char* yb = (LAS unsigned char*)YO + r * 128;
#pragma unroll
                for (int q4 = 0; q4 < 4; ++q4) { const int ch = 2 * q4 + hh; v2u p0, p1;
                    p0.x = cvtpk_c(ya0[4 * q4], ya0[4 * q4 + 1]); p0.y = cvtpk_c(ya0[4 * q4 + 2], ya0[4 * q4 + 3]); p1.x = cvtpk_c(ya1[4 * q4], ya1[4 * q4 + 1]); p1.y = cvtpk_c(ya1[4 * q4 + 2], ya1[4 * q4 + 3]);
                    *(LAS v2u*)(yb + 8 * (ch ^ ((r & 7) << 1))) = p0; *(LAS v2u*)(yb + 8 * ((ch + 8) ^ ((r & 7) << 1))) = p1; } }
        } else if (w >= 4) {
            const int tt = (w - 4) >> 1, ptj = w & 1;
            const LAS unsigned char* ht_nat = Lb + SD_HT + buf * 17408 + (32 * ptj + r) * 272 + hh * 16;
            f32x16 yi;
#pragma unroll
            for (int i = 0; i < 16; ++i) yi[i] = 0.f;
            const LAS unsigned char* cn_nat = Lb + SD_CN + (32 * tt + r) * 272 + hh * 16;
            { f32x16 yb2;
#pragma unroll
              for (int i = 0; i < 16; ++i) yb2[i] = 0.f;
#pragma unroll 2
              for (int ks = 0; ks < 8; ks += 2) { yi = MFMA32(lds_frag16(cn_nat + ks * 32), lds_frag16(ht_nat + ks * 32), yi); yb2 = MFMA32(lds_frag16(cn_nat + ks * 32 + 32), lds_frag16(ht_nat + ks * 32 + 32), yb2); }
              yi = yi + yb2; }
            const LAS unsigned short* xt_p = XT + (32 * ptj + r) * 72 + 32 * tt + 4 * hh;
#pragma unroll
            for (int q4 = 0; q4 < 4; ++q4) { const f32x4 ec = *(const LAS f32x4*)(ECUM + 32 * tt + 8 * q4 + 4 * hh); const v2u xw = *(const LAS v2u*)(xt_p + 8 * q4);
                const float x0 = bf2f(xw.x & 0xffffu), x1 = bf2f(xw.x >> 16), x2 = bf2f(xw.y & 0xffffu), x3 = bf2f(xw.y >> 16);
                LAS float* yb = YY + (32 * tt + 8 * q4 + 4 * hh) * 64 + 32 * ptj + r;
                yb[0] = ec[0] * yi[4 * q4] + Dk * x0; yb[64] = ec[1] * yi[4 * q4 + 1] + Dk * x1; yb[128] = ec[2] * yi[4 * q4 + 2] + Dk * x2; yb[192] = ec[3] * yi[4 * q4 + 3] + Dk * x3; }
        }
#define SSD_UPD(HX, TILE) { const int q_ = (lane >> 2) & 3, ch_ = 4 * ((TILE) >> 1) + 2 * ((lane >> 4) & 1) + ((lane >> 1) & 1); \
            const LAS unsigned char* bn_lo = Lb + SD_BN + (8 * hh + q_) * 256 + 16 * (ch_ ^ ((q_ << 2) | ((2 * hh) & 3))) + 8 * (lane & 1); \
            const LAS unsigned char* bn_hi = Lb + SD_BN + (8 * hh + 4 + q_) * 256 + 16 * (ch_ ^ ((q_ << 2) | ((2 * hh + 1) & 3))) + 8 * (lane & 1); \
            const LAS unsigned char* xt_nat = Lb + SD_XWT + (32 * ((TILE) & 1) + r) * 144 + hh * 16; \
            f32x16 Ha, Hb; \
            _Pragma("unroll") for (int i = 0; i < 16; ++i) { Ha[i] = 0.f; Hb[i] = 0.f; } \
            Ha = MFMA32(lds_frag_tr(bn_lo, bn_hi), lds_frag16(xt_nat), Ha); Hb = MFMA32(lds_frag_tr(bn_lo + 4096, bn_hi + 4096), lds_frag16(xt_nat + 32), Hb); \
            Ha = MFMA32(lds_frag_tr(bn_lo + 8192, bn_hi + 8192), lds_frag16(xt_nat + 64), Ha); Hb = MFMA32(lds_frag_tr(bn_lo + 12288, bn_hi + 12288), lds_frag16(xt_nat + 96), Hb);         \
            _Pragma("unroll") for (int i = 0; i < 16; ++i) HX[i] = HX[i] * el + (Ha[i] + Hb[i]); \
            SSD_PUBLISH(HX, TILE, buf ^ 1) }
        if (w >= 3) { const float el = ECUM[63];
            if (w == 3) { SSD_UPD(H0, 0) SSD_UPD(H1, 1) SSD_UPD(H2, 2) SSD_UPD(H3, 3) } else { SSD_UPD(H0, w) } }
        LDS_BARRIER();
        { const int tt = tid >> 3, p0 = (tid & 7) * 8;
          if (t0 + tt < L) { const size_t row = row_base + t0 + tt;
            const int c0 = 2 * (tid & 7);
            f32x4 y0 = *(const LAS f32x4*)(YA + tt * 64 + 4 * (c0 ^ (tt & 15))) + *(const LAS f32x4*)(YY + tt * 64 + p0), y1 = *(const LAS f32x4*)(YA + tt * 64 + 4 * ((c0 + 1) ^ (tt & 15))) + *(const LAS f32x4*)(YY + tt * 64 + p0 + 4);
            if (tt >= 32) { const v4u ow4 = *(const LAS v4u*)((const LAS unsigned char*)YO + (tt - 32) * 128 + 16 * ((tid & 7) ^ (tt & 7)));
                y0 = y0 + (f32x4){bf2f(ow4.x & 0xffffu), __uint_as_float(ow4.x & 0xffff0000u), bf2f(ow4.y & 0xffffu), __uint_as_float(ow4.y & 0xffff0000u)};
                y1 = y1 + (f32x4){bf2f(ow4.z & 0xffffu), __uint_as_float(ow4.z & 0xffff0000u), bf2f(ow4.w & 0xffffu), __uint_as_float(ow4.w & 0xffff0000u)}; }
            float o[8]; float sq = 0.f;
#pragma unroll
            for (int j = 0; j < 8; ++j) { const unsigned z16 = (zw[j >> 1] >> ((j & 1) * 16)) & 0xffffu; const float yv = (j < 4 ? y0[j & 3] : y1[j & 3]) * silu_f(bf2f(z16)); o[j] = yv; sq += yv * yv; }
            ow_pend.x = pk2(o[0], o[1]); ow_pend.y = pk2(o[2], o[3]); ow_pend.z = pk2(o[4], o[5]); ow_pend.w = pk2(o[6], o[7]);
            sq += __int_as_float(__builtin_amdgcn_update_dpp(0, __float_as_int(sq), 0x104, 0xf, 0xf, true));
            sq += __int_as_float(__builtin_amdgcn_update_dpp(0, __float_as_int(sq), 0x102, 0xf, 0xf, true));
            sq += __int_as_float(__builtin_amdgcn_update_dpp(0, __float_as_int(sq), 0x101, 0xf, 0xf, true)); sq_pend = sq; pend = true; } }
        }
    }
    if (pend) { const size_t prow = row_base + (L - 64) + (tid >> 3); *(v4u*)(YG + prow * 2048 + h * 64 + (tid & 7) * 8) = ow_pend; if ((tid & 7) == 0) SSQ[prow * 32 + h] = sq_pend; }
#define SSD_STOUT(HX, TILE) { float* st_g = st_base + (size_t)(32 * ((TILE) & 1)) * 128 + 32 * ((TILE) >> 1); \
        _Pragma("unroll") for (int q4 = 0; q4 < 4; ++q4) *(f32x4*)(st_g + 8 * q4) = (f32x4){HX[4 * q4], HX[4 * q4 + 1], HX[4 * q4 + 2], HX[4 * q4 + 3]}; }
    if (w == 3) { SSD_STOUT(H0, 0) SSD_STOUT(H1, 1) SSD_STOUT(H2, 2) SSD_STOUT(H3, 3) } else if (w >= 4) { SSD_STOUT(H0, w) }
#undef SSD_STOUT
#undef SSD_UPD
#undef SSD_PUBLISH
    __syncthreads();
}
__device__ __forceinline__ float tr_reduce32(const float (&v)[32], int lane) {
    const bool b4 = lane & 16, b3 = lane & 8, b2 = lane & 4, b1 = lane & 2, b0 = lane & 1;
    float a[16], b[8], c[4], d[2];
#pragma unroll
    for (int i = 0; i < 16; ++i) { const float keep = b4 ? v[i + 16] : v[i], send = b4 ? v[i] : v[i + 16]; a[i] = keep + __shfl_xor(send, 16); }
#pragma unroll
    for (int i = 0; i < 8; ++i) { const float keep = b3 ? a[i + 8] : a[i], send = b3 ? a[i] : a[i + 8]; b[i] = keep + __shfl_xor(send, 8); }
#pragma unroll
    for (int i = 0; i < 4; ++i) { const float keep = b2 ? b[i + 4] : b[i], send = b2 ? b[i] : b[i + 4]; c[i] = keep + __shfl_xor(send, 4); }
#pragma unroll
    for (int i = 0; i < 2; ++i) { const float keep = b1 ? c[i + 2] : c[i], send = b1 ? c[i] : c[i + 2]; d[i] = keep + __shfl_xor(send, 2); }
    const float keep = b0 ? d[1] : d[0], send = b0 ? d[0] : d[1];
    return keep + __shfl_xor(send, 1);
}
__device__ __forceinline__ void ssd_sample_unit(Frame& F, int sb, int g) {
    int tid_o = F.tid; asm volatile("" : "+v"(tid_o));
    const int tid = tid_o, lane = tid & 63, w = F.wave, hh = lane >> 5, nq = lane & 31; unsigned char* ws = F.ws;
    LAS float* XC = (LAS float*)(F.lds + RING_OFF); LAS float* BC = XC + 8 * 4 * 64; LAS float* CC = BC + 4 * 128; LAS float* DTS = CC + 4 * 128;
    const bf16* PROJ = (const bf16*)(ws + WS_PROJ); const float* DTR = (const float*)(ws + WS_DT); bf16* YG = (bf16*)(ws + WS_YG); float* SSQ = (float*)(ws + WS_SSQSSD);
    const size_t row0 = (size_t)TP + (size_t)sb * LS;
    const int h = 8 * g + w;
    const float* sp = F.in[3] + (size_t)(sb * 32 + h) * 8192 + (size_t)hh * 128 + 4 * nq;
    f32x4 hst[32];
#pragma unroll
    for (int i = 0; i < 32; ++i) hst[i] = ld_nt(sp + (size_t)i * 256);
    if (tid < 384) { typedef float f32x2 __attribute__((ext_vector_type(2)));
        const int col = tid < 256 ? g * 512 + 2 * tid : (tid < 320 ? 2048 + g * 128 + 2 * (tid - 256) : 2560 + g * 128 + 2 * (tid - 320));
        const float* cw = F.in[10]; const float* sc = F.in[4] + (size_t)sb * 3 * 3072 + col;
        const f32x2 w0 = *(const f32x2*)(cw + col), w1 = *(const f32x2*)(cw + 3072 + col), w2 = *(const f32x2*)(cw + 2 * 3072 + col), w3 = *(const f32x2*)(cw + 3 * 3072 + col), cb = *(const f32x2*)(F.in[11] + col);
        f32x2 full[7]; full[0] = *(const f32x2*)sc; full[1] = *(const f32x2*)(sc + 3072); full[2] = *(const f32x2*)(sc + 2 * 3072);
        const bf16* cp = PROJ + (size_t)(S_X0 + (col >> 10)) * SLOT_ELEMS + row0 * 1024 + (col & 1023);
#pragma unroll
        for (int t = 0; t < 4; ++t) { const unsigned wd = *(const unsigned*)(cp + (size_t)t * 1024); full[3 + t] = (f32x2){__uint_as_float(wd << 16), __uint_as_float(wd & 0xffff0000u)}; }
#pragma unroll
        for (int t = 0; t < 4; ++t) { f32x2 a = w0 * full[t] + cb; a = w1 * full[t + 1] + a; a = w2 * full[t + 2] + a; a = w3 * full[t + 3] + a;
            f32x2 o; o.x = silu_f(a.x); o.y = silu_f(a.y);
            LAS float* dst = tid < 256 ? XC + ((tid >> 5) * 4 + t) * 64 + 2 * (tid & 31) : (tid < 320 ? BC + t * 128 + 2 * (tid - 256) : CC + t * 128 + 2 * (tid - 320));
            *(LAS f32x2*)dst = o; }
    } else if (tid < 416) { const int idx = tid - 384, hl = idx >> 2, t = idx & 3; const float x = DTR[(row0 + t) * 32 + 8 * g + hl] + F.in[12][8 * g + hl]; DTS[idx] = x > 20.f ? x : log1pf(__expf(x)); }
    __syncthreads();
    const float a = -__expf(F.in[13][h]), Dk = F.in[14][h];
#pragma unroll 1
    for (int t = 0; t < 4; ++t) {
        const float dtv = DTS[w * 4 + t], dA = __expf(dtv * a);
        const f32x4 Bv = *(const LAS f32x4*)(BC + t * 128 + 4 * nq), Cv = *(const LAS f32x4*)(CC + t * 128 + 4 * nq);
        const LAS float* xrow = XC + (w * 4 + t) * 64;
        float part[32];
#pragma unroll
        for (int i = 0; i < 32; ++i) { const float xd = xrow[2 * i + hh] * dtv; hst[i] = hst[i] * dA + Bv * xd; part[i] = (hst[i].x * Cv.x + hst[i].y * Cv.y) + (hst[i].z * Cv.z + hst[i].w * Cv.w); }
        float yv = tr_reduce32(part, lane);
        const int p = 2 * nq + hh; const size_t row = row0 + t;
        yv += Dk * xrow[p];
        const float z = bf2f(PROJ[(size_t)(S_Z0 + (h >> 4)) * SLOT_ELEMS + row * 1024 + (h & 15) * 64 + p]);
        const float yg = yv * silu_f(z);
        YG[row * 2048 + h * 64 + p] = (bf16)f2bf(yg);
        const float sq = wave_sum(yg * yg);
        if (lane == 0) SSQ[row * 32 + h] = sq;
    }
    float* so = F.out + O_SSMS + (size_t)(sb * 32 + h) * 8192 + (size_t)hh * 128 + 4 * nq;
#pragma unroll
    for (int i = 0; i < 32; ++i) st_nt(so + (size_t)i * 256, hst[i]);
    __syncthreads();
}
__device__ __forceinline__ void hgrn_sample_unit(Frame& F, int sb, int hq) {
    int tid_o = F.tid; asm volatile("" : "+v"(tid_o));
    const int tid = tid_o, lane = tid & 63, w = F.wave, hh = lane >> 5, vq = lane & 31; unsigned char* ws = F.ws;
    LAS float* FS = (LAS float*)(F.lds + RING_OFF); LAS float* KS = FS + 2048; LAS float* QS = KS + 2048; LAS float* VS = QS + 2048; LAS float* OP = VS + 2048;
    const bf16* PROJ = (const bf16*)(ws + WS_PROJ); bf16* ON = (bf16*)(ws + WS_ON);
    const size_t row0 = (size_t)TP + (size_t)sb * LS;
    const int hl = w >> 1, kh = w & 1, hd = 4 * hq + hl;
    const float* sp = F.in[5] + (size_t)(sb * 8 + hd) * 16384 + (size_t)(64 * kh + hh) * 128 + 4 * vq;
    f32x4 S[32];
#pragma unroll
    for (int i = 0; i < 32; ++i) S[i] = ld_nt(sp + (size_t)i * 256);
    { const int ch = hq * 512 + tid; const float lb = __builtin_amdgcn_rcpf(1.0f + __expf(F.in[17][1024 + ch] - F.in[17][ch]));
      const bf16* fp = PROJ + (size_t)S_F * SLOT_ELEMS + row0 * 1024 + ch; const bf16* qp = PROJ + (size_t)S_Q * SLOT_ELEMS + row0 * 1024 + ch; const bf16* ip = PROJ + (size_t)S_I * SLOT_ELEMS + row0 * 1024 + ch;
#pragma unroll
      for (int t = 0; t < 4; ++t) { const float u = fminf(fmaxf(bf2f(fp[(size_t)t * 1024]), -30.f), 30.f); const float fg = lb + (1.0f - lb) * sigmoid_f(u);
          const int o = ((tid >> 7) * 4 + t) * 128 + (tid & 127);
          FS[o] = fg; KS[o] = 1.0f - fg; QS[o] = silu_f(bf2f(qp[(size_t)t * 1024])); VS[o] = bf2f(ip[(size_t)t * 1024]); } }
    __syncthreads();
#pragma unroll 1
    for (int t = 0; t < 4; ++t) {
        const int o = (hl * 4 + t) * 128;
        const f32x4 vv = *(const LAS f32x4*)(VS + o + 4 * vq);
        f32x4 oa = (f32x4){0.f, 0.f, 0.f, 0.f};
#pragma unroll
        for (int i = 0; i < 32; ++i) { const int k = 64 * kh + 2 * i + hh; const float fk = FS[o + k], kv = KS[o + k], qk = QS[o + k]; S[i] = S[i] * fk + vv * kv; oa = oa + S[i] * qk; }
        oa.x += __shfl_xor(oa.x, 32); oa.y += __shfl_xor(oa.y, 32); oa.z += __shfl_xor(oa.z, 32); oa.w += __shfl_xor(oa.w, 32);
        if (hh == 0) *(LAS f32x4*)(OP + ((hl * 4 + t) * 2 + kh) * 128 + 4 * vq) = oa;
    }
    float* so = F.out + O_HGS + (size_t)(sb * 8 + hd) * 16384 + (size_t)(64 * kh + hh) * 128 + 4 * vq;
#pragma unroll
    for (int i = 0; i < 32; ++i) st_nt(so + (size_t)i * 256, S[i]);
    __syncthreads();
#pragma unroll
    for (int rr2 = 0; rr2 < 2; ++rr2) { const int rr = 2 * w + rr2, ohl = rr >> 2, t = rr & 3, ohd = 4 * hq + ohl; typedef float f32x2 __attribute__((ext_vector_type(2)));
        const f32x2 p0 = *(const LAS f32x2*)(OP + (rr * 2) * 128 + 2 * lane), p1 = *(const LAS f32x2*)(OP + (rr * 2 + 1) * 128 + 2 * lane);
        const float o0 = p0.x + p1.x, o1 = p0.y + p1.y; const float sq = wave_sum(o0 * o0 + o1 * o1); const float rs = __builtin_amdgcn_rsqf(sq * (1.0f / 128.0f) + EPS);
        const size_t row = row0 + t; const unsigned gw = *(const unsigned*)(PROJ + (size_t)S_HG * SLOT_ELEMS + row * 1024 + ohd * 128 + 2 * lane);
        *(unsigned*)(ON + row * 1024 + ohd * 128 + 2 * lane) = pk2(o0 * rs * silu_f(bf2f(gw & 0xffffu)), o1 * rs * silu_f(__uint_as_float(gw & 0xffff0000u))); }
    __syncthreads();
}
constexpr int U_HGS = NBS * 2, U_SSDS = NBS * 4, U_CONV = NBP + NBS;
__device__ __forceinline__ void scan_phase(Frame& F) {
    gu32* head = F.ctl + CW_QUEUE;
#define SCAN_QUEUE(qi, count, body) for (;;) { if (F.tid == 0) F.MISC[0] = __hip_atomic_fetch_add(head + 64 * (qi), 1u, RLX_AGENT); __syncthreads(); const int u = (int)F.MISC[0]; __syncthreads(); if (u >= (count)) break; body }
    SCAN_QUEUE(1, NBP * 32, ssd_unit_mfma(F, u >> 5, u & 31);)
    SCAN_QUEUE(0, NBP * 32, hgrn_v_unit(F, u >> 5, (u >> 2) & 7, u & 3);)
    SCAN_QUEUE(2, U_HGS, hgrn_sample_unit(F, u >> 1, u & 1);)
    SCAN_QUEUE(3, U_SSDS + U_CONV, if (u >= U_SSDS) { conv_copy_unit(F, u - U_SSDS); continue; } ssd_sample_unit(F, u >> 2, u & 3);)
#undef SCAN_QUEUE
}
typedef float f32x4s __attribute__((ext_vector_type(4)));
template <class Epi> __device__ __forceinline__ void small_tile_phase(Frame& F, const bf16* A, const bf16* Bt, int K, const Epi& E) {
    const int lane = F.lane, w = F.wave, r = lane & 31, hh = lane >> 5;
#pragma unroll 1
    for (int v = F.vcu; v < 256; v += F.G) {
    const int mt = v >> 4, nt = v & 15;
    const int kw = K >> 3;
    const bf16* ap = A + (size_t)(TP + 32 * mt + r) * K + w * kw + 8 * hh;
    const bf16* bp = Bt + (size_t)(64 * nt + r) * K + w * kw + 8 * hh;
    f32x16 acc0, acc1;
#pragma unroll
    for (int i = 0; i < 16; ++i) { acc0[i] = 0.f; acc1[i] = 0.f; }
#pragma unroll 4
    for (int ks = 0; ks < kw / 16; ++ks) { const bf16x8 af = *(const bf16x8*)(ap + 16 * ks), b0 = *(const bf16x8*)(bp + 16 * ks), b1 = *(const bf16x8*)(bp + (size_t)32 * K + 16 * ks);
        acc0 = MFMA32(b0, af, acc0); acc1 = MFMA32(b1, af, acc1); }
    LAS float* part = (LAS float*)(F.lds + RING_OFF) + w * 2048;
#pragma unroll
    for (int q4 = 0; q4 < 4; ++q4) { *(LAS f32x4*)(part + r * 64 + 8 * q4 + 4 * hh) = (f32x4){acc0[4 * q4], acc0[4 * q4 + 1], acc0[4 * q4 + 2], acc0[4 * q4 + 3]};
        *(LAS f32x4*)(part + r * 64 + 32 + 8 * q4 + 4 * hh) = (f32x4){acc1[4 * q4], acc1[4 * q4 + 1], acc1[4 * q4 + 2], acc1[4 * q4 + 3]}; }
    __syncthreads();
    const int rl = F.tid >> 4, c4 = (F.tid & 15) * 4; const LAS float* src = (const LAS float*)(F.lds + RING_OFF) + rl * 64 + c4;
    f32x4 sum = *(const LAS f32x4*)src;
#pragma unroll
    for (int ww = 1; ww < 8; ++ww) sum = sum + *(const LAS f32x4*)(src + ww * 2048);
    const f32x4s acc = (f32x4s){sum.x, sum.y, sum.z, sum.w};
    E.small(F, acc, TP + 32 * mt + rl, 64 * nt + c4, nt);
    __syncthreads();
    }
}
template <bool ADD> struct SmGate { bf16* O; const bf16* gate;
    __device__ __forceinline__ void small(Frame&, const f32x4s& a, int row, int col, int) const { const size_t off = (size_t)row * 1024 + col;
        const v2u gw = __builtin_nontemporal_load((const v2u*)(gate + off)); v2u ow = (v2u){0u, 0u}; if (ADD) ow = *(const v2u*)(O + off);
        float rr[4];
#pragma unroll
        for (int e = 0; e < 4; ++e) { const unsigned g16 = (gw[e >> 1] >> ((e & 1) * 16)) & 0xffffu, o16 = (ow[e >> 1] >> ((e & 1) * 16)) & 0xffffu; rr[e] = (ADD ? bf2f(o16) : 0.f) + sigmoid_f(bf2f(g16)) * a[e]; }
        v2u wv; wv.x = cvtpk_c(rr[0], rr[1]); wv.y = cvtpk_c(rr[2], rr[3]); *(v2u*)(O + off) = wv; } };
template <bool BF, bool BSC = false> struct SmRes { const float* base; const bf16* bb; bf16* hb; float* ssqp; const float* bsc;
    __device__ __forceinline__ void small(Frame& F, const f32x4s& a, int row, int col, int nt) const { const size_t off = (size_t)row * 1024 + col; f32x4 b;
        if (BF) { const v2u w = *(const v2u*)(bb + off); b = (f32x4){bf2f(w.x & 0xffffu), __uint_as_float(w.x & 0xffff0000u), bf2f(w.y & 0xffffu), __uint_as_float(w.y & 0xffff0000u)}; }
        else b = *(const f32x4*)(base + off);
        if constexpr (BSC) b = b * bsc[row];
        const f32x4 v = b + (f32x4){a[0], a[1], a[2], a[3]};
        { v2u wv; wv.x = cvtpk_c(v[0], v[1]); wv.y = cvtpk_c(v[2], v[3]); *(v2u*)(hb + off) = wv; }
        float sq = (v[0] * v[0] + v[1] * v[1]) + (v[2] * v[2] + v[3] * v[3]); sq += __shfl_xor(sq, 1); sq += __shfl_xor(sq, 2); sq += __shfl_xor(sq, 4); sq += __shfl_xor(sq, 8);
        if ((F.tid & 15) == 0) ssqp[(size_t)row * 16 + nt] = sq; } };
struct SmScale { bf16* O; const float* ssq; float scale;
    __device__ __forceinline__ void small(Frame&, const f32x4s& a, int row, int col, int) const { const float rs = pg8::row_rs<16>(ssq, row) * scale;
        v2u wv; wv.x = cvtpk_c(a[0] * rs, a[1] * rs); wv.y = cvtpk_c(a[2] * rs, a[3] * rs); *(v2u*)(O + (size_t)row * 1024 + col) = wv; } };
__device__ __forceinline__ void attn_stage_tile(LAS unsigned char* Lb, const bf16* src, size_t pitch, int tid) {
#pragma unroll 1
    for (int hb = 0; hb < 2; ++hb) { v4u v[8];
#pragma unroll
        for (int i = 0; i < 8; ++i) { const int id = tid + 512 * (8 * hb + i), row = id >> 5, c = id & 31; v[i] = *(const v4u*)(src + (size_t)row * pitch + c * 8); }
#pragma unroll
        for (int i = 0; i < 8; ++i) { const int id = tid + 512 * (8 * hb + i), row = id >> 5, c = id & 31; *(LAS v4u*)(Lb + row * 512 + ((c ^ (row & 15)) << 4)) = v[i]; } }
}
__device__ __forceinline__ void attn_prompt_unit(Frame& F, int b, int hd, int qb) {
    const int tid = F.tid, lane = F.lane, w = F.wave, r = lane & 31, hh = lane >> 5; unsigned char* ws = F.ws;
    LAS unsigned char* Lb = F.lds + RING_OFF;
    const bf16* QB = (const bf16*)(ws + WS_QB); const bf16* KB = (const bf16*)(ws + WS_KB); const bf16* VT = (const bf16*)(ws + WS_VT); bf16* OB = (bf16*)(ws + WS_OB);
    const size_t qrow = (size_t)b * SEQ + (size_t)qb * 256 + 32 * w + r;
    attn_stage_tile(Lb, KB + (size_t)b * 256 * 1024 + hd * 256, 1024, tid);
    const bf16* qp = QB + qrow * 1024 + hd * 256 + 8 * hh;
    bf16x8 qf = *(const bf16x8*)qp;
    __syncthreads();
    f32x16 S[8];
#pragma unroll
    for (int t = 0; t < 8; ++t)
#pragma unroll
        for (int i = 0; i < 16; ++i) S[t][i] = 0.f;
    const int sw = r & 15;
#pragma unroll 1
    for (int ks = 0; ks < 16; ++ks) {
        const bf16x8 qn = *(const bf16x8*)(qp + 16 * (ks < 15 ? ks + 1 : ks));
        const LAS unsigned char* kp = Lb + r * 512 + (((2 * ks + hh) ^ sw) << 4);
#pragma unroll
        for (int t = 0; t < 8; ++t) S[t] = MFMA32(lds_frag16(kp + t * 32 * 512), qf, S[t]);
        qf = qn;
    }
    float m = -3.0e38f;
#pragma unroll
    for (int t = 0; t < 8; ++t)
#pragma unroll
        for (int i = 0; i < 16; ++i) m = fmaxf(m, S[t][i]);
    m = fmaxf(m, __shfl_xor(m, 32));
    float l = 0.f;
#pragma unroll
    for (int t = 0; t < 8; ++t)
#pragma unroll
        for (int i = 0; i < 16; ++i) { const float pv = __builtin_amdgcn_exp2f(S[t][i] - m); S[t][i] = pv; l += pv; }
    l += __shfl_xor(l, 32);
    const float rl = __builtin_amdgcn_rcpf(l);
    bf16x8 pf[8][2];
#pragma unroll
    for (int t = 0; t < 8; ++t) { pf[t][0] = ACC_FRAG(S[t], 0); pf[t][1] = ACC_FRAG(S[t], 1); }
    __syncthreads();
    attn_stage_tile(Lb, VT + (size_t)(b * 4 + hd) * 256 * 256, 256, tid);
    __syncthreads();
    bf16* op = OB + qrow * 1024 + hd * 256 + 4 * hh;
#pragma unroll 1
    for (int dt = 0; dt < 8; ++dt) {
        f32x16 O;
#pragma unroll
        for (int i = 0; i < 16; ++i) O[i] = 0.f;
        const LAS unsigned char* vrow = Lb + (32 * dt + r) * 512 + 8 * hh;
#pragma unroll
        for (int t = 0; t < 8; ++t)
#pragma unroll
            for (int s2 = 0; s2 < 2; ++s2) {
                const v2u lo = *(const LAS v2u*)(vrow + (((4 * t + 2 * s2) ^ sw) << 4)), hi = *(const LAS v2u*)(vrow + (((4 * t + 2 * s2 + 1) ^ sw) << 4));
                const v4u wv4 = (v4u){lo.x, lo.y, hi.x, hi.y};
                O = MFMA32(__builtin_bit_cast(bf16x8, wv4), pf[t][s2], O);
            }
#pragma unroll
        for (int q4 = 0; q4 < 4; ++q4) { v2u o; o.x = cvtpk_c(O[4 * q4] * rl, O[4 * q4 + 1] * rl); o.y = cvtpk_c(O[4 * q4 + 2] * rl, O[4 * q4 + 3] * rl);
            *(v2u*)(op + 32 * dt + 8 * q4) = o; }
    }
    __syncthreads();
}
__device__ __forceinline__ void attn_sample_unit(Frame& F, int sb, int hd) {
    const int tid = F.tid, lane = F.lane, w = F.wave; unsigned char* ws = F.ws;
    LAS float* sc = (LAS float*)(F.lds + RING_OFF);
    LAS float* red = sc + 4 * 256;
    const bf16* QB = (const bf16*)(ws + WS_QB); bf16* OB = (bf16*)(ws + WS_OB);
    const size_t rowq = (size_t)TP + (size_t)sb * LS;
    float q[4][4];
#pragma unroll
    for (int t = 0; t < 4; ++t) { const v2u qw = *(const v2u*)(QB + (rowq + t) * 1024 + hd * 256 + 4 * lane); q[t][0] = bf2f(qw.x & 0xffffu); q[t][1] = bf2f(qw.x >> 16); q[t][2] = bf2f(qw.y & 0xffffu); q[t][3] = bf2f(qw.y >> 16); }
    const float* Kc = F.in[6] + ((size_t)sb * 256 * 4 + hd) * 256 + 4 * lane; const float* Vc = F.in[7] + ((size_t)sb * 256 * 4 + hd) * 256 + 4 * lane;
    f32x4 kv[8], kn[8];
#pragma unroll
    for (int u = 0; u < 8; ++u) kv[u] = ld_nt(Kc + (size_t)(w * 32 + u) * 1024);
#pragma unroll 1
    for (int kk0 = 0; kk0 < 32; kk0 += 8) {
#pragma unroll
        for (int u = 0; u < 8; ++u) kn[u] = kk0 < 24 ? ld_nt(Kc + (size_t)(w * 32 + kk0 + 8 + u) * 1024) : ld_nt(Vc + (size_t)(w * 32 + u) * 1024);
        { float part[32];
#pragma unroll
          for (int u = 0; u < 8; ++u)
#pragma unroll
              for (int t = 0; t < 4; ++t) part[4 * u + t] = (q[t][0] * kv[u].x + q[t][1] * kv[u].y) + (q[t][2] * kv[u].z + q[t][3] * kv[u].w);
          float sv = tr_reduce32(part, lane); sv += __shfl_xor(sv, 32);
          if (lane < 32) sc[(lane & 3) * 256 + w * 32 + kk0 + (lane >> 2)] = sv; }
#pragma unroll
        for (int u = 0; u < 8; ++u) kv[u] = kn[u]; }
    __syncthreads();
    if (w < 4) { float v[4]; float m = -3.0e38f;
#pragma unroll
        for (int j = 0; j < 4; ++j) { v[j] = sc[w * 256 + j * 64 + lane]; m = fmaxf(m, v[j]); }
        m = wave_max(m); float l = 0.f;
#pragma unroll
        for (int j = 0; j < 4; ++j) { v[j] = __builtin_amdgcn_exp2f(v[j] - m); l += v[j]; }
        l = wave_sum(l); const float rl = 1.0f / l;
#pragma unroll
        for (int j = 0; j < 4; ++j) sc[w * 256 + j * 64 + lane] = v[j] * rl; }
    __syncthreads();
    float o[4][4];
#pragma unroll
    for (int t = 0; t < 4; ++t)
#pragma unroll
        for (int e = 0; e < 4; ++e) o[t][e] = 0.f;
#pragma unroll 1
    for (int kk0 = 0; kk0 < 32; kk0 += 8) {
        if (kk0 < 24) {
#pragma unroll
            for (int u = 0; u < 8; ++u) kn[u] = ld_nt(Vc + (size_t)(w * 32 + kk0 + 8 + u) * 1024); }
#pragma unroll
        for (int u = 0; u < 8; ++u) { const int key = w * 32 + kk0 + u;
#pragma unroll
            for (int t = 0; t < 4; ++t) { const float pr = sc[t * 256 + key]; o[t][0] += pr * kv[u].x; o[t][1] += pr * kv[u].y; o[t][2] += pr * kv[u].z; o[t][3] += pr * kv[u].w; } }
#pragma unroll
        for (int u = 0; u < 8; ++u) kv[u] = kn[u]; }
#pragma unroll
    for (int t = 0; t < 4; ++t) *(LAS f32x4*)(red + (w * 4 + t) * 256 + 4 * lane) = (f32x4){o[t][0], o[t][1], o[t][2], o[t][3]};
    __syncthreads();
    { const int t = tid >> 7, d0 = (tid & 127) * 2; float a0 = 0.f, a1 = 0.f;
#pragma unroll
      for (int ww = 0; ww < 8; ++ww) { a0 += red[(ww * 4 + t) * 256 + d0]; a1 += red[(ww * 4 + t) * 256 + d0 + 1]; }
      *(unsigned*)(OB + (rowq + t) * 1024 + hd * 256 + d0) = pk2(a0, a1); }
    __syncthreads();
}
__device__ __forceinline__ void attn_phase(Frame& F) {
    const bool sample_first = (blockIdx.x >> 3) & 1;
    for (int pass = 0; pass < 2; ++pass) {
        if ((pass == 0) != sample_first) { for (int u = F.vcu; u < NBP * 4 * 8; u += F.G) attn_prompt_unit(F, u >> 5, (u >> 3) & 3, u & 7); }
        else { for (int u = F.vcu; u < NBS * 4; u += F.G) attn_sample_unit(F, u >> 2, u & 3); }
    }
}
__device__ __forceinline__ void final_norm_phase(Frame& F) {
    const int gw = F.vcu * NWAVES + F.wave, NGW = F.G * NWAVES; const float* SSQ = (const float*)(F.ws + WS_SSQP3); const float* wn = F.in[31]; const bf16* HB = (const bf16*)(F.ws + WS_HB);
    f32x4 wv[4];
#pragma unroll
    for (int j = 0; j < 2; ++j) { wv[2 * j] = *((const f32x4*)wn + 2 * (64 * j + F.lane)); wv[2 * j + 1] = *((const f32x4*)wn + 2 * (64 * j + F.lane) + 1); }
    for (int row = gw; row < T; row += NGW) {
        const f32x4* sp = (const f32x4*)(SSQ + (size_t)row * 16); float s = 0.f;
#pragma unroll
        for (int j = 0; j < 4; ++j) { const f32x4 a = sp[j]; s += (a.x + a.y) + (a.z + a.w); }
        const float rs = __builtin_amdgcn_rsqf(s * (1.0f / 1024.0f) + EPS);
#pragma unroll
        for (int j = 0; j < 2; ++j) { const int pc = 64 * j + F.lane; const v4u w = ld_nt16((const v4u*)(HB + (size_t)row * 1024) + pc);
            const f32x4 v0 = (f32x4){bf2f(w.x & 0xffffu), __uint_as_float(w.x & 0xffff0000u), bf2f(w.y & 0xffffu), __uint_as_float(w.y & 0xffff0000u)};
            const f32x4 v1 = (f32x4){bf2f(w.z & 0xffffu), __uint_as_float(w.z & 0xffff0000u), bf2f(w.w & 0xffffu), __uint_as_float(w.w & 0xffff0000u)};
            float* o = F.out + O_Y + (size_t)row * 1024 + 8 * pc; st_nt(o, v0 * rs * wv[2 * j]); st_nt(o + 4, v1 * rs * wv[2 * j + 1]); }
    }
}
#ifndef MK_N_LAUNCHES
#define MK_N_LAUNCHES 1
#endif
constexpr int PER_PHASE = 13;
constexpr int N_LAUNCHES = MK_N_LAUNCHES;
struct Args { const float* in[32]; float* out; unsigned char* ws; int ph_lo, ph_hi; };
__global__ void __launch_bounds__(NTHR, 2) skel_fwd(Args args) {
    extern __shared__ __attribute__((aligned(16))) unsigned char lds[];
    Frame F;
    F.lds = (LAS unsigned char*)lds;
    F.MISC = (volatile LAS unsigned*)(F.lds + MISC_OFF);
    F.tid = threadIdx.x; F.lane = F.tid & 63; F.wave = __builtin_amdgcn_readfirstlane(F.tid >> 6);
    F.G = gridDim.x; { const int bx = blockIdx.x; F.vcu = (F.G % 8 == 0) ? (bx % 8) * (F.G / 8) + bx / 8 : bx; }
    unsigned char* ws = args.ws; F.ws = ws; F.out = args.out;
    F.ctl = (gu32*)(ws + WS_CTL);
#pragma unroll
    for (int i = 0; i < 32; ++i) F.in[i] = args.in[i];
    for (int u = F.tid; u < (LDS_BYTES - LDSCTL_OFF) / 4; u += NTHR) ((LAS unsigned*)(F.lds + LDSCTL_OFF))[u] = 0u;
    __syncthreads();
    XcdBarrier bar; bar.bar = (unsigned*)(F.ctl + CW_BAR); bar.x = 0; bar.st = nullptr;
    if (N_LAUNCHES == 1) bar = xcd_barrier_post((unsigned*)(F.ctl + CW_BAR), F.MISC + 8);
#define GRID_BAR() do { if (N_LAUNCHES == 1) xcd_barrier(bar); } while (0)
    const int lo = args.ph_lo, hi = args.ph_hi;
#ifdef ONLY_PHASE
#define IN(k) ((k) == ONLY_PHASE && lo <= (k) && (k) < hi)
#else
#define IN(k) (lo <= (k) && (k) < hi)
#endif
#define BOTH(k) (IN(k) && IN((k) + 1))
    bf16* const XB = (bf16*)(ws + WS_XB); bf16* const PROJ = (bf16*)(ws + WS_PROJ);
    float* const Y = F.out + O_Y;
    if (IN(0)) { p0_prologue(F); if (BOTH(0)) GRID_BAR(); }
    if (IN(1)) {
        { pg8::Gemm g{XB, (const bf16*)(ws + WS_WIN), T, NPROJ, 1024}; pg8::StaticOrder S; S.init(T, NPROJ, F.G, (int)blockIdx.x);
          pg8::EpiScaleBf16<0, true> E{PROJ, SLOT_ELEMS, nullptr, 1.0f, (float*)(ws + WS_DT)};
          pg8::gemm_phase<pg8::EpiScaleBf16<0, true>, pg8::StaticOrder, true, true>(F.lds + RING_OFF, g, S, E); }
        { pg8::Gemm g{(const bf16*)(ws + WS_MNB), (const bf16*)(ws + WS_WKV), MEMR, 2048, 1024}; pg8::StaticOrder S; S.init(MEMR, 2048, F.G, (int)((blockIdx.x + 64) % F.G));
          pg8::EpiKV E{F.out + O_MKP, F.out + O_MVP, (bf16*)(ws + WS_KB), (bf16*)(ws + WS_VT), (const float*)(ws + WS_SSQM)};
          pg8::gemm_phase<pg8::EpiKV, pg8::StaticOrder, true, true>(F.lds + RING_OFF, g, S, E); }
        if (BOTH(1)) GRID_BAR();
    }
    if (IN(2)) { bc_prep_phase(F); hg_prep_phase(F); if (BOTH(2)) GRID_BAR(); }
    if (IN(3)) { scan_phase(F); if (BOTH(3)) GRID_BAR(); }
    if (IN(4)) { ssdnorm_phase(F); hgnorm_phase(F); if (BOTH(4)) GRID_BAR(); }
    if (IN(5)) { { SmGate<false> Es{(bf16*)(ws + WS_MERGED), PROJ + (size_t)S_GS * SLOT_ELEMS}; small_tile_phase(F, (const bf16*)(ws + WS_YG), (const bf16*)(ws + WS_WSSD), 2048, Es); }
        pg8::Gemm g{(const bf16*)(ws + WS_YG), (const bf16*)(ws + WS_WSSD), TP, 1024, 2048}; pg8::StaticOrder S; S.init(TP, 1024, F.G, (int)blockIdx.x);
        pg8::EpiGate<false> E{(bf16*)(ws + WS_MERGED), PROJ + (size_t)S_GS * SLOT_ELEMS};
        pg8::gemm_phase<pg8::EpiGate<false>, pg8::StaticOrder, true, true>(F.lds + RING_OFF, g, S, E);
          }
    if (IN(5)) { { SmGate<true> Es{(bf16*)(ws + WS_MERGED), PROJ + (size_t)S_GH * SLOT_ELEMS}; small_tile_phase(F, (const bf16*)(ws + WS_ON), (const bf16*)(ws + WS_WHG), 1024, Es); }
        pg8::Gemm g{(const bf16*)(ws + WS_ON), (const bf16*)(ws + WS_WHG), TP, 1024, 1024}; pg8::StaticOrder S; S.init(TP, 1024, F.G, (int)blockIdx.x);
        pg8::EpiGate<true> E{(bf16*)(ws + WS_MERGED), PROJ + (size_t)S_GH * SLOT_ELEMS};
        pg8::gemm_phase<pg8::EpiGate<true>, pg8::StaticOrder, true, true>(F.lds + RING_OFF, g, S, E);
        if (BOTH(5)) GRID_BAR(); }
    if (IN(6)) { { SmRes<true, true> Es{nullptr, XB, (bf16*)(ws + WS_HB), (float*)(ws + WS_SSQP1), (const float*)(ws + WS_SSQX)}; small_tile_phase(F, (const bf16*)(ws + WS_MERGED), (const bf16*)(ws + WS_WOUT), 1024, Es); }
        pg8::Gemm g{(const bf16*)(ws + WS_MERGED), (const bf16*)(ws + WS_WOUT), TP, 1024, 1024}; pg8::StaticOrder S; S.init(TP, 1024, F.G, (int)blockIdx.x);
        pg8::EpiRes<true, true> E{nullptr, nullptr, XB, (bf16*)(ws + WS_HB), (float*)(ws + WS_SSQP1), (const float*)(ws + WS_SSQX)};
        pg8::gemm_phase<pg8::EpiRes<true, true>, pg8::StaticOrder, true, true>(F.lds + RING_OFF, g, S, E);
        if (BOTH(6)) GRID_BAR(); }
    if (IN(7)) { { SmScale Es{(bf16*)(ws + WS_QB), (const float*)(ws + WS_SSQP1), QSCALE}; small_tile_phase(F, (const bf16*)(ws + WS_HB), (const bf16*)(ws + WS_WCQ), 1024, Es); }
        pg8::Gemm g{(const bf16*)(ws + WS_HB), (const bf16*)(ws + WS_WCQ), TP, 1024, 1024}; pg8::StaticOrder S; S.init(TP, 1024, F.G, (int)blockIdx.x);
        pg8::EpiScaleBf16<16, false> E{(bf16*)(ws + WS_QB), SLOT_ELEMS, (const float*)(ws + WS_SSQP1), QSCALE, nullptr};
        pg8::gemm_phase<pg8::EpiScaleBf16<16, false>, pg8::StaticOrder, true, true>(F.lds + RING_OFF, g, S, E);
        if (BOTH(7)) GRID_BAR(); }
    if (IN(8)) { attn_phase(F); if (BOTH(8)) GRID_BAR(); }
    if (IN(9)) { { SmRes<true> Es{nullptr, (const bf16*)(ws + WS_HB), (bf16*)(ws + WS_HB), (float*)(ws + WS_SSQP2)}; small_tile_phase(F, (const bf16*)(ws + WS_OB), (const bf16*)(ws + WS_WCO), 1024, Es); }
        pg8::Gemm g{(const bf16*)(ws + WS_OB), (const bf16*)(ws + WS_WCO), TP, 1024, 1024}; pg8::StaticOrder S; S.init(TP, 1024, F.G, (int)blockIdx.x);
        pg8::EpiRes<true> E{nullptr, nullptr, (const bf16*)(ws + WS_HB), (bf16*)(ws + WS_HB), (float*)(ws + WS_SSQP2)};
        pg8::gemm_phase<pg8::EpiRes<true>, pg8::StaticOrder, true, true>(F.lds + RING_OFF, g, S, E);
        if (BOTH(9)) GRID_BAR(); }
    if (IN(10)) { pg8::Gemm g{(const bf16*)(ws + WS_HB), (const bf16*)(ws + WS_WGU), T, 2 * FFN, 1024}; pg8::StaticOrder S; S.init(T, 2 * FFN, F.G, (int)blockIdx.x);
        pg8::EpiSwiglu E{(bf16*)(ws + WS_ACT), (const float*)(ws + WS_SSQP2)};
        pg8::gemm_phase<pg8::EpiSwiglu, pg8::StaticOrder, true, true>(F.lds + RING_OFF, g, S, E);
        if (BOTH(10)) GRID_BAR(); }
    if (IN(11)) { { SmRes<true> Es{nullptr, (const bf16*)(ws + WS_HB), (bf16*)(ws + WS_HB), (float*)(ws + WS_SSQP3)}; small_tile_phase(F, (const bf16*)(ws + WS_ACT), (const bf16*)(ws + WS_WDN), FFN, Es); }
        pg8::Gemm g{(const bf16*)(ws + WS_ACT), (const bf16*)(ws + WS_WDN), TP, 1024, FFN}; pg8::StaticOrder S; S.init(TP, 1024, F.G, (int)blockIdx.x);
        pg8::EpiRes<true> E{nullptr, nullptr, (const bf16*)(ws + WS_HB), (bf16*)(ws + WS_HB), (float*)(ws + WS_SSQP3)};
        pg8::gemm_phase<pg8::EpiRes<true>, pg8::StaticOrder, true, true>(F.lds + RING_OFF, g, S, E);
        if (BOTH(11)) GRID_BAR(); }
    if (IN(12)) final_norm_phase(F);
#undef IN
#undef BOTH
}

extern "C" void kernel_launch(void* const* d_in, const int* in_sizes, int n_in, void* d_out, int out_size, void* d_ws, size_t ws_size, hipStream_t stream) {
    static int grid = 0;
    if (grid == 0) {
        const int want[32] = {TP * 1024, TS * 1024, MEMR * 1024, 33554432, 1179648, 16777216, 33554432, 33554432, 1024, 1024 * 11296, 4 * 3072, 3072, 32, 32, 32, 2048, 2048 * 1024, 2048, 1024,
                              1024 * 1024, 1024 * 1024, 1024, 1024, 1024 * 1024, 1024 * 1024, 1024 * 1024, 1024 * 1024, 1024, 1024 * FFN, 1024 * FFN, FFN * 1024, 1024};
        bool ok = (n_in == 32); for (int i = 0; ok && i < 32; ++i) if (in_sizes[i] != want[i]) { fprintf(stderr, "kernel_launch: input %d has %d elements, expected %d\n", i, in_sizes[i], want[i]); ok = false; }
        if (!ok || out_size != (int)O_END || ws_size < WS_END4) { fprintf(stderr, "kernel_launch: unexpected shapes: n_in %d out %d ws %zu\n", n_in, out_size, ws_size); grid = -1; return; }
        int dev = 0, cus = 0, per_cu = 0;
        if (hipGetDevice(&dev) != hipSuccess || hipDeviceGetAttribute(&cus, hipDeviceAttributeMultiprocessorCount, dev) != hipSuccess) { grid = -1; return; }
        if (hipFuncSetAttribute((const void*)skel_fwd, hipFuncAttributeMaxDynamicSharedMemorySize, LDS_BYTES) != hipSuccess) { fprintf(stderr, "kernel_launch: hipFuncSetAttribute failed\n"); grid = -1; return; }
        if (hipOccupancyMaxActiveBlocksPerMultiprocessor(&per_cu, (const void*)skel_fwd, NTHR, LDS_BYTES) != hipSuccess || per_cu < 1) fprintf(stderr, "kernel_launch: occupancy query reports %d blocks per CU\n", per_cu);
        (void)hipGetLastError();
        grid = cus;
    }
    if (grid < 0) return;
    (void)hipMemsetAsync((char*)d_ws + WS_CTL, 0, CTL_ZERO_BYTES, stream);
    Args a{};
    for (int i = 0; i < 32; ++i) a.in[i] = (const float*)d_in[i];
    a.out = (float*)d_out; a.ws = (unsigned char*)d_ws;
    for (int li = 0; li < N_LAUNCHES; ++li) {
        a.ph_lo = (N_LAUNCHES == PER_PHASE) ? li : 0; a.ph_hi = (N_LAUNCHES == PER_PHASE) ? li + 1 : PER_PHASE;
        hipLaunchKernelGGL(skel_fwd, dim3(grid), dim3(NTHR), LDS_BYTES, stream, a);
    }
}
```

```cpp
#include <hip/hip_runtime.h>
#include <cstdio>
#include <cstdint>
namespace pg8 {
#define PG8_LAS __attribute__((address_space(3)))
typedef unsigned short bf16_t;
typedef short bf16x8 __attribute__((ext_vector_type(8)));
typedef float f32x4 __attribute__((ext_vector_type(4)));
typedef unsigned u32x4 __attribute__((ext_vector_type(4)));
constexpr int BM = 256, BK = 64, HALF = 128, HTB = HALF * BK * 2  , STAGE_BYTES = 8 * HTB, NXCD = 8, WGM = 8;

__host__ __device__ __forceinline__ int lds_byte(int r, int c) { const int st = (r >> 4) * 2 + (c >> 5), rr = r & 15, cc = c & 31, ob = rr * 64 + cc * 2; return st * 1024 + (ob ^ (((ob >> 9) & 1) << 5)); }
__host__ __device__ __forceinline__ void stage_rc(int b, int& R, int& C) { const int st = b / 1024, sb = b % 1024, swz = sb ^ (((sb >> 9) & 1) << 5); R = (st >> 1) * 16 + swz / 64; C = (st & 1) * 32 + (swz % 64) / 2; }
__host__ __device__ __forceinline__ int perm32(int rho) { const int n = rho >> 4, i = rho & 15; return 8 * (i >> 2) + 4 * n + (i & 3); }

struct Unit { int pm, pn; };
struct Gemm { const bf16_t* A; const bf16_t* Bt; int M, N, K; };

struct StaticOrder {
    int nM, nN, nwg, G, c;
    __host__ __device__ void init(int M, int N, int G_, int c_) { nM = M / BM; nN = N / BM; nwg = nM * nN; G = G_; c = c_; }
    __host__ __device__ bool next(int i, Unit& u) const {
        const long L = (long)i * G + c; if (L >= nwg) return false;
        int wgid = (int)L; { const int q = nwg / NXCD, r = nwg % NXCD, xcd = wgid % NXCD, off = wgid / NXCD; wgid = (xcd < r ? xcd * (q + 1) : r * (q + 1) + (xcd - r) * q) + off; }
        const int nig = WGM * nN, gid = wgid / nig, fm = gid * WGM, gsz = (nM - fm) < WGM ? (nM - fm) : WGM;
        u.pm = fm + ((wgid % nig) % gsz); u.pn = (wgid % nig) / gsz; return true;
    }
    __device__ __forceinline__ void a_ready(const Unit&) const {}
    __device__ __forceinline__ void done(const Unit&) const {}
};

__device__ __forceinline__ unsigned cvt_pk_bf16(float lo, float hi) { unsigned r; asm volatile("v_cvt_pk_bf16_f32 %0, %1, %2" : "=v"(r) : "v"(lo), "v"(hi)); return r; }
typedef float f32x2 __attribute__((ext_vector_type(2)));
typedef unsigned u32x2 __attribute__((ext_vector_type(2)));
constexpr float RMS_EPS = 1e-6f;
__device__ __forceinline__ float bfbits2f(unsigned v16) { return __uint_as_float(v16 << 16); }
__device__ __forceinline__ float sigm(float x) { return __builtin_amdgcn_rcpf(1.0f + __expf(-x)); }
template <int NP> __device__ __forceinline__ float row_rs(const float* ssq, int row) {
    float s = 0.f;
    if constexpr (NP == 1) s = ssq[row];
    else {
#pragma unroll
        for (int i = 0; i < NP / 4; ++i) { const f32x4 v = *(const f32x4*)(ssq + (size_t)row * NP + 4 * i); s += (v[0] + v[1]) + (v[2] + v[3]); }
    }
    return 1.0f / sqrtf(s * (1.0f / 1024.0f) + RMS_EPS);
}
template <int NP, bool HAS_DT> struct EpiScaleBf16 {
    static constexpr bool PERM = true, AFTER_DRAIN = false;
    bf16_t* O; size_t slot_elems; const float* ssq; float scale; float* dt;
    __device__ __forceinline__ void operator()(const f32x4 (&acc)[2][2][4][2], const Unit& u, int wr, int wc, int fr, int fq) const {
        const int row0 = u.pm * BM + wr * 64 + fr;
        if (HAS_DT && u.pn == 44) {
            if (wc == 0) {
#pragma unroll
                for (int ai = 0; ai < 2; ++ai)
#pragma unroll
                    for (int m = 0; m < 4; ++m) { const int row = row0 + ai * HALF + m * 16; float rs = 1.0f; if constexpr (NP > 0) rs = row_rs<NP>(ssq, row);
                        float* p = dt + (size_t)row * 32 + 8 * fq; *(f32x4*)p = acc[ai][0][m][0] * rs; *(f32x4*)(p + 4) = acc[ai][0][m][1] * rs; }
            }
            return;
        }
        bf16_t* base = O + (size_t)(u.pn >> 2) * slot_elems; const int col0 = (u.pn & 3) * BM + wc * 32 + 8 * fq;
#pragma unroll
        for (int ai = 0; ai < 2; ++ai)
#pragma unroll
            for (int m = 0; m < 4; ++m) { const int row = row0 + ai * HALF + m * 16; float rs = scale; if constexpr (NP > 0) rs = row_rs<NP>(ssq, row) * scale; bf16_t* rowp = base + (size_t)row * 1024 + col0;
#pragma unroll
                for (int bj = 0; bj < 2; ++bj) { const f32x4 v0 = acc[ai][bj][m][0] * rs, v1 = acc[ai][bj][m][1] * rs;
                    u32x4 w; w.x = cvt_pk_bf16(v0[0], v0[1]); w.y = cvt_pk_bf16(v0[2], v0[3]); w.z = cvt_pk_bf16(v1[0], v1[1]); w.w = cvt_pk_bf16(v1[2], v1[3]);
                    if (HAS_DT) __builtin_nontemporal_store(w, (u32x4*)(rowp + bj * HALF));
                    else *(u32x4*)(rowp + bj * HALF) = w; } }
    }
};
struct EpiKV {
    static constexpr bool PERM = false, AFTER_DRAIN = false;
    float* mk; float* mv; bf16_t* kb; bf16_t* vt; const float* ssq;
    __device__ __forceinline__ void operator()(const f32x4 (&acc)[2][2][4][2], const Unit& u, int wr, int wc, int fr, int fq) const {
        const int row0 = u.pm * BM + wr * 64 + fr; const bool isv = u.pn >= 4; const int colt = (u.pn & 3) * BM + wc * 32 + 4 * fq;
#pragma unroll
        for (int ai = 0; ai < 2; ++ai)
#pragma unroll
            for (int m = 0; m < 4; ++m) { const int row = row0 + ai * HALF + m * 16; const float rs = 1.0f;
#pragma unroll
                for (int bj = 0; bj < 2; ++bj)
#pragma unroll
                    for (int n = 0; n < 2; ++n) { const int c = colt + bj * HALF + n * 16; const f32x4 v = acc[ai][bj][m][n] * rs;
                        if (!isv) { __builtin_nontemporal_store(v, (f32x4*)(mk + (size_t)row * 1024 + c)); u32x2 w; w.x = cvt_pk_bf16(v[0], v[1]); w.y = cvt_pk_bf16(v[2], v[3]); *(u32x2*)(kb + (size_t)row * 1024 + c) = w; }
                        else { __builtin_nontemporal_store(v, (f32x4*)(mv + (size_t)row * 1024 + c)); const int b = row >> 8, key = row & 255, hd = c >> 8, d = c & 255;
                            bf16_t* p = vt + ((size_t)((b * 4 + hd) * 256 + d)) * 256 + key; const unsigned w0 = cvt_pk_bf16(v[0], v[1]), w1 = cvt_pk_bf16(v[2], v[3]);
                            p[0] = (bf16_t)(w0 & 0xffffu); p[256] = (bf16_t)(w0 >> 16); p[512] = (bf16_t)(w1 & 0xffffu); p[768] = (bf16_t)(w1 >> 16); } } }
    }
};
template <bool ADD> struct EpiGate {
    static constexpr bool PERM = true, AFTER_DRAIN = false;
    bf16_t* O; const bf16_t* gate;
    __device__ __forceinline__ void operator()(const f32x4 (&acc)[2][2][4][2], const Unit& u, int wr, int wc, int fr, int fq) const {
        const int row0 = u.pm * BM + wr * 64 + fr, col0 = u.pn * BM + wc * 32 + 8 * fq;
#pragma unroll
        for (int ai = 0; ai < 2; ++ai)
#pragma unroll
            for (int m = 0; m < 4; ++m) { const size_t off = (size_t)(row0 + ai * HALF + m * 16) * 1024 + col0;
#pragma unroll
                for (int bj = 0; bj < 2; ++bj) { const u32x4 gw = __builtin_nontemporal_load((const u32x4*)(gate + off + bj * HALF)); u32x4 ow = (u32x4){0u, 0u, 0u, 0u}; if (ADD) ow = *(const u32x4*)(O + off + bj * HALF);
                    float r[8];
#pragma unroll
                    for (int e = 0; e < 8; ++e) { const unsigned g16 = (gw[e >> 1] >> ((e & 1) * 16)) & 0xffffu, o16 = (ow[e >> 1] >> ((e & 1) * 16)) & 0xffffu;
                        const float a = acc[ai][bj][m][e >> 2][e & 3]; r[e] = (ADD ? bfbits2f(o16) : 0.f) + sigm(bfbits2f(g16)) * a; }
                    u32x4 w; w.x = cvt_pk_bf16(r[0], r[1]); w.y = cvt_pk_bf16(r[2], r[3]); w.z = cvt_pk_bf16(r[4], r[5]); w.w = cvt_pk_bf16(r[6], r[7]);
                    *(u32x4*)(O + off + bj * HALF) = w; } }
    }
};
template <bool BF, bool BSC = false> struct EpiRes {
    static constexpr bool PERM = true, AFTER_DRAIN = false;
    const float* base0; const float* base1; const bf16_t* bb; bf16_t* hb; float* ssqp; const float* bsc;
    __device__ __forceinline__ void operator()(const f32x4 (&acc)[2][2][4][2], const Unit& u, int wr, int wc, int fr, int fq) const {
        const int row0 = u.pm * BM + wr * 64 + fr, col0 = u.pn * BM + wc * 32 + 8 * fq; const float* base = u.pm < 64 ? base0 : base1;
#pragma unroll
        for (int ai = 0; ai < 2; ++ai)
#pragma unroll
            for (int m = 0; m < 4; ++m) { const int row = row0 + ai * HALF + m * 16; const size_t off = (size_t)row * 1024 + col0; float sq = 0.f; float bs = 1.0f; if constexpr (BSC) bs = bsc[row];
#pragma unroll
                for (int bj = 0; bj < 2; ++bj) { const size_t o2 = off + bj * HALF; f32x4 b0, b1;
                    if (BF) { const u32x4 w = *(const u32x4*)(bb + o2); b0 = (f32x4){bfbits2f(w.x & 0xffffu), __uint_as_float(w.x & 0xffff0000u), bfbits2f(w.y & 0xffffu), __uint_as_float(w.y & 0xffff0000u)};
                        b1 = (f32x4){bfbits2f(w.z & 0xffffu), __uint_as_float(w.z & 0xffff0000u), bfbits2f(w.w & 0xffffu), __uint_as_float(w.w & 0xffff0000u)}; }
                    else { b0 = __builtin_nontemporal_load((const f32x4*)(base + o2)); b1 = __builtin_nontemporal_load((const f32x4*)(base + o2 + 4)); }
                    if constexpr (BSC) { b0 = b0 * bs; b1 = b1 * bs; }
                    const f32x4 v0 = b0 + acc[ai][bj][m][0], v1 = b1 + acc[ai][bj][m][1];
                    sq += ((v0[0] * v0[0] + v0[1] * v0[1]) + (v0[2] * v0[2] + v0[3] * v0[3])) + ((v1[0] * v1[0] + v1[1] * v1[1]) + (v1[2] * v1[2] + v1[3] * v1[3]));
                    u32x4 w; w.x = cvt_pk_bf16(v0[0], v0[1]); w.y = cvt_pk_bf16(v0[2], v0[3]); w.z = cvt_pk_bf16(v1[0], v1[1]); w.w = cvt_pk_bf16(v1[2], v1[3]); *(u32x4*)(hb + o2) = w; }
                sq += __shfl_xor(sq, 16); sq += __shfl_xor(sq, 32);
                if (fq == 0) ssqp[(size_t)row * 16 + u.pn * 4 + wc] = sq; }
    }
};
struct EpiSwiglu {
    static constexpr bool PERM = true, AFTER_DRAIN = false;
    bf16_t* act; const float* ssq;
    __device__ __forceinline__ void operator()(const f32x4 (&acc)[2][2][4][2], const Unit& u, int wr, int wc, int fr, int fq) const {
        const int row0 = u.pm * BM + wr * 64 + fr, col0 = u.pn * 128 + wc * 16 + 4 * fq;
#pragma unroll
        for (int ai = 0; ai < 2; ++ai)
#pragma unroll
            for (int m = 0; m < 4; ++m) { const int row = row0 + ai * HALF + m * 16; const float rs = row_rs<16>(ssq, row);
#pragma unroll
                for (int bj = 0; bj < 2; ++bj) { const f32x4 a = acc[ai][bj][m][0] * rs, b = acc[ai][bj][m][1] * rs;
                    const float r0 = a[0] * sigm(a[0]) * a[1], r1 = a[2] * sigm(a[2]) * a[3], r2 = b[0] * sigm(b[0]) * b[1], r3 = b[2] * sigm(b[2]) * b[3];
                    u32x2 w; w.x = cvt_pk_bf16(r0, r1); w.y = cvt_pk_bf16(r2, r3); *(u32x2*)(act + (size_t)row * 2816 + col0 + bj * 64) = w; } }
    }
};
template <class Epi, class Sched, bool ALIGN_EPI = false, bool SP2 = false, int EPI_REP = 1>
__device__ __forceinline__ void gemm_phase(PG8_LAS unsigned char* lds, const Gemm g, const Sched& S, const Epi& E) {
    const int tid = threadIdx.x, wid = __builtin_amdgcn_readfirstlane(tid >> 6), lane = tid & 63, wr = wid >> 2, wc = wid & 3, fr = lane & 15, fq = lane >> 4;
    const int K = g.K, nt = K / BK;
    unsigned voffA[2], voffB[2];
#pragma unroll
    for (int i = 0; i < 2; ++i) { int R, C; stage_rc(tid * 16 + i * 8192, R, C); const int Rb = Epi::PERM ? ((R & ~31) + perm32(R & 31)) : R;
        voffA[i] = (unsigned)(R * K + C) * 2u; voffB[i] = (unsigned)(Rb * K + C) * 2u; }
    const size_t kstep = (size_t)(BK * 2);
    const size_t hstep = (size_t)HALF * K * 2;
    const size_t tstep = 2 * hstep;
    const unsigned ldsw = (unsigned)wid * 1024u;
    const int aoff = lds_byte(wr * 64 + fr, fq * 8), boff = lds_byte(wc * 32 + fr, fq * 8);
#define PG8_SA(b, h) (((b) * 2 + (h)) * HTB)
#define PG8_SB(b, h) ((4 + (b) * 2 + (h)) * HTB)
#define PG8_STAGE(bufoff, gbase, voff) do { _Pragma("unroll") for (int _i = 0; _i < 2; ++_i) \
        __builtin_amdgcn_global_load_lds((const unsigned*)((const char*)(gbase) + (voff)[_i]), (PG8_LAS unsigned*)(lds + (bufoff) + ldsw + _i * 8192), 16, 0, 0); } while (0)
#define PG8_LDA(dst, b, h) do { _Pragma("unroll") for (int m = 0; m < 4; ++m) _Pragma("unroll") for (int k = 0; k < 2; ++k) dst[m][k] = *(const PG8_LAS bf16x8*)(lds + PG8_SA(b, h) + aoff + m * 2048 + k * 1024); } while (0)
#define PG8_LDB(dst, b, h) do { _Pragma("unroll") for (int n = 0; n < 2; ++n) _Pragma("unroll") for (int k = 0; k < 2; ++k) dst[n][k] = *(const PG8_LAS bf16x8*)(lds + PG8_SB(b, h) + boff + n * 2048 + k * 1024); } while (0)
#define PG8_MMA(ai, bj, At, Bt) do { __builtin_amdgcn_s_setprio(1); _Pragma("unroll") for (int m = 0; m < 4; ++m) _Pragma("unroll") for (int n = 0; n < 2; ++n) _Pragma("unroll") for (int k = 0; k < 2; ++k) \
        acc[ai][bj][m][n] = __builtin_amdgcn_mfma_f32_16x16x32_bf16(Bt[n][k], At[m][k], acc[ai][bj][m][n], 0, 0, 0); __builtin_amdgcn_s_setprio(0); } while (0)
#define PG8_WAIT_V(n) asm volatile("s_waitcnt vmcnt(" #n ")" ::: "memory")
#define PG8_WAIT_L(n) asm volatile("s_waitcnt lgkmcnt(" #n ")" ::: "memory")
#define PG8_BAR __builtin_amdgcn_s_barrier()
#define PG8_SCHED __builtin_amdgcn_sched_barrier(0)
    Unit cur, nxt; int ui = 0;
    if (!S.next(0, cur)) return;
    f32x4 acc[2][2][4][2];
#pragma unroll
    for (int a = 0; a < 2; ++a)
#pragma unroll
        for (int b = 0; b < 2; ++b)
#pragma unroll
            for (int m = 0; m < 4; ++m)
#pragma unroll
                for (int n = 0; n < 2; ++n) acc[a][b][m][n] = (f32x4){0.f, 0.f, 0.f, 0.f};
    bf16x8 At[4][2], B0[2][2], B1[2][2];
    const char* cA = (const char*)g.A + (size_t)cur.pm * tstep; const char* cB = (const char*)g.Bt + (size_t)cur.pn * tstep;
    S.a_ready(cur);
    if constexpr (SP2) {
        PG8_STAGE(PG8_SB(0, 0), cB, voffB); PG8_STAGE(PG8_SB(0, 1), cB + hstep, voffB); PG8_STAGE(PG8_SA(0, 0), cA, voffA); PG8_STAGE(PG8_SA(0, 1), cA + hstep, voffA);
        if (wr == 1) PG8_BAR;
        PG8_WAIT_V(2); PG8_BAR;
        PG8_STAGE(PG8_SB(1, 0), cB + kstep, voffB); PG8_STAGE(PG8_SA(1, 0), cA + kstep, voffA); PG8_STAGE(PG8_SB(1, 1), cB + hstep + kstep, voffB);
        PG8_WAIT_V(6); PG8_BAR;
    } else {
        PG8_STAGE(PG8_SB(0, 0), cB, voffB); PG8_STAGE(PG8_SA(0, 0), cA, voffA); PG8_STAGE(PG8_SB(0, 1), cB + hstep, voffB); PG8_STAGE(PG8_SA(0, 1), cA + hstep, voffA);
        if (wr == 1) PG8_BAR;
        PG8_WAIT_V(4); PG8_BAR;
        PG8_STAGE(PG8_SB(1, 0), cB + kstep, voffB); PG8_STAGE(PG8_SA(1, 0), cA + kstep, voffA); PG8_STAGE(PG8_SB(1, 1), cB + hstep + kstep, voffB);
        PG8_WAIT_V(6); PG8_BAR;
    }
    for (;;) {
        const bool has_next = S.next(ui + 1, nxt);
        const char* nA = has_next ? (const char*)g.A + (size_t)nxt.pm * tstep : cA; const char* nB = has_next ? (const char*)g.Bt + (size_t)nxt.pn * tstep : cB;
        for (int t = 0; t < nt; t += 2) {
            const bool last = (t == nt - 2);
            const char* a1 = cA + (size_t)(t + 1) * kstep;
            const char* a2 = last ? nA : cA + (size_t)(t + 2) * kstep; const char* b2 = last ? nB : cB + (size_t)(t + 2) * kstep;
            const char* a3 = a2 + kstep; const char* b3 = b2 + kstep;
            if (last && has_next) S.a_ready(nxt);
            if constexpr (SP2) {
            PG8_LDB(B0, 0, 0); PG8_LDB(B1, 0, 1); PG8_SCHED; PG8_LDA(At, 0, 0); PG8_STAGE(PG8_SA(1, 1), a1 + hstep, voffA);
            PG8_WAIT_V(8); PG8_WAIT_L(0); PG8_BAR; PG8_MMA(0, 0, At, B0); PG8_MMA(0, 1, At, B1); PG8_BAR; PG8_SCHED;
            PG8_LDA(At, 0, 1); PG8_STAGE(PG8_SB(0, 0), b2, voffB); PG8_STAGE(PG8_SB(0, 1), b2 + hstep, voffB); PG8_STAGE(PG8_SA(0, 0), a2, voffA);
            PG8_WAIT_V(8); PG8_WAIT_L(0); PG8_BAR; PG8_MMA(1, 0, At, B0); PG8_MMA(1, 1, At, B1); PG8_BAR; PG8_SCHED;
            PG8_LDB(B0, 1, 0); PG8_LDB(B1, 1, 1); PG8_SCHED; PG8_LDA(At, 1, 0); PG8_STAGE(PG8_SA(0, 1), a2 + hstep, voffA);
            PG8_WAIT_V(8); PG8_WAIT_L(0); PG8_BAR; PG8_MMA(0, 0, At, B0); PG8_MMA(0, 1, At, B1); PG8_BAR; PG8_SCHED;
            PG8_LDA(At, 1, 1); PG8_STAGE(PG8_SB(1, 0), b3, voffB); PG8_STAGE(PG8_SB(1, 1), b3 + hstep, voffB); PG8_STAGE(PG8_SA(1, 0), a3, voffA);
            PG8_WAIT_V(8); PG8_WAIT_L(0); PG8_BAR; PG8_MMA(1, 0, At, B0); PG8_MMA(1, 1, At, B1); PG8_BAR; PG8_SCHED;
            } else {
            PG8_LDB(B0, 0, 0); PG8_SCHED; PG8_LDA(At, 0, 0); PG8_STAGE(PG8_SA(1, 1), a1 + hstep, voffA);
            PG8_WAIT_L(8); PG8_BAR; PG8_WAIT_L(0); PG8_MMA(0, 0, At, B0); PG8_BAR; PG8_SCHED;
            PG8_LDB(B1, 0, 1); PG8_STAGE(PG8_SB(0, 0), b2, voffB);
            PG8_BAR; PG8_WAIT_L(0); PG8_MMA(0, 1, At, B1); PG8_BAR;
            PG8_LDA(At, 0, 1); PG8_STAGE(PG8_SA(0, 0), a2, voffA);
            PG8_BAR; PG8_WAIT_L(0); PG8_MMA(1, 0, At, B0); PG8_BAR; PG8_SCHED;
            PG8_STAGE(PG8_SB(0, 1), b2 + hstep, voffB);
            PG8_WAIT_V(6); PG8_BAR; PG8_MMA(1, 1, At, B1); PG8_BAR;
            PG8_LDB(B0, 1, 0); PG8_SCHED; PG8_LDA(At, 1, 0); PG8_STAGE(PG8_SA(0, 1), a2 + hstep, voffA);
            PG8_WAIT_L(8); PG8_BAR; PG8_WAIT_L(0); PG8_MMA(0, 0, At, B0); PG8_BAR; PG8_SCHED;
            PG8_LDB(B1, 1, 1); PG8_STAGE(PG8_SB(1, 0), b3, voffB);
            PG8_BAR; PG8_WAIT_L(0); PG8_MMA(0, 1, At, B1); PG8_BAR;
            PG8_LDA(At, 1, 1); PG8_STAGE(PG8_SA(1, 0), a3, voffA);
            PG8_BAR; PG8_WAIT_L(0); PG8_MMA(1, 0, At, B0); PG8_BAR; PG8_SCHED;
            PG8_STAGE(PG8_SB(1, 1), b3 + hstep, voffB);
            PG8_WAIT_V(6); PG8_BAR; PG8_MMA(1, 1, At, B1); PG8_BAR;
            }
        }
        if constexpr (ALIGN_EPI) { if (wr == 0) PG8_BAR; }
        if constexpr (!Epi::AFTER_DRAIN) { for (int rep = 0; rep < EPI_REP; ++rep) { E(acc, cur, wr, wc, fr, fq); asm volatile("" ::: "memory"); } S.done(cur); }
        if (!has_next) break;
#pragma unroll
        for (int a = 0; a < 2; ++a)
#pragma unroll
            for (int b = 0; b < 2; ++b)
#pragma unroll
                for (int m = 0; m < 4; ++m)
#pragma unroll
                    for (int n = 0; n < 2; ++n) acc[a][b][m][n] = (f32x4){0.f, 0.f, 0.f, 0.f};
        cur = nxt; cA = nA; cB = nB; ++ui;
        if constexpr (ALIGN_EPI) { if (wr == 1) PG8_BAR; }
    }
    PG8_WAIT_V(0);
    if constexpr (!ALIGN_EPI) { if (wr == 0) PG8_BAR; }
    PG8_BAR;
    if constexpr (Epi::AFTER_DRAIN) { E.fused(acc, cur, wr, wc, fr, fq, lds, wid, lane); S.done(cur); }
#undef PG8_SA
#undef PG8_SB
#undef PG8_STAGE
#undef PG8_LDA
#undef PG8_LDB
#undef PG8_MMA
#undef PG8_WAIT_V
#undef PG8_WAIT_L
#undef PG8_BAR
#undef PG8_SCHED
}
}
#define GAS __attribute__((address_space(1)))
#define LAS __attribute__((address_space(3)))
typedef unsigned short bf16;
typedef unsigned v4u __attribute__((ext_vector_type(4)));
typedef float f32x4 __attribute__((ext_vector_type(4)));
typedef short bf16x8 __attribute__((ext_vector_type(8)));
typedef GAS unsigned gu32;
typedef GAS unsigned long long gu64;
#define RLX_AGENT __ATOMIC_RELAXED, __HIP_MEMORY_SCOPE_AGENT
#define LDS_WAIT() asm volatile("s_waitcnt lgkmcnt(0)" ::: "memory")
#define VM_WAIT() asm volatile("s_waitcnt vmcnt(0)" ::: "memory")
__device__ __forceinline__ unsigned long long rt() { return __builtin_amdgcn_s_memrealtime(); }
typedef float f32x2_t __attribute__((ext_vector_type(2))); typedef __bf16 bf16x2_t __attribute__((ext_vector_type(2)));
__device__ __forceinline__ unsigned pk2(float lo, float hi) { const f32x2_t v = {lo, hi}; const bf16x2_t b = __builtin_convertvector(v, bf16x2_t); return __builtin_bit_cast(unsigned, b); }
__device__ __forceinline__ unsigned f2bf(float f) { return pk2(f, 0.f) & 0xffffu; }

#define XB_TMO      128
#define XB_XCNT(j)  (256  + 64 * (j))
#define XB_XSUB(j)  (1280 + 64 * (j))
#define XB_XGEN(j)  (2304 + 64 * (j))
#define XB_TOP      3328
#define XB_TOPGEN   3392
#define XCD_BAR_WORDS 3456
#define XB_SPIN_CAP (1u << 18)

__device__ __forceinline__ unsigned xb_ld(unsigned* p)              { return __hip_atomic_load(p, __ATOMIC_RELAXED, __HIP_MEMORY_SCOPE_AGENT); }
__device__ __forceinline__ unsigned xb_add(unsigned* p, unsigned v) { return __hip_atomic_fetch_add(p, v, __ATOMIC_RELAXED, __HIP_MEMORY_SCOPE_AGENT); }
__device__ __forceinline__ unsigned xb_xcc_id() { return (unsigned)__builtin_amdgcn_s_getreg((3 << 11) | 20) & 0xFu; }
#define XB_SPIN(cond, bar) do { unsigned _sp = 0; while (cond) { __builtin_amdgcn_s_sleep(1); \
    if ((++_sp & 255u) == 0u) { if (xb_ld(&(bar)[XB_TMO])) break; if (_sp > XB_SPIN_CAP) { atomicAdd(&(bar)[XB_TMO], 1u); break; } } } } while (0)

struct XcdBarrier {
    unsigned* bar; unsigned x;
    volatile LAS unsigned* st;
};

__device__ __forceinline__ XcdBarrier xcd_barrier_post(unsigned* bar, volatile LAS unsigned* st) {
    XcdBarrier b; b.bar = bar; b.x = xb_xcc_id(); b.st = st;
    if (threadIdx.x == 0) (void)xb_add(&bar[XB_XCNT(b.x)], 1u);
    return b;
}
__device__ __forceinline__ void xcd_barrier_complete(unsigned* bar, unsigned x, unsigned& nloc, unsigned& nx) {
    const unsigned G = gridDim.x * gridDim.y * gridDim.z;
    unsigned sum, cnt, mine, sp = 0u;
    for (;;) {
        sum = 0u; cnt = 0u; mine = 0u;
#pragma unroll
        for (unsigned j = 0; j < 16; ++j) { const unsigned c = xb_ld(&bar[XB_XCNT(j)]); sum += c; cnt += (c > 0u) ? 1u : 0u; mine = (j == x) ? c : mine; }
        if (sum == G) break;
        __builtin_amdgcn_s_sleep(1);
        if ((++sp & 255u) == 0u) { if (xb_ld(&bar[XB_TMO])) break; if (sp > XB_SPIN_CAP) { atomicAdd(&bar[XB_TMO], 1u); break; } }
    }
    nloc = mine > 0u ? mine : 1u; nx = cnt > 0u ? cnt : 1u;
}

__device__ __forceinline__ void xcd_barrier(const XcdBarrier& b) {
    asm volatile("s_waitcnt vmcnt(0)" ::: "memory");
    __syncthreads();
    if (threadIdx.x == 0) {
        unsigned* bar = b.bar;
        __builtin_amdgcn_s_waitcnt(0);
        unsigned nloc = b.st[0], nx = b.st[1];
        if (nloc == 0u) { xcd_barrier_complete(bar, b.x, nloc, nx); b.st[0] = nloc; b.st[1] = nx; }
        const unsigned old = xb_add(&bar[XB_XSUB(b.x)], 1u);
        const unsigned gen = old / nloc;
        if (old + 1u == (gen + 1u) * nloc) {
            __builtin_amdgcn_fence(__ATOMIC_RELEASE, "agent");
            asm volatile("s_waitcnt vmcnt(0)" ::: "memory");
            const unsigned og = xb_add(&bar[XB_TOP], 1u);
            const unsigned tg = og / nx;
            if (og + 1u == (tg + 1u) * nx) xb_add(&bar[XB_TOPGEN], 1u);
            else XB_SPIN(xb_ld(&bar[XB_TOPGEN]) == tg, bar);
            __builtin_amdgcn_fence(__ATOMIC_ACQUIRE, "agent");
            xb_add(&bar[XB_XGEN(b.x)], 1u);
            asm volatile("s_waitcnt vmcnt(0)" ::: "memory");
        } else {
            XB_SPIN(xb_ld(&bar[XB_XGEN(b.x)]) == gen, bar);
            __builtin_amdgcn_fence(__ATOMIC_ACQUIRE, "agent");
            asm volatile("s_waitcnt vmcnt(0)" ::: "memory");
        }
    }
    __syncthreads();
}
typedef unsigned v2u __attribute__((ext_vector_type(2)));
constexpr int NWAVES = 8, NTHR = 512;
constexpr int DM = 1024, TP = 16384, TS = 512, T = TP + TS;
constexpr int SEQ = 2048, NBP = 8, NBS = 128, LS = 4, MEMR = 2048;
constexpr int NPROJ = 11520;
constexpr int FFN = 2816;
constexpr float EPS = 1e-6f;
constexpr float QSCALE = 0.0625f * 1.4426950408889634f;

constexpr size_t MiB = 1u << 20;
constexpr size_t WS_CTL = 0, CTL_ZERO_BYTES = 32768;
constexpr size_t WS_SSQX = 1 * MiB, WS_SSQM = 1 * MiB + 512 * 1024;
constexpr size_t WS_DT = 2 * MiB, WS_SSQSSD = 5 * MiB, WS_SSQP1 = 8 * MiB, WS_SSQP2 = 9 * MiB + 512 * 1024, WS_SSQP3 = 11 * MiB;
constexpr size_t WS_WIN = 13 * MiB, WS_WKV = 36 * MiB, WS_WSSD = 40 * MiB, WS_WHG = 44 * MiB, WS_WOUT = 46 * MiB, WS_WCQ = 48 * MiB, WS_WCO = 50 * MiB, WS_WGU = 52 * MiB, WS_WDN = 63 * MiB;
constexpr size_t WS_XB = 69 * MiB, WS_MNB = 102 * MiB, WS_KB = 106 * MiB, WS_VT = 110 * MiB;
constexpr size_t SLOT = 33 * MiB, SLOT_ELEMS = (size_t)T * 1024;
constexpr size_t WS_PROJ = 114 * MiB;
constexpr size_t WS_YG = WS_PROJ + 11 * SLOT, WS_ON = WS_YG + 2 * SLOT, WS_END = WS_ON + SLOT;
static_assert(SLOT == SLOT_ELEMS * 2, "slot size");
static_assert(WS_WIN + (size_t)NPROJ * 1024 * 2 <= WS_WKV && WS_WGU + (size_t)2 * FFN * 1024 * 2 <= WS_WDN && WS_WDN + (size_t)1024 * FFN * 2 <= WS_XB && WS_SSQP3 + (size_t)T * 64 <= WS_WIN, "d_ws map");
static_assert(WS_DT + (size_t)T * 128 <= WS_SSQSSD && WS_SSQSSD + (size_t)T * 128 <= WS_SSQP1 && WS_SSQP1 + (size_t)T * 64 <= WS_SSQP2 && WS_SSQP2 + (size_t)T * 64 <= WS_SSQP3, "d_ws map 2");
enum { S_Z0 = 0, S_Z1 = 1, S_X0 = 2, S_X1 = 3, S_X2 = 4, S_Q = 5, S_F = 6, S_I = 7, S_HG = 8, S_GS = 9, S_GH = 10 };
constexpr size_t WS_MERGED = WS_PROJ + S_Q * SLOT, WS_HB = WS_PROJ + S_F * SLOT, WS_QB = WS_PROJ + S_I * SLOT, WS_OB = WS_PROJ + S_HG * SLOT, WS_ACT = WS_PROJ;
static_assert((size_t)T * FFN * 2 <= 3 * SLOT, "act overlay");
constexpr size_t O_Y = 0, O_SSMP = (size_t)T * 1024, O_CONVP = O_SSMP + 2097152, O_HGP = O_CONVP + 73728, O_MKP = O_HGP + 1048576, O_MVP = O_MKP + 2097152,
                 O_SSMS = O_MVP + 2097152, O_CONVS = O_SSMS + 33554432, O_HGS = O_CONVS + 1179648, O_END = O_HGS + 16777216;
constexpr int CW_QUEUE = 64;
constexpr int CW_BAR = 4096;
constexpr int RING_OFF = 0, RING_BYTES = 131072;
constexpr int LDS_BYTES = 147456;
constexpr int LDSCTL_OFF = LDS_BYTES - 1024, MISC_OFF = LDSCTL_OFF + 320;
struct Frame {
    LAS unsigned char* lds;
    volatile LAS unsigned* MISC;
    gu32* ctl;
    int tid, lane, wave;
    int vcu, G;
    const float* in[32];
    float* out; unsigned char* ws;
};
__device__ __forceinline__ float bf2f(unsigned v16) { return __uint_as_float(v16 << 16); }
__device__ __forceinline__ f32x4 ld_nt(const float* p) { return __builtin_nontemporal_load((const f32x4*)p); }
__device__ __forceinline__ void st_nt(float* p, f32x4 v) { __builtin_nontemporal_store(v, (f32x4*)p); }
__device__ __forceinline__ v4u ld_nt16(const void* p) { return __builtin_nontemporal_load((const v4u*)p); }
__device__ __forceinline__ unsigned ld_nt4(const void* p) { return __builtin_nontemporal_load((const unsigned*)p); }
__device__ __forceinline__ float sigmoid_f(float x) { return __builtin_amdgcn_rcpf(1.0f + __expf(-x)); }
__device__ __forceinline__ float silu_f(float x) { return x * sigmoid_f(x); }
__device__ __forceinline__ float wave_sum(float v) {
#pragma unroll
    for (int o = 1; o < 64; o <<= 1) v += __shfl_xor(v, o);
    return v;
}
__device__ __forceinline__ float wave_max(float v) {
#pragma unroll
    for (int o = 1; o < 64; o <<= 1) v = fmaxf(v, __shfl_xor(v, o));
    return v;
}
struct TSrc { const float* W; const float* W2; const float* ks; int ldw; int mode; };
__device__ __forceinline__ void p0_transpose_item(const TSrc& s, int K, int N, bf16* WT, LAS unsigned short* scr, int item, int lane) {
    const int nblk = N / 64, kb = item / nblk, nb = item % nblk, k0 = 64 * kb, n0 = 64 * nb;
    const int kr = lane >> 4, nq = lane & 15;
    const float* const Wa = s.W; const float* const Wb = s.W2;
    const float* src; int c0, cs; bool zero = false;
    if (s.mode == 2) { const float* wsel = Wa; if (nq >= 8) wsel = Wb; src = wsel + (n0 >> 1) + 4 * (nq & 7); c0 = 8 * (nq & 7) + (nq >> 3); cs = 2; }
    else { const int n = n0 + 4 * nq; c0 = 4 * nq; cs = 1;
        if (s.mode == 0) src = Wa + n;
        else if (s.mode == 1) { if (n < 5120) src = Wa + n; else if (n < 11264) src = Wa + n + 32; else if (n < 11296) src = Wa + 5120 + (n - 11264); else { src = Wa; zero = true; } }
        else { src = Wa + n; if (n >= 1024) src = Wb + (n - 1024); } }
    f32x4 v[16];
#pragma unroll
    for (int i = 0; i < 16; ++i) v[i] = zero ? (f32x4){0.f, 0.f, 0.f, 0.f} : ld_nt(src + (size_t)(k0 + 4 * i + kr) * s.ldw);
#pragma unroll
    for (int i = 0; i < 16; ++i) { const int kk = 4 * i + kr; const float sc = s.ks ? s.ks[k0 + kk] : 1.0f; const unsigned w0 = pk2(v[i].x * sc, v[i].y * sc), w1 = pk2(v[i].z * sc, v[i].w * sc);
        LAS unsigned short* d = scr + kk * 66 + c0;
        if (cs == 1) { *(LAS unsigned*)d = w0; *(LAS unsigned*)(d + 2) = w1; }
        else { d[0] = (unsigned short)(w0 & 0xffffu); d[2] = (unsigned short)(w0 >> 16); d[4] = (unsigned short)(w1 & 0xffffu); d[6] = (unsigned short)(w1 >> 16); } }
    LDS_WAIT(); asm volatile("" ::: "memory");
    const int nr = lane >> 3, kc = lane & 7;
#pragma unroll
    for (int j = 0; j < 8; ++j) { const int n = 8 * j + nr; const LAS unsigned short* p = scr + (8 * kc) * 66 + n;
        v4u o; o.x = (unsigned)p[0] | ((unsigned)p[66] << 16); o.y = (unsigned)p[2 * 66] | ((unsigned)p[3 * 66] << 16); o.z = (unsigned)p[4 * 66] | ((unsigned)p[5 * 66] << 16); o.w = (unsigned)p[6 * 66] | ((unsigned)p[7 * 66] << 16);
        *(v4u*)(WT + (size_t)(n0 + n) * K + k0 + 8 * kc) = o; }
    LDS_WAIT(); asm volatile("" ::: "memory");
}
__device__ __forceinline__ void rows4_to_bf16_ssq(const float* x0, bf16* o0, float* ssq0, int lane) {
    f32x4 v[4][4];
#pragma unroll
    for (int rr = 0; rr < 4; ++rr)
#pragma unroll
        for (int j = 0; j < 4; ++j) v[rr][j] = ld_nt(x0 + rr * 1024 + 4 * (64 * j + lane));
#pragma unroll
    for (int rr = 0; rr < 4; ++rr) { float sq = 0.f;
#pragma unroll
        for (int j = 0; j < 4; ++j) sq += (v[rr][j].x * v[rr][j].x + v[rr][j].y * v[rr][j].y) + (v[rr][j].z * v[rr][j].z + v[rr][j].w * v[rr][j].w);
        sq = wave_sum(sq);
        const float irs = sqrtf(sq * (1.0f / 1024.0f) + 1e-6f), rs = 1.0f / irs;
        unsigned long long* o8 = (unsigned long long*)(o0 + rr * 1024) + lane;
#pragma unroll
        for (int j = 0; j < 4; ++j) o8[64 * j] = (unsigned long long)pk2(v[rr][j].x * rs, v[rr][j].y * rs) | ((unsigned long long)pk2(v[rr][j].z * rs, v[rr][j].w * rs) << 32);
        if (lane == 0) ssq0[rr] = irs; }
}
__device__ __forceinline__ void p0_prologue(Frame& F) {
    LAS unsigned short* scr = (LAS unsigned short*)(F.lds + RING_OFF + F.wave * 16384);
    const int gw = F.vcu * NWAVES + F.wave, NGW = F.G * NWAVES;
    unsigned char* ws = F.ws;
    constexpr int I_IN = 16 * (NPROJ / 64), I_KV = 16 * 32, I_SSD = 32 * 16, I_SQ = 16 * 16, I_GU = 16 * (2 * FFN / 64), I_DN = (FFN / 64) * 16;
    constexpr int NITEMS = I_IN + I_KV + I_SSD + 4 * I_SQ + I_GU + I_DN;
    for (int it = gw; it < NITEMS; it += NGW) {
        int r = it;
        if (r < I_IN) { TSrc s{F.in[9], nullptr, F.in[8], 11296, 1}; p0_transpose_item(s, 1024, NPROJ, (bf16*)(ws + WS_WIN), scr, r, F.lane); continue; } r -= I_IN;
        if (r < I_KV) { TSrc s{F.in[24], F.in[25], F.in[22], 1024, 3}; p0_transpose_item(s, 1024, 2048, (bf16*)(ws + WS_WKV), scr, r, F.lane); continue; } r -= I_KV;
        if (r < I_SSD) { TSrc s{F.in[16], nullptr, F.in[15], 1024, 0}; p0_transpose_item(s, 2048, 1024, (bf16*)(ws + WS_WSSD), scr, r, F.lane); continue; } r -= I_SSD;
        if (r < I_SQ) { TSrc s{F.in[19], nullptr, F.in[18], 1024, 0}; p0_transpose_item(s, 1024, 1024, (bf16*)(ws + WS_WHG), scr, r, F.lane); continue; } r -= I_SQ;
        if (r < I_SQ) { TSrc s{F.in[20], nullptr, nullptr, 1024, 0}; p0_transpose_item(s, 1024, 1024, (bf16*)(ws + WS_WOUT), scr, r, F.lane); continue; } r -= I_SQ;
        if (r < I_SQ) { TSrc s{F.in[23], nullptr, F.in[21], 1024, 0}; p0_transpose_item(s, 1024, 1024, (bf16*)(ws + WS_WCQ), scr, r, F.lane); continue; } r -= I_SQ;
        if (r < I_SQ) { TSrc s{F.in[26], nullptr, nullptr, 1024, 0}; p0_transpose_item(s, 1024, 1024, (bf16*)(ws + WS_WCO), scr, r, F.lane); continue; } r -= I_SQ;
        if (r < I_GU) { TSrc s{F.in[28], F.in[29], F.in[27], FFN, 2}; p0_transpose_item(s, 1024, 2 * FFN, (bf16*)(ws + WS_WGU), scr, r, F.lane); continue; } r -= I_GU;
        { TSrc s{F.in[30], nullptr, nullptr, 1024, 0}; p0_transpose_item(s, FFN, 1024, (bf16*)(ws + WS_WDN), scr, r, F.lane); }
    }
    bf16* XB = (bf16*)(ws + WS_XB); float* SSQX = (float*)(ws + WS_SSQX);
    for (int m4 = gw; m4 < T / 4; m4 += NGW) { const int m = 4 * m4;
        rows4_to_bf16_ssq(m < TP ? F.in[0] + (size_t)m * DM : F.in[1] + (size_t)(m - TP) * DM, XB + (size_t)m * DM, SSQX + m, F.lane); }
    bf16* MNB = (bf16*)(ws + WS_MNB); float* SSQM = (float*)(ws + WS_SSQM);
    for (int m4 = gw; m4 < MEMR / 4; m4 += NGW) { const int m = 4 * m4; rows4_to_bf16_ssq(F.in[2] + (size_t)m * DM, MNB + (size_t)m * DM, SSQM + m, F.lane); }
}
__device__ __forceinline__ void conv_copy_unit(Frame& F, int gb) {
    const bf16* PROJ = (const bf16*)(F.ws + WS_PROJ);
    const bool prompt = gb < NBP; const int sb = gb - NBP;
    const size_t row0 = prompt ? (size_t)gb * SEQ + (SEQ - 3) : (size_t)TP + (size_t)sb * LS + 1;
    float* dst = prompt ? F.out + O_CONVP + (size_t)gb * 3 * 3072 : F.out + O_CONVS + (size_t)sb * 3 * 3072;
    for (int e = F.tid; e < 3 * 3072; e += NTHR) { const int j = e / 3072, col = e % 3072;
        dst[e] = bf2f(PROJ[(size_t)(S_X0 + (col >> 10)) * SLOT_ELEMS + (row0 + j) * 1024 + (col & 1023)]); }
}
__device__ __forceinline__ void ssdnorm_phase(Frame& F) {
    const int gw = F.vcu * NWAVES + F.wave, NGW = F.G * NWAVES; bf16* YG = (bf16*)(F.ws + WS_YG); const float* SSQ = (const float*)(F.ws + WS_SSQSSD);
    for (int row = gw; row < T; row += NGW) {
        const f32x4* sp = (const f32x4*)(SSQ + (size_t)row * 32);
#pragma unroll
        for (int j = 0; j < 4; ++j) { const f32x4 a = sp[2 * j], b = sp[2 * j + 1]; const float s = ((a.x + a.y) + (a.z + a.w)) + ((b.x + b.y) + (b.z + b.w)); const float rs = 1.0f / sqrtf(s * (1.0f / 512.0f) + EPS);
            v4u* p = (v4u*)(YG + (size_t)row * 2048) + j * 64 + F.lane; const v4u w = *p; v4u o;
#pragma unroll
            for (int e = 0; e < 4; ++e) o[e] = pk2(bf2f(w[e] & 0xffffu) * rs, bf2f(w[e] >> 16) * rs);
            *p = o; }
    }
}
typedef float f32x16 __attribute__((ext_vector_type(16)));
#define MFMA32(a, b, c) __builtin_amdgcn_mfma_f32_32x32x16_bf16((a), (b), (c), 0, 0, 0)
__device__ __forceinline__ unsigned cvtpk_c(float lo, float hi) { return pk2(lo, hi); }
__device__ __forceinline__ bf16x8 pack8(float a0, float a1, float a2, float a3, float a4, float a5, float a6, float a7) {
    v4u w; w.x = cvtpk_c(a0, a1); w.y = cvtpk_c(a2, a3); w.z = cvtpk_c(a4, a5); w.w = cvtpk_c(a6, a7); return __builtin_bit_cast(bf16x8, w); }
#define ACC_FRAG(x, s) pack8((x)[8 * (s)], (x)[8 * (s) + 1], (x)[8 * (s) + 2], (x)[8 * (s) + 3], (x)[8 * (s) + 4], (x)[8 * (s) + 5], (x)[8 * (s) + 6], (x)[8 * (s) + 7])
__device__ __forceinline__ bf16x8 lds_frag16(const LAS unsigned char* p) { return *(const LAS bf16x8*)p; }
__device__ __forceinline__ bf16x8 lds_frag8x2(const LAS unsigned char* p) { const v2u lo = *(const LAS v2u*)p, hi = *(const LAS v2u*)(p + 16);
    const v4u w = (v4u){lo.x, lo.y, hi.x, hi.y}; return __builtin_bit_cast(bf16x8, w); }
#define LDS_BARRIER() do { asm volatile("s_waitcnt lgkmcnt(0)" ::: "memory"); __builtin_amdgcn_s_barrier(); asm volatile("" ::: "memory"); } while (0)
typedef short s16x4 __attribute__((ext_vector_type(4)));
__device__ __forceinline__ bf16x8 lds_frag_tr(const LAS unsigned char* p, const LAS unsigned char* p4) {
    const s16x4 lo = __builtin_amdgcn_ds_read_tr16_b64_v4i16((LAS s16x4*)p), hi = __builtin_amdgcn_ds_read_tr16_b64_v4i16((LAS s16x4*)p4);
    return (bf16x8){lo.x, lo.y, lo.z, lo.w, hi.x, hi.y, hi.z, hi.w}; }
constexpr size_t WS_BCS = WS_END, WS_BTT = WS_BCS + (size_t)TP * 1024 * 2, WS_END2 = WS_BTT + (size_t)NBP * 32 * 4 * 128 * 64 * 2;
__device__ __forceinline__ void bc_prep_unit(Frame& F, int b, int c) {
    typedef float f32x2 __attribute__((ext_vector_type(2)));
    int tid_o = F.tid; asm volatile("" : "+v"(tid_o));
    const int tid = tid_o, cg = tid & 127, seg = tid >> 7; unsigned char* ws = F.ws;
    const bf16* src = (const bf16*)(ws + WS_PROJ) + (size_t)S_X2 * SLOT_ELEMS + (size_t)b * SEQ * 1024 + 8 * cg;
    bf16* BCS = (bf16*)(ws + WS_BCS);
    const float* cw = F.in[10] + 2048 + 8 * cg; const float* cbp = F.in[11] + 2048 + 8 * cg;
#pragma unroll 1
    for (int half = 0; half < 2; ++half) {
        const int s0 = 16 * seg + 8 * half;
        v4u raw[11];
#pragma unroll
        for (int i = 0; i < 11; ++i) { const int gt = 64 * c + s0 - 3 + i; raw[i] = (v4u){0u, 0u, 0u, 0u}; if (gt >= 0) raw[i] = ld_nt16(src + (size_t)gt * 1024); }
        v4u rowpk[8];
#pragma unroll
        for (int kp = 0; kp < 4; ++kp) {
            const f32x2 cw0 = *(const f32x2*)(cw + 2 * kp), cw1 = *(const f32x2*)(cw + 3072 + 2 * kp), cw2 = *(const f32x2*)(cw + 2 * 3072 + 2 * kp), cw3 = *(const f32x2*)(cw + 3 * 3072 + 2 * kp), cbb = *(const f32x2*)(cbp + 2 * kp);
            f32x2 xv[11];
#pragma unroll
            for (int i = 0; i < 11; ++i) { const unsigned wd = raw[i][kp]; xv[i] = (f32x2){__uint_as_float(wd << 16), __uint_as_float(wd & 0xffff0000u)}; }
            f32x2 o[8];
#pragma unroll
            for (int i = 0; i < 8; ++i) { f32x2 a = cw0 * xv[i] + cbb; a = cw1 * xv[i + 1] + a; a = cw2 * xv[i + 2] + a; a = cw3 * xv[i + 3] + a;
                const f32x2 t = a * (-1.4426950408889634f); f32x2 e; e.x = __builtin_amdgcn_exp2f(t.x); e.y = __builtin_amdgcn_exp2f(t.y); e = e + 1.0f;
                f32x2 rc; rc.x = __builtin_amdgcn_rcpf(e.x); rc.y = __builtin_amdgcn_rcpf(e.y); o[i] = a * rc; }
#pragma unroll
            for (int i = 0; i < 8; ++i) rowpk[i][kp] = pk2(o[i].x, o[i].y);
        }
        bf16* drow = BCS + ((size_t)b * SEQ + 64 * c + s0) * 1024 + 8 * cg;
#pragma unroll
        for (int i = 0; i < 8; ++i) *(v4u*)(drow + (size_t)i * 1024) = rowpk[i];
    }
}
__device__ __forceinline__ void bc_prep_phase(Frame& F) { for (int u = F.vcu; u < NBP * 32; u += F.G) bc_prep_unit(F, u >> 5, u & 31); }
constexpr size_t WS_HVT = WS_XB, WS_EGM = WS_END2, WS_EGL = WS_EGM + (size_t)NBP * 64 * 1024 * 4, WS_END3 = WS_EGL + (size_t)NBP * 64 * 1024 * 4;
__device__ __forceinline__ void hg_prep_unit(Frame& F, int b, int c) {
    typedef float f32x2 __attribute__((ext_vector_type(2)));
    int tid_o = F.tid; asm volatile("" : "+v"(tid_o));
    const int tid = tid_o; unsigned char* ws = F.ws;
    const int ch = 2 * tid;
    const size_t row0 = (size_t)b * SEQ + 32 * c;
    bf16* QS = (bf16*)(ws + WS_PROJ) + (size_t)S_Q * SLOT_ELEMS + row0 * 1024 + ch; bf16* FS = (bf16*)(ws + WS_PROJ) + (size_t)S_F * SLOT_ELEMS + row0 * 1024 + ch;
    const f32x2 l0 = *(const f32x2*)(F.in[17] + ch), l1 = *(const f32x2*)(F.in[17] + 1024 + ch);
    f32x2 lb; lb.x = __builtin_amdgcn_rcpf(1.0f + __expf(l1.x - l0.x)); lb.y = __builtin_amdgcn_rcpf(1.0f + __expf(l1.y - l0.y));
    const f32x2 omlb = 1.0f - lb;
    f32x2 P[32]; f32x2 run = (f32x2){1.0f, 1.0f};
#pragma unroll
    for (int t = 0; t < 32; ++t) { const unsigned wd = ld_nt4(FS + (size_t)t * 1024);
        f32x2 u = (f32x2){__uint_as_float(wd << 16), __uint_as_float(wd & 0xffff0000u)}; u.x = fminf(fmaxf(u.x, -30.f), 30.f); u.y = fminf(fmaxf(u.y, -30.f), 30.f);
        const f32x2 tt = u * (-1.4426950408889634f); f32x2 e; e.x = __builtin_amdgcn_exp2f(tt.x); e.y = __builtin_amdgcn_exp2f(tt.y); e = e + 1.0f;
        f32x2 sg; sg.x = __builtin_amdgcn_rcpf(e.x); sg.y = __builtin_amdgcn_rcpf(e.y);
        const f32x2 fg = lb + omlb * sg; run = run * fg; run.x = fmaxf(run.x, 1e-30f); run.y = fmaxf(run.y, 1e-30f); P[t] = run; }
    const f32x2 Pm = P[15], Pl = P[31]; f32x2 rPm; rPm.x = __builtin_amdgcn_rcpf(Pm.x); rPm.y = __builtin_amdgcn_rcpf(Pm.y);
    *(f32x2*)((float*)(ws + WS_EGM) + (size_t)(b * 64 + c) * 1024 + ch) = Pm; *(f32x2*)((float*)(ws + WS_EGL) + (size_t)(b * 64 + c) * 1024 + ch) = Pl * rPm;
    f32x2 rPprev = (f32x2){1.0f, 1.0f};
#pragma unroll
    for (int t = 0; t < 32; ++t) { f32x2 rP; rP.x = __builtin_amdgcn_rcpf(P[t].x); rP.y = __builtin_amdgcn_rcpf(P[t].y);
        const f32x2 e1 = P[t] * rPm, e2 = Pm * rP, fg = P[t] * rPprev, kk = 1.0f - fg; rPprev = rP;
        const unsigned qw = ld_nt4(QS + (size_t)t * 1024); const f32x2 q = (f32x2){__uint_as_float(qw << 16), __uint_as_float(qw & 0xffff0000u)};
        const f32x2 tq = q * (-1.4426950408889634f); f32x2 eq; eq.x = __builtin_amdgcn_exp2f(tq.x); eq.y = __builtin_amdgcn_exp2f(tq.y); eq = eq + 1.0f;
        f32x2 rq; rq.x = __builtin_amdgcn_rcpf(eq.x); rq.y = __builtin_amdgcn_rcpf(eq.y);
        const f32x2 qa = q * rq * e1, ka = kk * e2;
        *(unsigned*)(QS + (size_t)t * 1024) = pk2(qa.x, qa.y); *(unsigned*)(FS + (size_t)t * 1024) = pk2(ka.x, ka.y); }
}
__device__ __forceinline__ void hg_prep_phase(Frame& F) { for (int u = F.vcu; u < NBP * 64; u += F.G) hg_prep_unit(F, u >> 6, u & 63); }
constexpr int HV_QA = 0, HV_KA = 8704, HV_KAT = 17408, HV_VT = 27648, HV_EGM = 30208, HV_EGL = 30720, HV_PBUF = 31232, HV_OB = 2 * HV_PBUF, HV_OBUF = 23040;
constexpr size_t WS_SSQH = WS_END3, WS_END4 = WS_SSQH + (size_t)T * 32 * 4;
__device__ __forceinline__ void hgrn_v_unit(Frame& F, int b, int hd, int vt) {
    int tid_o = F.tid; asm volatile("" : "+v"(tid_o));
    const int tid = tid_o, lane = tid & 63, w = F.wave, r = lane & 31, hh = lane >> 5; unsigned char* ws = F.ws;
    LAS unsigned char* Lb = F.lds + RING_OFF;
    const bf16* PROJ = (const bf16*)(ws + WS_PROJ); bf16* OU = (bf16*)(ws + WS_ON); float* SSQH = (float*)(ws + WS_SSQH);
    const size_t rowb = (size_t)b * SEQ;
    const int pt_t = tid & 31, pt_g = tid >> 5;
    const bf16* qsrc = PROJ + (size_t)S_Q * SLOT_ELEMS + (rowb + pt_t) * 1024 + hd * 128 + 8 * pt_g;
    const bf16* ksrc = PROJ + (size_t)S_F * SLOT_ELEMS + (rowb + pt_t) * 1024 + hd * 128 + 8 * pt_g;
    const unsigned char* xsrc = nullptr; size_t xstr = 0;
    if (tid < 128) { xsrc = (const unsigned char*)(PROJ + (size_t)S_I * SLOT_ELEMS + (rowb + pt_t) * 1024 + hd * 128 + 32 * vt + 8 * pt_g); xstr = (size_t)32 * 1024 * 2; }
    else if (tid < 160) { xsrc = (const unsigned char*)((const float*)(ws + WS_EGM) + (size_t)b * 64 * 1024 + hd * 128 + 4 * (tid - 128)); xstr = 4096; }
    else if (tid < 192) { xsrc = (const unsigned char*)((const float*)(ws + WS_EGL) + (size_t)b * 64 * 1024 + hd * 128 + 4 * (tid - 160)); xstr = 4096; }
    const int o_img = pt_t * 272 + 16 * pt_g, o_ka = pt_t * 256 + 16 * (pt_g ^ (((pt_t & 3) << 2) | ((pt_t >> 2) & 3))), o_v = pt_t * 64 + 16 * pt_g;
#define HGV_LOAD(cc, pq, pk, px) { pq = *(const v4u*)(qsrc + (size_t)(cc) * 32 * 1024); pk = *(const v4u*)(ksrc + (size_t)(cc) * 32 * 1024); if (tid < 192) px = *(const v4u*)(xsrc + (size_t)(cc) * xstr); }
#define HGV_STORE(pb, pq, pk, px) { *(LAS v4u*)((pb) + HV_QA + o_img) = pq; *(LAS v4u*)((pb) + HV_KA + o_ka) = pk; \
        if (tid < 128) { *(LAS v4u*)((pb) + HV_VT + o_v) = px; } else if (tid < 160) { *(LAS v4u*)((pb) + HV_EGM + 16 * (tid - 128)) = px; } else if (tid < 192) { *(LAS v4u*)((pb) + HV_EGL + 16 * (tid - 160)) = px; } }
    v4u pqA, pkA, pxA = (v4u){0u, 0u, 0u, 0u}, pqB, pkB, pxB = (v4u){0u, 0u, 0u, 0u};
    HGV_LOAD(0, pqA, pkA, pxA) HGV_STORE(Lb, pqA, pkA, pxA)
    HGV_LOAD(1, pqA, pkA, pxA) HGV_LOAD(2, pqB, pkB, pxB)
    const int kt = w;
    v4u ow_pend = (v4u){0u, 0u, 0u, 0u}; float sq_pend = 0.f;
    f32x16 S;
#pragma unroll
    for (int i = 0; i < 16; ++i) S[i] = 0.f;
    __syncthreads();
#define HGV_ITER(c, pq, pk, px) { \
        int r_l = r, hh_l = hh, tid_l = tid; asm volatile("" : "+v"(r_l), "+v"(hh_l), "+v"(tid_l)); \
        { const int r = r_l, hh = hh_l, tid = tid_l; \
        LAS unsigned char* pbc = Lb + ((c) & 1) * HV_PBUF; LAS unsigned char* pbn = Lb + (((c) + 1) & 1) * HV_PBUF; \
        if ((c) < 63) { HGV_STORE(pbn, pq, pk, px) if ((c) < 61) HGV_LOAD((c) + 3, pq, pk, px) } \
        if (w < 4) { \
            LAS float* EGM = (LAS float*)(pbc + HV_EGM); LAS float* EGL = (LAS float*)(pbc + HV_EGL); LAS float* OB = (LAS float*)(Lb + HV_OB + ((c) & 1) * HV_OBUF); \
            _Pragma("unroll") \
            for (int q4 = 0; q4 < 4; ++q4) { const f32x4 e0 = *(const LAS f32x4*)(EGM + 32 * kt + 8 * q4 + 4 * hh); \
                _Pragma("unroll") \
                for (int j = 0; j < 4; ++j) S[4 * q4 + j] *= e0[j]; } \
            f32x16 o; \
            _Pragma("unroll") \
            for (int i = 0; i < 16; ++i) o[i] = 0.f; \
            const LAS unsigned char* qa_row = pbc + HV_QA + r * 272; \
            o = MFMA32(ACC_FRAG(S, 0), lds_frag8x2(qa_row + (32 * kt + 4 * hh) * 2), o);        \
            o = MFMA32(ACC_FRAG(S, 1), lds_frag8x2(qa_row + (32 * kt + 16 + 4 * hh) * 2), o); \
            LAS float* ob = OB + (kt * 32 + r) * 36 + 4 * hh; \
            _Pragma("unroll") \
            for (int q4 = 0; q4 < 4; ++q4) *(LAS f32x4*)(ob + 8 * q4) = (f32x4){o[4 * q4], o[4 * q4 + 1], o[4 * q4 + 2], o[4 * q4 + 3]}; \
              \
            const int q_ = ((tid & 63) >> 2) & 3, chk_ = 4 * kt + 2 * (((tid & 63) >> 4) & 1) + (((tid & 63) >> 1) & 1); \
            const LAS unsigned char* ka_lo = pbc + HV_KA + (8 * hh + q_) * 256 + 16 * (chk_ ^ ((q_ << 2) | ((2 * hh) & 3))) + 8 * ((tid & 63) & 1); \
            const LAS unsigned char* ka_hi = pbc + HV_KA + (8 * hh + 4 + q_) * 256 + 16 * (chk_ ^ ((q_ << 2) | ((2 * hh + 1) & 3))) + 8 * ((tid & 63) & 1); \
            const LAS unsigned char* v_lo = pbc + HV_VT + (8 * hh + q_) * 64 + (16 * (((tid & 63) >> 4) & 1) + 4 * ((tid & 63) & 3)) * 2; \
            S = MFMA32(lds_frag_tr(ka_lo, ka_hi), lds_frag_tr(v_lo, v_lo + 4 * 64), S); S = MFMA32(lds_frag_tr(ka_lo + 4096, ka_hi + 4096), lds_frag_tr(v_lo + 16 * 64, v_lo + 20 * 64), S); \
            _Pragma("unroll") \
            for (int q4 = 0; q4 < 4; ++q4) { const f32x4 e0 = *(const LAS f32x4*)(EGL + 32 * kt + 8 * q4 + 4 * hh); \
                _Pragma("unroll") \
                for (int j = 0; j < 4; ++j) S[4 * q4 + j] *= e0[j]; } \
        } else { \
            if (w == 4) { LAS float* OB = (LAS float*)(Lb + HV_OB + ((c) & 1) * HV_OBUF); f32x16 o; \
                _Pragma("unroll") \
                for (int i = 0; i < 16; ++i) o[i] = 0.f; \
                f32x16 X; \
                _Pragma("unroll") \
                for (int i = 0; i < 16; ++i) X[i] = 0.f; \
                const LAS unsigned char* ka_rowp = pbc + HV_KA + r * 256; const int ka_sw = ((r & 3) << 2) | ((r >> 2) & 3); const LAS unsigned char* qa_nat = pbc + HV_QA + r * 272 + hh * 16; \
                { f32x16 Xb, Xc, Xd;                                                 \
                _Pragma("unroll") \
                for (int i = 0; i < 16; ++i) { Xb[i] = 0.f; Xc[i] = 0.f; Xd[i] = 0.f; } \
                _Pragma("unroll") \
                for (int ks = 0; ks < 8; ks += 4) { X = MFMA32(lds_frag16(ka_rowp + 16 * ((2 * ks + hh) ^ ka_sw)), lds_frag16(qa_nat + ks * 32), X); Xb = MFMA32(lds_frag16(ka_rowp + 16 * ((2 * ks + 2 + hh) ^ ka_sw)), lds_frag16(qa_nat + ks * 32 + 32), Xb); \
                    Xc = MFMA32(lds_frag16(ka_rowp + 16 * ((2 * ks + 4 + hh) ^ ka_sw)), lds_frag16(qa_nat + ks * 32 + 64), Xc); Xd = MFMA32(lds_frag16(ka_rowp + 16 * ((2 * ks + 6 + hh) ^ ka_sw)), lds_frag16(qa_nat + ks * 32 + 96), Xd); } \
                X = (X + Xb) + (Xc + Xd); } \
                _Pragma("unroll") \
                for (int i = 0; i < 16; ++i) { const int srow = (i & 3) + 8 * (i >> 2) + 4 * hh; X[i] = (srow <= r) ? X[i] : 0.f; } \
                const LAS unsigned char* v4_lo = pbc + HV_VT + (4 * hh + (((tid & 63) >> 2) & 3)) * 64 + (16 * (((tid & 63) >> 4) & 1) + 4 * ((tid & 63) & 3)) * 2;        \
                o = MFMA32(lds_frag_tr(v4_lo, v4_lo + 8 * 64), ACC_FRAG(X, 0), o);                \
                o = MFMA32(lds_frag_tr(v4_lo + 16 * 64, v4_lo + 24 * 64), ACC_FRAG(X, 1), o); \
                LAS float* ob4 = OB + (4 * 32 + r) * 36 + 4 * hh; \
                _Pragma("unroll") \
                for (int q4 = 0; q4 < 4; ++q4) *(LAS f32x4*)(ob4 + 8 * q4) = (f32x4){o[4 * q4], o[4 * q4 + 1], o[4 * q4 + 2], o[4 * q4 + 3]}; \
            } \
            if (w == 5 || w == 6) { if ((c) > 1) { HGV_FLUSH((c) - 2) } if ((c) > 0) { HGV_OUT((c) - 1) } }        \
        } \
        LDS_BARRIER(); \
        } }
#define HGV_OUT(cp) { const LAS float* OB = (const LAS float*)(Lb + HV_OB + ((cp) & 1) * HV_OBUF); const int tl = tid - 320, t = tl >> 2, v0 = (tl & 3) * 8; f32x4 oa = (f32x4){0.f, 0.f, 0.f, 0.f}, ob_ = oa; \
            _Pragma("unroll") \
            for (int sl = 0; sl < 5; ++sl) { oa = oa + *(const LAS f32x4*)(OB + (32 * sl + t) * 36 + v0); ob_ = ob_ + *(const LAS f32x4*)(OB + (32 * sl + t) * 36 + v0 + 4); } \
            float sq = ((oa.x * oa.x + oa.y * oa.y) + (oa.z * oa.z + oa.w * oa.w)) + ((ob_.x * ob_.x + ob_.y * ob_.y) + (ob_.z * ob_.z + ob_.w * ob_.w)); \
            sq += __int_as_float(__builtin_amdgcn_update_dpp(0, __float_as_int(sq), 0x102, 0xf, 0xf, true)); sq += __int_as_float(__builtin_amdgcn_update_dpp(0, __float_as_int(sq), 0x101, 0xf, 0xf, true));   \
            sq_pend = sq; ow_pend.x = pk2(oa.x, oa.y); ow_pend.y = pk2(oa.z, oa.w); ow_pend.z = pk2(ob_.x, ob_.y); ow_pend.w = pk2(ob_.z, ob_.w); }
#define HGV_FLUSH(cp) { const int tl = tid - 320, t = tl >> 2, v0 = (tl & 3) * 8; const size_t row = rowb + 32 * (cp) + t; \
            if ((tl & 3) == 0) SSQH[row * 32 + hd * 4 + vt] = sq_pend; *(v4u*)(OU + row * 1024 + hd * 128 + 32 * vt + v0) = ow_pend; }
#pragma unroll 1
    for (int cc = 0; cc < 64; cc += 2) { HGV_ITER(cc, pqA, pkA, pxA) HGV_ITER(cc + 1, pqB, pkB, pxB) }
    if (w == 5 || w == 6) { HGV_FLUSH(62) HGV_OUT(63) HGV_FLUSH(63) }
#undef HGV_ITER
#undef HGV_OUT
#undef HGV_FLUSH
#undef HGV_LOAD
#undef HGV_STORE
    if (w < 4) { float* st_g = F.out + O_HGP + (size_t)(b * 8 + hd) * 16384 + 32 * vt + r;
#pragma unroll
        for (int i = 0; i < 16; ++i) { const int k = 32 * kt + (i & 3) + 8 * (i >> 2) + 4 * hh; st_g[(size_t)k * 128] = S[i]; } }
    __syncthreads();
}
__device__ __forceinline__ void hgnorm_phase(Frame& F) {
    const int gw = F.vcu * NWAVES + F.wave, NGW = F.G * NWAVES; bf16* ON = (bf16*)(F.ws + WS_ON); const float* SSQH = (const float*)(F.ws + WS_SSQH);
    const bf16* HG = (const bf16*)(F.ws + WS_PROJ) + (size_t)S_HG * SLOT_ELEMS;
    for (int row = gw; row < TP; row += NGW) {
#pragma unroll
        for (int j = 0; j < 2; ++j) { const int pc = j * 64 + F.lane, hd = pc >> 4;
            const f32x4 sp = *(const f32x4*)(SSQH + (size_t)row * 32 + hd * 4); const float rs = __builtin_amdgcn_rsqf(((sp.x + sp.y) + (sp.z + sp.w)) * (1.0f / 128.0f) + EPS);
            v4u* p = (v4u*)(ON + (size_t)row * 1024) + pc; const v4u o = *p; const v4u g = ld_nt16((const v4u*)(HG + (size_t)row * 1024) + pc); v4u res;
#pragma unroll
            for (int e = 0; e < 4; ++e) res[e] = pk2(bf2f(o[e] & 0xffffu) * rs * silu_f(bf2f(g[e] & 0xffffu)), __uint_as_float(o[e] & 0xffff0000u) * rs * silu_f(__uint_as_float(g[e] & 0xffff0000u)));
            *p = res; }
    }
}
constexpr int SD_BN = 0, SD_CN = 17408, SD_BT = 34816, SD_XT = 53248, SD_HT = 62464, SD_YA = 97280, SD_YY = 113664, SD_YO = 130048, SD_CUM = 134144, SD_DTV = 134400, SD_ECUM = 134656, SD_XWT = 134912, SD_CWL = 144128;
__device__ __forceinline__ void ssd_unit_mfma(Frame& F, int gb, int h) {
    int tid_o = F.tid; asm volatile("" : "+v"(tid_o));
    const int tid = tid_o, lane = tid & 63, w = F.wave, r = lane & 31, hh = lane >> 5; unsigned char* ws = F.ws;
    const int L = SEQ; const size_t row_base = (size_t)gb * SEQ;
    const int g = h >> 3;
    LAS unsigned char* Lb = F.lds + RING_OFF;
    LAS unsigned short* BN = (LAS unsigned short*)(Lb + SD_BN); LAS unsigned short* CN = (LAS unsigned short*)(Lb + SD_CN);
    LAS unsigned short* BT = (LAS unsigned short*)(Lb + SD_BT); LAS unsigned short* XT = (LAS unsigned short*)(Lb + SD_XT);
    LAS unsigned short* HT = (LAS unsigned short*)(Lb + SD_HT);
    LAS unsigned short* XWT = (LAS unsigned short*)(Lb + SD_XWT);
    LAS float* YA = (LAS float*)(Lb + SD_YA); LAS float* YY = (LAS float*)(Lb + SD_YY); LAS unsigned short* YO = (LAS unsigned short*)(Lb + SD_YO);
    LAS float* CUM = (LAS float*)(Lb + SD_CUM); LAS float* DTV = (LAS float*)(Lb + SD_DTV); LAS float* ECUM = (LAS float*)(Lb + SD_ECUM);
    const bf16* PROJ = (const bf16*)(ws + WS_PROJ); const float* DTR = (const float*)(ws + WS_DT); bf16* YG = (bf16*)(ws + WS_YG); float* SSQ = (float*)(ws + WS_SSQSSD);
    f32x16 H0, H1, H2, H3;
#pragma unroll
    for (int i = 0; i < 16; ++i) { H0[i] = 0.f; H1[i] = 0.f; H2[i] = 0.f; H3[i] = 0.f; }
    float* const st_base = F.out + O_SSMP + (size_t)(gb * 32 + h) * 8192 + (size_t)r * 128 + 4 * hh;
#define SSD_PUBLISH(HX, TILE, BUF) { LAS unsigned short* hp_ = HT + (BUF) * 8704 + (32 * ((TILE) & 1) + r) * 136 + 32 * ((TILE) >> 1) + 4 * hh; \
        _Pragma("unroll") for (int q4 = 0; q4 < 4; ++q4) { v2u pk; pk.x = cvtpk_c(HX[4 * q4], HX[4 * q4 + 1]); pk.y = cvtpk_c(HX[4 * q4 + 2], HX[4 * q4 + 3]); *(LAS v2u*)(hp_ + 8 * q4) = pk; } }
    if (w == 3) { SSD_PUBLISH(H0, 0, 0) SSD_PUBLISH(H1, 1, 0) SSD_PUBLISH(H2, 2, 0) SSD_PUBLISH(H3, 3, 0) } else if (w >= 4) { SSD_PUBLISH(H0, w, 0) }
    const float a = -__expf(F.in[13][h]), dtb = F.in[12][h], Dk = F.in[14][h];
    const float* cw = F.in[10]; const float* cbp = F.in[11];
    typedef float f32x2 __attribute__((ext_vector_type(2)));
    const int col = h * 64 + 2 * (tid & 31);
    const bf16* cptr = PROJ + (size_t)(S_X0 + (col >> 10)) * SLOT_ELEMS + row_base * 1024 + (col & 1023);
    const f32x2 cw0 = *(const f32x2*)(cw + col), cw1 = *(const f32x2*)(cw + 3072 + col), cw2 = *(const f32x2*)(cw + 2 * 3072 + col), cw3 = *(const f32x2*)(cw + 3 * 3072 + col), cbb = *(const f32x2*)(cbp + col);
    const bf16* BCS = (const bf16*)(ws + WS_BCS) + row_base * 1024 + g * 128;
    unsigned xr[7]; v4u pc[4];
#pragma unroll
    for (int i = 0; i < 7; ++i) { const int gt = 4 * (tid >> 5) - 3 + i; xr[i] = 0u; if (gt >= 0) xr[i] = *(const unsigned*)(cptr + (size_t)gt * 1024); }
#pragma unroll
    for (int j = 0; j < 4; ++j) { const int idx = (tid + 512 * j) & 1023; pc[j] = *(const v4u*)(BCS + (size_t)(idx >> 4) * 1024 + (j >> 1) * 512 + 8 * (idx & 15)); }
    __syncthreads();
    v4u ow_pend = (v4u){0u, 0u, 0u, 0u}; float sq_pend = 0.f; bool pend = false;
    int buf = 0;
    float dt_pf = 0.f;
    if (lane < L) dt_pf = DTR[(row_base + lane) * 32 + h];
    v4u zw_pf = ld_nt16(PROJ + (size_t)(S_Z0 + (h >> 4)) * SLOT_ELEMS + (row_base + (tid >> 3)) * 1024 + (h & 15) * 64 + (tid & 7) * 8);
    for (int t0 = 0; t0 < L; t0 += 64, buf ^= 1) {
        int r_l = r, hh_l = hh, tid_l = tid, lane_l = lane;
        asm volatile("" : "+v"(r_l), "+v"(hh_l), "+v"(tid_l), "+v"(lane_l));
        { const int r = r_l, hh = hh_l, tid = tid_l, lane = lane_l;
        float dtv = 0.f;
        if (t0 + lane < L) { const float x = dt_pf + dtb; dtv = fmaxf(x, 0.f) + 0.6931471805599453f * __builtin_amdgcn_logf(1.0f + __builtin_amdgcn_exp2f(-1.4426950408889634f * fabsf(x))); }
        dt_pf = 0.f; if (t0 + 64 + lane < L) dt_pf = DTR[(row_base + t0 + 64 + lane) * 32 + h];
        const v4u zw = zw_pf; zw_pf = (v4u){0u, 0u, 0u, 0u};
        if (t0 + 64 + (tid >> 3) < L) zw_pf = ld_nt16(PROJ + (size_t)(S_Z0 + (h >> 4)) * SLOT_ELEMS + (row_base + t0 + 64 + (tid >> 3)) * 1024 + (h & 15) * 64 + (tid & 7) * 8);
        float cum = dtv * a;
#define SSD_DPP_ADD(ctrl, rmask) cum += __int_as_float(__builtin_amdgcn_update_dpp(0, __float_as_int(cum), ctrl, rmask, 0xf, true))
        SSD_DPP_ADD(0x111, 0xf); SSD_DPP_ADD(0x112, 0xf); SSD_DPP_ADD(0x114, 0xf); SSD_DPP_ADD(0x118, 0xf);
        SSD_DPP_ADD(0x142, 0xa); SSD_DPP_ADD(0x143, 0xc);
#undef SSD_DPP_ADD
        const float cum_last = __int_as_float(__builtin_amdgcn_readlane(__float_as_int(cum), 63));
        const float wgt = __expf(cum_last - cum) * dtv;
        if (w == 0) { CUM[lane] = cum; DTV[lane] = dtv; ECUM[lane] = __expf(cum); }
#pragma unroll
        for (int j = 0; j < 4; ++j) { const int idx = (tid + 512 * j) & 1023;
            if (j < 2) { const int row = idx >> 4; *(LAS v4u*)((LAS unsigned char*)BN + 256 * row + 16 * ((idx & 15) ^ (((row & 3) << 2) | ((row >> 2) & 3)))) = pc[j]; }
            else *(LAS v4u*)(CN + (idx >> 4) * 136 + 8 * (idx & 15)) = pc[j]; }
        if (pend) { const size_t prow = row_base + (t0 - 64) + (tid >> 3);
            *(v4u*)(YG + prow * 2048 + h * 64 + (tid & 7) * 8) = ow_pend; if ((tid & 7) == 0) SSQ[prow * 32 + h] = sq_pend; pend = false; }
        { const int cp = tid & 31, sq = tid >> 5; const int wu = __builtin_amdgcn_readfirstlane(w);
          f32x2 xv[7];
#pragma unroll
          for (int i = 0; i < 7; ++i) xv[i] = (f32x2){__uint_as_float(xr[i] << 16), __uint_as_float(xr[i] & 0xffff0000u)};
          unsigned po[4], pw[4];
          f32x2 o[4], ow[4];
#pragma unroll
          for (int k = 0; k < 4; ++k) {
              const float w_lo = __int_as_float(__builtin_amdgcn_readlane(__float_as_int(wgt), 8 * wu + k)), w_hi = __int_as_float(__builtin_amdgcn_readlane(__float_as_int(wgt), 8 * wu + 4 + k));
              const float wx = hh ? w_hi : w_lo;
              f32x2 a = cw0 * xv[k] + cbb; a = cw1 * xv[k + 1] + a; a = cw2 * xv[k + 2] + a; a = cw3 * xv[k + 3] + a;
              const f32x2 t = a * (-1.4426950408889634f); f32x2 e; e.x = __builtin_amdgcn_exp2f(t.x); e.y = __builtin_amdgcn_exp2f(t.y); e = e + 1.0f;
              f32x2 rc; rc.x = __builtin_amdgcn_rcpf(e.x); rc.y = __builtin_amdgcn_rcpf(e.y); o[k] = a * rc; ow[k] = o[k] * wx; }
          po[0] = pk2(o[0].x, o[1].x); po[1] = pk2(o[2].x, o[3].x); po[2] = pk2(o[0].y, o[1].y); po[3] = pk2(o[2].y, o[3].y);
          pw[0] = pk2(ow[0].x, ow[1].x); pw[1] = pk2(ow[2].x, ow[3].x); pw[2] = pk2(ow[0].y, ow[1].y); pw[3] = pk2(ow[2].y, ow[3].y);
          *(LAS v2u*)(XT + (2 * cp) * 72 + 4 * sq) = (v2u){po[0], po[1]}; *(LAS v2u*)(XT + (2 * cp + 1) * 72 + 4 * sq) = (v2u){po[2], po[3]};
          *(LAS v2u*)(XWT + (2 * cp) * 72 + 4 * sq) = (v2u){pw[0], pw[1]}; *(LAS v2u*)(XWT + (2 * cp + 1) * 72 + 4 * sq) = (v2u){pw[2], pw[3]};
        }
        if (t0 + 64 < L) {
#pragma unroll
            for (int i = 0; i < 7; ++i) xr[i] = *(const unsigned*)(cptr + (size_t)(t0 + 64 + 4 * (tid >> 5) - 3 + i) * 1024);
#pragma unroll
            for (int j = 0; j < 4; ++j) { const int idx = (tid + 512 * j) & 1023; pc[j] = *(const v4u*)(BCS + (size_t)(t0 + 64 + (idx >> 4)) * 1024 + (j >> 1) * 512 + 8 * (idx & 15)); }
        }
        LDS_BARRIER();
        if (w < 3) {
            const int tt = w == 0 ? 0 : 1, st = w == 1 ? 1 : 0;
            f32x16 X, ya0, ya1;
#pragma unroll
            for (int i = 0; i < 16; ++i) { X[i] = 0.f; ya0[i] = 0.f; ya1[i] = 0.f; }
            const LAS unsigned char* cn_nat = Lb + SD_CN + (32 * tt + r) * 272 + hh * 16; const int bn_sw = ((r & 3) << 2) | ((r >> 2) & 3); const LAS unsigned char* bn_row = Lb + SD_BN + (32 * st + r) * 256;
            { f32x16 Xb;
#pragma unroll
              for (int i = 0; i < 16; ++i) Xb[i] = 0.f;
#pragma unroll
              for (int ks = 0; ks < 8; ks += 2) { X = MFMA32(lds_frag16(bn_row + 16 * ((2 * ks + hh) ^ bn_sw)), lds_frag16(cn_nat + ks * 32), X); Xb = MFMA32(lds_frag16(bn_row + 16 * ((2 * ks + 2 + hh) ^ bn_sw)), lds_frag16(cn_nat + ks * 32 + 32), Xb); }
              X = X + Xb; }
            const float cum_t = CUM[32 * tt + r];
#pragma unroll
            for (int q4 = 0; q4 < 4; ++q4) { const f32x4 cs = *(const LAS f32x4*)(CUM + 32 * st + 8 * q4 + 4 * hh), ds = *(const LAS f32x4*)(DTV + 32 * st + 8 * q4 + 4 * hh);
#pragma unroll
                for (int jj = 0; jj < 4; ++jj) { const int s_abs = 32 * st + 8 * q4 + 4 * hh + jj; const float f = __expf(cum_t - cs[jj]) * ds[jj]; X[4 * q4 + jj] = (s_abs <= 32 * tt + r) ? X[4 * q4 + jj] * f : 0.f;        } }
            const bf16x8 xf0 = ACC_FRAG(X, 0), xf1 = ACC_FRAG(X, 1);
            const LAS unsigned char* xt_row = Lb + SD_XT + r * 144 + (32 * st + 4 * hh) * 2;
            ya0 = MFMA32(lds_frag8x2(xt_row), xf0, ya0); ya0 = MFMA32(lds_frag8x2(xt_row + 32), xf1, ya0);
            ya1 = MFMA32(lds_frag8x2(xt_row + 32 * 144), xf0, ya1); ya1 = MFMA32(lds_frag8x2(xt_row + 32 * 144 + 32), xf1, ya1);
            if (w < 2) { LAS float* yb = YA + (32 * tt + r) * 64;
#pragma unroll
                for (int q4 = 0; q4 < 4; ++q4) { const int ch = 2 * q4 + hh;
                    *(LAS f32x4*)(yb + 4 * (ch ^ (r & 15))) = (f32x4){ya0[4 * q4], ya0[4 * q4 + 1], ya0[4 * q4 + 2], ya0[4 * q4 + 3]};
                    *(LAS f32x4*)(yb + 4 * ((ch + 8) ^ (r & 15))) = (f32x4){ya1[4 * q4], ya1[4 * q4 + 1], ya1[4 * q4 + 2], ya1[4 * q4 + 3]}; } }
            else { LAS unsigned char* yb = (LAS unsigned char*)YO + r * 128;
#pragma unroll
                for (int q4 = 0; q4 < 4; ++q4) { const int ch = 2 * q4 + hh; v2u p0, p1;
                    p0.x = cvtpk_c(ya0[4 * q4], ya0[4 * q4 + 1]); p0.y = cvtpk_c(ya0[4 * q4 + 2], ya0[4 * q4 + 3]); p1.x = cvtpk_c(ya1[4 * q4], ya1[4 * q4 + 1]); p1.y = cvtpk_c(ya1[4 * q4 + 2], ya1[4 * q4 + 3]);
                    *(LAS v2u*)(yb + 8 * (ch ^ ((r & 7) << 1))) = p0; *(LAS v2u*)(yb + 8 * ((ch + 8) ^ ((r & 7) << 1))) = p1; } }
        } else if (w >= 4) {
            const int tt = (w - 4) >> 1, ptj = w & 1;
            const LAS unsigned char* ht_nat = Lb + SD_HT + buf * 17408 + (32 * ptj + r) * 272 + hh * 16;
            f32x16 yi;
#pragma unroll
            for (int i = 0; i < 16; ++i) yi[i] = 0.f;
            const LAS unsigned char* cn_nat = Lb + SD_CN + (32 * tt + r) * 272 + hh * 16;
            { f32x16 yb2;
#pragma unroll
              for (int i = 0; i < 16; ++i) yb2[i] = 0.f;
#pragma unroll 2
              for (int ks = 0; ks < 8; ks += 2) { yi = MFMA32(lds_frag16(cn_nat + ks * 32), lds_frag16(ht_nat + ks * 32), yi); yb2 = MFMA32(lds_frag16(cn_nat + ks * 32 + 32), lds_frag16(ht_nat + ks * 32 + 32), yb2); }
              yi = yi + yb2; }
            const LAS unsigned short* xt_p = XT + (32 * ptj + r) * 72 + 32 * tt + 4 * hh;
#pragma unroll
            for (int q4 = 0; q4 < 4; ++q4) { const f32x4 ec = *(const LAS f32x4*)(ECUM + 32 * tt + 8 * q4 + 4 * hh); const v2u xw = *(const LAS v2u*)(xt_p + 8 * q4);
                const float x0 = bf2f(xw.x & 0xffffu), x1 = bf2f(xw.x >> 16), x2 = bf2f(xw.y & 0xffffu), x3 = bf2f(xw.y >> 16);
                LAS float* yb = YY + (32 * tt + 8 * q4 + 4 * hh) * 64 + 32 * ptj + r;
                yb[0] = ec[0] * yi[4 * q4] + Dk * x0; yb[64] = ec[1] * yi[4 * q4 + 1] + Dk * x1; yb[128] = ec[2] * yi[4 * q4 + 2] + Dk * x2; yb[192] = ec[3] * yi[4 * q4 + 3] + Dk * x3; }
        }
#define SSD_UPD(HX, TILE) { const int q_ = (lane >> 2) & 3, ch_ = 4 * ((TILE) >> 1) + 2 * ((lane >> 4) & 1) + ((lane >> 1) & 1); \
            const LAS unsigned char* bn_lo = Lb + SD_BN + (8 * hh + q_) * 256 + 16 * (ch_ ^ ((q_ << 2) | ((2 * hh) & 3))) + 8 * (lane & 1); \
            const LAS unsigned char* bn_hi = Lb + SD_BN + (8 * hh + 4 + q_) * 256 + 16 * (ch_ ^ ((q_ << 2) | ((2 * hh + 1) & 3))) + 8 * (lane & 1); \
            const LAS unsigned char* xt_nat = Lb + SD_XWT + (32 * ((TILE) & 1) + r) * 144 + hh * 16; \
            f32x16 Ha, Hb; \
            _Pragma("unroll") for (int i = 0; i < 16; ++i) { Ha[i] = 0.f; Hb[i] = 0.f; } \
            Ha = MFMA32(lds_frag_tr(bn_lo, bn_hi), lds_frag16(xt_nat), Ha); Hb = MFMA32(lds_frag_tr(bn_lo + 4096, bn_hi + 4096), lds_frag16(xt_nat + 32), Hb); \
            Ha = MFMA32(lds_frag_tr(bn_lo + 8192, bn_hi + 8192), lds_frag16(xt_nat + 64), Ha); Hb = MFMA32(lds_frag_tr(bn_lo + 12288, bn_hi + 12288), lds_frag16(xt_nat + 96), Hb);         \
            _Pragma("unroll") for (int i = 0; i < 16; ++i) HX[i] = HX[i] * el + (Ha[i] + Hb[i]); \
            SSD_PUBLISH(HX, TILE, buf ^ 1) }
        if (w >= 3) { const float el = ECUM[63];
            if (w == 3) { SSD_UPD(H0, 0) SSD_UPD(H1, 1) SSD_UPD(H2, 2) SSD_UPD(H3, 3) } else { SSD_UPD(H0, w) } }
        LDS_BARRIER();
        { const int tt = tid >> 3, p0 = (tid & 7) * 8;
          if (t0 + tt < L) { const size_t row = row_base + t0 + tt;
            const int c0 = 2 * (tid & 7);
            f32x4 y0 = *(const LAS f32x4*)(YA + tt * 64 + 4 * (c0 ^ (tt & 15))) + *(const LAS f32x4*)(YY + tt * 64 + p0), y1 = *(const LAS f32x4*)(YA + tt * 64 + 4 * ((c0 + 1) ^ (tt & 15))) + *(const LAS f32x4*)(YY + tt * 64 + p0 + 4);
            if (tt >= 32) { const v4u ow4 = *(const LAS v4u*)((const LAS unsigned char*)YO + (tt - 32) * 128 + 16 * ((tid & 7) ^ (tt & 7)));
                y0 = y0 + (f32x4){bf2f(ow4.x & 0xffffu), __uint_as_float(ow4.x & 0xffff0000u), bf2f(ow4.y & 0xffffu), __uint_as_float(ow4.y & 0xffff0000u)};
                y1 = y1 + (f32x4){bf2f(ow4.z & 0xffffu), __uint_as_float(ow4.z & 0xffff0000u), bf2f(ow4.w & 0xffffu), __uint_as_float(ow4.w & 0xffff0000u)}; }
            float o[8]; float sq = 0.f;
#pragma unroll
            for (int j = 0; j < 8; ++j) { const unsigned z16 = (zw[j >> 1] >> ((j & 1) * 16)) & 0xffffu; const float yv = (j < 4 ? y0[j & 3] : y1[j & 3]) * silu_f(bf2f(z16)); o[j] = yv; sq += yv * yv; }
            ow_pend.x = pk2(o[0], o[1]); ow_pend.y = pk2(o[2], o[3]); ow_pend.z = pk2(o[4], o[5]); ow_pend.w = pk2(o[6], o[7]);
            sq += __int_as_float(__builtin_amdgcn_update_dpp(0, __float_as_int(sq), 0x104, 0xf, 0xf, true));
            sq += __int_as_float(__builtin_amdgcn_update_dpp(0, __float_as_int(sq), 0x102, 0xf, 0xf, true));
            sq += __int_as_float(__builtin_amdgcn_update_dpp(0, __float_as_int(sq), 0x101, 0xf, 0xf, true)); sq_pend = sq; pend = true; } }
        }
    }
    if (pend) { const size_t prow = row_base + (L - 64) + (tid >> 3); *(v4u*)(YG + prow * 2048 + h * 64 + (tid & 7) * 8) = ow_pend; if ((tid & 7) == 0) SSQ[prow * 32 + h] = sq_pend; }
#define SSD_STOUT(HX, TILE) { float* st_g = st_base + (size_t)(32 * ((TILE) & 1)) * 128 + 32 * ((TILE) >> 1); \
        _Pragma("unroll") for (int q4 = 0; q4 < 4; ++q4) *(f32x4*)(st_g + 8 * q4) = (f32x4){HX[4 * q4], HX[4 * q4 + 1], HX[4 * q4 + 2], HX[4 * q4 + 3]}; }
    if (w == 3) { SSD_STOUT(H0, 0) SSD_STOUT(H1, 1) SSD_STOUT(H2, 2) SSD_STOUT(H3, 3) } else if (w >= 4) { SSD_STOUT(H0, w) }
#undef SSD_STOUT
#undef SSD_UPD
#undef SSD_PUBLISH
    __syncthreads();
}
__device__ __forceinline__ float tr_reduce32(const float (&v)[32], int lane) {
    const bool b4 = lane & 16, b3 = lane & 8, b2 = lane & 4, b1 = lane & 2, b0 = lane & 1;
    float a[16], b[8], c[4], d[2];
#pragma unroll
    for (int i = 0; i < 16; ++i) { const float keep = b4 ? v[i + 16] : v[i], send = b4 ? v[i] : v[i + 16]; a[i] = keep + __shfl_xor(send, 16); }
#pragma unroll
    for (int i = 0; i < 8; ++i) { const float keep = b3 ? a[i + 8] : a[i], send = b3 ? a[i] : a[i + 8]; b[i] = keep + __shfl_xor(send, 8); }
#pragma unroll
    for (int i = 0; i < 4; ++i) { const float keep = b2 ? b[i + 4] : b[i], send = b2 ? b[i] : b[i + 4]; c[i] = keep + __shfl_xor(send, 4); }
#pragma unroll
    for (int i = 0; i < 2; ++i) { const float keep = b1 ? c[i + 2] : c[i], send = b1 ? c[i] : c[i + 2]; d[i] = keep + __shfl_xor(send, 2); }
    const float keep = b0 ? d[1] : d[0], send = b0 ? d[0] : d[1];
    return keep + __shfl_xor(send, 1);
}
__device__ __forceinline__ void ssd_sample_unit(Frame& F, int sb, int g) {
    int tid_o = F.tid; asm volatile("" : "+v"(tid_o));
    const int tid = tid_o, lane = tid & 63, w = F.wave, hh = lane >> 5, nq = lane & 31; unsigned char* ws = F.ws;
    LAS float* XC = (LAS float*)(F.lds + RING_OFF); LAS float* BC = XC + 8 * 4 * 64; LAS float* CC = BC + 4 * 128; LAS float* DTS = CC + 4 * 128;
    const bf16* PROJ = (const bf16*)(ws + WS_PROJ); const float* DTR = (const float*)(ws + WS_DT); bf16* YG = (bf16*)(ws + WS_YG); float* SSQ = (float*)(ws + WS_SSQSSD);
    const size_t row0 = (size_t)TP + (size_t)sb * LS;
    const int h = 8 * g + w;
    const float* sp = F.in[3] + (size_t)(sb * 32 + h) * 8192 + (size_t)hh * 128 + 4 * nq;
    f32x4 hst[32];
#pragma unroll
    for (int i = 0; i < 32; ++i) hst[i] = ld_nt(sp + (size_t)i * 256);
    if (tid < 384) { typedef float f32x2 __attribute__((ext_vector_type(2)));
        const int col = tid < 256 ? g * 512 + 2 * tid : (tid < 320 ? 2048 + g * 128 + 2 * (tid - 256) : 2560 + g * 128 + 2 * (tid - 320));
        const float* cw = F.in[10]; const float* sc = F.in[4] + (size_t)sb * 3 * 3072 + col;
        const f32x2 w0 = *(const f32x2*)(cw + col), w1 = *(const f32x2*)(cw + 3072 + col), w2 = *(const f32x2*)(cw + 2 * 3072 + col), w3 = *(const f32x2*)(cw + 3 * 3072 + col), cb = *(const f32x2*)(F.in[11] + col);
        f32x2 full[7]; full[0] = *(const f32x2*)sc; full[1] = *(const f32x2*)(sc + 3072); full[2] = *(const f32x2*)(sc + 2 * 3072);
        const bf16* cp = PROJ + (size_t)(S_X0 + (col >> 10)) * SLOT_ELEMS + row0 * 1024 + (col & 1023);
#pragma unroll
        for (int t = 0; t < 4; ++t) { const unsigned wd = *(const unsigned*)(cp + (size_t)t * 1024); full[3 + t] = (f32x2){__uint_as_float(wd << 16), __uint_as_float(wd & 0xffff0000u)}; }
#pragma unroll
        for (int t = 0; t < 4; ++t) { f32x2 a = w0 * full[t] + cb; a = w1 * full[t + 1] + a; a = w2 * full[t + 2] + a; a = w3 * full[t + 3] + a;
            f32x2 o; o.x = silu_f(a.x); o.y = silu_f(a.y);
            LAS float* dst = tid < 256 ? XC + ((tid >> 5) * 4 + t) * 64 + 2 * (tid & 31) : (tid < 320 ? BC + t * 128 + 2 * (tid - 256) : CC + t * 128 + 2 * (tid - 320));
            *(LAS f32x2*)dst = o; }
    } else if (tid < 416) { const int idx = tid - 384, hl = idx >> 2, t = idx & 3; const float x = DTR[(row0 + t) * 32 + 8 * g + hl] + F.in[12][8 * g + hl]; DTS[idx] = x > 20.f ? x : log1pf(__expf(x)); }
    __syncthreads();
    const float a = -__expf(F.in[13][h]), Dk = F.in[14][h];
#pragma unroll 1
    for (int t = 0; t < 4; ++t) {
        const float dtv = DTS[w * 4 + t], dA = __expf(dtv * a);
        const f32x4 Bv = *(const LAS f32x4*)(BC + t * 128 + 4 * nq), Cv = *(const LAS f32x4*)(CC + t * 128 + 4 * nq);
        const LAS float* xrow = XC + (w * 4 + t) * 64;
        float part[32];
#pragma unroll
        for (int i = 0; i < 32; ++i) { const float xd = xrow[2 * i + hh] * dtv; hst[i] = hst[i] * dA + Bv * xd; part[i] = (hst[i].x * Cv.x + hst[i].y * Cv.y) + (hst[i].z * Cv.z + hst[i].w * Cv.w); }
        float yv = tr_reduce32(part, lane);
        const int p = 2 * nq + hh; const size_t row = row0 + t;
        yv += Dk * xrow[p];
        const float z = bf2f(PROJ[(size_t)(S_Z0 + (h >> 4)) * SLOT_ELEMS + row * 1024 + (h & 15) * 64 + p]);
        const float yg = yv * silu_f(z);
        YG[row * 2048 + h * 64 + p] = (bf16)f2bf(yg);
        const float sq = wave_sum(yg * yg);
        if (lane == 0) SSQ[row * 32 + h] = sq;
    }
    float* so = F.out + O_SSMS + (size_t)(sb * 32 + h) * 8192 + (size_t)hh * 128 + 4 * nq;
#pragma unroll
    for (int i = 0; i < 32; ++i) st_nt(so + (size_t)i * 256, hst[i]);
    __syncthreads();
}
__device__ __forceinline__ void hgrn_sample_unit(Frame& F, int sb, int hq) {
    int tid_o = F.tid; asm volatile("" : "+v"(tid_o));
    const int tid = tid_o, lane = tid & 63, w = F.wave, hh = lane >> 5, vq = lane & 31; unsigned char* ws = F.ws;
    LAS float* FS = (LAS float*)(F.lds + RING_OFF); LAS float* KS = FS + 2048; LAS float* QS = KS + 2048; LAS float* VS = QS + 2048; LAS float* OP = VS + 2048;
    const bf16* PROJ = (const bf16*)(ws + WS_PROJ); bf16* ON = (bf16*)(ws + WS_ON);
    const size_t row0 = (size_t)TP + (size_t)sb * LS;
    const int hl = w >> 1, kh = w & 1, hd = 4 * hq + hl;
    const float* sp = F.in[5] + (size_t)(sb * 8 + hd) * 16384 + (size_t)(64 * kh + hh) * 128 + 4 * vq;
    f32x4 S[32];
#pragma unroll
    for (int i = 0; i < 32; ++i) S[i] = ld_nt(sp + (size_t)i * 256);
    { const int ch = hq * 512 + tid; const float lb = __builtin_amdgcn_rcpf(1.0f + __expf(F.in[17][1024 + ch] - F.in[17][ch]));
      const bf16* fp = PROJ + (size_t)S_F * SLOT_ELEMS + row0 * 1024 + ch; const bf16* qp = PROJ + (size_t)S_Q * SLOT_ELEMS + row0 * 1024 + ch; const bf16* ip = PROJ + (size_t)S_I * SLOT_ELEMS + row0 * 1024 + ch;
#pragma unroll
      for (int t = 0; t < 4; ++t) { const float u = fminf(fmaxf(bf2f(fp[(size_t)t * 1024]), -30.f), 30.f); const float fg = lb + (1.0f - lb) * sigmoid_f(u);
          const int o = ((tid >> 7) * 4 + t) * 128 + (tid & 127);
          FS[o] = fg; KS[o] = 1.0f - fg; QS[o] = silu_f(bf2f(qp[(size_t)t * 1024])); VS[o] = bf2f(ip[(size_t)t * 1024]); } }
    __syncthreads();
#pragma unroll 1
    for (int t = 0; t < 4; ++t) {
        const int o = (hl * 4 + t) * 128;
        const f32x4 vv = *(const LAS f32x4*)(VS + o + 4 * vq);
        f32x4 oa = (f32x4){0.f, 0.f, 0.f, 0.f};
#pragma unroll
        for (int i = 0; i < 32; ++i) { const int k = 64 * kh + 2 * i + hh; const float fk = FS[o + k], kv = KS[o + k], qk = QS[o + k]; S[i] = S[i] * fk + vv * kv; oa = oa + S[i] * qk; }
        oa.x += __shfl_xor(oa.x, 32); oa.y += __shfl_xor(oa.y, 32); oa.z += __shfl_xor(oa.z, 32); oa.w += __shfl_xor(oa.w, 32);
        if (hh == 0) *(LAS f32x4*)(OP + ((hl * 4 + t) * 2 + kh) * 128 + 4 * vq) = oa;
    }
    float* so = F.out + O_HGS + (size_t)(sb * 8 + hd) * 16384 + (size_t)(64 * kh + hh) * 128 + 4 * vq;
#pragma unroll
    for (int i = 0; i < 32; ++i) st_nt(so + (size_t)i * 256, S[i]);
    __syncthreads();
#pragma unroll
    for (int rr2 = 0; rr2 < 2; ++rr2) { const int rr = 2 * w + rr2, ohl = rr >> 2, t = rr & 3, ohd = 4 * hq + ohl; typedef float f32x2 __attribute__((ext_vector_type(2)));
        const f32x2 p0 = *(const LAS f32x2*)(OP + (rr * 2) * 128 + 2 * lane), p1 = *(const LAS f32x2*)(OP + (rr * 2 + 1) * 128 + 2 * lane);
        const float o0 = p0.x + p1.x, o1 = p0.y + p1.y; const float sq = wave_sum(o0 * o0 + o1 * o1); const float rs = __builtin_amdgcn_rsqf(sq * (1.0f / 128.0f) + EPS);
        const size_t row = row0 + t; const unsigned gw = *(const unsigned*)(PROJ + (size_t)S_HG * SLOT_ELEMS + row * 1024 + ohd * 128 + 2 * lane);
        *(unsigned*)(ON + row * 1024 + ohd * 128 + 2 * lane) = pk2(o0 * rs * silu_f(bf2f(gw & 0xffffu)), o1 * rs * silu_f(__uint_as_float(gw & 0xffff0000u))); }
    __syncthreads();
}
constexpr int U_HGS = NBS * 2, U_SSDS = NBS * 4, U_CONV = NBP + NBS;
__device__ __forceinline__ void scan_phase(Frame& F) {
    gu32* head = F.ctl + CW_QUEUE;
#define SCAN_QUEUE(qi, count, body) for (;;) { if (F.tid == 0) F.MISC[0] = __hip_atomic_fetch_add(head + 64 * (qi), 1u, RLX_AGENT); __syncthreads(); const int u = (int)F.MISC[0]; __syncthreads(); if (u >= (count)) break; body }
    SCAN_QUEUE(1, NBP * 32, ssd_unit_mfma(F, u >> 5, u & 31);)
    SCAN_QUEUE(0, NBP * 32, hgrn_v_unit(F, u >> 5, (u >> 2) & 7, u & 3);)
    SCAN_QUEUE(2, U_HGS, hgrn_sample_unit(F, u >> 1, u & 1);)
    SCAN_QUEUE(3, U_SSDS + U_CONV, if (u >= U_SSDS) { conv_copy_unit(F, u - U_SSDS); continue; } ssd_sample_unit(F, u >> 2, u & 3);)
#undef SCAN_QUEUE
}
typedef float f32x4s __attribute__((ext_vector_type(4)));
template <class Epi> __device__ __forceinline__ void small_tile_phase(Frame& F, const bf16* A, const bf16* Bt, int K, const Epi& E) {
    const int lane = F.lane, w = F.wave, r = lane & 31, hh = lane >> 5;
#pragma unroll 1
    for (int v = F.vcu; v < 256; v += F.G) {
    const int mt = v >> 4, nt = v & 15;
    const int kw = K >> 3;
    const bf16* ap = A + (size_t)(TP + 32 * mt + r) * K + w * kw + 8 * hh;
    const bf16* bp = Bt + (size_t)(64 * nt + r) * K + w * kw + 8 * hh;
    f32x16 acc0, acc1;
#pragma unroll
    for (int i = 0; i < 16; ++i) { acc0[i] = 0.f; acc1[i] = 0.f; }
#pragma unroll 4
    for (int ks = 0; ks < kw / 16; ++ks) { const bf16x8 af = *(const bf16x8*)(ap + 16 * ks), b0 = *(const bf16x8*)(bp + 16 * ks), b1 = *(const bf16x8*)(bp + (size_t)32 * K + 16 * ks);
        acc0 = MFMA32(b0, af, acc0); acc1 = MFMA32(b1, af, acc1); }
    LAS float* part = (LAS float*)(F.lds + RING_OFF) + w * 2048;
#pragma unroll
    for (int q4 = 0; q4 < 4; ++q4) { *(LAS f32x4*)(part + r * 64 + 8 * q4 + 4 * hh) = (f32x4){acc0[4 * q4], acc0[4 * q4 + 1], acc0[4 * q4 + 2], acc0[4 * q4 + 3]};
        *(LAS f32x4*)(part + r * 64 + 32 + 8 * q4 + 4 * hh) = (f32x4){acc1[4 * q4], acc1[4 * q4 + 1], acc1[4 * q4 + 2], acc1[4 * q4 + 3]}; }
    __syncthreads();
    const int rl = F.tid >> 4, c4 = (F.tid & 15) * 4; const LAS float* src = (const LAS float*)(F.lds + RING_OFF) + rl * 64 + c4;
    f32x4 sum = *(const LAS f32x4*)src;
#pragma unroll
    for (int ww = 1; ww < 8; ++ww) sum = sum + *(const LAS f32x4*)(src + ww * 2048);
    const f32x4s acc = (f32x4s){sum.x, sum.y, sum.z, sum.w};
    E.small(F, acc, TP + 32 * mt + rl, 64 * nt + c4, nt);
    __syncthreads();
    }
}
template <bool ADD> struct SmGate { bf16* O; const bf16* gate;
    __device__ __forceinline__ void small(Frame&, const f32x4s& a, int row, int col, int) const { const size_t off = (size_t)row * 1024 + col;
        const v2u gw = __builtin_nontemporal_load((const v2u*)(gate + off)); v2u ow = (v2u){0u, 0u}; if (ADD) ow = *(const v2u*)(O + off);
        float rr[4];
#pragma unroll
        for (int e = 0; e < 4; ++e) { const unsigned g16 = (gw[e >> 1] >> ((e & 1) * 16)) & 0xffffu, o16 = (ow[e >> 1] >> ((e & 1) * 16)) & 0xffffu; rr[e] = (ADD ? bf2f(o16) : 0.f) + sigmoid_f(bf2f(g16)) * a[e]; }
        v2u wv; wv.x = cvtpk_c(rr[0], rr[1]); wv.y = cvtpk_c(rr[2], rr[3]); *(v2u*)(O + off) = wv; } };
template <bool BF, bool BSC = false> struct SmRes { const float* base; const bf16* bb; bf16* hb; float* ssqp; const float* bsc;
    __device__ __forceinline__ void small(Frame& F, const f32x4s& a, int row, int col, int nt) const { const size_t off = (size_t)row * 1024 + col; f32x4 b;
        if (BF) { const v2u w = *(const v2u*)(bb + off); b = (f32x4){bf2f(w.x & 0xffffu), __uint_as_float(w.x & 0xffff0000u), bf2f(w.y & 0xffffu), __uint_as_float(w.y & 0xffff0000u)}; }
        else b = *(const f32x4*)(base + off);
        if constexpr (BSC) b = b * bsc[row];
        const f32x4 v = b + (f32x4){a[0], a[1], a[2], a[3]};
        { v2u wv; wv.x = cvtpk_c(v[0], v[1]); wv.y = cvtpk_c(v[2], v[3]); *(v2u*)(hb + off) = wv; }
        float sq = (v[0] * v[0] + v[1] * v[1]) + (v[2] * v[2] + v[3] * v[3]); sq += __shfl_xor(sq, 1); sq += __shfl_xor(sq, 2); sq += __shfl_xor(sq, 4); sq += __shfl_xor(sq, 8);
        if ((F.tid & 15) == 0) ssqp[(size_t)row * 16 + nt] = sq; } };
struct SmScale { bf16* O; const float* ssq; float scale;
    __device__ __forceinline__ void small(Frame&, const f32x4s& a, int row, int col, int) const { const float rs = pg8::row_rs<16>(ssq, row) * scale;
        v2u wv; wv.x = cvtpk_c(a[0] * rs, a[1] * rs); wv.y = cvtpk_c(a[2] * rs, a[3] * rs); *(v2u*)(O + (size_t)row * 1024 + col) = wv; } };
__device__ __forceinline__ void attn_stage_tile(LAS unsigned char* Lb, const bf16* src, size_t pitch, int tid) {
#pragma unroll 1
    for (int hb = 0; hb < 2; ++hb) { v4u v[8];
#pragma unroll
        for (int i = 0; i < 8; ++i) { const int id = tid + 512 * (8 * hb + i), row = id >> 5, c = id & 31; v[i] = *(const v4u*)(src + (size_t)row * pitch + c * 8); }
#pragma unroll
        for (int i = 0; i < 8; ++i) { const int id = tid + 512 * (8 * hb + i), row = id >> 5, c = id & 31; *(LAS v4u*)(Lb + row * 512 + ((c ^ (row & 15)) << 4)) = v[i]; } }
}
__device__ __forceinline__ void attn_prompt_unit(Frame& F, int b, int hd, int qb) {
    const int tid = F.tid, lane = F.lane, w = F.wave, r = lane & 31, hh = lane >> 5; unsigned char* ws = F.ws;
    LAS unsigned char* Lb = F.lds + RING_OFF;
    const bf16* QB = (const bf16*)(ws + WS_QB); const bf16* KB = (const bf16*)(ws + WS_KB); const bf16* VT = (const bf16*)(ws + WS_VT); bf16* OB = (bf16*)(ws + WS_OB);
    const size_t qrow = (size_t)b * SEQ + (size_t)qb * 256 + 32 * w + r;
    attn_stage_tile(Lb, KB + (size_t)b * 256 * 1024 + hd * 256, 1024, tid);
    const bf16* qp = QB + qrow * 1024 + hd * 256 + 8 * hh;
    bf16x8 qf = *(const bf16x8*)qp;
    __syncthreads();
    f32x16 S[8];
#pragma unroll
    for (int t = 0; t < 8; ++t)
#pragma unroll
        for (int i = 0; i < 16; ++i) S[t][i] = 0.f;
    const int sw = r & 15;
#pragma unroll 1
    for (int ks = 0; ks < 16; ++ks) {
        const bf16x8 qn = *(const bf16x8*)(qp + 16 * (ks < 15 ? ks + 1 : ks));
        const LAS unsigned char* kp = Lb + r * 512 + (((2 * ks + hh) ^ sw) << 4);
#pragma unroll
        for (int t = 0; t < 8; ++t) S[t] = MFMA32(lds_frag16(kp + t * 32 * 512), qf, S[t]);
        qf = qn;
    }
    float m = -3.0e38f;
#pragma unroll
    for (int t = 0; t < 8; ++t)
#pragma unroll
        for (int i = 0; i < 16; ++i) m = fmaxf(m, S[t][i]);
    m = fmaxf(m, __shfl_xor(m, 32));
    float l = 0.f;
#pragma unroll
    for (int t = 0; t < 8; ++t)
#pragma unroll
        for (int i = 0; i < 16; ++i) { const float pv = __builtin_amdgcn_exp2f(S[t][i] - m); S[t][i] = pv; l += pv; }
    l += __shfl_xor(l, 32);
    const float rl = __builtin_amdgcn_rcpf(l);
    bf16x8 pf[8][2];
#pragma unroll
    for (int t = 0; t < 8; ++t) { pf[t][0] = ACC_FRAG(S[t], 0); pf[t][1] = ACC_FRAG(S[t], 1); }
    __syncthreads();
    attn_stage_tile(Lb, VT + (size_t)(b * 4 + hd) * 256 * 256, 256, tid);
    __syncthreads();
    bf16* op = OB + qrow * 1024 + hd * 256 + 4 * hh;
#pragma unroll 1
    for (int dt = 0; dt < 8; ++dt) {
        f32x16 O;
#pragma unroll
        for (int i = 0; i < 16; ++i) O[i] = 0.f;
        const LAS unsigned char* vrow = Lb + (32 * dt + r) * 512 + 8 * hh;
#pragma unroll
        for (int t = 0; t < 8; ++t)
#pragma unroll
            for (int s2 = 0; s2 < 2; ++s2) {
                const v2u lo = *(const LAS v2u*)(vrow + (((4 * t + 2 * s2) ^ sw) << 4)), hi = *(const LAS v2u*)(vrow + (((4 * t + 2 * s2 + 1) ^ sw) << 4));
                const v4u wv4 = (v4u){lo.x, lo.y, hi.x, hi.y};
                O = MFMA32(__builtin_bit_cast(bf16x8, wv4), pf[t][s2], O);
            }
#pragma unroll
        for (int q4 = 0; q4 < 4; ++q4) { v2u o; o.x = cvtpk_c(O[4 * q4] * rl, O[4 * q4 + 1] * rl); o.y = cvtpk_c(O[4 * q4 + 2] * rl, O[4 * q4 + 3] * rl);
            *(v2u*)(op + 32 * dt + 8 * q4) = o; }
    }
    __syncthreads();
}
__device__ __forceinline__ void attn_sample_unit(Frame& F, int sb, int hd) {
    const int tid = F.tid, lane = F.lane, w = F.wave; unsigned char* ws = F.ws;
    LAS float* sc = (LAS float*)(F.lds + RING_OFF);
    LAS float* red = sc + 4 * 256;
    const bf16* QB = (const bf16*)(ws + WS_QB); bf16* OB = (bf16*)(ws + WS_OB);
    const size_t rowq = (size_t)TP + (size_t)sb * LS;
    float q[4][4];
#pragma unroll
    for (int t = 0; t < 4; ++t) { const v2u qw = *(const v2u*)(QB + (rowq + t) * 1024 + hd * 256 + 4 * lane); q[t][0] = bf2f(qw.x & 0xffffu); q[t][1] = bf2f(qw.x >> 16); q[t][2] = bf2f(qw.y & 0xffffu); q[t][3] = bf2f(qw.y >> 16); }
    const float* Kc = F.in[6] + ((size_t)sb * 256 * 4 + hd) * 256 + 4 * lane; const float* Vc = F.in[7] + ((size_t)sb * 256 * 4 + hd) * 256 + 4 * lane;
    f32x4 kv[8], kn[8];
#pragma unroll
    for (int u = 0; u < 8; ++u) kv[u] = ld_nt(Kc + (size_t)(w * 32 + u) * 1024);
#pragma unroll 1
    for (int kk0 = 0; kk0 < 32; kk0 += 8) {
#pragma unroll
        for (int u = 0; u < 8; ++u) kn[u] = kk0 < 24 ? ld_nt(Kc + (size_t)(w * 32 + kk0 + 8 + u) * 1024) : ld_nt(Vc + (size_t)(w * 32 + u) * 1024);
        { float part[32];
#pragma unroll
          for (int u = 0; u < 8; ++u)
#pragma unroll
              for (int t = 0; t < 4; ++t) part[4 * u + t] = (q[t][0] * kv[u].x + q[t][1] * kv[u].y) + (q[t][2] * kv[u].z + q[t][3] * kv[u].w);
          float sv = tr_reduce32(part, lane); sv += __shfl_xor(sv, 32);
          if (lane < 32) sc[(lane & 3) * 256 + w * 32 + kk0 + (lane >> 2)] = sv; }
#pragma unroll
        for (int u = 0; u < 8; ++u) kv[u] = kn[u]; }
    __syncthreads();
    if (w < 4) { float v[4]; float m = -3.0e38f;
#pragma unroll
        for (int j = 0; j < 4; ++j) { v[j] = sc[w * 256 + j * 64 + lane]; m = fmaxf(m, v[j]); }
        m = wave_max(m); float l = 0.f;
#pragma unroll
        for (int j = 0; j < 4; ++j) { v[j] = __builtin_amdgcn_exp2f(v[j] - m); l += v[j]; }
        l = wave_sum(l); const float rl = 1.0f / l;
#pragma unroll
        for (int j = 0; j < 4; ++j) sc[w * 256 + j * 64 + lane] = v[j] * rl; }
    __syncthreads();
    float o[4][4];
#pragma unroll
    for (int t = 0; t < 4; ++t)
#pragma unroll
        for (int e = 0; e < 4; ++e) o[t][e] = 0.f;
#pragma unroll 1
    for (int kk0 = 0; kk0 < 32; kk0 += 8) {
        if (kk0 < 24) {
#pragma unroll
            for (int u = 0; u < 8; ++u) kn[u] = ld_nt(Vc + (size_t)(w * 32 + kk0 + 8 + u) * 1024); }
#pragma unroll
        for (int u = 0; u < 8; ++u) { const int key = w * 32 + kk0 + u;
#pragma unroll
            for (int t = 0; t < 4; ++t) { const float pr = sc[t * 256 + key]; o[t][0] += pr * kv[u].x; o[t][1] += pr * kv[u].y; o[t][2] += pr * kv[u].z; o[t][3] += pr * kv[u].w; } }
#pragma unroll
        for (int u = 0; u < 8; ++u) kv[u] = kn[u]; }
#pragma unroll
    for (int t = 0; t < 4; ++t) *(LAS f32x4*)(red + (w * 4 + t) * 256 + 4 * lane) = (f32x4){o[t][0], o[t][1], o[t][2], o[t][3]};
    __syncthreads();
    { const int t = tid >> 7, d0 = (tid & 127) * 2; float a0 = 0.f, a1 = 0.f;
#pragma unroll
      for (int ww = 0; ww < 8; ++ww) { a0 += red[(ww * 4 + t) * 256 + d0]; a1 += red[(ww * 4 + t) * 256 + d0 + 1]; }
      *(unsigned*)(OB + (rowq + t) * 1024 + hd * 256 + d0) = pk2(a0, a1); }
    __syncthreads();
}
__device__ __forceinline__ void attn_phase(Frame& F) {
    const bool sample_first = (blockIdx.x >> 3) & 1;
    for (int pass = 0; pass < 2; ++pass) {
        if ((pass == 0) != sample_first) { for (int u = F.vcu; u < NBP * 4 * 8; u += F.G) attn_prompt_unit(F, u >> 5, (u >> 3) & 3, u & 7); }
        else { for (int u = F.vcu; u < NBS * 4; u += F.G) attn_sample_unit(F, u >> 2, u & 3); }
    }
}
__device__ __forceinline__ void final_norm_phase(Frame& F) {
    const int gw = F.vcu * NWAVES + F.wave, NGW = F.G * NWAVES; const float* SSQ = (const float*)(F.ws + WS_SSQP3); const float* wn = F.in[31]; const bf16* HB = (const bf16*)(F.ws + WS_HB);
    f32x4 wv[4];
#pragma unroll
    for (int j = 0; j < 2; ++j) { wv[2 * j] = *((const f32x4*)wn + 2 * (64 * j + F.lane)); wv[2 * j + 1] = *((const f32x4*)wn + 2 * (64 * j + F.lane) + 1); }
    for (int row = gw; row < T; row += NGW) {
        const f32x4* sp = (const f32x4*)(SSQ + (size_t)row * 16); float s = 0.f;
#pragma unroll
        for (int j = 0; j < 4; ++j) { const f32x4 a = sp[j]; s += (a.x + a.y) + (a.z + a.w); }
        const float rs = __builtin_amdgcn_rsqf(s * (1.0f / 1024.0f) + EPS);
#pragma unroll
        for (int j = 0; j < 2; ++j) { const int pc = 64 * j + F.lane; const v4u w = ld_nt16((const v4u*)(HB + (size_t)row * 1024) + pc);
            const f32x4 v0 = (f32x4){bf2f(w.x & 0xffffu), __uint_as_float(w.x & 0xffff0000u), bf2f(w.y & 0xffffu), __uint_as_float(w.y & 0xffff0000u)};
            const f32x4 v1 = (f32x4){bf2f(w.z & 0xffffu), __uint_as_float(w.z & 0xffff0000u), bf2f(w.w & 0xffffu), __uint_as_float(w.w & 0xffff0000u)};
            float* o = F.out + O_Y + (size_t)row * 1024 + 8 * pc; st_nt(o, v0 * rs * wv[2 * j]); st_nt(o + 4, v1 * rs * wv[2 * j + 1]); }
    }
}
#ifndef MK_N_LAUNCHES
#define MK_N_LAUNCHES 1
#endif
constexpr int PER_PHASE = 13;
constexpr int N_LAUNCHES = MK_N_LAUNCHES;
struct Args { const float* in[32]; float* out; unsigned char* ws; int ph_lo, ph_hi; };
__global__ void __launch_bounds__(NTHR, 2) skel_fwd(Args args) {
    extern __shared__ __attribute__((aligned(16))) unsigned char lds[];
    Frame F;
    F.lds = (LAS unsigned char*)lds;
    F.MISC = (volatile LAS unsigned*)(F.lds + MISC_OFF);
    F.tid = threadIdx.x; F.lane = F.tid & 63; F.wave = __builtin_amdgcn_readfirstlane(F.tid >> 6);
    F.G = gridDim.x; { const int bx = blockIdx.x; F.vcu = (F.G % 8 == 0) ? (bx % 8) * (F.G / 8) + bx / 8 : bx; }
    unsigned char* ws = args.ws; F.ws = ws; F.out = args.out;
    F.ctl = (gu32*)(ws + WS_CTL);
#pragma unroll
    for (int i = 0; i < 32; ++i) F.in[i] = args.in[i];
    for (int u = F.tid; u < (LDS_BYTES - LDSCTL_OFF) / 4; u += NTHR) ((LAS unsigned*)(F.lds + LDSCTL_OFF))[u] = 0u;
    __syncthreads();
    XcdBarrier bar; bar.bar = (unsigned*)(F.ctl + CW_BAR); bar.x = 0; bar.st = nullptr;
    if (N_LAUNCHES == 1) bar = xcd_barrier_post((unsigned*)(F.ctl + CW_BAR), F.MISC + 8);
#define GRID_BAR() do { if (N_LAUNCHES == 1) xcd_barrier(bar); } while (0)
    const int lo = args.ph_lo, hi = args.ph_hi;
#ifdef ONLY_PHASE
#define IN(k) ((k) == ONLY_PHASE && lo <= (k) && (k) < hi)
#else
#define IN(k) (lo <= (k) && (k) < hi)
#endif
#define BOTH(k) (IN(k) && IN((k) + 1))
    bf16* const XB = (bf16*)(ws + WS_XB); bf16* const PROJ = (bf16*)(ws + WS_PROJ);
    float* const Y = F.out + O_Y;
    if (IN(0)) { p0_prologue(F); if (BOTH(0)) GRID_BAR(); }
    if (IN(1)) {
        { pg8::Gemm g{XB, (const bf16*)(ws + WS_WIN), T, NPROJ, 1024}; pg8::StaticOrder S; S.init(T, NPROJ, F.G, (int)blockIdx.x);
          pg8::EpiScaleBf16<0, true> E{PROJ, SLOT_ELEMS, nullptr, 1.0f, (float*)(ws + WS_DT)};
          pg8::gemm_phase<pg8::EpiScaleBf16<0, true>, pg8::StaticOrder, true, true>(F.lds + RING_OFF, g, S, E); }
        { pg8::Gemm g{(const bf16*)(ws + WS_MNB), (const bf16*)(ws + WS_WKV), MEMR, 2048, 1024}; pg8::StaticOrder S; S.init(MEMR, 2048, F.G, (int)((blockIdx.x + 64) % F.G));
          pg8::EpiKV E{F.out + O_MKP, F.out + O_MVP, (bf16*)(ws + WS_KB), (bf16*)(ws + WS_VT), (const float*)(ws + WS_SSQM)};
          pg8::gemm_phase<pg8::EpiKV, pg8::StaticOrder, true, true>(F.lds + RING_OFF, g, S, E); }
        if (BOTH(1)) GRID_BAR();
    }
    if (IN(2)) { bc_prep_phase(F); hg_prep_phase(F); if (BOTH(2)) GRID_BAR(); }
    if (IN(3)) { scan_phase(F); if (BOTH(3)) GRID_BAR(); }
    if (IN(4)) { ssdnorm_phase(F); hgnorm_phase(F); if (BOTH(4)) GRID_BAR(); }
    if (IN(5)) { { SmGate<false> Es{(bf16*)(ws + WS_MERGED), PROJ + (size_t)S_GS * SLOT_ELEMS}; small_tile_phase(F, (const bf16*)(ws + WS_YG), (const bf16*)(ws + WS_WSSD), 2048, Es); }
        pg8::Gemm g{(const bf16*)(ws + WS_YG), (const bf16*)(ws + WS_WSSD), TP, 1024, 2048}; pg8::StaticOrder S; S.init(TP, 1024, F.G, (int)blockIdx.x);
        pg8::EpiGate<false> E{(bf16*)(ws + WS_MERGED), PROJ + (size_t)S_GS * SLOT_ELEMS};
        pg8::gemm_phase<pg8::EpiGate<false>, pg8::StaticOrder, true, true>(F.lds + RING_OFF, g, S, E);
          }
    if (IN(5)) { { SmGate<true> Es{(bf16*)(ws + WS_MERGED), PROJ + (size_t)S_GH * SLOT_ELEMS}; small_tile_phase(F, (const bf16*)(ws + WS_ON), (const bf16*)(ws + WS_WHG), 1024, Es); }
        pg8::Gemm g{(const bf16*)(ws + WS_ON), (const bf16*)(ws + WS_WHG), TP, 1024, 1024}; pg8::StaticOrder S; S.init(TP, 1024, F.G, (int)blockIdx.x);
        pg8::EpiGate<true> E{(bf16*)(ws + WS_MERGED), PROJ + (size_t)S_GH * SLOT_ELEMS};
        pg8::gemm_phase<pg8::EpiGate<true>, pg8::StaticOrder, true, true>(F.lds + RING_OFF, g, S, E);
        if (BOTH(5)) GRID_BAR(); }
    if (IN(6)) { { SmRes<true, true> Es{nullptr, XB, (bf16*)(ws + WS_HB), (float*)(ws + WS_SSQP1), (const float*)(ws + WS_SSQX)}; small_tile_phase(F, (const bf16*)(ws + WS_MERGED), (const bf16*)(ws + WS_WOUT), 1024, Es); }
        pg8::Gemm g{(const bf16*)(ws + WS_MERGED), (const bf16*)(ws + WS_WOUT), TP, 1024, 1024}; pg8::StaticOrder S; S.init(TP, 1024, F.G, (int)blockIdx.x);
        pg8::EpiRes<true, true> E{nullptr, nullptr, XB, (bf16*)(ws + WS_HB), (float*)(ws + WS_SSQP1), (const float*)(ws + WS_SSQX)};
        pg8::gemm_phase<pg8::EpiRes<true, true>, pg8::StaticOrder, true, true>(F.lds + RING_OFF, g, S, E);
        if (BOTH(6)) GRID_BAR(); }
    if (IN(7)) { { SmScale Es{(bf16*)(ws + WS_QB), (const float*)(ws + WS_SSQP1), QSCALE}; small_tile_phase(F, (const bf16*)(ws + WS_HB), (const bf16*)(ws + WS_WCQ), 1024, Es); }
        pg8::Gemm g{(const bf16*)(ws + WS_HB), (const bf16*)(ws + WS_WCQ), TP, 1024, 1024}; pg8::StaticOrder S; S.init(TP, 1024, F.G, (int)blockIdx.x);
        pg8::EpiScaleBf16<16, false> E{(bf16*)(ws + WS_QB), SLOT_ELEMS, (const float*)(ws + WS_SSQP1), QSCALE, nullptr};
        pg8::gemm_phase<pg8::EpiScaleBf16<16, false>, pg8::StaticOrder, true, true>(F.lds + RING_OFF, g, S, E);
        if (BOTH(7)) GRID_BAR(); }
    if (IN(8)) { attn_phase(F); if (BOTH(8)) GRID_BAR(); }
    if (IN(9)) { { SmRes<true> Es{nullptr, (const bf16*)(ws + WS_HB), (bf16*)(ws + WS_HB), (float*)(ws + WS_SSQP2)}; small_tile_phase(F, (const bf16*)(ws + WS_OB), (const bf16*)(ws + WS_WCO), 1024, Es); }
        pg8::Gemm g{(const bf16*)(ws + WS_OB), (const bf16*)(ws + WS_WCO), TP, 1024, 1024}; pg8::StaticOrder S; S.init(TP, 1024, F.G, (int)blockIdx.x);
        pg8::EpiRes<true> E{nullptr, nullptr, (const bf16*)(ws + WS_HB), (bf16*)(ws + WS_HB), (float*)(ws + WS_SSQP2)};
        pg8::gemm_phase<pg8::EpiRes<true>, pg8::StaticOrder, true, true>(F.lds + RING_OFF, g, S, E);
        if (BOTH(9)) GRID_BAR(); }
    if (IN(10)) { pg8::Gemm g{(const bf16*)(ws + WS_HB), (const bf16*)(ws + WS_WGU), T, 2 * FFN, 1024}; pg8::StaticOrder S; S.init(T, 2 * FFN, F.G, (int)blockIdx.x);
        pg8::EpiSwiglu E{(bf16*)(ws + WS_ACT), (const float*)(ws + WS_SSQP2)};
        pg8::gemm_phase<pg8::EpiSwiglu, pg8::StaticOrder, true, true>(F.lds + RING_OFF, g, S, E);
        if (BOTH(10)) GRID_BAR(); }
    if (IN(11)) { { SmRes<true> Es{nullptr, (const bf16*)(ws + WS_HB), (bf16*)(ws + WS_HB), (float*)(ws + WS_SSQP3)}; small_tile_phase(F, (const bf16*)(ws + WS_ACT), (const bf16*)(ws + WS_WDN), FFN, Es); }
        pg8::Gemm g{(const bf16*)(ws + WS_ACT), (const bf16*)(ws + WS_WDN), TP, 1024, FFN}; pg8::StaticOrder S; S.init(TP, 1024, F.G, (int)blockIdx.x);
        pg8::EpiRes<true> E{nullptr, nullptr, (const bf16*)(ws + WS_HB), (bf16*)(ws + WS_HB), (float*)(ws + WS_SSQP3)};
        pg8::gemm_phase<pg8::EpiRes<true>, pg8::StaticOrder, true, true>(F.lds + RING_OFF, g, S, E);
        if (BOTH(11)) GRID_BAR(); }
    if (IN(12)) final_norm_phase(F);
#undef IN
#undef BOTH
}

extern "C" void kernel_launch(void* const* d_in, const int* in_sizes, int n_in, void* d_out, int out_size, void* d_ws, size_t ws_size, hipStream_t stream) {
    static int grid = 0;
    if (grid == 0) {
        const int want[32] = {TP * 1024, TS * 1024, MEMR * 1024, 33554432, 1179648, 16777216, 33554432, 33554432, 1024, 1024 * 11296, 4 * 3072, 3072, 32, 32, 32, 2048, 2048 * 1024, 2048, 1024,
                              1024 * 1024, 1024 * 1024, 1024, 1024, 1024 * 1024, 1024 * 1024, 1024 * 1024, 1024 * 1024, 1024, 1024 * FFN, 1024 * FFN, FFN * 1024, 1024};
        bool ok = (n_in == 32); for (int i = 0; ok && i < 32; ++i) if (in_sizes[i] != want[i]) { fprintf(stderr, "kernel_launch: input %d has %d elements, expected %d\n", i, in_sizes[i], want[i]); ok = false; }
        if (!ok || out_size != (int)O_END || ws_size < WS_END4) { fprintf(stderr, "kernel_launch: unexpected shapes: n_in %d out %d ws %zu\n", n_in, out_size, ws_size); grid = -1; return; }
        int dev = 0, cus = 0, per_cu = 0;
        if (hipGetDevice(&dev) != hipSuccess || hipDeviceGetAttribute(&cus, hipDeviceAttributeMultiprocessorCount, dev) != hipSuccess) { grid = -1; return; }
        if (hipFuncSetAttribute((const void*)skel_fwd, hipFuncAttributeMaxDynamicSharedMemorySize, LDS_BYTES) != hipSuccess) { fprintf(stderr, "kernel_launch: hipFuncSetAttribute failed\n"); grid = -1; return; }
        if (hipOccupancyMaxActiveBlocksPerMultiprocessor(&per_cu, (const void*)skel_fwd, NTHR, LDS_BYTES) != hipSuccess || per_cu < 1) fprintf(stderr, "kernel_launch: occupancy query reports %d blocks per CU\n", per_cu);
        (void)hipGetLastError();
        grid = cus;
    }
    if (grid < 0) return;
    (void)hipMemsetAsync((char*)d_ws + WS_CTL, 0, CTL_ZERO_BYTES, stream);
    Args a{};
    for (int i = 0; i < 32; ++i) a.in[i] = (const float*)d_in[i];
    a.out = (float*)d_out; a.ws = (unsigned char*)d_ws;
    for (int li = 0; li < N_LAUNCHES; ++li) {
        a.ph_lo = (N_LAUNCHES == PER_PHASE) ? li : 0; a.ph_hi = (N_LAUNCHES == PER_PHASE) ? li + 1 : PER_PHASE;
        hipLaunchKernelGGL(skel_fwd, dim3(grid), dim3(NTHR), LDS_BYTES, stream, a);
    }
}
```

```cpp
#include <hip/hip_runtime.h>
#include <cstdio>
#include <cstdint>
namespace pg8 {
#define PG8_LAS __attribute__((address_space(3)))
typedef unsigned short bf16_t;
typedef short bf16x8 __attribute__((ext_vector_type(8)));
typedef float f32x4 __attribute__((ext_vector_type(4)));
typedef unsigned u32x4 __attribute__((ext_vector_type(4)));
constexpr int BM = 256, BK = 64, HALF = 128, HTB = HALF * BK * 2  , STAGE_BYTES = 8 * HTB, NXCD = 8, WGM = 8;

__host__ __device__ __forceinline__ int lds_byte(int r, int c) { const int st = (r >> 4) * 2 + (c >> 5), rr = r & 15, cc = c & 31, ob = rr * 64 + cc * 2; return st * 1024 + (ob ^ (((ob >> 9) & 1) << 5)); }
__host__ __device__ __forceinline__ void stage_rc(int b, int& R, int& C) { const int st = b / 1024, sb = b % 1024, swz = sb ^ (((sb >> 9) & 1) << 5); R = (st >> 1) * 16 + swz / 64; C = (st & 1) * 32 + (swz % 64) / 2; }
__host__ __device__ __forceinline__ int perm32(int rho) { const int n = rho >> 4, i = rho & 15; return 8 * (i >> 2) + 4 * n + (i & 3); }

struct Unit { int pm, pn; };
struct Gemm { const bf16_t* A; const bf16_t* Bt; int M, N, K; };

struct StaticOrder {
    int nM, nN, nwg, G, c;
    __host__ __device__ void init(int M, int N, int G_, int c_) { nM = M / BM; nN = N / BM; nwg = nM * nN; G = G_; c = c_; }
    __host__ __device__ bool next(int i, Unit& u) const {
        const long L = (long)i * G + c; if (L >= nwg) return false;
        int wgid = (int)L; { const int q = nwg / NXCD, r = nwg % NXCD, xcd = wgid % NXCD, off = wgid / NXCD; wgid = (xcd < r ? xcd * (q + 1) : r * (q + 1) + (xcd - r) * q) + off; }
        const int nig = WGM * nN, gid = wgid / nig, fm = gid * WGM, gsz = (nM - fm) < WGM ? (nM - fm) : WGM;
        u.pm = fm + ((wgid % nig) % gsz); u.pn = (wgid % nig) / gsz; return true;
    }
    __device__ __forceinline__ void a_ready(const Unit&) const {}
    __device__ __forceinline__ void done(const Unit&) const {}
};

__device__ __forceinline__ unsigned cvt_pk_bf16(float lo, float hi) { unsigned r; asm volatile("v_cvt_pk_bf16_f32 %0, %1, %2" : "=v"(r) : "v"(lo), "v"(hi)); return r; }
typedef float f32x2 __attribute__((ext_vector_type(2)));
typedef unsigned u32x2 __attribute__((ext_vector_type(2)));
constexpr float RMS_EPS = 1e-6f;
__device__ __forceinline__ float bfbits2f(unsigned v16) { return __uint_as_float(v16 << 16); }
__device__ __forceinline__ float sigm(float x) { return __builtin_amdgcn_rcpf(1.0f + __expf(-x)); }
template <int NP> __device__ __forceinline__ float row_rs(const float* ssq, int row) {
    float s = 0.f;
    if constexpr (NP == 1) s = ssq[row];
    else {
#pragma unroll
        for (int i = 0; i < NP / 4; ++i) { const f32x4 v = *(const f32x4*)(ssq + (size_t)row * NP + 4 * i); s += (v[0] + v[1]) + (v[2] + v[3]); }
    }
    return 1.0f / sqrtf(s * (1.0f / 1024.0f) + RMS_EPS);
}
template <int NP, bool HAS_DT> struct EpiScaleBf16 {
    static constexpr bool PERM = true, AFTER_DRAIN = false;
    bf16_t* O; size_t slot_elems; const float* ssq; float scale; float* dt;
    __device__ __forceinline__ void operator()(const f32x4 (&acc)[2][2][4][2], const Unit& u, int wr, int wc, int fr, int fq) const {
        const int row0 = u.pm * BM + wr * 64 + fr;
        if (HAS_DT && u.pn == 44) {
            if (wc == 0) {
#pragma unroll
                for (int ai = 0; ai < 2; ++ai)
#pragma unroll
                    for (int m = 0; m < 4; ++m) { const int row = row0 + ai * HALF + m * 16; float rs = 1.0f; if constexpr (NP > 0) rs = row_rs<NP>(ssq, row);
                        float* p = dt + (size_t)row * 32 + 8 * fq; *(f32x4*)p = acc[ai][0][m][0] * rs; *(f32x4*)(p + 4) = acc[ai][0][m][1] * rs; }
            }
            return;
        }
        bf16_t* base = O + (size_t)(u.pn >> 2) * slot_elems; const int col0 = (u.pn & 3) * BM + wc * 32 + 8 * fq;
#pragma unroll
        for (int ai = 0; ai < 2; ++ai)
#pragma unroll
            for (int m = 0; m < 4; ++m) { const int row = row0 + ai * HALF + m * 16; float rs = scale; if constexpr (NP > 0) rs = row_rs<NP>(ssq, row) * scale; bf16_t* rowp = base + (size_t)row * 1024 + col0;
#pragma unroll
                for (int bj = 0; bj < 2; ++bj) { const f32x4 v0 = acc[ai][bj][m][0] * rs, v1 = acc[ai][bj][m][1] * rs;
                    u32x4 w; w.x = cvt_pk_bf16(v0[0], v0[1]); w.y = cvt_pk_bf16(v0[2], v0[3]); w.z = cvt_pk_bf16(v1[0], v1[1]); w.w = cvt_pk_bf16(v1[2], v1[3]);
                    if (HAS_DT) __builtin_nontemporal_store(w, (u32x4*)(rowp + bj * HALF));
                    else *(u32x4*)(rowp + bj * HALF) = w; } }
    }
};
struct EpiKV {
    static constexpr bool PERM = false, AFTER_DRAIN = false;
    float* mk; float* mv; bf16_t* kb; bf16_t* vt; const float* ssq;
    __device__ __forceinline__ void operator()(const f32x4 (&acc)[2][2][4][2], const Unit& u, int wr, int wc, int fr, int fq) const {
        const int row0 = u.pm * BM + wr * 64 + fr; const bool isv = u.pn >= 4; const int colt = (u.pn & 3) * BM + wc * 32 + 4 * fq;
#pragma unroll
        for (int ai = 0; ai < 2; ++ai)
#pragma unroll
            for (int m = 0; m < 4; ++m) { const int row = row0 + ai * HALF + m * 16; const float rs = 1.0f;
#pragma unroll
                for (int bj = 0; bj < 2; ++bj)
#pragma unroll
                    for (int n = 0; n < 2; ++n) { const int c = colt + bj * HALF + n * 16; const f32x4 v = acc[ai][bj][m][n] * rs;
                        if (!isv) { __builtin_nontemporal_store(v, (f32x4*)(mk + (size_t)row * 1024 + c)); u32x2 w; w.x = cvt_pk_bf16(v[0], v[1]); w.y = cvt_pk_bf16(v[2], v[3]); *(u32x2*)(kb + (size_t)row * 1024 + c) = w; }
                        else { __builtin_nontemporal_store(v, (f32x4*)(mv + (size_t)row * 1024 + c)); const int b = row >> 8, key = row & 255, hd = c >> 8, d = c & 255;
                            bf16_t* p = vt + ((size_t)((b * 4 + hd) * 256 + d)) * 256 + key; const unsigned w0 = cvt_pk_bf16(v[0], v[1]), w1 = cvt_pk_bf16(v[2], v[3]);
                            p[0] = (bf16_t)(w0 & 0xffffu); p[256] = (bf16_t)(w0 >> 16); p[512] = (bf16_t)(w1 & 0xffffu); p[768] = (bf16_t)(w1 >> 16); } } }
    }
};
template <bool ADD> struct EpiGate {
    static constexpr bool PERM = true, AFTER_DRAIN = false;
    bf16_t* O; const bf16_t* gate;
    __device__ __forceinline__ void operator()(const f32x4 (&acc)[2][2][4][2], const Unit& u, int wr, int wc, int fr, int fq) const {
        const int row0 = u.pm * BM + wr * 64 + fr, col0 = u.pn * BM + wc * 32 + 8 * fq;
#pragma unroll
        for (int ai = 0; ai < 2; ++ai)
#pragma unroll
            for (int m = 0; m < 4; ++m) { const size_t off = (size_t)(row0 + ai * HALF + m * 16) * 1024 + col0;
#pragma unroll
                for (int bj = 0; bj < 2; ++bj) { const u32x4 gw = __builtin_nontemporal_load((const u32x4*)(gate + off + bj * HALF)); u32x4 ow = (u32x4){0u, 0u, 0u, 0u}; if (ADD) ow = *(const u32x4*)(O + off + bj * HALF);
                    float r[8];
#pragma unroll
                    for (int e = 0; e < 8; ++e) { const unsigned g16 = (gw[e >> 1] >> ((e & 1) * 16)) & 0xffffu, o16 = (ow[e >> 1] >> ((e & 1) * 16)) & 0xffffu;
                        const float a = acc[ai][bj][m][e >> 2][e & 3]; r[e] = (ADD ? bfbits2f(o16) : 0.f) + sigm(bfbits2f(g16)) * a; }
                    u32x4 w; w.x = cvt_pk_bf16(r[0], r[1]); w.y = cvt_pk_bf16(r[2], r[3]); w.z = cvt_pk_bf16(r[4], r[5]); w.w = cvt_pk_bf16(r[6], r[7]);
                    *(u32x4*)(O + off + bj * HALF) = w; } }
    }
};
template <bool BF, bool BSC = false> struct EpiRes {
    static constexpr bool PERM = true, AFTER_DRAIN = false;
    const float* base0; const float* base1; const bf16_t* bb; bf16_t* hb; float* ssqp; const float* bsc;
    __device__ __forceinline__ void operator()(const f32x4 (&acc)[2][2][4][2], const Unit& u, int wr, int wc, int fr, int fq) const {
        const int row0 = u.pm * BM + wr * 64 + fr, col0 = u.pn * BM + wc * 32 + 8 * fq; const float* base = u.pm < 64 ? base0 : base1;
#pragma unroll
        for (int ai = 0; ai < 2; ++ai)
#pragma unroll
            for (int m = 0; m < 4; ++m) { const int row = row0 + ai * HALF + m * 16; const size_t off = (size_t)row * 1024 + col0; float sq = 0.f; float bs = 1.0f; if constexpr (BSC) bs = bsc[row];
#pragma unroll
                for (int bj = 0; bj < 2; ++bj) { const size_t o2 = off + bj * HALF; f32x4 b0, b1;
                    if (BF) { const u32x4 w = *(const u32x4*)(bb + o2); b0 = (f32x4){bfbits2f(w.x & 0xffffu), __uint_as_float(w.x & 0xffff0000u), bfbits2f(w.y & 0xffffu), __uint_as_float(w.y & 0xffff0000u)};
                        b1 = (f32x4){bfbits2f(w.z & 0xffffu), __uint_as_float(w.z & 0xffff0000u), bfbits2f(w.w & 0xffffu), __uint_as_float(w.w & 0xffff0000u)}; }
                    else { b0 = __builtin_nontemporal_load((const f32x4*)(base + o2)); b1 = __builtin_nontemporal_load((const f32x4*)(base + o2 + 4)); }
                    if constexpr (BSC) { b0 = b0 * bs; b1 = b1 * bs; }
                    const f32x4 v0 = b0 + acc[ai][bj][m][0], v1 = b1 + acc[ai][bj][m][1];
                    sq += ((v0[0] * v0[0] + v0[1] * v0[1]) + (v0[2] * v0[2] + v0[3] * v0[3])) + ((v1[0] * v1[0] + v1[1] * v1[1]) + (v1[2] * v1[2] + v1[3] * v1[3]));
                    u32x4 w; w.x = cvt_pk_bf16(v0[0], v0[1]); w.y = cvt_pk_bf16(v0[2], v0[3]); w.z = cvt_pk_bf16(v1[0], v1[1]); w.w = cvt_pk_bf16(v1[2], v1[3]); *(u32x4*)(hb + o2) = w; }
                sq += __shfl_xor(sq, 16); sq += __shfl_xor(sq, 32);
                if (fq == 0) ssqp[(size_t)row * 16 + u.pn * 4 + wc] = sq; }
    }
};
struct EpiSwiglu {
    static constexpr bool PERM = true, AFTER_DRAIN = false;
    bf16_t* act; const float* ssq;
    __device__ __forceinline__ void operator()(const f32x4 (&acc)[2][2][4][2], const Unit& u, int wr, int wc, int fr, int fq) const {
        const int row0 = u.pm * BM + wr * 64 + fr, col0 = u.pn * 128 + wc * 16 + 4 * fq;
#pragma unroll
        for (int ai = 0; ai < 2; ++ai)
#pragma unroll
            for (int m = 0; m < 4; ++m) { const int row = row0 + ai * HALF + m * 16; const float rs = row_rs<16>(ssq, row);
#pragma unroll
                for (int bj = 0; bj < 2; ++bj) { const f32x4 a = acc[ai][bj][m][0] * rs, b = acc[ai][bj][m][1] * rs;
                    const float r0 = a[0] * sigm(a[0]) * a[1], r1 = a[2] * sigm(a[2]) * a[3], r2 = b[0] * sigm(b[0]) * b[1], r3 = b[2] * sigm(b[2]) * b[3];
                    u32x2 w; w.x = cvt_pk_bf16(r0, r1); w.y = cvt_pk_bf16(r2, r3); *(u32x2*)(act + (size_t)row * 2816 + col0 + bj * 64) = w; } }
    }
};
template <class Epi, class Sched, bool ALIGN_EPI = false, bool SP2 = false, int EPI_REP = 1>
__device__ __forceinline__ void gemm_phase(PG8_LAS unsigned char* lds, const Gemm g, const Sched& S, const Epi& E) {
    const int tid = threadIdx.x, wid = __builtin_amdgcn_readfirstlane(tid >> 6), lane = tid & 63, wr = wid >> 2, wc = wid & 3, fr = lane & 15, fq = lane >> 4;
    const int K = g.K, nt = K / BK;
    unsigned voffA[2], voffB[2];
#pragma unroll
    for (int i = 0; i < 2; ++i) { int R, C; stage_rc(tid * 16 + i * 8192, R, C); const int Rb = Epi::PERM ? ((R & ~31) + perm32(R & 31)) : R;
        voffA[i] = (unsigned)(R * K + C) * 2u; voffB[i] = (unsigned)(Rb * K + C) * 2u; }
    const size_t kstep = (size_t)(BK * 2);
    const size_t hstep = (size_t)HALF * K * 2;
    const size_t tstep = 2 * hstep;
    const unsigned ldsw = (unsigned)wid * 1024u;
    const int aoff = lds_byte(wr * 64 + fr, fq * 8), boff = lds_byte(wc * 32 + fr, fq * 8);
#define PG8_SA(b, h) (((b) * 2 + (h)) * HTB)
#define PG8_SB(b, h) ((4 + (b) * 2 + (h)) * HTB)
#define PG8_STAGE(bufoff, gbase, voff) do { _Pragma("unroll") for (int _i = 0; _i < 2; ++_i) \
        __builtin_amdgcn_global_load_lds((const unsigned*)((const char*)(gbase) + (voff)[_i]), (PG8_LAS unsigned*)(lds + (bufoff) + ldsw + _i * 8192), 16, 0, 0); } while (0)
#define PG8_LDA(dst, b, h) do { _Pragma("unroll") for (int m = 0; m < 4; ++m) _Pragma("unroll") for (int k = 0; k < 2; ++k) dst[m][k] = *(const PG8_LAS bf16x8*)(lds + PG8_SA(b, h) + aoff + m * 2048 + k * 1024); } while (0)
#define PG8_LDB(dst, b, h) do { _Pragma("unroll") for (int n = 0; n < 2; ++n) _Pragma("unroll") for (int k = 0; k < 2; ++k) dst[n][k] = *(const PG8_LAS bf16x8*)(lds + PG8_SB(b, h) + boff + n * 2048 + k * 1024); } while (0)
#define PG8_MMA(ai, bj, At, Bt) do { __builtin_amdgcn_s_setprio(1); _Pragma("unroll") for (int m = 0; m < 4; ++m) _Pragma("unroll") for (int n = 0; n < 2; ++n) _Pragma("unroll") for (int k = 0; k < 2; ++k) \
        acc[ai][bj][m][n] = __builtin_amdgcn_mfma_f32_16x16x32_bf16(Bt[n][k], At[m][k], acc[ai][bj][m][n], 0, 0, 0); __builtin_amdgcn_s_setprio(0); } while (0)
#define PG8_WAIT_V(n) asm volatile("s_waitcnt vmcnt(" #n ")" ::: "memory")
#define PG8_WAIT_L(n) asm volatile("s_waitcnt lgkmcnt(" #n ")" ::: "memory")
#define PG8_BAR __builtin_amdgcn_s_barrier()
#define PG8_SCHED __builtin_amdgcn_sched_barrier(0)
    Unit cur, nxt; int ui = 0;
    if (!S.next(0, cur)) return;
    f32x4 acc[2][2][4][2];
#pragma unroll
    for (int a = 0; a < 2; ++a)
#pragma unroll
        for (int b = 0; b < 2; ++b)
#pragma unroll
            for (int m = 0; m < 4; ++m)
#pragma unroll
                for (int n = 0; n < 2; ++n) acc[a][b][m][n] = (f32x4){0.f, 0.f, 0.f, 0.f};
    bf16x8 At[4][2], B0[2][2], B1[2][2];
    const char* cA = (const char*)g.A + (size_t)cur.pm * tstep; const char* cB = (const char*)g.Bt + (size_t)cur.pn * tstep;
    S.a_ready(cur);
    if constexpr (SP2) {
        PG8_STAGE(PG8_SB(0, 0), cB, voffB); PG8_STAGE(PG8_SB(0, 1), cB + hstep, voffB); PG8_STAGE(PG8_SA(0, 0), cA, voffA); PG8_STAGE(PG8_SA(0, 1), cA + hstep, voffA);
        if (wr == 1) PG8_BAR;
        PG8_WAIT_V(2); PG8_BAR;
        PG8_STAGE(PG8_SB(1, 0), cB + kstep, voffB); PG8_STAGE(PG8_SA(1, 0), cA + kstep, voffA); PG8_STAGE(PG8_SB(1, 1), cB + hstep + kstep, voffB);
        PG8_WAIT_V(6); PG8_BAR;
    } else {
        PG8_STAGE(PG8_SB(0, 0), cB, voffB); PG8_STAGE(PG8_SA(0, 0), cA, voffA); PG8_STAGE(PG8_SB(0, 1), cB + hstep, voffB); PG8_STAGE(PG8_SA(0, 1), cA + hstep, voffA);
        if (wr == 1) PG8_BAR;
        PG8_WAIT_V(4); PG8_BAR;
        PG8_STAGE(PG8_SB(1, 0), cB + kstep, voffB); PG8_STAGE(PG8_SA(1, 0), cA + kstep, voffA); PG8_STAGE(PG8_SB(1, 1), cB + hstep + kstep, voffB);
        PG8_WAIT_V(6); PG8_BAR;
    }
    for (;;) {
        const bool has_next = S.next(ui + 1, nxt);
        const char* nA = has_next ? (const char*)g.A + (size_t)nxt.pm * tstep : cA; const char* nB = has_next ? (const char*)g.Bt + (size_t)nxt.pn * tstep : cB;
        for (int t = 0; t < nt; t += 2) {
            const bool last = (t == nt - 2);
            const char* a1 = cA + (size_t)(t + 1) * kstep;
            const char* a2 = last ? nA : cA + (size_t)(t + 2) * kstep; const char* b2 = last ? nB : cB + (size_t)(t + 2) * kstep;
            const char* a3 = a2 + kstep; const char* b3 = b2 + kstep;
            if (last && has_next) S.a_ready(nxt);
            if constexpr (SP2) {
            PG8_LDB(B0, 0, 0); PG8_LDB(B1, 0, 1); PG8_SCHED; PG8_LDA(At, 0, 0); PG8_STAGE(PG8_SA(1, 1), a1 + hstep, voffA);
            PG8_WAIT_V(8); PG8_WAIT_L(0); PG8_BAR; PG8_MMA(0, 0, At, B0); PG8_MMA(0, 1, At, B1); PG8_BAR; PG8_SCHED;
            PG8_LDA(At, 0, 1); PG8_STAGE(PG8_SB(0, 0), b2, voffB); PG8_STAGE(PG8_SB(0, 1), b2 + hstep, voffB); PG8_STAGE(PG8_SA(0, 0), a2, voffA);
            PG8_WAIT_V(8); PG8_WAIT_L(0); PG8_BAR; PG8_MMA(1, 0, At, B0); PG8_MMA(1, 1, At, B1); PG8_BAR; PG8_SCHED;
            PG8_LDB(B0, 1, 0); PG8_LDB(B1, 1, 1); PG8_SCHED; PG8_LDA(At, 1, 0); PG8_STAGE(PG8_SA(0, 1), a2 + hstep, voffA);
            PG8_WAIT_V(8); PG8_WAIT_L(0); PG8_BAR; PG8_MMA(0, 0, At, B0); PG8_MMA(0, 1, At, B1); PG8_BAR; PG8_SCHED;
            PG8_LDA(At, 1, 1); PG8_STAGE(PG8_SB(1, 0), b3, voffB); PG8_STAGE(PG8_SB(1, 1), b3 + hstep, voffB); PG8_STAGE(PG8_SA(1, 0), a3, voffA);
            PG8_WAIT_V(8); PG8_WAIT_L(0); PG8_BAR; PG8_MMA(1, 0, At, B0); PG8_MMA(1, 1, At, B1); PG8_BAR; PG8_SCHED;
            } else {
            PG8_LDB(B0, 0, 0); PG8_SCHED; PG8_LDA(At, 0, 0); PG8_STAGE(PG8_SA(1, 1), a1 + hstep, voffA);
            PG8_WAIT_L(8); PG8_BAR; PG8_WAIT_L(0); PG8_MMA(0, 0, At, B0); PG8_BAR; PG8_SCHED;
            PG8_LDB(B1, 0, 1); PG8_STAGE(PG8_SB(0, 0), b2, voffB);
            PG8_BAR; PG8_WAIT_L(0); PG8_MMA(0, 1, At, B1); PG8_BAR;
            PG8_LDA(At, 0, 1); PG8_STAGE(PG8_SA(0, 0), a2, voffA);
            PG8_BAR; PG8_WAIT_L(0); PG8_MMA(1, 0, At, B0); PG8_BAR; PG8_SCHED;
            PG8_STAGE(PG8_SB(0, 1), b2 + hstep, voffB);
            PG8_WAIT_V(6); PG8_BAR; PG8_MMA(1, 1, At, B1); PG8_BAR;
            PG8_LDB(B0, 1, 0); PG8_SCHED; PG8_LDA(At, 1, 0); PG8_STAGE(PG8_SA(0, 1), a2 + hstep, voffA);
            PG8_WAIT_L(8); PG8_BAR; PG8_WAIT_L(0); PG8_MMA(0, 0, At, B0); PG8_BAR; PG8_SCHED;
            PG8_LDB(B1, 1, 1); PG8_STAGE(PG8_SB(1, 0), b3, voffB);
            PG8_BAR; PG8_WAIT_L(0); PG8_MMA(0, 1, At, B1); PG8_BAR;
            PG8_LDA(At, 1, 1); PG8_STAGE(PG8_SA(1, 0), a3, voffA);
            PG8_BAR; PG8_WAIT_L(0); PG8_MMA(1, 0, At, B0); PG8_BAR; PG8_SCHED;
            PG8_STAGE(PG8_SB(1, 1), b3 + hstep, voffB);
            PG8_WAIT_V(6); PG8_BAR; PG8_MMA(1, 1, At, B1); PG8_BAR;
            }
        }
        if constexpr (ALIGN_EPI) { if (wr == 0) PG8_BAR; }
        if constexpr (!Epi::AFTER_DRAIN) { for (int rep = 0; rep < EPI_REP; ++rep) { E(acc, cur, wr, wc, fr, fq); asm volatile("" ::: "memory"); } S.done(cur); }
        if (!has_next) break;
#pragma unroll
        for (int a = 0; a < 2; ++a)
#pragma unroll
            for (int b = 0; b < 2; ++b)
#pragma unroll
                for (int m = 0; m < 4; ++m)
#pragma unroll
                    for (int n = 0; n < 2; ++n) acc[a][b][m][n] = (f32x4){0.f, 0.f, 0.f, 0.f};
        cur = nxt; cA = nA; cB = nB; ++ui;
        if constexpr (ALIGN_EPI) { if (wr == 1) PG8_BAR; }
    }
    PG8_WAIT_V(0);
    if constexpr (!ALIGN_EPI) { if (wr == 0) PG8_BAR; }
    PG8_BAR;
    if constexpr (Epi::AFTER_DRAIN) { E.fused(acc, cur, wr, wc, fr, fq, lds, wid, lane); S.done(cur); }
#undef PG8_SA
#undef PG8_SB
#undef PG8_STAGE
#undef PG8_LDA
#undef PG8_LDB
#undef PG8_MMA
#undef PG8_WAIT_V
#undef PG8_WAIT_L
#undef PG8_BAR
#undef PG8_SCHED
}
}
#define GAS __attribute__((address_space(1)))
#define LAS __attribute__((address_space(3)))
typedef unsigned short bf16;
typedef unsigned v4u __attribute__((ext_vector_type(4)));
typedef float f32x4 __attribute__((ext_vector_type(4)));
typedef short bf16x8 __attribute__((ext_vector_type(8)));
typedef GAS unsigned gu32;
typedef GAS unsigned long long gu64;
#define RLX_AGENT __ATOMIC_RELAXED, __HIP_MEMORY_SCOPE_AGENT
#define LDS_WAIT() asm volatile("s_waitcnt lgkmcnt(0)" ::: "memory")
#define VM_WAIT() asm volatile("s_waitcnt vmcnt(0)" ::: "memory")
__device__ __forceinline__ unsigned long long rt() { return __builtin_amdgcn_s_memrealtime(); }
typedef float f32x2_t __attribute__((ext_vector_type(2))); typedef __bf16 bf16x2_t __attribute__((ext_vector_type(2)));
__device__ __forceinline__ unsigned pk2(float lo, float hi) { const f32x2_t v = {lo, hi}; const bf16x2_t b = __builtin_convertvector(v, bf16x2_t); return __builtin_bit_cast(unsigned, b); }
__device__ __forceinline__ unsigned f2bf(float f) { return pk2(f, 0.f) & 0xffffu; }

#define XB_TMO      128
#define XB_XCNT(j)  (256  + 64 * (j))
#define XB_XSUB(j)  (1280 + 64 * (j))
#define XB_XGEN(j)  (2304 + 64 * (j))
#define XB_TOP      3328
#define XB_TOPGEN   3392
#define XCD_BAR_WORDS 3456
#define XB_SPIN_CAP (1u << 18)

__device__ __forceinline__ unsigned xb_ld(unsigned* p)              { return __hip_atomic_load(p, __ATOMIC_RELAXED, __HIP_MEMORY_SCOPE_AGENT); }
__device__ __forceinline__ unsigned xb_add(unsigned* p, unsigned v) { return __hip_atomic_fetch_add(p, v, __ATOMIC_RELAXED, __HIP_MEMORY_SCOPE_AGENT); }
__device__ __forceinline__ unsigned xb_xcc_id() { return (unsigned)__builtin_amdgcn_s_getreg((3 << 11) | 20) & 0xFu; }
#define XB_SPIN(cond, bar) do { unsigned _sp = 0; while (cond) { __builtin_amdgcn_s_sleep(1); \
    if ((++_sp & 255u) == 0u) { if (xb_ld(&(bar)[XB_TMO])) break; if (_sp > XB_SPIN_CAP) { atomicAdd(&(bar)[XB_TMO], 1u); break; } } } } while (0)

struct XcdBarrier {
    unsigned* bar; unsigned x;
    volatile LAS unsigned* st;
};

__device__ __forceinline__ XcdBarrier xcd_barrier_post(unsigned* bar, volatile LAS unsigned* st) {
    XcdBarrier b; b.bar = bar; b.x = xb_xcc_id(); b.st = st;
    if (threadIdx.x == 0) (void)xb_add(&bar[XB_XCNT(b.x)], 1u);
    return b;
}
__device__ __forceinline__ void xcd_barrier_complete(unsigned* bar, unsigned x, unsigned& nloc, unsigned& nx) {
    const unsigned G = gridDim.x * gridDim.y * gridDim.z;
    unsigned sum, cnt, mine, sp = 0u;
    for (;;) {
        sum = 0u; cnt = 0u; mine = 0u;
#pragma unroll
        for (unsigned j = 0; j < 16; ++j) { const unsigned c = xb_ld(&bar[XB_XCNT(j)]); sum += c; cnt += (c > 0u) ? 1u : 0u; mine = (j == x) ? c : mine; }
        if (sum == G) break;
        __builtin_amdgcn_s_sleep(1);
        if ((++sp & 255u) == 0u) { if (xb_ld(&bar[XB_TMO])) break; if (sp > XB_SPIN_CAP) { atomicAdd(&bar[XB_TMO], 1u); break; } }
    }
    nloc = mine > 0u ? mine : 1u; nx = cnt > 0u ? cnt : 1u;
}

__device__ __forceinline__ void xcd_barrier(const XcdBarrier& b) {
    asm volatile("s_waitcnt vmcnt(0)" ::: "memory");
    __syncthreads();
    if (threadIdx.x == 0) {
        unsigned* bar = b.bar;
        __builtin_amdgcn_s_waitcnt(0);
        unsigned nloc = b.st[0], nx = b.st[1];
        if (nloc == 0u) { xcd_barrier_complete(bar, b.x, nloc, nx); b.st[0] = nloc; b.st[1] = nx; }
        const unsigned old = xb_add(&bar[XB_XSUB(b.x)], 1u);
        const unsigned gen = old / nloc;
        if (old + 1u == (gen + 1u) * nloc) {
            __builtin_amdgcn_fence(__ATOMIC_RELEASE, "agent");
            asm volatile("s_waitcnt vmcnt(0)" ::: "memory");
            const unsigned og = xb_add(&bar[XB_TOP], 1u);
            const unsigned tg = og / nx;
            if (og + 1u == (tg + 1u) * nx) xb_add(&bar[XB_TOPGEN], 1u);
            else XB_SPIN(xb_ld(&bar[XB_TOPGEN]) == tg, bar);
            __builtin_amdgcn_fence(__ATOMIC_ACQUIRE, "agent");
            xb_add(&bar[XB_XGEN(b.x)], 1u);
            asm volatile("s_waitcnt vmcnt(0)" ::: "memory");
        } else {
            XB_SPIN(xb_ld(&bar[XB_XGEN(b.x)]) == gen, bar);
            __builtin_amdgcn_fence(__ATOMIC_ACQUIRE, "agent");
            asm volatile("s_waitcnt vmcnt(0)" ::: "memory");
        }
    }
    __syncthreads();
}
typedef unsigned v2u __attribute__((ext_vector_type(2)));
constexpr int NWAVES = 8, NTHR = 512;
constexpr int DM = 1024, TP = 16384, TS = 512, T = TP + TS;
constexpr int SEQ = 2048, NBP = 8, NBS = 128, LS = 4, MEMR = 2048;
constexpr int NPROJ = 11520;
constexpr int FFN = 2816;
constexpr float EPS = 1e-6f;
constexpr float QSCALE = 0.0625f * 1.4426950408889634f;

constexpr size_t MiB = 1u << 20;
constexpr size_t WS_CTL = 0, CTL_ZERO_BYTES = 32768;
constexpr size_t WS_SSQX = 1 * MiB, WS_SSQM = 1 * MiB + 512 * 1024;
constexpr size_t WS_DT = 2 * MiB, WS_SSQSSD = 5 * MiB, WS_SSQP1 = 8 * MiB, WS_SSQP2 = 9 * MiB + 512 * 1024, WS_SSQP3 = 11 * MiB;
constexpr size_t WS_WIN = 13 * MiB, WS_WKV = 36 * MiB, WS_WSSD = 40 * MiB, WS_WHG = 44 * MiB, WS_WOUT = 46 * MiB, WS_WCQ = 48 * MiB, WS_WCO = 50 * MiB, WS_WGU = 52 * MiB, WS_WDN = 63 * MiB;
constexpr size_t WS_XB = 69 * MiB, WS_MNB = 102 * MiB, WS_KB = 106 * MiB, WS_VT = 110 * MiB;
constexpr size_t SLOT = 33 * MiB, SLOT_ELEMS = (size_t)T * 1024;
constexpr size_t WS_PROJ = 114 * MiB;
constexpr size_t WS_YG = WS_PROJ + 11 * SLOT, WS_ON = WS_YG + 2 * SLOT, WS_END = WS_ON + SLOT;
static_assert(SLOT == SLOT_ELEMS * 2, "slot size");
static_assert(WS_WIN + (size_t)NPROJ * 1024 * 2 <= WS_WKV && WS_WGU + (size_t)2 * FFN * 1024 * 2 <= WS_WDN && WS_WDN + (size_t)1024 * FFN * 2 <= WS_XB && WS_SSQP3 + (size_t)T * 64 <= WS_WIN, "d_ws map");
static_assert(WS_DT + (size_t)T * 128 <= WS_SSQSSD && WS_SSQSSD + (size_t)T * 128 <= WS_SSQP1 && WS_SSQP1 + (size_t)T * 64 <= WS_SSQP2 && WS_SSQP2 + (size_t)T * 64 <= WS_SSQP3, "d_ws map 2");
enum { S_Z0 = 0, S_Z1 = 1, S_X0 = 2, S_X1 = 3, S_X2 = 4, S_Q = 5, S_F = 6, S_I = 7, S_HG = 8, S_GS = 9, S_GH = 10 };
constexpr size_t WS_MERGED = WS_PROJ + S_Q * SLOT, WS_HB = WS_PROJ + S_F * SLOT, WS_QB = WS_PROJ + S_I * SLOT, WS_OB = WS_PROJ + S_HG * SLOT, WS_ACT = WS_PROJ;
static_assert((size_t)T * FFN * 2 <= 3 * SLOT, "act overlay");
constexpr size_t O_Y = 0, O_SSMP = (size_t)T * 1024, O_CONVP = O_SSMP + 2097152, O_HGP = O_CONVP + 73728, O_MKP = O_HGP + 1048576, O_MVP = O_MKP + 2097152,
                 O_SSMS = O_MVP + 2097152, O_CONVS = O_SSMS + 33554432, O_HGS = O_CONVS + 1179648, O_END = O_HGS + 16777216;
constexpr int CW_QUEUE = 64;
constexpr int CW_BAR = 4096;
constexpr int RING_OFF = 0, RING_BYTES = 131072;
constexpr int LDS_BYTES = 147456;
constexpr int LDSCTL_OFF = LDS_BYTES - 1024, MISC_OFF = LDSCTL_OFF + 320;
struct Frame {
    LAS unsigned char* lds;
    volatile LAS unsigned* MISC;
    gu32* ctl;
    int tid, lane, wave;
    int vcu, G;
    const float* in[32];
    float* out; unsigned char* ws;
};
__device__ __forceinline__ float bf2f(unsigned v16) { return __uint_as_float(v16 << 16); }
__device__ __forceinline__ f32x4 ld_nt(const float* p) { return __builtin_nontemporal_load((const f32x4*)p); }
__device__ __forceinline__ void st_nt(float* p, f32x4 v) { __builtin_nontemporal_store(v, (f32x4*)p); }
__device__ __forceinline__ v4u ld_nt16(const void* p) { return __builtin_nontemporal_load((const v4u*)p); }
__device__ __forceinline__ unsigned ld_nt4(const void* p) { return __builtin_nontemporal_load((const unsigned*)p); }
__device__ __forceinline__ float sigmoid_f(float x) { return __builtin_amdgcn_rcpf(1.0f + __expf(-x)); }
__device__ __forceinline__ float silu_f(float x) { return x * sigmoid_f(x); }
__device__ __forceinline__ float wave_sum(float v) {
#pragma unroll
    for (int o = 1; o < 64; o <<= 1) v += __shfl_xor(v, o);
    return v;
}
__device__ __forceinline__ float wave_max(float v) {
#pragma unroll
    for (int o = 1; o < 64; o <<= 1) v = fmaxf(v, __shfl_xor(v, o));
    return v;
}
struct TSrc { const float* W; const float* W2; const float* ks; int ldw; int mode; };
__device__ __forceinline__ void p0_transpose_item(const TSrc& s, int K, int N, bf16* WT, LAS unsigned short* scr, int item, int lane) {
    const int nblk = N / 64, kb = item / nblk, nb = item % nblk, k0 = 64 * kb, n0 = 64 * nb;
    const int kr = lane >> 4, nq = lane & 15;
    const float* const Wa = s.W; const float* const Wb = s.W2;
    const float* src; int c0, cs; bool zero = false;
    if (s.mode == 2) { const float* wsel = Wa; if (nq >= 8) wsel = Wb; src = wsel + (n0 >> 1) + 4 * (nq & 7); c0 = 8 * (nq & 7) + (nq >> 3); cs = 2; }
    else { const int n = n0 + 4 * nq; c0 = 4 * nq; cs = 1;
        if (s.mode == 0) src = Wa + n;
        else if (s.mode == 1) { if (n < 5120) src = Wa + n; else if (n < 11264) src = Wa + n + 32; else if (n < 11296) src = Wa + 5120 + (n - 11264); else { src = Wa; zero = true; } }
        else { src = Wa + n; if (n >= 1024) src = Wb + (n - 1024); } }
    f32x4 v[16];
#pragma unroll
    for (int i = 0; i < 16; ++i) v[i] = zero ? (f32x4){0.f, 0.f, 0.f, 0.f} : ld_nt(src + (size_t)(k0 + 4 * i + kr) * s.ldw);
#pragma unroll
    for (int i = 0; i < 16; ++i) { const int kk = 4 * i + kr; const float sc = s.ks ? s.ks[k0 + kk] : 1.0f; const unsigned w0 = pk2(v[i].x * sc, v[i].y * sc), w1 = pk2(v[i].z * sc, v[i].w * sc);
        LAS unsigned short* d = scr + kk * 66 + c0;
        if (cs == 1) { *(LAS unsigned*)d = w0; *(LAS unsigned*)(d + 2) = w1; }
        else { d[0] = (unsigned short)(w0 & 0xffffu); d[2] = (unsigned short)(w0 >> 16); d[4] = (unsigned short)(w1 & 0xffffu); d[6] = (unsigned short)(w1 >> 16); } }
    LDS_WAIT(); asm volatile("" ::: "memory");
    const int nr = lane >> 3, kc = lane & 7;
#pragma unroll
    for (int j = 0; j < 8; ++j) { const int n = 8 * j + nr; const LAS unsigned short* p = scr + (8 * kc) * 66 + n;
        v4u o; o.x = (unsigned)p[0] | ((unsigned)p[66] << 16); o.y = (unsigned)p[2 * 66] | ((unsigned)p[3 * 66] << 16); o.z = (unsigned)p[4 * 66] | ((unsigned)p[5 * 66] << 16); o.w = (unsigned)p[6 * 66] | ((unsigned)p[7 * 66] << 16);
        *(v4u*)(WT + (size_t)(n0 + n) * K + k0 + 8 * kc) = o; }
    LDS_WAIT(); asm volatile("" ::: "memory");
}
__device__ __forceinline__ void rows4_to_bf16_ssq(const float* x0, bf16* o0, float* ssq0, int lane) {
    f32x4 v[4][4];
#pragma unroll
    for (int rr = 0; rr < 4; ++rr)
#pragma unroll
        for (int j = 0; j < 4; ++j) v[rr][j] = ld_nt(x0 + rr * 1024 + 4 * (64 * j + lane));
#pragma unroll
    for (int rr = 0; rr < 4; ++rr) { float sq = 0.f;
#pragma unroll
        for (int j = 0; j < 4; ++j) sq += (v[rr][j].x * v[rr][j].x + v[rr][j].y * v[rr][j].y) + (v[rr][j].z * v[rr][j].z + v[rr][j].w * v[rr][j].w);
        sq = wave_sum(sq);
        const float irs = sqrtf(sq * (1.0f / 1024.0f) + 1e-6f), rs = 1.0f / irs;
        unsigned long long* o8 = (unsigned long long*)(o0 + rr * 1024) + lane;
#pragma unroll
        for (int j = 0; j < 4; ++j) o8[64 * j] = (unsigned long long)pk2(v[rr][j].x * rs, v[rr][j].y * rs) | ((unsigned long long)pk2(v[rr][j].z * rs, v[rr][j].w * rs) << 32);
        if (lane == 0) ssq0[rr] = irs; }
}
__device__ __forceinline__ void p0_prologue(Frame& F) {
    LAS unsigned short* scr = (LAS unsigned short*)(F.lds + RING_OFF + F.wave * 16384);
    const int gw = F.vcu * NWAVES + F.wave, NGW = F.G * NWAVES;
    unsigned char* ws = F.ws;
    constexpr int I_IN = 16 * (NPROJ / 64), I_KV = 16 * 32, I_SSD = 32 * 16, I_SQ = 16 * 16, I_GU = 16 * (2 * FFN / 64), I_DN = (FFN / 64) * 16;
    constexpr int NITEMS = I_IN + I_KV + I_SSD + 4 * I_SQ + I_GU + I_DN;
    for (int it = gw; it < NITEMS; it += NGW) {
        int r = it;
        if (r < I_IN) { TSrc s{F.in[9], nullptr, F.in[8], 11296, 1}; p0_transpose_item(s, 1024, NPROJ, (bf16*)(ws + WS_WIN), scr, r, F.lane); continue; } r -= I_IN;
        if (r < I_KV) { TSrc s{F.in[24], F.in[25], F.in[22], 1024, 3}; p0_transpose_item(s, 1024, 2048, (bf16*)(ws + WS_WKV), scr, r, F.lane); continue; } r -= I_KV;
        if (r < I_SSD) { TSrc s{F.in[16], nullptr, F.in[15], 1024, 0}; p0_transpose_item(s, 2048, 1024, (bf16*)(ws + WS_WSSD), scr, r, F.lane); continue; } r -= I_SSD;
        if (r < I_SQ) { TSrc s{F.in[19], nullptr, F.in[18], 1024, 0}; p0_transpose_item(s, 1024, 1024, (bf16*)(ws + WS_WHG), scr, r, F.lane); continue; } r -= I_SQ;
        if (r < I_SQ) { TSrc s{F.in[20], nullptr, nullptr, 1024, 0}; p0_transpose_item(s, 1024, 1024, (bf16*)(ws + WS_WOUT), scr, r, F.lane); continue; } r -= I_SQ;
        if (r < I_SQ) { TSrc s{F.in[23], nullptr, F.in[21], 1024, 0}; p0_transpose_item(s, 1024, 1024, (bf16*)(ws + WS_WCQ), scr, r, F.lane); continue; } r -= I_SQ;
        if (r < I_SQ) { TSrc s{F.in[26], nullptr, nullptr, 1024, 0}; p0_transpose_item(s, 1024, 1024, (bf16*)(ws + WS_WCO), scr, r, F.lane); continue; } r -= I_SQ;
        if (r < I_GU) { TSrc s{F.in[28], F.in[29], F.in[27], FFN, 2}; p0_transpose_item(s, 1024, 2 * FFN, (bf16*)(ws + WS_WGU), scr, r, F.lane); continue; } r -= I_GU;
        { TSrc s{F.in[30], nullptr, nullptr, 1024, 0}; p0_transpose_item(s, FFN, 1024, (bf16*)(ws + WS_WDN), scr, r, F.lane); }
    }
    bf16* XB = (bf16*)(ws + WS_XB); float* SSQX = (float*)(ws + WS_SSQX);
    for (int m4 = gw; m4 < T / 4; m4 += NGW) { const int m = 4 * m4;
        rows4_to_bf16_ssq(m < TP ? F.in[0] + (size_t)m * DM : F.in[1] + (size_t)(m - TP) * DM, XB + (size_t)m * DM, SSQX + m, F.lane); }
    bf16* MNB = (bf16*)(ws + WS_MNB); float* SSQM = (float*)(ws + WS_SSQM);
    for (int m4 = gw; m4 < MEMR / 4; m4 += NGW) { const int m = 4 * m4; rows4_to_bf16_ssq(F.in[2] + (size_t)m * DM, MNB + (size_t)m * DM, SSQM + m, F.lane); }
}
__device__ __forceinline__ void conv_copy_unit(Frame& F, int gb) {
    const bf16* PROJ = (const bf16*)(F.ws + WS_PROJ);
    const bool prompt = gb < NBP; const int sb = gb - NBP;
    const size_t row0 = prompt ? (size_t)gb * SEQ + (SEQ - 3) : (size_t)TP + (size_t)sb * LS + 1;
    float* dst = prompt ? F.out + O_CONVP + (size_t)gb * 3 * 3072 : F.out + O_CONVS + (size_t)sb * 3 * 3072;
    for (int e = F.tid; e < 3 * 3072; e += NTHR) { const int j = e / 3072, col = e % 3072;
        dst[e] = bf2f(PROJ[(size_t)(S_X0 + (col >> 10)) * SLOT_ELEMS + (row0 + j) * 1024 + (col & 1023)]); }
}
__device__ __forceinline__ void ssdnorm_phase(Frame& F) {
    const int gw = F.vcu * NWAVES + F.wave, NGW = F.G * NWAVES; bf16* YG = (bf16*)(F.ws + WS_YG); const float* SSQ = (const float*)(F.ws + WS_SSQSSD);
    for (int row = gw; row < T; row += NGW) {
        const f32x4* sp = (const f32x4*)(SSQ + (size_t)row * 32);
#pragma unroll
        for (int j = 0; j < 4; ++j) { const f32x4 a = sp[2 * j], b = sp[2 * j + 1]; const float s = ((a.x + a.y) + (a.z + a.w)) + ((b.x + b.y) + (b.z + b.w)); const float rs = 1.0f / sqrtf(s * (1.0f / 512.0f) + EPS);
            v4u* p = (v4u*)(YG + (size_t)row * 2048) + j * 64 + F.lane; const v4u w = *p; v4u o;
#pragma unroll
            for (int e = 0; e < 4; ++e) o[e] = pk2(bf2f(w[e] & 0xffffu) * rs, bf2f(w[e] >> 16) * rs);
            *p = o; }
    }
}
typedef float f32x16 __attribute__((ext_vector_type(16)));
#define MFMA32(a, b, c) __builtin_amdgcn_mfma_f32_32x32x16_bf16((a), (b), (c), 0, 0, 0)
__device__ __forceinline__ unsigned cvtpk_c(float lo, float hi) { return pk2(lo, hi); }
__device__ __forceinline__ bf16x8 pack8(float a0, float a1, float a2, float a3, float a4, float a5, float a6, float a7) {
    v4u w; w.x = cvtpk_c(a0, a1); w.y = cvtpk_c(a2, a3); w.z = cvtpk_c(a4, a5); w.w = cvtpk_c(a6, a7); return __builtin_bit_cast(bf16x8, w); }
#define ACC_FRAG(x, s) pack8((x)[8 * (s)], (x)[8 * (s) + 1], (x)[8 * (s) + 2], (x)[8 * (s) + 3], (x)[8 * (s) + 4], (x)[8 * (s) + 5], (x)[8 * (s) + 6], (x)[8 * (s) + 7])
__device__ __forceinline__ bf16x8 lds_frag16(const LAS unsigned char* p) { return *(const LAS bf16x8*)p; }
__device__ __forceinline__ bf16x8 lds_frag8x2(const LAS unsigned char* p) { const v2u lo = *(const LAS v2u*)p, hi = *(const LAS v2u*)(p + 16);
    const v4u w = (v4u){lo.x, lo.y, hi.x, hi.y}; return __builtin_bit_cast(bf16x8, w); }
#define LDS_BARRIER() do { asm volatile("s_waitcnt lgkmcnt(0)" ::: "memory"); __builtin_amdgcn_s_barrier(); asm volatile("" ::: "memory"); } while (0)
typedef short s16x4 __attribute__((ext_vector_type(4)));
__device__ __forceinline__ bf16x8 lds_frag_tr(const LAS unsigned char* p, const LAS unsigned char* p4) {
    const s16x4 lo = __builtin_amdgcn_ds_read_tr16_b64_v4i16((LAS s16x4*)p), hi = __builtin_amdgcn_ds_read_tr16_b64_v4i16((LAS s16x4*)p4);
    return (bf16x8){lo.x, lo.y, lo.z, lo.w, hi.x, hi.y, hi.z, hi.w}; }
constexpr size_t WS_BCS = WS_END, WS_BTT = WS_BCS + (size_t)TP * 1024 * 2, WS_END2 = WS_BTT + (size_t)NBP * 32 * 4 * 128 * 64 * 2;
__device__ __forceinline__ void bc_prep_unit(Frame& F, int b, int c) {
    typedef float f32x2 __attribute__((ext_vector_type(2)));
    int tid_o = F.tid; asm volatile("" : "+v"(tid_o));
    const int tid = tid_o, cg = tid & 127, seg = tid >> 7; unsigned char* ws = F.ws;
    const bf16* src = (const bf16*)(ws + WS_PROJ) + (size_t)S_X2 * SLOT_ELEMS + (size_t)b * SEQ * 1024 + 8 * cg;
    bf16* BCS = (bf16*)(ws + WS_BCS);
    const float* cw = F.in[10] + 2048 + 8 * cg; const float* cbp = F.in[11] + 2048 + 8 * cg;
#pragma unroll 1
    for (int half = 0; half < 2; ++half) {
        const int s0 = 16 * seg + 8 * half;
        v4u raw[11];
#pragma unroll
        for (int i = 0; i < 11; ++i) { const int gt = 64 * c + s0 - 3 + i; raw[i] = (v4u){0u, 0u, 0u, 0u}; if (gt >= 0) raw[i] = ld_nt16(src + (size_t)gt * 1024); }
        v4u rowpk[8];
#pragma unroll
        for (int kp = 0; kp < 4; ++kp) {
            const f32x2 cw0 = *(const f32x2*)(cw + 2 * kp), cw1 = *(const f32x2*)(cw + 3072 + 2 * kp), cw2 = *(const f32x2*)(cw + 2 * 3072 + 2 * kp), cw3 = *(const f32x2*)(cw + 3 * 3072 + 2 * kp), cbb = *(const f32x2*)(cbp + 2 * kp);
            f32x2 xv[11];
#pragma unroll
            for (int i = 0; i < 11; ++i) { const unsigned wd = raw[i][kp]; xv[i] = (f32x2){__uint_as_float(wd << 16), __uint_as_float(wd & 0xffff0000u)}; }
            f32x2 o[8];
#pragma unroll
            for (int i = 0; i < 8; ++i) { f32x2 a = cw0 * xv[i] + cbb; a = cw1 * xv[i + 1] + a; a = cw2 * xv[i + 2] + a; a = cw3 * xv[i + 3] + a;
                const f32x2 t = a * (-1.4426950408889634f); f32x2 e; e.x = __builtin_amdgcn_exp2f(t.x); e.y = __builtin_amdgcn_exp2f(t.y); e = e + 1.0f;
                f32x2 rc; rc.x = __builtin_amdgcn_rcpf(e.x); rc.y = __builtin_amdgcn_rcpf(e.y); o[i] = a * rc; }
#pragma unroll
            for (int i = 0; i < 8; ++i) rowpk[i][kp] = pk2(o[i].x, o[i].y);
        }
        bf16* drow = BCS + ((size_t)b * SEQ + 64 * c + s0) * 1024 + 8 * cg;
#pragma unroll
        for (int i = 0; i < 8; ++i) *(v4u*)(drow + (size_t)i * 1024) = rowpk[i];
    }
}
__device__ __forceinline__ void bc_prep_phase(Frame& F) { for (int u = F.vcu; u < NBP * 32; u += F.G) bc_prep_unit(F, u >> 5, u & 31); }
constexpr size_t WS_HVT = WS_XB, WS_EGM = WS_END2, WS_EGL = WS_EGM + (size_t)NBP * 64 * 1024 * 4, WS_END3 = WS_EGL + (size_t)NBP * 64 * 1024 * 4;
__device__ __forceinline__ void hg_prep_unit(Frame& F, int b, int c) {
    typedef float f32x2 __attribute__((ext_vector_type(2)));
    int tid_o = F.tid; asm volatile("" : "+v"(tid_o));
    const int tid = tid_o; unsigned char* ws = F.ws;
    const int ch = 2 * tid;
    const size_t row0 = (size_t)b * SEQ + 32 * c;
    bf16* QS = (bf16*)(ws + WS_PROJ) + (size_t)S_Q * SLOT_ELEMS + row0 * 1024 + ch; bf16* FS = (bf16*)(ws + WS_PROJ) + (size_t)S_F * SLOT_ELEMS + row0 * 1024 + ch;
    const f32x2 l0 = *(const f32x2*)(F.in[17] + ch), l1 = *(const f32x2*)(F.in[17] + 1024 + ch);
    f32x2 lb; lb.x = __builtin_amdgcn_rcpf(1.0f + __expf(l1.x - l0.x)); lb.y = __builtin_amdgcn_rcpf(1.0f + __expf(l1.y - l0.y));
    const f32x2 omlb = 1.0f - lb;
    f32x2 P[32]; f32x2 run = (f32x2){1.0f, 1.0f};
#pragma unroll
    for (int t = 0; t < 32; ++t) { const unsigned wd = ld_nt4(FS + (size_t)t * 1024);
        f32x2 u = (f32x2){__uint_as_float(wd << 16), __uint_as_float(wd & 0xffff0000u)}; u.x = fminf(fmaxf(u.x, -30.f), 30.f); u.y = fminf(fmaxf(u.y, -30.f), 30.f);
        const f32x2 tt = u * (-1.4426950408889634f); f32x2 e; e.x = __builtin_amdgcn_exp2f(tt.x); e.y = __builtin_amdgcn_exp2f(tt.y); e = e + 1.0f;
        f32x2 sg; sg.x = __builtin_amdgcn_rcpf(e.x); sg.y = __builtin_amdgcn_rcpf(e.y);
        const f32x2 fg = lb + omlb * sg; run = run * fg; run.x = fmaxf(run.x, 1e-30f); run.y = fmaxf(run.y, 1e-30f); P[t] = run; }
    const f32x2 Pm = P[15], Pl = P[31]; f32x2 rPm; rPm.x = __builtin_amdgcn_rcpf(Pm.x); rPm.y = __builtin_amdgcn_rcpf(Pm.y);
    *(f32x2*)((float*)(ws + WS_EGM) + (size_t)(b * 64 + c) * 1024 + ch) = Pm; *(f32x2*)((float*)(ws + WS_EGL) + (size_t)(b * 64 + c) * 1024 + ch) = Pl * rPm;
    f32x2 rPprev = (f32x2){1.0f, 1.0f};
#pragma unroll
    for (int t = 0; t < 32; ++t) { f32x2 rP; rP.x = __builtin_amdgcn_rcpf(P[t].x); rP.y = __builtin_amdgcn_rcpf(P[t].y);
        const f32x2 e1 = P[t] * rPm, e2 = Pm * rP, fg = P[t] * rPprev, kk = 1.0f - fg; rPprev = rP;
        const unsigned qw = ld_nt4(QS + (size_t)t * 1024); const f32x2 q = (f32x2){__uint_as_float(qw << 16), __uint_as_float(qw & 0xffff0000u)};
        const f32x2 tq = q * (-1.4426950408889634f); f32x2 eq; eq.x = __builtin_amdgcn_exp2f(tq.x); eq.y = __builtin_amdgcn_exp2f(tq.y); eq = eq + 1.0f;
        f32x2 rq; rq.x = __builtin_amdgcn_rcpf(eq.x); rq.y = __builtin_amdgcn_rcpf(eq.y);
        const f32x2 qa = q * rq * e1, ka = kk * e2;
        *(unsigned*)(QS + (size_t)t * 1024) = pk2(qa.x, qa.y); *(unsigned*)(FS + (size_t)t * 1024) = pk2(ka.x, ka.y); }
}
__device__ __forceinline__ void hg_prep_phase(Frame& F) { for (int u = F.vcu; u < NBP * 64; u += F.G) hg_prep_unit(F, u >> 6, u & 63); }
constexpr int HV_QA = 0, HV_KA = 8704, HV_KAT = 17408, HV_VT = 27648, HV_EGM = 30208, HV_EGL = 30720, HV_PBUF = 31232, HV_OB = 2 * HV_PBUF, HV_OBUF = 23040;
constexpr size_t WS_SSQH = WS_END3, WS_END4 = WS_SSQH + (size_t)T * 32 * 4;
__device__ __forceinline__ void hgrn_v_unit(Frame& F, int b, int hd, int vt) {
    int tid_o = F.tid; asm volatile("" : "+v"(tid_o));
    const int tid = tid_o, lane = tid & 63, w = F.wave, r = lane & 31, hh = lane >> 5; unsigned char* ws = F.ws;
    LAS unsigned char* Lb = F.lds + RING_OFF;
    const bf16* PROJ = (const bf16*)(ws + WS_PROJ); bf16* OU = (bf16*)(ws + WS_ON); float* SSQH = (float*)(ws + WS_SSQH);
    const size_t rowb = (size_t)b * SEQ;
    const int pt_t = tid & 31, pt_g = tid >> 5;
    const bf16* qsrc = PROJ + (size_t)S_Q * SLOT_ELEMS + (rowb + pt_t) * 1024 + hd * 128 + 8 * pt_g;
    const bf16* ksrc = PROJ + (size_t)S_F * SLOT_ELEMS + (rowb + pt_t) * 1024 + hd * 128 + 8 * pt_g;
    const unsigned char* xsrc = nullptr; size_t xstr = 0;
    if (tid < 128) { xsrc = (const unsigned char*)(PROJ + (size_t)S_I * SLOT_ELEMS + (rowb + pt_t) * 1024 + hd * 128 + 32 * vt + 8 * pt_g); xstr = (size_t)32 * 1024 * 2; }
    else if (tid < 160) { xsrc = (const unsigned char*)((const float*)(ws + WS_EGM) + (size_t)b * 64 * 1024 + hd * 128 + 4 * (tid - 128)); xstr = 4096; }
    else if (tid < 192) { xsrc = (const unsigned char*)((const float*)(ws + WS_EGL) + (size_t)b * 64 * 1024 + hd * 128 + 4 * (tid - 160)); xstr = 4096; }
    const int o_img = pt_t * 272 + 16 * pt_g, o_ka = pt_t * 256 + 16 * (pt_g ^ (((pt_t & 3) << 2) | ((pt_t >> 2) & 3))), o_v = pt_t * 64 + 16 * pt_g;
#define HGV_LOAD(cc, pq, pk, px) { pq = *(const v4u*)(qsrc + (size_t)(cc) * 32 * 1024); pk = *(const v4u*)(ksrc + (size_t)(cc) * 32 * 1024); if (tid < 192) px = *(const v4u*)(xsrc + (size_t)(cc) * xstr); }
#define HGV_STORE(pb, pq, pk, px) { *(LAS v4u*)((pb) + HV_QA + o_img) = pq; *(LAS v4u*)((pb) + HV_KA + o_ka) = pk; \
        if (tid < 128) { *(LAS v4u*)((pb) + HV_VT + o_v) = px; } else if (tid < 160) { *(LAS v4u*)((pb) + HV_EGM + 16 * (tid - 128)) = px; } else if (tid < 192) { *(LAS v4u*)((pb) + HV_EGL + 16 * (tid - 160)) = px; } }
    v4u pqA, pkA, pxA = (v4u){0u, 0u, 0u, 0u}, pqB, pkB, pxB = (v4u){0u, 0u, 0u, 0u};
    HGV_LOAD(0, pqA, pkA, pxA) HGV_STORE(Lb, pqA, pkA, pxA)
    HGV_LOAD(1, pqA, pkA, pxA) HGV_LOAD(2, pqB, pkB, pxB)
    const int kt = w;
    v4u ow_pend = (v4u){0u, 0u, 0u, 0u}; float sq_pend = 0.f;
    f32x16 S;
#pragma unroll
    for (int i = 0; i < 16; ++i) S[i] = 0.f;
    __syncthreads();
#define HGV_ITER(c, pq, pk, px) { \
        int r_l = r, hh_l = hh, tid_l = tid; asm volatile("" : "+v"(r_l), "+v"(hh_l), "+v"(tid_l)); \
        { const int r = r_l, hh = hh_l, tid = tid_l; \
        LAS unsigned char* pbc = Lb + ((c) & 1) * HV_PBUF; LAS unsigned char* pbn = Lb + (((c) + 1) & 1) * HV_PBUF; \
        if ((c) < 63) { HGV_STORE(pbn, pq, pk, px) if ((c) < 61) HGV_LOAD((c) + 3, pq, pk, px) } \
        if (w < 4) { \
            LAS float* EGM = (LAS float*)(pbc + HV_EGM); LAS float* EGL = (LAS float*)(pbc + HV_EGL); LAS float* OB = (LAS float*)(Lb + HV_OB + ((c) & 1) * HV_OBUF); \
            _Pragma("unroll") \
            for (int q4 = 0; q4 < 4; ++q4) { const f32x4 e0 = *(const LAS f32x4*)(EGM + 32 * kt + 8 * q4 + 4 * hh); \
                _Pragma("unroll") \
                for (int j = 0; j < 4; ++j) S[4 * q4 + j] *= e0[j]; } \
            f32x16 o; \
            _Pragma("unroll") \
            for (int i = 0; i < 16; ++i) o[i] = 0.f; \
            const LAS unsigned char* qa_row = pbc + HV_QA + r * 272; \
            o = MFMA32(ACC_FRAG(S, 0), lds_frag8x2(qa_row + (32 * kt + 4 * hh) * 2), o);        \
            o = MFMA32(ACC_FRAG(S, 1), lds_frag8x2(qa_row + (32 * kt + 16 + 4 * hh) * 2), o); \
            LAS float* ob = OB + (kt * 32 + r) * 36 + 4 * hh; \
            _Pragma("unroll") \
            for (int q4 = 0; q4 < 4; ++q4) *(LAS f32x4*)(ob + 8 * q4) = (f32x4){o[4 * q4], o[4 * q4 + 1], o[4 * q4 + 2], o[4 * q4 + 3]}; \
              \
            const int q_ = ((tid & 63) >> 2) & 3, chk_ = 4 * kt + 2 * (((tid & 63) >> 4) & 1) + (((tid & 63) >> 1) & 1); \
            const LAS unsigned char* ka_lo = pbc + HV_KA + (8 * hh + q_) * 256 + 16 * (chk_ ^ ((q_ << 2) | ((2 * hh) & 3))) + 8 * ((tid & 63) & 1); \
            const LAS unsigned char* ka_hi = pbc + HV_KA + (8 * hh + 4 + q_) * 256 + 16 * (chk_ ^ ((q_ << 2) | ((2 * hh + 1) & 3))) + 8 * ((tid & 63) & 1); \
            const LAS unsigned char* v_lo = pbc + HV_VT + (8 * hh + q_) * 64 + (16 * (((tid & 63) >> 4) & 1) + 4 * ((tid & 63) & 3)) * 2; \
            S = MFMA32(lds_frag_tr(ka_lo, ka_hi), lds_frag_tr(v_lo, v_lo + 4 * 64), S); S = MFMA32(lds_frag_tr(ka_lo + 4096, ka_hi + 4096), lds_frag_tr(v_lo + 16 * 64, v_lo + 20 * 64), S); \
            _Pragma("unroll") \
            for (int q4 = 0; q4 < 4; ++q4) { const f32x4 e0 = *(const LAS f32x4*)(EGL + 32 * kt + 8 * q4 + 4 * hh); \
                _Pragma("unroll") \
                for (int j = 0; j < 4; ++j) S[4 * q4 + j] *= e0[j]; } \
        } else { \
            if (w == 4 || w == 7) {        \
                LAS float* OB = (LAS float*)(Lb + HV_OB + ((c) & 1) * HV_OBUF); const int tb = (w == 7) ? 1 : 0, l_ = tid & 63, fr = l_ & 15, fq = l_ >> 4; \
                const LAS unsigned char* qa_b = pbc + HV_QA + (16 * tb + fr) * 272 + 16 * fq;                        \
                const LAS unsigned char* ka0 = pbc + HV_KA + 256 * fr; const int sw0 = ((fr & 3) << 2) | ((fr >> 2) & 3);                         \
                const LAS unsigned char* ka1 = pbc + HV_KA + 256 * (16 + fr); const int sw1 = ((fr & 3) << 2) | (((16 + fr) >> 2) & 3); \
                f32x4 X0a = (f32x4){0.f, 0.f, 0.f, 0.f}, X0b = X0a, X1a = X0a, X1b = X0a; \
                const bf16x8 q0 = lds_frag16(qa_b), q1 = lds_frag16(qa_b + 64), q2 = lds_frag16(qa_b + 128), q3 = lds_frag16(qa_b + 192); \
                X0a = __builtin_amdgcn_mfma_f32_16x16x32_bf16(lds_frag16(ka0 + 16 * ((0 + fq) ^ sw0)), q0, X0a, 0, 0, 0); X0b = __builtin_amdgcn_mfma_f32_16x16x32_bf16(lds_frag16(ka0 + 16 * ((4 + fq) ^ sw0)), q1, X0b, 0, 0, 0); \
                X0a = __builtin_amdgcn_mfma_f32_16x16x32_bf16(lds_frag16(ka0 + 16 * ((8 + fq) ^ sw0)), q2, X0a, 0, 0, 0); X0b = __builtin_amdgcn_mfma_f32_16x16x32_bf16(lds_frag16(ka0 + 16 * ((12 + fq) ^ sw0)), q3, X0b, 0, 0, 0); \
                if (tb) {                                                         \
                    X1a = __builtin_amdgcn_mfma_f32_16x16x32_bf16(lds_frag16(ka1 + 16 * ((0 + fq) ^ sw1)), q0, X1a, 0, 0, 0); X1b = __builtin_amdgcn_mfma_f32_16x16x32_bf16(lds_frag16(ka1 + 16 * ((4 + fq) ^ sw1)), q1, X1b, 0, 0, 0); \
                    X1a = __builtin_amdgcn_mfma_f32_16x16x32_bf16(lds_frag16(ka1 + 16 * ((8 + fq) ^ sw1)), q2, X1a, 0, 0, 0); X1b = __builtin_amdgcn_mfma_f32_16x16x32_bf16(lds_frag16(ka1 + 16 * ((12 + fq) ^ sw1)), q3, X1b, 0, 0, 0); } \
                f32x4 X0 = X0a + X0b, X1 = X1a + X1b;                              \
                _Pragma("unroll") \
                for (int e = 0; e < 4; ++e) { const bool keep = (4 * fq + e) <= fr; if (tb) X1[e] = keep ? X1[e] : 0.f; else X0[e] = keep ? X0[e] : 0.f; }        \
                const bf16x8 xb = pack8(X0[0], X0[1], X0[2], X0[3], X1[0], X1[1], X1[2], X1[3]);        \
                const LAS unsigned char* v_tr = pbc + HV_VT + (4 * fq + ((l_ >> 2) & 3)) * 64 + (4 * (l_ & 3)) * 2;        \
                _Pragma("unroll") \
                for (int vb = 0; vb < 2; ++vb) { const f32x4 o = __builtin_amdgcn_mfma_f32_16x16x32_bf16(lds_frag_tr(v_tr + 32 * vb, v_tr + 32 * vb + 16 * 64), xb, (f32x4){0.f, 0.f, 0.f, 0.f}, 0, 0, 0); \
                    *(LAS f32x4*)(OB + (4 * 32 + 16 * tb + fr) * 36 + 16 * vb + 4 * fq) = o; }        \
            } \
            if (w == 5 || w == 6) { if ((c) > 1) { HGV_FLUSH((c) - 2) } if ((c) > 0) { HGV_OUT((c) - 1) } }        \
        } \
        LDS_BARRIER(); \
        } }
#define HGV_OUT(cp) { const LAS float* OB = (const LAS float*)(Lb + HV_OB + ((cp) & 1) * HV_OBUF); const int tl = tid - 320, t = tl >> 2, v0 = (tl & 3) * 8; f32x4 oa = (f32x4){0.f, 0.f, 0.f, 0.f}, ob_ = oa; \
            _Pragma("unroll") \
            for (int sl = 0; sl < 5; ++sl) { oa = oa + *(const LAS f32x4*)(OB + (32 * sl + t) * 36 + v0); ob_ = ob_ + *(const LAS f32x4*)(OB + (32 * sl + t) * 36 + v0 + 4); } \
            float sq = ((oa.x * oa.x + oa.y * oa.y) + (oa.z * oa.z + oa.w * oa.w)) + ((ob_.x * ob_.x + ob_.y * ob_.y) + (ob_.z * ob_.z + ob_.w * ob_.w)); \
            sq += __int_as_float(__builtin_amdgcn_update_dpp(0, __float_as_int(sq), 0x102, 0xf, 0xf, true)); sq += __int_as_float(__builtin_amdgcn_update_dpp(0, __float_as_int(sq), 0x101, 0xf, 0xf, true));   \
            sq_pend = sq; ow_pend.x = pk2(oa.x, oa.y); ow_pend.y = pk2(oa.z, oa.w); ow_pend.z = pk2(ob_.x, ob_.y); ow_pend.w = pk2(ob_.z, ob_.w); }
#define HGV_FLUSH(cp) { const int tl = tid - 320, t = tl >> 2, v0 = (tl & 3) * 8; const size_t row = rowb + 32 * (cp) + t; \
            if ((tl & 3) == 0) SSQH[row * 32 + hd * 4 + vt] = sq_pend; *(v4u*)(OU + row * 1024 + hd * 128 + 32 * vt + v0) = ow_pend; }
#pragma unroll 1
    for (int cc = 0; cc < 64; cc += 2) { HGV_ITER(cc, pqA, pkA, pxA) HGV_ITER(cc + 1, pqB, pkB, pxB) }
    if (w == 5 || w == 6) { HGV_FLUSH(62) HGV_OUT(63) HGV_FLUSH(63) }
#undef HGV_ITER
#undef HGV_OUT
#undef HGV_FLUSH
#undef HGV_LOAD
#undef HGV_STORE
    if (w < 4) { float* st_g = F.out + O_HGP + (size_t)(b * 8 + hd) * 16384 + 32 * vt + r;
#pragma unroll
        for (int i = 0; i < 16; ++i) { const int k = 32 * kt + (i & 3) + 8 * (i >> 2) + 4 * hh; st_g[(size_t)k * 128] = S[i]; } }
    __syncthreads();
}
__device__ __forceinline__ void hgnorm_phase(Frame& F) {
    const int gw = F.vcu * NWAVES + F.wave, NGW = F.G * NWAVES; bf16* ON = (bf16*)(F.ws + WS_ON); const float* SSQH = (const float*)(F.ws + WS_SSQH);
    const bf16* HG = (const bf16*)(F.ws + WS_PROJ) + (size_t)S_HG * SLOT_ELEMS;
    for (int row = gw; row < TP; row += NGW) {
#pragma unroll
        for (int j = 0; j < 2; ++j) { const int pc = j * 64 + F.lane, hd = pc >> 4;
            const f32x4 sp = *(const f32x4*)(SSQH + (size_t)row * 32 + hd * 4); const float rs = __builtin_amdgcn_rsqf(((sp.x + sp.y) + (sp.z + sp.w)) * (1.0f / 128.0f) + EPS);
            v4u* p = (v4u*)(ON + (size_t)row * 1024) + pc; const v4u o = *p; const v4u g = ld_nt16((const v4u*)(HG + (size_t)row * 1024) + pc); v4u res;
#pragma unroll
            for (int e = 0; e < 4; ++e) res[e] = pk2(bf2f(o[e] & 0xffffu) * rs * silu_f(bf2f(g[e] & 0xffffu)), __uint_as_float(o[e] & 0xffff0000u) * rs * silu_f(__uint_as_float(g[e] & 0xffff0000u)));
            *p = res; }
    }
}
constexpr int SD_BN = 0, SD_CN = 17408, SD_BT = 34816, SD_XT = 53248, SD_HT = 62464, SD_YA = 97280, SD_YY = 113664, SD_YO = 130048, SD_CUM = 134144, SD_DTV = 134400, SD_ECUM = 134656, SD_XWT = 134912, SD_CWL = 144128;
__device__ __forceinline__ void ssd_unit_mfma(Frame& F, int gb, int h) {
    int tid_o = F.tid; asm volatile("" : "+v"(tid_o));
    const int tid = tid_o, lane = tid & 63, w = F.wave, r = lane & 31, hh = lane >> 5; unsigned char* ws = F.ws;
    const int L = SEQ; const size_t row_base = (size_t)gb * SEQ;
    const int g = h >> 3;
    LAS unsigned char* Lb = F.lds + RING_OFF;
    LAS unsigned short* BN = (LAS unsigned short*)(Lb + SD_BN); LAS unsigned short* CN = (LAS unsigned short*)(Lb + SD_CN);
    LAS unsigned short* BT = (LAS unsigned short*)(Lb + SD_BT); LAS unsigned short* XT = (LAS unsigned short*)(Lb + SD_XT);
    LAS unsigned short* HT = (LAS unsigned short*)(Lb + SD_HT);
    LAS unsigned short* XWT = (LAS unsigned short*)(Lb + SD_XWT);
    LAS float* YA = (LAS float*)(Lb + SD_YA); LAS float* YY = (LAS float*)(Lb + SD_YY); LAS unsigned short* YO = (LAS unsigned short*)(Lb + SD_YO);
    LAS float* CUM = (LAS float*)(Lb + SD_CUM); LAS float* DTV = (LAS float*)(Lb + SD_DTV); LAS float* ECUM = (LAS float*)(Lb + SD_ECUM);
    const bf16* PROJ = (const bf16*)(ws + WS_PROJ); const float* DTR = (const float*)(ws + WS_DT); bf16* YG = (bf16*)(ws + WS_YG); float* SSQ = (float*)(ws + WS_SSQSSD);
    f32x16 H0, H1, H2, H3;
#pragma unroll
    for (int i = 0; i < 16; ++i) { H0[i] = 0.f; H1[i] = 0.f; H2[i] = 0.f; H3[i] = 0.f; }
    float* const st_base = F.out + O_SSMP + (size_t)(gb * 32 + h) * 8192 + (size_t)r * 128 + 4 * hh;
#define SSD_PUBLISH(HX, TILE, BUF) { LAS unsigned short* hp_ = HT + (BUF) * 8704 + (32 * ((TILE) & 1) + r) * 136 + 32 * ((TILE) >> 1) + 4 * hh; \
        _Pragma("unroll") for (int q4 = 0; q4 < 4; ++q4) { v2u pk; pk.x = cvtpk_c(HX[4 * q4], HX[4 * q4 + 1]); pk.y = cvtpk_c(HX[4 * q4 + 2], HX[4 * q4 + 3]); *(LAS v2u*)(hp_ + 8 * q4) = pk; } }
    if (w == 3) { SSD_PUBLISH(H0, 0, 0) SSD_PUBLISH(H1, 1, 0) SSD_PUBLISH(H2, 2, 0) SSD_PUBLISH(H3, 3, 0) } else if (w >= 4) { SSD_PUBLISH(H0, w, 0) }
    const float a = -__expf(F.in[13][h]), dtb = F.in[12][h], Dk = F.in[14][h];
    const float* cw = F.in[10]; const float* cbp = F.in[11];
    typedef float f32x2 __attribute__((ext_vector_type(2)));
    const int col = h * 64 + 2 * (tid & 31);
    const bf16* cptr = PROJ + (size_t)(S_X0 + (col >> 10)) * SLOT_ELEMS + row_base * 1024 + (col & 1023);
    const f32x2 cw0 = *(const f32x2*)(cw + col), cw1 = *(const f32x2*)(cw + 3072 + col), cw2 = *(const f32x2*)(cw + 2 * 3072 + col), cw3 = *(const f32x2*)(cw + 3 * 3072 + col), cbb = *(const f32x2*)(cbp + col);
    const bf16* BCS = (const bf16*)(ws + WS_BCS) + row_base * 1024 + g * 128;
    unsigned xr[7]; v4u pc[4];
#pragma unroll
    for (int i = 0; i < 7; ++i) { const int gt = 4 * (tid >> 5) - 3 + i; xr[i] = 0u; if (gt >= 0) xr[i] = *(const unsigned*)(cptr + (size_t)gt * 1024); }
#pragma unroll
    for (int j = 0; j < 4; ++j) { const int idx = (tid + 512 * j) & 1023; pc[j] = *(const v4u*)(BCS + (size_t)(idx >> 4) * 1024 + (j >> 1) * 512 + 8 * (idx & 15)); }
    __syncthreads();
    v4u ow_pend = (v4u){0u, 0u, 0u, 0u}; float sq_pend = 0.f; bool pend = false;
    int buf = 0;
    float dt_pf = 0.f;
    if (lane < L) dt_pf = DTR[(row_base + lane) * 32 + h];
    v4u zw_pf = ld_nt16(PROJ + (size_t)(S_Z0 + (h >> 4)) * SLOT_ELEMS + (row_base + (tid >> 3)) * 1024 + (h & 15) * 64 + (tid & 7) * 8);
    for (int t0 = 0; t0 < L; t0 += 64, buf ^= 1) {
        int r_l = r, hh_l = hh, tid_l = tid, lane_l = lane;
        asm volatile("" : "+v"(r_l), "+v"(hh_l), "+v"(tid_l), "+v"(lane_l));
        { const int r = r_l, hh = hh_l, tid = tid_l, lane = lane_l;
        float dtv = 0.f;
        if (t0 + lane < L) { const float x = dt_pf + dtb; dtv = fmaxf(x, 0.f) + 0.6931471805599453f * __builtin_amdgcn_logf(1.0f + __builtin_amdgcn_exp2f(-1.4426950408889634f * fabsf(x))); }
        dt_pf = 0.f; if (t0 + 64 + lane < L) dt_pf = DTR[(row_base + t0 + 64 + lane) * 32 + h];
        const v4u zw = zw_pf; zw_pf = (v4u){0u, 0u, 0u, 0u};
        if (t0 + 64 + (tid >> 3) < L) zw_pf = ld_nt16(PROJ + (size_t)(S_Z0 + (h >> 4)) * SLOT_ELEMS + (row_base + t0 + 64 + (tid >> 3)) * 1024 + (h & 15) * 64 + (tid & 7) * 8);
        float cum = dtv * a;
#define SSD_DPP_ADD(ctrl, rmask) cum += __int_as_float(__builtin_amdgcn_update_dpp(0, __float_as_int(cum), ctrl, rmask, 0xf, true))
        SSD_DPP_ADD(0x111, 0xf); SSD_DPP_ADD(0x112, 0xf); SSD_DPP_ADD(0x114, 0xf); SSD_DPP_ADD(0x118, 0xf);
        SSD_DPP_ADD(0x142, 0xa); SSD_DPP_ADD(0x143, 0xc);
#undef SSD_DPP_ADD
        const float cum_last = __int_as_float(__builtin_amdgcn_readlane(__float_as_int(cum), 63));
        const float wgt = __expf(cum_last - cum) * dtv;
        if (w == 0) { CUM[lane] = cum; DTV[lane] = dtv; ECUM[lane] = __expf(cum); }
#pragma unroll
        for (int j = 0; j < 4; ++j) { const int idx = (tid + 512 * j) & 1023;
            if (j < 2) { const int row = idx >> 4; *(LAS v4u*)((LAS unsigned char*)BN + 256 * row + 16 * ((idx & 15) ^ (((row & 3) << 2) | ((row >> 2) & 3)))) = pc[j]; }
            else *(LAS v4u*)(CN + (idx >> 4) * 136 + 8 * (idx & 15)) = pc[j]; }
        if (pend) { const size_t prow = row_base + (t0 - 64) + (tid >> 3);
            *(v4u*)(YG + prow * 2048 + h * 64 + (tid & 7) * 8) = ow_pend; if ((tid & 7) == 0) SSQ[prow * 32 + h] = sq_pend; pend = false; }
        { const int cp = tid & 31, sq = tid >> 5; const int wu = __builtin_amdgcn_readfirstlane(w);
          f32x2 xv[7];
#pragma unroll
          for (int i = 0; i < 7; ++i) xv[i] = (f32x2){__uint_as_float(xr[i] << 16), __uint_as_float(xr[i] & 0xffff0000u)};
          unsigned po[4], pw[4];
          f32x2 o[4], ow[4];
#pragma unroll
          for (int k = 0; k < 4; ++k) {
              const float w_lo = __int_as_float(__builtin_amdgcn_readlane(__float_as_int(wgt), 8 * wu + k)), w_hi = __int_as_float(__builtin_amdgcn_readlane(__float_as_int(wgt), 8 * wu + 4 + k));
              const float wx = hh ? w_hi : w_lo;
              f32x2 a = cw0 * xv[k] + cbb; a = cw1 * xv[k + 1] + a; a = cw2 * xv[k + 2] + a; a = cw3 * xv[k + 3] + a;
              const f32x2 t = a * (-1.4426950408889634f); f32x2 e; e.x = __builtin_amdgcn_exp2f(t.x); e.y = __builtin_amdgcn_exp2f(t.y); e = e + 1.0f;
              f32x2 rc; rc.x = __builtin_amdgcn_rcpf(e.x); rc.y = __builtin_amdgcn_rcpf(e.y); o[k] = a * rc; ow[k] = o[k] * wx; }
          po[0] = pk2(o[0].x, o[1].x); po[1] = pk2(o[2].x, o[3].x); po[2] = pk2(o[0].y, o[1].y); po[3] = pk2(o[2].y, o[3].y);
          pw[0] = pk2(ow[0].x, ow[1].x); pw[1] = pk2(ow[2].x, ow[3].x); pw[2] = pk2(ow[0].y, ow[1].y); pw[3] = pk2(ow[2].y, ow[3].y);
          *(LAS v2u*)(XT + (2 * cp) * 72 + 4 * sq) = (v2u){po[0], po[1]}; *(LAS v2u*)(XT + (2 * cp + 1) * 72 + 4 * sq) = (v2u){po[2], po[3]};
          *(LAS v2u*)(XWT + (2 * cp) * 72 + 4 * sq) = (v2u){pw[0], pw[1]}; *(LAS v2u*)(XWT + (2 * cp + 1) * 72 + 4 * sq) = (v2u){pw[2], pw[3]};
        }
        if (t0 + 64 < L) {
#pragma unroll
            for (int i = 0; i < 7; ++i) xr[i] = *(const unsigned*)(cptr + (size_t)(t0 + 64 + 4 * (tid >> 5) - 3 + i) * 1024);
#pragma unroll
            for (int j = 0; j < 4; ++j) { const int idx = (tid + 512 * j) & 1023; pc[j] = *(const v4u*)(BCS + (size_t)(t0 + 64 + (idx >> 4)) * 1024 + (j >> 1) * 512 + 8 * (idx & 15)); }
        }
        LDS_BARRIER();
        if (w < 3) {
            const int tt = w == 0 ? 0 : 1, st = w == 1 ? 1 : 0;
            f32x16 X, ya0, ya1;
#pragma unroll
            for (int i = 0; i < 16; ++i) { X[i] = 0.f; ya0[i] = 0.f; ya1[i] = 0.f; }
            const LAS unsigned char* cn_nat = Lb + SD_CN + (32 * tt + r) * 272 + hh * 16; const int bn_sw = ((r & 3) << 2) | ((r >> 2) & 3); const LAS unsigned char* bn_row = Lb + SD_BN + (32 * st + r) * 256;
            { f32x16 Xb;
#pragma unroll
              for (int i = 0; i < 16; ++i) Xb[i] = 0.f;
#pragma unroll
              for (int ks = 0; ks < 8; ks += 2) { X = MFMA32(lds_frag16(bn_row + 16 * ((2 * ks + hh) ^ bn_sw)), lds_frag16(cn_nat + ks * 32), X); Xb = MFMA32(lds_frag16(bn_row + 16 * ((2 * ks + 2 + hh) ^ bn_sw)), lds_frag16(cn_nat + ks * 32 + 32), Xb); }
              X = X + Xb; }
            const float cum_t = CUM[32 * tt + r];
#pragma unroll
            for (int q4 = 0; q4 < 4; ++q4) { const f32x4 cs = *(const LAS f32x4*)(CUM + 32 * st + 8 * q4 + 4 * hh), ds = *(const LAS f32x4*)(DTV + 32 * st + 8 * q4 + 4 * hh);
#pragma unroll
                for (int jj = 0; jj < 4; ++jj) { const int s_abs = 32 * st + 8 * q4 + 4 * hh + jj; const float f = __expf(cum_t - cs[jj]) * ds[jj]; X[4 * q4 + jj] = (s_abs <= 32 * tt + r) ? X[4 * q4 + jj] * f : 0.f;        } }
            const bf16x8 xf0 = ACC_FRAG(X, 0), xf1 = ACC_FRAG(X, 1);
            const LAS unsigned char* xt_row = Lb + SD_XT + r * 144 + (32 * st + 4 * hh) * 2;
            ya0 = MFMA32(lds_frag8x2(xt_row), xf0, ya0); ya0 = MFMA32(lds_frag8x2(xt_row + 32), xf1, ya0);
            ya1 = MFMA32(lds_frag8x2(xt_row + 32 * 144), xf0, ya1); ya1 = MFMA32(lds_frag8x2(xt_row + 32 * 144 + 32), xf1, ya1);
            if (w < 2) { LAS float* yb = YA + (32 * tt + r) * 64;
#pragma unroll
                for (int q4 = 0; q4 < 4; ++q4) { const int ch = 2 * q4 + hh;
                    *(LAS f32x4*)(yb + 4 * (ch ^ (r & 15))) = (f32x4){ya0[4 * q4], ya0[4 * q4 + 1], ya0[4 * q4 + 2], ya0[4 * q4 + 3]};
                    *(LAS f32x4*)(yb + 4 * ((ch + 8) ^ (r & 15))) = (f32x4){ya1[4 * q4], ya1[4 * q4 + 1], ya1[4 * q4 + 2], ya1[4 * q4 + 3]}; } }
            else { LAS unsigned char* yb = (LAS unsigned char*)YO + r * 128;
#pragma unroll
                for (int q4 = 0; q4 < 4; ++q4) { const int ch = 2 * q4 + hh; v2u p0, p1;
                    p0.x = cvtpk_c(ya0[4 * q4], ya0[4 * q4 + 1]); p0.y = cvtpk_c(ya0[4 * q4 + 2], ya0[4 * q4 + 3]); p1.x = cvtpk_c(ya1[4 * q4], ya1[4 * q4 + 1]); p1.y = cvtpk_c(ya1[4 * q4 + 2], ya1[4 * q4 + 3]);
                    *(LAS v2u*)(yb + 8 * (ch ^ ((r & 7) << 1))) = p0; *(LAS v2u*)(yb + 8 * ((ch + 8) ^ ((r & 7) << 1))) = p1; } }
        } else if (w >= 4) {
            const int tt = (w - 4) >> 1, ptj = w & 1;
            const LAS unsigned char* ht_nat = Lb + SD_HT + buf * 17408 + (32 * ptj + r) * 272 + hh * 16;
            f32x16 yi;
#pragma unroll
            for (int i = 0; i < 16; ++i) yi[i] = 0.f;
            const LAS unsigned char* cn_nat = Lb + SD_CN + (32 * tt + r) * 272 + hh * 16;
            { f32x16 yb2;
#pragma unroll
              for (int i = 0; i < 16; ++i) yb2[i] = 0.f;
#pragma unroll 2
              for (int ks = 0; ks < 8; ks += 2) { yi = MFMA32(lds_frag16(cn_nat + ks * 32), lds_frag16(ht_nat + ks * 32), yi); yb2 = MFMA32(lds_frag16(cn_nat + ks * 32 + 32), lds_frag16(ht_nat + ks * 32 + 32), yb2); }
              yi = yi + yb2; }
            const LAS unsigned short* xt_p = XT + (32 * ptj + r) * 72 + 32 * tt + 4 * hh;
#pragma unroll
            for (int q4 = 0; q4 < 4; ++q4) { const f32x4 ec = *(const LAS f32x4*)(ECUM + 32 * tt + 8 * q4 + 4 * hh); const v2u xw = *(const LAS v2u*)(xt_p + 8 * q4);
                const float x0 = bf2f(xw.x & 0xffffu), x1 = bf2f(xw.x >> 16), x2 = bf2f(xw.y & 0xffffu), x3 = bf2f(xw.y >> 16);
                LAS float* yb = YY + (32 * tt + 8 * q4 + 4 * hh) * 64 + 32 * ptj + r;
                yb[0] = ec[0] * yi[4 * q4] + Dk * x0; yb[64] = ec[1] * yi[4 * q4 + 1] + Dk * x1; yb[128] = ec[2] * yi[4 * q4 + 2] + Dk * x2; yb[192] = ec[3] * yi[4 * q4 + 3] + Dk * x3; }
        }
#define SSD_UPD(HX, TILE) { const int q_ = (lane >> 2) & 3, ch_ = 4 * ((TILE) >> 1) + 2 * ((lane >> 4) & 1) + ((lane >> 1) & 1); \
            const LAS unsigned char* bn_lo = Lb + SD_BN + (8 * hh + q_) * 256 + 16 * (ch_ ^ ((q_ << 2) | ((2 * hh) & 3))) + 8 * (lane & 1); \
            const LAS unsigned char* bn_hi = Lb + SD_BN + (8 * hh + 4 + q_) * 256 + 16 * (ch_ ^ ((q_ << 2) | ((2 * hh + 1) & 3))) + 8 * (lane & 1); \
            const LAS unsigned char* xt_nat = Lb + SD_XWT + (32 * ((TILE) & 1) + r) * 144 + hh * 16; \
            f32x16 Ha, Hb; \
            _Pragma("unroll") for (int i = 0; i < 16; ++i) { Ha[i] = 0.f; Hb[i] = 0.f; } \
            Ha = MFMA32(lds_frag_tr(bn_lo, bn_hi), lds_frag16(xt_nat), Ha); Hb = MFMA32(lds_frag_tr(bn_lo + 4096, bn_hi + 4096), lds_frag16(xt_nat + 32), Hb); \
            Ha = MFMA32(lds_frag_tr(bn_lo + 8192, bn_hi + 8192), lds_frag16(xt_nat + 64), Ha); Hb = MFMA32(lds_frag_tr(bn_lo + 12288, bn_hi + 12288), lds_frag16(xt_nat + 96), Hb);         \
            _Pragma("unroll") for (int i = 0; i < 16; ++i) HX[i] = HX[i] * el + (Ha[i] + Hb[i]); \
            SSD_PUBLISH(HX, TILE, buf ^ 1) }
        if (w >= 3) { const float el = ECUM[63];
            if (w == 3) { SSD_UPD(H0, 0) SSD_UPD(H1, 1) SSD_UPD(H2, 2) SSD_UPD(H3, 3) } else { SSD_UPD(H0, w) } }
        LDS_BARRIER();
        { const int tt = tid >> 3, p0 = (tid & 7) * 8;
          if (t0 + tt < L) { const size_t row = row_base + t0 + tt;
            const int c0 = 2 * (tid & 7);
            f32x4 y0 = *(const LAS f32x4*)(YA + tt * 64 + 4 * (c0 ^ (tt & 15))) + *(const LAS f32x4*)(YY + tt * 64 + p0), y1 = *(const LAS f32x4*)(YA + tt * 64 + 4 * ((c0 + 1) ^ (tt & 15))) + *(const LAS f32x4*)(YY + tt * 64 + p0 + 4);
            if (tt >= 32) { const v4u ow4 = *(const LAS v4u*)((const LAS unsigned char*)YO + (tt - 32) * 128 + 16 * ((tid & 7) ^ (tt & 7)));
                y0 = y0 + (f32x4){bf2f(ow4.x & 0xffffu), __uint_as_float(ow4.x & 0xffff0000u), bf2f(ow4.y & 0xffffu), __uint_as_float(ow4.y & 0xffff0000u)};
                y1 = y1 + (f32x4){bf2f(ow4.z & 0xffffu), __uint_as_float(ow4.z & 0xffff0000u), bf2f(ow4.w & 0xffffu), __uint_as_float(ow4.w & 0xffff0000u)}; }
            float o[8]; float sq = 0.f;
#pragma unroll
            for (int j = 0; j < 8; ++j) { const unsigned z16 = (zw[j >> 1] >> ((j & 1) * 16)) & 0xffffu; const float yv = (j < 4 ? y0[j & 3] : y1[j & 3]) * silu_f(bf2f(z16)); o[j] = yv; sq += yv * yv; }
            ow_pend.x = pk2(o[0], o[1]); ow_pend.y = pk2(o[2], o[3]); ow_pend.z = pk2(o[4], o[5]); ow_pend.w = pk2(o[6], o[7]);
            sq += __int_as_float(__builtin_amdgcn_update_dpp(0, __float_as_int(sq), 0x104, 0xf, 0xf, true));
            sq += __int_as_float(__builtin_amdgcn_update_dpp(0, __float_as_int(sq), 0x102, 0xf, 0xf, true));
            sq += __int_as_float(__builtin_amdgcn_update_dpp(0, __float_as_int(sq), 0x101, 0xf, 0xf, true)); sq_pend = sq; pend = true; } }
        }
    }
    if (pend) { const size_t prow = row_base + (L - 64) + (tid >> 3); *(v4u*)(YG + prow * 2048 + h * 64 + (tid & 7) * 8) = ow_pend; if ((tid & 7) == 0) SSQ[prow * 32 + h] = sq_pend; }
#define SSD_STOUT(HX, TILE) { float* st_g = st_base + (size_t)(32 * ((TILE) & 1)) * 128 + 32 * ((TILE) >> 1); \
        _Pragma("unroll") for (int q4 = 0; q4 < 4; ++q4) *(f32x4*)(st_g + 8 * q4) = (f32x4){HX[4 * q4], HX[4 * q4 + 1], HX[4 * q4 + 2], HX[4 * q4 + 3]}; }
    if (w == 3) { SSD_STOUT(H0, 0) SSD_STOUT(H1, 1) SSD_STOUT(H2, 2) SSD_STOUT(H3, 3) } else if (w >= 4) { SSD_STOUT(H0, w) }
#undef SSD_STOUT
#undef SSD_UPD
#undef SSD_PUBLISH
    __syncthreads();
}
__device__ __forceinline__ float tr_reduce32(const float (&v)[32], int lane) {
    const bool b4 = lane & 16, b3 = lane & 8, b2 = lane & 4, b1 = lane & 2, b0 = lane & 1;
    float a[16], b[8], c[4], d[2];
#pragma unroll
    for (int i = 0; i < 16; ++i) { const float keep = b4 ? v[i + 16] : v[i], send = b4 ? v[i] : v[i + 16]; a[i] = keep + __shfl_xor(send, 16); }
#pragma unroll
    for (int i = 0; i < 8; ++i) { const float keep = b3 ? a[i + 8] : a[i], send = b3 ? a[i] : a[i + 8]; b[i] = keep + __shfl_xor(send, 8); }
#pragma unroll
    for (int i = 0; i < 4; ++i) { const float keep = b2 ? b[i + 4] : b[i], send = b2 ? b[i] : b[i + 4]; c[i] = keep + __shfl_xor(send, 4); }
#pragma unroll
    for (int i = 0; i < 2; ++i) { const float keep = b1 ? c[i + 2] : c[i], send = b1 ? c[i] : c[i + 2]; d[i] = keep + __shfl_xor(send, 2); }
    const float keep = b0 ? d[1] : d[0], send = b0 ? d[0] : d[1];
    return keep + __shfl_xor(send, 1);
}
__device__ __forceinline__ void ssd_sample_unit(Frame& F, int sb, int g) {
    int tid_o = F.tid; asm volatile("" : "+v"(tid_o));
    const int tid = tid_o, lane = tid & 63, w = F.wave, hh = lane >> 5, nq = lane & 31; unsigned char* ws = F.ws;
    LAS float* XC = (LAS float*)(F.lds + RING_OFF); LAS float* BC = XC + 8 * 4 * 64; LAS float* CC = BC + 4 * 128; LAS float* DTS = CC + 4 * 128;
    const bf16* PROJ = (const bf16*)(ws + WS_PROJ); const float* DTR = (const float*)(ws + WS_DT); bf16* YG = (bf16*)(ws + WS_YG); float* SSQ = (float*)(ws + WS_SSQSSD);
    const size_t row0 = (size_t)TP + (size_t)sb * LS;
    const int h = 8 * g + w;
    const float* sp = F.in[3] + (size_t)(sb * 32 + h) * 8192 + (size_t)hh * 128 + 4 * nq;
    f32x4 hst[32];
#pragma unroll
    for (int i = 0; i < 32; ++i) hst[i] = ld_nt(sp + (size_t)i * 256);
    if (tid < 384) { typedef float f32x2 __attribute__((ext_vector_type(2)));
        const int col = tid < 256 ? g * 512 + 2 * tid : (tid < 320 ? 2048 + g * 128 + 2 * (tid - 256) : 2560 + g * 128 + 2 * (tid - 320));
        const float* cw = F.in[10]; const float* sc = F.in[4] + (size_t)sb * 3 * 3072 + col;
        const f32x2 w0 = *(const f32x2*)(cw + col), w1 = *(const f32x2*)(cw + 3072 + col), w2 = *(const f32x2*)(cw + 2 * 3072 + col), w3 = *(const f32x2*)(cw + 3 * 3072 + col), cb = *(const f32x2*)(F.in[11] + col);
        f32x2 full[7]; full[0] = *(const f32x2*)sc; full[1] = *(const f32x2*)(sc + 3072); full[2] = *(const f32x2*)(sc + 2 * 3072);
        const bf16* cp = PROJ + (size_t)(S_X0 + (col >> 10)) * SLOT_ELEMS + row0 * 1024 + (col & 1023);
#pragma unroll
        for (int t = 0; t < 4; ++t) { const unsigned wd = *(const unsigned*)(cp + (size_t)t * 1024); full[3 + t] = (f32x2){__uint_as_float(wd << 16), __uint_as_float(wd & 0xffff0000u)}; }
#pragma unroll
        for (int t = 0; t < 4; ++t) { f32x2 a = w0 * full[t] + cb; a = w1 * full[t + 1] + a; a = w2 * full[t + 2] + a; a = w3 * full[t + 3] + a;
            f32x2 o; o.x = silu_f(a.x); o.y = silu_f(a.y);
            LAS float* dst = tid < 256 ? XC + ((tid >> 5) * 4 + t) * 64 + 2 * (tid & 31) : (tid < 320 ? BC + t * 128 + 2 * (tid - 256) : CC + t * 128 + 2 * (tid - 320));
            *(LAS f32x2*)dst = o; }
    } else if (tid < 416) { const int idx = tid - 384, hl = idx >> 2, t = idx & 3; const float x = DTR[(row0 + t) * 32 + 8 * g + hl] + F.in[12][8 * g + hl]; DTS[idx] = x > 20.f ? x : log1pf(__expf(x)); }
    __syncthreads();
    const float a = -__expf(F.in[13][h]), Dk = F.in[14][h];
#pragma unroll 1
    for (int t = 0; t < 4; ++t) {
        const float dtv = DTS[w * 4 + t], dA = __expf(dtv * a);
        const f32x4 Bv = *(const LAS f32x4*)(BC + t * 128 + 4 * nq), Cv = *(const LAS f32x4*)(CC + t * 128 + 4 * nq);
        const LAS float* xrow = XC + (w * 4 + t) * 64;
        float part[32];
#pragma unroll
        for (int i = 0; i < 32; ++i) { const float xd = xrow[2 * i + hh] * dtv; hst[i] = hst[i] * dA + Bv * xd; part[i] = (hst[i].x * Cv.x + hst[i].y * Cv.y) + (hst[i].z * Cv.z + hst[i].w * Cv.w); }
        float yv = tr_reduce32(part, lane);
        const int p = 2 * nq + hh; const size_t row = row0 + t;
        yv += Dk * xrow[p];
        const float z = bf2f(PROJ[(size_t)(S_Z0 + (h >> 4)) * SLOT_ELEMS + row * 1024 + (h & 15) * 64 + p]);
        const float yg = yv * silu_f(z);
        YG[row * 2048 + h * 64 + p] = (bf16)f2bf(yg);
        const float sq = wave_sum(yg * yg);
        if (lane == 0) SSQ[row * 32 + h] = sq;
    }
    float* so = F.out + O_SSMS + (size_t)(sb * 32 + h) * 8192 + (size_t)hh * 128 + 4 * nq;
#pragma unroll
    for (int i = 0; i < 32; ++i) st_nt(so + (size_t)i * 256, hst[i]);
    __syncthreads();
}
__device__ __forceinline__ void hgrn_sample_unit(Frame& F, int sb, int hq) {
    int tid_o = F.tid; asm volatile("" : "+v"(tid_o));
    const int tid = tid_o, lane = tid & 63, w = F.wave, hh = lane >> 5, vq = lane & 31; unsigned char* ws = F.ws;
    LAS float* FS = (LAS float*)(F.lds + RING_OFF); LAS float* KS = FS + 2048; LAS float* QS = KS + 2048; LAS float* VS = QS + 2048; LAS float* OP = VS + 2048;
    const bf16* PROJ = (const bf16*)(ws + WS_PROJ); bf16* ON = (bf16*)(ws + WS_ON);
    const size_t row0 = (size_t)TP + (size_t)sb * LS;
    const int hl = w >> 1, kh = w & 1, hd = 4 * hq + hl;
    const float* sp = F.in[5] + (size_t)(sb * 8 + hd) * 16384 + (size_t)(64 * kh + hh) * 128 + 4 * vq;
    f32x4 S[32];
#pragma unroll
    for (int i = 0; i < 32; ++i) S[i] = ld_nt(sp + (size_t)i * 256);
    { const int ch = hq * 512 + tid; const float lb = __builtin_amdgcn_rcpf(1.0f + __expf(F.in[17][1024 + ch] - F.in[17][ch]));
      const bf16* fp = PROJ + (size_t)S_F * SLOT_ELEMS + row0 * 1024 + ch; const bf16* qp = PROJ + (size_t)S_Q * SLOT_ELEMS + row0 * 1024 + ch; const bf16* ip = PROJ + (size_t)S_I * SLOT_ELEMS + row0 * 1024 + ch;
#pragma unroll
      for (int t = 0; t < 4; ++t) { const float u = fminf(fmaxf(bf2f(fp[(size_t)t * 1024]), -30.f), 30.f); const float fg = lb + (1.0f - lb) * sigmoid_f(u);
          const int o = ((tid >> 7) * 4 + t) * 128 + (tid & 127);
          FS[o] = fg; KS[o] = 1.0f - fg; QS[o] = silu_f(bf2f(qp[(size_t)t * 1024])); VS[o] = bf2f(ip[(size_t)t * 1024]); } }
    __syncthreads();
#pragma unroll 1
    for (int t = 0; t < 4; ++t) {
        const int o = (hl * 4 + t) * 128;
        const f32x4 vv = *(const LAS f32x4*)(VS + o + 4 * vq);
        f32x4 oa = (f32x4){0.f, 0.f, 0.f, 0.f};
#pragma unroll
        for (int i = 0; i < 32; ++i) { const int k = 64 * kh + 2 * i + hh; const float fk = FS[o + k], kv = KS[o + k], qk = QS[o + k]; S[i] = S[i] * fk + vv * kv; oa = oa + S[i] * qk; }
        oa.x += __shfl_xor(oa.x, 32); oa.y += __shfl_xor(oa.y, 32); oa.z += __shfl_xor(oa.z, 32); oa.w += __shfl_xor(oa.w, 32);
        if (hh == 0) *(LAS f32x4*)(OP + ((hl * 4 + t) * 2 + kh) * 128 + 4 * vq) = oa;
    }
    float* so = F.out + O_HGS + (size_t)(sb * 8 + hd) * 16384 + (size_t)(64 * kh + hh) * 128 + 4 * vq;
#pragma unroll
    for (int i = 0; i < 32; ++i) st_nt(so + (size_t)i * 256, S[i]);
    __syncthreads();
#pragma unroll
    for (int rr2 = 0; rr2 < 2; ++rr2) { const int rr = 2 * w + rr2, ohl = rr >> 2, t = rr & 3, ohd = 4 * hq + ohl; typedef float f32x2 __attribute__((ext_vector_type(2)));
        const f32x2 p0 = *(const LAS f32x2*)(OP + (rr * 2) * 128 + 2 * lane), p1 = *(const LAS f32x2*)(OP + (rr * 2 + 1) * 128 + 2 * lane);
        const float o0 = p0.x + p1.x, o1 = p0.y + p1.y; const float sq = wave_sum(o0 * o0 + o1 * o1); const float rs = __builtin_amdgcn_rsqf(sq * (1.0f / 128.0f) + EPS);
        const size_t row = row0 + t; const unsigned gw = *(const unsigned*)(PROJ + (size_t)S_HG * SLOT_ELEMS + row * 1024 + ohd * 128 + 2 * lane);
        *(unsigned*)(ON + row * 1024 + ohd * 128 + 2 * lane) = pk2(o0 * rs * silu_f(bf2f(gw & 0xffffu)), o1 * rs * silu_f(__uint_as_float(gw & 0xffff0000u))); }
    __syncthreads();
}
constexpr int U_HGS = NBS * 2, U_SSDS = NBS * 4, U_CONV = NBP + NBS;
__device__ __forceinline__ void scan_phase(Frame& F) {
    gu32* head = F.ctl + CW_QUEUE;
#define SCAN_QUEUE(qi, count, body) for (;;) { if (F.tid == 0) F.MISC[0] = __hip_atomic_fetch_add(head + 64 * (qi), 1u, RLX_AGENT); __syncthreads(); const int u = (int)F.MISC[0]; __syncthreads(); if (u >= (count)) break; body }
    SCAN_QUEUE(1, NBP * 32, ssd_unit_mfma(F, u >> 5, u & 31);)
    SCAN_QUEUE(0, NBP * 32, hgrn_v_unit(F, u >> 5, (u >> 2) & 7, u & 3);)
    SCAN_QUEUE(2, U_HGS, hgrn_sample_unit(F, u >> 1, u & 1);)
    SCAN_QUEUE(3, U_SSDS + U_CONV, if (u >= U_SSDS) { conv_copy_unit(F, u - U_SSDS); continue; } ssd_sample_unit(F, u >> 2, u & 3);)
#undef SCAN_QUEUE
}
typedef float f32x4s __attribute__((ext_vector_type(4)));
template <class Epi> __device__ __forceinline__ void small_tile_phase(Frame& F, const bf16* A, const bf16* Bt, int K, const Epi& E) {
    const int lane = F.lane, w = F.wave, r = lane & 31, hh = lane >> 5;
#pragma unroll 1
    for (int v = F.vcu; v < 256; v += F.G) {
    const int mt = v >> 4, nt = v & 15;
    const int kw = K >> 3;
    const bf16* ap = A + (size_t)(TP + 32 * mt + r) * K + w * kw + 8 * hh;
    const bf16* bp = Bt + (size_t)(64 * nt + r) * K + w * kw + 8 * hh;
    f32x16 acc0, acc1;
#pragma unroll
    for (int i = 0; i < 16; ++i) { acc0[i] = 0.f; acc1[i] = 0.f; }
#pragma unroll 4
    for (int ks = 0; ks < kw / 16; ++ks) { const bf16x8 af = *(const bf16x8*)(ap + 16 * ks), b0 = *(const bf16x8*)(bp + 16 * ks), b1 = *(const bf16x8*)(bp + (size_t)32 * K + 16 * ks);
        acc0 = MFMA32(b0, af, acc0); acc1 = MFMA32(b1, af, acc1); }
    LAS float* part = (LAS float*)(F.lds + RING_OFF) + w * 2048;
#pragma unroll
    for (int q4 = 0; q4 < 4; ++q4) { *(LAS f32x4*)(part + r * 64 + 8 * q4 + 4 * hh) = (f32x4){acc0[4 * q4], acc0[4 * q4 + 1], acc0[4 * q4 + 2], acc0[4 * q4 + 3]};
        *(LAS f32x4*)(part + r * 64 + 32 + 8 * q4 + 4 * hh) = (f32x4){acc1[4 * q4], acc1[4 * q4 + 1], acc1[4 * q4 + 2], acc1[4 * q4 + 3]}; }
    __syncthreads();
    const int rl = F.tid >> 4, c4 = (F.tid & 15) * 4; const LAS float* src = (const LAS float*)(F.lds + RING_OFF) + rl * 64 + c4;
    f32x4 sum = *(const LAS f32x4*)src;
#pragma unroll
    for (int ww = 1; ww < 8; ++ww) sum = sum + *(const LAS f32x4*)(src + ww * 2048);
    const f32x4s acc = (f32x4s){sum.x, sum.y, sum.z, sum.w};
    E.small(F, acc, TP + 32 * mt + rl, 64 * nt + c4, nt);
    __syncthreads();
    }
}
template <bool ADD> struct SmGate { bf16* O; const bf16* gate;
    __device__ __forceinline__ void small(Frame&, const f32x4s& a, int row, int col, int) const { const size_t off = (size_t)row * 1024 + col;
        const v2u gw = __builtin_nontemporal_load((const v2u*)(gate + off)); v2u ow = (v2u){0u, 0u}; if (ADD) ow = *(const v2u*)(O + off);
        float rr[4];
#pragma unroll
        for (int e = 0; e < 4; ++e) { const unsigned g16 = (gw[e >> 1] >> ((e & 1) * 16)) & 0xffffu, o16 = (ow[e >> 1] >> ((e & 1) * 16)) & 0xffffu; rr[e] = (ADD ? bf2f(o16) : 0.f) + sigmoid_f(bf2f(g16)) * a[e]; }
        v2u wv; wv.x = cvtpk_c(rr[0], rr[1]); wv.y = cvtpk_c(rr[2], rr[3]); *(v2u*)(O + off) = wv; } };
template <bool BF, bool BSC = false> struct SmRes { const float* base; const bf16* bb; bf16* hb; float* ssqp; const float* bsc;
    __device__ __forceinline__ void small(Frame& F, const f32x4s& a, int row, int col, int nt) const { const size_t off = (size_t)row * 1024 + col; f32x4 b;
        if (BF) { const v2u w = *(const v2u*)(bb + off); b = (f32x4){bf2f(w.x & 0xffffu), __uint_as_float(w.x & 0xffff0000u), bf2f(w.y & 0xffffu), __uint_as_float(w.y & 0xffff0000u)}; }
        else b = *(const f32x4*)(base + off);
        if constexpr (BSC) b = b * bsc[row];
        const f32x4 v = b + (f32x4){a[0], a[1], a[2], a[3]};
        { v2u wv; wv.x = cvtpk_c(v[0], v[1]); wv.y = cvtpk_c(v[2], v[3]); *(v2u*)(hb + off) = wv; }
        float sq = (v[0] * v[0] + v[1] * v[1]) + (v[2] * v[2] + v[3] * v[3]); sq += __shfl_xor(sq, 1); sq += __shfl_xor(sq, 2); sq += __shfl_xor(sq, 4); sq += __shfl_xor(sq, 8);
        if ((F.tid & 15) == 0) ssqp[(size_t)row * 16 + nt] = sq; } };
struct SmScale { bf16* O; const float* ssq; float scale;
    __device__ __forceinline__ void small(Frame&, const f32x4s& a, int row, int col, int) const { const float rs = pg8::row_rs<16>(ssq, row) * scale;
        v2u wv; wv.x = cvtpk_c(a[0] * rs, a[1] * rs); wv.y = cvtpk_c(a[2] * rs, a[3] * rs); *(v2u*)(O + (size_t)row * 1024 + col) = wv; } };
__device__ __forceinline__ void attn_stage_tile(LAS unsigned char* Lb, const bf16* src, size_t pitch, int tid) {
#pragma unroll 1
    for (int hb = 0; hb < 2; ++hb) { v4u v[8];
#pragma unroll
        for (int i = 0; i < 8; ++i) { const int id = tid + 512 * (8 * hb + i), row = id >> 5, c = id & 31; v[i] = *(const v4u*)(src + (size_t)row * pitch + c * 8); }
#pragma unroll
        for (int i = 0; i < 8; ++i) { const int id = tid + 512 * (8 * hb + i), row = id >> 5, c = id & 31; *(LAS v4u*)(Lb + row * 512 + ((c ^ (row & 15)) << 4)) = v[i]; } }
}
__device__ __forceinline__ void attn_prompt_unit(Frame& F, int b, int hd, int qb) {
    const int tid = F.tid, lane = F.lane, w = F.wave, r = lane & 31, hh = lane >> 5; unsigned char* ws = F.ws;
    LAS unsigned char* Lb = F.lds + RING_OFF;
    const bf16* QB = (const bf16*)(ws + WS_QB); const bf16* KB = (const bf16*)(ws + WS_KB); const bf16* VT = (const bf16*)(ws + WS_VT); bf16* OB = (bf16*)(ws + WS_OB);
    const size_t qrow = (size_t)b * SEQ + (size_t)qb * 256 + 32 * w + r;
    attn_stage_tile(Lb, KB + (size_t)b * 256 * 1024 + hd * 256, 1024, tid);
    const bf16* qp = QB + qrow * 1024 + hd * 256 + 8 * hh;
    bf16x8 qf = *(const bf16x8*)qp;
    __syncthreads();
    f32x16 S[8];
#pragma unroll
    for (int t = 0; t < 8; ++t)
#pragma unroll
        for (int i = 0; i < 16; ++i) S[t][i] = 0.f;
    const int sw = r & 15;
#pragma unroll 1
    for (int ks = 0; ks < 16; ++ks) {
        const bf16x8 qn = *(const bf16x8*)(qp + 16 * (ks < 15 ? ks + 1 : ks));
        const LAS unsigned char* kp = Lb + r * 512 + (((2 * ks + hh) ^ sw) << 4);
#pragma unroll
        for (int t = 0; t < 8; ++t) S[t] = MFMA32(lds_frag16(kp + t * 32 * 512), qf, S[t]);
        qf = qn;
    }
    float m = -3.0e38f;
#pragma unroll
    for (int t = 0; t < 8; ++t)
#pragma unroll
        for (int i = 0; i < 16; ++i) m = fmaxf(m, S[t][i]);
    m = fmaxf(m, __shfl_xor(m, 32));
    float l = 0.f;
#pragma unroll
    for (int t = 0; t < 8; ++t)
#pragma unroll
        for (int i = 0; i < 16; ++i) { const float pv = __builtin_amdgcn_exp2f(S[t][i] - m); S[t][i] = pv; l += pv; }
    l += __shfl_xor(l, 32);
    const float rl = __builtin_amdgcn_rcpf(l);
    bf16x8 pf[8][2];
#pragma unroll
    for (int t = 0; t < 8; ++t) { pf[t][0] = ACC_FRAG(S[t], 0); pf[t][1] = ACC_FRAG(S[t], 1); }
    __syncthreads();
    attn_stage_tile(Lb, VT + (size_t)(b * 4 + hd) * 256 * 256, 256, tid);
    __syncthreads();
    bf16* op = OB + qrow * 1024 + hd * 256 + 4 * hh;
#pragma unroll 1
    for (int dt = 0; dt < 8; ++dt) {
        f32x16 O;
#pragma unroll
        for (int i = 0; i < 16; ++i) O[i] = 0.f;
        const LAS unsigned char* vrow = Lb + (32 * dt + r) * 512 + 8 * hh;
#pragma unroll
        for (int t = 0; t < 8; ++t)
#pragma unroll
            for (int s2 = 0; s2 < 2; ++s2) {
                const v2u lo = *(const LAS v2u*)(vrow + (((4 * t + 2 * s2) ^ sw) << 4)), hi = *(const LAS v2u*)(vrow + (((4 * t + 2 * s2 + 1) ^ sw) << 4));
                const v4u wv4 = (v4u){lo.x, lo.y, hi.x, hi.y};
                O = MFMA32(__builtin_bit_cast(bf16x8, wv4), pf[t][s2], O);
            }
#pragma unroll
        for (int q4 = 0; q4 < 4; ++q4) { v2u o; o.x = cvtpk_c(O[4 * q4] * rl, O[4 * q4 + 1] * rl); o.y = cvtpk_c(O[4 * q4 + 2] * rl, O[4 * q4 + 3] * rl);
            *(v2u*)(op + 32 * dt + 8 * q4) = o; }
    }
    __syncthreads();
}
__device__ __forceinline__ void attn_sample_unit(Frame& F, int sb, int hd) {
    const int tid = F.tid, lane = F.lane, w = F.wave; unsigned char* ws = F.ws;
    LAS float* sc = (LAS float*)(F.lds + RING_OFF);
    LAS float* red = sc + 4 * 256;
    const bf16* QB = (const bf16*)(ws + WS_QB); bf16* OB = (bf16*)(ws + WS_OB);
    const size_t rowq = (size_t)TP + (size_t)sb * LS;
    float q[4][4];
#pragma unroll
    for (int t = 0; t < 4; ++t) { const v2u qw = *(const v2u*)(QB + (rowq + t) * 1024 + hd * 256 + 4 * lane); q[t][0] = bf2f(qw.x & 0xffffu); q[t][1] = bf2f(qw.x >> 16); q[t][2] = bf2f(qw.y & 0xffffu); q[t][3] = bf2f(qw.y >> 16); }
    const float* Kc = F.in[6] + ((size_t)sb * 256 * 4 + hd) * 256 + 4 * lane; const float* Vc = F.in[7] + ((size_t)sb * 256 * 4 + hd) * 256 + 4 * lane;
    f32x4 kv[8], kn[8];
#pragma unroll
    for (int u = 0; u < 8; ++u) kv[u] = ld_nt(Kc + (size_t)(w * 32 + u) * 1024);
#pragma unroll 1
    for (int kk0 = 0; kk0 < 32; kk0 += 8) {
#pragma unroll
        for (int u = 0; u < 8; ++u) kn[u] = kk0 < 24 ? ld_nt(Kc + (size_t)(w * 32 + kk0 + 8 + u) * 1024) : ld_nt(Vc + (size_t)(w * 32 + u) * 1024);
        { float part[32];
#pragma unroll
          for (int u = 0; u < 8; ++u)
#pragma unroll
              for (int t = 0; t < 4; ++t) part[4 * u + t] = (q[t][0] * kv[u].x + q[t][1] * kv[u].y) + (q[t][2] * kv[u].z + q[t][3] * kv[u].w);
          float sv = tr_reduce32(part, lane); sv += __shfl_xor(sv, 32);
          if (lane < 32) sc[(lane & 3) * 256 + w * 32 + kk0 + (lane >> 2)] = sv; }
#pragma unroll
        for (int u = 0; u < 8; ++u) kv[u] = kn[u]; }
    __syncthreads();
    if (w < 4) { float v[4]; float m = -3.0e38f;
#pragma unroll
        for (int j = 0; j < 4; ++j) { v[j] = sc[w * 256 + j * 64 + lane]; m = fmaxf(m, v[j]); }
        m = wave_max(m); float l = 0.f;
#pragma unroll
        for (int j = 0; j < 4; ++j) { v[j] = __builtin_amdgcn_exp2f(v[j] - m); l += v[j]; }
        l = wave_sum(l); const float rl = 1.0f / l;
#pragma unroll
        for (int j = 0; j < 4; ++j) sc[w * 256 + j * 64 + lane] = v[j] * rl; }
    __syncthreads();
    float o[4][4];
#pragma unroll
    for (int t = 0; t < 4; ++t)
#pragma unroll
        for (int e = 0; e < 4; ++e) o[t][e] = 0.f;
#pragma unroll 1
    for (int kk0 = 0; kk0 < 32; kk0 += 8) {
        if (kk0 < 24) {
#pragma unroll
            for (int u = 0; u < 8; ++u) kn[u] = ld_nt(Vc + (size_t)(w * 32 + kk0 + 8 + u) * 1024); }
#pragma unroll
        for (int u = 0; u < 8; ++u) { const int key = w * 32 + kk0 + u;
#pragma unroll
            for (int t = 0; t < 4; ++t) { const float pr = sc[t * 256 + key]; o[t][0] += pr * kv[u].x; o[t][1] += pr * kv[u].y; o[t][2] += pr * kv[u].z; o[t][3] += pr * kv[u].w; } }
#pragma unroll
        for (int u = 0; u < 8; ++u) kv[u] = kn[u]; }
#pragma unroll
    for (int t = 0; t < 4; ++t) *(LAS f32x4*)(red + (w * 4 + t) * 256 + 4 * lane) = (f32x4){o[t][0], o[t][1], o[t][2], o[t][3]};
    __syncthreads();
    { const int t = tid >> 7, d0 = (tid & 127) * 2; float a0 = 0.f, a1 = 0.f;
#pragma unroll
      for (int ww = 0; ww < 8; ++ww) { a0 += red[(ww * 4 + t) * 256 + d0]; a1 += red[(ww * 4 + t) * 256 + d0 + 1]; }
      *(unsigned*)(OB + (rowq + t) * 1024 + hd * 256 + d0) = pk2(a0, a1); }
    __syncthreads();
}
__device__ __forceinline__ void attn_phase(Frame& F) {
    const bool sample_first = (blockIdx.x >> 3) & 1;
    for (int pass = 0; pass < 2; ++pass) {
        if ((pass == 0) != sample_first) { for (int u = F.vcu; u < NBP * 4 * 8; u += F.G) attn_prompt_unit(F, u >> 5, (u >> 3) & 3, u & 7); }
        else { for (int u = F.vcu; u < NBS * 4; u += F.G) attn_sample_unit(F, u >> 2, u & 3); }
    }
}
__device__ __forceinline__ void final_norm_phase(Frame& F) {
    const int gw = F.vcu * NWAVES + F.wave, NGW = F.G * NWAVES; const float* SSQ = (const float*)(F.ws + WS_SSQP3); const float* wn = F.in[31]; const bf16* HB = (const bf16*)(F.ws + WS_HB);
    f32x4 wv[4];
#pragma unroll
    for (int j = 0; j < 2; ++j) { wv[2 * j] = *((const f32x4*)wn + 2 * (64 * j + F.lane)); wv[2 * j + 1] = *((const f32x4*)wn + 2 * (64 * j + F.lane) + 1); }
    for (int row = gw; row < T; row += NGW) {
        const f32x4* sp = (const f32x4*)(SSQ + (size_t)row * 16); float s = 0.f;
#pragma unroll
        for (int j = 0; j < 4; ++j) { const f32x4 a = sp[j]; s += (a.x + a.y) + (a.z + a.w); }
        const float rs = __builtin_amdgcn_rsqf(s * (1.0f / 1024.0f) + EPS);
#pragma unroll
        for (int j = 0; j < 2; ++j) { const int pc = 64 * j + F.lane; const v4u w = ld_nt16((const v4u*)(HB + (size_t)row * 1024) + pc);
            const f32x4 v0 = (f32x4){bf2f(w.x & 0xffffu), __uint_as_float(w.x & 0xffff0000u), bf2f(w.y & 0xffffu), __uint_as_float(w.y & 0xffff0000u)};
            const f32x4 v1 = (f32x4){bf2f(w.z & 0xffffu), __uint_as_float(w.z & 0xffff0000u), bf2f(w.w & 0xffffu), __uint_as_float(w.w & 0xffff0000u)};
            float* o = F.out + O_Y + (size_t)row * 1024 + 8 * pc; st_nt(o, v0 * rs * wv[2 * j]); st_nt(o + 4, v1 * rs * wv[2 * j + 1]); }
    }
}
#ifndef MK_N_LAUNCHES
#define MK_N_LAUNCHES 1
#endif
constexpr int PER_PHASE = 13;
constexpr int N_LAUNCHES = MK_N_LAUNCHES;
struct Args { const float* in[32]; float* out; unsigned char* ws; int ph_lo, ph_hi; };
__global__ void __launch_bounds__(NTHR, 2) skel_fwd(Args args) {
    extern __shared__ __attribute__((aligned(16))) unsigned char lds[];
    Frame F;
    F.lds = (LAS unsigned char*)lds;
    F.MISC = (volatile LAS unsigned*)(F.lds + MISC_OFF);
    F.tid = threadIdx.x; F.lane = F.tid & 63; F.wave = __builtin_amdgcn_readfirstlane(F.tid >> 6);
    F.G = gridDim.x; { const int bx = blockIdx.x; F.vcu = (F.G % 8 == 0) ? (bx % 8) * (F.G / 8) + bx / 8 : bx; }
    unsigned char* ws = args.ws; F.ws = ws; F.out = args.out;
    F.ctl = (gu32*)(ws + WS_CTL);
#pragma unroll
    for (int i = 0; i < 32; ++i) F.in[i] = args.in[i];
    for (int u = F.tid; u < (LDS_BYTES - LDSCTL_OFF) / 4; u += NTHR) ((LAS unsigned*)(F.lds + LDSCTL_OFF))[u] = 0u;
    __syncthreads();
    XcdBarrier bar; bar.bar = (unsigned*)(F.ctl + CW_BAR); bar.x = 0; bar.st = nullptr;
    if (N_LAUNCHES == 1) bar = xcd_barrier_post((unsigned*)(F.ctl + CW_BAR), F.MISC + 8);
#define GRID_BAR() do { if (N_LAUNCHES == 1) xcd_barrier(bar); } while (0)
    const int lo = args.ph_lo, hi = args.ph_hi;
#ifdef ONLY_PHASE
#define IN(k) ((k) == ONLY_PHASE && lo <= (k) && (k) < hi)
#else
#define IN(k) (lo <= (k) && (k) < hi)
#endif
#define BOTH(k) (IN(k) && IN((k) + 1))
    bf16* const XB = (bf16*)(ws + WS_XB); bf16* const PROJ = (bf16*)(ws + WS_PROJ);
    float* const Y = F.out + O_Y;
    if (IN(0)) { p0_prologue(F); if (BOTH(0)) GRID_BAR(); }
    if (IN(1)) {
        { pg8::Gemm g{XB, (const bf16*)(ws + WS_WIN), T, NPROJ, 1024}; pg8::StaticOrder S; S.init(T, NPROJ, F.G, (int)blockIdx.x);
          pg8::EpiScaleBf16<0, true> E{PROJ, SLOT_ELEMS, nullptr, 1.0f, (float*)(ws + WS_DT)};
          pg8::gemm_phase<pg8::EpiScaleBf16<0, true>, pg8::StaticOrder, true, true>(F.lds + RING_OFF, g, S, E); }
        { pg8::Gemm g{(const bf16*)(ws + WS_MNB), (const bf16*)(ws + WS_WKV), MEMR, 2048, 1024}; pg8::StaticOrder S; S.init(MEMR, 2048, F.G, (int)((blockIdx.x + 64) % F.G));
          pg8::EpiKV E{F.out + O_MKP, F.out + O_MVP, (bf16*)(ws + WS_KB), (bf16*)(ws + WS_VT), (const float*)(ws + WS_SSQM)};
          pg8::gemm_phase<pg8::EpiKV, pg8::StaticOrder, true, true>(F.lds + RING_OFF, g, S, E); }
        if (BOTH(1)) GRID_BAR();
    }
    if (IN(2)) { bc_prep_phase(F); hg_prep_phase(F); if (BOTH(2)) GRID_BAR(); }
    if (IN(3)) { scan_phase(F); if (BOTH(3)) GRID_BAR(); }
    if (IN(4)) { ssdnorm_phase(F); hgnorm_phase(F); if (BOTH(4)) GRID_BAR(); }
    if (IN(5)) { { SmGate<false> Es{(bf16*)(ws + WS_MERGED), PROJ + (size_t)S_GS * SLOT_ELEMS}; small_tile_phase(F, (const bf16*)(ws + WS_YG), (const bf16*)(ws + WS_WSSD), 2048, Es); }
        pg8::Gemm g{(const bf16*)(ws + WS_YG), (const bf16*)(ws + WS_WSSD), TP, 1024, 2048}; pg8::StaticOrder S; S.init(TP, 1024, F.G, (int)blockIdx.x);
        pg8::EpiGate<false> E{(bf16*)(ws + WS_MERGED), PROJ + (size_t)S_GS * SLOT_ELEMS};
        pg8::gemm_phase<pg8::EpiGate<false>, pg8::StaticOrder, true, true>(F.lds + RING_OFF, g, S, E);
          }
    if (IN(5)) { { SmGate<true> Es{(bf16*)(ws + WS_MERGED), PROJ + (size_t)S_GH * SLOT_ELEMS}; small_tile_phase(F, (const bf16*)(ws + WS_ON), (const bf16*)(ws + WS_WHG), 1024, Es); }
        pg8::Gemm g{(const bf16*)(ws + WS_ON), (const bf16*)(ws + WS_WHG), TP, 1024, 1024}; pg8::StaticOrder S; S.init(TP, 1024, F.G, (int)blockIdx.x);
        pg8::EpiGate<true> E{(bf16*)(ws + WS_MERGED), PROJ + (size_t)S_GH * SLOT_ELEMS};
        pg8::gemm_phase<pg8::EpiGate<true>, pg8::StaticOrder, true, true>(F.lds + RING_OFF, g, S, E);
        if (BOTH(5)) GRID_BAR(); }
    if (IN(6)) { { SmRes<true, true> Es{nullptr, XB, (bf16*)(ws + WS_HB), (float*)(ws + WS_SSQP1), (const float*)(ws + WS_SSQX)}; small_tile_phase(F, (const bf16*)(ws + WS_MERGED), (const bf16*)(ws + WS_WOUT), 1024, Es); }
        pg8::Gemm g{(const bf16*)(ws + WS_MERGED), (const bf16*)(ws + WS_WOUT), TP, 1024, 1024}; pg8::StaticOrder S; S.init(TP, 1024, F.G, (int)blockIdx.x);
        pg8::EpiRes<true, true> E{nullptr, nullptr, XB, (bf16*)(ws + WS_HB), (float*)(ws + WS_SSQP1), (const float*)(ws + WS_SSQX)};
        pg8::gemm_phase<pg8::EpiRes<true, true>, pg8::StaticOrder, true, true>(F.lds + RING_OFF, g, S, E);
        if (BOTH(6)) GRID_BAR(); }
    if (IN(7)) { { SmScale Es{(bf16*)(ws + WS_QB), (const float*)(ws + WS_SSQP1), QSCALE}; small_tile_phase(F, (const bf16*)(ws + WS_HB), (const bf16*)(ws + WS_WCQ), 1024, Es); }
        pg8::Gemm g{(const bf16*)(ws + WS_HB), (const bf16*)(ws + WS_WCQ), TP, 1024, 1024}; pg8::StaticOrder S; S.init(TP, 1024, F.G, (int)blockIdx.x);
        pg8::EpiScaleBf16<16, false> E{(bf16*)(ws + WS_QB), SLOT_ELEMS, (const float*)(ws + WS_SSQP1), QSCALE, nullptr};
        pg8::gemm_phase<pg8::EpiScaleBf16<16, false>, pg8::StaticOrder, true, true>(F.lds + RING_OFF, g, S, E);
        if (BOTH(7)) GRID_BAR(); }
    if (IN(8)) { attn_phase(F); if (BOTH(8)) GRID_BAR(); }
    if (IN(9)) { { SmRes<true> Es{nullptr, (const bf16*)(ws + WS_HB), (bf16*)(ws + WS_HB), (float*)(ws + WS_SSQP2)}; small_tile_phase(F, (const bf16*)(ws + WS_OB), (const bf16*)(ws + WS_WCO), 1024, Es); }
        pg8::Gemm g{(const bf16*)(ws + WS_OB), (const bf16*)(ws + WS_WCO), TP, 1024, 1024}; pg8::StaticOrder S; S.init(TP, 1024, F.G, (int)blockIdx.x);
        pg8::EpiRes<true> E{nullptr, nullptr, (const bf16*)(ws + WS_HB), (bf16*)(ws + WS_HB), (float*)(ws + WS_SSQP2)};
        pg8::gemm_phase<pg8::EpiRes<true>, pg8::StaticOrder, true, true>(F.lds + RING_OFF, g, S, E);
        if (BOTH(9)) GRID_BAR(); }
    if (IN(10)) { pg8::Gemm g{(const bf16*)(ws + WS_HB), (const bf16*)(ws + WS_WGU), T, 2 * FFN, 1024}; pg8::StaticOrder S; S.init(T, 2 * FFN, F.G, (int)blockIdx.x);
        pg8::EpiSwiglu E{(bf16*)(ws + WS_ACT), (const float*)(ws + WS_SSQP2)};
        pg8::gemm_phase<pg8::EpiSwiglu, pg8::StaticOrder, true, true>(F.lds + RING_OFF, g, S, E);
        if (BOTH(10)) GRID_BAR(); }
    if (IN(11)) { { SmRes<true> Es{nullptr, (const bf16*)(ws + WS_HB), (bf16*)(ws + WS_HB), (float*)(ws + WS_SSQP3)}; small_tile_phase(F, (const bf16*)(ws + WS_ACT), (const bf16*)(ws + WS_WDN), FFN, Es); }
        pg8::Gemm g{(const bf16*)(ws + WS_ACT), (const bf16*)(ws + WS_WDN), TP, 1024, FFN}; pg8::StaticOrder S; S.init(TP, 1024, F.G, (int)blockIdx.x);
        pg8::EpiRes<true> E{nullptr, nullptr, (const bf16*)(ws + WS_HB), (bf16*)(ws + WS_HB), (float*)(ws + WS_SSQP3)};
        pg8::gemm_phase<pg8::EpiRes<true>, pg8::StaticOrder, true, true>(F.lds + RING_OFF, g, S, E);
        if (BOTH(11)) GRID_BAR(); }
    if (IN(12)) final_norm_phase(F);
#undef IN
#undef BOTH
}

extern "C" void kernel_launch(void* const* d_in, const int* in_sizes, int n_in, void* d_out, int out_size, void* d_ws, size_t ws_size, hipStream_t stream) {
    static int grid = 0;
    if (grid == 0) {
        const int want[32] = {TP * 1024, TS * 1024, MEMR * 1024, 33554432, 1179648, 16777216, 33554432, 33554432, 1024, 1024 * 11296, 4 * 3072, 3072, 32, 32, 32, 2048, 2048 * 1024, 2048, 1024,
                              1024 * 1024, 1024 * 1024, 1024, 1024, 1024 * 1024, 1024 * 1024, 1024 * 1024, 1024 * 1024, 1024, 1024 * FFN, 1024 * FFN, FFN * 1024, 1024};
        bool ok = (n_in == 32); for (int i = 0; ok && i < 32; ++i) if (in_sizes[i] != want[i]) { fprintf(stderr, "kernel_launch: input %d has %d elements, expected %d\n", i, in_sizes[i], want[i]); ok = false; }
        if (!ok || out_size != (int)O_END || ws_size < WS_END4) { fprintf(stderr, "kernel_launch: unexpected shapes: n_in %d out %d ws %zu\n", n_in, out_size, ws_size); grid = -1; return; }
        int dev = 0, cus = 0, per_cu = 0;
        if (hipGetDevice(&dev) != hipSuccess || hipDeviceGetAttribute(&cus, hipDeviceAttributeMultiprocessorCount, dev) != hipSuccess) { grid = -1; return; }
        if (hipFuncSetAttribute((const void*)skel_fwd, hipFuncAttributeMaxDynamicSharedMemorySize, LDS_BYTES) != hipSuccess) { fprintf(stderr, "kernel_launch: hipFuncSetAttribute failed\n"); grid = -1; return; }
        if (hipOccupancyMaxActiveBlocksPerMultiprocessor(&per_cu, (const void*)skel_fwd, NTHR, LDS_BYTES) != hipSuccess || per_cu < 1) fprintf(stderr, "kernel_launch: occupancy query reports %d blocks per CU\n", per_cu);
        (void)hipGetLastError();
        grid = cus;
    }
    if (grid < 0) return;
    (void)hipMemsetAsync((char*)d_ws + WS_CTL, 0, CTL_ZERO_BYTES, stream);
    Args a{};
    for (int i = 0; i < 32; ++i) a.in[i] = (const float*)d_in[i];
    a.out = (float*)d_out; a.ws = (unsigned char*)d_ws;
    for (int li = 0; li < N_LAUNCHES; ++li) {
        a.ph_lo = (N_LAUNCHES == PER_PHASE) ? li : 0; a.ph_hi = (N_LAUNCHES == PER_PHASE) ? li + 1 : PER_PHASE;
        hipLaunchKernelGGL(skel_fwd, dim3(grid), dim3(NTHR), LDS_BYTES, stream, a);
    }
}
```

```cpp
#include <hip/hip_runtime.h>
#include <cstdio>
#include <cstdint>
namespace pg8 {
#define PG8_LAS __attribute__((address_space(3)))
typedef unsigned short bf16_t;
typedef short bf16x8 __attribute__((ext_vector_type(8)));
typedef float f32x4 __attribute__((ext_vector_type(4)));
typedef unsigned u32x4 __attribute__((ext_vector_type(4)));
constexpr int BM = 256, BK = 64, HALF = 128, HTB = HALF * BK * 2  , STAGE_BYTES = 8 * HTB, NXCD = 8, WGM = 4;

__host__ __device__ __forceinline__ int lds_byte(int r, int c) { const int st = (r >> 4) * 2 + (c >> 5), rr = r & 15, cc = c & 31, ob = rr * 64 + cc * 2; return st * 1024 + (ob ^ (((ob >> 9) & 1) << 5)); }
__host__ __device__ __forceinline__ void stage_rc(int b, int& R, int& C) { const int st = b / 1024, sb = b % 1024, swz = sb ^ (((sb >> 9) & 1) << 5); R = (st >> 1) * 16 + swz / 64; C = (st & 1) * 32 + (swz % 64) / 2; }
__host__ __device__ __forceinline__ int perm32(int rho) { const int n = rho >> 4, i = rho & 15; return 8 * (i >> 2) + 4 * n + (i & 3); }

struct Unit { int pm, pn; };
struct Gemm { const bf16_t* A; const bf16_t* Bt; int M, N, K; };

struct StaticOrder {
    int nM, nN, nwg, G, c;
    __host__ __device__ void init(int M, int N, int G_, int c_) { nM = M / BM; nN = N / BM; nwg = nM * nN; G = G_; c = c_; }
    __host__ __device__ __forceinline__ bool next(int i, Unit& u) const {
        const long L = (long)i * G + c; if (L >= nwg) return false;
        int wgid = (int)L; { const int q = nwg / NXCD, r = nwg % NXCD, xcd = wgid % NXCD, off = wgid / NXCD; wgid = (xcd < r ? xcd * (q + 1) : r * (q + 1) + (xcd - r) * q) + off; }
        const int nig = WGM * nN, gid = wgid / nig, fm = gid * WGM, gsz = (nM - fm) < WGM ? (nM - fm) : WGM;
        u.pm = fm + ((wgid % nig) % gsz); u.pn = (wgid % nig) / gsz; return true;
    }
    __device__ __forceinline__ void a_ready(const Unit&) const {}
    __device__ __forceinline__ void done(const Unit&) const {}
};

__device__ __forceinline__ unsigned cvt_pk_bf16(float lo, float hi) { unsigned r; asm volatile("v_cvt_pk_bf16_f32 %0, %1, %2" : "=v"(r) : "v"(lo), "v"(hi)); return r; }
typedef float f32x2 __attribute__((ext_vector_type(2)));
typedef unsigned u32x2 __attribute__((ext_vector_type(2)));
constexpr float RMS_EPS = 1e-6f;
__device__ __forceinline__ float bfbits2f(unsigned v16) { return __uint_as_float(v16 << 16); }
__device__ __forceinline__ float sigm(float x) { return __builtin_amdgcn_rcpf(1.0f + __expf(-x)); }
template <int NP> __device__ __forceinline__ float row_rs(const float* ssq, int row) {
    float s = 0.f;
    if constexpr (NP == 1) s = ssq[row];
    else {
#pragma unroll
        for (int i = 0; i < NP / 4; ++i) { const f32x4 v = *(const f32x4*)(ssq + (size_t)row * NP + 4 * i); s += (v[0] + v[1]) + (v[2] + v[3]); }
    }
    return 1.0f / sqrtf(s * (1.0f / 1024.0f) + RMS_EPS);
}
template <int NP, bool HAS_DT> struct EpiScaleBf16 {
    static constexpr bool PERM = true, AFTER_DRAIN = false;
    bf16_t* O; size_t slot_elems; const float* ssq; float scale; float* dt;
    __device__ __forceinline__ void operator()(const f32x4 (&acc)[2][2][4][2], const Unit& u, int wr, int wc, int fr, int fq) const {
        const int row0 = u.pm * BM + wr * 64 + fr;
        if (HAS_DT && u.pn == 44) {
            if (wc == 0) {
#pragma unroll
                for (int ai = 0; ai < 2; ++ai)
#pragma unroll
                    for (int m = 0; m < 4; ++m) { const int row = row0 + ai * HALF + m * 16; float rs = 1.0f; if constexpr (NP > 0) rs = row_rs<NP>(ssq, row);
                        float* p = dt + (size_t)row * 32 + 8 * fq; *(f32x4*)p = acc[ai][0][m][0] * rs; *(f32x4*)(p + 4) = acc[ai][0][m][1] * rs; }
            }
            return;
        }
        bf16_t* base = O + (size_t)(u.pn >> 2) * slot_elems; const int col0 = (u.pn & 3) * BM + wc * 32 + 8 * fq;
#pragma unroll
        for (int ai = 0; ai < 2; ++ai)
#pragma unroll
            for (int m = 0; m < 4; ++m) { const int row = row0 + ai * HALF + m * 16; float rs = scale; if constexpr (NP > 0) rs = row_rs<NP>(ssq, row) * scale; bf16_t* rowp = base + (size_t)row * 1024 + col0;
#pragma unroll
                for (int bj = 0; bj < 2; ++bj) { const f32x4 v0 = acc[ai][bj][m][0] * rs, v1 = acc[ai][bj][m][1] * rs;
                    u32x4 w; w.x = cvt_pk_bf16(v0[0], v0[1]); w.y = cvt_pk_bf16(v0[2], v0[3]); w.z = cvt_pk_bf16(v1[0], v1[1]); w.w = cvt_pk_bf16(v1[2], v1[3]);
                    if (HAS_DT) __builtin_nontemporal_store(w, (u32x4*)(rowp + bj * HALF));
                    else *(u32x4*)(rowp + bj * HALF) = w; } }
    }
};
struct EpiKV {
    static constexpr bool PERM = false, AFTER_DRAIN = false;
    float* mk; float* mv; bf16_t* kb; bf16_t* vt; const float* ssq;
    __device__ __forceinline__ void operator()(const f32x4 (&acc)[2][2][4][2], const Unit& u, int wr, int wc, int fr, int fq) const {
        const int row0 = u.pm * BM + wr * 64 + fr; const bool isv = u.pn >= 4; const int colt = (u.pn & 3) * BM + wc * 32 + 4 * fq;
#pragma unroll
        for (int ai = 0; ai < 2; ++ai)
#pragma unroll
            for (int m = 0; m < 4; ++m) { const int row = row0 + ai * HALF + m * 16; const float rs = 1.0f;
#pragma unroll
                for (int bj = 0; bj < 2; ++bj)
#pragma unroll
                    for (int n = 0; n < 2; ++n) { const int c = colt + bj * HALF + n * 16; const f32x4 v = acc[ai][bj][m][n] * rs;
                        if (!isv) { __builtin_nontemporal_store(v, (f32x4*)(mk + (size_t)row * 1024 + c)); u32x2 w; w.x = cvt_pk_bf16(v[0], v[1]); w.y = cvt_pk_bf16(v[2], v[3]); *(u32x2*)(kb + (size_t)row * 1024 + c) = w; }
                        else { __builtin_nontemporal_store(v, (f32x4*)(mv + (size_t)row * 1024 + c)); const int b = row >> 8, key = row & 255, hd = c >> 8, d = c & 255;
                            bf16_t* p = vt + ((size_t)((b * 4 + hd) * 256 + d)) * 256 + key; const unsigned w0 = cvt_pk_bf16(v[0], v[1]), w1 = cvt_pk_bf16(v[2], v[3]);
                            p[0] = (bf16_t)(w0 & 0xffffu); p[256] = (bf16_t)(w0 >> 16); p[512] = (bf16_t)(w1 & 0xffffu); p[768] = (bf16_t)(w1 >> 16); } } }
    }
};
template <bool ADD, bool RS = false> struct EpiGate {
    static constexpr bool PERM = true, AFTER_DRAIN = false;
    bf16_t* O; const bf16_t* gate; const PG8_LAS float* rt;
    __device__ __forceinline__ void operator()(const f32x4 (&acc)[2][2][4][2], const Unit& u, int wr, int wc, int fr, int fq) const {
        const int row0 = u.pm * BM + wr * 64 + fr, col0 = u.pn * BM + wc * 32 + 8 * fq;
#pragma unroll
        for (int ai = 0; ai < 2; ++ai)
#pragma unroll
            for (int m = 0; m < 4; ++m) { const size_t off = (size_t)(row0 + ai * HALF + m * 16) * 1024 + col0; float rsl = 1.0f; if constexpr (RS) rsl = rt[(ai * HALF + wr * 64 + m * 16 + fr) * 4 + 3];
#pragma unroll
                for (int bj = 0; bj < 2; ++bj) { const u32x4 gw = __builtin_nontemporal_load((const u32x4*)(gate + off + bj * HALF)); u32x4 ow = (u32x4){0u, 0u, 0u, 0u}; if (ADD) ow = *(const u32x4*)(O + off + bj * HALF);
                    float r[8];
#pragma unroll
                    for (int e = 0; e < 8; ++e) { const unsigned g16 = (gw[e >> 1] >> ((e & 1) * 16)) & 0xffffu, o16 = (ow[e >> 1] >> ((e & 1) * 16)) & 0xffffu;
                        const float a = RS ? acc[ai][bj][m][e >> 2][e & 3] * rsl : acc[ai][bj][m][e >> 2][e & 3]; r[e] = (ADD ? bfbits2f(o16) : 0.f) + sigm(bfbits2f(g16)) * a; }
                    u32x4 w; w.x = cvt_pk_bf16(r[0], r[1]); w.y = cvt_pk_bf16(r[2], r[3]); w.z = cvt_pk_bf16(r[4], r[5]); w.w = cvt_pk_bf16(r[6], r[7]);
                    *(u32x4*)(O + off + bj * HALF) = w; } }
    }
};
template <bool BF, bool BSC = false> struct EpiRes {
    static constexpr bool PERM = true, AFTER_DRAIN = false;
    const float* base0; const float* base1; const bf16_t* bb; bf16_t* hb; float* ssqp; const float* bsc;
    __device__ __forceinline__ void operator()(const f32x4 (&acc)[2][2][4][2], const Unit& u, int wr, int wc, int fr, int fq) const {
        const int row0 = u.pm * BM + wr * 64 + fr, col0 = u.pn * BM + wc * 32 + 8 * fq; const float* base = u.pm < 64 ? base0 : base1;
#pragma unroll
        for (int ai = 0; ai < 2; ++ai)
#pragma unroll
            for (int m = 0; m < 4; ++m) { const int row = row0 + ai * HALF + m * 16; const size_t off = (size_t)row * 1024 + col0; float sq = 0.f; float bs = 1.0f; if constexpr (BSC) bs = bsc[row];
#pragma unroll
                for (int bj = 0; bj < 2; ++bj) { const size_t o2 = off + bj * HALF; f32x4 b0, b1;
                    if (BF) { const u32x4 w = *(const u32x4*)(bb + o2); b0 = (f32x4){bfbits2f(w.x & 0xffffu), __uint_as_float(w.x & 0xffff0000u), bfbits2f(w.y & 0xffffu), __uint_as_float(w.y & 0xffff0000u)};
                        b1 = (f32x4){bfbits2f(w.z & 0xffffu), __uint_as_float(w.z & 0xffff0000u), bfbits2f(w.w & 0xffffu), __uint_as_float(w.w & 0xffff0000u)}; }
                    else { b0 = __builtin_nontemporal_load((const f32x4*)(base + o2)); b1 = __builtin_nontemporal_load((const f32x4*)(base + o2 + 4)); }
                    if constexpr (BSC) { b0 = b0 * bs; b1 = b1 * bs; }
                    const f32x4 v0 = b0 + acc[ai][bj][m][0], v1 = b1 + acc[ai][bj][m][1];
                    sq += ((v0[0] * v0[0] + v0[1] * v0[1]) + (v0[2] * v0[2] + v0[3] * v0[3])) + ((v1[0] * v1[0] + v1[1] * v1[1]) + (v1[2] * v1[2] + v1[3] * v1[3]));
                    u32x4 w; w.x = cvt_pk_bf16(v0[0], v0[1]); w.y = cvt_pk_bf16(v0[2], v0[3]); w.z = cvt_pk_bf16(v1[0], v1[1]); w.w = cvt_pk_bf16(v1[2], v1[3]); *(u32x4*)(hb + o2) = w; }
                sq += __shfl_xor(sq, 16); sq += __shfl_xor(sq, 32);
                if (fq == 0) ssqp[(size_t)row * 16 + u.pn * 4 + wc] = sq; }
    }
};
struct EpiSwiglu {
    static constexpr bool PERM = true, AFTER_DRAIN = false;
    bf16_t* act; const float* ssq;
    __device__ __forceinline__ void operator()(const f32x4 (&acc)[2][2][4][2], const Unit& u, int wr, int wc, int fr, int fq) const {
        const int row0 = u.pm * BM + wr * 64 + fr, col0 = u.pn * 128 + wc * 16 + 4 * fq;
#pragma unroll
        for (int ai = 0; ai < 2; ++ai)
#pragma unroll
            for (int m = 0; m < 4; ++m) { const int row = row0 + ai * HALF + m * 16; const float rs = row_rs<16>(ssq, row);
#pragma unroll
                for (int bj = 0; bj < 2; ++bj) { const f32x4 a = acc[ai][bj][m][0] * rs, b = acc[ai][bj][m][1] * rs;
                    const float r0 = a[0] * sigm(a[0]) * a[1], r1 = a[2] * sigm(a[2]) * a[3], r2 = b[0] * sigm(b[0]) * b[1], r3 = b[2] * sigm(b[2]) * b[3];
                    u32x2 w; w.x = cvt_pk_bf16(r0, r1); w.y = cvt_pk_bf16(r2, r3); *(u32x2*)(act + (size_t)row * 2816 + col0 + bj * 64) = w; } }
    }
};
template <class Epi, class Sched, bool ALIGN_EPI = false, bool SP2 = false, int EPI_REP = 1, bool KSEG = false>
__device__ __forceinline__ void gemm_phase(PG8_LAS unsigned char* lds, const Gemm g, const Sched& S, const Epi& E, const PG8_LAS float* rt = nullptr) {
    int tid_o = threadIdx.x; if constexpr (KSEG) asm volatile("" : "+v"(tid_o));
    const int tid = tid_o, wid = __builtin_amdgcn_readfirstlane(tid >> 6), lane = tid & 63, wr = wid >> 2, wc = wid & 3, fr = lane & 15, fq = lane >> 4;
    const int K = g.K, nt = KSEG ? 8 : K / BK;
    unsigned voffA[2], voffB[2];
#pragma unroll
    for (int i = 0; i < 2; ++i) { int R, C; stage_rc(tid * 16 + i * 8192, R, C); const int Rb = Epi::PERM ? ((R & ~31) + perm32(R & 31)) : R;
        voffA[i] = (unsigned)(R * K + C) * 2u; voffB[i] = (unsigned)(Rb * K + C) * 2u; }
    const size_t kstep = (size_t)(BK * 2);
    const size_t hstep = (size_t)HALF * K * 2;
    const size_t tstep = 2 * hstep;
    const unsigned ldsw = (unsigned)wid * 1024u;
    const int aoff = lds_byte(wr * 64 + fr, fq * 8), boff = lds_byte(wc * 32 + fr, fq * 8);
#define PG8_SA(b, h) (((b) * 2 + (h)) * HTB)
#define PG8_SB(b, h) ((4 + (b) * 2 + (h)) * HTB)
#define PG8_STAGE(bufoff, gbase, voff) do { _Pragma("unroll") for (int _i = 0; _i < 2; ++_i) \
        __builtin_amdgcn_global_load_lds((const unsigned*)((const char*)(gbase) + (voff)[_i]), (PG8_LAS unsigned*)(lds + (bufoff) + ldsw + _i * 8192), 16, 0, 0); } while (0)
#define PG8_LDA(dst, b, h) do { _Pragma("unroll") for (int m = 0; m < 4; ++m) _Pragma("unroll") for (int k = 0; k < 2; ++k) dst[m][k] = *(const PG8_LAS bf16x8*)(lds + PG8_SA(b, h) + aoff + m * 2048 + k * 1024); } while (0)
#define PG8_LDB(dst, b, h) do { _Pragma("unroll") for (int n = 0; n < 2; ++n) _Pragma("unroll") for (int k = 0; k < 2; ++k) dst[n][k] = *(const PG8_LAS bf16x8*)(lds + PG8_SB(b, h) + boff + n * 2048 + k * 1024); } while (0)
#define PG8_MMA(ai, bj, At, Bt) do { __builtin_amdgcn_s_setprio(1); _Pragma("unroll") for (int m = 0; m < 4; ++m) _Pragma("unroll") for (int n = 0; n < 2; ++n) _Pragma("unroll") for (int k = 0; k < 2; ++k) \
        acc[ai][bj][m][n] = __builtin_amdgcn_mfma_f32_16x16x32_bf16(Bt[n][k], At[m][k], acc[ai][bj][m][n], 0, 0, 0); __builtin_amdgcn_s_setprio(0); } while (0)
#define PG8_WAIT_V(n) asm volatile("s_waitcnt vmcnt(" #n ")" ::: "memory")
#define PG8_WAIT_L(n) asm volatile("s_waitcnt lgkmcnt(" #n ")" ::: "memory")
#define PG8_BAR __builtin_amdgcn_s_barrier()
#define PG8_SCHED __builtin_amdgcn_sched_barrier(0)
    Unit cur, nxt; int ui = 0;
    if (!S.next(0, cur)) return;
    f32x4 acc[2][2][4][2];
#pragma unroll
    for (int a = 0; a < 2; ++a)
#pragma unroll
        for (int b = 0; b < 2; ++b)
#pragma unroll
            for (int m = 0; m < 4; ++m)
#pragma unroll
                for (int n = 0; n < 2; ++n) acc[a][b][m][n] = (f32x4){0.f, 0.f, 0.f, 0.f};
    bf16x8 At[4][2], B0[2][2], B1[2][2];
    const char* cA = (const char*)g.A + (size_t)cur.pm * tstep; const char* cB = (const char*)g.Bt + (size_t)cur.pn * tstep;
    S.a_ready(cur);
    if constexpr (SP2) {
        PG8_STAGE(PG8_SB(0, 0), cB, voffB); PG8_STAGE(PG8_SB(0, 1), cB + hstep, voffB); PG8_STAGE(PG8_SA(0, 0), cA, voffA); PG8_STAGE(PG8_SA(0, 1), cA + hstep, voffA);
        if (wr == 1) PG8_BAR;
        PG8_WAIT_V(2); PG8_BAR;
        PG8_STAGE(PG8_SB(1, 0), cB + kstep, voffB); PG8_STAGE(PG8_SA(1, 0), cA + kstep, voffA); PG8_STAGE(PG8_SB(1, 1), cB + hstep + kstep, voffB);
        PG8_WAIT_V(6); PG8_BAR;
    } else {
        PG8_STAGE(PG8_SB(0, 0), cB, voffB); PG8_STAGE(PG8_SA(0, 0), cA, voffA); PG8_STAGE(PG8_SB(0, 1), cB + hstep, voffB); PG8_STAGE(PG8_SA(0, 1), cA + hstep, voffA);
        if (wr == 1) PG8_BAR;
        PG8_WAIT_V(4); PG8_BAR;
        PG8_STAGE(PG8_SB(1, 0), cB + kstep, voffB); PG8_STAGE(PG8_SA(1, 0), cA + kstep, voffA); PG8_STAGE(PG8_SB(1, 1), cB + hstep + kstep, voffB);
        PG8_WAIT_V(6); PG8_BAR;
    }
    for (;;) {
        bool has_next; if constexpr (KSEG) { has_next = ui < 3; nxt = cur; } else has_next = S.next(ui + 1, nxt);
        const char* nA = has_next ? (KSEG ? cA + 8 * kstep : (const char*)g.A + (size_t)nxt.pm * tstep) : cA; const char* nB = has_next ? (KSEG ? cB + 8 * kstep : (const char*)g.Bt + (size_t)nxt.pn * tstep) : cB;
        for (int t = 0; t < nt; t += 2) {
            const bool last = (t == nt - 2);
            const char* a1 = cA + (size_t)(t + 1) * kstep;
            const char* a2 = last ? nA : cA + (size_t)(t + 2) * kstep; const char* b2 = last ? nB : cB + (size_t)(t + 2) * kstep;
            const char* a3 = a2 + kstep; const char* b3 = b2 + kstep;
            if (last && has_next) S.a_ready(nxt);
            if constexpr (SP2) {
            PG8_LDB(B0, 0, 0); PG8_LDB(B1, 0, 1); PG8_SCHED; PG8_LDA(At, 0, 0); PG8_STAGE(PG8_SA(1, 1), a1 + hstep, voffA);
            PG8_WAIT_V(8); PG8_WAIT_L(0); PG8_BAR; PG8_MMA(0, 0, At, B0); PG8_MMA(0, 1, At, B1); PG8_BAR; PG8_SCHED;
            PG8_LDA(At, 0, 1); PG8_STAGE(PG8_SB(0, 0), b2, voffB); PG8_STAGE(PG8_SB(0, 1), b2 + hstep, voffB); PG8_STAGE(PG8_SA(0, 0), a2, voffA);
            PG8_WAIT_V(8); PG8_WAIT_L(0); PG8_BAR; PG8_MMA(1, 0, At, B0); PG8_MMA(1, 1, At, B1); PG8_BAR; PG8_SCHED;
            PG8_LDB(B0, 1, 0); PG8_LDB(B1, 1, 1); PG8_SCHED; PG8_LDA(At, 1, 0); PG8_STAGE(PG8_SA(0, 1), a2 + hstep, voffA);
            PG8_WAIT_V(8); PG8_WAIT_L(0); PG8_BAR; PG8_MMA(0, 0, At, B0); PG8_MMA(0, 1, At, B1); PG8_BAR; PG8_SCHED;
            PG8_LDA(At, 1, 1); PG8_STAGE(PG8_SB(1, 0), b3, voffB); PG8_STAGE(PG8_SB(1, 1), b3 + hstep, voffB); PG8_STAGE(PG8_SA(1, 0), a3, voffA);
            PG8_WAIT_V(8); PG8_WAIT_L(0); PG8_BAR; PG8_MMA(1, 0, At, B0); PG8_MMA(1, 1, At, B1); PG8_BAR; PG8_SCHED;
            } else {
            PG8_LDB(B0, 0, 0); PG8_SCHED; PG8_LDA(At, 0, 0); PG8_STAGE(PG8_SA(1, 1), a1 + hstep, voffA);
            PG8_WAIT_L(8); PG8_BAR; PG8_WAIT_L(0); PG8_MMA(0, 0, At, B0); PG8_BAR; PG8_SCHED;
            PG8_LDB(B1, 0, 1); PG8_STAGE(PG8_SB(0, 0), b2, voffB);
            PG8_BAR; PG8_WAIT_L(0); PG8_MMA(0, 1, At, B1); PG8_BAR;
            PG8_LDA(At, 0, 1); PG8_STAGE(PG8_SA(0, 0), a2, voffA);
            PG8_BAR; PG8_WAIT_L(0); PG8_MMA(1, 0, At, B0); PG8_BAR; PG8_SCHED;
            PG8_STAGE(PG8_SB(0, 1), b2 + hstep, voffB);
            PG8_WAIT_V(6); PG8_BAR; PG8_MMA(1, 1, At, B1); PG8_BAR;
            PG8_LDB(B0, 1, 0); PG8_SCHED; PG8_LDA(At, 1, 0); PG8_STAGE(PG8_SA(0, 1), a2 + hstep, voffA);
            PG8_WAIT_L(8); PG8_BAR; PG8_WAIT_L(0); PG8_MMA(0, 0, At, B0); PG8_BAR; PG8_SCHED;
            PG8_LDB(B1, 1, 1); PG8_STAGE(PG8_SB(1, 0), b3, voffB);
            PG8_BAR; PG8_WAIT_L(0); PG8_MMA(0, 1, At, B1); PG8_BAR;
            PG8_LDA(At, 1, 1); PG8_STAGE(PG8_SA(1, 0), a3, voffA);
            PG8_BAR; PG8_WAIT_L(0); PG8_MMA(1, 0, At, B0); PG8_BAR; PG8_SCHED;
            PG8_STAGE(PG8_SB(1, 1), b3 + hstep, voffB);
            PG8_WAIT_V(6); PG8_BAR; PG8_MMA(1, 1, At, B1); PG8_BAR;
            }
        }
        if constexpr (ALIGN_EPI) { if (wr == 0) PG8_BAR; }
        if constexpr (KSEG) { if (has_next) { const PG8_LAS float* rp = rt + (wr * 64 + fr) * 4 + ui;
#pragma unroll
                for (int a = 0; a < 2; ++a)
#pragma unroll
                    for (int m = 0; m < 4; ++m) { const float rr = rp[(a * 128 + m * 16) * 4];
#pragma unroll
                        for (int b = 0; b < 2; ++b)
#pragma unroll
                            for (int n = 0; n < 2; ++n) acc[a][b][m][n] = acc[a][b][m][n] * rr; } }
            else { E(acc, cur, wr, wc, fr, fq); S.done(cur); } }
        else if constexpr (!Epi::AFTER_DRAIN) { for (int rep = 0; rep < EPI_REP; ++rep) { E(acc, cur, wr, wc, fr, fq); asm volatile("" ::: "memory"); } S.done(cur); }
        if (!has_next) break;
        if constexpr (!KSEG)
#pragma unroll
        for (int a = 0; a < 2; ++a)
#pragma unroll
            for (int b = 0; b < 2; ++b)
#pragma unroll
                for (int m = 0; m < 4; ++m)
#pragma unroll
                    for (int n = 0; n < 2; ++n) acc[a][b][m][n] = (f32x4){0.f, 0.f, 0.f, 0.f};
        cur = nxt; cA = nA; cB = nB; ++ui;
        if constexpr (ALIGN_EPI) { if (wr == 1) PG8_BAR; }
    }
    PG8_WAIT_V(0);
    if constexpr (!ALIGN_EPI) { if (wr == 0) PG8_BAR; }
    PG8_BAR;
    if constexpr (Epi::AFTER_DRAIN) { E.fused(acc, cur, wr, wc, fr, fq, lds, wid, lane); S.done(cur); }
#undef PG8_SA
#undef PG8_SB
#undef PG8_STAGE
#undef PG8_LDA
#undef PG8_LDB
#undef PG8_MMA
#undef PG8_WAIT_V
#undef PG8_WAIT_L
#undef PG8_BAR
#undef PG8_SCHED
}
}
#define GAS __attribute__((address_space(1)))
#define LAS __attribute__((address_space(3)))
typedef unsigned short bf16;
typedef unsigned v4u __attribute__((ext_vector_type(4)));
typedef float f32x4 __attribute__((ext_vector_type(4)));
typedef short bf16x8 __attribute__((ext_vector_type(8)));
typedef GAS unsigned gu32;
typedef GAS unsigned long long gu64;
#define RLX_AGENT __ATOMIC_RELAXED, __HIP_MEMORY_SCOPE_AGENT
#define LDS_WAIT() asm volatile("s_waitcnt lgkmcnt(0)" ::: "memory")
#define VM_WAIT() asm volatile("s_waitcnt vmcnt(0)" ::: "memory")
__device__ __forceinline__ unsigned long long rt() { return __builtin_amdgcn_s_memrealtime(); }
typedef float f32x2_t __attribute__((ext_vector_type(2))); typedef __bf16 bf16x2_t __attribute__((ext_vector_type(2)));
__device__ __forceinline__ unsigned pk2(float lo, float hi) { const f32x2_t v = {lo, hi}; const bf16x2_t b = __builtin_convertvector(v, bf16x2_t); return __builtin_bit_cast(unsigned, b); }
__device__ __forceinline__ unsigned f2bf(float f) { return pk2(f, 0.f) & 0xffffu; }

#define XB_TMO      128
#define XB_XCNT(j)  (256  + 64 * (j))
#define XB_XSUB(j)  (1280 + 64 * (j))
#define XB_XGEN(j)  (2304 + 64 * (j))
#define XB_TOP      3328
#define XB_TOPGEN   3392
#define XCD_BAR_WORDS 3456
#define XB_SPIN_CAP (1u << 18)

__device__ __forceinline__ unsigned xb_ld(unsigned* p)              { return __hip_atomic_load(p, __ATOMIC_RELAXED, __HIP_MEMORY_SCOPE_AGENT); }
__device__ __forceinline__ unsigned xb_add(unsigned* p, unsigned v) { return __hip_atomic_fetch_add(p, v, __ATOMIC_RELAXED, __HIP_MEMORY_SCOPE_AGENT); }
__device__ __forceinline__ unsigned xb_xcc_id() { return (unsigned)__builtin_amdgcn_s_getreg((3 << 11) | 20) & 0xFu; }
#define XB_SPIN(cond, bar) do { unsigned _sp = 0; while (cond) { __builtin_amdgcn_s_sleep(1); \
    if ((++_sp & 255u) == 0u) { if (xb_ld(&(bar)[XB_TMO])) break; if (_sp > XB_SPIN_CAP) { atomicAdd(&(bar)[XB_TMO], 1u); break; } } } } while (0)

struct XcdBarrier {
    unsigned* bar; unsigned x;
    volatile LAS unsigned* st;
};

__device__ __forceinline__ XcdBarrier xcd_barrier_post(unsigned* bar, volatile LAS unsigned* st) {
    XcdBarrier b; b.bar = bar; b.x = xb_xcc_id(); b.st = st;
    if (threadIdx.x == 0) (void)xb_add(&bar[XB_XCNT(b.x)], 1u);
    return b;
}
__device__ __forceinline__ void xcd_barrier_complete(unsigned* bar, unsigned x, unsigned& nloc, unsigned& nx) {
    const unsigned G = gridDim.x * gridDim.y * gridDim.z;
    unsigned sum, cnt, mine, sp = 0u;
    for (;;) {
        sum = 0u; cnt = 0u; mine = 0u;
#pragma unroll
        for (unsigned j = 0; j < 16; ++j) { const unsigned c = xb_ld(&bar[XB_XCNT(j)]); sum += c; cnt += (c > 0u) ? 1u : 0u; mine = (j == x) ? c : mine; }
        if (sum == G) break;
        __builtin_amdgcn_s_sleep(1);
        if ((++sp & 255u) == 0u) { if (xb_ld(&bar[XB_TMO])) break; if (sp > XB_SPIN_CAP) { atomicAdd(&bar[XB_TMO], 1u); break; } }
    }
    nloc = mine > 0u ? mine : 1u; nx = cnt > 0u ? cnt : 1u;
}

__device__ __forceinline__ void xcd_barrier(const XcdBarrier& b) {
    asm volatile("s_waitcnt vmcnt(0)" ::: "memory");
    __syncthreads();
    if (threadIdx.x == 0) {
        unsigned* bar = b.bar;
        __builtin_amdgcn_s_waitcnt(0);
        unsigned nloc = b.st[0], nx = b.st[1];
        if (nloc == 0u) { xcd_barrier_complete(bar, b.x, nloc, nx); b.st[0] = nloc; b.st[1] = nx; }
        const unsigned old = xb_add(&bar[XB_XSUB(b.x)], 1u);
        const unsigned gen = old / nloc;
        if (old + 1u == (gen + 1u) * nloc) {
            __builtin_amdgcn_fence(__ATOMIC_RELEASE, "agent");
            asm volatile("s_waitcnt vmcnt(0)" ::: "memory");
            const unsigned og = xb_add(&bar[XB_TOP], 1u);
            const unsigned tg = og / nx;
            if (og + 1u == (tg + 1u) * nx) xb_add(&bar[XB_TOPGEN], 1u);
            else XB_SPIN(xb_ld(&bar[XB_TOPGEN]) == tg, bar);
            __builtin_amdgcn_fence(__ATOMIC_ACQUIRE, "agent");
            xb_add(&bar[XB_XGEN(b.x)], 1u);
            asm volatile("s_waitcnt vmcnt(0)" ::: "memory");
        } else {
            XB_SPIN(xb_ld(&bar[XB_XGEN(b.x)]) == gen, bar);
            __builtin_amdgcn_fence(__ATOMIC_ACQUIRE, "agent");
            asm volatile("s_waitcnt vmcnt(0)" ::: "memory");
        }
    }
    __syncthreads();
}
typedef unsigned v2u __attribute__((ext_vector_type(2)));
constexpr int NWAVES = 8, NTHR = 512;
constexpr int DM = 1024, TP = 16384, TS = 512, T = TP + TS;
constexpr int SEQ = 2048, NBP = 8, NBS = 128, LS = 4, MEMR = 2048;
constexpr int NPROJ = 11520;
constexpr int FFN = 2816;
constexpr float EPS = 1e-6f;
constexpr float QSCALE = 0.0625f * 1.4426950408889634f;

constexpr size_t MiB = 1u << 20;
constexpr size_t WS_CTL = 0, CTL_ZERO_BYTES = 32768;
constexpr size_t WS_SSQX = 1 * MiB, WS_SSQM = 1 * MiB + 512 * 1024;
constexpr size_t WS_DT = 2 * MiB, WS_SSQSSD = 5 * MiB, WS_SSQP1 = 8 * MiB, WS_SSQP2 = 9 * MiB + 512 * 1024, WS_SSQP3 = 11 * MiB;
constexpr size_t WS_WIN = 13 * MiB, WS_WKV = 36 * MiB, WS_WSSD = 40 * MiB, WS_WHG = 44 * MiB, WS_WOUT = 46 * MiB, WS_WCQ = 48 * MiB, WS_WCO = 50 * MiB, WS_WGU = 52 * MiB, WS_WDN = 63 * MiB;
constexpr size_t WS_XB = 69 * MiB, WS_MNB = 102 * MiB, WS_KB = 106 * MiB, WS_VT = 110 * MiB;
constexpr size_t SLOT = 33 * MiB, SLOT_ELEMS = (size_t)T * 1024;
constexpr size_t WS_PROJ = 114 * MiB;
constexpr size_t WS_YG = WS_PROJ + 11 * SLOT, WS_ON = WS_YG + 2 * SLOT, WS_END = WS_ON + SLOT;
static_assert(SLOT == SLOT_ELEMS * 2, "slot size");
static_assert(WS_WIN + (size_t)NPROJ * 1024 * 2 <= WS_WKV && WS_WGU + (size_t)2 * FFN * 1024 * 2 <= WS_WDN && WS_WDN + (size_t)1024 * FFN * 2 <= WS_XB && WS_SSQP3 + (size_t)T * 64 <= WS_WIN, "d_ws map");
static_assert(WS_DT + (size_t)T * 128 <= WS_SSQSSD && WS_SSQSSD + (size_t)T * 128 <= WS_SSQP1 && WS_SSQP1 + (size_t)T * 64 <= WS_SSQP2 && WS_SSQP2 + (size_t)T * 64 <= WS_SSQP3, "d_ws map 2");
enum { S_Z0 = 0, S_Z1 = 1, S_X0 = 2, S_X1 = 3, S_X2 = 4, S_Q = 5, S_F = 6, S_I = 7, S_HG = 8, S_GS = 9, S_GH = 10 };
constexpr size_t WS_MERGED = WS_PROJ + S_Q * SLOT, WS_HB = WS_PROJ + S_F * SLOT, WS_QB = WS_PROJ + S_I * SLOT, WS_OB = WS_PROJ + S_HG * SLOT, WS_ACT = WS_PROJ;
static_assert((size_t)T * FFN * 2 <= 3 * SLOT, "act overlay");
constexpr size_t O_Y = 0, O_SSMP = (size_t)T * 1024, O_CONVP = O_SSMP + 2097152, O_HGP = O_CONVP + 73728, O_MKP = O_HGP + 1048576, O_MVP = O_MKP + 2097152,
                 O_SSMS = O_MVP + 2097152, O_CONVS = O_SSMS + 33554432, O_HGS = O_CONVS + 1179648, O_END = O_HGS + 16777216;
constexpr int CW_QUEUE = 64;
constexpr int CW_BAR = 4096;
constexpr int RING_OFF = 0, RING_BYTES = 131072;
constexpr int LDS_BYTES = 147456;
constexpr int LDSCTL_OFF = LDS_BYTES - 1024, MISC_OFF = LDSCTL_OFF + 320;
struct Frame {
    LAS unsigned char* lds;
    volatile LAS unsigned* MISC;
    gu32* ctl;
    int tid, lane, wave;
    int vcu, G;
    const float* in[32];
    float* out; unsigned char* ws;
};
__device__ __forceinline__ float bf2f(unsigned v16) { return __uint_as_float(v16 << 16); }
__device__ __forceinline__ f32x4 ld_nt(const float* p) { return __builtin_nontemporal_load((const f32x4*)p); }
__device__ __forceinline__ void st_nt(float* p, f32x4 v) { __builtin_nontemporal_store(v, (f32x4*)p); }
__device__ __forceinline__ v4u ld_nt16(const void* p) { return __builtin_nontemporal_load((const v4u*)p); }
__device__ __forceinline__ unsigned ld_nt4(const void* p) { return __builtin_nontemporal_load((const unsigned*)p); }
__device__ __forceinline__ float sigmoid_f(float x) { return __builtin_amdgcn_rcpf(1.0f + __expf(-x)); }
__device__ __forceinline__ float silu_f(float x) { return x * sigmoid_f(x); }
__device__ __forceinline__ float wave_sum(float v) {
#pragma unroll
    for (int o = 1; o < 64; o <<= 1) v += __shfl_xor(v, o);
    return v;
}
__device__ __forceinline__ float wave_max(float v) {
#pragma unroll
    for (int o = 1; o < 64; o <<= 1) v = fmaxf(v, __shfl_xor(v, o));
    return v;
}
struct TSrc { const float* W; const float* W2; const float* ks; int ldw; int mode; };
__device__ __forceinline__ void p0_transpose_item(const TSrc& s, int K, int N, bf16* WT, LAS unsigned short* scr, int item, int lane) {
    const int nblk = N / 64, kb = item / nblk, nb = item % nblk, k0 = 64 * kb, n0 = 64 * nb;
    const int kr = lane >> 4, nq = lane & 15;
    const float* const Wa = s.W; const float* const Wb = s.W2;
    const float* src; int c0, cs; bool zero = false;
    if (s.mode == 2) { const float* wsel = Wa; if (nq >= 8) wsel = Wb; src = wsel + (n0 >> 1) + 4 * (nq & 7); c0 = 8 * (nq & 7) + (nq >> 3); cs = 2; }
    else { const int n = n0 + 4 * nq; c0 = 4 * nq; cs = 1;
        if (s.mode == 0) src = Wa + n;
        else if (s.mode == 1) { if (n < 5120) src = Wa + n; else if (n < 11264) src = Wa + n + 32; else if (n < 11296) src = Wa + 5120 + (n - 11264); else { src = Wa; zero = true; } }
        else { src = Wa + n; if (n >= 1024) src = Wb + (n - 1024); } }
    f32x4 v[16];
#pragma unroll
    for (int i = 0; i < 16; ++i) v[i] = zero ? (f32x4){0.f, 0.f, 0.f, 0.f} : ld_nt(src + (size_t)(k0 + 4 * i + kr) * s.ldw);
#pragma unroll
    for (int i = 0; i < 16; ++i) { const int kk = 4 * i + kr; const float sc = s.ks ? s.ks[k0 + kk] : 1.0f; const unsigned w0 = pk2(v[i].x * sc, v[i].y * sc), w1 = pk2(v[i].z * sc, v[i].w * sc);
        LAS unsigned short* d = scr + kk * 66 + c0;
        if (cs == 1) { *(LAS unsigned*)d = w0; *(LAS unsigned*)(d + 2) = w1; }
        else { d[0] = (unsigned short)(w0 & 0xffffu); d[2] = (unsigned short)(w0 >> 16); d[4] = (unsigned short)(w1 & 0xffffu); d[6] = (unsigned short)(w1 >> 16); } }
    LDS_WAIT(); asm volatile("" ::: "memory");
    const int nr = lane >> 3, kc = lane & 7;
#pragma unroll
    for (int j = 0; j < 8; ++j) { const int n = 8 * j + nr; const LAS unsigned short* p = scr + (8 * kc) * 66 + n;
        v4u o; o.x = (unsigned)p[0] | ((unsigned)p[66] << 16); o.y = (unsigned)p[2 * 66] | ((unsigned)p[3 * 66] << 16); o.z = (unsigned)p[4 * 66] | ((unsigned)p[5 * 66] << 16); o.w = (unsigned)p[6 * 66] | ((unsigned)p[7 * 66] << 16);
        *(v4u*)(WT + (size_t)(n0 + n) * K + k0 + 8 * kc) = o; }
    LDS_WAIT(); asm volatile("" ::: "memory");
}
__device__ __forceinline__ void rows4_to_bf16_ssq(const float* x0, bf16* o0, float* ssq0, int lane) {
    f32x4 v[4][4];
#pragma unroll
    for (int rr = 0; rr < 4; ++rr)
#pragma unroll
        for (int j = 0; j < 4; ++j) v[rr][j] = ld_nt(x0 + rr * 1024 + 4 * (64 * j + lane));
#pragma unroll
    for (int rr = 0; rr < 4; ++rr) { float sq = 0.f;
#pragma unroll
        for (int j = 0; j < 4; ++j) sq += (v[rr][j].x * v[rr][j].x + v[rr][j].y * v[rr][j].y) + (v[rr][j].z * v[rr][j].z + v[rr][j].w * v[rr][j].w);
        sq = wave_sum(sq);
        const float irs = sqrtf(sq * (1.0f / 1024.0f) + 1e-6f), rs = 1.0f / irs;
        unsigned long long* o8 = (unsigned long long*)(o0 + rr * 1024) + lane;
#pragma unroll
        for (int j = 0; j < 4; ++j) o8[64 * j] = (unsigned long long)pk2(v[rr][j].x * rs, v[rr][j].y * rs) | ((unsigned long long)pk2(v[rr][j].z * rs, v[rr][j].w * rs) << 32);
        if (lane == 0) ssq0[rr] = irs; }
}
__device__ __forceinline__ void p0_prologue(Frame& F) {
    LAS unsigned short* scr = (LAS unsigned short*)(F.lds + RING_OFF + F.wave * 16384);
    const int gw = F.vcu * NWAVES + F.wave, NGW = F.G * NWAVES;
    unsigned char* ws = F.ws;
    constexpr int I_IN = 16 * (NPROJ / 64), I_KV = 16 * 32, I_SSD = 32 * 16, I_SQ = 16 * 16, I_GU = 16 * (2 * FFN / 64), I_DN = (FFN / 64) * 16;
    constexpr int NITEMS = I_IN + I_KV + I_SSD + 4 * I_SQ + I_GU + I_DN;
    for (int it = gw; it < NITEMS; it += NGW) {
        int r = it;
        if (r < I_IN) { TSrc s{F.in[9], nullptr, F.in[8], 11296, 1}; p0_transpose_item(s, 1024, NPROJ, (bf16*)(ws + WS_WIN), scr, r, F.lane); continue; } r -= I_IN;
        if (r < I_KV) { TSrc s{F.in[24], F.in[25], F.in[22], 1024, 3}; p0_transpose_item(s, 1024, 2048, (bf16*)(ws + WS_WKV), scr, r, F.lane); continue; } r -= I_KV;
        if (r < I_SSD) { TSrc s{F.in[16], nullptr, F.in[15], 1024, 0}; p0_transpose_item(s, 2048, 1024, (bf16*)(ws + WS_WSSD), scr, r, F.lane); continue; } r -= I_SSD;
        if (r < I_SQ) { TSrc s{F.in[19], nullptr, F.in[18], 1024, 0}; p0_transpose_item(s, 1024, 1024, (bf16*)(ws + WS_WHG), scr, r, F.lane); continue; } r -= I_SQ;
        if (r < I_SQ) { TSrc s{F.in[20], nullptr, nullptr, 1024, 0}; p0_transpose_item(s, 1024, 1024, (bf16*)(ws + WS_WOUT), scr, r, F.lane); continue; } r -= I_SQ;
        if (r < I_SQ) { TSrc s{F.in[23], nullptr, F.in[21], 1024, 0}; p0_transpose_item(s, 1024, 1024, (bf16*)(ws + WS_WCQ), scr, r, F.lane); continue; } r -= I_SQ;
        if (r < I_SQ) { TSrc s{F.in[26], nullptr, nullptr, 1024, 0}; p0_transpose_item(s, 1024, 1024, (bf16*)(ws + WS_WCO), scr, r, F.lane); continue; } r -= I_SQ;
        if (r < I_GU) { TSrc s{F.in[28], F.in[29], F.in[27], FFN, 2}; p0_transpose_item(s, 1024, 2 * FFN, (bf16*)(ws + WS_WGU), scr, r, F.lane); continue; } r -= I_GU;
        { TSrc s{F.in[30], nullptr, nullptr, 1024, 0}; p0_transpose_item(s, FFN, 1024, (bf16*)(ws + WS_WDN), scr, r, F.lane); }
    }
    bf16* XB = (bf16*)(ws + WS_XB); float* SSQX = (float*)(ws + WS_SSQX);
    for (int m4 = gw; m4 < T / 4; m4 += NGW) { const int m = 4 * m4;
        rows4_to_bf16_ssq(m < TP ? F.in[0] + (size_t)m * DM : F.in[1] + (size_t)(m - TP) * DM, XB + (size_t)m * DM, SSQX + m, F.lane); }
    bf16* MNB = (bf16*)(ws + WS_MNB); float* SSQM = (float*)(ws + WS_SSQM);
    for (int m4 = gw; m4 < MEMR / 4; m4 += NGW) { const int m = 4 * m4; rows4_to_bf16_ssq(F.in[2] + (size_t)m * DM, MNB + (size_t)m * DM, SSQM + m, F.lane); }
}
__device__ __forceinline__ void conv_copy_unit(Frame& F, int gb) {
    const bf16* PROJ = (const bf16*)(F.ws + WS_PROJ);
    const bool prompt = gb < NBP; const int sb = gb - NBP;
    const size_t row0 = prompt ? (size_t)gb * SEQ + (SEQ - 3) : (size_t)TP + (size_t)sb * LS + 1;
    float* dst = prompt ? F.out + O_CONVP + (size_t)gb * 3 * 3072 : F.out + O_CONVS + (size_t)sb * 3 * 3072;
    for (int e = F.tid; e < 3 * 3072; e += NTHR) { const int j = e / 3072, col = e % 3072;
        dst[e] = bf2f(PROJ[(size_t)(S_X0 + (col >> 10)) * SLOT_ELEMS + (row0 + j) * 1024 + (col & 1023)]); }
}
__device__ __forceinline__ void ssdnorm_phase(Frame& F) {
    const int gw = F.vcu * NWAVES + F.wave, NGW = F.G * NWAVES; bf16* YG = (bf16*)(F.ws + WS_YG); const float* SSQ = (const float*)(F.ws + WS_SSQSSD);
    for (int row = TP + gw; row < T; row += NGW) {
        const f32x4* sp = (const f32x4*)(SSQ + (size_t)row * 32); v4u* p = (v4u*)(YG + (size_t)row * 2048) + F.lane; f32x4 sa[8]; v4u wv[4];
#pragma unroll
        for (int j = 0; j < 8; ++j) sa[j] = sp[j];
#pragma unroll
        for (int j = 0; j < 4; ++j) wv[j] = p[j * 64];
#pragma unroll
        for (int j = 0; j < 4; ++j) { const f32x4 a = sa[2 * j], b = sa[2 * j + 1]; const float s = ((a.x + a.y) + (a.z + a.w)) + ((b.x + b.y) + (b.z + b.w)); const float rs = 1.0f / sqrtf(s * (1.0f / 512.0f) + EPS); v4u o;
#pragma unroll
            for (int e = 0; e < 4; ++e) o[e] = pk2(bf2f(wv[j][e] & 0xffffu) * rs, bf2f(wv[j][e] >> 16) * rs);
            p[j * 64] = o; }
    }
}
typedef float f32x16 __attribute__((ext_vector_type(16)));
#define MFMA32(a, b, c) __builtin_amdgcn_mfma_f32_32x32x16_bf16((a), (b), (c), 0, 0, 0)
__device__ __forceinline__ unsigned cvtpk_c(float lo, float hi) { return pk2(lo, hi); }
__device__ __forceinline__ bf16x8 pack8(float a0, float a1, float a2, float a3, float a4, float a5, float a6, float a7) {
    v4u w; w.x = cvtpk_c(a0, a1); w.y = cvtpk_c(a2, a3); w.z = cvtpk_c(a4, a5); w.w = cvtpk_c(a6, a7); return __builtin_bit_cast(bf16x8, w); }
#define ACC_FRAG(x, s) pack8((x)[8 * (s)], (x)[8 * (s) + 1], (x)[8 * (s) + 2], (x)[8 * (s) + 3], (x)[8 * (s) + 4], (x)[8 * (s) + 5], (x)[8 * (s) + 6], (x)[8 * (s) + 7])
__device__ __forceinline__ bf16x8 lds_frag16(const LAS unsigned char* p) { return *(const LAS bf16x8*)p; }
__device__ __forceinline__ bf16x8 lds_frag8x2(const LAS unsigned char* p) { const v2u lo = *(const LAS v2u*)p, hi = *(const LAS v2u*)(p + 16);
    const v4u w = (v4u){lo.x, lo.y, hi.x, hi.y}; return __builtin_bit_cast(bf16x8, w); }
#define LDS_BARRIER() do { asm volatile("s_waitcnt lgkmcnt(0)" ::: "memory"); __builtin_amdgcn_s_barrier(); asm volatile("" ::: "memory"); } while (0)
typedef short s16x4 __attribute__((ext_vector_type(4)));
__device__ __forceinline__ bf16x8 lds_frag_tr(const LAS unsigned char* p, const LAS unsigned char* p4) {
    const s16x4 lo = __builtin_amdgcn_ds_read_tr16_b64_v4i16((LAS s16x4*)p), hi = __builtin_amdgcn_ds_read_tr16_b64_v4i16((LAS s16x4*)p4);
    return (bf16x8){lo.x, lo.y, lo.z, lo.w, hi.x, hi.y, hi.z, hi.w}; }
constexpr size_t WS_BCS = WS_END, WS_BTT = WS_BCS + (size_t)TP * 1024 * 2, WS_END2 = WS_BTT + (size_t)NBP * 32 * 4 * 128 * 64 * 2;
__device__ __forceinline__ void bc_prep_unit(Frame& F, int b, int c) {
    typedef float f32x2 __attribute__((ext_vector_type(2)));
    int tid_o = F.tid; asm volatile("" : "+v"(tid_o));
    const int tid = tid_o, cg = tid & 127, seg = tid >> 7; unsigned char* ws = F.ws;
    const bf16* src = (const bf16*)(ws + WS_PROJ) + (size_t)S_X2 * SLOT_ELEMS + (size_t)b * SEQ * 1024 + 8 * cg;
    bf16* BCS = (bf16*)(ws + WS_BCS);
    const float* cw = F.in[10] + 2048 + 8 * cg; const float* cbp = F.in[11] + 2048 + 8 * cg;
#pragma unroll 1
    for (int half = 0; half < 2; ++half) {
        const int s0 = 16 * seg + 8 * half;
        v4u raw[11];
#pragma unroll
        for (int i = 0; i < 11; ++i) { const int gt = 64 * c + s0 - 3 + i; raw[i] = (v4u){0u, 0u, 0u, 0u}; if (gt >= 0) raw[i] = ld_nt16(src + (size_t)gt * 1024); }
        v4u rowpk[8];
#pragma unroll
        for (int kp = 0; kp < 4; ++kp) {
            const f32x2 cw0 = *(const f32x2*)(cw + 2 * kp), cw1 = *(const f32x2*)(cw + 3072 + 2 * kp), cw2 = *(const f32x2*)(cw + 2 * 3072 + 2 * kp), cw3 = *(const f32x2*)(cw + 3 * 3072 + 2 * kp), cbb = *(const f32x2*)(cbp + 2 * kp);
            f32x2 xv[11];
#pragma unroll
            for (int i = 0; i < 11; ++i) { const unsigned wd = raw[i][kp]; xv[i] = (f32x2){__uint_as_float(wd << 16), __uint_as_float(wd & 0xffff0000u)}; }
            f32x2 o[8];
#pragma unroll
            for (int i = 0; i < 8; ++i) { f32x2 a = cw0 * xv[i] + cbb; a = cw1 * xv[i + 1] + a; a = cw2 * xv[i + 2] + a; a = cw3 * xv[i + 3] + a;
                const f32x2 t = a * (-1.4426950408889634f); f32x2 e; e.x = __builtin_amdgcn_exp2f(t.x); e.y = __builtin_amdgcn_exp2f(t.y); e = e + 1.0f;
                f32x2 rc; rc.x = __builtin_amdgcn_rcpf(e.x); rc.y = __builtin_amdgcn_rcpf(e.y); o[i] = a * rc; }
#pragma unroll
            for (int i = 0; i < 8; ++i) rowpk[i][kp] = pk2(o[i].x, o[i].y);
        }
        bf16* drow = BCS + ((size_t)b * SEQ + 64 * c + s0) * 1024 + 8 * cg;
#pragma unroll
        for (int i = 0; i < 8; ++i) *(v4u*)(drow + (size_t)i * 1024) = rowpk[i];
    }
}
__device__ __forceinline__ void bc_prep_phase(Frame& F) { for (int u = F.vcu; u < NBP * 32; u += F.G) bc_prep_unit(F, u >> 5, u & 31); }
constexpr size_t WS_HVT = WS_XB, WS_EGM = WS_END2, WS_EGL = WS_EGM + (size_t)NBP * 64 * 1024 * 4, WS_END3 = WS_EGL + (size_t)NBP * 64 * 1024 * 4;
__device__ __forceinline__ void hg_prep_unit(Frame& F, int b, int c) {
    typedef float f32x2 __attribute__((ext_vector_type(2)));
    int tid_o = F.tid; asm volatile("" : "+v"(tid_o));
    const int tid = tid_o; unsigned char* ws = F.ws;
    const int ch = 2 * tid;
    const size_t row0 = (size_t)b * SEQ + 32 * c;
    bf16* QS = (bf16*)(ws + WS_PROJ) + (size_t)S_Q * SLOT_ELEMS + row0 * 1024 + ch; bf16* FS = (bf16*)(ws + WS_PROJ) + (size_t)S_F * SLOT_ELEMS + row0 * 1024 + ch;
    const f32x2 l0 = *(const f32x2*)(F.in[17] + ch), l1 = *(const f32x2*)(F.in[17] + 1024 + ch);
    f32x2 lb; lb.x = __builtin_amdgcn_rcpf(1.0f + __expf(l1.x - l0.x)); lb.y = __builtin_amdgcn_rcpf(1.0f + __expf(l1.y - l0.y));
    const f32x2 omlb = 1.0f - lb;
    f32x2 P[32]; f32x2 run = (f32x2){1.0f, 1.0f};
#pragma unroll
    for (int t = 0; t < 32; ++t) { const unsigned wd = ld_nt4(FS + (size_t)t * 1024);
        f32x2 u = (f32x2){__uint_as_float(wd << 16), __uint_as_float(wd & 0xffff0000u)}; u.x = fminf(fmaxf(u.x, -30.f), 30.f); u.y = fminf(fmaxf(u.y, -30.f), 30.f);
        const f32x2 tt = u * (-1.4426950408889634f); f32x2 e; e.x = __builtin_amdgcn_exp2f(tt.x); e.y = __builtin_amdgcn_exp2f(tt.y); e = e + 1.0f;
        f32x2 sg; sg.x = __builtin_amdgcn_rcpf(e.x); sg.y = __builtin_amdgcn_rcpf(e.y);
        const f32x2 fg = lb + omlb * sg; run = run * fg; run.x = fmaxf(run.x, 1e-30f); run.y = fmaxf(run.y, 1e-30f); P[t] = run; }
    const f32x2 Pm = P[15], Pl = P[31]; f32x2 rPm; rPm.x = __builtin_amdgcn_rcpf(Pm.x); rPm.y = __builtin_amdgcn_rcpf(Pm.y);
    *(f32x2*)((float*)(ws + WS_EGM) + (size_t)(b * 64 + c) * 1024 + ch) = Pm; *(f32x2*)((float*)(ws + WS_EGL) + (size_t)(b * 64 + c) * 1024 + ch) = Pl * rPm;
    f32x2 rPprev = (f32x2){1.0f, 1.0f};
#pragma unroll
    for (int t = 0; t < 32; ++t) { f32x2 rP; rP.x = __builtin_amdgcn_rcpf(P[t].x); rP.y = __builtin_amdgcn_rcpf(P[t].y);
        const f32x2 e1 = P[t] * rPm, e2 = Pm * rP, fg = P[t] * rPprev, kk = 1.0f - fg; rPprev = rP;
        const unsigned qw = ld_nt4(QS + (size_t)t * 1024); const f32x2 q = (f32x2){__uint_as_float(qw << 16), __uint_as_float(qw & 0xffff0000u)};
        const f32x2 tq = q * (-1.4426950408889634f); f32x2 eq; eq.x = __builtin_amdgcn_exp2f(tq.x); eq.y = __builtin_amdgcn_exp2f(tq.y); eq = eq + 1.0f;
        f32x2 rq; rq.x = __builtin_amdgcn_rcpf(eq.x); rq.y = __builtin_amdgcn_rcpf(eq.y);
        const f32x2 qa = q * rq * e1, ka = kk * e2;
        *(unsigned*)(QS + (size_t)t * 1024) = pk2(qa.x, qa.y); *(unsigned*)(FS + (size_t)t * 1024) = pk2(ka.x, ka.y); }
}
__device__ __forceinline__ void hg_prep_phase(Frame& F) { for (int u = F.vcu; u < NBP * 64; u += F.G) hg_prep_unit(F, u >> 6, u & 63); }
constexpr int HV_QA = 0, HV_KA = 8704, HV_KAT = 17408, HV_VT = 27648, HV_EGM = 30208, HV_EGL = 30720, HV_PBUF = 31232, HV_OB = 2 * HV_PBUF, HV_OBUF = 23040;
constexpr size_t WS_SSQH = WS_END3, WS_END4 = WS_SSQH + (size_t)T * 32 * 4;
__device__ __forceinline__ void hgrn_v_unit(Frame& F, int b, int hd, int vt) {
    int tid_o = F.tid; asm volatile("" : "+v"(tid_o));
    const int tid = tid_o, lane = tid & 63, w = F.wave, r = lane & 31, hh = lane >> 5; unsigned char* ws = F.ws;
    LAS unsigned char* Lb = F.lds + RING_OFF;
    const bf16* PROJ = (const bf16*)(ws + WS_PROJ); bf16* OU = (bf16*)(ws + WS_ON); float* SSQH = (float*)(ws + WS_SSQH);
    const size_t rowb = (size_t)b * SEQ;
    const int pt_t = tid & 31, pt_g = tid >> 5;
    const bf16* qsrc = PROJ + (size_t)S_Q * SLOT_ELEMS + (rowb + pt_t) * 1024 + hd * 128 + 8 * pt_g;
    const bf16* ksrc = PROJ + (size_t)S_F * SLOT_ELEMS + (rowb + pt_t) * 1024 + hd * 128 + 8 * pt_g;
    const unsigned char* xsrc = nullptr; size_t xstr = 0;
    if (tid < 128) { xsrc = (const unsigned char*)(PROJ + (size_t)S_I * SLOT_ELEMS + (rowb + pt_t) * 1024 + hd * 128 + 32 * vt + 8 * pt_g); xstr = (size_t)32 * 1024 * 2; }
    else if (tid < 160) { xsrc = (const unsigned char*)((const float*)(ws + WS_EGM) + (size_t)b * 64 * 1024 + hd * 128 + 4 * (tid - 128)); xstr = 4096; }
    else if (tid < 192) { xsrc = (const unsigned char*)((const float*)(ws + WS_EGL) + (size_t)b * 64 * 1024 + hd * 128 + 4 * (tid - 160)); xstr = 4096; }
    const int o_img = pt_t * 272 + 16 * pt_g, o_ka = pt_t * 256 + 16 * (pt_g ^ (((pt_t & 3) << 2) | ((pt_t >> 2) & 3))), o_v = pt_t * 64 + 16 * pt_g;
#define HGV_LOAD(cc, pq, pk, px) { pq = *(const v4u*)(qsrc + (size_t)(cc) * 32 * 1024); pk = *(const v4u*)(ksrc + (size_t)(cc) * 32 * 1024); if (tid < 192) px = *(const v4u*)(xsrc + (size_t)(cc) * xstr); }
#define HGV_STORE(pb, pq, pk, px) { *(LAS v4u*)((pb) + HV_QA + o_img) = pq; *(LAS v4u*)((pb) + HV_KA + o_ka) = pk; \
        if (tid < 128) { *(LAS v4u*)((pb) + HV_VT + o_v) = px; } else if (tid < 160) { *(LAS v4u*)((pb) + HV_EGM + 16 * (tid - 128)) = px; } else if (tid < 192) { *(LAS v4u*)((pb) + HV_EGL + 16 * (tid - 160)) = px; } }
    v4u pqA, pkA, pxA = (v4u){0u, 0u, 0u, 0u}, pqB, pkB, pxB = (v4u){0u, 0u, 0u, 0u};
    HGV_LOAD(0, pqA, pkA, pxA) HGV_STORE(Lb, pqA, pkA, pxA)
    HGV_LOAD(1, pqA, pkA, pxA) HGV_LOAD(2, pqB, pkB, pxB)
    const int kt = w;
    v4u ow_pend = (v4u){0u, 0u, 0u, 0u}; float sq_pend = 0.f;
    f32x16 S;
#pragma unroll
    for (int i = 0; i < 16; ++i) S[i] = 0.f;
    __syncthreads();
#define HGV_ITER(c, pq, pk, px) { \
        int r_l = r, hh_l = hh, tid_l = tid; asm volatile("" : "+v"(r_l), "+v"(hh_l), "+v"(tid_l)); \
        { const int r = r_l, hh = hh_l, tid = tid_l; \
        LAS unsigned char* pbc = Lb + ((c) & 1) * HV_PBUF; LAS unsigned char* pbn = Lb + (((c) + 1) & 1) * HV_PBUF; \
        if (w < 4) { \
            LAS float* EGM = (LAS float*)(pbc + HV_EGM); LAS float* EGL = (LAS float*)(pbc + HV_EGL); LAS float* OB = (LAS float*)(Lb + HV_OB + ((c) & 1) * HV_OBUF); \
            _Pragma("unroll") \
            for (int q4 = 0; q4 < 4; ++q4) { const f32x4 e0 = *(const LAS f32x4*)(EGM + 32 * kt + 8 * q4 + 4 * hh); \
                _Pragma("unroll") \
                for (int j = 0; j < 4; ++j) S[4 * q4 + j] *= e0[j]; } \
            f32x16 o; \
            _Pragma("unroll") \
            for (int i = 0; i < 16; ++i) o[i] = 0.f; \
            const LAS unsigned char* qa_row = pbc + HV_QA + r * 272; \
            o = MFMA32(ACC_FRAG(S, 0), lds_frag8x2(qa_row + (32 * kt + 4 * hh) * 2), o);        \
            o = MFMA32(ACC_FRAG(S, 1), lds_frag8x2(qa_row + (32 * kt + 16 + 4 * hh) * 2), o); \
            LAS float* ob = OB + (kt * 32 + r) * 36 + 4 * hh; \
            _Pragma("unroll") \
            for (int q4 = 0; q4 < 4; ++q4) *(LAS f32x4*)(ob + 8 * q4) = (f32x4){o[4 * q4], o[4 * q4 + 1], o[4 * q4 + 2], o[4 * q4 + 3]}; \
              \
            const int q_ = ((tid & 63) >> 2) & 3, chk_ = 4 * kt + 2 * (((tid & 63) >> 4) & 1) + (((tid & 63) >> 1) & 1); \
            const LAS unsigned char* ka_lo = pbc + HV_KA + (8 * hh + q_) * 256 + 16 * (chk_ ^ ((q_ << 2) | ((2 * hh) & 3))) + 8 * ((tid & 63) & 1); \
            const LAS unsigned char* ka_hi = pbc + HV_KA + (8 * hh + 4 + q_) * 256 + 16 * (chk_ ^ ((q_ << 2) | ((2 * hh + 1) & 3))) + 8 * ((tid & 63) & 1); \
            const LAS unsigned char* v_lo = pbc + HV_VT + (8 * hh + q_) * 64 + (16 * (((tid & 63) >> 4) & 1) + 4 * ((tid & 63) & 3)) * 2; \
            S = MFMA32(lds_frag_tr(ka_lo, ka_hi), lds_frag_tr(v_lo, v_lo + 4 * 64), S); S = MFMA32(lds_frag_tr(ka_lo + 4096, ka_hi + 4096), lds_frag_tr(v_lo + 16 * 64, v_lo + 20 * 64), S); \
            _Pragma("unroll") \
            for (int q4 = 0; q4 < 4; ++q4) { const f32x4 e0 = *(const LAS f32x4*)(EGL + 32 * kt + 8 * q4 + 4 * hh); \
                _Pragma("unroll") \
                for (int j = 0; j < 4; ++j) S[4 * q4 + j] *= e0[j]; } \
        } else { \
            if (w == 4 || w == 7) {        \
                LAS float* OB = (LAS float*)(Lb + HV_OB + ((c) & 1) * HV_OBUF); const int tb = (w == 7) ? 1 : 0, l_ = tid & 63, fr = l_ & 15, fq = l_ >> 4; \
                const LAS unsigned char* qa_b = pbc + HV_QA + (16 * tb + fr) * 272 + 16 * fq;                        \
                const LAS unsigned char* ka0 = pbc + HV_KA + 256 * fr; const int sw0 = ((fr & 3) << 2) | ((fr >> 2) & 3);                         \
                const LAS unsigned char* ka1 = pbc + HV_KA + 256 * (16 + fr); const int sw1 = ((fr & 3) << 2) | (((16 + fr) >> 2) & 3); \
                f32x4 X0a = (f32x4){0.f, 0.f, 0.f, 0.f}, X0b = X0a, X1a = X0a, X1b = X0a; \
                const bf16x8 q0 = lds_frag16(qa_b), q1 = lds_frag16(qa_b + 64), q2 = lds_frag16(qa_b + 128), q3 = lds_frag16(qa_b + 192); \
                const LAS unsigned char* v_tr = pbc + HV_VT + (4 * fq + ((l_ >> 2) & 3)) * 64 + (4 * (l_ & 3)) * 2;        \
                const bf16x8 vf0 = lds_frag_tr(v_tr, v_tr + 16 * 64), vf1 = lds_frag_tr(v_tr + 32, v_tr + 32 + 16 * 64); \
                X0a = __builtin_amdgcn_mfma_f32_16x16x32_bf16(lds_frag16(ka0 + 16 * ((0 + fq) ^ sw0)), q0, X0a, 0, 0, 0); X0b = __builtin_amdgcn_mfma_f32_16x16x32_bf16(lds_frag16(ka0 + 16 * ((4 + fq) ^ sw0)), q1, X0b, 0, 0, 0); \
                X0a = __builtin_amdgcn_mfma_f32_16x16x32_bf16(lds_frag16(ka0 + 16 * ((8 + fq) ^ sw0)), q2, X0a, 0, 0, 0); X0b = __builtin_amdgcn_mfma_f32_16x16x32_bf16(lds_frag16(ka0 + 16 * ((12 + fq) ^ sw0)), q3, X0b, 0, 0, 0); \
                if (tb) {                                                         \
                    X1a = __builtin_amdgcn_mfma_f32_16x16x32_bf16(lds_frag16(ka1 + 16 * ((0 + fq) ^ sw1)), q0, X1a, 0, 0, 0); X1b = __builtin_amdgcn_mfma_f32_16x16x32_bf16(lds_frag16(ka1 + 16 * ((4 + fq) ^ sw1)), q1, X1b, 0, 0, 0); \
                    X1a = __builtin_amdgcn_mfma_f32_16x16x32_bf16(lds_frag16(ka1 + 16 * ((8 + fq) ^ sw1)), q2, X1a, 0, 0, 0); X1b = __builtin_amdgcn_mfma_f32_16x16x32_bf16(lds_frag16(ka1 + 16 * ((12 + fq) ^ sw1)), q3, X1b, 0, 0, 0); } \
                f32x4 X0 = X0a + X0b, X1 = X1a + X1b;                              \
                _Pragma("unroll") \
                for (int e = 0; e < 4; ++e) { const bool keep = (4 * fq + e) <= fr; if (tb) X1[e] = keep ? X1[e] : 0.f; else X0[e] = keep ? X0[e] : 0.f; }        \
                const bf16x8 xb = pack8(X0[0], X0[1], X0[2], X0[3], X1[0], X1[1], X1[2], X1[3]);        \
                _Pragma("unroll") \
                for (int vb = 0; vb < 2; ++vb) { const f32x4 o = __builtin_amdgcn_mfma_f32_16x16x32_bf16(vb ? vf1 : vf0, xb, (f32x4){0.f, 0.f, 0.f, 0.f}, 0, 0, 0); \
                    *(LAS f32x4*)(OB + (4 * 32 + 16 * tb + fr) * 36 + 16 * vb + 4 * fq) = o; }        \
            } \
            if (w == 5 || w == 6) { if ((c) > 1) { HGV_FLUSH((c) - 2) } if ((c) > 0) { HGV_OUT((c) - 1) } }        \
        } \
        if ((c) < 63) { HGV_STORE(pbn, pq, pk, px) if ((c) < 61) HGV_LOAD((c) + 3, pq, pk, px) }        \
        LDS_BARRIER(); \
        } }
#define HGV_OUT(cp) { const LAS float* OB = (const LAS float*)(Lb + HV_OB + ((cp) & 1) * HV_OBUF); const int tl = tid - 320, t = tl >> 2, v0 = (tl & 3) * 8; f32x4 oa = (f32x4){0.f, 0.f, 0.f, 0.f}, ob_ = oa; \
            _Pragma("unroll") \
            for (int sl = 0; sl < 5; ++sl) { oa = oa + *(const LAS f32x4*)(OB + (32 * sl + t) * 36 + v0); ob_ = ob_ + *(const LAS f32x4*)(OB + (32 * sl + t) * 36 + v0 + 4); } \
            float sq = ((oa.x * oa.x + oa.y * oa.y) + (oa.z * oa.z + oa.w * oa.w)) + ((ob_.x * ob_.x + ob_.y * ob_.y) + (ob_.z * ob_.z + ob_.w * ob_.w)); \
            sq += __int_as_float(__builtin_amdgcn_update_dpp(0, __float_as_int(sq), 0x102, 0xf, 0xf, true)); sq += __int_as_float(__builtin_amdgcn_update_dpp(0, __float_as_int(sq), 0x101, 0xf, 0xf, true));   \
            sq_pend = sq; ow_pend.x = pk2(oa.x, oa.y); ow_pend.y = pk2(oa.z, oa.w); ow_pend.z = pk2(ob_.x, ob_.y); ow_pend.w = pk2(ob_.z, ob_.w); }
#define HGV_FLUSH(cp) { const int tl = tid - 320, t = tl >> 2, v0 = (tl & 3) * 8; const size_t row = rowb + 32 * (cp) + t; \
            if ((tl & 3) == 0) SSQH[row * 32 + hd * 4 + vt] = sq_pend; *(v4u*)(OU + row * 1024 + hd * 128 + 32 * vt + v0) = ow_pend; }
#pragma unroll 1
    for (int cc = 0; cc < 64; cc += 2) { HGV_ITER(cc, pqA, pkA, pxA) HGV_ITER(cc + 1, pqB, pkB, pxB) }
    if (w == 5 || w == 6) { HGV_FLUSH(62) HGV_OUT(63) HGV_FLUSH(63) }
#undef HGV_ITER
#undef HGV_OUT
#undef HGV_FLUSH
#undef HGV_LOAD
#undef HGV_STORE
    if (w < 4) { float* st_g = F.out + O_HGP + (size_t)(b * 8 + hd) * 16384 + 32 * vt + r;
#pragma unroll
        for (int i = 0; i < 16; ++i) { const int k = 32 * kt + (i & 3) + 8 * (i >> 2) + 4 * hh; st_g[(size_t)k * 128] = S[i]; } }
    __syncthreads();
}
__device__ __forceinline__ void hgnorm_phase(Frame& F) {
    const int gw = F.vcu * NWAVES + F.wave, NGW = F.G * NWAVES; bf16* ON = (bf16*)(F.ws + WS_ON); const float* SSQH = (const float*)(F.ws + WS_SSQH);
    const bf16* HG = (const bf16*)(F.ws + WS_PROJ) + (size_t)S_HG * SLOT_ELEMS;
    for (int row = gw; row < TP; row += 4 * NGW) {
        f32x4 sp[8]; v4u ov[8], gv[8];
#pragma unroll
        for (int k = 0; k < 8; ++k) { const int rq = row + (k >> 1) * NGW, rw = rq < TP ? rq : row, pc = (k & 1) * 64 + F.lane, hd = pc >> 4;
            sp[k] = *(const f32x4*)(SSQH + (size_t)rw * 32 + hd * 4); ov[k] = *((const v4u*)(ON + (size_t)rw * 1024) + pc); gv[k] = ld_nt16((const v4u*)(HG + (size_t)rw * 1024) + pc); }
#pragma unroll
        for (int k = 0; k < 8; ++k) { const int rq = row + (k >> 1) * NGW, pc = (k & 1) * 64 + F.lane; if (rq < TP) {
            const float rs = __builtin_amdgcn_rsqf(((sp[k].x + sp[k].y) + (sp[k].z + sp[k].w)) * (1.0f / 128.0f) + EPS); v4u res;
#pragma unroll
            for (int e = 0; e < 4; ++e) res[e] = pk2(bf2f(ov[k][e] & 0xffffu) * rs * silu_f(bf2f(gv[k][e] & 0xffffu)), __uint_as_float(ov[k][e] & 0xffff0000u) * rs * silu_f(__uint_as_float(gv[k][e] & 0xffff0000u)));
            *((v4u*)(ON + (size_t)rq * 1024) + pc) = res; } }
    }
}
constexpr int SD_BN = 0, SD_CN = 17408, SD_BT = 34816, SD_XT = 53248, SD_HT = 62464, SD_YA = 97280, SD_YY = 113664, SD_YO = 130048, SD_CUM = 134144, SD_DTV = 134400, SD_ECUM = 134656, SD_XWT = 134912, SD_CWL = 144128;
__device__ __forceinline__ void ssd_unit_mfma(Frame& F, int gb, int h) {
    int tid_o = F.tid; asm volatile("" : "+v"(tid_o));
    const int tid = tid_o, lane = tid & 63, w = F.wave, r = lane & 31, hh = lane >> 5; unsigned char* ws = F.ws;
    const int L = SEQ; const size_t row_base = (size_t)gb * SEQ;
    const int g = h >> 3;
    LAS unsigned char* Lb = F.lds + RING_OFF;
    LAS unsigned short* BN = (LAS unsigned short*)(Lb + SD_BN); LAS unsigned short* CN = (LAS unsigned short*)(Lb + SD_CN);
    LAS unsigned short* BT = (LAS unsigned short*)(Lb + SD_BT); LAS unsigned short* XT = (LAS unsigned short*)(Lb + SD_XT);
    LAS unsigned short* HT = (LAS unsigned short*)(Lb + SD_HT);
    LAS unsigned short* XWT = (LAS unsigned short*)(Lb + SD_XWT);
    LAS float* YA = (LAS float*)(Lb + SD_YA); LAS float* YY = (LAS float*)(Lb + SD_YY); LAS unsigned short* YO = (LAS unsigned short*)(Lb + SD_YO);
    LAS float* CUM = (LAS float*)(Lb + SD_CUM); LAS float* DTV = (LAS float*)(Lb + SD_DTV); LAS float* ECUM = (LAS float*)(Lb + SD_ECUM);
    const bf16* PROJ = (const bf16*)(ws + WS_PROJ); const float* DTR = (const float*)(ws + WS_DT); bf16* YG = (bf16*)(ws + WS_YG); float* SSQ = (float*)(ws + WS_SSQSSD);
    f32x16 H0, H1, H2, H3;
#pragma unroll
    for (int i = 0; i < 16; ++i) { H0[i] = 0.f; H1[i] = 0.f; H2[i] = 0.f; H3[i] = 0.f; }
    float* const st_base = F.out + O_SSMP + (size_t)(gb * 32 + h) * 8192 + (size_t)r * 128 + 4 * hh;
#define SSD_PUBLISH(HX, TILE, BUF) { LAS unsigned short* hp_ = HT + (BUF) * 8704 + (32 * ((TILE) & 1) + r) * 136 + 32 * ((TILE) >> 1) + 4 * hh; \
        _Pragma("unroll") for (int q4 = 0; q4 < 4; ++q4) { v2u pk; pk.x = cvtpk_c(HX[4 * q4], HX[4 * q4 + 1]); pk.y = cvtpk_c(HX[4 * q4 + 2], HX[4 * q4 + 3]); *(LAS v2u*)(hp_ + 8 * q4) = pk; } }
    if (w == 3) { SSD_PUBLISH(H0, 0, 0) SSD_PUBLISH(H1, 1, 0) SSD_PUBLISH(H2, 2, 0) SSD_PUBLISH(H3, 3, 0) } else if (w >= 4) { SSD_PUBLISH(H0, w, 0) }
    const float a = -__expf(F.in[13][h]), dtb = F.in[12][h], Dk = F.in[14][h];
    const float* cw = F.in[10]; const float* cbp = F.in[11];
    typedef float f32x2 __attribute__((ext_vector_type(2)));
    const int col = h * 64 + 2 * (tid & 31);
    const bf16* cptr = PROJ + (size_t)(S_X0 + (col >> 10)) * SLOT_ELEMS + row_base * 1024 + (col & 1023);
    const f32x2 cw0 = *(const f32x2*)(cw + col), cw1 = *(const f32x2*)(cw + 3072 + col), cw2 = *(const f32x2*)(cw + 2 * 3072 + col), cw3 = *(const f32x2*)(cw + 3 * 3072 + col), cbb = *(const f32x2*)(cbp + col);
    const bf16* BCS = (const bf16*)(ws + WS_BCS) + row_base * 1024 + g * 128;
    unsigned xr[7]; v4u pc[4];
#pragma unroll
    for (int i = 0; i < 7; ++i) { const int gt = 4 * (tid >> 5) - 3 + i; xr[i] = 0u; if (gt >= 0) xr[i] = *(const unsigned*)(cptr + (size_t)gt * 1024); }
#pragma unroll
    for (int j = 0; j < 4; ++j) { const int idx = (tid + 512 * j) & 1023; pc[j] = *(const v4u*)(BCS + (size_t)(idx >> 4) * 1024 + (j >> 1) * 512 + 8 * (idx & 15)); }
    __syncthreads();
    v4u ow_pend = (v4u){0u, 0u, 0u, 0u}; float sq_pend = 0.f; bool pend = false;
    int buf = 0;
    float dt_pf = 0.f;
    if (lane < L) dt_pf = DTR[(row_base + lane) * 32 + h];
    v4u zw_pf = ld_nt16(PROJ + (size_t)(S_Z0 + (h >> 4)) * SLOT_ELEMS + (row_base + (tid >> 3)) * 1024 + (h & 15) * 64 + (tid & 7) * 8);
    for (int t0 = 0; t0 < L; t0 += 64, buf ^= 1) {
        int r_l = r, hh_l = hh, tid_l = tid, lane_l = lane;
        asm volatile("" : "+v"(r_l), "+v"(hh_l), "+v"(tid_l), "+v"(lane_l));
        { const int r = r_l, hh = hh_l, tid = tid_l, lane = lane_l;
        float dtv = 0.f;
        if (t0 + lane < L) { const float x = dt_pf + dtb; dtv = fmaxf(x, 0.f) + 0.6931471805599453f * __builtin_amdgcn_logf(1.0f + __builtin_amdgcn_exp2f(-1.4426950408889634f * fabsf(x))); }
        dt_pf = 0.f; if (t0 + 64 + lane < L) dt_pf = DTR[(row_base + t0 + 64 + lane) * 32 + h];
        const v4u zw = zw_pf; zw_pf = (v4u){0u, 0u, 0u, 0u};
        if (t0 + 64 + (tid >> 3) < L) zw_pf = ld_nt16(PROJ + (size_t)(S_Z0 + (h >> 4)) * SLOT_ELEMS + (row_base + t0 + 64 + (tid >> 3)) * 1024 + (h & 15) * 64 + (tid & 7) * 8);
        float cum = dtv * a;
#define SSD_DPP_ADD(ctrl, rmask) cum += __int_as_float(__builtin_amdgcn_update_dpp(0, __float_as_int(cum), ctrl, rmask, 0xf, true))
        SSD_DPP_ADD(0x111, 0xf); SSD_DPP_ADD(0x112, 0xf); SSD_DPP_ADD(0x114, 0xf); SSD_DPP_ADD(0x118, 0xf);
        SSD_DPP_ADD(0x142, 0xa); SSD_DPP_ADD(0x143, 0xc);
#undef SSD_DPP_ADD
        const float cum_last = __int_as_float(__builtin_amdgcn_readlane(__float_as_int(cum), 63));
        const float wgt = __expf(cum_last - cum) * dtv;
        if (w == 0) { CUM[lane] = cum; DTV[lane] = dtv; ECUM[lane] = __expf(cum); }
#pragma unroll
        for (int j = 0; j < 4; ++j) { const int idx = (tid + 512 * j) & 1023;
            if (j < 2) { const int row = idx >> 4; *(LAS v4u*)((LAS unsigned char*)BN + 256 * row + 16 * ((idx & 15) ^ (((row & 3) << 2) | ((row >> 2) & 3)))) = pc[j]; }
            else *(LAS v4u*)(CN + (idx >> 4) * 136 + 8 * (idx & 15)) = pc[j]; }
        if (pend) { const size_t prow = row_base + (t0 - 64) + (tid >> 3);
            *(v4u*)(YG + prow * 2048 + h * 64 + (tid & 7) * 8) = ow_pend; if ((tid & 7) == 0) SSQ[prow * 32 + h] = sq_pend; pend = false; }
        { const int cp = tid & 31, sq = tid >> 5; const int wu = __builtin_amdgcn_readfirstlane(w);
          f32x2 xv[7];
#pragma unroll
          for (int i = 0; i < 7; ++i) xv[i] = (f32x2){__uint_as_float(xr[i] << 16), __uint_as_float(xr[i] & 0xffff0000u)};
          unsigned po[4], pw[4];
          f32x2 o[4], ow[4];
#pragma unroll
          for (int k = 0; k < 4; ++k) {
              const float w_lo = __int_as_float(__builtin_amdgcn_readlane(__float_as_int(wgt), 8 * wu + k)), w_hi = __int_as_float(__builtin_amdgcn_readlane(__float_as_int(wgt), 8 * wu + 4 + k));
              const float wx = hh ? w_hi : w_lo;
              f32x2 a = cw0 * xv[k] + cbb; a = cw1 * xv[k + 1] + a; a = cw2 * xv[k + 2] + a; a = cw3 * xv[k + 3] + a;
              const f32x2 t = a * (-1.4426950408889634f); f32x2 e; e.x = __builtin_amdgcn_exp2f(t.x); e.y = __builtin_amdgcn_exp2f(t.y); e = e + 1.0f;
              f32x2 rc; rc.x = __builtin_amdgcn_rcpf(e.x); rc.y = __builtin_amdgcn_rcpf(e.y); o[k] = a * rc; ow[k] = o[k] * wx; }
          po[0] = pk2(o[0].x, o[1].x); po[1] = pk2(o[2].x, o[3].x); po[2] = pk2(o[0].y, o[1].y); po[3] = pk2(o[2].y, o[3].y);
          pw[0] = pk2(ow[0].x, ow[1].x); pw[1] = pk2(ow[2].x, ow[3].x); pw[2] = pk2(ow[0].y, ow[1].y); pw[3] = pk2(ow[2].y, ow[3].y);
          *(LAS v2u*)(XT + (2 * cp) * 72 + 4 * sq) = (v2u){po[0], po[1]}; *(LAS v2u*)(XT + (2 * cp + 1) * 72 + 4 * sq) = (v2u){po[2], po[3]};
          *(LAS v2u*)(XWT + (2 * cp) * 72 + 4 * sq) = (v2u){pw[0], pw[1]}; *(LAS v2u*)(XWT + (2 * cp + 1) * 72 + 4 * sq) = (v2u){pw[2], pw[3]};
        }
        if (t0 + 64 < L) {
#pragma unroll
            for (int i = 0; i < 7; ++i) xr[i] = *(const unsigned*)(cptr + (size_t)(t0 + 64 + 4 * (tid >> 5) - 3 + i) * 1024);
#pragma unroll
            for (int j = 0; j < 4; ++j) { const int idx = (tid + 512 * j) & 1023; pc[j] = *(const v4u*)(BCS + (size_t)(t0 + 64 + (idx >> 4)) * 1024 + (j >> 1) * 512 + 8 * (idx & 15)); }
        }
        LDS_BARRIER(); LDS_BARRIER();
        if (w < 3) {
            const int tt = w == 0 ? 0 : 1, st = w == 1 ? 1 : 0;
            f32x16 X, ya0, ya1;
#pragma unroll
            for (int i = 0; i < 16; ++i) { X[i] = 0.f; ya0[i] = 0.f; ya1[i] = 0.f; }
            const LAS unsigned char* cn_nat = Lb + SD_CN + (32 * tt + r) * 272 + hh * 16; const int bn_sw = ((r & 3) << 2) | ((r >> 2) & 3); const LAS unsigned char* bn_row = Lb + SD_BN + (32 * st + r) * 256;
            { f32x16 Xb;
#pragma unroll
              for (int i = 0; i < 16; ++i) Xb[i] = 0.f;
#pragma unroll
              for (int ks = 0; ks < 8; ks += 2) { X = MFMA32(lds_frag16(bn_row + 16 * ((2 * ks + hh) ^ bn_sw)), lds_frag16(cn_nat + ks * 32), X); Xb = MFMA32(lds_frag16(bn_row + 16 * ((2 * ks + 2 + hh) ^ bn_sw)), lds_frag16(cn_nat + ks * 32 + 32), Xb); }
              X = X + Xb; }
            const float cum_t = CUM[32 * tt + r];
#pragma unroll
            for (int q4 = 0; q4 < 4; ++q4) { const f32x4 cs = *(const LAS f32x4*)(CUM + 32 * st + 8 * q4 + 4 * hh), ds = *(const LAS f32x4*)(DTV + 32 * st + 8 * q4 + 4 * hh);
#pragma unroll
                for (int jj = 0; jj < 4; ++jj) { const int s_abs = 32 * st + 8 * q4 + 4 * hh + jj; const float f = __expf(cum_t - cs[jj]) * ds[jj]; X[4 * q4 + jj] = (s_abs <= 32 * tt + r) ? X[4 * q4 + jj] * f : 0.f;        } }
            const bf16x8 xf0 = ACC_FRAG(X, 0), xf1 = ACC_FRAG(X, 1);
            const LAS unsigned char* xt_row = Lb + SD_XT + r * 144 + (32 * st + 4 * hh) * 2;
            ya0 = MFMA32(lds_frag8x2(xt_row), xf0, ya0); ya0 = MFMA32(lds_frag8x2(xt_row + 32), xf1, ya0);
            ya1 = MFMA32(lds_frag8x2(xt_row + 32 * 144), xf0, ya1); ya1 = MFMA32(lds_frag8x2(xt_row + 32 * 144 + 32), xf1, ya1);
            if (w < 2) { LAS float* yb = YA + (32 * tt + r) * 64;
#pragma unroll
                for (int q4 = 0; q4 < 4; ++q4) { const int ch = 2 * q4 + hh;
                    *(LAS f32x4*)(yb + 4 * (ch ^ (r & 15))) = (f32x4){ya0[4 * q4], ya0[4 * q4 + 1], ya0[4 * q4 + 2], ya0[4 * q4 + 3]};
                    *(LAS f32x4*)(yb + 4 * ((ch + 8) ^ (r & 15))) = (f32x4){ya1[4 * q4], ya1[4 * q4 + 1], ya1[4 * q4 + 2], ya1[4 * q4 + 3]}; } }
            else { LAS unsigned char* yb = (LAS unsigned char*)YO + r * 128;
#pragma unroll
                for (int q4 = 0; q4 < 4; ++q4) { const int ch = 2 * q4 + hh; v2u p0, p1;
                    p0.x = cvtpk_c(ya0[4 * q4], ya0[4 * q4 + 1]); p0.y = cvtpk_c(ya0[4 * q4 + 2], ya0[4 * q4 + 3]); p1.x = cvtpk_c(ya1[4 * q4], ya1[4 * q4 + 1]); p1.y = cvtpk_c(ya1[4 * q4 + 2], ya1[4 * q4 + 3]);
                    *(LAS v2u*)(yb + 8 * (ch ^ ((r & 7) << 1))) = p0; *(LAS v2u*)(yb + 8 * ((ch + 8) ^ ((r & 7) << 1))) = p1; } }
        } else if (w >= 4) {
            const int tt = (w - 4) >> 1, ptj = w & 1;
            const LAS unsigned char* ht_nat = Lb + SD_HT + buf * 17408 + (32 * ptj + r) * 272 + hh * 16;
            f32x16 yi;
#pragma unroll
            for (int i = 0; i < 16; ++i) yi[i] = 0.f;
            const LAS unsigned char* cn_nat = Lb + SD_CN + (32 * tt + r) * 272 + hh * 16;
            { f32x16 yb2;
#pragma unroll
              for (int i = 0; i < 16; ++i) yb2[i] = 0.f;
#pragma unroll 2
              for (int ks = 0; ks < 8; ks += 2) { yi = MFMA32(lds_frag16(cn_nat + ks * 32), lds_frag16(ht_nat + ks * 32), yi); yb2 = MFMA32(lds_frag16(cn_nat + ks * 32 + 32), lds_frag16(ht_nat + ks * 32 + 32), yb2); }
              yi = yi + yb2; }
            const LAS unsigned short* xt_p = XT + (32 * ptj + r) * 72 + 32 * tt + 4 * hh;
#pragma unroll
            for (int q4 = 0; q4 < 4; ++q4) { const f32x4 ec = *(const LAS f32x4*)(ECUM + 32 * tt + 8 * q4 + 4 * hh); const v2u xw = *(const LAS v2u*)(xt_p + 8 * q4);
                const float x0 = bf2f(xw.x & 0xffffu), x1 = bf2f(xw.x >> 16), x2 = bf2f(xw.y & 0xffffu), x3 = bf2f(xw.y >> 16);
                LAS float* yb = YY + (32 * tt + 8 * q4 + 4 * hh) * 64 + 32 * ptj + r;
                yb[0] = ec[0] * yi[4 * q4] + Dk * x0; yb[64] = ec[1] * yi[4 * q4 + 1] + Dk * x1; yb[128] = ec[2] * yi[4 * q4 + 2] + Dk * x2; yb[192] = ec[3] * yi[4 * q4 + 3] + Dk * x3; }
        }
#define SSD_UPD(HX, TILE) { const int q_ = (lane >> 2) & 3, ch_ = 4 * ((TILE) >> 1) + 2 * ((lane >> 4) & 1) + ((lane >> 1) & 1); \
            const LAS unsigned char* bn_lo = Lb + SD_BN + (8 * hh + q_) * 256 + 16 * (ch_ ^ ((q_ << 2) | ((2 * hh) & 3))) + 8 * (lane & 1); \
            const LAS unsigned char* bn_hi = Lb + SD_BN + (8 * hh + 4 + q_) * 256 + 16 * (ch_ ^ ((q_ << 2) | ((2 * hh + 1) & 3))) + 8 * (lane & 1); \
            const LAS unsigned char* xt_nat = Lb + SD_XWT + (32 * ((TILE) & 1) + r) * 144 + hh * 16; \
            f32x16 Ha, Hb; \
            _Pragma("unroll") for (int i = 0; i < 16; ++i) { Ha[i] = 0.f; Hb[i] = 0.f; } \
            Ha = MFMA32(lds_frag_tr(bn_lo, bn_hi), lds_frag16(xt_nat), Ha); Hb = MFMA32(lds_frag_tr(bn_lo + 4096, bn_hi + 4096), lds_frag16(xt_nat + 32), Hb); \
            Ha = MFMA32(lds_frag_tr(bn_lo + 8192, bn_hi + 8192), lds_frag16(xt_nat + 64), Ha); Hb = MFMA32(lds_frag_tr(bn_lo + 12288, bn_hi + 12288), lds_frag16(xt_nat + 96), Hb);         \
            _Pragma("unroll") for (int i = 0; i < 16; ++i) HX[i] = HX[i] * el + (Ha[i] + Hb[i]); \
            SSD_PUBLISH(HX, TILE, buf ^ 1) }
        if (w >= 3) { const float el = ECUM[63];
            if (w == 3) { SSD_UPD(H0, 0) SSD_UPD(H1, 1) SSD_UPD(H2, 2) SSD_UPD(H3, 3) } else { SSD_UPD(H0, w) } }
        LDS_BARRIER(); LDS_BARRIER();
        { const int tt = tid >> 3, p0 = (tid & 7) * 8;
          if (t0 + tt < L) { const size_t row = row_base + t0 + tt;
            const int c0 = 2 * (tid & 7);
            f32x4 y0 = *(const LAS f32x4*)(YA + tt * 64 + 4 * (c0 ^ (tt & 15))) + *(const LAS f32x4*)(YY + tt * 64 + p0), y1 = *(const LAS f32x4*)(YA + tt * 64 + 4 * ((c0 + 1) ^ (tt & 15))) + *(const LAS f32x4*)(YY + tt * 64 + p0 + 4);
            if (tt >= 32) { const v4u ow4 = *(const LAS v4u*)((const LAS unsigned char*)YO + (tt - 32) * 128 + 16 * ((tid & 7) ^ (tt & 7)));
                y0 = y0 + (f32x4){bf2f(ow4.x & 0xffffu), __uint_as_float(ow4.x & 0xffff0000u), bf2f(ow4.y & 0xffffu), __uint_as_float(ow4.y & 0xffff0000u)};
                y1 = y1 + (f32x4){bf2f(ow4.z & 0xffffu), __uint_as_float(ow4.z & 0xffff0000u), bf2f(ow4.w & 0xffffu), __uint_as_float(ow4.w & 0xffff0000u)}; }
            float o[8]; float sq = 0.f;
#pragma unroll
            for (int j = 0; j < 8; ++j) { const unsigned z16 = (zw[j >> 1] >> ((j & 1) * 16)) & 0xffffu; const float yv = (j < 4 ? y0[j & 3] : y1[j & 3]) * silu_f(bf2f(z16)); o[j] = yv; sq += yv * yv; }
            ow_pend.x = pk2(o[0], o[1]); ow_pend.y = pk2(o[2], o[3]); ow_pend.z = pk2(o[4], o[5]); ow_pend.w = pk2(o[6], o[7]);
            sq += __int_as_float(__builtin_amdgcn_update_dpp(0, __float_as_int(sq), 0x104, 0xf, 0xf, true));
            sq += __int_as_float(__builtin_amdgcn_update_dpp(0, __float_as_int(sq), 0x102, 0xf, 0xf, true));
            sq += __int_as_float(__builtin_amdgcn_update_dpp(0, __float_as_int(sq), 0x101, 0xf, 0xf, true)); sq_pend = sq; pend = true; } }
        }
    }
    if (pend) { const size_t prow = row_base + (L - 64) + (tid >> 3); *(v4u*)(YG + prow * 2048 + h * 64 + (tid & 7) * 8) = ow_pend; if ((tid & 7) == 0) SSQ[prow * 32 + h] = sq_pend; }
#define SSD_STOUT(HX, TILE) { float* st_g = st_base + (size_t)(32 * ((TILE) & 1)) * 128 + 32 * ((TILE) >> 1); \
        _Pragma("unroll") for (int q4 = 0; q4 < 4; ++q4) *(f32x4*)(st_g + 8 * q4) = (f32x4){HX[4 * q4], HX[4 * q4 + 1], HX[4 * q4 + 2], HX[4 * q4 + 3]}; }
    if (w == 3) { SSD_STOUT(H0, 0) SSD_STOUT(H1, 1) SSD_STOUT(H2, 2) SSD_STOUT(H3, 3) } else if (w >= 4) { SSD_STOUT(H0, w) }
#undef SSD_STOUT
#undef SSD_UPD
#undef SSD_PUBLISH
    __syncthreads();
}
__device__ __forceinline__ float tr_reduce32(const float (&v)[32], int lane) {
    const bool b4 = lane & 16, b3 = lane & 8, b2 = lane & 4, b1 = lane & 2, b0 = lane & 1;
    float a[16], b[8], c[4], d[2];
#pragma unroll
    for (int i = 0; i < 16; ++i) { const float keep = b4 ? v[i + 16] : v[i], send = b4 ? v[i] : v[i + 16]; a[i] = keep + __shfl_xor(send, 16); }
#pragma unroll
    for (int i = 0; i < 8; ++i) { const float keep = b3 ? a[i + 8] : a[i], send = b3 ? a[i] : a[i + 8]; b[i] = keep + __shfl_xor(send, 8); }
#pragma unroll
    for (int i = 0; i < 4; ++i) { const float keep = b2 ? b[i + 4] : b[i], send = b2 ? b[i] : b[i + 4]; c[i] = keep + __shfl_xor(send, 4); }
#pragma unroll
    for (int i = 0; i < 2; ++i) { const float keep = b1 ? c[i + 2] : c[i], send = b1 ? c[i] : c[i + 2]; d[i] = keep + __shfl_xor(send, 2); }
    const float keep = b0 ? d[1] : d[0], send = b0 ? d[0] : d[1];
    return keep + __shfl_xor(send, 1);
}
__device__ __forceinline__ void ssd_sample_unit(Frame& F, int sb, int g) {
    int tid_o = F.tid; asm volatile("" : "+v"(tid_o));
    const int tid = tid_o, lane = tid & 63, w = F.wave, hh = lane >> 5, nq = lane & 31; unsigned char* ws = F.ws;
    LAS float* XC = (LAS float*)(F.lds + RING_OFF); LAS float* BC = XC + 8 * 4 * 64; LAS float* CC = BC + 4 * 128; LAS float* DTS = CC + 4 * 128;
    const bf16* PROJ = (const bf16*)(ws + WS_PROJ); const float* DTR = (const float*)(ws + WS_DT); bf16* YG = (bf16*)(ws + WS_YG); float* SSQ = (float*)(ws + WS_SSQSSD);
    const size_t row0 = (size_t)TP + (size_t)sb * LS;
    const int h = 8 * g + w;
    const float* sp = F.in[3] + (size_t)(sb * 32 + h) * 8192 + (size_t)hh * 128 + 4 * nq;
    f32x4 hst[32];
#pragma unroll
    for (int i = 0; i < 32; ++i) hst[i] = ld_nt(sp + (size_t)i * 256);
    if (tid < 384) { typedef float f32x2 __attribute__((ext_vector_type(2)));
        const int col = tid < 256 ? g * 512 + 2 * tid : (tid < 320 ? 2048 + g * 128 + 2 * (tid - 256) : 2560 + g * 128 + 2 * (tid - 320));
        const float* cw = F.in[10]; const float* sc = F.in[4] + (size_t)sb * 3 * 3072 + col;
        const f32x2 w0 = *(const f32x2*)(cw + col), w1 = *(const f32x2*)(cw + 3072 + col), w2 = *(const f32x2*)(cw + 2 * 3072 + col), w3 = *(const f32x2*)(cw + 3 * 3072 + col), cb = *(const f32x2*)(F.in[11] + col);
        f32x2 full[7]; full[0] = *(const f32x2*)sc; full[1] = *(const f32x2*)(sc + 3072); full[2] = *(const f32x2*)(sc + 2 * 3072);
        const bf16* cp = PROJ + (size_t)(S_X0 + (col >> 10)) * SLOT_ELEMS + row0 * 1024 + (col & 1023);
#pragma unroll
        for (int t = 0; t < 4; ++t) { const unsigned wd = *(const unsigned*)(cp + (size_t)t * 1024); full[3 + t] = (f32x2){__uint_as_float(wd << 16), __uint_as_float(wd & 0xffff0000u)}; }
#pragma unroll
        for (int t = 0; t < 4; ++t) { f32x2 a = w0 * full[t] + cb; a = w1 * full[t + 1] + a; a = w2 * full[t + 2] + a; a = w3 * full[t + 3] + a;
            f32x2 o; o.x = silu_f(a.x); o.y = silu_f(a.y);
            LAS float* dst = tid < 256 ? XC + ((tid >> 5) * 4 + t) * 64 + 2 * (tid & 31) : (tid < 320 ? BC + t * 128 + 2 * (tid - 256) : CC + t * 128 + 2 * (tid - 320));
            *(LAS f32x2*)dst = o; }
    } else if (tid < 416) { const int idx = tid - 384, hl = idx >> 2, t = idx & 3; const float x = DTR[(row0 + t) * 32 + 8 * g + hl] + F.in[12][8 * g + hl]; DTS[idx] = x > 20.f ? x : log1pf(__expf(x)); }
    __syncthreads();
    const float a = -__expf(F.in[13][h]), Dk = F.in[14][h];
#pragma unroll 1
    for (int t = 0; t < 4; ++t) {
        const float dtv = DTS[w * 4 + t], dA = __expf(dtv * a);
        const f32x4 Bv = *(const LAS f32x4*)(BC + t * 128 + 4 * nq), Cv = *(const LAS f32x4*)(CC + t * 128 + 4 * nq);
        const LAS float* xrow = XC + (w * 4 + t) * 64;
        float part[32];
#pragma unroll
        for (int i = 0; i < 32; ++i) { const float xd = xrow[2 * i + hh] * dtv; hst[i] = hst[i] * dA + Bv * xd; part[i] = (hst[i].x * Cv.x + hst[i].y * Cv.y) + (hst[i].z * Cv.z + hst[i].w * Cv.w); }
        float yv = tr_reduce32(part, lane);
        const int p = 2 * nq + hh; const size_t row = row0 + t;
        yv += Dk * xrow[p];
        const float z = bf2f(PROJ[(size_t)(S_Z0 + (h >> 4)) * SLOT_ELEMS + row * 1024 + (h & 15) * 64 + p]);
        const float yg = yv * silu_f(z);
        YG[row * 2048 + h * 64 + p] = (bf16)f2bf(yg);
        const float sq = wave_sum(yg * yg);
        if (lane == 0) SSQ[row * 32 + h] = sq;
    }
    float* so = F.out + O_SSMS + (size_t)(sb * 32 + h) * 8192 + (size_t)hh * 128 + 4 * nq;
#pragma unroll
    for (int i = 0; i < 32; ++i) st_nt(so + (size_t)i * 256, hst[i]);
    __syncthreads();
}
__device__ __forceinline__ void hgrn_sample_unit(Frame& F, int sb, int hq) {
    int tid_o = F.tid; asm volatile("" : "+v"(tid_o));
    const int tid = tid_o, lane = tid & 63, w = F.wave, hh = lane >> 5, vq = lane & 31; unsigned char* ws = F.ws;
    LAS float* FS = (LAS float*)(F.lds + RING_OFF); LAS float* KS = FS + 2048; LAS float* QS = KS + 2048; LAS float* VS = QS + 2048; LAS float* OP = VS + 2048;
    const bf16* PROJ = (const bf16*)(ws + WS_PROJ); bf16* ON = (bf16*)(ws + WS_ON);
    const size_t row0 = (size_t)TP + (size_t)sb * LS;
    const int hl = w >> 1, kh = w & 1, hd = 4 * hq + hl;
    const float* sp = F.in[5] + (size_t)(sb * 8 + hd) * 16384 + (size_t)(64 * kh + hh) * 128 + 4 * vq;
    f32x4 S[32];
#pragma unroll
    for (int i = 0; i < 32; ++i) S[i] = ld_nt(sp + (size_t)i * 256);
    { const int ch = hq * 512 + tid; const float lb = __builtin_amdgcn_rcpf(1.0f + __expf(F.in[17][1024 + ch] - F.in[17][ch]));
      const bf16* fp = PROJ + (size_t)S_F * SLOT_ELEMS + row0 * 1024 + ch; const bf16* qp = PROJ + (size_t)S_Q * SLOT_ELEMS + row0 * 1024 + ch; const bf16* ip = PROJ + (size_t)S_I * SLOT_ELEMS + row0 * 1024 + ch;
#pragma unroll
      for (int t = 0; t < 4; ++t) { const float u = fminf(fmaxf(bf2f(fp[(size_t)t * 1024]), -30.f), 30.f); const float fg = lb + (1.0f - lb) * sigmoid_f(u);
          const int o = ((tid >> 7) * 4 + t) * 128 + (tid & 127);
          FS[o] = fg; KS[o] = 1.0f - fg; QS[o] = silu_f(bf2f(qp[(size_t)t * 1024])); VS[o] = bf2f(ip[(size_t)t * 1024]); } }
    __syncthreads();
#pragma unroll 1
    for (int t = 0; t < 4; ++t) {
        const int o = (hl * 4 + t) * 128;
        const f32x4 vv = *(const LAS f32x4*)(VS + o + 4 * vq);
        f32x4 oa = (f32x4){0.f, 0.f, 0.f, 0.f};
#pragma unroll
        for (int i = 0; i < 32; ++i) { const int k = 64 * kh + 2 * i + hh; const float fk = FS[o + k], kv = KS[o + k], qk = QS[o + k]; S[i] = S[i] * fk + vv * kv; oa = oa + S[i] * qk; }
        oa.x += __shfl_xor(oa.x, 32); oa.y += __shfl_xor(oa.y, 32); oa.z += __shfl_xor(oa.z, 32); oa.w += __shfl_xor(oa.w, 32);
        if (hh == 0) *(LAS f32x4*)(OP + ((hl * 4 + t) * 2 + kh) * 128 + 4 * vq) = oa;
    }
    float* so = F.out + O_HGS + (size_t)(sb * 8 + hd) * 16384 + (size_t)(64 * kh + hh) * 128 + 4 * vq;
#pragma unroll
    for (int i = 0; i < 32; ++i) st_nt(so + (size_t)i * 256, S[i]);
    __syncthreads();
#pragma unroll
    for (int rr2 = 0; rr2 < 2; ++rr2) { const int rr = 2 * w + rr2, ohl = rr >> 2, t = rr & 3, ohd = 4 * hq + ohl; typedef float f32x2 __attribute__((ext_vector_type(2)));
        const f32x2 p0 = *(const LAS f32x2*)(OP + (rr * 2) * 128 + 2 * lane), p1 = *(const LAS f32x2*)(OP + (rr * 2 + 1) * 128 + 2 * lane);
        const float o0 = p0.x + p1.x, o1 = p0.y + p1.y; const float sq = wave_sum(o0 * o0 + o1 * o1); const float rs = __builtin_amdgcn_rsqf(sq * (1.0f / 128.0f) + EPS);
        const size_t row = row0 + t; const unsigned gw = *(const unsigned*)(PROJ + (size_t)S_HG * SLOT_ELEMS + row * 1024 + ohd * 128 + 2 * lane);
        *(unsigned*)(ON + row * 1024 + ohd * 128 + 2 * lane) = pk2(o0 * rs * silu_f(bf2f(gw & 0xffffu)), o1 * rs * silu_f(__uint_as_float(gw & 0xffff0000u))); }
    __syncthreads();
}
constexpr int U_HGS = NBS * 2, U_SSDS = NBS * 4, U_CONV = NBP + NBS;
__device__ __forceinline__ void scan_phase(Frame& F) {
    gu32* head = F.ctl + CW_QUEUE;
#define SCAN_QUEUE(qi, count, body) for (;;) { if (F.tid == 0) F.MISC[0] = __hip_atomic_fetch_add(head + 64 * (qi), 1u, RLX_AGENT); __syncthreads(); const int u = (int)F.MISC[0]; __syncthreads(); if (u >= (count)) break; body }
    SCAN_QUEUE(1, NBP * 32, ssd_unit_mfma(F, u >> 5, u & 31);)
    SCAN_QUEUE(0, NBP * 32, hgrn_v_unit(F, u >> 5, (u >> 2) & 7, u & 3);)
    SCAN_QUEUE(2, U_HGS, hgrn_sample_unit(F, u >> 1, u & 1);)
    SCAN_QUEUE(3, U_SSDS + U_CONV, if (u >= U_SSDS) { conv_copy_unit(F, u - U_SSDS); continue; } ssd_sample_unit(F, u >> 2, u & 3);)
#undef SCAN_QUEUE
}
typedef float f32x4s __attribute__((ext_vector_type(4)));
template <class Epi> __device__ __forceinline__ void small_tile_phase(Frame& F, const bf16* A, const bf16* Bt, int K, const Epi& E) {
    const int lane = F.lane, w = F.wave, r = lane & 31, hh = lane >> 5;
#pragma unroll 1
    for (int v = F.vcu; v < 256; v += F.G) {
    const int mt = v >> 4, nt = v & 15;
    const int kw = K >> 3;
    const bf16* ap = A + (size_t)(TP + 32 * mt + r) * K + w * kw + 8 * hh;
    const bf16* bp = Bt + (size_t)(64 * nt + r) * K + w * kw + 8 * hh;
    f32x16 acc0, acc1;
#pragma unroll
    for (int i = 0; i < 16; ++i) { acc0[i] = 0.f; acc1[i] = 0.f; }
#pragma unroll 8
    for (int ks = 0; ks < kw / 16; ++ks) { const bf16x8 af = *(const bf16x8*)(ap + 16 * ks), b0 = *(const bf16x8*)(bp + 16 * ks), b1 = *(const bf16x8*)(bp + (size_t)32 * K + 16 * ks);
        acc0 = MFMA32(b0, af, acc0); acc1 = MFMA32(b1, af, acc1); }
    LAS float* part = (LAS float*)(F.lds + RING_OFF) + w * 2176;
#pragma unroll
    for (int q4 = 0; q4 < 4; ++q4) { *(LAS f32x4*)(part + r * 68 + 8 * q4 + 4 * hh) = (f32x4){acc0[4 * q4], acc0[4 * q4 + 1], acc0[4 * q4 + 2], acc0[4 * q4 + 3]};
        *(LAS f32x4*)(part + r * 68 + 32 + 8 * q4 + 4 * hh) = (f32x4){acc1[4 * q4], acc1[4 * q4 + 1], acc1[4 * q4 + 2], acc1[4 * q4 + 3]}; }
    __syncthreads();
    const int rl = F.tid >> 4, c4 = (F.tid & 15) * 4; const LAS float* src = (const LAS float*)(F.lds + RING_OFF) + rl * 68 + c4;
    f32x4 sum = *(const LAS f32x4*)src;
#pragma unroll
    for (int ww = 1; ww < 8; ++ww) sum = sum + *(const LAS f32x4*)(src + ww * 2176);
    const f32x4s acc = (f32x4s){sum.x, sum.y, sum.z, sum.w};
    E.small(F, acc, TP + 32 * mt + rl, 64 * nt + c4, nt);
    __syncthreads();
    }
}
template <bool ADD> struct SmGate { bf16* O; const bf16* gate;
    __device__ __forceinline__ void small(Frame&, const f32x4s& a, int row, int col, int) const { const size_t off = (size_t)row * 1024 + col;
        const v2u gw = __builtin_nontemporal_load((const v2u*)(gate + off)); v2u ow = (v2u){0u, 0u}; if (ADD) ow = *(const v2u*)(O + off);
        float rr[4];
#pragma unroll
        for (int e = 0; e < 4; ++e) { const unsigned g16 = (gw[e >> 1] >> ((e & 1) * 16)) & 0xffffu, o16 = (ow[e >> 1] >> ((e & 1) * 16)) & 0xffffu; rr[e] = (ADD ? bf2f(o16) : 0.f) + sigmoid_f(bf2f(g16)) * a[e]; }
        v2u wv; wv.x = cvtpk_c(rr[0], rr[1]); wv.y = cvtpk_c(rr[2], rr[3]); *(v2u*)(O + off) = wv; } };
template <bool BF, bool BSC = false> struct SmRes { const float* base; const bf16* bb; bf16* hb; float* ssqp; const float* bsc;
    __device__ __forceinline__ void small(Frame& F, const f32x4s& a, int row, int col, int nt) const { const size_t off = (size_t)row * 1024 + col; f32x4 b;
        if (BF) { const v2u w = *(const v2u*)(bb + off); b = (f32x4){bf2f(w.x & 0xffffu), __uint_as_float(w.x & 0xffff0000u), bf2f(w.y & 0xffffu), __uint_as_float(w.y & 0xffff0000u)}; }
        else b = *(const f32x4*)(base + off);
        if constexpr (BSC) b = b * bsc[row];
        const f32x4 v = b + (f32x4){a[0], a[1], a[2], a[3]};
        { v2u wv; wv.x = cvtpk_c(v[0], v[1]); wv.y = cvtpk_c(v[2], v[3]); *(v2u*)(hb + off) = wv; }
        float sq = (v[0] * v[0] + v[1] * v[1]) + (v[2] * v[2] + v[3] * v[3]); sq += __shfl_xor(sq, 1); sq += __shfl_xor(sq, 2); sq += __shfl_xor(sq, 4); sq += __shfl_xor(sq, 8);
        if ((F.tid & 15) == 0) ssqp[(size_t)row * 16 + nt] = sq; } };
struct SmScale { bf16* O; const float* ssq; float scale;
    __device__ __forceinline__ void small(Frame&, const f32x4s& a, int row, int col, int) const { const float rs = pg8::row_rs<16>(ssq, row) * scale;
        v2u wv; wv.x = cvtpk_c(a[0] * rs, a[1] * rs); wv.y = cvtpk_c(a[2] * rs, a[3] * rs); *(v2u*)(O + (size_t)row * 1024 + col) = wv; } };
__device__ __forceinline__ void attn_stage_tile(LAS unsigned char* Lb, const bf16* src, size_t pitch, int tid) {
#pragma unroll 1
    for (int hb = 0; hb < 2; ++hb) { v4u v[8];
#pragma unroll
        for (int i = 0; i < 8; ++i) { const int id = tid + 512 * (8 * hb + i), row = id >> 5, c = id & 31; v[i] = *(const v4u*)(src + (size_t)row * pitch + c * 8); }
#pragma unroll
        for (int i = 0; i < 8; ++i) { const int id = tid + 512 * (8 * hb + i), row = id >> 5, c = id & 31; *(LAS v4u*)(Lb + row * 512 + ((c ^ (row & 15)) << 4)) = v[i]; } }
}
__device__ __forceinline__ void attn_prompt_unit(Frame& F, int b, int hd, int qb) {
    const int tid = F.tid, lane = F.lane, w = F.wave, r = lane & 31, hh = lane >> 5; unsigned char* ws = F.ws;
    LAS unsigned char* Lb = F.lds + RING_OFF;
    const bf16* QB = (const bf16*)(ws + WS_QB); const bf16* KB = (const bf16*)(ws + WS_KB); const bf16* VT = (const bf16*)(ws + WS_VT); bf16* OB = (bf16*)(ws + WS_OB);
    const size_t qrow = (size_t)b * SEQ + (size_t)qb * 256 + 32 * w + r;
    attn_stage_tile(Lb, KB + (size_t)b * 256 * 1024 + hd * 256, 1024, tid);
    const bf16* qp = QB + qrow * 1024 + hd * 256 + 8 * hh;
    bf16x8 qf = *(const bf16x8*)qp;
    __syncthreads();
    f32x16 S[8];
#pragma unroll
    for (int t = 0; t < 8; ++t)
#pragma unroll
        for (int i = 0; i < 16; ++i) S[t][i] = 0.f;
    const int sw = r & 15;
#pragma unroll 1
    for (int ks = 0; ks < 16; ++ks) {
        const bf16x8 qn = *(const bf16x8*)(qp + 16 * (ks < 15 ? ks + 1 : ks));
        const LAS unsigned char* kp = Lb + r * 512 + (((2 * ks + hh) ^ sw) << 4);
#pragma unroll
        for (int t = 0; t < 8; ++t) S[t] = MFMA32(lds_frag16(kp + t * 32 * 512), qf, S[t]);
        qf = qn;
    }
    float m = -3.0e38f;
#pragma unroll
    for (int t = 0; t < 8; ++t)
#pragma unroll
        for (int i = 0; i < 16; ++i) m = fmaxf(m, S[t][i]);
    m = fmaxf(m, __shfl_xor(m, 32));
    float l = 0.f;
#pragma unroll
    for (int t = 0; t < 8; ++t)
#pragma unroll
        for (int i = 0; i < 16; ++i) { const float pv = __builtin_amdgcn_exp2f(S[t][i] - m); S[t][i] = pv; l += pv; }
    l += __shfl_xor(l, 32);
    const float rl = __builtin_amdgcn_rcpf(l);
    bf16x8 pf[8][2];
#pragma unroll
    for (int t = 0; t < 8; ++t) { pf[t][0] = ACC_FRAG(S[t], 0); pf[t][1] = ACC_FRAG(S[t], 1); }
    __syncthreads();
    attn_stage_tile(Lb, VT + (size_t)(b * 4 + hd) * 256 * 256, 256, tid);
    __syncthreads();
    bf16* op = OB + qrow * 1024 + hd * 256 + 4 * hh;
#pragma unroll 1
    for (int dt = 0; dt < 8; ++dt) {
        f32x16 O;
#pragma unroll
        for (int i = 0; i < 16; ++i) O[i] = 0.f;
        const LAS unsigned char* vrow = Lb + (32 * dt + r) * 512 + 8 * hh;
#pragma unroll
        for (int t = 0; t < 8; ++t)
#pragma unroll
            for (int s2 = 0; s2 < 2; ++s2) {
                const v2u lo = *(const LAS v2u*)(vrow + (((4 * t + 2 * s2) ^ sw) << 4)), hi = *(const LAS v2u*)(vrow + (((4 * t + 2 * s2 + 1) ^ sw) << 4));
                const v4u wv4 = (v4u){lo.x, lo.y, hi.x, hi.y};
                O = MFMA32(__builtin_bit_cast(bf16x8, wv4), pf[t][s2], O);
            }
#pragma unroll
        for (int q4 = 0; q4 < 4; ++q4) { v2u o; o.x = cvtpk_c(O[4 * q4] * rl, O[4 * q4 + 1] * rl); o.y = cvtpk_c(O[4 * q4 + 2] * rl, O[4 * q4 + 3] * rl);
            *(v2u*)(op + 32 * dt + 8 * q4) = o; }
    }
    __syncthreads();
}
__device__ __forceinline__ void attn_sample_unit(Frame& F, int sb, int hd) {
    const int tid = F.tid, lane = F.lane, w = F.wave; unsigned char* ws = F.ws;
    LAS float* sc = (LAS float*)(F.lds + RING_OFF);
    LAS float* red = sc + 4 * 256;
    const bf16* QB = (const bf16*)(ws + WS_QB); bf16* OB = (bf16*)(ws + WS_OB);
    const size_t rowq = (size_t)TP + (size_t)sb * LS;
    float q[4][4];
#pragma unroll
    for (int t = 0; t < 4; ++t) { const v2u qw = *(const v2u*)(QB + (rowq + t) * 1024 + hd * 256 + 4 * lane); q[t][0] = bf2f(qw.x & 0xffffu); q[t][1] = bf2f(qw.x >> 16); q[t][2] = bf2f(qw.y & 0xffffu); q[t][3] = bf2f(qw.y >> 16); }
    const float* Kc = F.in[6] + ((size_t)sb * 256 * 4 + hd) * 256 + 4 * lane; const float* Vc = F.in[7] + ((size_t)sb * 256 * 4 + hd) * 256 + 4 * lane;
    f32x4 kv[8], kn[8];
#pragma unroll
    for (int u = 0; u < 8; ++u) kv[u] = ld_nt(Kc + (size_t)(w * 32 + u) * 1024);
#pragma unroll 1
    for (int kk0 = 0; kk0 < 32; kk0 += 8) {
#pragma unroll
        for (int u = 0; u < 8; ++u) kn[u] = kk0 < 24 ? ld_nt(Kc + (size_t)(w * 32 + kk0 + 8 + u) * 1024) : ld_nt(Vc + (size_t)(w * 32 + u) * 1024);
        { float part[32];
#pragma unroll
          for (int u = 0; u < 8; ++u)
#pragma unroll
              for (int t = 0; t < 4; ++t) part[4 * u + t] = (q[t][0] * kv[u].x + q[t][1] * kv[u].y) + (q[t][2] * kv[u].z + q[t][3] * kv[u].w);
          float sv = tr_reduce32(part, lane); sv += __shfl_xor(sv, 32);
          if (lane < 32) sc[(lane & 3) * 256 + w * 32 + kk0 + (lane >> 2)] = sv; }
#pragma unroll
        for (int u = 0; u < 8; ++u) kv[u] = kn[u]; }
    __syncthreads();
    if (w < 4) { float v[4]; float m = -3.0e38f;
#pragma unroll
        for (int j = 0; j < 4; ++j) { v[j] = sc[w * 256 + j * 64 + lane]; m = fmaxf(m, v[j]); }
        m = wave_max(m); float l = 0.f;
#pragma unroll
        for (int j = 0; j < 4; ++j) { v[j] = __builtin_amdgcn_exp2f(v[j] - m); l += v[j]; }
        l = wave_sum(l); const float rl = 1.0f / l;
#pragma unroll
        for (int j = 0; j < 4; ++j) sc[w * 256 + j * 64 + lane] = v[j] * rl; }
    __syncthreads();
    float o[4][4];
#pragma unroll
    for (int t = 0; t < 4; ++t)
#pragma unroll
        for (int e = 0; e < 4; ++e) o[t][e] = 0.f;
#pragma unroll 1
    for (int kk0 = 0; kk0 < 32; kk0 += 8) {
        if (kk0 < 24) {
#pragma unroll
            for (int u = 0; u < 8; ++u) kn[u] = ld_nt(Vc + (size_t)(w * 32 + kk0 + 8 + u) * 1024); }
#pragma unroll
        for (int u = 0; u < 8; ++u) { const int key = w * 32 + kk0 + u;
#pragma unroll
            for (int t = 0; t < 4; ++t) { const float pr = sc[t * 256 + key]; o[t][0] += pr * kv[u].x; o[t][1] += pr * kv[u].y; o[t][2] += pr * kv[u].z; o[t][3] += pr * kv[u].w; } }
#pragma unroll
        for (int u = 0; u < 8; ++u) kv[u] = kn[u]; }
#pragma unroll
    for (int t = 0; t < 4; ++t) *(LAS f32x4*)(red + (w * 4 + t) * 256 + 4 * lane) = (f32x4){o[t][0], o[t][1], o[t][2], o[t][3]};
    __syncthreads();
    { const int t = tid >> 7, d0 = (tid & 127) * 2; float a0 = 0.f, a1 = 0.f;
#pragma unroll
      for (int ww = 0; ww < 8; ++ww) { a0 += red[(ww * 4 + t) * 256 + d0]; a1 += red[(ww * 4 + t) * 256 + d0 + 1]; }
      *(unsigned*)(OB + (rowq + t) * 1024 + hd * 256 + d0) = pk2(a0, a1); }
    __syncthreads();
}
__device__ __forceinline__ void attn_phase(Frame& F) {
    const bool sample_first = (blockIdx.x >> 3) & 1;
    for (int pass = 0; pass < 2; ++pass) {
        if ((pass == 0) != sample_first) { for (int u = F.vcu; u < NBP * 4 * 8; u += F.G) attn_prompt_unit(F, u >> 5, (u >> 3) & 3, u & 7); }
        else { for (int u = F.vcu; u < NBS * 4; u += F.G) attn_sample_unit(F, u >> 2, u & 3); }
    }
}
__device__ __forceinline__ void final_norm_phase(Frame& F) {
    const int gw = F.vcu * NWAVES + F.wave, NGW = F.G * NWAVES; const float* SSQ = (const float*)(F.ws + WS_SSQP3); const float* wn = F.in[31]; const bf16* HB = (const bf16*)(F.ws + WS_HB);
    f32x4 wv[4];
#pragma unroll
    for (int j = 0; j < 2; ++j) { wv[2 * j] = *((const f32x4*)wn + 2 * (64 * j + F.lane)); wv[2 * j + 1] = *((const f32x4*)wn + 2 * (64 * j + F.lane) + 1); }
    for (int row = gw; row < T; row += NGW) {
        const f32x4* sp = (const f32x4*)(SSQ + (size_t)row * 16); float s = 0.f;
#pragma unroll
        for (int j = 0; j < 4; ++j) { const f32x4 a = sp[j]; s += (a.x + a.y) + (a.z + a.w); }
        const float rs = __builtin_amdgcn_rsqf(s * (1.0f / 1024.0f) + EPS);
#pragma unroll
        for (int j = 0; j < 2; ++j) { const int pc = 64 * j + F.lane; const v4u w = ld_nt16((const v4u*)(HB + (size_t)row * 1024) + pc);
            const f32x4 v0 = (f32x4){bf2f(w.x & 0xffffu), __uint_as_float(w.x & 0xffff0000u), bf2f(w.y & 0xffffu), __uint_as_float(w.y & 0xffff0000u)};
            const f32x4 v1 = (f32x4){bf2f(w.z & 0xffffu), __uint_as_float(w.z & 0xffff0000u), bf2f(w.w & 0xffffu), __uint_as_float(w.w & 0xffff0000u)};
            float* o = F.out + O_Y + (size_t)row * 1024 + 8 * pc; st_nt(o, v0 * rs * wv[2 * j]); st_nt(o + 4, v1 * rs * wv[2 * j + 1]); }
    }
}
#ifndef MK_N_LAUNCHES
#define MK_N_LAUNCHES 1
#endif
constexpr int PER_PHASE = 13;
constexpr int N_LAUNCHES = MK_N_LAUNCHES;
struct Args { const float* in[32]; float* out; unsigned char* ws; int ph_lo, ph_hi; };
__global__ void __launch_bounds__(NTHR, 2) skel_fwd(Args args) {
    extern __shared__ __attribute__((aligned(16))) unsigned char lds[];
    Frame F;
    F.lds = (LAS unsigned char*)lds;
    F.MISC = (volatile LAS unsigned*)(F.lds + MISC_OFF);
    F.tid = threadIdx.x; F.lane = F.tid & 63; F.wave = __builtin_amdgcn_readfirstlane(F.tid >> 6);
    F.G = gridDim.x; { const int bx = blockIdx.x; F.vcu = (F.G % 8 == 0) ? (bx % 8) * (F.G / 8) + bx / 8 : bx; }
    unsigned char* ws = args.ws; F.ws = ws; F.out = args.out;
    F.ctl = (gu32*)(ws + WS_CTL);
#pragma unroll
    for (int i = 0; i < 32; ++i) F.in[i] = args.in[i];
    for (int u = F.tid; u < (LDS_BYTES - LDSCTL_OFF) / 4; u += NTHR) ((LAS unsigned*)(F.lds + LDSCTL_OFF))[u] = 0u;
    __syncthreads();
    XcdBarrier bar; bar.bar = (unsigned*)(F.ctl + CW_BAR); bar.x = 0; bar.st = nullptr;
    if (N_LAUNCHES == 1) bar = xcd_barrier_post((unsigned*)(F.ctl + CW_BAR), F.MISC + 8);
#define GRID_BAR() do { if (N_LAUNCHES == 1) xcd_barrier(bar); } while (0)
    const int lo = args.ph_lo, hi = args.ph_hi;
#ifdef ONLY_PHASE
#define IN(k) ((k) == ONLY_PHASE && lo <= (k) && (k) < hi)
#else
#define IN(k) (lo <= (k) && (k) < hi)
#endif
#define BOTH(k) (IN(k) && IN((k) + 1))
    bf16* const XB = (bf16*)(ws + WS_XB); bf16* const PROJ = (bf16*)(ws + WS_PROJ);
    float* const Y = F.out + O_Y;
    if (IN(0)) { p0_prologue(F); if (BOTH(0)) GRID_BAR(); }
    if (IN(1)) {
        { pg8::Gemm g{XB, (const bf16*)(ws + WS_WIN), T, NPROJ, 1024}; pg8::StaticOrder S; S.init(T, NPROJ, F.G, (int)blockIdx.x);
          pg8::EpiScaleBf16<0, true> E{PROJ, SLOT_ELEMS, nullptr, 1.0f, (float*)(ws + WS_DT)};
          pg8::gemm_phase<pg8::EpiScaleBf16<0, true>, pg8::StaticOrder, true, true>(F.lds + RING_OFF, g, S, E); }
        { pg8::Gemm g{(const bf16*)(ws + WS_MNB), (const bf16*)(ws + WS_WKV), MEMR, 2048, 1024}; pg8::StaticOrder S; S.init(MEMR, 2048, F.G, (int)((blockIdx.x + 64) % F.G));
          pg8::EpiKV E{F.out + O_MKP, F.out + O_MVP, (bf16*)(ws + WS_KB), (bf16*)(ws + WS_VT), (const float*)(ws + WS_SSQM)};
          pg8::gemm_phase<pg8::EpiKV, pg8::StaticOrder, true, true>(F.lds + RING_OFF, g, S, E); }
        if (BOTH(1)) GRID_BAR();
    }
    if (IN(2)) { bc_prep_phase(F); hg_prep_phase(F); if (BOTH(2)) GRID_BAR(); }
    if (IN(3)) { scan_phase(F); if (BOTH(3)) GRID_BAR(); }
    if (IN(4)) { const bool norm_first = (blockIdx.x >> 3) & 1;
      if (norm_first) { ssdnorm_phase(F); hgnorm_phase(F); }
      {
        pg8::Gemm g{(const bf16*)(ws + WS_YG), (const bf16*)(ws + WS_WSSD), TP, 1024, 2048}; pg8::StaticOrder S; S.init(TP, 1024, F.G, (int)blockIdx.x);
        LAS float* RT = (LAS float*)(F.lds + RING_OFF + RING_BYTES);
        { pg8::Unit u0; if (S.next(0, u0) && F.tid < 256) { const f32x4* sp = (const f32x4*)((const float*)(ws + WS_SSQSSD) + (size_t)(u0.pm * 256 + F.tid) * 32); float rsg[4];
#pragma unroll
            for (int j = 0; j < 4; ++j) { const f32x4 a = sp[2 * j], b = sp[2 * j + 1]; const float s = ((a.x + a.y) + (a.z + a.w)) + ((b.x + b.y) + (b.z + b.w)); rsg[j] = 1.0f / sqrtf(s * (1.0f / 512.0f) + EPS); }
            *(LAS f32x4*)(RT + 4 * F.tid) = (f32x4){rsg[0] / rsg[1], rsg[1] / rsg[2], rsg[2] / rsg[3], rsg[3]}; }
          __syncthreads(); }
        pg8::EpiGate<false, true> E{(bf16*)(ws + WS_MERGED), PROJ + (size_t)S_GS * SLOT_ELEMS, RT};
        pg8::gemm_phase<pg8::EpiGate<false, true>, pg8::StaticOrder, true, true, 1, true>(F.lds + RING_OFF, g, S, E, RT);
      }
      if (!norm_first) { ssdnorm_phase(F); hgnorm_phase(F); }
      if (BOTH(4)) GRID_BAR(); }
    if (IN(5)) { { SmGate<false> Es{(bf16*)(ws + WS_MERGED), PROJ + (size_t)S_GS * SLOT_ELEMS}; small_tile_phase(F, (const bf16*)(ws + WS_YG), (const bf16*)(ws + WS_WSSD), 2048, Es); }
    }
    if (IN(5)) { { SmGate<true> Es{(bf16*)(ws + WS_MERGED), PROJ + (size_t)S_GH * SLOT_ELEMS}; small_tile_phase(F, (const bf16*)(ws + WS_ON), (const bf16*)(ws + WS_WHG), 1024, Es); }
        pg8::Gemm g{(const bf16*)(ws + WS_ON), (const bf16*)(ws + WS_WHG), TP, 1024, 1024}; pg8::StaticOrder S; S.init(TP, 1024, F.G, (int)blockIdx.x);
        pg8::EpiGate<true> E{(bf16*)(ws + WS_MERGED), PROJ + (size_t)S_GH * SLOT_ELEMS};
        pg8::gemm_phase<pg8::EpiGate<true>, pg8::StaticOrder, true, true>(F.lds + RING_OFF, g, S, E);
        if (BOTH(5)) GRID_BAR(); }
    if (IN(6)) { { SmRes<true, true> Es{nullptr, XB, (bf16*)(ws + WS_HB), (float*)(ws + WS_SSQP1), (const float*)(ws + WS_SSQX)}; small_tile_phase(F, (const bf16*)(ws + WS_MERGED), (const bf16*)(ws + WS_WOUT), 1024, Es); }
        pg8::Gemm g{(const bf16*)(ws + WS_MERGED), (const bf16*)(ws + WS_WOUT), TP, 1024, 1024}; pg8::StaticOrder S; S.init(TP, 1024, F.G, (int)blockIdx.x);
        pg8::EpiRes<true, true> E{nullptr, nullptr, XB, (bf16*)(ws + WS_HB), (float*)(ws + WS_SSQP1), (const float*)(ws + WS_SSQX)};
        pg8::gemm_phase<pg8::EpiRes<true, true>, pg8::StaticOrder, true, true>(F.lds + RING_OFF, g, S, E);
        if (BOTH(6)) GRID_BAR(); }
    if (IN(7)) { { SmScale Es{(bf16*)(ws + WS_QB), (const float*)(ws + WS_SSQP1), QSCALE}; small_tile_phase(F, (const bf16*)(ws + WS_HB), (const bf16*)(ws + WS_WCQ), 1024, Es); }
        pg8::Gemm g{(const bf16*)(ws + WS_HB), (const bf16*)(ws + WS_WCQ), TP, 1024, 1024}; pg8::StaticOrder S; S.init(TP, 1024, F.G, (int)blockIdx.x);
        pg8::EpiScaleBf16<16, false> E{(bf16*)(ws + WS_QB), SLOT_ELEMS, (const float*)(ws + WS_SSQP1), QSCALE, nullptr};
        pg8::gemm_phase<pg8::EpiScaleBf16<16, false>, pg8::StaticOrder, true, true>(F.lds + RING_OFF, g, S, E);
        if (BOTH(7)) GRID_BAR(); }
    if (IN(8)) { attn_phase(F); if (BOTH(8)) GRID_BAR(); }
    if (IN(9)) { { SmRes<true> Es{nullptr, (const bf16*)(ws + WS_HB), (bf16*)(ws + WS_HB), (float*)(ws + WS_SSQP2)}; small_tile_phase(F, (const bf16*)(ws + WS_OB), (const bf16*)(ws + WS_WCO), 1024, Es); }
        pg8::Gemm g{(const bf16*)(ws + WS_OB), (const bf16*)(ws + WS_WCO), TP, 1024, 1024}; pg8::StaticOrder S; S.init(TP, 1024, F.G, (int)blockIdx.x);
        pg8::EpiRes<true> E{nullptr, nullptr, (const bf16*)(ws + WS_HB), (bf16*)(ws + WS_HB), (float*)(ws + WS_SSQP2)};
        pg8::gemm_phase<pg8::EpiRes<true>, pg8::StaticOrder, true, true>(F.lds + RING_OFF, g, S, E);
        if (BOTH(9)) GRID_BAR(); }
    if (IN(10)) { pg8::Gemm g{(const bf16*)(ws + WS_HB), (const bf16*)(ws + WS_WGU), T, 2 * FFN, 1024}; pg8::StaticOrder S; S.init(T, 2 * FFN, F.G, (int)blockIdx.x);
        pg8::EpiSwiglu E{(bf16*)(ws + WS_ACT), (const float*)(ws + WS_SSQP2)};
        pg8::gemm_phase<pg8::EpiSwiglu, pg8::StaticOrder, true, true>(F.lds + RING_OFF, g, S, E);
        if (BOTH(10)) GRID_BAR(); }
    if (IN(11)) { { SmRes<true> Es{nullptr, (const bf16*)(ws + WS_HB), (bf16*)(ws + WS_HB), (float*)(ws + WS_SSQP3)}; small_tile_phase(F, (const bf16*)(ws + WS_ACT), (const bf16*)(ws + WS_WDN), FFN, Es); }
        pg8::Gemm g{(const bf16*)(ws + WS_ACT), (const bf16*)(ws + WS_WDN), TP, 1024, FFN}; pg8::StaticOrder S; S.init(TP, 1024, F.G, (int)blockIdx.x);
        pg8::EpiRes<true> E{nullptr, nullptr, (const bf16*)(ws + WS_HB), (bf16*)(ws + WS_HB), (float*)(ws + WS_SSQP3)};
        pg8::gemm_phase<pg8::EpiRes<true>, pg8::StaticOrder, true, true>(F.lds + RING_OFF, g, S, E);
        if (BOTH(11)) GRID_BAR(); }
    if (IN(12)) final_norm_phase(F);
#undef IN
#undef BOTH
}

extern "C" void kernel_launch(void* const* d_in, const int* in_sizes, int n_in, void* d_out, int out_size, void* d_ws, size_t ws_size, hipStream_t stream) {
    static int grid = 0;
    if (grid == 0) {
        const int want[32] = {TP * 1024, TS * 1024, MEMR * 1024, 33554432, 1179648, 16777216, 33554432, 33554432, 1024, 1024 * 11296, 4 * 3072, 3072, 32, 32, 32, 2048, 2048 * 1024, 2048, 1024,
                              1024 * 1024, 1024 * 1024, 1024, 1024, 1024 * 1024, 1024 * 1024, 1024 * 1024, 1024 * 1024, 1024, 1024 * FFN, 1024 * FFN, FFN * 1024, 1024};
        bool ok = (n_in == 32); for (int i = 0; ok && i < 32; ++i) if (in_sizes[i] != want[i]) { fprintf(stderr, "kernel_launch: input %d has %d elements, expected %d\n", i, in_sizes[i], want[i]); ok = false; }
        if (!ok || out_size != (int)O_END || ws_size < WS_END4) { fprintf(stderr, "kernel_launch: unexpected shapes: n_in %d out %d ws %zu\n", n_in, out_size, ws_size); grid = -1; return; }
        int dev = 0, cus = 0, per_cu = 0;
        if (hipGetDevice(&dev) != hipSuccess || hipDeviceGetAttribute(&cus, hipDeviceAttributeMultiprocessorCount, dev) != hipSuccess) { grid = -1; return; }
        if (hipFuncSetAttribute((const void*)skel_fwd, hipFuncAttributeMaxDynamicSharedMemorySize, LDS_BYTES) != hipSuccess) { fprintf(stderr, "kernel_launch: hipFuncSetAttribute failed\n"); grid = -1; return; }
        if (hipOccupancyMaxActiveBlocksPerMultiprocessor(&per_cu, (const void*)skel_fwd, NTHR, LDS_BYTES) != hipSuccess || per_cu < 1) fprintf(stderr, "kernel_launch: occupancy query reports %d blocks per CU\n", per_cu);
        (void)hipGetLastError();
        grid = cus;
    }
    if (grid < 0) return;
    (void)hipMemsetAsync((char*)d_ws + WS_CTL, 0, CTL_ZERO_BYTES, stream);
    Args a{};
    for (int i = 0; i < 32; ++i) a.in[i] = (const float*)d_in[i];
    a.out = (float*)d_out; a.ws = (unsigned char*)d_ws;
    for (int li = 0; li < N_LAUNCHES; ++li) {
        a.ph_lo = (N_LAUNCHES == PER_PHASE) ? li : 0; a.ph_hi = (N_LAUNCHES == PER_PHASE) ? li + 1 : PER_PHASE;
        hipLaunchKernelGGL(skel_fwd, dim3(grid), dim3(NTHR), LDS_BYTES, stream, a);
    }
}
```
